# Optimizing an MI355X kernel written in HIP

```python
import math
import jax
import jax.numpy as jnp
from jax import lax
import numpy as np

D_MODEL = 1024
BATCH = 8
SEQ = 2048
DEPTH = 4

GRID_W = 64
CTX_LEN = 256
N_EVEN = (DEPTH + 1) // 2
N_ODD = DEPTH // 2
NORM_EPS = 1e-6
ROPE_THETA = 10000.0
N_MOD = 6

ML_HEADS = 4
ML_DQK = 64
ML_DV = 128
ML_CHUNK = 64
ML_CONV = 3
ML_W = ML_HEADS * ML_DV

DA_HEADS = 4
DA_DQK = 64
DA_DV = 128
DA_W = DA_HEADS * DA_DV
Q_BLOCK = 128

EVEN_SIZES = (2 * ML_HEADS * ML_DQK, ML_W, ML_W, 4 * ML_HEADS,
              DA_HEADS * 2 * DA_DQK, DA_HEADS * 2 * DA_DQK, DA_W)
EVEN_IN = sum(EVEN_SIZES)
EVEN_SPLITS = tuple(sum(EVEN_SIZES[:i + 1]) for i in range(len(EVEN_SIZES) - 1))
MIX_W = ML_W + DA_W

WA_HEADS = 16
WA_KV_HEADS = 4
WA_GROUP = WA_HEADS // WA_KV_HEADS
WA_DH = 64
WINDOW = 128
W_BLOCK = WINDOW
WA_W = WA_HEADS * WA_DH
WA_KV_W = WA_KV_HEADS * WA_DH
ODD_IN = WA_W + 2 * WA_KV_W
ODD_SPLITS = (WA_W, WA_W + WA_KV_W)

PEER_HEADS = 8
PEER_NKEYS = 128
PEER_EXPERTS = PEER_NKEYS * PEER_NKEYS
PEER_DQ = 256
PEER_DHALF = PEER_DQ // 2
PEER_TOPK = 16
PEER_TOK_BLOCK = 128

kernel_name = 'hybrid_mlstm_diffattn_swa_peer_dit'


def _rmsnorm(x, g):
    xf = x.astype(jnp.float32)
    y = xf * lax.rsqrt(jnp.mean(xf * xf, axis=-1, keepdims=True) + NORM_EPS)
    return (y * g.astype(jnp.float32)).astype(x.dtype)


def _headnorm(x, g):
    xf = x.astype(jnp.float32)
    y = xf * lax.rsqrt(jnp.mean(xf * xf, axis=-1, keepdims=True) + NORM_EPS)
    y = y * g.astype(jnp.float32).reshape(x.shape[-2:])
    return y.reshape(x.shape[:-2] + (-1,))


def _axial_rope_tables(n_tok, dim):
    rows = n_tok // GRID_W
    r = jnp.repeat(jnp.arange(rows, dtype=jnp.float32), GRID_W)
    col = jnp.broadcast_to(jnp.arange(GRID_W, dtype=jnp.float32), (rows, GRID_W)).reshape(-1)
    nf = dim // 4
    inv = ROPE_THETA ** (-jnp.arange(nf, dtype=jnp.float32) / nf)
    ang = jnp.concatenate([r[:, None] * inv, col[:, None] * inv], axis=-1)
    return jnp.cos(ang), jnp.sin(ang)


def _apply_rope(x, cos, sin):
    shp = (x.shape[1],) + (1,) * (x.ndim - 3) + (cos.shape[-1],)
    cs = cos.reshape(shp)
    sn = sin.reshape(shp)
    xf = x.astype(jnp.float32)
    x1, x2 = jnp.split(xf, 2, axis=-1)
    return jnp.concatenate([x1 * cs - x2 * sn, x1 * sn + x2 * cs], axis=-1).astype(x.dtype)


def _centred_conv(x, w, b):
    taps = w.shape[0]
    p = taps // 2
    t = x.shape[1]
    xp = jnp.pad(x, ((0, 0), (p, p), (0, 0)))
    out = b
    for j in range(taps):
        out = out + xp[:, j:j + t] * w[j]
    return out


def _mlstm_prepare(qk, v, g, conv_w, conv_b, gate_b):
    bsz, t, _ = qk.shape
    qk = jax.nn.silu(_centred_conv(qk, conv_w, conv_b))
    q, k = jnp.split(qk, 2, axis=-1)

    def heads(a, d):
        return a.reshape(bsz, t, ML_HEADS, d).transpose(0, 2, 1, 3).astype(jnp.float32)

    q = heads(q, ML_DQK)
    k = heads(k, ML_DQK) * (ML_DQK ** -0.5)
    v = heads(v, ML_DV)
    g = (g + gate_b).astype(jnp.float32).reshape(bsz, t, 4, ML_HEADS).transpose(2, 0, 3, 1)
    return (q, k, v, g[0], jax.nn.log_sigmoid(g[1]), g[2], jax.nn.log_sigmoid(g[3]))


def _mlstm_state0(bsz):
    return (jnp.zeros((bsz, ML_HEADS, ML_DV, ML_DQK), jnp.float32),
            jnp.zeros((bsz, ML_HEADS, ML_DQK), jnp.float32),
            jnp.zeros((bsz, ML_HEADS), jnp.float32))


def _mlstm_chunk_scan(q, k, v, ig, lf, state):
    bsz, nh, t, _ = q.shape
    nc = t // ML_CHUNK

    def to_chunks(a):
        return jnp.moveaxis(a.reshape((bsz, nh, nc, ML_CHUNK) + a.shape[3:]), 2, 0)

    tri = jnp.tril(jnp.ones((ML_CHUNK, ML_CHUNK), dtype=bool))

    def step(carry, xs):
        c_st, n_st, m_st = carry
        qc, kc, vc, ic, fc = xs
        b = jnp.cumsum(fc, axis=-1)
        log_d = jnp.where(tri, b[..., :, None] - b[..., None, :] + ic[..., None, :], -jnp.inf)
        inter = b + m_st[..., None]
        m_t = jnp.maximum(inter, jnp.max(log_d, axis=-1))
        s = jnp.einsum('bhtd,bhsd->bhts', qc, kc) * jnp.exp(log_d - m_t[..., None])
        w_inter = jnp.exp(inter - m_t)
        num = (jnp.einsum('bhts,bhsv->bhtv', s, vc)
               + w_inter[..., None] * jnp.einsum('bhvd,bhtd->bhtv', c_st, qc))
        den = jnp.sum(s, axis=-1) + w_inter * jnp.einsum('bhd,bhtd->bht', n_st, qc)
        h = num / jnp.maximum(jnp.abs(den), jnp.exp(-m_t))[..., None]
        b_last = b[..., -1]
        log_w = b_last[..., None] - b + ic
        m_new = jnp.maximum(b_last + m_st, jnp.max(log_w, axis=-1))
        wk = jnp.exp(log_w - m_new[..., None])
        decay = jnp.exp(b_last + m_st - m_new)
        c_new = decay[..., None, None] * c_st + jnp.einsum('bhs,bhsv,bhsd->bhvd', wk, vc, kc)
        n_new = decay[..., None] * n_st + jnp.einsum('bhs,bhsd->bhd', wk, kc)
        return (c_new, n_new, m_new), h

    state, hs = lax.scan(step, state, tuple(to_chunks(a) for a in (q, k, v, ig, lf)))
    h = jnp.moveaxis(hs, 0, 2).reshape(bsz, nh, t, -1)
    return h, state


def _mlstm_bidir(lat, ctx_in):
    ql, kl, vl, il_f, fl_f, il_b, fl_b = lat
    qc, kc, vc, ic_f, fc_f, ic_b, fc_b = ctx_in
    bsz = ql.shape[0]

    def rev(a):
        return jnp.flip(a, axis=2)

    hc_f, st_f = _mlstm_chunk_scan(qc, kc, vc, ic_f, fc_f, _mlstm_state0(bsz))
    hl_f, _ = _mlstm_chunk_scan(ql, kl, vl, il_f, fl_f, st_f)
    hc_b, st_b = _mlstm_chunk_scan(rev(qc), rev(kc), rev(vc), rev(ic_b), rev(fc_b), _mlstm_state0(bsz))
    hl_b, _ = _mlstm_chunk_scan(rev(ql), rev(kl), rev(vl), rev(il_b), rev(fl_b), st_b)
    return hl_f + rev(hl_b), hc_f + rev(hc_b)


def _mlstm_out(h, o, g, dtype):
    y = _headnorm(h.transpose(0, 2, 1, 3), g)
    return (y * jax.nn.sigmoid(o.astype(jnp.float32))).astype(dtype)


def _da_heads(q, k, v):
    bsz, t, _ = q.shape
    return (q.reshape(bsz, t, DA_HEADS, 2, DA_DQK),
            k.reshape(bsz, t, DA_HEADS, 2, DA_DQK),
            v.reshape(bsz, t, DA_HEADS, DA_DV))


def _diff_lambda(lp, lam_init):
    lp = lp.astype(jnp.float32)
    return jnp.exp(jnp.sum(lp[0] * lp[1])) - jnp.exp(jnp.sum(lp[2] * lp[3])) + lam_init


def _diff_attend(q, k, v, lam):
    s = jnp.einsum('bqhmd,bkhmd->bhmqk', q, k).astype(jnp.float32) * (DA_DQK ** -0.5)
    p = jax.nn.softmax(s, axis=-1)
    p = p[:, :, 0] - lam * p[:, :, 1]
    return jnp.einsum('bhqk,bkhv->bqhv', p.astype(v.dtype), v)


def _blocked_queries(fn, q):
    bsz, s = q.shape[:2]
    nb = s // Q_BLOCK
    qb = jnp.moveaxis(q.reshape((bsz, nb, Q_BLOCK) + q.shape[2:]), 1, 0)
    out = jnp.moveaxis(lax.map(fn, qb), 0, 1)
    return out.reshape((bsz, s) + out.shape[3:])


def _da_out(o, g, lam_init, dtype):
    return (_headnorm(o, g) * (1.0 - lam_init)).astype(dtype)


def _even_mixer(xl, xc, w_in, conv_w, conv_b, gate_b, ml_g, da_lam, da_g, w_out,
                lam_init, cos, sin, need_ctx):
    dt = xl.dtype
    pl = jnp.split(xl @ w_in, EVEN_SPLITS, axis=-1)
    pc = jnp.split(xc @ w_in, EVEN_SPLITS, axis=-1)
    lat = _mlstm_prepare(pl[0], pl[1], pl[3], conv_w, conv_b, gate_b)
    cin = _mlstm_prepare(pc[0], pc[1], pc[3], conv_w, conv_b, gate_b)
    hl, hc = _mlstm_bidir(lat, cin)
    ml_l = _mlstm_out(hl, pl[2], ml_g, dt)
    lam = _diff_lambda(da_lam, lam_init)
    ql, kl, vl = _da_heads(pl[4], pl[5], pl[6])
    qc, kc, vc = _da_heads(pc[4], pc[5], pc[6])
    ql = _apply_rope(ql, cos, sin)
    kl = _apply_rope(kl, cos, sin)
    kk = jnp.concatenate([kc, kl], axis=1)
    vv = jnp.concatenate([vc, vl], axis=1)
    da_l = _blocked_queries(lambda qb: _diff_attend(qb, kk, vv, lam), ql)
    yl = jnp.concatenate([ml_l, _da_out(da_l, da_g, lam_init, dt)], axis=-1) @ w_out
    yc = None
    if need_ctx:
        ml_c = _mlstm_out(hc, pc[2], ml_g, dt)
        da_c = _da_out(_diff_attend(qc, kc, vc, lam), da_g, lam_init, dt)
        yc = jnp.concatenate([ml_c, da_c], axis=-1) @ w_out
    return yl, yc


def _sink_softmax(s, sink):
    sk = jnp.broadcast_to(sink[None, :, :, None, None], s.shape[:-1] + (1,))
    p = jax.nn.softmax(jnp.concatenate([s, sk], axis=-1), axis=-1)
    return p[..., :-1]


def _ctx_gqa_attend(q, kc, vc, sink):
    bsz, t = q.shape[:2]
    qg = q.reshape(bsz, t, WA_KV_HEADS, WA_GROUP, WA_DH)
    s = jnp.einsum('bqhgd,bkhd->bhgqk', qg, kc).astype(jnp.float32) * (WA_DH ** -0.5)
    p = _sink_softmax(s, sink)
    o = jnp.einsum('bhgqk,bkhd->bqhgd', p.astype(vc.dtype), vc)
    return o.reshape(bsz, t, WA_W)


def _window_attend(q, k, v, kc, vc, sink):
    bsz, s = q.shape[:2]
    nb = s // W_BLOCK
    tc = kc.shape[1]
    qb = q.reshape(bsz, nb, W_BLOCK, WA_KV_HEADS, WA_GROUP, WA_DH)
    pad = ((0, 0), (W_BLOCK, W_BLOCK), (0, 0), (0, 0))
    kp = jnp.pad(k, pad).reshape(bsz, nb + 2, W_BLOCK, WA_KV_HEADS, WA_DH)
    vp = jnp.pad(v, pad).reshape(bsz, nb + 2, W_BLOCK, WA_KV_HEADS, WA_DH)
    kw = jnp.concatenate([kp[:, :-2], kp[:, 1:-1], kp[:, 2:]], axis=2)
    vw = jnp.concatenate([vp[:, :-2], vp[:, 1:-1], vp[:, 2:]], axis=2)
    qpos = jnp.arange(nb)[:, None] * W_BLOCK + jnp.arange(W_BLOCK)[None, :]
    kpos = (jnp.arange(nb)[:, None] - 1) * W_BLOCK + jnp.arange(3 * W_BLOCK)[None, :]
    mask = ((jnp.abs(qpos[:, :, None] - kpos[:, None, :]) <= WINDOW)
            & (kpos[:, None, :] >= 0) & (kpos[:, None, :] < s))
    scale = WA_DH ** -0.5

    def blk(args):
        qi, ki, vi, mi = args
        s_loc = jnp.einsum('bqhgd,bkhd->bhgqk', qi, ki).astype(jnp.float32) * scale
        s_loc = jnp.where(mi, s_loc, -jnp.inf)
        s_ctx = jnp.einsum('bqhgd,bkhd->bhgqk', qi, kc).astype(jnp.float32) * scale
        p = _sink_softmax(jnp.concatenate([s_ctx, s_loc], axis=-1), sink).astype(vi.dtype)
        return (jnp.einsum('bhgqk,bkhd->bqhgd', p[..., :tc], vc)
                + jnp.einsum('bhgqk,bkhd->bqhgd', p[..., tc:], vi))

    out = lax.map(blk, (jnp.moveaxis(qb, 1, 0), jnp.moveaxis(kw, 1, 0), jnp.moveaxis(vw, 1, 0), mask))
    return jnp.moveaxis(out, 0, 1).reshape(bsz, s, WA_W)


def _odd_mixer(xl, xc, w_in, sink, w_out, cos, sin, need_ctx):
    bsz, s, _ = xl.shape
    tc = xc.shape[1]
    ql, kl, vl = jnp.split(xl @ w_in, ODD_SPLITS, axis=-1)
    ql = _apply_rope(ql.reshape(bsz, s, WA_HEADS, WA_DH), cos, sin)
    kl = _apply_rope(kl.reshape(bsz, s, WA_KV_HEADS, WA_DH), cos, sin)
    vl = vl.reshape(bsz, s, WA_KV_HEADS, WA_DH)
    kc, vc = jnp.split(xc @ w_in[:, WA_W:], 2, axis=-1)
    kc = kc.reshape(bsz, tc, WA_KV_HEADS, WA_DH)
    vc = vc.reshape(bsz, tc, WA_KV_HEADS, WA_DH)
    sink = sink.astype(jnp.float32).reshape(WA_KV_HEADS, WA_GROUP)
    yl = _window_attend(ql, kl, vl, kc, vc, sink) @ w_out
    yc = None
    if need_ctx:
        qc = (xc @ w_in[:, :WA_W]).reshape(bsz, tc, WA_HEADS, WA_DH)
        yc = _ctx_gqa_attend(qc, kc, vc, sink) @ w_out
    return yl, yc


def _peer_ffn(x, w_q, keys, u, v):
    shp = x.shape
    xb = x.reshape(-1, PEER_TOK_BLOCK, shp[-1])

    def block(xt):
        n = xt.shape[0]
        q = (xt @ w_q).reshape(n, PEER_HEADS, 2, PEER_DHALF)
        s = jnp.einsum('nhpd,hpkd->nhpk', q, keys).astype(jnp.float32)
        sv, si = lax.top_k(s, PEER_TOPK)
        cand = sv[:, :, 0, :, None] + sv[:, :, 1, None, :]
        cidx = si[:, :, 0, :, None] * PEER_NKEYS + si[:, :, 1, None, :]
        cs, ci = lax.top_k(cand.reshape(n, PEER_HEADS, -1), PEER_TOPK)
        eidx = jnp.take_along_axis(cidx.reshape(n, PEER_HEADS, -1), ci, axis=-1)
        gate = jax.nn.softmax(cs, axis=-1)
        a = jnp.einsum('nd,nhkd->nhk', xt, u[eidx]).astype(jnp.float32)
        w = (gate * jax.nn.gelu(a, approximate=False)).astype(xt.dtype)
        return jnp.einsum('nhk,nhkd->nd', w, v[eidx])

    return lax.map(block, xb).reshape(shp)


def setup_inputs(seed: int = 0) -> dict:
    key = jax.random.key(seed)
    ks = iter(jax.random.split(key, 32))

    def nrm(shape, scale):
        return jax.random.normal(next(ks), shape, jnp.float32) * scale

    d = D_MODEL
    zeros_h = jnp.zeros((ML_HEADS,), jnp.float32)
    f_bias = jnp.linspace(3.0, 6.0, ML_HEADS, dtype=jnp.float32)
    gate_base = jnp.concatenate([zeros_h, f_bias, zeros_h, f_bias])
    return {
        'x': nrm((BATCH, SEQ, d), 1.0),
        'c': nrm((BATCH, d), 1.0),
        'ctx': nrm((BATCH, CTX_LEN, d), 1.0),
        'c_ctx': nrm((d,), 1.0),
        'mod_w': nrm((DEPTH, d, N_MOD * d), 0.5 * d ** -0.5),
        'mod_b': nrm((DEPTH, N_MOD * d), 0.02),
        'norm1_g': 1.0 + nrm((DEPTH, d), 0.02),
        'norm2_g': 1.0 + nrm((DEPTH, d), 0.02),
        'ev_w_in': nrm((N_EVEN, d, EVEN_IN), d ** -0.5),
        'ev_ml_conv_w': nrm((N_EVEN, ML_CONV, 2 * ML_HEADS * ML_DQK), ML_CONV ** -0.5),
        'ev_ml_conv_b': nrm((N_EVEN, 2 * ML_HEADS * ML_DQK), 0.02),
        'ev_ml_gate_b': gate_base[None, :] + nrm((N_EVEN, 4 * ML_HEADS), 0.1),
        'ev_ml_norm_g': 1.0 + nrm((N_EVEN, ML_W), 0.02),
        'ev_da_lam': nrm((N_EVEN, 4, DA_DQK), 0.1),
        'ev_da_norm_g': 1.0 + nrm((N_EVEN, DA_W), 0.02),
        'ev_w_out': nrm((N_EVEN, MIX_W, d), MIX_W ** -0.5),
        'od_w_in': nrm((N_ODD, d, ODD_IN), d ** -0.5),
        'od_sink': nrm((N_ODD, WA_HEADS), 1.0),
        'od_w_out': nrm((N_ODD, WA_W, d), WA_W ** -0.5),
        'pr_w_q': nrm((DEPTH, d, PEER_HEADS * PEER_DQ), d ** -0.5),
        'pr_keys': nrm((DEPTH, PEER_HEADS, 2, PEER_NKEYS, PEER_DHALF), PEER_DHALF ** -0.5),
        'pr_u': nrm((DEPTH, PEER_EXPERTS, d), d ** -0.5),
        'pr_v': nrm((DEPTH, PEER_EXPERTS, d), PEER_HEADS ** -0.5),
        'final_g': 1.0 + nrm((d,), 0.02),
    }


def reference(x, c, ctx, c_ctx, mod_w, mod_b, norm1_g, norm2_g, ev_w_in, ev_ml_conv_w,
              ev_ml_conv_b, ev_ml_gate_b, ev_ml_norm_g, ev_da_lam, ev_da_norm_g, ev_w_out,
              od_w_in, od_sink, od_w_out, pr_w_q, pr_keys, pr_u, pr_v, final_g):
    bsz, s, d = x.shape
    cos_da, sin_da = _axial_rope_tables(s, DA_DQK)
    cos_wa, sin_wa = _axial_rope_tables(s, WA_DH)
    sc = jax.nn.silu(c)
    scc = jax.nn.silu(c_ctx)
    hl, hc = x, ctx
    for i in range(DEPTH):
        need_ctx = i < DEPTH - 1
        j = i // 2
        ml = (sc @ mod_w[i] + mod_b[i]).reshape(bsz, 1, N_MOD, d)
        mc = (scc @ mod_w[i] + mod_b[i]).reshape(N_MOD, d)
        xl = _rmsnorm(hl, norm1_g[i]) * (1.0 + ml[:, :, 1]) + ml[:, :, 0]
        xc = _rmsnorm(hc, norm1_g[i]) * (1.0 + mc[1]) + mc[0]
        if i % 2 == 0:
            lam_init = 0.8 - 0.6 * math.exp(-0.3 * i)
            yl, yc = _even_mixer(xl, xc, ev_w_in[j], ev_ml_conv_w[j], ev_ml_conv_b[j],
                                 ev_ml_gate_b[j], ev_ml_norm_g[j], ev_da_lam[j], ev_da_norm_g[j],
                                 ev_w_out[j], lam_init, cos_da, sin_da, need_ctx)
        else:
            yl, yc = _odd_mixer(xl, xc, od_w_in[j], od_sink[j], od_w_out[j],
                                cos_wa, sin_wa, need_ctx)
        hl = hl + ml[:, :, 2] * yl
        xl = _rmsnorm(hl, norm2_g[i]) * (1.0 + ml[:, :, 4]) + ml[:, :, 3]
        hl = hl + ml[:, :, 5] * _peer_ffn(xl, pr_w_q[i], pr_keys[i], pr_u[i], pr_v[i])
        if need_ctx:
            hc = hc + mc[2] * yc
            xc = _rmsnorm(hc, norm2_g[i]) * (1.0 + mc[4]) + mc[3]
            hc = hc + mc[5] * _peer_ffn(xc, pr_w_q[i], pr_keys[i], pr_u[i], pr_v[i])
    return _rmsnorm(hl, final_g)
```

```cpp
#include <hip/hip_runtime.h>
#include <hip/hip_cooperative_groups.h>
#include <cstdio>
#include <cstdint>
namespace cg = cooperative_groups;

#ifndef ONE_LAUNCH
#define ONE_LAUNCH 0
#endif

#define NT 18432
#define NL 16384
#define DM 1024
#define EVW 3088
#define ODW 1536
#define C_QK 0
#define C_V 512
#define C_O 1024
#define C_G 1536
#define C_DQ 1552
#define C_DK 2064
#define C_DV 2576
#define NPH 42

struct P {
    const float *x, *c, *ctx, *c_ctx, *mod_w, *mod_b, *norm1_g, *norm2_g, *ev_w_in, *ev_conv_w, *ev_conv_b, *ev_gate_b,
        *ev_ml_g, *ev_da_lam, *ev_da_g, *ev_w_out, *od_w_in, *od_sink, *od_w_out, *pr_w_q, *pr_keys, *pr_u, *pr_v, *final_g;
    float* out;
    float *modv, *H, *XN, *PROJ, *MIX, *QKC, *HM, *DAO, *Q, *GATE, *rope;
    int* EIDX;
    int ph_lo, ph_hi;
};

__device__ __forceinline__ int modrow(int r) { return r < NL ? (r >> 11) : 8; }
__device__ __forceinline__ float silu_f(float x) { return x / (1.f + expf(-x)); }
__device__ __forceinline__ float sigmoid_f(float x) { return 1.f / (1.f + expf(-x)); }
__device__ __forceinline__ float log_sigmoid_f(float x) { return fminf(x, 0.f) - log1pf(expf(-fabsf(x))); }
__device__ __forceinline__ float wave_sum(float v) {
#pragma unroll
    for (int o = 32; o > 0; o >>= 1) v += __shfl_xor(v, o);
    return v;
}

__device__ void ph_prologue(const P& p, float* smem) {
    const int tid = threadIdx.x, nb = gridDim.x, bid = blockIdx.x;
    {
        const float4* xs = (const float4*)p.x; const float4* cs = (const float4*)p.ctx; float4* hd = (float4*)p.H;
        const size_t nx = (size_t)NL * DM / 4, nc = (size_t)(NT - NL) * DM / 4;
        for (size_t i = (size_t)bid * 256 + tid; i < nx + nc; i += (size_t)nb * 256) hd[i] = i < nx ? xs[i] : cs[i - nx];
    }
    for (int i = bid * 256 + tid; i < 2048 * 32; i += nb * 256) {
        const int s = i >> 5, d = i & 31;
        const float pos = (d < 16) ? (float)(s >> 6) : (float)(s & 63);
        const float inv = powf(10000.0f, -(float)(d & 15) / 16.0f);
        const float ang = pos * inv;
        p.rope[2 * i] = cosf(ang); p.rope[2 * i + 1] = sinf(ang);
    }
    float* sc = smem;
    float* red = smem + 9 * 1024;
    for (int i = tid; i < 9 * 1024; i += 256) { const int r = i >> 10, k = i & 1023; const float v = r < 8 ? p.c[r * 1024 + k] : p.c_ctx[k]; sc[i] = silu_f(v); }
    __syncthreads();
    for (int item = bid; item < 4 * 96; item += nb) {
        const int L = item / 96, n0 = (item % 96) * 64, tx = tid & 63, kq = tid >> 6;
        float acc[9];
#pragma unroll
        for (int r = 0; r < 9; ++r) acc[r] = 0.f;
        const float* w = p.mod_w + (size_t)L * 1024 * 6144 + n0 + tx;
        for (int k = kq * 256; k < kq * 256 + 256; ++k) {
            const float wv = w[(size_t)k * 6144];
#pragma unroll
            for (int r = 0; r < 9; ++r) acc[r] += sc[r * 1024 + k] * wv;
        }
#pragma unroll
        for (int r = 0; r < 9; ++r) red[(kq * 9 + r) * 64 + tx] = acc[r];
        __syncthreads();
        if (kq == 0) {
#pragma unroll
            for (int r = 0; r < 9; ++r) {
                const float s = red[(0 * 9 + r) * 64 + tx] + red[(1 * 9 + r) * 64 + tx] + red[(2 * 9 + r) * 64 + tx] + red[(3 * 9 + r) * 64 + tx];
                p.modv[((size_t)L * 9 + r) * 6144 + n0 + tx] = s + p.mod_b[L * 6144 + n0 + tx];
            }
        }
        __syncthreads();
    }
}

__device__ void ph_normmod(const float* src, const float* g, const float* modv_layer, int shift_off, int scale_off, float* dst, int nrows) {
    const int lane = threadIdx.x & 63, wid = threadIdx.x >> 6;
    for (int r = blockIdx.x * 4 + wid; r < nrows; r += gridDim.x * 4) {
        const float4* s4 = (const float4*)(src + (size_t)r * DM);
        float4 v[4]; float ss = 0.f;
#pragma unroll
        for (int i = 0; i < 4; ++i) { v[i] = s4[i * 64 + lane]; ss += v[i].x * v[i].x + v[i].y * v[i].y + v[i].z * v[i].z + v[i].w * v[i].w; }
        ss = wave_sum(ss);
        const float rstd = rsqrtf(ss * (1.0f / DM) + 1e-6f);
        const float* mv = modv_layer + (size_t)modrow(r) * 6144;
        float4* d4 = (float4*)(dst + (size_t)r * DM);
#pragma unroll
        for (int i = 0; i < 4; ++i) {
            const int c = (i * 64 + lane) * 4;
            const float4 gg = *(const float4*)(g + c), sh = *(const float4*)(mv + shift_off + c), scl = *(const float4*)(mv + scale_off + c);
            float4 o;
            o.x = v[i].x * rstd * gg.x * (1.f + scl.x) + sh.x; o.y = v[i].y * rstd * gg.y * (1.f + scl.y) + sh.y;
            o.z = v[i].z * rstd * gg.z * (1.f + scl.z) + sh.z; o.w = v[i].w * rstd * gg.w * (1.f + scl.w) + sh.w;
            d4[i * 64 + lane] = o;
        }
    }
}

__device__ void ph_final(const P& p) {
    const int lane = threadIdx.x & 63, wid = threadIdx.x >> 6;
    for (int r = blockIdx.x * 4 + wid; r < NL; r += gridDim.x * 4) {
        const float4* s4 = (const float4*)(p.H + (size_t)r * DM);
        float4 v[4]; float ss = 0.f;
#pragma unroll
        for (int i = 0; i < 4; ++i) { v[i] = s4[i * 64 + lane]; ss += v[i].x * v[i].x + v[i].y * v[i].y + v[i].z * v[i].z + v[i].w * v[i].w; }
        ss = wave_sum(ss);
        const float rstd = rsqrtf(ss * (1.0f / DM) + 1e-6f);
        float4* d4 = (float4*)(p.out + (size_t)r * DM);
#pragma unroll
        for (int i = 0; i < 4; ++i) {
            const int c = (i * 64 + lane) * 4; const float4 gg = *(const float4*)(p.final_g + c);
            float4 o; o.x = v[i].x * rstd * gg.x; o.y = v[i].y * rstd * gg.y; o.z = v[i].z * rstd * gg.z; o.w = v[i].w * rstd * gg.w;
            d4[i * 64 + lane] = o;
        }
    }
}

template <int EPI>
__device__ void ph_gemm(const float* A, int lda, const float* B, int ldb, int M, int N, int K, float* C, int ldc, const float* gate_base, float* smem) {
    float (*As)[68] = (float (*)[68])smem;
    float (*Bs)[68] = (float (*)[68])(smem + 16 * 68);
    const int tid = threadIdx.x, tx = tid & 15, ty = tid >> 4;
    const int tm = M / 64, tn = (N + 63) / 64;
    for (int tile = blockIdx.x; tile < tm * tn; tile += gridDim.x) {
        const int m0 = (tile % tm) * 64, n0 = (tile / tm) * 64;
        float acc[4][4];
#pragma unroll
        for (int i = 0; i < 4; ++i)
#pragma unroll
            for (int j = 0; j < 4; ++j) acc[i][j] = 0.f;
        for (int k0 = 0; k0 < K; k0 += 16) {
            {
                const int row = tid >> 2, kq = (tid & 3) * 4;
                const float4 a = *(const float4*)(A + (size_t)(m0 + row) * lda + k0 + kq);
                As[kq + 0][row] = a.x; As[kq + 1][row] = a.y; As[kq + 2][row] = a.z; As[kq + 3][row] = a.w;
                const int brow = tid >> 4, c4 = (tid & 15) * 4;
                float4 b = make_float4(0.f, 0.f, 0.f, 0.f);
                if (n0 + c4 < N) b = *(const float4*)(B + (size_t)(k0 + brow) * ldb + n0 + c4);
                *(float4*)&Bs[brow][c4] = b;
            }
            __syncthreads();
#pragma unroll
            for (int kk = 0; kk < 16; ++kk) {
                const float4 a = *(const float4*)&As[kk][ty * 4];
                const float4 b = *(const float4*)&Bs[kk][tx * 4];
                const float av[4] = {a.x, a.y, a.z, a.w}, bv[4] = {b.x, b.y, b.z, b.w};
#pragma unroll
                for (int i = 0; i < 4; ++i)
#pragma unroll
                    for (int j = 0; j < 4; ++j) acc[i][j] += av[i] * bv[j];
            }
            __syncthreads();
        }
        const int cn = n0 + tx * 4;
        if (cn < N) {
#pragma unroll
            for (int i = 0; i < 4; ++i) {
                const int r = m0 + ty * 4 + i;
                float4* cp = (float4*)(C + (size_t)r * ldc + cn);
                if (EPI == 0) { *cp = make_float4(acc[i][0], acc[i][1], acc[i][2], acc[i][3]); }
                else {
                    const float4 g = *(const float4*)(gate_base + (size_t)modrow(r) * 6144 + cn);
                    float4 o = *cp; o.x += g.x * acc[i][0]; o.y += g.y * acc[i][1]; o.z += g.z * acc[i][2]; o.w += g.w * acc[i][3]; *cp = o;
                }
            }
        }
    }
}

__device__ __forceinline__ void rope_pair(float* rowp, int base, int d, const float* rp) {
    const float cs = rp[2 * d], sn = rp[2 * d + 1];
    const float x1 = rowp[base + d], x2 = rowp[base + d + 32];
    rowp[base + d] = x1 * cs - x2 * sn; rowp[base + d + 32] = x1 * sn + x2 * cs;
}
__device__ void ph_prep_even(const P& p, int j) {
    const float* cw = p.ev_conv_w + (size_t)j * 3 * 512; const float* cb = p.ev_conv_b + (size_t)j * 512;
    const size_t tot = (size_t)NT * 512;
    for (size_t i = (size_t)blockIdx.x * 256 + threadIdx.x; i < tot; i += (size_t)gridDim.x * 256) {
        const int r = (int)(i >> 9), c = (int)(i & 511);
        int t, T; if (r < NL) { t = r & 2047; T = 2048; } else { t = (r - NL) & 255; T = 256; }
        float v = cb[c] + p.PROJ[(size_t)r * EVW + c] * cw[512 + c];
        if (t > 0) v += p.PROJ[(size_t)(r - 1) * EVW + c] * cw[c];
        if (t < T - 1) v += p.PROJ[(size_t)(r + 1) * EVW + c] * cw[1024 + c];
        v = silu_f(v);
        if (c >= 256) v *= 0.125f;
        p.QKC[i] = v;
    }
    const size_t tot2 = (size_t)NL * 512;
    for (size_t i = (size_t)blockIdx.x * 256 + threadIdx.x; i < tot2; i += (size_t)gridDim.x * 256) {
        const int r = (int)(i >> 9), e = (int)(i & 511);
        const int d = e & 31, hm = (e >> 5) & 7, which = e >> 8;
        const int base = (which ? C_DK : C_DQ) + hm * 64;
        rope_pair(p.PROJ + (size_t)r * EVW, base, d, p.rope + (size_t)(r & 2047) * 64);
    }
}
__device__ void ph_prep_odd(const P& p) {
    const size_t tot = (size_t)NL * 640;
    for (size_t i = (size_t)blockIdx.x * 256 + threadIdx.x; i < tot; i += (size_t)gridDim.x * 256) {
        const int r = (int)(i / 640), e = (int)(i % 640);
        const int d = e & 31, hh = e >> 5;
        rope_pair(p.PROJ + (size_t)r * ODW, hh * 64, d, p.rope + (size_t)(r & 2047) * 64);
    }
}

template <bool MASK>
__device__ __forceinline__ void attn_seg(const float (&q)[64], float (&o)[64], float& m, float& l, const float* base, int ld, int krow0, int cnt,
                                         int kc, int vc, int qpos, int kpos0, float* sK, float* sV) {
    for (int t0 = 0; t0 < cnt; t0 += 32) {
        __syncthreads();
        for (int e = threadIdx.x; e < 32 * 16; e += 256) {
            const int kk = e >> 4, c4 = (e & 15) * 4;
            float4 kv = make_float4(0.f, 0.f, 0.f, 0.f), vv = kv;
            bool ok = true;
            if (MASK) { const int kpos = kpos0 + t0 + kk; ok = (kpos >= 0 && kpos < 2048); }
            if (ok) { const float* rp = base + (size_t)(krow0 + t0 + kk) * ld; kv = *(const float4*)(rp + kc + c4); vv = *(const float4*)(rp + vc + c4); }
            *(float4*)(sK + kk * 64 + c4) = kv; *(float4*)(sV + kk * 64 + c4) = vv;
        }
        __syncthreads();
        for (int kk = 0; kk < 32; ++kk) {
            if (MASK) { const int kpos = kpos0 + t0 + kk; const int dlt = qpos - kpos; if (!(dlt <= 128 && dlt >= -128 && kpos >= 0 && kpos < 2048)) continue; }
            float s = 0.f;
#pragma unroll
            for (int d = 0; d < 64; ++d) s += q[d] * sK[kk * 64 + d];
            const float mn = fmaxf(m, s), corr = expf(m - mn), pp = expf(s - mn);
            l = l * corr + pp;
#pragma unroll
            for (int d = 0; d < 64; ++d) o[d] = o[d] * corr + pp * sV[kk * 64 + d];
            m = mn;
        }
    }
}

__device__ void da_item(const P& p, int item, float* smem) {
    float* sK = smem; float* sV = smem + 2048;
    int b, h, mp, vh, qrow;
    const bool lat = item < 1024;
    if (lat) { const int qb = item & 7; vh = (item >> 3) & 1; mp = (item >> 4) & 1; h = (item >> 5) & 3; b = item >> 7; qrow = b * 2048 + qb * 256 + threadIdx.x; }
    else { const int it = item - 1024; vh = it & 1; mp = (it >> 1) & 1; h = (it >> 2) & 3; b = it >> 4; qrow = NL + b * 256 + threadIdx.x; }
    float q[64], o[64];
    const float* qp = p.PROJ + (size_t)qrow * EVW + C_DQ + h * 128 + mp * 64;
#pragma unroll
    for (int d = 0; d < 64; ++d) { q[d] = qp[d] * 0.125f; o[d] = 0.f; }
    float m = -INFINITY, l = 0.f;
    const int kc = C_DK + h * 128 + mp * 64, vc = C_DV + h * 128 + vh * 64;
    attn_seg<false>(q, o, m, l, p.PROJ, EVW, NL + b * 256, 256, kc, vc, 0, 0, sK, sV);
    if (lat) attn_seg<false>(q, o, m, l, p.PROJ, EVW, b * 2048, 2048, kc, vc, 0, 0, sK, sV);
    const float il = 1.f / l;
    float* op = p.DAO + ((size_t)mp * NT + qrow) * 512 + h * 128 + vh * 64;
#pragma unroll
    for (int d = 0; d < 64; ++d) op[d] = o[d] * il;
}

__device__ void wa_item(const P& p, int item, int j, float* smem) {
    float* sK = smem; float* sV = smem + 2048;
    const int qi = threadIdx.x & 127;
    const bool lat = item < 1024;
    int b, nbk, hh, qrow;
    if (lat) { hh = item & 7; nbk = (item >> 3) & 15; b = item >> 7; qrow = b * 2048 + nbk * 128 + qi; }
    else { const int it = item - 1024; hh = it & 7; nbk = (it >> 3) & 1; b = it >> 4; qrow = NL + b * 256 + nbk * 128 + qi; }
    const int hq = hh * 2 + (threadIdx.x >> 7), hkv = hh >> 1;
    float q[64], o[64];
    const float* qp = p.PROJ + (size_t)qrow * ODW + hq * 64;
#pragma unroll
    for (int d = 0; d < 64; ++d) { q[d] = qp[d] * 0.125f; o[d] = 0.f; }
    float m = p.od_sink[j * 16 + hq], l = 1.f;
    const int kc = 1024 + hkv * 64, vc = 1280 + hkv * 64;
    attn_seg<false>(q, o, m, l, p.PROJ, ODW, NL + b * 256, 256, kc, vc, 0, 0, sK, sV);
    if (lat) attn_seg<true>(q, o, m, l, p.PROJ, ODW, b * 2048 + (nbk - 1) * 128, 384, kc, vc, nbk * 128 + qi, (nbk - 1) * 128, sK, sV);
    const float il = 1.f / l;
    float* op = p.MIX + (size_t)qrow * DM + hq * 64;
#pragma unroll
    for (int d = 0; d < 64; ++d) op[d] = o[d] * il;
}

__device__ void mlstm_item(const P& p, int item, int j, float* smem) {
    const int dir = item & 1, h = (item >> 1) & 3, b = item >> 3;
    const int tid = threadIdx.x, vi = tid >> 1, kh = tid & 1;
    float* sq = smem;
    float* sk = smem + 32 * 64;
    float* sv = smem + 2 * 32 * 64;
    float* sg = smem + 2 * 32 * 64 + 32 * 128;
    int* srow = (int*)(sg + 64);
    float C[32], n[32];
#pragma unroll
    for (int i = 0; i < 32; ++i) { C[i] = 0.f; n[i] = 0.f; }
    float m = 0.f;
    const float gbi = p.ev_gate_b[j * 16 + (dir * 2) * 4 + h], gbf = p.ev_gate_b[j * 16 + (dir * 2 + 1) * 4 + h];
    float* hm = p.HM + (size_t)dir * NT * 512;
    for (int s0 = 0; s0 < 2304; s0 += 32) {
        __syncthreads();
        if (tid < 32) {
            const int st = s0 + tid; int row;
            if (st < 256) row = NL + b * 256 + (dir ? 255 - st : st);
            else { const int t = st - 256; row = b * 2048 + (dir ? 2047 - t : t); }
            srow[tid] = row;
            const float ig = p.PROJ[(size_t)row * EVW + C_G + (dir * 2) * 4 + h] + gbi;
            const float fg = p.PROJ[(size_t)row * EVW + C_G + (dir * 2 + 1) * 4 + h] + gbf;
            sg[tid * 2] = ig; sg[tid * 2 + 1] = log_sigmoid_f(fg);
        }
        __syncthreads();
        for (int e = tid; e < 32 * 256; e += 256) {
            const int st = e >> 8, c = e & 255; const int row = srow[st];
            if (c < 64) sq[st * 64 + c] = p.QKC[(size_t)row * 512 + h * 64 + c];
            else if (c < 128) sk[st * 64 + (c - 64)] = p.QKC[(size_t)row * 512 + 256 + h * 64 + (c - 64)];
            else sv[st * 128 + (c - 128)] = p.PROJ[(size_t)row * EVW + C_V + h * 128 + (c - 128)];
        }
        __syncthreads();
        for (int st = 0; st < 32; ++st) {
            const float ig = sg[st * 2], lf = sg[st * 2 + 1];
            const float mn = fmaxf(lf + m, ig);
            const float fd = expf(lf + m - mn), ie = expf(ig - mn);
            m = mn;
            const float vv = sv[st * 128 + vi] * ie;
            float num = 0.f, den = 0.f;
#pragma unroll
            for (int i = 0; i < 32; ++i) {
                const float kk = sk[st * 64 + kh * 32 + i], qq = sq[st * 64 + kh * 32 + i];
                C[i] = fd * C[i] + vv * kk; n[i] = fd * n[i] + ie * kk;
                num += C[i] * qq; den += n[i] * qq;
            }
            num += __shfl_xor(num, 1); den += __shfl_xor(den, 1);
            const float hv = num / fmaxf(fabsf(den), expf(-m));
            if (kh == 0) hm[(size_t)srow[st] * 512 + h * 128 + vi] = hv;
        }
    }
}

__device__ void ph_attn_even(const P& p, int j, float* smem) {
    for (int item = blockIdx.x; item < 64 + 1152; item += gridDim.x) {
        if (item < 64) mlstm_item(p, item, j, smem); else da_item(p, item - 64, smem);
        __syncthreads();
    }
}
__device__ void ph_attn_odd(const P& p, int j, bool need_ctx, float* smem) {
    const int nitem = need_ctx ? 1152 : 1024;
    for (int item = blockIdx.x; item < nitem; item += gridDim.x) { wa_item(p, item, j, smem); __syncthreads(); }
}

__device__ void ph_mixout_even(const P& p, int L, int j) {
    const int lane = threadIdx.x & 63, wid = threadIdx.x >> 6;
    const float lam_init = 0.8f - 0.6f * expf(-0.3f * (float)L);
    const float* lp = p.ev_da_lam + (size_t)j * 256;
    float a0 = lp[lane] * lp[64 + lane], a1 = lp[128 + lane] * lp[192 + lane];
    a0 = wave_sum(a0); a1 = wave_sum(a1);
    const float lam = expf(a0) - expf(a1) + lam_init;
    for (int w = blockIdx.x * 4 + wid; w < NT * 8; w += gridDim.x * 4) {
        const int r = w >> 3, hh = w & 7;
        if (hh < 4) {
            const int c = hh * 128 + lane * 2;
            const float2 f = *(const float2*)(p.HM + (size_t)r * 512 + c), bk = *(const float2*)(p.HM + (size_t)NT * 512 + (size_t)r * 512 + c);
            const float v0 = f.x + bk.x, v1 = f.y + bk.y;
            const float ss = wave_sum(v0 * v0 + v1 * v1);
            const float rstd = rsqrtf(ss * (1.f / 128.f) + 1e-6f);
            const float2 g = *(const float2*)(p.ev_ml_g + (size_t)j * 512 + c), og = *(const float2*)(p.PROJ + (size_t)r * EVW + C_O + c);
            float2 o; o.x = v0 * rstd * g.x * sigmoid_f(og.x); o.y = v1 * rstd * g.y * sigmoid_f(og.y);
            *(float2*)(p.MIX + (size_t)r * DM + c) = o;
        } else {
            const int c = (hh - 4) * 128 + lane * 2;
            const float2 d0 = *(const float2*)(p.DAO + (size_t)r * 512 + c), d1 = *(const float2*)(p.DAO + (size_t)NT * 512 + (size_t)r * 512 + c);
            const float v0 = d0.x - lam * d1.x, v1 = d0.y - lam * d1.y;
            const float ss = wave_sum(v0 * v0 + v1 * v1);
            const float rstd = rsqrtf(ss * (1.f / 128.f) + 1e-6f);
            const float2 g = *(const float2*)(p.ev_da_g + (size_t)j * 512 + c);
            float2 o; o.x = v0 * rstd * g.x * (1.f - lam_init); o.y = v1 * rstd * g.y * (1.f - lam_init);
            *(float2*)(p.MIX + (size_t)r * DM + 512 + c) = o;
        }
    }
}

__device__ void ph_peer_select(const P& p, int L, int nrows, float* smem) {
    float* qs = smem;
    float* ss = smem + 256;
    float* sv = smem + 512;
    int* si = (int*)(smem + 544);
    float* cand = smem + 576;
    float* cs = smem + 832;
    int* ce = (int*)(smem + 848);
    const int tid = threadIdx.x, pp = tid >> 7, k = tid & 127;
    for (int item = blockIdx.x; item < nrows * 8; item += gridDim.x) {
        const int r = item >> 3, h = item & 7;
        __syncthreads();
        qs[tid] = p.Q[(size_t)r * 2048 + h * 256 + tid];
        __syncthreads();
        {
            const float4* kp = (const float4*)(p.pr_keys + ((((size_t)L * 8 + h) * 2 + pp) * 128 + k) * 128);
            float s = 0.f;
#pragma unroll 8
            for (int d = 0; d < 32; ++d) { const float4 kv = kp[d]; const float* qq = qs + pp * 128 + d * 4; s += qq[0] * kv.x + qq[1] * kv.y + qq[2] * kv.z + qq[3] * kv.w; }
            ss[tid] = s;
        }
        __syncthreads();
        {
            const float me = ss[tid]; int rank = 0;
            for (int k2 = 0; k2 < 128; ++k2) { const float o = ss[pp * 128 + k2]; rank += (o > me || (o == me && k2 < k)) ? 1 : 0; }
            if (rank < 16) { sv[pp * 16 + rank] = me; si[pp * 16 + rank] = k; }
        }
        __syncthreads();
        const int ci = tid >> 4, cj = tid & 15;
        const float cme = sv[ci] + sv[16 + cj];
        cand[tid] = cme;
        __syncthreads();
        {
            int rank = 0;
            for (int t2 = 0; t2 < 256; ++t2) { const float o = cand[t2]; rank += (o > cme || (o == cme && t2 < tid)) ? 1 : 0; }
            if (rank < 16) { cs[rank] = cme; ce[rank] = si[ci] * 128 + si[16 + cj]; }
        }
        __syncthreads();
        if (tid < 16) {
            const float mx = cs[0]; float sum = 0.f;
            for (int t2 = 0; t2 < 16; ++t2) sum += expf(cs[t2] - mx);
            p.GATE[(size_t)r * 128 + h * 16 + tid] = expf(cs[tid] - mx) / sum;
            p.EIDX[(size_t)r * 128 + h * 16 + tid] = ce[tid];
        }
    }
}

__device__ void ph_peer_gather(const P& p, int L, int nrows, float* smem) {
    const int tid = threadIdx.x, lane = tid & 63, wid = tid >> 6;
    const float* U = p.pr_u + (size_t)L * 16384 * 1024; const float* V = p.pr_v + (size_t)L * 16384 * 1024;
    const float* gate2 = p.modv + (size_t)L * 9 * 6144 + 5120;
    for (int r = blockIdx.x; r < nrows; r += gridDim.x) {
        const float4* x4 = (const float4*)(p.XN + (size_t)r * DM);
        float4 xv[4], acc[4];
#pragma unroll
        for (int i = 0; i < 4; ++i) { xv[i] = x4[i * 64 + lane]; acc[i] = make_float4(0.f, 0.f, 0.f, 0.f); }
        for (int e = 0; e < 32; ++e) {
            const int idx = p.EIDX[(size_t)r * 128 + wid * 32 + e]; const float g = p.GATE[(size_t)r * 128 + wid * 32 + e];
            const float4* u4 = (const float4*)(U + (size_t)idx * 1024);
            float s = 0.f;
#pragma unroll
            for (int i = 0; i < 4; ++i) { const float4 uv = u4[i * 64 + lane]; s += xv[i].x * uv.x + xv[i].y * uv.y + xv[i].z * uv.z + xv[i].w * uv.w; }
            s = wave_sum(s);
            const float wgt = g * 0.5f * s * (1.f + erff(s * 0.70710678118654752f));
            const float4* v4 = (const float4*)(V + (size_t)idx * 1024);
#pragma unroll
            for (int i = 0; i < 4; ++i) { const float4 vv = v4[i * 64 + lane]; acc[i].x += wgt * vv.x; acc[i].y += wgt * vv.y; acc[i].z += wgt * vv.z; acc[i].w += wgt * vv.w; }
        }
        __syncthreads();
#pragma unroll
        for (int i = 0; i < 4; ++i) *(float4*)(smem + wid * 1024 + (i * 64 + lane) * 4) = acc[i];
        __syncthreads();
        {
            const int c = tid * 4;
            const float4 a0 = *(const float4*)(smem + c), a1 = *(const float4*)(smem + 1024 + c), a2 = *(const float4*)(smem + 2048 + c), a3 = *(const float4*)(smem + 3072 + c);
            const float4 g = *(const float4*)(gate2 + (size_t)modrow(r) * 6144 + c);
            float4* hp = (float4*)(p.H + (size_t)r * DM + c);
            float4 hv = *hp;
            hv.x += g.x * (a0.x + a1.x + a2.x + a3.x); hv.y += g.y * (a0.y + a1.y + a2.y + a3.y);
            hv.z += g.z * (a0.z + a1.z + a2.z + a3.z); hv.w += g.w * (a0.w + a1.w + a2.w + a3.w);
            *hp = hv;
        }
    }
}

__device__ void run_phase(const P& p, int ph, float* smem) {
    if (ph == 0) { ph_prologue(p, smem); return; }
    if (ph == NPH - 1) { ph_final(p); return; }
    const int L = (ph - 1) / 10, s = (ph - 1) % 10, j = L >> 1;
    const bool even = (L & 1) == 0, need_ctx = L < 3;
    const int nrows = need_ctx ? NT : NL;
    const float* mv = p.modv + (size_t)L * 9 * 6144;
    switch (s) {
    case 0: ph_normmod(p.H, p.norm1_g + L * DM, mv, 0, 1024, p.XN, NT); break;
    case 1:
        if (even) ph_gemm<0>(p.XN, DM, p.ev_w_in + (size_t)j * DM * EVW, EVW, NT, EVW, DM, p.PROJ, EVW, nullptr, smem);
        else ph_gemm<0>(p.XN, DM, p.od_w_in + (size_t)j * DM * ODW, ODW, NT, ODW, DM, p.PROJ, ODW, nullptr, smem);
        break;
    case 2: if (even) ph_prep_even(p, j); else ph_prep_odd(p); break;
    case 3: if (even) ph_attn_even(p, j, smem); else ph_attn_odd(p, j, need_ctx, smem); break;
    case 4: if (even) ph_mixout_even(p, L, j); break;
    case 5:
        if (even) ph_gemm<1>(p.MIX, DM, p.ev_w_out + (size_t)j * DM * DM, DM, nrows, DM, DM, p.H, DM, mv + 2048, smem);
        else ph_gemm<1>(p.MIX, DM, p.od_w_out + (size_t)j * DM * DM, DM, nrows, DM, DM, p.H, DM, mv + 2048, smem);
        break;
    case 6: ph_normmod(p.H, p.norm2_g + L * DM, mv, 3072, 4096, p.XN, nrows); break;
    case 7: ph_gemm<0>(p.XN, DM, p.pr_w_q + (size_t)L * DM * 2048, 2048, nrows, 2048, DM, p.Q, 2048, nullptr, smem); break;
    case 8: ph_peer_select(p, L, nrows, smem); break;
    case 9: ph_peer_gather(p, L, nrows, smem); break;
    }
}

__global__ void __launch_bounds__(256) mega(P p) {
    __shared__ __attribute__((aligned(16))) float smem[12288];
    cg::grid_group grid = cg::this_grid();
    for (int ph = p.ph_lo; ph < p.ph_hi; ++ph) {
        run_phase(p, ph, smem);
        if (ph + 1 < p.ph_hi) grid.sync();
    }
}

extern "C" void kernel_launch(void* const* d_in, const int* in_sizes, int n_in, void* d_out, int out_size, void* d_ws, size_t ws_size, hipStream_t stream) {
    static int grid_blocks = 0;
    if (!grid_blocks) {
        int dev = 0, cus = 0, per_cu = 0;
        hipGetDevice(&dev);
        hipDeviceGetAttribute(&cus, hipDeviceAttributeMultiprocessorCount, dev);
        hipOccupancyMaxActiveBlocksPerMultiprocessor(&per_cu, mega, 256, 0);
        if (per_cu < 1) per_cu = 1;
        if (per_cu > 4) per_cu = 4;
        grid_blocks = cus * per_cu;
    }
    P p{};
    const float** ins = (const float**)&p;
    for (int i = 0; i < 24; ++i) ins[i] = (const float*)d_in[i];
    p.out = (float*)d_out;
    size_t off = 0; char* ws = (char*)d_ws;
    auto carve = [&](size_t bytes) { void* r = ws + off; off += (bytes + 255) & ~(size_t)255; return r; };
    p.modv = (float*)carve((size_t)4 * 9 * 6144 * 4);
    p.rope = (float*)carve((size_t)2048 * 64 * 4);
    p.H = (float*)carve((size_t)NT * DM * 4);
    p.XN = (float*)carve((size_t)NT * DM * 4);
    p.PROJ = (float*)carve((size_t)NT * EVW * 4);
    p.MIX = (float*)carve((size_t)NT * DM * 4);
    p.QKC = (float*)carve((size_t)NT * 512 * 4);
    p.HM = (float*)carve((size_t)2 * NT * 512 * 4);
    p.DAO = (float*)carve((size_t)2 * NT * 512 * 4);
    p.Q = (float*)carve((size_t)NT * 2048 * 4);
    p.GATE = (float*)carve((size_t)NT * 128 * 4);
    p.EIDX = (int*)carve((size_t)NT * 128 * 4);
    if (off > ws_size) { fprintf(stderr, "kernel_launch: workspace too small: need %zu have %zu\n", off, ws_size); return; }
#if ONE_LAUNCH
    p.ph_lo = 0; p.ph_hi = NPH;
    void* args[] = {&p};
    hipError_t e = hipLaunchCooperativeKernel((void*)mega, dim3(grid_blocks), dim3(256), args, 0, stream);
    if (e != hipSuccess) fprintf(stderr, "cooperative launch failed: %s (grid %d)\n", hipGetErrorString(e), grid_blocks);
#else
    for (int ph = 0; ph < NPH; ++ph) {
        if (ph > 0 && ph < NPH - 1) { const int L = (ph - 1) / 10, s = (ph - 1) % 10; if (s == 4 && (L & 1)) continue; }
        p.ph_lo = ph; p.ph_hi = ph + 1;
        hipLaunchKernelGGL(mega, dim3(grid_blocks), dim3(256), 0, stream, p);
    }
#endif
}
```

```cpp
#include <hip/hip_runtime.h>
#include <hip/hip_cooperative_groups.h>
#include <cstdio>
#include <cstdint>
namespace cg = cooperative_groups;

#ifndef ONE_LAUNCH
#define ONE_LAUNCH 1
#endif

#define NT 18432
#define NL 16384
#define DM 1024
#define EVW 3088
#define ODW 1536
#define C_QK 0
#define C_V 512
#define C_O 1024
#define C_G 1536
#define C_DQ 1552
#define C_DK 2064
#define C_DV 2576
#define NPH 42

struct P {
    const float *x, *c, *ctx, *c_ctx, *mod_w, *mod_b, *norm1_g, *norm2_g, *ev_w_in, *ev_conv_w, *ev_conv_b, *ev_gate_b,
        *ev_ml_g, *ev_da_lam, *ev_da_g, *ev_w_out, *od_w_in, *od_sink, *od_w_out, *pr_w_q, *pr_keys, *pr_u, *pr_v, *final_g;
    float* out;
    float *modv, *H, *XN, *PROJ, *MIX, *QKC, *HM, *DAO, *Q, *GATE, *rope;
    int* EIDX;
    int ph_lo, ph_hi;
};

__device__ __forceinline__ int modrow(int r) { return r < NL ? (r >> 11) : 8; }
__device__ __forceinline__ float silu_f(float x) { return x / (1.f + expf(-x)); }
__device__ __forceinline__ float sigmoid_f(float x) { return 1.f / (1.f + expf(-x)); }
__device__ __forceinline__ float log_sigmoid_f(float x) { return fminf(x, 0.f) - log1pf(expf(-fabsf(x))); }
__device__ __forceinline__ float wave_sum(float v) {
#pragma unroll
    for (int o = 32; o > 0; o >>= 1) v += __shfl_xor(v, o);
    return v;
}

__device__ void ph_prologue(const P& p, float* smem) {
    const int tid = threadIdx.x, nb = gridDim.x, bid = blockIdx.x;
    {
        const float4* xs = (const float4*)p.x; const float4* cs = (const float4*)p.ctx; float4* hd = (float4*)p.H;
        const size_t nx = (size_t)NL * DM / 4, nc = (size_t)(NT - NL) * DM / 4;
        for (size_t i = (size_t)bid * 256 + tid; i < nx + nc; i += (size_t)nb * 256) hd[i] = i < nx ? xs[i] : cs[i - nx];
    }
    for (int i = bid * 256 + tid; i < 2048 * 32; i += nb * 256) {
        const int s = i >> 5, d = i & 31;
        const float pos = (d < 16) ? (float)(s >> 6) : (float)(s & 63);
        const float inv = powf(10000.0f, -(float)(d & 15) / 16.0f);
        const float ang = pos * inv;
        p.rope[2 * i] = cosf(ang); p.rope[2 * i + 1] = sinf(ang);
    }
    float* sc = smem;
    float* red = smem + 9 * 1024;
    for (int i = tid; i < 9 * 1024; i += 256) { const int r = i >> 10, k = i & 1023; const float v = r < 8 ? p.c[r * 1024 + k] : p.c_ctx[k]; sc[i] = silu_f(v); }
    __syncthreads();
    for (int item = bid; item < 4 * 96; item += nb) {
        const int L = item / 96, n0 = (item % 96) * 64, tx = tid & 63, kq = tid >> 6;
        float acc[9];
#pragma unroll
        for (int r = 0; r < 9; ++r) acc[r] = 0.f;
        const float* w = p.mod_w + (size_t)L * 1024 * 6144 + n0 + tx;
        for (int k = kq * 256; k < kq * 256 + 256; ++k) {
            const float wv = w[(size_t)k * 6144];
#pragma unroll
            for (int r = 0; r < 9; ++r) acc[r] += sc[r * 1024 + k] * wv;
        }
#pragma unroll
        for (int r = 0; r < 9; ++r) red[(kq * 9 + r) * 64 + tx] = acc[r];
        __syncthreads();
        if (kq == 0) {
#pragma unroll
            for (int r = 0; r < 9; ++r) {
                const float s = red[(0 * 9 + r) * 64 + tx] + red[(1 * 9 + r) * 64 + tx] + red[(2 * 9 + r) * 64 + tx] + red[(3 * 9 + r) * 64 + tx];
                p.modv[((size_t)L * 9 + r) * 6144 + n0 + tx] = s + p.mod_b[L * 6144 + n0 + tx];
            }
        }
        __syncthreads();
    }
}

__device__ void ph_normmod(const float* src, const float* g, const float* modv_layer, int shift_off, int scale_off, float* dst, int nrows) {
    const int lane = threadIdx.x & 63, wid = threadIdx.x >> 6;
    for (int r = blockIdx.x * 4 + wid; r < nrows; r += gridDim.x * 4) {
        const float4* s4 = (const float4*)(src + (size_t)r * DM);
        float4 v[4]; float ss = 0.f;
#pragma unroll
        for (int i = 0; i < 4; ++i) { v[i] = s4[i * 64 + lane]; ss += v[i].x * v[i].x + v[i].y * v[i].y + v[i].z * v[i].z + v[i].w * v[i].w; }
        ss = wave_sum(ss);
        const float rstd = rsqrtf(ss * (1.0f / DM) + 1e-6f);
        const float* mv = modv_layer + (size_t)modrow(r) * 6144;
        float4* d4 = (float4*)(dst + (size_t)r * DM);
#pragma unroll
        for (int i = 0; i < 4; ++i) {
            const int c = (i * 64 + lane) * 4;
            const float4 gg = *(const float4*)(g + c), sh = *(const float4*)(mv + shift_off + c), scl = *(const float4*)(mv + scale_off + c);
            float4 o;
            o.x = v[i].x * rstd * gg.x * (1.f + scl.x) + sh.x; o.y = v[i].y * rstd * gg.y * (1.f + scl.y) + sh.y;
            o.z = v[i].z * rstd * gg.z * (1.f + scl.z) + sh.z; o.w = v[i].w * rstd * gg.w * (1.f + scl.w) + sh.w;
            d4[i * 64 + lane] = o;
        }
    }
}

__device__ void ph_final(const P& p) {
    const int lane = threadIdx.x & 63, wid = threadIdx.x >> 6;
    for (int r = blockIdx.x * 4 + wid; r < NL; r += gridDim.x * 4) {
        const float4* s4 = (const float4*)(p.H + (size_t)r * DM);
        float4 v[4]; float ss = 0.f;
#pragma unroll
        for (int i = 0; i < 4; ++i) { v[i] = s4[i * 64 + lane]; ss += v[i].x * v[i].x + v[i].y * v[i].y + v[i].z * v[i].z + v[i].w * v[i].w; }
        ss = wave_sum(ss);
        const float rstd = rsqrtf(ss * (1.0f / DM) + 1e-6f);
        float4* d4 = (float4*)(p.out + (size_t)r * DM);
#pragma unroll
        for (int i = 0; i < 4; ++i) {
            const int c = (i * 64 + lane) * 4; const float4 gg = *(const float4*)(p.final_g + c);
            float4 o; o.x = v[i].x * rstd * gg.x; o.y = v[i].y * rstd * gg.y; o.z = v[i].z * rstd * gg.z; o.w = v[i].w * rstd * gg.w;
            d4[i * 64 + lane] = o;
        }
    }
}

template <int EPI>
__device__ void ph_gemm(const float* A, int lda, const float* B, int ldb, int M, int N, int K, float* C, int ldc, const float* gate_base, float* smem) {
    float (*As)[68] = (float (*)[68])smem;
    float (*Bs)[68] = (float (*)[68])(smem + 16 * 68);
    const int tid = threadIdx.x, tx = tid & 15, ty = tid >> 4;
    const int tm = M / 64, tn = (N + 63) / 64;
    for (int tile = blockIdx.x; tile < tm * tn; tile += gridDim.x) {
        const int m0 = (tile % tm) * 64, n0 = (tile / tm) * 64;
        float acc[4][4];
#pragma unroll
        for (int i = 0; i < 4; ++i)
#pragma unroll
            for (int j = 0; j < 4; ++j) acc[i][j] = 0.f;
        for (int k0 = 0; k0 < K; k0 += 16) {
            {
                const int row = tid >> 2, kq = (tid & 3) * 4;
                const float4 a = *(const float4*)(A + (size_t)(m0 + row) * lda + k0 + kq);
                As[kq + 0][row] = a.x; As[kq + 1][row] = a.y; As[kq + 2][row] = a.z; As[kq + 3][row] = a.w;
                const int brow = tid >> 4, c4 = (tid & 15) * 4;
                float4 b = make_float4(0.f, 0.f, 0.f, 0.f);
                if (n0 + c4 < N) b = *(const float4*)(B + (size_t)(k0 + brow) * ldb + n0 + c4);
                *(float4*)&Bs[brow][c4] = b;
            }
            __syncthreads();
#pragma unroll
            for (int kk = 0; kk < 16; ++kk) {
                const float4 a = *(const float4*)&As[kk][ty * 4];
                const float4 b = *(const float4*)&Bs[kk][tx * 4];
                const float av[4] = {a.x, a.y, a.z, a.w}, bv[4] = {b.x, b.y, b.z, b.w};
#pragma unroll
                for (int i = 0; i < 4; ++i)
#pragma unroll
                    for (int j = 0; j < 4; ++j) acc[i][j] += av[i] * bv[j];
            }
            __syncthreads();
        }
        const int cn = n0 + tx * 4;
        if (cn < N) {
#pragma unroll
            for (int i = 0; i < 4; ++i) {
                const int r = m0 + ty * 4 + i;
                float4* cp = (float4*)(C + (size_t)r * ldc + cn);
                if (EPI == 0) { *cp = make_float4(acc[i][0], acc[i][1], acc[i][2], acc[i][3]); }
                else {
                    const float4 g = *(const float4*)(gate_base + (size_t)modrow(r) * 6144 + cn);
                    float4 o = *cp; o.x += g.x * acc[i][0]; o.y += g.y * acc[i][1]; o.z += g.z * acc[i][2]; o.w += g.w * acc[i][3]; *cp = o;
                }
            }
        }
    }
}

__device__ __forceinline__ void rope_pair(float* rowp, int base, int d, const float* rp) {
    const float cs = rp[2 * d], sn = rp[2 * d + 1];
    const float x1 = rowp[base + d], x2 = rowp[base + d + 32];
    rowp[base + d] = x1 * cs - x2 * sn; rowp[base + d + 32] = x1 * sn + x2 * cs;
}
__device__ void ph_prep_even(const P& p, int j) {
    const float* cw = p.ev_conv_w + (size_t)j * 3 * 512; const float* cb = p.ev_conv_b + (size_t)j * 512;
    const size_t tot = (size_t)NT * 512;
    for (size_t i = (size_t)blockIdx.x * 256 + threadIdx.x; i < tot; i += (size_t)gridDim.x * 256) {
        const int r = (int)(i >> 9), c = (int)(i & 511);
        int t, T; if (r < NL) { t = r & 2047; T = 2048; } else { t = (r - NL) & 255; T = 256; }
        float v = cb[c] + p.PROJ[(size_t)r * EVW + c] * cw[512 + c];
        if (t > 0) v += p.PROJ[(size_t)(r - 1) * EVW + c] * cw[c];
        if (t < T - 1) v += p.PROJ[(size_t)(r + 1) * EVW + c] * cw[1024 + c];
        v = silu_f(v);
        if (c >= 256) v *= 0.125f;
        p.QKC[i] = v;
    }
    const size_t tot2 = (size_t)NL * 512;
    for (size_t i = (size_t)blockIdx.x * 256 + threadIdx.x; i < tot2; i += (size_t)gridDim.x * 256) {
        const int r = (int)(i >> 9), e = (int)(i & 511);
        const int d = e & 31, hm = (e >> 5) & 7, which = e >> 8;
        const int base = (which ? C_DK : C_DQ) + hm * 64;
        rope_pair(p.PROJ + (size_t)r * EVW, base, d, p.rope + (size_t)(r & 2047) * 64);
    }
}
__device__ void ph_prep_odd(const P& p) {
    const size_t tot = (size_t)NL * 640;
    for (size_t i = (size_t)blockIdx.x * 256 + threadIdx.x; i < tot; i += (size_t)gridDim.x * 256) {
        const int r = (int)(i / 640), e = (int)(i % 640);
        const int d = e & 31, hh = e >> 5;
        rope_pair(p.PROJ + (size_t)r * ODW, hh * 64, d, p.rope + (size_t)(r & 2047) * 64);
    }
}

template <bool MASK>
__device__ __forceinline__ void attn_seg(const float (&q)[64], float (&o)[64], float& m, float& l, const float* base, int ld, int krow0, int cnt,
                                         int kc, int vc, int qpos, int kpos0, float* sK, float* sV) {
    for (int t0 = 0; t0 < cnt; t0 += 32) {
        __syncthreads();
        for (int e = threadIdx.x; e < 32 * 16; e += 256) {
            const int kk = e >> 4, c4 = (e & 15) * 4;
            float4 kv = make_float4(0.f, 0.f, 0.f, 0.f), vv = kv;
            bool ok = true;
            if (MASK) { const int kpos = kpos0 + t0 + kk; ok = (kpos >= 0 && kpos < 2048); }
            if (ok) { const float* rp = base + (size_t)(krow0 + t0 + kk) * ld; kv = *(const float4*)(rp + kc + c4); vv = *(const float4*)(rp + vc + c4); }
            *(float4*)(sK + kk * 64 + c4) = kv; *(float4*)(sV + kk * 64 + c4) = vv;
        }
        __syncthreads();
        for (int kk = 0; kk < 32; ++kk) {
            if (MASK) { const int kpos = kpos0 + t0 + kk; const int dlt = qpos - kpos; if (!(dlt <= 128 && dlt >= -128 && kpos >= 0 && kpos < 2048)) continue; }
            float s = 0.f;
#pragma unroll
            for (int d = 0; d < 64; ++d) s += q[d] * sK[kk * 64 + d];
            const float mn = fmaxf(m, s), corr = expf(m - mn), pp = expf(s - mn);
            l = l * corr + pp;
#pragma unroll
            for (int d = 0; d < 64; ++d) o[d] = o[d] * corr + pp * sV[kk * 64 + d];
            m = mn;
        }
    }
}

__device__ void da_item(const P& p, int item, float* smem) {
    float* sK = smem; float* sV = smem + 2048;
    int b, h, mp, vh, qrow;
    const bool lat = item < 1024;
    if (lat) { const int qb = item & 7; vh = (item >> 3) & 1; mp = (item >> 4) & 1; h = (item >> 5) & 3; b = item >> 7; qrow = b * 2048 + qb * 256 + threadIdx.x; }
    else { const int it = item - 1024; vh = it & 1; mp = (it >> 1) & 1; h = (it >> 2) & 3; b = it >> 4; qrow = NL + b * 256 + threadIdx.x; }
    float q[64], o[64];
    const float* qp = p.PROJ + (size_t)qrow * EVW + C_DQ + h * 128 + mp * 64;
#pragma unroll
    for (int d = 0; d < 64; ++d) { q[d] = qp[d] * 0.125f; o[d] = 0.f; }
    float m = -INFINITY, l = 0.f;
    const int kc = C_DK + h * 128 + mp * 64, vc = C_DV + h * 128 + vh * 64;
    attn_seg<false>(q, o, m, l, p.PROJ, EVW, NL + b * 256, 256, kc, vc, 0, 0, sK, sV);
    if (lat) attn_seg<false>(q, o, m, l, p.PROJ, EVW, b * 2048, 2048, kc, vc, 0, 0, sK, sV);
    const float il = 1.f / l;
    float* op = p.DAO + ((size_t)mp * NT + qrow) * 512 + h * 128 + vh * 64;
#pragma unroll
    for (int d = 0; d < 64; ++d) op[d] = o[d] * il;
}

__device__ void wa_item(const P& p, int item, int j, float* smem) {
    float* sK = smem; float* sV = smem + 2048;
    const int qi = threadIdx.x & 127;
    const bool lat = item < 1024;
    int b, nbk, hh, qrow;
    if (lat) { hh = item & 7; nbk = (item >> 3) & 15; b = item >> 7; qrow = b * 2048 + nbk * 128 + qi; }
    else { const int it = item - 1024; hh = it & 7; nbk = (it >> 3) & 1; b = it >> 4; qrow = NL + b * 256 + nbk * 128 + qi; }
    const int hq = hh * 2 + (threadIdx.x >> 7), hkv = hh >> 1;
    float q[64], o[64];
    const float* qp = p.PROJ + (size_t)qrow * ODW + hq * 64;
#pragma unroll
    for (int d = 0; d < 64; ++d) { q[d] = qp[d] * 0.125f; o[d] = 0.f; }
    float m = p.od_sink[j * 16 + hq], l = 1.f;
    const int kc = 1024 + hkv * 64, vc = 1280 + hkv * 64;
    attn_seg<false>(q, o, m, l, p.PROJ, ODW, NL + b * 256, 256, kc, vc, 0, 0, sK, sV);
    if (lat) attn_seg<true>(q, o, m, l, p.PROJ, ODW, b * 2048 + (nbk - 1) * 128, 384, kc, vc, nbk * 128 + qi, (nbk - 1) * 128, sK, sV);
    const float il = 1.f / l;
    float* op = p.MIX + (size_t)qrow * DM + hq * 64;
#pragma unroll
    for (int d = 0; d < 64; ++d) op[d] = o[d] * il;
}

__device__ void mlstm_item(const P& p, int item, int j, float* smem) {
    const int dir = item & 1, h = (item >> 1) & 3, b = item >> 3;
    const int tid = threadIdx.x, vi = tid >> 1, kh = tid & 1;
    float* sq = smem;
    float* sk = smem + 32 * 64;
    float* sv = smem + 2 * 32 * 64;
    float* sg = smem + 2 * 32 * 64 + 32 * 128;
    int* srow = (int*)(sg + 64);
    float C[32], n[32];
#pragma unroll
    for (int i = 0; i < 32; ++i) { C[i] = 0.f; n[i] = 0.f; }
    float m = 0.f;
    const float gbi = p.ev_gate_b[j * 16 + (dir * 2) * 4 + h], gbf = p.ev_gate_b[j * 16 + (dir * 2 + 1) * 4 + h];
    float* hm = p.HM + (size_t)dir * NT * 512;
    for (int s0 = 0; s0 < 2304; s0 += 32) {
        __syncthreads();
        if (tid < 32) {
            const int st = s0 + tid; int row;
            if (st < 256) row = NL + b * 256 + (dir ? 255 - st : st);
            else { const int t = st - 256; row = b * 2048 + (dir ? 2047 - t : t); }
            srow[tid] = row;
            const float ig = p.PROJ[(size_t)row * EVW + C_G + (dir * 2) * 4 + h] + gbi;
            const float fg = p.PROJ[(size_t)row * EVW + C_G + (dir * 2 + 1) * 4 + h] + gbf;
            sg[tid * 2] = ig; sg[tid * 2 + 1] = log_sigmoid_f(fg);
        }
        __syncthreads();
        for (int e = tid; e < 32 * 256; e += 256) {
            const int st = e >> 8, c = e & 255; const int row = srow[st];
            if (c < 64) sq[st * 64 + c] = p.QKC[(size_t)row * 512 + h * 64 + c];
            else if (c < 128) sk[st * 64 + (c - 64)] = p.QKC[(size_t)row * 512 + 256 + h * 64 + (c - 64)];
            else sv[st * 128 + (c - 128)] = p.PROJ[(size_t)row * EVW + C_V + h * 128 + (c - 128)];
        }
        __syncthreads();
        for (int st = 0; st < 32; ++st) {
            const float ig = sg[st * 2], lf = sg[st * 2 + 1];
            const float mn = fmaxf(lf + m, ig);
            const float fd = expf(lf + m - mn), ie = expf(ig - mn);
            m = mn;
            const float vv = sv[st * 128 + vi] * ie;
            float num = 0.f, den = 0.f;
#pragma unroll
            for (int i = 0; i < 32; ++i) {
                const float kk = sk[st * 64 + kh * 32 + i], qq = sq[st * 64 + kh * 32 + i];
                C[i] = fd * C[i] + vv * kk; n[i] = fd * n[i] + ie * kk;
                num += C[i] * qq; den += n[i] * qq;
            }
            num += __shfl_xor(num, 1); den += __shfl_xor(den, 1);
            const float hv = num / fmaxf(fabsf(den), expf(-m));
            if (kh == 0) hm[(size_t)srow[st] * 512 + h * 128 + vi] = hv;
        }
    }
}

__device__ void ph_attn_even(const P& p, int j, float* smem) {
    for (int item = blockIdx.x; item < 64 + 1152; item += gridDim.x) {
        if (item < 64) mlstm_item(p, item, j, smem); else da_item(p, item - 64, smem);
        __syncthreads();
    }
}
__device__ void ph_attn_odd(const P& p, int j, bool need_ctx, float* smem) {
    const int nitem = need_ctx ? 1152 : 1024;
    for (int item = blockIdx.x; item < nitem; item += gridDim.x) { wa_item(p, item, j, smem); __syncthreads(); }
}

__device__ void ph_mixout_even(const P& p, int L, int j) {
    const int lane = threadIdx.x & 63, wid = threadIdx.x >> 6;
    const float lam_init = 0.8f - 0.6f * expf(-0.3f * (float)L);
    const float* lp = p.ev_da_lam + (size_t)j * 256;
    float a0 = lp[lane] * lp[64 + lane], a1 = lp[128 + lane] * lp[192 + lane];
    a0 = wave_sum(a0); a1 = wave_sum(a1);
    const float lam = expf(a0) - expf(a1) + lam_init;
    for (int w = blockIdx.x * 4 + wid; w < NT * 8; w += gridDim.x * 4) {
        const int r = w >> 3, hh = w & 7;
        if (hh < 4) {
            const int c = hh * 128 + lane * 2;
            const float2 f = *(const float2*)(p.HM + (size_t)r * 512 + c), bk = *(const float2*)(p.HM + (size_t)NT * 512 + (size_t)r * 512 + c);
            const float v0 = f.x + bk.x, v1 = f.y + bk.y;
            const float ss = wave_sum(v0 * v0 + v1 * v1);
            const float rstd = rsqrtf(ss * (1.f / 128.f) + 1e-6f);
            const float2 g = *(const float2*)(p.ev_ml_g + (size_t)j * 512 + c), og = *(const float2*)(p.PROJ + (size_t)r * EVW + C_O + c);
            float2 o; o.x = v0 * rstd * g.x * sigmoid_f(og.x); o.y = v1 * rstd * g.y * sigmoid_f(og.y);
            *(float2*)(p.MIX + (size_t)r * DM + c) = o;
        } else {
            const int c = (hh - 4) * 128 + lane * 2;
            const float2 d0 = *(const float2*)(p.DAO + (size_t)r * 512 + c), d1 = *(const float2*)(p.DAO + (size_t)NT * 512 + (size_t)r * 512 + c);
            const float v0 = d0.x - lam * d1.x, v1 = d0.y - lam * d1.y;
            const float ss = wave_sum(v0 * v0 + v1 * v1);
            const float rstd = rsqrtf(ss * (1.f / 128.f) + 1e-6f);
            const float2 g = *(const float2*)(p.ev_da_g + (size_t)j * 512 + c);
            float2 o; o.x = v0 * rstd * g.x * (1.f - lam_init); o.y = v1 * rstd * g.y * (1.f - lam_init);
            *(float2*)(p.MIX + (size_t)r * DM + 512 + c) = o;
        }
    }
}

__device__ void ph_peer_select(const P& p, int L, int nrows, float* smem) {
    float* qs = smem;
    float* ss = smem + 256;
    float* sv = smem + 512;
    int* si = (int*)(smem + 544);
    float* cand = smem + 576;
    float* cs = smem + 832;
    int* ce = (int*)(smem + 848);
    const int tid = threadIdx.x, pp = tid >> 7, k = tid & 127;
    for (int item = blockIdx.x; item < nrows * 8; item += gridDim.x) {
        const int r = item >> 3, h = item & 7;
        __syncthreads();
        qs[tid] = p.Q[(size_t)r * 2048 + h * 256 + tid];
        __syncthreads();
        {
            const float4* kp = (const float4*)(p.pr_keys + ((((size_t)L * 8 + h) * 2 + pp) * 128 + k) * 128);
            float s = 0.f;
#pragma unroll 8
            for (int d = 0; d < 32; ++d) { const float4 kv = kp[d]; const float* qq = qs + pp * 128 + d * 4; s += qq[0] * kv.x + qq[1] * kv.y + qq[2] * kv.z + qq[3] * kv.w; }
            ss[tid] = s;
        }
        __syncthreads();
        {
            const float me = ss[tid]; int rank = 0;
            for (int k2 = 0; k2 < 128; ++k2) { const float o = ss[pp * 128 + k2]; rank += (o > me || (o == me && k2 < k)) ? 1 : 0; }
            if (rank < 16) { sv[pp * 16 + rank] = me; si[pp * 16 + rank] = k; }
        }
        __syncthreads();
        const int ci = tid >> 4, cj = tid & 15;
        const float cme = sv[ci] + sv[16 + cj];
        cand[tid] = cme;
        __syncthreads();
        {
            int rank = 0;
            for (int t2 = 0; t2 < 256; ++t2) { const float o = cand[t2]; rank += (o > cme || (o == cme && t2 < tid)) ? 1 : 0; }
            if (rank < 16) { cs[rank] = cme; ce[rank] = si[ci] * 128 + si[16 + cj]; }
        }
        __syncthreads();
        if (tid < 16) {
            const float mx = cs[0]; float sum = 0.f;
            for (int t2 = 0; t2 < 16; ++t2) sum += expf(cs[t2] - mx);
            p.GATE[(size_t)r * 128 + h * 16 + tid] = expf(cs[tid] - mx) / sum;
            p.EIDX[(size_t)r * 128 + h * 16 + tid] = ce[tid];
        }
    }
}

__device__ void ph_peer_gather(const P& p, int L, int nrows, float* smem) {
    const int tid = threadIdx.x, lane = tid & 63, wid = tid >> 6;
    const float* U = p.pr_u + (size_t)L * 16384 * 1024; const float* V = p.pr_v + (size_t)L * 16384 * 1024;
    const float* gate2 = p.modv + (size_t)L * 9 * 6144 + 5120;
    for (int r = blockIdx.x; r < nrows; r += gridDim.x) {
        const float4* x4 = (const float4*)(p.XN + (size_t)r * DM);
        float4 xv[4], acc[4];
#pragma unroll
        for (int i = 0; i < 4; ++i) { xv[i] = x4[i * 64 + lane]; acc[i] = make_float4(0.f, 0.f, 0.f, 0.f); }
        for (int e = 0; e < 32; ++e) {
            const int idx = p.EIDX[(size_t)r * 128 + wid * 32 + e]; const float g = p.GATE[(size_t)r * 128 + wid * 32 + e];
            const float4* u4 = (const float4*)(U + (size_t)idx * 1024);
            float s = 0.f;
#pragma unroll
            for (int i = 0; i < 4; ++i) { const float4 uv = u4[i * 64 + lane]; s += xv[i].x * uv.x + xv[i].y * uv.y + xv[i].z * uv.z + xv[i].w * uv.w; }
            s = wave_sum(s);
            const float wgt = g * 0.5f * s * (1.f + erff(s * 0.70710678118654752f));
            const float4* v4 = (const float4*)(V + (size_t)idx * 1024);
#pragma unroll
            for (int i = 0; i < 4; ++i) { const float4 vv = v4[i * 64 + lane]; acc[i].x += wgt * vv.x; acc[i].y += wgt * vv.y; acc[i].z += wgt * vv.z; acc[i].w += wgt * vv.w; }
        }
        __syncthreads();
#pragma unroll
        for (int i = 0; i < 4; ++i) *(float4*)(smem + wid * 1024 + (i * 64 + lane) * 4) = acc[i];
        __syncthreads();
        {
            const int c = tid * 4;
            const float4 a0 = *(const float4*)(smem + c), a1 = *(const float4*)(smem + 1024 + c), a2 = *(const float4*)(smem + 2048 + c), a3 = *(const float4*)(smem + 3072 + c);
            const float4 g = *(const float4*)(gate2 + (size_t)modrow(r) * 6144 + c);
            float4* hp = (float4*)(p.H + (size_t)r * DM + c);
            float4 hv = *hp;
            hv.x += g.x * (a0.x + a1.x + a2.x + a3.x); hv.y += g.y * (a0.y + a1.y + a2.y + a3.y);
            hv.z += g.z * (a0.z + a1.z + a2.z + a3.z); hv.w += g.w * (a0.w + a1.w + a2.w + a3.w);
            *hp = hv;
        }
    }
}

__device__ void run_phase(const P& p, int ph, float* smem) {
    if (ph == 0) { ph_prologue(p, smem); return; }
    if (ph == NPH - 1) { ph_final(p); return; }
    const int L = (ph - 1) / 10, s = (ph - 1) % 10, j = L >> 1;
    const bool even = (L & 1) == 0, need_ctx = L < 3;
    const int nrows = need_ctx ? NT : NL;
    const float* mv = p.modv + (size_t)L * 9 * 6144;
    switch (s) {
    case 0: ph_normmod(p.H, p.norm1_g + L * DM, mv, 0, 1024, p.XN, NT); break;
    case 1:
        if (even) ph_gemm<0>(p.XN, DM, p.ev_w_in + (size_t)j * DM * EVW, EVW, NT, EVW, DM, p.PROJ, EVW, nullptr, smem);
        else ph_gemm<0>(p.XN, DM, p.od_w_in + (size_t)j * DM * ODW, ODW, NT, ODW, DM, p.PROJ, ODW, nullptr, smem);
        break;
    case 2: if (even) ph_prep_even(p, j); else ph_prep_odd(p); break;
    case 3: if (even) ph_attn_even(p, j, smem); else ph_attn_odd(p, j, need_ctx, smem); break;
    case 4: if (even) ph_mixout_even(p, L, j); break;
    case 5:
        if (even) ph_gemm<1>(p.MIX, DM, p.ev_w_out + (size_t)j * DM * DM, DM, nrows, DM, DM, p.H, DM, mv + 2048, smem);
        else ph_gemm<1>(p.MIX, DM, p.od_w_out + (size_t)j * DM * DM, DM, nrows, DM, DM, p.H, DM, mv + 2048, smem);
        break;
    case 6: ph_normmod(p.H, p.norm2_g + L * DM, mv, 3072, 4096, p.XN, nrows); break;
    case 7: ph_gemm<0>(p.XN, DM, p.pr_w_q + (size_t)L * DM * 2048, 2048, nrows, 2048, DM, p.Q, 2048, nullptr, smem); break;
    case 8: ph_peer_select(p, L, nrows, smem); break;
    case 9: ph_peer_gather(p, L, nrows, smem); break;
    }
}

__global__ void __launch_bounds__(256) mega(P p) {
    __shared__ __attribute__((aligned(16))) float smem[12288];
    cg::grid_group grid = cg::this_grid();
    for (int ph = p.ph_lo; ph < p.ph_hi; ++ph) {
        run_phase(p, ph, smem);
        if (ph + 1 < p.ph_hi) grid.sync();
    }
}

extern "C" void kernel_launch(void* const* d_in, const int* in_sizes, int n_in, void* d_out, int out_size, void* d_ws, size_t ws_size, hipStream_t stream) {
    static int grid_blocks = 0;
    if (!grid_blocks) {
        int dev = 0, cus = 0, per_cu = 0;
        hipGetDevice(&dev);
        hipDeviceGetAttribute(&cus, hipDeviceAttributeMultiprocessorCount, dev);
        hipOccupancyMaxActiveBlocksPerMultiprocessor(&per_cu, mega, 256, 0);
        if (per_cu < 1) per_cu = 1;
        if (per_cu > 4) per_cu = 4;
        grid_blocks = cus * per_cu;
    }
    P p{};
    const float** ins = (const float**)&p;
    for (int i = 0; i < 24; ++i) ins[i] = (const float*)d_in[i];
    p.out = (float*)d_out;
    size_t off = 0; char* ws = (char*)d_ws;
    auto carve = [&](size_t bytes) { void* r = ws + off; off += (bytes + 255) & ~(size_t)255; return r; };
    p.modv = (float*)carve((size_t)4 * 9 * 6144 * 4);
    p.rope = (float*)carve((size_t)2048 * 64 * 4);
    p.H = (float*)carve((size_t)NT * DM * 4);
    p.XN = (float*)carve((size_t)NT * DM * 4);
    p.PROJ = (float*)carve((size_t)NT * EVW * 4);
    p.MIX = (float*)carve((size_t)NT * DM * 4);
    p.QKC = (float*)carve((size_t)NT * 512 * 4);
    p.HM = (float*)carve((size_t)2 * NT * 512 * 4);
    p.DAO = (float*)carve((size_t)2 * NT * 512 * 4);
    p.Q = (float*)carve((size_t)NT * 2048 * 4);
    p.GATE = (float*)carve((size_t)NT * 128 * 4);
    p.EIDX = (int*)carve((size_t)NT * 128 * 4);
    if (off > ws_size) { fprintf(stderr, "kernel_launch: workspace too small: need %zu have %zu\n", off, ws_size); return; }
#if ONE_LAUNCH
    p.ph_lo = 0; p.ph_hi = NPH;
    void* args[] = {&p};
    hipError_t e = hipLaunchCooperativeKernel((void*)mega, dim3(grid_blocks), dim3(256), args, 0, stream);
    if (e != hipSuccess) fprintf(stderr, "cooperative launch failed: %s (grid %d)\n", hipGetErrorString(e), grid_blocks);
#else
    for (int ph = 0; ph < NPH; ++ph) {
        if (ph > 0 && ph < NPH - 1) { const int L = (ph - 1) / 10, s = (ph - 1) % 10; if (s == 4 && (L & 1)) continue; }
        p.ph_lo = ph; p.ph_hi = ph + 1;
        hipLaunchKernelGGL(mega, dim3(grid_blocks), dim3(256), 0, stream, p);
    }
#endif
}
```

```cpp
#include <hip/hip_runtime.h>
#include <hip/hip_cooperative_groups.h>
#include <cstdio>
#include <cstdint>
namespace cg = cooperative_groups;

#ifndef ONE_LAUNCH
#define ONE_LAUNCH 1
#endif

#define NT 18432
#define NL 16384
#define DM 1024
#define EVW 3088
#define ODW 1536
#define C_QK 0
#define C_V 512
#define C_O 1024
#define C_G 1536
#define C_DQ 1552
#define C_DK 2064
#define C_DV 2576
#define NPH 42

typedef unsigned short bf16_t;
typedef short bf16x8 __attribute__((ext_vector_type(8)));
typedef float f32x4 __attribute__((ext_vector_type(4)));
#define LDS_BYTES 73728

struct P {
    const float *x, *c, *ctx, *c_ctx, *mod_w, *mod_b, *norm1_g, *norm2_g, *ev_w_in, *ev_conv_w, *ev_conv_b, *ev_gate_b,
        *ev_ml_g, *ev_da_lam, *ev_da_g, *ev_w_out, *od_w_in, *od_sink, *od_w_out, *pr_w_q, *pr_keys, *pr_u, *pr_v, *final_g;
    float* out;
    float *modv, *H, *PROJ, *QKC, *HM, *DAO, *GATE, *rope;
    int* EIDX;
    bf16_t *XN, *MIX, *WT, *UB, *VB, *KB, *QB;
    int ph_lo, ph_hi;
};

__device__ __forceinline__ int modrow(int r) { return r < NL ? (r >> 11) : 8; }
__device__ __forceinline__ float silu_f(float x) { return x / (1.f + expf(-x)); }
__device__ __forceinline__ float sigmoid_f(float x) { return 1.f / (1.f + expf(-x)); }
__device__ __forceinline__ float log_sigmoid_f(float x) { return fminf(x, 0.f) - log1pf(expf(-fabsf(x))); }
__device__ __forceinline__ unsigned cvt_pk_bf16(float lo, float hi) { unsigned r; asm("v_cvt_pk_bf16_f32 %0, %1, %2" : "=v"(r) : "v"(lo), "v"(hi)); return r; }
__device__ __forceinline__ float bf_lo(unsigned u) { return __uint_as_float(u << 16); }
__device__ __forceinline__ float bf_hi(unsigned u) { return __uint_as_float(u & 0xffff0000u); }
#define WT_EVIN(j) ((size_t)(j) * 3200 * 1024)
#define WT_EVOUT(j) ((size_t)2 * 3200 * 1024 + (size_t)(j) * 1024 * 1024)
#define WT_ODIN(j) ((size_t)2 * 3200 * 1024 + (size_t)2 * 1024 * 1024 + (size_t)(j) * 1536 * 1024)
#define WT_ODOUT(j) ((size_t)2 * 3200 * 1024 + (size_t)2 * 1024 * 1024 + (size_t)2 * 1536 * 1024 + (size_t)(j) * 1024 * 1024)
#define WT_PQ(L) ((size_t)2 * 3200 * 1024 + (size_t)4 * 1024 * 1024 + (size_t)2 * 1536 * 1024 + (size_t)(L) * 2048 * 1024)
#define WT_TOTAL ((size_t)2 * 3200 * 1024 + (size_t)4 * 1024 * 1024 + (size_t)2 * 1536 * 1024 + (size_t)4 * 2048 * 1024)
__device__ __forceinline__ float wave_sum(float v) {
#pragma unroll
    for (int o = 32; o > 0; o >>= 1) v += __shfl_xor(v, o);
    return v;
}

__device__ void cvt_copy_bf16(const float* src, bf16_t* dst, size_t n);
__device__ void ph_prologue(const P& p, float* smem) {
    const int tid = threadIdx.x, nb = gridDim.x, bid = blockIdx.x;
    {
        const float4* xs = (const float4*)p.x; const float4* cs = (const float4*)p.ctx; float4* hd = (float4*)p.H;
        const size_t nx = (size_t)NL * DM / 4, nc = (size_t)(NT - NL) * DM / 4;
        for (size_t i = (size_t)bid * 256 + tid; i < nx + nc; i += (size_t)nb * 256) hd[i] = i < nx ? xs[i] : cs[i - nx];
    }
    for (int i = bid * 256 + tid; i < 2048 * 32; i += nb * 256) {
        const int s = i >> 5, d = i & 31;
        const float pos = (d < 16) ? (float)(s >> 6) : (float)(s & 63);
        const float inv = powf(10000.0f, -(float)(d & 15) / 16.0f);
        const float ang = pos * inv;
        p.rope[2 * i] = cosf(ang); p.rope[2 * i + 1] = sinf(ang);
    }
    float* sc = smem;
    float* red = smem + 9 * 1024;
    for (int i = tid; i < 9 * 1024; i += 256) { const int r = i >> 10, k = i & 1023; const float v = r < 8 ? p.c[r * 1024 + k] : p.c_ctx[k]; sc[i] = silu_f(v); }
    __syncthreads();
    for (int item = bid; item < 4 * 96; item += nb) {
        const int L = item / 96, n0 = (item % 96) * 64, tx = tid & 63, kq = tid >> 6;
        float acc[9];
#pragma unroll
        for (int r = 0; r < 9; ++r) acc[r] = 0.f;
        const float* w = p.mod_w + (size_t)L * 1024 * 6144 + n0 + tx;
        for (int k = kq * 256; k < kq * 256 + 256; ++k) {
            const float wv = w[(size_t)k * 6144];
#pragma unroll
            for (int r = 0; r < 9; ++r) acc[r] += sc[r * 1024 + k] * wv;
        }
#pragma unroll
        for (int r = 0; r < 9; ++r) red[(kq * 9 + r) * 64 + tx] = acc[r];
        __syncthreads();
        if (kq == 0) {
#pragma unroll
            for (int r = 0; r < 9; ++r) {
                const float s = red[(0 * 9 + r) * 64 + tx] + red[(1 * 9 + r) * 64 + tx] + red[(2 * 9 + r) * 64 + tx] + red[(3 * 9 + r) * 64 + tx];
                p.modv[((size_t)L * 9 + r) * 6144 + n0 + tx] = s + p.mod_b[L * 6144 + n0 + tx];
            }
        }
        __syncthreads();
    }
    {
        float (*tile)[65] = (float (*)[65])smem;
        for (int item = bid; item < 5440; item += nb) {
            int it = item, mat = 0, N = 0, Npad = 0; const float* src = nullptr; bf16_t* dst = nullptr;
            for (mat = 0; mat < 12; ++mat) {
                if (mat < 2) { N = EVW; Npad = 3200; src = p.ev_w_in + (size_t)mat * DM * EVW; dst = p.WT + WT_EVIN(mat); }
                else if (mat < 4) { N = 1024; Npad = 1024; src = p.ev_w_out + (size_t)(mat - 2) * DM * DM; dst = p.WT + WT_EVOUT(mat - 2); }
                else if (mat < 6) { N = ODW; Npad = ODW; src = p.od_w_in + (size_t)(mat - 4) * DM * ODW; dst = p.WT + WT_ODIN(mat - 4); }
                else if (mat < 8) { N = 1024; Npad = 1024; src = p.od_w_out + (size_t)(mat - 6) * DM * DM; dst = p.WT + WT_ODOUT(mat - 6); }
                else { N = 2048; Npad = 2048; src = p.pr_w_q + (size_t)(mat - 8) * DM * 2048; dst = p.WT + WT_PQ(mat - 8); }
                const int nt = 16 * (Npad / 64);
                if (it < nt) break;
                it -= nt;
            }
            const int k0 = (it & 15) * 64, n0 = (it >> 4) * 64;
            __syncthreads();
#pragma unroll
            for (int rep = 0; rep < 4; ++rep) {
                const int i = (tid >> 4) + 16 * rep, c4 = (tid & 15) * 4;
                float4 v = make_float4(0.f, 0.f, 0.f, 0.f);
                if (n0 + c4 < N) v = *(const float4*)(src + (size_t)(k0 + i) * N + n0 + c4);
                tile[i][c4] = v.x; tile[i][c4 + 1] = v.y; tile[i][c4 + 2] = v.z; tile[i][c4 + 3] = v.w;
            }
            __syncthreads();
            {
                const int n = tid >> 2, kq = (tid & 3) * 16;
                unsigned w[8];
#pragma unroll
                for (int e = 0; e < 8; ++e) w[e] = cvt_pk_bf16(tile[kq + 2 * e][n], tile[kq + 2 * e + 1][n]);
                uint4* dp = (uint4*)(dst + (size_t)(n0 + n) * DM + k0 + kq);
                dp[0] = make_uint4(w[0], w[1], w[2], w[3]); dp[1] = make_uint4(w[4], w[5], w[6], w[7]);
            }
        }
    }
    cvt_copy_bf16(p.pr_u, p.UB, (size_t)4 * 16384 * 1024);
    cvt_copy_bf16(p.pr_v, p.VB, (size_t)4 * 16384 * 1024);
    cvt_copy_bf16(p.pr_keys, p.KB, (size_t)4 * 8 * 2 * 128 * 128);
}

__device__ void cvt_copy_bf16(const float* src, bf16_t* dst, size_t n) {
    const size_t n8 = n / 8;
    for (size_t i = (size_t)blockIdx.x * 256 + threadIdx.x; i < n8; i += (size_t)gridDim.x * 256) {
        const float4 a = ((const float4*)src)[2 * i], b = ((const float4*)src)[2 * i + 1];
        ((uint4*)dst)[i] = make_uint4(cvt_pk_bf16(a.x, a.y), cvt_pk_bf16(a.z, a.w), cvt_pk_bf16(b.x, b.y), cvt_pk_bf16(b.z, b.w));
    }
}

__device__ void ph_normmod(const float* src, const float* g, const float* modv_layer, int shift_off, int scale_off, bf16_t* dst, int nrows) {
    const int lane = threadIdx.x & 63, wid = threadIdx.x >> 6;
    for (int r = blockIdx.x * 4 + wid; r < nrows; r += gridDim.x * 4) {
        const float4* s4 = (const float4*)(src + (size_t)r * DM);
        float4 v[4]; float ss = 0.f;
#pragma unroll
        for (int i = 0; i < 4; ++i) { v[i] = s4[i * 64 + lane]; ss += v[i].x * v[i].x + v[i].y * v[i].y + v[i].z * v[i].z + v[i].w * v[i].w; }
        ss = wave_sum(ss);
        const float rstd = rsqrtf(ss * (1.0f / DM) + 1e-6f);
        const float* mv = modv_layer + (size_t)modrow(r) * 6144;
        uint2* d2 = (uint2*)(dst + (size_t)r * DM);
#pragma unroll
        for (int i = 0; i < 4; ++i) {
            const int c = (i * 64 + lane) * 4;
            const float4 gg = *(const float4*)(g + c), sh = *(const float4*)(mv + shift_off + c), scl = *(const float4*)(mv + scale_off + c);
            float4 o;
            o.x = v[i].x * rstd * gg.x * (1.f + scl.x) + sh.x; o.y = v[i].y * rstd * gg.y * (1.f + scl.y) + sh.y;
            o.z = v[i].z * rstd * gg.z * (1.f + scl.z) + sh.z; o.w = v[i].w * rstd * gg.w * (1.f + scl.w) + sh.w;
            d2[i * 64 + lane] = make_uint2(cvt_pk_bf16(o.x, o.y), cvt_pk_bf16(o.z, o.w));
        }
    }
}

__device__ void ph_final(const P& p) {
    const int lane = threadIdx.x & 63, wid = threadIdx.x >> 6;
    for (int r = blockIdx.x * 4 + wid; r < NL; r += gridDim.x * 4) {
        const float4* s4 = (const float4*)(p.H + (size_t)r * DM);
        float4 v[4]; float ss = 0.f;
#pragma unroll
        for (int i = 0; i < 4; ++i) { v[i] = s4[i * 64 + lane]; ss += v[i].x * v[i].x + v[i].y * v[i].y + v[i].z * v[i].z + v[i].w * v[i].w; }
        ss = wave_sum(ss);
        const float rstd = rsqrtf(ss * (1.0f / DM) + 1e-6f);
        float4* d4 = (float4*)(p.out + (size_t)r * DM);
#pragma unroll
        for (int i = 0; i < 4; ++i) {
            const int c = (i * 64 + lane) * 4; const float4 gg = *(const float4*)(p.final_g + c);
            float4 o; o.x = v[i].x * rstd * gg.x; o.y = v[i].y * rstd * gg.y; o.z = v[i].z * rstd * gg.z; o.w = v[i].w * rstd * gg.w;
            d4[i * 64 + lane] = o;
        }
    }
}

#define GL_ROWB 144
#define GL_TILEB (128 * GL_ROWB)
struct EpiStoreF32 {
    float* C; int ldc, N;
    __device__ __forceinline__ void operator()(int row, int col, f32x4 v) const { if (col < N) *(f32x4*)(C + (size_t)row * ldc + col) = v; }
};
struct EpiStoreBF16 {
    bf16_t* C; int ldc;
    __device__ __forceinline__ void operator()(int row, int col, f32x4 v) const { *(uint2*)(C + (size_t)row * ldc + col) = make_uint2(cvt_pk_bf16(v[0], v[1]), cvt_pk_bf16(v[2], v[3])); }
};
struct EpiResid {
    float* H; const float* gate;
    __device__ __forceinline__ void operator()(int row, int col, f32x4 v) const {
        const f32x4 g = *(const f32x4*)(gate + (size_t)modrow(row) * 6144 + col);
        f32x4* hp = (f32x4*)(H + (size_t)row * DM + col);
        *hp = *hp + g * v;
    }
};
template <class Epi>
__device__ void ph_gemm(const bf16_t* A, const bf16_t* Bt, int M, int Npad, Epi epi, char* smem) {
    const int tid = threadIdx.x, lane = tid & 63, wid = tid >> 6, wm = wid >> 1, wn = wid & 1;
    const int fr = lane & 15, fq = lane >> 4;
    const int tm = M / 128, tn = Npad / 128, ntiles = tm * tn;
    const int lrow = tid >> 3, lch = tid & 7;
    for (int tile = blockIdx.x; tile < ntiles; tile += gridDim.x) {
        const int m0 = (tile % tm) * 128, n0 = (tile / tm) * 128;
        f32x4 acc[4][4];
#pragma unroll
        for (int a = 0; a < 4; ++a)
#pragma unroll
            for (int b = 0; b < 4; ++b) acc[a][b] = (f32x4){0.f, 0.f, 0.f, 0.f};
        const bf16_t* ap = A + (size_t)(m0 + lrow) * DM + lch * 8;
        const bf16_t* bp = Bt + (size_t)(n0 + lrow) * DM + lch * 8;
        uint4 ra0, ra1, ra2, ra3, rb0, rb1, rb2, rb3;
#define GL_LOAD(KO) { ra0 = *(const uint4*)(ap + (KO)); ra1 = *(const uint4*)(ap + (size_t)32 * DM + (KO)); ra2 = *(const uint4*)(ap + (size_t)64 * DM + (KO)); ra3 = *(const uint4*)(ap + (size_t)96 * DM + (KO)); \
                      rb0 = *(const uint4*)(bp + (KO)); rb1 = *(const uint4*)(bp + (size_t)32 * DM + (KO)); rb2 = *(const uint4*)(bp + (size_t)64 * DM + (KO)); rb3 = *(const uint4*)(bp + (size_t)96 * DM + (KO)); }
#define GL_STORE(BUF) { char* sa_ = (BUF) + lrow * GL_ROWB + lch * 16; char* sb_ = sa_ + GL_TILEB; \
                        *(uint4*)(sa_) = ra0; *(uint4*)(sa_ + 32 * GL_ROWB) = ra1; *(uint4*)(sa_ + 64 * GL_ROWB) = ra2; *(uint4*)(sa_ + 96 * GL_ROWB) = ra3; \
                        *(uint4*)(sb_) = rb0; *(uint4*)(sb_ + 32 * GL_ROWB) = rb1; *(uint4*)(sb_ + 64 * GL_ROWB) = rb2; *(uint4*)(sb_ + 96 * GL_ROWB) = rb3; }
        GL_LOAD(0)
        __syncthreads();
        GL_STORE(smem)
        __syncthreads();
        for (int kt = 0; kt < 16; ++kt) {
            char* cur = smem + (kt & 1) * 2 * GL_TILEB;
            char* nxt = smem + ((kt + 1) & 1) * 2 * GL_TILEB;
            if (kt + 1 < 16) GL_LOAD((kt + 1) * 64)
#pragma unroll
            for (int ks = 0; ks < 2; ++ks) {
                bf16x8 af[4], wf[4];
#pragma unroll
                for (int i = 0; i < 4; ++i) {
                    af[i] = *(const bf16x8*)(cur + (wm * 64 + i * 16 + fr) * GL_ROWB + (ks * 4 + fq) * 16);
                    wf[i] = *(const bf16x8*)(cur + GL_TILEB + (wn * 64 + i * 16 + fr) * GL_ROWB + (ks * 4 + fq) * 16);
                }
#pragma unroll
                for (int ni = 0; ni < 4; ++ni)
#pragma unroll
                    for (int mi = 0; mi < 4; ++mi) acc[ni][mi] = __builtin_amdgcn_mfma_f32_16x16x32_bf16(wf[ni], af[mi], acc[ni][mi], 0, 0, 0);
            }
            if (kt + 1 < 16) GL_STORE(nxt)
            __syncthreads();
        }
#pragma unroll
        for (int mi = 0; mi < 4; ++mi)
#pragma unroll
            for (int ni = 0; ni < 4; ++ni) epi(m0 + wm * 64 + mi * 16 + fr, n0 + wn * 64 + ni * 16 + fq * 4, acc[ni][mi]);
    }
}

__device__ __forceinline__ void rope_pair(float* rowp, int base, int d, const float* rp) {
    const float cs = rp[2 * d], sn = rp[2 * d + 1];
    const float x1 = rowp[base + d], x2 = rowp[base + d + 32];
    rowp[base + d] = x1 * cs - x2 * sn; rowp[base + d + 32] = x1 * sn + x2 * cs;
}
__device__ void ph_prep_even(const P& p, int j) {
    const float* cw = p.ev_conv_w + (size_t)j * 3 * 512; const float* cb = p.ev_conv_b + (size_t)j * 512;
    const size_t tot = (size_t)NT * 512;
    for (size_t i = (size_t)blockIdx.x * 256 + threadIdx.x; i < tot; i += (size_t)gridDim.x * 256) {
        const int r = (int)(i >> 9), c = (int)(i & 511);
        int t, T; if (r < NL) { t = r & 2047; T = 2048; } else { t = (r - NL) & 255; T = 256; }
        float v = cb[c] + p.PROJ[(size_t)r * EVW + c] * cw[512 + c];
        if (t > 0) v += p.PROJ[(size_t)(r - 1) * EVW + c] * cw[c];
        if (t < T - 1) v += p.PROJ[(size_t)(r + 1) * EVW + c] * cw[1024 + c];
        v = silu_f(v);
        if (c >= 256) v *= 0.125f;
        p.QKC[i] = v;
    }
    const size_t tot2 = (size_t)NL * 512;
    for (size_t i = (size_t)blockIdx.x * 256 + threadIdx.x; i < tot2; i += (size_t)gridDim.x * 256) {
        const int r = (int)(i >> 9), e = (int)(i & 511);
        const int d = e & 31, hm = (e >> 5) & 7, which = e >> 8;
        const int base = (which ? C_DK : C_DQ) + hm * 64;
        rope_pair(p.PROJ + (size_t)r * EVW, base, d, p.rope + (size_t)(r & 2047) * 64);
    }
}
__device__ void ph_prep_odd(const P& p) {
    const size_t tot = (size_t)NL * 640;
    for (size_t i = (size_t)blockIdx.x * 256 + threadIdx.x; i < tot; i += (size_t)gridDim.x * 256) {
        const int r = (int)(i / 640), e = (int)(i % 640);
        const int d = e & 31, hh = e >> 5;
        rope_pair(p.PROJ + (size_t)r * ODW, hh * 64, d, p.rope + (size_t)(r & 2047) * 64);
    }
}

template <bool MASK>
__device__ __forceinline__ void attn_seg(const float (&q)[64], float (&o)[64], float& m, float& l, const float* base, int ld, int krow0, int cnt,
                                         int kc, int vc, int qpos, int kpos0, float* sK, float* sV) {
    for (int t0 = 0; t0 < cnt; t0 += 32) {
        __syncthreads();
        for (int e = threadIdx.x; e < 32 * 16; e += 256) {
            const int kk = e >> 4, c4 = (e & 15) * 4;
            float4 kv = make_float4(0.f, 0.f, 0.f, 0.f), vv = kv;
            bool ok = true;
            if (MASK) { const int kpos = kpos0 + t0 + kk; ok = (kpos >= 0 && kpos < 2048); }
            if (ok) { const float* rp = base + (size_t)(krow0 + t0 + kk) * ld; kv = *(const float4*)(rp + kc + c4); vv = *(const float4*)(rp + vc + c4); }
            *(float4*)(sK + kk * 64 + c4) = kv; *(float4*)(sV + kk * 64 + c4) = vv;
        }
        __syncthreads();
        for (int kk = 0; kk < 32; ++kk) {
            if (MASK) { const int kpos = kpos0 + t0 + kk; const int dlt = qpos - kpos; if (!(dlt <= 128 && dlt >= -128 && kpos >= 0 && kpos < 2048)) continue; }
            float s = 0.f;
#pragma unroll
            for (int d = 0; d < 64; ++d) s += q[d] * sK[kk * 64 + d];
            const float mn = fmaxf(m, s), corr = expf(m - mn), pp = expf(s - mn);
            l = l * corr + pp;
#pragma unroll
            for (int d = 0; d < 64; ++d) o[d] = o[d] * corr + pp * sV[kk * 64 + d];
            m = mn;
        }
    }
}

__device__ void da_item(const P& p, int item, float* smem) {
    float* sK = smem; float* sV = smem + 2048;
    int b, h, mp, vh, qrow;
    const bool lat = item < 1024;
    if (lat) { const int qb = item & 7; vh = (item >> 3) & 1; mp = (item >> 4) & 1; h = (item >> 5) & 3; b = item >> 7; qrow = b * 2048 + qb * 256 + threadIdx.x; }
    else { const int it = item - 1024; vh = it & 1; mp = (it >> 1) & 1; h = (it >> 2) & 3; b = it >> 4; qrow = NL + b * 256 + threadIdx.x; }
    float q[64], o[64];
    const float* qp = p.PROJ + (size_t)qrow * EVW + C_DQ + h * 128 + mp * 64;
#pragma unroll
    for (int d = 0; d < 64; ++d) { q[d] = qp[d] * 0.125f; o[d] = 0.f; }
    float m = -INFINITY, l = 0.f;
    const int kc = C_DK + h * 128 + mp * 64, vc = C_DV + h * 128 + vh * 64;
    attn_seg<false>(q, o, m, l, p.PROJ, EVW, NL + b * 256, 256, kc, vc, 0, 0, sK, sV);
    if (lat) attn_seg<false>(q, o, m, l, p.PROJ, EVW, b * 2048, 2048, kc, vc, 0, 0, sK, sV);
    const float il = 1.f / l;
    float* op = p.DAO + ((size_t)mp * NT + qrow) * 512 + h * 128 + vh * 64;
#pragma unroll
    for (int d = 0; d < 64; ++d) op[d] = o[d] * il;
}

__device__ void wa_item(const P& p, int item, int j, float* smem) {
    float* sK = smem; float* sV = smem + 2048;
    const int qi = threadIdx.x & 127;
    const bool lat = item < 1024;
    int b, nbk, hh, qrow;
    if (lat) { hh = item & 7; nbk = (item >> 3) & 15; b = item >> 7; qrow = b * 2048 + nbk * 128 + qi; }
    else { const int it = item - 1024; hh = it & 7; nbk = (it >> 3) & 1; b = it >> 4; qrow = NL + b * 256 + nbk * 128 + qi; }
    const int hq = hh * 2 + (threadIdx.x >> 7), hkv = hh >> 1;
    float q[64], o[64];
    const float* qp = p.PROJ + (size_t)qrow * ODW + hq * 64;
#pragma unroll
    for (int d = 0; d < 64; ++d) { q[d] = qp[d] * 0.125f; o[d] = 0.f; }
    float m = p.od_sink[j * 16 + hq], l = 1.f;
    const int kc = 1024 + hkv * 64, vc = 1280 + hkv * 64;
    attn_seg<false>(q, o, m, l, p.PROJ, ODW, NL + b * 256, 256, kc, vc, 0, 0, sK, sV);
    if (lat) attn_seg<true>(q, o, m, l, p.PROJ, ODW, b * 2048 + (nbk - 1) * 128, 384, kc, vc, nbk * 128 + qi, (nbk - 1) * 128, sK, sV);
    const float il = 1.f / l;
    uint4* op = (uint4*)(p.MIX + (size_t)qrow * DM + hq * 64);
#pragma unroll
    for (int d = 0; d < 8; ++d)
        op[d] = make_uint4(cvt_pk_bf16(o[8 * d] * il, o[8 * d + 1] * il), cvt_pk_bf16(o[8 * d + 2] * il, o[8 * d + 3] * il),
                           cvt_pk_bf16(o[8 * d + 4] * il, o[8 * d + 5] * il), cvt_pk_bf16(o[8 * d + 6] * il, o[8 * d + 7] * il));
}

__device__ void mlstm_item(const P& p, int item, int j, float* smem) {
    const int dir = item & 1, h = (item >> 1) & 3, b = item >> 3;
    const int tid = threadIdx.x, vi = tid >> 1, kh = tid & 1;
    float* sq = smem;
    float* sk = smem + 32 * 64;
    float* sv = smem + 2 * 32 * 64;
    float* sg = smem + 2 * 32 * 64 + 32 * 128;
    int* srow = (int*)(sg + 64);
    float C[32], n[32];
#pragma unroll
    for (int i = 0; i < 32; ++i) { C[i] = 0.f; n[i] = 0.f; }
    float m = 0.f;
    const float gbi = p.ev_gate_b[j * 16 + (dir * 2) * 4 + h], gbf = p.ev_gate_b[j * 16 + (dir * 2 + 1) * 4 + h];
    float* hm = p.HM + (size_t)dir * NT * 512;
    for (int s0 = 0; s0 < 2304; s0 += 32) {
        __syncthreads();
        if (tid < 32) {
            const int st = s0 + tid; int row;
            if (st < 256) row = NL + b * 256 + (dir ? 255 - st : st);
            else { const int t = st - 256; row = b * 2048 + (dir ? 2047 - t : t); }
            srow[tid] = row;
            const float ig = p.PROJ[(size_t)row * EVW + C_G + (dir * 2) * 4 + h] + gbi;
            const float fg = p.PROJ[(size_t)row * EVW + C_G + (dir * 2 + 1) * 4 + h] + gbf;
            sg[tid * 2] = ig; sg[tid * 2 + 1] = log_sigmoid_f(fg);
        }
        __syncthreads();
        for (int e = tid; e < 32 * 256; e += 256) {
            const int st = e >> 8, c = e & 255; const int row = srow[st];
            if (c < 64) sq[st * 64 + c] = p.QKC[(size_t)row * 512 + h * 64 + c];
            else if (c < 128) sk[st * 64 + (c - 64)] = p.QKC[(size_t)row * 512 + 256 + h * 64 + (c - 64)];
            else sv[st * 128 + (c - 128)] = p.PROJ[(size_t)row * EVW + C_V + h * 128 + (c - 128)];
        }
        __syncthreads();
        for (int st = 0; st < 32; ++st) {
            const float ig = sg[st * 2], lf = sg[st * 2 + 1];
            const float mn = fmaxf(lf + m, ig);
            const float fd = expf(lf + m - mn), ie = expf(ig - mn);
            m = mn;
            const float vv = sv[st * 128 + vi] * ie;
            float num = 0.f, den = 0.f;
#pragma unroll
            for (int i = 0; i < 32; ++i) {
                const float kk = sk[st * 64 + kh * 32 + i], qq = sq[st * 64 + kh * 32 + i];
                C[i] = fd * C[i] + vv * kk; n[i] = fd * n[i] + ie * kk;
                num += C[i] * qq; den += n[i] * qq;
            }
            num += __shfl_xor(num, 1); den += __shfl_xor(den, 1);
            const float hv = num / fmaxf(fabsf(den), expf(-m));
            if (kh == 0) hm[(size_t)srow[st] * 512 + h * 128 + vi] = hv;
        }
    }
}

__device__ void ph_attn_even(const P& p, int j, float* smem) {
    for (int item = blockIdx.x; item < 64 + 1152; item += gridDim.x) {
        if (item < 64) mlstm_item(p, item, j, smem); else da_item(p, item - 64, smem);
        __syncthreads();
    }
}
__device__ void ph_attn_odd(const P& p, int j, bool need_ctx, float* smem) {
    const int nitem = need_ctx ? 1152 : 1024;
    for (int item = blockIdx.x; item < nitem; item += gridDim.x) { wa_item(p, item, j, smem); __syncthreads(); }
}

__device__ void ph_mixout_even(const P& p, int L, int j) {
    const int lane = threadIdx.x & 63, wid = threadIdx.x >> 6;
    const float lam_init = 0.8f - 0.6f * expf(-0.3f * (float)L);
    const float* lp = p.ev_da_lam + (size_t)j * 256;
    float a0 = lp[lane] * lp[64 + lane], a1 = lp[128 + lane] * lp[192 + lane];
    a0 = wave_sum(a0); a1 = wave_sum(a1);
    const float lam = expf(a0) - expf(a1) + lam_init;
    for (int w = blockIdx.x * 4 + wid; w < NT * 8; w += gridDim.x * 4) {
        const int r = w >> 3, hh = w & 7;
        if (hh < 4) {
            const int c = hh * 128 + lane * 2;
            const float2 f = *(const float2*)(p.HM + (size_t)r * 512 + c), bk = *(const float2*)(p.HM + (size_t)NT * 512 + (size_t)r * 512 + c);
            const float v0 = f.x + bk.x, v1 = f.y + bk.y;
            const float ss = wave_sum(v0 * v0 + v1 * v1);
            const float rstd = rsqrtf(ss * (1.f / 128.f) + 1e-6f);
            const float2 g = *(const float2*)(p.ev_ml_g + (size_t)j * 512 + c), og = *(const float2*)(p.PROJ + (size_t)r * EVW + C_O + c);
            *(unsigned*)(p.MIX + (size_t)r * DM + c) = cvt_pk_bf16(v0 * rstd * g.x * sigmoid_f(og.x), v1 * rstd * g.y * sigmoid_f(og.y));
        } else {
            const int c = (hh - 4) * 128 + lane * 2;
            const float2 d0 = *(const float2*)(p.DAO + (size_t)r * 512 + c), d1 = *(const float2*)(p.DAO + (size_t)NT * 512 + (size_t)r * 512 + c);
            const float v0 = d0.x - lam * d1.x, v1 = d0.y - lam * d1.y;
            const float ss = wave_sum(v0 * v0 + v1 * v1);
            const float rstd = rsqrtf(ss * (1.f / 128.f) + 1e-6f);
            const float2 g = *(const float2*)(p.ev_da_g + (size_t)j * 512 + c);
            *(unsigned*)(p.MIX + (size_t)r * DM + 512 + c) = cvt_pk_bf16(v0 * rstd * g.x * (1.f - lam_init), v1 * rstd * g.y * (1.f - lam_init));
        }
    }
}

__device__ __forceinline__ float wave_max(float v) {
#pragma unroll
    for (int o = 32; o > 0; o >>= 1) v = fmaxf(v, __shfl_xor(v, o));
    return v;
}
#define SEL_LD 132
__device__ void ph_peer_select(const P& p, int L, int nrows, char* smem) {
    float* S = (float*)smem;
    const int tid = threadIdx.x, lane = tid & 63, wid = tid >> 6, fr = lane & 15, fq = lane >> 4;
    const bf16_t* KBL = p.KB + (size_t)L * 8 * 2 * 128 * 128;
    int ci = 0, cj = 0; bool cvalid = false;
    {
        int base = 0;
#pragma unroll
        for (int ii = 0; ii < 16; ++ii) { const int c = 16 / (ii + 1); if (lane >= base && lane < base + c) { ci = ii; cj = lane - base; cvalid = true; } base += c; }
    }
    const int ntile = nrows / 32;
    for (int item = blockIdx.x; item < ntile * 8; item += gridDim.x) {
        const int h = item & 7, t0 = (item >> 3) * 32;
        __syncthreads();
        {
            const int pp = wid >> 1, th = wid & 1;
            const bf16_t* qp = p.QB + (size_t)(t0 + th * 16 + fr) * 2048 + h * 256 + pp * 128 + fq * 8;
            bf16x8 qf[4];
#pragma unroll
            for (int ks = 0; ks < 4; ++ks) qf[ks] = *(const bf16x8*)(qp + ks * 32);
            const bf16_t* kp = KBL + ((size_t)(h * 2 + pp) * 128 + fr) * 128 + fq * 8;
#pragma unroll
            for (int ni = 0; ni < 8; ++ni) {
                f32x4 acc = (f32x4){0.f, 0.f, 0.f, 0.f};
#pragma unroll
                for (int ks = 0; ks < 4; ++ks) {
                    const bf16x8 kf = *(const bf16x8*)(kp + (size_t)ni * 16 * 128 + ks * 32);
                    acc = __builtin_amdgcn_mfma_f32_16x16x32_bf16(qf[ks], kf, acc, 0, 0, 0);
                }
#pragma unroll
                for (int j = 0; j < 4; ++j) S[(pp * 32 + th * 16 + fq * 4 + j) * SEL_LD + ni * 16 + fr] = acc[j];
            }
        }
        __syncthreads();
        for (int tt = 0; tt < 8; ++tt) {
            const int t = wid * 8 + tt, r = t0 + t;
            float v00 = S[t * SEL_LD + lane], v01 = S[t * SEL_LD + 64 + lane], v10 = S[(32 + t) * SEL_LD + lane], v11 = S[(32 + t) * SEL_LD + 64 + lane];
            float sv0 = 0.f, sv1 = 0.f; int si0 = 0, si1 = 0;
            for (int rd = 0; rd < 16; ++rd) {
                {
                    const float m = wave_max(fmaxf(v00, v01));
                    unsigned long long b = __ballot(v00 == m); int idx;
                    if (b) { idx = __ffsll((long long)b) - 1; if (lane == idx) v00 = -INFINITY; }
                    else { b = __ballot(v01 == m); idx = __ffsll((long long)b) - 1; if (lane == idx) v01 = -INFINITY; idx += 64; }
                    if (lane == rd) { sv0 = m; si0 = idx; }
                }
                {
                    const float m = wave_max(fmaxf(v10, v11));
                    unsigned long long b = __ballot(v10 == m); int idx;
                    if (b) { idx = __ffsll((long long)b) - 1; if (lane == idx) v10 = -INFINITY; }
                    else { b = __ballot(v11 == m); idx = __ffsll((long long)b) - 1; if (lane == idx) v11 = -INFINITY; idx += 64; }
                    if (lane == rd) { sv1 = m; si1 = idx; }
                }
            }
            float cand = __shfl(sv0, ci) + __shfl(sv1, cj);
            const int cidx = __shfl(si0, ci) * 128 + __shfl(si1, cj);
            if (!cvalid) cand = -INFINITY;
            float cs = -INFINITY; int ce = 0;
            for (int rd = 0; rd < 16; ++rd) {
                const float m = wave_max(cand);
                const unsigned long long b = __ballot(cand == m);
                const int idx = __ffsll((long long)b) - 1;
                const int e = __builtin_amdgcn_readlane(cidx, idx);
                if (lane == idx) cand = -INFINITY;
                if (lane == rd) { cs = m; ce = e; }
            }
            const float mx = __int_as_float(__builtin_amdgcn_readlane(__float_as_int(cs), 0));
            const float ex = lane < 16 ? expf(cs - mx) : 0.f;
            const float sum = wave_sum(ex);
            if (lane < 16) { p.GATE[(size_t)r * 128 + h * 16 + lane] = ex / sum; p.EIDX[(size_t)r * 128 + h * 16 + lane] = ce; }
        }
    }
}

__device__ __forceinline__ void unpack8(const uint4 u, float* f) {
    f[0] = bf_lo(u.x); f[1] = bf_hi(u.x); f[2] = bf_lo(u.y); f[3] = bf_hi(u.y); f[4] = bf_lo(u.z); f[5] = bf_hi(u.z); f[6] = bf_lo(u.w); f[7] = bf_hi(u.w);
}
__device__ void ph_peer_gather(const P& p, int L, int nrows) {
    const int lane = threadIdx.x & 63, wid = threadIdx.x >> 6;
    const bf16_t* U = p.UB + (size_t)L * 16384 * 1024; const bf16_t* V = p.VB + (size_t)L * 16384 * 1024;
    const float* gate2 = p.modv + (size_t)L * 9 * 6144 + 5120;
    for (int r = blockIdx.x * 4 + wid; r < nrows; r += gridDim.x * 4) {
        const int e0 = p.EIDX[(size_t)r * 128 + lane], e1 = p.EIDX[(size_t)r * 128 + 64 + lane];
        const float g0 = p.GATE[(size_t)r * 128 + lane], g1 = p.GATE[(size_t)r * 128 + 64 + lane];
        float x[16];
        { const uint4 xa = *(const uint4*)(p.XN + (size_t)r * DM + lane * 8), xb = *(const uint4*)(p.XN + (size_t)r * DM + 512 + lane * 8); unpack8(xa, x); unpack8(xb, x + 8); }
        float a0 = 0.f, a1 = 0.f;
#pragma unroll
        for (int half = 0; half < 2; ++half) {
            const int ev = half ? e1 : e0;
            float av = 0.f;
            for (int kb = 0; kb < 8; ++kb) {
                uint4 ua[8], ub[8];
#pragma unroll
                for (int j = 0; j < 8; ++j) {
                    const int idx = __builtin_amdgcn_readlane(ev, kb * 8 + j);
                    const bf16_t* rp = U + (size_t)idx * 1024 + lane * 8;
                    ua[j] = *(const uint4*)rp; ub[j] = *(const uint4*)(rp + 512);
                }
#pragma unroll
                for (int j = 0; j < 8; ++j) {
                    float f[16]; unpack8(ua[j], f); unpack8(ub[j], f + 8);
                    float s = 0.f;
#pragma unroll
                    for (int c = 0; c < 16; ++c) s += x[c] * f[c];
                    s = wave_sum(s);
                    if (lane == kb * 8 + j) av = s;
                }
            }
            if (half) a1 = av; else a0 = av;
        }
        const float w0 = g0 * 0.5f * a0 * (1.f + erff(a0 * 0.70710678118654752f));
        const float w1 = g1 * 0.5f * a1 * (1.f + erff(a1 * 0.70710678118654752f));
        float acc[16];
#pragma unroll
        for (int c = 0; c < 16; ++c) acc[c] = 0.f;
#pragma unroll
        for (int half = 0; half < 2; ++half) {
            const int ev = half ? e1 : e0; const int wv = __float_as_int(half ? w1 : w0);
            for (int kb = 0; kb < 8; ++kb) {
                uint4 ua[8], ub[8];
#pragma unroll
                for (int j = 0; j < 8; ++j) {
                    const int idx = __builtin_amdgcn_readlane(ev, kb * 8 + j);
                    const bf16_t* rp = V + (size_t)idx * 1024 + lane * 8;
                    ua[j] = *(const uint4*)rp; ub[j] = *(const uint4*)(rp + 512);
                }
#pragma unroll
                for (int j = 0; j < 8; ++j) {
                    const float wj = __int_as_float(__builtin_amdgcn_readlane(wv, kb * 8 + j));
                    float f[16]; unpack8(ua[j], f); unpack8(ub[j], f + 8);
#pragma unroll
                    for (int c = 0; c < 16; ++c) acc[c] += wj * f[c];
                }
            }
        }
        const float* gp = gate2 + (size_t)modrow(r) * 6144;
        float* hp = p.H + (size_t)r * DM;
#pragma unroll
        for (int q = 0; q < 4; ++q) {
            const int c = (q >> 1) * 512 + lane * 8 + (q & 1) * 4;
            const float4 g = *(const float4*)(gp + c);
            float4 hv = *(float4*)(hp + c);
            hv.x += g.x * acc[q * 4 + 0]; hv.y += g.y * acc[q * 4 + 1]; hv.z += g.z * acc[q * 4 + 2]; hv.w += g.w * acc[q * 4 + 3];
            *(float4*)(hp + c) = hv;
        }
    }
}

__device__ void run_phase(const P& p, int ph, float* smem) {
    if (ph == 0) { ph_prologue(p, smem); return; }
    if (ph == NPH - 1) { ph_final(p); return; }
    const int L = (ph - 1) / 10, s = (ph - 1) % 10, j = L >> 1;
    const bool even = (L & 1) == 0, need_ctx = L < 3;
    const int nrows = need_ctx ? NT : NL;
    const float* mv = p.modv + (size_t)L * 9 * 6144;
    switch (s) {
    case 0: ph_normmod(p.H, p.norm1_g + L * DM, mv, 0, 1024, p.XN, NT); break;
    case 1:
        if (even) ph_gemm(p.XN, p.WT + WT_EVIN(j), NT, 3200, EpiStoreF32{p.PROJ, EVW, EVW}, (char*)smem);
        else ph_gemm(p.XN, p.WT + WT_ODIN(j), NT, ODW, EpiStoreF32{p.PROJ, ODW, ODW}, (char*)smem);
        break;
    case 2: if (even) ph_prep_even(p, j); else ph_prep_odd(p); break;
    case 3: if (even) ph_attn_even(p, j, smem); else ph_attn_odd(p, j, need_ctx, smem); break;
    case 4: if (even) ph_mixout_even(p, L, j); break;
    case 5:
        ph_gemm(p.MIX, p.WT + (even ? WT_EVOUT(j) : WT_ODOUT(j)), nrows, DM, EpiResid{p.H, mv + 2048}, (char*)smem);
        break;
    case 6: ph_normmod(p.H, p.norm2_g + L * DM, mv, 3072, 4096, p.XN, nrows); break;
    case 7: ph_gemm(p.XN, p.WT + WT_PQ(L), nrows, 2048, EpiStoreBF16{p.QB, 2048}, (char*)smem); break;
    case 8: ph_peer_select(p, L, nrows, (char*)smem); break;
    case 9: ph_peer_gather(p, L, nrows); break;
    }
}

__global__ void __launch_bounds__(256) mega(P p) {
    extern __shared__ __attribute__((aligned(16))) float smem[];
    cg::grid_group grid = cg::this_grid();
    for (int ph = p.ph_lo; ph < p.ph_hi; ++ph) {
        run_phase(p, ph, smem);
        if (ph + 1 < p.ph_hi) grid.sync();
    }
}

extern "C" void kernel_launch(void* const* d_in, const int* in_sizes, int n_in, void* d_out, int out_size, void* d_ws, size_t ws_size, hipStream_t stream) {
    static int grid_blocks = 0;
    if (!grid_blocks) {
        int dev = 0, cus = 0, per_cu = 0;
        hipGetDevice(&dev);
        hipDeviceGetAttribute(&cus, hipDeviceAttributeMultiprocessorCount, dev);
        hipFuncSetAttribute((const void*)mega, hipFuncAttributeMaxDynamicSharedMemorySize, LDS_BYTES);
        hipOccupancyMaxActiveBlocksPerMultiprocessor(&per_cu, mega, 256, LDS_BYTES);
        if (per_cu < 1) per_cu = 1;
        if (per_cu > 2) per_cu = 2;
        grid_blocks = cus * per_cu;
    }
    P p{};
    const float** ins = (const float**)&p;
    for (int i = 0; i < 24; ++i) ins[i] = (const float*)d_in[i];
    p.out = (float*)d_out;
    size_t off = 0; char* ws = (char*)d_ws;
    auto carve = [&](size_t bytes) { void* r = ws + off; off += (bytes + 255) & ~(size_t)255; return r; };
    p.modv = (float*)carve((size_t)4 * 9 * 6144 * 4);
    p.rope = (float*)carve((size_t)2048 * 64 * 4);
    p.H = (float*)carve((size_t)NT * DM * 4);
    p.XN = (bf16_t*)carve((size_t)NT * DM * 2);
    p.WT = (bf16_t*)carve(WT_TOTAL * 2);
    p.PROJ = (float*)carve((size_t)NT * EVW * 4);
    p.MIX = (bf16_t*)carve((size_t)NT * DM * 2);
    p.QKC = (float*)carve((size_t)NT * 512 * 4);
    p.HM = (float*)carve((size_t)2 * NT * 512 * 4);
    p.DAO = (float*)carve((size_t)2 * NT * 512 * 4);
    p.QB = (bf16_t*)p.PROJ;
    p.UB = (bf16_t*)carve((size_t)4 * 16384 * 1024 * 2);
    p.VB = (bf16_t*)carve((size_t)4 * 16384 * 1024 * 2);
    p.KB = (bf16_t*)carve((size_t)4 * 8 * 2 * 128 * 128 * 2);
    p.GATE = (float*)carve((size_t)NT * 128 * 4);
    p.EIDX = (int*)carve((size_t)NT * 128 * 4);
    if (off > ws_size) { fprintf(stderr, "kernel_launch: workspace too small: need %zu have %zu\n", off, ws_size); return; }
#if ONE_LAUNCH
    p.ph_lo = 0; p.ph_hi = NPH;
    void* args[] = {&p};
    hipError_t e = hipLaunchCooperativeKernel((void*)mega, dim3(grid_blocks), dim3(256), args, LDS_BYTES, stream);
    if (e != hipSuccess) fprintf(stderr, "cooperative launch failed: %s (grid %d)\n", hipGetErrorString(e), grid_blocks);
#else
    for (int ph = 0; ph < NPH; ++ph) {
        if (ph > 0 && ph < NPH - 1) { const int L = (ph - 1) / 10, s = (ph - 1) % 10; if (s == 4 && (L & 1)) continue; }
        p.ph_lo = ph; p.ph_hi = ph + 1;
        hipLaunchKernelGGL(mega, dim3(grid_blocks), dim3(256), LDS_BYTES, stream, p);
    }
#endif
}
```

```cpp
#include <hip/hip_runtime.h>
#include <hip/hip_cooperative_groups.h>
#include <cstdio>
#include <cstdint>
namespace cg = cooperative_groups;

#ifndef ONE_LAUNCH
#define ONE_LAUNCH 1
#endif

#define NT 18432
#define NL 16384
#define DM 1024
#define EVW 3088
#define ODW 1536
#define C_QK 0
#define C_V 512
#define C_O 1024
#define C_G 1536
#define C_DQ 1552
#define C_DK 2064
#define C_DV 2576
#define NPH 42

typedef unsigned short bf16_t;
typedef short bf16x8 __attribute__((ext_vector_type(8)));
typedef float f32x4 __attribute__((ext_vector_type(4)));
#define LDS_BYTES 73728

typedef float f32x16 __attribute__((ext_vector_type(16)));
typedef unsigned u32x4 __attribute__((ext_vector_type(4)));
struct P {
    const float *x, *c, *ctx, *c_ctx, *mod_w, *mod_b, *norm1_g, *norm2_g, *ev_w_in, *ev_conv_w, *ev_conv_b, *ev_gate_b,
        *ev_ml_g, *ev_da_lam, *ev_da_g, *ev_w_out, *od_w_in, *od_sink, *od_w_out, *pr_w_q, *pr_keys, *pr_u, *pr_v, *final_g;
    float* out;
    float *modv, *H, *QKC, *HM, *GATE, *rope, *GT;
    int* EIDX;
    bf16_t *XN, *MIX, *WT, *UB, *VB, *KB, *QB, *PB, *AQL, *AQC, *AK, *AV;
    int ph_lo, ph_hi;
};
#define QSCALE 0.18033688011112042f

__device__ __forceinline__ int modrow(int r) { return r < NL ? (r >> 11) : 8; }
__device__ __forceinline__ float silu_f(float x) { return x / (1.f + expf(-x)); }
__device__ __forceinline__ float sigmoid_f(float x) { return 1.f / (1.f + expf(-x)); }
__device__ __forceinline__ float log_sigmoid_f(float x) { return fminf(x, 0.f) - log1pf(expf(-fabsf(x))); }
typedef __bf16 bf16v2_t __attribute__((ext_vector_type(2)));
typedef float f32x2_t __attribute__((ext_vector_type(2)));
__device__ __forceinline__ unsigned cvt_pk_bf16(float lo, float hi) { const bf16v2_t v = __builtin_convertvector((f32x2_t){lo, hi}, bf16v2_t); return __builtin_bit_cast(unsigned, v); }
__device__ __forceinline__ float bf_lo(unsigned u) { return __uint_as_float(u << 16); }
__device__ __forceinline__ float bf_hi(unsigned u) { return __uint_as_float(u & 0xffff0000u); }
#define WT_EVIN(j) ((size_t)(j) * 3200 * 1024)
#define WT_EVOUT(j) ((size_t)2 * 3200 * 1024 + (size_t)(j) * 1024 * 1024)
#define WT_ODIN(j) ((size_t)2 * 3200 * 1024 + (size_t)2 * 1024 * 1024 + (size_t)(j) * 1536 * 1024)
#define WT_ODOUT(j) ((size_t)2 * 3200 * 1024 + (size_t)2 * 1024 * 1024 + (size_t)2 * 1536 * 1024 + (size_t)(j) * 1024 * 1024)
#define WT_PQ(L) ((size_t)2 * 3200 * 1024 + (size_t)4 * 1024 * 1024 + (size_t)2 * 1536 * 1024 + (size_t)(L) * 2048 * 1024)
#define WT_TOTAL ((size_t)2 * 3200 * 1024 + (size_t)4 * 1024 * 1024 + (size_t)2 * 1536 * 1024 + (size_t)4 * 2048 * 1024)
__device__ __forceinline__ float wave_sum(float v) {
#pragma unroll
    for (int o = 32; o > 0; o >>= 1) v += __shfl_xor(v, o);
    return v;
}

__device__ void cvt_copy_bf16(const float* src, bf16_t* dst, size_t n);
__device__ void ph_prologue(const P& p, float* smem) {
    const int tid = threadIdx.x, nb = gridDim.x, bid = blockIdx.x;
    {
        const float4* xs = (const float4*)p.x; const float4* cs = (const float4*)p.ctx; float4* hd = (float4*)p.H;
        const size_t nx = (size_t)NL * DM / 4, nc = (size_t)(NT - NL) * DM / 4;
        for (size_t i = (size_t)bid * 256 + tid; i < nx + nc; i += (size_t)nb * 256) hd[i] = i < nx ? xs[i] : cs[i - nx];
    }
    for (int i = bid * 256 + tid; i < 2048 * 32; i += nb * 256) {
        const int s = i >> 5, d = i & 31;
        const float pos = (d < 16) ? (float)(s >> 6) : (float)(s & 63);
        const float inv = powf(10000.0f, -(float)(d & 15) / 16.0f);
        const float ang = pos * inv;
        p.rope[2 * i] = cosf(ang); p.rope[2 * i + 1] = sinf(ang);
    }
    float* sc = smem;
    float* red = smem + 9 * 1024;
    for (int i = tid; i < 9 * 1024; i += 256) { const int r = i >> 10, k = i & 1023; const float v = r < 8 ? p.c[r * 1024 + k] : p.c_ctx[k]; sc[i] = silu_f(v); }
    __syncthreads();
    for (int item = bid; item < 4 * 96; item += nb) {
        const int L = item / 96, n0 = (item % 96) * 64, tx = tid & 63, kq = tid >> 6;
        float acc[9];
#pragma unroll
        for (int r = 0; r < 9; ++r) acc[r] = 0.f;
        const float* w = p.mod_w + (size_t)L * 1024 * 6144 + n0 + tx;
        for (int k = kq * 256; k < kq * 256 + 256; ++k) {
            const float wv = w[(size_t)k * 6144];
#pragma unroll
            for (int r = 0; r < 9; ++r) acc[r] += sc[r * 1024 + k] * wv;
        }
#pragma unroll
        for (int r = 0; r < 9; ++r) red[(kq * 9 + r) * 64 + tx] = acc[r];
        __syncthreads();
        if (kq == 0) {
#pragma unroll
            for (int r = 0; r < 9; ++r) {
                const float s = red[(0 * 9 + r) * 64 + tx] + red[(1 * 9 + r) * 64 + tx] + red[(2 * 9 + r) * 64 + tx] + red[(3 * 9 + r) * 64 + tx];
                p.modv[((size_t)L * 9 + r) * 6144 + n0 + tx] = s + p.mod_b[L * 6144 + n0 + tx];
            }
        }
        __syncthreads();
    }
    {
        float (*tile)[65] = (float (*)[65])smem;
        for (int item = bid; item < 5440; item += nb) {
            int it = item, mat = 0, N = 0, Npad = 0; const float* src = nullptr; bf16_t* dst = nullptr;
            for (mat = 0; mat < 12; ++mat) {
                if (mat < 2) { N = EVW; Npad = 3200; src = p.ev_w_in + (size_t)mat * DM * EVW; dst = p.WT + WT_EVIN(mat); }
                else if (mat < 4) { N = 1024; Npad = 1024; src = p.ev_w_out + (size_t)(mat - 2) * DM * DM; dst = p.WT + WT_EVOUT(mat - 2); }
                else if (mat < 6) { N = ODW; Npad = ODW; src = p.od_w_in + (size_t)(mat - 4) * DM * ODW; dst = p.WT + WT_ODIN(mat - 4); }
                else if (mat < 8) { N = 1024; Npad = 1024; src = p.od_w_out + (size_t)(mat - 6) * DM * DM; dst = p.WT + WT_ODOUT(mat - 6); }
                else { N = 2048; Npad = 2048; src = p.pr_w_q + (size_t)(mat - 8) * DM * 2048; dst = p.WT + WT_PQ(mat - 8); }
                const int nt = 16 * (Npad / 64);
                if (it < nt) break;
                it -= nt;
            }
            const int k0 = (it & 15) * 64, n0 = (it >> 4) * 64;
            __syncthreads();
#pragma unroll
            for (int rep = 0; rep < 4; ++rep) {
                const int i = (tid >> 4) + 16 * rep, c4 = (tid & 15) * 4;
                float4 v = make_float4(0.f, 0.f, 0.f, 0.f);
                int sc = n0 + c4;
                if (mat < 2) sc = sc < 1536 ? sc : (sc < 3072 ? sc + 16 : (sc < 3088 ? sc - 3072 + 1536 : N));
                if (sc < N) v = *(const float4*)(src + (size_t)(k0 + i) * N + sc);
                tile[i][c4] = v.x; tile[i][c4 + 1] = v.y; tile[i][c4 + 2] = v.z; tile[i][c4 + 3] = v.w;
            }
            __syncthreads();
            {
                const int n = tid >> 2, kq = (tid & 3) * 16;
                unsigned w[8];
#pragma unroll
                for (int e = 0; e < 8; ++e) w[e] = cvt_pk_bf16(tile[kq + 2 * e][n], tile[kq + 2 * e + 1][n]);
                uint4* dp = (uint4*)(dst + (size_t)(n0 + n) * DM + k0 + kq);
                dp[0] = make_uint4(w[0], w[1], w[2], w[3]); dp[1] = make_uint4(w[4], w[5], w[6], w[7]);
            }
        }
    }
    cvt_copy_bf16(p.pr_u, p.UB, (size_t)4 * 16384 * 1024);
    cvt_copy_bf16(p.pr_v, p.VB, (size_t)4 * 16384 * 1024);
    cvt_copy_bf16(p.pr_keys, p.KB, (size_t)4 * 8 * 2 * 128 * 128);
}

__device__ void cvt_copy_bf16(const float* src, bf16_t* dst, size_t n) {
    const size_t n8 = n / 8;
    for (size_t i = (size_t)blockIdx.x * 256 + threadIdx.x; i < n8; i += (size_t)gridDim.x * 256) {
        const float4 a = ((const float4*)src)[2 * i], b = ((const float4*)src)[2 * i + 1];
        ((uint4*)dst)[i] = make_uint4(cvt_pk_bf16(a.x, a.y), cvt_pk_bf16(a.z, a.w), cvt_pk_bf16(b.x, b.y), cvt_pk_bf16(b.z, b.w));
    }
}

__device__ void ph_normmod(const float* src, const float* g, const float* modv_layer, int shift_off, int scale_off, bf16_t* dst, int nrows) {
    const int lane = threadIdx.x & 63, wid = threadIdx.x >> 6;
    for (int r = blockIdx.x * 4 + wid; r < nrows; r += gridDim.x * 4) {
        const float4* s4 = (const float4*)(src + (size_t)r * DM);
        float4 v[4]; float ss = 0.f;
#pragma unroll
        for (int i = 0; i < 4; ++i) { v[i] = s4[i * 64 + lane]; ss += v[i].x * v[i].x + v[i].y * v[i].y + v[i].z * v[i].z + v[i].w * v[i].w; }
        ss = wave_sum(ss);
        const float rstd = rsqrtf(ss * (1.0f / DM) + 1e-6f);
        const float* mv = modv_layer + (size_t)modrow(r) * 6144;
        uint2* d2 = (uint2*)(dst + (size_t)r * DM);
#pragma unroll
        for (int i = 0; i < 4; ++i) {
            const int c = (i * 64 + lane) * 4;
            const float4 gg = *(const float4*)(g + c), sh = *(const float4*)(mv + shift_off + c), scl = *(const float4*)(mv + scale_off + c);
            float4 o;
            o.x = v[i].x * rstd * gg.x * (1.f + scl.x) + sh.x; o.y = v[i].y * rstd * gg.y * (1.f + scl.y) + sh.y;
            o.z = v[i].z * rstd * gg.z * (1.f + scl.z) + sh.z; o.w = v[i].w * rstd * gg.w * (1.f + scl.w) + sh.w;
            d2[i * 64 + lane] = make_uint2(cvt_pk_bf16(o.x, o.y), cvt_pk_bf16(o.z, o.w));
        }
    }
}

__device__ void ph_final(const P& p) {
    const int lane = threadIdx.x & 63, wid = threadIdx.x >> 6;
    for (int r = blockIdx.x * 4 + wid; r < NL; r += gridDim.x * 4) {
        const float4* s4 = (const float4*)(p.H + (size_t)r * DM);
        float4 v[4]; float ss = 0.f;
#pragma unroll
        for (int i = 0; i < 4; ++i) { v[i] = s4[i * 64 + lane]; ss += v[i].x * v[i].x + v[i].y * v[i].y + v[i].z * v[i].z + v[i].w * v[i].w; }
        ss = wave_sum(ss);
        const float rstd = rsqrtf(ss * (1.0f / DM) + 1e-6f);
        float4* d4 = (float4*)(p.out + (size_t)r * DM);
#pragma unroll
        for (int i = 0; i < 4; ++i) {
            const int c = (i * 64 + lane) * 4; const float4 gg = *(const float4*)(p.final_g + c);
            float4 o; o.x = v[i].x * rstd * gg.x; o.y = v[i].y * rstd * gg.y; o.z = v[i].z * rstd * gg.z; o.w = v[i].w * rstd * gg.w;
            d4[i * 64 + lane] = o;
        }
    }
}

#define GL_ROWB 144
#define GL_TILEB (128 * GL_ROWB)
struct TokPos { int b, pos, kpos; bool lat; };
__device__ __forceinline__ TokPos tokpos(int row) {
    TokPos t; t.lat = row < NL;
    if (t.lat) { t.b = row >> 11; t.pos = row & 2047; t.kpos = 256 + t.pos; } else { const int r = row - NL; t.b = r >> 8; t.pos = r & 255; t.kpos = t.pos; }
    return t;
}
struct EpiStoreBF16 {
    bf16_t* C; int ldc;
    __device__ __forceinline__ bool swapped(int) const { return false; }
    __device__ __forceinline__ void operator()(const f32x4 (&acc)[4][4], int m0, int n0, int wm, int wn, int fr, int fq) const {
#pragma unroll
        for (int mi = 0; mi < 4; ++mi)
#pragma unroll
            for (int ni = 0; ni < 4; ++ni) {
                const f32x4 v = acc[ni][mi];
                *(uint2*)(C + (size_t)(m0 + wm * 64 + mi * 16 + fr) * ldc + n0 + wn * 64 + ni * 16 + fq * 4) = make_uint2(cvt_pk_bf16(v[0], v[1]), cvt_pk_bf16(v[2], v[3]));
            }
    }
};
struct EpiResid {
    float* H; const float* gate;
    __device__ __forceinline__ bool swapped(int) const { return false; }
    __device__ __forceinline__ void operator()(const f32x4 (&acc)[4][4], int m0, int n0, int wm, int wn, int fr, int fq) const {
#pragma unroll
        for (int mi = 0; mi < 4; ++mi) {
            const int row = m0 + wm * 64 + mi * 16 + fr;
            const float* gp = gate + (size_t)modrow(row) * 6144;
#pragma unroll
            for (int ni = 0; ni < 4; ++ni) {
                const int col = n0 + wn * 64 + ni * 16 + fq * 4;
                const f32x4 g = *(const f32x4*)(gp + col);
                f32x4* hp = (f32x4*)(H + (size_t)row * DM + col);
                *hp = *hp + g * acc[ni][mi];
            }
        }
    }
};
__device__ __forceinline__ void rope_store64(const f32x4 (&acc)[4][4], int mi, bool do_rope, const float* ropep  , float scale, bf16_t* dst  , int fq) {
#pragma unroll
    for (int ni = 0; ni < 2; ++ni) {
        f32x4 x1 = acc[ni][mi], x2 = acc[ni + 2][mi];
        if (do_rope) {
            const f32x4 r0 = *(const f32x4*)(ropep + (ni * 16 + fq * 4) * 2), r1 = *(const f32x4*)(ropep + (ni * 16 + fq * 4) * 2 + 4);
            const f32x4 cs = (f32x4){r0[0], r0[2], r1[0], r1[2]}, sn = (f32x4){r0[1], r0[3], r1[1], r1[3]};
            const f32x4 y1 = x1 * cs - x2 * sn, y2 = x1 * sn + x2 * cs;
            x1 = y1; x2 = y2;
        }
        x1 = x1 * scale; x2 = x2 * scale;
        *(uint2*)(dst + ni * 16 + fq * 4) = make_uint2(cvt_pk_bf16(x1[0], x1[1]), cvt_pk_bf16(x1[2], x1[3]));
        *(uint2*)(dst + 32 + ni * 16 + fq * 4) = make_uint2(cvt_pk_bf16(x2[0], x2[1]), cvt_pk_bf16(x2[2], x2[3]));
    }
}
struct EpiEven {
    bf16_t *PB, *AQL, *AQC, *AK, *AV; float* GT; const float* rope;
    __device__ __forceinline__ bool swapped(int n0) const { return n0 >= 2560 && n0 < 3072; }
    __device__ __forceinline__ void operator()(const f32x4 (&acc)[4][4], int m0, int n0, int wm, int wn, int fr, int fq) const {
        const int t = n0 >> 7;
        if (t < 12) {
#pragma unroll
            for (int mi = 0; mi < 4; ++mi)
#pragma unroll
                for (int ni = 0; ni < 4; ++ni) {
                    const f32x4 v = acc[ni][mi];
                    *(uint2*)(PB + (size_t)(m0 + wm * 64 + mi * 16 + fr) * 1536 + n0 + wn * 64 + ni * 16 + fq * 4) = make_uint2(cvt_pk_bf16(v[0], v[1]), cvt_pk_bf16(v[2], v[3]));
                }
        } else if (t < 20) {
            const bool isq = t < 16; const int h = t & 3;
#pragma unroll
            for (int mi = 0; mi < 4; ++mi) {
                const TokPos tp = tokpos(m0 + wm * 64 + mi * 16 + fr);
                const int hm = (tp.b * 4 + h) * 2 + wn;
                bf16_t* dst;
                if (isq) dst = tp.lat ? AQL + ((size_t)hm * 2048 + tp.pos) * 64 : AQC + ((size_t)hm * 256 + tp.pos) * 64;
                else dst = AK + ((size_t)hm * 2304 + tp.kpos) * 64;
                rope_store64(acc, mi, tp.lat, rope + (size_t)tp.pos * 64, isq ? QSCALE : 1.0f, dst, fq);
            }
        } else if (t < 24) {
            const int h = t - 20;
#pragma unroll
            for (int mi = 0; mi < 4; ++mi) {
                const TokPos tp = tokpos(m0 + wm * 64 + mi * 16 + fq * 4);
#pragma unroll
                for (int ni = 0; ni < 4; ++ni) {
                    const f32x4 v = acc[ni][mi];
                    const int d = wn * 64 + ni * 16 + fr;
                    *(uint2*)(AV + ((size_t)(tp.b * 4 + h) * 128 + d) * 2304 + tp.kpos) = make_uint2(cvt_pk_bf16(v[0], v[1]), cvt_pk_bf16(v[2], v[3]));
                }
            }
        } else {
            if (wn == 0) {
#pragma unroll
                for (int mi = 0; mi < 4; ++mi) *(f32x4*)(GT + (size_t)(m0 + wm * 64 + mi * 16 + fr) * 16 + fq * 4) = acc[0][mi];
            }
        }
    }
};
struct EpiOdd {
    bf16_t *AQL, *AQC, *AK, *AV; const float* rope;
    __device__ __forceinline__ bool swapped(int n0) const { return n0 >= 1280; }
    __device__ __forceinline__ void operator()(const f32x4 (&acc)[4][4], int m0, int n0, int wm, int wn, int fr, int fq) const {
        const int t = n0 >> 7;
        if (t < 10) {
            const bool isq = t < 8; const int hd = isq ? t * 2 + wn : (t - 8) * 2 + wn;
#pragma unroll
            for (int mi = 0; mi < 4; ++mi) {
                const TokPos tp = tokpos(m0 + wm * 64 + mi * 16 + fr);
                bf16_t* dst;
                if (isq) dst = tp.lat ? AQL + ((size_t)(tp.b * 16 + hd) * 2048 + tp.pos) * 64 : AQC + ((size_t)(tp.b * 16 + hd) * 256 + tp.pos) * 64;
                else dst = AK + ((size_t)(tp.b * 4 + hd) * 2304 + tp.kpos) * 64;
                rope_store64(acc, mi, tp.lat, rope + (size_t)tp.pos * 64, isq ? QSCALE : 1.0f, dst, fq);
            }
        } else {
            const int hkv = (t - 10) * 2 + wn;
#pragma unroll
            for (int mi = 0; mi < 4; ++mi) {
                const TokPos tp = tokpos(m0 + wm * 64 + mi * 16 + fq * 4);
#pragma unroll
                for (int ni = 0; ni < 4; ++ni) {
                    const f32x4 v = acc[ni][mi];
                    const int d = ni * 16 + fr;
                    *(uint2*)(AV + ((size_t)(tp.b * 4 + hkv) * 64 + d) * 2304 + tp.kpos) = make_uint2(cvt_pk_bf16(v[0], v[1]), cvt_pk_bf16(v[2], v[3]));
                }
            }
        }
    }
};
template <bool SWAP>
__device__ __forceinline__ void gemm_tile_kloop(f32x4 (&acc)[4][4], const bf16_t* ap, const bf16_t* bp, char* smem, int lrow, int lch, int wm, int wn, int fr, int fq) {
    uint4 ra0, ra1, ra2, ra3, rb0, rb1, rb2, rb3;
#define GL_LOAD(KO) { ra0 = *(const uint4*)(ap + (KO)); ra1 = *(const uint4*)(ap + (size_t)32 * DM + (KO)); ra2 = *(const uint4*)(ap + (size_t)64 * DM + (KO)); ra3 = *(const uint4*)(ap + (size_t)96 * DM + (KO)); \
                      rb0 = *(const uint4*)(bp + (KO)); rb1 = *(const uint4*)(bp + (size_t)32 * DM + (KO)); rb2 = *(const uint4*)(bp + (size_t)64 * DM + (KO)); rb3 = *(const uint4*)(bp + (size_t)96 * DM + (KO)); }
#define GL_STORE(BUF) { char* sa_ = (BUF) + lrow * GL_ROWB + lch * 16; char* sb_ = sa_ + GL_TILEB; \
                        *(uint4*)(sa_) = ra0; *(uint4*)(sa_ + 32 * GL_ROWB) = ra1; *(uint4*)(sa_ + 64 * GL_ROWB) = ra2; *(uint4*)(sa_ + 96 * GL_ROWB) = ra3; \
                        *(uint4*)(sb_) = rb0; *(uint4*)(sb_ + 32 * GL_ROWB) = rb1; *(uint4*)(sb_ + 64 * GL_ROWB) = rb2; *(uint4*)(sb_ + 96 * GL_ROWB) = rb3; }
    GL_LOAD(0)
    __syncthreads();
    GL_STORE(smem)
    __syncthreads();
    for (int kt = 0; kt < 16; ++kt) {
        char* cur = smem + (kt & 1) * 2 * GL_TILEB;
        char* nxt = smem + ((kt + 1) & 1) * 2 * GL_TILEB;
        if (kt + 1 < 16) GL_LOAD((kt + 1) * 64)
#pragma unroll
        for (int ks = 0; ks < 2; ++ks) {
            bf16x8 af[4], wf[4];
#pragma unroll
            for (int i = 0; i < 4; ++i) {
                af[i] = *(const bf16x8*)(cur + (wm * 64 + i * 16 + fr) * GL_ROWB + (ks * 4 + fq) * 16);
                wf[i] = *(const bf16x8*)(cur + GL_TILEB + (wn * 64 + i * 16 + fr) * GL_ROWB + (ks * 4 + fq) * 16);
            }
#pragma unroll
            for (int ni = 0; ni < 4; ++ni)
#pragma unroll
                for (int mi = 0; mi < 4; ++mi)
                    acc[ni][mi] = SWAP ? __builtin_amdgcn_mfma_f32_16x16x32_bf16(af[mi], wf[ni], acc[ni][mi], 0, 0, 0)
                                       : __builtin_amdgcn_mfma_f32_16x16x32_bf16(wf[ni], af[mi], acc[ni][mi], 0, 0, 0);
        }
        if (kt + 1 < 16) GL_STORE(nxt)
        __syncthreads();
    }
#undef GL_LOAD
#undef GL_STORE
}
template <class Epi>
__device__ void ph_gemm(const bf16_t* A, const bf16_t* Bt, int M, int Npad, const Epi& epi, char* smem) {
    const int tid = threadIdx.x, lane = tid & 63, wid = tid >> 6, wm = wid >> 1, wn = wid & 1;
    const int fr = lane & 15, fq = lane >> 4;
    const int tm = M / 128, tn = Npad / 128, ntiles = tm * tn;
    const int lrow = tid >> 3, lch = tid & 7;
    for (int tile = blockIdx.x; tile < ntiles; tile += gridDim.x) {
        const int m0 = (tile % tm) * 128, n0 = (tile / tm) * 128;
        f32x4 acc[4][4];
#pragma unroll
        for (int a = 0; a < 4; ++a)
#pragma unroll
            for (int b = 0; b < 4; ++b) acc[a][b] = (f32x4){0.f, 0.f, 0.f, 0.f};
        const bf16_t* ap = A + (size_t)(m0 + lrow) * DM + lch * 8;
        const bf16_t* bp = Bt + (size_t)(n0 + lrow) * DM + lch * 8;
        if (epi.swapped(n0)) gemm_tile_kloop<true>(acc, ap, bp, smem, lrow, lch, wm, wn, fr, fq);
        else gemm_tile_kloop<false>(acc, ap, bp, smem, lrow, lch, wm, wn, fr, fq);
        epi(acc, m0, n0, wm, wn, fr, fq);
    }
}

__device__ void ph_prep_even(const P& p, int j) {
    const float* cw = p.ev_conv_w + (size_t)j * 3 * 512; const float* cb = p.ev_conv_b + (size_t)j * 512;
    const size_t tot = (size_t)NT * 512;
    for (size_t i = (size_t)blockIdx.x * 256 + threadIdx.x; i < tot; i += (size_t)gridDim.x * 256) {
        const int r = (int)(i >> 9), c = (int)(i & 511);
        int t, T; if (r < NL) { t = r & 2047; T = 2048; } else { t = (r - NL) & 255; T = 256; }
        float v = cb[c] + __uint_as_float((unsigned)p.PB[(size_t)r * 1536 + c] << 16) * cw[512 + c];
        if (t > 0) v += __uint_as_float((unsigned)p.PB[(size_t)(r - 1) * 1536 + c] << 16) * cw[c];
        if (t < T - 1) v += __uint_as_float((unsigned)p.PB[(size_t)(r + 1) * 1536 + c] << 16) * cw[1024 + c];
        v = silu_f(v);
        if (c >= 256) v *= 0.125f;
        p.QKC[i] = v;
    }
}

#define FA_KROW 144
#define FA_VROW 136
__device__ __forceinline__ bf16x8 pack8(float a0, float a1, float a2, float a3, float a4, float a5, float a6, float a7) {
    const u32x4 u = (u32x4){cvt_pk_bf16(a0, a1), cvt_pk_bf16(a2, a3), cvt_pk_bf16(a4, a5), cvt_pk_bf16(a6, a7)};
    return __builtin_bit_cast(bf16x8, u);
}
template <int NDB, bool MASK>
__device__ __forceinline__ void flash_tile(const bf16x8 (&qf)[4], f32x16 (&o)[NDB], float& m, float& l, const char* Kl, const char* Vl, int lane, int qpos, int kp0) {
    const int j = lane & 31, h = lane >> 5;
    f32x16 s0, s1;
#pragma unroll
    for (int i = 0; i < 16; ++i) { s0[i] = 0.f; s1[i] = 0.f; }
#pragma unroll
    for (int ks = 0; ks < 4; ++ks) {
        const bf16x8 a0 = *(const bf16x8*)(Kl + j * FA_KROW + (2 * ks + h) * 16);
        const bf16x8 a1 = *(const bf16x8*)(Kl + (32 + j) * FA_KROW + (2 * ks + h) * 16);
        s0 = __builtin_amdgcn_mfma_f32_32x32x16_bf16(a0, qf[ks], s0, 0, 0, 0);
        s1 = __builtin_amdgcn_mfma_f32_32x32x16_bf16(a1, qf[ks], s1, 0, 0, 0);
    }
    if (MASK) {
#pragma unroll
        for (int r = 0; r < 16; ++r) {
            const int key = (r & 3) + 8 * (r >> 2) + 4 * h;
            const int d0 = qpos - (kp0 + key), d1 = d0 - 32;
            if (d0 > 128 || d0 < -128) s0[r] = -1e30f;
            if (d1 > 128 || d1 < -128) s1[r] = -1e30f;
        }
    }
    float mx = fmaxf(s0[0], s1[0]);
#pragma unroll
    for (int r = 1; r < 16; ++r) mx = fmaxf(mx, fmaxf(s0[r], s1[r]));
    mx = fmaxf(mx, __shfl_xor(mx, 32));
    const float mn = fmaxf(m, mx);
    const float alpha = __builtin_amdgcn_exp2f(m - mn);
    m = mn;
    float ls = 0.f;
#pragma unroll
    for (int r = 0; r < 16; ++r) { s0[r] = __builtin_amdgcn_exp2f(s0[r] - mn); s1[r] = __builtin_amdgcn_exp2f(s1[r] - mn); ls += s0[r] + s1[r]; }
    l = l * alpha + ls;
#pragma unroll
    for (int db = 0; db < NDB; ++db) o[db] = o[db] * alpha;
    bf16x8 pb[4];
    pb[0] = pack8(s0[0], s0[1], s0[2], s0[3], s0[4], s0[5], s0[6], s0[7]);
    pb[1] = pack8(s0[8], s0[9], s0[10], s0[11], s0[12], s0[13], s0[14], s0[15]);
    pb[2] = pack8(s1[0], s1[1], s1[2], s1[3], s1[4], s1[5], s1[6], s1[7]);
    pb[3] = pack8(s1[8], s1[9], s1[10], s1[11], s1[12], s1[13], s1[14], s1[15]);
#pragma unroll
    for (int db = 0; db < NDB; ++db)
#pragma unroll
        for (int kk = 0; kk < 4; ++kk) {
            const char* vp = Vl + (db * 32 + j) * FA_VROW + (kk * 16 + 4 * h) * 2;
            const uint2 lo = *(const uint2*)vp, hi = *(const uint2*)(vp + 16);
            const u32x4 u = (u32x4){lo.x, lo.y, hi.x, hi.y};
            o[db] = __builtin_amdgcn_mfma_f32_32x32x16_bf16(__builtin_bit_cast(bf16x8, u), pb[kk], o[db], 0, 0, 0);
        }
}

#define DA_BUFB 35840
__device__ void da_block(const P& p, int item, int L, int j, char* smem) {
    const int tid = threadIdx.x, lane = tid & 63, wid = tid >> 6, mp = wid & 1, qg = wid >> 1, jq = lane & 31, hh = lane >> 5;
    const bool lat = item < 1024;
    int b, h, qt;
    if (lat) { b = item >> 7; h = (item >> 5) & 3; qt = item & 31; } else { const int it = item - 1024; b = it >> 4; h = (it >> 2) & 3; qt = it & 3; }
    const int qi = qt * 64 + qg * 32 + jq;
    const bf16_t* qp = lat ? p.AQL + ((size_t)((b * 4 + h) * 2 + mp) * 2048 + qi) * 64 : p.AQC + ((size_t)((b * 4 + h) * 2 + mp) * 256 + qi) * 64;
    bf16x8 qf[4];
#pragma unroll
    for (int ks = 0; ks < 4; ++ks) qf[ks] = *(const bf16x8*)(qp + (2 * ks + hh) * 8);
    const int ntile = lat ? 36 : 4;
    const bf16_t* kg = p.AK + (size_t)((b * 4 + h) * 2) * 2304 * 64 + (size_t)(tid >> 3) * 64 + (tid & 7) * 8;
    const bf16_t* vg = p.AV + (size_t)(b * 4 + h) * 128 * 2304 + (size_t)(tid >> 3) * 2304 + (tid & 7) * 8;
    uint4 k0, k1, k2, k3, v0, v1, v2, v3;
#define DA_LOAD(KEY0) { k0 = *(const uint4*)(kg + (size_t)(KEY0) * 64); k1 = *(const uint4*)(kg + (size_t)((KEY0) + 32) * 64); \
                        k2 = *(const uint4*)(kg + (size_t)2304 * 64 + (size_t)(KEY0) * 64); k3 = *(const uint4*)(kg + (size_t)2304 * 64 + (size_t)((KEY0) + 32) * 64); \
                        v0 = *(const uint4*)(vg + (KEY0)); v1 = *(const uint4*)(vg + (size_t)32 * 2304 + (KEY0)); v2 = *(const uint4*)(vg + (size_t)64 * 2304 + (KEY0)); v3 = *(const uint4*)(vg + (size_t)96 * 2304 + (KEY0)); }
#define DA_STORE(BUF) { char* kb_ = (BUF) + (tid >> 3) * FA_KROW + (tid & 7) * 16; \
                        *(uint4*)kb_ = k0; *(uint4*)(kb_ + 32 * FA_KROW) = k1; *(uint4*)(kb_ + 64 * FA_KROW) = k2; *(uint4*)(kb_ + 96 * FA_KROW) = k3; \
                        char* vb_ = (BUF) + 18432 + (tid >> 3) * FA_VROW + (tid & 7) * 16; \
                        *(uint2*)vb_ = make_uint2(v0.x, v0.y); *(uint2*)(vb_ + 8) = make_uint2(v0.z, v0.w); \
                        *(uint2*)(vb_ + 32 * FA_VROW) = make_uint2(v1.x, v1.y); *(uint2*)(vb_ + 32 * FA_VROW + 8) = make_uint2(v1.z, v1.w); \
                        *(uint2*)(vb_ + 64 * FA_VROW) = make_uint2(v2.x, v2.y); *(uint2*)(vb_ + 64 * FA_VROW + 8) = make_uint2(v2.z, v2.w); \
                        *(uint2*)(vb_ + 96 * FA_VROW) = make_uint2(v3.x, v3.y); *(uint2*)(vb_ + 96 * FA_VROW + 8) = make_uint2(v3.z, v3.w); }
    f32x16 o[4];
#pragma unroll
    for (int db = 0; db < 4; ++db)
#pragma unroll
        for (int i = 0; i < 16; ++i) o[db][i] = 0.f;
    float m = -1e30f, l = 0.f;
    DA_LOAD(0)
    __syncthreads();
    DA_STORE(smem)
    __syncthreads();
    for (int t = 0; t < ntile; ++t) {
        char* cur = smem + (t & 1) * DA_BUFB;
        char* nxt = smem + ((t + 1) & 1) * DA_BUFB;
        if (t + 1 < ntile) DA_LOAD((t + 1) * 64)
        flash_tile<4, false>(qf, o, m, l, cur + mp * 9216, cur + 18432, lane, 0, 0);
        if (t + 1 < ntile) DA_STORE(nxt)
        __syncthreads();
    }
#undef DA_LOAD
#undef DA_STORE
    const float inv = 1.f / (l + __shfl_xor(l, 32));
#pragma unroll
    for (int db = 0; db < 4; ++db) o[db] = o[db] * inv;
    float* X = (float*)smem + qg * 4096;
    if (mp == 1) {
#pragma unroll
        for (int db = 0; db < 4; ++db)
#pragma unroll
            for (int r = 0; r < 16; ++r) X[(db * 32 + (r & 3) + 8 * (r >> 2) + 4 * hh) * 32 + jq] = o[db][r];
    }
    __syncthreads();
    if (mp == 0) {
        const float lam_init = 0.8f - 0.6f * expf(-0.3f * (float)L);
        const float* lp = p.ev_da_lam + (size_t)j * 256;
        float a0 = lp[lane] * lp[64 + lane], a1 = lp[128 + lane] * lp[192 + lane];
        a0 = wave_sum(a0); a1 = wave_sum(a1);
        const float lam = expf(a0) - expf(a1) + lam_init;
        float ss = 0.f;
#pragma unroll
        for (int db = 0; db < 4; ++db)
#pragma unroll
            for (int r = 0; r < 16; ++r) { const float v = o[db][r] - lam * X[(db * 32 + (r & 3) + 8 * (r >> 2) + 4 * hh) * 32 + jq]; o[db][r] = v; ss += v * v; }
        ss += __shfl_xor(ss, 32);
        const float sc = rsqrtf(ss * (1.f / 128.f) + 1e-6f) * (1.f - lam_init);
        const int row = lat ? b * 2048 + qi : NL + b * 256 + qi;
        bf16_t* mrow = p.MIX + (size_t)row * DM + 512 + h * 128;
        const float* g = p.ev_da_g + (size_t)j * 512 + h * 128;
#pragma unroll
        for (int db = 0; db < 4; ++db)
#pragma unroll
            for (int r4 = 0; r4 < 4; ++r4) {
                const int d = db * 32 + 8 * r4 + 4 * hh;
                const f32x4 gg = *(const f32x4*)(g + d);
                *(uint2*)(mrow + d) = make_uint2(cvt_pk_bf16(o[db][r4 * 4 + 0] * sc * gg[0], o[db][r4 * 4 + 1] * sc * gg[1]), cvt_pk_bf16(o[db][r4 * 4 + 2] * sc * gg[2], o[db][r4 * 4 + 3] * sc * gg[3]));
            }
    }
    __syncthreads();
}

#define WA_BUFB 17920
__device__ void wa_block(const P& p, int item, int j, char* smem) {
    const int tid = threadIdx.x, lane = tid & 63, wid = tid >> 6, jq = lane & 31, hh = lane >> 5;
    const bool lat = item < 2048;
    int b, nb, hq;
    if (lat) { hq = item & 15; nb = (item >> 4) & 15; b = item >> 8; } else { const int it = item - 2048; hq = it & 15; nb = (it >> 4) & 1; b = it >> 5; }
    const int hkv = hq >> 2;
    const int qi = nb * 128 + wid * 32 + jq;
    const bf16_t* qp = lat ? p.AQL + ((size_t)(b * 16 + hq) * 2048 + qi) * 64 : p.AQC + ((size_t)(b * 16 + hq) * 256 + qi) * 64;
    bf16x8 qf[4];
#pragma unroll
    for (int ks = 0; ks < 4; ++ks) qf[ks] = *(const bf16x8*)(qp + (2 * ks + hh) * 8);
    const int lfirst = (nb == 0) ? 2 : 0, nloc = lat ? 6 - lfirst - ((nb == 15) ? 2 : 0) : 0;
    const int ntile = 4 + nloc;
    const bf16_t* kg = p.AK + (size_t)(b * 4 + hkv) * 2304 * 64 + (size_t)(tid >> 3) * 64 + (tid & 7) * 8;
    const bf16_t* vg = p.AV + (size_t)(b * 4 + hkv) * 64 * 2304 + (size_t)(tid >> 3) * 2304 + (tid & 7) * 8;
    uint4 k0, k1, v0, v1;
#define WA_KEY0(T) ((T) < 4 ? (T) * 64 : 256 + (nb - 1) * 128 + ((T) - 4 + lfirst) * 64)
#define WA_LOAD(KEY0) { k0 = *(const uint4*)(kg + (size_t)(KEY0) * 64); k1 = *(const uint4*)(kg + (size_t)((KEY0) + 32) * 64); v0 = *(const uint4*)(vg + (KEY0)); v1 = *(const uint4*)(vg + (size_t)32 * 2304 + (KEY0)); }
#define WA_STORE(BUF) { char* kb_ = (BUF) + (tid >> 3) * FA_KROW + (tid & 7) * 16; *(uint4*)kb_ = k0; *(uint4*)(kb_ + 32 * FA_KROW) = k1; \
                        char* vb_ = (BUF) + 9216 + (tid >> 3) * FA_VROW + (tid & 7) * 16; \
                        *(uint2*)vb_ = make_uint2(v0.x, v0.y); *(uint2*)(vb_ + 8) = make_uint2(v0.z, v0.w); \
                        *(uint2*)(vb_ + 32 * FA_VROW) = make_uint2(v1.x, v1.y); *(uint2*)(vb_ + 32 * FA_VROW + 8) = make_uint2(v1.z, v1.w); }
    f32x16 o[2];
#pragma unroll
    for (int db = 0; db < 2; ++db)
#pragma unroll
        for (int i = 0; i < 16; ++i) o[db][i] = 0.f;
    float m = p.od_sink[j * 16 + hq] * 1.4426950408889634f, l = hh == 0 ? 1.f : 0.f;
    { const int key0 = WA_KEY0(0); WA_LOAD(key0) }
    __syncthreads();
    WA_STORE(smem)
    __syncthreads();
    for (int t = 0; t < ntile; ++t) {
        char* cur = smem + (t & 1) * WA_BUFB;
        char* nxt = smem + ((t + 1) & 1) * WA_BUFB;
        if (t + 1 < ntile) { const int key0 = WA_KEY0(t + 1); WA_LOAD(key0) }
        if (t < 4) flash_tile<2, false>(qf, o, m, l, cur, cur + 9216, lane, 0, 0);
        else flash_tile<2, true>(qf, o, m, l, cur, cur + 9216, lane, qi, WA_KEY0(t) - 256);
        if (t + 1 < ntile) WA_STORE(nxt)
        __syncthreads();
    }
#undef WA_LOAD
#undef WA_STORE
#undef WA_KEY0
    const float inv = 1.f / (l + __shfl_xor(l, 32));
    const int row = lat ? b * 2048 + qi : NL + b * 256 + qi;
    bf16_t* mrow = p.MIX + (size_t)row * DM + hq * 64;
#pragma unroll
    for (int db = 0; db < 2; ++db)
#pragma unroll
        for (int r4 = 0; r4 < 4; ++r4) {
            const int d = db * 32 + 8 * r4 + 4 * hh;
            *(uint2*)(mrow + d) = make_uint2(cvt_pk_bf16(o[db][r4 * 4 + 0] * inv, o[db][r4 * 4 + 1] * inv), cvt_pk_bf16(o[db][r4 * 4 + 2] * inv, o[db][r4 * 4 + 3] * inv));
        }
}

#ifndef DEBUG_WA_NAIVE
#define DEBUG_WA_NAIVE 0
#endif
__device__ void wa_naive_item(const P& p, int item, int j) {
    const bool lat = item < 1024;
    int b, nb, hh;
    if (lat) { hh = item & 7; nb = (item >> 3) & 15; b = item >> 7; } else { const int it = item - 1024; hh = it & 7; nb = (it >> 3) & 1; b = it >> 4; }
    const int hq = hh * 2 + (threadIdx.x >> 7), hkv = hq >> 2, qi = nb * 128 + (threadIdx.x & 127);
    const bf16_t* qp = lat ? p.AQL + ((size_t)(b * 16 + hq) * 2048 + qi) * 64 : p.AQC + ((size_t)(b * 16 + hq) * 256 + qi) * 64;
    float q[64], o[64];
#pragma unroll
    for (int d = 0; d < 64; ++d) { q[d] = __uint_as_float((unsigned)qp[d] << 16); o[d] = 0.f; }
    float m = p.od_sink[j * 16 + hq] * 1.4426950408889634f, l = 1.f;
    const bf16_t* Kb = p.AK + (size_t)(b * 4 + hkv) * 2304 * 64;
    const bf16_t* Vb = p.AV + (size_t)(b * 4 + hkv) * 64 * 2304;
    const int nk = lat ? 256 + 384 : 256;
    for (int kk = 0; kk < nk; ++kk) {
        int kpos = kk;
        if (kk >= 256) {
            const int lp = (nb - 1) * 128 + (kk - 256);
            if (lp < 0 || lp >= 2048) continue;
            const int dl = qi - lp;
            if (dl > 128 || dl < -128) continue;
            kpos = 256 + lp;
        }
        float s = 0.f;
#pragma unroll
        for (int d = 0; d < 64; ++d) s += q[d] * __uint_as_float((unsigned)Kb[(size_t)kpos * 64 + d] << 16);
        const float mn = fmaxf(m, s), corr = exp2f(m - mn), pp = exp2f(s - mn);
        l = l * corr + pp;
#pragma unroll
        for (int d = 0; d < 64; ++d) o[d] = o[d] * corr + pp * __uint_as_float((unsigned)Vb[(size_t)d * 2304 + kpos] << 16);
        m = mn;
    }
    const float il = 1.f / l;
    const int row = lat ? b * 2048 + qi : NL + b * 256 + qi;
    bf16_t* mrow = p.MIX + (size_t)row * DM + hq * 64;
#pragma unroll
    for (int d = 0; d < 64; d += 2) *(unsigned*)(mrow + d) = cvt_pk_bf16(o[d] * il, o[d + 1] * il);
}

__device__ void mlstm_item(const P& p, int item, int j, float* smem) {
    const int dir = item & 1, h = (item >> 1) & 3, b = item >> 3;
    const int tid = threadIdx.x, vi = tid >> 1, kh = tid & 1;
    float* sq = smem;
    float* sk = smem + 32 * 64;
    float* sv = smem + 2 * 32 * 64;
    float* sg = smem + 2 * 32 * 64 + 32 * 128;
    int* srow = (int*)(sg + 64);
    float C[32], n[32];
#pragma unroll
    for (int i = 0; i < 32; ++i) { C[i] = 0.f; n[i] = 0.f; }
    float m = 0.f;
    const float gbi = p.ev_gate_b[j * 16 + (dir * 2) * 4 + h], gbf = p.ev_gate_b[j * 16 + (dir * 2 + 1) * 4 + h];
    float* hm = p.HM + (size_t)dir * NT * 512;
    for (int s0 = 0; s0 < 2304; s0 += 32) {
        __syncthreads();
        if (tid < 32) {
            const int st = s0 + tid; int row;
            if (st < 256) row = NL + b * 256 + (dir ? 255 - st : st);
            else { const int t = st - 256; row = b * 2048 + (dir ? 2047 - t : t); }
            srow[tid] = row;
            const float ig = p.GT[(size_t)row * 16 + (dir * 2) * 4 + h] + gbi;
            const float fg = p.GT[(size_t)row * 16 + (dir * 2 + 1) * 4 + h] + gbf;
            sg[tid * 2] = ig; sg[tid * 2 + 1] = log_sigmoid_f(fg);
        }
        __syncthreads();
        for (int e = tid; e < 32 * 256; e += 256) {
            const int st = e >> 8, c = e & 255; const int row = srow[st];
            if (c < 64) sq[st * 64 + c] = p.QKC[(size_t)row * 512 + h * 64 + c];
            else if (c < 128) sk[st * 64 + (c - 64)] = p.QKC[(size_t)row * 512 + 256 + h * 64 + (c - 64)];
            else sv[st * 128 + (c - 128)] = __uint_as_float((unsigned)p.PB[(size_t)row * 1536 + 512 + h * 128 + (c - 128)] << 16);
        }
        __syncthreads();
        for (int st = 0; st < 32; ++st) {
            const float ig = sg[st * 2], lf = sg[st * 2 + 1];
            const float mn = fmaxf(lf + m, ig);
            const float fd = expf(lf + m - mn), ie = expf(ig - mn);
            m = mn;
            const float vv = sv[st * 128 + vi] * ie;
            float num = 0.f, den = 0.f;
#pragma unroll
            for (int i = 0; i < 32; ++i) {
                const float kk = sk[st * 64 + kh * 32 + i], qq = sq[st * 64 + kh * 32 + i];
                C[i] = fd * C[i] + vv * kk; n[i] = fd * n[i] + ie * kk;
                num += C[i] * qq; den += n[i] * qq;
            }
            num += __shfl_xor(num, 1); den += __shfl_xor(den, 1);
            const float hv = num / fmaxf(fabsf(den), expf(-m));
            if (kh == 0) hm[(size_t)srow[st] * 512 + h * 128 + vi] = hv;
        }
    }
}

__device__ void ph_attn_even(const P& p, int L, int j, float* smem) {
    for (int item = blockIdx.x; item < 64 + 1152; item += gridDim.x) {
        if (item < 64) mlstm_item(p, item, j, smem); else da_block(p, item - 64, L, j, (char*)smem);
        __syncthreads();
    }
}
__device__ void ph_attn_odd(const P& p, int j, bool need_ctx, float* smem) {
#if DEBUG_WA_NAIVE == 1
    const int nitem = need_ctx ? 1152 : 1024;
    for (int item = blockIdx.x; item < nitem; item += gridDim.x) wa_naive_item(p, item, j);
#elif DEBUG_WA_NAIVE == 3
    for (int item = blockIdx.x; item < 1024; item += gridDim.x) { const int nbk = (item >> 3) & 15; if (nbk == 0 || nbk == 15) wa_naive_item(p, item, j); }
    for (int item = blockIdx.x; item < 2048; item += gridDim.x) { const int nbk = (item >> 4) & 15; if (nbk != 0 && nbk != 15) { wa_block(p, item, j, (char*)smem); __syncthreads(); } }
    if (need_ctx) for (int item = 2048 + blockIdx.x; item < 2304; item += gridDim.x) { wa_block(p, item, j, (char*)smem); __syncthreads(); }
#elif DEBUG_WA_NAIVE == 2
    for (int item = blockIdx.x; item < 1024; item += gridDim.x) wa_naive_item(p, item, j);
    if (need_ctx) for (int item = 2048 + blockIdx.x; item < 2304; item += gridDim.x) { wa_block(p, item, j, (char*)smem); __syncthreads(); }
#else
    const int nitem = need_ctx ? 2304 : 2048;
    for (int item = blockIdx.x; item < nitem; item += gridDim.x) { wa_block(p, item, j, (char*)smem); __syncthreads(); }
#endif
}

__device__ void ph_mixout_even(const P& p, int L, int j) {
    const int lane = threadIdx.x & 63, wid = threadIdx.x >> 6;
    for (int w = blockIdx.x * 4 + wid; w < NT * 4; w += gridDim.x * 4) {
        const int r = w >> 2, hh = w & 3;
        const int c = hh * 128 + lane * 2;
        const float2 f = *(const float2*)(p.HM + (size_t)r * 512 + c), bk = *(const float2*)(p.HM + (size_t)NT * 512 + (size_t)r * 512 + c);
        const float v0 = f.x + bk.x, v1 = f.y + bk.y;
        const float ss = wave_sum(v0 * v0 + v1 * v1);
        const float rstd = rsqrtf(ss * (1.f / 128.f) + 1e-6f);
        const float2 g = *(const float2*)(p.ev_ml_g + (size_t)j * 512 + c);
        const unsigned ou = *(const unsigned*)(p.PB + (size_t)r * 1536 + 1024 + c);
        *(unsigned*)(p.MIX + (size_t)r * DM + c) = cvt_pk_bf16(v0 * rstd * g.x * sigmoid_f(bf_lo(ou)), v1 * rstd * g.y * sigmoid_f(bf_hi(ou)));
    }
}

__device__ __forceinline__ float wave_max(float v) {
#pragma unroll
    for (int o = 32; o > 0; o >>= 1) v = fmaxf(v, __shfl_xor(v, o));
    return v;
}
#define SEL_LD 132
__device__ void ph_peer_select(const P& p, int L, int nrows, char* smem) {
    float* S = (float*)smem;
    const int tid = threadIdx.x, lane = tid & 63, wid = tid >> 6, fr = lane & 15, fq = lane >> 4;
    const bf16_t* KBL = p.KB + (size_t)L * 8 * 2 * 128 * 128;
    int ci = 0, cj = 0; bool cvalid = false;
    {
        int base = 0;
#pragma unroll
        for (int ii = 0; ii < 16; ++ii) { const int c = 16 / (ii + 1); if (lane >= base && lane < base + c) { ci = ii; cj = lane - base; cvalid = true; } base += c; }
    }
    const int ntile = nrows / 32;
    for (int item = blockIdx.x; item < ntile * 8; item += gridDim.x) {
        const int h = item & 7, t0 = (item >> 3) * 32;
        __syncthreads();
        {
            const int pp = wid >> 1, th = wid & 1;
            const bf16_t* qp = p.QB + (size_t)(t0 + th * 16 + fr) * 2048 + h * 256 + pp * 128 + fq * 8;
            bf16x8 qf[4];
#pragma unroll
            for (int ks = 0; ks < 4; ++ks) qf[ks] = *(const bf16x8*)(qp + ks * 32);
            const bf16_t* kp = KBL + ((size_t)(h * 2 + pp) * 128 + fr) * 128 + fq * 8;
#pragma unroll
            for (int ni = 0; ni < 8; ++ni) {
                f32x4 acc = (f32x4){0.f, 0.f, 0.f, 0.f};
#pragma unroll
                for (int ks = 0; ks < 4; ++ks) {
                    const bf16x8 kf = *(const bf16x8*)(kp + (size_t)ni * 16 * 128 + ks * 32);
                    acc = __builtin_amdgcn_mfma_f32_16x16x32_bf16(qf[ks], kf, acc, 0, 0, 0);
                }
#pragma unroll
                for (int j = 0; j < 4; ++j) S[(pp * 32 + th * 16 + fq * 4 + j) * SEL_LD + ni * 16 + fr] = acc[j];
            }
        }
        __syncthreads();
        for (int tt = 0; tt < 8; ++tt) {
            const int t = wid * 8 + tt, r = t0 + t;
            float v00 = S[t * SEL_LD + lane], v01 = S[t * SEL_LD + 64 + lane], v10 = S[(32 + t) * SEL_LD + lane], v11 = S[(32 + t) * SEL_LD + 64 + lane];
            float sv0 = 0.f, sv1 = 0.f; int si0 = 0, si1 = 0;
            for (int rd = 0; rd < 16; ++rd) {
                {
                    const float m = wave_max(fmaxf(v00, v01));
                    unsigned long long b = __ballot(v00 == m); int idx;
                    if (b) { idx = __ffsll((long long)b) - 1; if (lane == idx) v00 = -INFINITY; }
                    else { b = __ballot(v01 == m); idx = __ffsll((long long)b) - 1; if (lane == idx) v01 = -INFINITY; idx += 64; }
                    if (lane == rd) { sv0 = m; si0 = idx; }
                }
                {
                    const float m = wave_max(fmaxf(v10, v11));
                    unsigned long long b = __ballot(v10 == m); int idx;
                    if (b) { idx = __ffsll((long long)b) - 1; if (lane == idx) v10 = -INFINITY; }
                    else { b = __ballot(v11 == m); idx = __ffsll((long long)b) - 1; if (lane == idx) v11 = -INFINITY; idx += 64; }
                    if (lane == rd) { sv1 = m; si1 = idx; }
                }
            }
            float cand = __shfl(sv0, ci) + __shfl(sv1, cj);
            const int cidx = __shfl(si0, ci) * 128 + __shfl(si1, cj);
            if (!cvalid) cand = -INFINITY;
            float cs = -INFINITY; int ce = 0;
            for (int rd = 0; rd < 16; ++rd) {
                const float m = wave_max(cand);
                const unsigned long long b = __ballot(cand == m);
                const int idx = __ffsll((long long)b) - 1;
                const int e = __builtin_amdgcn_readlane(cidx, idx);
                if (lane == idx) cand = -INFINITY;
                if (lane == rd) { cs = m; ce = e; }
            }
            const float mx = __int_as_float(__builtin_amdgcn_readlane(__float_as_int(cs), 0));
            const float ex = lane < 16 ? expf(cs - mx) : 0.f;
            const float sum = wave_sum(ex);
            if (lane < 16) { p.GATE[(size_t)r * 128 + h * 16 + lane] = ex / sum; p.EIDX[(size_t)r * 128 + h * 16 + lane] = ce; }
        }
    }
}

__device__ __forceinline__ void unpack8(const uint4 u, float* f) {
    f[0] = bf_lo(u.x); f[1] = bf_hi(u.x); f[2] = bf_lo(u.y); f[3] = bf_hi(u.y); f[4] = bf_lo(u.z); f[5] = bf_hi(u.z); f[6] = bf_lo(u.w); f[7] = bf_hi(u.w);
}
__device__ void ph_peer_gather(const P& p, int L, int nrows) {
    const int lane = threadIdx.x & 63, wid = threadIdx.x >> 6;
    const bf16_t* U = p.UB + (size_t)L * 16384 * 1024; const bf16_t* V = p.VB + (size_t)L * 16384 * 1024;
    const float* gate2 = p.modv + (size_t)L * 9 * 6144 + 5120;
    for (int r = blockIdx.x * 4 + wid; r < nrows; r += gridDim.x * 4) {
        const int e0 = p.EIDX[(size_t)r * 128 + lane], e1 = p.EIDX[(size_t)r * 128 + 64 + lane];
        const float g0 = p.GATE[(size_t)r * 128 + lane], g1 = p.GATE[(size_t)r * 128 + 64 + lane];
        float x[16];
        { const uint4 xa = *(const uint4*)(p.XN + (size_t)r * DM + lane * 8), xb = *(const uint4*)(p.XN + (size_t)r * DM + 512 + lane * 8); unpack8(xa, x); unpack8(xb, x + 8); }
        float a0 = 0.f, a1 = 0.f;
#pragma unroll
        for (int half = 0; half < 2; ++half) {
            const int ev = half ? e1 : e0;
            float av = 0.f;
            for (int kb = 0; kb < 8; ++kb) {
                uint4 ua[8], ub[8];
#pragma unroll
                for (int j = 0; j < 8; ++j) {
                    const int idx = __builtin_amdgcn_readlane(ev, kb * 8 + j);
                    const bf16_t* rp = U + (size_t)idx * 1024 + lane * 8;
                    ua[j] = *(const uint4*)rp; ub[j] = *(const uint4*)(rp + 512);
                }
#pragma unroll
                for (int j = 0; j < 8; ++j) {
                    float f[16]; unpack8(ua[j], f); unpack8(ub[j], f + 8);
                    float s = 0.f;
#pragma unroll
                    for (int c = 0; c < 16; ++c) s += x[c] * f[c];
                    s = wave_sum(s);
                    if (lane == kb * 8 + j) av = s;
                }
            }
            if (half) a1 = av; else a0 = av;
        }
        const float w0 = g0 * 0.5f * a0 * (1.f + erff(a0 * 0.70710678118654752f));
        const float w1 = g1 * 0.5f * a1 * (1.f + erff(a1 * 0.70710678118654752f));
        float acc[16];
#pragma unroll
        for (int c = 0; c < 16; ++c) acc[c] = 0.f;
#pragma unroll
        for (int half = 0; half < 2; ++half) {
            const int ev = half ? e1 : e0; const int wv = __float_as_int(half ? w1 : w0);
            for (int kb = 0; kb < 8; ++kb) {
                uint4 ua[8], ub[8];
#pragma unroll
                for (int j = 0; j < 8; ++j) {
                    const int idx = __builtin_amdgcn_readlane(ev, kb * 8 + j);
                    const bf16_t* rp = V + (size_t)idx * 1024 + lane * 8;
                    ua[j] = *(const uint4*)rp; ub[j] = *(const uint4*)(rp + 512);
                }
#pragma unroll
                for (int j = 0; j < 8; ++j) {
                    const float wj = __int_as_float(__builtin_amdgcn_readlane(wv, kb * 8 + j));
                    float f[16]; unpack8(ua[j], f); unpack8(ub[j], f + 8);
#pragma unroll
                    for (int c = 0; c < 16; ++c) acc[c] += wj * f[c];
                }
            }
        }
        const float* gp = gate2 + (size_t)modrow(r) * 6144;
        float* hp = p.H + (size_t)r * DM;
#pragma unroll
        for (int q = 0; q < 4; ++q) {
            const int c = (q >> 1) * 512 + lane * 8 + (q & 1) * 4;
            const float4 g = *(const float4*)(gp + c);
            float4 hv = *(float4*)(hp + c);
            hv.x += g.x * acc[q * 4 + 0]; hv.y += g.y * acc[q * 4 + 1]; hv.z += g.z * acc[q * 4 + 2]; hv.w += g.w * acc[q * 4 + 3];
            *(float4*)(hp + c) = hv;
        }
    }
}

__device__ void run_phase(const P& p, int ph, float* smem) {
    if (ph == 0) { ph_prologue(p, smem); return; }
    if (ph == NPH - 1) { ph_final(p); return; }
    const int L = (ph - 1) / 10, s = (ph - 1) % 10, j = L >> 1;
    const bool even = (L & 1) == 0, need_ctx = L < 3;
    const int nrows = need_ctx ? NT : NL;
    const float* mv = p.modv + (size_t)L * 9 * 6144;
    switch (s) {
    case 0: ph_normmod(p.H, p.norm1_g + L * DM, mv, 0, 1024, p.XN, NT); break;
    case 1:
        if (even) ph_gemm(p.XN, p.WT + WT_EVIN(j), NT, 3200, EpiEven{p.PB, p.AQL, p.AQC, p.AK, p.AV, p.GT, p.rope}, (char*)smem);
        else ph_gemm(p.XN, p.WT + WT_ODIN(j), NT, ODW, EpiOdd{p.AQL, p.AQC, p.AK, p.AV, p.rope}, (char*)smem);
        break;
    case 2: if (even) ph_prep_even(p, j); break;
    case 3: if (even) ph_attn_even(p, L, j, smem); else ph_attn_odd(p, j, need_ctx, smem); break;
    case 4: if (even) ph_mixout_even(p, L, j); break;
    case 5:
        ph_gemm(p.MIX, p.WT + (even ? WT_EVOUT(j) : WT_ODOUT(j)), nrows, DM, EpiResid{p.H, mv + 2048}, (char*)smem);
        break;
    case 6: ph_normmod(p.H, p.norm2_g + L * DM, mv, 3072, 4096, p.XN, nrows); break;
    case 7: ph_gemm(p.XN, p.WT + WT_PQ(L), nrows, 2048, EpiStoreBF16{p.QB, 2048}, (char*)smem); break;
    case 8: ph_peer_select(p, L, nrows, (char*)smem); break;
    case 9: ph_peer_gather(p, L, nrows); break;
    }
}

__global__ void __launch_bounds__(256) mega(P p) {
    extern __shared__ __attribute__((aligned(16))) float smem[];
    cg::grid_group grid = cg::this_grid();
    for (int ph = p.ph_lo; ph < p.ph_hi; ++ph) {
        run_phase(p, ph, smem);
        if (ph + 1 < p.ph_hi) grid.sync();
    }
}

extern "C" void kernel_launch(void* const* d_in, const int* in_sizes, int n_in, void* d_out, int out_size, void* d_ws, size_t ws_size, hipStream_t stream) {
    static int grid_blocks = 0;
    if (!grid_blocks) {
        int dev = 0, cus = 0, per_cu = 0;
        hipGetDevice(&dev);
        hipDeviceGetAttribute(&cus, hipDeviceAttributeMultiprocessorCount, dev);
        hipFuncSetAttribute((const void*)mega, hipFuncAttributeMaxDynamicSharedMemorySize, LDS_BYTES);
        hipOccupancyMaxActiveBlocksPerMultiprocessor(&per_cu, mega, 256, LDS_BYTES);
        if (per_cu < 1) per_cu = 1;
        if (per_cu > 2) per_cu = 2;
        grid_blocks = cus * per_cu;
    }
    P p{};
    const float** ins = (const float**)&p;
    for (int i = 0; i < 24; ++i) ins[i] = (const float*)d_in[i];
    p.out = (float*)d_out;
    size_t off = 0; char* ws = (char*)d_ws;
    auto carve = [&](size_t bytes) { void* r = ws + off; off += (bytes + 255) & ~(size_t)255; return r; };
    p.modv = (float*)carve((size_t)4 * 9 * 6144 * 4);
    p.rope = (float*)carve((size_t)2048 * 64 * 4);
    p.H = (float*)carve((size_t)NT * DM * 4);
    p.XN = (bf16_t*)carve((size_t)NT * DM * 2);
    p.WT = (bf16_t*)carve(WT_TOTAL * 2);
    p.MIX = (bf16_t*)carve((size_t)NT * DM * 2);
    p.PB = (bf16_t*)carve((size_t)NT * 1536 * 2);
    p.GT = (float*)carve((size_t)NT * 16 * 4);
    p.AQL = (bf16_t*)carve((size_t)8 * 16 * 2048 * 64 * 2);
    p.AQC = (bf16_t*)carve((size_t)8 * 16 * 256 * 64 * 2);
    p.AK = (bf16_t*)carve((size_t)8 * 4 * 2 * 2304 * 64 * 2);
    p.AV = (bf16_t*)carve((size_t)8 * 4 * 128 * 2304 * 2);
    p.QKC = (float*)carve((size_t)NT * 512 * 4);
    p.HM = (float*)carve((size_t)2 * NT * 512 * 4);
    p.QB = (bf16_t*)carve((size_t)NT * 2048 * 2);
    p.GATE = (float*)carve((size_t)NT * 128 * 4);
    p.EIDX = (int*)carve((size_t)NT * 128 * 4);
    p.UB = (bf16_t*)carve((size_t)4 * 16384 * 1024 * 2);
    p.VB = (bf16_t*)carve((size_t)4 * 16384 * 1024 * 2);
    p.KB = (bf16_t*)carve((size_t)4 * 8 * 2 * 128 * 128 * 2);
    if (off > ws_size) { fprintf(stderr, "kernel_launch: workspace too small: need %zu have %zu\n", off, ws_size); return; }
#if ONE_LAUNCH
    p.ph_lo = 0; p.ph_hi = NPH;
    void* args[] = {&p};
    hipError_t e = hipLaunchCooperativeKernel((void*)mega, dim3(grid_blocks), dim3(256), args, LDS_BYTES, stream);
    if (e != hipSuccess) fprintf(stderr, "cooperative launch failed: %s (grid %d)\n", hipGetErrorString(e), grid_blocks);
#else
    for (int ph = 0; ph < NPH; ++ph) {
        if (ph > 0 && ph < NPH - 1) { const int L = (ph - 1) / 10, s = (ph - 1) % 10; if ((s == 4 || s == 2) && (L & 1)) continue; }
        p.ph_lo = ph; p.ph_hi = ph + 1;
        hipLaunchKernelGGL(mega, dim3(grid_blocks), dim3(256), LDS_BYTES, stream, p);
    }
#endif
}
```

```cpp
#include <hip/hip_runtime.h>
#include <hip/hip_cooperative_groups.h>
#include <cstdio>
#include <cstdint>
namespace cg = cooperative_groups;

#ifndef ONE_LAUNCH
#define ONE_LAUNCH 1
#endif

#define NT 18432
#define NL 16384
#define DM 1024
#define EVW 3088
#define ODW 1536
#define C_QK 0
#define C_V 512
#define C_O 1024
#define C_G 1536
#define C_DQ 1552
#define C_DK 2064
#define C_DV 2576
#define NPH 42

typedef unsigned short bf16_t;
typedef short bf16x8 __attribute__((ext_vector_type(8)));
typedef float f32x4 __attribute__((ext_vector_type(4)));
#define LDS_BYTES 73728

typedef float f32x16 __attribute__((ext_vector_type(16)));
typedef unsigned u32x4 __attribute__((ext_vector_type(4)));
struct P {
    const float *x, *c, *ctx, *c_ctx, *mod_w, *mod_b, *norm1_g, *norm2_g, *ev_w_in, *ev_conv_w, *ev_conv_b, *ev_gate_b,
        *ev_ml_g, *ev_da_lam, *ev_da_g, *ev_w_out, *od_w_in, *od_sink, *od_w_out, *pr_w_q, *pr_keys, *pr_u, *pr_v, *final_g;
    float* out;
    float *modv, *H, *QKC, *HM, *GATE, *rope, *GT;
    int *EIDX, *ctr;
    bf16_t *XN, *MIX, *WT, *UB, *VB, *KB, *QB, *PB, *AQL, *AQC, *AK, *AV;
    int ph_lo, ph_hi;
};
#define QSCALE 0.18033688011112042f

__device__ __forceinline__ int otid() { int t = threadIdx.x; asm volatile("" : "+v"(t)); return t; }
__device__ __forceinline__ int modrow(int r) { return r < NL ? (r >> 11) : 8; }
__device__ __forceinline__ float silu_f(float x) { return x / (1.f + expf(-x)); }
__device__ __forceinline__ float sigmoid_f(float x) { return 1.f / (1.f + expf(-x)); }
__device__ __forceinline__ float log_sigmoid_f(float x) { return fminf(x, 0.f) - log1pf(expf(-fabsf(x))); }
typedef __bf16 bf16v2_t __attribute__((ext_vector_type(2)));
typedef float f32x2_t __attribute__((ext_vector_type(2)));
__device__ __forceinline__ unsigned cvt_pk_bf16(float lo, float hi) { const bf16v2_t v = __builtin_convertvector((f32x2_t){lo, hi}, bf16v2_t); return __builtin_bit_cast(unsigned, v); }
__device__ __forceinline__ float bf_lo(unsigned u) { return __uint_as_float(u << 16); }
__device__ __forceinline__ float bf_hi(unsigned u) { return __uint_as_float(u & 0xffff0000u); }
#define WT_EVIN(j) ((size_t)(j) * 3200 * 1024)
#define WT_EVOUT(j) ((size_t)2 * 3200 * 1024 + (size_t)(j) * 1024 * 1024)
#define WT_ODIN(j) ((size_t)2 * 3200 * 1024 + (size_t)2 * 1024 * 1024 + (size_t)(j) * 1536 * 1024)
#define WT_ODOUT(j) ((size_t)2 * 3200 * 1024 + (size_t)2 * 1024 * 1024 + (size_t)2 * 1536 * 1024 + (size_t)(j) * 1024 * 1024)
#define WT_PQ(L) ((size_t)2 * 3200 * 1024 + (size_t)4 * 1024 * 1024 + (size_t)2 * 1536 * 1024 + (size_t)(L) * 2048 * 1024)
#define WT_TOTAL ((size_t)2 * 3200 * 1024 + (size_t)4 * 1024 * 1024 + (size_t)2 * 1536 * 1024 + (size_t)4 * 2048 * 1024)
__device__ __forceinline__ float wave_sum(float v) {
#pragma unroll
    for (int o = 32; o > 0; o >>= 1) v += __shfl_xor(v, o);
    return v;
}

__device__ void cvt_copy_bf16(const float* src, bf16_t* dst, size_t n);
__device__ void ph_prologue(const P& p, float* smem) {
    const int tid = otid(), nb = gridDim.x, bid = blockIdx.x;
    if (bid == 0 && tid < 64) p.ctr[tid] = 0;
    {
        const float4* xs = (const float4*)p.x; const float4* cs = (const float4*)p.ctx; float4* hd = (float4*)p.H;
        const size_t nx = (size_t)NL * DM / 4, nc = (size_t)(NT - NL) * DM / 4;
        for (size_t i = (size_t)bid * 256 + tid; i < nx + nc; i += (size_t)nb * 256) hd[i] = i < nx ? xs[i] : cs[i - nx];
    }
    for (int i = bid * 256 + tid; i < 2048 * 32; i += nb * 256) {
        const int s = i >> 5, d = i & 31;
        const float pos = (d < 16) ? (float)(s >> 6) : (float)(s & 63);
        const float inv = powf(10000.0f, -(float)(d & 15) / 16.0f);
        const float ang = pos * inv;
        p.rope[2 * i] = cosf(ang); p.rope[2 * i + 1] = sinf(ang);
    }
    float* sc = smem;
    float* red = smem + 9 * 1024;
    for (int i = tid; i < 9 * 1024; i += 256) { const int r = i >> 10, k = i & 1023; const float v = r < 8 ? p.c[r * 1024 + k] : p.c_ctx[k]; sc[i] = silu_f(v); }
    __syncthreads();
    for (int item = bid; item < 4 * 96; item += nb) {
        const int L = item / 96, n0 = (item % 96) * 64, tx = tid & 63, kq = tid >> 6;
        float acc[9];
#pragma unroll
        for (int r = 0; r < 9; ++r) acc[r] = 0.f;
        const float* w = p.mod_w + (size_t)L * 1024 * 6144 + n0 + tx;
        for (int k = kq * 256; k < kq * 256 + 256; ++k) {
            const float wv = w[(size_t)k * 6144];
#pragma unroll
            for (int r = 0; r < 9; ++r) acc[r] += sc[r * 1024 + k] * wv;
        }
#pragma unroll
        for (int r = 0; r < 9; ++r) red[(kq * 9 + r) * 64 + tx] = acc[r];
        __syncthreads();
        if (kq == 0) {
#pragma unroll
            for (int r = 0; r < 9; ++r) {
                const float s = red[(0 * 9 + r) * 64 + tx] + red[(1 * 9 + r) * 64 + tx] + red[(2 * 9 + r) * 64 + tx] + red[(3 * 9 + r) * 64 + tx];
                p.modv[((size_t)L * 9 + r) * 6144 + n0 + tx] = s + p.mod_b[L * 6144 + n0 + tx];
            }
        }
        __syncthreads();
    }
    {
        float (*tile)[65] = (float (*)[65])smem;
        for (int item = bid; item < 5440; item += nb) {
            int it = item, mat = 0, N = 0, Npad = 0; const float* src = nullptr; bf16_t* dst = nullptr;
            for (mat = 0; mat < 12; ++mat) {
                if (mat < 2) { N = EVW; Npad = 3200; src = p.ev_w_in + (size_t)mat * DM * EVW; dst = p.WT + WT_EVIN(mat); }
                else if (mat < 4) { N = 1024; Npad = 1024; src = p.ev_w_out + (size_t)(mat - 2) * DM * DM; dst = p.WT + WT_EVOUT(mat - 2); }
                else if (mat < 6) { N = ODW; Npad = ODW; src = p.od_w_in + (size_t)(mat - 4) * DM * ODW; dst = p.WT + WT_ODIN(mat - 4); }
                else if (mat < 8) { N = 1024; Npad = 1024; src = p.od_w_out + (size_t)(mat - 6) * DM * DM; dst = p.WT + WT_ODOUT(mat - 6); }
                else { N = 2048; Npad = 2048; src = p.pr_w_q + (size_t)(mat - 8) * DM * 2048; dst = p.WT + WT_PQ(mat - 8); }
                const int nt = 16 * (Npad / 64);
                if (it < nt) break;
                it -= nt;
            }
            const int k0 = (it & 15) * 64, n0 = (it >> 4) * 64;
            __syncthreads();
#pragma unroll
            for (int rep = 0; rep < 4; ++rep) {
                const int i = (tid >> 4) + 16 * rep, c4 = (tid & 15) * 4;
                float4 v = make_float4(0.f, 0.f, 0.f, 0.f);
                int sc = n0 + c4;
                if (mat < 2) sc = sc < 1536 ? sc : (sc < 3072 ? sc + 16 : (sc < 3088 ? sc - 3072 + 1536 : N));
                if (sc < N) v = *(const float4*)(src + (size_t)(k0 + i) * N + sc);
                tile[i][c4] = v.x; tile[i][c4 + 1] = v.y; tile[i][c4 + 2] = v.z; tile[i][c4 + 3] = v.w;
            }
            __syncthreads();
            {
                const int n = tid >> 2, kq = (tid & 3) * 16;
                unsigned w[8];
#pragma unroll
                for (int e = 0; e < 8; ++e) w[e] = cvt_pk_bf16(tile[kq + 2 * e][n], tile[kq + 2 * e + 1][n]);
                uint4* dp = (uint4*)(dst + (size_t)(n0 + n) * DM + k0 + kq);
                dp[0] = make_uint4(w[0], w[1], w[2], w[3]); dp[1] = make_uint4(w[4], w[5], w[6], w[7]);
            }
        }
    }
    cvt_copy_bf16(p.pr_u, p.UB, (size_t)4 * 16384 * 1024);
    cvt_copy_bf16(p.pr_v, p.VB, (size_t)4 * 16384 * 1024);
    cvt_copy_bf16(p.pr_keys, p.KB, (size_t)4 * 8 * 2 * 128 * 128);
}

__device__ void cvt_copy_bf16(const float* src, bf16_t* dst, size_t n) {
    const size_t n8 = n / 8;
    for (size_t i = (size_t)blockIdx.x * 256 + otid(); i < n8; i += (size_t)gridDim.x * 256) {
        const float4 a = ((const float4*)src)[2 * i], b = ((const float4*)src)[2 * i + 1];
        ((uint4*)dst)[i] = make_uint4(cvt_pk_bf16(a.x, a.y), cvt_pk_bf16(a.z, a.w), cvt_pk_bf16(b.x, b.y), cvt_pk_bf16(b.z, b.w));
    }
}

__device__ void ph_normmod(const float* src, const float* g, const float* modv_layer, int shift_off, int scale_off, bf16_t* dst, int nrows) {
    const int lane = otid() & 63, wid = otid() >> 6;
    for (int r = blockIdx.x * 4 + wid; r < nrows; r += gridDim.x * 4) {
        const float4* s4 = (const float4*)(src + (size_t)r * DM);
        float4 v[4]; float ss = 0.f;
#pragma unroll
        for (int i = 0; i < 4; ++i) { v[i] = s4[i * 64 + lane]; ss += v[i].x * v[i].x + v[i].y * v[i].y + v[i].z * v[i].z + v[i].w * v[i].w; }
        ss = wave_sum(ss);
        const float rstd = rsqrtf(ss * (1.0f / DM) + 1e-6f);
        const float* mv = modv_layer + (size_t)modrow(r) * 6144;
        uint2* d2 = (uint2*)(dst + (size_t)r * DM);
#pragma unroll
        for (int i = 0; i < 4; ++i) {
            const int c = (i * 64 + lane) * 4;
            const float4 gg = *(const float4*)(g + c), sh = *(const float4*)(mv + shift_off + c), scl = *(const float4*)(mv + scale_off + c);
            float4 o;
            o.x = v[i].x * rstd * gg.x * (1.f + scl.x) + sh.x; o.y = v[i].y * rstd * gg.y * (1.f + scl.y) + sh.y;
            o.z = v[i].z * rstd * gg.z * (1.f + scl.z) + sh.z; o.w = v[i].w * rstd * gg.w * (1.f + scl.w) + sh.w;
            d2[i * 64 + lane] = make_uint2(cvt_pk_bf16(o.x, o.y), cvt_pk_bf16(o.z, o.w));
        }
    }
}

__device__ void ph_final(const P& p) {
    const int lane = otid() & 63, wid = otid() >> 6;
    for (int r = blockIdx.x * 4 + wid; r < NL; r += gridDim.x * 4) {
        const float4* s4 = (const float4*)(p.H + (size_t)r * DM);
        float4 v[4]; float ss = 0.f;
#pragma unroll
        for (int i = 0; i < 4; ++i) { v[i] = s4[i * 64 + lane]; ss += v[i].x * v[i].x + v[i].y * v[i].y + v[i].z * v[i].z + v[i].w * v[i].w; }
        ss = wave_sum(ss);
        const float rstd = rsqrtf(ss * (1.0f / DM) + 1e-6f);
        float4* d4 = (float4*)(p.out + (size_t)r * DM);
#pragma unroll
        for (int i = 0; i < 4; ++i) {
            const int c = (i * 64 + lane) * 4; const float4 gg = *(const float4*)(p.final_g + c);
            float4 o; o.x = v[i].x * rstd * gg.x; o.y = v[i].y * rstd * gg.y; o.z = v[i].z * rstd * gg.z; o.w = v[i].w * rstd * gg.w;
            d4[i * 64 + lane] = o;
        }
    }
}

#define GL_ROWB 144
#define GL_TILEB (128 * GL_ROWB)
struct TokPos { int b, pos, kpos; bool lat; };
__device__ __forceinline__ TokPos tokpos(int row) {
    TokPos t; t.lat = row < NL;
    if (t.lat) { t.b = row >> 11; t.pos = row & 2047; t.kpos = 256 + t.pos; } else { const int r = row - NL; t.b = r >> 8; t.pos = r & 255; t.kpos = t.pos; }
    return t;
}
struct EpiStoreBF16 {
    bf16_t* C; int ldc;
    __device__ __forceinline__ bool swapped(int) const { return false; }
    __device__ __forceinline__ void operator()(const f32x4 (&acc)[4][4], int m0, int n0, int wm, int wn, int fr, int fq) const {
#pragma unroll
        for (int mi = 0; mi < 4; ++mi)
#pragma unroll
            for (int ni = 0; ni < 4; ++ni) {
                const f32x4 v = acc[ni][mi];
                *(uint2*)(C + (size_t)(m0 + wm * 64 + mi * 16 + fr) * ldc + n0 + wn * 64 + ni * 16 + fq * 4) = make_uint2(cvt_pk_bf16(v[0], v[1]), cvt_pk_bf16(v[2], v[3]));
            }
    }
};
struct EpiResid {
    float* H; const float* gate;
    __device__ __forceinline__ bool swapped(int) const { return false; }
    __device__ __forceinline__ void operator()(const f32x4 (&acc)[4][4], int m0, int n0, int wm, int wn, int fr, int fq) const {
#pragma unroll
        for (int mi = 0; mi < 4; ++mi) {
            const int row = m0 + wm * 64 + mi * 16 + fr;
            const float* gp = gate + (size_t)modrow(row) * 6144;
#pragma unroll
            for (int ni = 0; ni < 4; ++ni) {
                const int col = n0 + wn * 64 + ni * 16 + fq * 4;
                const f32x4 g = *(const f32x4*)(gp + col);
                f32x4* hp = (f32x4*)(H + (size_t)row * DM + col);
                *hp = *hp + g * acc[ni][mi];
            }
        }
    }
};
__device__ __forceinline__ void rope_store64(const f32x4 (&acc)[4][4], int mi, bool do_rope, const float* ropep  , float scale, bf16_t* dst  , int fq) {
#pragma unroll
    for (int ni = 0; ni < 2; ++ni) {
        f32x4 x1 = acc[ni][mi], x2 = acc[ni + 2][mi];
        if (do_rope) {
            const f32x4 r0 = *(const f32x4*)(ropep + (ni * 16 + fq * 4) * 2), r1 = *(const f32x4*)(ropep + (ni * 16 + fq * 4) * 2 + 4);
            const f32x4 cs = (f32x4){r0[0], r0[2], r1[0], r1[2]}, sn = (f32x4){r0[1], r0[3], r1[1], r1[3]};
            const f32x4 y1 = x1 * cs - x2 * sn, y2 = x1 * sn + x2 * cs;
            x1 = y1; x2 = y2;
        }
        x1 = x1 * scale; x2 = x2 * scale;
        *(uint2*)(dst + ni * 16 + fq * 4) = make_uint2(cvt_pk_bf16(x1[0], x1[1]), cvt_pk_bf16(x1[2], x1[3]));
        *(uint2*)(dst + 32 + ni * 16 + fq * 4) = make_uint2(cvt_pk_bf16(x2[0], x2[1]), cvt_pk_bf16(x2[2], x2[3]));
    }
}
struct EpiEven {
    bf16_t *PB, *AQL, *AQC, *AK, *AV; float* GT; const float* rope;
    __device__ __forceinline__ bool swapped(int n0) const { return n0 >= 2560 && n0 < 3072; }
    __device__ __forceinline__ void operator()(const f32x4 (&acc)[4][4], int m0, int n0, int wm, int wn, int fr, int fq) const {
        const int t = n0 >> 7;
        if (t < 12) {
#pragma unroll
            for (int mi = 0; mi < 4; ++mi)
#pragma unroll
                for (int ni = 0; ni < 4; ++ni) {
                    const f32x4 v = acc[ni][mi];
                    *(uint2*)(PB + (size_t)(m0 + wm * 64 + mi * 16 + fr) * 1536 + n0 + wn * 64 + ni * 16 + fq * 4) = make_uint2(cvt_pk_bf16(v[0], v[1]), cvt_pk_bf16(v[2], v[3]));
                }
        } else if (t < 20) {
            const bool isq = t < 16; const int h = t & 3;
#pragma unroll
            for (int mi = 0; mi < 4; ++mi) {
                const TokPos tp = tokpos(m0 + wm * 64 + mi * 16 + fr);
                const int hm = (tp.b * 4 + h) * 2 + wn;
                bf16_t* dst;
                if (isq) dst = tp.lat ? AQL + ((size_t)hm * 2048 + tp.pos) * 64 : AQC + ((size_t)hm * 256 + tp.pos) * 64;
                else dst = AK + ((size_t)hm * 2304 + tp.kpos) * 64;
                rope_store64(acc, mi, tp.lat, rope + (size_t)tp.pos * 64, isq ? QSCALE : 1.0f, dst, fq);
            }
        } else if (t < 24) {
            const int h = t - 20;
#pragma unroll
            for (int mi = 0; mi < 4; ++mi) {
                const TokPos tp = tokpos(m0 + wm * 64 + mi * 16 + fq * 4);
#pragma unroll
                for (int ni = 0; ni < 4; ++ni) {
                    const f32x4 v = acc[ni][mi];
                    const int d = wn * 64 + ni * 16 + fr;
                    *(uint2*)(AV + ((size_t)(tp.b * 4 + h) * 128 + d) * 2304 + tp.kpos) = make_uint2(cvt_pk_bf16(v[0], v[1]), cvt_pk_bf16(v[2], v[3]));
                }
            }
        } else {
            if (wn == 0) {
#pragma unroll
                for (int mi = 0; mi < 4; ++mi) *(f32x4*)(GT + (size_t)(m0 + wm * 64 + mi * 16 + fr) * 16 + fq * 4) = acc[0][mi];
            }
        }
    }
};
struct EpiOdd {
    bf16_t *AQL, *AQC, *AK, *AV; const float* rope;
    __device__ __forceinline__ bool swapped(int n0) const { return n0 >= 1280; }
    __device__ __forceinline__ void operator()(const f32x4 (&acc)[4][4], int m0, int n0, int wm, int wn, int fr, int fq) const {
        const int t = n0 >> 7;
        if (t < 10) {
            const bool isq = t < 8; const int hd = isq ? t * 2 + wn : (t - 8) * 2 + wn;
#pragma unroll
            for (int mi = 0; mi < 4; ++mi) {
                const TokPos tp = tokpos(m0 + wm * 64 + mi * 16 + fr);
                bf16_t* dst;
                if (isq) dst = tp.lat ? AQL + ((size_t)(tp.b * 16 + hd) * 2048 + tp.pos) * 64 : AQC + ((size_t)(tp.b * 16 + hd) * 256 + tp.pos) * 64;
                else dst = AK + ((size_t)(tp.b * 4 + hd) * 2304 + tp.kpos) * 64;
                rope_store64(acc, mi, tp.lat, rope + (size_t)tp.pos * 64, isq ? QSCALE : 1.0f, dst, fq);
            }
        } else {
            const int hkv = (t - 10) * 2 + wn;
#pragma unroll
            for (int mi = 0; mi < 4; ++mi) {
                const TokPos tp = tokpos(m0 + wm * 64 + mi * 16 + fq * 4);
#pragma unroll
                for (int ni = 0; ni < 4; ++ni) {
                    const f32x4 v = acc[ni][mi];
                    const int d = ni * 16 + fr;
                    *(uint2*)(AV + ((size_t)(tp.b * 4 + hkv) * 64 + d) * 2304 + tp.kpos) = make_uint2(cvt_pk_bf16(v[0], v[1]), cvt_pk_bf16(v[2], v[3]));
                }
            }
        }
    }
};
template <bool SWAP>
__device__ __forceinline__ void gemm_tile_kloop(f32x4 (&acc)[4][4], const bf16_t* ap, const bf16_t* bp, char* smem, int lrow, int lch, int wm, int wn, int fr, int fq) {
    uint4 ra0, ra1, ra2, ra3, rb0, rb1, rb2, rb3;
#define GL_LOAD(KO) { ra0 = *(const uint4*)(ap + (KO)); ra1 = *(const uint4*)(ap + (size_t)32 * DM + (KO)); ra2 = *(const uint4*)(ap + (size_t)64 * DM + (KO)); ra3 = *(const uint4*)(ap + (size_t)96 * DM + (KO)); \
                      rb0 = *(const uint4*)(bp + (KO)); rb1 = *(const uint4*)(bp + (size_t)32 * DM + (KO)); rb2 = *(const uint4*)(bp + (size_t)64 * DM + (KO)); rb3 = *(const uint4*)(bp + (size_t)96 * DM + (KO)); }
#define GL_STORE(BUF) { char* sa_ = (BUF) + lrow * GL_ROWB + lch * 16; char* sb_ = sa_ + GL_TILEB; \
                        *(uint4*)(sa_) = ra0; *(uint4*)(sa_ + 32 * GL_ROWB) = ra1; *(uint4*)(sa_ + 64 * GL_ROWB) = ra2; *(uint4*)(sa_ + 96 * GL_ROWB) = ra3; \
                        *(uint4*)(sb_) = rb0; *(uint4*)(sb_ + 32 * GL_ROWB) = rb1; *(uint4*)(sb_ + 64 * GL_ROWB) = rb2; *(uint4*)(sb_ + 96 * GL_ROWB) = rb3; }
    GL_LOAD(0)
    __syncthreads();
    GL_STORE(smem)
    __syncthreads();
    for (int kt = 0; kt < 16; ++kt) {
        char* cur = smem + (kt & 1) * 2 * GL_TILEB;
        char* nxt = smem + ((kt + 1) & 1) * 2 * GL_TILEB;
        if (kt + 1 < 16) GL_LOAD((kt + 1) * 64)
#pragma unroll
        for (int ks = 0; ks < 2; ++ks) {
            bf16x8 af[4], wf[4];
#pragma unroll
            for (int i = 0; i < 4; ++i) {
                af[i] = *(const bf16x8*)(cur + (wm * 64 + i * 16 + fr) * GL_ROWB + (ks * 4 + fq) * 16);
                wf[i] = *(const bf16x8*)(cur + GL_TILEB + (wn * 64 + i * 16 + fr) * GL_ROWB + (ks * 4 + fq) * 16);
            }
#pragma unroll
            for (int ni = 0; ni < 4; ++ni)
#pragma unroll
                for (int mi = 0; mi < 4; ++mi)
                    acc[ni][mi] = SWAP ? __builtin_amdgcn_mfma_f32_16x16x32_bf16(af[mi], wf[ni], acc[ni][mi], 0, 0, 0)
                                       : __builtin_amdgcn_mfma_f32_16x16x32_bf16(wf[ni], af[mi], acc[ni][mi], 0, 0, 0);
        }
        if (kt + 1 < 16) GL_STORE(nxt)
        __syncthreads();
    }
#undef GL_LOAD
#undef GL_STORE
}
template <class Epi>
__device__ void ph_gemm(const bf16_t* A, const bf16_t* Bt, int M, int Npad, const Epi& epi, char* smem) {
    const int tid = otid(), lane = tid & 63, wid = tid >> 6, wm = wid >> 1, wn = wid & 1;
    const int fr = lane & 15, fq = lane >> 4;
    const int tm = M / 128, tn = Npad / 128, ntiles = tm * tn;
    const int lrow = tid >> 3, lch = tid & 7;
    for (int tile = blockIdx.x; tile < ntiles; tile += gridDim.x) {
        const int m0 = (tile % tm) * 128, n0 = (tile / tm) * 128;
        f32x4 acc[4][4];
#pragma unroll
        for (int a = 0; a < 4; ++a)
#pragma unroll
            for (int b = 0; b < 4; ++b) acc[a][b] = (f32x4){0.f, 0.f, 0.f, 0.f};
        const bf16_t* ap = A + (size_t)(m0 + lrow) * DM + lch * 8;
        const bf16_t* bp = Bt + (size_t)(n0 + lrow) * DM + lch * 8;
        if (epi.swapped(n0)) gemm_tile_kloop<true>(acc, ap, bp, smem, lrow, lch, wm, wn, fr, fq);
        else gemm_tile_kloop<false>(acc, ap, bp, smem, lrow, lch, wm, wn, fr, fq);
        epi(acc, m0, n0, wm, wn, fr, fq);
    }
}

__device__ void ph_prep_even(const P& p, int j) {
    const float* cw = p.ev_conv_w + (size_t)j * 3 * 512; const float* cb = p.ev_conv_b + (size_t)j * 512;
    const size_t tot = (size_t)NT * 512;
    for (size_t i = (size_t)blockIdx.x * 256 + otid(); i < tot; i += (size_t)gridDim.x * 256) {
        const int r = (int)(i >> 9), c = (int)(i & 511);
        int t, T; if (r < NL) { t = r & 2047; T = 2048; } else { t = (r - NL) & 255; T = 256; }
        float v = cb[c] + __uint_as_float((unsigned)p.PB[(size_t)r * 1536 + c] << 16) * cw[512 + c];
        if (t > 0) v += __uint_as_float((unsigned)p.PB[(size_t)(r - 1) * 1536 + c] << 16) * cw[c];
        if (t < T - 1) v += __uint_as_float((unsigned)p.PB[(size_t)(r + 1) * 1536 + c] << 16) * cw[1024 + c];
        v = silu_f(v);
        if (c >= 256) v *= 0.125f;
        p.QKC[i] = v;
    }
}

#define FA_KROW 144
#define FA_VROW 136
__device__ __forceinline__ bf16x8 pack8(float a0, float a1, float a2, float a3, float a4, float a5, float a6, float a7) {
    const u32x4 u = (u32x4){cvt_pk_bf16(a0, a1), cvt_pk_bf16(a2, a3), cvt_pk_bf16(a4, a5), cvt_pk_bf16(a6, a7)};
    return __builtin_bit_cast(bf16x8, u);
}
template <int NDB, bool MASK>
__device__ __forceinline__ void flash_tile(const bf16x8 (&qf)[4], f32x16 (&o)[NDB], float& m, float& l, const char* Kl, const char* Vl, int lane, int qpos, int kp0) {
    const int j = lane & 31, h = lane >> 5;
    f32x16 s0, s1;
#pragma unroll
    for (int i = 0; i < 16; ++i) { s0[i] = 0.f; s1[i] = 0.f; }
#pragma unroll
    for (int ks = 0; ks < 4; ++ks) {
        const bf16x8 a0 = *(const bf16x8*)(Kl + j * FA_KROW + (2 * ks + h) * 16);
        const bf16x8 a1 = *(const bf16x8*)(Kl + (32 + j) * FA_KROW + (2 * ks + h) * 16);
        s0 = __builtin_amdgcn_mfma_f32_32x32x16_bf16(a0, qf[ks], s0, 0, 0, 0);
        s1 = __builtin_amdgcn_mfma_f32_32x32x16_bf16(a1, qf[ks], s1, 0, 0, 0);
    }
    if (MASK) {
#pragma unroll
        for (int r = 0; r < 16; ++r) {
            const int key = (r & 3) + 8 * (r >> 2) + 4 * h;
            const int d0 = qpos - (kp0 + key), d1 = d0 - 32;
            if (d0 > 128 || d0 < -128) s0[r] = -1e30f;
            if (d1 > 128 || d1 < -128) s1[r] = -1e30f;
        }
    }
    float mx = fmaxf(s0[0], s1[0]);
#pragma unroll
    for (int r = 1; r < 16; ++r) mx = fmaxf(mx, fmaxf(s0[r], s1[r]));
    mx = fmaxf(mx, __shfl_xor(mx, 32));
    const float mn = fmaxf(m, mx);
    const float alpha = __builtin_amdgcn_exp2f(m - mn);
    m = mn;
    float ls = 0.f;
#pragma unroll
    for (int r = 0; r < 16; ++r) { s0[r] = __builtin_amdgcn_exp2f(s0[r] - mn); s1[r] = __builtin_amdgcn_exp2f(s1[r] - mn); ls += s0[r] + s1[r]; }
    l = l * alpha + ls;
#pragma unroll
    for (int db = 0; db < NDB; ++db) o[db] = o[db] * alpha;
    bf16x8 pb[4];
    pb[0] = pack8(s0[0], s0[1], s0[2], s0[3], s0[4], s0[5], s0[6], s0[7]);
    pb[1] = pack8(s0[8], s0[9], s0[10], s0[11], s0[12], s0[13], s0[14], s0[15]);
    pb[2] = pack8(s1[0], s1[1], s1[2], s1[3], s1[4], s1[5], s1[6], s1[7]);
    pb[3] = pack8(s1[8], s1[9], s1[10], s1[11], s1[12], s1[13], s1[14], s1[15]);
#pragma unroll
    for (int db = 0; db < NDB; ++db)
#pragma unroll
        for (int kk = 0; kk < 4; ++kk) {
            const char* vp = Vl + (db * 32 + j) * FA_VROW + (kk * 16 + 4 * h) * 2;
            const uint2 lo = *(const uint2*)vp, hi = *(const uint2*)(vp + 16);
            const u32x4 u = (u32x4){lo.x, lo.y, hi.x, hi.y};
            o[db] = __builtin_amdgcn_mfma_f32_32x32x16_bf16(__builtin_bit_cast(bf16x8, u), pb[kk], o[db], 0, 0, 0);
        }
}

#define DA_BUFB 35840
__device__ void da_block(const P& p, int item, int L, int j, char* smem) {
    const int tid = otid(), lane = tid & 63, wid = tid >> 6, mp = wid & 1, qg = wid >> 1, jq = lane & 31, hh = lane >> 5;
    const bool lat = item < 1024;
    int b, h, qt;
    if (lat) { b = item >> 7; h = (item >> 5) & 3; qt = item & 31; } else { const int it = item - 1024; b = it >> 4; h = (it >> 2) & 3; qt = it & 3; }
    const int qi = qt * 64 + qg * 32 + jq;
    const bf16_t* qp = lat ? p.AQL + ((size_t)((b * 4 + h) * 2 + mp) * 2048 + qi) * 64 : p.AQC + ((size_t)((b * 4 + h) * 2 + mp) * 256 + qi) * 64;
    bf16x8 qf[4];
#pragma unroll
    for (int ks = 0; ks < 4; ++ks) qf[ks] = *(const bf16x8*)(qp + (2 * ks + hh) * 8);
    const int ntile = lat ? 36 : 4;
    const bf16_t* kg = p.AK + (size_t)((b * 4 + h) * 2) * 2304 * 64 + (size_t)(tid >> 3) * 64 + (tid & 7) * 8;
    const bf16_t* vg = p.AV + (size_t)(b * 4 + h) * 128 * 2304 + (size_t)(tid >> 3) * 2304 + (tid & 7) * 8;
    uint4 k0, k1, k2, k3, v0, v1, v2, v3;
#define DA_LOAD(KEY0) { k0 = *(const uint4*)(kg + (size_t)(KEY0) * 64); k1 = *(const uint4*)(kg + (size_t)((KEY0) + 32) * 64); \
                        k2 = *(const uint4*)(kg + (size_t)2304 * 64 + (size_t)(KEY0) * 64); k3 = *(const uint4*)(kg + (size_t)2304 * 64 + (size_t)((KEY0) + 32) * 64); \
                        v0 = *(const uint4*)(vg + (KEY0)); v1 = *(const uint4*)(vg + (size_t)32 * 2304 + (KEY0)); v2 = *(const uint4*)(vg + (size_t)64 * 2304 + (KEY0)); v3 = *(const uint4*)(vg + (size_t)96 * 2304 + (KEY0)); }
#define DA_STORE(BUF) { char* kb_ = (BUF) + (tid >> 3) * FA_KROW + (tid & 7) * 16; \
                        *(uint4*)kb_ = k0; *(uint4*)(kb_ + 32 * FA_KROW) = k1; *(uint4*)(kb_ + 64 * FA_KROW) = k2; *(uint4*)(kb_ + 96 * FA_KROW) = k3; \
                        char* vb_ = (BUF) + 18432 + (tid >> 3) * FA_VROW + (tid & 7) * 16; \
                        *(uint2*)vb_ = make_uint2(v0.x, v0.y); *(uint2*)(vb_ + 8) = make_uint2(v0.z, v0.w); \
                        *(uint2*)(vb_ + 32 * FA_VROW) = make_uint2(v1.x, v1.y); *(uint2*)(vb_ + 32 * FA_VROW + 8) = make_uint2(v1.z, v1.w); \
                        *(uint2*)(vb_ + 64 * FA_VROW) = make_uint2(v2.x, v2.y); *(uint2*)(vb_ + 64 * FA_VROW + 8) = make_uint2(v2.z, v2.w); \
                        *(uint2*)(vb_ + 96 * FA_VROW) = make_uint2(v3.x, v3.y); *(uint2*)(vb_ + 96 * FA_VROW + 8) = make_uint2(v3.z, v3.w); }
    f32x16 o[4];
#pragma unroll
    for (int db = 0; db < 4; ++db)
#pragma unroll
        for (int i = 0; i < 16; ++i) o[db][i] = 0.f;
    float m = -1e30f, l = 0.f;
    DA_LOAD(0)
    __syncthreads();
    DA_STORE(smem)
    __syncthreads();
    for (int t = 0; t < ntile; ++t) {
        char* cur = smem + (t & 1) * DA_BUFB;
        char* nxt = smem + ((t + 1) & 1) * DA_BUFB;
        if (t + 1 < ntile) DA_LOAD((t + 1) * 64)
        flash_tile<4, false>(qf, o, m, l, cur + mp * 9216, cur + 18432, lane, 0, 0);
        if (t + 1 < ntile) DA_STORE(nxt)
        __syncthreads();
    }
#undef DA_LOAD
#undef DA_STORE
    const float inv = 1.f / (l + __shfl_xor(l, 32));
#pragma unroll
    for (int db = 0; db < 4; ++db) o[db] = o[db] * inv;
    float* X = (float*)smem + qg * 4096;
    if (mp == 1) {
#pragma unroll
        for (int db = 0; db < 4; ++db)
#pragma unroll
            for (int r = 0; r < 16; ++r) X[(db * 32 + (r & 3) + 8 * (r >> 2) + 4 * hh) * 32 + jq] = o[db][r];
    }
    __syncthreads();
    if (mp == 0) {
        const float lam_init = 0.8f - 0.6f * expf(-0.3f * (float)L);
        const float* lp = p.ev_da_lam + (size_t)j * 256;
        float a0 = lp[lane] * lp[64 + lane], a1 = lp[128 + lane] * lp[192 + lane];
        a0 = wave_sum(a0); a1 = wave_sum(a1);
        const float lam = expf(a0) - expf(a1) + lam_init;
        float ss = 0.f;
#pragma unroll
        for (int db = 0; db < 4; ++db)
#pragma unroll
            for (int r = 0; r < 16; ++r) { const float v = o[db][r] - lam * X[(db * 32 + (r & 3) + 8 * (r >> 2) + 4 * hh) * 32 + jq]; o[db][r] = v; ss += v * v; }
        ss += __shfl_xor(ss, 32);
        const float sc = rsqrtf(ss * (1.f / 128.f) + 1e-6f) * (1.f - lam_init);
        const int row = lat ? b * 2048 + qi : NL + b * 256 + qi;
        bf16_t* mrow = p.MIX + (size_t)row * DM + 512 + h * 128;
        const float* g = p.ev_da_g + (size_t)j * 512 + h * 128;
#pragma unroll
        for (int db = 0; db < 4; ++db)
#pragma unroll
            for (int r4 = 0; r4 < 4; ++r4) {
                const int d = db * 32 + 8 * r4 + 4 * hh;
                const f32x4 gg = *(const f32x4*)(g + d);
                *(uint2*)(mrow + d) = make_uint2(cvt_pk_bf16(o[db][r4 * 4 + 0] * sc * gg[0], o[db][r4 * 4 + 1] * sc * gg[1]), cvt_pk_bf16(o[db][r4 * 4 + 2] * sc * gg[2], o[db][r4 * 4 + 3] * sc * gg[3]));
            }
    }
    __syncthreads();
}

#define WA_BUFB 17920
__device__ void wa_block(const P& p, int item, int j, char* smem) {
    const int tid = otid(), lane = tid & 63, wid = tid >> 6, jq = lane & 31, hh = lane >> 5;
    const bool lat = item < 2048;
    int b, nb, hq;
    if (lat) { hq = item & 15; nb = (item >> 4) & 15; b = item >> 8; } else { const int it = item - 2048; hq = it & 15; nb = (it >> 4) & 1; b = it >> 5; }
    const int hkv = hq >> 2;
    const int qi = nb * 128 + wid * 32 + jq;
    const bf16_t* qp = lat ? p.AQL + ((size_t)(b * 16 + hq) * 2048 + qi) * 64 : p.AQC + ((size_t)(b * 16 + hq) * 256 + qi) * 64;
    bf16x8 qf[4];
#pragma unroll
    for (int ks = 0; ks < 4; ++ks) qf[ks] = *(const bf16x8*)(qp + (2 * ks + hh) * 8);
    const int lfirst = (nb == 0) ? 2 : 0, nloc = lat ? 6 - lfirst - ((nb == 15) ? 2 : 0) : 0;
    const int ntile = 4 + nloc;
    const bf16_t* kg = p.AK + (size_t)(b * 4 + hkv) * 2304 * 64 + (size_t)(tid >> 3) * 64 + (tid & 7) * 8;
    const bf16_t* vg = p.AV + (size_t)(b * 4 + hkv) * 64 * 2304 + (size_t)(tid >> 3) * 2304 + (tid & 7) * 8;
    uint4 k0, k1, v0, v1;
#define WA_KEY0(T) ((T) < 4 ? (T) * 64 : 256 + (nb - 1) * 128 + ((T) - 4 + lfirst) * 64)
#define WA_LOAD(KEY0) { k0 = *(const uint4*)(kg + (size_t)(KEY0) * 64); k1 = *(const uint4*)(kg + (size_t)((KEY0) + 32) * 64); v0 = *(const uint4*)(vg + (KEY0)); v1 = *(const uint4*)(vg + (size_t)32 * 2304 + (KEY0)); }
#define WA_STORE(BUF) { char* kb_ = (BUF) + (tid >> 3) * FA_KROW + (tid & 7) * 16; *(uint4*)kb_ = k0; *(uint4*)(kb_ + 32 * FA_KROW) = k1; \
                        char* vb_ = (BUF) + 9216 + (tid >> 3) * FA_VROW + (tid & 7) * 16; \
                        *(uint2*)vb_ = make_uint2(v0.x, v0.y); *(uint2*)(vb_ + 8) = make_uint2(v0.z, v0.w); \
                        *(uint2*)(vb_ + 32 * FA_VROW) = make_uint2(v1.x, v1.y); *(uint2*)(vb_ + 32 * FA_VROW + 8) = make_uint2(v1.z, v1.w); }
    f32x16 o[2];
#pragma unroll
    for (int db = 0; db < 2; ++db)
#pragma unroll
        for (int i = 0; i < 16; ++i) o[db][i] = 0.f;
    float m = p.od_sink[j * 16 + hq] * 1.4426950408889634f, l = hh == 0 ? 1.f : 0.f;
    { const int key0 = WA_KEY0(0); WA_LOAD(key0) }
    __syncthreads();
    WA_STORE(smem)
    __syncthreads();
    for (int t = 0; t < ntile; ++t) {
        char* cur = smem + (t & 1) * WA_BUFB;
        char* nxt = smem + ((t + 1) & 1) * WA_BUFB;
        if (t + 1 < ntile) { const int key0 = WA_KEY0(t + 1); WA_LOAD(key0) }
        if (t < 4) flash_tile<2, false>(qf, o, m, l, cur, cur + 9216, lane, 0, 0);
        else flash_tile<2, true>(qf, o, m, l, cur, cur + 9216, lane, qi, WA_KEY0(t) - 256);
        if (t + 1 < ntile) WA_STORE(nxt)
        __syncthreads();
    }
#undef WA_LOAD
#undef WA_STORE
#undef WA_KEY0
    const float inv = 1.f / (l + __shfl_xor(l, 32));
    const int row = lat ? b * 2048 + qi : NL + b * 256 + qi;
    bf16_t* mrow = p.MIX + (size_t)row * DM + hq * 64;
#pragma unroll
    for (int db = 0; db < 2; ++db)
#pragma unroll
        for (int r4 = 0; r4 < 4; ++r4) {
            const int d = db * 32 + 8 * r4 + 4 * hh;
            *(uint2*)(mrow + d) = make_uint2(cvt_pk_bf16(o[db][r4 * 4 + 0] * inv, o[db][r4 * 4 + 1] * inv), cvt_pk_bf16(o[db][r4 * 4 + 2] * inv, o[db][r4 * 4 + 3] * inv));
        }
}

#define ML_LD 68
__device__ void mlstm_chunk_item(const P& p, int item, int j, float* smem) {
    const int vs = item & 3, dir = (item >> 2) & 1, h = (item >> 3) & 3, b = item >> 5;
    const int tid = otid(), lane = tid & 63;
    float* sq = smem;
    float* sk = sq + 64 * ML_LD;
    float* sv = sk + 64 * ML_LD;
    float* sP = sv + 64 * 32;
    float* sCT = sP + 64 * 65;
    float* sn = sCT + 64 * 36;
    float* sa = sn + 64;
    float* sb = sa + 64;
    float* sg = sb + 64;
    float* swk = sg + 64;
    int* srow = (int*)(swk + 64);
    float* ssc = (float*)(srow + 64);
    const float gbi = p.ev_gate_b[j * 16 + (dir * 2) * 4 + h], gbf = p.ev_gate_b[j * 16 + (dir * 2 + 1) * 4 + h];
    float* hm = p.HM + (size_t)dir * NT * 512;
    __syncthreads();
    for (int i = tid; i < 64 * 36; i += 256) sCT[i] = 0.f;
    if (tid < 64) sn[tid] = 0.f;
    float m_st = 0.f;
    for (int c = 0; c < 36; ++c) {
        __syncthreads();
        if (tid < 64) {
            const int st = c * 64 + tid; int row;
            if (st < 256) row = NL + b * 256 + (dir ? 255 - st : st);
            else { const int t = st - 256; row = b * 2048 + (dir ? 2047 - t : t); }
            srow[tid] = row;
            const float ig = p.GT[(size_t)row * 16 + (dir * 2) * 4 + h] + gbi;
            const float lf = log_sigmoid_f(p.GT[(size_t)row * 16 + (dir * 2 + 1) * 4 + h] + gbf);
            float bc = lf;
#pragma unroll
            for (int o = 1; o < 64; o <<= 1) { const float t2 = __shfl_up(bc, o); if (lane >= o) bc += t2; }
            const float a = ig - bc;
            float mxa = a;
#pragma unroll
            for (int o = 1; o < 64; o <<= 1) { const float t2 = __shfl_up(mxa, o); if (lane >= o) mxa = fmaxf(mxa, t2); }
            const float g = fmaxf(m_st, mxa);
            const float g63 = __shfl(g, 63), b63 = __shfl(bc, 63);
            sa[tid] = a; sb[tid] = bc; sg[tid] = g; swk[tid] = expf(a - g63);
            if (tid == 0) { ssc[0] = m_st; ssc[1] = expf(m_st - g63); ssc[2] = b63 + g63; }
        }
        __syncthreads();
#pragma unroll
        for (int i = 0; i < 4; ++i) {
            const int e = tid + 256 * i, t = e >> 4, c4 = (e & 15) * 4; const int row = srow[t];
            *(float4*)(sq + t * ML_LD + c4) = *(const float4*)(p.QKC + (size_t)row * 512 + h * 64 + c4);
            *(float4*)(sk + t * ML_LD + c4) = *(const float4*)(p.QKC + (size_t)row * 512 + 256 + h * 64 + c4);
        }
        {
            const int t = tid >> 2, c8 = (tid & 3) * 8; const int row = srow[t];
            const uint4 u = *(const uint4*)(p.PB + (size_t)row * 1536 + 512 + h * 128 + vs * 32 + c8);
            float* d = sv + t * 32 + c8;
            d[0] = bf_lo(u.x); d[1] = bf_hi(u.x); d[2] = bf_lo(u.y); d[3] = bf_hi(u.y); d[4] = bf_lo(u.z); d[5] = bf_hi(u.z); d[6] = bf_lo(u.w); d[7] = bf_hi(u.w);
        }
        __syncthreads();
        const float mst = ssc[0], decay = ssc[1];
        {
            const int t = tid >> 2, sq4 = tid & 3;
            float acc[16];
#pragma unroll
            for (int i = 0; i < 16; ++i) acc[i] = 0.f;
            for (int d4 = 0; d4 < 16; ++d4) {
                const float4 qv = *(const float4*)(sq + t * ML_LD + d4 * 4);
#pragma unroll
                for (int i = 0; i < 16; ++i) {
                    const float4 kv = *(const float4*)(sk + (sq4 + 4 * i) * ML_LD + d4 * 4);
                    acc[i] += qv.x * kv.x + qv.y * kv.y + qv.z * kv.z + qv.w * kv.w;
                }
            }
            const float gt = sg[t];
#pragma unroll
            for (int i = 0; i < 16; ++i) { const int s2 = sq4 + 4 * i; sP[t * 65 + s2] = (s2 <= t) ? acc[i] * expf(sa[s2] - gt) : 0.f; }
        }
        __syncthreads();
        {
            const int t = tid >> 2, vq = tid & 3;
            float num[8], cq[8];
#pragma unroll
            for (int i = 0; i < 8; ++i) { num[i] = 0.f; cq[i] = 0.f; }
            float psum = 0.f, nq = 0.f;
            for (int s2 = 0; s2 < 64; ++s2) {
                const float pv = sP[t * 65 + s2];
                const float4 v0 = *(const float4*)(sv + s2 * 32 + vq * 8), v1 = *(const float4*)(sv + s2 * 32 + vq * 8 + 4);
                num[0] += pv * v0.x; num[1] += pv * v0.y; num[2] += pv * v0.z; num[3] += pv * v0.w;
                num[4] += pv * v1.x; num[5] += pv * v1.y; num[6] += pv * v1.z; num[7] += pv * v1.w;
                const float qd = sq[t * ML_LD + s2];
                const float4 c0 = *(const float4*)(sCT + s2 * 36 + vq * 8), c1 = *(const float4*)(sCT + s2 * 36 + vq * 8 + 4);
                cq[0] += qd * c0.x; cq[1] += qd * c0.y; cq[2] += qd * c0.z; cq[3] += qd * c0.w;
                cq[4] += qd * c1.x; cq[5] += qd * c1.y; cq[6] += qd * c1.z; cq[7] += qd * c1.w;
                if ((s2 >> 4) == vq) { psum += pv; nq += sn[s2] * qd; }
            }
            psum += __shfl_xor(psum, 1); psum += __shfl_xor(psum, 2);
            nq += __shfl_xor(nq, 1); nq += __shfl_xor(nq, 2);
            const float gt = sg[t], wint = expf(mst - gt);
            const float den = psum + wint * nq;
            const float sc = 1.f / fmaxf(fabsf(den), expf(-(sb[t] + gt)));
            float* op = hm + (size_t)srow[t] * 512 + h * 128 + vs * 32 + vq * 8;
            *(float4*)op = make_float4((num[0] + wint * cq[0]) * sc, (num[1] + wint * cq[1]) * sc, (num[2] + wint * cq[2]) * sc, (num[3] + wint * cq[3]) * sc);
            *(float4*)(op + 4) = make_float4((num[4] + wint * cq[4]) * sc, (num[5] + wint * cq[5]) * sc, (num[6] + wint * cq[6]) * sc, (num[7] + wint * cq[7]) * sc);
        }
        __syncthreads();
        {
            const int d = tid >> 2, vq = tid & 3;
            float cn[8];
            const float4 c0 = *(const float4*)(sCT + d * 36 + vq * 8), c1 = *(const float4*)(sCT + d * 36 + vq * 8 + 4);
            cn[0] = decay * c0.x; cn[1] = decay * c0.y; cn[2] = decay * c0.z; cn[3] = decay * c0.w;
            cn[4] = decay * c1.x; cn[5] = decay * c1.y; cn[6] = decay * c1.z; cn[7] = decay * c1.w;
            float nn = decay * sn[d];
            for (int s2 = 0; s2 < 64; ++s2) {
                const float kd = swk[s2] * sk[s2 * ML_LD + d];
                const float4 v0 = *(const float4*)(sv + s2 * 32 + vq * 8), v1 = *(const float4*)(sv + s2 * 32 + vq * 8 + 4);
                cn[0] += kd * v0.x; cn[1] += kd * v0.y; cn[2] += kd * v0.z; cn[3] += kd * v0.w;
                cn[4] += kd * v1.x; cn[5] += kd * v1.y; cn[6] += kd * v1.z; cn[7] += kd * v1.w;
                nn += kd;
            }
            *(float4*)(sCT + d * 36 + vq * 8) = make_float4(cn[0], cn[1], cn[2], cn[3]);
            *(float4*)(sCT + d * 36 + vq * 8 + 4) = make_float4(cn[4], cn[5], cn[6], cn[7]);
            if (vq == 0) sn[d] = nn;
        }
        m_st = ssc[2];
    }
    __syncthreads();
}

__device__ void ph_attn_even(const P& p, int L, int j, float* smem) {
    int* s_item = (int*)((char*)smem + LDS_BYTES - 16);
    for (;;) {
        __syncthreads();
        if (otid() == 0) *s_item = atomicAdd(&p.ctr[L], 1);
        __syncthreads();
        const int item = *s_item;
        if (item >= 256 + 1152) break;
        if (item < 256) mlstm_chunk_item(p, item, j, smem); else da_block(p, item - 256, L, j, (char*)smem);
    }
}
__device__ void ph_attn_odd(const P& p, int j, bool need_ctx, float* smem) {
    const int nitem = need_ctx ? 2304 : 2048;
    for (int item = blockIdx.x; item < nitem; item += gridDim.x) { wa_block(p, item, j, (char*)smem); __syncthreads(); }
}

__device__ void ph_mixout_even(const P& p, int L, int j) {
    const int lane = otid() & 63, wid = otid() >> 6;
    for (int w = blockIdx.x * 4 + wid; w < NT * 4; w += gridDim.x * 4) {
        const int r = w >> 2, hh = w & 3;
        const int c = hh * 128 + lane * 2;
        const float2 f = *(const float2*)(p.HM + (size_t)r * 512 + c), bk = *(const float2*)(p.HM + (size_t)NT * 512 + (size_t)r * 512 + c);
        const float v0 = f.x + bk.x, v1 = f.y + bk.y;
        const float ss = wave_sum(v0 * v0 + v1 * v1);
        const float rstd = rsqrtf(ss * (1.f / 128.f) + 1e-6f);
        const float2 g = *(const float2*)(p.ev_ml_g + (size_t)j * 512 + c);
        const unsigned ou = *(const unsigned*)(p.PB + (size_t)r * 1536 + 1024 + c);
        *(unsigned*)(p.MIX + (size_t)r * DM + c) = cvt_pk_bf16(v0 * rstd * g.x * sigmoid_f(bf_lo(ou)), v1 * rstd * g.y * sigmoid_f(bf_hi(ou)));
    }
}

__device__ __forceinline__ float wave_max(float v) {
#pragma unroll
    for (int o = 32; o > 0; o >>= 1) v = fmaxf(v, __shfl_xor(v, o));
    return v;
}
#define SEL_LD 132
__device__ void ph_peer_select(const P& p, int L, int nrows, char* smem) {
    float* S = (float*)smem;
    const int tid = otid(), lane = tid & 63, wid = tid >> 6, fr = lane & 15, fq = lane >> 4;
    const bf16_t* KBL = p.KB + (size_t)L * 8 * 2 * 128 * 128;
    int ci = 0, cj = 0; bool cvalid = false;
    {
        int base = 0;
#pragma unroll
        for (int ii = 0; ii < 16; ++ii) { const int c = 16 / (ii + 1); if (lane >= base && lane < base + c) { ci = ii; cj = lane - base; cvalid = true; } base += c; }
    }
    const int ntile = nrows / 32;
    for (int item = blockIdx.x; item < ntile * 8; item += gridDim.x) {
        const int h = item & 7, t0 = (item >> 3) * 32;
        __syncthreads();
        {
            const int pp = wid >> 1, th = wid & 1;
            const bf16_t* qp = p.QB + (size_t)(t0 + th * 16 + fr) * 2048 + h * 256 + pp * 128 + fq * 8;
            bf16x8 qf[4];
#pragma unroll
            for (int ks = 0; ks < 4; ++ks) qf[ks] = *(const bf16x8*)(qp + ks * 32);
            const bf16_t* kp = KBL + ((size_t)(h * 2 + pp) * 128 + fr) * 128 + fq * 8;
#pragma unroll
            for (int ni = 0; ni < 8; ++ni) {
                f32x4 acc = (f32x4){0.f, 0.f, 0.f, 0.f};
#pragma unroll
                for (int ks = 0; ks < 4; ++ks) {
                    const bf16x8 kf = *(const bf16x8*)(kp + (size_t)ni * 16 * 128 + ks * 32);
                    acc = __builtin_amdgcn_mfma_f32_16x16x32_bf16(qf[ks], kf, acc, 0, 0, 0);
                }
#pragma unroll
                for (int j = 0; j < 4; ++j) S[(pp * 32 + th * 16 + fq * 4 + j) * SEL_LD + ni * 16 + fr] = acc[j];
            }
        }
        __syncthreads();
        for (int tt = 0; tt < 8; ++tt) {
            const int t = wid * 8 + tt, r = t0 + t;
            float v00 = S[t * SEL_LD + lane], v01 = S[t * SEL_LD + 64 + lane], v10 = S[(32 + t) * SEL_LD + lane], v11 = S[(32 + t) * SEL_LD + 64 + lane];
            float sv0 = 0.f, sv1 = 0.f; int si0 = 0, si1 = 0;
            for (int rd = 0; rd < 16; ++rd) {
                {
                    const float m = wave_max(fmaxf(v00, v01));
                    unsigned long long b = __ballot(v00 == m); int idx;
                    if (b) { idx = __ffsll((long long)b) - 1; if (lane == idx) v00 = -INFINITY; }
                    else { b = __ballot(v01 == m); idx = __ffsll((long long)b) - 1; if (lane == idx) v01 = -INFINITY; idx += 64; }
                    if (lane == rd) { sv0 = m; si0 = idx; }
                }
                {
                    const float m = wave_max(fmaxf(v10, v11));
                    unsigned long long b = __ballot(v10 == m); int idx;
                    if (b) { idx = __ffsll((long long)b) - 1; if (lane == idx) v10 = -INFINITY; }
                    else { b = __ballot(v11 == m); idx = __ffsll((long long)b) - 1; if (lane == idx) v11 = -INFINITY; idx += 64; }
                    if (lane == rd) { sv1 = m; si1 = idx; }
                }
            }
            float cand = __shfl(sv0, ci) + __shfl(sv1, cj);
            const int cidx = __shfl(si0, ci) * 128 + __shfl(si1, cj);
            if (!cvalid) cand = -INFINITY;
            float cs = -INFINITY; int ce = 0;
            for (int rd = 0; rd < 16; ++rd) {
                const float m = wave_max(cand);
                const unsigned long long b = __ballot(cand == m);
                const int idx = __ffsll((long long)b) - 1;
                const int e = __builtin_amdgcn_readlane(cidx, idx);
                if (lane == idx) cand = -INFINITY;
                if (lane == rd) { cs = m; ce = e; }
            }
            const float mx = __int_as_float(__builtin_amdgcn_readlane(__float_as_int(cs), 0));
            const float ex = lane < 16 ? expf(cs - mx) : 0.f;
            const float sum = wave_sum(ex);
            if (lane < 16) { p.GATE[(size_t)r * 128 + h * 16 + lane] = ex / sum; p.EIDX[(size_t)r * 128 + h * 16 + lane] = ce; }
        }
    }
}

__device__ __forceinline__ void unpack8(const uint4 u, float* f) {
    f[0] = bf_lo(u.x); f[1] = bf_hi(u.x); f[2] = bf_lo(u.y); f[3] = bf_hi(u.y); f[4] = bf_lo(u.z); f[5] = bf_hi(u.z); f[6] = bf_lo(u.w); f[7] = bf_hi(u.w);
}
__device__ void ph_peer_gather(const P& p, int L, int nrows) {
    const int lane = otid() & 63, wid = otid() >> 6;
    const bf16_t* U = p.UB + (size_t)L * 16384 * 1024; const bf16_t* V = p.VB + (size_t)L * 16384 * 1024;
    const float* gate2 = p.modv + (size_t)L * 9 * 6144 + 5120;
    for (int r = blockIdx.x * 4 + wid; r < nrows; r += gridDim.x * 4) {
        const int e0 = p.EIDX[(size_t)r * 128 + lane], e1 = p.EIDX[(size_t)r * 128 + 64 + lane];
        const float g0 = p.GATE[(size_t)r * 128 + lane], g1 = p.GATE[(size_t)r * 128 + 64 + lane];
        float x[16];
        { const uint4 xa = *(const uint4*)(p.XN + (size_t)r * DM + lane * 8), xb = *(const uint4*)(p.XN + (size_t)r * DM + 512 + lane * 8); unpack8(xa, x); unpack8(xb, x + 8); }
        float a0 = 0.f, a1 = 0.f;
#pragma unroll
        for (int half = 0; half < 2; ++half) {
            const int ev = half ? e1 : e0;
            float av = 0.f;
            for (int kb = 0; kb < 8; ++kb) {
                uint4 ua[8], ub[8];
#pragma unroll
                for (int j = 0; j < 8; ++j) {
                    const int idx = __builtin_amdgcn_readlane(ev, kb * 8 + j);
                    const bf16_t* rp = U + (size_t)idx * 1024 + lane * 8;
                    ua[j] = *(const uint4*)rp; ub[j] = *(const uint4*)(rp + 512);
                }
#pragma unroll
                for (int j = 0; j < 8; ++j) {
                    float f[16]; unpack8(ua[j], f); unpack8(ub[j], f + 8);
                    float s = 0.f;
#pragma unroll
                    for (int c = 0; c < 16; ++c) s += x[c] * f[c];
                    s = wave_sum(s);
                    if (lane == kb * 8 + j) av = s;
                }
            }
            if (half) a1 = av; else a0 = av;
        }
        const float w0 = g0 * 0.5f * a0 * (1.f + erff(a0 * 0.70710678118654752f));
        const float w1 = g1 * 0.5f * a1 * (1.f + erff(a1 * 0.70710678118654752f));
        float acc[16];
#pragma unroll
        for (int c = 0; c < 16; ++c) acc[c] = 0.f;
#pragma unroll
        for (int half = 0; half < 2; ++half) {
            const int ev = half ? e1 : e0; const int wv = __float_as_int(half ? w1 : w0);
            for (int kb = 0; kb < 8; ++kb) {
                uint4 ua[8], ub[8];
#pragma unroll
                for (int j = 0; j < 8; ++j) {
                    const int idx = __builtin_amdgcn_readlane(ev, kb * 8 + j);
                    const bf16_t* rp = V + (size_t)idx * 1024 + lane * 8;
                    ua[j] = *(const uint4*)rp; ub[j] = *(const uint4*)(rp + 512);
                }
#pragma unroll
                for (int j = 0; j < 8; ++j) {
                    const float wj = __int_as_float(__builtin_amdgcn_readlane(wv, kb * 8 + j));
                    float f[16]; unpack8(ua[j], f); unpack8(ub[j], f + 8);
#pragma unroll
                    for (int c = 0; c < 16; ++c) acc[c] += wj * f[c];
                }
            }
        }
        const float* gp = gate2 + (size_t)modrow(r) * 6144;
        float* hp = p.H + (size_t)r * DM;
#pragma unroll
        for (int q = 0; q < 4; ++q) {
            const int c = (q >> 1) * 512 + lane * 8 + (q & 1) * 4;
            const float4 g = *(const float4*)(gp + c);
            float4 hv = *(float4*)(hp + c);
            hv.x += g.x * acc[q * 4 + 0]; hv.y += g.y * acc[q * 4 + 1]; hv.z += g.z * acc[q * 4 + 2]; hv.w += g.w * acc[q * 4 + 3];
            *(float4*)(hp + c) = hv;
        }
    }
}

__device__ void run_phase(const P& p, int ph, float* smem) {
    if (ph == 0) { ph_prologue(p, smem); return; }
    if (ph == NPH - 1) { ph_final(p); return; }
    const int L = (ph - 1) / 10, s = (ph - 1) % 10, j = L >> 1;
    const bool even = (L & 1) == 0, need_ctx = L < 3;
    const int nrows = need_ctx ? NT : NL;
    const float* mv = p.modv + (size_t)L * 9 * 6144;
    switch (s) {
    case 0: ph_normmod(p.H, p.norm1_g + L * DM, mv, 0, 1024, p.XN, NT); break;
    case 1:
        if (even) ph_gemm(p.XN, p.WT + WT_EVIN(j), NT, 3200, EpiEven{p.PB, p.AQL, p.AQC, p.AK, p.AV, p.GT, p.rope}, (char*)smem);
        else ph_gemm(p.XN, p.WT + WT_ODIN(j), NT, ODW, EpiOdd{p.AQL, p.AQC, p.AK, p.AV, p.rope}, (char*)smem);
        break;
    case 2: if (even) ph_prep_even(p, j); break;
    case 3: if (even) ph_attn_even(p, L, j, smem); else ph_attn_odd(p, j, need_ctx, smem); break;
    case 4: if (even) ph_mixout_even(p, L, j); break;
    case 5:
        ph_gemm(p.MIX, p.WT + (even ? WT_EVOUT(j) : WT_ODOUT(j)), nrows, DM, EpiResid{p.H, mv + 2048}, (char*)smem);
        break;
    case 6: ph_normmod(p.H, p.norm2_g + L * DM, mv, 3072, 4096, p.XN, nrows); break;
    case 7: ph_gemm(p.XN, p.WT + WT_PQ(L), nrows, 2048, EpiStoreBF16{p.QB, 2048}, (char*)smem); break;
    case 8: ph_peer_select(p, L, nrows, (char*)smem); break;
    case 9: ph_peer_gather(p, L, nrows); break;
    }
}

__global__ void __launch_bounds__(256, 2) mega(P p) {
    extern __shared__ __attribute__((aligned(16))) float smem[];
    cg::grid_group grid = cg::this_grid();
    for (int ph = p.ph_lo; ph < p.ph_hi; ++ph) {
        run_phase(p, ph, smem);
        if (ph + 1 < p.ph_hi) grid.sync();
    }
}

extern "C" void kernel_launch(void* const* d_in, const int* in_sizes, int n_in, void* d_out, int out_size, void* d_ws, size_t ws_size, hipStream_t stream) {
    static int grid_blocks = 0;
    if (!grid_blocks) {
        int dev = 0, cus = 0, per_cu = 0;
        hipGetDevice(&dev);
        hipDeviceGetAttribute(&cus, hipDeviceAttributeMultiprocessorCount, dev);
        hipFuncSetAttribute((const void*)mega, hipFuncAttributeMaxDynamicSharedMemorySize, LDS_BYTES);
        hipOccupancyMaxActiveBlocksPerMultiprocessor(&per_cu, mega, 256, LDS_BYTES);
        if (per_cu < 1) per_cu = 1;
        if (per_cu > 2) per_cu = 2;
        grid_blocks = cus * per_cu;
    }
    P p{};
    const float** ins = (const float**)&p;
    for (int i = 0; i < 24; ++i) ins[i] = (const float*)d_in[i];
    p.out = (float*)d_out;
    size_t off = 0; char* ws = (char*)d_ws;
    auto carve = [&](size_t bytes) { void* r = ws + off; off += (bytes + 255) & ~(size_t)255; return r; };
    p.modv = (float*)carve((size_t)4 * 9 * 6144 * 4);
    p.rope = (float*)carve((size_t)2048 * 64 * 4);
    p.H = (float*)carve((size_t)NT * DM * 4);
    p.XN = (bf16_t*)carve((size_t)NT * DM * 2);
    p.WT = (bf16_t*)carve(WT_TOTAL * 2);
    p.MIX = (bf16_t*)carve((size_t)NT * DM * 2);
    p.PB = (bf16_t*)carve((size_t)NT * 1536 * 2);
    p.GT = (float*)carve((size_t)NT * 16 * 4);
    p.AQL = (bf16_t*)carve((size_t)8 * 16 * 2048 * 64 * 2);
    p.AQC = (bf16_t*)carve((size_t)8 * 16 * 256 * 64 * 2);
    p.AK = (bf16_t*)carve((size_t)8 * 4 * 2 * 2304 * 64 * 2);
    p.AV = (bf16_t*)carve((size_t)8 * 4 * 128 * 2304 * 2);
    p.QKC = (float*)carve((size_t)NT * 512 * 4);
    p.HM = (float*)carve((size_t)2 * NT * 512 * 4);
    p.QB = (bf16_t*)carve((size_t)NT * 2048 * 2);
    p.GATE = (float*)carve((size_t)NT * 128 * 4);
    p.EIDX = (int*)carve((size_t)NT * 128 * 4);
    p.ctr = (int*)carve(256);
    p.UB = (bf16_t*)carve((size_t)4 * 16384 * 1024 * 2);
    p.VB = (bf16_t*)carve((size_t)4 * 16384 * 1024 * 2);
    p.KB = (bf16_t*)carve((size_t)4 * 8 * 2 * 128 * 128 * 2);
    if (off > ws_size) { fprintf(stderr, "kernel_launch: workspace too small: need %zu have %zu\n", off, ws_size); return; }
#if ONE_LAUNCH
    p.ph_lo = 0; p.ph_hi = NPH;
    void* args[] = {&p};
    hipError_t e = hipLaunchCooperativeKernel((void*)mega, dim3(grid_blocks), dim3(256), args, LDS_BYTES, stream);
    if (e != hipSuccess) fprintf(stderr, "cooperative launch failed: %s (grid %d)\n", hipGetErrorString(e), grid_blocks);
#else
    for (int ph = 0; ph < NPH; ++ph) {
        if (ph > 0 && ph < NPH - 1) { const int L = (ph - 1) / 10, s = (ph - 1) % 10; if ((s == 4 || s == 2) && (L & 1)) continue; }
        p.ph_lo = ph; p.ph_hi = ph + 1;
        hipLaunchKernelGGL(mega, dim3(grid_blocks), dim3(256), LDS_BYTES, stream, p);
    }
#endif
}
```

```cpp
#include <hip/hip_runtime.h>
#include <hip/hip_cooperative_groups.h>
#include <cstdio>
#include <cstdint>
namespace cg = cooperative_groups;

#ifndef ONE_LAUNCH
#define ONE_LAUNCH 1
#endif

#define NT 18432
#define NL 16384
#define DM 1024
#define EVW 3088
#define ODW 1536
#define C_QK 0
#define C_V 512
#define C_O 1024
#define C_G 1536
#define C_DQ 1552
#define C_DK 2064
#define C_DV 2576
#define NPH 42

typedef unsigned short bf16_t;
typedef short bf16x8 __attribute__((ext_vector_type(8)));
typedef float f32x4 __attribute__((ext_vector_type(4)));
#define LDS_BYTES 73792

typedef float f32x16 __attribute__((ext_vector_type(16)));
typedef unsigned u32x4 __attribute__((ext_vector_type(4)));
struct P {
    const float *x, *c, *ctx, *c_ctx, *mod_w, *mod_b, *norm1_g, *norm2_g, *ev_w_in, *ev_conv_w, *ev_conv_b, *ev_gate_b,
        *ev_ml_g, *ev_da_lam, *ev_da_g, *ev_w_out, *od_w_in, *od_sink, *od_w_out, *pr_w_q, *pr_keys, *pr_u, *pr_v, *final_g;
    float* out;
    float *modv, *H, *QKC, *HM, *GATE, *rope, *GT;
    int *EIDX, *ctr;
    unsigned* bar;
    bf16_t *XN, *MIX, *WT, *UB, *VB, *KB, *QB, *PB, *AQL, *AQC, *AK, *AV;
    int ph_lo, ph_hi;
};
#define QSCALE 0.18033688011112042f

__device__ __forceinline__ int otid() { int t = threadIdx.x; asm volatile("" : "+v"(t)); return t; }
__device__ __forceinline__ int modrow(int r) { return r < NL ? (r >> 11) : 8; }
__device__ __forceinline__ float silu_f(float x) { return x / (1.f + expf(-x)); }
__device__ __forceinline__ float sigmoid_f(float x) { return 1.f / (1.f + expf(-x)); }
__device__ __forceinline__ float log_sigmoid_f(float x) { return fminf(x, 0.f) - log1pf(expf(-fabsf(x))); }
typedef __bf16 bf16v2_t __attribute__((ext_vector_type(2)));
typedef float f32x2_t __attribute__((ext_vector_type(2)));
__device__ __forceinline__ unsigned cvt_pk_bf16(float lo, float hi) { const bf16v2_t v = __builtin_convertvector((f32x2_t){lo, hi}, bf16v2_t); return __builtin_bit_cast(unsigned, v); }
__device__ __forceinline__ float bf_lo(unsigned u) { return __uint_as_float(u << 16); }
__device__ __forceinline__ float bf_hi(unsigned u) { return __uint_as_float(u & 0xffff0000u); }
#define WT_EVIN(j) ((size_t)(j) * 3200 * 1024)
#define WT_EVOUT(j) ((size_t)2 * 3200 * 1024 + (size_t)(j) * 1024 * 1024)
#define WT_ODIN(j) ((size_t)2 * 3200 * 1024 + (size_t)2 * 1024 * 1024 + (size_t)(j) * 1536 * 1024)
#define WT_ODOUT(j) ((size_t)2 * 3200 * 1024 + (size_t)2 * 1024 * 1024 + (size_t)2 * 1536 * 1024 + (size_t)(j) * 1024 * 1024)
#define WT_PQ(L) ((size_t)2 * 3200 * 1024 + (size_t)4 * 1024 * 1024 + (size_t)2 * 1536 * 1024 + (size_t)(L) * 2048 * 1024)
#define WT_TOTAL ((size_t)2 * 3200 * 1024 + (size_t)4 * 1024 * 1024 + (size_t)2 * 1536 * 1024 + (size_t)4 * 2048 * 1024)
__device__ __forceinline__ float wave_sum(float v) {
#pragma unroll
    for (int o = 32; o > 0; o >>= 1) v += __shfl_xor(v, o);
    return v;
}

__device__ void cvt_copy_bf16(const float* src, bf16_t* dst, size_t n);
__device__ void ph_prologue(const P& p, float* smem) {
    const int tid = otid(), nb = gridDim.x, bid = blockIdx.x;
    if (bid == 0 && tid < 64) p.ctr[tid] = 0;
    {
        const float4* xs = (const float4*)p.x; const float4* cs = (const float4*)p.ctx; float4* hd = (float4*)p.H;
        const size_t nx = (size_t)NL * DM / 4, nc = (size_t)(NT - NL) * DM / 4;
        for (size_t i = (size_t)bid * 256 + tid; i < nx + nc; i += (size_t)nb * 256) hd[i] = i < nx ? xs[i] : cs[i - nx];
    }
    for (int i = bid * 256 + tid; i < 2048 * 32; i += nb * 256) {
        const int s = i >> 5, d = i & 31;
        const float pos = (d < 16) ? (float)(s >> 6) : (float)(s & 63);
        const float inv = powf(10000.0f, -(float)(d & 15) / 16.0f);
        const float ang = pos * inv;
        p.rope[2 * i] = cosf(ang); p.rope[2 * i + 1] = sinf(ang);
    }
    float* sc = smem;
    float* red = smem + 9 * 1024;
    for (int i = tid; i < 9 * 1024; i += 256) { const int r = i >> 10, k = i & 1023; const float v = r < 8 ? p.c[r * 1024 + k] : p.c_ctx[k]; sc[i] = silu_f(v); }
    __syncthreads();
    for (int item = bid; item < 4 * 96; item += nb) {
        const int L = item / 96, n0 = (item % 96) * 64, tx = tid & 63, kq = tid >> 6;
        float acc[9];
#pragma unroll
        for (int r = 0; r < 9; ++r) acc[r] = 0.f;
        const float* w = p.mod_w + (size_t)L * 1024 * 6144 + n0 + tx;
        for (int k = kq * 256; k < kq * 256 + 256; ++k) {
            const float wv = w[(size_t)k * 6144];
#pragma unroll
            for (int r = 0; r < 9; ++r) acc[r] += sc[r * 1024 + k] * wv;
        }
#pragma unroll
        for (int r = 0; r < 9; ++r) red[(kq * 9 + r) * 64 + tx] = acc[r];
        __syncthreads();
        if (kq == 0) {
#pragma unroll
            for (int r = 0; r < 9; ++r) {
                const float s = red[(0 * 9 + r) * 64 + tx] + red[(1 * 9 + r) * 64 + tx] + red[(2 * 9 + r) * 64 + tx] + red[(3 * 9 + r) * 64 + tx];
                p.modv[((size_t)L * 9 + r) * 6144 + n0 + tx] = s + p.mod_b[L * 6144 + n0 + tx];
            }
        }
        __syncthreads();
    }
    {
        float (*tile)[65] = (float (*)[65])smem;
        for (int item = bid; item < 5440; item += nb) {
            int it = item, mat = 0, N = 0, Npad = 0; const float* src = nullptr; bf16_t* dst = nullptr;
            for (mat = 0; mat < 12; ++mat) {
                if (mat < 2) { N = EVW; Npad = 3200; src = p.ev_w_in + (size_t)mat * DM * EVW; dst = p.WT + WT_EVIN(mat); }
                else if (mat < 4) { N = 1024; Npad = 1024; src = p.ev_w_out + (size_t)(mat - 2) * DM * DM; dst = p.WT + WT_EVOUT(mat - 2); }
                else if (mat < 6) { N = ODW; Npad = ODW; src = p.od_w_in + (size_t)(mat - 4) * DM * ODW; dst = p.WT + WT_ODIN(mat - 4); }
                else if (mat < 8) { N = 1024; Npad = 1024; src = p.od_w_out + (size_t)(mat - 6) * DM * DM; dst = p.WT + WT_ODOUT(mat - 6); }
                else { N = 2048; Npad = 2048; src = p.pr_w_q + (size_t)(mat - 8) * DM * 2048; dst = p.WT + WT_PQ(mat - 8); }
                const int nt = 16 * (Npad / 64);
                if (it < nt) break;
                it -= nt;
            }
            const int k0 = (it & 15) * 64, n0 = (it >> 4) * 64;
            __syncthreads();
#pragma unroll
            for (int rep = 0; rep < 4; ++rep) {
                const int i = (tid >> 4) + 16 * rep, c4 = (tid & 15) * 4;
                float4 v = make_float4(0.f, 0.f, 0.f, 0.f);
                int sc = n0 + c4;
                if (mat < 2) sc = sc < 1536 ? sc : (sc < 3072 ? sc + 16 : (sc < 3088 ? sc - 3072 + 1536 : N));
                if (sc < N) v = *(const float4*)(src + (size_t)(k0 + i) * N + sc);
                tile[i][c4] = v.x; tile[i][c4 + 1] = v.y; tile[i][c4 + 2] = v.z; tile[i][c4 + 3] = v.w;
            }
            __syncthreads();
            {
                const int n = tid >> 2, kq = (tid & 3) * 16;
                unsigned w[8];
#pragma unroll
                for (int e = 0; e < 8; ++e) w[e] = cvt_pk_bf16(tile[kq + 2 * e][n], tile[kq + 2 * e + 1][n]);
                uint4* dp = (uint4*)(dst + (size_t)(n0 + n) * DM + k0 + kq);
                dp[0] = make_uint4(w[0], w[1], w[2], w[3]); dp[1] = make_uint4(w[4], w[5], w[6], w[7]);
            }
        }
    }
    cvt_copy_bf16(p.pr_u, p.UB, (size_t)4 * 16384 * 1024);
    cvt_copy_bf16(p.pr_v, p.VB, (size_t)4 * 16384 * 1024);
    cvt_copy_bf16(p.pr_keys, p.KB, (size_t)4 * 8 * 2 * 128 * 128);
}

__device__ void cvt_copy_bf16(const float* src, bf16_t* dst, size_t n) {
    const size_t n8 = n / 8;
    for (size_t i = (size_t)blockIdx.x * 256 + otid(); i < n8; i += (size_t)gridDim.x * 256) {
        const float4 a = ((const float4*)src)[2 * i], b = ((const float4*)src)[2 * i + 1];
        ((uint4*)dst)[i] = make_uint4(cvt_pk_bf16(a.x, a.y), cvt_pk_bf16(a.z, a.w), cvt_pk_bf16(b.x, b.y), cvt_pk_bf16(b.z, b.w));
    }
}

__device__ void ph_normmod(const float* src, const float* g, const float* modv_layer, int shift_off, int scale_off, bf16_t* dst, int nrows) {
    const int lane = otid() & 63, wid = otid() >> 6;
    for (int r = blockIdx.x * 4 + wid; r < nrows; r += gridDim.x * 4) {
        const float4* s4 = (const float4*)(src + (size_t)r * DM);
        float4 v[4]; float ss = 0.f;
#pragma unroll
        for (int i = 0; i < 4; ++i) { v[i] = s4[i * 64 + lane]; ss += v[i].x * v[i].x + v[i].y * v[i].y + v[i].z * v[i].z + v[i].w * v[i].w; }
        ss = wave_sum(ss);
        const float rstd = rsqrtf(ss * (1.0f / DM) + 1e-6f);
        const float* mv = modv_layer + (size_t)modrow(r) * 6144;
        uint2* d2 = (uint2*)(dst + (size_t)r * DM);
#pragma unroll
        for (int i = 0; i < 4; ++i) {
            const int c = (i * 64 + lane) * 4;
            const float4 gg = *(const float4*)(g + c), sh = *(const float4*)(mv + shift_off + c), scl = *(const float4*)(mv + scale_off + c);
            float4 o;
            o.x = v[i].x * rstd * gg.x * (1.f + scl.x) + sh.x; o.y = v[i].y * rstd * gg.y * (1.f + scl.y) + sh.y;
            o.z = v[i].z * rstd * gg.z * (1.f + scl.z) + sh.z; o.w = v[i].w * rstd * gg.w * (1.f + scl.w) + sh.w;
            d2[i * 64 + lane] = make_uint2(cvt_pk_bf16(o.x, o.y), cvt_pk_bf16(o.z, o.w));
        }
    }
}

__device__ void ph_final(const P& p) {
    const int lane = otid() & 63, wid = otid() >> 6;
    for (int r = blockIdx.x * 4 + wid; r < NL; r += gridDim.x * 4) {
        const float4* s4 = (const float4*)(p.H + (size_t)r * DM);
        float4 v[4]; float ss = 0.f;
#pragma unroll
        for (int i = 0; i < 4; ++i) { v[i] = s4[i * 64 + lane]; ss += v[i].x * v[i].x + v[i].y * v[i].y + v[i].z * v[i].z + v[i].w * v[i].w; }
        ss = wave_sum(ss);
        const float rstd = rsqrtf(ss * (1.0f / DM) + 1e-6f);
        float4* d4 = (float4*)(p.out + (size_t)r * DM);
#pragma unroll
        for (int i = 0; i < 4; ++i) {
            const int c = (i * 64 + lane) * 4; const float4 gg = *(const float4*)(p.final_g + c);
            float4 o; o.x = v[i].x * rstd * gg.x; o.y = v[i].y * rstd * gg.y; o.z = v[i].z * rstd * gg.z; o.w = v[i].w * rstd * gg.w;
            d4[i * 64 + lane] = o;
        }
    }
}

#define GL_ROWB 144
#define GL_TILEB (128 * GL_ROWB)
struct TokPos { int b, pos, kpos; bool lat; };
__device__ __forceinline__ TokPos tokpos(int row) {
    TokPos t; t.lat = row < NL;
    if (t.lat) { t.b = row >> 11; t.pos = row & 2047; t.kpos = 256 + t.pos; } else { const int r = row - NL; t.b = r >> 8; t.pos = r & 255; t.kpos = t.pos; }
    return t;
}
struct EpiStoreBF16 {
    bf16_t* C; int ldc;
    __device__ __forceinline__ bool swapped(int) const { return false; }
    __device__ __forceinline__ void operator()(const f32x4 (&acc)[4][4], int m0, int n0, int wm, int wn, int fr, int fq) const {
#pragma unroll
        for (int mi = 0; mi < 4; ++mi)
#pragma unroll
            for (int ni = 0; ni < 4; ++ni) {
                const f32x4 v = acc[ni][mi];
                *(uint2*)(C + (size_t)(m0 + wm * 64 + mi * 16 + fr) * ldc + n0 + wn * 64 + ni * 16 + fq * 4) = make_uint2(cvt_pk_bf16(v[0], v[1]), cvt_pk_bf16(v[2], v[3]));
            }
    }
};
struct EpiResid {
    float* H; const float* gate;
    __device__ __forceinline__ bool swapped(int) const { return false; }
    __device__ __forceinline__ void operator()(const f32x4 (&acc)[4][4], int m0, int n0, int wm, int wn, int fr, int fq) const {
#pragma unroll
        for (int mi = 0; mi < 4; ++mi) {
            const int row = m0 + wm * 64 + mi * 16 + fr;
            const float* gp = gate + (size_t)modrow(row) * 6144;
#pragma unroll
            for (int ni = 0; ni < 4; ++ni) {
                const int col = n0 + wn * 64 + ni * 16 + fq * 4;
                const f32x4 g = *(const f32x4*)(gp + col);
                f32x4* hp = (f32x4*)(H + (size_t)row * DM + col);
                *hp = *hp + g * acc[ni][mi];
            }
        }
    }
};
__device__ __forceinline__ void rope_store64(const f32x4 (&acc)[4][4], int mi, bool do_rope, const float* ropep  , float scale, bf16_t* dst  , int fq) {
#pragma unroll
    for (int ni = 0; ni < 2; ++ni) {
        f32x4 x1 = acc[ni][mi], x2 = acc[ni + 2][mi];
        if (do_rope) {
            const f32x4 r0 = *(const f32x4*)(ropep + (ni * 16 + fq * 4) * 2), r1 = *(const f32x4*)(ropep + (ni * 16 + fq * 4) * 2 + 4);
            const f32x4 cs = (f32x4){r0[0], r0[2], r1[0], r1[2]}, sn = (f32x4){r0[1], r0[3], r1[1], r1[3]};
            const f32x4 y1 = x1 * cs - x2 * sn, y2 = x1 * sn + x2 * cs;
            x1 = y1; x2 = y2;
        }
        x1 = x1 * scale; x2 = x2 * scale;
        *(uint2*)(dst + ni * 16 + fq * 4) = make_uint2(cvt_pk_bf16(x1[0], x1[1]), cvt_pk_bf16(x1[2], x1[3]));
        *(uint2*)(dst + 32 + ni * 16 + fq * 4) = make_uint2(cvt_pk_bf16(x2[0], x2[1]), cvt_pk_bf16(x2[2], x2[3]));
    }
}
struct EpiEven {
    bf16_t *PB, *AQL, *AQC, *AK, *AV; float* GT; const float* rope;
    __device__ __forceinline__ bool swapped(int n0) const { return n0 >= 2560 && n0 < 3072; }
    __device__ __forceinline__ void operator()(const f32x4 (&acc)[4][4], int m0, int n0, int wm, int wn, int fr, int fq) const {
        const int t = n0 >> 7;
        if (t < 12) {
#pragma unroll
            for (int mi = 0; mi < 4; ++mi)
#pragma unroll
                for (int ni = 0; ni < 4; ++ni) {
                    const f32x4 v = acc[ni][mi];
                    *(uint2*)(PB + (size_t)(m0 + wm * 64 + mi * 16 + fr) * 1536 + n0 + wn * 64 + ni * 16 + fq * 4) = make_uint2(cvt_pk_bf16(v[0], v[1]), cvt_pk_bf16(v[2], v[3]));
                }
        } else if (t < 20) {
            const bool isq = t < 16; const int h = t & 3;
#pragma unroll
            for (int mi = 0; mi < 4; ++mi) {
                const TokPos tp = tokpos(m0 + wm * 64 + mi * 16 + fr);
                const int hm = (tp.b * 4 + h) * 2 + wn;
                bf16_t* dst;
                if (isq) dst = tp.lat ? AQL + ((size_t)hm * 2048 + tp.pos) * 64 : AQC + ((size_t)hm * 256 + tp.pos) * 64;
                else dst = AK + ((size_t)hm * 2304 + tp.kpos) * 64;
                rope_store64(acc, mi, tp.lat, rope + (size_t)tp.pos * 64, isq ? QSCALE : 1.0f, dst, fq);
            }
        } else if (t < 24) {
            const int h = t - 20;
#pragma unroll
            for (int mi = 0; mi < 4; ++mi) {
                const TokPos tp = tokpos(m0 + wm * 64 + mi * 16 + fq * 4);
#pragma unroll
                for (int ni = 0; ni < 4; ++ni) {
                    const f32x4 v = acc[ni][mi];
                    const int d = wn * 64 + ni * 16 + fr;
                    *(uint2*)(AV + ((size_t)(tp.b * 4 + h) * 128 + d) * 2304 + tp.kpos) = make_uint2(cvt_pk_bf16(v[0], v[1]), cvt_pk_bf16(v[2], v[3]));
                }
            }
        } else {
            if (wn == 0) {
#pragma unroll
                for (int mi = 0; mi < 4; ++mi) *(f32x4*)(GT + (size_t)(m0 + wm * 64 + mi * 16 + fr) * 16 + fq * 4) = acc[0][mi];
            }
        }
    }
};
struct EpiOdd {
    bf16_t *AQL, *AQC, *AK, *AV; const float* rope;
    __device__ __forceinline__ bool swapped(int n0) const { return n0 >= 1280; }
    __device__ __forceinline__ void operator()(const f32x4 (&acc)[4][4], int m0, int n0, int wm, int wn, int fr, int fq) const {
        const int t = n0 >> 7;
        if (t < 10) {
            const bool isq = t < 8; const int hd = isq ? t * 2 + wn : (t - 8) * 2 + wn;
#pragma unroll
            for (int mi = 0; mi < 4; ++mi) {
                const TokPos tp = tokpos(m0 + wm * 64 + mi * 16 + fr);
                bf16_t* dst;
                if (isq) dst = tp.lat ? AQL + ((size_t)(tp.b * 16 + hd) * 2048 + tp.pos) * 64 : AQC + ((size_t)(tp.b * 16 + hd) * 256 + tp.pos) * 64;
                else dst = AK + ((size_t)(tp.b * 4 + hd) * 2304 + tp.kpos) * 64;
                rope_store64(acc, mi, tp.lat, rope + (size_t)tp.pos * 64, isq ? QSCALE : 1.0f, dst, fq);
            }
        } else {
            const int hkv = (t - 10) * 2 + wn;
#pragma unroll
            for (int mi = 0; mi < 4; ++mi) {
                const TokPos tp = tokpos(m0 + wm * 64 + mi * 16 + fq * 4);
#pragma unroll
                for (int ni = 0; ni < 4; ++ni) {
                    const f32x4 v = acc[ni][mi];
                    const int d = ni * 16 + fr;
                    *(uint2*)(AV + ((size_t)(tp.b * 4 + hkv) * 64 + d) * 2304 + tp.kpos) = make_uint2(cvt_pk_bf16(v[0], v[1]), cvt_pk_bf16(v[2], v[3]));
                }
            }
        }
    }
};
template <bool SWAP>
__device__ __forceinline__ void gemm_tile_kloop(f32x4 (&acc)[4][4], const bf16_t* ap, const bf16_t* bp, char* smem, int lrow, int lch, int wm, int wn, int fr, int fq) {
    uint4 ra0, ra1, ra2, ra3, rb0, rb1, rb2, rb3;
#define GL_LOAD(KO) { ra0 = *(const uint4*)(ap + (KO)); ra1 = *(const uint4*)(ap + (size_t)32 * DM + (KO)); ra2 = *(const uint4*)(ap + (size_t)64 * DM + (KO)); ra3 = *(const uint4*)(ap + (size_t)96 * DM + (KO)); \
                      rb0 = *(const uint4*)(bp + (KO)); rb1 = *(const uint4*)(bp + (size_t)32 * DM + (KO)); rb2 = *(const uint4*)(bp + (size_t)64 * DM + (KO)); rb3 = *(const uint4*)(bp + (size_t)96 * DM + (KO)); }
#define GL_STORE(BUF) { char* sa_ = (BUF) + lrow * GL_ROWB + lch * 16; char* sb_ = sa_ + GL_TILEB; \
                        *(uint4*)(sa_) = ra0; *(uint4*)(sa_ + 32 * GL_ROWB) = ra1; *(uint4*)(sa_ + 64 * GL_ROWB) = ra2; *(uint4*)(sa_ + 96 * GL_ROWB) = ra3; \
                        *(uint4*)(sb_) = rb0; *(uint4*)(sb_ + 32 * GL_ROWB) = rb1; *(uint4*)(sb_ + 64 * GL_ROWB) = rb2; *(uint4*)(sb_ + 96 * GL_ROWB) = rb3; }
    GL_LOAD(0)
    __syncthreads();
    GL_STORE(smem)
    __syncthreads();
    for (int kt = 0; kt < 16; ++kt) {
        char* cur = smem + (kt & 1) * 2 * GL_TILEB;
        char* nxt = smem + ((kt + 1) & 1) * 2 * GL_TILEB;
        if (kt + 1 < 16) GL_LOAD((kt + 1) * 64)
#pragma unroll
        for (int ks = 0; ks < 2; ++ks) {
            bf16x8 af[4], wf[4];
#pragma unroll
            for (int i = 0; i < 4; ++i) {
                af[i] = *(const bf16x8*)(cur + (wm * 64 + i * 16 + fr) * GL_ROWB + (ks * 4 + fq) * 16);
                wf[i] = *(const bf16x8*)(cur + GL_TILEB + (wn * 64 + i * 16 + fr) * GL_ROWB + (ks * 4 + fq) * 16);
            }
#pragma unroll
            for (int ni = 0; ni < 4; ++ni)
#pragma unroll
                for (int mi = 0; mi < 4; ++mi)
                    acc[ni][mi] = SWAP ? __builtin_amdgcn_mfma_f32_16x16x32_bf16(af[mi], wf[ni], acc[ni][mi], 0, 0, 0)
                                       : __builtin_amdgcn_mfma_f32_16x16x32_bf16(wf[ni], af[mi], acc[ni][mi], 0, 0, 0);
        }
        if (kt + 1 < 16) GL_STORE(nxt)
        __syncthreads();
    }
#undef GL_LOAD
#undef GL_STORE
}
template <class Epi>
__device__ void ph_gemm(const bf16_t* A, const bf16_t* Bt, int M, int Npad, const Epi& epi, char* smem) {
    const int tid = otid(), lane = tid & 63, wid = tid >> 6, wm = wid >> 1, wn = wid & 1;
    const int fr = lane & 15, fq = lane >> 4;
    const int tm = M / 128, tn = Npad / 128, ntiles = tm * tn;
    const int lrow = tid >> 3, lch = tid & 7;
    for (int tile = blockIdx.x; tile < ntiles; tile += gridDim.x) {
        const int m0 = (tile % tm) * 128, n0 = (tile / tm) * 128;
        f32x4 acc[4][4];
#pragma unroll
        for (int a = 0; a < 4; ++a)
#pragma unroll
            for (int b = 0; b < 4; ++b) acc[a][b] = (f32x4){0.f, 0.f, 0.f, 0.f};
        const bf16_t* ap = A + (size_t)(m0 + lrow) * DM + lch * 8;
        const bf16_t* bp = Bt + (size_t)(n0 + lrow) * DM + lch * 8;
        if (epi.swapped(n0)) gemm_tile_kloop<true>(acc, ap, bp, smem, lrow, lch, wm, wn, fr, fq);
        else gemm_tile_kloop<false>(acc, ap, bp, smem, lrow, lch, wm, wn, fr, fq);
        epi(acc, m0, n0, wm, wn, fr, fq);
    }
}

__device__ void ph_prep_even(const P& p, int j) {
    const float* cw = p.ev_conv_w + (size_t)j * 3 * 512; const float* cb = p.ev_conv_b + (size_t)j * 512;
    const size_t tot = (size_t)NT * 512;
    for (size_t i = (size_t)blockIdx.x * 256 + otid(); i < tot; i += (size_t)gridDim.x * 256) {
        const int r = (int)(i >> 9), c = (int)(i & 511);
        int t, T; if (r < NL) { t = r & 2047; T = 2048; } else { t = (r - NL) & 255; T = 256; }
        float v = cb[c] + __uint_as_float((unsigned)p.PB[(size_t)r * 1536 + c] << 16) * cw[512 + c];
        if (t > 0) v += __uint_as_float((unsigned)p.PB[(size_t)(r - 1) * 1536 + c] << 16) * cw[c];
        if (t < T - 1) v += __uint_as_float((unsigned)p.PB[(size_t)(r + 1) * 1536 + c] << 16) * cw[1024 + c];
        v = silu_f(v);
        if (c >= 256) v *= 0.125f;
        p.QKC[i] = v;
    }
}

#define FA_KROW 144
#define FA_VROW 136
__device__ __forceinline__ bf16x8 pack8(float a0, float a1, float a2, float a3, float a4, float a5, float a6, float a7) {
    const u32x4 u = (u32x4){cvt_pk_bf16(a0, a1), cvt_pk_bf16(a2, a3), cvt_pk_bf16(a4, a5), cvt_pk_bf16(a6, a7)};
    return __builtin_bit_cast(bf16x8, u);
}
template <int NDB, bool MASK>
__device__ __forceinline__ void flash_tile(const bf16x8 (&qf)[4], f32x16 (&o)[NDB], float& m, float& l, const char* Kl, const char* Vl, int lane, int qpos, int kp0) {
    const int j = lane & 31, h = lane >> 5;
    f32x16 s0, s1;
#pragma unroll
    for (int i = 0; i < 16; ++i) { s0[i] = 0.f; s1[i] = 0.f; }
#pragma unroll
    for (int ks = 0; ks < 4; ++ks) {
        const bf16x8 a0 = *(const bf16x8*)(Kl + j * FA_KROW + (2 * ks + h) * 16);
        const bf16x8 a1 = *(const bf16x8*)(Kl + (32 + j) * FA_KROW + (2 * ks + h) * 16);
        s0 = __builtin_amdgcn_mfma_f32_32x32x16_bf16(a0, qf[ks], s0, 0, 0, 0);
        s1 = __builtin_amdgcn_mfma_f32_32x32x16_bf16(a1, qf[ks], s1, 0, 0, 0);
    }
    if (MASK) {
#pragma unroll
        for (int r = 0; r < 16; ++r) {
            const int key = (r & 3) + 8 * (r >> 2) + 4 * h;
            const int d0 = qpos - (kp0 + key), d1 = d0 - 32;
            if (d0 > 128 || d0 < -128) s0[r] = -1e30f;
            if (d1 > 128 || d1 < -128) s1[r] = -1e30f;
        }
    }
    float mx = fmaxf(s0[0], s1[0]);
#pragma unroll
    for (int r = 1; r < 16; ++r) mx = fmaxf(mx, fmaxf(s0[r], s1[r]));
    mx = fmaxf(mx, __shfl_xor(mx, 32));
    const float mn = fmaxf(m, mx);
    const float alpha = __builtin_amdgcn_exp2f(m - mn);
    m = mn;
    float ls = 0.f;
#pragma unroll
    for (int r = 0; r < 16; ++r) { s0[r] = __builtin_amdgcn_exp2f(s0[r] - mn); s1[r] = __builtin_amdgcn_exp2f(s1[r] - mn); ls += s0[r] + s1[r]; }
    l = l * alpha + ls;
#pragma unroll
    for (int db = 0; db < NDB; ++db) o[db] = o[db] * alpha;
    bf16x8 pb[4];
    pb[0] = pack8(s0[0], s0[1], s0[2], s0[3], s0[4], s0[5], s0[6], s0[7]);
    pb[1] = pack8(s0[8], s0[9], s0[10], s0[11], s0[12], s0[13], s0[14], s0[15]);
    pb[2] = pack8(s1[0], s1[1], s1[2], s1[3], s1[4], s1[5], s1[6], s1[7]);
    pb[3] = pack8(s1[8], s1[9], s1[10], s1[11], s1[12], s1[13], s1[14], s1[15]);
#pragma unroll
    for (int db = 0; db < NDB; ++db)
#pragma unroll
        for (int kk = 0; kk < 4; ++kk) {
            const char* vp = Vl + (db * 32 + j) * FA_VROW + (kk * 16 + 4 * h) * 2;
            const uint2 lo = *(const uint2*)vp, hi = *(const uint2*)(vp + 16);
            const u32x4 u = (u32x4){lo.x, lo.y, hi.x, hi.y};
            o[db] = __builtin_amdgcn_mfma_f32_32x32x16_bf16(__builtin_bit_cast(bf16x8, u), pb[kk], o[db], 0, 0, 0);
        }
}

#define DA_BUFB 35840
__device__ void da_block(const P& p, int item, int L, int j, char* smem) {
    const int tid = otid(), lane = tid & 63, wid = tid >> 6, mp = wid & 1, qg = wid >> 1, jq = lane & 31, hh = lane >> 5;
    const bool lat = item < 1024;
    int b, h, qt;
    if (lat) { b = item >> 7; h = (item >> 5) & 3; qt = item & 31; } else { const int it = item - 1024; b = it >> 4; h = (it >> 2) & 3; qt = it & 3; }
    const int qi = qt * 64 + qg * 32 + jq;
    const bf16_t* qp = lat ? p.AQL + ((size_t)((b * 4 + h) * 2 + mp) * 2048 + qi) * 64 : p.AQC + ((size_t)((b * 4 + h) * 2 + mp) * 256 + qi) * 64;
    bf16x8 qf[4];
#pragma unroll
    for (int ks = 0; ks < 4; ++ks) qf[ks] = *(const bf16x8*)(qp + (2 * ks + hh) * 8);
    const int ntile = lat ? 36 : 4;
    const bf16_t* kg = p.AK + (size_t)((b * 4 + h) * 2) * 2304 * 64 + (size_t)(tid >> 3) * 64 + (tid & 7) * 8;
    const bf16_t* vg = p.AV + (size_t)(b * 4 + h) * 128 * 2304 + (size_t)(tid >> 3) * 2304 + (tid & 7) * 8;
    uint4 k0, k1, k2, k3, v0, v1, v2, v3;
#define DA_LOAD(KEY0) { k0 = *(const uint4*)(kg + (size_t)(KEY0) * 64); k1 = *(const uint4*)(kg + (size_t)((KEY0) + 32) * 64); \
                        k2 = *(const uint4*)(kg + (size_t)2304 * 64 + (size_t)(KEY0) * 64); k3 = *(const uint4*)(kg + (size_t)2304 * 64 + (size_t)((KEY0) + 32) * 64); \
                        v0 = *(const uint4*)(vg + (KEY0)); v1 = *(const uint4*)(vg + (size_t)32 * 2304 + (KEY0)); v2 = *(const uint4*)(vg + (size_t)64 * 2304 + (KEY0)); v3 = *(const uint4*)(vg + (size_t)96 * 2304 + (KEY0)); }
#define DA_STORE(BUF) { char* kb_ = (BUF) + (tid >> 3) * FA_KROW + (tid & 7) * 16; \
                        *(uint4*)kb_ = k0; *(uint4*)(kb_ + 32 * FA_KROW) = k1; *(uint4*)(kb_ + 64 * FA_KROW) = k2; *(uint4*)(kb_ + 96 * FA_KROW) = k3; \
                        char* vb_ = (BUF) + 18432 + (tid >> 3) * FA_VROW + (tid & 7) * 16; \
                        *(uint2*)vb_ = make_uint2(v0.x, v0.y); *(uint2*)(vb_ + 8) = make_uint2(v0.z, v0.w); \
                        *(uint2*)(vb_ + 32 * FA_VROW) = make_uint2(v1.x, v1.y); *(uint2*)(vb_ + 32 * FA_VROW + 8) = make_uint2(v1.z, v1.w); \
                        *(uint2*)(vb_ + 64 * FA_VROW) = make_uint2(v2.x, v2.y); *(uint2*)(vb_ + 64 * FA_VROW + 8) = make_uint2(v2.z, v2.w); \
                        *(uint2*)(vb_ + 96 * FA_VROW) = make_uint2(v3.x, v3.y); *(uint2*)(vb_ + 96 * FA_VROW + 8) = make_uint2(v3.z, v3.w); }
    f32x16 o[4];
#pragma unroll
    for (int db = 0; db < 4; ++db)
#pragma unroll
        for (int i = 0; i < 16; ++i) o[db][i] = 0.f;
    float m = -1e30f, l = 0.f;
    DA_LOAD(0)
    __syncthreads();
    DA_STORE(smem)
    __syncthreads();
    for (int t = 0; t < ntile; ++t) {
        char* cur = smem + (t & 1) * DA_BUFB;
        char* nxt = smem + ((t + 1) & 1) * DA_BUFB;
        if (t + 1 < ntile) DA_LOAD((t + 1) * 64)
        flash_tile<4, false>(qf, o, m, l, cur + mp * 9216, cur + 18432, lane, 0, 0);
        if (t + 1 < ntile) DA_STORE(nxt)
        __syncthreads();
    }
#undef DA_LOAD
#undef DA_STORE
    const float inv = 1.f / (l + __shfl_xor(l, 32));
#pragma unroll
    for (int db = 0; db < 4; ++db) o[db] = o[db] * inv;
    float* X = (float*)smem + qg * 4096;
    if (mp == 1) {
#pragma unroll
        for (int db = 0; db < 4; ++db)
#pragma unroll
            for (int r = 0; r < 16; ++r) X[(db * 32 + (r & 3) + 8 * (r >> 2) + 4 * hh) * 32 + jq] = o[db][r];
    }
    __syncthreads();
    if (mp == 0) {
        const float lam_init = 0.8f - 0.6f * expf(-0.3f * (float)L);
        const float* lp = p.ev_da_lam + (size_t)j * 256;
        float a0 = lp[lane] * lp[64 + lane], a1 = lp[128 + lane] * lp[192 + lane];
        a0 = wave_sum(a0); a1 = wave_sum(a1);
        const float lam = expf(a0) - expf(a1) + lam_init;
        float ss = 0.f;
#pragma unroll
        for (int db = 0; db < 4; ++db)
#pragma unroll
            for (int r = 0; r < 16; ++r) { const float v = o[db][r] - lam * X[(db * 32 + (r & 3) + 8 * (r >> 2) + 4 * hh) * 32 + jq]; o[db][r] = v; ss += v * v; }
        ss += __shfl_xor(ss, 32);
        const float sc = rsqrtf(ss * (1.f / 128.f) + 1e-6f) * (1.f - lam_init);
        const int row = lat ? b * 2048 + qi : NL + b * 256 + qi;
        bf16_t* mrow = p.MIX + (size_t)row * DM + 512 + h * 128;
        const float* g = p.ev_da_g + (size_t)j * 512 + h * 128;
#pragma unroll
        for (int db = 0; db < 4; ++db)
#pragma unroll
            for (int r4 = 0; r4 < 4; ++r4) {
                const int d = db * 32 + 8 * r4 + 4 * hh;
                const f32x4 gg = *(const f32x4*)(g + d);
                *(uint2*)(mrow + d) = make_uint2(cvt_pk_bf16(o[db][r4 * 4 + 0] * sc * gg[0], o[db][r4 * 4 + 1] * sc * gg[1]), cvt_pk_bf16(o[db][r4 * 4 + 2] * sc * gg[2], o[db][r4 * 4 + 3] * sc * gg[3]));
            }
    }
    __syncthreads();
}

#define WA_BUFB 17920
__device__ void wa_block(const P& p, int item, int j, char* smem) {
    const int tid = otid(), lane = tid & 63, wid = tid >> 6, jq = lane & 31, hh = lane >> 5;
    const bool lat = item < 2048;
    int b, nb, hq;
    if (lat) { hq = item & 15; nb = (item >> 4) & 15; b = item >> 8; } else { const int it = item - 2048; hq = it & 15; nb = (it >> 4) & 1; b = it >> 5; }
    const int hkv = hq >> 2;
    const int qi = nb * 128 + wid * 32 + jq;
    const bf16_t* qp = lat ? p.AQL + ((size_t)(b * 16 + hq) * 2048 + qi) * 64 : p.AQC + ((size_t)(b * 16 + hq) * 256 + qi) * 64;
    bf16x8 qf[4];
#pragma unroll
    for (int ks = 0; ks < 4; ++ks) qf[ks] = *(const bf16x8*)(qp + (2 * ks + hh) * 8);
    const int lfirst = (nb == 0) ? 2 : 0, nloc = lat ? 6 - lfirst - ((nb == 15) ? 2 : 0) : 0;
    const int ntile = 4 + nloc;
    const bf16_t* kg = p.AK + (size_t)(b * 4 + hkv) * 2304 * 64 + (size_t)(tid >> 3) * 64 + (tid & 7) * 8;
    const bf16_t* vg = p.AV + (size_t)(b * 4 + hkv) * 64 * 2304 + (size_t)(tid >> 3) * 2304 + (tid & 7) * 8;
    uint4 k0, k1, v0, v1;
#define WA_KEY0(T) ((T) < 4 ? (T) * 64 : 256 + (nb - 1) * 128 + ((T) - 4 + lfirst) * 64)
#define WA_LOAD(KEY0) { k0 = *(const uint4*)(kg + (size_t)(KEY0) * 64); k1 = *(const uint4*)(kg + (size_t)((KEY0) + 32) * 64); v0 = *(const uint4*)(vg + (KEY0)); v1 = *(const uint4*)(vg + (size_t)32 * 2304 + (KEY0)); }
#define WA_STORE(BUF) { char* kb_ = (BUF) + (tid >> 3) * FA_KROW + (tid & 7) * 16; *(uint4*)kb_ = k0; *(uint4*)(kb_ + 32 * FA_KROW) = k1; \
                        char* vb_ = (BUF) + 9216 + (tid >> 3) * FA_VROW + (tid & 7) * 16; \
                        *(uint2*)vb_ = make_uint2(v0.x, v0.y); *(uint2*)(vb_ + 8) = make_uint2(v0.z, v0.w); \
                        *(uint2*)(vb_ + 32 * FA_VROW) = make_uint2(v1.x, v1.y); *(uint2*)(vb_ + 32 * FA_VROW + 8) = make_uint2(v1.z, v1.w); }
    f32x16 o[2];
#pragma unroll
    for (int db = 0; db < 2; ++db)
#pragma unroll
        for (int i = 0; i < 16; ++i) o[db][i] = 0.f;
    float m = p.od_sink[j * 16 + hq] * 1.4426950408889634f, l = hh == 0 ? 1.f : 0.f;
    { const int key0 = WA_KEY0(0); WA_LOAD(key0) }
    __syncthreads();
    WA_STORE(smem)
    __syncthreads();
    for (int t = 0; t < ntile; ++t) {
        char* cur = smem + (t & 1) * WA_BUFB;
        char* nxt = smem + ((t + 1) & 1) * WA_BUFB;
        if (t + 1 < ntile) { const int key0 = WA_KEY0(t + 1); WA_LOAD(key0) }
        if (t < 4) flash_tile<2, false>(qf, o, m, l, cur, cur + 9216, lane, 0, 0);
        else flash_tile<2, true>(qf, o, m, l, cur, cur + 9216, lane, qi, WA_KEY0(t) - 256);
        if (t + 1 < ntile) WA_STORE(nxt)
        __syncthreads();
    }
#undef WA_LOAD
#undef WA_STORE
#undef WA_KEY0
    const float inv = 1.f / (l + __shfl_xor(l, 32));
    const int row = lat ? b * 2048 + qi : NL + b * 256 + qi;
    bf16_t* mrow = p.MIX + (size_t)row * DM + hq * 64;
#pragma unroll
    for (int db = 0; db < 2; ++db)
#pragma unroll
        for (int r4 = 0; r4 < 4; ++r4) {
            const int d = db * 32 + 8 * r4 + 4 * hh;
            *(uint2*)(mrow + d) = make_uint2(cvt_pk_bf16(o[db][r4 * 4 + 0] * inv, o[db][r4 * 4 + 1] * inv), cvt_pk_bf16(o[db][r4 * 4 + 2] * inv, o[db][r4 * 4 + 3] * inv));
        }
}

#define ML_LD 68
__device__ void mlstm_chunk_item(const P& p, int item, int j, float* smem) {
    const int vs = item & 3, dir = (item >> 2) & 1, h = (item >> 3) & 3, b = item >> 5;
    const int tid = otid(), lane = tid & 63;
    float* sq = smem;
    float* sk = sq + 64 * ML_LD;
    float* sv = sk + 64 * ML_LD;
    float* sP = sv + 64 * 32;
    float* sCT = sP + 64 * 65;
    float* sn = sCT + 64 * 36;
    float* sa = sn + 64;
    float* sb = sa + 64;
    float* sg = sb + 64;
    float* swk = sg + 64;
    int* srow = (int*)(swk + 64);
    float* ssc = (float*)(srow + 64);
    const float gbi = p.ev_gate_b[j * 16 + (dir * 2) * 4 + h], gbf = p.ev_gate_b[j * 16 + (dir * 2 + 1) * 4 + h];
    float* hm = p.HM + (size_t)dir * NT * 512;
    __syncthreads();
    for (int i = tid; i < 64 * 36; i += 256) sCT[i] = 0.f;
    if (tid < 64) sn[tid] = 0.f;
    float m_st = 0.f;
    for (int c = 0; c < 36; ++c) {
        __syncthreads();
        if (tid < 64) {
            const int st = c * 64 + tid; int row;
            if (st < 256) row = NL + b * 256 + (dir ? 255 - st : st);
            else { const int t = st - 256; row = b * 2048 + (dir ? 2047 - t : t); }
            srow[tid] = row;
            const float ig = p.GT[(size_t)row * 16 + (dir * 2) * 4 + h] + gbi;
            const float lf = log_sigmoid_f(p.GT[(size_t)row * 16 + (dir * 2 + 1) * 4 + h] + gbf);
            float bc = lf;
#pragma unroll
            for (int o = 1; o < 64; o <<= 1) { const float t2 = __shfl_up(bc, o); if (lane >= o) bc += t2; }
            const float a = ig - bc;
            float mxa = a;
#pragma unroll
            for (int o = 1; o < 64; o <<= 1) { const float t2 = __shfl_up(mxa, o); if (lane >= o) mxa = fmaxf(mxa, t2); }
            const float g = fmaxf(m_st, mxa);
            const float g63 = __shfl(g, 63), b63 = __shfl(bc, 63);
            sa[tid] = a; sb[tid] = bc; sg[tid] = g; swk[tid] = expf(a - g63);
            if (tid == 0) { ssc[0] = m_st; ssc[1] = expf(m_st - g63); ssc[2] = b63 + g63; }
        }
        __syncthreads();
#pragma unroll
        for (int i = 0; i < 4; ++i) {
            const int e = tid + 256 * i, t = e >> 4, c4 = (e & 15) * 4; const int row = srow[t];
            *(float4*)(sq + t * ML_LD + c4) = *(const float4*)(p.QKC + (size_t)row * 512 + h * 64 + c4);
            *(float4*)(sk + t * ML_LD + c4) = *(const float4*)(p.QKC + (size_t)row * 512 + 256 + h * 64 + c4);
        }
        {
            const int t = tid >> 2, c8 = (tid & 3) * 8; const int row = srow[t];
            const uint4 u = *(const uint4*)(p.PB + (size_t)row * 1536 + 512 + h * 128 + vs * 32 + c8);
            float* d = sv + t * 32 + c8;
            d[0] = bf_lo(u.x); d[1] = bf_hi(u.x); d[2] = bf_lo(u.y); d[3] = bf_hi(u.y); d[4] = bf_lo(u.z); d[5] = bf_hi(u.z); d[6] = bf_lo(u.w); d[7] = bf_hi(u.w);
        }
        __syncthreads();
        const float mst = ssc[0], decay = ssc[1];
        {
            const int t = tid >> 2, sq4 = tid & 3;
            float acc[16];
#pragma unroll
            for (int i = 0; i < 16; ++i) acc[i] = 0.f;
            for (int d4 = 0; d4 < 16; ++d4) {
                const float4 qv = *(const float4*)(sq + t * ML_LD + d4 * 4);
#pragma unroll
                for (int i = 0; i < 16; ++i) {
                    const float4 kv = *(const float4*)(sk + (sq4 + 4 * i) * ML_LD + d4 * 4);
                    acc[i] += qv.x * kv.x + qv.y * kv.y + qv.z * kv.z + qv.w * kv.w;
                }
            }
            const float gt = sg[t];
#pragma unroll
            for (int i = 0; i < 16; ++i) { const int s2 = sq4 + 4 * i; sP[t * 65 + s2] = (s2 <= t) ? acc[i] * expf(sa[s2] - gt) : 0.f; }
        }
        __syncthreads();
        {
            const int t = tid >> 2, vq = tid & 3;
            float num[8], cq[8];
#pragma unroll
            for (int i = 0; i < 8; ++i) { num[i] = 0.f; cq[i] = 0.f; }
            float psum = 0.f, nq = 0.f;
            for (int s2 = 0; s2 < 64; ++s2) {
                const float pv = sP[t * 65 + s2];
                const float4 v0 = *(const float4*)(sv + s2 * 32 + vq * 8), v1 = *(const float4*)(sv + s2 * 32 + vq * 8 + 4);
                num[0] += pv * v0.x; num[1] += pv * v0.y; num[2] += pv * v0.z; num[3] += pv * v0.w;
                num[4] += pv * v1.x; num[5] += pv * v1.y; num[6] += pv * v1.z; num[7] += pv * v1.w;
                const float qd = sq[t * ML_LD + s2];
                const float4 c0 = *(const float4*)(sCT + s2 * 36 + vq * 8), c1 = *(const float4*)(sCT + s2 * 36 + vq * 8 + 4);
                cq[0] += qd * c0.x; cq[1] += qd * c0.y; cq[2] += qd * c0.z; cq[3] += qd * c0.w;
                cq[4] += qd * c1.x; cq[5] += qd * c1.y; cq[6] += qd * c1.z; cq[7] += qd * c1.w;
                if ((s2 >> 4) == vq) { psum += pv; nq += sn[s2] * qd; }
            }
            psum += __shfl_xor(psum, 1); psum += __shfl_xor(psum, 2);
            nq += __shfl_xor(nq, 1); nq += __shfl_xor(nq, 2);
            const float gt = sg[t], wint = expf(mst - gt);
            const float den = psum + wint * nq;
            const float sc = 1.f / fmaxf(fabsf(den), expf(-(sb[t] + gt)));
            float* op = hm + (size_t)srow[t] * 512 + h * 128 + vs * 32 + vq * 8;
            *(float4*)op = make_float4((num[0] + wint * cq[0]) * sc, (num[1] + wint * cq[1]) * sc, (num[2] + wint * cq[2]) * sc, (num[3] + wint * cq[3]) * sc);
            *(float4*)(op + 4) = make_float4((num[4] + wint * cq[4]) * sc, (num[5] + wint * cq[5]) * sc, (num[6] + wint * cq[6]) * sc, (num[7] + wint * cq[7]) * sc);
        }
        __syncthreads();
        {
            const int d = tid >> 2, vq = tid & 3;
            float cn[8];
            const float4 c0 = *(const float4*)(sCT + d * 36 + vq * 8), c1 = *(const float4*)(sCT + d * 36 + vq * 8 + 4);
            cn[0] = decay * c0.x; cn[1] = decay * c0.y; cn[2] = decay * c0.z; cn[3] = decay * c0.w;
            cn[4] = decay * c1.x; cn[5] = decay * c1.y; cn[6] = decay * c1.z; cn[7] = decay * c1.w;
            float nn = decay * sn[d];
            for (int s2 = 0; s2 < 64; ++s2) {
                const float kd = swk[s2] * sk[s2 * ML_LD + d];
                const float4 v0 = *(const float4*)(sv + s2 * 32 + vq * 8), v1 = *(const float4*)(sv + s2 * 32 + vq * 8 + 4);
                cn[0] += kd * v0.x; cn[1] += kd * v0.y; cn[2] += kd * v0.z; cn[3] += kd * v0.w;
                cn[4] += kd * v1.x; cn[5] += kd * v1.y; cn[6] += kd * v1.z; cn[7] += kd * v1.w;
                nn += kd;
            }
            *(float4*)(sCT + d * 36 + vq * 8) = make_float4(cn[0], cn[1], cn[2], cn[3]);
            *(float4*)(sCT + d * 36 + vq * 8 + 4) = make_float4(cn[4], cn[5], cn[6], cn[7]);
            if (vq == 0) sn[d] = nn;
        }
        m_st = ssc[2];
    }
    __syncthreads();
}

__device__ void ph_attn_even(const P& p, int L, int j, float* smem) {
    int* s_item = (int*)((char*)smem + 73728);
    for (;;) {
        __syncthreads();
        if (otid() == 0) *s_item = atomicAdd(&p.ctr[L], 1);
        __syncthreads();
        const int item = *s_item;
        if (item >= 256 + 1152) break;
        if (item < 256) mlstm_chunk_item(p, item, j, smem); else da_block(p, item - 256, L, j, (char*)smem);
    }
}
__device__ void ph_attn_odd(const P& p, int j, bool need_ctx, float* smem) {
    const int nitem = need_ctx ? 2304 : 2048;
    for (int item = blockIdx.x; item < nitem; item += gridDim.x) { wa_block(p, item, j, (char*)smem); __syncthreads(); }
}

__device__ void ph_mixout_even(const P& p, int L, int j) {
    const int lane = otid() & 63, wid = otid() >> 6;
    for (int w = blockIdx.x * 4 + wid; w < NT * 4; w += gridDim.x * 4) {
        const int r = w >> 2, hh = w & 3;
        const int c = hh * 128 + lane * 2;
        const float2 f = *(const float2*)(p.HM + (size_t)r * 512 + c), bk = *(const float2*)(p.HM + (size_t)NT * 512 + (size_t)r * 512 + c);
        const float v0 = f.x + bk.x, v1 = f.y + bk.y;
        const float ss = wave_sum(v0 * v0 + v1 * v1);
        const float rstd = rsqrtf(ss * (1.f / 128.f) + 1e-6f);
        const float2 g = *(const float2*)(p.ev_ml_g + (size_t)j * 512 + c);
        const unsigned ou = *(const unsigned*)(p.PB + (size_t)r * 1536 + 1024 + c);
        *(unsigned*)(p.MIX + (size_t)r * DM + c) = cvt_pk_bf16(v0 * rstd * g.x * sigmoid_f(bf_lo(ou)), v1 * rstd * g.y * sigmoid_f(bf_hi(ou)));
    }
}

__device__ __forceinline__ float wave_max(float v) {
#pragma unroll
    for (int o = 32; o > 0; o >>= 1) v = fmaxf(v, __shfl_xor(v, o));
    return v;
}
#define SEL_LD 132
__device__ void ph_peer_select(const P& p, int L, int nrows, char* smem) {
    float* S = (float*)smem;
    const int tid = otid(), lane = tid & 63, wid = tid >> 6, fr = lane & 15, fq = lane >> 4;
    const bf16_t* KBL = p.KB + (size_t)L * 8 * 2 * 128 * 128;
    int ci = 0, cj = 0; bool cvalid = false;
    {
        int base = 0;
#pragma unroll
        for (int ii = 0; ii < 16; ++ii) { const int c = 16 / (ii + 1); if (lane >= base && lane < base + c) { ci = ii; cj = lane - base; cvalid = true; } base += c; }
    }
    const int ntile = nrows / 32;
    for (int item = blockIdx.x; item < ntile * 8; item += gridDim.x) {
        const int h = item & 7, t0 = (item >> 3) * 32;
        __syncthreads();
        {
            const int pp = wid >> 1, th = wid & 1;
            const bf16_t* qp = p.QB + (size_t)(t0 + th * 16 + fr) * 2048 + h * 256 + pp * 128 + fq * 8;
            bf16x8 qf[4];
#pragma unroll
            for (int ks = 0; ks < 4; ++ks) qf[ks] = *(const bf16x8*)(qp + ks * 32);
            const bf16_t* kp = KBL + ((size_t)(h * 2 + pp) * 128 + fr) * 128 + fq * 8;
#pragma unroll
            for (int ni = 0; ni < 8; ++ni) {
                f32x4 acc = (f32x4){0.f, 0.f, 0.f, 0.f};
#pragma unroll
                for (int ks = 0; ks < 4; ++ks) {
                    const bf16x8 kf = *(const bf16x8*)(kp + (size_t)ni * 16 * 128 + ks * 32);
                    acc = __builtin_amdgcn_mfma_f32_16x16x32_bf16(qf[ks], kf, acc, 0, 0, 0);
                }
#pragma unroll
                for (int j = 0; j < 4; ++j) S[(pp * 32 + th * 16 + fq * 4 + j) * SEL_LD + ni * 16 + fr] = acc[j];
            }
        }
        __syncthreads();
        for (int tt = 0; tt < 8; ++tt) {
            const int t = wid * 8 + tt, r = t0 + t;
            float v00 = S[t * SEL_LD + lane], v01 = S[t * SEL_LD + 64 + lane], v10 = S[(32 + t) * SEL_LD + lane], v11 = S[(32 + t) * SEL_LD + 64 + lane];
            float sv0 = 0.f, sv1 = 0.f; int si0 = 0, si1 = 0;
            for (int rd = 0; rd < 16; ++rd) {
                {
                    const float m = wave_max(fmaxf(v00, v01));
                    unsigned long long b = __ballot(v00 == m); int idx;
                    if (b) { idx = __ffsll((long long)b) - 1; if (lane == idx) v00 = -INFINITY; }
                    else { b = __ballot(v01 == m); idx = __ffsll((long long)b) - 1; if (lane == idx) v01 = -INFINITY; idx += 64; }
                    if (lane == rd) { sv0 = m; si0 = idx; }
                }
                {
                    const float m = wave_max(fmaxf(v10, v11));
                    unsigned long long b = __ballot(v10 == m); int idx;
                    if (b) { idx = __ffsll((long long)b) - 1; if (lane == idx) v10 = -INFINITY; }
                    else { b = __ballot(v11 == m); idx = __ffsll((long long)b) - 1; if (lane == idx) v11 = -INFINITY; idx += 64; }
                    if (lane == rd) { sv1 = m; si1 = idx; }
                }
            }
            float cand = __shfl(sv0, ci) + __shfl(sv1, cj);
            const int cidx = __shfl(si0, ci) * 128 + __shfl(si1, cj);
            if (!cvalid) cand = -INFINITY;
            float cs = -INFINITY; int ce = 0;
            for (int rd = 0; rd < 16; ++rd) {
                const float m = wave_max(cand);
                const unsigned long long b = __ballot(cand == m);
                const int idx = __ffsll((long long)b) - 1;
                const int e = __builtin_amdgcn_readlane(cidx, idx);
                if (lane == idx) cand = -INFINITY;
                if (lane == rd) { cs = m; ce = e; }
            }
            const float mx = __int_as_float(__builtin_amdgcn_readlane(__float_as_int(cs), 0));
            const float ex = lane < 16 ? expf(cs - mx) : 0.f;
            const float sum = wave_sum(ex);
            if (lane < 16) { p.GATE[(size_t)r * 128 + h * 16 + lane] = ex / sum; p.EIDX[(size_t)r * 128 + h * 16 + lane] = ce; }
        }
    }
}

__device__ __forceinline__ void unpack8(const uint4 u, float* f) {
    f[0] = bf_lo(u.x); f[1] = bf_hi(u.x); f[2] = bf_lo(u.y); f[3] = bf_hi(u.y); f[4] = bf_lo(u.z); f[5] = bf_hi(u.z); f[6] = bf_lo(u.w); f[7] = bf_hi(u.w);
}
__device__ void ph_peer_gather(const P& p, int L, int nrows) {
    const int lane = otid() & 63, wid = otid() >> 6;
    const bf16_t* U = p.UB + (size_t)L * 16384 * 1024; const bf16_t* V = p.VB + (size_t)L * 16384 * 1024;
    const float* gate2 = p.modv + (size_t)L * 9 * 6144 + 5120;
    for (int r = blockIdx.x * 4 + wid; r < nrows; r += gridDim.x * 4) {
        const int e0 = p.EIDX[(size_t)r * 128 + lane], e1 = p.EIDX[(size_t)r * 128 + 64 + lane];
        const float g0 = p.GATE[(size_t)r * 128 + lane], g1 = p.GATE[(size_t)r * 128 + 64 + lane];
        float x[16];
        { const uint4 xa = *(const uint4*)(p.XN + (size_t)r * DM + lane * 8), xb = *(const uint4*)(p.XN + (size_t)r * DM + 512 + lane * 8); unpack8(xa, x); unpack8(xb, x + 8); }
        float a0 = 0.f, a1 = 0.f;
#pragma unroll
        for (int half = 0; half < 2; ++half) {
            const int ev = half ? e1 : e0;
            float av = 0.f;
            for (int kb = 0; kb < 8; ++kb) {
                uint4 ua[8], ub[8];
#pragma unroll
                for (int j = 0; j < 8; ++j) {
                    const int idx = __builtin_amdgcn_readlane(ev, kb * 8 + j);
                    const bf16_t* rp = U + (size_t)idx * 1024 + lane * 8;
                    ua[j] = *(const uint4*)rp; ub[j] = *(const uint4*)(rp + 512);
                }
#pragma unroll
                for (int j = 0; j < 8; ++j) {
                    float f[16]; unpack8(ua[j], f); unpack8(ub[j], f + 8);
                    float s = 0.f;
#pragma unroll
                    for (int c = 0; c < 16; ++c) s += x[c] * f[c];
                    s = wave_sum(s);
                    if (lane == kb * 8 + j) av = s;
                }
            }
            if (half) a1 = av; else a0 = av;
        }
        const float w0 = g0 * 0.5f * a0 * (1.f + erff(a0 * 0.70710678118654752f));
        const float w1 = g1 * 0.5f * a1 * (1.f + erff(a1 * 0.70710678118654752f));
        float acc[16];
#pragma unroll
        for (int c = 0; c < 16; ++c) acc[c] = 0.f;
#pragma unroll
        for (int half = 0; half < 2; ++half) {
            const int ev = half ? e1 : e0; const int wv = __float_as_int(half ? w1 : w0);
            for (int kb = 0; kb < 8; ++kb) {
                uint4 ua[8], ub[8];
#pragma unroll
                for (int j = 0; j < 8; ++j) {
                    const int idx = __builtin_amdgcn_readlane(ev, kb * 8 + j);
                    const bf16_t* rp = V + (size_t)idx * 1024 + lane * 8;
                    ua[j] = *(const uint4*)rp; ub[j] = *(const uint4*)(rp + 512);
                }
#pragma unroll
                for (int j = 0; j < 8; ++j) {
                    const float wj = __int_as_float(__builtin_amdgcn_readlane(wv, kb * 8 + j));
                    float f[16]; unpack8(ua[j], f); unpack8(ub[j], f + 8);
#pragma unroll
                    for (int c = 0; c < 16; ++c) acc[c] += wj * f[c];
                }
            }
        }
        const float* gp = gate2 + (size_t)modrow(r) * 6144;
        float* hp = p.H + (size_t)r * DM;
#pragma unroll
        for (int q = 0; q < 4; ++q) {
            const int c = (q >> 1) * 512 + lane * 8 + (q & 1) * 4;
            const float4 g = *(const float4*)(gp + c);
            float4 hv = *(float4*)(hp + c);
            hv.x += g.x * acc[q * 4 + 0]; hv.y += g.y * acc[q * 4 + 1]; hv.z += g.z * acc[q * 4 + 2]; hv.w += g.w * acc[q * 4 + 3];
            *(float4*)(hp + c) = hv;
        }
    }
}

__device__ void run_phase(const P& p, int ph, float* smem) {
    if (ph == 0) { ph_prologue(p, smem); return; }
    if (ph == NPH - 1) { ph_final(p); return; }
    const int L = (ph - 1) / 10, s = (ph - 1) % 10, j = L >> 1;
    const bool even = (L & 1) == 0, need_ctx = L < 3;
    const int nrows = need_ctx ? NT : NL;
    const float* mv = p.modv + (size_t)L * 9 * 6144;
    switch (s) {
    case 0: ph_normmod(p.H, p.norm1_g + L * DM, mv, 0, 1024, p.XN, NT); break;
    case 1:
        if (even) ph_gemm(p.XN, p.WT + WT_EVIN(j), NT, 3200, EpiEven{p.PB, p.AQL, p.AQC, p.AK, p.AV, p.GT, p.rope}, (char*)smem);
        else ph_gemm(p.XN, p.WT + WT_ODIN(j), NT, ODW, EpiOdd{p.AQL, p.AQC, p.AK, p.AV, p.rope}, (char*)smem);
        break;
    case 2: if (even) ph_prep_even(p, j); break;
    case 3: if (even) ph_attn_even(p, L, j, smem); else ph_attn_odd(p, j, need_ctx, smem); break;
    case 4: if (even) ph_mixout_even(p, L, j); break;
    case 5:
        ph_gemm(p.MIX, p.WT + (even ? WT_EVOUT(j) : WT_ODOUT(j)), nrows, DM, EpiResid{p.H, mv + 2048}, (char*)smem);
        break;
    case 6: ph_normmod(p.H, p.norm2_g + L * DM, mv, 3072, 4096, p.XN, nrows); break;
    case 7: ph_gemm(p.XN, p.WT + WT_PQ(L), nrows, 2048, EpiStoreBF16{p.QB, 2048}, (char*)smem); break;
    case 8: ph_peer_select(p, L, nrows, (char*)smem); break;
    case 9: ph_peer_gather(p, L, nrows); break;
    }
}


#define XB_TMO      128
#define XB_XCNT(j)  (256  + 64 * (j))
#define XB_XSUB(j)  (1280 + 64 * (j))
#define XB_XGEN(j)  (2304 + 64 * (j))
#define XB_TOP      3328
#define XB_TOPGEN   3392
#define XCD_BAR_WORDS 3456
#define XB_SPIN_CAP (1u << 20)
#define LAS __attribute__((address_space(3)))
__device__ __forceinline__ unsigned xb_ld(unsigned* p)              { return __hip_atomic_load(p, __ATOMIC_RELAXED, __HIP_MEMORY_SCOPE_AGENT); }
__device__ __forceinline__ unsigned xb_add(unsigned* p, unsigned v) { return __hip_atomic_fetch_add(p, v, __ATOMIC_RELAXED, __HIP_MEMORY_SCOPE_AGENT); }
__device__ __forceinline__ unsigned xb_xcc_id() { return (unsigned)__builtin_amdgcn_s_getreg((3 << 11) | 20) & 0xFu; }
#define XB_SPIN(cond, bar) do { unsigned _sp = 0; while (cond) { __builtin_amdgcn_s_sleep(1); \
    if ((++_sp & 255u) == 0u) { if (xb_ld(&(bar)[XB_TMO])) break; if (_sp > XB_SPIN_CAP) { atomicAdd(&(bar)[XB_TMO], 1u); break; } } } } while (0)
struct XcdBarrier { unsigned* bar; unsigned x; volatile LAS unsigned* st; };
__device__ __forceinline__ XcdBarrier xcd_barrier_post(unsigned* bar, volatile LAS unsigned* st) {
    XcdBarrier b; b.bar = bar; b.x = xb_xcc_id(); b.st = st;
    if (threadIdx.x == 0) (void)xb_add(&bar[XB_XCNT(b.x)], 1u);
    return b;
}
__device__ __forceinline__ void xcd_barrier_complete(unsigned* bar, unsigned x, unsigned& nloc, unsigned& nx) {
    const unsigned G = gridDim.x * gridDim.y * gridDim.z;
    unsigned sum, cnt, mine, sp = 0u;
    for (;;) {
        sum = 0u; cnt = 0u; mine = 0u;
#pragma unroll
        for (unsigned j = 0; j < 16; ++j) { const unsigned c = xb_ld(&bar[XB_XCNT(j)]); sum += c; cnt += (c > 0u) ? 1u : 0u; mine = (j == x) ? c : mine; }
        if (sum == G) break;
        __builtin_amdgcn_s_sleep(1);
        if ((++sp & 255u) == 0u) { if (xb_ld(&bar[XB_TMO])) break; if (sp > XB_SPIN_CAP) { atomicAdd(&bar[XB_TMO], 1u); break; } }
    }
    nloc = mine > 0u ? mine : 1u; nx = cnt > 0u ? cnt : 1u;
}
__device__ __forceinline__ void xcd_barrier(const XcdBarrier& b) {
    asm volatile("s_waitcnt vmcnt(0)" ::: "memory");
    __syncthreads();
    if (threadIdx.x == 0) {
        unsigned* bar = b.bar;
        __builtin_amdgcn_s_waitcnt(0);
        unsigned nloc = b.st[0], nx = b.st[1];
        if (nloc == 0u) { xcd_barrier_complete(bar, b.x, nloc, nx); b.st[0] = nloc; b.st[1] = nx; }
        const unsigned old = xb_add(&bar[XB_XSUB(b.x)], 1u);
        const unsigned gen = old / nloc;
        if (old + 1u == (gen + 1u) * nloc) {
            __builtin_amdgcn_fence(__ATOMIC_RELEASE, "agent");
            asm volatile("s_waitcnt vmcnt(0)" ::: "memory");
            const unsigned og = xb_add(&bar[XB_TOP], 1u);
            const unsigned tg = og / nx;
            if (og + 1u == (tg + 1u) * nx) xb_add(&bar[XB_TOPGEN], 1u);
            else XB_SPIN(xb_ld(&bar[XB_TOPGEN]) == tg, bar);
            __builtin_amdgcn_fence(__ATOMIC_ACQUIRE, "agent");
            xb_add(&bar[XB_XGEN(b.x)], 1u);
            asm volatile("s_waitcnt vmcnt(0)" ::: "memory");
        } else {
            XB_SPIN(xb_ld(&bar[XB_XGEN(b.x)]) == gen, bar);
            __builtin_amdgcn_fence(__ATOMIC_ACQUIRE, "agent");
            asm volatile("s_waitcnt vmcnt(0)" ::: "memory");
        }
    }
    __syncthreads();
}

__global__ void __launch_bounds__(256, 2) mega(P p) {
    extern __shared__ __attribute__((aligned(16))) float smem[];
    cg::grid_group grid = cg::this_grid();
    volatile LAS unsigned* st = (volatile LAS unsigned*)((char*)smem + 73744);
    if (threadIdx.x < 4) st[threadIdx.x] = 0u;
    __syncthreads();
    XcdBarrier xb = xcd_barrier_post(p.bar, st);
    for (int ph = p.ph_lo; ph < p.ph_hi; ++ph) {
        run_phase(p, ph, smem);
        if (ph + 1 < p.ph_hi) { if (ph == 0) grid.sync(); else xcd_barrier(xb); }
    }
}

extern "C" void kernel_launch(void* const* d_in, const int* in_sizes, int n_in, void* d_out, int out_size, void* d_ws, size_t ws_size, hipStream_t stream) {
    static int grid_blocks = 0;
    if (!grid_blocks) {
        int dev = 0, cus = 0, per_cu = 0;
        hipGetDevice(&dev);
        hipDeviceGetAttribute(&cus, hipDeviceAttributeMultiprocessorCount, dev);
        hipFuncSetAttribute((const void*)mega, hipFuncAttributeMaxDynamicSharedMemorySize, LDS_BYTES);
        hipOccupancyMaxActiveBlocksPerMultiprocessor(&per_cu, mega, 256, LDS_BYTES);
        if (per_cu < 1) per_cu = 1;
        if (per_cu > 2) per_cu = 2;
        grid_blocks = cus * per_cu;
    }
    P p{};
    const float** ins = (const float**)&p;
    for (int i = 0; i < 24; ++i) ins[i] = (const float*)d_in[i];
    p.out = (float*)d_out;
    size_t off = 0; char* ws = (char*)d_ws;
    auto carve = [&](size_t bytes) { void* r = ws + off; off += (bytes + 255) & ~(size_t)255; return r; };
    p.modv = (float*)carve((size_t)4 * 9 * 6144 * 4);
    p.rope = (float*)carve((size_t)2048 * 64 * 4);
    p.H = (float*)carve((size_t)NT * DM * 4);
    p.XN = (bf16_t*)carve((size_t)NT * DM * 2);
    p.WT = (bf16_t*)carve(WT_TOTAL * 2);
    p.MIX = (bf16_t*)carve((size_t)NT * DM * 2);
    p.PB = (bf16_t*)carve((size_t)NT * 1536 * 2);
    p.GT = (float*)carve((size_t)NT * 16 * 4);
    p.AQL = (bf16_t*)carve((size_t)8 * 16 * 2048 * 64 * 2);
    p.AQC = (bf16_t*)carve((size_t)8 * 16 * 256 * 64 * 2);
    p.AK = (bf16_t*)carve((size_t)8 * 4 * 2 * 2304 * 64 * 2);
    p.AV = (bf16_t*)carve((size_t)8 * 4 * 128 * 2304 * 2);
    p.QKC = (float*)carve((size_t)NT * 512 * 4);
    p.HM = (float*)carve((size_t)2 * NT * 512 * 4);
    p.QB = (bf16_t*)carve((size_t)NT * 2048 * 2);
    p.GATE = (float*)carve((size_t)NT * 128 * 4);
    p.EIDX = (int*)carve((size_t)NT * 128 * 4);
    p.ctr = (int*)carve(256);
    p.bar = (unsigned*)carve((size_t)XCD_BAR_WORDS * 4);
    p.UB = (bf16_t*)carve((size_t)4 * 16384 * 1024 * 2);
    p.VB = (bf16_t*)carve((size_t)4 * 16384 * 1024 * 2);
    p.KB = (bf16_t*)carve((size_t)4 * 8 * 2 * 128 * 128 * 2);
    if (off > ws_size) { fprintf(stderr, "kernel_launch: workspace too small: need %zu have %zu\n", off, ws_size); return; }
    hipMemsetAsync(p.bar, 0, (size_t)XCD_BAR_WORDS * 4, stream);
#if ONE_LAUNCH
    p.ph_lo = 0; p.ph_hi = NPH;
    void* args[] = {&p};
    hipError_t e = hipLaunchCooperativeKernel((void*)mega, dim3(grid_blocks), dim3(256), args, LDS_BYTES, stream);
    if (e != hipSuccess) fprintf(stderr, "cooperative launch failed: %s (grid %d)\n", hipGetErrorString(e), grid_blocks);
#else
    for (int ph = 0; ph < NPH; ++ph) {
        if (ph > 0 && ph < NPH - 1) { const int L = (ph - 1) / 10, s = (ph - 1) % 10; if ((s == 4 || s == 2) && (L & 1)) continue; }
        p.ph_lo = ph; p.ph_hi = ph + 1;
        hipLaunchKernelGGL(mega, dim3(grid_blocks), dim3(256), LDS_BYTES, stream, p);
    }
#endif
}
```

```cpp
#include <hip/hip_runtime.h>
#include <hip/hip_cooperative_groups.h>
#include <cstdio>
#include <cstdint>
namespace cg = cooperative_groups;

#ifndef ONE_LAUNCH
#define ONE_LAUNCH 1
#endif

#define NT 18432
#define NL 16384
#define DM 1024
#define EVW 3088
#define ODW 1536
#define C_QK 0
#define C_V 512
#define C_O 1024
#define C_G 1536
#define C_DQ 1552
#define C_DK 2064
#define C_DV 2576
#define NPH 42
#ifndef PROBE_S
#define PROBE_S -1
#endif
#ifndef PROBE_N
#define PROBE_N 1
#endif

typedef unsigned short bf16_t;
typedef short bf16x8 __attribute__((ext_vector_type(8)));
typedef float f32x4 __attribute__((ext_vector_type(4)));
#define LDS_BYTES 73792

typedef float f32x16 __attribute__((ext_vector_type(16)));
typedef unsigned u32x4 __attribute__((ext_vector_type(4)));
struct P {
    const float *x, *c, *ctx, *c_ctx, *mod_w, *mod_b, *norm1_g, *norm2_g, *ev_w_in, *ev_conv_w, *ev_conv_b, *ev_gate_b,
        *ev_ml_g, *ev_da_lam, *ev_da_g, *ev_w_out, *od_w_in, *od_sink, *od_w_out, *pr_w_q, *pr_keys, *pr_u, *pr_v, *final_g;
    float* out;
    float *modv, *H, *QKC, *HM, *GATE, *rope, *GT;
    int *EIDX, *ctr;
    unsigned* bar;
    bf16_t *XN, *MIX, *WT, *UB, *VB, *KB, *QB, *PB, *AQL, *AQC, *AK, *AV;
    int ph_lo, ph_hi;
};
#define QSCALE 0.18033688011112042f

__device__ __forceinline__ int otid() { int t = threadIdx.x; asm volatile("" : "+v"(t)); return t; }
__device__ __forceinline__ int modrow(int r) { return r < NL ? (r >> 11) : 8; }
__device__ __forceinline__ float silu_f(float x) { return x / (1.f + expf(-x)); }
__device__ __forceinline__ float sigmoid_f(float x) { return 1.f / (1.f + expf(-x)); }
__device__ __forceinline__ float log_sigmoid_f(float x) { return fminf(x, 0.f) - log1pf(expf(-fabsf(x))); }
typedef __bf16 bf16v2_t __attribute__((ext_vector_type(2)));
typedef float f32x2_t __attribute__((ext_vector_type(2)));
__device__ __forceinline__ unsigned cvt_pk_bf16(float lo, float hi) { const bf16v2_t v = __builtin_convertvector((f32x2_t){lo, hi}, bf16v2_t); return __builtin_bit_cast(unsigned, v); }
__device__ __forceinline__ float bf_lo(unsigned u) { return __uint_as_float(u << 16); }
__device__ __forceinline__ float bf_hi(unsigned u) { return __uint_as_float(u & 0xffff0000u); }
#define WT_EVIN(j) ((size_t)(j) * 3200 * 1024)
#define WT_EVOUT(j) ((size_t)2 * 3200 * 1024 + (size_t)(j) * 1024 * 1024)
#define WT_ODIN(j) ((size_t)2 * 3200 * 1024 + (size_t)2 * 1024 * 1024 + (size_t)(j) * 1536 * 1024)
#define WT_ODOUT(j) ((size_t)2 * 3200 * 1024 + (size_t)2 * 1024 * 1024 + (size_t)2 * 1536 * 1024 + (size_t)(j) * 1024 * 1024)
#define WT_PQ(L) ((size_t)2 * 3200 * 1024 + (size_t)4 * 1024 * 1024 + (size_t)2 * 1536 * 1024 + (size_t)(L) * 2048 * 1024)
#define WT_TOTAL ((size_t)2 * 3200 * 1024 + (size_t)4 * 1024 * 1024 + (size_t)2 * 1536 * 1024 + (size_t)4 * 2048 * 1024)
__device__ __forceinline__ float wave_sum(float v) {
#pragma unroll
    for (int o = 32; o > 0; o >>= 1) v += __shfl_xor(v, o);
    return v;
}

__device__ void cvt_copy_bf16(const float* src, bf16_t* dst, size_t n);
__device__ void ph_prologue(const P& p, float* smem) {
    const int tid = otid(), nb = gridDim.x, bid = blockIdx.x;
    if (bid == 0 && tid < 64) p.ctr[tid] = 0;
    {
        const float4* xs = (const float4*)p.x; const float4* cs = (const float4*)p.ctx; float4* hd = (float4*)p.H;
        const size_t nx = (size_t)NL * DM / 4, nc = (size_t)(NT - NL) * DM / 4;
        for (size_t i = (size_t)bid * 256 + tid; i < nx + nc; i += (size_t)nb * 256) hd[i] = i < nx ? xs[i] : cs[i - nx];
    }
    for (int i = bid * 256 + tid; i < 2048 * 32; i += nb * 256) {
        const int s = i >> 5, d = i & 31;
        const float pos = (d < 16) ? (float)(s >> 6) : (float)(s & 63);
        const float inv = powf(10000.0f, -(float)(d & 15) / 16.0f);
        const float ang = pos * inv;
        p.rope[2 * i] = cosf(ang); p.rope[2 * i + 1] = sinf(ang);
    }
    float* sc = smem;
    float* red = smem + 9 * 1024;
    for (int i = tid; i < 9 * 1024; i += 256) { const int r = i >> 10, k = i & 1023; const float v = r < 8 ? p.c[r * 1024 + k] : p.c_ctx[k]; sc[i] = silu_f(v); }
    __syncthreads();
    for (int item = bid; item < 4 * 96; item += nb) {
        const int L = item / 96, n0 = (item % 96) * 64, tx = tid & 63, kq = tid >> 6;
        float acc[9];
#pragma unroll
        for (int r = 0; r < 9; ++r) acc[r] = 0.f;
        const float* w = p.mod_w + (size_t)L * 1024 * 6144 + n0 + tx;
        for (int k = kq * 256; k < kq * 256 + 256; ++k) {
            const float wv = w[(size_t)k * 6144];
#pragma unroll
            for (int r = 0; r < 9; ++r) acc[r] += sc[r * 1024 + k] * wv;
        }
#pragma unroll
        for (int r = 0; r < 9; ++r) red[(kq * 9 + r) * 64 + tx] = acc[r];
        __syncthreads();
        if (kq == 0) {
#pragma unroll
            for (int r = 0; r < 9; ++r) {
                const float s = red[(0 * 9 + r) * 64 + tx] + red[(1 * 9 + r) * 64 + tx] + red[(2 * 9 + r) * 64 + tx] + red[(3 * 9 + r) * 64 + tx];
                p.modv[((size_t)L * 9 + r) * 6144 + n0 + tx] = s + p.mod_b[L * 6144 + n0 + tx];
            }
        }
        __syncthreads();
    }
    {
        float (*tile)[65] = (float (*)[65])smem;
        for (int item = bid; item < 5440; item += nb) {
            int it = item, mat = 0, N = 0, Npad = 0; const float* src = nullptr; bf16_t* dst = nullptr;
            for (mat = 0; mat < 12; ++mat) {
                if (mat < 2) { N = EVW; Npad = 3200; src = p.ev_w_in + (size_t)mat * DM * EVW; dst = p.WT + WT_EVIN(mat); }
                else if (mat < 4) { N = 1024; Npad = 1024; src = p.ev_w_out + (size_t)(mat - 2) * DM * DM; dst = p.WT + WT_EVOUT(mat - 2); }
                else if (mat < 6) { N = ODW; Npad = ODW; src = p.od_w_in + (size_t)(mat - 4) * DM * ODW; dst = p.WT + WT_ODIN(mat - 4); }
                else if (mat < 8) { N = 1024; Npad = 1024; src = p.od_w_out + (size_t)(mat - 6) * DM * DM; dst = p.WT + WT_ODOUT(mat - 6); }
                else { N = 2048; Npad = 2048; src = p.pr_w_q + (size_t)(mat - 8) * DM * 2048; dst = p.WT + WT_PQ(mat - 8); }
                const int nt = 16 * (Npad / 64);
                if (it < nt) break;
                it -= nt;
            }
            const int k0 = (it & 15) * 64, n0 = (it >> 4) * 64;
            __syncthreads();
#pragma unroll
            for (int rep = 0; rep < 4; ++rep) {
                const int i = (tid >> 4) + 16 * rep, c4 = (tid & 15) * 4;
                float4 v = make_float4(0.f, 0.f, 0.f, 0.f);
                int sc = n0 + c4;
                if (mat < 2) sc = sc < 1536 ? sc : (sc < 3072 ? sc + 16 : (sc < 3088 ? sc - 3072 + 1536 : N));
                if (sc < N) v = *(const float4*)(src + (size_t)(k0 + i) * N + sc);
                tile[i][c4] = v.x; tile[i][c4 + 1] = v.y; tile[i][c4 + 2] = v.z; tile[i][c4 + 3] = v.w;
            }
            __syncthreads();
            {
                const int n = tid >> 2, kq = (tid & 3) * 16;
                unsigned w[8];
#pragma unroll
                for (int e = 0; e < 8; ++e) w[e] = cvt_pk_bf16(tile[kq + 2 * e][n], tile[kq + 2 * e + 1][n]);
                uint4* dp = (uint4*)(dst + (size_t)(n0 + n) * DM + k0 + kq);
                dp[0] = make_uint4(w[0], w[1], w[2], w[3]); dp[1] = make_uint4(w[4], w[5], w[6], w[7]);
            }
        }
    }
    cvt_copy_bf16(p.pr_u, p.UB, (size_t)4 * 16384 * 1024);
    cvt_copy_bf16(p.pr_v, p.VB, (size_t)4 * 16384 * 1024);
    cvt_copy_bf16(p.pr_keys, p.KB, (size_t)4 * 8 * 2 * 128 * 128);
}

__device__ void cvt_copy_bf16(const float* src, bf16_t* dst, size_t n) {
    const size_t n8 = n / 8;
    for (size_t i = (size_t)blockIdx.x * 256 + otid(); i < n8; i += (size_t)gridDim.x * 256) {
        const float4 a = ((const float4*)src)[2 * i], b = ((const float4*)src)[2 * i + 1];
        ((uint4*)dst)[i] = make_uint4(cvt_pk_bf16(a.x, a.y), cvt_pk_bf16(a.z, a.w), cvt_pk_bf16(b.x, b.y), cvt_pk_bf16(b.z, b.w));
    }
}

__device__ void ph_normmod(const float* src, const float* g, const float* modv_layer, int shift_off, int scale_off, bf16_t* dst, int nrows) {
    const int lane = otid() & 63, wid = otid() >> 6;
    for (int r = blockIdx.x * 4 + wid; r < nrows; r += gridDim.x * 4) {
        const float4* s4 = (const float4*)(src + (size_t)r * DM);
        float4 v[4]; float ss = 0.f;
#pragma unroll
        for (int i = 0; i < 4; ++i) { v[i] = s4[i * 64 + lane]; ss += v[i].x * v[i].x + v[i].y * v[i].y + v[i].z * v[i].z + v[i].w * v[i].w; }
        ss = wave_sum(ss);
        const float rstd = rsqrtf(ss * (1.0f / DM) + 1e-6f);
        const float* mv = modv_layer + (size_t)modrow(r) * 6144;
        uint2* d2 = (uint2*)(dst + (size_t)r * DM);
#pragma unroll
        for (int i = 0; i < 4; ++i) {
            const int c = (i * 64 + lane) * 4;
            const float4 gg = *(const float4*)(g + c), sh = *(const float4*)(mv + shift_off + c), scl = *(const float4*)(mv + scale_off + c);
            float4 o;
            o.x = v[i].x * rstd * gg.x * (1.f + scl.x) + sh.x; o.y = v[i].y * rstd * gg.y * (1.f + scl.y) + sh.y;
            o.z = v[i].z * rstd * gg.z * (1.f + scl.z) + sh.z; o.w = v[i].w * rstd * gg.w * (1.f + scl.w) + sh.w;
            d2[i * 64 + lane] = make_uint2(cvt_pk_bf16(o.x, o.y), cvt_pk_bf16(o.z, o.w));
        }
    }
}

__device__ void ph_final(const P& p) {
    const int lane = otid() & 63, wid = otid() >> 6;
    for (int r = blockIdx.x * 4 + wid; r < NL; r += gridDim.x * 4) {
        const float4* s4 = (const float4*)(p.H + (size_t)r * DM);
        float4 v[4]; float ss = 0.f;
#pragma unroll
        for (int i = 0; i < 4; ++i) { v[i] = s4[i * 64 + lane]; ss += v[i].x * v[i].x + v[i].y * v[i].y + v[i].z * v[i].z + v[i].w * v[i].w; }
        ss = wave_sum(ss);
        const float rstd = rsqrtf(ss * (1.0f / DM) + 1e-6f);
        float4* d4 = (float4*)(p.out + (size_t)r * DM);
#pragma unroll
        for (int i = 0; i < 4; ++i) {
            const int c = (i * 64 + lane) * 4; const float4 gg = *(const float4*)(p.final_g + c);
            float4 o; o.x = v[i].x * rstd * gg.x; o.y = v[i].y * rstd * gg.y; o.z = v[i].z * rstd * gg.z; o.w = v[i].w * rstd * gg.w;
            d4[i * 64 + lane] = o;
        }
    }
}

#define GL_ROWB 144
#define GL_TILEB (128 * GL_ROWB)
struct TokPos { int b, pos, kpos; bool lat; };
__device__ __forceinline__ TokPos tokpos(int row) {
    TokPos t; t.lat = row < NL;
    if (t.lat) { t.b = row >> 11; t.pos = row & 2047; t.kpos = 256 + t.pos; } else { const int r = row - NL; t.b = r >> 8; t.pos = r & 255; t.kpos = t.pos; }
    return t;
}
struct EpiStoreBF16 {
    bf16_t* C; int ldc;
    __device__ __forceinline__ bool swapped(int) const { return false; }
    __device__ __forceinline__ void operator()(const f32x4 (&acc)[4][4], int m0, int n0, int wm, int wn, int fr, int fq) const {
#pragma unroll
        for (int mi = 0; mi < 4; ++mi)
#pragma unroll
            for (int ni = 0; ni < 4; ++ni) {
                const f32x4 v = acc[ni][mi];
                *(uint2*)(C + (size_t)(m0 + wm * 64 + mi * 16 + fr) * ldc + n0 + wn * 64 + ni * 16 + fq * 4) = make_uint2(cvt_pk_bf16(v[0], v[1]), cvt_pk_bf16(v[2], v[3]));
            }
    }
};
struct EpiResid {
    float* H; const float* gate; float scale;
    __device__ __forceinline__ bool swapped(int) const { return false; }
    __device__ __forceinline__ void operator()(const f32x4 (&acc)[4][4], int m0, int n0, int wm, int wn, int fr, int fq) const {
#pragma unroll
        for (int mi = 0; mi < 4; ++mi) {
            const int row = m0 + wm * 64 + mi * 16 + fr;
            const float* gp = gate + (size_t)modrow(row) * 6144;
#pragma unroll
            for (int ni = 0; ni < 4; ++ni) {
                const int col = n0 + wn * 64 + ni * 16 + fq * 4;
                const f32x4 g = *(const f32x4*)(gp + col);
                f32x4* hp = (f32x4*)(H + (size_t)row * DM + col);
                *hp = *hp + g * acc[ni][mi] * scale;
            }
        }
    }
};
__device__ __forceinline__ void rope_store64(const f32x4 (&acc)[4][4], int mi, bool do_rope, const float* ropep  , float scale, bf16_t* dst  , int fq) {
#pragma unroll
    for (int ni = 0; ni < 2; ++ni) {
        f32x4 x1 = acc[ni][mi], x2 = acc[ni + 2][mi];
        if (do_rope) {
            const f32x4 r0 = *(const f32x4*)(ropep + (ni * 16 + fq * 4) * 2), r1 = *(const f32x4*)(ropep + (ni * 16 + fq * 4) * 2 + 4);
            const f32x4 cs = (f32x4){r0[0], r0[2], r1[0], r1[2]}, sn = (f32x4){r0[1], r0[3], r1[1], r1[3]};
            const f32x4 y1 = x1 * cs - x2 * sn, y2 = x1 * sn + x2 * cs;
            x1 = y1; x2 = y2;
        }
        x1 = x1 * scale; x2 = x2 * scale;
        *(uint2*)(dst + ni * 16 + fq * 4) = make_uint2(cvt_pk_bf16(x1[0], x1[1]), cvt_pk_bf16(x1[2], x1[3]));
        *(uint2*)(dst + 32 + ni * 16 + fq * 4) = make_uint2(cvt_pk_bf16(x2[0], x2[1]), cvt_pk_bf16(x2[2], x2[3]));
    }
}
struct EpiEven {
    bf16_t *PB, *AQL, *AQC, *AK, *AV; float* GT; const float* rope;
    __device__ __forceinline__ bool swapped(int n0) const { return n0 >= 2560 && n0 < 3072; }
    __device__ __forceinline__ void operator()(const f32x4 (&acc)[4][4], int m0, int n0, int wm, int wn, int fr, int fq) const {
        const int t = n0 >> 7;
        if (t < 12) {
#pragma unroll
            for (int mi = 0; mi < 4; ++mi)
#pragma unroll
                for (int ni = 0; ni < 4; ++ni) {
                    const f32x4 v = acc[ni][mi];
                    *(uint2*)(PB + (size_t)(m0 + wm * 64 + mi * 16 + fr) * 1536 + n0 + wn * 64 + ni * 16 + fq * 4) = make_uint2(cvt_pk_bf16(v[0], v[1]), cvt_pk_bf16(v[2], v[3]));
                }
        } else if (t < 20) {
            const bool isq = t < 16; const int h = t & 3;
#pragma unroll
            for (int mi = 0; mi < 4; ++mi) {
                const TokPos tp = tokpos(m0 + wm * 64 + mi * 16 + fr);
                const int hm = (tp.b * 4 + h) * 2 + wn;
                bf16_t* dst;
                if (isq) dst = tp.lat ? AQL + ((size_t)hm * 2048 + tp.pos) * 64 : AQC + ((size_t)hm * 256 + tp.pos) * 64;
                else dst = AK + ((size_t)hm * 2304 + tp.kpos) * 64;
                rope_store64(acc, mi, tp.lat, rope + (size_t)tp.pos * 64, isq ? QSCALE : 1.0f, dst, fq);
            }
        } else if (t < 24) {
            const int h = t - 20;
#pragma unroll
            for (int mi = 0; mi < 4; ++mi) {
                const TokPos tp = tokpos(m0 + wm * 64 + mi * 16 + fq * 4);
#pragma unroll
                for (int ni = 0; ni < 4; ++ni) {
                    const f32x4 v = acc[ni][mi];
                    const int d = wn * 64 + ni * 16 + fr;
                    *(uint2*)(AV + ((size_t)(tp.b * 4 + h) * 128 + d) * 2304 + tp.kpos) = make_uint2(cvt_pk_bf16(v[0], v[1]), cvt_pk_bf16(v[2], v[3]));
                }
            }
        } else {
            if (wn == 0) {
#pragma unroll
                for (int mi = 0; mi < 4; ++mi) *(f32x4*)(GT + (size_t)(m0 + wm * 64 + mi * 16 + fr) * 16 + fq * 4) = acc[0][mi];
            }
        }
    }
};
struct EpiOdd {
    bf16_t *AQL, *AQC, *AK, *AV; const float* rope;
    __device__ __forceinline__ bool swapped(int n0) const { return n0 >= 1280; }
    __device__ __forceinline__ void operator()(const f32x4 (&acc)[4][4], int m0, int n0, int wm, int wn, int fr, int fq) const {
        const int t = n0 >> 7;
        if (t < 10) {
            const bool isq = t < 8; const int hd = isq ? t * 2 + wn : (t - 8) * 2 + wn;
#pragma unroll
            for (int mi = 0; mi < 4; ++mi) {
                const TokPos tp = tokpos(m0 + wm * 64 + mi * 16 + fr);
                bf16_t* dst;
                if (isq) dst = tp.lat ? AQL + ((size_t)(tp.b * 16 + hd) * 2048 + tp.pos) * 64 : AQC + ((size_t)(tp.b * 16 + hd) * 256 + tp.pos) * 64;
                else dst = AK + ((size_t)(tp.b * 4 + hd) * 2304 + tp.kpos) * 64;
                rope_store64(acc, mi, tp.lat, rope + (size_t)tp.pos * 64, isq ? QSCALE : 1.0f, dst, fq);
            }
        } else {
            const int hkv = (t - 10) * 2 + wn;
#pragma unroll
            for (int mi = 0; mi < 4; ++mi) {
                const TokPos tp = tokpos(m0 + wm * 64 + mi * 16 + fq * 4);
#pragma unroll
                for (int ni = 0; ni < 4; ++ni) {
                    const f32x4 v = acc[ni][mi];
                    const int d = ni * 16 + fr;
                    *(uint2*)(AV + ((size_t)(tp.b * 4 + hkv) * 64 + d) * 2304 + tp.kpos) = make_uint2(cvt_pk_bf16(v[0], v[1]), cvt_pk_bf16(v[2], v[3]));
                }
            }
        }
    }
};
template <bool SWAP>
__device__ __forceinline__ void gemm_tile_kloop(f32x4 (&acc)[4][4], const bf16_t* ap, const bf16_t* bp, char* smem, int lrow, int lch, int wm, int wn, int fr, int fq) {
    uint4 ra0, ra1, ra2, ra3, rb0, rb1, rb2, rb3;
#define GL_LOAD(KO) { ra0 = *(const uint4*)(ap + (KO)); ra1 = *(const uint4*)(ap + (size_t)32 * DM + (KO)); ra2 = *(const uint4*)(ap + (size_t)64 * DM + (KO)); ra3 = *(const uint4*)(ap + (size_t)96 * DM + (KO)); \
                      rb0 = *(const uint4*)(bp + (KO)); rb1 = *(const uint4*)(bp + (size_t)32 * DM + (KO)); rb2 = *(const uint4*)(bp + (size_t)64 * DM + (KO)); rb3 = *(const uint4*)(bp + (size_t)96 * DM + (KO)); }
#define GL_STORE(BUF) { char* sa_ = (BUF) + lrow * GL_ROWB + lch * 16; char* sb_ = sa_ + GL_TILEB; \
                        *(uint4*)(sa_) = ra0; *(uint4*)(sa_ + 32 * GL_ROWB) = ra1; *(uint4*)(sa_ + 64 * GL_ROWB) = ra2; *(uint4*)(sa_ + 96 * GL_ROWB) = ra3; \
                        *(uint4*)(sb_) = rb0; *(uint4*)(sb_ + 32 * GL_ROWB) = rb1; *(uint4*)(sb_ + 64 * GL_ROWB) = rb2; *(uint4*)(sb_ + 96 * GL_ROWB) = rb3; }
    GL_LOAD(0)
    __syncthreads();
    GL_STORE(smem)
    __syncthreads();
    for (int kt = 0; kt < 16; ++kt) {
        char* cur = smem + (kt & 1) * 2 * GL_TILEB;
        char* nxt = smem + ((kt + 1) & 1) * 2 * GL_TILEB;
        if (kt + 1 < 16) GL_LOAD((kt + 1) * 64)
#pragma unroll
        for (int ks = 0; ks < 2; ++ks) {
            bf16x8 af[4], wf[4];
#pragma unroll
            for (int i = 0; i < 4; ++i) {
                af[i] = *(const bf16x8*)(cur + (wm * 64 + i * 16 + fr) * GL_ROWB + (ks * 4 + fq) * 16);
                wf[i] = *(const bf16x8*)(cur + GL_TILEB + (wn * 64 + i * 16 + fr) * GL_ROWB + (ks * 4 + fq) * 16);
            }
#pragma unroll
            for (int ni = 0; ni < 4; ++ni)
#pragma unroll
                for (int mi = 0; mi < 4; ++mi)
                    acc[ni][mi] = SWAP ? __builtin_amdgcn_mfma_f32_16x16x32_bf16(af[mi], wf[ni], acc[ni][mi], 0, 0, 0)
                                       : __builtin_amdgcn_mfma_f32_16x16x32_bf16(wf[ni], af[mi], acc[ni][mi], 0, 0, 0);
        }
        if (kt + 1 < 16) GL_STORE(nxt)
        __syncthreads();
    }
#undef GL_LOAD
#undef GL_STORE
}
template <class Epi>
__device__ void ph_gemm(const bf16_t* A, const bf16_t* Bt, int M, int Npad, const Epi& epi, char* smem) {
    const int tid = otid(), lane = tid & 63, wid = tid >> 6, wm = wid >> 1, wn = wid & 1;
    const int fr = lane & 15, fq = lane >> 4;
    const int tm = M / 128, tn = Npad / 128, ntiles = tm * tn;
    const int lrow = tid >> 3, lch = tid & 7;
    for (int tile = blockIdx.x; tile < ntiles; tile += gridDim.x) {
        const int m0 = (tile % tm) * 128, n0 = (tile / tm) * 128;
        f32x4 acc[4][4];
#pragma unroll
        for (int a = 0; a < 4; ++a)
#pragma unroll
            for (int b = 0; b < 4; ++b) acc[a][b] = (f32x4){0.f, 0.f, 0.f, 0.f};
        const bf16_t* ap = A + (size_t)(m0 + lrow) * DM + lch * 8;
        const bf16_t* bp = Bt + (size_t)(n0 + lrow) * DM + lch * 8;
        if (epi.swapped(n0)) gemm_tile_kloop<true>(acc, ap, bp, smem, lrow, lch, wm, wn, fr, fq);
        else gemm_tile_kloop<false>(acc, ap, bp, smem, lrow, lch, wm, wn, fr, fq);
        epi(acc, m0, n0, wm, wn, fr, fq);
    }
}

__device__ void ph_prep_even(const P& p, int j) {
    const float* cw = p.ev_conv_w + (size_t)j * 3 * 512; const float* cb = p.ev_conv_b + (size_t)j * 512;
    const size_t tot = (size_t)NT * 512;
    for (size_t i = (size_t)blockIdx.x * 256 + otid(); i < tot; i += (size_t)gridDim.x * 256) {
        const int r = (int)(i >> 9), c = (int)(i & 511);
        int t, T; if (r < NL) { t = r & 2047; T = 2048; } else { t = (r - NL) & 255; T = 256; }
        float v = cb[c] + __uint_as_float((unsigned)p.PB[(size_t)r * 1536 + c] << 16) * cw[512 + c];
        if (t > 0) v += __uint_as_float((unsigned)p.PB[(size_t)(r - 1) * 1536 + c] << 16) * cw[c];
        if (t < T - 1) v += __uint_as_float((unsigned)p.PB[(size_t)(r + 1) * 1536 + c] << 16) * cw[1024 + c];
        v = silu_f(v);
        if (c >= 256) v *= 0.125f;
        p.QKC[i] = v;
    }
}

#define FA_KROW 144
#define FA_VROW 136
__device__ __forceinline__ bf16x8 pack8(float a0, float a1, float a2, float a3, float a4, float a5, float a6, float a7) {
    const u32x4 u = (u32x4){cvt_pk_bf16(a0, a1), cvt_pk_bf16(a2, a3), cvt_pk_bf16(a4, a5), cvt_pk_bf16(a6, a7)};
    return __builtin_bit_cast(bf16x8, u);
}
template <int NDB, bool MASK>
__device__ __forceinline__ void flash_tile(const bf16x8 (&qf)[4], f32x16 (&o)[NDB], float& m, float& l, const char* Kl, const char* Vl, int lane, int qpos, int kp0) {
    const int j = lane & 31, h = lane >> 5;
    f32x16 s0, s1;
#pragma unroll
    for (int i = 0; i < 16; ++i) { s0[i] = 0.f; s1[i] = 0.f; }
#pragma unroll
    for (int ks = 0; ks < 4; ++ks) {
        const bf16x8 a0 = *(const bf16x8*)(Kl + j * FA_KROW + (2 * ks + h) * 16);
        const bf16x8 a1 = *(const bf16x8*)(Kl + (32 + j) * FA_KROW + (2 * ks + h) * 16);
        s0 = __builtin_amdgcn_mfma_f32_32x32x16_bf16(a0, qf[ks], s0, 0, 0, 0);
        s1 = __builtin_amdgcn_mfma_f32_32x32x16_bf16(a1, qf[ks], s1, 0, 0, 0);
    }
    if (MASK) {
#pragma unroll
        for (int r = 0; r < 16; ++r) {
            const int key = (r & 3) + 8 * (r >> 2) + 4 * h;
            const int d0 = qpos - (kp0 + key), d1 = d0 - 32;
            if (d0 > 128 || d0 < -128) s0[r] = -1e30f;
            if (d1 > 128 || d1 < -128) s1[r] = -1e30f;
        }
    }
    float mx = fmaxf(s0[0], s1[0]);
#pragma unroll
    for (int r = 1; r < 16; ++r) mx = fmaxf(mx, fmaxf(s0[r], s1[r]));
    mx = fmaxf(mx, __shfl_xor(mx, 32));
    const float mn = fmaxf(m, mx);
    const float alpha = __builtin_amdgcn_exp2f(m - mn);
    m = mn;
    float ls = 0.f;
#pragma unroll
    for (int r = 0; r < 16; ++r) { s0[r] = __builtin_amdgcn_exp2f(s0[r] - mn); s1[r] = __builtin_amdgcn_exp2f(s1[r] - mn); ls += s0[r] + s1[r]; }
    l = l * alpha + ls;
#pragma unroll
    for (int db = 0; db < NDB; ++db) o[db] = o[db] * alpha;
    bf16x8 pb[4];
    pb[0] = pack8(s0[0], s0[1], s0[2], s0[3], s0[4], s0[5], s0[6], s0[7]);
    pb[1] = pack8(s0[8], s0[9], s0[10], s0[11], s0[12], s0[13], s0[14], s0[15]);
    pb[2] = pack8(s1[0], s1[1], s1[2], s1[3], s1[4], s1[5], s1[6], s1[7]);
    pb[3] = pack8(s1[8], s1[9], s1[10], s1[11], s1[12], s1[13], s1[14], s1[15]);
#pragma unroll
    for (int db = 0; db < NDB; ++db)
#pragma unroll
        for (int kk = 0; kk < 4; ++kk) {
            const char* vp = Vl + (db * 32 + j) * FA_VROW + (kk * 16 + 4 * h) * 2;
            const uint2 lo = *(const uint2*)vp, hi = *(const uint2*)(vp + 16);
            const u32x4 u = (u32x4){lo.x, lo.y, hi.x, hi.y};
            o[db] = __builtin_amdgcn_mfma_f32_32x32x16_bf16(__builtin_bit_cast(bf16x8, u), pb[kk], o[db], 0, 0, 0);
        }
}

#define DA_BUFB 35840
__device__ void da_block(const P& p, int item, int L, int j, char* smem) {
    const int tid = otid(), lane = tid & 63, wid = tid >> 6, mp = wid & 1, qg = wid >> 1, jq = lane & 31, hh = lane >> 5;
    const bool lat = item < 1024;
    int b, h, qt;
    if (lat) { b = item >> 7; h = (item >> 5) & 3; qt = item & 31; } else { const int it = item - 1024; b = it >> 4; h = (it >> 2) & 3; qt = it & 3; }
    const int qi = qt * 64 + qg * 32 + jq;
    const bf16_t* qp = lat ? p.AQL + ((size_t)((b * 4 + h) * 2 + mp) * 2048 + qi) * 64 : p.AQC + ((size_t)((b * 4 + h) * 2 + mp) * 256 + qi) * 64;
    bf16x8 qf[4];
#pragma unroll
    for (int ks = 0; ks < 4; ++ks) qf[ks] = *(const bf16x8*)(qp + (2 * ks + hh) * 8);
    const int ntile = lat ? 36 : 4;
    const bf16_t* kg = p.AK + (size_t)((b * 4 + h) * 2) * 2304 * 64 + (size_t)(tid >> 3) * 64 + (tid & 7) * 8;
    const bf16_t* vg = p.AV + (size_t)(b * 4 + h) * 128 * 2304 + (size_t)(tid >> 3) * 2304 + (tid & 7) * 8;
    uint4 k0, k1, k2, k3, v0, v1, v2, v3;
#define DA_LOAD(KEY0) { k0 = *(const uint4*)(kg + (size_t)(KEY0) * 64); k1 = *(const uint4*)(kg + (size_t)((KEY0) + 32) * 64); \
                        k2 = *(const uint4*)(kg + (size_t)2304 * 64 + (size_t)(KEY0) * 64); k3 = *(const uint4*)(kg + (size_t)2304 * 64 + (size_t)((KEY0) + 32) * 64); \
                        v0 = *(const uint4*)(vg + (KEY0)); v1 = *(const uint4*)(vg + (size_t)32 * 2304 + (KEY0)); v2 = *(const uint4*)(vg + (size_t)64 * 2304 + (KEY0)); v3 = *(const uint4*)(vg + (size_t)96 * 2304 + (KEY0)); }
#define DA_STORE(BUF) { char* kb_ = (BUF) + (tid >> 3) * FA_KROW + (tid & 7) * 16; \
                        *(uint4*)kb_ = k0; *(uint4*)(kb_ + 32 * FA_KROW) = k1; *(uint4*)(kb_ + 64 * FA_KROW) = k2; *(uint4*)(kb_ + 96 * FA_KROW) = k3; \
                        char* vb_ = (BUF) + 18432 + (tid >> 3) * FA_VROW + (tid & 7) * 16; \
                        *(uint2*)vb_ = make_uint2(v0.x, v0.y); *(uint2*)(vb_ + 8) = make_uint2(v0.z, v0.w); \
                        *(uint2*)(vb_ + 32 * FA_VROW) = make_uint2(v1.x, v1.y); *(uint2*)(vb_ + 32 * FA_VROW + 8) = make_uint2(v1.z, v1.w); \
                        *(uint2*)(vb_ + 64 * FA_VROW) = make_uint2(v2.x, v2.y); *(uint2*)(vb_ + 64 * FA_VROW + 8) = make_uint2(v2.z, v2.w); \
                        *(uint2*)(vb_ + 96 * FA_VROW) = make_uint2(v3.x, v3.y); *(uint2*)(vb_ + 96 * FA_VROW + 8) = make_uint2(v3.z, v3.w); }
    f32x16 o[4];
#pragma unroll
    for (int db = 0; db < 4; ++db)
#pragma unroll
        for (int i = 0; i < 16; ++i) o[db][i] = 0.f;
    float m = -1e30f, l = 0.f;
    DA_LOAD(0)
    __syncthreads();
    DA_STORE(smem)
    __syncthreads();
    for (int t = 0; t < ntile; ++t) {
        char* cur = smem + (t & 1) * DA_BUFB;
        char* nxt = smem + ((t + 1) & 1) * DA_BUFB;
        if (t + 1 < ntile) DA_LOAD((t + 1) * 64)
        flash_tile<4, false>(qf, o, m, l, cur + mp * 9216, cur + 18432, lane, 0, 0);
        if (t + 1 < ntile) DA_STORE(nxt)
        __syncthreads();
    }
#undef DA_LOAD
#undef DA_STORE
    const float inv = 1.f / (l + __shfl_xor(l, 32));
#pragma unroll
    for (int db = 0; db < 4; ++db) o[db] = o[db] * inv;
    float* X = (float*)smem + qg * 4096;
    if (mp == 1) {
#pragma unroll
        for (int db = 0; db < 4; ++db)
#pragma unroll
            for (int r = 0; r < 16; ++r) X[(db * 32 + (r & 3) + 8 * (r >> 2) + 4 * hh) * 32 + jq] = o[db][r];
    }
    __syncthreads();
    if (mp == 0) {
        const float lam_init = 0.8f - 0.6f * expf(-0.3f * (float)L);
        const float* lp = p.ev_da_lam + (size_t)j * 256;
        float a0 = lp[lane] * lp[64 + lane], a1 = lp[128 + lane] * lp[192 + lane];
        a0 = wave_sum(a0); a1 = wave_sum(a1);
        const float lam = expf(a0) - expf(a1) + lam_init;
        float ss = 0.f;
#pragma unroll
        for (int db = 0; db < 4; ++db)
#pragma unroll
            for (int r = 0; r < 16; ++r) { const float v = o[db][r] - lam * X[(db * 32 + (r & 3) + 8 * (r >> 2) + 4 * hh) * 32 + jq]; o[db][r] = v; ss += v * v; }
        ss += __shfl_xor(ss, 32);
        const float sc = rsqrtf(ss * (1.f / 128.f) + 1e-6f) * (1.f - lam_init);
        const int row = lat ? b * 2048 + qi : NL + b * 256 + qi;
        bf16_t* mrow = p.MIX + (size_t)row * DM + 512 + h * 128;
        const float* g = p.ev_da_g + (size_t)j * 512 + h * 128;
#pragma unroll
        for (int db = 0; db < 4; ++db)
#pragma unroll
            for (int r4 = 0; r4 < 4; ++r4) {
                const int d = db * 32 + 8 * r4 + 4 * hh;
                const f32x4 gg = *(const f32x4*)(g + d);
                *(uint2*)(mrow + d) = make_uint2(cvt_pk_bf16(o[db][r4 * 4 + 0] * sc * gg[0], o[db][r4 * 4 + 1] * sc * gg[1]), cvt_pk_bf16(o[db][r4 * 4 + 2] * sc * gg[2], o[db][r4 * 4 + 3] * sc * gg[3]));
            }
    }
    __syncthreads();
}

#define WA_BUFB 17920
__device__ void wa_block(const P& p, int item, int j, char* smem) {
    const int tid = otid(), lane = tid & 63, wid = tid >> 6, jq = lane & 31, hh = lane >> 5;
    const bool lat = item < 2048;
    int b, nb, hq;
    if (lat) { hq = item & 15; nb = (item >> 4) & 15; b = item >> 8; } else { const int it = item - 2048; hq = it & 15; nb = (it >> 4) & 1; b = it >> 5; }
    const int hkv = hq >> 2;
    const int qi = nb * 128 + wid * 32 + jq;
    const bf16_t* qp = lat ? p.AQL + ((size_t)(b * 16 + hq) * 2048 + qi) * 64 : p.AQC + ((size_t)(b * 16 + hq) * 256 + qi) * 64;
    bf16x8 qf[4];
#pragma unroll
    for (int ks = 0; ks < 4; ++ks) qf[ks] = *(const bf16x8*)(qp + (2 * ks + hh) * 8);
    const int lfirst = (nb == 0) ? 2 : 0, nloc = lat ? 6 - lfirst - ((nb == 15) ? 2 : 0) : 0;
    const int ntile = 4 + nloc;
    const bf16_t* kg = p.AK + (size_t)(b * 4 + hkv) * 2304 * 64 + (size_t)(tid >> 3) * 64 + (tid & 7) * 8;
    const bf16_t* vg = p.AV + (size_t)(b * 4 + hkv) * 64 * 2304 + (size_t)(tid >> 3) * 2304 + (tid & 7) * 8;
    uint4 k0, k1, v0, v1;
#define WA_KEY0(T) ((T) < 4 ? (T) * 64 : 256 + (nb - 1) * 128 + ((T) - 4 + lfirst) * 64)
#define WA_LOAD(KEY0) { k0 = *(const uint4*)(kg + (size_t)(KEY0) * 64); k1 = *(const uint4*)(kg + (size_t)((KEY0) + 32) * 64); v0 = *(const uint4*)(vg + (KEY0)); v1 = *(const uint4*)(vg + (size_t)32 * 2304 + (KEY0)); }
#define WA_STORE(BUF) { char* kb_ = (BUF) + (tid >> 3) * FA_KROW + (tid & 7) * 16; *(uint4*)kb_ = k0; *(uint4*)(kb_ + 32 * FA_KROW) = k1; \
                        char* vb_ = (BUF) + 9216 + (tid >> 3) * FA_VROW + (tid & 7) * 16; \
                        *(uint2*)vb_ = make_uint2(v0.x, v0.y); *(uint2*)(vb_ + 8) = make_uint2(v0.z, v0.w); \
                        *(uint2*)(vb_ + 32 * FA_VROW) = make_uint2(v1.x, v1.y); *(uint2*)(vb_ + 32 * FA_VROW + 8) = make_uint2(v1.z, v1.w); }
    f32x16 o[2];
#pragma unroll
    for (int db = 0; db < 2; ++db)
#pragma unroll
        for (int i = 0; i < 16; ++i) o[db][i] = 0.f;
    float m = p.od_sink[j * 16 + hq] * 1.4426950408889634f, l = hh == 0 ? 1.f : 0.f;
    { const int key0 = WA_KEY0(0); WA_LOAD(key0) }
    __syncthreads();
    WA_STORE(smem)
    __syncthreads();
    for (int t = 0; t < ntile; ++t) {
        char* cur = smem + (t & 1) * WA_BUFB;
        char* nxt = smem + ((t + 1) & 1) * WA_BUFB;
        if (t + 1 < ntile) { const int key0 = WA_KEY0(t + 1); WA_LOAD(key0) }
        if (t < 4) flash_tile<2, false>(qf, o, m, l, cur, cur + 9216, lane, 0, 0);
        else flash_tile<2, true>(qf, o, m, l, cur, cur + 9216, lane, qi, WA_KEY0(t) - 256);
        if (t + 1 < ntile) WA_STORE(nxt)
        __syncthreads();
    }
#undef WA_LOAD
#undef WA_STORE
#undef WA_KEY0
    const float inv = 1.f / (l + __shfl_xor(l, 32));
    const int row = lat ? b * 2048 + qi : NL + b * 256 + qi;
    bf16_t* mrow = p.MIX + (size_t)row * DM + hq * 64;
#pragma unroll
    for (int db = 0; db < 2; ++db)
#pragma unroll
        for (int r4 = 0; r4 < 4; ++r4) {
            const int d = db * 32 + 8 * r4 + 4 * hh;
            *(uint2*)(mrow + d) = make_uint2(cvt_pk_bf16(o[db][r4 * 4 + 0] * inv, o[db][r4 * 4 + 1] * inv), cvt_pk_bf16(o[db][r4 * 4 + 2] * inv, o[db][r4 * 4 + 3] * inv));
        }
}

#define ML_LD 68
__device__ void mlstm_chunk_item(const P& p, int item, int j, float* smem) {
    const int vs = item & 3, dir = (item >> 2) & 1, h = (item >> 3) & 3, b = item >> 5;
    const int tid = otid(), lane = tid & 63;
    float* sq = smem;
    float* sk = sq + 64 * ML_LD;
    float* sv = sk + 64 * ML_LD;
    float* sP = sv + 64 * 32;
    float* sCT = sP + 64 * 65;
    float* sn = sCT + 64 * 36;
    float* sa = sn + 64;
    float* sb = sa + 64;
    float* sg = sb + 64;
    float* swk = sg + 64;
    int* srow = (int*)(swk + 64);
    float* ssc = (float*)(srow + 64);
    const float gbi = p.ev_gate_b[j * 16 + (dir * 2) * 4 + h], gbf = p.ev_gate_b[j * 16 + (dir * 2 + 1) * 4 + h];
    float* hm = p.HM + (size_t)dir * NT * 512;
    __syncthreads();
    for (int i = tid; i < 64 * 36; i += 256) sCT[i] = 0.f;
    if (tid < 64) sn[tid] = 0.f;
    float m_st = 0.f;
    for (int c = 0; c < 36; ++c) {
        __syncthreads();
        if (tid < 64) {
            const int st = c * 64 + tid; int row;
            if (st < 256) row = NL + b * 256 + (dir ? 255 - st : st);
            else { const int t = st - 256; row = b * 2048 + (dir ? 2047 - t : t); }
            srow[tid] = row;
            const float ig = p.GT[(size_t)row * 16 + (dir * 2) * 4 + h] + gbi;
            const float lf = log_sigmoid_f(p.GT[(size_t)row * 16 + (dir * 2 + 1) * 4 + h] + gbf);
            float bc = lf;
#pragma unroll
            for (int o = 1; o < 64; o <<= 1) { const float t2 = __shfl_up(bc, o); if (lane >= o) bc += t2; }
            const float a = ig - bc;
            float mxa = a;
#pragma unroll
            for (int o = 1; o < 64; o <<= 1) { const float t2 = __shfl_up(mxa, o); if (lane >= o) mxa = fmaxf(mxa, t2); }
            const float g = fmaxf(m_st, mxa);
            const float g63 = __shfl(g, 63), b63 = __shfl(bc, 63);
            sa[tid] = a; sb[tid] = bc; sg[tid] = g; swk[tid] = expf(a - g63);
            if (tid == 0) { ssc[0] = m_st; ssc[1] = expf(m_st - g63); ssc[2] = b63 + g63; }
        }
        __syncthreads();
#pragma unroll
        for (int i = 0; i < 4; ++i) {
            const int e = tid + 256 * i, t = e >> 4, c4 = (e & 15) * 4; const int row = srow[t];
            *(float4*)(sq + t * ML_LD + c4) = *(const float4*)(p.QKC + (size_t)row * 512 + h * 64 + c4);
            *(float4*)(sk + t * ML_LD + c4) = *(const float4*)(p.QKC + (size_t)row * 512 + 256 + h * 64 + c4);
        }
        {
            const int t = tid >> 2, c8 = (tid & 3) * 8; const int row = srow[t];
            const uint4 u = *(const uint4*)(p.PB + (size_t)row * 1536 + 512 + h * 128 + vs * 32 + c8);
            float* d = sv + t * 32 + c8;
            d[0] = bf_lo(u.x); d[1] = bf_hi(u.x); d[2] = bf_lo(u.y); d[3] = bf_hi(u.y); d[4] = bf_lo(u.z); d[5] = bf_hi(u.z); d[6] = bf_lo(u.w); d[7] = bf_hi(u.w);
        }
        __syncthreads();
        const float mst = ssc[0], decay = ssc[1];
        {
            const int t = tid >> 2, sq4 = tid & 3;
            float acc[16];
#pragma unroll
            for (int i = 0; i < 16; ++i) acc[i] = 0.f;
            for (int d4 = 0; d4 < 16; ++d4) {
                const float4 qv = *(const float4*)(sq + t * ML_LD + d4 * 4);
#pragma unroll
                for (int i = 0; i < 16; ++i) {
                    const float4 kv = *(const float4*)(sk + (sq4 + 4 * i) * ML_LD + d4 * 4);
                    acc[i] += qv.x * kv.x + qv.y * kv.y + qv.z * kv.z + qv.w * kv.w;
                }
            }
            const float gt = sg[t];
#pragma unroll
            for (int i = 0; i < 16; ++i) { const int s2 = sq4 + 4 * i; sP[t * 65 + s2] = (s2 <= t) ? acc[i] * expf(sa[s2] - gt) : 0.f; }
        }
        __syncthreads();
        {
            const int t = tid >> 2, vq = tid & 3;
            float num[8], cq[8];
#pragma unroll
            for (int i = 0; i < 8; ++i) { num[i] = 0.f; cq[i] = 0.f; }
            float psum = 0.f, nq = 0.f;
            for (int s2 = 0; s2 < 64; ++s2) {
                const float pv = sP[t * 65 + s2];
                const float4 v0 = *(const float4*)(sv + s2 * 32 + vq * 8), v1 = *(const float4*)(sv + s2 * 32 + vq * 8 + 4);
                num[0] += pv * v0.x; num[1] += pv * v0.y; num[2] += pv * v0.z; num[3] += pv * v0.w;
                num[4] += pv * v1.x; num[5] += pv * v1.y; num[6] += pv * v1.z; num[7] += pv * v1.w;
                const float qd = sq[t * ML_LD + s2];
                const float4 c0 = *(const float4*)(sCT + s2 * 36 + vq * 8), c1 = *(const float4*)(sCT + s2 * 36 + vq * 8 + 4);
                cq[0] += qd * c0.x; cq[1] += qd * c0.y; cq[2] += qd * c0.z; cq[3] += qd * c0.w;
                cq[4] += qd * c1.x; cq[5] += qd * c1.y; cq[6] += qd * c1.z; cq[7] += qd * c1.w;
                if ((s2 >> 4) == vq) { psum += pv; nq += sn[s2] * qd; }
            }
            psum += __shfl_xor(psum, 1); psum += __shfl_xor(psum, 2);
            nq += __shfl_xor(nq, 1); nq += __shfl_xor(nq, 2);
            const float gt = sg[t], wint = expf(mst - gt);
            const float den = psum + wint * nq;
            const float sc = 1.f / fmaxf(fabsf(den), expf(-(sb[t] + gt)));
            float* op = hm + (size_t)srow[t] * 512 + h * 128 + vs * 32 + vq * 8;
            *(float4*)op = make_float4((num[0] + wint * cq[0]) * sc, (num[1] + wint * cq[1]) * sc, (num[2] + wint * cq[2]) * sc, (num[3] + wint * cq[3]) * sc);
            *(float4*)(op + 4) = make_float4((num[4] + wint * cq[4]) * sc, (num[5] + wint * cq[5]) * sc, (num[6] + wint * cq[6]) * sc, (num[7] + wint * cq[7]) * sc);
        }
        __syncthreads();
        {
            const int d = tid >> 2, vq = tid & 3;
            float cn[8];
            const float4 c0 = *(const float4*)(sCT + d * 36 + vq * 8), c1 = *(const float4*)(sCT + d * 36 + vq * 8 + 4);
            cn[0] = decay * c0.x; cn[1] = decay * c0.y; cn[2] = decay * c0.z; cn[3] = decay * c0.w;
            cn[4] = decay * c1.x; cn[5] = decay * c1.y; cn[6] = decay * c1.z; cn[7] = decay * c1.w;
            float nn = decay * sn[d];
            for (int s2 = 0; s2 < 64; ++s2) {
                const float kd = swk[s2] * sk[s2 * ML_LD + d];
                const float4 v0 = *(const float4*)(sv + s2 * 32 + vq * 8), v1 = *(const float4*)(sv + s2 * 32 + vq * 8 + 4);
                cn[0] += kd * v0.x; cn[1] += kd * v0.y; cn[2] += kd * v0.z; cn[3] += kd * v0.w;
                cn[4] += kd * v1.x; cn[5] += kd * v1.y; cn[6] += kd * v1.z; cn[7] += kd * v1.w;
                nn += kd;
            }
            *(float4*)(sCT + d * 36 + vq * 8) = make_float4(cn[0], cn[1], cn[2], cn[3]);
            *(float4*)(sCT + d * 36 + vq * 8 + 4) = make_float4(cn[4], cn[5], cn[6], cn[7]);
            if (vq == 0) sn[d] = nn;
        }
        m_st = ssc[2];
    }
    __syncthreads();
}

__device__ void ph_attn_even(const P& p, int ci, int L, int j, float* smem) {
    int* s_item = (int*)((char*)smem + 73728);
    for (;;) {
        __syncthreads();
        if (otid() == 0) *s_item = atomicAdd(&p.ctr[ci], 1);
        __syncthreads();
        const int item = *s_item;
        if (item >= 256 + 1152) break;
        if (item < 256) mlstm_chunk_item(p, item, j, smem); else da_block(p, item - 256, L, j, (char*)smem);
    }
}
__device__ void ph_attn_odd(const P& p, int j, bool need_ctx, float* smem) {
    const int nitem = need_ctx ? 2304 : 2048;
    for (int item = blockIdx.x; item < nitem; item += gridDim.x) { wa_block(p, item, j, (char*)smem); __syncthreads(); }
}

__device__ void ph_mixout_even(const P& p, int L, int j) {
    const int lane = otid() & 63, wid = otid() >> 6;
    for (int w = blockIdx.x * 4 + wid; w < NT * 4; w += gridDim.x * 4) {
        const int r = w >> 2, hh = w & 3;
        const int c = hh * 128 + lane * 2;
        const float2 f = *(const float2*)(p.HM + (size_t)r * 512 + c), bk = *(const float2*)(p.HM + (size_t)NT * 512 + (size_t)r * 512 + c);
        const float v0 = f.x + bk.x, v1 = f.y + bk.y;
        const float ss = wave_sum(v0 * v0 + v1 * v1);
        const float rstd = rsqrtf(ss * (1.f / 128.f) + 1e-6f);
        const float2 g = *(const float2*)(p.ev_ml_g + (size_t)j * 512 + c);
        const unsigned ou = *(const unsigned*)(p.PB + (size_t)r * 1536 + 1024 + c);
        *(unsigned*)(p.MIX + (size_t)r * DM + c) = cvt_pk_bf16(v0 * rstd * g.x * sigmoid_f(bf_lo(ou)), v1 * rstd * g.y * sigmoid_f(bf_hi(ou)));
    }
}

__device__ __forceinline__ float wave_max(float v) {
#pragma unroll
    for (int o = 32; o > 0; o >>= 1) v = fmaxf(v, __shfl_xor(v, o));
    return v;
}
#define SEL_LD 132
__device__ __forceinline__ unsigned fkey(float f) { const unsigned u = __float_as_uint(f); return (u & 0x80000000u) ? ~u : (u | 0x80000000u); }
__device__ __forceinline__ unsigned mbcnt64(unsigned long long m) { return __builtin_amdgcn_mbcnt_hi((unsigned)(m >> 32), __builtin_amdgcn_mbcnt_lo((unsigned)m, 0u)); }
__device__ void ph_peer_select(const P& p, int L, int nrows, char* smem) {
    float* S = (float*)smem;
    const int tid = otid(), lane = tid & 63, wid = tid >> 6, fr = lane & 15, fq = lane >> 4;
    const bf16_t* KBL = p.KB + (size_t)L * 8 * 2 * 128 * 128;
    const int ntile = nrows / 32;
    for (int item = blockIdx.x; item < ntile * 8; item += gridDim.x) {
        const int h = item & 7, t0 = (item >> 3) * 32;
        __syncthreads();
        {
            const int pp = wid >> 1, th = wid & 1;
            const bf16_t* qp = p.QB + (size_t)(t0 + th * 16 + fr) * 2048 + h * 256 + pp * 128 + fq * 8;
            bf16x8 qf[4];
#pragma unroll
            for (int ks = 0; ks < 4; ++ks) qf[ks] = *(const bf16x8*)(qp + ks * 32);
            const bf16_t* kp = KBL + ((size_t)(h * 2 + pp) * 128 + fr) * 128 + fq * 8;
#pragma unroll
            for (int ni = 0; ni < 8; ++ni) {
                f32x4 acc = (f32x4){0.f, 0.f, 0.f, 0.f};
#pragma unroll
                for (int ks = 0; ks < 4; ++ks) {
                    const bf16x8 kf = *(const bf16x8*)(kp + (size_t)ni * 16 * 128 + ks * 32);
                    acc = __builtin_amdgcn_mfma_f32_16x16x32_bf16(qf[ks], kf, acc, 0, 0, 0);
                }
#pragma unroll
                for (int j = 0; j < 4; ++j) S[(pp * 32 + th * 16 + fq * 4 + j) * SEL_LD + ni * 16 + fr] = acc[j];
            }
        }
        __syncthreads();
        for (int tt = 0; tt < 8; ++tt) {
            const int t = wid * 8 + tt, r = t0 + t;
            const float v00 = S[t * SEL_LD + lane], v01 = S[t * SEL_LD + 64 + lane], v10 = S[(32 + t) * SEL_LD + lane], v11 = S[(32 + t) * SEL_LD + 64 + lane];
            const unsigned ka0 = fkey(v00), ka1 = fkey(v01), kb0 = fkey(v10), kb1 = fkey(v11);
            unsigned T0 = 0u, T1 = 0u;
#pragma unroll 8
            for (int bit = 31; bit >= 0; --bit) {
                const unsigned c0 = T0 | (1u << bit), c1 = T1 | (1u << bit);
                const int n0 = __builtin_popcountll(__ballot(ka0 >= c0)) + __builtin_popcountll(__ballot(ka1 >= c0));
                const int n1 = __builtin_popcountll(__ballot(kb0 >= c1)) + __builtin_popcountll(__ballot(kb1 >= c1));
                if (n0 >= 16) T0 = c0;
                if (n1 >= 16) T1 = c1;
            }
            float* wsA = (float*)(smem + 34816 + wid * 512);
            {
                const unsigned long long g0 = __ballot(ka0 > T0), g1 = __ballot(ka1 > T0), e0 = __ballot(ka0 == T0), e1 = __ballot(ka1 == T0);
                const int need = 16 - __builtin_popcountll(g0) - __builtin_popcountll(g1);
                const int pe0 = __builtin_popcountll(e0), need1 = need - (pe0 < need ? pe0 : need);
                const bool s0 = (ka0 > T0) || (ka0 == T0 && (int)mbcnt64(e0) < need);
                const bool s1 = (ka1 > T0) || (ka1 == T0 && (int)mbcnt64(e1) < need1);
                const unsigned long long m0 = __ballot(s0), m1 = __ballot(s1);
                if (s0) { const int pos = mbcnt64(m0); wsA[pos] = v00; ((int*)wsA)[16 + pos] = lane; }
                if (s1) { const int pos = __builtin_popcountll(m0) + mbcnt64(m1); wsA[pos] = v01; ((int*)wsA)[16 + pos] = 64 + lane; }
            }
            {
                const unsigned long long g0 = __ballot(kb0 > T1), g1 = __ballot(kb1 > T1), e0 = __ballot(kb0 == T1), e1 = __ballot(kb1 == T1);
                const int need = 16 - __builtin_popcountll(g0) - __builtin_popcountll(g1);
                const int pe0 = __builtin_popcountll(e0), need1 = need - (pe0 < need ? pe0 : need);
                const bool s0 = (kb0 > T1) || (kb0 == T1 && (int)mbcnt64(e0) < need);
                const bool s1 = (kb1 > T1) || (kb1 == T1 && (int)mbcnt64(e1) < need1);
                const unsigned long long m0 = __ballot(s0), m1 = __ballot(s1);
                if (s0) { const int pos = mbcnt64(m0); wsA[32 + pos] = v10; ((int*)wsA)[48 + pos] = lane; }
                if (s1) { const int pos = __builtin_popcountll(m0) + mbcnt64(m1); wsA[32 + pos] = v11; ((int*)wsA)[48 + pos] = 64 + lane; }
            }
            __builtin_amdgcn_wave_barrier();
            float cand[4]; int cidx[4]; unsigned kc[4];
            {
                const float av = wsA[lane >> 2]; const int ai = ((int*)wsA)[16 + (lane >> 2)];
                const float4 bv = *(const float4*)(wsA + 32 + (lane & 3) * 4); const int4 bi = *(const int4*)((int*)wsA + 48 + (lane & 3) * 4);
                cand[0] = av + bv.x; cand[1] = av + bv.y; cand[2] = av + bv.z; cand[3] = av + bv.w;
                cidx[0] = ai * 128 + bi.x; cidx[1] = ai * 128 + bi.y; cidx[2] = ai * 128 + bi.z; cidx[3] = ai * 128 + bi.w;
#pragma unroll
                for (int c = 0; c < 4; ++c) kc[c] = fkey(cand[c]);
            }
            unsigned T = 0u;
#pragma unroll 8
            for (int bit = 31; bit >= 0; --bit) {
                const unsigned cc = T | (1u << bit);
                const int n = __builtin_popcountll(__ballot(kc[0] >= cc)) + __builtin_popcountll(__ballot(kc[1] >= cc)) + __builtin_popcountll(__ballot(kc[2] >= cc)) + __builtin_popcountll(__ballot(kc[3] >= cc));
                if (n >= 16) T = cc;
            }
            {
                int need = 16, base = 0;
#pragma unroll
                for (int c = 0; c < 4; ++c) need -= __builtin_popcountll(__ballot(kc[c] > T));
#pragma unroll
                for (int c = 0; c < 4; ++c) {
                    const unsigned long long e = __ballot(kc[c] == T);
                    const bool sel = (kc[c] > T) || (kc[c] == T && (int)mbcnt64(e) < need);
                    const int pe = __builtin_popcountll(e); need -= (pe < need ? pe : need);
                    const unsigned long long m = __ballot(sel);
                    if (sel) { const int pos = base + mbcnt64(m); wsA[64 + pos] = cand[c]; ((int*)wsA)[80 + pos] = cidx[c]; }
                    base += __builtin_popcountll(m);
                }
            }
            __builtin_amdgcn_wave_barrier();
            if (lane < 16) {
                const float cv = wsA[64 + lane];
                float mx = wsA[64];
#pragma unroll
                for (int q = 1; q < 16; ++q) mx = fmaxf(mx, wsA[64 + q]);
                float sum = 0.f;
#pragma unroll
                for (int q = 0; q < 16; ++q) sum += expf(wsA[64 + q] - mx);
                p.GATE[(size_t)r * 128 + h * 16 + lane] = expf(cv - mx) / sum;
                p.EIDX[(size_t)r * 128 + h * 16 + lane] = ((int*)wsA)[80 + lane];
            }
            __builtin_amdgcn_wave_barrier();
        }
    }
}


__device__ __forceinline__ void unpack8(const uint4 u, float* f) {
    f[0] = bf_lo(u.x); f[1] = bf_hi(u.x); f[2] = bf_lo(u.y); f[3] = bf_hi(u.y); f[4] = bf_lo(u.z); f[5] = bf_hi(u.z); f[6] = bf_lo(u.w); f[7] = bf_hi(u.w);
}
__device__ void ph_peer_gather(const P& p, int L, int nrows, float oscale) {
    const int lane = otid() & 63, wid = otid() >> 6;
    const bf16_t* U = p.UB + (size_t)L * 16384 * 1024; const bf16_t* V = p.VB + (size_t)L * 16384 * 1024;
    const float* gate2 = p.modv + (size_t)L * 9 * 6144 + 5120;
    for (int r = blockIdx.x * 4 + wid; r < nrows; r += gridDim.x * 4) {
        const int e0 = p.EIDX[(size_t)r * 128 + lane], e1 = p.EIDX[(size_t)r * 128 + 64 + lane];
        const float g0 = p.GATE[(size_t)r * 128 + lane], g1 = p.GATE[(size_t)r * 128 + 64 + lane];
        float x[16];
        { const uint4 xa = *(const uint4*)(p.XN + (size_t)r * DM + lane * 8), xb = *(const uint4*)(p.XN + (size_t)r * DM + 512 + lane * 8); unpack8(xa, x); unpack8(xb, x + 8); }
        float a0 = 0.f, a1 = 0.f;
#pragma unroll
        for (int half = 0; half < 2; ++half) {
            const int ev = half ? e1 : e0;
            float av = 0.f;
            for (int kb = 0; kb < 8; ++kb) {
                uint4 ua[8], ub[8];
#pragma unroll
                for (int j = 0; j < 8; ++j) {
                    const int idx = __builtin_amdgcn_readlane(ev, kb * 8 + j);
                    const bf16_t* rp = U + (size_t)idx * 1024 + lane * 8;
                    ua[j] = *(const uint4*)rp; ub[j] = *(const uint4*)(rp + 512);
                }
#pragma unroll
                for (int j = 0; j < 8; ++j) {
                    float f[16]; unpack8(ua[j], f); unpack8(ub[j], f + 8);
                    float s = 0.f;
#pragma unroll
                    for (int c = 0; c < 16; ++c) s += x[c] * f[c];
                    s = wave_sum(s);
                    if (lane == kb * 8 + j) av = s;
                }
            }
            if (half) a1 = av; else a0 = av;
        }
        const float w0 = g0 * 0.5f * a0 * (1.f + erff(a0 * 0.70710678118654752f));
        const float w1 = g1 * 0.5f * a1 * (1.f + erff(a1 * 0.70710678118654752f));
        float acc[16];
#pragma unroll
        for (int c = 0; c < 16; ++c) acc[c] = 0.f;
#pragma unroll
        for (int half = 0; half < 2; ++half) {
            const int ev = half ? e1 : e0; const int wv = __float_as_int(half ? w1 : w0);
            for (int kb = 0; kb < 8; ++kb) {
                uint4 ua[8], ub[8];
#pragma unroll
                for (int j = 0; j < 8; ++j) {
                    const int idx = __builtin_amdgcn_readlane(ev, kb * 8 + j);
                    const bf16_t* rp = V + (size_t)idx * 1024 + lane * 8;
                    ua[j] = *(const uint4*)rp; ub[j] = *(const uint4*)(rp + 512);
                }
#pragma unroll
                for (int j = 0; j < 8; ++j) {
                    const float wj = __int_as_float(__builtin_amdgcn_readlane(wv, kb * 8 + j));
                    float f[16]; unpack8(ua[j], f); unpack8(ub[j], f + 8);
#pragma unroll
                    for (int c = 0; c < 16; ++c) acc[c] += wj * f[c];
                }
            }
        }
        const float* gp = gate2 + (size_t)modrow(r) * 6144;
        float* hp = p.H + (size_t)r * DM;
#pragma unroll
        for (int q = 0; q < 4; ++q) {
            const int c = (q >> 1) * 512 + lane * 8 + (q & 1) * 4;
            const float4 g = *(const float4*)(gp + c);
            float4 hv = *(float4*)(hp + c);
            hv.x += oscale * g.x * acc[q * 4 + 0]; hv.y += oscale * g.y * acc[q * 4 + 1]; hv.z += oscale * g.z * acc[q * 4 + 2]; hv.w += oscale * g.w * acc[q * 4 + 3];
            *(float4*)(hp + c) = hv;
        }
    }
}

__device__ void run_phase(const P& p, int ph, float* smem, int rep) {
    if (ph == 0) { ph_prologue(p, smem); return; }
    if (ph == NPH - 1) { ph_final(p); return; }
    const int L = (ph - 1) / 10, s = (ph - 1) % 10, j = L >> 1;
    const bool even = (L & 1) == 0, need_ctx = L < 3;
    const int nrows = need_ctx ? NT : NL;
    const float* mv = p.modv + (size_t)L * 9 * 6144;
    switch (s) {
    case 0: ph_normmod(p.H, p.norm1_g + L * DM, mv, 0, 1024, p.XN, NT); break;
    case 1:
        if (even) ph_gemm(p.XN, p.WT + WT_EVIN(j), NT, 3200, EpiEven{p.PB, p.AQL, p.AQC, p.AK, p.AV, p.GT, p.rope}, (char*)smem);
        else ph_gemm(p.XN, p.WT + WT_ODIN(j), NT, ODW, EpiOdd{p.AQL, p.AQC, p.AK, p.AV, p.rope}, (char*)smem);
        break;
    case 2: if (even) ph_prep_even(p, j); break;
    case 3: if (even) ph_attn_even(p, L + 4 * rep, L, j, smem); else ph_attn_odd(p, j, need_ctx, smem); break;
    case 4: if (even) ph_mixout_even(p, L, j); break;
    case 5:
        ph_gemm(p.MIX, p.WT + (even ? WT_EVOUT(j) : WT_ODOUT(j)), nrows, DM, EpiResid{p.H, mv + 2048, rep ? 0.f : 1.f}, (char*)smem);
        break;
    case 6: ph_normmod(p.H, p.norm2_g + L * DM, mv, 3072, 4096, p.XN, nrows); break;
    case 7: ph_gemm(p.XN, p.WT + WT_PQ(L), nrows, 2048, EpiStoreBF16{p.QB, 2048}, (char*)smem); break;
    case 8: ph_peer_select(p, L, nrows, (char*)smem); break;
    case 9: ph_peer_gather(p, L, nrows, rep ? 0.f : 1.f); break;
    }
}


#define XB_TMO      128
#define XB_XCNT(j)  (256  + 64 * (j))
#define XB_XSUB(j)  (1280 + 64 * (j))
#define XB_XGEN(j)  (2304 + 64 * (j))
#define XB_TOP      3328
#define XB_TOPGEN   3392
#define XCD_BAR_WORDS 3456
#define XB_SPIN_CAP (1u << 20)
#define LAS __attribute__((address_space(3)))
__device__ __forceinline__ unsigned xb_ld(unsigned* p)              { return __hip_atomic_load(p, __ATOMIC_RELAXED, __HIP_MEMORY_SCOPE_AGENT); }
__device__ __forceinline__ unsigned xb_add(unsigned* p, unsigned v) { return __hip_atomic_fetch_add(p, v, __ATOMIC_RELAXED, __HIP_MEMORY_SCOPE_AGENT); }
__device__ __forceinline__ unsigned xb_xcc_id() { return (unsigned)__builtin_amdgcn_s_getreg((3 << 11) | 20) & 0xFu; }
#define XB_SPIN(cond, bar) do { unsigned _sp = 0; while (cond) { __builtin_amdgcn_s_sleep(1); \
    if ((++_sp & 255u) == 0u) { if (xb_ld(&(bar)[XB_TMO])) break; if (_sp > XB_SPIN_CAP) { atomicAdd(&(bar)[XB_TMO], 1u); break; } } } } while (0)
struct XcdBarrier { unsigned* bar; unsigned x; volatile LAS unsigned* st; };
__device__ __forceinline__ XcdBarrier xcd_barrier_post(unsigned* bar, volatile LAS unsigned* st) {
    XcdBarrier b; b.bar = bar; b.x = xb_xcc_id(); b.st = st;
    if (threadIdx.x == 0) (void)xb_add(&bar[XB_XCNT(b.x)], 1u);
    return b;
}
__device__ __forceinline__ void xcd_barrier_complete(unsigned* bar, unsigned x, unsigned& nloc, unsigned& nx) {
    const unsigned G = gridDim.x * gridDim.y * gridDim.z;
    unsigned sum, cnt, mine, sp = 0u;
    for (;;) {
        sum = 0u; cnt = 0u; mine = 0u;
#pragma unroll
        for (unsigned j = 0; j < 16; ++j) { const unsigned c = xb_ld(&bar[XB_XCNT(j)]); sum += c; cnt += (c > 0u) ? 1u : 0u; mine = (j == x) ? c : mine; }
        if (sum == G) break;
        __builtin_amdgcn_s_sleep(1);
        if ((++sp & 255u) == 0u) { if (xb_ld(&bar[XB_TMO])) break; if (sp > XB_SPIN_CAP) { atomicAdd(&bar[XB_TMO], 1u); break; } }
    }
    nloc = mine > 0u ? mine : 1u; nx = cnt > 0u ? cnt : 1u;
}
__device__ __forceinline__ void xcd_barrier(const XcdBarrier& b) {
    asm volatile("s_waitcnt vmcnt(0)" ::: "memory");
    __syncthreads();
    if (threadIdx.x == 0) {
        unsigned* bar = b.bar;
        __builtin_amdgcn_s_waitcnt(0);
        unsigned nloc = b.st[0], nx = b.st[1];
        if (nloc == 0u) { xcd_barrier_complete(bar, b.x, nloc, nx); b.st[0] = nloc; b.st[1] = nx; }
        const unsigned old = xb_add(&bar[XB_XSUB(b.x)], 1u);
        const unsigned gen = old / nloc;
        if (old + 1u == (gen + 1u) * nloc) {
            __builtin_amdgcn_fence(__ATOMIC_RELEASE, "agent");
            asm volatile("s_waitcnt vmcnt(0)" ::: "memory");
            const unsigned og = xb_add(&bar[XB_TOP], 1u);
            const unsigned tg = og / nx;
            if (og + 1u == (tg + 1u) * nx) xb_add(&bar[XB_TOPGEN], 1u);
            else XB_SPIN(xb_ld(&bar[XB_TOPGEN]) == tg, bar);
            __builtin_amdgcn_fence(__ATOMIC_ACQUIRE, "agent");
            xb_add(&bar[XB_XGEN(b.x)], 1u);
            asm volatile("s_waitcnt vmcnt(0)" ::: "memory");
        } else {
            XB_SPIN(xb_ld(&bar[XB_XGEN(b.x)]) == gen, bar);
            __builtin_amdgcn_fence(__ATOMIC_ACQUIRE, "agent");
            asm volatile("s_waitcnt vmcnt(0)" ::: "memory");
        }
    }
    __syncthreads();
}

__global__ void __launch_bounds__(256, 2) mega(P p) {
    extern __shared__ __attribute__((aligned(16))) float smem[];
    cg::grid_group grid = cg::this_grid();
    volatile LAS unsigned* st = (volatile LAS unsigned*)((char*)smem + 73744);
    if (threadIdx.x < 4) st[threadIdx.x] = 0u;
    __syncthreads();
    XcdBarrier xb = xcd_barrier_post(p.bar, st);
    for (int ph = p.ph_lo; ph < p.ph_hi; ++ph) {
        run_phase(p, ph, smem, 0);
        if (PROBE_N > 1 && ph > 0 && ph < NPH - 1 && (ph - 1) % 10 == PROBE_S)
            for (int rep = 1; rep < PROBE_N; ++rep) { xcd_barrier(xb); run_phase(p, ph, smem, rep); }
        if (ph + 1 < p.ph_hi) { if (ph == 0) grid.sync(); else xcd_barrier(xb); }
    }
}

extern "C" void kernel_launch(void* const* d_in, const int* in_sizes, int n_in, void* d_out, int out_size, void* d_ws, size_t ws_size, hipStream_t stream) {
    static int grid_blocks = 0;
    if (!grid_blocks) {
        int dev = 0, cus = 0, per_cu = 0;
        hipGetDevice(&dev);
        hipDeviceGetAttribute(&cus, hipDeviceAttributeMultiprocessorCount, dev);
        hipFuncSetAttribute((const void*)mega, hipFuncAttributeMaxDynamicSharedMemorySize, LDS_BYTES);
        hipOccupancyMaxActiveBlocksPerMultiprocessor(&per_cu, mega, 256, LDS_BYTES);
        if (per_cu < 1) per_cu = 1;
        if (per_cu > 2) per_cu = 2;
        grid_blocks = cus * per_cu;
    }
    P p{};
    const float** ins = (const float**)&p;
    for (int i = 0; i < 24; ++i) ins[i] = (const float*)d_in[i];
    p.out = (float*)d_out;
    size_t off = 0; char* ws = (char*)d_ws;
    auto carve = [&](size_t bytes) { void* r = ws + off; off += (bytes + 255) & ~(size_t)255; return r; };
    p.modv = (float*)carve((size_t)4 * 9 * 6144 * 4);
    p.rope = (float*)carve((size_t)2048 * 64 * 4);
    p.H = (float*)carve((size_t)NT * DM * 4);
    p.XN = (bf16_t*)carve((size_t)NT * DM * 2);
    p.WT = (bf16_t*)carve(WT_TOTAL * 2);
    p.MIX = (bf16_t*)carve((size_t)NT * DM * 2);
    p.PB = (bf16_t*)carve((size_t)NT * 1536 * 2);
    p.GT = (float*)carve((size_t)NT * 16 * 4);
    p.AQL = (bf16_t*)carve((size_t)8 * 16 * 2048 * 64 * 2);
    p.AQC = (bf16_t*)carve((size_t)8 * 16 * 256 * 64 * 2);
    p.AK = (bf16_t*)carve((size_t)8 * 4 * 2 * 2304 * 64 * 2);
    p.AV = (bf16_t*)carve((size_t)8 * 4 * 128 * 2304 * 2);
    p.QKC = (float*)carve((size_t)NT * 512 * 4);
    p.HM = (float*)carve((size_t)2 * NT * 512 * 4);
    p.QB = (bf16_t*)carve((size_t)NT * 2048 * 2);
    p.GATE = (float*)carve((size_t)NT * 128 * 4);
    p.EIDX = (int*)carve((size_t)NT * 128 * 4);
    p.ctr = (int*)carve(256);
    p.bar = (unsigned*)carve((size_t)XCD_BAR_WORDS * 4);
    p.UB = (bf16_t*)carve((size_t)4 * 16384 * 1024 * 2);
    p.VB = (bf16_t*)carve((size_t)4 * 16384 * 1024 * 2);
    p.KB = (bf16_t*)carve((size_t)4 * 8 * 2 * 128 * 128 * 2);
    if (off > ws_size) { fprintf(stderr, "kernel_launch: workspace too small: need %zu have %zu\n", off, ws_size); return; }
    hipMemsetAsync(p.bar, 0, (size_t)XCD_BAR_WORDS * 4, stream);
#if ONE_LAUNCH
    p.ph_lo = 0; p.ph_hi = NPH;
    void* args[] = {&p};
    hipError_t e = hipLaunchCooperativeKernel((void*)mega, dim3(grid_blocks), dim3(256), args, LDS_BYTES, stream);
    if (e != hipSuccess) fprintf(stderr, "cooperative launch failed: %s (grid %d)\n", hipGetErrorString(e), grid_blocks);
#else
    for (int ph = 0; ph < NPH; ++ph) {
        if (ph > 0 && ph < NPH - 1) { const int L = (ph - 1) / 10, s = (ph - 1) % 10; if ((s == 4 || s == 2) && (L & 1)) continue; }
        p.ph_lo = ph; p.ph_hi = ph + 1;
        hipLaunchKernelGGL(mega, dim3(grid_blocks), dim3(256), LDS_BYTES, stream, p);
    }
#endif
}
```

```cpp
#include <hip/hip_runtime.h>
#include <hip/hip_cooperative_groups.h>
#include <cstdio>
#include <cstdint>
namespace cg = cooperative_groups;

#ifndef ONE_LAUNCH
#define ONE_LAUNCH 1
#endif

#define NT 18432
#define NL 16384
#define DM 1024
#define EVW 3088
#define ODW 1536
#define C_QK 0
#define C_V 512
#define C_O 1024
#define C_G 1536
#define C_DQ 1552
#define C_DK 2064
#define C_DV 2576
#define NPH 42
#ifndef PROBE_S
#define PROBE_S -1
#endif
#ifndef PROBE_N
#define PROBE_N 1
#endif

typedef unsigned short bf16_t;
typedef short bf16x8 __attribute__((ext_vector_type(8)));
typedef float f32x4 __attribute__((ext_vector_type(4)));
#define LDS_BYTES 73792

typedef float f32x16 __attribute__((ext_vector_type(16)));
typedef unsigned u32x4 __attribute__((ext_vector_type(4)));
struct P {
    const float *x, *c, *ctx, *c_ctx, *mod_w, *mod_b, *norm1_g, *norm2_g, *ev_w_in, *ev_conv_w, *ev_conv_b, *ev_gate_b,
        *ev_ml_g, *ev_da_lam, *ev_da_g, *ev_w_out, *od_w_in, *od_sink, *od_w_out, *pr_w_q, *pr_keys, *pr_u, *pr_v, *final_g;
    float* out;
    float *modv, *H, *QKC, *HM, *GATE, *rope, *GT;
    int *EIDX, *ctr;
    unsigned* bar;
    bf16_t *XN, *MIX, *WT, *KB, *QB, *PB, *AQL, *AQC, *AK, *AV;
    unsigned char *U8, *V8;
    float *USC, *VSC;
    int ph_lo, ph_hi;
};
#define QSCALE 0.18033688011112042f

__device__ __forceinline__ int otid() { int t = threadIdx.x; asm volatile("" : "+v"(t)); return t; }
__device__ __forceinline__ int modrow(int r) { return r < NL ? (r >> 11) : 8; }
__device__ __forceinline__ float silu_f(float x) { return x / (1.f + expf(-x)); }
__device__ __forceinline__ float sigmoid_f(float x) { return 1.f / (1.f + expf(-x)); }
__device__ __forceinline__ float log_sigmoid_f(float x) { return fminf(x, 0.f) - log1pf(expf(-fabsf(x))); }
typedef __bf16 bf16v2_t __attribute__((ext_vector_type(2)));
typedef float f32x2_t __attribute__((ext_vector_type(2)));
__device__ __forceinline__ unsigned cvt_pk_bf16(float lo, float hi) { const bf16v2_t v = __builtin_convertvector((f32x2_t){lo, hi}, bf16v2_t); return __builtin_bit_cast(unsigned, v); }
__device__ __forceinline__ float bf_lo(unsigned u) { return __uint_as_float(u << 16); }
__device__ __forceinline__ float bf_hi(unsigned u) { return __uint_as_float(u & 0xffff0000u); }
#define WT_EVIN(j) ((size_t)(j) * 3200 * 1024)
#define WT_EVOUT(j) ((size_t)2 * 3200 * 1024 + (size_t)(j) * 1024 * 1024)
#define WT_ODIN(j) ((size_t)2 * 3200 * 1024 + (size_t)2 * 1024 * 1024 + (size_t)(j) * 1536 * 1024)
#define WT_ODOUT(j) ((size_t)2 * 3200 * 1024 + (size_t)2 * 1024 * 1024 + (size_t)2 * 1536 * 1024 + (size_t)(j) * 1024 * 1024)
#define WT_PQ(L) ((size_t)2 * 3200 * 1024 + (size_t)4 * 1024 * 1024 + (size_t)2 * 1536 * 1024 + (size_t)(L) * 2048 * 1024)
#define WT_TOTAL ((size_t)2 * 3200 * 1024 + (size_t)4 * 1024 * 1024 + (size_t)2 * 1536 * 1024 + (size_t)4 * 2048 * 1024)
__device__ __forceinline__ float wave_sum(float v) {
#pragma unroll
    for (int o = 32; o > 0; o >>= 1) v += __shfl_xor(v, o);
    return v;
}

__device__ void cvt_copy_bf16(const float* src, bf16_t* dst, size_t n);
__device__ void quant_rows_i8(const float* src, unsigned char* dst, float* scl, int nrows);
__device__ void ph_prologue(const P& p, float* smem) {
    const int tid = otid(), nb = gridDim.x, bid = blockIdx.x;
    if (bid == 0 && tid < 64) p.ctr[tid] = 0;
    {
        const float4* xs = (const float4*)p.x; const float4* cs = (const float4*)p.ctx; float4* hd = (float4*)p.H;
        const size_t nx = (size_t)NL * DM / 4, nc = (size_t)(NT - NL) * DM / 4;
        for (size_t i = (size_t)bid * 256 + tid; i < nx + nc; i += (size_t)nb * 256) hd[i] = i < nx ? xs[i] : cs[i - nx];
    }
    for (int i = bid * 256 + tid; i < 2048 * 32; i += nb * 256) {
        const int s = i >> 5, d = i & 31;
        const float pos = (d < 16) ? (float)(s >> 6) : (float)(s & 63);
        const float inv = powf(10000.0f, -(float)(d & 15) / 16.0f);
        const float ang = pos * inv;
        p.rope[2 * i] = cosf(ang); p.rope[2 * i + 1] = sinf(ang);
    }
    float* sc = smem;
    float* red = smem + 9 * 1024;
    for (int i = tid; i < 9 * 1024; i += 256) { const int r = i >> 10, k = i & 1023; const float v = r < 8 ? p.c[r * 1024 + k] : p.c_ctx[k]; sc[i] = silu_f(v); }
    __syncthreads();
    for (int item = bid; item < 4 * 96; item += nb) {
        const int L = item / 96, n0 = (item % 96) * 64, tx = tid & 63, kq = tid >> 6;
        float acc[9];
#pragma unroll
        for (int r = 0; r < 9; ++r) acc[r] = 0.f;
        const float* w = p.mod_w + (size_t)L * 1024 * 6144 + n0 + tx;
        for (int k = kq * 256; k < kq * 256 + 256; ++k) {
            const float wv = w[(size_t)k * 6144];
#pragma unroll
            for (int r = 0; r < 9; ++r) acc[r] += sc[r * 1024 + k] * wv;
        }
#pragma unroll
        for (int r = 0; r < 9; ++r) red[(kq * 9 + r) * 64 + tx] = acc[r];
        __syncthreads();
        if (kq == 0) {
#pragma unroll
            for (int r = 0; r < 9; ++r) {
                const float s = red[(0 * 9 + r) * 64 + tx] + red[(1 * 9 + r) * 64 + tx] + red[(2 * 9 + r) * 64 + tx] + red[(3 * 9 + r) * 64 + tx];
                p.modv[((size_t)L * 9 + r) * 6144 + n0 + tx] = s + p.mod_b[L * 6144 + n0 + tx];
            }
        }
        __syncthreads();
    }
    {
        float (*tile)[65] = (float (*)[65])smem;
        for (int item = bid; item < 5440; item += nb) {
            int it = item, mat = 0, N = 0, Npad = 0; const float* src = nullptr; bf16_t* dst = nullptr;
            for (mat = 0; mat < 12; ++mat) {
                if (mat < 2) { N = EVW; Npad = 3200; src = p.ev_w_in + (size_t)mat * DM * EVW; dst = p.WT + WT_EVIN(mat); }
                else if (mat < 4) { N = 1024; Npad = 1024; src = p.ev_w_out + (size_t)(mat - 2) * DM * DM; dst = p.WT + WT_EVOUT(mat - 2); }
                else if (mat < 6) { N = ODW; Npad = ODW; src = p.od_w_in + (size_t)(mat - 4) * DM * ODW; dst = p.WT + WT_ODIN(mat - 4); }
                else if (mat < 8) { N = 1024; Npad = 1024; src = p.od_w_out + (size_t)(mat - 6) * DM * DM; dst = p.WT + WT_ODOUT(mat - 6); }
                else { N = 2048; Npad = 2048; src = p.pr_w_q + (size_t)(mat - 8) * DM * 2048; dst = p.WT + WT_PQ(mat - 8); }
                const int nt = 16 * (Npad / 64);
                if (it < nt) break;
                it -= nt;
            }
            const int k0 = (it & 15) * 64, n0 = (it >> 4) * 64;
            __syncthreads();
#pragma unroll
            for (int rep = 0; rep < 4; ++rep) {
                const int i = (tid >> 4) + 16 * rep, c4 = (tid & 15) * 4;
                float4 v = make_float4(0.f, 0.f, 0.f, 0.f);
                int sc = n0 + c4;
                if (mat < 2) sc = sc < 1536 ? sc : (sc < 3072 ? sc + 16 : (sc < 3088 ? sc - 3072 + 1536 : N));
                if (sc < N) v = *(const float4*)(src + (size_t)(k0 + i) * N + sc);
                tile[i][c4] = v.x; tile[i][c4 + 1] = v.y; tile[i][c4 + 2] = v.z; tile[i][c4 + 3] = v.w;
            }
            __syncthreads();
            {
                const int n = tid >> 2, kq = (tid & 3) * 16;
                unsigned w[8];
#pragma unroll
                for (int e = 0; e < 8; ++e) w[e] = cvt_pk_bf16(tile[kq + 2 * e][n], tile[kq + 2 * e + 1][n]);
                uint4* dp = (uint4*)(dst + (size_t)(n0 + n) * DM + k0 + kq);
                dp[0] = make_uint4(w[0], w[1], w[2], w[3]); dp[1] = make_uint4(w[4], w[5], w[6], w[7]);
            }
        }
    }
    quant_rows_i8(p.pr_u, p.U8, p.USC, 4 * 16384);
    quant_rows_i8(p.pr_v, p.V8, p.VSC, 4 * 16384);
    cvt_copy_bf16(p.pr_keys, p.KB, (size_t)4 * 8 * 2 * 128 * 128);
}

__device__ void cvt_copy_bf16(const float* src, bf16_t* dst, size_t n) {
    const size_t n8 = n / 8;
    for (size_t i = (size_t)blockIdx.x * 256 + otid(); i < n8; i += (size_t)gridDim.x * 256) {
        const float4 a = ((const float4*)src)[2 * i], b = ((const float4*)src)[2 * i + 1];
        ((uint4*)dst)[i] = make_uint4(cvt_pk_bf16(a.x, a.y), cvt_pk_bf16(a.z, a.w), cvt_pk_bf16(b.x, b.y), cvt_pk_bf16(b.z, b.w));
    }
}

__device__ void quant_rows_i8(const float* src, unsigned char* dst, float* scl, int nrows) {
    const int lane = otid() & 63, wid = otid() >> 6;
    for (int r = blockIdx.x * 4 + wid; r < nrows; r += gridDim.x * 4) {
        const float4* sp = (const float4*)(src + (size_t)r * 1024 + lane * 16);
        float4 v[4]; float mx = 0.f;
#pragma unroll
        for (int i = 0; i < 4; ++i) { v[i] = sp[i]; mx = fmaxf(mx, fmaxf(fmaxf(fabsf(v[i].x), fabsf(v[i].y)), fmaxf(fabsf(v[i].z), fabsf(v[i].w)))); }
#pragma unroll
        for (int o = 32; o > 0; o >>= 1) mx = fmaxf(mx, __shfl_xor(mx, o));
        const float inv = mx > 0.f ? 127.f / mx : 0.f;
        unsigned w[4];
#pragma unroll
        for (int i = 0; i < 4; ++i) {
            const unsigned b0 = (unsigned)((int)rintf(v[i].x * inv) + 128), b1 = (unsigned)((int)rintf(v[i].y * inv) + 128), b2 = (unsigned)((int)rintf(v[i].z * inv) + 128), b3 = (unsigned)((int)rintf(v[i].w * inv) + 128);
            w[i] = b0 | (b1 << 8) | (b2 << 16) | (b3 << 24);
        }
        *(uint4*)(dst + (size_t)r * 1024 + lane * 16) = make_uint4(w[0], w[1], w[2], w[3]);
        if (lane == 0) scl[r] = mx * (1.f / 127.f);
    }
}

__device__ void ph_normmod(const float* src, const float* g, const float* modv_layer, int shift_off, int scale_off, bf16_t* dst, int nrows) {
    const int lane = otid() & 63, wid = otid() >> 6;
    for (int r = blockIdx.x * 4 + wid; r < nrows; r += gridDim.x * 4) {
        const float4* s4 = (const float4*)(src + (size_t)r * DM);
        float4 v[4]; float ss = 0.f;
#pragma unroll
        for (int i = 0; i < 4; ++i) { v[i] = s4[i * 64 + lane]; ss += v[i].x * v[i].x + v[i].y * v[i].y + v[i].z * v[i].z + v[i].w * v[i].w; }
        ss = wave_sum(ss);
        const float rstd = rsqrtf(ss * (1.0f / DM) + 1e-6f);
        const float* mv = modv_layer + (size_t)modrow(r) * 6144;
        uint2* d2 = (uint2*)(dst + (size_t)r * DM);
#pragma unroll
        for (int i = 0; i < 4; ++i) {
            const int c = (i * 64 + lane) * 4;
            const float4 gg = *(const float4*)(g + c), sh = *(const float4*)(mv + shift_off + c), scl = *(const float4*)(mv + scale_off + c);
            float4 o;
            o.x = v[i].x * rstd * gg.x * (1.f + scl.x) + sh.x; o.y = v[i].y * rstd * gg.y * (1.f + scl.y) + sh.y;
            o.z = v[i].z * rstd * gg.z * (1.f + scl.z) + sh.z; o.w = v[i].w * rstd * gg.w * (1.f + scl.w) + sh.w;
            d2[i * 64 + lane] = make_uint2(cvt_pk_bf16(o.x, o.y), cvt_pk_bf16(o.z, o.w));
        }
    }
}

__device__ void ph_final(const P& p) {
    const int lane = otid() & 63, wid = otid() >> 6;
    for (int r = blockIdx.x * 4 + wid; r < NL; r += gridDim.x * 4) {
        const float4* s4 = (const float4*)(p.H + (size_t)r * DM);
        float4 v[4]; float ss = 0.f;
#pragma unroll
        for (int i = 0; i < 4; ++i) { v[i] = s4[i * 64 + lane]; ss += v[i].x * v[i].x + v[i].y * v[i].y + v[i].z * v[i].z + v[i].w * v[i].w; }
        ss = wave_sum(ss);
        const float rstd = rsqrtf(ss * (1.0f / DM) + 1e-6f);
        float4* d4 = (float4*)(p.out + (size_t)r * DM);
#pragma unroll
        for (int i = 0; i < 4; ++i) {
            const int c = (i * 64 + lane) * 4; const float4 gg = *(const float4*)(p.final_g + c);
            float4 o; o.x = v[i].x * rstd * gg.x; o.y = v[i].y * rstd * gg.y; o.z = v[i].z * rstd * gg.z; o.w = v[i].w * rstd * gg.w;
            d4[i * 64 + lane] = o;
        }
    }
}

#define GL_ROWB 144
#define GL_TILEB (128 * GL_ROWB)
struct TokPos { int b, pos, kpos; bool lat; };
__device__ __forceinline__ TokPos tokpos(int row) {
    TokPos t; t.lat = row < NL;
    if (t.lat) { t.b = row >> 11; t.pos = row & 2047; t.kpos = 256 + t.pos; } else { const int r = row - NL; t.b = r >> 8; t.pos = r & 255; t.kpos = t.pos; }
    return t;
}
struct EpiStoreBF16 {
    bf16_t* C; int ldc;
    __device__ __forceinline__ bool swapped(int) const { return false; }
    __device__ __forceinline__ void operator()(const f32x4 (&acc)[4][4], int m0, int n0, int wm, int wn, int fr, int fq) const {
#pragma unroll
        for (int mi = 0; mi < 4; ++mi)
#pragma unroll
            for (int ni = 0; ni < 4; ++ni) {
                const f32x4 v = acc[ni][mi];
                *(uint2*)(C + (size_t)(m0 + wm * 64 + mi * 16 + fr) * ldc + n0 + wn * 64 + ni * 16 + fq * 4) = make_uint2(cvt_pk_bf16(v[0], v[1]), cvt_pk_bf16(v[2], v[3]));
            }
    }
};
struct EpiResid {
    float* H; const float* gate; float scale;
    __device__ __forceinline__ bool swapped(int) const { return false; }
    __device__ __forceinline__ void operator()(const f32x4 (&acc)[4][4], int m0, int n0, int wm, int wn, int fr, int fq) const {
#pragma unroll
        for (int mi = 0; mi < 4; ++mi) {
            const int row = m0 + wm * 64 + mi * 16 + fr;
            const float* gp = gate + (size_t)modrow(row) * 6144;
#pragma unroll
            for (int ni = 0; ni < 4; ++ni) {
                const int col = n0 + wn * 64 + ni * 16 + fq * 4;
                const f32x4 g = *(const f32x4*)(gp + col);
                f32x4* hp = (f32x4*)(H + (size_t)row * DM + col);
                *hp = *hp + g * acc[ni][mi] * scale;
            }
        }
    }
};
__device__ __forceinline__ void rope_store64(const f32x4 (&acc)[4][4], int mi, bool do_rope, const float* ropep  , float scale, bf16_t* dst  , int fq) {
#pragma unroll
    for (int ni = 0; ni < 2; ++ni) {
        f32x4 x1 = acc[ni][mi], x2 = acc[ni + 2][mi];
        if (do_rope) {
            const f32x4 r0 = *(const f32x4*)(ropep + (ni * 16 + fq * 4) * 2), r1 = *(const f32x4*)(ropep + (ni * 16 + fq * 4) * 2 + 4);
            const f32x4 cs = (f32x4){r0[0], r0[2], r1[0], r1[2]}, sn = (f32x4){r0[1], r0[3], r1[1], r1[3]};
            const f32x4 y1 = x1 * cs - x2 * sn, y2 = x1 * sn + x2 * cs;
            x1 = y1; x2 = y2;
        }
        x1 = x1 * scale; x2 = x2 * scale;
        *(uint2*)(dst + ni * 16 + fq * 4) = make_uint2(cvt_pk_bf16(x1[0], x1[1]), cvt_pk_bf16(x1[2], x1[3]));
        *(uint2*)(dst + 32 + ni * 16 + fq * 4) = make_uint2(cvt_pk_bf16(x2[0], x2[1]), cvt_pk_bf16(x2[2], x2[3]));
    }
}
struct EpiEven {
    bf16_t *PB, *AQL, *AQC, *AK, *AV; float* GT; const float* rope;
    __device__ __forceinline__ bool swapped(int n0) const { return n0 >= 2560 && n0 < 3072; }
    __device__ __forceinline__ void operator()(const f32x4 (&acc)[4][4], int m0, int n0, int wm, int wn, int fr, int fq) const {
        const int t = n0 >> 7;
        if (t < 12) {
#pragma unroll
            for (int mi = 0; mi < 4; ++mi)
#pragma unroll
                for (int ni = 0; ni < 4; ++ni) {
                    const f32x4 v = acc[ni][mi];
                    *(uint2*)(PB + (size_t)(m0 + wm * 64 + mi * 16 + fr) * 1536 + n0 + wn * 64 + ni * 16 + fq * 4) = make_uint2(cvt_pk_bf16(v[0], v[1]), cvt_pk_bf16(v[2], v[3]));
                }
        } else if (t < 20) {
            const bool isq = t < 16; const int h = t & 3;
#pragma unroll
            for (int mi = 0; mi < 4; ++mi) {
                const TokPos tp = tokpos(m0 + wm * 64 + mi * 16 + fr);
                const int hm = (tp.b * 4 + h) * 2 + wn;
                bf16_t* dst;
                if (isq) dst = tp.lat ? AQL + ((size_t)hm * 2048 + tp.pos) * 64 : AQC + ((size_t)hm * 256 + tp.pos) * 64;
                else dst = AK + ((size_t)hm * 2304 + tp.kpos) * 64;
                rope_store64(acc, mi, tp.lat, rope + (size_t)tp.pos * 64, isq ? QSCALE : 1.0f, dst, fq);
            }
        } else if (t < 24) {
            const int h = t - 20;
#pragma unroll
            for (int mi = 0; mi < 4; ++mi) {
                const TokPos tp = tokpos(m0 + wm * 64 + mi * 16 + fq * 4);
#pragma unroll
                for (int ni = 0; ni < 4; ++ni) {
                    const f32x4 v = acc[ni][mi];
                    const int d = wn * 64 + ni * 16 + fr;
                    *(uint2*)(AV + ((size_t)(tp.b * 4 + h) * 128 + d) * 2304 + tp.kpos) = make_uint2(cvt_pk_bf16(v[0], v[1]), cvt_pk_bf16(v[2], v[3]));
                }
            }
        } else {
            if (wn == 0) {
#pragma unroll
                for (int mi = 0; mi < 4; ++mi) *(f32x4*)(GT + (size_t)(m0 + wm * 64 + mi * 16 + fr) * 16 + fq * 4) = acc[0][mi];
            }
        }
    }
};
struct EpiOdd {
    bf16_t *AQL, *AQC, *AK, *AV; const float* rope;
    __device__ __forceinline__ bool swapped(int n0) const { return n0 >= 1280; }
    __device__ __forceinline__ void operator()(const f32x4 (&acc)[4][4], int m0, int n0, int wm, int wn, int fr, int fq) const {
        const int t = n0 >> 7;
        if (t < 10) {
            const bool isq = t < 8; const int hd = isq ? t * 2 + wn : (t - 8) * 2 + wn;
#pragma unroll
            for (int mi = 0; mi < 4; ++mi) {
                const TokPos tp = tokpos(m0 + wm * 64 + mi * 16 + fr);
                bf16_t* dst;
                if (isq) dst = tp.lat ? AQL + ((size_t)(tp.b * 16 + hd) * 2048 + tp.pos) * 64 : AQC + ((size_t)(tp.b * 16 + hd) * 256 + tp.pos) * 64;
                else dst = AK + ((size_t)(tp.b * 4 + hd) * 2304 + tp.kpos) * 64;
                rope_store64(acc, mi, tp.lat, rope + (size_t)tp.pos * 64, isq ? QSCALE : 1.0f, dst, fq);
            }
        } else {
            const int hkv = (t - 10) * 2 + wn;
#pragma unroll
            for (int mi = 0; mi < 4; ++mi) {
                const TokPos tp = tokpos(m0 + wm * 64 + mi * 16 + fq * 4);
#pragma unroll
                for (int ni = 0; ni < 4; ++ni) {
                    const f32x4 v = acc[ni][mi];
                    const int d = ni * 16 + fr;
                    *(uint2*)(AV + ((size_t)(tp.b * 4 + hkv) * 64 + d) * 2304 + tp.kpos) = make_uint2(cvt_pk_bf16(v[0], v[1]), cvt_pk_bf16(v[2], v[3]));
                }
            }
        }
    }
};
template <bool SWAP>
__device__ __forceinline__ void gemm_tile_kloop(f32x4 (&acc)[4][4], const bf16_t* ap, const bf16_t* bp, char* smem, int lrow, int lch, int wm, int wn, int fr, int fq) {
    uint4 ra0, ra1, ra2, ra3, rb0, rb1, rb2, rb3;
#define GL_LOAD(KO) { ra0 = *(const uint4*)(ap + (KO)); ra1 = *(const uint4*)(ap + (size_t)32 * DM + (KO)); ra2 = *(const uint4*)(ap + (size_t)64 * DM + (KO)); ra3 = *(const uint4*)(ap + (size_t)96 * DM + (KO)); \
                      rb0 = *(const uint4*)(bp + (KO)); rb1 = *(const uint4*)(bp + (size_t)32 * DM + (KO)); rb2 = *(const uint4*)(bp + (size_t)64 * DM + (KO)); rb3 = *(const uint4*)(bp + (size_t)96 * DM + (KO)); }
#define GL_STORE(BUF) { char* sa_ = (BUF) + lrow * GL_ROWB + lch * 16; char* sb_ = sa_ + GL_TILEB; \
                        *(uint4*)(sa_) = ra0; *(uint4*)(sa_ + 32 * GL_ROWB) = ra1; *(uint4*)(sa_ + 64 * GL_ROWB) = ra2; *(uint4*)(sa_ + 96 * GL_ROWB) = ra3; \
                        *(uint4*)(sb_) = rb0; *(uint4*)(sb_ + 32 * GL_ROWB) = rb1; *(uint4*)(sb_ + 64 * GL_ROWB) = rb2; *(uint4*)(sb_ + 96 * GL_ROWB) = rb3; }
    GL_LOAD(0)
    __syncthreads();
    GL_STORE(smem)
    __syncthreads();
    for (int kt = 0; kt < 16; ++kt) {
        char* cur = smem + (kt & 1) * 2 * GL_TILEB;
        char* nxt = smem + ((kt + 1) & 1) * 2 * GL_TILEB;
        if (kt + 1 < 16) GL_LOAD((kt + 1) * 64)
#pragma unroll
        for (int ks = 0; ks < 2; ++ks) {
            bf16x8 af[4], wf[4];
#pragma unroll
            for (int i = 0; i < 4; ++i) {
                af[i] = *(const bf16x8*)(cur + (wm * 64 + i * 16 + fr) * GL_ROWB + (ks * 4 + fq) * 16);
                wf[i] = *(const bf16x8*)(cur + GL_TILEB + (wn * 64 + i * 16 + fr) * GL_ROWB + (ks * 4 + fq) * 16);
            }
#pragma unroll
            for (int ni = 0; ni < 4; ++ni)
#pragma unroll
                for (int mi = 0; mi < 4; ++mi)
                    acc[ni][mi] = SWAP ? __builtin_amdgcn_mfma_f32_16x16x32_bf16(af[mi], wf[ni], acc[ni][mi], 0, 0, 0)
                                       : __builtin_amdgcn_mfma_f32_16x16x32_bf16(wf[ni], af[mi], acc[ni][mi], 0, 0, 0);
        }
        if (kt + 1 < 16) GL_STORE(nxt)
        __syncthreads();
    }
#undef GL_LOAD
#undef GL_STORE
}
template <class Epi>
__device__ void ph_gemm(const bf16_t* A, const bf16_t* Bt, int M, int Npad, const Epi& epi, char* smem) {
    const int tid = otid(), lane = tid & 63, wid = tid >> 6, wm = wid >> 1, wn = wid & 1;
    const int fr = lane & 15, fq = lane >> 4;
    const int tm = M / 128, tn = Npad / 128, ntiles = tm * tn;
    const int lrow = tid >> 3, lch = tid & 7;
    for (int tile = blockIdx.x; tile < ntiles; tile += gridDim.x) {
        const int m0 = (tile % tm) * 128, n0 = (tile / tm) * 128;
        f32x4 acc[4][4];
#pragma unroll
        for (int a = 0; a < 4; ++a)
#pragma unroll
            for (int b = 0; b < 4; ++b) acc[a][b] = (f32x4){0.f, 0.f, 0.f, 0.f};
        const bf16_t* ap = A + (size_t)(m0 + lrow) * DM + lch * 8;
        const bf16_t* bp = Bt + (size_t)(n0 + lrow) * DM + lch * 8;
        if (epi.swapped(n0)) gemm_tile_kloop<true>(acc, ap, bp, smem, lrow, lch, wm, wn, fr, fq);
        else gemm_tile_kloop<false>(acc, ap, bp, smem, lrow, lch, wm, wn, fr, fq);
        epi(acc, m0, n0, wm, wn, fr, fq);
    }
}

__device__ void ph_prep_even(const P& p, int j) {
    const float* cw = p.ev_conv_w + (size_t)j * 3 * 512; const float* cb = p.ev_conv_b + (size_t)j * 512;
    const size_t tot = (size_t)NT * 512;
    for (size_t i = (size_t)blockIdx.x * 256 + otid(); i < tot; i += (size_t)gridDim.x * 256) {
        const int r = (int)(i >> 9), c = (int)(i & 511);
        int t, T; if (r < NL) { t = r & 2047; T = 2048; } else { t = (r - NL) & 255; T = 256; }
        float v = cb[c] + __uint_as_float((unsigned)p.PB[(size_t)r * 1536 + c] << 16) * cw[512 + c];
        if (t > 0) v += __uint_as_float((unsigned)p.PB[(size_t)(r - 1) * 1536 + c] << 16) * cw[c];
        if (t < T - 1) v += __uint_as_float((unsigned)p.PB[(size_t)(r + 1) * 1536 + c] << 16) * cw[1024 + c];
        v = silu_f(v);
        if (c >= 256) v *= 0.125f;
        p.QKC[i] = v;
    }
}

#define FA_KROW 144
#define FA_VROW 136
__device__ __forceinline__ bf16x8 pack8(float a0, float a1, float a2, float a3, float a4, float a5, float a6, float a7) {
    const u32x4 u = (u32x4){cvt_pk_bf16(a0, a1), cvt_pk_bf16(a2, a3), cvt_pk_bf16(a4, a5), cvt_pk_bf16(a6, a7)};
    return __builtin_bit_cast(bf16x8, u);
}
template <int NDB, bool MASK>
__device__ __forceinline__ void flash_tile(const bf16x8 (&qf)[4], f32x16 (&o)[NDB], float& m, float& l, const char* Kl, const char* Vl, int lane, int qpos, int kp0) {
    const int j = lane & 31, h = lane >> 5;
    f32x16 s0, s1;
#pragma unroll
    for (int i = 0; i < 16; ++i) { s0[i] = 0.f; s1[i] = 0.f; }
#pragma unroll
    for (int ks = 0; ks < 4; ++ks) {
        const bf16x8 a0 = *(const bf16x8*)(Kl + j * FA_KROW + (2 * ks + h) * 16);
        const bf16x8 a1 = *(const bf16x8*)(Kl + (32 + j) * FA_KROW + (2 * ks + h) * 16);
        s0 = __builtin_amdgcn_mfma_f32_32x32x16_bf16(a0, qf[ks], s0, 0, 0, 0);
        s1 = __builtin_amdgcn_mfma_f32_32x32x16_bf16(a1, qf[ks], s1, 0, 0, 0);
    }
    if (MASK) {
#pragma unroll
        for (int r = 0; r < 16; ++r) {
            const int key = (r & 3) + 8 * (r >> 2) + 4 * h;
            const int d0 = qpos - (kp0 + key), d1 = d0 - 32;
            if (d0 > 128 || d0 < -128) s0[r] = -1e30f;
            if (d1 > 128 || d1 < -128) s1[r] = -1e30f;
        }
    }
    float mx = fmaxf(s0[0], s1[0]);
#pragma unroll
    for (int r = 1; r < 16; ++r) mx = fmaxf(mx, fmaxf(s0[r], s1[r]));
    mx = fmaxf(mx, __shfl_xor(mx, 32));
    const float mn = fmaxf(m, mx);
    const float alpha = __builtin_amdgcn_exp2f(m - mn);
    m = mn;
    float ls = 0.f;
#pragma unroll
    for (int r = 0; r < 16; ++r) { s0[r] = __builtin_amdgcn_exp2f(s0[r] - mn); s1[r] = __builtin_amdgcn_exp2f(s1[r] - mn); ls += s0[r] + s1[r]; }
    l = l * alpha + ls;
#pragma unroll
    for (int db = 0; db < NDB; ++db) o[db] = o[db] * alpha;
    bf16x8 pb[4];
    pb[0] = pack8(s0[0], s0[1], s0[2], s0[3], s0[4], s0[5], s0[6], s0[7]);
    pb[1] = pack8(s0[8], s0[9], s0[10], s0[11], s0[12], s0[13], s0[14], s0[15]);
    pb[2] = pack8(s1[0], s1[1], s1[2], s1[3], s1[4], s1[5], s1[6], s1[7]);
    pb[3] = pack8(s1[8], s1[9], s1[10], s1[11], s1[12], s1[13], s1[14], s1[15]);
#pragma unroll
    for (int db = 0; db < NDB; ++db)
#pragma unroll
        for (int kk = 0; kk < 4; ++kk) {
            const char* vp = Vl + (db * 32 + j) * FA_VROW + (kk * 16 + 4 * h) * 2;
            const uint2 lo = *(const uint2*)vp, hi = *(const uint2*)(vp + 16);
            const u32x4 u = (u32x4){lo.x, lo.y, hi.x, hi.y};
            o[db] = __builtin_amdgcn_mfma_f32_32x32x16_bf16(__builtin_bit_cast(bf16x8, u), pb[kk], o[db], 0, 0, 0);
        }
}

#define DA_BUFB 35840
__device__ void da_block(const P& p, int item, int L, int j, char* smem) {
    const int tid = otid(), lane = tid & 63, wid = tid >> 6, mp = wid & 1, qg = wid >> 1, jq = lane & 31, hh = lane >> 5;
    const bool lat = item < 1024;
    int b, h, qt;
    if (lat) { b = item >> 7; h = (item >> 5) & 3; qt = item & 31; } else { const int it = item - 1024; b = it >> 4; h = (it >> 2) & 3; qt = it & 3; }
    const int qi = qt * 64 + qg * 32 + jq;
    const bf16_t* qp = lat ? p.AQL + ((size_t)((b * 4 + h) * 2 + mp) * 2048 + qi) * 64 : p.AQC + ((size_t)((b * 4 + h) * 2 + mp) * 256 + qi) * 64;
    bf16x8 qf[4];
#pragma unroll
    for (int ks = 0; ks < 4; ++ks) qf[ks] = *(const bf16x8*)(qp + (2 * ks + hh) * 8);
    const int ntile = lat ? 36 : 4;
    const bf16_t* kg = p.AK + (size_t)((b * 4 + h) * 2) * 2304 * 64 + (size_t)(tid >> 3) * 64 + (tid & 7) * 8;
    const bf16_t* vg = p.AV + (size_t)(b * 4 + h) * 128 * 2304 + (size_t)(tid >> 3) * 2304 + (tid & 7) * 8;
    uint4 k0, k1, k2, k3, v0, v1, v2, v3;
#define DA_LOAD(KEY0) { k0 = *(const uint4*)(kg + (size_t)(KEY0) * 64); k1 = *(const uint4*)(kg + (size_t)((KEY0) + 32) * 64); \
                        k2 = *(const uint4*)(kg + (size_t)2304 * 64 + (size_t)(KEY0) * 64); k3 = *(const uint4*)(kg + (size_t)2304 * 64 + (size_t)((KEY0) + 32) * 64); \
                        v0 = *(const uint4*)(vg + (KEY0)); v1 = *(const uint4*)(vg + (size_t)32 * 2304 + (KEY0)); v2 = *(const uint4*)(vg + (size_t)64 * 2304 + (KEY0)); v3 = *(const uint4*)(vg + (size_t)96 * 2304 + (KEY0)); }
#define DA_STORE(BUF) { char* kb_ = (BUF) + (tid >> 3) * FA_KROW + (tid & 7) * 16; \
                        *(uint4*)kb_ = k0; *(uint4*)(kb_ + 32 * FA_KROW) = k1; *(uint4*)(kb_ + 64 * FA_KROW) = k2; *(uint4*)(kb_ + 96 * FA_KROW) = k3; \
                        char* vb_ = (BUF) + 18432 + (tid >> 3) * FA_VROW + (tid & 7) * 16; \
                        *(uint2*)vb_ = make_uint2(v0.x, v0.y); *(uint2*)(vb_ + 8) = make_uint2(v0.z, v0.w); \
                        *(uint2*)(vb_ + 32 * FA_VROW) = make_uint2(v1.x, v1.y); *(uint2*)(vb_ + 32 * FA_VROW + 8) = make_uint2(v1.z, v1.w); \
                        *(uint2*)(vb_ + 64 * FA_VROW) = make_uint2(v2.x, v2.y); *(uint2*)(vb_ + 64 * FA_VROW + 8) = make_uint2(v2.z, v2.w); \
                        *(uint2*)(vb_ + 96 * FA_VROW) = make_uint2(v3.x, v3.y); *(uint2*)(vb_ + 96 * FA_VROW + 8) = make_uint2(v3.z, v3.w); }
    f32x16 o[4];
#pragma unroll
    for (int db = 0; db < 4; ++db)
#pragma unroll
        for (int i = 0; i < 16; ++i) o[db][i] = 0.f;
    float m = -1e30f, l = 0.f;
    DA_LOAD(0)
    __syncthreads();
    DA_STORE(smem)
    __syncthreads();
    for (int t = 0; t < ntile; ++t) {
        char* cur = smem + (t & 1) * DA_BUFB;
        char* nxt = smem + ((t + 1) & 1) * DA_BUFB;
        if (t + 1 < ntile) DA_LOAD((t + 1) * 64)
        flash_tile<4, false>(qf, o, m, l, cur + mp * 9216, cur + 18432, lane, 0, 0);
        if (t + 1 < ntile) DA_STORE(nxt)
        __syncthreads();
    }
#undef DA_LOAD
#undef DA_STORE
    const float inv = 1.f / (l + __shfl_xor(l, 32));
#pragma unroll
    for (int db = 0; db < 4; ++db) o[db] = o[db] * inv;
    float* X = (float*)smem + qg * 4096;
    if (mp == 1) {
#pragma unroll
        for (int db = 0; db < 4; ++db)
#pragma unroll
            for (int r = 0; r < 16; ++r) X[(db * 32 + (r & 3) + 8 * (r >> 2) + 4 * hh) * 32 + jq] = o[db][r];
    }
    __syncthreads();
    if (mp == 0) {
        const float lam_init = 0.8f - 0.6f * expf(-0.3f * (float)L);
        const float* lp = p.ev_da_lam + (size_t)j * 256;
        float a0 = lp[lane] * lp[64 + lane], a1 = lp[128 + lane] * lp[192 + lane];
        a0 = wave_sum(a0); a1 = wave_sum(a1);
        const float lam = expf(a0) - expf(a1) + lam_init;
        float ss = 0.f;
#pragma unroll
        for (int db = 0; db < 4; ++db)
#pragma unroll
            for (int r = 0; r < 16; ++r) { const float v = o[db][r] - lam * X[(db * 32 + (r & 3) + 8 * (r >> 2) + 4 * hh) * 32 + jq]; o[db][r] = v; ss += v * v; }
        ss += __shfl_xor(ss, 32);
        const float sc = rsqrtf(ss * (1.f / 128.f) + 1e-6f) * (1.f - lam_init);
        const int row = lat ? b * 2048 + qi : NL + b * 256 + qi;
        bf16_t* mrow = p.MIX + (size_t)row * DM + 512 + h * 128;
        const float* g = p.ev_da_g + (size_t)j * 512 + h * 128;
#pragma unroll
        for (int db = 0; db < 4; ++db)
#pragma unroll
            for (int r4 = 0; r4 < 4; ++r4) {
                const int d = db * 32 + 8 * r4 + 4 * hh;
                const f32x4 gg = *(const f32x4*)(g + d);
                *(uint2*)(mrow + d) = make_uint2(cvt_pk_bf16(o[db][r4 * 4 + 0] * sc * gg[0], o[db][r4 * 4 + 1] * sc * gg[1]), cvt_pk_bf16(o[db][r4 * 4 + 2] * sc * gg[2], o[db][r4 * 4 + 3] * sc * gg[3]));
            }
    }
    __syncthreads();
}

#define WA_BUFB 17920
__device__ void wa_block(const P& p, int item, int j, char* smem) {
    const int tid = otid(), lane = tid & 63, wid = tid >> 6, jq = lane & 31, hh = lane >> 5;
    const bool lat = item < 2048;
    int b, nb, hq;
    if (lat) { hq = item & 15; nb = (item >> 4) & 15; b = item >> 8; } else { const int it = item - 2048; hq = it & 15; nb = (it >> 4) & 1; b = it >> 5; }
    const int hkv = hq >> 2;
    const int qi = nb * 128 + wid * 32 + jq;
    const bf16_t* qp = lat ? p.AQL + ((size_t)(b * 16 + hq) * 2048 + qi) * 64 : p.AQC + ((size_t)(b * 16 + hq) * 256 + qi) * 64;
    bf16x8 qf[4];
#pragma unroll
    for (int ks = 0; ks < 4; ++ks) qf[ks] = *(const bf16x8*)(qp + (2 * ks + hh) * 8);
    const int lfirst = (nb == 0) ? 2 : 0, nloc = lat ? 6 - lfirst - ((nb == 15) ? 2 : 0) : 0;
    const int ntile = 4 + nloc;
    const bf16_t* kg = p.AK + (size_t)(b * 4 + hkv) * 2304 * 64 + (size_t)(tid >> 3) * 64 + (tid & 7) * 8;
    const bf16_t* vg = p.AV + (size_t)(b * 4 + hkv) * 64 * 2304 + (size_t)(tid >> 3) * 2304 + (tid & 7) * 8;
    uint4 k0, k1, v0, v1;
#define WA_KEY0(T) ((T) < 4 ? (T) * 64 : 256 + (nb - 1) * 128 + ((T) - 4 + lfirst) * 64)
#define WA_LOAD(KEY0) { k0 = *(const uint4*)(kg + (size_t)(KEY0) * 64); k1 = *(const uint4*)(kg + (size_t)((KEY0) + 32) * 64); v0 = *(const uint4*)(vg + (KEY0)); v1 = *(const uint4*)(vg + (size_t)32 * 2304 + (KEY0)); }
#define WA_STORE(BUF) { char* kb_ = (BUF) + (tid >> 3) * FA_KROW + (tid & 7) * 16; *(uint4*)kb_ = k0; *(uint4*)(kb_ + 32 * FA_KROW) = k1; \
                        char* vb_ = (BUF) + 9216 + (tid >> 3) * FA_VROW + (tid & 7) * 16; \
                        *(uint2*)vb_ = make_uint2(v0.x, v0.y); *(uint2*)(vb_ + 8) = make_uint2(v0.z, v0.w); \
                        *(uint2*)(vb_ + 32 * FA_VROW) = make_uint2(v1.x, v1.y); *(uint2*)(vb_ + 32 * FA_VROW + 8) = make_uint2(v1.z, v1.w); }
    f32x16 o[2];
#pragma unroll
    for (int db = 0; db < 2; ++db)
#pragma unroll
        for (int i = 0; i < 16; ++i) o[db][i] = 0.f;
    float m = p.od_sink[j * 16 + hq] * 1.4426950408889634f, l = hh == 0 ? 1.f : 0.f;
    { const int key0 = WA_KEY0(0); WA_LOAD(key0) }
    __syncthreads();
    WA_STORE(smem)
    __syncthreads();
    for (int t = 0; t < ntile; ++t) {
        char* cur = smem + (t & 1) * WA_BUFB;
        char* nxt = smem + ((t + 1) & 1) * WA_BUFB;
        if (t + 1 < ntile) { const int key0 = WA_KEY0(t + 1); WA_LOAD(key0) }
        if (t < 4) flash_tile<2, false>(qf, o, m, l, cur, cur + 9216, lane, 0, 0);
        else flash_tile<2, true>(qf, o, m, l, cur, cur + 9216, lane, qi, WA_KEY0(t) - 256);
        if (t + 1 < ntile) WA_STORE(nxt)
        __syncthreads();
    }
#undef WA_LOAD
#undef WA_STORE
#undef WA_KEY0
    const float inv = 1.f / (l + __shfl_xor(l, 32));
    const int row = lat ? b * 2048 + qi : NL + b * 256 + qi;
    bf16_t* mrow = p.MIX + (size_t)row * DM + hq * 64;
#pragma unroll
    for (int db = 0; db < 2; ++db)
#pragma unroll
        for (int r4 = 0; r4 < 4; ++r4) {
            const int d = db * 32 + 8 * r4 + 4 * hh;
            *(uint2*)(mrow + d) = make_uint2(cvt_pk_bf16(o[db][r4 * 4 + 0] * inv, o[db][r4 * 4 + 1] * inv), cvt_pk_bf16(o[db][r4 * 4 + 2] * inv, o[db][r4 * 4 + 3] * inv));
        }
}

#define ML_LD 68
__device__ void mlstm_chunk_item(const P& p, int item, int j, float* smem) {
    const int vs = item & 3, dir = (item >> 2) & 1, h = (item >> 3) & 3, b = item >> 5;
    const int tid = otid(), lane = tid & 63;
    float* sq = smem;
    float* sk = sq + 64 * ML_LD;
    float* sv = sk + 64 * ML_LD;
    float* sP = sv + 64 * 32;
    float* sCT = sP + 64 * 65;
    float* sn = sCT + 64 * 36;
    float* sa = sn + 64;
    float* sb = sa + 64;
    float* sg = sb + 64;
    float* swk = sg + 64;
    int* srow = (int*)(swk + 64);
    float* ssc = (float*)(srow + 64);
    const float gbi = p.ev_gate_b[j * 16 + (dir * 2) * 4 + h], gbf = p.ev_gate_b[j * 16 + (dir * 2 + 1) * 4 + h];
    float* hm = p.HM + (size_t)dir * NT * 512;
    __syncthreads();
    for (int i = tid; i < 64 * 36; i += 256) sCT[i] = 0.f;
    if (tid < 64) sn[tid] = 0.f;
    float m_st = 0.f;
    for (int c = 0; c < 36; ++c) {
        __syncthreads();
        if (tid < 64) {
            const int st = c * 64 + tid; int row;
            if (st < 256) row = NL + b * 256 + (dir ? 255 - st : st);
            else { const int t = st - 256; row = b * 2048 + (dir ? 2047 - t : t); }
            srow[tid] = row;
            const float ig = p.GT[(size_t)row * 16 + (dir * 2) * 4 + h] + gbi;
            const float lf = log_sigmoid_f(p.GT[(size_t)row * 16 + (dir * 2 + 1) * 4 + h] + gbf);
            float bc = lf;
#pragma unroll
            for (int o = 1; o < 64; o <<= 1) { const float t2 = __shfl_up(bc, o); if (lane >= o) bc += t2; }
            const float a = ig - bc;
            float mxa = a;
#pragma unroll
            for (int o = 1; o < 64; o <<= 1) { const float t2 = __shfl_up(mxa, o); if (lane >= o) mxa = fmaxf(mxa, t2); }
            const float g = fmaxf(m_st, mxa);
            const float g63 = __shfl(g, 63), b63 = __shfl(bc, 63);
            sa[tid] = a; sb[tid] = bc; sg[tid] = g; swk[tid] = expf(a - g63);
            if (tid == 0) { ssc[0] = m_st; ssc[1] = expf(m_st - g63); ssc[2] = b63 + g63; }
        }
        __syncthreads();
#pragma unroll
        for (int i = 0; i < 4; ++i) {
            const int e = tid + 256 * i, t = e >> 4, c4 = (e & 15) * 4; const int row = srow[t];
            *(float4*)(sq + t * ML_LD + c4) = *(const float4*)(p.QKC + (size_t)row * 512 + h * 64 + c4);
            *(float4*)(sk + t * ML_LD + c4) = *(const float4*)(p.QKC + (size_t)row * 512 + 256 + h * 64 + c4);
        }
        {
            const int t = tid >> 2, c8 = (tid & 3) * 8; const int row = srow[t];
            const uint4 u = *(const uint4*)(p.PB + (size_t)row * 1536 + 512 + h * 128 + vs * 32 + c8);
            float* d = sv + t * 32 + c8;
            d[0] = bf_lo(u.x); d[1] = bf_hi(u.x); d[2] = bf_lo(u.y); d[3] = bf_hi(u.y); d[4] = bf_lo(u.z); d[5] = bf_hi(u.z); d[6] = bf_lo(u.w); d[7] = bf_hi(u.w);
        }
        __syncthreads();
        const float mst = ssc[0], decay = ssc[1];
        {
            const int t = tid >> 2, sq4 = tid & 3;
            float acc[16];
#pragma unroll
            for (int i = 0; i < 16; ++i) acc[i] = 0.f;
            for (int d4 = 0; d4 < 16; ++d4) {
                const float4 qv = *(const float4*)(sq + t * ML_LD + d4 * 4);
#pragma unroll
                for (int i = 0; i < 16; ++i) {
                    const float4 kv = *(const float4*)(sk + (sq4 + 4 * i) * ML_LD + d4 * 4);
                    acc[i] += qv.x * kv.x + qv.y * kv.y + qv.z * kv.z + qv.w * kv.w;
                }
            }
            const float gt = sg[t];
#pragma unroll
            for (int i = 0; i < 16; ++i) { const int s2 = sq4 + 4 * i; sP[t * 65 + s2] = (s2 <= t) ? acc[i] * expf(sa[s2] - gt) : 0.f; }
        }
        __syncthreads();
        {
            const int t = tid >> 2, vq = tid & 3;
            float num[8], cq[8];
#pragma unroll
            for (int i = 0; i < 8; ++i) { num[i] = 0.f; cq[i] = 0.f; }
            float psum = 0.f, nq = 0.f;
            for (int s2 = 0; s2 < 64; ++s2) {
                const float pv = sP[t * 65 + s2];
                const float4 v0 = *(const float4*)(sv + s2 * 32 + vq * 8), v1 = *(const float4*)(sv + s2 * 32 + vq * 8 + 4);
                num[0] += pv * v0.x; num[1] += pv * v0.y; num[2] += pv * v0.z; num[3] += pv * v0.w;
                num[4] += pv * v1.x; num[5] += pv * v1.y; num[6] += pv * v1.z; num[7] += pv * v1.w;
                const float qd = sq[t * ML_LD + s2];
                const float4 c0 = *(const float4*)(sCT + s2 * 36 + vq * 8), c1 = *(const float4*)(sCT + s2 * 36 + vq * 8 + 4);
                cq[0] += qd * c0.x; cq[1] += qd * c0.y; cq[2] += qd * c0.z; cq[3] += qd * c0.w;
                cq[4] += qd * c1.x; cq[5] += qd * c1.y; cq[6] += qd * c1.z; cq[7] += qd * c1.w;
                if ((s2 >> 4) == vq) { psum += pv; nq += sn[s2] * qd; }
            }
            psum += __shfl_xor(psum, 1); psum += __shfl_xor(psum, 2);
            nq += __shfl_xor(nq, 1); nq += __shfl_xor(nq, 2);
            const float gt = sg[t], wint = expf(mst - gt);
            const float den = psum + wint * nq;
            const float sc = 1.f / fmaxf(fabsf(den), expf(-(sb[t] + gt)));
            float* op = hm + (size_t)srow[t] * 512 + h * 128 + vs * 32 + vq * 8;
            *(float4*)op = make_float4((num[0] + wint * cq[0]) * sc, (num[1] + wint * cq[1]) * sc, (num[2] + wint * cq[2]) * sc, (num[3] + wint * cq[3]) * sc);
            *(float4*)(op + 4) = make_float4((num[4] + wint * cq[4]) * sc, (num[5] + wint * cq[5]) * sc, (num[6] + wint * cq[6]) * sc, (num[7] + wint * cq[7]) * sc);
        }
        __syncthreads();
        {
            const int d = tid >> 2, vq = tid & 3;
            float cn[8];
            const float4 c0 = *(const float4*)(sCT + d * 36 + vq * 8), c1 = *(const float4*)(sCT + d * 36 + vq * 8 + 4);
            cn[0] = decay * c0.x; cn[1] = decay * c0.y; cn[2] = decay * c0.z; cn[3] = decay * c0.w;
            cn[4] = decay * c1.x; cn[5] = decay * c1.y; cn[6] = decay * c1.z; cn[7] = decay * c1.w;
            float nn = decay * sn[d];
            for (int s2 = 0; s2 < 64; ++s2) {
                const float kd = swk[s2] * sk[s2 * ML_LD + d];
                const float4 v0 = *(const float4*)(sv + s2 * 32 + vq * 8), v1 = *(const float4*)(sv + s2 * 32 + vq * 8 + 4);
                cn[0] += kd * v0.x; cn[1] += kd * v0.y; cn[2] += kd * v0.z; cn[3] += kd * v0.w;
                cn[4] += kd * v1.x; cn[5] += kd * v1.y; cn[6] += kd * v1.z; cn[7] += kd * v1.w;
                nn += kd;
            }
            *(float4*)(sCT + d * 36 + vq * 8) = make_float4(cn[0], cn[1], cn[2], cn[3]);
            *(float4*)(sCT + d * 36 + vq * 8 + 4) = make_float4(cn[4], cn[5], cn[6], cn[7]);
            if (vq == 0) sn[d] = nn;
        }
        m_st = ssc[2];
    }
    __syncthreads();
}

__device__ void ph_attn_even(const P& p, int ci, int L, int j, float* smem) {
    int* s_item = (int*)((char*)smem + 73728);
    for (;;) {
        __syncthreads();
        if (otid() == 0) *s_item = atomicAdd(&p.ctr[ci], 1);
        __syncthreads();
        const int item = *s_item;
        if (item >= 256 + 1152) break;
        if (item < 256) mlstm_chunk_item(p, item, j, smem); else da_block(p, item - 256, L, j, (char*)smem);
    }
}
__device__ void ph_attn_odd(const P& p, int j, bool need_ctx, float* smem) {
    const int nitem = need_ctx ? 2304 : 2048;
    for (int item = blockIdx.x; item < nitem; item += gridDim.x) { wa_block(p, item, j, (char*)smem); __syncthreads(); }
}

__device__ void ph_mixout_even(const P& p, int L, int j) {
    const int lane = otid() & 63, wid = otid() >> 6;
    for (int w = blockIdx.x * 4 + wid; w < NT * 4; w += gridDim.x * 4) {
        const int r = w >> 2, hh = w & 3;
        const int c = hh * 128 + lane * 2;
        const float2 f = *(const float2*)(p.HM + (size_t)r * 512 + c), bk = *(const float2*)(p.HM + (size_t)NT * 512 + (size_t)r * 512 + c);
        const float v0 = f.x + bk.x, v1 = f.y + bk.y;
        const float ss = wave_sum(v0 * v0 + v1 * v1);
        const float rstd = rsqrtf(ss * (1.f / 128.f) + 1e-6f);
        const float2 g = *(const float2*)(p.ev_ml_g + (size_t)j * 512 + c);
        const unsigned ou = *(const unsigned*)(p.PB + (size_t)r * 1536 + 1024 + c);
        *(unsigned*)(p.MIX + (size_t)r * DM + c) = cvt_pk_bf16(v0 * rstd * g.x * sigmoid_f(bf_lo(ou)), v1 * rstd * g.y * sigmoid_f(bf_hi(ou)));
    }
}

__device__ __forceinline__ float wave_max(float v) {
#pragma unroll
    for (int o = 32; o > 0; o >>= 1) v = fmaxf(v, __shfl_xor(v, o));
    return v;
}
#define SEL_LD 132
__device__ __forceinline__ unsigned fkey(float f) { const unsigned u = __float_as_uint(f); return (u & 0x80000000u) ? ~u : (u | 0x80000000u); }
__device__ __forceinline__ unsigned mbcnt64(unsigned long long m) { return __builtin_amdgcn_mbcnt_hi((unsigned)(m >> 32), __builtin_amdgcn_mbcnt_lo((unsigned)m, 0u)); }
__device__ void ph_peer_select(const P& p, int L, int nrows, char* smem) {
    float* S = (float*)smem;
    const int tid = otid(), lane = tid & 63, wid = tid >> 6, fr = lane & 15, fq = lane >> 4;
    const bf16_t* KBL = p.KB + (size_t)L * 8 * 2 * 128 * 128;
    const int ntile = nrows / 32;
    for (int item = blockIdx.x; item < ntile * 8; item += gridDim.x) {
        const int h = item & 7, t0 = (item >> 3) * 32;
        __syncthreads();
        {
            const int pp = wid >> 1, th = wid & 1;
            const bf16_t* qp = p.QB + (size_t)(t0 + th * 16 + fr) * 2048 + h * 256 + pp * 128 + fq * 8;
            bf16x8 qf[4];
#pragma unroll
            for (int ks = 0; ks < 4; ++ks) qf[ks] = *(const bf16x8*)(qp + ks * 32);
            const bf16_t* kp = KBL + ((size_t)(h * 2 + pp) * 128 + fr) * 128 + fq * 8;
#pragma unroll
            for (int ni = 0; ni < 8; ++ni) {
                f32x4 acc = (f32x4){0.f, 0.f, 0.f, 0.f};
#pragma unroll
                for (int ks = 0; ks < 4; ++ks) {
                    const bf16x8 kf = *(const bf16x8*)(kp + (size_t)ni * 16 * 128 + ks * 32);
                    acc = __builtin_amdgcn_mfma_f32_16x16x32_bf16(qf[ks], kf, acc, 0, 0, 0);
                }
#pragma unroll
                for (int j = 0; j < 4; ++j) S[(pp * 32 + th * 16 + fq * 4 + j) * SEL_LD + ni * 16 + fr] = acc[j];
            }
        }
        __syncthreads();
        for (int tt = 0; tt < 8; ++tt) {
            const int t = wid * 8 + tt, r = t0 + t;
            const float v00 = S[t * SEL_LD + lane], v01 = S[t * SEL_LD + 64 + lane], v10 = S[(32 + t) * SEL_LD + lane], v11 = S[(32 + t) * SEL_LD + 64 + lane];
            const unsigned ka0 = fkey(v00), ka1 = fkey(v01), kb0 = fkey(v10), kb1 = fkey(v11);
            unsigned T0 = 0u, T1 = 0u;
#pragma unroll 8
            for (int bit = 31; bit >= 0; --bit) {
                const unsigned c0 = T0 | (1u << bit), c1 = T1 | (1u << bit);
                const int n0 = __builtin_popcountll(__ballot(ka0 >= c0)) + __builtin_popcountll(__ballot(ka1 >= c0));
                const int n1 = __builtin_popcountll(__ballot(kb0 >= c1)) + __builtin_popcountll(__ballot(kb1 >= c1));
                if (n0 >= 16) T0 = c0;
                if (n1 >= 16) T1 = c1;
            }
            float* wsA = (float*)(smem + 34816 + wid * 512);
            {
                const unsigned long long g0 = __ballot(ka0 > T0), g1 = __ballot(ka1 > T0), e0 = __ballot(ka0 == T0), e1 = __ballot(ka1 == T0);
                const int need = 16 - __builtin_popcountll(g0) - __builtin_popcountll(g1);
                const int pe0 = __builtin_popcountll(e0), need1 = need - (pe0 < need ? pe0 : need);
                const bool s0 = (ka0 > T0) || (ka0 == T0 && (int)mbcnt64(e0) < need);
                const bool s1 = (ka1 > T0) || (ka1 == T0 && (int)mbcnt64(e1) < need1);
                const unsigned long long m0 = __ballot(s0), m1 = __ballot(s1);
                if (s0) { const int pos = mbcnt64(m0); wsA[pos] = v00; ((int*)wsA)[16 + pos] = lane; }
                if (s1) { const int pos = __builtin_popcountll(m0) + mbcnt64(m1); wsA[pos] = v01; ((int*)wsA)[16 + pos] = 64 + lane; }
            }
            {
                const unsigned long long g0 = __ballot(kb0 > T1), g1 = __ballot(kb1 > T1), e0 = __ballot(kb0 == T1), e1 = __ballot(kb1 == T1);
                const int need = 16 - __builtin_popcountll(g0) - __builtin_popcountll(g1);
                const int pe0 = __builtin_popcountll(e0), need1 = need - (pe0 < need ? pe0 : need);
                const bool s0 = (kb0 > T1) || (kb0 == T1 && (int)mbcnt64(e0) < need);
                const bool s1 = (kb1 > T1) || (kb1 == T1 && (int)mbcnt64(e1) < need1);
                const unsigned long long m0 = __ballot(s0), m1 = __ballot(s1);
                if (s0) { const int pos = mbcnt64(m0); wsA[32 + pos] = v10; ((int*)wsA)[48 + pos] = lane; }
                if (s1) { const int pos = __builtin_popcountll(m0) + mbcnt64(m1); wsA[32 + pos] = v11; ((int*)wsA)[48 + pos] = 64 + lane; }
            }
            __builtin_amdgcn_wave_barrier();
            float cand[4]; int cidx[4]; unsigned kc[4];
            {
                const float av = wsA[lane >> 2]; const int ai = ((int*)wsA)[16 + (lane >> 2)];
                const float4 bv = *(const float4*)(wsA + 32 + (lane & 3) * 4); const int4 bi = *(const int4*)((int*)wsA + 48 + (lane & 3) * 4);
                cand[0] = av + bv.x; cand[1] = av + bv.y; cand[2] = av + bv.z; cand[3] = av + bv.w;
                cidx[0] = ai * 128 + bi.x; cidx[1] = ai * 128 + bi.y; cidx[2] = ai * 128 + bi.z; cidx[3] = ai * 128 + bi.w;
#pragma unroll
                for (int c = 0; c < 4; ++c) kc[c] = fkey(cand[c]);
            }
            unsigned T = 0u;
#pragma unroll 8
            for (int bit = 31; bit >= 0; --bit) {
                const unsigned cc = T | (1u << bit);
                const int n = __builtin_popcountll(__ballot(kc[0] >= cc)) + __builtin_popcountll(__ballot(kc[1] >= cc)) + __builtin_popcountll(__ballot(kc[2] >= cc)) + __builtin_popcountll(__ballot(kc[3] >= cc));
                if (n >= 16) T = cc;
            }
            {
                int need = 16, base = 0;
#pragma unroll
                for (int c = 0; c < 4; ++c) need -= __builtin_popcountll(__ballot(kc[c] > T));
#pragma unroll
                for (int c = 0; c < 4; ++c) {
                    const unsigned long long e = __ballot(kc[c] == T);
                    const bool sel = (kc[c] > T) || (kc[c] == T && (int)mbcnt64(e) < need);
                    const int pe = __builtin_popcountll(e); need -= (pe < need ? pe : need);
                    const unsigned long long m = __ballot(sel);
                    if (sel) { const int pos = base + mbcnt64(m); wsA[64 + pos] = cand[c]; ((int*)wsA)[80 + pos] = cidx[c]; }
                    base += __builtin_popcountll(m);
                }
            }
            __builtin_amdgcn_wave_barrier();
            if (lane < 16) {
                const float cv = wsA[64 + lane];
                float mx = wsA[64];
#pragma unroll
                for (int q = 1; q < 16; ++q) mx = fmaxf(mx, wsA[64 + q]);
                float sum = 0.f;
#pragma unroll
                for (int q = 0; q < 16; ++q) sum += expf(wsA[64 + q] - mx);
                p.GATE[(size_t)r * 128 + h * 16 + lane] = expf(cv - mx) / sum;
                p.EIDX[(size_t)r * 128 + h * 16 + lane] = ((int*)wsA)[80 + lane];
            }
            __builtin_amdgcn_wave_barrier();
        }
    }
}


__device__ __forceinline__ void unpack8(const uint4 u, float* f) {
    f[0] = bf_lo(u.x); f[1] = bf_hi(u.x); f[2] = bf_lo(u.y); f[3] = bf_hi(u.y); f[4] = bf_lo(u.z); f[5] = bf_hi(u.z); f[6] = bf_lo(u.w); f[7] = bf_hi(u.w);
}
__device__ __forceinline__ void unpack16_u8(const uint4 u, float* f) {
    f[0] = (float)(u.x & 0xffu); f[1] = (float)((u.x >> 8) & 0xffu); f[2] = (float)((u.x >> 16) & 0xffu); f[3] = (float)((u.x >> 24) & 0xffu);
    f[4] = (float)(u.y & 0xffu); f[5] = (float)((u.y >> 8) & 0xffu); f[6] = (float)((u.y >> 16) & 0xffu); f[7] = (float)((u.y >> 24) & 0xffu);
    f[8] = (float)(u.z & 0xffu); f[9] = (float)((u.z >> 8) & 0xffu); f[10] = (float)((u.z >> 16) & 0xffu); f[11] = (float)((u.z >> 24) & 0xffu);
    f[12] = (float)(u.w & 0xffu); f[13] = (float)((u.w >> 8) & 0xffu); f[14] = (float)((u.w >> 16) & 0xffu); f[15] = (float)((u.w >> 24) & 0xffu);
}
__device__ void ph_peer_gather(const P& p, int L, int nrows, float oscale) {
    const int lane = otid() & 63, wid = otid() >> 6;
    const unsigned char* U = p.U8 + (size_t)L * 16384 * 1024; const unsigned char* V = p.V8 + (size_t)L * 16384 * 1024;
    const float* USC = p.USC + (size_t)L * 16384; const float* VSC = p.VSC + (size_t)L * 16384;
    const float* gate2 = p.modv + (size_t)L * 9 * 6144 + 5120;
    for (int r = blockIdx.x * 4 + wid; r < nrows; r += gridDim.x * 4) {
        const int e0 = p.EIDX[(size_t)r * 128 + lane], e1 = p.EIDX[(size_t)r * 128 + 64 + lane];
        const float g0 = p.GATE[(size_t)r * 128 + lane], g1 = p.GATE[(size_t)r * 128 + 64 + lane];
        const float us0 = USC[e0], us1 = USC[e1], vs0 = VSC[e0], vs1 = VSC[e1];
        float x[16];
        { const uint4 xa = *(const uint4*)(p.XN + (size_t)r * DM + lane * 16), xb = *(const uint4*)(p.XN + (size_t)r * DM + lane * 16 + 8); unpack8(xa, x); unpack8(xb, x + 8); }
        float sx = 0.f;
#pragma unroll
        for (int c = 0; c < 16; ++c) sx += x[c];
        sx = wave_sum(sx);
        float a0 = 0.f, a1 = 0.f;
#pragma unroll
        for (int half = 0; half < 2; ++half) {
            const int ev = half ? e1 : e0;
            float av = 0.f;
            for (int kb = 0; kb < 4; ++kb) {
                uint4 ua[16];
#pragma unroll
                for (int j = 0; j < 16; ++j) {
                    const int idx = __builtin_amdgcn_readlane(ev, kb * 16 + j);
                    ua[j] = *(const uint4*)(U + (size_t)idx * 1024 + lane * 16);
                }
#pragma unroll
                for (int j = 0; j < 16; ++j) {
                    float f[16]; unpack16_u8(ua[j], f);
                    float s = 0.f;
#pragma unroll
                    for (int c = 0; c < 16; ++c) s += x[c] * f[c];
                    s = wave_sum(s);
                    if (lane == kb * 16 + j) av = s;
                }
            }
            if (half) a1 = av; else a0 = av;
        }
        a0 = us0 * (a0 - 128.f * sx); a1 = us1 * (a1 - 128.f * sx);
        const float w0 = vs0 * g0 * 0.5f * a0 * (1.f + erff(a0 * 0.70710678118654752f));
        const float w1 = vs1 * g1 * 0.5f * a1 * (1.f + erff(a1 * 0.70710678118654752f));
        const float wsum = wave_sum(w0 + w1);
        float acc[16];
#pragma unroll
        for (int c = 0; c < 16; ++c) acc[c] = 0.f;
#pragma unroll
        for (int half = 0; half < 2; ++half) {
            const int ev = half ? e1 : e0; const int wv = __float_as_int(half ? w1 : w0);
            for (int kb = 0; kb < 4; ++kb) {
                uint4 ua[16];
#pragma unroll
                for (int j = 0; j < 16; ++j) {
                    const int idx = __builtin_amdgcn_readlane(ev, kb * 16 + j);
                    ua[j] = *(const uint4*)(V + (size_t)idx * 1024 + lane * 16);
                }
#pragma unroll
                for (int j = 0; j < 16; ++j) {
                    const float wj = __int_as_float(__builtin_amdgcn_readlane(wv, kb * 16 + j));
                    float f[16]; unpack16_u8(ua[j], f);
#pragma unroll
                    for (int c = 0; c < 16; ++c) acc[c] += wj * f[c];
                }
            }
        }
        const float* gp = gate2 + (size_t)modrow(r) * 6144 + lane * 16;
        float* hp = p.H + (size_t)r * DM + lane * 16;
#pragma unroll
        for (int q = 0; q < 4; ++q) {
            const float4 g = *(const float4*)(gp + q * 4);
            float4 hv = *(float4*)(hp + q * 4);
            hv.x += oscale * g.x * (acc[q * 4 + 0] - 128.f * wsum); hv.y += oscale * g.y * (acc[q * 4 + 1] - 128.f * wsum);
            hv.z += oscale * g.z * (acc[q * 4 + 2] - 128.f * wsum); hv.w += oscale * g.w * (acc[q * 4 + 3] - 128.f * wsum);
            *(float4*)(hp + q * 4) = hv;
        }
    }
}

__device__ void run_phase(const P& p, int ph, float* smem, int rep) {
    if (ph == 0) { ph_prologue(p, smem); return; }
    if (ph == NPH - 1) { ph_final(p); return; }
    const int L = (ph - 1) / 10, s = (ph - 1) % 10, j = L >> 1;
    const bool even = (L & 1) == 0, need_ctx = L < 3;
    const int nrows = need_ctx ? NT : NL;
    const float* mv = p.modv + (size_t)L * 9 * 6144;
    switch (s) {
    case 0: ph_normmod(p.H, p.norm1_g + L * DM, mv, 0, 1024, p.XN, NT); break;
    case 1:
        if (even) ph_gemm(p.XN, p.WT + WT_EVIN(j), NT, 3200, EpiEven{p.PB, p.AQL, p.AQC, p.AK, p.AV, p.GT, p.rope}, (char*)smem);
        else ph_gemm(p.XN, p.WT + WT_ODIN(j), NT, ODW, EpiOdd{p.AQL, p.AQC, p.AK, p.AV, p.rope}, (char*)smem);
        break;
    case 2: if (even) ph_prep_even(p, j); break;
    case 3: if (even) ph_attn_even(p, L + 4 * rep, L, j, smem); else ph_attn_odd(p, j, need_ctx, smem); break;
    case 4: if (even) ph_mixout_even(p, L, j); break;
    case 5:
        ph_gemm(p.MIX, p.WT + (even ? WT_EVOUT(j) : WT_ODOUT(j)), nrows, DM, EpiResid{p.H, mv + 2048, rep ? 0.f : 1.f}, (char*)smem);
        break;
    case 6: ph_normmod(p.H, p.norm2_g + L * DM, mv, 3072, 4096, p.XN, nrows); break;
    case 7: ph_gemm(p.XN, p.WT + WT_PQ(L), nrows, 2048, EpiStoreBF16{p.QB, 2048}, (char*)smem); break;
    case 8: ph_peer_select(p, L, nrows, (char*)smem); break;
    case 9: ph_peer_gather(p, L, nrows, rep ? 0.f : 1.f); break;
    }
}


#define XB_TMO      128
#define XB_XCNT(j)  (256  + 64 * (j))
#define XB_XSUB(j)  (1280 + 64 * (j))
#define XB_XGEN(j)  (2304 + 64 * (j))
#define XB_TOP      3328
#define XB_TOPGEN   3392
#define XCD_BAR_WORDS 3456
#define XB_SPIN_CAP (1u << 20)
#define LAS __attribute__((address_space(3)))
__device__ __forceinline__ unsigned xb_ld(unsigned* p)              { return __hip_atomic_load(p, __ATOMIC_RELAXED, __HIP_MEMORY_SCOPE_AGENT); }
__device__ __forceinline__ unsigned xb_add(unsigned* p, unsigned v) { return __hip_atomic_fetch_add(p, v, __ATOMIC_RELAXED, __HIP_MEMORY_SCOPE_AGENT); }
__device__ __forceinline__ unsigned xb_xcc_id() { return (unsigned)__builtin_amdgcn_s_getreg((3 << 11) | 20) & 0xFu; }
#define XB_SPIN(cond, bar) do { unsigned _sp = 0; while (cond) { __builtin_amdgcn_s_sleep(1); \
    if ((++_sp & 255u) == 0u) { if (xb_ld(&(bar)[XB_TMO])) break; if (_sp > XB_SPIN_CAP) { atomicAdd(&(bar)[XB_TMO], 1u); break; } } } } while (0)
struct XcdBarrier { unsigned* bar; unsigned x; volatile LAS unsigned* st; };
__device__ __forceinline__ XcdBarrier xcd_barrier_post(unsigned* bar, volatile LAS unsigned* st) {
    XcdBarrier b; b.bar = bar; b.x = xb_xcc_id(); b.st = st;
    if (threadIdx.x == 0) (void)xb_add(&bar[XB_XCNT(b.x)], 1u);
    return b;
}
__device__ __forceinline__ void xcd_barrier_complete(unsigned* bar, unsigned x, unsigned& nloc, unsigned& nx) {
    const unsigned G = gridDim.x * gridDim.y * gridDim.z;
    unsigned sum, cnt, mine, sp = 0u;
    for (;;) {
        sum = 0u; cnt = 0u; mine = 0u;
#pragma unroll
        for (unsigned j = 0; j < 16; ++j) { const unsigned c = xb_ld(&bar[XB_XCNT(j)]); sum += c; cnt += (c > 0u) ? 1u : 0u; mine = (j == x) ? c : mine; }
        if (sum == G) break;
        __builtin_amdgcn_s_sleep(1);
        if ((++sp & 255u) == 0u) { if (xb_ld(&bar[XB_TMO])) break; if (sp > XB_SPIN_CAP) { atomicAdd(&bar[XB_TMO], 1u); break; } }
    }
    nloc = mine > 0u ? mine : 1u; nx = cnt > 0u ? cnt : 1u;
}
__device__ __forceinline__ void xcd_barrier(const XcdBarrier& b) {
    asm volatile("s_waitcnt vmcnt(0)" ::: "memory");
    __syncthreads();
    if (threadIdx.x == 0) {
        unsigned* bar = b.bar;
        __builtin_amdgcn_s_waitcnt(0);
        unsigned nloc = b.st[0], nx = b.st[1];
        if (nloc == 0u) { xcd_barrier_complete(bar, b.x, nloc, nx); b.st[0] = nloc; b.st[1] = nx; }
        const unsigned old = xb_add(&bar[XB_XSUB(b.x)], 1u);
        const unsigned gen = old / nloc;
        if (old + 1u == (gen + 1u) * nloc) {
            __builtin_amdgcn_fence(__ATOMIC_RELEASE, "agent");
            asm volatile("s_waitcnt vmcnt(0)" ::: "memory");
            const unsigned og = xb_add(&bar[XB_TOP], 1u);
            const unsigned tg = og / nx;
            if (og + 1u == (tg + 1u) * nx) xb_add(&bar[XB_TOPGEN], 1u);
            else XB_SPIN(xb_ld(&bar[XB_TOPGEN]) == tg, bar);
            __builtin_amdgcn_fence(__ATOMIC_ACQUIRE, "agent");
            xb_add(&bar[XB_XGEN(b.x)], 1u);
            asm volatile("s_waitcnt vmcnt(0)" ::: "memory");
        } else {
            XB_SPIN(xb_ld(&bar[XB_XGEN(b.x)]) == gen, bar);
            __builtin_amdgcn_fence(__ATOMIC_ACQUIRE, "agent");
            asm volatile("s_waitcnt vmcnt(0)" ::: "memory");
        }
    }
    __syncthreads();
}

__global__ void __launch_bounds__(256, 2) mega(P p) {
    extern __shared__ __attribute__((aligned(16))) float smem[];
    cg::grid_group grid = cg::this_grid();
    volatile LAS unsigned* st = (volatile LAS unsigned*)((char*)smem + 73744);
    if (threadIdx.x < 4) st[threadIdx.x] = 0u;
    __syncthreads();
    XcdBarrier xb = xcd_barrier_post(p.bar, st);
    for (int ph = p.ph_lo; ph < p.ph_hi; ++ph) {
        run_phase(p, ph, smem, 0);
        if (PROBE_N > 1 && ph > 0 && ph < NPH - 1 && (ph - 1) % 10 == PROBE_S)
            for (int rep = 1; rep < PROBE_N; ++rep) { xcd_barrier(xb); run_phase(p, ph, smem, rep); }
        if (ph + 1 < p.ph_hi) { if (ph == 0) grid.sync(); else xcd_barrier(xb); }
    }
}

extern "C" void kernel_launch(void* const* d_in, const int* in_sizes, int n_in, void* d_out, int out_size, void* d_ws, size_t ws_size, hipStream_t stream) {
    static int grid_blocks = 0;
    if (!grid_blocks) {
        int dev = 0, cus = 0, per_cu = 0;
        hipGetDevice(&dev);
        hipDeviceGetAttribute(&cus, hipDeviceAttributeMultiprocessorCount, dev);
        hipFuncSetAttribute((const void*)mega, hipFuncAttributeMaxDynamicSharedMemorySize, LDS_BYTES);
        hipOccupancyMaxActiveBlocksPerMultiprocessor(&per_cu, mega, 256, LDS_BYTES);
        if (per_cu < 1) per_cu = 1;
        if (per_cu > 2) per_cu = 2;
        grid_blocks = cus * per_cu;
    }
    P p{};
    const float** ins = (const float**)&p;
    for (int i = 0; i < 24; ++i) ins[i] = (const float*)d_in[i];
    p.out = (float*)d_out;
    size_t off = 0; char* ws = (char*)d_ws;
    auto carve = [&](size_t bytes) { void* r = ws + off; off += (bytes + 255) & ~(size_t)255; return r; };
    p.modv = (float*)carve((size_t)4 * 9 * 6144 * 4);
    p.rope = (float*)carve((size_t)2048 * 64 * 4);
    p.H = (float*)carve((size_t)NT * DM * 4);
    p.XN = (bf16_t*)carve((size_t)NT * DM * 2);
    p.WT = (bf16_t*)carve(WT_TOTAL * 2);
    p.MIX = (bf16_t*)carve((size_t)NT * DM * 2);
    p.PB = (bf16_t*)carve((size_t)NT * 1536 * 2);
    p.GT = (float*)carve((size_t)NT * 16 * 4);
    p.AQL = (bf16_t*)carve((size_t)8 * 16 * 2048 * 64 * 2);
    p.AQC = (bf16_t*)carve((size_t)8 * 16 * 256 * 64 * 2);
    p.AK = (bf16_t*)carve((size_t)8 * 4 * 2 * 2304 * 64 * 2);
    p.AV = (bf16_t*)carve((size_t)8 * 4 * 128 * 2304 * 2);
    p.QKC = (float*)carve((size_t)NT * 512 * 4);
    p.HM = (float*)carve((size_t)2 * NT * 512 * 4);
    p.QB = (bf16_t*)carve((size_t)NT * 2048 * 2);
    p.GATE = (float*)carve((size_t)NT * 128 * 4);
    p.EIDX = (int*)carve((size_t)NT * 128 * 4);
    p.ctr = (int*)carve(256);
    p.bar = (unsigned*)carve((size_t)XCD_BAR_WORDS * 4);
    p.U8 = (unsigned char*)carve((size_t)4 * 16384 * 1024);
    p.V8 = (unsigned char*)carve((size_t)4 * 16384 * 1024);
    p.USC = (float*)carve((size_t)4 * 16384 * 4);
    p.VSC = (float*)carve((size_t)4 * 16384 * 4);
    p.KB = (bf16_t*)carve((size_t)4 * 8 * 2 * 128 * 128 * 2);
    if (off > ws_size) { fprintf(stderr, "kernel_launch: workspace too small: need %zu have %zu\n", off, ws_size); return; }
    hipMemsetAsync(p.bar, 0, (size_t)XCD_BAR_WORDS * 4, stream);
#if ONE_LAUNCH
    p.ph_lo = 0; p.ph_hi = NPH;
    void* args[] = {&p};
    hipError_t e = hipLaunchCooperativeKernel((void*)mega, dim3(grid_blocks), dim3(256), args, LDS_BYTES, stream);
    if (e != hipSuccess) fprintf(stderr, "cooperative launch failed: %s (grid %d)\n", hipGetErrorString(e), grid_blocks);
#else
    for (int ph = 0; ph < NPH; ++ph) {
        if (ph > 0 && ph < NPH - 1) { const int L = (ph - 1) / 10, s = (ph - 1) % 10; if ((s == 4 || s == 2) && (L & 1)) continue; }
        p.ph_lo = ph; p.ph_hi = ph + 1;
        hipLaunchKernelGGL(mega, dim3(grid_blocks), dim3(256), LDS_BYTES, stream, p);
    }
#endif
}
```

```cpp
#include <hip/hip_runtime.h>
#include <hip/hip_cooperative_groups.h>
#include <cstdio>
#include <cstdint>
namespace cg = cooperative_groups;

#ifndef ONE_LAUNCH
#define ONE_LAUNCH 1
#endif

#define NT 18432
#define NL 16384
#define DM 1024
#define EVW 3088
#define ODW 1536
#define C_QK 0
#define C_V 512
#define C_O 1024
#define C_G 1536
#define C_DQ 1552
#define C_DK 2064
#define C_DV 2576
#define NPH 46
#ifndef PROBE_S
#define PROBE_S -1
#endif
#ifndef PROBE_N
#define PROBE_N 1
#endif

typedef unsigned short bf16_t;
typedef short bf16x8 __attribute__((ext_vector_type(8)));
typedef float f32x4 __attribute__((ext_vector_type(4)));
#define LDS_BYTES 73792

typedef float f32x16 __attribute__((ext_vector_type(16)));
typedef unsigned u32x4 __attribute__((ext_vector_type(4)));
struct P {
    const float *x, *c, *ctx, *c_ctx, *mod_w, *mod_b, *norm1_g, *norm2_g, *ev_w_in, *ev_conv_w, *ev_conv_b, *ev_gate_b,
        *ev_ml_g, *ev_da_lam, *ev_da_g, *ev_w_out, *od_w_in, *od_sink, *od_w_out, *pr_w_q, *pr_keys, *pr_u, *pr_v, *final_g;
    float* out;
    float *modv, *H, *GATE, *rope, *GT, *CLOC, *NLOC, *NST, *CHB, *CHM, *MST;
    int *EIDX, *ctr;
    unsigned* bar;
    bf16_t *XN, *MIX, *WT, *KB, *QB, *PB, *AQL, *AQC, *AK, *AV, *QKB, *CST;
    unsigned char *U8, *V8;
    float *USC, *VSC;
    int ph_lo, ph_hi;
};
#define QSCALE 0.18033688011112042f

__device__ __forceinline__ int otid() { int t = threadIdx.x; asm volatile("" : "+v"(t)); return t; }
__device__ __forceinline__ int modrow(int r) { return r < NL ? (r >> 11) : 8; }
__device__ __forceinline__ float silu_f(float x) { return x / (1.f + expf(-x)); }
__device__ __forceinline__ float sigmoid_f(float x) { return 1.f / (1.f + expf(-x)); }
__device__ __forceinline__ float log_sigmoid_f(float x) { return fminf(x, 0.f) - log1pf(expf(-fabsf(x))); }
typedef __bf16 bf16v2_t __attribute__((ext_vector_type(2)));
typedef float f32x2_t __attribute__((ext_vector_type(2)));
__device__ __forceinline__ unsigned cvt_pk_bf16(float lo, float hi) { const bf16v2_t v = __builtin_convertvector((f32x2_t){lo, hi}, bf16v2_t); return __builtin_bit_cast(unsigned, v); }
__device__ __forceinline__ float bf_lo(unsigned u) { return __uint_as_float(u << 16); }
__device__ __forceinline__ float bf_hi(unsigned u) { return __uint_as_float(u & 0xffff0000u); }
#define WT_EVIN(j) ((size_t)(j) * 3200 * 1024)
#define WT_EVOUT(j) ((size_t)2 * 3200 * 1024 + (size_t)(j) * 1024 * 1024)
#define WT_ODIN(j) ((size_t)2 * 3200 * 1024 + (size_t)2 * 1024 * 1024 + (size_t)(j) * 1536 * 1024)
#define WT_ODOUT(j) ((size_t)2 * 3200 * 1024 + (size_t)2 * 1024 * 1024 + (size_t)2 * 1536 * 1024 + (size_t)(j) * 1024 * 1024)
#define WT_PQ(L) ((size_t)2 * 3200 * 1024 + (size_t)4 * 1024 * 1024 + (size_t)2 * 1536 * 1024 + (size_t)(L) * 2048 * 1024)
#define WT_TOTAL ((size_t)2 * 3200 * 1024 + (size_t)4 * 1024 * 1024 + (size_t)2 * 1536 * 1024 + (size_t)4 * 2048 * 1024)
__device__ __forceinline__ float wave_sum(float v) {
#pragma unroll
    for (int o = 32; o > 0; o >>= 1) v += __shfl_xor(v, o);
    return v;
}

__device__ void cvt_copy_bf16(const float* src, bf16_t* dst, size_t n);
__device__ void quant_rows_i8(const float* src, unsigned char* dst, float* scl, int nrows);
__device__ void ph_prologue(const P& p, float* smem) {
    const int tid = otid(), nb = gridDim.x, bid = blockIdx.x;
    if (bid == 0 && tid < 64) p.ctr[tid] = 0;
    {
        const float4* xs = (const float4*)p.x; const float4* cs = (const float4*)p.ctx; float4* hd = (float4*)p.H;
        const size_t nx = (size_t)NL * DM / 4, nc = (size_t)(NT - NL) * DM / 4;
        for (size_t i = (size_t)bid * 256 + tid; i < nx + nc; i += (size_t)nb * 256) hd[i] = i < nx ? xs[i] : cs[i - nx];
    }
    for (int i = bid * 256 + tid; i < 2048 * 32; i += nb * 256) {
        const int s = i >> 5, d = i & 31;
        const float pos = (d < 16) ? (float)(s >> 6) : (float)(s & 63);
        const float inv = powf(10000.0f, -(float)(d & 15) / 16.0f);
        const float ang = pos * inv;
        p.rope[2 * i] = cosf(ang); p.rope[2 * i + 1] = sinf(ang);
    }
    float* sc = smem;
    float* red = smem + 9 * 1024;
    for (int i = tid; i < 9 * 1024; i += 256) { const int r = i >> 10, k = i & 1023; const float v = r < 8 ? p.c[r * 1024 + k] : p.c_ctx[k]; sc[i] = silu_f(v); }
    __syncthreads();
    for (int item = bid; item < 4 * 96; item += nb) {
        const int L = item / 96, n0 = (item % 96) * 64, tx = tid & 63, kq = tid >> 6;
        float acc[9];
#pragma unroll
        for (int r = 0; r < 9; ++r) acc[r] = 0.f;
        const float* w = p.mod_w + (size_t)L * 1024 * 6144 + n0 + tx;
        for (int k = kq * 256; k < kq * 256 + 256; ++k) {
            const float wv = w[(size_t)k * 6144];
#pragma unroll
            for (int r = 0; r < 9; ++r) acc[r] += sc[r * 1024 + k] * wv;
        }
#pragma unroll
        for (int r = 0; r < 9; ++r) red[(kq * 9 + r) * 64 + tx] = acc[r];
        __syncthreads();
        if (kq == 0) {
#pragma unroll
            for (int r = 0; r < 9; ++r) {
                const float s = red[(0 * 9 + r) * 64 + tx] + red[(1 * 9 + r) * 64 + tx] + red[(2 * 9 + r) * 64 + tx] + red[(3 * 9 + r) * 64 + tx];
                p.modv[((size_t)L * 9 + r) * 6144 + n0 + tx] = s + p.mod_b[L * 6144 + n0 + tx];
            }
        }
        __syncthreads();
    }
    {
        float (*tile)[65] = (float (*)[65])smem;
        for (int item = bid; item < 5440; item += nb) {
            int it = item, mat = 0, N = 0, Npad = 0; const float* src = nullptr; bf16_t* dst = nullptr;
            for (mat = 0; mat < 12; ++mat) {
                if (mat < 2) { N = EVW; Npad = 3200; src = p.ev_w_in + (size_t)mat * DM * EVW; dst = p.WT + WT_EVIN(mat); }
                else if (mat < 4) { N = 1024; Npad = 1024; src = p.ev_w_out + (size_t)(mat - 2) * DM * DM; dst = p.WT + WT_EVOUT(mat - 2); }
                else if (mat < 6) { N = ODW; Npad = ODW; src = p.od_w_in + (size_t)(mat - 4) * DM * ODW; dst = p.WT + WT_ODIN(mat - 4); }
                else if (mat < 8) { N = 1024; Npad = 1024; src = p.od_w_out + (size_t)(mat - 6) * DM * DM; dst = p.WT + WT_ODOUT(mat - 6); }
                else { N = 2048; Npad = 2048; src = p.pr_w_q + (size_t)(mat - 8) * DM * 2048; dst = p.WT + WT_PQ(mat - 8); }
                const int nt = 16 * (Npad / 64);
                if (it < nt) break;
                it -= nt;
            }
            const int k0 = (it & 15) * 64, n0 = (it >> 4) * 64;
            __syncthreads();
#pragma unroll
            for (int rep = 0; rep < 4; ++rep) {
                const int i = (tid >> 4) + 16 * rep, c4 = (tid & 15) * 4;
                float4 v = make_float4(0.f, 0.f, 0.f, 0.f);
                int sc = n0 + c4;
                if (mat < 2) sc = sc < 1536 ? sc : (sc < 3072 ? sc + 16 : (sc < 3088 ? sc - 3072 + 1536 : N));
                if (sc < N) v = *(const float4*)(src + (size_t)(k0 + i) * N + sc);
                tile[i][c4] = v.x; tile[i][c4 + 1] = v.y; tile[i][c4 + 2] = v.z; tile[i][c4 + 3] = v.w;
            }
            __syncthreads();
            {
                const int n = tid >> 2, kq = (tid & 3) * 16;
                unsigned w[8];
#pragma unroll
                for (int e = 0; e < 8; ++e) w[e] = cvt_pk_bf16(tile[kq + 2 * e][n], tile[kq + 2 * e + 1][n]);
                uint4* dp = (uint4*)(dst + (size_t)(n0 + n) * DM + k0 + kq);
                dp[0] = make_uint4(w[0], w[1], w[2], w[3]); dp[1] = make_uint4(w[4], w[5], w[6], w[7]);
            }
        }
    }
    quant_rows_i8(p.pr_u, p.U8, p.USC, 4 * 16384);
    quant_rows_i8(p.pr_v, p.V8, p.VSC, 4 * 16384);
    cvt_copy_bf16(p.pr_keys, p.KB, (size_t)4 * 8 * 2 * 128 * 128);
}

__device__ void cvt_copy_bf16(const float* src, bf16_t* dst, size_t n) {
    const size_t n8 = n / 8;
    for (size_t i = (size_t)blockIdx.x * 256 + otid(); i < n8; i += (size_t)gridDim.x * 256) {
        const float4 a = ((const float4*)src)[2 * i], b = ((const float4*)src)[2 * i + 1];
        ((uint4*)dst)[i] = make_uint4(cvt_pk_bf16(a.x, a.y), cvt_pk_bf16(a.z, a.w), cvt_pk_bf16(b.x, b.y), cvt_pk_bf16(b.z, b.w));
    }
}

__device__ void quant_rows_i8(const float* src, unsigned char* dst, float* scl, int nrows) {
    const int lane = otid() & 63, wid = otid() >> 6;
    for (int r = blockIdx.x * 4 + wid; r < nrows; r += gridDim.x * 4) {
        const float4* sp = (const float4*)(src + (size_t)r * 1024 + lane * 16);
        float4 v[4]; float mx = 0.f;
#pragma unroll
        for (int i = 0; i < 4; ++i) { v[i] = sp[i]; mx = fmaxf(mx, fmaxf(fmaxf(fabsf(v[i].x), fabsf(v[i].y)), fmaxf(fabsf(v[i].z), fabsf(v[i].w)))); }
#pragma unroll
        for (int o = 32; o > 0; o >>= 1) mx = fmaxf(mx, __shfl_xor(mx, o));
        const float inv = mx > 0.f ? 127.f / mx : 0.f;
        unsigned w[4];
#pragma unroll
        for (int i = 0; i < 4; ++i) {
            const unsigned b0 = (unsigned)((int)rintf(v[i].x * inv) + 128), b1 = (unsigned)((int)rintf(v[i].y * inv) + 128), b2 = (unsigned)((int)rintf(v[i].z * inv) + 128), b3 = (unsigned)((int)rintf(v[i].w * inv) + 128);
            w[i] = b0 | (b1 << 8) | (b2 << 16) | (b3 << 24);
        }
        *(uint4*)(dst + (size_t)r * 1024 + lane * 16) = make_uint4(w[0], w[1], w[2], w[3]);
        if (lane == 0) scl[r] = mx * (1.f / 127.f);
    }
}

__device__ void ph_normmod(const float* src, const float* g, const float* modv_layer, int shift_off, int scale_off, bf16_t* dst, int nrows) {
    const int lane = otid() & 63, wid = otid() >> 6;
    for (int r = blockIdx.x * 4 + wid; r < nrows; r += gridDim.x * 4) {
        const float4* s4 = (const float4*)(src + (size_t)r * DM);
        float4 v[4]; float ss = 0.f;
#pragma unroll
        for (int i = 0; i < 4; ++i) { v[i] = s4[i * 64 + lane]; ss += v[i].x * v[i].x + v[i].y * v[i].y + v[i].z * v[i].z + v[i].w * v[i].w; }
        ss = wave_sum(ss);
        const float rstd = rsqrtf(ss * (1.0f / DM) + 1e-6f);
        const float* mv = modv_layer + (size_t)modrow(r) * 6144;
        uint2* d2 = (uint2*)(dst + (size_t)r * DM);
#pragma unroll
        for (int i = 0; i < 4; ++i) {
            const int c = (i * 64 + lane) * 4;
            const float4 gg = *(const float4*)(g + c), sh = *(const float4*)(mv + shift_off + c), scl = *(const float4*)(mv + scale_off + c);
            float4 o;
            o.x = v[i].x * rstd * gg.x * (1.f + scl.x) + sh.x; o.y = v[i].y * rstd * gg.y * (1.f + scl.y) + sh.y;
            o.z = v[i].z * rstd * gg.z * (1.f + scl.z) + sh.z; o.w = v[i].w * rstd * gg.w * (1.f + scl.w) + sh.w;
            d2[i * 64 + lane] = make_uint2(cvt_pk_bf16(o.x, o.y), cvt_pk_bf16(o.z, o.w));
        }
    }
}

__device__ void ph_final(const P& p) {
    const int lane = otid() & 63, wid = otid() >> 6;
    for (int r = blockIdx.x * 4 + wid; r < NL; r += gridDim.x * 4) {
        const float4* s4 = (const float4*)(p.H + (size_t)r * DM);
        float4 v[4]; float ss = 0.f;
#pragma unroll
        for (int i = 0; i < 4; ++i) { v[i] = s4[i * 64 + lane]; ss += v[i].x * v[i].x + v[i].y * v[i].y + v[i].z * v[i].z + v[i].w * v[i].w; }
        ss = wave_sum(ss);
        const float rstd = rsqrtf(ss * (1.0f / DM) + 1e-6f);
        float4* d4 = (float4*)(p.out + (size_t)r * DM);
#pragma unroll
        for (int i = 0; i < 4; ++i) {
            const int c = (i * 64 + lane) * 4; const float4 gg = *(const float4*)(p.final_g + c);
            float4 o; o.x = v[i].x * rstd * gg.x; o.y = v[i].y * rstd * gg.y; o.z = v[i].z * rstd * gg.z; o.w = v[i].w * rstd * gg.w;
            d4[i * 64 + lane] = o;
        }
    }
}

#define GL_ROWB 144
#define GL_TILEB (128 * GL_ROWB)
struct TokPos { int b, pos, kpos; bool lat; };
__device__ __forceinline__ TokPos tokpos(int row) {
    TokPos t; t.lat = row < NL;
    if (t.lat) { t.b = row >> 11; t.pos = row & 2047; t.kpos = 256 + t.pos; } else { const int r = row - NL; t.b = r >> 8; t.pos = r & 255; t.kpos = t.pos; }
    return t;
}
struct EpiStoreBF16 {
    bf16_t* C; int ldc;
    __device__ __forceinline__ bool swapped(int) const { return false; }
    __device__ __forceinline__ void operator()(const f32x4 (&acc)[4][4], int m0, int n0, int wm, int wn, int fr, int fq) const {
#pragma unroll
        for (int mi = 0; mi < 4; ++mi)
#pragma unroll
            for (int ni = 0; ni < 4; ++ni) {
                const f32x4 v = acc[ni][mi];
                *(uint2*)(C + (size_t)(m0 + wm * 64 + mi * 16 + fr) * ldc + n0 + wn * 64 + ni * 16 + fq * 4) = make_uint2(cvt_pk_bf16(v[0], v[1]), cvt_pk_bf16(v[2], v[3]));
            }
    }
};
struct EpiResid {
    float* H; const float* gate; float scale;
    __device__ __forceinline__ bool swapped(int) const { return false; }
    __device__ __forceinline__ void operator()(const f32x4 (&acc)[4][4], int m0, int n0, int wm, int wn, int fr, int fq) const {
#pragma unroll
        for (int mi = 0; mi < 4; ++mi) {
            const int row = m0 + wm * 64 + mi * 16 + fr;
            const float* gp = gate + (size_t)modrow(row) * 6144;
#pragma unroll
            for (int ni = 0; ni < 4; ++ni) {
                const int col = n0 + wn * 64 + ni * 16 + fq * 4;
                const f32x4 g = *(const f32x4*)(gp + col);
                f32x4* hp = (f32x4*)(H + (size_t)row * DM + col);
                *hp = *hp + g * acc[ni][mi] * scale;
            }
        }
    }
};
__device__ __forceinline__ void rope_store64(const f32x4 (&acc)[4][4], int mi, bool do_rope, const float* ropep  , float scale, bf16_t* dst  , int fq) {
#pragma unroll
    for (int ni = 0; ni < 2; ++ni) {
        f32x4 x1 = acc[ni][mi], x2 = acc[ni + 2][mi];
        if (do_rope) {
            const f32x4 r0 = *(const f32x4*)(ropep + (ni * 16 + fq * 4) * 2), r1 = *(const f32x4*)(ropep + (ni * 16 + fq * 4) * 2 + 4);
            const f32x4 cs = (f32x4){r0[0], r0[2], r1[0], r1[2]}, sn = (f32x4){r0[1], r0[3], r1[1], r1[3]};
            const f32x4 y1 = x1 * cs - x2 * sn, y2 = x1 * sn + x2 * cs;
            x1 = y1; x2 = y2;
        }
        x1 = x1 * scale; x2 = x2 * scale;
        *(uint2*)(dst + ni * 16 + fq * 4) = make_uint2(cvt_pk_bf16(x1[0], x1[1]), cvt_pk_bf16(x1[2], x1[3]));
        *(uint2*)(dst + 32 + ni * 16 + fq * 4) = make_uint2(cvt_pk_bf16(x2[0], x2[1]), cvt_pk_bf16(x2[2], x2[3]));
    }
}
struct EpiEven {
    bf16_t *PB, *AQL, *AQC, *AK, *AV; float* GT; const float* rope;
    __device__ __forceinline__ bool swapped(int n0) const { return n0 >= 2560 && n0 < 3072; }
    __device__ __forceinline__ void operator()(const f32x4 (&acc)[4][4], int m0, int n0, int wm, int wn, int fr, int fq) const {
        const int t = n0 >> 7;
        if (t < 12) {
#pragma unroll
            for (int mi = 0; mi < 4; ++mi)
#pragma unroll
                for (int ni = 0; ni < 4; ++ni) {
                    const f32x4 v = acc[ni][mi];
                    *(uint2*)(PB + (size_t)(m0 + wm * 64 + mi * 16 + fr) * 1536 + n0 + wn * 64 + ni * 16 + fq * 4) = make_uint2(cvt_pk_bf16(v[0], v[1]), cvt_pk_bf16(v[2], v[3]));
                }
        } else if (t < 20) {
            const bool isq = t < 16; const int h = t & 3;
#pragma unroll
            for (int mi = 0; mi < 4; ++mi) {
                const TokPos tp = tokpos(m0 + wm * 64 + mi * 16 + fr);
                const int hm = (tp.b * 4 + h) * 2 + wn;
                bf16_t* dst;
                if (isq) dst = tp.lat ? AQL + ((size_t)hm * 2048 + tp.pos) * 64 : AQC + ((size_t)hm * 256 + tp.pos) * 64;
                else dst = AK + ((size_t)hm * 2304 + tp.kpos) * 64;
                rope_store64(acc, mi, tp.lat, rope + (size_t)tp.pos * 64, isq ? QSCALE : 1.0f, dst, fq);
            }
        } else if (t < 24) {
            const int h = t - 20;
#pragma unroll
            for (int mi = 0; mi < 4; ++mi) {
                const TokPos tp = tokpos(m0 + wm * 64 + mi * 16 + fq * 4);
#pragma unroll
                for (int ni = 0; ni < 4; ++ni) {
                    const f32x4 v = acc[ni][mi];
                    const int d = wn * 64 + ni * 16 + fr;
                    *(uint2*)(AV + ((size_t)(tp.b * 4 + h) * 128 + d) * 2304 + tp.kpos) = make_uint2(cvt_pk_bf16(v[0], v[1]), cvt_pk_bf16(v[2], v[3]));
                }
            }
        } else {
            if (wn == 0) {
#pragma unroll
                for (int mi = 0; mi < 4; ++mi) *(f32x4*)(GT + (size_t)(m0 + wm * 64 + mi * 16 + fr) * 16 + fq * 4) = acc[0][mi];
            }
        }
    }
};
struct EpiOdd {
    bf16_t *AQL, *AQC, *AK, *AV; const float* rope;
    __device__ __forceinline__ bool swapped(int n0) const { return n0 >= 1280; }
    __device__ __forceinline__ void operator()(const f32x4 (&acc)[4][4], int m0, int n0, int wm, int wn, int fr, int fq) const {
        const int t = n0 >> 7;
        if (t < 10) {
            const bool isq = t < 8; const int hd = isq ? t * 2 + wn : (t - 8) * 2 + wn;
#pragma unroll
            for (int mi = 0; mi < 4; ++mi) {
                const TokPos tp = tokpos(m0 + wm * 64 + mi * 16 + fr);
                bf16_t* dst;
                if (isq) dst = tp.lat ? AQL + ((size_t)(tp.b * 16 + hd) * 2048 + tp.pos) * 64 : AQC + ((size_t)(tp.b * 16 + hd) * 256 + tp.pos) * 64;
                else dst = AK + ((size_t)(tp.b * 4 + hd) * 2304 + tp.kpos) * 64;
                rope_store64(acc, mi, tp.lat, rope + (size_t)tp.pos * 64, isq ? QSCALE : 1.0f, dst, fq);
            }
        } else {
            const int hkv = (t - 10) * 2 + wn;
#pragma unroll
            for (int mi = 0; mi < 4; ++mi) {
                const TokPos tp = tokpos(m0 + wm * 64 + mi * 16 + fq * 4);
#pragma unroll
                for (int ni = 0; ni < 4; ++ni) {
                    const f32x4 v = acc[ni][mi];
                    const int d = ni * 16 + fr;
                    *(uint2*)(AV + ((size_t)(tp.b * 4 + hkv) * 64 + d) * 2304 + tp.kpos) = make_uint2(cvt_pk_bf16(v[0], v[1]), cvt_pk_bf16(v[2], v[3]));
                }
            }
        }
    }
};
template <bool SWAP>
__device__ __forceinline__ void gemm_tile_kloop(f32x4 (&acc)[4][4], const bf16_t* ap, const bf16_t* bp, char* smem, int lrow, int lch, int wm, int wn, int fr, int fq) {
    uint4 ra0, ra1, ra2, ra3, rb0, rb1, rb2, rb3;
#define GL_LOAD(KO) { ra0 = *(const uint4*)(ap + (KO)); ra1 = *(const uint4*)(ap + (size_t)32 * DM + (KO)); ra2 = *(const uint4*)(ap + (size_t)64 * DM + (KO)); ra3 = *(const uint4*)(ap + (size_t)96 * DM + (KO)); \
                      rb0 = *(const uint4*)(bp + (KO)); rb1 = *(const uint4*)(bp + (size_t)32 * DM + (KO)); rb2 = *(const uint4*)(bp + (size_t)64 * DM + (KO)); rb3 = *(const uint4*)(bp + (size_t)96 * DM + (KO)); }
#define GL_STORE(BUF) { char* sa_ = (BUF) + lrow * GL_ROWB + lch * 16; char* sb_ = sa_ + GL_TILEB; \
                        *(uint4*)(sa_) = ra0; *(uint4*)(sa_ + 32 * GL_ROWB) = ra1; *(uint4*)(sa_ + 64 * GL_ROWB) = ra2; *(uint4*)(sa_ + 96 * GL_ROWB) = ra3; \
                        *(uint4*)(sb_) = rb0; *(uint4*)(sb_ + 32 * GL_ROWB) = rb1; *(uint4*)(sb_ + 64 * GL_ROWB) = rb2; *(uint4*)(sb_ + 96 * GL_ROWB) = rb3; }
    GL_LOAD(0)
    __syncthreads();
    GL_STORE(smem)
    __syncthreads();
    for (int kt = 0; kt < 16; ++kt) {
        char* cur = smem + (kt & 1) * 2 * GL_TILEB;
        char* nxt = smem + ((kt + 1) & 1) * 2 * GL_TILEB;
        if (kt + 1 < 16) GL_LOAD((kt + 1) * 64)
#pragma unroll
        for (int ks = 0; ks < 2; ++ks) {
            bf16x8 af[4], wf[4];
#pragma unroll
            for (int i = 0; i < 4; ++i) {
                af[i] = *(const bf16x8*)(cur + (wm * 64 + i * 16 + fr) * GL_ROWB + (ks * 4 + fq) * 16);
                wf[i] = *(const bf16x8*)(cur + GL_TILEB + (wn * 64 + i * 16 + fr) * GL_ROWB + (ks * 4 + fq) * 16);
            }
#pragma unroll
            for (int ni = 0; ni < 4; ++ni)
#pragma unroll
                for (int mi = 0; mi < 4; ++mi)
                    acc[ni][mi] = SWAP ? __builtin_amdgcn_mfma_f32_16x16x32_bf16(af[mi], wf[ni], acc[ni][mi], 0, 0, 0)
                                       : __builtin_amdgcn_mfma_f32_16x16x32_bf16(wf[ni], af[mi], acc[ni][mi], 0, 0, 0);
        }
        if (kt + 1 < 16) GL_STORE(nxt)
        __syncthreads();
    }
#undef GL_LOAD
#undef GL_STORE
}
template <class Epi>
__device__ void ph_gemm(const bf16_t* A, const bf16_t* Bt, int M, int Npad, const Epi& epi, char* smem) {
    const int tid = otid(), lane = tid & 63, wid = tid >> 6, wm = wid >> 1, wn = wid & 1;
    const int fr = lane & 15, fq = lane >> 4;
    const int tm = M / 128, tn = Npad / 128, ntiles = tm * tn;
    const int lrow = tid >> 3, lch = tid & 7;
    for (int tile = blockIdx.x; tile < ntiles; tile += gridDim.x) {
        const int m0 = (tile % tm) * 128, n0 = (tile / tm) * 128;
        f32x4 acc[4][4];
#pragma unroll
        for (int a = 0; a < 4; ++a)
#pragma unroll
            for (int b = 0; b < 4; ++b) acc[a][b] = (f32x4){0.f, 0.f, 0.f, 0.f};
        const bf16_t* ap = A + (size_t)(m0 + lrow) * DM + lch * 8;
        const bf16_t* bp = Bt + (size_t)(n0 + lrow) * DM + lch * 8;
        if (epi.swapped(n0)) gemm_tile_kloop<true>(acc, ap, bp, smem, lrow, lch, wm, wn, fr, fq);
        else gemm_tile_kloop<false>(acc, ap, bp, smem, lrow, lch, wm, wn, fr, fq);
        epi(acc, m0, n0, wm, wn, fr, fq);
    }
}

__device__ void ph_prep_even(const P& p, int j) {
    const float* cw = p.ev_conv_w + (size_t)j * 3 * 512; const float* cb = p.ev_conv_b + (size_t)j * 512;
    const size_t tot = (size_t)NT * 256;
    for (size_t i = (size_t)blockIdx.x * 256 + otid(); i < tot; i += (size_t)gridDim.x * 256) {
        const int r = (int)(i >> 8), c = (int)(i & 255) * 2;
        int t, T; if (r < NL) { t = r & 2047; T = 2048; } else { t = (r - NL) & 255; T = 256; }
        const unsigned x1 = *(const unsigned*)(p.PB + (size_t)r * 1536 + c);
        float v0 = cb[c] + bf_lo(x1) * cw[512 + c], v1 = cb[c + 1] + bf_hi(x1) * cw[512 + c + 1];
        if (t > 0) { const unsigned x0 = *(const unsigned*)(p.PB + (size_t)(r - 1) * 1536 + c); v0 += bf_lo(x0) * cw[c]; v1 += bf_hi(x0) * cw[c + 1]; }
        if (t < T - 1) { const unsigned x2 = *(const unsigned*)(p.PB + (size_t)(r + 1) * 1536 + c); v0 += bf_lo(x2) * cw[1024 + c]; v1 += bf_hi(x2) * cw[1024 + c + 1]; }
        v0 = silu_f(v0); v1 = silu_f(v1);
        if (c >= 256) { v0 *= 0.125f; v1 *= 0.125f; }
        *(unsigned*)(p.QKB + (size_t)r * 512 + c) = cvt_pk_bf16(v0, v1);
    }
}

#define FA_KROW 144
#define FA_VROW 136
__device__ __forceinline__ bf16x8 pack8(float a0, float a1, float a2, float a3, float a4, float a5, float a6, float a7) {
    const u32x4 u = (u32x4){cvt_pk_bf16(a0, a1), cvt_pk_bf16(a2, a3), cvt_pk_bf16(a4, a5), cvt_pk_bf16(a6, a7)};
    return __builtin_bit_cast(bf16x8, u);
}
template <int NDB, bool MASK>
__device__ __forceinline__ void flash_tile(const bf16x8 (&qf)[4], f32x16 (&o)[NDB], float& m, float& l, const char* Kl, const char* Vl, int lane, int qpos, int kp0) {
    const int j = lane & 31, h = lane >> 5;
    f32x16 s0, s1;
#pragma unroll
    for (int i = 0; i < 16; ++i) { s0[i] = 0.f; s1[i] = 0.f; }
#pragma unroll
    for (int ks = 0; ks < 4; ++ks) {
        const bf16x8 a0 = *(const bf16x8*)(Kl + j * FA_KROW + (2 * ks + h) * 16);
        const bf16x8 a1 = *(const bf16x8*)(Kl + (32 + j) * FA_KROW + (2 * ks + h) * 16);
        s0 = __builtin_amdgcn_mfma_f32_32x32x16_bf16(a0, qf[ks], s0, 0, 0, 0);
        s1 = __builtin_amdgcn_mfma_f32_32x32x16_bf16(a1, qf[ks], s1, 0, 0, 0);
    }
    if (MASK) {
#pragma unroll
        for (int r = 0; r < 16; ++r) {
            const int key = (r & 3) + 8 * (r >> 2) + 4 * h;
            const int d0 = qpos - (kp0 + key), d1 = d0 - 32;
            if (d0 > 128 || d0 < -128) s0[r] = -1e30f;
            if (d1 > 128 || d1 < -128) s1[r] = -1e30f;
        }
    }
    float mx = fmaxf(s0[0], s1[0]);
#pragma unroll
    for (int r = 1; r < 16; ++r) mx = fmaxf(mx, fmaxf(s0[r], s1[r]));
    mx = fmaxf(mx, __shfl_xor(mx, 32));
    const float mn = fmaxf(m, mx);
    const float alpha = __builtin_amdgcn_exp2f(m - mn);
    m = mn;
    float ls = 0.f;
#pragma unroll
    for (int r = 0; r < 16; ++r) { s0[r] = __builtin_amdgcn_exp2f(s0[r] - mn); s1[r] = __builtin_amdgcn_exp2f(s1[r] - mn); ls += s0[r] + s1[r]; }
    l = l * alpha + ls;
#pragma unroll
    for (int db = 0; db < NDB; ++db) o[db] = o[db] * alpha;
    bf16x8 pb[4];
    pb[0] = pack8(s0[0], s0[1], s0[2], s0[3], s0[4], s0[5], s0[6], s0[7]);
    pb[1] = pack8(s0[8], s0[9], s0[10], s0[11], s0[12], s0[13], s0[14], s0[15]);
    pb[2] = pack8(s1[0], s1[1], s1[2], s1[3], s1[4], s1[5], s1[6], s1[7]);
    pb[3] = pack8(s1[8], s1[9], s1[10], s1[11], s1[12], s1[13], s1[14], s1[15]);
#pragma unroll
    for (int db = 0; db < NDB; ++db)
#pragma unroll
        for (int kk = 0; kk < 4; ++kk) {
            const char* vp = Vl + (db * 32 + j) * FA_VROW + (kk * 16 + 4 * h) * 2;
            const uint2 lo = *(const uint2*)vp, hi = *(const uint2*)(vp + 16);
            const u32x4 u = (u32x4){lo.x, lo.y, hi.x, hi.y};
            o[db] = __builtin_amdgcn_mfma_f32_32x32x16_bf16(__builtin_bit_cast(bf16x8, u), pb[kk], o[db], 0, 0, 0);
        }
}

#define DA_BUFB 35840
__device__ void da_block(const P& p, int item, int L, int j, char* smem) {
    const int tid = otid(), lane = tid & 63, wid = tid >> 6, mp = wid & 1, qg = wid >> 1, jq = lane & 31, hh = lane >> 5;
    const bool lat = item < 1024;
    int b, h, qt;
    if (lat) { b = item >> 7; h = (item >> 5) & 3; qt = item & 31; } else { const int it = item - 1024; b = it >> 4; h = (it >> 2) & 3; qt = it & 3; }
    const int qi = qt * 64 + qg * 32 + jq;
    const bf16_t* qp = lat ? p.AQL + ((size_t)((b * 4 + h) * 2 + mp) * 2048 + qi) * 64 : p.AQC + ((size_t)((b * 4 + h) * 2 + mp) * 256 + qi) * 64;
    bf16x8 qf[4];
#pragma unroll
    for (int ks = 0; ks < 4; ++ks) qf[ks] = *(const bf16x8*)(qp + (2 * ks + hh) * 8);
    const int ntile = lat ? 36 : 4;
    const bf16_t* kg = p.AK + (size_t)((b * 4 + h) * 2) * 2304 * 64 + (size_t)(tid >> 3) * 64 + (tid & 7) * 8;
    const bf16_t* vg = p.AV + (size_t)(b * 4 + h) * 128 * 2304 + (size_t)(tid >> 3) * 2304 + (tid & 7) * 8;
    uint4 k0, k1, k2, k3, v0, v1, v2, v3;
#define DA_LOAD(KEY0) { k0 = *(const uint4*)(kg + (size_t)(KEY0) * 64); k1 = *(const uint4*)(kg + (size_t)((KEY0) + 32) * 64); \
                        k2 = *(const uint4*)(kg + (size_t)2304 * 64 + (size_t)(KEY0) * 64); k3 = *(const uint4*)(kg + (size_t)2304 * 64 + (size_t)((KEY0) + 32) * 64); \
                        v0 = *(const uint4*)(vg + (KEY0)); v1 = *(const uint4*)(vg + (size_t)32 * 2304 + (KEY0)); v2 = *(const uint4*)(vg + (size_t)64 * 2304 + (KEY0)); v3 = *(const uint4*)(vg + (size_t)96 * 2304 + (KEY0)); }
#define DA_STORE(BUF) { char* kb_ = (BUF) + (tid >> 3) * FA_KROW + (tid & 7) * 16; \
                        *(uint4*)kb_ = k0; *(uint4*)(kb_ + 32 * FA_KROW) = k1; *(uint4*)(kb_ + 64 * FA_KROW) = k2; *(uint4*)(kb_ + 96 * FA_KROW) = k3; \
                        char* vb_ = (BUF) + 18432 + (tid >> 3) * FA_VROW + (tid & 7) * 16; \
                        *(uint2*)vb_ = make_uint2(v0.x, v0.y); *(uint2*)(vb_ + 8) = make_uint2(v0.z, v0.w); \
                        *(uint2*)(vb_ + 32 * FA_VROW) = make_uint2(v1.x, v1.y); *(uint2*)(vb_ + 32 * FA_VROW + 8) = make_uint2(v1.z, v1.w); \
                        *(uint2*)(vb_ + 64 * FA_VROW) = make_uint2(v2.x, v2.y); *(uint2*)(vb_ + 64 * FA_VROW + 8) = make_uint2(v2.z, v2.w); \
                        *(uint2*)(vb_ + 96 * FA_VROW) = make_uint2(v3.x, v3.y); *(uint2*)(vb_ + 96 * FA_VROW + 8) = make_uint2(v3.z, v3.w); }
    f32x16 o[4];
#pragma unroll
    for (int db = 0; db < 4; ++db)
#pragma unroll
        for (int i = 0; i < 16; ++i) o[db][i] = 0.f;
    float m = -1e30f, l = 0.f;
    DA_LOAD(0)
    __syncthreads();
    DA_STORE(smem)
    __syncthreads();
    for (int t = 0; t < ntile; ++t) {
        char* cur = smem + (t & 1) * DA_BUFB;
        char* nxt = smem + ((t + 1) & 1) * DA_BUFB;
        if (t + 1 < ntile) DA_LOAD((t + 1) * 64)
        flash_tile<4, false>(qf, o, m, l, cur + mp * 9216, cur + 18432, lane, 0, 0);
        if (t + 1 < ntile) DA_STORE(nxt)
        __syncthreads();
    }
#undef DA_LOAD
#undef DA_STORE
    const float inv = 1.f / (l + __shfl_xor(l, 32));
#pragma unroll
    for (int db = 0; db < 4; ++db) o[db] = o[db] * inv;
    float* X = (float*)smem + qg * 4096;
    if (mp == 1) {
#pragma unroll
        for (int db = 0; db < 4; ++db)
#pragma unroll
            for (int r = 0; r < 16; ++r) X[(db * 32 + (r & 3) + 8 * (r >> 2) + 4 * hh) * 32 + jq] = o[db][r];
    }
    __syncthreads();
    if (mp == 0) {
        const float lam_init = 0.8f - 0.6f * expf(-0.3f * (float)L);
        const float* lp = p.ev_da_lam + (size_t)j * 256;
        float a0 = lp[lane] * lp[64 + lane], a1 = lp[128 + lane] * lp[192 + lane];
        a0 = wave_sum(a0); a1 = wave_sum(a1);
        const float lam = expf(a0) - expf(a1) + lam_init;
        float ss = 0.f;
#pragma unroll
        for (int db = 0; db < 4; ++db)
#pragma unroll
            for (int r = 0; r < 16; ++r) { const float v = o[db][r] - lam * X[(db * 32 + (r & 3) + 8 * (r >> 2) + 4 * hh) * 32 + jq]; o[db][r] = v; ss += v * v; }
        ss += __shfl_xor(ss, 32);
        const float sc = rsqrtf(ss * (1.f / 128.f) + 1e-6f) * (1.f - lam_init);
        const int row = lat ? b * 2048 + qi : NL + b * 256 + qi;
        bf16_t* mrow = p.MIX + (size_t)row * DM + 512 + h * 128;
        const float* g = p.ev_da_g + (size_t)j * 512 + h * 128;
#pragma unroll
        for (int db = 0; db < 4; ++db)
#pragma unroll
            for (int r4 = 0; r4 < 4; ++r4) {
                const int d = db * 32 + 8 * r4 + 4 * hh;
                const f32x4 gg = *(const f32x4*)(g + d);
                *(uint2*)(mrow + d) = make_uint2(cvt_pk_bf16(o[db][r4 * 4 + 0] * sc * gg[0], o[db][r4 * 4 + 1] * sc * gg[1]), cvt_pk_bf16(o[db][r4 * 4 + 2] * sc * gg[2], o[db][r4 * 4 + 3] * sc * gg[3]));
            }
    }
    __syncthreads();
}

#define WA_BUFB 17920
__device__ void wa_block(const P& p, int item, int j, char* smem) {
    const int tid = otid(), lane = tid & 63, wid = tid >> 6, jq = lane & 31, hh = lane >> 5;
    const bool lat = item < 2048;
    int b, nb, hq;
    if (lat) { hq = item & 15; nb = (item >> 4) & 15; b = item >> 8; } else { const int it = item - 2048; hq = it & 15; nb = (it >> 4) & 1; b = it >> 5; }
    const int hkv = hq >> 2;
    const int qi = nb * 128 + wid * 32 + jq;
    const bf16_t* qp = lat ? p.AQL + ((size_t)(b * 16 + hq) * 2048 + qi) * 64 : p.AQC + ((size_t)(b * 16 + hq) * 256 + qi) * 64;
    bf16x8 qf[4];
#pragma unroll
    for (int ks = 0; ks < 4; ++ks) qf[ks] = *(const bf16x8*)(qp + (2 * ks + hh) * 8);
    const int lfirst = (nb == 0) ? 2 : 0, nloc = lat ? 6 - lfirst - ((nb == 15) ? 2 : 0) : 0;
    const int ntile = 4 + nloc;
    const bf16_t* kg = p.AK + (size_t)(b * 4 + hkv) * 2304 * 64 + (size_t)(tid >> 3) * 64 + (tid & 7) * 8;
    const bf16_t* vg = p.AV + (size_t)(b * 4 + hkv) * 64 * 2304 + (size_t)(tid >> 3) * 2304 + (tid & 7) * 8;
    uint4 k0, k1, v0, v1;
#define WA_KEY0(T) ((T) < 4 ? (T) * 64 : 256 + (nb - 1) * 128 + ((T) - 4 + lfirst) * 64)
#define WA_LOAD(KEY0) { k0 = *(const uint4*)(kg + (size_t)(KEY0) * 64); k1 = *(const uint4*)(kg + (size_t)((KEY0) + 32) * 64); v0 = *(const uint4*)(vg + (KEY0)); v1 = *(const uint4*)(vg + (size_t)32 * 2304 + (KEY0)); }
#define WA_STORE(BUF) { char* kb_ = (BUF) + (tid >> 3) * FA_KROW + (tid & 7) * 16; *(uint4*)kb_ = k0; *(uint4*)(kb_ + 32 * FA_KROW) = k1; \
                        char* vb_ = (BUF) + 9216 + (tid >> 3) * FA_VROW + (tid & 7) * 16; \
                        *(uint2*)vb_ = make_uint2(v0.x, v0.y); *(uint2*)(vb_ + 8) = make_uint2(v0.z, v0.w); \
                        *(uint2*)(vb_ + 32 * FA_VROW) = make_uint2(v1.x, v1.y); *(uint2*)(vb_ + 32 * FA_VROW + 8) = make_uint2(v1.z, v1.w); }
    f32x16 o[2];
#pragma unroll
    for (int db = 0; db < 2; ++db)
#pragma unroll
        for (int i = 0; i < 16; ++i) o[db][i] = 0.f;
    float m = p.od_sink[j * 16 + hq] * 1.4426950408889634f, l = hh == 0 ? 1.f : 0.f;
    { const int key0 = WA_KEY0(0); WA_LOAD(key0) }
    __syncthreads();
    WA_STORE(smem)
    __syncthreads();
    for (int t = 0; t < ntile; ++t) {
        char* cur = smem + (t & 1) * WA_BUFB;
        char* nxt = smem + ((t + 1) & 1) * WA_BUFB;
        if (t + 1 < ntile) { const int key0 = WA_KEY0(t + 1); WA_LOAD(key0) }
        if (t < 4) flash_tile<2, false>(qf, o, m, l, cur, cur + 9216, lane, 0, 0);
        else flash_tile<2, true>(qf, o, m, l, cur, cur + 9216, lane, qi, WA_KEY0(t) - 256);
        if (t + 1 < ntile) WA_STORE(nxt)
        __syncthreads();
    }
#undef WA_LOAD
#undef WA_STORE
#undef WA_KEY0
    const float inv = 1.f / (l + __shfl_xor(l, 32));
    const int row = lat ? b * 2048 + qi : NL + b * 256 + qi;
    bf16_t* mrow = p.MIX + (size_t)row * DM + hq * 64;
#pragma unroll
    for (int db = 0; db < 2; ++db)
#pragma unroll
        for (int r4 = 0; r4 < 4; ++r4) {
            const int d = db * 32 + 8 * r4 + 4 * hh;
            *(uint2*)(mrow + d) = make_uint2(cvt_pk_bf16(o[db][r4 * 4 + 0] * inv, o[db][r4 * 4 + 1] * inv), cvt_pk_bf16(o[db][r4 * 4 + 2] * inv, o[db][r4 * 4 + 3] * inv));
        }
}

__device__ __forceinline__ int ml_row(int b, int tc, int i) { return tc < 4 ? NL + b * 256 + tc * 64 + i : b * 2048 + (tc - 4) * 64 + i; }
__device__ __forceinline__ void ml_gates(const P& p, int j, int b, int h, int dir, int tc, int lane, float* sa, float* sb, float* sml, float& Bt, float& Mc) {
    const int row = ml_row(b, tc, lane);
    const float ig = p.GT[(size_t)row * 16 + (dir * 2) * 4 + h] + p.ev_gate_b[j * 16 + (dir * 2) * 4 + h];
    const float lf = log_sigmoid_f(p.GT[(size_t)row * 16 + (dir * 2 + 1) * 4 + h] + p.ev_gate_b[j * 16 + (dir * 2 + 1) * 4 + h]);
    float bc = lf;
    if (dir == 0) {
#pragma unroll
        for (int o = 1; o < 64; o <<= 1) { const float t2 = __shfl_up(bc, o); if (lane >= o) bc += t2; }
    } else {
#pragma unroll
        for (int o = 1; o < 64; o <<= 1) { const float t2 = __shfl_down(bc, o); if (lane + o < 64) bc += t2; }
    }
    const float a = ig - bc;
    float ml = a;
    if (dir == 0) {
#pragma unroll
        for (int o = 1; o < 64; o <<= 1) { const float t2 = __shfl_up(ml, o); if (lane >= o) ml = fmaxf(ml, t2); }
    } else {
#pragma unroll
        for (int o = 1; o < 64; o <<= 1) { const float t2 = __shfl_down(ml, o); if (lane + o < 64) ml = fmaxf(ml, t2); }
    }
    sa[lane] = a; sb[lane] = bc; sml[lane] = ml;
    const int last = dir == 0 ? 63 : 0;
    Bt = __shfl(bc, last); Mc = __shfl(ml, last);
}
__device__ __forceinline__ int ml_tc_of(int dir, int c) { return dir == 0 ? c : (c < 4 ? 3 - c : 39 - c); }
__device__ __forceinline__ int ml_c_of(int dir, int tc) { return dir == 0 ? tc : (tc < 4 ? 3 - tc : 39 - tc); }

__device__ void ml_pass1_item(const P& p, int item, int j, char* smem) {
    const int c = item % 36, dir = (item / 36) & 1, h = (item / 72) & 3, b = item / 288;
    const int tc = ml_tc_of(dir, c);
    const int tid = otid(), lane = tid & 63, wid = tid >> 6, jl = lane & 31, hh = lane >> 5;
    bf16_t* VT = (bf16_t*)smem;
    bf16_t* KWT = (bf16_t*)(smem + 18432);
    float* sa = (float*)(smem + 27648);
    float* sb = sa + 64; float* sml = sb + 64; float* sw = sml + 64; float* ssc = sw + 64;
    __syncthreads();
    if (wid == 0) {
        float Bt, Mc; ml_gates(p, j, b, h, dir, tc, lane, sa, sb, sml, Bt, Mc);
        sw[lane] = expf(sa[lane] - Mc);
        if (lane == 0) { p.CHB[item] = Bt; p.CHM[item] = Mc; }
    }
    __syncthreads();
#pragma unroll
    for (int i = 0; i < 4; ++i) {
        const int e = tid + 256 * i, st = e >> 4, ch = e & 15;
        const uint4 u = *(const uint4*)(p.PB + (size_t)ml_row(b, tc, st) * 1536 + 512 + h * 128 + ch * 8);
        bf16_t* d = VT + (ch * 8) * 72 + st;
        d[0] = (bf16_t)u.x; d[72] = (bf16_t)(u.x >> 16); d[144] = (bf16_t)u.y; d[216] = (bf16_t)(u.y >> 16);
        d[288] = (bf16_t)u.z; d[360] = (bf16_t)(u.z >> 16); d[432] = (bf16_t)u.w; d[504] = (bf16_t)(u.w >> 16);
    }
#pragma unroll
    for (int i = 0; i < 2; ++i) {
        const int e = tid + 256 * i, st = e >> 3, ch = e & 7;
        const uint4 u = *(const uint4*)(p.QKB + (size_t)ml_row(b, tc, st) * 512 + 256 + h * 64 + ch * 8);
        const float w = sw[st];
        bf16_t* d = KWT + (ch * 8) * 72 + st;
        const unsigned q0 = cvt_pk_bf16(bf_lo(u.x) * w, bf_hi(u.x) * w), q1 = cvt_pk_bf16(bf_lo(u.y) * w, bf_hi(u.y) * w), q2 = cvt_pk_bf16(bf_lo(u.z) * w, bf_hi(u.z) * w), q3 = cvt_pk_bf16(bf_lo(u.w) * w, bf_hi(u.w) * w);
        d[0] = (bf16_t)q0; d[72] = (bf16_t)(q0 >> 16); d[144] = (bf16_t)q1; d[216] = (bf16_t)(q1 >> 16);
        d[288] = (bf16_t)q2; d[360] = (bf16_t)(q2 >> 16); d[432] = (bf16_t)q3; d[504] = (bf16_t)(q3 >> 16);
    }
    __syncthreads();
    {
        const int db = wid & 1, vb0 = (wid >> 1) * 2;
        bf16x8 kf[4];
#pragma unroll
        for (int ks = 0; ks < 4; ++ks) kf[ks] = *(const bf16x8*)((const char*)KWT + (db * 32 + jl) * 144 + (2 * ks + hh) * 16);
        float* cl = p.CLOC + (size_t)item * 8192;
#pragma unroll
        for (int vv = 0; vv < 2; ++vv) {
            const int vb = vb0 + vv;
            f32x16 acc;
#pragma unroll
            for (int r = 0; r < 16; ++r) acc[r] = 0.f;
#pragma unroll
            for (int ks = 0; ks < 4; ++ks) {
                const bf16x8 vf = *(const bf16x8*)((const char*)VT + (vb * 32 + jl) * 144 + (2 * ks + hh) * 16);
                acc = __builtin_amdgcn_mfma_f32_32x32x16_bf16(vf, kf[ks], acc, 0, 0, 0);
            }
#pragma unroll
            for (int r = 0; r < 16; ++r) cl[(size_t)(vb * 32 + (r & 3) + 8 * (r >> 2) + 4 * hh) * 64 + db * 32 + jl] = acc[r];
        }
        if (tid < 64) {
            float sum = 0.f;
#pragma unroll
            for (int q = 0; q < 8; ++q) { const uint4 u = *(const uint4*)((const char*)KWT + tid * 144 + q * 16); sum += bf_lo(u.x) + bf_hi(u.x) + bf_lo(u.y) + bf_hi(u.y) + bf_lo(u.z) + bf_hi(u.z) + bf_lo(u.w) + bf_hi(u.w); }
            p.NLOC[(size_t)item * 64 + tid] = sum;
        }
    }
}

__device__ void ph_ml_pass2(const P& p) {
    const int gt = blockIdx.x * 256 + otid(), nthr = gridDim.x * 256;
    for (int w = gt; w < 64 * 2048; w += nthr) {
        const int chain = w >> 11, e = (w & 2047) * 4;
        float c0 = 0.f, c1 = 0.f, c2 = 0.f, c3 = 0.f, m = 0.f;
        for (int c = 0; c < 36; ++c) {
            const int it = chain * 36 + c;
            *(uint2*)(p.CST + (size_t)it * 8192 + e) = make_uint2(cvt_pk_bf16(c0, c1), cvt_pk_bf16(c2, c3));
            const float Bt = p.CHB[it], Mc = p.CHM[it];
            const float g = fmaxf(m, Mc), al = expf(m - g), be = expf(Mc - g);
            const float4 cl = *(const float4*)(p.CLOC + (size_t)it * 8192 + e);
            c0 = al * c0 + be * cl.x; c1 = al * c1 + be * cl.y; c2 = al * c2 + be * cl.z; c3 = al * c3 + be * cl.w;
            m = Bt + g;
        }
    }
    for (int w = gt; w < 64 * 64; w += nthr) {
        const int chain = w >> 6, d = w & 63;
        float n = 0.f, m = 0.f;
        for (int c = 0; c < 36; ++c) {
            const int it = chain * 36 + c;
            p.NST[(size_t)it * 64 + d] = n;
            if (d == 0) p.MST[it] = m;
            const float Bt = p.CHB[it], Mc = p.CHM[it];
            const float g = fmaxf(m, Mc);
            n = expf(m - g) * n + expf(Mc - g) * p.NLOC[(size_t)it * 64 + d];
            m = Bt + g;
        }
    }
}

__device__ void ml_pass3_item(const P& p, int item, int j, char* smem) {
    const int tc = item % 36, h = (item / 36) & 3, b = item / 144;
    const int tid = otid(), lane = tid & 63, wid = tid >> 6, jl = lane & 31, hh = lane >> 5, tb = wid & 1, dir = wid >> 1;
    char* Ql = smem;
    char* Kl = smem + 9216;
    bf16_t* VT = (bf16_t*)(smem + 18432);
    float* gs = (float*)(smem + 35840);
    float* ssc = gs + 512;
    __syncthreads();
    if (wid < 2) {
        const int d2 = wid; float Bt, Mc;
        float* sa = gs + d2 * 256; float* sb = sa + 64; float* sg = sb + 64; float* sn = sg + 64;
        ml_gates(p, j, b, h, d2, tc, lane, sa, sb, sg, Bt, Mc);
        const int sidx = ((b * 4 + h) * 2 + d2) * 36 + ml_c_of(d2, tc);
        const float mst = p.MST[sidx];
        sg[lane] = fmaxf(mst, sg[lane]);
        sn[lane] = p.NST[(size_t)sidx * 64 + lane];
        if (lane == 0) ssc[d2] = mst;
    }
#pragma unroll
    for (int i = 0; i < 2; ++i) {
        const int e = tid + 256 * i, st = e >> 3, ch = e & 7; const int row = ml_row(b, tc, st);
        *(uint4*)(Ql + st * 144 + ch * 16) = *(const uint4*)(p.QKB + (size_t)row * 512 + h * 64 + ch * 8);
        *(uint4*)(Kl + st * 144 + ch * 16) = *(const uint4*)(p.QKB + (size_t)row * 512 + 256 + h * 64 + ch * 8);
    }
#pragma unroll
    for (int i = 0; i < 4; ++i) {
        const int e = tid + 256 * i, st = e >> 4, ch = e & 15;
        const uint4 u = *(const uint4*)(p.PB + (size_t)ml_row(b, tc, st) * 1536 + 512 + h * 128 + ch * 8);
        bf16_t* d = VT + (ch * 8) * 68 + st;
        d[0] = (bf16_t)u.x; d[68] = (bf16_t)(u.x >> 16); d[136] = (bf16_t)u.y; d[204] = (bf16_t)(u.y >> 16);
        d[272] = (bf16_t)u.z; d[340] = (bf16_t)(u.z >> 16); d[408] = (bf16_t)u.w; d[476] = (bf16_t)(u.w >> 16);
    }
    __syncthreads();
    const float* sa = gs + dir * 256; const float* sb = sa + 64; const float* sg = sb + 64; const float* sn = sg + 64;
    const int t = tb * 32 + jl;
    const float gtv = sg[t], btv = sb[t], mst = ssc[dir];
    const float e2 = expf(mst - gtv);
    const int sidx = ((b * 4 + h) * 2 + dir) * 36 + ml_c_of(dir, tc);
    bf16x8 qf[4];
#pragma unroll
    for (int ks = 0; ks < 4; ++ks) qf[ks] = *(const bf16x8*)(Ql + t * 144 + (2 * ks + hh) * 16);
    f32x16 acc[4];
    {
        const bf16_t* cst = p.CST + (size_t)sidx * 8192 + (size_t)jl * 64 + hh * 8;
#pragma unroll
        for (int vb = 0; vb < 4; ++vb) {
#pragma unroll
            for (int r = 0; r < 16; ++r) acc[vb][r] = 0.f;
#pragma unroll
            for (int ks = 0; ks < 4; ++ks) {
                const bf16x8 cf = *(const bf16x8*)(cst + (size_t)vb * 32 * 64 + ks * 16);
                acc[vb] = __builtin_amdgcn_mfma_f32_32x32x16_bf16(cf, qf[ks], acc[vb], 0, 0, 0);
            }
            acc[vb] = acc[vb] * e2;
        }
    }
    float den = 0.f;
    {
        float nq = 0.f;
#pragma unroll
        for (int ks = 0; ks < 4; ++ks) {
            const u32x4 u = __builtin_bit_cast(u32x4, qf[ks]);
            const float* np = sn + 16 * ks + 8 * hh;
            nq += bf_lo(u[0]) * np[0] + bf_hi(u[0]) * np[1] + bf_lo(u[1]) * np[2] + bf_hi(u[1]) * np[3] + bf_lo(u[2]) * np[4] + bf_hi(u[2]) * np[5] + bf_lo(u[3]) * np[6] + bf_hi(u[3]) * np[7];
        }
        den = e2 * nq;
    }
#pragma unroll
    for (int sbk = 0; sbk < 2; ++sbk) {
        const bool use = dir == 0 ? (sbk <= tb) : (sbk >= tb);
        if (use) {
            f32x16 sc;
#pragma unroll
            for (int r = 0; r < 16; ++r) sc[r] = 0.f;
#pragma unroll
            for (int ks = 0; ks < 4; ++ks) {
                const bf16x8 kf = *(const bf16x8*)(Kl + (sbk * 32 + jl) * 144 + (2 * ks + hh) * 16);
                sc = __builtin_amdgcn_mfma_f32_32x32x16_bf16(kf, qf[ks], sc, 0, 0, 0);
            }
#pragma unroll
            for (int r4 = 0; r4 < 4; ++r4) {
                const int s0 = sbk * 32 + 8 * r4 + 4 * hh;
                const f32x4 av = *(const f32x4*)(sa + s0);
#pragma unroll
                for (int q = 0; q < 4; ++q) {
                    const int s2 = s0 + q;
                    const bool ok = dir == 0 ? (s2 <= t) : (s2 >= t);
                    const float pv = ok ? sc[r4 * 4 + q] * expf(av[q] - gtv) : 0.f;
                    sc[r4 * 4 + q] = pv; den += pv;
                }
            }
            bf16x8 pb[2];
            pb[0] = pack8(sc[0], sc[1], sc[2], sc[3], sc[4], sc[5], sc[6], sc[7]);
            pb[1] = pack8(sc[8], sc[9], sc[10], sc[11], sc[12], sc[13], sc[14], sc[15]);
#pragma unroll
            for (int vb = 0; vb < 4; ++vb)
#pragma unroll
                for (int k2 = 0; k2 < 2; ++k2) {
                    const char* vp = (const char*)VT + (vb * 32 + jl) * 136 + (sbk * 32 + k2 * 16 + 4 * hh) * 2;
                    const uint2 lo = *(const uint2*)vp, hi = *(const uint2*)(vp + 16);
                    const u32x4 u = (u32x4){lo.x, lo.y, hi.x, hi.y};
                    acc[vb] = __builtin_amdgcn_mfma_f32_32x32x16_bf16(__builtin_bit_cast(bf16x8, u), pb[k2], acc[vb], 0, 0, 0);
                }
        }
    }
    den += __shfl_xor(den, 32);
    const float scl = 1.f / fmaxf(fabsf(den), expf(-(btv + gtv)));
#pragma unroll
    for (int vb = 0; vb < 4; ++vb) acc[vb] = acc[vb] * scl;
    __syncthreads();
    float* X = (float*)smem + tb * 4096;
    if (dir == 1) {
#pragma unroll
        for (int vb = 0; vb < 4; ++vb)
#pragma unroll
            for (int r = 0; r < 16; ++r) X[(vb * 32 + (r & 3) + 8 * (r >> 2) + 4 * hh) * 32 + jl] = acc[vb][r];
    }
    __syncthreads();
    if (dir == 0) {
        float ss = 0.f;
#pragma unroll
        for (int vb = 0; vb < 4; ++vb)
#pragma unroll
            for (int r = 0; r < 16; ++r) { const float v = acc[vb][r] + X[(vb * 32 + (r & 3) + 8 * (r >> 2) + 4 * hh) * 32 + jl]; acc[vb][r] = v; ss += v * v; }
        ss += __shfl_xor(ss, 32);
        const float rstd = rsqrtf(ss * (1.f / 128.f) + 1e-6f);
        const int row = ml_row(b, tc, t);
        const float* g = p.ev_ml_g + (size_t)j * 512 + h * 128;
        const bf16_t* og = p.PB + (size_t)row * 1536 + 1024 + h * 128;
        bf16_t* mrow = p.MIX + (size_t)row * DM + h * 128;
#pragma unroll
        for (int vb = 0; vb < 4; ++vb)
#pragma unroll
            for (int r4 = 0; r4 < 4; ++r4) {
                const int v = vb * 32 + 8 * r4 + 4 * hh;
                const f32x4 gg = *(const f32x4*)(g + v);
                const uint2 ou = *(const uint2*)(og + v);
                *(uint2*)(mrow + v) = make_uint2(cvt_pk_bf16(acc[vb][r4 * 4 + 0] * rstd * gg[0] * sigmoid_f(bf_lo(ou.x)), acc[vb][r4 * 4 + 1] * rstd * gg[1] * sigmoid_f(bf_hi(ou.x))),
                                                 cvt_pk_bf16(acc[vb][r4 * 4 + 2] * rstd * gg[2] * sigmoid_f(bf_lo(ou.y)), acc[vb][r4 * 4 + 3] * rstd * gg[3] * sigmoid_f(bf_hi(ou.y))));
            }
    }
}

__device__ void ph_attn_even(const P& p, int ci, int L, int j, float* smem) {
    int* s_item = (int*)((char*)smem + 73728);
    for (;;) {
        __syncthreads();
        if (otid() == 0) *s_item = atomicAdd(&p.ctr[ci], 1);
        __syncthreads();
        const int item = *s_item;
        if (item >= 1152 + 2304) break;
        if (item < 1152) da_block(p, item, L, j, (char*)smem); else ml_pass1_item(p, item - 1152, j, (char*)smem);
    }
}
__device__ void ph_ml_pass3(const P& p, int j, float* smem) {
    for (int item = blockIdx.x; item < 1152; item += gridDim.x) ml_pass3_item(p, item, j, (char*)smem);
}
__device__ void ph_attn_odd(const P& p, int j, bool need_ctx, float* smem) {
    const int nitem = need_ctx ? 2304 : 2048;
    for (int item = blockIdx.x; item < nitem; item += gridDim.x) { wa_block(p, item, j, (char*)smem); __syncthreads(); }
}

__device__ __forceinline__ float wave_max(float v) {
#pragma unroll
    for (int o = 32; o > 0; o >>= 1) v = fmaxf(v, __shfl_xor(v, o));
    return v;
}
#define SEL_LD 132
__device__ __forceinline__ unsigned fkey(float f) { const unsigned u = __float_as_uint(f); return (u & 0x80000000u) ? ~u : (u | 0x80000000u); }
__device__ __forceinline__ unsigned mbcnt64(unsigned long long m) { return __builtin_amdgcn_mbcnt_hi((unsigned)(m >> 32), __builtin_amdgcn_mbcnt_lo((unsigned)m, 0u)); }
__device__ void ph_peer_select(const P& p, int L, int nrows, char* smem) {
    float* S = (float*)smem;
    const int tid = otid(), lane = tid & 63, wid = tid >> 6, fr = lane & 15, fq = lane >> 4;
    const bf16_t* KBL = p.KB + (size_t)L * 8 * 2 * 128 * 128;
    const int ntile = nrows / 32;
    for (int item = blockIdx.x; item < ntile * 8; item += gridDim.x) {
        const int h = item & 7, t0 = (item >> 3) * 32;
        __syncthreads();
        {
            const int pp = wid >> 1, th = wid & 1;
            const bf16_t* qp = p.QB + (size_t)(t0 + th * 16 + fr) * 2048 + h * 256 + pp * 128 + fq * 8;
            bf16x8 qf[4];
#pragma unroll
            for (int ks = 0; ks < 4; ++ks) qf[ks] = *(const bf16x8*)(qp + ks * 32);
            const bf16_t* kp = KBL + ((size_t)(h * 2 + pp) * 128 + fr) * 128 + fq * 8;
#pragma unroll
            for (int ni = 0; ni < 8; ++ni) {
                f32x4 acc = (f32x4){0.f, 0.f, 0.f, 0.f};
#pragma unroll
                for (int ks = 0; ks < 4; ++ks) {
                    const bf16x8 kf = *(const bf16x8*)(kp + (size_t)ni * 16 * 128 + ks * 32);
                    acc = __builtin_amdgcn_mfma_f32_16x16x32_bf16(qf[ks], kf, acc, 0, 0, 0);
                }
#pragma unroll
                for (int j = 0; j < 4; ++j) S[(pp * 32 + th * 16 + fq * 4 + j) * SEL_LD + ni * 16 + fr] = acc[j];
            }
        }
        __syncthreads();
        for (int tt = 0; tt < 8; ++tt) {
            const int t = wid * 8 + tt, r = t0 + t;
            const float v00 = S[t * SEL_LD + lane], v01 = S[t * SEL_LD + 64 + lane], v10 = S[(32 + t) * SEL_LD + lane], v11 = S[(32 + t) * SEL_LD + 64 + lane];
            const unsigned ka0 = fkey(v00), ka1 = fkey(v01), kb0 = fkey(v10), kb1 = fkey(v11);
            unsigned T0 = 0u, T1 = 0u;
#pragma unroll 8
            for (int bit = 31; bit >= 0; --bit) {
                const unsigned c0 = T0 | (1u << bit), c1 = T1 | (1u << bit);
                const int n0 = __builtin_popcountll(__ballot(ka0 >= c0)) + __builtin_popcountll(__ballot(ka1 >= c0));
                const int n1 = __builtin_popcountll(__ballot(kb0 >= c1)) + __builtin_popcountll(__ballot(kb1 >= c1));
                if (n0 >= 16) T0 = c0;
                if (n1 >= 16) T1 = c1;
            }
            float* wsA = (float*)(smem + 34816 + wid * 512);
            {
                const unsigned long long g0 = __ballot(ka0 > T0), g1 = __ballot(ka1 > T0), e0 = __ballot(ka0 == T0), e1 = __ballot(ka1 == T0);
                const int need = 16 - __builtin_popcountll(g0) - __builtin_popcountll(g1);
                const int pe0 = __builtin_popcountll(e0), need1 = need - (pe0 < need ? pe0 : need);
                const bool s0 = (ka0 > T0) || (ka0 == T0 && (int)mbcnt64(e0) < need);
                const bool s1 = (ka1 > T0) || (ka1 == T0 && (int)mbcnt64(e1) < need1);
                const unsigned long long m0 = __ballot(s0), m1 = __ballot(s1);
                if (s0) { const int pos = mbcnt64(m0); wsA[pos] = v00; ((int*)wsA)[16 + pos] = lane; }
                if (s1) { const int pos = __builtin_popcountll(m0) + mbcnt64(m1); wsA[pos] = v01; ((int*)wsA)[16 + pos] = 64 + lane; }
            }
            {
                const unsigned long long g0 = __ballot(kb0 > T1), g1 = __ballot(kb1 > T1), e0 = __ballot(kb0 == T1), e1 = __ballot(kb1 == T1);
                const int need = 16 - __builtin_popcountll(g0) - __builtin_popcountll(g1);
                const int pe0 = __builtin_popcountll(e0), need1 = need - (pe0 < need ? pe0 : need);
                const bool s0 = (kb0 > T1) || (kb0 == T1 && (int)mbcnt64(e0) < need);
                const bool s1 = (kb1 > T1) || (kb1 == T1 && (int)mbcnt64(e1) < need1);
                const unsigned long long m0 = __ballot(s0), m1 = __ballot(s1);
                if (s0) { const int pos = mbcnt64(m0); wsA[32 + pos] = v10; ((int*)wsA)[48 + pos] = lane; }
                if (s1) { const int pos = __builtin_popcountll(m0) + mbcnt64(m1); wsA[32 + pos] = v11; ((int*)wsA)[48 + pos] = 64 + lane; }
            }
            __builtin_amdgcn_wave_barrier();
            float cand[4]; int cidx[4]; unsigned kc[4];
            {
                const float av = wsA[lane >> 2]; const int ai = ((int*)wsA)[16 + (lane >> 2)];
                const float4 bv = *(const float4*)(wsA + 32 + (lane & 3) * 4); const int4 bi = *(const int4*)((int*)wsA + 48 + (lane & 3) * 4);
                cand[0] = av + bv.x; cand[1] = av + bv.y; cand[2] = av + bv.z; cand[3] = av + bv.w;
                cidx[0] = ai * 128 + bi.x; cidx[1] = ai * 128 + bi.y; cidx[2] = ai * 128 + bi.z; cidx[3] = ai * 128 + bi.w;
#pragma unroll
                for (int c = 0; c < 4; ++c) kc[c] = fkey(cand[c]);
            }
            unsigned T = 0u;
#pragma unroll 8
            for (int bit = 31; bit >= 0; --bit) {
                const unsigned cc = T | (1u << bit);
                const int n = __builtin_popcountll(__ballot(kc[0] >= cc)) + __builtin_popcountll(__ballot(kc[1] >= cc)) + __builtin_popcountll(__ballot(kc[2] >= cc)) + __builtin_popcountll(__ballot(kc[3] >= cc));
                if (n >= 16) T = cc;
            }
            {
                int need = 16, base = 0;
#pragma unroll
                for (int c = 0; c < 4; ++c) need -= __builtin_popcountll(__ballot(kc[c] > T));
#pragma unroll
                for (int c = 0; c < 4; ++c) {
                    const unsigned long long e = __ballot(kc[c] == T);
                    const bool sel = (kc[c] > T) || (kc[c] == T && (int)mbcnt64(e) < need);
                    const int pe = __builtin_popcountll(e); need -= (pe < need ? pe : need);
                    const unsigned long long m = __ballot(sel);
                    if (sel) { const int pos = base + mbcnt64(m); wsA[64 + pos] = cand[c]; ((int*)wsA)[80 + pos] = cidx[c]; }
                    base += __builtin_popcountll(m);
                }
            }
            __builtin_amdgcn_wave_barrier();
            if (lane < 16) {
                const float cv = wsA[64 + lane];
                float mx = wsA[64];
#pragma unroll
                for (int q = 1; q < 16; ++q) mx = fmaxf(mx, wsA[64 + q]);
                float sum = 0.f;
#pragma unroll
                for (int q = 0; q < 16; ++q) sum += expf(wsA[64 + q] - mx);
                p.GATE[(size_t)r * 128 + h * 16 + lane] = expf(cv - mx) / sum;
                p.EIDX[(size_t)r * 128 + h * 16 + lane] = ((int*)wsA)[80 + lane];
            }
            __builtin_amdgcn_wave_barrier();
        }
    }
}


__device__ __forceinline__ void unpack8(const uint4 u, float* f) {
    f[0] = bf_lo(u.x); f[1] = bf_hi(u.x); f[2] = bf_lo(u.y); f[3] = bf_hi(u.y); f[4] = bf_lo(u.z); f[5] = bf_hi(u.z); f[6] = bf_lo(u.w); f[7] = bf_hi(u.w);
}
__device__ __forceinline__ void unpack16_u8(const uint4 u, float* f) {
    f[0] = (float)(u.x & 0xffu); f[1] = (float)((u.x >> 8) & 0xffu); f[2] = (float)((u.x >> 16) & 0xffu); f[3] = (float)((u.x >> 24) & 0xffu);
    f[4] = (float)(u.y & 0xffu); f[5] = (float)((u.y >> 8) & 0xffu); f[6] = (float)((u.y >> 16) & 0xffu); f[7] = (float)((u.y >> 24) & 0xffu);
    f[8] = (float)(u.z & 0xffu); f[9] = (float)((u.z >> 8) & 0xffu); f[10] = (float)((u.z >> 16) & 0xffu); f[11] = (float)((u.z >> 24) & 0xffu);
    f[12] = (float)(u.w & 0xffu); f[13] = (float)((u.w >> 8) & 0xffu); f[14] = (float)((u.w >> 16) & 0xffu); f[15] = (float)((u.w >> 24) & 0xffu);
}
__device__ void ph_peer_gather(const P& p, int L, int nrows, float oscale) {
    const int lane = otid() & 63, wid = otid() >> 6;
    const unsigned char* U = p.U8 + (size_t)L * 16384 * 1024; const unsigned char* V = p.V8 + (size_t)L * 16384 * 1024;
    const float* USC = p.USC + (size_t)L * 16384; const float* VSC = p.VSC + (size_t)L * 16384;
    const float* gate2 = p.modv + (size_t)L * 9 * 6144 + 5120;
    for (int r = blockIdx.x * 4 + wid; r < nrows; r += gridDim.x * 4) {
        const int e0 = p.EIDX[(size_t)r * 128 + lane], e1 = p.EIDX[(size_t)r * 128 + 64 + lane];
        const float g0 = p.GATE[(size_t)r * 128 + lane], g1 = p.GATE[(size_t)r * 128 + 64 + lane];
        const float us0 = USC[e0], us1 = USC[e1], vs0 = VSC[e0], vs1 = VSC[e1];
        float x[16];
        { const uint4 xa = *(const uint4*)(p.XN + (size_t)r * DM + lane * 16), xb = *(const uint4*)(p.XN + (size_t)r * DM + lane * 16 + 8); unpack8(xa, x); unpack8(xb, x + 8); }
        float sx = 0.f;
#pragma unroll
        for (int c = 0; c < 16; ++c) sx += x[c];
        sx = wave_sum(sx);
        float a0 = 0.f, a1 = 0.f;
#pragma unroll
        for (int half = 0; half < 2; ++half) {
            const int ev = half ? e1 : e0;
            float av = 0.f;
            for (int kb = 0; kb < 4; ++kb) {
                uint4 ua[16];
#pragma unroll
                for (int j = 0; j < 16; ++j) {
                    const int idx = __builtin_amdgcn_readlane(ev, kb * 16 + j);
                    ua[j] = *(const uint4*)(U + (size_t)idx * 1024 + lane * 16);
                }
#pragma unroll
                for (int j = 0; j < 16; ++j) {
                    float f[16]; unpack16_u8(ua[j], f);
                    float s = 0.f;
#pragma unroll
                    for (int c = 0; c < 16; ++c) s += x[c] * f[c];
                    s = wave_sum(s);
                    if (lane == kb * 16 + j) av = s;
                }
            }
            if (half) a1 = av; else a0 = av;
        }
        a0 = us0 * (a0 - 128.f * sx); a1 = us1 * (a1 - 128.f * sx);
        const float w0 = vs0 * g0 * 0.5f * a0 * (1.f + erff(a0 * 0.70710678118654752f));
        const float w1 = vs1 * g1 * 0.5f * a1 * (1.f + erff(a1 * 0.70710678118654752f));
        const float wsum = wave_sum(w0 + w1);
        float acc[16];
#pragma unroll
        for (int c = 0; c < 16; ++c) acc[c] = 0.f;
#pragma unroll
        for (int half = 0; half < 2; ++half) {
            const int ev = half ? e1 : e0; const int wv = __float_as_int(half ? w1 : w0);
            for (int kb = 0; kb < 4; ++kb) {
                uint4 ua[16];
#pragma unroll
                for (int j = 0; j < 16; ++j) {
                    const int idx = __builtin_amdgcn_readlane(ev, kb * 16 + j);
                    ua[j] = *(const uint4*)(V + (size_t)idx * 1024 + lane * 16);
                }
#pragma unroll
                for (int j = 0; j < 16; ++j) {
                    const float wj = __int_as_float(__builtin_amdgcn_readlane(wv, kb * 16 + j));
                    float f[16]; unpack16_u8(ua[j], f);
#pragma unroll
                    for (int c = 0; c < 16; ++c) acc[c] += wj * f[c];
                }
            }
        }
        const float* gp = gate2 + (size_t)modrow(r) * 6144 + lane * 16;
        float* hp = p.H + (size_t)r * DM + lane * 16;
#pragma unroll
        for (int q = 0; q < 4; ++q) {
            const float4 g = *(const float4*)(gp + q * 4);
            float4 hv = *(float4*)(hp + q * 4);
            hv.x += oscale * g.x * (acc[q * 4 + 0] - 128.f * wsum); hv.y += oscale * g.y * (acc[q * 4 + 1] - 128.f * wsum);
            hv.z += oscale * g.z * (acc[q * 4 + 2] - 128.f * wsum); hv.w += oscale * g.w * (acc[q * 4 + 3] - 128.f * wsum);
            *(float4*)(hp + q * 4) = hv;
        }
    }
}

#define NSUB 11
__device__ __forceinline__ bool phase_empty(int ph) {
    if (ph == 0 || ph == NPH - 1) return false;
    const int L = (ph - 1) / NSUB, s = (ph - 1) % NSUB;
    return (L & 1) && (s == 2 || s == 4 || s == 5);
}
__device__ void run_phase(const P& p, int ph, float* smem, int rep) {
    if (ph == 0) { ph_prologue(p, smem); return; }
    if (ph == NPH - 1) { ph_final(p); return; }
    const int L = (ph - 1) / NSUB, s = (ph - 1) % NSUB, j = L >> 1;
    const bool even = (L & 1) == 0, need_ctx = L < 3;
    const int nrows = need_ctx ? NT : NL;
    const float* mv = p.modv + (size_t)L * 9 * 6144;
    switch (s) {
    case 0: ph_normmod(p.H, p.norm1_g + L * DM, mv, 0, 1024, p.XN, NT); break;
    case 1:
        if (even) ph_gemm(p.XN, p.WT + WT_EVIN(j), NT, 3200, EpiEven{p.PB, p.AQL, p.AQC, p.AK, p.AV, p.GT, p.rope}, (char*)smem);
        else ph_gemm(p.XN, p.WT + WT_ODIN(j), NT, ODW, EpiOdd{p.AQL, p.AQC, p.AK, p.AV, p.rope}, (char*)smem);
        break;
    case 2: if (even) ph_prep_even(p, j); break;
    case 3: if (even) ph_attn_even(p, L + 4 * rep, L, j, smem); else ph_attn_odd(p, j, need_ctx, smem); break;
    case 4: if (even) ph_ml_pass2(p); break;
    case 5: if (even) ph_ml_pass3(p, j, smem); break;
    case 6: ph_gemm(p.MIX, p.WT + (even ? WT_EVOUT(j) : WT_ODOUT(j)), nrows, DM, EpiResid{p.H, mv + 2048, rep ? 0.f : 1.f}, (char*)smem); break;
    case 7: ph_normmod(p.H, p.norm2_g + L * DM, mv, 3072, 4096, p.XN, nrows); break;
    case 8: ph_gemm(p.XN, p.WT + WT_PQ(L), nrows, 2048, EpiStoreBF16{p.QB, 2048}, (char*)smem); break;
    case 9: ph_peer_select(p, L, nrows, (char*)smem); break;
    case 10: ph_peer_gather(p, L, nrows, rep ? 0.f : 1.f); break;
    }
}

#define XB_TMO      128
#define XB_XCNT(j)  (256  + 64 * (j))
#define XB_XSUB(j)  (1280 + 64 * (j))
#define XB_XGEN(j)  (2304 + 64 * (j))
#define XB_TOP      3328
#define XB_TOPGEN   3392
#define XCD_BAR_WORDS 3456
#define XB_SPIN_CAP (1u << 20)
#define LAS __attribute__((address_space(3)))
__device__ __forceinline__ unsigned xb_ld(unsigned* p)              { return __hip_atomic_load(p, __ATOMIC_RELAXED, __HIP_MEMORY_SCOPE_AGENT); }
__device__ __forceinline__ unsigned xb_add(unsigned* p, unsigned v) { return __hip_atomic_fetch_add(p, v, __ATOMIC_RELAXED, __HIP_MEMORY_SCOPE_AGENT); }
__device__ __forceinline__ unsigned xb_xcc_id() { return (unsigned)__builtin_amdgcn_s_getreg((3 << 11) | 20) & 0xFu; }
#define XB_SPIN(cond, bar) do { unsigned _sp = 0; while (cond) { __builtin_amdgcn_s_sleep(1); \
    if ((++_sp & 255u) == 0u) { if (xb_ld(&(bar)[XB_TMO])) break; if (_sp > XB_SPIN_CAP) { atomicAdd(&(bar)[XB_TMO], 1u); break; } } } } while (0)
struct XcdBarrier { unsigned* bar; unsigned x; volatile LAS unsigned* st; };
__device__ __forceinline__ XcdBarrier xcd_barrier_post(unsigned* bar, volatile LAS unsigned* st) {
    XcdBarrier b; b.bar = bar; b.x = xb_xcc_id(); b.st = st;
    if (threadIdx.x == 0) (void)xb_add(&bar[XB_XCNT(b.x)], 1u);
    return b;
}
__device__ __forceinline__ void xcd_barrier_complete(unsigned* bar, unsigned x, unsigned& nloc, unsigned& nx) {
    const unsigned G = gridDim.x * gridDim.y * gridDim.z;
    unsigned sum, cnt, mine, sp = 0u;
    for (;;) {
        sum = 0u; cnt = 0u; mine = 0u;
#pragma unroll
        for (unsigned j = 0; j < 16; ++j) { const unsigned c = xb_ld(&bar[XB_XCNT(j)]); sum += c; cnt += (c > 0u) ? 1u : 0u; mine = (j == x) ? c : mine; }
        if (sum == G) break;
        __builtin_amdgcn_s_sleep(1);
        if ((++sp & 255u) == 0u) { if (xb_ld(&bar[XB_TMO])) break; if (sp > XB_SPIN_CAP) { atomicAdd(&bar[XB_TMO], 1u); break; } }
    }
    nloc = mine > 0u ? mine : 1u; nx = cnt > 0u ? cnt : 1u;
}
__device__ __forceinline__ void xcd_barrier(const XcdBarrier& b) {
    asm volatile("s_waitcnt vmcnt(0)" ::: "memory");
    __syncthreads();
    if (threadIdx.x == 0) {
        unsigned* bar = b.bar;
        __builtin_amdgcn_s_waitcnt(0);
        unsigned nloc = b.st[0], nx = b.st[1];
        if (nloc == 0u) { xcd_barrier_complete(bar, b.x, nloc, nx); b.st[0] = nloc; b.st[1] = nx; }
        const unsigned old = xb_add(&bar[XB_XSUB(b.x)], 1u);
        const unsigned gen = old / nloc;
        if (old + 1u == (gen + 1u) * nloc) {
            __builtin_amdgcn_fence(__ATOMIC_RELEASE, "agent");
            asm volatile("s_waitcnt vmcnt(0)" ::: "memory");
            const unsigned og = xb_add(&bar[XB_TOP], 1u);
            const unsigned tg = og / nx;
            if (og + 1u == (tg + 1u) * nx) xb_add(&bar[XB_TOPGEN], 1u);
            else XB_SPIN(xb_ld(&bar[XB_TOPGEN]) == tg, bar);
            __builtin_amdgcn_fence(__ATOMIC_ACQUIRE, "agent");
            xb_add(&bar[XB_XGEN(b.x)], 1u);
            asm volatile("s_waitcnt vmcnt(0)" ::: "memory");
        } else {
            XB_SPIN(xb_ld(&bar[XB_XGEN(b.x)]) == gen, bar);
            __builtin_amdgcn_fence(__ATOMIC_ACQUIRE, "agent");
            asm volatile("s_waitcnt vmcnt(0)" ::: "memory");
        }
    }
    __syncthreads();
}

__global__ void __launch_bounds__(256, 2) mega(P p) {
    extern __shared__ __attribute__((aligned(16))) float smem[];
    cg::grid_group grid = cg::this_grid();
    volatile LAS unsigned* st = (volatile LAS unsigned*)((char*)smem + 73744);
    if (threadIdx.x < 4) st[threadIdx.x] = 0u;
    __syncthreads();
    XcdBarrier xb = xcd_barrier_post(p.bar, st);
    for (int ph = p.ph_lo; ph < p.ph_hi; ++ph) {
        if (phase_empty(ph)) continue;
        run_phase(p, ph, smem, 0);
        if (PROBE_N > 1 && ph > 0 && ph < NPH - 1 && (ph - 1) % NSUB == PROBE_S)
            for (int rep = 1; rep < PROBE_N; ++rep) { xcd_barrier(xb); run_phase(p, ph, smem, rep); }
        if (ph + 1 < p.ph_hi) { if (ph == 0) grid.sync(); else xcd_barrier(xb); }
    }
}

extern "C" void kernel_launch(void* const* d_in, const int* in_sizes, int n_in, void* d_out, int out_size, void* d_ws, size_t ws_size, hipStream_t stream) {
    static int grid_blocks = 0;
    if (!grid_blocks) {
        int dev = 0, cus = 0, per_cu = 0;
        hipGetDevice(&dev);
        hipDeviceGetAttribute(&cus, hipDeviceAttributeMultiprocessorCount, dev);
        hipFuncSetAttribute((const void*)mega, hipFuncAttributeMaxDynamicSharedMemorySize, LDS_BYTES);
        hipOccupancyMaxActiveBlocksPerMultiprocessor(&per_cu, mega, 256, LDS_BYTES);
        if (per_cu < 1) per_cu = 1;
        if (per_cu > 2) per_cu = 2;
        grid_blocks = cus * per_cu;
    }
    P p{};
    const float** ins = (const float**)&p;
    for (int i = 0; i < 24; ++i) ins[i] = (const float*)d_in[i];
    p.out = (float*)d_out;
    size_t off = 0; char* ws = (char*)d_ws;
    auto carve = [&](size_t bytes) { void* r = ws + off; off += (bytes + 255) & ~(size_t)255; return r; };
    p.modv = (float*)carve((size_t)4 * 9 * 6144 * 4);
    p.rope = (float*)carve((size_t)2048 * 64 * 4);
    p.H = (float*)carve((size_t)NT * DM * 4);
    p.XN = (bf16_t*)carve((size_t)NT * DM * 2);
    p.WT = (bf16_t*)carve(WT_TOTAL * 2);
    p.MIX = (bf16_t*)carve((size_t)NT * DM * 2);
    p.PB = (bf16_t*)carve((size_t)NT * 1536 * 2);
    p.GT = (float*)carve((size_t)NT * 16 * 4);
    p.AQL = (bf16_t*)carve((size_t)8 * 16 * 2048 * 64 * 2);
    p.AQC = (bf16_t*)carve((size_t)8 * 16 * 256 * 64 * 2);
    p.AK = (bf16_t*)carve((size_t)8 * 4 * 2 * 2304 * 64 * 2);
    p.AV = (bf16_t*)carve((size_t)8 * 4 * 128 * 2304 * 2);
    p.QKB = (bf16_t*)carve((size_t)NT * 512 * 2);
    p.CLOC = (float*)carve((size_t)2304 * 8192 * 4);
    p.CST = (bf16_t*)carve((size_t)2304 * 8192 * 2);
    p.NLOC = (float*)carve((size_t)2304 * 64 * 4);
    p.NST = (float*)carve((size_t)2304 * 64 * 4);
    p.CHB = (float*)carve((size_t)2304 * 4);
    p.CHM = (float*)carve((size_t)2304 * 4);
    p.MST = (float*)carve((size_t)2304 * 4);
    p.QB = (bf16_t*)carve((size_t)NT * 2048 * 2);
    p.GATE = (float*)carve((size_t)NT * 128 * 4);
    p.EIDX = (int*)carve((size_t)NT * 128 * 4);
    p.ctr = (int*)carve(256);
    p.bar = (unsigned*)carve((size_t)XCD_BAR_WORDS * 4);
    p.U8 = (unsigned char*)carve((size_t)4 * 16384 * 1024);
    p.V8 = (unsigned char*)carve((size_t)4 * 16384 * 1024);
    p.USC = (float*)carve((size_t)4 * 16384 * 4);
    p.VSC = (float*)carve((size_t)4 * 16384 * 4);
    p.KB = (bf16_t*)carve((size_t)4 * 8 * 2 * 128 * 128 * 2);
    if (off > ws_size) { fprintf(stderr, "kernel_launch: workspace too small: need %zu have %zu\n", off, ws_size); return; }
    hipMemsetAsync(p.bar, 0, (size_t)XCD_BAR_WORDS * 4, stream);
#if ONE_LAUNCH
    p.ph_lo = 0; p.ph_hi = NPH;
    void* args[] = {&p};
    hipError_t e = hipLaunchCooperativeKernel((void*)mega, dim3(grid_blocks), dim3(256), args, LDS_BYTES, stream);
    if (e != hipSuccess) fprintf(stderr, "cooperative launch failed: %s (grid %d)\n", hipGetErrorString(e), grid_blocks);
#else
    for (int ph = 0; ph < NPH; ++ph) {
        if (ph > 0 && ph < NPH - 1) { const int L = (ph - 1) / NSUB, s = (ph - 1) % NSUB; if ((s == 2 || s == 4 || s == 5) && (L & 1)) continue; }
        p.ph_lo = ph; p.ph_hi = ph + 1;
        hipLaunchKernelGGL(mega, dim3(grid_blocks), dim3(256), LDS_BYTES, stream, p);
    }
#endif
}
```

```cpp
#include <hip/hip_runtime.h>
#include <hip/hip_cooperative_groups.h>
#include <cstdio>
#include <cstdint>
namespace cg = cooperative_groups;

#ifndef ONE_LAUNCH
#define ONE_LAUNCH 1
#endif

#define NT 18432
#define NL 16384
#define DM 1024
#define EVW 3088
#define ODW 1536
#define C_QK 0
#define C_V 512
#define C_O 1024
#define C_G 1536
#define C_DQ 1552
#define C_DK 2064
#define C_DV 2576
#define NPH 46
#ifndef PROBE_S
#define PROBE_S -1
#endif
#ifndef PROBE_N
#define PROBE_N 1
#endif

typedef unsigned short bf16_t;
typedef short bf16x8 __attribute__((ext_vector_type(8)));
typedef float f32x4 __attribute__((ext_vector_type(4)));
#define LDS_BYTES 73792

typedef float f32x16 __attribute__((ext_vector_type(16)));
typedef unsigned u32x4 __attribute__((ext_vector_type(4)));
struct P {
    const float *x, *c, *ctx, *c_ctx, *mod_w, *mod_b, *norm1_g, *norm2_g, *ev_w_in, *ev_conv_w, *ev_conv_b, *ev_gate_b,
        *ev_ml_g, *ev_da_lam, *ev_da_g, *ev_w_out, *od_w_in, *od_sink, *od_w_out, *pr_w_q, *pr_keys, *pr_u, *pr_v, *final_g;
    float* out;
    float *modv, *H, *GATE, *rope, *GT, *CLOC, *NLOC, *NST, *CHB, *CHM, *MST;
    int *EIDX, *ctr;
    unsigned* bar;
    bf16_t *XN, *MIX, *WT, *KB, *QB, *PB, *AQL, *AQC, *AK, *AV, *QKB, *CST;
    unsigned char *U8, *V8;
    float *USC, *VSC;
    int ph_lo, ph_hi;
};
#define QSCALE 0.18033688011112042f

__device__ __forceinline__ int otid() { int t = threadIdx.x; asm volatile("" : "+v"(t)); return t; }
__device__ __forceinline__ int modrow(int r) { return r < NL ? (r >> 11) : 8; }
__device__ __forceinline__ float silu_f(float x) { return x / (1.f + expf(-x)); }
__device__ __forceinline__ float sigmoid_f(float x) { return 1.f / (1.f + expf(-x)); }
__device__ __forceinline__ float log_sigmoid_f(float x) { return fminf(x, 0.f) - log1pf(expf(-fabsf(x))); }
typedef __bf16 bf16v2_t __attribute__((ext_vector_type(2)));
typedef float f32x2_t __attribute__((ext_vector_type(2)));
__device__ __forceinline__ unsigned cvt_pk_bf16(float lo, float hi) { const bf16v2_t v = __builtin_convertvector((f32x2_t){lo, hi}, bf16v2_t); return __builtin_bit_cast(unsigned, v); }
__device__ __forceinline__ float bf_lo(unsigned u) { return __uint_as_float(u << 16); }
__device__ __forceinline__ float bf_hi(unsigned u) { return __uint_as_float(u & 0xffff0000u); }
#define WT_EVIN(j) ((size_t)(j) * 3200 * 1024)
#define WT_EVOUT(j) ((size_t)2 * 3200 * 1024 + (size_t)(j) * 1024 * 1024)
#define WT_ODIN(j) ((size_t)2 * 3200 * 1024 + (size_t)2 * 1024 * 1024 + (size_t)(j) * 1536 * 1024)
#define WT_ODOUT(j) ((size_t)2 * 3200 * 1024 + (size_t)2 * 1024 * 1024 + (size_t)2 * 1536 * 1024 + (size_t)(j) * 1024 * 1024)
#define WT_PQ(L) ((size_t)2 * 3200 * 1024 + (size_t)4 * 1024 * 1024 + (size_t)2 * 1536 * 1024 + (size_t)(L) * 2048 * 1024)
#define WT_TOTAL ((size_t)2 * 3200 * 1024 + (size_t)4 * 1024 * 1024 + (size_t)2 * 1536 * 1024 + (size_t)4 * 2048 * 1024)
__device__ __forceinline__ float wave_sum(float v) {
#pragma unroll
    for (int o = 32; o > 0; o >>= 1) v += __shfl_xor(v, o);
    return v;
}

__device__ void cvt_copy_bf16(const float* src, bf16_t* dst, size_t n);
__device__ void quant_rows_i8(const float* src, unsigned char* dst, float* scl, int nrows);
__device__ void ph_prologue(const P& p, float* smem) {
    const int tid = otid(), nb = gridDim.x, bid = blockIdx.x;
    if (bid == 0 && tid < 64) p.ctr[tid] = 0;
    {
        const float4* xs = (const float4*)p.x; const float4* cs = (const float4*)p.ctx; float4* hd = (float4*)p.H;
        const size_t nx = (size_t)NL * DM / 4, nc = (size_t)(NT - NL) * DM / 4;
        for (size_t i = (size_t)bid * 256 + tid; i < nx + nc; i += (size_t)nb * 256) hd[i] = i < nx ? xs[i] : cs[i - nx];
    }
    for (int i = bid * 256 + tid; i < 2048 * 32; i += nb * 256) {
        const int s = i >> 5, d = i & 31;
        const float pos = (d < 16) ? (float)(s >> 6) : (float)(s & 63);
        const float inv = powf(10000.0f, -(float)(d & 15) / 16.0f);
        const float ang = pos * inv;
        p.rope[2 * i] = cosf(ang); p.rope[2 * i + 1] = sinf(ang);
    }
    float* sc = smem;
    float* red = smem + 9 * 1024;
    for (int i = tid; i < 9 * 1024; i += 256) { const int r = i >> 10, k = i & 1023; const float v = r < 8 ? p.c[r * 1024 + k] : p.c_ctx[k]; sc[i] = silu_f(v); }
    __syncthreads();
    for (int item = bid; item < 4 * 96; item += nb) {
        const int L = item / 96, n0 = (item % 96) * 64, tx = tid & 63, kq = tid >> 6;
        float acc[9];
#pragma unroll
        for (int r = 0; r < 9; ++r) acc[r] = 0.f;
        const float* w = p.mod_w + (size_t)L * 1024 * 6144 + n0 + tx;
        for (int k = kq * 256; k < kq * 256 + 256; ++k) {
            const float wv = w[(size_t)k * 6144];
#pragma unroll
            for (int r = 0; r < 9; ++r) acc[r] += sc[r * 1024 + k] * wv;
        }
#pragma unroll
        for (int r = 0; r < 9; ++r) red[(kq * 9 + r) * 64 + tx] = acc[r];
        __syncthreads();
        if (kq == 0) {
#pragma unroll
            for (int r = 0; r < 9; ++r) {
                const float s = red[(0 * 9 + r) * 64 + tx] + red[(1 * 9 + r) * 64 + tx] + red[(2 * 9 + r) * 64 + tx] + red[(3 * 9 + r) * 64 + tx];
                p.modv[((size_t)L * 9 + r) * 6144 + n0 + tx] = s + p.mod_b[L * 6144 + n0 + tx];
            }
        }
        __syncthreads();
    }
    {
        float (*tile)[65] = (float (*)[65])smem;
        for (int item = bid; item < 5440; item += nb) {
            int it = item, mat = 0, N = 0, Npad = 0; const float* src = nullptr; bf16_t* dst = nullptr;
            for (mat = 0; mat < 12; ++mat) {
                if (mat < 2) { N = EVW; Npad = 3200; src = p.ev_w_in + (size_t)mat * DM * EVW; dst = p.WT + WT_EVIN(mat); }
                else if (mat < 4) { N = 1024; Npad = 1024; src = p.ev_w_out + (size_t)(mat - 2) * DM * DM; dst = p.WT + WT_EVOUT(mat - 2); }
                else if (mat < 6) { N = ODW; Npad = ODW; src = p.od_w_in + (size_t)(mat - 4) * DM * ODW; dst = p.WT + WT_ODIN(mat - 4); }
                else if (mat < 8) { N = 1024; Npad = 1024; src = p.od_w_out + (size_t)(mat - 6) * DM * DM; dst = p.WT + WT_ODOUT(mat - 6); }
                else { N = 2048; Npad = 2048; src = p.pr_w_q + (size_t)(mat - 8) * DM * 2048; dst = p.WT + WT_PQ(mat - 8); }
                const int nt = 16 * (Npad / 64);
                if (it < nt) break;
                it -= nt;
            }
            const int k0 = (it & 15) * 64, n0 = (it >> 4) * 64;
            __syncthreads();
#pragma unroll
            for (int rep = 0; rep < 4; ++rep) {
                const int i = (tid >> 4) + 16 * rep, c4 = (tid & 15) * 4;
                float4 v = make_float4(0.f, 0.f, 0.f, 0.f);
                int sc = n0 + c4;
                if (mat < 2) sc = sc < 1536 ? sc : (sc < 3072 ? sc + 16 : (sc < 3088 ? sc - 3072 + 1536 : N));
                if (sc < N) v = *(const float4*)(src + (size_t)(k0 + i) * N + sc);
                tile[i][c4] = v.x; tile[i][c4 + 1] = v.y; tile[i][c4 + 2] = v.z; tile[i][c4 + 3] = v.w;
            }
            __syncthreads();
            {
                const int n = tid >> 2, kq = (tid & 3) * 16;
                unsigned w[8];
#pragma unroll
                for (int e = 0; e < 8; ++e) w[e] = cvt_pk_bf16(tile[kq + 2 * e][n], tile[kq + 2 * e + 1][n]);
                uint4* dp = (uint4*)(dst + (size_t)(n0 + n) * DM + k0 + kq);
                dp[0] = make_uint4(w[0], w[1], w[2], w[3]); dp[1] = make_uint4(w[4], w[5], w[6], w[7]);
            }
        }
    }
    quant_rows_i8(p.pr_u, p.U8, p.USC, 4 * 16384);
    quant_rows_i8(p.pr_v, p.V8, p.VSC, 4 * 16384);
    cvt_copy_bf16(p.pr_keys, p.KB, (size_t)4 * 8 * 2 * 128 * 128);
}

__device__ void cvt_copy_bf16(const float* src, bf16_t* dst, size_t n) {
    const size_t n8 = n / 8;
    for (size_t i = (size_t)blockIdx.x * 256 + otid(); i < n8; i += (size_t)gridDim.x * 256) {
        const float4 a = ((const float4*)src)[2 * i], b = ((const float4*)src)[2 * i + 1];
        ((uint4*)dst)[i] = make_uint4(cvt_pk_bf16(a.x, a.y), cvt_pk_bf16(a.z, a.w), cvt_pk_bf16(b.x, b.y), cvt_pk_bf16(b.z, b.w));
    }
}

__device__ void quant_rows_i8(const float* src, unsigned char* dst, float* scl, int nrows) {
    const int lane = otid() & 63, wid = otid() >> 6;
    for (int r = blockIdx.x * 4 + wid; r < nrows; r += gridDim.x * 4) {
        const float4* sp = (const float4*)(src + (size_t)r * 1024 + lane * 16);
        float4 v[4]; float mx = 0.f;
#pragma unroll
        for (int i = 0; i < 4; ++i) { v[i] = sp[i]; mx = fmaxf(mx, fmaxf(fmaxf(fabsf(v[i].x), fabsf(v[i].y)), fmaxf(fabsf(v[i].z), fabsf(v[i].w)))); }
#pragma unroll
        for (int o = 32; o > 0; o >>= 1) mx = fmaxf(mx, __shfl_xor(mx, o));
        const float inv = mx > 0.f ? 127.f / mx : 0.f;
        unsigned w[4];
#pragma unroll
        for (int i = 0; i < 4; ++i) {
            const unsigned b0 = (unsigned)((int)rintf(v[i].x * inv) + 128), b1 = (unsigned)((int)rintf(v[i].y * inv) + 128), b2 = (unsigned)((int)rintf(v[i].z * inv) + 128), b3 = (unsigned)((int)rintf(v[i].w * inv) + 128);
            w[i] = b0 | (b1 << 8) | (b2 << 16) | (b3 << 24);
        }
        *(uint4*)(dst + (size_t)r * 1024 + lane * 16) = make_uint4(w[0], w[1], w[2], w[3]);
        if (lane == 0) scl[r] = mx * (1.f / 127.f);
    }
}

__device__ void ph_normmod(const float* src, const float* g, const float* modv_layer, int shift_off, int scale_off, bf16_t* dst, int nrows) {
    const int lane = otid() & 63, wid = otid() >> 6;
    for (int r = blockIdx.x * 4 + wid; r < nrows; r += gridDim.x * 4) {
        const float4* s4 = (const float4*)(src + (size_t)r * DM);
        float4 v[4]; float ss = 0.f;
#pragma unroll
        for (int i = 0; i < 4; ++i) { v[i] = s4[i * 64 + lane]; ss += v[i].x * v[i].x + v[i].y * v[i].y + v[i].z * v[i].z + v[i].w * v[i].w; }
        ss = wave_sum(ss);
        const float rstd = rsqrtf(ss * (1.0f / DM) + 1e-6f);
        const float* mv = modv_layer + (size_t)modrow(r) * 6144;
        uint2* d2 = (uint2*)(dst + (size_t)r * DM);
#pragma unroll
        for (int i = 0; i < 4; ++i) {
            const int c = (i * 64 + lane) * 4;
            const float4 gg = *(const float4*)(g + c), sh = *(const float4*)(mv + shift_off + c), scl = *(const float4*)(mv + scale_off + c);
            float4 o;
            o.x = v[i].x * rstd * gg.x * (1.f + scl.x) + sh.x; o.y = v[i].y * rstd * gg.y * (1.f + scl.y) + sh.y;
            o.z = v[i].z * rstd * gg.z * (1.f + scl.z) + sh.z; o.w = v[i].w * rstd * gg.w * (1.f + scl.w) + sh.w;
            d2[i * 64 + lane] = make_uint2(cvt_pk_bf16(o.x, o.y), cvt_pk_bf16(o.z, o.w));
        }
    }
}

__device__ void ph_final(const P& p) {
    const int lane = otid() & 63, wid = otid() >> 6;
    for (int r = blockIdx.x * 4 + wid; r < NL; r += gridDim.x * 4) {
        const float4* s4 = (const float4*)(p.H + (size_t)r * DM);
        float4 v[4]; float ss = 0.f;
#pragma unroll
        for (int i = 0; i < 4; ++i) { v[i] = s4[i * 64 + lane]; ss += v[i].x * v[i].x + v[i].y * v[i].y + v[i].z * v[i].z + v[i].w * v[i].w; }
        ss = wave_sum(ss);
        const float rstd = rsqrtf(ss * (1.0f / DM) + 1e-6f);
        float4* d4 = (float4*)(p.out + (size_t)r * DM);
#pragma unroll
        for (int i = 0; i < 4; ++i) {
            const int c = (i * 64 + lane) * 4; const float4 gg = *(const float4*)(p.final_g + c);
            float4 o; o.x = v[i].x * rstd * gg.x; o.y = v[i].y * rstd * gg.y; o.z = v[i].z * rstd * gg.z; o.w = v[i].w * rstd * gg.w;
            d4[i * 64 + lane] = o;
        }
    }
}

#define GL_ROWB 144
#define GL_TILEB (128 * GL_ROWB)
struct TokPos { int b, pos, kpos; bool lat; };
__device__ __forceinline__ TokPos tokpos(int row) {
    TokPos t; t.lat = row < NL;
    if (t.lat) { t.b = row >> 11; t.pos = row & 2047; t.kpos = 256 + t.pos; } else { const int r = row - NL; t.b = r >> 8; t.pos = r & 255; t.kpos = t.pos; }
    return t;
}
struct EpiStoreBF16 {
    bf16_t* C; int ldc;
    __device__ __forceinline__ bool swapped(int) const { return false; }
    __device__ __forceinline__ void operator()(const f32x4 (&acc)[4][4], int m0, int n0, int wm, int wn, int fr, int fq) const {
#pragma unroll
        for (int mi = 0; mi < 4; ++mi)
#pragma unroll
            for (int ni = 0; ni < 4; ++ni) {
                const f32x4 v = acc[ni][mi];
                *(uint2*)(C + (size_t)(m0 + wm * 64 + mi * 16 + fr) * ldc + n0 + wn * 64 + ni * 16 + fq * 4) = make_uint2(cvt_pk_bf16(v[0], v[1]), cvt_pk_bf16(v[2], v[3]));
            }
    }
};
struct EpiResid {
    float* H; const float* gate; float scale;
    __device__ __forceinline__ bool swapped(int) const { return false; }
    __device__ __forceinline__ void operator()(const f32x4 (&acc)[4][4], int m0, int n0, int wm, int wn, int fr, int fq) const {
#pragma unroll
        for (int mi = 0; mi < 4; ++mi) {
            const int row = m0 + wm * 64 + mi * 16 + fr;
            const float* gp = gate + (size_t)modrow(row) * 6144;
#pragma unroll
            for (int ni = 0; ni < 4; ++ni) {
                const int col = n0 + wn * 64 + ni * 16 + fq * 4;
                const f32x4 g = *(const f32x4*)(gp + col);
                f32x4* hp = (f32x4*)(H + (size_t)row * DM + col);
                *hp = *hp + g * acc[ni][mi] * scale;
            }
        }
    }
};
__device__ __forceinline__ void rope_store64(const f32x4 (&acc)[4][4], int mi, bool do_rope, const float* ropep  , float scale, bf16_t* dst  , int fq) {
#pragma unroll
    for (int ni = 0; ni < 2; ++ni) {
        f32x4 x1 = acc[ni][mi], x2 = acc[ni + 2][mi];
        if (do_rope) {
            const f32x4 r0 = *(const f32x4*)(ropep + (ni * 16 + fq * 4) * 2), r1 = *(const f32x4*)(ropep + (ni * 16 + fq * 4) * 2 + 4);
            const f32x4 cs = (f32x4){r0[0], r0[2], r1[0], r1[2]}, sn = (f32x4){r0[1], r0[3], r1[1], r1[3]};
            const f32x4 y1 = x1 * cs - x2 * sn, y2 = x1 * sn + x2 * cs;
            x1 = y1; x2 = y2;
        }
        x1 = x1 * scale; x2 = x2 * scale;
        *(uint2*)(dst + ni * 16 + fq * 4) = make_uint2(cvt_pk_bf16(x1[0], x1[1]), cvt_pk_bf16(x1[2], x1[3]));
        *(uint2*)(dst + 32 + ni * 16 + fq * 4) = make_uint2(cvt_pk_bf16(x2[0], x2[1]), cvt_pk_bf16(x2[2], x2[3]));
    }
}
struct EpiEven {
    bf16_t *PB, *AQL, *AQC, *AK, *AV; float* GT; const float* rope;
    __device__ __forceinline__ bool swapped(int n0) const { return n0 >= 2560 && n0 < 3072; }
    __device__ __forceinline__ void operator()(const f32x4 (&acc)[4][4], int m0, int n0, int wm, int wn, int fr, int fq) const {
        const int t = n0 >> 7;
        if (t < 12) {
#pragma unroll
            for (int mi = 0; mi < 4; ++mi)
#pragma unroll
                for (int ni = 0; ni < 4; ++ni) {
                    const f32x4 v = acc[ni][mi];
                    *(uint2*)(PB + (size_t)(m0 + wm * 64 + mi * 16 + fr) * 1536 + n0 + wn * 64 + ni * 16 + fq * 4) = make_uint2(cvt_pk_bf16(v[0], v[1]), cvt_pk_bf16(v[2], v[3]));
                }
        } else if (t < 20) {
            const bool isq = t < 16; const int h = t & 3;
#pragma unroll
            for (int mi = 0; mi < 4; ++mi) {
                const TokPos tp = tokpos(m0 + wm * 64 + mi * 16 + fr);
                const int hm = (tp.b * 4 + h) * 2 + wn;
                bf16_t* dst;
                if (isq) dst = tp.lat ? AQL + ((size_t)hm * 2048 + tp.pos) * 64 : AQC + ((size_t)hm * 256 + tp.pos) * 64;
                else dst = AK + ((size_t)hm * 2304 + tp.kpos) * 64;
                rope_store64(acc, mi, tp.lat, rope + (size_t)tp.pos * 64, isq ? QSCALE : 1.0f, dst, fq);
            }
        } else if (t < 24) {
            const int h = t - 20;
#pragma unroll
            for (int mi = 0; mi < 4; ++mi) {
                const TokPos tp = tokpos(m0 + wm * 64 + mi * 16 + fq * 4);
#pragma unroll
                for (int ni = 0; ni < 4; ++ni) {
                    const f32x4 v = acc[ni][mi];
                    const int d = wn * 64 + ni * 16 + fr;
                    *(uint2*)(AV + ((size_t)(tp.b * 4 + h) * 128 + d) * 2304 + tp.kpos) = make_uint2(cvt_pk_bf16(v[0], v[1]), cvt_pk_bf16(v[2], v[3]));
                }
            }
        } else {
            if (wn == 0) {
#pragma unroll
                for (int mi = 0; mi < 4; ++mi) *(f32x4*)(GT + (size_t)(m0 + wm * 64 + mi * 16 + fr) * 16 + fq * 4) = acc[0][mi];
            }
        }
    }
};
struct EpiOdd {
    bf16_t *AQL, *AQC, *AK, *AV; const float* rope;
    __device__ __forceinline__ bool swapped(int n0) const { return n0 >= 1280; }
    __device__ __forceinline__ void operator()(const f32x4 (&acc)[4][4], int m0, int n0, int wm, int wn, int fr, int fq) const {
        const int t = n0 >> 7;
        if (t < 10) {
            const bool isq = t < 8; const int hd = isq ? t * 2 + wn : (t - 8) * 2 + wn;
#pragma unroll
            for (int mi = 0; mi < 4; ++mi) {
                const TokPos tp = tokpos(m0 + wm * 64 + mi * 16 + fr);
                bf16_t* dst;
                if (isq) dst = tp.lat ? AQL + ((size_t)(tp.b * 16 + hd) * 2048 + tp.pos) * 64 : AQC + ((size_t)(tp.b * 16 + hd) * 256 + tp.pos) * 64;
                else dst = AK + ((size_t)(tp.b * 4 + hd) * 2304 + tp.kpos) * 64;
                rope_store64(acc, mi, tp.lat, rope + (size_t)tp.pos * 64, isq ? QSCALE : 1.0f, dst, fq);
            }
        } else {
            const int hkv = (t - 10) * 2 + wn;
#pragma unroll
            for (int mi = 0; mi < 4; ++mi) {
                const TokPos tp = tokpos(m0 + wm * 64 + mi * 16 + fq * 4);
#pragma unroll
                for (int ni = 0; ni < 4; ++ni) {
                    const f32x4 v = acc[ni][mi];
                    const int d = ni * 16 + fr;
                    *(uint2*)(AV + ((size_t)(tp.b * 4 + hkv) * 64 + d) * 2304 + tp.kpos) = make_uint2(cvt_pk_bf16(v[0], v[1]), cvt_pk_bf16(v[2], v[3]));
                }
            }
        }
    }
};
template <bool SWAP>
__device__ __forceinline__ void gemm_tile_kloop(f32x4 (&acc)[4][4], const bf16_t* ap, const bf16_t* bp, char* smem, int lrow, int lch, int wm, int wn, int fr, int fq) {
    uint4 ra0, ra1, ra2, ra3, rb0, rb1, rb2, rb3;
#define GL_LOAD(KO) { ra0 = *(const uint4*)(ap + (KO)); ra1 = *(const uint4*)(ap + (size_t)32 * DM + (KO)); ra2 = *(const uint4*)(ap + (size_t)64 * DM + (KO)); ra3 = *(const uint4*)(ap + (size_t)96 * DM + (KO)); \
                      rb0 = *(const uint4*)(bp + (KO)); rb1 = *(const uint4*)(bp + (size_t)32 * DM + (KO)); rb2 = *(const uint4*)(bp + (size_t)64 * DM + (KO)); rb3 = *(const uint4*)(bp + (size_t)96 * DM + (KO)); }
#define GL_STORE(BUF) { char* sa_ = (BUF) + lrow * GL_ROWB + lch * 16; char* sb_ = sa_ + GL_TILEB; \
                        *(uint4*)(sa_) = ra0; *(uint4*)(sa_ + 32 * GL_ROWB) = ra1; *(uint4*)(sa_ + 64 * GL_ROWB) = ra2; *(uint4*)(sa_ + 96 * GL_ROWB) = ra3; \
                        *(uint4*)(sb_) = rb0; *(uint4*)(sb_ + 32 * GL_ROWB) = rb1; *(uint4*)(sb_ + 64 * GL_ROWB) = rb2; *(uint4*)(sb_ + 96 * GL_ROWB) = rb3; }
    GL_LOAD(0)
    __syncthreads();
    GL_STORE(smem)
    __syncthreads();
    for (int kt = 0; kt < 16; ++kt) {
        char* cur = smem + (kt & 1) * 2 * GL_TILEB;
        char* nxt = smem + ((kt + 1) & 1) * 2 * GL_TILEB;
        if (kt + 1 < 16) GL_LOAD((kt + 1) * 64)
#pragma unroll
        for (int ks = 0; ks < 2; ++ks) {
            bf16x8 af[4], wf[4];
#pragma unroll
            for (int i = 0; i < 4; ++i) {
                af[i] = *(const bf16x8*)(cur + (wm * 64 + i * 16 + fr) * GL_ROWB + (ks * 4 + fq) * 16);
                wf[i] = *(const bf16x8*)(cur + GL_TILEB + (wn * 64 + i * 16 + fr) * GL_ROWB + (ks * 4 + fq) * 16);
            }
#pragma unroll
            for (int ni = 0; ni < 4; ++ni)
#pragma unroll
                for (int mi = 0; mi < 4; ++mi)
                    acc[ni][mi] = SWAP ? __builtin_amdgcn_mfma_f32_16x16x32_bf16(af[mi], wf[ni], acc[ni][mi], 0, 0, 0)
                                       : __builtin_amdgcn_mfma_f32_16x16x32_bf16(wf[ni], af[mi], acc[ni][mi], 0, 0, 0);
        }
        if (kt + 1 < 16) GL_STORE(nxt)
        __syncthreads();
    }
#undef GL_LOAD
#undef GL_STORE
}
template <class Epi>
__device__ void ph_gemm(const bf16_t* A, const bf16_t* Bt, int M, int Npad, const Epi& epi, char* smem) {
    const int tid = otid(), lane = tid & 63, wid = tid >> 6, wm = wid >> 1, wn = wid & 1;
    const int fr = lane & 15, fq = lane >> 4;
    const int tm = M / 128, tn = Npad / 128, ntiles = tm * tn;
    const int lrow = tid >> 3, lch = tid & 7;
    for (int tile = blockIdx.x; tile < ntiles; tile += gridDim.x) {
        const int m0 = (tile % tm) * 128, n0 = (tile / tm) * 128;
        f32x4 acc[4][4];
#pragma unroll
        for (int a = 0; a < 4; ++a)
#pragma unroll
            for (int b = 0; b < 4; ++b) acc[a][b] = (f32x4){0.f, 0.f, 0.f, 0.f};
        const bf16_t* ap = A + (size_t)(m0 + lrow) * DM + lch * 8;
        const bf16_t* bp = Bt + (size_t)(n0 + lrow) * DM + lch * 8;
        if (epi.swapped(n0)) gemm_tile_kloop<true>(acc, ap, bp, smem, lrow, lch, wm, wn, fr, fq);
        else gemm_tile_kloop<false>(acc, ap, bp, smem, lrow, lch, wm, wn, fr, fq);
        epi(acc, m0, n0, wm, wn, fr, fq);
    }
}

__device__ void ph_prep_even(const P& p, int j) {
    const float* cw = p.ev_conv_w + (size_t)j * 3 * 512; const float* cb = p.ev_conv_b + (size_t)j * 512;
    const size_t tot = (size_t)NT * 256;
    for (size_t i = (size_t)blockIdx.x * 256 + otid(); i < tot; i += (size_t)gridDim.x * 256) {
        const int r = (int)(i >> 8), c = (int)(i & 255) * 2;
        int t, T; if (r < NL) { t = r & 2047; T = 2048; } else { t = (r - NL) & 255; T = 256; }
        const unsigned x1 = *(const unsigned*)(p.PB + (size_t)r * 1536 + c);
        float v0 = cb[c] + bf_lo(x1) * cw[512 + c], v1 = cb[c + 1] + bf_hi(x1) * cw[512 + c + 1];
        if (t > 0) { const unsigned x0 = *(const unsigned*)(p.PB + (size_t)(r - 1) * 1536 + c); v0 += bf_lo(x0) * cw[c]; v1 += bf_hi(x0) * cw[c + 1]; }
        if (t < T - 1) { const unsigned x2 = *(const unsigned*)(p.PB + (size_t)(r + 1) * 1536 + c); v0 += bf_lo(x2) * cw[1024 + c]; v1 += bf_hi(x2) * cw[1024 + c + 1]; }
        v0 = silu_f(v0); v1 = silu_f(v1);
        if (c >= 256) { v0 *= 0.125f; v1 *= 0.125f; }
        *(unsigned*)(p.QKB + (size_t)r * 512 + c) = cvt_pk_bf16(v0, v1);
    }
}

#define FA_KROW 144
#define FA_VROW 136
__device__ __forceinline__ bf16x8 pack8(float a0, float a1, float a2, float a3, float a4, float a5, float a6, float a7) {
    const u32x4 u = (u32x4){cvt_pk_bf16(a0, a1), cvt_pk_bf16(a2, a3), cvt_pk_bf16(a4, a5), cvt_pk_bf16(a6, a7)};
    return __builtin_bit_cast(bf16x8, u);
}
template <int NDB, bool MASK>
__device__ __forceinline__ void flash_tile(const bf16x8 (&qf)[4], f32x16 (&o)[NDB], float& m, float& l, const char* Kl, const char* Vl, int lane, int qpos, int kp0) {
    const int j = lane & 31, h = lane >> 5;
    f32x16 s0, s1;
#pragma unroll
    for (int i = 0; i < 16; ++i) { s0[i] = 0.f; s1[i] = 0.f; }
#pragma unroll
    for (int ks = 0; ks < 4; ++ks) {
        const bf16x8 a0 = *(const bf16x8*)(Kl + j * FA_KROW + (2 * ks + h) * 16);
        const bf16x8 a1 = *(const bf16x8*)(Kl + (32 + j) * FA_KROW + (2 * ks + h) * 16);
        s0 = __builtin_amdgcn_mfma_f32_32x32x16_bf16(a0, qf[ks], s0, 0, 0, 0);
        s1 = __builtin_amdgcn_mfma_f32_32x32x16_bf16(a1, qf[ks], s1, 0, 0, 0);
    }
    if (MASK) {
#pragma unroll
        for (int r = 0; r < 16; ++r) {
            const int key = (r & 3) + 8 * (r >> 2) + 4 * h;
            const int d0 = qpos - (kp0 + key), d1 = d0 - 32;
            if (d0 > 128 || d0 < -128) s0[r] = -1e30f;
            if (d1 > 128 || d1 < -128) s1[r] = -1e30f;
        }
    }
    float mx = fmaxf(s0[0], s1[0]);
#pragma unroll
    for (int r = 1; r < 16; ++r) mx = fmaxf(mx, fmaxf(s0[r], s1[r]));
    mx = fmaxf(mx, __shfl_xor(mx, 32));
    const float mn = fmaxf(m, mx);
    const float alpha = __builtin_amdgcn_exp2f(m - mn);
    m = mn;
    float ls = 0.f;
#pragma unroll
    for (int r = 0; r < 16; ++r) { s0[r] = __builtin_amdgcn_exp2f(s0[r] - mn); s1[r] = __builtin_amdgcn_exp2f(s1[r] - mn); ls += s0[r] + s1[r]; }
    l = l * alpha + ls;
#pragma unroll
    for (int db = 0; db < NDB; ++db) o[db] = o[db] * alpha;
    bf16x8 pb[4];
    pb[0] = pack8(s0[0], s0[1], s0[2], s0[3], s0[4], s0[5], s0[6], s0[7]);
    pb[1] = pack8(s0[8], s0[9], s0[10], s0[11], s0[12], s0[13], s0[14], s0[15]);
    pb[2] = pack8(s1[0], s1[1], s1[2], s1[3], s1[4], s1[5], s1[6], s1[7]);
    pb[3] = pack8(s1[8], s1[9], s1[10], s1[11], s1[12], s1[13], s1[14], s1[15]);
#pragma unroll
    for (int db = 0; db < NDB; ++db)
#pragma unroll
        for (int kk = 0; kk < 4; ++kk) {
            const char* vp = Vl + (db * 32 + j) * FA_VROW + (kk * 16 + 4 * h) * 2;
            const uint2 lo = *(const uint2*)vp, hi = *(const uint2*)(vp + 16);
            const u32x4 u = (u32x4){lo.x, lo.y, hi.x, hi.y};
            o[db] = __builtin_amdgcn_mfma_f32_32x32x16_bf16(__builtin_bit_cast(bf16x8, u), pb[kk], o[db], 0, 0, 0);
        }
}

#define DA_BUFB 35840
__device__ void da_block(const P& p, int item, int L, int j, char* smem) {
    const int tid = otid(), lane = tid & 63, wid = tid >> 6, mp = wid & 1, qg = wid >> 1, jq = lane & 31, hh = lane >> 5;
    const bool lat = item < 1024;
    int b, h, qt;
    if (lat) { b = item >> 7; h = (item >> 5) & 3; qt = item & 31; } else { const int it = item - 1024; b = it >> 4; h = (it >> 2) & 3; qt = it & 3; }
    const int qi = qt * 64 + qg * 32 + jq;
    const bf16_t* qp = lat ? p.AQL + ((size_t)((b * 4 + h) * 2 + mp) * 2048 + qi) * 64 : p.AQC + ((size_t)((b * 4 + h) * 2 + mp) * 256 + qi) * 64;
    bf16x8 qf[4];
#pragma unroll
    for (int ks = 0; ks < 4; ++ks) qf[ks] = *(const bf16x8*)(qp + (2 * ks + hh) * 8);
    const int ntile = lat ? 36 : 4;
    const bf16_t* kg = p.AK + (size_t)((b * 4 + h) * 2) * 2304 * 64 + (size_t)(tid >> 3) * 64 + (tid & 7) * 8;
    const bf16_t* vg = p.AV + (size_t)(b * 4 + h) * 128 * 2304 + (size_t)(tid >> 3) * 2304 + (tid & 7) * 8;
    uint4 k0, k1, k2, k3, v0, v1, v2, v3;
#define DA_LOAD(KEY0) { k0 = *(const uint4*)(kg + (size_t)(KEY0) * 64); k1 = *(const uint4*)(kg + (size_t)((KEY0) + 32) * 64); \
                        k2 = *(const uint4*)(kg + (size_t)2304 * 64 + (size_t)(KEY0) * 64); k3 = *(const uint4*)(kg + (size_t)2304 * 64 + (size_t)((KEY0) + 32) * 64); \
                        v0 = *(const uint4*)(vg + (KEY0)); v1 = *(const uint4*)(vg + (size_t)32 * 2304 + (KEY0)); v2 = *(const uint4*)(vg + (size_t)64 * 2304 + (KEY0)); v3 = *(const uint4*)(vg + (size_t)96 * 2304 + (KEY0)); }
#define DA_STORE(BUF) { char* kb_ = (BUF) + (tid >> 3) * FA_KROW + (tid & 7) * 16; \
                        *(uint4*)kb_ = k0; *(uint4*)(kb_ + 32 * FA_KROW) = k1; *(uint4*)(kb_ + 64 * FA_KROW) = k2; *(uint4*)(kb_ + 96 * FA_KROW) = k3; \
                        char* vb_ = (BUF) + 18432 + (tid >> 3) * FA_VROW + (tid & 7) * 16; \
                        *(uint2*)vb_ = make_uint2(v0.x, v0.y); *(uint2*)(vb_ + 8) = make_uint2(v0.z, v0.w); \
                        *(uint2*)(vb_ + 32 * FA_VROW) = make_uint2(v1.x, v1.y); *(uint2*)(vb_ + 32 * FA_VROW + 8) = make_uint2(v1.z, v1.w); \
                        *(uint2*)(vb_ + 64 * FA_VROW) = make_uint2(v2.x, v2.y); *(uint2*)(vb_ + 64 * FA_VROW + 8) = make_uint2(v2.z, v2.w); \
                        *(uint2*)(vb_ + 96 * FA_VROW) = make_uint2(v3.x, v3.y); *(uint2*)(vb_ + 96 * FA_VROW + 8) = make_uint2(v3.z, v3.w); }
    f32x16 o[4];
#pragma unroll
    for (int db = 0; db < 4; ++db)
#pragma unroll
        for (int i = 0; i < 16; ++i) o[db][i] = 0.f;
    float m = -1e30f, l = 0.f;
    DA_LOAD(0)
    __syncthreads();
    DA_STORE(smem)
    __syncthreads();
    for (int t = 0; t < ntile; ++t) {
        char* cur = smem + (t & 1) * DA_BUFB;
        char* nxt = smem + ((t + 1) & 1) * DA_BUFB;
        if (t + 1 < ntile) DA_LOAD((t + 1) * 64)
        flash_tile<4, false>(qf, o, m, l, cur + mp * 9216, cur + 18432, lane, 0, 0);
        if (t + 1 < ntile) DA_STORE(nxt)
        __syncthreads();
    }
#undef DA_LOAD
#undef DA_STORE
    const float inv = 1.f / (l + __shfl_xor(l, 32));
#pragma unroll
    for (int db = 0; db < 4; ++db) o[db] = o[db] * inv;
    float* X = (float*)smem + qg * 4096;
    if (mp == 1) {
#pragma unroll
        for (int db = 0; db < 4; ++db)
#pragma unroll
            for (int r = 0; r < 16; ++r) X[(db * 32 + (r & 3) + 8 * (r >> 2) + 4 * hh) * 32 + jq] = o[db][r];
    }
    __syncthreads();
    if (mp == 0) {
        const float lam_init = 0.8f - 0.6f * expf(-0.3f * (float)L);
        const float* lp = p.ev_da_lam + (size_t)j * 256;
        float a0 = lp[lane] * lp[64 + lane], a1 = lp[128 + lane] * lp[192 + lane];
        a0 = wave_sum(a0); a1 = wave_sum(a1);
        const float lam = expf(a0) - expf(a1) + lam_init;
        float ss = 0.f;
#pragma unroll
        for (int db = 0; db < 4; ++db)
#pragma unroll
            for (int r = 0; r < 16; ++r) { const float v = o[db][r] - lam * X[(db * 32 + (r & 3) + 8 * (r >> 2) + 4 * hh) * 32 + jq]; o[db][r] = v; ss += v * v; }
        ss += __shfl_xor(ss, 32);
        const float sc = rsqrtf(ss * (1.f / 128.f) + 1e-6f) * (1.f - lam_init);
        const int row = lat ? b * 2048 + qi : NL + b * 256 + qi;
        bf16_t* mrow = p.MIX + (size_t)row * DM + 512 + h * 128;
        const float* g = p.ev_da_g + (size_t)j * 512 + h * 128;
#pragma unroll
        for (int db = 0; db < 4; ++db)
#pragma unroll
            for (int r4 = 0; r4 < 4; ++r4) {
                const int d = db * 32 + 8 * r4 + 4 * hh;
                const f32x4 gg = *(const f32x4*)(g + d);
                *(uint2*)(mrow + d) = make_uint2(cvt_pk_bf16(o[db][r4 * 4 + 0] * sc * gg[0], o[db][r4 * 4 + 1] * sc * gg[1]), cvt_pk_bf16(o[db][r4 * 4 + 2] * sc * gg[2], o[db][r4 * 4 + 3] * sc * gg[3]));
            }
    }
    __syncthreads();
}

#define WA_BUFB 17920
__device__ void wa_block(const P& p, int item, int j, char* smem) {
    const int tid = otid(), lane = tid & 63, wid = tid >> 6, jq = lane & 31, hh = lane >> 5;
    const bool lat = item < 2048;
    int b, nb, hq;
    if (lat) { hq = item & 15; nb = (item >> 4) & 15; b = item >> 8; } else { const int it = item - 2048; hq = it & 15; nb = (it >> 4) & 1; b = it >> 5; }
    const int hkv = hq >> 2;
    const int qi = nb * 128 + wid * 32 + jq;
    const bf16_t* qp = lat ? p.AQL + ((size_t)(b * 16 + hq) * 2048 + qi) * 64 : p.AQC + ((size_t)(b * 16 + hq) * 256 + qi) * 64;
    bf16x8 qf[4];
#pragma unroll
    for (int ks = 0; ks < 4; ++ks) qf[ks] = *(const bf16x8*)(qp + (2 * ks + hh) * 8);
    const int lfirst = (nb == 0) ? 2 : 0, nloc = lat ? 6 - lfirst - ((nb == 15) ? 2 : 0) : 0;
    const int ntile = 4 + nloc;
    const bf16_t* kg = p.AK + (size_t)(b * 4 + hkv) * 2304 * 64 + (size_t)(tid >> 3) * 64 + (tid & 7) * 8;
    const bf16_t* vg = p.AV + (size_t)(b * 4 + hkv) * 64 * 2304 + (size_t)(tid >> 3) * 2304 + (tid & 7) * 8;
    uint4 k0, k1, v0, v1;
#define WA_KEY0(T) ((T) < 4 ? (T) * 64 : 256 + (nb - 1) * 128 + ((T) - 4 + lfirst) * 64)
#define WA_LOAD(KEY0) { k0 = *(const uint4*)(kg + (size_t)(KEY0) * 64); k1 = *(const uint4*)(kg + (size_t)((KEY0) + 32) * 64); v0 = *(const uint4*)(vg + (KEY0)); v1 = *(const uint4*)(vg + (size_t)32 * 2304 + (KEY0)); }
#define WA_STORE(BUF) { char* kb_ = (BUF) + (tid >> 3) * FA_KROW + (tid & 7) * 16; *(uint4*)kb_ = k0; *(uint4*)(kb_ + 32 * FA_KROW) = k1; \
                        char* vb_ = (BUF) + 9216 + (tid >> 3) * FA_VROW + (tid & 7) * 16; \
                        *(uint2*)vb_ = make_uint2(v0.x, v0.y); *(uint2*)(vb_ + 8) = make_uint2(v0.z, v0.w); \
                        *(uint2*)(vb_ + 32 * FA_VROW) = make_uint2(v1.x, v1.y); *(uint2*)(vb_ + 32 * FA_VROW + 8) = make_uint2(v1.z, v1.w); }
    f32x16 o[2];
#pragma unroll
    for (int db = 0; db < 2; ++db)
#pragma unroll
        for (int i = 0; i < 16; ++i) o[db][i] = 0.f;
    float m = p.od_sink[j * 16 + hq] * 1.4426950408889634f, l = hh == 0 ? 1.f : 0.f;
    { const int key0 = WA_KEY0(0); WA_LOAD(key0) }
    __syncthreads();
    WA_STORE(smem)
    __syncthreads();
    for (int t = 0; t < ntile; ++t) {
        char* cur = smem + (t & 1) * WA_BUFB;
        char* nxt = smem + ((t + 1) & 1) * WA_BUFB;
        if (t + 1 < ntile) { const int key0 = WA_KEY0(t + 1); WA_LOAD(key0) }
        if (t < 4) flash_tile<2, false>(qf, o, m, l, cur, cur + 9216, lane, 0, 0);
        else flash_tile<2, true>(qf, o, m, l, cur, cur + 9216, lane, qi, WA_KEY0(t) - 256);
        if (t + 1 < ntile) WA_STORE(nxt)
        __syncthreads();
    }
#undef WA_LOAD
#undef WA_STORE
#undef WA_KEY0
    const float inv = 1.f / (l + __shfl_xor(l, 32));
    const int row = lat ? b * 2048 + qi : NL + b * 256 + qi;
    bf16_t* mrow = p.MIX + (size_t)row * DM + hq * 64;
#pragma unroll
    for (int db = 0; db < 2; ++db)
#pragma unroll
        for (int r4 = 0; r4 < 4; ++r4) {
            const int d = db * 32 + 8 * r4 + 4 * hh;
            *(uint2*)(mrow + d) = make_uint2(cvt_pk_bf16(o[db][r4 * 4 + 0] * inv, o[db][r4 * 4 + 1] * inv), cvt_pk_bf16(o[db][r4 * 4 + 2] * inv, o[db][r4 * 4 + 3] * inv));
        }
}

__device__ __forceinline__ int ml_row(int b, int tc, int i) { return tc < 4 ? NL + b * 256 + tc * 64 + i : b * 2048 + (tc - 4) * 64 + i; }
__device__ __forceinline__ void ml_gates(const P& p, int j, int b, int h, int dir, int tc, int lane, float* sa, float* sb, float* sml, float& Bt, float& Mc) {
    const int row = ml_row(b, tc, lane);
    const float ig = p.GT[(size_t)row * 16 + (dir * 2) * 4 + h] + p.ev_gate_b[j * 16 + (dir * 2) * 4 + h];
    const float lf = log_sigmoid_f(p.GT[(size_t)row * 16 + (dir * 2 + 1) * 4 + h] + p.ev_gate_b[j * 16 + (dir * 2 + 1) * 4 + h]);
    float bc = lf;
    if (dir == 0) {
#pragma unroll
        for (int o = 1; o < 64; o <<= 1) { const float t2 = __shfl_up(bc, o); if (lane >= o) bc += t2; }
    } else {
#pragma unroll
        for (int o = 1; o < 64; o <<= 1) { const float t2 = __shfl_down(bc, o); if (lane + o < 64) bc += t2; }
    }
    const float a = ig - bc;
    float ml = a;
    if (dir == 0) {
#pragma unroll
        for (int o = 1; o < 64; o <<= 1) { const float t2 = __shfl_up(ml, o); if (lane >= o) ml = fmaxf(ml, t2); }
    } else {
#pragma unroll
        for (int o = 1; o < 64; o <<= 1) { const float t2 = __shfl_down(ml, o); if (lane + o < 64) ml = fmaxf(ml, t2); }
    }
    sa[lane] = a; sb[lane] = bc; sml[lane] = ml;
    const int last = dir == 0 ? 63 : 0;
    Bt = __shfl(bc, last); Mc = __shfl(ml, last);
}
__device__ __forceinline__ int ml_tc_of(int dir, int c) { return dir == 0 ? c : (c < 4 ? 3 - c : 39 - c); }
__device__ __forceinline__ int ml_c_of(int dir, int tc) { return dir == 0 ? tc : (tc < 4 ? 3 - tc : 39 - tc); }

__device__ void ml_pass1_item(const P& p, int item, int j, char* smem) {
    const int c = item % 36, dir = (item / 36) & 1, h = (item / 72) & 3, b = item / 288;
    const int tc = ml_tc_of(dir, c);
    const int tid = otid(), lane = tid & 63, wid = tid >> 6, jl = lane & 31, hh = lane >> 5;
    bf16_t* VT = (bf16_t*)smem;
    bf16_t* KWT = (bf16_t*)(smem + 18432);
    float* sa = (float*)(smem + 27648);
    float* sb = sa + 64; float* sml = sb + 64; float* sw = sml + 64; float* ssc = sw + 64;
    __syncthreads();
    if (wid == 0) {
        float Bt, Mc; ml_gates(p, j, b, h, dir, tc, lane, sa, sb, sml, Bt, Mc);
        sw[lane] = expf(sa[lane] - Mc);
        if (lane == 0) { p.CHB[item] = Bt; p.CHM[item] = Mc; }
    }
    __syncthreads();
#pragma unroll
    for (int i = 0; i < 4; ++i) {
        const int e = tid + 256 * i, st = e >> 4, ch = e & 15;
        const uint4 u = *(const uint4*)(p.PB + (size_t)ml_row(b, tc, st) * 1536 + 512 + h * 128 + ch * 8);
        bf16_t* d = VT + (ch * 8) * 72 + st;
        d[0] = (bf16_t)u.x; d[72] = (bf16_t)(u.x >> 16); d[144] = (bf16_t)u.y; d[216] = (bf16_t)(u.y >> 16);
        d[288] = (bf16_t)u.z; d[360] = (bf16_t)(u.z >> 16); d[432] = (bf16_t)u.w; d[504] = (bf16_t)(u.w >> 16);
    }
#pragma unroll
    for (int i = 0; i < 2; ++i) {
        const int e = tid + 256 * i, st = e >> 3, ch = e & 7;
        const uint4 u = *(const uint4*)(p.QKB + (size_t)ml_row(b, tc, st) * 512 + 256 + h * 64 + ch * 8);
        const float w = sw[st];
        bf16_t* d = KWT + (ch * 8) * 72 + st;
        const unsigned q0 = cvt_pk_bf16(bf_lo(u.x) * w, bf_hi(u.x) * w), q1 = cvt_pk_bf16(bf_lo(u.y) * w, bf_hi(u.y) * w), q2 = cvt_pk_bf16(bf_lo(u.z) * w, bf_hi(u.z) * w), q3 = cvt_pk_bf16(bf_lo(u.w) * w, bf_hi(u.w) * w);
        d[0] = (bf16_t)q0; d[72] = (bf16_t)(q0 >> 16); d[144] = (bf16_t)q1; d[216] = (bf16_t)(q1 >> 16);
        d[288] = (bf16_t)q2; d[360] = (bf16_t)(q2 >> 16); d[432] = (bf16_t)q3; d[504] = (bf16_t)(q3 >> 16);
    }
    __syncthreads();
    {
        const int db = wid & 1, vb0 = (wid >> 1) * 2;
        bf16x8 kf[4];
#pragma unroll
        for (int ks = 0; ks < 4; ++ks) kf[ks] = *(const bf16x8*)((const char*)KWT + (db * 32 + jl) * 144 + (2 * ks + hh) * 16);
        float* cl = p.CLOC + (size_t)item * 8192;
#pragma unroll
        for (int vv = 0; vv < 2; ++vv) {
            const int vb = vb0 + vv;
            f32x16 acc;
#pragma unroll
            for (int r = 0; r < 16; ++r) acc[r] = 0.f;
#pragma unroll
            for (int ks = 0; ks < 4; ++ks) {
                const bf16x8 vf = *(const bf16x8*)((const char*)VT + (vb * 32 + jl) * 144 + (2 * ks + hh) * 16);
                acc = __builtin_amdgcn_mfma_f32_32x32x16_bf16(vf, kf[ks], acc, 0, 0, 0);
            }
#pragma unroll
            for (int r = 0; r < 16; ++r) cl[(size_t)(vb * 32 + (r & 3) + 8 * (r >> 2) + 4 * hh) * 64 + db * 32 + jl] = acc[r];
        }
        if (tid < 64) {
            float sum = 0.f;
#pragma unroll
            for (int q = 0; q < 8; ++q) { const uint4 u = *(const uint4*)((const char*)KWT + tid * 144 + q * 16); sum += bf_lo(u.x) + bf_hi(u.x) + bf_lo(u.y) + bf_hi(u.y) + bf_lo(u.z) + bf_hi(u.z) + bf_lo(u.w) + bf_hi(u.w); }
            p.NLOC[(size_t)item * 64 + tid] = sum;
        }
    }
}

__device__ void ph_ml_pass2(const P& p) {
    const int gt = blockIdx.x * 256 + otid(), nthr = gridDim.x * 256;
    for (int w = gt; w < 64 * 2048; w += nthr) {
        const int chain = w >> 11, e = (w & 2047) * 4;
        float c0 = 0.f, c1 = 0.f, c2 = 0.f, c3 = 0.f, m = 0.f;
        for (int c = 0; c < 36; ++c) {
            const int it = chain * 36 + c;
            *(uint2*)(p.CST + (size_t)it * 8192 + e) = make_uint2(cvt_pk_bf16(c0, c1), cvt_pk_bf16(c2, c3));
            const float Bt = p.CHB[it], Mc = p.CHM[it];
            const float g = fmaxf(m, Mc), al = expf(m - g), be = expf(Mc - g);
            const float4 cl = *(const float4*)(p.CLOC + (size_t)it * 8192 + e);
            c0 = al * c0 + be * cl.x; c1 = al * c1 + be * cl.y; c2 = al * c2 + be * cl.z; c3 = al * c3 + be * cl.w;
            m = Bt + g;
        }
    }
    for (int w = gt; w < 64 * 64; w += nthr) {
        const int chain = w >> 6, d = w & 63;
        float n = 0.f, m = 0.f;
        for (int c = 0; c < 36; ++c) {
            const int it = chain * 36 + c;
            p.NST[(size_t)it * 64 + d] = n;
            if (d == 0) p.MST[it] = m;
            const float Bt = p.CHB[it], Mc = p.CHM[it];
            const float g = fmaxf(m, Mc);
            n = expf(m - g) * n + expf(Mc - g) * p.NLOC[(size_t)it * 64 + d];
            m = Bt + g;
        }
    }
}

__device__ void ml_pass3_item(const P& p, int item, int j, char* smem) {
    const int tc = item % 36, h = (item / 36) & 3, b = item / 144;
    const int tid = otid(), lane = tid & 63, wid = tid >> 6, jl = lane & 31, hh = lane >> 5, tb = wid & 1, dir = wid >> 1;
    char* Ql = smem;
    char* Kl = smem + 9216;
    bf16_t* VT = (bf16_t*)(smem + 18432);
    float* gs = (float*)(smem + 35840);
    float* ssc = gs + 512;
    __syncthreads();
    if (wid < 2) {
        const int d2 = wid; float Bt, Mc;
        float* sa = gs + d2 * 256; float* sb = sa + 64; float* sg = sb + 64; float* sn = sg + 64;
        ml_gates(p, j, b, h, d2, tc, lane, sa, sb, sg, Bt, Mc);
        const int sidx = ((b * 4 + h) * 2 + d2) * 36 + ml_c_of(d2, tc);
        const float mst = p.MST[sidx];
        sg[lane] = fmaxf(mst, sg[lane]);
        sn[lane] = p.NST[(size_t)sidx * 64 + lane];
        if (lane == 0) ssc[d2] = mst;
    }
#pragma unroll
    for (int i = 0; i < 2; ++i) {
        const int e = tid + 256 * i, st = e >> 3, ch = e & 7; const int row = ml_row(b, tc, st);
        *(uint4*)(Ql + st * 144 + ch * 16) = *(const uint4*)(p.QKB + (size_t)row * 512 + h * 64 + ch * 8);
        *(uint4*)(Kl + st * 144 + ch * 16) = *(const uint4*)(p.QKB + (size_t)row * 512 + 256 + h * 64 + ch * 8);
    }
#pragma unroll
    for (int i = 0; i < 4; ++i) {
        const int e = tid + 256 * i, st = e >> 4, ch = e & 15;
        const uint4 u = *(const uint4*)(p.PB + (size_t)ml_row(b, tc, st) * 1536 + 512 + h * 128 + ch * 8);
        bf16_t* d = VT + (ch * 8) * 68 + st;
        d[0] = (bf16_t)u.x; d[68] = (bf16_t)(u.x >> 16); d[136] = (bf16_t)u.y; d[204] = (bf16_t)(u.y >> 16);
        d[272] = (bf16_t)u.z; d[340] = (bf16_t)(u.z >> 16); d[408] = (bf16_t)u.w; d[476] = (bf16_t)(u.w >> 16);
    }
    __syncthreads();
    const float* sa = gs + dir * 256; const float* sb = sa + 64; const float* sg = sb + 64; const float* sn = sg + 64;
    const int t = tb * 32 + jl;
    const float gtv = sg[t], btv = sb[t], mst = ssc[dir];
    const float e2 = expf(mst - gtv);
    const int sidx = ((b * 4 + h) * 2 + dir) * 36 + ml_c_of(dir, tc);
    bf16x8 qf[4];
#pragma unroll
    for (int ks = 0; ks < 4; ++ks) qf[ks] = *(const bf16x8*)(Ql + t * 144 + (2 * ks + hh) * 16);
    f32x16 acc[4];
    {
        const bf16_t* cst = p.CST + (size_t)sidx * 8192 + (size_t)jl * 64 + hh * 8;
#pragma unroll
        for (int vb = 0; vb < 4; ++vb) {
#pragma unroll
            for (int r = 0; r < 16; ++r) acc[vb][r] = 0.f;
#pragma unroll
            for (int ks = 0; ks < 4; ++ks) {
                const bf16x8 cf = *(const bf16x8*)(cst + (size_t)vb * 32 * 64 + ks * 16);
                acc[vb] = __builtin_amdgcn_mfma_f32_32x32x16_bf16(cf, qf[ks], acc[vb], 0, 0, 0);
            }
            acc[vb] = acc[vb] * e2;
        }
    }
    float den = 0.f;
    {
        float nq = 0.f;
#pragma unroll
        for (int ks = 0; ks < 4; ++ks) {
            const u32x4 u = __builtin_bit_cast(u32x4, qf[ks]);
            const float* np = sn + 16 * ks + 8 * hh;
            nq += bf_lo(u[0]) * np[0] + bf_hi(u[0]) * np[1] + bf_lo(u[1]) * np[2] + bf_hi(u[1]) * np[3] + bf_lo(u[2]) * np[4] + bf_hi(u[2]) * np[5] + bf_lo(u[3]) * np[6] + bf_hi(u[3]) * np[7];
        }
        den = e2 * nq;
    }
#pragma unroll
    for (int sbk = 0; sbk < 2; ++sbk) {
        const bool use = dir == 0 ? (sbk <= tb) : (sbk >= tb);
        if (use) {
            f32x16 sc;
#pragma unroll
            for (int r = 0; r < 16; ++r) sc[r] = 0.f;
#pragma unroll
            for (int ks = 0; ks < 4; ++ks) {
                const bf16x8 kf = *(const bf16x8*)(Kl + (sbk * 32 + jl) * 144 + (2 * ks + hh) * 16);
                sc = __builtin_amdgcn_mfma_f32_32x32x16_bf16(kf, qf[ks], sc, 0, 0, 0);
            }
#pragma unroll
            for (int r4 = 0; r4 < 4; ++r4) {
                const int s0 = sbk * 32 + 8 * r4 + 4 * hh;
                const f32x4 av = *(const f32x4*)(sa + s0);
#pragma unroll
                for (int q = 0; q < 4; ++q) {
                    const int s2 = s0 + q;
                    const bool ok = dir == 0 ? (s2 <= t) : (s2 >= t);
                    const float pv = ok ? sc[r4 * 4 + q] * expf(av[q] - gtv) : 0.f;
                    sc[r4 * 4 + q] = pv; den += pv;
                }
            }
            bf16x8 pb[2];
            pb[0] = pack8(sc[0], sc[1], sc[2], sc[3], sc[4], sc[5], sc[6], sc[7]);
            pb[1] = pack8(sc[8], sc[9], sc[10], sc[11], sc[12], sc[13], sc[14], sc[15]);
#pragma unroll
            for (int vb = 0; vb < 4; ++vb)
#pragma unroll
                for (int k2 = 0; k2 < 2; ++k2) {
                    const char* vp = (const char*)VT + (vb * 32 + jl) * 136 + (sbk * 32 + k2 * 16 + 4 * hh) * 2;
                    const uint2 lo = *(const uint2*)vp, hi = *(const uint2*)(vp + 16);
                    const u32x4 u = (u32x4){lo.x, lo.y, hi.x, hi.y};
                    acc[vb] = __builtin_amdgcn_mfma_f32_32x32x16_bf16(__builtin_bit_cast(bf16x8, u), pb[k2], acc[vb], 0, 0, 0);
                }
        }
    }
    den += __shfl_xor(den, 32);
    const float scl = 1.f / fmaxf(fabsf(den), expf(-(btv + gtv)));
#pragma unroll
    for (int vb = 0; vb < 4; ++vb) acc[vb] = acc[vb] * scl;
    __syncthreads();
    float* X = (float*)smem + tb * 4096;
    if (dir == 1) {
#pragma unroll
        for (int vb = 0; vb < 4; ++vb)
#pragma unroll
            for (int r = 0; r < 16; ++r) X[(vb * 32 + (r & 3) + 8 * (r >> 2) + 4 * hh) * 32 + jl] = acc[vb][r];
    }
    __syncthreads();
    if (dir == 0) {
        float ss = 0.f;
#pragma unroll
        for (int vb = 0; vb < 4; ++vb)
#pragma unroll
            for (int r = 0; r < 16; ++r) { const float v = acc[vb][r] + X[(vb * 32 + (r & 3) + 8 * (r >> 2) + 4 * hh) * 32 + jl]; acc[vb][r] = v; ss += v * v; }
        ss += __shfl_xor(ss, 32);
        const float rstd = rsqrtf(ss * (1.f / 128.f) + 1e-6f);
        const int row = ml_row(b, tc, t);
        const float* g = p.ev_ml_g + (size_t)j * 512 + h * 128;
        const bf16_t* og = p.PB + (size_t)row * 1536 + 1024 + h * 128;
        bf16_t* mrow = p.MIX + (size_t)row * DM + h * 128;
#pragma unroll
        for (int vb = 0; vb < 4; ++vb)
#pragma unroll
            for (int r4 = 0; r4 < 4; ++r4) {
                const int v = vb * 32 + 8 * r4 + 4 * hh;
                const f32x4 gg = *(const f32x4*)(g + v);
                const uint2 ou = *(const uint2*)(og + v);
                *(uint2*)(mrow + v) = make_uint2(cvt_pk_bf16(acc[vb][r4 * 4 + 0] * rstd * gg[0] * sigmoid_f(bf_lo(ou.x)), acc[vb][r4 * 4 + 1] * rstd * gg[1] * sigmoid_f(bf_hi(ou.x))),
                                                 cvt_pk_bf16(acc[vb][r4 * 4 + 2] * rstd * gg[2] * sigmoid_f(bf_lo(ou.y)), acc[vb][r4 * 4 + 3] * rstd * gg[3] * sigmoid_f(bf_hi(ou.y))));
            }
    }
}

__device__ void ph_attn_even(const P& p, int ci, int L, int j, float* smem) {
    int* s_item = (int*)((char*)smem + 73728);
    for (;;) {
        __syncthreads();
        if (otid() == 0) *s_item = atomicAdd(&p.ctr[ci], 1);
        __syncthreads();
        const int item = *s_item;
        if (item >= 1152 + 2304) break;
        if (item < 1152) da_block(p, item, L, j, (char*)smem); else ml_pass1_item(p, item - 1152, j, (char*)smem);
    }
}
__device__ void ph_ml_pass3(const P& p, int j, float* smem) {
    for (int item = blockIdx.x; item < 1152; item += gridDim.x) ml_pass3_item(p, item, j, (char*)smem);
}
__device__ void ph_attn_odd(const P& p, int j, bool need_ctx, float* smem) {
    const int nitem = need_ctx ? 2304 : 2048;
    for (int item = blockIdx.x; item < nitem; item += gridDim.x) { wa_block(p, item, j, (char*)smem); __syncthreads(); }
}

__device__ __forceinline__ float wave_max(float v) {
#pragma unroll
    for (int o = 32; o > 0; o >>= 1) v = fmaxf(v, __shfl_xor(v, o));
    return v;
}
#define SEL_LD 132
__device__ __forceinline__ unsigned fkey(float f) { const unsigned u = __float_as_uint(f); return (u & 0x80000000u) ? ~u : (u | 0x80000000u); }
__device__ __forceinline__ unsigned mbcnt64(unsigned long long m) { return __builtin_amdgcn_mbcnt_hi((unsigned)(m >> 32), __builtin_amdgcn_mbcnt_lo((unsigned)m, 0u)); }
__device__ void ph_peer_select(const P& p, int L, int nrows, char* smem) {
    float* S = (float*)smem;
    const int tid = otid(), lane = tid & 63, wid = tid >> 6, fr = lane & 15, fq = lane >> 4;
    const bf16_t* KBL = p.KB + (size_t)L * 8 * 2 * 128 * 128;
    const int ntile = nrows / 32;
    bf16x8 kfr[8][4];
    int hcur = -1;
    for (int item = blockIdx.x; item < ntile * 8; item += gridDim.x) {
        const int h = item & 7, t0 = (item >> 3) * 32;
        __syncthreads();
        {
            const int pp = wid >> 1, th = wid & 1;
            const bf16_t* qp = p.QB + (size_t)(t0 + th * 16 + fr) * 2048 + h * 256 + pp * 128 + fq * 8;
            bf16x8 qf[4];
#pragma unroll
            for (int ks = 0; ks < 4; ++ks) qf[ks] = *(const bf16x8*)(qp + ks * 32);
            if (h != hcur) {
                const bf16_t* kp = KBL + ((size_t)(h * 2 + pp) * 128 + fr) * 128 + fq * 8;
#pragma unroll
                for (int ni = 0; ni < 8; ++ni)
#pragma unroll
                    for (int ks = 0; ks < 4; ++ks) kfr[ni][ks] = *(const bf16x8*)(kp + (size_t)ni * 16 * 128 + ks * 32);
                hcur = h;
            }
#pragma unroll
            for (int ni = 0; ni < 8; ++ni) {
                f32x4 acc = (f32x4){0.f, 0.f, 0.f, 0.f};
#pragma unroll
                for (int ks = 0; ks < 4; ++ks) acc = __builtin_amdgcn_mfma_f32_16x16x32_bf16(qf[ks], kfr[ni][ks], acc, 0, 0, 0);
#pragma unroll
                for (int j = 0; j < 4; ++j) S[(pp * 32 + th * 16 + fq * 4 + j) * SEL_LD + ni * 16 + fr] = acc[j];
            }
        }
        __syncthreads();
        for (int tt = 0; tt < 8; ++tt) {
            const int t = wid * 8 + tt, r = t0 + t;
            const float v00 = S[t * SEL_LD + lane], v01 = S[t * SEL_LD + 64 + lane], v10 = S[(32 + t) * SEL_LD + lane], v11 = S[(32 + t) * SEL_LD + 64 + lane];
            const unsigned ka0 = fkey(v00), ka1 = fkey(v01), kb0 = fkey(v10), kb1 = fkey(v11);
            unsigned T0 = 0u, T1 = 0u; bool dn0 = false, dn1 = false;
            for (int bit = 31; bit >= 0 && !(dn0 && dn1); --bit) {
                if (!dn0) { const unsigned c0 = T0 | (1u << bit); const int n0 = __builtin_popcountll(__ballot(ka0 >= c0)) + __builtin_popcountll(__ballot(ka1 >= c0)); if (n0 >= 16) T0 = c0; dn0 = (n0 == 16); }
                if (!dn1) { const unsigned c1 = T1 | (1u << bit); const int n1 = __builtin_popcountll(__ballot(kb0 >= c1)) + __builtin_popcountll(__ballot(kb1 >= c1)); if (n1 >= 16) T1 = c1; dn1 = (n1 == 16); }
            }
            float* wsA = (float*)(smem + 34816 + wid * 512);
            {
                const unsigned long long g0 = __ballot(ka0 > T0), g1 = __ballot(ka1 > T0), e0 = __ballot(ka0 == T0), e1 = __ballot(ka1 == T0);
                const int need = 16 - __builtin_popcountll(g0) - __builtin_popcountll(g1);
                const int pe0 = __builtin_popcountll(e0), need1 = need - (pe0 < need ? pe0 : need);
                const bool s0 = (ka0 > T0) || (ka0 == T0 && (int)mbcnt64(e0) < need);
                const bool s1 = (ka1 > T0) || (ka1 == T0 && (int)mbcnt64(e1) < need1);
                const unsigned long long m0 = __ballot(s0), m1 = __ballot(s1);
                if (s0) { const int pos = mbcnt64(m0); wsA[pos] = v00; ((int*)wsA)[16 + pos] = lane; }
                if (s1) { const int pos = __builtin_popcountll(m0) + mbcnt64(m1); wsA[pos] = v01; ((int*)wsA)[16 + pos] = 64 + lane; }
            }
            {
                const unsigned long long g0 = __ballot(kb0 > T1), g1 = __ballot(kb1 > T1), e0 = __ballot(kb0 == T1), e1 = __ballot(kb1 == T1);
                const int need = 16 - __builtin_popcountll(g0) - __builtin_popcountll(g1);
                const int pe0 = __builtin_popcountll(e0), need1 = need - (pe0 < need ? pe0 : need);
                const bool s0 = (kb0 > T1) || (kb0 == T1 && (int)mbcnt64(e0) < need);
                const bool s1 = (kb1 > T1) || (kb1 == T1 && (int)mbcnt64(e1) < need1);
                const unsigned long long m0 = __ballot(s0), m1 = __ballot(s1);
                if (s0) { const int pos = mbcnt64(m0); wsA[32 + pos] = v10; ((int*)wsA)[48 + pos] = lane; }
                if (s1) { const int pos = __builtin_popcountll(m0) + mbcnt64(m1); wsA[32 + pos] = v11; ((int*)wsA)[48 + pos] = 64 + lane; }
            }
            __builtin_amdgcn_wave_barrier();
            float cand[4]; int cidx[4]; unsigned kc[4];
            {
                const float av = wsA[lane >> 2]; const int ai = ((int*)wsA)[16 + (lane >> 2)];
                const float4 bv = *(const float4*)(wsA + 32 + (lane & 3) * 4); const int4 bi = *(const int4*)((int*)wsA + 48 + (lane & 3) * 4);
                cand[0] = av + bv.x; cand[1] = av + bv.y; cand[2] = av + bv.z; cand[3] = av + bv.w;
                cidx[0] = ai * 128 + bi.x; cidx[1] = ai * 128 + bi.y; cidx[2] = ai * 128 + bi.z; cidx[3] = ai * 128 + bi.w;
#pragma unroll
                for (int c = 0; c < 4; ++c) kc[c] = fkey(cand[c]);
            }
            unsigned T = 0u;
            for (int bit = 31; bit >= 0; --bit) {
                const unsigned cc = T | (1u << bit);
                const int n = __builtin_popcountll(__ballot(kc[0] >= cc)) + __builtin_popcountll(__ballot(kc[1] >= cc)) + __builtin_popcountll(__ballot(kc[2] >= cc)) + __builtin_popcountll(__ballot(kc[3] >= cc));
                if (n >= 16) T = cc;
                if (n == 16) break;
            }
            {
                int need = 16, base = 0;
#pragma unroll
                for (int c = 0; c < 4; ++c) need -= __builtin_popcountll(__ballot(kc[c] > T));
#pragma unroll
                for (int c = 0; c < 4; ++c) {
                    const unsigned long long e = __ballot(kc[c] == T);
                    const bool sel = (kc[c] > T) || (kc[c] == T && (int)mbcnt64(e) < need);
                    const int pe = __builtin_popcountll(e); need -= (pe < need ? pe : need);
                    const unsigned long long m = __ballot(sel);
                    if (sel) { const int pos = base + mbcnt64(m); wsA[64 + pos] = cand[c]; ((int*)wsA)[80 + pos] = cidx[c]; }
                    base += __builtin_popcountll(m);
                }
            }
            __builtin_amdgcn_wave_barrier();
            {
                const float cv = lane < 16 ? wsA[64 + lane] : -INFINITY;
                const float mx = wave_max(cv);
                const float ex = lane < 16 ? __builtin_amdgcn_exp2f((cv - mx) * 1.4426950408889634f) : 0.f;
                const float sum = wave_sum(ex);
                if (lane < 16) { p.GATE[(size_t)r * 128 + h * 16 + lane] = ex / sum; p.EIDX[(size_t)r * 128 + h * 16 + lane] = ((int*)wsA)[80 + lane]; }
            }
            __builtin_amdgcn_wave_barrier();
        }
    }
}


__device__ __forceinline__ void unpack8(const uint4 u, float* f) {
    f[0] = bf_lo(u.x); f[1] = bf_hi(u.x); f[2] = bf_lo(u.y); f[3] = bf_hi(u.y); f[4] = bf_lo(u.z); f[5] = bf_hi(u.z); f[6] = bf_lo(u.w); f[7] = bf_hi(u.w);
}
__device__ __forceinline__ void unpack16_u8(const uint4 u, float* f) {
    f[0] = (float)(u.x & 0xffu); f[1] = (float)((u.x >> 8) & 0xffu); f[2] = (float)((u.x >> 16) & 0xffu); f[3] = (float)((u.x >> 24) & 0xffu);
    f[4] = (float)(u.y & 0xffu); f[5] = (float)((u.y >> 8) & 0xffu); f[6] = (float)((u.y >> 16) & 0xffu); f[7] = (float)((u.y >> 24) & 0xffu);
    f[8] = (float)(u.z & 0xffu); f[9] = (float)((u.z >> 8) & 0xffu); f[10] = (float)((u.z >> 16) & 0xffu); f[11] = (float)((u.z >> 24) & 0xffu);
    f[12] = (float)(u.w & 0xffu); f[13] = (float)((u.w >> 8) & 0xffu); f[14] = (float)((u.w >> 16) & 0xffu); f[15] = (float)((u.w >> 24) & 0xffu);
}
__device__ void ph_peer_gather(const P& p, int L, int nrows, float oscale) {
    const int lane = otid() & 63, wid = otid() >> 6;
    const unsigned char* U = p.U8 + (size_t)L * 16384 * 1024; const unsigned char* V = p.V8 + (size_t)L * 16384 * 1024;
    const float* USC = p.USC + (size_t)L * 16384; const float* VSC = p.VSC + (size_t)L * 16384;
    const float* gate2 = p.modv + (size_t)L * 9 * 6144 + 5120;
    for (int r = blockIdx.x * 4 + wid; r < nrows; r += gridDim.x * 4) {
        const int e0 = p.EIDX[(size_t)r * 128 + lane], e1 = p.EIDX[(size_t)r * 128 + 64 + lane];
        const float g0 = p.GATE[(size_t)r * 128 + lane], g1 = p.GATE[(size_t)r * 128 + 64 + lane];
        const float us0 = USC[e0], us1 = USC[e1], vs0 = VSC[e0], vs1 = VSC[e1];
        float x[16];
        { const uint4 xa = *(const uint4*)(p.XN + (size_t)r * DM + lane * 16), xb = *(const uint4*)(p.XN + (size_t)r * DM + lane * 16 + 8); unpack8(xa, x); unpack8(xb, x + 8); }
        float sx = 0.f;
#pragma unroll
        for (int c = 0; c < 16; ++c) sx += x[c];
        sx = wave_sum(sx);
        float a0 = 0.f, a1 = 0.f;
#pragma unroll
        for (int half = 0; half < 2; ++half) {
            const int ev = half ? e1 : e0;
            float av = 0.f;
            for (int kb = 0; kb < 4; ++kb) {
                uint4 ua[16];
#pragma unroll
                for (int j = 0; j < 16; ++j) {
                    const int idx = __builtin_amdgcn_readlane(ev, kb * 16 + j);
                    ua[j] = *(const uint4*)(U + (size_t)idx * 1024 + lane * 16);
                }
#pragma unroll
                for (int j = 0; j < 16; ++j) {
                    float f[16]; unpack16_u8(ua[j], f);
                    float s = 0.f;
#pragma unroll
                    for (int c = 0; c < 16; ++c) s += x[c] * f[c];
                    s = wave_sum(s);
                    if (lane == kb * 16 + j) av = s;
                }
            }
            if (half) a1 = av; else a0 = av;
        }
        a0 = us0 * (a0 - 128.f * sx); a1 = us1 * (a1 - 128.f * sx);
        const float w0 = vs0 * g0 * 0.5f * a0 * (1.f + erff(a0 * 0.70710678118654752f));
        const float w1 = vs1 * g1 * 0.5f * a1 * (1.f + erff(a1 * 0.70710678118654752f));
        const float wsum = wave_sum(w0 + w1);
        float acc[16];
#pragma unroll
        for (int c = 0; c < 16; ++c) acc[c] = 0.f;
#pragma unroll
        for (int half = 0; half < 2; ++half) {
            const int ev = half ? e1 : e0; const int wv = __float_as_int(half ? w1 : w0);
            for (int kb = 0; kb < 4; ++kb) {
                uint4 ua[16];
#pragma unroll
                for (int j = 0; j < 16; ++j) {
                    const int idx = __builtin_amdgcn_readlane(ev, kb * 16 + j);
                    ua[j] = *(const uint4*)(V + (size_t)idx * 1024 + lane * 16);
                }
#pragma unroll
                for (int j = 0; j < 16; ++j) {
                    const float wj = __int_as_float(__builtin_amdgcn_readlane(wv, kb * 16 + j));
                    float f[16]; unpack16_u8(ua[j], f);
#pragma unroll
                    for (int c = 0; c < 16; ++c) acc[c] += wj * f[c];
                }
            }
        }
        const float* gp = gate2 + (size_t)modrow(r) * 6144 + lane * 16;
        float* hp = p.H + (size_t)r * DM + lane * 16;
#pragma unroll
        for (int q = 0; q < 4; ++q) {
            const float4 g = *(const float4*)(gp + q * 4);
            float4 hv = *(float4*)(hp + q * 4);
            hv.x += oscale * g.x * (acc[q * 4 + 0] - 128.f * wsum); hv.y += oscale * g.y * (acc[q * 4 + 1] - 128.f * wsum);
            hv.z += oscale * g.z * (acc[q * 4 + 2] - 128.f * wsum); hv.w += oscale * g.w * (acc[q * 4 + 3] - 128.f * wsum);
            *(float4*)(hp + q * 4) = hv;
        }
    }
}

#define NSUB 11
__device__ __forceinline__ bool phase_empty(int ph) {
    if (ph == 0 || ph == NPH - 1) return false;
    const int L = (ph - 1) / NSUB, s = (ph - 1) % NSUB;
    return (L & 1) && (s == 2 || s == 4 || s == 5);
}
__device__ void run_phase(const P& p, int ph, float* smem, int rep) {
    if (ph == 0) { ph_prologue(p, smem); return; }
    if (ph == NPH - 1) { ph_final(p); return; }
    const int L = (ph - 1) / NSUB, s = (ph - 1) % NSUB, j = L >> 1;
    const bool even = (L & 1) == 0, need_ctx = L < 3;
    const int nrows = need_ctx ? NT : NL;
    const float* mv = p.modv + (size_t)L * 9 * 6144;
    switch (s) {
    case 0: ph_normmod(p.H, p.norm1_g + L * DM, mv, 0, 1024, p.XN, NT); break;
    case 1:
        if (even) ph_gemm(p.XN, p.WT + WT_EVIN(j), NT, 3200, EpiEven{p.PB, p.AQL, p.AQC, p.AK, p.AV, p.GT, p.rope}, (char*)smem);
        else ph_gemm(p.XN, p.WT + WT_ODIN(j), NT, ODW, EpiOdd{p.AQL, p.AQC, p.AK, p.AV, p.rope}, (char*)smem);
        break;
    case 2: if (even) ph_prep_even(p, j); break;
    case 3: if (even) ph_attn_even(p, L + 4 * rep, L, j, smem); else ph_attn_odd(p, j, need_ctx, smem); break;
    case 4: if (even) ph_ml_pass2(p); break;
    case 5: if (even) ph_ml_pass3(p, j, smem); break;
    case 6: ph_gemm(p.MIX, p.WT + (even ? WT_EVOUT(j) : WT_ODOUT(j)), nrows, DM, EpiResid{p.H, mv + 2048, rep ? 0.f : 1.f}, (char*)smem); break;
    case 7: ph_normmod(p.H, p.norm2_g + L * DM, mv, 3072, 4096, p.XN, nrows); break;
    case 8: ph_gemm(p.XN, p.WT + WT_PQ(L), nrows, 2048, EpiStoreBF16{p.QB, 2048}, (char*)smem); break;
    case 9: ph_peer_select(p, L, nrows, (char*)smem); break;
    case 10: ph_peer_gather(p, L, nrows, rep ? 0.f : 1.f); break;
    }
}

#define XB_TMO      128
#define XB_XCNT(j)  (256  + 64 * (j))
#define XB_XSUB(j)  (1280 + 64 * (j))
#define XB_XGEN(j)  (2304 + 64 * (j))
#define XB_TOP      3328
#define XB_TOPGEN   3392
#define XCD_BAR_WORDS 3456
#define XB_SPIN_CAP (1u << 20)
#define LAS __attribute__((address_space(3)))
__device__ __forceinline__ unsigned xb_ld(unsigned* p)              { return __hip_atomic_load(p, __ATOMIC_RELAXED, __HIP_MEMORY_SCOPE_AGENT); }
__device__ __forceinline__ unsigned xb_add(unsigned* p, unsigned v) { return __hip_atomic_fetch_add(p, v, __ATOMIC_RELAXED, __HIP_MEMORY_SCOPE_AGENT); }
__device__ __forceinline__ unsigned xb_xcc_id() { return (unsigned)__builtin_amdgcn_s_getreg((3 << 11) | 20) & 0xFu; }
#define XB_SPIN(cond, bar) do { unsigned _sp = 0; while (cond) { __builtin_amdgcn_s_sleep(1); \
    if ((++_sp & 255u) == 0u) { if (xb_ld(&(bar)[XB_TMO])) break; if (_sp > XB_SPIN_CAP) { atomicAdd(&(bar)[XB_TMO], 1u); break; } } } } while (0)
struct XcdBarrier { unsigned* bar; unsigned x; volatile LAS unsigned* st; };
__device__ __forceinline__ XcdBarrier xcd_barrier_post(unsigned* bar, volatile LAS unsigned* st) {
    XcdBarrier b; b.bar = bar; b.x = xb_xcc_id(); b.st = st;
    if (threadIdx.x == 0) (void)xb_add(&bar[XB_XCNT(b.x)], 1u);
    return b;
}
__device__ __forceinline__ void xcd_barrier_complete(unsigned* bar, unsigned x, unsigned& nloc, unsigned& nx) {
    const unsigned G = gridDim.x * gridDim.y * gridDim.z;
    unsigned sum, cnt, mine, sp = 0u;
    for (;;) {
        sum = 0u; cnt = 0u; mine = 0u;
#pragma unroll
        for (unsigned j = 0; j < 16; ++j) { const unsigned c = xb_ld(&bar[XB_XCNT(j)]); sum += c; cnt += (c > 0u) ? 1u : 0u; mine = (j == x) ? c : mine; }
        if (sum == G) break;
        __builtin_amdgcn_s_sleep(1);
        if ((++sp & 255u) == 0u) { if (xb_ld(&bar[XB_TMO])) break; if (sp > XB_SPIN_CAP) { atomicAdd(&bar[XB_TMO], 1u); break; } }
    }
    nloc = mine > 0u ? mine : 1u; nx = cnt > 0u ? cnt : 1u;
}
__device__ __forceinline__ void xcd_barrier(const XcdBarrier& b) {
    asm volatile("s_waitcnt vmcnt(0)" ::: "memory");
    __syncthreads();
    if (threadIdx.x == 0) {
        unsigned* bar = b.bar;
        __builtin_amdgcn_s_waitcnt(0);
        unsigned nloc = b.st[0], nx = b.st[1];
        if (nloc == 0u) { xcd_barrier_complete(bar, b.x, nloc, nx); b.st[0] = nloc; b.st[1] = nx; }
        const unsigned old = xb_add(&bar[XB_XSUB(b.x)], 1u);
        const unsigned gen = old / nloc;
        if (old + 1u == (gen + 1u) * nloc) {
            __builtin_amdgcn_fence(__ATOMIC_RELEASE, "agent");
            asm volatile("s_waitcnt vmcnt(0)" ::: "memory");
            const unsigned og = xb_add(&bar[XB_TOP], 1u);
            const unsigned tg = og / nx;
            if (og + 1u == (tg + 1u) * nx) xb_add(&bar[XB_TOPGEN], 1u);
            else XB_SPIN(xb_ld(&bar[XB_TOPGEN]) == tg, bar);
            __builtin_amdgcn_fence(__ATOMIC_ACQUIRE, "agent");
            xb_add(&bar[XB_XGEN(b.x)], 1u);
            asm volatile("s_waitcnt vmcnt(0)" ::: "memory");
        } else {
            XB_SPIN(xb_ld(&bar[XB_XGEN(b.x)]) == gen, bar);
            __builtin_amdgcn_fence(__ATOMIC_ACQUIRE, "agent");
            asm volatile("s_waitcnt vmcnt(0)" ::: "memory");
        }
    }
    __syncthreads();
}

__global__ void __launch_bounds__(256, 2) mega(P p) {
    extern __shared__ __attribute__((aligned(16))) float smem[];
    cg::grid_group grid = cg::this_grid();
    volatile LAS unsigned* st = (volatile LAS unsigned*)((char*)smem + 73744);
    if (threadIdx.x < 4) st[threadIdx.x] = 0u;
    __syncthreads();
    XcdBarrier xb = xcd_barrier_post(p.bar, st);
    for (int ph = p.ph_lo; ph < p.ph_hi; ++ph) {
        if (phase_empty(ph)) continue;
        run_phase(p, ph, smem, 0);
        if (PROBE_N > 1 && ph > 0 && ph < NPH - 1 && (ph - 1) % NSUB == PROBE_S)
            for (int rep = 1; rep < PROBE_N; ++rep) { xcd_barrier(xb); run_phase(p, ph, smem, rep); }
        if (ph + 1 < p.ph_hi) { if (ph == 0) grid.sync(); else xcd_barrier(xb); }
    }
}

extern "C" void kernel_launch(void* const* d_in, const int* in_sizes, int n_in, void* d_out, int out_size, void* d_ws, size_t ws_size, hipStream_t stream) {
    static int grid_blocks = 0;
    if (!grid_blocks) {
        int dev = 0, cus = 0, per_cu = 0;
        hipGetDevice(&dev);
        hipDeviceGetAttribute(&cus, hipDeviceAttributeMultiprocessorCount, dev);
        hipFuncSetAttribute((const void*)mega, hipFuncAttributeMaxDynamicSharedMemorySize, LDS_BYTES);
        hipOccupancyMaxActiveBlocksPerMultiprocessor(&per_cu, mega, 256, LDS_BYTES);
        if (per_cu < 1) per_cu = 1;
        if (per_cu > 2) per_cu = 2;
        grid_blocks = cus * per_cu;
    }
    P p{};
    const float** ins = (const float**)&p;
    for (int i = 0; i < 24; ++i) ins[i] = (const float*)d_in[i];
    p.out = (float*)d_out;
    size_t off = 0; char* ws = (char*)d_ws;
    auto carve = [&](size_t bytes) { void* r = ws + off; off += (bytes + 255) & ~(size_t)255; return r; };
    p.modv = (float*)carve((size_t)4 * 9 * 6144 * 4);
    p.rope = (float*)carve((size_t)2048 * 64 * 4);
    p.H = (float*)carve((size_t)NT * DM * 4);
    p.XN = (bf16_t*)carve((size_t)NT * DM * 2);
    p.WT = (bf16_t*)carve(WT_TOTAL * 2);
    p.MIX = (bf16_t*)carve((size_t)NT * DM * 2);
    p.PB = (bf16_t*)carve((size_t)NT * 1536 * 2);
    p.GT = (float*)carve((size_t)NT * 16 * 4);
    p.AQL = (bf16_t*)carve((size_t)8 * 16 * 2048 * 64 * 2);
    p.AQC = (bf16_t*)carve((size_t)8 * 16 * 256 * 64 * 2);
    p.AK = (bf16_t*)carve((size_t)8 * 4 * 2 * 2304 * 64 * 2);
    p.AV = (bf16_t*)carve((size_t)8 * 4 * 128 * 2304 * 2);
    p.QKB = (bf16_t*)carve((size_t)NT * 512 * 2);
    p.CLOC = (float*)carve((size_t)2304 * 8192 * 4);
    p.CST = (bf16_t*)carve((size_t)2304 * 8192 * 2);
    p.NLOC = (float*)carve((size_t)2304 * 64 * 4);
    p.NST = (float*)carve((size_t)2304 * 64 * 4);
    p.CHB = (float*)carve((size_t)2304 * 4);
    p.CHM = (float*)carve((size_t)2304 * 4);
    p.MST = (float*)carve((size_t)2304 * 4);
    p.QB = (bf16_t*)carve((size_t)NT * 2048 * 2);
    p.GATE = (float*)carve((size_t)NT * 128 * 4);
    p.EIDX = (int*)carve((size_t)NT * 128 * 4);
    p.ctr = (int*)carve(256);
    p.bar = (unsigned*)carve((size_t)XCD_BAR_WORDS * 4);
    p.U8 = (unsigned char*)carve((size_t)4 * 16384 * 1024);
    p.V8 = (unsigned char*)carve((size_t)4 * 16384 * 1024);
    p.USC = (float*)carve((size_t)4 * 16384 * 4);
    p.VSC = (float*)carve((size_t)4 * 16384 * 4);
    p.KB = (bf16_t*)carve((size_t)4 * 8 * 2 * 128 * 128 * 2);
    if (off > ws_size) { fprintf(stderr, "kernel_launch: workspace too small: need %zu have %zu\n", off, ws_size); return; }
    hipMemsetAsync(p.bar, 0, (size_t)XCD_BAR_WORDS * 4, stream);
#if ONE_LAUNCH
    p.ph_lo = 0; p.ph_hi = NPH;
    void* args[] = {&p};
    hipError_t e = hipLaunchCooperativeKernel((void*)mega, dim3(grid_blocks), dim3(256), args, LDS_BYTES, stream);
    if (e != hipSuccess) fprintf(stderr, "cooperative launch failed: %s (grid %d)\n", hipGetErrorString(e), grid_blocks);
#else
    for (int ph = 0; ph < NPH; ++ph) {
        if (ph > 0 && ph < NPH - 1) { const int L = (ph - 1) / NSUB, s = (ph - 1) % NSUB; if ((s == 2 || s == 4 || s == 5) && (L & 1)) continue; }
        p.ph_lo = ph; p.ph_hi = ph + 1;
        hipLaunchKernelGGL(mega, dim3(grid_blocks), dim3(256), LDS_BYTES, stream, p);
    }
#endif
}
```

```cpp
#include <hip/hip_runtime.h>
#include <hip/hip_cooperative_groups.h>
#include <cstdio>
#include <cstdint>
namespace cg = cooperative_groups;

#ifndef ONE_LAUNCH
#define ONE_LAUNCH 1
#endif

#define NT 18432
#define NL 16384
#define DM 1024
#define EVW 3088
#define ODW 1536
#define C_QK 0
#define C_V 512
#define C_O 1024
#define C_G 1536
#define C_DQ 1552
#define C_DK 2064
#define C_DV 2576
#define NPH 46
#ifndef PROBE_S
#define PROBE_S -1
#endif
#ifndef PROBE_N
#define PROBE_N 1
#endif

typedef unsigned short bf16_t;
typedef short bf16x8 __attribute__((ext_vector_type(8)));
typedef float f32x4 __attribute__((ext_vector_type(4)));
#define LDS_BYTES 73792

typedef float f32x16 __attribute__((ext_vector_type(16)));
typedef unsigned u32x4 __attribute__((ext_vector_type(4)));
struct P {
    const float *x, *c, *ctx, *c_ctx, *mod_w, *mod_b, *norm1_g, *norm2_g, *ev_w_in, *ev_conv_w, *ev_conv_b, *ev_gate_b,
        *ev_ml_g, *ev_da_lam, *ev_da_g, *ev_w_out, *od_w_in, *od_sink, *od_w_out, *pr_w_q, *pr_keys, *pr_u, *pr_v, *final_g;
    float* out;
    float *modv, *H, *GATE, *rope, *GT, *CLOC, *NLOC, *NST, *CHB, *CHM, *MST;
    int *EIDX, *ctr;
    unsigned* bar;
    bf16_t *XN, *MIX, *WT, *KB, *QB, *PB, *AQL, *AQC, *AK, *AV, *QKB, *CST;
    unsigned char *U8, *V8;
    float *USC, *VSC;
    int ph_lo, ph_hi;
};
#define QSCALE 0.18033688011112042f

__device__ __forceinline__ int otid() { int t = threadIdx.x; asm volatile("" : "+v"(t)); return t; }
__device__ __forceinline__ int modrow(int r) { return r < NL ? (r >> 11) : 8; }
__device__ __forceinline__ float silu_f(float x) { return x / (1.f + expf(-x)); }
__device__ __forceinline__ float sigmoid_f(float x) { return 1.f / (1.f + expf(-x)); }
__device__ __forceinline__ float log_sigmoid_f(float x) { return fminf(x, 0.f) - log1pf(expf(-fabsf(x))); }
typedef __bf16 bf16v2_t __attribute__((ext_vector_type(2)));
typedef float f32x2_t __attribute__((ext_vector_type(2)));
__device__ __forceinline__ unsigned cvt_pk_bf16(float lo, float hi) { const bf16v2_t v = __builtin_convertvector((f32x2_t){lo, hi}, bf16v2_t); return __builtin_bit_cast(unsigned, v); }
__device__ __forceinline__ float bf_lo(unsigned u) { return __uint_as_float(u << 16); }
__device__ __forceinline__ float bf_hi(unsigned u) { return __uint_as_float(u & 0xffff0000u); }
#define WT_EVIN(j) ((size_t)(j) * 3200 * 1024)
#define WT_EVOUT(j) ((size_t)2 * 3200 * 1024 + (size_t)(j) * 1024 * 1024)
#define WT_ODIN(j) ((size_t)2 * 3200 * 1024 + (size_t)2 * 1024 * 1024 + (size_t)(j) * 1536 * 1024)
#define WT_ODOUT(j) ((size_t)2 * 3200 * 1024 + (size_t)2 * 1024 * 1024 + (size_t)2 * 1536 * 1024 + (size_t)(j) * 1024 * 1024)
#define WT_PQ(L) ((size_t)2 * 3200 * 1024 + (size_t)4 * 1024 * 1024 + (size_t)2 * 1536 * 1024 + (size_t)(L) * 2048 * 1024)
#define WT_TOTAL ((size_t)2 * 3200 * 1024 + (size_t)4 * 1024 * 1024 + (size_t)2 * 1536 * 1024 + (size_t)4 * 2048 * 1024)
__device__ __forceinline__ float lshfl(float v, int src) { return __int_as_float(__builtin_amdgcn_ds_bpermute(src << 2, __float_as_int(v))); }
#define SHX(v, m) lshfl((v), lane ^ (m))
#define wave_sum(v) wave_sum_l((v), lane)
#define wave_max(v) wave_max_l((v), lane)
__device__ __forceinline__ float wave_sum_l(float v, int lane) {
#pragma unroll
    for (int o = 32; o > 0; o >>= 1) v += lshfl(v, lane ^ o);
    return v;
}
__device__ __forceinline__ float wave_max_l(float v, int lane) {
#pragma unroll
    for (int o = 32; o > 0; o >>= 1) v = fmaxf(v, lshfl(v, lane ^ o));
    return v;
}

__device__ void cvt_copy_bf16(const float* src, bf16_t* dst, size_t n);
__device__ void quant_rows_i8(const float* src, unsigned char* dst, float* scl, int nrows);
__device__ void ph_prologue(const P& p, float* smem) {
    const int tid = otid(), nb = gridDim.x, bid = blockIdx.x;
    if (bid == 0 && tid < 64) p.ctr[tid] = 0;
    {
        const float4* xs = (const float4*)p.x; const float4* cs = (const float4*)p.ctx; float4* hd = (float4*)p.H;
        const size_t nx = (size_t)NL * DM / 4, nc = (size_t)(NT - NL) * DM / 4;
        for (size_t i = (size_t)bid * 256 + tid; i < nx + nc; i += (size_t)nb * 256) hd[i] = i < nx ? xs[i] : cs[i - nx];
    }
    for (int i = bid * 256 + tid; i < 2048 * 32; i += nb * 256) {
        const int s = i >> 5, d = i & 31;
        const float pos = (d < 16) ? (float)(s >> 6) : (float)(s & 63);
        const float inv = powf(10000.0f, -(float)(d & 15) / 16.0f);
        const float ang = pos * inv;
        p.rope[2 * i] = cosf(ang); p.rope[2 * i + 1] = sinf(ang);
    }
    float* sc = smem;
    float* red = smem + 9 * 1024;
    for (int i = tid; i < 9 * 1024; i += 256) { const int r = i >> 10, k = i & 1023; const float v = r < 8 ? p.c[r * 1024 + k] : p.c_ctx[k]; sc[i] = silu_f(v); }
    __syncthreads();
    for (int item = bid; item < 4 * 96; item += nb) {
        const int L = item / 96, n0 = (item % 96) * 64, tx = tid & 63, kq = tid >> 6;
        float acc[9];
#pragma unroll
        for (int r = 0; r < 9; ++r) acc[r] = 0.f;
        const float* w = p.mod_w + (size_t)L * 1024 * 6144 + n0 + tx;
        for (int k = kq * 256; k < kq * 256 + 256; ++k) {
            const float wv = w[(size_t)k * 6144];
#pragma unroll
            for (int r = 0; r < 9; ++r) acc[r] += sc[r * 1024 + k] * wv;
        }
#pragma unroll
        for (int r = 0; r < 9; ++r) red[(kq * 9 + r) * 64 + tx] = acc[r];
        __syncthreads();
        if (kq == 0) {
#pragma unroll
            for (int r = 0; r < 9; ++r) {
                const float s = red[(0 * 9 + r) * 64 + tx] + red[(1 * 9 + r) * 64 + tx] + red[(2 * 9 + r) * 64 + tx] + red[(3 * 9 + r) * 64 + tx];
                p.modv[((size_t)L * 9 + r) * 6144 + n0 + tx] = s + p.mod_b[L * 6144 + n0 + tx];
            }
        }
        __syncthreads();
    }
    {
        float (*tile)[65] = (float (*)[65])smem;
        for (int item = bid; item < 5440; item += nb) {
            int it = item, mat = 0, N = 0, Npad = 0; const float* src = nullptr; bf16_t* dst = nullptr;
            for (mat = 0; mat < 12; ++mat) {
                if (mat < 2) { N = EVW; Npad = 3200; src = p.ev_w_in + (size_t)mat * DM * EVW; dst = p.WT + WT_EVIN(mat); }
                else if (mat < 4) { N = 1024; Npad = 1024; src = p.ev_w_out + (size_t)(mat - 2) * DM * DM; dst = p.WT + WT_EVOUT(mat - 2); }
                else if (mat < 6) { N = ODW; Npad = ODW; src = p.od_w_in + (size_t)(mat - 4) * DM * ODW; dst = p.WT + WT_ODIN(mat - 4); }
                else if (mat < 8) { N = 1024; Npad = 1024; src = p.od_w_out + (size_t)(mat - 6) * DM * DM; dst = p.WT + WT_ODOUT(mat - 6); }
                else { N = 2048; Npad = 2048; src = p.pr_w_q + (size_t)(mat - 8) * DM * 2048; dst = p.WT + WT_PQ(mat - 8); }
                const int nt = 16 * (Npad / 64);
                if (it < nt) break;
                it -= nt;
            }
            const int k0 = (it & 15) * 64, n0 = (it >> 4) * 64;
            __syncthreads();
#pragma unroll
            for (int rep = 0; rep < 4; ++rep) {
                const int i = (tid >> 4) + 16 * rep, c4 = (tid & 15) * 4;
                float4 v = make_float4(0.f, 0.f, 0.f, 0.f);
                int sc = n0 + c4;
                if (mat < 2) sc = sc < 1536 ? sc : (sc < 3072 ? sc + 16 : (sc < 3088 ? sc - 3072 + 1536 : N));
                if (sc < N) v = *(const float4*)(src + (size_t)(k0 + i) * N + sc);
                tile[i][c4] = v.x; tile[i][c4 + 1] = v.y; tile[i][c4 + 2] = v.z; tile[i][c4 + 3] = v.w;
            }
            __syncthreads();
            {
                const int n = tid >> 2, kq = (tid & 3) * 16;
                unsigned w[8];
#pragma unroll
                for (int e = 0; e < 8; ++e) w[e] = cvt_pk_bf16(tile[kq + 2 * e][n], tile[kq + 2 * e + 1][n]);
                uint4* dp = (uint4*)(dst + (size_t)(n0 + n) * DM + k0 + kq);
                dp[0] = make_uint4(w[0], w[1], w[2], w[3]); dp[1] = make_uint4(w[4], w[5], w[6], w[7]);
            }
        }
    }
    quant_rows_i8(p.pr_u, p.U8, p.USC, 4 * 16384);
    quant_rows_i8(p.pr_v, p.V8, p.VSC, 4 * 16384);
    cvt_copy_bf16(p.pr_keys, p.KB, (size_t)4 * 8 * 2 * 128 * 128);
}

__device__ void cvt_copy_bf16(const float* src, bf16_t* dst, size_t n) {
    const size_t n8 = n / 8;
    for (size_t i = (size_t)blockIdx.x * 256 + otid(); i < n8; i += (size_t)gridDim.x * 256) {
        const float4 a = ((const float4*)src)[2 * i], b = ((const float4*)src)[2 * i + 1];
        ((uint4*)dst)[i] = make_uint4(cvt_pk_bf16(a.x, a.y), cvt_pk_bf16(a.z, a.w), cvt_pk_bf16(b.x, b.y), cvt_pk_bf16(b.z, b.w));
    }
}

__device__ void quant_rows_i8(const float* src, unsigned char* dst, float* scl, int nrows) {
    const int lane = otid() & 63, wid = otid() >> 6;
    for (int r = blockIdx.x * 4 + wid; r < nrows; r += gridDim.x * 4) {
        const float4* sp = (const float4*)(src + (size_t)r * 1024 + lane * 16);
        float4 v[4]; float mx = 0.f;
#pragma unroll
        for (int i = 0; i < 4; ++i) { v[i] = sp[i]; mx = fmaxf(mx, fmaxf(fmaxf(fabsf(v[i].x), fabsf(v[i].y)), fmaxf(fabsf(v[i].z), fabsf(v[i].w)))); }
#pragma unroll
        for (int o = 32; o > 0; o >>= 1) mx = fmaxf(mx, SHX(mx, o));
        const float inv = mx > 0.f ? 127.f / mx : 0.f;
        unsigned w[4];
#pragma unroll
        for (int i = 0; i < 4; ++i) {
            const unsigned b0 = (unsigned)((int)rintf(v[i].x * inv) + 128), b1 = (unsigned)((int)rintf(v[i].y * inv) + 128), b2 = (unsigned)((int)rintf(v[i].z * inv) + 128), b3 = (unsigned)((int)rintf(v[i].w * inv) + 128);
            w[i] = b0 | (b1 << 8) | (b2 << 16) | (b3 << 24);
        }
        *(uint4*)(dst + (size_t)r * 1024 + lane * 16) = make_uint4(w[0], w[1], w[2], w[3]);
        if (lane == 0) scl[r] = mx * (1.f / 127.f);
    }
}

__device__ void ph_normmod(const float* src, const float* g, const float* modv_layer, int shift_off, int scale_off, bf16_t* dst, int nrows) {
    const int lane = otid() & 63, wid = otid() >> 6;
    for (int r = blockIdx.x * 4 + wid; r < nrows; r += gridDim.x * 4) {
        const float4* s4 = (const float4*)(src + (size_t)r * DM);
        float4 v[4]; float ss = 0.f;
#pragma unroll
        for (int i = 0; i < 4; ++i) { v[i] = s4[i * 64 + lane]; ss += v[i].x * v[i].x + v[i].y * v[i].y + v[i].z * v[i].z + v[i].w * v[i].w; }
        ss = wave_sum(ss);
        const float rstd = rsqrtf(ss * (1.0f / DM) + 1e-6f);
        const float* mv = modv_layer + (size_t)modrow(r) * 6144;
        uint2* d2 = (uint2*)(dst + (size_t)r * DM);
#pragma unroll
        for (int i = 0; i < 4; ++i) {
            const int c = (i * 64 + lane) * 4;
            const float4 gg = *(const float4*)(g + c), sh = *(const float4*)(mv + shift_off + c), scl = *(const float4*)(mv + scale_off + c);
            float4 o;
            o.x = v[i].x * rstd * gg.x * (1.f + scl.x) + sh.x; o.y = v[i].y * rstd * gg.y * (1.f + scl.y) + sh.y;
            o.z = v[i].z * rstd * gg.z * (1.f + scl.z) + sh.z; o.w = v[i].w * rstd * gg.w * (1.f + scl.w) + sh.w;
            d2[i * 64 + lane] = make_uint2(cvt_pk_bf16(o.x, o.y), cvt_pk_bf16(o.z, o.w));
        }
    }
}

__device__ void ph_final(const P& p) {
    const int lane = otid() & 63, wid = otid() >> 6;
    for (int r = blockIdx.x * 4 + wid; r < NL; r += gridDim.x * 4) {
        const float4* s4 = (const float4*)(p.H + (size_t)r * DM);
        float4 v[4]; float ss = 0.f;
#pragma unroll
        for (int i = 0; i < 4; ++i) { v[i] = s4[i * 64 + lane]; ss += v[i].x * v[i].x + v[i].y * v[i].y + v[i].z * v[i].z + v[i].w * v[i].w; }
        ss = wave_sum(ss);
        const float rstd = rsqrtf(ss * (1.0f / DM) + 1e-6f);
        float4* d4 = (float4*)(p.out + (size_t)r * DM);
#pragma unroll
        for (int i = 0; i < 4; ++i) {
            const int c = (i * 64 + lane) * 4; const float4 gg = *(const float4*)(p.final_g + c);
            float4 o; o.x = v[i].x * rstd * gg.x; o.y = v[i].y * rstd * gg.y; o.z = v[i].z * rstd * gg.z; o.w = v[i].w * rstd * gg.w;
            d4[i * 64 + lane] = o;
        }
    }
}

#define GL_ROWB 144
#define GL_TILEB (128 * GL_ROWB)
struct TokPos { int b, pos, kpos; bool lat; };
__device__ __forceinline__ TokPos tokpos(int row) {
    TokPos t; t.lat = row < NL;
    if (t.lat) { t.b = row >> 11; t.pos = row & 2047; t.kpos = 256 + t.pos; } else { const int r = row - NL; t.b = r >> 8; t.pos = r & 255; t.kpos = t.pos; }
    return t;
}
struct EpiStoreBF16 {
    bf16_t* C; int ldc;
    __device__ __forceinline__ bool swapped(int) const { return false; }
    __device__ __forceinline__ void operator()(const f32x4 (&acc)[4][4], int m0, int n0, int wm, int wn, int fr, int fq) const {
#pragma unroll
        for (int mi = 0; mi < 4; ++mi)
#pragma unroll
            for (int ni = 0; ni < 4; ++ni) {
                const f32x4 v = acc[ni][mi];
                *(uint2*)(C + (size_t)(m0 + wm * 64 + mi * 16 + fr) * ldc + n0 + wn * 64 + ni * 16 + fq * 4) = make_uint2(cvt_pk_bf16(v[0], v[1]), cvt_pk_bf16(v[2], v[3]));
            }
    }
};
struct EpiResid {
    float* H; const float* gate; float scale;
    __device__ __forceinline__ bool swapped(int) const { return false; }
    __device__ __forceinline__ void operator()(const f32x4 (&acc)[4][4], int m0, int n0, int wm, int wn, int fr, int fq) const {
#pragma unroll
        for (int mi = 0; mi < 4; ++mi) {
            const int row = m0 + wm * 64 + mi * 16 + fr;
            const float* gp = gate + (size_t)modrow(row) * 6144;
#pragma unroll
            for (int ni = 0; ni < 4; ++ni) {
                const int col = n0 + wn * 64 + ni * 16 + fq * 4;
                const f32x4 g = *(const f32x4*)(gp + col);
                f32x4* hp = (f32x4*)(H + (size_t)row * DM + col);
                *hp = *hp + g * acc[ni][mi] * scale;
            }
        }
    }
};
__device__ __forceinline__ void rope_store64(const f32x4 (&acc)[4][4], int mi, bool do_rope, const float* ropep  , float scale, bf16_t* dst  , int fq) {
#pragma unroll
    for (int ni = 0; ni < 2; ++ni) {
        f32x4 x1 = acc[ni][mi], x2 = acc[ni + 2][mi];
        if (do_rope) {
            const f32x4 r0 = *(const f32x4*)(ropep + (ni * 16 + fq * 4) * 2), r1 = *(const f32x4*)(ropep + (ni * 16 + fq * 4) * 2 + 4);
            const f32x4 cs = (f32x4){r0[0], r0[2], r1[0], r1[2]}, sn = (f32x4){r0[1], r0[3], r1[1], r1[3]};
            const f32x4 y1 = x1 * cs - x2 * sn, y2 = x1 * sn + x2 * cs;
            x1 = y1; x2 = y2;
        }
        x1 = x1 * scale; x2 = x2 * scale;
        *(uint2*)(dst + ni * 16 + fq * 4) = make_uint2(cvt_pk_bf16(x1[0], x1[1]), cvt_pk_bf16(x1[2], x1[3]));
        *(uint2*)(dst + 32 + ni * 16 + fq * 4) = make_uint2(cvt_pk_bf16(x2[0], x2[1]), cvt_pk_bf16(x2[2], x2[3]));
    }
}
struct EpiEven {
    bf16_t *PB, *AQL, *AQC, *AK, *AV; float* GT; const float* rope;
    __device__ __forceinline__ bool swapped(int n0) const { return n0 >= 2560 && n0 < 3072; }
    __device__ __forceinline__ void operator()(const f32x4 (&acc)[4][4], int m0, int n0, int wm, int wn, int fr, int fq) const {
        const int t = n0 >> 7;
        if (t < 12) {
#pragma unroll
            for (int mi = 0; mi < 4; ++mi)
#pragma unroll
                for (int ni = 0; ni < 4; ++ni) {
                    const f32x4 v = acc[ni][mi];
                    *(uint2*)(PB + (size_t)(m0 + wm * 64 + mi * 16 + fr) * 1536 + n0 + wn * 64 + ni * 16 + fq * 4) = make_uint2(cvt_pk_bf16(v[0], v[1]), cvt_pk_bf16(v[2], v[3]));
                }
        } else if (t < 20) {
            const bool isq = t < 16; const int h = t & 3;
#pragma unroll
            for (int mi = 0; mi < 4; ++mi) {
                const TokPos tp = tokpos(m0 + wm * 64 + mi * 16 + fr);
                const int hm = (tp.b * 4 + h) * 2 + wn;
                bf16_t* dst;
                if (isq) dst = tp.lat ? AQL + ((size_t)hm * 2048 + tp.pos) * 64 : AQC + ((size_t)hm * 256 + tp.pos) * 64;
                else dst = AK + ((size_t)hm * 2304 + tp.kpos) * 64;
                rope_store64(acc, mi, tp.lat, rope + (size_t)tp.pos * 64, isq ? QSCALE : 1.0f, dst, fq);
            }
        } else if (t < 24) {
            const int h = t - 20;
#pragma unroll
            for (int mi = 0; mi < 4; ++mi) {
                const TokPos tp = tokpos(m0 + wm * 64 + mi * 16 + fq * 4);
#pragma unroll
                for (int ni = 0; ni < 4; ++ni) {
                    const f32x4 v = acc[ni][mi];
                    const int d = wn * 64 + ni * 16 + fr;
                    *(uint2*)(AV + ((size_t)(tp.b * 4 + h) * 128 + d) * 2304 + tp.kpos) = make_uint2(cvt_pk_bf16(v[0], v[1]), cvt_pk_bf16(v[2], v[3]));
                }
            }
        } else {
            if (wn == 0) {
#pragma unroll
                for (int mi = 0; mi < 4; ++mi) *(f32x4*)(GT + (size_t)(m0 + wm * 64 + mi * 16 + fr) * 16 + fq * 4) = acc[0][mi];
            }
        }
    }
};
struct EpiOdd {
    bf16_t *AQL, *AQC, *AK, *AV; const float* rope;
    __device__ __forceinline__ bool swapped(int n0) const { return n0 >= 1280; }
    __device__ __forceinline__ void operator()(const f32x4 (&acc)[4][4], int m0, int n0, int wm, int wn, int fr, int fq) const {
        const int t = n0 >> 7;
        if (t < 10) {
            const bool isq = t < 8; const int hd = isq ? t * 2 + wn : (t - 8) * 2 + wn;
#pragma unroll
            for (int mi = 0; mi < 4; ++mi) {
                const TokPos tp = tokpos(m0 + wm * 64 + mi * 16 + fr);
                bf16_t* dst;
                if (isq) dst = tp.lat ? AQL + ((size_t)(tp.b * 16 + hd) * 2048 + tp.pos) * 64 : AQC + ((size_t)(tp.b * 16 + hd) * 256 + tp.pos) * 64;
                else dst = AK + ((size_t)(tp.b * 4 + hd) * 2304 + tp.kpos) * 64;
                rope_store64(acc, mi, tp.lat, rope + (size_t)tp.pos * 64, isq ? QSCALE : 1.0f, dst, fq);
            }
        } else {
            const int hkv = (t - 10) * 2 + wn;
#pragma unroll
            for (int mi = 0; mi < 4; ++mi) {
                const TokPos tp = tokpos(m0 + wm * 64 + mi * 16 + fq * 4);
#pragma unroll
                for (int ni = 0; ni < 4; ++ni) {
                    const f32x4 v = acc[ni][mi];
                    const int d = ni * 16 + fr;
                    *(uint2*)(AV + ((size_t)(tp.b * 4 + hkv) * 64 + d) * 2304 + tp.kpos) = make_uint2(cvt_pk_bf16(v[0], v[1]), cvt_pk_bf16(v[2], v[3]));
                }
            }
        }
    }
};
template <bool SWAP>
__device__ __forceinline__ void gemm_tile_kloop(f32x4 (&acc)[4][4], const bf16_t* aub, const bf16_t* bub, char* smem, int lrow, int lch, int wm, int wn, int fr, int fq) {
    const unsigned voff = (unsigned)(lrow * DM + lch * 8) * 2u;
    uint4 ra0, ra1, ra2, ra3, rb0, rb1, rb2, rb3;
#define GL_LD(BASE, ROWS, KO) (*(const uint4*)((const char*)(BASE) + ((size_t)(ROWS) * DM + (KO)) * 2 + voff))
#define GL_LOAD(KO) { ra0 = GL_LD(aub, 0, KO); ra1 = GL_LD(aub, 32, KO); ra2 = GL_LD(aub, 64, KO); ra3 = GL_LD(aub, 96, KO); rb0 = GL_LD(bub, 0, KO); rb1 = GL_LD(bub, 32, KO); rb2 = GL_LD(bub, 64, KO); rb3 = GL_LD(bub, 96, KO); }
#define GL_STORE(BUF) { char* sa_ = (BUF) + lrow * GL_ROWB + lch * 16; char* sb_ = sa_ + GL_TILEB; \
                        *(uint4*)(sa_) = ra0; *(uint4*)(sa_ + 32 * GL_ROWB) = ra1; *(uint4*)(sa_ + 64 * GL_ROWB) = ra2; *(uint4*)(sa_ + 96 * GL_ROWB) = ra3; \
                        *(uint4*)(sb_) = rb0; *(uint4*)(sb_ + 32 * GL_ROWB) = rb1; *(uint4*)(sb_ + 64 * GL_ROWB) = rb2; *(uint4*)(sb_ + 96 * GL_ROWB) = rb3; }
    GL_LOAD(0)
    __syncthreads();
    GL_STORE(smem)
    __syncthreads();
    for (int kt = 0; kt < 16; ++kt) {
        char* cur = smem + (kt & 1) * 2 * GL_TILEB;
        char* nxt = smem + ((kt + 1) & 1) * 2 * GL_TILEB;
        if (kt + 1 < 16) GL_LOAD((kt + 1) * 64)
#pragma unroll
        for (int ks = 0; ks < 2; ++ks) {
            bf16x8 af[4], wf[4];
#pragma unroll
            for (int i = 0; i < 4; ++i) {
                af[i] = *(const bf16x8*)(cur + (wm * 64 + i * 16 + fr) * GL_ROWB + (ks * 4 + fq) * 16);
                wf[i] = *(const bf16x8*)(cur + GL_TILEB + (wn * 64 + i * 16 + fr) * GL_ROWB + (ks * 4 + fq) * 16);
            }
#pragma unroll
            for (int ni = 0; ni < 4; ++ni)
#pragma unroll
                for (int mi = 0; mi < 4; ++mi)
                    acc[ni][mi] = SWAP ? __builtin_amdgcn_mfma_f32_16x16x32_bf16(af[mi], wf[ni], acc[ni][mi], 0, 0, 0)
                                       : __builtin_amdgcn_mfma_f32_16x16x32_bf16(wf[ni], af[mi], acc[ni][mi], 0, 0, 0);
        }
        if (kt + 1 < 16) GL_STORE(nxt)
        __syncthreads();
    }
#undef GL_LD
#undef GL_LOAD
#undef GL_STORE
}
template <class Epi>
__device__ void ph_gemm(const bf16_t* A, const bf16_t* Bt, int M, int Npad, const Epi& epi, char* smem) {
    const int tid = otid(), lane = tid & 63, wid = tid >> 6, wm = wid >> 1, wn = wid & 1;
    const int fr = lane & 15, fq = lane >> 4;
    const int tm = M / 128, tn = Npad / 128, ntiles = tm * tn;
    const int lrow = tid >> 3, lch = tid & 7;
    for (int tile = blockIdx.x; tile < ntiles; tile += gridDim.x) {
        const int m0 = (tile % tm) * 128, n0 = (tile / tm) * 128;
        f32x4 acc[4][4];
#pragma unroll
        for (int a = 0; a < 4; ++a)
#pragma unroll
            for (int b = 0; b < 4; ++b) acc[a][b] = (f32x4){0.f, 0.f, 0.f, 0.f};
        const bf16_t* ap = A + (size_t)m0 * DM;
        const bf16_t* bp = Bt + (size_t)n0 * DM;
        if (epi.swapped(n0)) gemm_tile_kloop<true>(acc, ap, bp, smem, lrow, lch, wm, wn, fr, fq);
        else gemm_tile_kloop<false>(acc, ap, bp, smem, lrow, lch, wm, wn, fr, fq);
        int fr2 = fr, fq2 = fq, wm2 = wm, wn2 = wn;
        asm volatile("" : "+v"(fr2), "+v"(fq2), "+v"(wm2), "+v"(wn2));
        epi(acc, m0, n0, wm2, wn2, fr2, fq2);
    }
}

__device__ void ph_prep_even(const P& p, int j) {
    const float* cw = p.ev_conv_w + (size_t)j * 3 * 512; const float* cb = p.ev_conv_b + (size_t)j * 512;
    const size_t tot = (size_t)NT * 256;
    for (size_t i = (size_t)blockIdx.x * 256 + otid(); i < tot; i += (size_t)gridDim.x * 256) {
        const int r = (int)(i >> 8), c = (int)(i & 255) * 2;
        int t, T; if (r < NL) { t = r & 2047; T = 2048; } else { t = (r - NL) & 255; T = 256; }
        const unsigned x1 = *(const unsigned*)(p.PB + (size_t)r * 1536 + c);
        float v0 = cb[c] + bf_lo(x1) * cw[512 + c], v1 = cb[c + 1] + bf_hi(x1) * cw[512 + c + 1];
        if (t > 0) { const unsigned x0 = *(const unsigned*)(p.PB + (size_t)(r - 1) * 1536 + c); v0 += bf_lo(x0) * cw[c]; v1 += bf_hi(x0) * cw[c + 1]; }
        if (t < T - 1) { const unsigned x2 = *(const unsigned*)(p.PB + (size_t)(r + 1) * 1536 + c); v0 += bf_lo(x2) * cw[1024 + c]; v1 += bf_hi(x2) * cw[1024 + c + 1]; }
        v0 = silu_f(v0); v1 = silu_f(v1);
        if (c >= 256) { v0 *= 0.125f; v1 *= 0.125f; }
        *(unsigned*)(p.QKB + (size_t)r * 512 + c) = cvt_pk_bf16(v0, v1);
    }
}

#define FA_KROW 144
#define FA_VROW 136
__device__ __forceinline__ bf16x8 pack8(float a0, float a1, float a2, float a3, float a4, float a5, float a6, float a7) {
    const u32x4 u = (u32x4){cvt_pk_bf16(a0, a1), cvt_pk_bf16(a2, a3), cvt_pk_bf16(a4, a5), cvt_pk_bf16(a6, a7)};
    return __builtin_bit_cast(bf16x8, u);
}
template <int NDB, bool MASK>
__device__ __forceinline__ void flash_tile(const bf16x8 (&qf)[4], f32x16 (&o)[NDB], float& m, float& l, const char* Kl, const char* Vl, int lane, int qpos, int kp0) {
    const int j = lane & 31, h = lane >> 5;
    f32x16 s0, s1;
#pragma unroll
    for (int i = 0; i < 16; ++i) { s0[i] = 0.f; s1[i] = 0.f; }
#pragma unroll
    for (int ks = 0; ks < 4; ++ks) {
        const bf16x8 a0 = *(const bf16x8*)(Kl + j * FA_KROW + (2 * ks + h) * 16);
        const bf16x8 a1 = *(const bf16x8*)(Kl + (32 + j) * FA_KROW + (2 * ks + h) * 16);
        s0 = __builtin_amdgcn_mfma_f32_32x32x16_bf16(a0, qf[ks], s0, 0, 0, 0);
        s1 = __builtin_amdgcn_mfma_f32_32x32x16_bf16(a1, qf[ks], s1, 0, 0, 0);
    }
    if (MASK) {
#pragma unroll
        for (int r = 0; r < 16; ++r) {
            const int key = (r & 3) + 8 * (r >> 2) + 4 * h;
            const int d0 = qpos - (kp0 + key), d1 = d0 - 32;
            if (d0 > 128 || d0 < -128) s0[r] = -1e30f;
            if (d1 > 128 || d1 < -128) s1[r] = -1e30f;
        }
    }
    float mx = fmaxf(s0[0], s1[0]);
#pragma unroll
    for (int r = 1; r < 16; ++r) mx = fmaxf(mx, fmaxf(s0[r], s1[r]));
    mx = fmaxf(mx, SHX(mx, 32));
    const float mn = fmaxf(m, mx);
    const float alpha = __builtin_amdgcn_exp2f(m - mn);
    m = mn;
    float ls = 0.f;
#pragma unroll
    for (int r = 0; r < 16; ++r) { s0[r] = __builtin_amdgcn_exp2f(s0[r] - mn); s1[r] = __builtin_amdgcn_exp2f(s1[r] - mn); ls += s0[r] + s1[r]; }
    l = l * alpha + ls;
#pragma unroll
    for (int db = 0; db < NDB; ++db) o[db] = o[db] * alpha;
    bf16x8 pb[4];
    pb[0] = pack8(s0[0], s0[1], s0[2], s0[3], s0[4], s0[5], s0[6], s0[7]);
    pb[1] = pack8(s0[8], s0[9], s0[10], s0[11], s0[12], s0[13], s0[14], s0[15]);
    pb[2] = pack8(s1[0], s1[1], s1[2], s1[3], s1[4], s1[5], s1[6], s1[7]);
    pb[3] = pack8(s1[8], s1[9], s1[10], s1[11], s1[12], s1[13], s1[14], s1[15]);
#pragma unroll
    for (int db = 0; db < NDB; ++db)
#pragma unroll
        for (int kk = 0; kk < 4; ++kk) {
            const char* vp = Vl + (db * 32 + j) * FA_VROW + (kk * 16 + 4 * h) * 2;
            const uint2 lo = *(const uint2*)vp, hi = *(const uint2*)(vp + 16);
            const u32x4 u = (u32x4){lo.x, lo.y, hi.x, hi.y};
            o[db] = __builtin_amdgcn_mfma_f32_32x32x16_bf16(__builtin_bit_cast(bf16x8, u), pb[kk], o[db], 0, 0, 0);
        }
}

#define DA_BUFB 35840
__device__ void da_block(const P& p, int item, int L, int j, char* smem) {
    const int tid = otid(), lane = tid & 63, wid = tid >> 6, mp = wid & 1, qg = wid >> 1, jq = lane & 31, hh = lane >> 5;
    const bool lat = item < 1024;
    int b, h, qt;
    if (lat) { b = item >> 7; h = (item >> 5) & 3; qt = item & 31; } else { const int it = item - 1024; b = it >> 4; h = (it >> 2) & 3; qt = it & 3; }
    const int qi = qt * 64 + qg * 32 + jq;
    const bf16_t* qp = lat ? p.AQL + ((size_t)((b * 4 + h) * 2 + mp) * 2048 + qi) * 64 : p.AQC + ((size_t)((b * 4 + h) * 2 + mp) * 256 + qi) * 64;
    bf16x8 qf[4];
#pragma unroll
    for (int ks = 0; ks < 4; ++ks) qf[ks] = *(const bf16x8*)(qp + (2 * ks + hh) * 8);
    const int ntile = lat ? 36 : 4;
    const bf16_t* kg = p.AK + (size_t)((b * 4 + h) * 2) * 2304 * 64 + (size_t)(tid >> 3) * 64 + (tid & 7) * 8;
    const bf16_t* vg = p.AV + (size_t)(b * 4 + h) * 128 * 2304 + (size_t)(tid >> 3) * 2304 + (tid & 7) * 8;
    uint4 k0, k1, k2, k3, v0, v1, v2, v3;
#define DA_LOAD(KEY0) { k0 = *(const uint4*)(kg + (size_t)(KEY0) * 64); k1 = *(const uint4*)(kg + (size_t)((KEY0) + 32) * 64); \
                        k2 = *(const uint4*)(kg + (size_t)2304 * 64 + (size_t)(KEY0) * 64); k3 = *(const uint4*)(kg + (size_t)2304 * 64 + (size_t)((KEY0) + 32) * 64); \
                        v0 = *(const uint4*)(vg + (KEY0)); v1 = *(const uint4*)(vg + (size_t)32 * 2304 + (KEY0)); v2 = *(const uint4*)(vg + (size_t)64 * 2304 + (KEY0)); v3 = *(const uint4*)(vg + (size_t)96 * 2304 + (KEY0)); }
#define DA_STORE(BUF) { char* kb_ = (BUF) + (tid >> 3) * FA_KROW + (tid & 7) * 16; \
                        *(uint4*)kb_ = k0; *(uint4*)(kb_ + 32 * FA_KROW) = k1; *(uint4*)(kb_ + 64 * FA_KROW) = k2; *(uint4*)(kb_ + 96 * FA_KROW) = k3; \
                        char* vb_ = (BUF) + 18432 + (tid >> 3) * FA_VROW + (tid & 7) * 16; \
                        *(uint2*)vb_ = make_uint2(v0.x, v0.y); *(uint2*)(vb_ + 8) = make_uint2(v0.z, v0.w); \
                        *(uint2*)(vb_ + 32 * FA_VROW) = make_uint2(v1.x, v1.y); *(uint2*)(vb_ + 32 * FA_VROW + 8) = make_uint2(v1.z, v1.w); \
                        *(uint2*)(vb_ + 64 * FA_VROW) = make_uint2(v2.x, v2.y); *(uint2*)(vb_ + 64 * FA_VROW + 8) = make_uint2(v2.z, v2.w); \
                        *(uint2*)(vb_ + 96 * FA_VROW) = make_uint2(v3.x, v3.y); *(uint2*)(vb_ + 96 * FA_VROW + 8) = make_uint2(v3.z, v3.w); }
    f32x16 o[4];
#pragma unroll
    for (int db = 0; db < 4; ++db)
#pragma unroll
        for (int i = 0; i < 16; ++i) o[db][i] = 0.f;
    float m = -1e30f, l = 0.f;
    DA_LOAD(0)
    __syncthreads();
    DA_STORE(smem)
    __syncthreads();
    for (int t = 0; t < ntile; ++t) {
        char* cur = smem + (t & 1) * DA_BUFB;
        char* nxt = smem + ((t + 1) & 1) * DA_BUFB;
        if (t + 1 < ntile) DA_LOAD((t + 1) * 64)
        flash_tile<4, false>(qf, o, m, l, cur + mp * 9216, cur + 18432, lane, 0, 0);
        if (t + 1 < ntile) DA_STORE(nxt)
        __syncthreads();
    }
#undef DA_LOAD
#undef DA_STORE
    const float inv = 1.f / (l + SHX(l, 32));
#pragma unroll
    for (int db = 0; db < 4; ++db) o[db] = o[db] * inv;
    float* X = (float*)smem + qg * 4096;
    if (mp == 1) {
#pragma unroll
        for (int db = 0; db < 4; ++db)
#pragma unroll
            for (int r = 0; r < 16; ++r) X[(db * 32 + (r & 3) + 8 * (r >> 2) + 4 * hh) * 32 + jq] = o[db][r];
    }
    __syncthreads();
    if (mp == 0) {
        const float lam_init = 0.8f - 0.6f * expf(-0.3f * (float)L);
        const float* lp = p.ev_da_lam + (size_t)j * 256;
        float a0 = lp[lane] * lp[64 + lane], a1 = lp[128 + lane] * lp[192 + lane];
        a0 = wave_sum(a0); a1 = wave_sum(a1);
        const float lam = expf(a0) - expf(a1) + lam_init;
        float ss = 0.f;
#pragma unroll
        for (int db = 0; db < 4; ++db)
#pragma unroll
            for (int r = 0; r < 16; ++r) { const float v = o[db][r] - lam * X[(db * 32 + (r & 3) + 8 * (r >> 2) + 4 * hh) * 32 + jq]; o[db][r] = v; ss += v * v; }
        ss += SHX(ss, 32);
        const float sc = rsqrtf(ss * (1.f / 128.f) + 1e-6f) * (1.f - lam_init);
        const int row = lat ? b * 2048 + qi : NL + b * 256 + qi;
        bf16_t* mrow = p.MIX + (size_t)row * DM + 512 + h * 128;
        const float* g = p.ev_da_g + (size_t)j * 512 + h * 128;
#pragma unroll
        for (int db = 0; db < 4; ++db)
#pragma unroll
            for (int r4 = 0; r4 < 4; ++r4) {
                const int d = db * 32 + 8 * r4 + 4 * hh;
                const f32x4 gg = *(const f32x4*)(g + d);
                *(uint2*)(mrow + d) = make_uint2(cvt_pk_bf16(o[db][r4 * 4 + 0] * sc * gg[0], o[db][r4 * 4 + 1] * sc * gg[1]), cvt_pk_bf16(o[db][r4 * 4 + 2] * sc * gg[2], o[db][r4 * 4 + 3] * sc * gg[3]));
            }
    }
    __syncthreads();
}

#define WA_BUFB 17920
__device__ void wa_block(const P& p, int item, int j, char* smem) {
    const int tid = otid(), lane = tid & 63, wid = tid >> 6, jq = lane & 31, hh = lane >> 5;
    const bool lat = item < 2048;
    int b, nb, hq;
    if (lat) { hq = item & 15; nb = (item >> 4) & 15; b = item >> 8; } else { const int it = item - 2048; hq = it & 15; nb = (it >> 4) & 1; b = it >> 5; }
    const int hkv = hq >> 2;
    const int qi = nb * 128 + wid * 32 + jq;
    const bf16_t* qp = lat ? p.AQL + ((size_t)(b * 16 + hq) * 2048 + qi) * 64 : p.AQC + ((size_t)(b * 16 + hq) * 256 + qi) * 64;
    bf16x8 qf[4];
#pragma unroll
    for (int ks = 0; ks < 4; ++ks) qf[ks] = *(const bf16x8*)(qp + (2 * ks + hh) * 8);
    const int lfirst = (nb == 0) ? 2 : 0, nloc = lat ? 6 - lfirst - ((nb == 15) ? 2 : 0) : 0;
    const int ntile = 4 + nloc;
    const bf16_t* kg = p.AK + (size_t)(b * 4 + hkv) * 2304 * 64 + (size_t)(tid >> 3) * 64 + (tid & 7) * 8;
    const bf16_t* vg = p.AV + (size_t)(b * 4 + hkv) * 64 * 2304 + (size_t)(tid >> 3) * 2304 + (tid & 7) * 8;
    uint4 k0, k1, v0, v1;
#define WA_KEY0(T) ((T) < 4 ? (T) * 64 : 256 + (nb - 1) * 128 + ((T) - 4 + lfirst) * 64)
#define WA_LOAD(KEY0) { k0 = *(const uint4*)(kg + (size_t)(KEY0) * 64); k1 = *(const uint4*)(kg + (size_t)((KEY0) + 32) * 64); v0 = *(const uint4*)(vg + (KEY0)); v1 = *(const uint4*)(vg + (size_t)32 * 2304 + (KEY0)); }
#define WA_STORE(BUF) { char* kb_ = (BUF) + (tid >> 3) * FA_KROW + (tid & 7) * 16; *(uint4*)kb_ = k0; *(uint4*)(kb_ + 32 * FA_KROW) = k1; \
                        char* vb_ = (BUF) + 9216 + (tid >> 3) * FA_VROW + (tid & 7) * 16; \
                        *(uint2*)vb_ = make_uint2(v0.x, v0.y); *(uint2*)(vb_ + 8) = make_uint2(v0.z, v0.w); \
                        *(uint2*)(vb_ + 32 * FA_VROW) = make_uint2(v1.x, v1.y); *(uint2*)(vb_ + 32 * FA_VROW + 8) = make_uint2(v1.z, v1.w); }
    f32x16 o[2];
#pragma unroll
    for (int db = 0; db < 2; ++db)
#pragma unroll
        for (int i = 0; i < 16; ++i) o[db][i] = 0.f;
    float m = p.od_sink[j * 16 + hq] * 1.4426950408889634f, l = hh == 0 ? 1.f : 0.f;
    { const int key0 = WA_KEY0(0); WA_LOAD(key0) }
    __syncthreads();
    WA_STORE(smem)
    __syncthreads();
    for (int t = 0; t < ntile; ++t) {
        char* cur = smem + (t & 1) * WA_BUFB;
        char* nxt = smem + ((t + 1) & 1) * WA_BUFB;
        if (t + 1 < ntile) { const int key0 = WA_KEY0(t + 1); WA_LOAD(key0) }
        if (t < 4) flash_tile<2, false>(qf, o, m, l, cur, cur + 9216, lane, 0, 0);
        else flash_tile<2, true>(qf, o, m, l, cur, cur + 9216, lane, qi, WA_KEY0(t) - 256);
        if (t + 1 < ntile) WA_STORE(nxt)
        __syncthreads();
    }
#undef WA_LOAD
#undef WA_STORE
#undef WA_KEY0
    const float inv = 1.f / (l + SHX(l, 32));
    const int row = lat ? b * 2048 + qi : NL + b * 256 + qi;
    bf16_t* mrow = p.MIX + (size_t)row * DM + hq * 64;
#pragma unroll
    for (int db = 0; db < 2; ++db)
#pragma unroll
        for (int r4 = 0; r4 < 4; ++r4) {
            const int d = db * 32 + 8 * r4 + 4 * hh;
            *(uint2*)(mrow + d) = make_uint2(cvt_pk_bf16(o[db][r4 * 4 + 0] * inv, o[db][r4 * 4 + 1] * inv), cvt_pk_bf16(o[db][r4 * 4 + 2] * inv, o[db][r4 * 4 + 3] * inv));
        }
}

__device__ __forceinline__ int ml_row(int b, int tc, int i) { return tc < 4 ? NL + b * 256 + tc * 64 + i : b * 2048 + (tc - 4) * 64 + i; }
__device__ __forceinline__ void ml_gates(const P& p, int j, int b, int h, int dir, int tc, int lane, float* sa, float* sb, float* sml, float& Bt, float& Mc) {
    const int row = ml_row(b, tc, lane);
    const float ig = p.GT[(size_t)row * 16 + (dir * 2) * 4 + h] + p.ev_gate_b[j * 16 + (dir * 2) * 4 + h];
    const float lf = log_sigmoid_f(p.GT[(size_t)row * 16 + (dir * 2 + 1) * 4 + h] + p.ev_gate_b[j * 16 + (dir * 2 + 1) * 4 + h]);
    float bc = lf;
    if (dir == 0) {
#pragma unroll
        for (int o = 1; o < 64; o <<= 1) { const float t2 = lshfl(bc, lane - o); if (lane >= o) bc += t2; }
    } else {
#pragma unroll
        for (int o = 1; o < 64; o <<= 1) { const float t2 = lshfl(bc, lane + o); if (lane + o < 64) bc += t2; }
    }
    const float a = ig - bc;
    float ml = a;
    if (dir == 0) {
#pragma unroll
        for (int o = 1; o < 64; o <<= 1) { const float t2 = lshfl(ml, lane - o); if (lane >= o) ml = fmaxf(ml, t2); }
    } else {
#pragma unroll
        for (int o = 1; o < 64; o <<= 1) { const float t2 = lshfl(ml, lane + o); if (lane + o < 64) ml = fmaxf(ml, t2); }
    }
    sa[lane] = a; sb[lane] = bc; sml[lane] = ml;
    const int last = dir == 0 ? 63 : 0;
    Bt = lshfl(bc, last); Mc = lshfl(ml, last);
}
__device__ __forceinline__ int ml_tc_of(int dir, int c) { return dir == 0 ? c : (c < 4 ? 3 - c : 39 - c); }
__device__ __forceinline__ int ml_c_of(int dir, int tc) { return dir == 0 ? tc : (tc < 4 ? 3 - tc : 39 - tc); }

__device__ void ml_pass1_item(const P& p, int item, int j, char* smem) {
    const int c = item % 36, dir = (item / 36) & 1, h = (item / 72) & 3, b = item / 288;
    const int tc = ml_tc_of(dir, c);
    const int tid = otid(), lane = tid & 63, wid = tid >> 6, jl = lane & 31, hh = lane >> 5;
    bf16_t* VT = (bf16_t*)smem;
    bf16_t* KWT = (bf16_t*)(smem + 18432);
    float* sa = (float*)(smem + 27648);
    float* sb = sa + 64; float* sml = sb + 64; float* sw = sml + 64; float* ssc = sw + 64;
    __syncthreads();
    if (wid == 0) {
        float Bt, Mc; ml_gates(p, j, b, h, dir, tc, lane, sa, sb, sml, Bt, Mc);
        sw[lane] = expf(sa[lane] - Mc);
        if (lane == 0) { p.CHB[item] = Bt; p.CHM[item] = Mc; }
    }
    __syncthreads();
#pragma unroll
    for (int i = 0; i < 4; ++i) {
        const int e = tid + 256 * i, st = e >> 4, ch = e & 15;
        const uint4 u = *(const uint4*)(p.PB + (size_t)ml_row(b, tc, st) * 1536 + 512 + h * 128 + ch * 8);
        bf16_t* d = VT + (ch * 8) * 72 + st;
        d[0] = (bf16_t)u.x; d[72] = (bf16_t)(u.x >> 16); d[144] = (bf16_t)u.y; d[216] = (bf16_t)(u.y >> 16);
        d[288] = (bf16_t)u.z; d[360] = (bf16_t)(u.z >> 16); d[432] = (bf16_t)u.w; d[504] = (bf16_t)(u.w >> 16);
    }
#pragma unroll
    for (int i = 0; i < 2; ++i) {
        const int e = tid + 256 * i, st = e >> 3, ch = e & 7;
        const uint4 u = *(const uint4*)(p.QKB + (size_t)ml_row(b, tc, st) * 512 + 256 + h * 64 + ch * 8);
        const float w = sw[st];
        bf16_t* d = KWT + (ch * 8) * 72 + st;
        const unsigned q0 = cvt_pk_bf16(bf_lo(u.x) * w, bf_hi(u.x) * w), q1 = cvt_pk_bf16(bf_lo(u.y) * w, bf_hi(u.y) * w), q2 = cvt_pk_bf16(bf_lo(u.z) * w, bf_hi(u.z) * w), q3 = cvt_pk_bf16(bf_lo(u.w) * w, bf_hi(u.w) * w);
        d[0] = (bf16_t)q0; d[72] = (bf16_t)(q0 >> 16); d[144] = (bf16_t)q1; d[216] = (bf16_t)(q1 >> 16);
        d[288] = (bf16_t)q2; d[360] = (bf16_t)(q2 >> 16); d[432] = (bf16_t)q3; d[504] = (bf16_t)(q3 >> 16);
    }
    __syncthreads();
    {
        const int db = wid & 1, vb0 = (wid >> 1) * 2;
        bf16x8 kf[4];
#pragma unroll
        for (int ks = 0; ks < 4; ++ks) kf[ks] = *(const bf16x8*)((const char*)KWT + (db * 32 + jl) * 144 + (2 * ks + hh) * 16);
        float* cl = p.CLOC + (size_t)item * 8192;
#pragma unroll
        for (int vv = 0; vv < 2; ++vv) {
            const int vb = vb0 + vv;
            f32x16 acc;
#pragma unroll
            for (int r = 0; r < 16; ++r) acc[r] = 0.f;
#pragma unroll
            for (int ks = 0; ks < 4; ++ks) {
                const bf16x8 vf = *(const bf16x8*)((const char*)VT + (vb * 32 + jl) * 144 + (2 * ks + hh) * 16);
                acc = __builtin_amdgcn_mfma_f32_32x32x16_bf16(vf, kf[ks], acc, 0, 0, 0);
            }
#pragma unroll
            for (int r = 0; r < 16; ++r) cl[(size_t)(vb * 32 + (r & 3) + 8 * (r >> 2) + 4 * hh) * 64 + db * 32 + jl] = acc[r];
        }
        if (tid < 64) {
            float sum = 0.f;
#pragma unroll
            for (int q = 0; q < 8; ++q) { const uint4 u = *(const uint4*)((const char*)KWT + tid * 144 + q * 16); sum += bf_lo(u.x) + bf_hi(u.x) + bf_lo(u.y) + bf_hi(u.y) + bf_lo(u.z) + bf_hi(u.z) + bf_lo(u.w) + bf_hi(u.w); }
            p.NLOC[(size_t)item * 64 + tid] = sum;
        }
    }
}

__device__ void ph_ml_pass2(const P& p) {
    const int gt = blockIdx.x * 256 + otid(), nthr = gridDim.x * 256;
    for (int w = gt; w < 64 * 2048; w += nthr) {
        const int chain = w >> 11, e = (w & 2047) * 4;
        float c0 = 0.f, c1 = 0.f, c2 = 0.f, c3 = 0.f, m = 0.f;
        for (int c = 0; c < 36; ++c) {
            const int it = chain * 36 + c;
            *(uint2*)(p.CST + (size_t)it * 8192 + e) = make_uint2(cvt_pk_bf16(c0, c1), cvt_pk_bf16(c2, c3));
            const float Bt = p.CHB[it], Mc = p.CHM[it];
            const float g = fmaxf(m, Mc), al = expf(m - g), be = expf(Mc - g);
            const float4 cl = *(const float4*)(p.CLOC + (size_t)it * 8192 + e);
            c0 = al * c0 + be * cl.x; c1 = al * c1 + be * cl.y; c2 = al * c2 + be * cl.z; c3 = al * c3 + be * cl.w;
            m = Bt + g;
        }
    }
    for (int w = gt; w < 64 * 64; w += nthr) {
        const int chain = w >> 6, d = w & 63;
        float n = 0.f, m = 0.f;
        for (int c = 0; c < 36; ++c) {
            const int it = chain * 36 + c;
            p.NST[(size_t)it * 64 + d] = n;
            if (d == 0) p.MST[it] = m;
            const float Bt = p.CHB[it], Mc = p.CHM[it];
            const float g = fmaxf(m, Mc);
            n = expf(m - g) * n + expf(Mc - g) * p.NLOC[(size_t)it * 64 + d];
            m = Bt + g;
        }
    }
}

__device__ void ml_pass3_item(const P& p, int item, int j, char* smem) {
    const int tc = item % 36, h = (item / 36) & 3, b = item / 144;
    const int tid = otid(), lane = tid & 63, wid = tid >> 6, jl = lane & 31, hh = lane >> 5, tb = wid & 1, dir = wid >> 1;
    char* Ql = smem;
    char* Kl = smem + 9216;
    bf16_t* VT = (bf16_t*)(smem + 18432);
    float* gs = (float*)(smem + 35840);
    float* ssc = gs + 512;
    __syncthreads();
    if (wid < 2) {
        const int d2 = wid; float Bt, Mc;
        float* sa = gs + d2 * 256; float* sb = sa + 64; float* sg = sb + 64; float* sn = sg + 64;
        ml_gates(p, j, b, h, d2, tc, lane, sa, sb, sg, Bt, Mc);
        const int sidx = ((b * 4 + h) * 2 + d2) * 36 + ml_c_of(d2, tc);
        const float mst = p.MST[sidx];
        sg[lane] = fmaxf(mst, sg[lane]);
        sn[lane] = p.NST[(size_t)sidx * 64 + lane];
        if (lane == 0) ssc[d2] = mst;
    }
#pragma unroll
    for (int i = 0; i < 2; ++i) {
        const int e = tid + 256 * i, st = e >> 3, ch = e & 7; const int row = ml_row(b, tc, st);
        *(uint4*)(Ql + st * 144 + ch * 16) = *(const uint4*)(p.QKB + (size_t)row * 512 + h * 64 + ch * 8);
        *(uint4*)(Kl + st * 144 + ch * 16) = *(const uint4*)(p.QKB + (size_t)row * 512 + 256 + h * 64 + ch * 8);
    }
#pragma unroll
    for (int i = 0; i < 4; ++i) {
        const int e = tid + 256 * i, st = e >> 4, ch = e & 15;
        const uint4 u = *(const uint4*)(p.PB + (size_t)ml_row(b, tc, st) * 1536 + 512 + h * 128 + ch * 8);
        bf16_t* d = VT + (ch * 8) * 68 + st;
        d[0] = (bf16_t)u.x; d[68] = (bf16_t)(u.x >> 16); d[136] = (bf16_t)u.y; d[204] = (bf16_t)(u.y >> 16);
        d[272] = (bf16_t)u.z; d[340] = (bf16_t)(u.z >> 16); d[408] = (bf16_t)u.w; d[476] = (bf16_t)(u.w >> 16);
    }
    __syncthreads();
    const float* sa = gs + dir * 256; const float* sb = sa + 64; const float* sg = sb + 64; const float* sn = sg + 64;
    const int t = tb * 32 + jl;
    const float gtv = sg[t], btv = sb[t], mst = ssc[dir];
    const float e2 = expf(mst - gtv);
    const int sidx = ((b * 4 + h) * 2 + dir) * 36 + ml_c_of(dir, tc);
    bf16x8 qf[4];
#pragma unroll
    for (int ks = 0; ks < 4; ++ks) qf[ks] = *(const bf16x8*)(Ql + t * 144 + (2 * ks + hh) * 16);
    f32x16 acc[4];
    {
        const bf16_t* cst = p.CST + (size_t)sidx * 8192 + (size_t)jl * 64 + hh * 8;
#pragma unroll
        for (int vb = 0; vb < 4; ++vb) {
#pragma unroll
            for (int r = 0; r < 16; ++r) acc[vb][r] = 0.f;
#pragma unroll
            for (int ks = 0; ks < 4; ++ks) {
                const bf16x8 cf = *(const bf16x8*)(cst + (size_t)vb * 32 * 64 + ks * 16);
                acc[vb] = __builtin_amdgcn_mfma_f32_32x32x16_bf16(cf, qf[ks], acc[vb], 0, 0, 0);
            }
            acc[vb] = acc[vb] * e2;
        }
    }
    float den = 0.f;
    {
        float nq = 0.f;
#pragma unroll
        for (int ks = 0; ks < 4; ++ks) {
            const u32x4 u = __builtin_bit_cast(u32x4, qf[ks]);
            const float* np = sn + 16 * ks + 8 * hh;
            nq += bf_lo(u[0]) * np[0] + bf_hi(u[0]) * np[1] + bf_lo(u[1]) * np[2] + bf_hi(u[1]) * np[3] + bf_lo(u[2]) * np[4] + bf_hi(u[2]) * np[5] + bf_lo(u[3]) * np[6] + bf_hi(u[3]) * np[7];
        }
        den = e2 * nq;
    }
#pragma unroll
    for (int sbk = 0; sbk < 2; ++sbk) {
        const bool use = dir == 0 ? (sbk <= tb) : (sbk >= tb);
        if (use) {
            f32x16 sc;
#pragma unroll
            for (int r = 0; r < 16; ++r) sc[r] = 0.f;
#pragma unroll
            for (int ks = 0; ks < 4; ++ks) {
                const bf16x8 kf = *(const bf16x8*)(Kl + (sbk * 32 + jl) * 144 + (2 * ks + hh) * 16);
                sc = __builtin_amdgcn_mfma_f32_32x32x16_bf16(kf, qf[ks], sc, 0, 0, 0);
            }
#pragma unroll
            for (int r4 = 0; r4 < 4; ++r4) {
                const int s0 = sbk * 32 + 8 * r4 + 4 * hh;
                const f32x4 av = *(const f32x4*)(sa + s0);
#pragma unroll
                for (int q = 0; q < 4; ++q) {
                    const int s2 = s0 + q;
                    const bool ok = dir == 0 ? (s2 <= t) : (s2 >= t);
                    const float pv = ok ? sc[r4 * 4 + q] * expf(av[q] - gtv) : 0.f;
                    sc[r4 * 4 + q] = pv; den += pv;
                }
            }
            bf16x8 pb[2];
            pb[0] = pack8(sc[0], sc[1], sc[2], sc[3], sc[4], sc[5], sc[6], sc[7]);
            pb[1] = pack8(sc[8], sc[9], sc[10], sc[11], sc[12], sc[13], sc[14], sc[15]);
#pragma unroll
            for (int vb = 0; vb < 4; ++vb)
#pragma unroll
                for (int k2 = 0; k2 < 2; ++k2) {
                    const char* vp = (const char*)VT + (vb * 32 + jl) * 136 + (sbk * 32 + k2 * 16 + 4 * hh) * 2;
                    const uint2 lo = *(const uint2*)vp, hi = *(const uint2*)(vp + 16);
                    const u32x4 u = (u32x4){lo.x, lo.y, hi.x, hi.y};
                    acc[vb] = __builtin_amdgcn_mfma_f32_32x32x16_bf16(__builtin_bit_cast(bf16x8, u), pb[k2], acc[vb], 0, 0, 0);
                }
        }
    }
    den += SHX(den, 32);
    const float scl = 1.f / fmaxf(fabsf(den), expf(-(btv + gtv)));
#pragma unroll
    for (int vb = 0; vb < 4; ++vb) acc[vb] = acc[vb] * scl;
    __syncthreads();
    float* X = (float*)smem + tb * 4096;
    if (dir == 1) {
#pragma unroll
        for (int vb = 0; vb < 4; ++vb)
#pragma unroll
            for (int r = 0; r < 16; ++r) X[(vb * 32 + (r & 3) + 8 * (r >> 2) + 4 * hh) * 32 + jl] = acc[vb][r];
    }
    __syncthreads();
    if (dir == 0) {
        float ss = 0.f;
#pragma unroll
        for (int vb = 0; vb < 4; ++vb)
#pragma unroll
            for (int r = 0; r < 16; ++r) { const float v = acc[vb][r] + X[(vb * 32 + (r & 3) + 8 * (r >> 2) + 4 * hh) * 32 + jl]; acc[vb][r] = v; ss += v * v; }
        ss += SHX(ss, 32);
        const float rstd = rsqrtf(ss * (1.f / 128.f) + 1e-6f);
        const int row = ml_row(b, tc, t);
        const float* g = p.ev_ml_g + (size_t)j * 512 + h * 128;
        const bf16_t* og = p.PB + (size_t)row * 1536 + 1024 + h * 128;
        bf16_t* mrow = p.MIX + (size_t)row * DM + h * 128;
#pragma unroll
        for (int vb = 0; vb < 4; ++vb)
#pragma unroll
            for (int r4 = 0; r4 < 4; ++r4) {
                const int v = vb * 32 + 8 * r4 + 4 * hh;
                const f32x4 gg = *(const f32x4*)(g + v);
                const uint2 ou = *(const uint2*)(og + v);
                *(uint2*)(mrow + v) = make_uint2(cvt_pk_bf16(acc[vb][r4 * 4 + 0] * rstd * gg[0] * sigmoid_f(bf_lo(ou.x)), acc[vb][r4 * 4 + 1] * rstd * gg[1] * sigmoid_f(bf_hi(ou.x))),
                                                 cvt_pk_bf16(acc[vb][r4 * 4 + 2] * rstd * gg[2] * sigmoid_f(bf_lo(ou.y)), acc[vb][r4 * 4 + 3] * rstd * gg[3] * sigmoid_f(bf_hi(ou.y))));
            }
    }
}

__device__ void ph_attn_even(const P& p, int ci, int L, int j, float* smem) {
    int* s_item = (int*)((char*)smem + 73728);
    for (;;) {
        __syncthreads();
        if (otid() == 0) *s_item = atomicAdd(&p.ctr[ci], 1);
        __syncthreads();
        const int item = *s_item;
        if (item >= 1152 + 2304) break;
        if (item < 1152) da_block(p, item, L, j, (char*)smem); else ml_pass1_item(p, item - 1152, j, (char*)smem);
    }
}
__device__ void ph_ml_pass3(const P& p, int j, float* smem) {
    for (int item = blockIdx.x; item < 1152; item += gridDim.x) ml_pass3_item(p, item, j, (char*)smem);
}
__device__ void ph_attn_odd(const P& p, int j, bool need_ctx, float* smem) {
    const int nitem = need_ctx ? 2304 : 2048;
    for (int item = blockIdx.x; item < nitem; item += gridDim.x) { wa_block(p, item, j, (char*)smem); __syncthreads(); }
}

#define SEL_LD 132
__device__ __forceinline__ unsigned fkey(float f) { const unsigned u = __float_as_uint(f); return (u & 0x80000000u) ? ~u : (u | 0x80000000u); }
__device__ __forceinline__ unsigned mbcnt64(unsigned long long m) { return __builtin_amdgcn_mbcnt_hi((unsigned)(m >> 32), __builtin_amdgcn_mbcnt_lo((unsigned)m, 0u)); }
__device__ void ph_peer_select(const P& p, int L, int nrows, char* smem) {
    float* S = (float*)smem;
    const int tid = otid(), lane = tid & 63, wid = tid >> 6, fr = lane & 15, fq = lane >> 4;
    const bf16_t* KBL = p.KB + (size_t)L * 8 * 2 * 128 * 128;
    const int ntile = nrows / 32;
    bf16x8 kfr[8][4];
    int hcur = -1;
    for (int item = blockIdx.x; item < ntile * 8; item += gridDim.x) {
        const int h = item & 7, t0 = (item >> 3) * 32;
        __syncthreads();
        {
            const int pp = wid >> 1, th = wid & 1;
            const bf16_t* qp = p.QB + (size_t)(t0 + th * 16 + fr) * 2048 + h * 256 + pp * 128 + fq * 8;
            bf16x8 qf[4];
#pragma unroll
            for (int ks = 0; ks < 4; ++ks) qf[ks] = *(const bf16x8*)(qp + ks * 32);
            if (h != hcur) {
                const bf16_t* kp = KBL + ((size_t)(h * 2 + pp) * 128 + fr) * 128 + fq * 8;
#pragma unroll
                for (int ni = 0; ni < 8; ++ni)
#pragma unroll
                    for (int ks = 0; ks < 4; ++ks) kfr[ni][ks] = *(const bf16x8*)(kp + (size_t)ni * 16 * 128 + ks * 32);
                hcur = h;
            }
#pragma unroll
            for (int ni = 0; ni < 8; ++ni) {
                f32x4 acc = (f32x4){0.f, 0.f, 0.f, 0.f};
#pragma unroll
                for (int ks = 0; ks < 4; ++ks) acc = __builtin_amdgcn_mfma_f32_16x16x32_bf16(qf[ks], kfr[ni][ks], acc, 0, 0, 0);
#pragma unroll
                for (int j = 0; j < 4; ++j) S[(pp * 32 + th * 16 + fq * 4 + j) * SEL_LD + ni * 16 + fr] = acc[j];
            }
        }
        __syncthreads();
        for (int tt = 0; tt < 8; ++tt) {
            const int t = wid * 8 + tt, r = t0 + t;
            const float v00 = S[t * SEL_LD + lane], v01 = S[t * SEL_LD + 64 + lane], v10 = S[(32 + t) * SEL_LD + lane], v11 = S[(32 + t) * SEL_LD + 64 + lane];
            const unsigned ka0 = fkey(v00), ka1 = fkey(v01), kb0 = fkey(v10), kb1 = fkey(v11);
            unsigned T0 = 0u, T1 = 0u; bool dn0 = false, dn1 = false;
            for (int bit = 31; bit >= 0 && !(dn0 && dn1); --bit) {
                if (!dn0) { const unsigned c0 = T0 | (1u << bit); const int n0 = __builtin_popcountll(__ballot(ka0 >= c0)) + __builtin_popcountll(__ballot(ka1 >= c0)); if (n0 >= 16) T0 = c0; dn0 = (n0 == 16); }
                if (!dn1) { const unsigned c1 = T1 | (1u << bit); const int n1 = __builtin_popcountll(__ballot(kb0 >= c1)) + __builtin_popcountll(__ballot(kb1 >= c1)); if (n1 >= 16) T1 = c1; dn1 = (n1 == 16); }
            }
            float* wsA = (float*)(smem + 34816 + wid * 512);
            {
                const unsigned long long g0 = __ballot(ka0 > T0), g1 = __ballot(ka1 > T0), e0 = __ballot(ka0 == T0), e1 = __ballot(ka1 == T0);
                const int need = 16 - __builtin_popcountll(g0) - __builtin_popcountll(g1);
                const int pe0 = __builtin_popcountll(e0), need1 = need - (pe0 < need ? pe0 : need);
                const bool s0 = (ka0 > T0) || (ka0 == T0 && (int)mbcnt64(e0) < need);
                const bool s1 = (ka1 > T0) || (ka1 == T0 && (int)mbcnt64(e1) < need1);
                const unsigned long long m0 = __ballot(s0), m1 = __ballot(s1);
                if (s0) { const int pos = mbcnt64(m0); wsA[pos] = v00; ((int*)wsA)[16 + pos] = lane; }
                if (s1) { const int pos = __builtin_popcountll(m0) + mbcnt64(m1); wsA[pos] = v01; ((int*)wsA)[16 + pos] = 64 + lane; }
            }
            {
                const unsigned long long g0 = __ballot(kb0 > T1), g1 = __ballot(kb1 > T1), e0 = __ballot(kb0 == T1), e1 = __ballot(kb1 == T1);
                const int need = 16 - __builtin_popcountll(g0) - __builtin_popcountll(g1);
                const int pe0 = __builtin_popcountll(e0), need1 = need - (pe0 < need ? pe0 : need);
                const bool s0 = (kb0 > T1) || (kb0 == T1 && (int)mbcnt64(e0) < need);
                const bool s1 = (kb1 > T1) || (kb1 == T1 && (int)mbcnt64(e1) < need1);
                const unsigned long long m0 = __ballot(s0), m1 = __ballot(s1);
                if (s0) { const int pos = mbcnt64(m0); wsA[32 + pos] = v10; ((int*)wsA)[48 + pos] = lane; }
                if (s1) { const int pos = __builtin_popcountll(m0) + mbcnt64(m1); wsA[32 + pos] = v11; ((int*)wsA)[48 + pos] = 64 + lane; }
            }
            __builtin_amdgcn_wave_barrier();
            float cand[4]; int cidx[4]; unsigned kc[4];
            {
                const float av = wsA[lane >> 2]; const int ai = ((int*)wsA)[16 + (lane >> 2)];
                const float4 bv = *(const float4*)(wsA + 32 + (lane & 3) * 4); const int4 bi = *(const int4*)((int*)wsA + 48 + (lane & 3) * 4);
                cand[0] = av + bv.x; cand[1] = av + bv.y; cand[2] = av + bv.z; cand[3] = av + bv.w;
                cidx[0] = ai * 128 + bi.x; cidx[1] = ai * 128 + bi.y; cidx[2] = ai * 128 + bi.z; cidx[3] = ai * 128 + bi.w;
#pragma unroll
                for (int c = 0; c < 4; ++c) kc[c] = fkey(cand[c]);
            }
            unsigned T = 0u;
            for (int bit = 31; bit >= 0; --bit) {
                const unsigned cc = T | (1u << bit);
                const int n = __builtin_popcountll(__ballot(kc[0] >= cc)) + __builtin_popcountll(__ballot(kc[1] >= cc)) + __builtin_popcountll(__ballot(kc[2] >= cc)) + __builtin_popcountll(__ballot(kc[3] >= cc));
                if (n >= 16) T = cc;
                if (n == 16) break;
            }
            {
                int need = 16, base = 0;
#pragma unroll
                for (int c = 0; c < 4; ++c) need -= __builtin_popcountll(__ballot(kc[c] > T));
#pragma unroll
                for (int c = 0; c < 4; ++c) {
                    const unsigned long long e = __ballot(kc[c] == T);
                    const bool sel = (kc[c] > T) || (kc[c] == T && (int)mbcnt64(e) < need);
                    const int pe = __builtin_popcountll(e); need -= (pe < need ? pe : need);
                    const unsigned long long m = __ballot(sel);
                    if (sel) { const int pos = base + mbcnt64(m); wsA[64 + pos] = cand[c]; ((int*)wsA)[80 + pos] = cidx[c]; }
                    base += __builtin_popcountll(m);
                }
            }
            __builtin_amdgcn_wave_barrier();
            {
                const float cv = lane < 16 ? wsA[64 + lane] : -INFINITY;
                const float mx = wave_max(cv);
                const float ex = lane < 16 ? __builtin_amdgcn_exp2f((cv - mx) * 1.4426950408889634f) : 0.f;
                const float sum = wave_sum(ex);
                if (lane < 16) { p.GATE[(size_t)r * 128 + h * 16 + lane] = ex / sum; p.EIDX[(size_t)r * 128 + h * 16 + lane] = ((int*)wsA)[80 + lane]; }
            }
            __builtin_amdgcn_wave_barrier();
        }
    }
}


__device__ __forceinline__ void unpack8(const uint4 u, float* f) {
    f[0] = bf_lo(u.x); f[1] = bf_hi(u.x); f[2] = bf_lo(u.y); f[3] = bf_hi(u.y); f[4] = bf_lo(u.z); f[5] = bf_hi(u.z); f[6] = bf_lo(u.w); f[7] = bf_hi(u.w);
}
__device__ __forceinline__ void unpack16_u8(const uint4 u, float* f) {
    f[0] = (float)(u.x & 0xffu); f[1] = (float)((u.x >> 8) & 0xffu); f[2] = (float)((u.x >> 16) & 0xffu); f[3] = (float)((u.x >> 24) & 0xffu);
    f[4] = (float)(u.y & 0xffu); f[5] = (float)((u.y >> 8) & 0xffu); f[6] = (float)((u.y >> 16) & 0xffu); f[7] = (float)((u.y >> 24) & 0xffu);
    f[8] = (float)(u.z & 0xffu); f[9] = (float)((u.z >> 8) & 0xffu); f[10] = (float)((u.z >> 16) & 0xffu); f[11] = (float)((u.z >> 24) & 0xffu);
    f[12] = (float)(u.w & 0xffu); f[13] = (float)((u.w >> 8) & 0xffu); f[14] = (float)((u.w >> 16) & 0xffu); f[15] = (float)((u.w >> 24) & 0xffu);
}
__device__ void ph_peer_gather(const P& p, int L, int nrows, float oscale) {
    const int lane = otid() & 63, wid = otid() >> 6;
    const unsigned char* U = p.U8 + (size_t)L * 16384 * 1024; const unsigned char* V = p.V8 + (size_t)L * 16384 * 1024;
    const float* USC = p.USC + (size_t)L * 16384; const float* VSC = p.VSC + (size_t)L * 16384;
    const float* gate2 = p.modv + (size_t)L * 9 * 6144 + 5120;
    for (int r = blockIdx.x * 4 + wid; r < nrows; r += gridDim.x * 4) {
        const int e0 = p.EIDX[(size_t)r * 128 + lane], e1 = p.EIDX[(size_t)r * 128 + 64 + lane];
        const float g0 = p.GATE[(size_t)r * 128 + lane], g1 = p.GATE[(size_t)r * 128 + 64 + lane];
        const float us0 = USC[e0], us1 = USC[e1], vs0 = VSC[e0], vs1 = VSC[e1];
        float x[16];
        { const uint4 xa = *(const uint4*)(p.XN + (size_t)r * DM + lane * 16), xb = *(const uint4*)(p.XN + (size_t)r * DM + lane * 16 + 8); unpack8(xa, x); unpack8(xb, x + 8); }
        float sx = 0.f;
#pragma unroll
        for (int c = 0; c < 16; ++c) sx += x[c];
        sx = wave_sum(sx);
        float a0 = 0.f, a1 = 0.f;
#pragma unroll
        for (int half = 0; half < 2; ++half) {
            const int ev = half ? e1 : e0;
            float av = 0.f;
            for (int kb = 0; kb < 4; ++kb) {
                uint4 ua[16];
#pragma unroll
                for (int j = 0; j < 16; ++j) {
                    const int idx = __builtin_amdgcn_readlane(ev, kb * 16 + j);
                    ua[j] = *(const uint4*)(U + (size_t)idx * 1024 + lane * 16);
                }
#pragma unroll
                for (int j = 0; j < 16; ++j) {
                    float f[16]; unpack16_u8(ua[j], f);
                    float s = 0.f;
#pragma unroll
                    for (int c = 0; c < 16; ++c) s += x[c] * f[c];
                    s = wave_sum(s);
                    if (lane == kb * 16 + j) av = s;
                }
            }
            if (half) a1 = av; else a0 = av;
        }
        a0 = us0 * (a0 - 128.f * sx); a1 = us1 * (a1 - 128.f * sx);
        const float w0 = vs0 * g0 * 0.5f * a0 * (1.f + erff(a0 * 0.70710678118654752f));
        const float w1 = vs1 * g1 * 0.5f * a1 * (1.f + erff(a1 * 0.70710678118654752f));
        const float wsum = wave_sum(w0 + w1);
        float acc[16];
#pragma unroll
        for (int c = 0; c < 16; ++c) acc[c] = 0.f;
#pragma unroll
        for (int half = 0; half < 2; ++half) {
            const int ev = half ? e1 : e0; const int wv = __float_as_int(half ? w1 : w0);
            for (int kb = 0; kb < 4; ++kb) {
                uint4 ua[16];
#pragma unroll
                for (int j = 0; j < 16; ++j) {
                    const int idx = __builtin_amdgcn_readlane(ev, kb * 16 + j);
                    ua[j] = *(const uint4*)(V + (size_t)idx * 1024 + lane * 16);
                }
#pragma unroll
                for (int j = 0; j < 16; ++j) {
                    const float wj = __int_as_float(__builtin_amdgcn_readlane(wv, kb * 16 + j));
                    float f[16]; unpack16_u8(ua[j], f);
#pragma unroll
                    for (int c = 0; c < 16; ++c) acc[c] += wj * f[c];
                }
            }
        }
        const float* gp = gate2 + (size_t)modrow(r) * 6144 + lane * 16;
        float* hp = p.H + (size_t)r * DM + lane * 16;
#pragma unroll
        for (int q = 0; q < 4; ++q) {
            const float4 g = *(const float4*)(gp + q * 4);
            float4 hv = *(float4*)(hp + q * 4);
            hv.x += oscale * g.x * (acc[q * 4 + 0] - 128.f * wsum); hv.y += oscale * g.y * (acc[q * 4 + 1] - 128.f * wsum);
            hv.z += oscale * g.z * (acc[q * 4 + 2] - 128.f * wsum); hv.w += oscale * g.w * (acc[q * 4 + 3] - 128.f * wsum);
            *(float4*)(hp + q * 4) = hv;
        }
    }
}

#define NSUB 11
__device__ __forceinline__ bool phase_empty(int ph) {
    if (ph == 0 || ph == NPH - 1) return false;
    const int L = (ph - 1) / NSUB, s = (ph - 1) % NSUB;
    return (L & 1) && (s == 2 || s == 4 || s == 5);
}
__device__ void run_phase(const P& p, int ph, float* smem, int rep) {
    if (ph == 0) { ph_prologue(p, smem); return; }
    if (ph == NPH - 1) { ph_final(p); return; }
    const int L = (ph - 1) / NSUB, s = (ph - 1) % NSUB, j = L >> 1;
    const bool even = (L & 1) == 0, need_ctx = L < 3;
    const int nrows = need_ctx ? NT : NL;
    const float* mv = p.modv + (size_t)L * 9 * 6144;
    switch (s) {
    case 0: ph_normmod(p.H, p.norm1_g + L * DM, mv, 0, 1024, p.XN, NT); break;
    case 1:
        if (even) ph_gemm(p.XN, p.WT + WT_EVIN(j), NT, 3200, EpiEven{p.PB, p.AQL, p.AQC, p.AK, p.AV, p.GT, p.rope}, (char*)smem);
        else ph_gemm(p.XN, p.WT + WT_ODIN(j), NT, ODW, EpiOdd{p.AQL, p.AQC, p.AK, p.AV, p.rope}, (char*)smem);
        break;
    case 2: if (even) ph_prep_even(p, j); break;
    case 3: if (even) ph_attn_even(p, L + 4 * rep, L, j, smem); else ph_attn_odd(p, j, need_ctx, smem); break;
    case 4: if (even) ph_ml_pass2(p); break;
    case 5: if (even) ph_ml_pass3(p, j, smem); break;
    case 6: ph_gemm(p.MIX, p.WT + (even ? WT_EVOUT(j) : WT_ODOUT(j)), nrows, DM, EpiResid{p.H, mv + 2048, rep ? 0.f : 1.f}, (char*)smem); break;
    case 7: ph_normmod(p.H, p.norm2_g + L * DM, mv, 3072, 4096, p.XN, nrows); break;
    case 8: ph_gemm(p.XN, p.WT + WT_PQ(L), nrows, 2048, EpiStoreBF16{p.QB, 2048}, (char*)smem); break;
    case 9: ph_peer_select(p, L, nrows, (char*)smem); break;
    case 10: ph_peer_gather(p, L, nrows, rep ? 0.f : 1.f); break;
    }
}

#define XB_TMO      128
#define XB_XCNT(j)  (256  + 64 * (j))
#define XB_XSUB(j)  (1280 + 64 * (j))
#define XB_XGEN(j)  (2304 + 64 * (j))
#define XB_TOP      3328
#define XB_TOPGEN   3392
#define XCD_BAR_WORDS 3456
#define XB_SPIN_CAP (1u << 20)
#define LAS __attribute__((address_space(3)))
__device__ __forceinline__ unsigned xb_ld(unsigned* p)              { return __hip_atomic_load(p, __ATOMIC_RELAXED, __HIP_MEMORY_SCOPE_AGENT); }
__device__ __forceinline__ unsigned xb_add(unsigned* p, unsigned v) { return __hip_atomic_fetch_add(p, v, __ATOMIC_RELAXED, __HIP_MEMORY_SCOPE_AGENT); }
__device__ __forceinline__ unsigned xb_xcc_id() { return (unsigned)__builtin_amdgcn_s_getreg((3 << 11) | 20) & 0xFu; }
#define XB_SPIN(cond, bar) do { unsigned _sp = 0; while (cond) { __builtin_amdgcn_s_sleep(1); \
    if ((++_sp & 255u) == 0u) { if (xb_ld(&(bar)[XB_TMO])) break; if (_sp > XB_SPIN_CAP) { atomicAdd(&(bar)[XB_TMO], 1u); break; } } } } while (0)
struct XcdBarrier { unsigned* bar; unsigned x; volatile LAS unsigned* st; };
__device__ __forceinline__ XcdBarrier xcd_barrier_post(unsigned* bar, volatile LAS unsigned* st) {
    XcdBarrier b; b.bar = bar; b.x = xb_xcc_id(); b.st = st;
    if (threadIdx.x == 0) (void)xb_add(&bar[XB_XCNT(b.x)], 1u);
    return b;
}
__device__ __forceinline__ void xcd_barrier_complete(unsigned* bar, unsigned x, unsigned& nloc, unsigned& nx) {
    const unsigned G = gridDim.x * gridDim.y * gridDim.z;
    unsigned sum, cnt, mine, sp = 0u;
    for (;;) {
        sum = 0u; cnt = 0u; mine = 0u;
#pragma unroll
        for (unsigned j = 0; j < 16; ++j) { const unsigned c = xb_ld(&bar[XB_XCNT(j)]); sum += c; cnt += (c > 0u) ? 1u : 0u; mine = (j == x) ? c : mine; }
        if (sum == G) break;
        __builtin_amdgcn_s_sleep(1);
        if ((++sp & 255u) == 0u) { if (xb_ld(&bar[XB_TMO])) break; if (sp > XB_SPIN_CAP) { atomicAdd(&bar[XB_TMO], 1u); break; } }
    }
    nloc = mine > 0u ? mine : 1u; nx = cnt > 0u ? cnt : 1u;
}
__device__ __forceinline__ void xcd_barrier(const XcdBarrier& b) {
    asm volatile("s_waitcnt vmcnt(0)" ::: "memory");
    __syncthreads();
    if (threadIdx.x == 0) {
        unsigned* bar = b.bar;
        __builtin_amdgcn_s_waitcnt(0);
        unsigned nloc = b.st[0], nx = b.st[1];
        if (nloc == 0u) { xcd_barrier_complete(bar, b.x, nloc, nx); b.st[0] = nloc; b.st[1] = nx; }
        const unsigned old = xb_add(&bar[XB_XSUB(b.x)], 1u);
        const unsigned gen = old / nloc;
        if (old + 1u == (gen + 1u) * nloc) {
            __builtin_amdgcn_fence(__ATOMIC_RELEASE, "agent");
            asm volatile("s_waitcnt vmcnt(0)" ::: "memory");
            const unsigned og = xb_add(&bar[XB_TOP], 1u);
            const unsigned tg = og / nx;
            if (og + 1u == (tg + 1u) * nx) xb_add(&bar[XB_TOPGEN], 1u);
            else XB_SPIN(xb_ld(&bar[XB_TOPGEN]) == tg, bar);
            __builtin_amdgcn_fence(__ATOMIC_ACQUIRE, "agent");
            xb_add(&bar[XB_XGEN(b.x)], 1u);
            asm volatile("s_waitcnt vmcnt(0)" ::: "memory");
        } else {
            XB_SPIN(xb_ld(&bar[XB_XGEN(b.x)]) == gen, bar);
            __builtin_amdgcn_fence(__ATOMIC_ACQUIRE, "agent");
            asm volatile("s_waitcnt vmcnt(0)" ::: "memory");
        }
    }
    __syncthreads();
}

__global__ void __launch_bounds__(256, 2) mega(P p) {
    extern __shared__ __attribute__((aligned(16))) float smem[];
    cg::grid_group grid = cg::this_grid();
    volatile LAS unsigned* st = (volatile LAS unsigned*)((char*)smem + 73744);
    if (threadIdx.x < 4) st[threadIdx.x] = 0u;
    __syncthreads();
    XcdBarrier xb = xcd_barrier_post(p.bar, st);
    for (int ph = p.ph_lo; ph < p.ph_hi; ++ph) {
        if (phase_empty(ph)) continue;
        run_phase(p, ph, smem, 0);
        if (PROBE_N > 1 && ph > 0 && ph < NPH - 1 && (ph - 1) % NSUB == PROBE_S)
            for (int rep = 1; rep < PROBE_N; ++rep) { xcd_barrier(xb); run_phase(p, ph, smem, rep); }
        if (ph + 1 < p.ph_hi) { if (ph == 0) grid.sync(); else xcd_barrier(xb); }
    }
}

extern "C" void kernel_launch(void* const* d_in, const int* in_sizes, int n_in, void* d_out, int out_size, void* d_ws, size_t ws_size, hipStream_t stream) {
    static int grid_blocks = 0;
    if (!grid_blocks) {
        int dev = 0, cus = 0, per_cu = 0;
        hipGetDevice(&dev);
        hipDeviceGetAttribute(&cus, hipDeviceAttributeMultiprocessorCount, dev);
        hipFuncSetAttribute((const void*)mega, hipFuncAttributeMaxDynamicSharedMemorySize, LDS_BYTES);
        hipOccupancyMaxActiveBlocksPerMultiprocessor(&per_cu, mega, 256, LDS_BYTES);
        if (per_cu < 1) per_cu = 1;
        if (per_cu > 2) per_cu = 2;
        grid_blocks = cus * per_cu;
    }
    P p{};
    const float** ins = (const float**)&p;
    for (int i = 0; i < 24; ++i) ins[i] = (const float*)d_in[i];
    p.out = (float*)d_out;
    size_t off = 0; char* ws = (char*)d_ws;
    auto carve = [&](size_t bytes) { void* r = ws + off; off += (bytes + 255) & ~(size_t)255; return r; };
    p.modv = (float*)carve((size_t)4 * 9 * 6144 * 4);
    p.rope = (float*)carve((size_t)2048 * 64 * 4);
    p.H = (float*)carve((size_t)NT * DM * 4);
    p.XN = (bf16_t*)carve((size_t)NT * DM * 2);
    p.WT = (bf16_t*)carve(WT_TOTAL * 2);
    p.MIX = (bf16_t*)carve((size_t)NT * DM * 2);
    p.PB = (bf16_t*)carve((size_t)NT * 1536 * 2);
    p.GT = (float*)carve((size_t)NT * 16 * 4);
    p.AQL = (bf16_t*)carve((size_t)8 * 16 * 2048 * 64 * 2);
    p.AQC = (bf16_t*)carve((size_t)8 * 16 * 256 * 64 * 2);
    p.AK = (bf16_t*)carve((size_t)8 * 4 * 2 * 2304 * 64 * 2);
    p.AV = (bf16_t*)carve((size_t)8 * 4 * 128 * 2304 * 2);
    p.QKB = (bf16_t*)carve((size_t)NT * 512 * 2);
    p.CLOC = (float*)carve((size_t)2304 * 8192 * 4);
    p.CST = (bf16_t*)carve((size_t)2304 * 8192 * 2);
    p.NLOC = (float*)carve((size_t)2304 * 64 * 4);
    p.NST = (float*)carve((size_t)2304 * 64 * 4);
    p.CHB = (float*)carve((size_t)2304 * 4);
    p.CHM = (float*)carve((size_t)2304 * 4);
    p.MST = (float*)carve((size_t)2304 * 4);
    p.QB = (bf16_t*)carve((size_t)NT * 2048 * 2);
    p.GATE = (float*)carve((size_t)NT * 128 * 4);
    p.EIDX = (int*)carve((size_t)NT * 128 * 4);
    p.ctr = (int*)carve(256);
    p.bar = (unsigned*)carve((size_t)XCD_BAR_WORDS * 4);
    p.U8 = (unsigned char*)carve((size_t)4 * 16384 * 1024);
    p.V8 = (unsigned char*)carve((size_t)4 * 16384 * 1024);
    p.USC = (float*)carve((size_t)4 * 16384 * 4);
    p.VSC = (float*)carve((size_t)4 * 16384 * 4);
    p.KB = (bf16_t*)carve((size_t)4 * 8 * 2 * 128 * 128 * 2);
    if (off > ws_size) { fprintf(stderr, "kernel_launch: workspace too small: need %zu have %zu\n", off, ws_size); return; }
    hipMemsetAsync(p.bar, 0, (size_t)XCD_BAR_WORDS * 4, stream);
#if ONE_LAUNCH
    p.ph_lo = 0; p.ph_hi = NPH;
    void* args[] = {&p};
    hipError_t e = hipLaunchCooperativeKernel((void*)mega, dim3(grid_blocks), dim3(256), args, LDS_BYTES, stream);
    if (e != hipSuccess) fprintf(stderr, "cooperative launch failed: %s (grid %d)\n", hipGetErrorString(e), grid_blocks);
#else
    for (int ph = 0; ph < NPH; ++ph) {
        if (ph > 0 && ph < NPH - 1) { const int L = (ph - 1) / NSUB, s = (ph - 1) % NSUB; if ((s == 2 || s == 4 || s == 5) && (L & 1)) continue; }
        p.ph_lo = ph; p.ph_hi = ph + 1;
        hipLaunchKernelGGL(mega, dim3(grid_blocks), dim3(256), LDS_BYTES, stream, p);
    }
#endif
}
```

```cpp
#include <hip/hip_runtime.h>
#include <hip/hip_cooperative_groups.h>
#include <cstdio>
#include <cstdint>
namespace cg = cooperative_groups;

#ifndef ONE_LAUNCH
#define ONE_LAUNCH 1
#endif

#define NT 18432
#define NL 16384
#define DM 1024
#define EVW 3088
#define ODW 1536
#define C_QK 0
#define C_V 512
#define C_O 1024
#define C_G 1536
#define C_DQ 1552
#define C_DK 2064
#define C_DV 2576
#define NPH 45
#ifndef PROBE_S
#define PROBE_S -1
#endif
#ifndef PROBE_N
#define PROBE_N 1
#endif

typedef unsigned short bf16_t;
typedef short bf16x8 __attribute__((ext_vector_type(8)));
typedef float f32x4 __attribute__((ext_vector_type(4)));
#define LDS_BYTES 73792

typedef float f32x16 __attribute__((ext_vector_type(16)));
typedef unsigned u32x4 __attribute__((ext_vector_type(4)));
struct P {
    const float *x, *c, *ctx, *c_ctx, *mod_w, *mod_b, *norm1_g, *norm2_g, *ev_w_in, *ev_conv_w, *ev_conv_b, *ev_gate_b,
        *ev_ml_g, *ev_da_lam, *ev_da_g, *ev_w_out, *od_w_in, *od_sink, *od_w_out, *pr_w_q, *pr_keys, *pr_u, *pr_v, *final_g;
    float* out;
    float *modv, *H, *GATE, *rope, *GT, *CLOC, *NLOC, *NST, *CHB, *CHM, *MST;
    int *EIDX, *ctr;
    unsigned* bar;
    bf16_t *XN, *MIX, *WT, *KB, *QB, *PB, *AQL, *AQC, *AK, *AV, *QKB, *CST;
    unsigned char *U8, *V8;
    float *USC, *VSC;
    int ph_lo, ph_hi;
};
#define QSCALE 0.18033688011112042f

__device__ __forceinline__ int otid() { int t = threadIdx.x; asm volatile("" : "+v"(t)); return t; }
__device__ __forceinline__ int modrow(int r) { return r < NL ? (r >> 11) : 8; }
__device__ __forceinline__ float silu_f(float x) { return x / (1.f + expf(-x)); }
__device__ __forceinline__ float sigmoid_f(float x) { return 1.f / (1.f + expf(-x)); }
__device__ __forceinline__ float log_sigmoid_f(float x) { return fminf(x, 0.f) - log1pf(expf(-fabsf(x))); }
typedef __bf16 bf16v2_t __attribute__((ext_vector_type(2)));
typedef float f32x2_t __attribute__((ext_vector_type(2)));
__device__ __forceinline__ unsigned cvt_pk_bf16(float lo, float hi) { const bf16v2_t v = __builtin_convertvector((f32x2_t){lo, hi}, bf16v2_t); return __builtin_bit_cast(unsigned, v); }
__device__ __forceinline__ float bf_lo(unsigned u) { return __uint_as_float(u << 16); }
__device__ __forceinline__ float bf_hi(unsigned u) { return __uint_as_float(u & 0xffff0000u); }
#define WT_EVIN(j) ((size_t)(j) * 3200 * 1024)
#define WT_EVOUT(j) ((size_t)2 * 3200 * 1024 + (size_t)(j) * 1024 * 1024)
#define WT_ODIN(j) ((size_t)2 * 3200 * 1024 + (size_t)2 * 1024 * 1024 + (size_t)(j) * 1536 * 1024)
#define WT_ODOUT(j) ((size_t)2 * 3200 * 1024 + (size_t)2 * 1024 * 1024 + (size_t)2 * 1536 * 1024 + (size_t)(j) * 1024 * 1024)
#define WT_PQ(L) ((size_t)2 * 3200 * 1024 + (size_t)4 * 1024 * 1024 + (size_t)2 * 1536 * 1024 + (size_t)(L) * 2048 * 1024)
#define WT_TOTAL ((size_t)2 * 3200 * 1024 + (size_t)4 * 1024 * 1024 + (size_t)2 * 1536 * 1024 + (size_t)4 * 2048 * 1024)
__device__ __forceinline__ float lshfl(float v, int src) { return __int_as_float(__builtin_amdgcn_ds_bpermute(src << 2, __float_as_int(v))); }
#define SHX(v, m) lshfl((v), lane ^ (m))
#define wave_sum(v) wave_sum_l((v), lane)
#define wave_max(v) wave_max_l((v), lane)
__device__ __forceinline__ float wave_sum_l(float v, int lane) {
#pragma unroll
    for (int o = 32; o > 0; o >>= 1) v += lshfl(v, lane ^ o);
    return v;
}
__device__ __forceinline__ float wave_max_l(float v, int lane) {
#pragma unroll
    for (int o = 32; o > 0; o >>= 1) v = fmaxf(v, lshfl(v, lane ^ o));
    return v;
}

__device__ void cvt_copy_bf16(const float* src, bf16_t* dst, size_t n);
__device__ void quant_rows_i8(const float* src, unsigned char* dst, float* scl, int nrows);
__device__ void ph_prologue(const P& p, float* smem) {
    const int tid = otid(), nb = gridDim.x, bid = blockIdx.x;
    if (bid == 0 && tid < 64) p.ctr[tid] = 0;
    {
        const float4* xs = (const float4*)p.x; const float4* cs = (const float4*)p.ctx; float4* hd = (float4*)p.H;
        const size_t nx = (size_t)NL * DM / 4, nc = (size_t)(NT - NL) * DM / 4;
        for (size_t i = (size_t)bid * 256 + tid; i < nx + nc; i += (size_t)nb * 256) hd[i] = i < nx ? xs[i] : cs[i - nx];
    }
    for (int i = bid * 256 + tid; i < 2048 * 32; i += nb * 256) {
        const int s = i >> 5, d = i & 31;
        const float pos = (d < 16) ? (float)(s >> 6) : (float)(s & 63);
        const float inv = powf(10000.0f, -(float)(d & 15) / 16.0f);
        const float ang = pos * inv;
        p.rope[2 * i] = cosf(ang); p.rope[2 * i + 1] = sinf(ang);
    }
    float* sc = smem;
    float* red = smem + 9 * 1024;
    for (int i = tid; i < 9 * 1024; i += 256) { const int r = i >> 10, k = i & 1023; const float v = r < 8 ? p.c[r * 1024 + k] : p.c_ctx[k]; sc[i] = silu_f(v); }
    __syncthreads();
    for (int item = bid; item < 4 * 96; item += nb) {
        const int L = item / 96, n0 = (item % 96) * 64, tx = tid & 63, kq = tid >> 6;
        float acc[9];
#pragma unroll
        for (int r = 0; r < 9; ++r) acc[r] = 0.f;
        const float* w = p.mod_w + (size_t)L * 1024 * 6144 + n0 + tx;
        for (int k = kq * 256; k < kq * 256 + 256; ++k) {
            const float wv = w[(size_t)k * 6144];
#pragma unroll
            for (int r = 0; r < 9; ++r) acc[r] += sc[r * 1024 + k] * wv;
        }
#pragma unroll
        for (int r = 0; r < 9; ++r) red[(kq * 9 + r) * 64 + tx] = acc[r];
        __syncthreads();
        if (kq == 0) {
#pragma unroll
            for (int r = 0; r < 9; ++r) {
                const float s = red[(0 * 9 + r) * 64 + tx] + red[(1 * 9 + r) * 64 + tx] + red[(2 * 9 + r) * 64 + tx] + red[(3 * 9 + r) * 64 + tx];
                p.modv[((size_t)L * 9 + r) * 6144 + n0 + tx] = s + p.mod_b[L * 6144 + n0 + tx];
            }
        }
        __syncthreads();
    }
    {
        float (*tile)[65] = (float (*)[65])smem;
        for (int item = bid; item < 5440; item += nb) {
            int it = item, mat = 0, N = 0, Npad = 0; const float* src = nullptr; bf16_t* dst = nullptr;
            for (mat = 0; mat < 12; ++mat) {
                if (mat < 2) { N = EVW; Npad = 3200; src = p.ev_w_in + (size_t)mat * DM * EVW; dst = p.WT + WT_EVIN(mat); }
                else if (mat < 4) { N = 1024; Npad = 1024; src = p.ev_w_out + (size_t)(mat - 2) * DM * DM; dst = p.WT + WT_EVOUT(mat - 2); }
                else if (mat < 6) { N = ODW; Npad = ODW; src = p.od_w_in + (size_t)(mat - 4) * DM * ODW; dst = p.WT + WT_ODIN(mat - 4); }
                else if (mat < 8) { N = 1024; Npad = 1024; src = p.od_w_out + (size_t)(mat - 6) * DM * DM; dst = p.WT + WT_ODOUT(mat - 6); }
                else { N = 2048; Npad = 2048; src = p.pr_w_q + (size_t)(mat - 8) * DM * 2048; dst = p.WT + WT_PQ(mat - 8); }
                const int nt = 16 * (Npad / 64);
                if (it < nt) break;
                it -= nt;
            }
            const int k0 = (it & 15) * 64, n0 = (it >> 4) * 64;
            __syncthreads();
#pragma unroll
            for (int rep = 0; rep < 4; ++rep) {
                const int i = (tid >> 4) + 16 * rep, c4 = (tid & 15) * 4;
                float4 v = make_float4(0.f, 0.f, 0.f, 0.f);
                int sc = n0 + c4;
                if (mat < 2) sc = sc < 1536 ? sc : (sc < 3072 ? sc + 16 : (sc < 3088 ? sc - 3072 + 1536 : N));
                if (sc < N) v = *(const float4*)(src + (size_t)(k0 + i) * N + sc);
                tile[i][c4] = v.x; tile[i][c4 + 1] = v.y; tile[i][c4 + 2] = v.z; tile[i][c4 + 3] = v.w;
            }
            __syncthreads();
            {
                const int n = tid >> 2, kq = (tid & 3) * 16;
                unsigned w[8];
#pragma unroll
                for (int e = 0; e < 8; ++e) w[e] = cvt_pk_bf16(tile[kq + 2 * e][n], tile[kq + 2 * e + 1][n]);
                uint4* dp = (uint4*)(dst + (size_t)(n0 + n) * DM + k0 + kq);
                dp[0] = make_uint4(w[0], w[1], w[2], w[3]); dp[1] = make_uint4(w[4], w[5], w[6], w[7]);
            }
        }
    }
    quant_rows_i8(p.pr_u, p.U8, p.USC, 4 * 16384);
    quant_rows_i8(p.pr_v, p.V8, p.VSC, 4 * 16384);
    cvt_copy_bf16(p.pr_keys, p.KB, (size_t)4 * 8 * 2 * 128 * 128);
}

__device__ void cvt_copy_bf16(const float* src, bf16_t* dst, size_t n) {
    const size_t n8 = n / 8;
    for (size_t i = (size_t)blockIdx.x * 256 + otid(); i < n8; i += (size_t)gridDim.x * 256) {
        const float4 a = ((const float4*)src)[2 * i], b = ((const float4*)src)[2 * i + 1];
        ((uint4*)dst)[i] = make_uint4(cvt_pk_bf16(a.x, a.y), cvt_pk_bf16(a.z, a.w), cvt_pk_bf16(b.x, b.y), cvt_pk_bf16(b.z, b.w));
    }
}

__device__ void quant_rows_i8(const float* src, unsigned char* dst, float* scl, int nrows) {
    const int lane = otid() & 63, wid = otid() >> 6;
    for (int r = blockIdx.x * 4 + wid; r < nrows; r += gridDim.x * 4) {
        const float4* sp = (const float4*)(src + (size_t)r * 1024 + lane * 16);
        float4 v[4]; float mx = 0.f;
#pragma unroll
        for (int i = 0; i < 4; ++i) { v[i] = sp[i]; mx = fmaxf(mx, fmaxf(fmaxf(fabsf(v[i].x), fabsf(v[i].y)), fmaxf(fabsf(v[i].z), fabsf(v[i].w)))); }
#pragma unroll
        for (int o = 32; o > 0; o >>= 1) mx = fmaxf(mx, SHX(mx, o));
        const float inv = mx > 0.f ? 127.f / mx : 0.f;
        unsigned w[4];
#pragma unroll
        for (int i = 0; i < 4; ++i) {
            const unsigned b0 = (unsigned)((int)rintf(v[i].x * inv) + 128), b1 = (unsigned)((int)rintf(v[i].y * inv) + 128), b2 = (unsigned)((int)rintf(v[i].z * inv) + 128), b3 = (unsigned)((int)rintf(v[i].w * inv) + 128);
            w[i] = b0 | (b1 << 8) | (b2 << 16) | (b3 << 24);
        }
        *(uint4*)(dst + (size_t)r * 1024 + lane * 16) = make_uint4(w[0], w[1], w[2], w[3]);
        if (lane == 0) scl[r] = mx * (1.f / 127.f);
    }
}

__device__ void ph_normmod(const float* src, const float* g, const float* modv_layer, int shift_off, int scale_off, bf16_t* dst, int nrows) {
    const int lane = otid() & 63, wid = otid() >> 6;
    for (int r = blockIdx.x * 4 + wid; r < nrows; r += gridDim.x * 4) {
        const float4* s4 = (const float4*)(src + (size_t)r * DM);
        float4 v[4]; float ss = 0.f;
#pragma unroll
        for (int i = 0; i < 4; ++i) { v[i] = s4[i * 64 + lane]; ss += v[i].x * v[i].x + v[i].y * v[i].y + v[i].z * v[i].z + v[i].w * v[i].w; }
        ss = wave_sum(ss);
        const float rstd = rsqrtf(ss * (1.0f / DM) + 1e-6f);
        const float* mv = modv_layer + (size_t)modrow(r) * 6144;
        uint2* d2 = (uint2*)(dst + (size_t)r * DM);
#pragma unroll
        for (int i = 0; i < 4; ++i) {
            const int c = (i * 64 + lane) * 4;
            const float4 gg = *(const float4*)(g + c), sh = *(const float4*)(mv + shift_off + c), scl = *(const float4*)(mv + scale_off + c);
            float4 o;
            o.x = v[i].x * rstd * gg.x * (1.f + scl.x) + sh.x; o.y = v[i].y * rstd * gg.y * (1.f + scl.y) + sh.y;
            o.z = v[i].z * rstd * gg.z * (1.f + scl.z) + sh.z; o.w = v[i].w * rstd * gg.w * (1.f + scl.w) + sh.w;
            d2[i * 64 + lane] = make_uint2(cvt_pk_bf16(o.x, o.y), cvt_pk_bf16(o.z, o.w));
        }
    }
}

__device__ void ph_final(const P& p) {
    const int lane = otid() & 63, wid = otid() >> 6;
    for (int r = blockIdx.x * 4 + wid; r < NL; r += gridDim.x * 4) {
        const float4* s4 = (const float4*)(p.H + (size_t)r * DM);
        float4 v[4]; float ss = 0.f;
#pragma unroll
        for (int i = 0; i < 4; ++i) { v[i] = s4[i * 64 + lane]; ss += v[i].x * v[i].x + v[i].y * v[i].y + v[i].z * v[i].z + v[i].w * v[i].w; }
        ss = wave_sum(ss);
        const float rstd = rsqrtf(ss * (1.0f / DM) + 1e-6f);
        float4* d4 = (float4*)(p.out + (size_t)r * DM);
#pragma unroll
        for (int i = 0; i < 4; ++i) {
            const int c = (i * 64 + lane) * 4; const float4 gg = *(const float4*)(p.final_g + c);
            float4 o; o.x = v[i].x * rstd * gg.x; o.y = v[i].y * rstd * gg.y; o.z = v[i].z * rstd * gg.z; o.w = v[i].w * rstd * gg.w;
            d4[i * 64 + lane] = o;
        }
    }
}

#define GL_ROWB 144
#define GL_TILEB (128 * GL_ROWB)
struct TokPos { int b, pos, kpos; bool lat; };
__device__ __forceinline__ TokPos tokpos(int row) {
    TokPos t; t.lat = row < NL;
    if (t.lat) { t.b = row >> 11; t.pos = row & 2047; t.kpos = 256 + t.pos; } else { const int r = row - NL; t.b = r >> 8; t.pos = r & 255; t.kpos = t.pos; }
    return t;
}
struct EpiStoreBF16 {
    bf16_t* C; int ldc;
    __device__ __forceinline__ bool swapped(int) const { return false; }
    __device__ __forceinline__ void operator()(const f32x4 (&acc)[4][4], int m0, int n0, int wm, int wn, int fr, int fq) const {
#pragma unroll
        for (int mi = 0; mi < 4; ++mi)
#pragma unroll
            for (int ni = 0; ni < 4; ++ni) {
                const f32x4 v = acc[ni][mi];
                *(uint2*)(C + (size_t)(m0 + wm * 64 + mi * 16 + fr) * ldc + n0 + wn * 64 + ni * 16 + fq * 4) = make_uint2(cvt_pk_bf16(v[0], v[1]), cvt_pk_bf16(v[2], v[3]));
            }
    }
};
struct EpiResid {
    float* H; const float* gate; float scale;
    __device__ __forceinline__ bool swapped(int) const { return false; }
    __device__ __forceinline__ void operator()(const f32x4 (&acc)[4][4], int m0, int n0, int wm, int wn, int fr, int fq) const {
#pragma unroll
        for (int mi = 0; mi < 4; ++mi) {
            const int row = m0 + wm * 64 + mi * 16 + fr;
            const float* gp = gate + (size_t)modrow(row) * 6144;
#pragma unroll
            for (int ni = 0; ni < 4; ++ni) {
                const int col = n0 + wn * 64 + ni * 16 + fq * 4;
                const f32x4 g = *(const f32x4*)(gp + col);
                f32x4* hp = (f32x4*)(H + (size_t)row * DM + col);
                *hp = *hp + g * acc[ni][mi] * scale;
            }
        }
    }
};
__device__ __forceinline__ void rope_store64(const f32x4 (&acc)[4][4], int mi, bool do_rope, const float* ropep  , float scale, bf16_t* dst  , int fq) {
#pragma unroll
    for (int ni = 0; ni < 2; ++ni) {
        f32x4 x1 = acc[ni][mi], x2 = acc[ni + 2][mi];
        if (do_rope) {
            const f32x4 r0 = *(const f32x4*)(ropep + (ni * 16 + fq * 4) * 2), r1 = *(const f32x4*)(ropep + (ni * 16 + fq * 4) * 2 + 4);
            const f32x4 cs = (f32x4){r0[0], r0[2], r1[0], r1[2]}, sn = (f32x4){r0[1], r0[3], r1[1], r1[3]};
            const f32x4 y1 = x1 * cs - x2 * sn, y2 = x1 * sn + x2 * cs;
            x1 = y1; x2 = y2;
        }
        x1 = x1 * scale; x2 = x2 * scale;
        *(uint2*)(dst + ni * 16 + fq * 4) = make_uint2(cvt_pk_bf16(x1[0], x1[1]), cvt_pk_bf16(x1[2], x1[3]));
        *(uint2*)(dst + 32 + ni * 16 + fq * 4) = make_uint2(cvt_pk_bf16(x2[0], x2[1]), cvt_pk_bf16(x2[2], x2[3]));
    }
}
struct EpiEven {
    bf16_t *PB, *AQL, *AQC, *AK, *AV; float* GT; const float* rope;
    __device__ __forceinline__ bool swapped(int n0) const { return n0 >= 2560 && n0 < 3072; }
    __device__ __forceinline__ void operator()(const f32x4 (&acc)[4][4], int m0, int n0, int wm, int wn, int fr, int fq) const {
        const int t = n0 >> 7;
        if (t < 12) {
#pragma unroll
            for (int mi = 0; mi < 4; ++mi)
#pragma unroll
                for (int ni = 0; ni < 4; ++ni) {
                    const f32x4 v = acc[ni][mi];
                    *(uint2*)(PB + (size_t)(m0 + wm * 64 + mi * 16 + fr) * 1536 + n0 + wn * 64 + ni * 16 + fq * 4) = make_uint2(cvt_pk_bf16(v[0], v[1]), cvt_pk_bf16(v[2], v[3]));
                }
        } else if (t < 20) {
            const bool isq = t < 16; const int h = t & 3;
#pragma unroll
            for (int mi = 0; mi < 4; ++mi) {
                const TokPos tp = tokpos(m0 + wm * 64 + mi * 16 + fr);
                const int hm = (tp.b * 4 + h) * 2 + wn;
                bf16_t* dst;
                if (isq) dst = tp.lat ? AQL + ((size_t)hm * 2048 + tp.pos) * 64 : AQC + ((size_t)hm * 256 + tp.pos) * 64;
                else dst = AK + ((size_t)hm * 2304 + tp.kpos) * 64;
                rope_store64(acc, mi, tp.lat, rope + (size_t)tp.pos * 64, isq ? QSCALE : 1.0f, dst, fq);
            }
        } else if (t < 24) {
            const int h = t - 20;
#pragma unroll
            for (int mi = 0; mi < 4; ++mi) {
                const TokPos tp = tokpos(m0 + wm * 64 + mi * 16 + fq * 4);
#pragma unroll
                for (int ni = 0; ni < 4; ++ni) {
                    const f32x4 v = acc[ni][mi];
                    const int d = wn * 64 + ni * 16 + fr;
                    *(uint2*)(AV + ((size_t)(tp.b * 4 + h) * 128 + d) * 2304 + tp.kpos) = make_uint2(cvt_pk_bf16(v[0], v[1]), cvt_pk_bf16(v[2], v[3]));
                }
            }
        } else {
            if (wn == 0) {
#pragma unroll
                for (int mi = 0; mi < 4; ++mi) *(f32x4*)(GT + (size_t)(m0 + wm * 64 + mi * 16 + fr) * 16 + fq * 4) = acc[0][mi];
            }
        }
    }
};
struct EpiOdd {
    bf16_t *AQL, *AQC, *AK, *AV; const float* rope;
    __device__ __forceinline__ bool swapped(int n0) const { return n0 >= 1280; }
    __device__ __forceinline__ void operator()(const f32x4 (&acc)[4][4], int m0, int n0, int wm, int wn, int fr, int fq) const {
        const int t = n0 >> 7;
        if (t < 10) {
            const bool isq = t < 8; const int hd = isq ? t * 2 + wn : (t - 8) * 2 + wn;
#pragma unroll
            for (int mi = 0; mi < 4; ++mi) {
                const TokPos tp = tokpos(m0 + wm * 64 + mi * 16 + fr);
                bf16_t* dst;
                if (isq) dst = tp.lat ? AQL + ((size_t)(tp.b * 16 + hd) * 2048 + tp.pos) * 64 : AQC + ((size_t)(tp.b * 16 + hd) * 256 + tp.pos) * 64;
                else dst = AK + ((size_t)(tp.b * 4 + hd) * 2304 + tp.kpos) * 64;
                rope_store64(acc, mi, tp.lat, rope + (size_t)tp.pos * 64, isq ? QSCALE : 1.0f, dst, fq);
            }
        } else {
            const int hkv = (t - 10) * 2 + wn;
#pragma unroll
            for (int mi = 0; mi < 4; ++mi) {
                const TokPos tp = tokpos(m0 + wm * 64 + mi * 16 + fq * 4);
#pragma unroll
                for (int ni = 0; ni < 4; ++ni) {
                    const f32x4 v = acc[ni][mi];
                    const int d = ni * 16 + fr;
                    *(uint2*)(AV + ((size_t)(tp.b * 4 + hkv) * 64 + d) * 2304 + tp.kpos) = make_uint2(cvt_pk_bf16(v[0], v[1]), cvt_pk_bf16(v[2], v[3]));
                }
            }
        }
    }
};
template <bool SWAP>
__device__ __forceinline__ void gemm_tile_kloop(f32x4 (&acc)[4][4], const bf16_t* aub, const bf16_t* bub, char* smem, int lrow, int lch, int wm, int wn, int fr, int fq) {
    const unsigned voff = (unsigned)(lrow * DM + lch * 8) * 2u;
    uint4 ra0, ra1, ra2, ra3, rb0, rb1, rb2, rb3;
#define GL_LD(BASE, ROWS, KO) (*(const uint4*)((const char*)(BASE) + ((size_t)(ROWS) * DM + (KO)) * 2 + voff))
#define GL_LOAD(KO) { ra0 = GL_LD(aub, 0, KO); ra1 = GL_LD(aub, 32, KO); ra2 = GL_LD(aub, 64, KO); ra3 = GL_LD(aub, 96, KO); rb0 = GL_LD(bub, 0, KO); rb1 = GL_LD(bub, 32, KO); rb2 = GL_LD(bub, 64, KO); rb3 = GL_LD(bub, 96, KO); }
#define GL_STORE(BUF) { char* sa_ = (BUF) + lrow * GL_ROWB + lch * 16; char* sb_ = sa_ + GL_TILEB; \
                        *(uint4*)(sa_) = ra0; *(uint4*)(sa_ + 32 * GL_ROWB) = ra1; *(uint4*)(sa_ + 64 * GL_ROWB) = ra2; *(uint4*)(sa_ + 96 * GL_ROWB) = ra3; \
                        *(uint4*)(sb_) = rb0; *(uint4*)(sb_ + 32 * GL_ROWB) = rb1; *(uint4*)(sb_ + 64 * GL_ROWB) = rb2; *(uint4*)(sb_ + 96 * GL_ROWB) = rb3; }
    GL_LOAD(0)
    __syncthreads();
    GL_STORE(smem)
    __syncthreads();
    for (int kt = 0; kt < 16; ++kt) {
        char* cur = smem + (kt & 1) * 2 * GL_TILEB;
        char* nxt = smem + ((kt + 1) & 1) * 2 * GL_TILEB;
        if (kt + 1 < 16) GL_LOAD((kt + 1) * 64)
#pragma unroll
        for (int ks = 0; ks < 2; ++ks) {
            bf16x8 af[4], wf[4];
#pragma unroll
            for (int i = 0; i < 4; ++i) {
                af[i] = *(const bf16x8*)(cur + (wm * 64 + i * 16 + fr) * GL_ROWB + (ks * 4 + fq) * 16);
                wf[i] = *(const bf16x8*)(cur + GL_TILEB + (wn * 64 + i * 16 + fr) * GL_ROWB + (ks * 4 + fq) * 16);
            }
#pragma unroll
            for (int ni = 0; ni < 4; ++ni)
#pragma unroll
                for (int mi = 0; mi < 4; ++mi)
                    acc[ni][mi] = SWAP ? __builtin_amdgcn_mfma_f32_16x16x32_bf16(af[mi], wf[ni], acc[ni][mi], 0, 0, 0)
                                       : __builtin_amdgcn_mfma_f32_16x16x32_bf16(wf[ni], af[mi], acc[ni][mi], 0, 0, 0);
        }
        if (kt + 1 < 16) GL_STORE(nxt)
        __syncthreads();
    }
#undef GL_LD
#undef GL_LOAD
#undef GL_STORE
}
template <class Epi>
__device__ void ph_gemm(const bf16_t* A, const bf16_t* Bt, int M, int Npad, const Epi& epi, char* smem) {
    const int tid = otid(), lane = tid & 63, wid = tid >> 6, wm = wid >> 1, wn = wid & 1;
    const int fr = lane & 15, fq = lane >> 4;
    const int tm = M / 128, tn = Npad / 128, ntiles = tm * tn;
    const int lrow = tid >> 3, lch = tid & 7;
    for (int tile = blockIdx.x; tile < ntiles; tile += gridDim.x) {
        const int m0 = (tile % tm) * 128, n0 = (tile / tm) * 128;
        f32x4 acc[4][4];
#pragma unroll
        for (int a = 0; a < 4; ++a)
#pragma unroll
            for (int b = 0; b < 4; ++b) acc[a][b] = (f32x4){0.f, 0.f, 0.f, 0.f};
        const bf16_t* ap = A + (size_t)m0 * DM;
        const bf16_t* bp = Bt + (size_t)n0 * DM;
        if (epi.swapped(n0)) gemm_tile_kloop<true>(acc, ap, bp, smem, lrow, lch, wm, wn, fr, fq);
        else gemm_tile_kloop<false>(acc, ap, bp, smem, lrow, lch, wm, wn, fr, fq);
        int fr2 = fr, fq2 = fq, wm2 = wm, wn2 = wn;
        asm volatile("" : "+v"(fr2), "+v"(fq2), "+v"(wm2), "+v"(wn2));
        epi(acc, m0, n0, wm2, wn2, fr2, fq2);
    }
}

__device__ void ph_prep_even(const P& p, int j) {
    const float* cw = p.ev_conv_w + (size_t)j * 3 * 512; const float* cb = p.ev_conv_b + (size_t)j * 512;
    const size_t tot = (size_t)NT * 256;
    for (size_t i = (size_t)blockIdx.x * 256 + otid(); i < tot; i += (size_t)gridDim.x * 256) {
        const int r = (int)(i >> 8), c = (int)(i & 255) * 2;
        int t, T; if (r < NL) { t = r & 2047; T = 2048; } else { t = (r - NL) & 255; T = 256; }
        const unsigned x1 = *(const unsigned*)(p.PB + (size_t)r * 1536 + c);
        float v0 = cb[c] + bf_lo(x1) * cw[512 + c], v1 = cb[c + 1] + bf_hi(x1) * cw[512 + c + 1];
        if (t > 0) { const unsigned x0 = *(const unsigned*)(p.PB + (size_t)(r - 1) * 1536 + c); v0 += bf_lo(x0) * cw[c]; v1 += bf_hi(x0) * cw[c + 1]; }
        if (t < T - 1) { const unsigned x2 = *(const unsigned*)(p.PB + (size_t)(r + 1) * 1536 + c); v0 += bf_lo(x2) * cw[1024 + c]; v1 += bf_hi(x2) * cw[1024 + c + 1]; }
        v0 = silu_f(v0); v1 = silu_f(v1);
        if (c >= 256) { v0 *= 0.125f; v1 *= 0.125f; }
        *(unsigned*)(p.QKB + (size_t)r * 512 + c) = cvt_pk_bf16(v0, v1);
    }
}

#define FA_KROW 144
#define FA_VROW 136
__device__ __forceinline__ bf16x8 pack8(float a0, float a1, float a2, float a3, float a4, float a5, float a6, float a7) {
    const u32x4 u = (u32x4){cvt_pk_bf16(a0, a1), cvt_pk_bf16(a2, a3), cvt_pk_bf16(a4, a5), cvt_pk_bf16(a6, a7)};
    return __builtin_bit_cast(bf16x8, u);
}
template <int NDB, bool MASK>
__device__ __forceinline__ void flash_tile(const bf16x8 (&qf)[4], f32x16 (&o)[NDB], float& m, float& l, const char* Kl, const char* Vl, int lane, int qpos, int kp0) {
    const int j = lane & 31, h = lane >> 5;
    f32x16 s0, s1;
#pragma unroll
    for (int i = 0; i < 16; ++i) { s0[i] = 0.f; s1[i] = 0.f; }
#pragma unroll
    for (int ks = 0; ks < 4; ++ks) {
        const bf16x8 a0 = *(const bf16x8*)(Kl + j * FA_KROW + (2 * ks + h) * 16);
        const bf16x8 a1 = *(const bf16x8*)(Kl + (32 + j) * FA_KROW + (2 * ks + h) * 16);
        s0 = __builtin_amdgcn_mfma_f32_32x32x16_bf16(a0, qf[ks], s0, 0, 0, 0);
        s1 = __builtin_amdgcn_mfma_f32_32x32x16_bf16(a1, qf[ks], s1, 0, 0, 0);
    }
    if (MASK) {
#pragma unroll
        for (int r = 0; r < 16; ++r) {
            const int key = (r & 3) + 8 * (r >> 2) + 4 * h;
            const int d0 = qpos - (kp0 + key), d1 = d0 - 32;
            if (d0 > 128 || d0 < -128) s0[r] = -1e30f;
            if (d1 > 128 || d1 < -128) s1[r] = -1e30f;
        }
    }
    float mx = fmaxf(s0[0], s1[0]);
#pragma unroll
    for (int r = 1; r < 16; ++r) mx = fmaxf(mx, fmaxf(s0[r], s1[r]));
    mx = fmaxf(mx, SHX(mx, 32));
    const float mn = fmaxf(m, mx);
    const float alpha = __builtin_amdgcn_exp2f(m - mn);
    m = mn;
    float ls = 0.f;
#pragma unroll
    for (int r = 0; r < 16; ++r) { s0[r] = __builtin_amdgcn_exp2f(s0[r] - mn); s1[r] = __builtin_amdgcn_exp2f(s1[r] - mn); ls += s0[r] + s1[r]; }
    l = l * alpha + ls;
#pragma unroll
    for (int db = 0; db < NDB; ++db) o[db] = o[db] * alpha;
    bf16x8 pb[4];
    pb[0] = pack8(s0[0], s0[1], s0[2], s0[3], s0[4], s0[5], s0[6], s0[7]);
    pb[1] = pack8(s0[8], s0[9], s0[10], s0[11], s0[12], s0[13], s0[14], s0[15]);
    pb[2] = pack8(s1[0], s1[1], s1[2], s1[3], s1[4], s1[5], s1[6], s1[7]);
    pb[3] = pack8(s1[8], s1[9], s1[10], s1[11], s1[12], s1[13], s1[14], s1[15]);
#pragma unroll
    for (int db = 0; db < NDB; ++db)
#pragma unroll
        for (int kk = 0; kk < 4; ++kk) {
            const char* vp = Vl + (db * 32 + j) * FA_VROW + (kk * 16 + 4 * h) * 2;
            const uint2 lo = *(const uint2*)vp, hi = *(const uint2*)(vp + 16);
            const u32x4 u = (u32x4){lo.x, lo.y, hi.x, hi.y};
            o[db] = __builtin_amdgcn_mfma_f32_32x32x16_bf16(__builtin_bit_cast(bf16x8, u), pb[kk], o[db], 0, 0, 0);
        }
}

#define DA_BUFB 35840
__device__ void da_block(const P& p, int item, int L, int j, char* smem) {
    const int tid = otid(), lane = tid & 63, wid = tid >> 6, mp = wid & 1, qg = wid >> 1, jq = lane & 31, hh = lane >> 5;
    const bool lat = item < 1024;
    int b, h, qt;
    if (lat) { b = item >> 7; h = (item >> 5) & 3; qt = item & 31; } else { const int it = item - 1024; b = it >> 4; h = (it >> 2) & 3; qt = it & 3; }
    const int qi = qt * 64 + qg * 32 + jq;
    const bf16_t* qp = lat ? p.AQL + ((size_t)((b * 4 + h) * 2 + mp) * 2048 + qi) * 64 : p.AQC + ((size_t)((b * 4 + h) * 2 + mp) * 256 + qi) * 64;
    bf16x8 qf[4];
#pragma unroll
    for (int ks = 0; ks < 4; ++ks) qf[ks] = *(const bf16x8*)(qp + (2 * ks + hh) * 8);
    const int ntile = lat ? 36 : 4;
    const bf16_t* kg = p.AK + (size_t)((b * 4 + h) * 2) * 2304 * 64 + (size_t)(tid >> 3) * 64 + (tid & 7) * 8;
    const bf16_t* vg = p.AV + (size_t)(b * 4 + h) * 128 * 2304 + (size_t)(tid >> 3) * 2304 + (tid & 7) * 8;
    uint4 k0, k1, k2, k3, v0, v1, v2, v3;
#define DA_LOAD(KEY0) { k0 = *(const uint4*)(kg + (size_t)(KEY0) * 64); k1 = *(const uint4*)(kg + (size_t)((KEY0) + 32) * 64); \
                        k2 = *(const uint4*)(kg + (size_t)2304 * 64 + (size_t)(KEY0) * 64); k3 = *(const uint4*)(kg + (size_t)2304 * 64 + (size_t)((KEY0) + 32) * 64); \
                        v0 = *(const uint4*)(vg + (KEY0)); v1 = *(const uint4*)(vg + (size_t)32 * 2304 + (KEY0)); v2 = *(const uint4*)(vg + (size_t)64 * 2304 + (KEY0)); v3 = *(const uint4*)(vg + (size_t)96 * 2304 + (KEY0)); }
#define DA_STORE(BUF) { char* kb_ = (BUF) + (tid >> 3) * FA_KROW + (tid & 7) * 16; \
                        *(uint4*)kb_ = k0; *(uint4*)(kb_ + 32 * FA_KROW) = k1; *(uint4*)(kb_ + 64 * FA_KROW) = k2; *(uint4*)(kb_ + 96 * FA_KROW) = k3; \
                        char* vb_ = (BUF) + 18432 + (tid >> 3) * FA_VROW + (tid & 7) * 16; \
                        *(uint2*)vb_ = make_uint2(v0.x, v0.y); *(uint2*)(vb_ + 8) = make_uint2(v0.z, v0.w); \
                        *(uint2*)(vb_ + 32 * FA_VROW) = make_uint2(v1.x, v1.y); *(uint2*)(vb_ + 32 * FA_VROW + 8) = make_uint2(v1.z, v1.w); \
                        *(uint2*)(vb_ + 64 * FA_VROW) = make_uint2(v2.x, v2.y); *(uint2*)(vb_ + 64 * FA_VROW + 8) = make_uint2(v2.z, v2.w); \
                        *(uint2*)(vb_ + 96 * FA_VROW) = make_uint2(v3.x, v3.y); *(uint2*)(vb_ + 96 * FA_VROW + 8) = make_uint2(v3.z, v3.w); }
    f32x16 o[4];
#pragma unroll
    for (int db = 0; db < 4; ++db)
#pragma unroll
        for (int i = 0; i < 16; ++i) o[db][i] = 0.f;
    float m = -1e30f, l = 0.f;
    DA_LOAD(0)
    __syncthreads();
    DA_STORE(smem)
    __syncthreads();
    for (int t = 0; t < ntile; ++t) {
        char* cur = smem + (t & 1) * DA_BUFB;
        char* nxt = smem + ((t + 1) & 1) * DA_BUFB;
        if (t + 1 < ntile) DA_LOAD((t + 1) * 64)
        flash_tile<4, false>(qf, o, m, l, cur + mp * 9216, cur + 18432, lane, 0, 0);
        if (t + 1 < ntile) DA_STORE(nxt)
        __syncthreads();
    }
#undef DA_LOAD
#undef DA_STORE
    const float inv = 1.f / (l + SHX(l, 32));
#pragma unroll
    for (int db = 0; db < 4; ++db) o[db] = o[db] * inv;
    float* X = (float*)smem + qg * 4096;
    if (mp == 1) {
#pragma unroll
        for (int db = 0; db < 4; ++db)
#pragma unroll
            for (int r = 0; r < 16; ++r) X[(db * 32 + (r & 3) + 8 * (r >> 2) + 4 * hh) * 32 + jq] = o[db][r];
    }
    __syncthreads();
    if (mp == 0) {
        const float lam_init = 0.8f - 0.6f * expf(-0.3f * (float)L);
        const float* lp = p.ev_da_lam + (size_t)j * 256;
        float a0 = lp[lane] * lp[64 + lane], a1 = lp[128 + lane] * lp[192 + lane];
        a0 = wave_sum(a0); a1 = wave_sum(a1);
        const float lam = expf(a0) - expf(a1) + lam_init;
        float ss = 0.f;
#pragma unroll
        for (int db = 0; db < 4; ++db)
#pragma unroll
            for (int r = 0; r < 16; ++r) { const float v = o[db][r] - lam * X[(db * 32 + (r & 3) + 8 * (r >> 2) + 4 * hh) * 32 + jq]; o[db][r] = v; ss += v * v; }
        ss += SHX(ss, 32);
        const float sc = rsqrtf(ss * (1.f / 128.f) + 1e-6f) * (1.f - lam_init);
        const int row = lat ? b * 2048 + qi : NL + b * 256 + qi;
        bf16_t* mrow = p.MIX + (size_t)row * DM + 512 + h * 128;
        const float* g = p.ev_da_g + (size_t)j * 512 + h * 128;
#pragma unroll
        for (int db = 0; db < 4; ++db)
#pragma unroll
            for (int r4 = 0; r4 < 4; ++r4) {
                const int d = db * 32 + 8 * r4 + 4 * hh;
                const f32x4 gg = *(const f32x4*)(g + d);
                *(uint2*)(mrow + d) = make_uint2(cvt_pk_bf16(o[db][r4 * 4 + 0] * sc * gg[0], o[db][r4 * 4 + 1] * sc * gg[1]), cvt_pk_bf16(o[db][r4 * 4 + 2] * sc * gg[2], o[db][r4 * 4 + 3] * sc * gg[3]));
            }
    }
    __syncthreads();
}

#define WA_BUFB 17920
__device__ void wa_block(const P& p, int item, int j, char* smem) {
    const int tid = otid(), lane = tid & 63, wid = tid >> 6, jq = lane & 31, hh = lane >> 5;
    const bool lat = item < 2048;
    int b, nb, hq;
    if (lat) { hq = item & 15; nb = (item >> 4) & 15; b = item >> 8; } else { const int it = item - 2048; hq = it & 15; nb = (it >> 4) & 1; b = it >> 5; }
    const int hkv = hq >> 2;
    const int qi = nb * 128 + wid * 32 + jq;
    const bf16_t* qp = lat ? p.AQL + ((size_t)(b * 16 + hq) * 2048 + qi) * 64 : p.AQC + ((size_t)(b * 16 + hq) * 256 + qi) * 64;
    bf16x8 qf[4];
#pragma unroll
    for (int ks = 0; ks < 4; ++ks) qf[ks] = *(const bf16x8*)(qp + (2 * ks + hh) * 8);
    const int lfirst = (nb == 0) ? 2 : 0, nloc = lat ? 6 - lfirst - ((nb == 15) ? 2 : 0) : 0;
    const int ntile = 4 + nloc;
    const bf16_t* kg = p.AK + (size_t)(b * 4 + hkv) * 2304 * 64 + (size_t)(tid >> 3) * 64 + (tid & 7) * 8;
    const bf16_t* vg = p.AV + (size_t)(b * 4 + hkv) * 64 * 2304 + (size_t)(tid >> 3) * 2304 + (tid & 7) * 8;
    uint4 k0, k1, v0, v1;
#define WA_KEY0(T) ((T) < 4 ? (T) * 64 : 256 + (nb - 1) * 128 + ((T) - 4 + lfirst) * 64)
#define WA_LOAD(KEY0) { k0 = *(const uint4*)(kg + (size_t)(KEY0) * 64); k1 = *(const uint4*)(kg + (size_t)((KEY0) + 32) * 64); v0 = *(const uint4*)(vg + (KEY0)); v1 = *(const uint4*)(vg + (size_t)32 * 2304 + (KEY0)); }
#define WA_STORE(BUF) { char* kb_ = (BUF) + (tid >> 3) * FA_KROW + (tid & 7) * 16; *(uint4*)kb_ = k0; *(uint4*)(kb_ + 32 * FA_KROW) = k1; \
                        char* vb_ = (BUF) + 9216 + (tid >> 3) * FA_VROW + (tid & 7) * 16; \
                        *(uint2*)vb_ = make_uint2(v0.x, v0.y); *(uint2*)(vb_ + 8) = make_uint2(v0.z, v0.w); \
                        *(uint2*)(vb_ + 32 * FA_VROW) = make_uint2(v1.x, v1.y); *(uint2*)(vb_ + 32 * FA_VROW + 8) = make_uint2(v1.z, v1.w); }
    f32x16 o[2];
#pragma unroll
    for (int db = 0; db < 2; ++db)
#pragma unroll
        for (int i = 0; i < 16; ++i) o[db][i] = 0.f;
    float m = p.od_sink[j * 16 + hq] * 1.4426950408889634f, l = hh == 0 ? 1.f : 0.f;
    { const int key0 = WA_KEY0(0); WA_LOAD(key0) }
    __syncthreads();
    WA_STORE(smem)
    __syncthreads();
    for (int t = 0; t < ntile; ++t) {
        char* cur = smem + (t & 1) * WA_BUFB;
        char* nxt = smem + ((t + 1) & 1) * WA_BUFB;
        if (t + 1 < ntile) { const int key0 = WA_KEY0(t + 1); WA_LOAD(key0) }
        if (t < 4) flash_tile<2, false>(qf, o, m, l, cur, cur + 9216, lane, 0, 0);
        else flash_tile<2, true>(qf, o, m, l, cur, cur + 9216, lane, qi, WA_KEY0(t) - 256);
        if (t + 1 < ntile) WA_STORE(nxt)
        __syncthreads();
    }
#undef WA_LOAD
#undef WA_STORE
#undef WA_KEY0
    const float inv = 1.f / (l + SHX(l, 32));
    const int row = lat ? b * 2048 + qi : NL + b * 256 + qi;
    bf16_t* mrow = p.MIX + (size_t)row * DM + hq * 64;
#pragma unroll
    for (int db = 0; db < 2; ++db)
#pragma unroll
        for (int r4 = 0; r4 < 4; ++r4) {
            const int d = db * 32 + 8 * r4 + 4 * hh;
            *(uint2*)(mrow + d) = make_uint2(cvt_pk_bf16(o[db][r4 * 4 + 0] * inv, o[db][r4 * 4 + 1] * inv), cvt_pk_bf16(o[db][r4 * 4 + 2] * inv, o[db][r4 * 4 + 3] * inv));
        }
}

__device__ __forceinline__ int ml_row(int b, int tc, int i) { return tc < 4 ? NL + b * 256 + tc * 64 + i : b * 2048 + (tc - 4) * 64 + i; }
__device__ __forceinline__ void ml_gates(const P& p, int j, int b, int h, int dir, int tc, int lane, float* sa, float* sb, float* sml, float& Bt, float& Mc) {
    const int row = ml_row(b, tc, lane);
    const float ig = p.GT[(size_t)row * 16 + (dir * 2) * 4 + h] + p.ev_gate_b[j * 16 + (dir * 2) * 4 + h];
    const float lf = log_sigmoid_f(p.GT[(size_t)row * 16 + (dir * 2 + 1) * 4 + h] + p.ev_gate_b[j * 16 + (dir * 2 + 1) * 4 + h]);
    float bc = lf;
    if (dir == 0) {
#pragma unroll
        for (int o = 1; o < 64; o <<= 1) { const float t2 = lshfl(bc, lane - o); if (lane >= o) bc += t2; }
    } else {
#pragma unroll
        for (int o = 1; o < 64; o <<= 1) { const float t2 = lshfl(bc, lane + o); if (lane + o < 64) bc += t2; }
    }
    const float a = ig - bc;
    float ml = a;
    if (dir == 0) {
#pragma unroll
        for (int o = 1; o < 64; o <<= 1) { const float t2 = lshfl(ml, lane - o); if (lane >= o) ml = fmaxf(ml, t2); }
    } else {
#pragma unroll
        for (int o = 1; o < 64; o <<= 1) { const float t2 = lshfl(ml, lane + o); if (lane + o < 64) ml = fmaxf(ml, t2); }
    }
    sa[lane] = a; sb[lane] = bc; sml[lane] = ml;
    const int last = dir == 0 ? 63 : 0;
    Bt = lshfl(bc, last); Mc = lshfl(ml, last);
}
__device__ __forceinline__ int ml_tc_of(int dir, int c) { return dir == 0 ? c : (c < 4 ? 3 - c : 39 - c); }
__device__ __forceinline__ int ml_c_of(int dir, int tc) { return dir == 0 ? tc : (tc < 4 ? 3 - tc : 39 - tc); }

__device__ void ml_pass1_item(const P& p, int item, int j, char* smem) {
    const int c = item % 36, dir = (item / 36) & 1, h = (item / 72) & 3, b = item / 288;
    const int tc = ml_tc_of(dir, c);
    const int tid = otid(), lane = tid & 63, wid = tid >> 6, jl = lane & 31, hh = lane >> 5;
    bf16_t* VT = (bf16_t*)smem;
    bf16_t* KWT = (bf16_t*)(smem + 18432);
    float* sa = (float*)(smem + 27648);
    float* sb = sa + 64; float* sml = sb + 64; float* sw = sml + 64; float* ssc = sw + 64;
    __syncthreads();
    if (wid == 0) {
        float Bt, Mc; ml_gates(p, j, b, h, dir, tc, lane, sa, sb, sml, Bt, Mc);
        sw[lane] = expf(sa[lane] - Mc);
        if (lane == 0) { p.CHB[item] = Bt; p.CHM[item] = Mc; }
    }
    __syncthreads();
#pragma unroll
    for (int i = 0; i < 4; ++i) {
        const int e = tid + 256 * i, st = e >> 4, ch = e & 15;
        const uint4 u = *(const uint4*)(p.PB + (size_t)ml_row(b, tc, st) * 1536 + 512 + h * 128 + ch * 8);
        bf16_t* d = VT + (ch * 8) * 72 + st;
        d[0] = (bf16_t)u.x; d[72] = (bf16_t)(u.x >> 16); d[144] = (bf16_t)u.y; d[216] = (bf16_t)(u.y >> 16);
        d[288] = (bf16_t)u.z; d[360] = (bf16_t)(u.z >> 16); d[432] = (bf16_t)u.w; d[504] = (bf16_t)(u.w >> 16);
    }
#pragma unroll
    for (int i = 0; i < 2; ++i) {
        const int e = tid + 256 * i, st = e >> 3, ch = e & 7;
        const uint4 u = *(const uint4*)(p.QKB + (size_t)ml_row(b, tc, st) * 512 + 256 + h * 64 + ch * 8);
        const float w = sw[st];
        bf16_t* d = KWT + (ch * 8) * 72 + st;
        const unsigned q0 = cvt_pk_bf16(bf_lo(u.x) * w, bf_hi(u.x) * w), q1 = cvt_pk_bf16(bf_lo(u.y) * w, bf_hi(u.y) * w), q2 = cvt_pk_bf16(bf_lo(u.z) * w, bf_hi(u.z) * w), q3 = cvt_pk_bf16(bf_lo(u.w) * w, bf_hi(u.w) * w);
        d[0] = (bf16_t)q0; d[72] = (bf16_t)(q0 >> 16); d[144] = (bf16_t)q1; d[216] = (bf16_t)(q1 >> 16);
        d[288] = (bf16_t)q2; d[360] = (bf16_t)(q2 >> 16); d[432] = (bf16_t)q3; d[504] = (bf16_t)(q3 >> 16);
    }
    __syncthreads();
    {
        const int db = wid & 1, vb0 = (wid >> 1) * 2;
        bf16x8 kf[4];
#pragma unroll
        for (int ks = 0; ks < 4; ++ks) kf[ks] = *(const bf16x8*)((const char*)KWT + (db * 32 + jl) * 144 + (2 * ks + hh) * 16);
        float* cl = p.CLOC + (size_t)item * 8192;
#pragma unroll
        for (int vv = 0; vv < 2; ++vv) {
            const int vb = vb0 + vv;
            f32x16 acc;
#pragma unroll
            for (int r = 0; r < 16; ++r) acc[r] = 0.f;
#pragma unroll
            for (int ks = 0; ks < 4; ++ks) {
                const bf16x8 vf = *(const bf16x8*)((const char*)VT + (vb * 32 + jl) * 144 + (2 * ks + hh) * 16);
                acc = __builtin_amdgcn_mfma_f32_32x32x16_bf16(vf, kf[ks], acc, 0, 0, 0);
            }
#pragma unroll
            for (int r = 0; r < 16; ++r) cl[(size_t)(vb * 32 + (r & 3) + 8 * (r >> 2) + 4 * hh) * 64 + db * 32 + jl] = acc[r];
        }
        if (tid < 64) {
            float sum = 0.f;
#pragma unroll
            for (int q = 0; q < 8; ++q) { const uint4 u = *(const uint4*)((const char*)KWT + tid * 144 + q * 16); sum += bf_lo(u.x) + bf_hi(u.x) + bf_lo(u.y) + bf_hi(u.y) + bf_lo(u.z) + bf_hi(u.z) + bf_lo(u.w) + bf_hi(u.w); }
            p.NLOC[(size_t)item * 64 + tid] = sum;
        }
    }
}

__device__ void ph_ml_pass2(const P& p) {
    const int gt = blockIdx.x * 256 + otid(), nthr = gridDim.x * 256;
    for (int w = gt; w < 64 * 2048; w += nthr) {
        const int chain = w >> 11, e = (w & 2047) * 4;
        float c0 = 0.f, c1 = 0.f, c2 = 0.f, c3 = 0.f, m = 0.f;
        for (int c = 0; c < 36; ++c) {
            const int it = chain * 36 + c;
            *(uint2*)(p.CST + (size_t)it * 8192 + e) = make_uint2(cvt_pk_bf16(c0, c1), cvt_pk_bf16(c2, c3));
            const float Bt = p.CHB[it], Mc = p.CHM[it];
            const float g = fmaxf(m, Mc), al = expf(m - g), be = expf(Mc - g);
            const float4 cl = *(const float4*)(p.CLOC + (size_t)it * 8192 + e);
            c0 = al * c0 + be * cl.x; c1 = al * c1 + be * cl.y; c2 = al * c2 + be * cl.z; c3 = al * c3 + be * cl.w;
            m = Bt + g;
        }
    }
    for (int w = gt; w < 64 * 64; w += nthr) {
        const int chain = w >> 6, d = w & 63;
        float n = 0.f, m = 0.f;
        for (int c = 0; c < 36; ++c) {
            const int it = chain * 36 + c;
            p.NST[(size_t)it * 64 + d] = n;
            if (d == 0) p.MST[it] = m;
            const float Bt = p.CHB[it], Mc = p.CHM[it];
            const float g = fmaxf(m, Mc);
            n = expf(m - g) * n + expf(Mc - g) * p.NLOC[(size_t)it * 64 + d];
            m = Bt + g;
        }
    }
}

__device__ void ml_pass3_item(const P& p, int item, int j, char* smem) {
    const int tc = item % 36, h = (item / 36) & 3, b = item / 144;
    const int tid = otid(), lane = tid & 63, wid = tid >> 6, jl = lane & 31, hh = lane >> 5, tb = wid & 1, dir = wid >> 1;
    char* Ql = smem;
    char* Kl = smem + 9216;
    bf16_t* VT = (bf16_t*)(smem + 18432);
    float* gs = (float*)(smem + 35840);
    float* ssc = gs + 512;
    __syncthreads();
    if (wid < 2) {
        const int d2 = wid; float Bt, Mc;
        float* sa = gs + d2 * 256; float* sb = sa + 64; float* sg = sb + 64; float* sn = sg + 64;
        ml_gates(p, j, b, h, d2, tc, lane, sa, sb, sg, Bt, Mc);
        const int sidx = ((b * 4 + h) * 2 + d2) * 36 + ml_c_of(d2, tc);
        const float mst = p.MST[sidx];
        sg[lane] = fmaxf(mst, sg[lane]);
        sn[lane] = p.NST[(size_t)sidx * 64 + lane];
        if (lane == 0) ssc[d2] = mst;
    }
#pragma unroll
    for (int i = 0; i < 2; ++i) {
        const int e = tid + 256 * i, st = e >> 3, ch = e & 7; const int row = ml_row(b, tc, st);
        *(uint4*)(Ql + st * 144 + ch * 16) = *(const uint4*)(p.QKB + (size_t)row * 512 + h * 64 + ch * 8);
        *(uint4*)(Kl + st * 144 + ch * 16) = *(const uint4*)(p.QKB + (size_t)row * 512 + 256 + h * 64 + ch * 8);
    }
#pragma unroll
    for (int i = 0; i < 4; ++i) {
        const int e = tid + 256 * i, st = e >> 4, ch = e & 15;
        const uint4 u = *(const uint4*)(p.PB + (size_t)ml_row(b, tc, st) * 1536 + 512 + h * 128 + ch * 8);
        bf16_t* d = VT + (ch * 8) * 68 + st;
        d[0] = (bf16_t)u.x; d[68] = (bf16_t)(u.x >> 16); d[136] = (bf16_t)u.y; d[204] = (bf16_t)(u.y >> 16);
        d[272] = (bf16_t)u.z; d[340] = (bf16_t)(u.z >> 16); d[408] = (bf16_t)u.w; d[476] = (bf16_t)(u.w >> 16);
    }
    __syncthreads();
    const float* sa = gs + dir * 256; const float* sb = sa + 64; const float* sg = sb + 64; const float* sn = sg + 64;
    const int t = tb * 32 + jl;
    const float gtv = sg[t], btv = sb[t], mst = ssc[dir];
    const float e2 = expf(mst - gtv);
    const int sidx = ((b * 4 + h) * 2 + dir) * 36 + ml_c_of(dir, tc);
    bf16x8 qf[4];
#pragma unroll
    for (int ks = 0; ks < 4; ++ks) qf[ks] = *(const bf16x8*)(Ql + t * 144 + (2 * ks + hh) * 16);
    f32x16 acc[4];
    {
        const bf16_t* cst = p.CST + (size_t)sidx * 8192 + (size_t)jl * 64 + hh * 8;
#pragma unroll
        for (int vb = 0; vb < 4; ++vb) {
#pragma unroll
            for (int r = 0; r < 16; ++r) acc[vb][r] = 0.f;
#pragma unroll
            for (int ks = 0; ks < 4; ++ks) {
                const bf16x8 cf = *(const bf16x8*)(cst + (size_t)vb * 32 * 64 + ks * 16);
                acc[vb] = __builtin_amdgcn_mfma_f32_32x32x16_bf16(cf, qf[ks], acc[vb], 0, 0, 0);
            }
            acc[vb] = acc[vb] * e2;
        }
    }
    float den = 0.f;
    {
        float nq = 0.f;
#pragma unroll
        for (int ks = 0; ks < 4; ++ks) {
            const u32x4 u = __builtin_bit_cast(u32x4, qf[ks]);
            const float* np = sn + 16 * ks + 8 * hh;
            nq += bf_lo(u[0]) * np[0] + bf_hi(u[0]) * np[1] + bf_lo(u[1]) * np[2] + bf_hi(u[1]) * np[3] + bf_lo(u[2]) * np[4] + bf_hi(u[2]) * np[5] + bf_lo(u[3]) * np[6] + bf_hi(u[3]) * np[7];
        }
        den = e2 * nq;
    }
#pragma unroll
    for (int sbk = 0; sbk < 2; ++sbk) {
        const bool use = dir == 0 ? (sbk <= tb) : (sbk >= tb);
        if (use) {
            f32x16 sc;
#pragma unroll
            for (int r = 0; r < 16; ++r) sc[r] = 0.f;
#pragma unroll
            for (int ks = 0; ks < 4; ++ks) {
                const bf16x8 kf = *(const bf16x8*)(Kl + (sbk * 32 + jl) * 144 + (2 * ks + hh) * 16);
                sc = __builtin_amdgcn_mfma_f32_32x32x16_bf16(kf, qf[ks], sc, 0, 0, 0);
            }
#pragma unroll
            for (int r4 = 0; r4 < 4; ++r4) {
                const int s0 = sbk * 32 + 8 * r4 + 4 * hh;
                const f32x4 av = *(const f32x4*)(sa + s0);
#pragma unroll
                for (int q = 0; q < 4; ++q) {
                    const int s2 = s0 + q;
                    const bool ok = dir == 0 ? (s2 <= t) : (s2 >= t);
                    const float pv = ok ? sc[r4 * 4 + q] * expf(av[q] - gtv) : 0.f;
                    sc[r4 * 4 + q] = pv; den += pv;
                }
            }
            bf16x8 pb[2];
            pb[0] = pack8(sc[0], sc[1], sc[2], sc[3], sc[4], sc[5], sc[6], sc[7]);
            pb[1] = pack8(sc[8], sc[9], sc[10], sc[11], sc[12], sc[13], sc[14], sc[15]);
#pragma unroll
            for (int vb = 0; vb < 4; ++vb)
#pragma unroll
                for (int k2 = 0; k2 < 2; ++k2) {
                    const char* vp = (const char*)VT + (vb * 32 + jl) * 136 + (sbk * 32 + k2 * 16 + 4 * hh) * 2;
                    const uint2 lo = *(const uint2*)vp, hi = *(const uint2*)(vp + 16);
                    const u32x4 u = (u32x4){lo.x, lo.y, hi.x, hi.y};
                    acc[vb] = __builtin_amdgcn_mfma_f32_32x32x16_bf16(__builtin_bit_cast(bf16x8, u), pb[k2], acc[vb], 0, 0, 0);
                }
        }
    }
    den += SHX(den, 32);
    const float scl = 1.f / fmaxf(fabsf(den), expf(-(btv + gtv)));
#pragma unroll
    for (int vb = 0; vb < 4; ++vb) acc[vb] = acc[vb] * scl;
    __syncthreads();
    float* X = (float*)smem + tb * 4096;
    if (dir == 1) {
#pragma unroll
        for (int vb = 0; vb < 4; ++vb)
#pragma unroll
            for (int r = 0; r < 16; ++r) X[(vb * 32 + (r & 3) + 8 * (r >> 2) + 4 * hh) * 32 + jl] = acc[vb][r];
    }
    __syncthreads();
    if (dir == 0) {
        float ss = 0.f;
#pragma unroll
        for (int vb = 0; vb < 4; ++vb)
#pragma unroll
            for (int r = 0; r < 16; ++r) { const float v = acc[vb][r] + X[(vb * 32 + (r & 3) + 8 * (r >> 2) + 4 * hh) * 32 + jl]; acc[vb][r] = v; ss += v * v; }
        ss += SHX(ss, 32);
        const float rstd = rsqrtf(ss * (1.f / 128.f) + 1e-6f);
        const int row = ml_row(b, tc, t);
        const float* g = p.ev_ml_g + (size_t)j * 512 + h * 128;
        const bf16_t* og = p.PB + (size_t)row * 1536 + 1024 + h * 128;
        bf16_t* mrow = p.MIX + (size_t)row * DM + h * 128;
#pragma unroll
        for (int vb = 0; vb < 4; ++vb)
#pragma unroll
            for (int r4 = 0; r4 < 4; ++r4) {
                const int v = vb * 32 + 8 * r4 + 4 * hh;
                const f32x4 gg = *(const f32x4*)(g + v);
                const uint2 ou = *(const uint2*)(og + v);
                *(uint2*)(mrow + v) = make_uint2(cvt_pk_bf16(acc[vb][r4 * 4 + 0] * rstd * gg[0] * sigmoid_f(bf_lo(ou.x)), acc[vb][r4 * 4 + 1] * rstd * gg[1] * sigmoid_f(bf_hi(ou.x))),
                                                 cvt_pk_bf16(acc[vb][r4 * 4 + 2] * rstd * gg[2] * sigmoid_f(bf_lo(ou.y)), acc[vb][r4 * 4 + 3] * rstd * gg[3] * sigmoid_f(bf_hi(ou.y))));
            }
    }
}

__device__ void ph_attn_even(const P& p, int ci, int L, int j, float* smem) {
    int* s_item = (int*)((char*)smem + 73728);
    for (;;) {
        __syncthreads();
        if (otid() == 0) *s_item = atomicAdd(&p.ctr[ci], 1);
        __syncthreads();
        const int item = *s_item;
        if (item >= 1152 + 2304) break;
        if (item < 1152) da_block(p, item, L, j, (char*)smem); else ml_pass1_item(p, item - 1152, j, (char*)smem);
    }
}
__device__ void ph_ml_pass3(const P& p, int j, float* smem) {
    for (int item = blockIdx.x; item < 1152; item += gridDim.x) ml_pass3_item(p, item, j, (char*)smem);
}
__device__ void ph_attn_odd(const P& p, int j, bool need_ctx, float* smem) {
    const int nitem = need_ctx ? 2304 : 2048;
    for (int item = blockIdx.x; item < nitem; item += gridDim.x) { wa_block(p, item, j, (char*)smem); __syncthreads(); }
}

#define SEL_LD 132
__device__ __forceinline__ unsigned fkey(float f) { const unsigned u = __float_as_uint(f); return (u & 0x80000000u) ? ~u : (u | 0x80000000u); }
__device__ __forceinline__ unsigned mbcnt64(unsigned long long m) { return __builtin_amdgcn_mbcnt_hi((unsigned)(m >> 32), __builtin_amdgcn_mbcnt_lo((unsigned)m, 0u)); }
__device__ void ph_peer_select(const P& p, int L, int nrows, char* smem) {
    float* S = (float*)smem;
    const int tid = otid(), lane = tid & 63, wid = tid >> 6, fr = lane & 15, fq = lane >> 4;
    const bf16_t* KBL = p.KB + (size_t)L * 8 * 2 * 128 * 128;
    const int ntile = nrows / 32;
    bf16x8 kfr[8][4];
    int hcur = -1;
    for (int item = blockIdx.x; item < ntile * 8; item += gridDim.x) {
        const int h = item & 7, t0 = (item >> 3) * 32;
        __syncthreads();
        {
            const int pp = wid >> 1, th = wid & 1;
            const bf16_t* qp = p.QB + (size_t)(t0 + th * 16 + fr) * 2048 + h * 256 + pp * 128 + fq * 8;
            bf16x8 qf[4];
#pragma unroll
            for (int ks = 0; ks < 4; ++ks) qf[ks] = *(const bf16x8*)(qp + ks * 32);
            if (h != hcur) {
                const bf16_t* kp = KBL + ((size_t)(h * 2 + pp) * 128 + fr) * 128 + fq * 8;
#pragma unroll
                for (int ni = 0; ni < 8; ++ni)
#pragma unroll
                    for (int ks = 0; ks < 4; ++ks) kfr[ni][ks] = *(const bf16x8*)(kp + (size_t)ni * 16 * 128 + ks * 32);
                hcur = h;
            }
#pragma unroll
            for (int ni = 0; ni < 8; ++ni) {
                f32x4 acc = (f32x4){0.f, 0.f, 0.f, 0.f};
#pragma unroll
                for (int ks = 0; ks < 4; ++ks) acc = __builtin_amdgcn_mfma_f32_16x16x32_bf16(qf[ks], kfr[ni][ks], acc, 0, 0, 0);
#pragma unroll
                for (int j = 0; j < 4; ++j) S[(pp * 32 + th * 16 + fq * 4 + j) * SEL_LD + ni * 16 + fr] = acc[j];
            }
        }
        __syncthreads();
        for (int tt = 0; tt < 8; ++tt) {
            const int t = wid * 8 + tt, r = t0 + t;
            const float v00 = S[t * SEL_LD + lane], v01 = S[t * SEL_LD + 64 + lane], v10 = S[(32 + t) * SEL_LD + lane], v11 = S[(32 + t) * SEL_LD + 64 + lane];
            const unsigned ka0 = fkey(v00), ka1 = fkey(v01), kb0 = fkey(v10), kb1 = fkey(v11);
            unsigned T0 = 0u, T1 = 0u; bool dn0 = false, dn1 = false;
            for (int bit = 31; bit >= 0 && !(dn0 && dn1); --bit) {
                if (!dn0) { const unsigned c0 = T0 | (1u << bit); const int n0 = __builtin_popcountll(__ballot(ka0 >= c0)) + __builtin_popcountll(__ballot(ka1 >= c0)); if (n0 >= 16) T0 = c0; dn0 = (n0 == 16); }
                if (!dn1) { const unsigned c1 = T1 | (1u << bit); const int n1 = __builtin_popcountll(__ballot(kb0 >= c1)) + __builtin_popcountll(__ballot(kb1 >= c1)); if (n1 >= 16) T1 = c1; dn1 = (n1 == 16); }
            }
            float* wsA = (float*)(smem + 34816 + wid * 512);
            {
                const unsigned long long g0 = __ballot(ka0 > T0), g1 = __ballot(ka1 > T0), e0 = __ballot(ka0 == T0), e1 = __ballot(ka1 == T0);
                const int need = 16 - __builtin_popcountll(g0) - __builtin_popcountll(g1);
                const int pe0 = __builtin_popcountll(e0), need1 = need - (pe0 < need ? pe0 : need);
                const bool s0 = (ka0 > T0) || (ka0 == T0 && (int)mbcnt64(e0) < need);
                const bool s1 = (ka1 > T0) || (ka1 == T0 && (int)mbcnt64(e1) < need1);
                const unsigned long long m0 = __ballot(s0), m1 = __ballot(s1);
                if (s0) { const int pos = mbcnt64(m0); wsA[pos] = v00; ((int*)wsA)[16 + pos] = lane; }
                if (s1) { const int pos = __builtin_popcountll(m0) + mbcnt64(m1); wsA[pos] = v01; ((int*)wsA)[16 + pos] = 64 + lane; }
            }
            {
                const unsigned long long g0 = __ballot(kb0 > T1), g1 = __ballot(kb1 > T1), e0 = __ballot(kb0 == T1), e1 = __ballot(kb1 == T1);
                const int need = 16 - __builtin_popcountll(g0) - __builtin_popcountll(g1);
                const int pe0 = __builtin_popcountll(e0), need1 = need - (pe0 < need ? pe0 : need);
                const bool s0 = (kb0 > T1) || (kb0 == T1 && (int)mbcnt64(e0) < need);
                const bool s1 = (kb1 > T1) || (kb1 == T1 && (int)mbcnt64(e1) < need1);
                const unsigned long long m0 = __ballot(s0), m1 = __ballot(s1);
                if (s0) { const int pos = mbcnt64(m0); wsA[32 + pos] = v10; ((int*)wsA)[48 + pos] = lane; }
                if (s1) { const int pos = __builtin_popcountll(m0) + mbcnt64(m1); wsA[32 + pos] = v11; ((int*)wsA)[48 + pos] = 64 + lane; }
            }
            __builtin_amdgcn_wave_barrier();
            float cand[4]; int cidx[4]; unsigned kc[4];
            {
                const float av = wsA[lane >> 2]; const int ai = ((int*)wsA)[16 + (lane >> 2)];
                const float4 bv = *(const float4*)(wsA + 32 + (lane & 3) * 4); const int4 bi = *(const int4*)((int*)wsA + 48 + (lane & 3) * 4);
                cand[0] = av + bv.x; cand[1] = av + bv.y; cand[2] = av + bv.z; cand[3] = av + bv.w;
                cidx[0] = ai * 128 + bi.x; cidx[1] = ai * 128 + bi.y; cidx[2] = ai * 128 + bi.z; cidx[3] = ai * 128 + bi.w;
#pragma unroll
                for (int c = 0; c < 4; ++c) kc[c] = fkey(cand[c]);
            }
            unsigned T = 0u;
            for (int bit = 31; bit >= 0; --bit) {
                const unsigned cc = T | (1u << bit);
                const int n = __builtin_popcountll(__ballot(kc[0] >= cc)) + __builtin_popcountll(__ballot(kc[1] >= cc)) + __builtin_popcountll(__ballot(kc[2] >= cc)) + __builtin_popcountll(__ballot(kc[3] >= cc));
                if (n >= 16) T = cc;
                if (n == 16) break;
            }
            {
                int need = 16, base = 0;
#pragma unroll
                for (int c = 0; c < 4; ++c) need -= __builtin_popcountll(__ballot(kc[c] > T));
#pragma unroll
                for (int c = 0; c < 4; ++c) {
                    const unsigned long long e = __ballot(kc[c] == T);
                    const bool sel = (kc[c] > T) || (kc[c] == T && (int)mbcnt64(e) < need);
                    const int pe = __builtin_popcountll(e); need -= (pe < need ? pe : need);
                    const unsigned long long m = __ballot(sel);
                    if (sel) { const int pos = base + mbcnt64(m); wsA[64 + pos] = cand[c]; ((int*)wsA)[80 + pos] = cidx[c]; }
                    base += __builtin_popcountll(m);
                }
            }
            __builtin_amdgcn_wave_barrier();
            {
                const float cv = lane < 16 ? wsA[64 + lane] : -INFINITY;
                const float mx = wave_max(cv);
                const float ex = lane < 16 ? __builtin_amdgcn_exp2f((cv - mx) * 1.4426950408889634f) : 0.f;
                const float sum = wave_sum(ex);
                if (lane < 16) { p.GATE[(size_t)r * 128 + h * 16 + lane] = ex / sum; p.EIDX[(size_t)r * 128 + h * 16 + lane] = ((int*)wsA)[80 + lane]; }
            }
            __builtin_amdgcn_wave_barrier();
        }
    }
}


__device__ __forceinline__ void unpack8(const uint4 u, float* f) {
    f[0] = bf_lo(u.x); f[1] = bf_hi(u.x); f[2] = bf_lo(u.y); f[3] = bf_hi(u.y); f[4] = bf_lo(u.z); f[5] = bf_hi(u.z); f[6] = bf_lo(u.w); f[7] = bf_hi(u.w);
}
__device__ __forceinline__ void unpack16_u8(const uint4 u, float* f) {
    f[0] = (float)(u.x & 0xffu); f[1] = (float)((u.x >> 8) & 0xffu); f[2] = (float)((u.x >> 16) & 0xffu); f[3] = (float)((u.x >> 24) & 0xffu);
    f[4] = (float)(u.y & 0xffu); f[5] = (float)((u.y >> 8) & 0xffu); f[6] = (float)((u.y >> 16) & 0xffu); f[7] = (float)((u.y >> 24) & 0xffu);
    f[8] = (float)(u.z & 0xffu); f[9] = (float)((u.z >> 8) & 0xffu); f[10] = (float)((u.z >> 16) & 0xffu); f[11] = (float)((u.z >> 24) & 0xffu);
    f[12] = (float)(u.w & 0xffu); f[13] = (float)((u.w >> 8) & 0xffu); f[14] = (float)((u.w >> 16) & 0xffu); f[15] = (float)((u.w >> 24) & 0xffu);
}
__device__ void ph_peer_gather(const P& p, int L, int nrows, float oscale) {
    const int lane = otid() & 63, wid = otid() >> 6;
    const unsigned char* U = p.U8 + (size_t)L * 16384 * 1024; const unsigned char* V = p.V8 + (size_t)L * 16384 * 1024;
    const float* USC = p.USC + (size_t)L * 16384; const float* VSC = p.VSC + (size_t)L * 16384;
    const float* gate2 = p.modv + (size_t)L * 9 * 6144 + 5120;
    for (int r = blockIdx.x * 4 + wid; r < nrows; r += gridDim.x * 4) {
        const int e0 = p.EIDX[(size_t)r * 128 + lane], e1 = p.EIDX[(size_t)r * 128 + 64 + lane];
        const float g0 = p.GATE[(size_t)r * 128 + lane], g1 = p.GATE[(size_t)r * 128 + 64 + lane];
        const float us0 = USC[e0], us1 = USC[e1], vs0 = VSC[e0], vs1 = VSC[e1];
        float x[16];
        { const uint4 xa = *(const uint4*)(p.XN + (size_t)r * DM + lane * 16), xb = *(const uint4*)(p.XN + (size_t)r * DM + lane * 16 + 8); unpack8(xa, x); unpack8(xb, x + 8); }
        float sx = 0.f;
#pragma unroll
        for (int c = 0; c < 16; ++c) sx += x[c];
        sx = wave_sum(sx);
        float a0 = 0.f, a1 = 0.f;
#pragma unroll
        for (int half = 0; half < 2; ++half) {
            const int ev = half ? e1 : e0;
            float av = 0.f;
            for (int kb = 0; kb < 4; ++kb) {
                uint4 ua[16];
#pragma unroll
                for (int j = 0; j < 16; ++j) {
                    const int idx = __builtin_amdgcn_readlane(ev, kb * 16 + j);
                    ua[j] = *(const uint4*)(U + (size_t)idx * 1024 + lane * 16);
                }
#pragma unroll
                for (int j = 0; j < 16; ++j) {
                    float f[16]; unpack16_u8(ua[j], f);
                    float s = 0.f;
#pragma unroll
                    for (int c = 0; c < 16; ++c) s += x[c] * f[c];
                    s = wave_sum(s);
                    if (lane == kb * 16 + j) av = s;
                }
            }
            if (half) a1 = av; else a0 = av;
        }
        a0 = us0 * (a0 - 128.f * sx); a1 = us1 * (a1 - 128.f * sx);
        const float w0 = vs0 * g0 * 0.5f * a0 * (1.f + erff(a0 * 0.70710678118654752f));
        const float w1 = vs1 * g1 * 0.5f * a1 * (1.f + erff(a1 * 0.70710678118654752f));
        const float wsum = wave_sum(w0 + w1);
        float acc[16];
#pragma unroll
        for (int c = 0; c < 16; ++c) acc[c] = 0.f;
#pragma unroll
        for (int half = 0; half < 2; ++half) {
            const int ev = half ? e1 : e0; const int wv = __float_as_int(half ? w1 : w0);
            for (int kb = 0; kb < 4; ++kb) {
                uint4 ua[16];
#pragma unroll
                for (int j = 0; j < 16; ++j) {
                    const int idx = __builtin_amdgcn_readlane(ev, kb * 16 + j);
                    ua[j] = *(const uint4*)(V + (size_t)idx * 1024 + lane * 16);
                }
#pragma unroll
                for (int j = 0; j < 16; ++j) {
                    const float wj = __int_as_float(__builtin_amdgcn_readlane(wv, kb * 16 + j));
                    float f[16]; unpack16_u8(ua[j], f);
#pragma unroll
                    for (int c = 0; c < 16; ++c) acc[c] += wj * f[c];
                }
            }
        }
        const float* gp = gate2 + (size_t)modrow(r) * 6144 + lane * 16;
        float* hp = p.H + (size_t)r * DM + lane * 16;
        float hn[16]; float ss = 0.f;
#pragma unroll
        for (int q = 0; q < 4; ++q) {
            const float4 g = *(const float4*)(gp + q * 4);
            float4 hv = *(float4*)(hp + q * 4);
            hv.x += oscale * g.x * (acc[q * 4 + 0] - 128.f * wsum); hv.y += oscale * g.y * (acc[q * 4 + 1] - 128.f * wsum);
            hv.z += oscale * g.z * (acc[q * 4 + 2] - 128.f * wsum); hv.w += oscale * g.w * (acc[q * 4 + 3] - 128.f * wsum);
            if (L < 3) *(float4*)(hp + q * 4) = hv;
            hn[q * 4 + 0] = hv.x; hn[q * 4 + 1] = hv.y; hn[q * 4 + 2] = hv.z; hn[q * 4 + 3] = hv.w;
            ss += hv.x * hv.x + hv.y * hv.y + hv.z * hv.z + hv.w * hv.w;
        }
        ss = wave_sum(ss);
        const float rstd = rsqrtf(ss * (1.0f / DM) + 1e-6f);
        if (L < 3) {
            const float* g1 = p.norm1_g + (size_t)(L + 1) * DM + lane * 16;
            const float* mvn = p.modv + ((size_t)(L + 1) * 9 + modrow(r)) * 6144 + lane * 16;
            unsigned w[8];
#pragma unroll
            for (int q = 0; q < 4; ++q) {
                const float4 gg = *(const float4*)(g1 + q * 4), sh = *(const float4*)(mvn + q * 4), scl = *(const float4*)(mvn + 1024 + q * 4);
                w[q * 2] = cvt_pk_bf16(hn[q * 4 + 0] * rstd * gg.x * (1.f + scl.x) + sh.x, hn[q * 4 + 1] * rstd * gg.y * (1.f + scl.y) + sh.y);
                w[q * 2 + 1] = cvt_pk_bf16(hn[q * 4 + 2] * rstd * gg.z * (1.f + scl.z) + sh.z, hn[q * 4 + 3] * rstd * gg.w * (1.f + scl.w) + sh.w);
            }
            uint4* xp = (uint4*)(p.XN + (size_t)r * DM + lane * 16);
            xp[0] = make_uint4(w[0], w[1], w[2], w[3]); xp[1] = make_uint4(w[4], w[5], w[6], w[7]);
        } else {
            const float* fg = p.final_g + lane * 16;
            float* op = p.out + (size_t)r * DM + lane * 16;
#pragma unroll
            for (int q = 0; q < 4; ++q) {
                const float4 gg = *(const float4*)(fg + q * 4);
                *(float4*)(op + q * 4) = make_float4(hn[q * 4 + 0] * rstd * gg.x, hn[q * 4 + 1] * rstd * gg.y, hn[q * 4 + 2] * rstd * gg.z, hn[q * 4 + 3] * rstd * gg.w);
            }
        }
    }
}

#define NSUB 11
__device__ __forceinline__ bool phase_empty(int ph) {
    if (ph == 0) return false;
    const int L = (ph - 1) / NSUB, s = (ph - 1) % NSUB;
    return ((L & 1) && (s == 2 || s == 4 || s == 5)) || (L > 0 && s == 0);
}
__device__ void run_phase(const P& p, int ph, float* smem, int rep) {
    if (ph == 0) { ph_prologue(p, smem); return; }
    const int L = (ph - 1) / NSUB, s = (ph - 1) % NSUB, j = L >> 1;
    const bool even = (L & 1) == 0, need_ctx = L < 3;
    const int nrows = need_ctx ? NT : NL;
    const float* mv = p.modv + (size_t)L * 9 * 6144;
    switch (s) {
    case 0: ph_normmod(p.H, p.norm1_g + L * DM, mv, 0, 1024, p.XN, NT); break;
    case 1:
        if (even) ph_gemm(p.XN, p.WT + WT_EVIN(j), NT, 3200, EpiEven{p.PB, p.AQL, p.AQC, p.AK, p.AV, p.GT, p.rope}, (char*)smem);
        else ph_gemm(p.XN, p.WT + WT_ODIN(j), NT, ODW, EpiOdd{p.AQL, p.AQC, p.AK, p.AV, p.rope}, (char*)smem);
        break;
    case 2: if (even) ph_prep_even(p, j); break;
    case 3: if (even) ph_attn_even(p, L + 4 * rep, L, j, smem); else ph_attn_odd(p, j, need_ctx, smem); break;
    case 4: if (even) ph_ml_pass2(p); break;
    case 5: if (even) ph_ml_pass3(p, j, smem); break;
    case 6: ph_gemm(p.MIX, p.WT + (even ? WT_EVOUT(j) : WT_ODOUT(j)), nrows, DM, EpiResid{p.H, mv + 2048, rep ? 0.f : 1.f}, (char*)smem); break;
    case 7: ph_normmod(p.H, p.norm2_g + L * DM, mv, 3072, 4096, p.XN, nrows); break;
    case 8: ph_gemm(p.XN, p.WT + WT_PQ(L), nrows, 2048, EpiStoreBF16{p.QB, 2048}, (char*)smem); break;
    case 9: ph_peer_select(p, L, nrows, (char*)smem); break;
    case 10: ph_peer_gather(p, L, nrows, rep ? 0.f : 1.f); break;
    }
}

#define XB_TMO      128
#define XB_XCNT(j)  (256  + 64 * (j))
#define XB_XSUB(j)  (1280 + 64 * (j))
#define XB_XGEN(j)  (2304 + 64 * (j))
#define XB_TOP      3328
#define XB_TOPGEN   3392
#define XCD_BAR_WORDS 3456
#define XB_SPIN_CAP (1u << 20)
#define LAS __attribute__((address_space(3)))
__device__ __forceinline__ unsigned xb_ld(unsigned* p)              { return __hip_atomic_load(p, __ATOMIC_RELAXED, __HIP_MEMORY_SCOPE_AGENT); }
__device__ __forceinline__ unsigned xb_add(unsigned* p, unsigned v) { return __hip_atomic_fetch_add(p, v, __ATOMIC_RELAXED, __HIP_MEMORY_SCOPE_AGENT); }
__device__ __forceinline__ unsigned xb_xcc_id() { return (unsigned)__builtin_amdgcn_s_getreg((3 << 11) | 20) & 0xFu; }
#define XB_SPIN(cond, bar) do { unsigned _sp = 0; while (cond) { __builtin_amdgcn_s_sleep(1); \
    if ((++_sp & 255u) == 0u) { if (xb_ld(&(bar)[XB_TMO])) break; if (_sp > XB_SPIN_CAP) { atomicAdd(&(bar)[XB_TMO], 1u); break; } } } } while (0)
struct XcdBarrier { unsigned* bar; unsigned x; volatile LAS unsigned* st; };
__device__ __forceinline__ XcdBarrier xcd_barrier_post(unsigned* bar, volatile LAS unsigned* st) {
    XcdBarrier b; b.bar = bar; b.x = xb_xcc_id(); b.st = st;
    if (threadIdx.x == 0) (void)xb_add(&bar[XB_XCNT(b.x)], 1u);
    return b;
}
__device__ __forceinline__ void xcd_barrier_complete(unsigned* bar, unsigned x, unsigned& nloc, unsigned& nx) {
    const unsigned G = gridDim.x * gridDim.y * gridDim.z;
    unsigned sum, cnt, mine, sp = 0u;
    for (;;) {
        sum = 0u; cnt = 0u; mine = 0u;
#pragma unroll
        for (unsigned j = 0; j < 16; ++j) { const unsigned c = xb_ld(&bar[XB_XCNT(j)]); sum += c; cnt += (c > 0u) ? 1u : 0u; mine = (j == x) ? c : mine; }
        if (sum == G) break;
        __builtin_amdgcn_s_sleep(1);
        if ((++sp & 255u) == 0u) { if (xb_ld(&bar[XB_TMO])) break; if (sp > XB_SPIN_CAP) { atomicAdd(&bar[XB_TMO], 1u); break; } }
    }
    nloc = mine > 0u ? mine : 1u; nx = cnt > 0u ? cnt : 1u;
}
__device__ __forceinline__ void xcd_barrier(const XcdBarrier& b) {
    asm volatile("s_waitcnt vmcnt(0)" ::: "memory");
    __syncthreads();
    if (threadIdx.x == 0) {
        unsigned* bar = b.bar;
        __builtin_amdgcn_s_waitcnt(0);
        unsigned nloc = b.st[0], nx = b.st[1];
        if (nloc == 0u) { xcd_barrier_complete(bar, b.x, nloc, nx); b.st[0] = nloc; b.st[1] = nx; }
        const unsigned old = xb_add(&bar[XB_XSUB(b.x)], 1u);
        const unsigned gen = old / nloc;
        if (old + 1u == (gen + 1u) * nloc) {
            __builtin_amdgcn_fence(__ATOMIC_RELEASE, "agent");
            asm volatile("s_waitcnt vmcnt(0)" ::: "memory");
            const unsigned og = xb_add(&bar[XB_TOP], 1u);
            const unsigned tg = og / nx;
            if (og + 1u == (tg + 1u) * nx) xb_add(&bar[XB_TOPGEN], 1u);
            else XB_SPIN(xb_ld(&bar[XB_TOPGEN]) == tg, bar);
            __builtin_amdgcn_fence(__ATOMIC_ACQUIRE, "agent");
            xb_add(&bar[XB_XGEN(b.x)], 1u);
            asm volatile("s_waitcnt vmcnt(0)" ::: "memory");
        } else {
            XB_SPIN(xb_ld(&bar[XB_XGEN(b.x)]) == gen, bar);
            __builtin_amdgcn_fence(__ATOMIC_ACQUIRE, "agent");
            asm volatile("s_waitcnt vmcnt(0)" ::: "memory");
        }
    }
    __syncthreads();
}

__global__ void __launch_bounds__(256, 2) mega(P p) {
    extern __shared__ __attribute__((aligned(16))) float smem[];
    cg::grid_group grid = cg::this_grid();
    volatile LAS unsigned* st = (volatile LAS unsigned*)((char*)smem + 73744);
    if (threadIdx.x < 4) st[threadIdx.x] = 0u;
    __syncthreads();
    XcdBarrier xb = xcd_barrier_post(p.bar, st);
    for (int ph = p.ph_lo; ph < p.ph_hi; ++ph) {
        if (phase_empty(ph)) continue;
        run_phase(p, ph, smem, 0);
        if (PROBE_N > 1 && ph > 0 && (ph - 1) % NSUB == PROBE_S)
            for (int rep = 1; rep < PROBE_N; ++rep) { xcd_barrier(xb); run_phase(p, ph, smem, rep); }
        if (ph + 1 < p.ph_hi) { if (ph == 0) grid.sync(); else xcd_barrier(xb); }
    }
}

extern "C" void kernel_launch(void* const* d_in, const int* in_sizes, int n_in, void* d_out, int out_size, void* d_ws, size_t ws_size, hipStream_t stream) {
    static int grid_blocks = 0;
    if (!grid_blocks) {
        int dev = 0, cus = 0, per_cu = 0;
        hipGetDevice(&dev);
        hipDeviceGetAttribute(&cus, hipDeviceAttributeMultiprocessorCount, dev);
        hipFuncSetAttribute((const void*)mega, hipFuncAttributeMaxDynamicSharedMemorySize, LDS_BYTES);
        hipOccupancyMaxActiveBlocksPerMultiprocessor(&per_cu, mega, 256, LDS_BYTES);
        if (per_cu < 1) per_cu = 1;
        if (per_cu > 2) per_cu = 2;
        grid_blocks = cus * per_cu;
    }
    P p{};
    const float** ins = (const float**)&p;
    for (int i = 0; i < 24; ++i) ins[i] = (const float*)d_in[i];
    p.out = (float*)d_out;
    size_t off = 0; char* ws = (char*)d_ws;
    auto carve = [&](size_t bytes) { void* r = ws + off; off += (bytes + 255) & ~(size_t)255; return r; };
    p.modv = (float*)carve((size_t)4 * 9 * 6144 * 4);
    p.rope = (float*)carve((size_t)2048 * 64 * 4);
    p.H = (float*)carve((size_t)NT * DM * 4);
    p.XN = (bf16_t*)carve((size_t)NT * DM * 2);
    p.WT = (bf16_t*)carve(WT_TOTAL * 2);
    p.MIX = (bf16_t*)carve((size_t)NT * DM * 2);
    p.PB = (bf16_t*)carve((size_t)NT * 1536 * 2);
    p.GT = (float*)carve((size_t)NT * 16 * 4);
    p.AQL = (bf16_t*)carve((size_t)8 * 16 * 2048 * 64 * 2);
    p.AQC = (bf16_t*)carve((size_t)8 * 16 * 256 * 64 * 2);
    p.AK = (bf16_t*)carve((size_t)8 * 4 * 2 * 2304 * 64 * 2);
    p.AV = (bf16_t*)carve((size_t)8 * 4 * 128 * 2304 * 2);
    p.QKB = (bf16_t*)carve((size_t)NT * 512 * 2);
    p.CLOC = (float*)carve((size_t)2304 * 8192 * 4);
    p.CST = (bf16_t*)carve((size_t)2304 * 8192 * 2);
    p.NLOC = (float*)carve((size_t)2304 * 64 * 4);
    p.NST = (float*)carve((size_t)2304 * 64 * 4);
    p.CHB = (float*)carve((size_t)2304 * 4);
    p.CHM = (float*)carve((size_t)2304 * 4);
    p.MST = (float*)carve((size_t)2304 * 4);
    p.QB = (bf16_t*)carve((size_t)NT * 2048 * 2);
    p.GATE = (float*)carve((size_t)NT * 128 * 4);
    p.EIDX = (int*)carve((size_t)NT * 128 * 4);
    p.ctr = (int*)carve(256);
    p.bar = (unsigned*)carve((size_t)XCD_BAR_WORDS * 4);
    p.U8 = (unsigned char*)carve((size_t)4 * 16384 * 1024);
    p.V8 = (unsigned char*)carve((size_t)4 * 16384 * 1024);
    p.USC = (float*)carve((size_t)4 * 16384 * 4);
    p.VSC = (float*)carve((size_t)4 * 16384 * 4);
    p.KB = (bf16_t*)carve((size_t)4 * 8 * 2 * 128 * 128 * 2);
    if (off > ws_size) { fprintf(stderr, "kernel_launch: workspace too small: need %zu have %zu\n", off, ws_size); return; }
    hipMemsetAsync(p.bar, 0, (size_t)XCD_BAR_WORDS * 4, stream);
#if ONE_LAUNCH
    p.ph_lo = 0; p.ph_hi = NPH;
    void* args[] = {&p};
    hipError_t e = hipLaunchCooperativeKernel((void*)mega, dim3(grid_blocks), dim3(256), args, LDS_BYTES, stream);
    if (e != hipSuccess) fprintf(stderr, "cooperative launch failed: %s (grid %d)\n", hipGetErrorString(e), grid_blocks);
#else
    for (int ph = 0; ph < NPH; ++ph) {
        if (ph > 0 && ph < NPH - 1) { const int L = (ph - 1) / NSUB, s = (ph - 1) % NSUB; if ((s == 2 || s == 4 || s == 5) && (L & 1)) continue; }
        p.ph_lo = ph; p.ph_hi = ph + 1;
        hipLaunchKernelGGL(mega, dim3(grid_blocks), dim3(256), LDS_BYTES, stream, p);
    }
#endif
}
```

```cpp
#include <hip/hip_runtime.h>
#include <hip/hip_cooperative_groups.h>
#include <cstdio>
#include <cstdint>
namespace cg = cooperative_groups;

#ifndef ONE_LAUNCH
#define ONE_LAUNCH 1
#endif

#define NT 18432
#define NL 16384
#define DM 1024
#define EVW 3088
#define ODW 1536
#define C_QK 0
#define C_V 512
#define C_O 1024
#define C_G 1536
#define C_DQ 1552
#define C_DK 2064
#define C_DV 2576
#define NPH 45
#ifndef PROBE_S
#define PROBE_S -1
#endif
#ifndef PROBE_N
#define PROBE_N 1
#endif

typedef unsigned short bf16_t;
typedef short bf16x8 __attribute__((ext_vector_type(8)));
typedef float f32x4 __attribute__((ext_vector_type(4)));
#define LDS_BYTES 73792

typedef float f32x16 __attribute__((ext_vector_type(16)));
typedef unsigned u32x4 __attribute__((ext_vector_type(4)));
struct P {
    const float *x, *c, *ctx, *c_ctx, *mod_w, *mod_b, *norm1_g, *norm2_g, *ev_w_in, *ev_conv_w, *ev_conv_b, *ev_gate_b,
        *ev_ml_g, *ev_da_lam, *ev_da_g, *ev_w_out, *od_w_in, *od_sink, *od_w_out, *pr_w_q, *pr_keys, *pr_u, *pr_v, *final_g;
    float* out;
    float *modv, *H, *GATE, *rope, *GT, *CLOC, *NLOC, *NST, *CHB, *CHM, *MST;
    int *EIDX, *ctr;
    unsigned* bar;
    bf16_t *XN, *MIX, *WT, *KB, *QB, *PB, *AQL, *AQC, *AK, *AV, *QKB, *CST;
    unsigned char *U8, *V8;
    float *USC, *VSC;
    int ph_lo, ph_hi;
};
#define QSCALE 0.18033688011112042f

__device__ __forceinline__ int otid() { int t = threadIdx.x; asm volatile("" : "+v"(t)); return t; }
__device__ __forceinline__ int modrow(int r) { return r < NL ? (r >> 11) : 8; }
__device__ __forceinline__ float silu_f(float x) { return x / (1.f + expf(-x)); }
__device__ __forceinline__ float sigmoid_f(float x) { return 1.f / (1.f + expf(-x)); }
__device__ __forceinline__ float log_sigmoid_f(float x) { return fminf(x, 0.f) - log1pf(expf(-fabsf(x))); }
typedef __bf16 bf16v2_t __attribute__((ext_vector_type(2)));
typedef float f32x2_t __attribute__((ext_vector_type(2)));
__device__ __forceinline__ unsigned cvt_pk_bf16(float lo, float hi) { const bf16v2_t v = __builtin_convertvector((f32x2_t){lo, hi}, bf16v2_t); return __builtin_bit_cast(unsigned, v); }
__device__ __forceinline__ float bf_lo(unsigned u) { return __uint_as_float(u << 16); }
__device__ __forceinline__ float bf_hi(unsigned u) { return __uint_as_float(u & 0xffff0000u); }
#define WT_EVIN(j) ((size_t)(j) * 3200 * 1024)
#define WT_EVOUT(j) ((size_t)2 * 3200 * 1024 + (size_t)(j) * 1024 * 1024)
#define WT_ODIN(j) ((size_t)2 * 3200 * 1024 + (size_t)2 * 1024 * 1024 + (size_t)(j) * 1536 * 1024)
#define WT_ODOUT(j) ((size_t)2 * 3200 * 1024 + (size_t)2 * 1024 * 1024 + (size_t)2 * 1536 * 1024 + (size_t)(j) * 1024 * 1024)
#define WT_PQ(L) ((size_t)2 * 3200 * 1024 + (size_t)4 * 1024 * 1024 + (size_t)2 * 1536 * 1024 + (size_t)(L) * 2048 * 1024)
#define WT_TOTAL ((size_t)2 * 3200 * 1024 + (size_t)4 * 1024 * 1024 + (size_t)2 * 1536 * 1024 + (size_t)4 * 2048 * 1024)
__device__ __forceinline__ float lshfl(float v, int src) { return __int_as_float(__builtin_amdgcn_ds_bpermute(src << 2, __float_as_int(v))); }
#define SHX(v, m) lshfl((v), lane ^ (m))
#define wave_sum(v) wave_sum_l((v), lane)
#define wave_max(v) wave_max_l((v), lane)
__device__ __forceinline__ float wave_sum_l(float v, int lane) {
#pragma unroll
    for (int o = 32; o > 0; o >>= 1) v += lshfl(v, lane ^ o);
    return v;
}
__device__ __forceinline__ float wave_max_l(float v, int lane) {
#pragma unroll
    for (int o = 32; o > 0; o >>= 1) v = fmaxf(v, lshfl(v, lane ^ o));
    return v;
}

__device__ void cvt_copy_bf16(const float* src, bf16_t* dst, size_t n);
__device__ void quant_rows_i8(const float* src, unsigned char* dst, float* scl, int nrows);
__device__ void ph_prologue(const P& p, float* smem) {
    const int tid = otid(), nb = gridDim.x, bid = blockIdx.x;
    if (bid == 0 && tid < 64) p.ctr[tid] = 0;
    {
        const float4* xs = (const float4*)p.x; const float4* cs = (const float4*)p.ctx; float4* hd = (float4*)p.H;
        const size_t nx = (size_t)NL * DM / 4, nc = (size_t)(NT - NL) * DM / 4;
        for (size_t i = (size_t)bid * 256 + tid; i < nx + nc; i += (size_t)nb * 256) hd[i] = i < nx ? xs[i] : cs[i - nx];
    }
    for (int i = bid * 256 + tid; i < 2048 * 32; i += nb * 256) {
        const int s = i >> 5, d = i & 31;
        const float pos = (d < 16) ? (float)(s >> 6) : (float)(s & 63);
        const float inv = powf(10000.0f, -(float)(d & 15) / 16.0f);
        const float ang = pos * inv;
        p.rope[2 * i] = cosf(ang); p.rope[2 * i + 1] = sinf(ang);
    }
    float* sc = smem;
    float* red = smem + 9 * 1024;
    for (int i = tid; i < 9 * 1024; i += 256) { const int r = i >> 10, k = i & 1023; const float v = r < 8 ? p.c[r * 1024 + k] : p.c_ctx[k]; sc[i] = silu_f(v); }
    __syncthreads();
    for (int item = bid; item < 4 * 96; item += nb) {
        const int L = item / 96, n0 = (item % 96) * 64, tx = tid & 63, kq = tid >> 6;
        float acc[9];
#pragma unroll
        for (int r = 0; r < 9; ++r) acc[r] = 0.f;
        const float* w = p.mod_w + (size_t)L * 1024 * 6144 + n0 + tx;
        for (int k = kq * 256; k < kq * 256 + 256; ++k) {
            const float wv = w[(size_t)k * 6144];
#pragma unroll
            for (int r = 0; r < 9; ++r) acc[r] += sc[r * 1024 + k] * wv;
        }
#pragma unroll
        for (int r = 0; r < 9; ++r) red[(kq * 9 + r) * 64 + tx] = acc[r];
        __syncthreads();
        if (kq == 0) {
#pragma unroll
            for (int r = 0; r < 9; ++r) {
                const float s = red[(0 * 9 + r) * 64 + tx] + red[(1 * 9 + r) * 64 + tx] + red[(2 * 9 + r) * 64 + tx] + red[(3 * 9 + r) * 64 + tx];
                p.modv[((size_t)L * 9 + r) * 6144 + n0 + tx] = s + p.mod_b[L * 6144 + n0 + tx];
            }
        }
        __syncthreads();
    }
    {
        float (*tile)[65] = (float (*)[65])smem;
        for (int item = bid; item < 5440; item += nb) {
            int it = item, mat = 0, N = 0, Npad = 0; const float* src = nullptr; bf16_t* dst = nullptr;
            for (mat = 0; mat < 12; ++mat) {
                if (mat < 2) { N = EVW; Npad = 3200; src = p.ev_w_in + (size_t)mat * DM * EVW; dst = p.WT + WT_EVIN(mat); }
                else if (mat < 4) { N = 1024; Npad = 1024; src = p.ev_w_out + (size_t)(mat - 2) * DM * DM; dst = p.WT + WT_EVOUT(mat - 2); }
                else if (mat < 6) { N = ODW; Npad = ODW; src = p.od_w_in + (size_t)(mat - 4) * DM * ODW; dst = p.WT + WT_ODIN(mat - 4); }
                else if (mat < 8) { N = 1024; Npad = 1024; src = p.od_w_out + (size_t)(mat - 6) * DM * DM; dst = p.WT + WT_ODOUT(mat - 6); }
                else { N = 2048; Npad = 2048; src = p.pr_w_q + (size_t)(mat - 8) * DM * 2048; dst = p.WT + WT_PQ(mat - 8); }
                const int nt = 16 * (Npad / 64);
                if (it < nt) break;
                it -= nt;
            }
            const int k0 = (it & 15) * 64, n0 = (it >> 4) * 64;
            __syncthreads();
#pragma unroll
            for (int rep = 0; rep < 4; ++rep) {
                const int i = (tid >> 4) + 16 * rep, c4 = (tid & 15) * 4;
                float4 v = make_float4(0.f, 0.f, 0.f, 0.f);
                int sc = n0 + c4;
                if (mat < 2) sc = sc < 1536 ? sc : (sc < 3072 ? sc + 16 : (sc < 3088 ? sc - 3072 + 1536 : N));
                if (sc < N) v = *(const float4*)(src + (size_t)(k0 + i) * N + sc);
                tile[i][c4] = v.x; tile[i][c4 + 1] = v.y; tile[i][c4 + 2] = v.z; tile[i][c4 + 3] = v.w;
            }
            __syncthreads();
            {
                const int n = tid >> 2, kq = (tid & 3) * 16;
                unsigned w[8];
#pragma unroll
                for (int e = 0; e < 8; ++e) w[e] = cvt_pk_bf16(tile[kq + 2 * e][n], tile[kq + 2 * e + 1][n]);
                uint4* dp = (uint4*)(dst + (size_t)(n0 + n) * DM + k0 + kq);
                dp[0] = make_uint4(w[0], w[1], w[2], w[3]); dp[1] = make_uint4(w[4], w[5], w[6], w[7]);
            }
        }
    }
    quant_rows_i8(p.pr_u, p.U8, p.USC, 4 * 16384);
    quant_rows_i8(p.pr_v, p.V8, p.VSC, 4 * 16384);
    cvt_copy_bf16(p.pr_keys, p.KB, (size_t)4 * 8 * 2 * 128 * 128);
}

__device__ void cvt_copy_bf16(const float* src, bf16_t* dst, size_t n) {
    const size_t n8 = n / 8;
    for (size_t i = (size_t)blockIdx.x * 256 + otid(); i < n8; i += (size_t)gridDim.x * 256) {
        const float4 a = ((const float4*)src)[2 * i], b = ((const float4*)src)[2 * i + 1];
        ((uint4*)dst)[i] = make_uint4(cvt_pk_bf16(a.x, a.y), cvt_pk_bf16(a.z, a.w), cvt_pk_bf16(b.x, b.y), cvt_pk_bf16(b.z, b.w));
    }
}

__device__ void quant_rows_i8(const float* src, unsigned char* dst, float* scl, int nrows) {
    const int lane = otid() & 63, wid = otid() >> 6;
    for (int r = blockIdx.x * 4 + wid; r < nrows; r += gridDim.x * 4) {
        const float4* sp = (const float4*)(src + (size_t)r * 1024 + lane * 16);
        float4 v[4]; float mx = 0.f;
#pragma unroll
        for (int i = 0; i < 4; ++i) { v[i] = sp[i]; mx = fmaxf(mx, fmaxf(fmaxf(fabsf(v[i].x), fabsf(v[i].y)), fmaxf(fabsf(v[i].z), fabsf(v[i].w)))); }
#pragma unroll
        for (int o = 32; o > 0; o >>= 1) mx = fmaxf(mx, SHX(mx, o));
        const float inv = mx > 0.f ? 127.f / mx : 0.f;
        unsigned w[4];
#pragma unroll
        for (int i = 0; i < 4; ++i) {
            const unsigned b0 = (unsigned)((int)rintf(v[i].x * inv) + 128), b1 = (unsigned)((int)rintf(v[i].y * inv) + 128), b2 = (unsigned)((int)rintf(v[i].z * inv) + 128), b3 = (unsigned)((int)rintf(v[i].w * inv) + 128);
            w[i] = b0 | (b1 << 8) | (b2 << 16) | (b3 << 24);
        }
        *(uint4*)(dst + (size_t)r * 1024 + lane * 16) = make_uint4(w[0], w[1], w[2], w[3]);
        if (lane == 0) scl[r] = mx * (1.f / 127.f);
    }
}

__device__ void ph_normmod(const float* src, const float* g, const float* modv_layer, int shift_off, int scale_off, bf16_t* dst, int nrows) {
    const int lane = otid() & 63, wid = otid() >> 6;
    for (int r = blockIdx.x * 4 + wid; r < nrows; r += gridDim.x * 4) {
        const float4* s4 = (const float4*)(src + (size_t)r * DM);
        float4 v[4]; float ss = 0.f;
#pragma unroll
        for (int i = 0; i < 4; ++i) { v[i] = s4[i * 64 + lane]; ss += v[i].x * v[i].x + v[i].y * v[i].y + v[i].z * v[i].z + v[i].w * v[i].w; }
        ss = wave_sum(ss);
        const float rstd = rsqrtf(ss * (1.0f / DM) + 1e-6f);
        const float* mv = modv_layer + (size_t)modrow(r) * 6144;
        uint2* d2 = (uint2*)(dst + (size_t)r * DM);
#pragma unroll
        for (int i = 0; i < 4; ++i) {
            const int c = (i * 64 + lane) * 4;
            const float4 gg = *(const float4*)(g + c), sh = *(const float4*)(mv + shift_off + c), scl = *(const float4*)(mv + scale_off + c);
            float4 o;
            o.x = v[i].x * rstd * gg.x * (1.f + scl.x) + sh.x; o.y = v[i].y * rstd * gg.y * (1.f + scl.y) + sh.y;
            o.z = v[i].z * rstd * gg.z * (1.f + scl.z) + sh.z; o.w = v[i].w * rstd * gg.w * (1.f + scl.w) + sh.w;
            d2[i * 64 + lane] = make_uint2(cvt_pk_bf16(o.x, o.y), cvt_pk_bf16(o.z, o.w));
        }
    }
}

__device__ void ph_final(const P& p) {
    const int lane = otid() & 63, wid = otid() >> 6;
    for (int r = blockIdx.x * 4 + wid; r < NL; r += gridDim.x * 4) {
        const float4* s4 = (const float4*)(p.H + (size_t)r * DM);
        float4 v[4]; float ss = 0.f;
#pragma unroll
        for (int i = 0; i < 4; ++i) { v[i] = s4[i * 64 + lane]; ss += v[i].x * v[i].x + v[i].y * v[i].y + v[i].z * v[i].z + v[i].w * v[i].w; }
        ss = wave_sum(ss);
        const float rstd = rsqrtf(ss * (1.0f / DM) + 1e-6f);
        float4* d4 = (float4*)(p.out + (size_t)r * DM);
#pragma unroll
        for (int i = 0; i < 4; ++i) {
            const int c = (i * 64 + lane) * 4; const float4 gg = *(const float4*)(p.final_g + c);
            float4 o; o.x = v[i].x * rstd * gg.x; o.y = v[i].y * rstd * gg.y; o.z = v[i].z * rstd * gg.z; o.w = v[i].w * rstd * gg.w;
            d4[i * 64 + lane] = o;
        }
    }
}

#define GL_ROWB 144
#define GL_TILEB (128 * GL_ROWB)
struct TokPos { int b, pos, kpos; bool lat; };
__device__ __forceinline__ TokPos tokpos(int row) {
    TokPos t; t.lat = row < NL;
    if (t.lat) { t.b = row >> 11; t.pos = row & 2047; t.kpos = 256 + t.pos; } else { const int r = row - NL; t.b = r >> 8; t.pos = r & 255; t.kpos = t.pos; }
    return t;
}
struct EpiStoreBF16 {
    bf16_t* C; int ldc;
    __device__ __forceinline__ bool swapped(int) const { return false; }
    __device__ __forceinline__ void operator()(const f32x4 (&acc)[4][4], int m0, int n0, int wm, int wn, int fr, int fq) const {
#pragma unroll
        for (int mi = 0; mi < 4; ++mi)
#pragma unroll
            for (int ni = 0; ni < 4; ++ni) {
                const f32x4 v = acc[ni][mi];
                *(uint2*)(C + (size_t)(m0 + wm * 64 + mi * 16 + fr) * ldc + n0 + wn * 64 + ni * 16 + fq * 4) = make_uint2(cvt_pk_bf16(v[0], v[1]), cvt_pk_bf16(v[2], v[3]));
            }
    }
};
struct EpiResid {
    float* H; const float* gate; float scale;
    __device__ __forceinline__ bool swapped(int) const { return false; }
    __device__ __forceinline__ void operator()(const f32x4 (&acc)[4][4], int m0, int n0, int wm, int wn, int fr, int fq) const {
#pragma unroll
        for (int mi = 0; mi < 4; ++mi) {
            const int row = m0 + wm * 64 + mi * 16 + fr;
            const float* gp = gate + (size_t)modrow(row) * 6144;
#pragma unroll
            for (int ni = 0; ni < 4; ++ni) {
                const int col = n0 + wn * 64 + ni * 16 + fq * 4;
                const f32x4 g = *(const f32x4*)(gp + col);
                f32x4* hp = (f32x4*)(H + (size_t)row * DM + col);
                *hp = *hp + g * acc[ni][mi] * scale;
            }
        }
    }
};
__device__ __forceinline__ void rope_store64(const f32x4 (&acc)[4][4], int mi, bool do_rope, const float* ropep  , float scale, bf16_t* dst  , int fq) {
#pragma unroll
    for (int ni = 0; ni < 2; ++ni) {
        f32x4 x1 = acc[ni][mi], x2 = acc[ni + 2][mi];
        if (do_rope) {
            const f32x4 r0 = *(const f32x4*)(ropep + (ni * 16 + fq * 4) * 2), r1 = *(const f32x4*)(ropep + (ni * 16 + fq * 4) * 2 + 4);
            const f32x4 cs = (f32x4){r0[0], r0[2], r1[0], r1[2]}, sn = (f32x4){r0[1], r0[3], r1[1], r1[3]};
            const f32x4 y1 = x1 * cs - x2 * sn, y2 = x1 * sn + x2 * cs;
            x1 = y1; x2 = y2;
        }
        x1 = x1 * scale; x2 = x2 * scale;
        *(uint2*)(dst + ni * 16 + fq * 4) = make_uint2(cvt_pk_bf16(x1[0], x1[1]), cvt_pk_bf16(x1[2], x1[3]));
        *(uint2*)(dst + 32 + ni * 16 + fq * 4) = make_uint2(cvt_pk_bf16(x2[0], x2[1]), cvt_pk_bf16(x2[2], x2[3]));
    }
}
struct EpiEven {
    bf16_t *PB, *AQL, *AQC, *AK, *AV; float* GT; const float* rope;
    __device__ __forceinline__ bool swapped(int n0) const { return n0 >= 2560 && n0 < 3072; }
    __device__ __forceinline__ void operator()(const f32x4 (&acc)[4][4], int m0, int n0, int wm, int wn, int fr, int fq) const {
        const int t = n0 >> 7;
        if (t < 12) {
#pragma unroll
            for (int mi = 0; mi < 4; ++mi)
#pragma unroll
                for (int ni = 0; ni < 4; ++ni) {
                    const f32x4 v = acc[ni][mi];
                    *(uint2*)(PB + (size_t)(m0 + wm * 64 + mi * 16 + fr) * 1536 + n0 + wn * 64 + ni * 16 + fq * 4) = make_uint2(cvt_pk_bf16(v[0], v[1]), cvt_pk_bf16(v[2], v[3]));
                }
        } else if (t < 20) {
            const bool isq = t < 16; const int h = t & 3;
#pragma unroll
            for (int mi = 0; mi < 4; ++mi) {
                const TokPos tp = tokpos(m0 + wm * 64 + mi * 16 + fr);
                const int hm = (tp.b * 4 + h) * 2 + wn;
                bf16_t* dst;
                if (isq) dst = tp.lat ? AQL + ((size_t)hm * 2048 + tp.pos) * 64 : AQC + ((size_t)hm * 256 + tp.pos) * 64;
                else dst = AK + ((size_t)hm * 2304 + tp.kpos) * 64;
                rope_store64(acc, mi, tp.lat, rope + (size_t)tp.pos * 64, isq ? QSCALE : 1.0f, dst, fq);
            }
        } else if (t < 24) {
            const int h = t - 20;
#pragma unroll
            for (int mi = 0; mi < 4; ++mi) {
                const TokPos tp = tokpos(m0 + wm * 64 + mi * 16 + fq * 4);
#pragma unroll
                for (int ni = 0; ni < 4; ++ni) {
                    const f32x4 v = acc[ni][mi];
                    const int d = wn * 64 + ni * 16 + fr;
                    *(uint2*)(AV + ((size_t)(tp.b * 4 + h) * 128 + d) * 2304 + tp.kpos) = make_uint2(cvt_pk_bf16(v[0], v[1]), cvt_pk_bf16(v[2], v[3]));
                }
            }
        } else {
            if (wn == 0) {
#pragma unroll
                for (int mi = 0; mi < 4; ++mi) *(f32x4*)(GT + (size_t)(m0 + wm * 64 + mi * 16 + fr) * 16 + fq * 4) = acc[0][mi];
            }
        }
    }
};
struct EpiOdd {
    bf16_t *AQL, *AQC, *AK, *AV; const float* rope;
    __device__ __forceinline__ bool swapped(int n0) const { return n0 >= 1280; }
    __device__ __forceinline__ void operator()(const f32x4 (&acc)[4][4], int m0, int n0, int wm, int wn, int fr, int fq) const {
        const int t = n0 >> 7;
        if (t < 10) {
            const bool isq = t < 8; const int hd = isq ? t * 2 + wn : (t - 8) * 2 + wn;
#pragma unroll
            for (int mi = 0; mi < 4; ++mi) {
                const TokPos tp = tokpos(m0 + wm * 64 + mi * 16 + fr);
                bf16_t* dst;
                if (isq) dst = tp.lat ? AQL + ((size_t)(tp.b * 16 + hd) * 2048 + tp.pos) * 64 : AQC + ((size_t)(tp.b * 16 + hd) * 256 + tp.pos) * 64;
                else dst = AK + ((size_t)(tp.b * 4 + hd) * 2304 + tp.kpos) * 64;
                rope_store64(acc, mi, tp.lat, rope + (size_t)tp.pos * 64, isq ? QSCALE : 1.0f, dst, fq);
            }
        } else {
            const int hkv = (t - 10) * 2 + wn;
#pragma unroll
            for (int mi = 0; mi < 4; ++mi) {
                const TokPos tp = tokpos(m0 + wm * 64 + mi * 16 + fq * 4);
#pragma unroll
                for (int ni = 0; ni < 4; ++ni) {
                    const f32x4 v = acc[ni][mi];
                    const int d = ni * 16 + fr;
                    *(uint2*)(AV + ((size_t)(tp.b * 4 + hkv) * 64 + d) * 2304 + tp.kpos) = make_uint2(cvt_pk_bf16(v[0], v[1]), cvt_pk_bf16(v[2], v[3]));
                }
            }
        }
    }
};
template <bool SWAP>
__device__ __forceinline__ void gemm_tile_kloop(f32x4 (&acc)[4][4], const bf16_t* aub, const bf16_t* bub, char* smem, int lrow, int lch, int wm, int wn, int fr, int fq) {
    const unsigned voff = (unsigned)(lrow * DM + lch * 8) * 2u;
    uint4 ra0, ra1, ra2, ra3, rb0, rb1, rb2, rb3;
#define GL_LD(BASE, ROWS, KO) (*(const uint4*)((const char*)(BASE) + ((size_t)(ROWS) * DM + (KO)) * 2 + voff))
#define GL_LOAD(KO) { ra0 = GL_LD(aub, 0, KO); ra1 = GL_LD(aub, 32, KO); ra2 = GL_LD(aub, 64, KO); ra3 = GL_LD(aub, 96, KO); rb0 = GL_LD(bub, 0, KO); rb1 = GL_LD(bub, 32, KO); rb2 = GL_LD(bub, 64, KO); rb3 = GL_LD(bub, 96, KO); }
#define GL_STORE(BUF) { char* sa_ = (BUF) + lrow * GL_ROWB + lch * 16; char* sb_ = sa_ + GL_TILEB; \
                        *(uint4*)(sa_) = ra0; *(uint4*)(sa_ + 32 * GL_ROWB) = ra1; *(uint4*)(sa_ + 64 * GL_ROWB) = ra2; *(uint4*)(sa_ + 96 * GL_ROWB) = ra3; \
                        *(uint4*)(sb_) = rb0; *(uint4*)(sb_ + 32 * GL_ROWB) = rb1; *(uint4*)(sb_ + 64 * GL_ROWB) = rb2; *(uint4*)(sb_ + 96 * GL_ROWB) = rb3; }
    GL_LOAD(0)
    __syncthreads();
    GL_STORE(smem)
    __syncthreads();
    for (int kt = 0; kt < 16; ++kt) {
        char* cur = smem + (kt & 1) * 2 * GL_TILEB;
        char* nxt = smem + ((kt + 1) & 1) * 2 * GL_TILEB;
        if (kt + 1 < 16) GL_LOAD((kt + 1) * 64)
#pragma unroll
        for (int ks = 0; ks < 2; ++ks) {
            bf16x8 af[4], wf[4];
#pragma unroll
            for (int i = 0; i < 4; ++i) {
                af[i] = *(const bf16x8*)(cur + (wm * 64 + i * 16 + fr) * GL_ROWB + (ks * 4 + fq) * 16);
                wf[i] = *(const bf16x8*)(cur + GL_TILEB + (wn * 64 + i * 16 + fr) * GL_ROWB + (ks * 4 + fq) * 16);
            }
#pragma unroll
            for (int ni = 0; ni < 4; ++ni)
#pragma unroll
                for (int mi = 0; mi < 4; ++mi)
                    acc[ni][mi] = SWAP ? __builtin_amdgcn_mfma_f32_16x16x32_bf16(af[mi], wf[ni], acc[ni][mi], 0, 0, 0)
                                       : __builtin_amdgcn_mfma_f32_16x16x32_bf16(wf[ni], af[mi], acc[ni][mi], 0, 0, 0);
        }
        if (kt + 1 < 16) GL_STORE(nxt)
        __syncthreads();
    }
#undef GL_LD
#undef GL_LOAD
#undef GL_STORE
}
template <class Epi>
__device__ void ph_gemm(const bf16_t* A, const bf16_t* Bt, int M, int Npad, const Epi& epi, char* smem) {
    const int tid = otid(), lane = tid & 63, wid = tid >> 6, wm = wid >> 1, wn = wid & 1;
    const int fr = lane & 15, fq = lane >> 4;
    const int tm = M / 128, tn = Npad / 128, ntiles = tm * tn;
    const int lrow = tid >> 3, lch = tid & 7;
    for (int tile = blockIdx.x; tile < ntiles; tile += gridDim.x) {
        const int m0 = (tile % tm) * 128, n0 = (tile / tm) * 128;
        f32x4 acc[4][4];
#pragma unroll
        for (int a = 0; a < 4; ++a)
#pragma unroll
            for (int b = 0; b < 4; ++b) acc[a][b] = (f32x4){0.f, 0.f, 0.f, 0.f};
        const bf16_t* ap = A + (size_t)m0 * DM;
        const bf16_t* bp = Bt + (size_t)n0 * DM;
        if (epi.swapped(n0)) gemm_tile_kloop<true>(acc, ap, bp, smem, lrow, lch, wm, wn, fr, fq);
        else gemm_tile_kloop<false>(acc, ap, bp, smem, lrow, lch, wm, wn, fr, fq);
        int fr2 = fr, fq2 = fq, wm2 = wm, wn2 = wn;
        asm volatile("" : "+v"(fr2), "+v"(fq2), "+v"(wm2), "+v"(wn2));
        epi(acc, m0, n0, wm2, wn2, fr2, fq2);
    }
}

__device__ void ph_prep_even(const P& p, int j) {
    const float* cw = p.ev_conv_w + (size_t)j * 3 * 512; const float* cb = p.ev_conv_b + (size_t)j * 512;
    const size_t tot = (size_t)NT * 256;
    for (size_t i = (size_t)blockIdx.x * 256 + otid(); i < tot; i += (size_t)gridDim.x * 256) {
        const int r = (int)(i >> 8), c = (int)(i & 255) * 2;
        int t, T; if (r < NL) { t = r & 2047; T = 2048; } else { t = (r - NL) & 255; T = 256; }
        const unsigned x1 = *(const unsigned*)(p.PB + (size_t)r * 1536 + c);
        float v0 = cb[c] + bf_lo(x1) * cw[512 + c], v1 = cb[c + 1] + bf_hi(x1) * cw[512 + c + 1];
        if (t > 0) { const unsigned x0 = *(const unsigned*)(p.PB + (size_t)(r - 1) * 1536 + c); v0 += bf_lo(x0) * cw[c]; v1 += bf_hi(x0) * cw[c + 1]; }
        if (t < T - 1) { const unsigned x2 = *(const unsigned*)(p.PB + (size_t)(r + 1) * 1536 + c); v0 += bf_lo(x2) * cw[1024 + c]; v1 += bf_hi(x2) * cw[1024 + c + 1]; }
        v0 = silu_f(v0); v1 = silu_f(v1);
        if (c >= 256) { v0 *= 0.125f; v1 *= 0.125f; }
        *(unsigned*)(p.QKB + (size_t)r * 512 + c) = cvt_pk_bf16(v0, v1);
    }
}

#define FA_KROW 144
#define FA_VROW 136
__device__ __forceinline__ bf16x8 pack8(float a0, float a1, float a2, float a3, float a4, float a5, float a6, float a7) {
    const u32x4 u = (u32x4){cvt_pk_bf16(a0, a1), cvt_pk_bf16(a2, a3), cvt_pk_bf16(a4, a5), cvt_pk_bf16(a6, a7)};
    return __builtin_bit_cast(bf16x8, u);
}
template <int NDB, bool MASK>
__device__ __forceinline__ void flash_tile(const bf16x8 (&qf)[4], f32x16 (&o)[NDB], float& m, float& l, const char* Kl, const char* Vl, int lane, int qpos, int kp0) {
    const int j = lane & 31, h = lane >> 5;
    f32x16 s0, s1;
#pragma unroll
    for (int i = 0; i < 16; ++i) { s0[i] = 0.f; s1[i] = 0.f; }
#pragma unroll
    for (int ks = 0; ks < 4; ++ks) {
        const bf16x8 a0 = *(const bf16x8*)(Kl + j * FA_KROW + (2 * ks + h) * 16);
        const bf16x8 a1 = *(const bf16x8*)(Kl + (32 + j) * FA_KROW + (2 * ks + h) * 16);
        s0 = __builtin_amdgcn_mfma_f32_32x32x16_bf16(a0, qf[ks], s0, 0, 0, 0);
        s1 = __builtin_amdgcn_mfma_f32_32x32x16_bf16(a1, qf[ks], s1, 0, 0, 0);
    }
    if (MASK) {
#pragma unroll
        for (int r = 0; r < 16; ++r) {
            const int key = (r & 3) + 8 * (r >> 2) + 4 * h;
            const int d0 = qpos - (kp0 + key), d1 = d0 - 32;
            if (d0 > 128 || d0 < -128) s0[r] = -1e30f;
            if (d1 > 128 || d1 < -128) s1[r] = -1e30f;
        }
    }
    float mx = fmaxf(s0[0], s1[0]);
#pragma unroll
    for (int r = 1; r < 16; ++r) mx = fmaxf(mx, fmaxf(s0[r], s1[r]));
    mx = fmaxf(mx, SHX(mx, 32));
    const float mn = fmaxf(m, mx);
    const float alpha = __builtin_amdgcn_exp2f(m - mn);
    m = mn;
    float ls = 0.f;
#pragma unroll
    for (int r = 0; r < 16; ++r) { s0[r] = __builtin_amdgcn_exp2f(s0[r] - mn); s1[r] = __builtin_amdgcn_exp2f(s1[r] - mn); ls += s0[r] + s1[r]; }
    l = l * alpha + ls;
#pragma unroll
    for (int db = 0; db < NDB; ++db) o[db] = o[db] * alpha;
    bf16x8 pb[4];
    pb[0] = pack8(s0[0], s0[1], s0[2], s0[3], s0[4], s0[5], s0[6], s0[7]);
    pb[1] = pack8(s0[8], s0[9], s0[10], s0[11], s0[12], s0[13], s0[14], s0[15]);
    pb[2] = pack8(s1[0], s1[1], s1[2], s1[3], s1[4], s1[5], s1[6], s1[7]);
    pb[3] = pack8(s1[8], s1[9], s1[10], s1[11], s1[12], s1[13], s1[14], s1[15]);
#pragma unroll
    for (int db = 0; db < NDB; ++db)
#pragma unroll
        for (int kk = 0; kk < 4; ++kk) {
            const char* vp = Vl + (db * 32 + j) * FA_VROW + (kk * 16 + 4 * h) * 2;
            const uint2 lo = *(const uint2*)vp, hi = *(const uint2*)(vp + 16);
            const u32x4 u = (u32x4){lo.x, lo.y, hi.x, hi.y};
            o[db] = __builtin_amdgcn_mfma_f32_32x32x16_bf16(__builtin_bit_cast(bf16x8, u), pb[kk], o[db], 0, 0, 0);
        }
}

#define DA_BUFB 35840
__device__ void da_block(const P& p, int item, int L, int j, char* smem) {
    const int tid = otid(), lane = tid & 63, wid = tid >> 6, mp = wid & 1, qg = wid >> 1, jq = lane & 31, hh = lane >> 5;
    const bool lat = item < 1024;
    int b, h, qt;
    if (lat) { b = item >> 7; h = (item >> 5) & 3; qt = item & 31; } else { const int it = item - 1024; b = it >> 4; h = (it >> 2) & 3; qt = it & 3; }
    const int qi = qt * 64 + qg * 32 + jq;
    const bf16_t* qp = lat ? p.AQL + ((size_t)((b * 4 + h) * 2 + mp) * 2048 + qi) * 64 : p.AQC + ((size_t)((b * 4 + h) * 2 + mp) * 256 + qi) * 64;
    bf16x8 qf[4];
#pragma unroll
    for (int ks = 0; ks < 4; ++ks) qf[ks] = *(const bf16x8*)(qp + (2 * ks + hh) * 8);
    const int ntile = lat ? 36 : 4;
    const bf16_t* kg = p.AK + (size_t)((b * 4 + h) * 2) * 2304 * 64 + (size_t)(tid >> 3) * 64 + (tid & 7) * 8;
    const bf16_t* vg = p.AV + (size_t)(b * 4 + h) * 128 * 2304 + (size_t)(tid >> 3) * 2304 + (tid & 7) * 8;
    uint4 k0, k1, k2, k3, v0, v1, v2, v3;
#define DA_LOAD(KEY0) { k0 = *(const uint4*)(kg + (size_t)(KEY0) * 64); k1 = *(const uint4*)(kg + (size_t)((KEY0) + 32) * 64); \
                        k2 = *(const uint4*)(kg + (size_t)2304 * 64 + (size_t)(KEY0) * 64); k3 = *(const uint4*)(kg + (size_t)2304 * 64 + (size_t)((KEY0) + 32) * 64); \
                        v0 = *(const uint4*)(vg + (KEY0)); v1 = *(const uint4*)(vg + (size_t)32 * 2304 + (KEY0)); v2 = *(const uint4*)(vg + (size_t)64 * 2304 + (KEY0)); v3 = *(const uint4*)(vg + (size_t)96 * 2304 + (KEY0)); }
#define DA_STORE(BUF) { char* kb_ = (BUF) + (tid >> 3) * FA_KROW + (tid & 7) * 16; \
                        *(uint4*)kb_ = k0; *(uint4*)(kb_ + 32 * FA_KROW) = k1; *(uint4*)(kb_ + 64 * FA_KROW) = k2; *(uint4*)(kb_ + 96 * FA_KROW) = k3; \
                        char* vb_ = (BUF) + 18432 + (tid >> 3) * FA_VROW + (tid & 7) * 16; \
                        *(uint2*)vb_ = make_uint2(v0.x, v0.y); *(uint2*)(vb_ + 8) = make_uint2(v0.z, v0.w); \
                        *(uint2*)(vb_ + 32 * FA_VROW) = make_uint2(v1.x, v1.y); *(uint2*)(vb_ + 32 * FA_VROW + 8) = make_uint2(v1.z, v1.w); \
                        *(uint2*)(vb_ + 64 * FA_VROW) = make_uint2(v2.x, v2.y); *(uint2*)(vb_ + 64 * FA_VROW + 8) = make_uint2(v2.z, v2.w); \
                        *(uint2*)(vb_ + 96 * FA_VROW) = make_uint2(v3.x, v3.y); *(uint2*)(vb_ + 96 * FA_VROW + 8) = make_uint2(v3.z, v3.w); }
    f32x16 o[4];
#pragma unroll
    for (int db = 0; db < 4; ++db)
#pragma unroll
        for (int i = 0; i < 16; ++i) o[db][i] = 0.f;
    float m = -1e30f, l = 0.f;
    DA_LOAD(0)
    __syncthreads();
    DA_STORE(smem)
    __syncthreads();
    for (int t = 0; t < ntile; ++t) {
        char* cur = smem + (t & 1) * DA_BUFB;
        char* nxt = smem + ((t + 1) & 1) * DA_BUFB;
        if (t + 1 < ntile) DA_LOAD((t + 1) * 64)
        flash_tile<4, false>(qf, o, m, l, cur + mp * 9216, cur + 18432, lane, 0, 0);
        if (t + 1 < ntile) DA_STORE(nxt)
        __syncthreads();
    }
#undef DA_LOAD
#undef DA_STORE
    const float inv = 1.f / (l + SHX(l, 32));
#pragma unroll
    for (int db = 0; db < 4; ++db) o[db] = o[db] * inv;
    float* X = (float*)smem + qg * 4096;
    if (mp == 1) {
#pragma unroll
        for (int db = 0; db < 4; ++db)
#pragma unroll
            for (int r = 0; r < 16; ++r) X[(db * 32 + (r & 3) + 8 * (r >> 2) + 4 * hh) * 32 + jq] = o[db][r];
    }
    __syncthreads();
    if (mp == 0) {
        const float lam_init = 0.8f - 0.6f * expf(-0.3f * (float)L);
        const float* lp = p.ev_da_lam + (size_t)j * 256;
        float a0 = lp[lane] * lp[64 + lane], a1 = lp[128 + lane] * lp[192 + lane];
        a0 = wave_sum(a0); a1 = wave_sum(a1);
        const float lam = expf(a0) - expf(a1) + lam_init;
        float ss = 0.f;
#pragma unroll
        for (int db = 0; db < 4; ++db)
#pragma unroll
            for (int r = 0; r < 16; ++r) { const float v = o[db][r] - lam * X[(db * 32 + (r & 3) + 8 * (r >> 2) + 4 * hh) * 32 + jq]; o[db][r] = v; ss += v * v; }
        ss += SHX(ss, 32);
        const float sc = rsqrtf(ss * (1.f / 128.f) + 1e-6f) * (1.f - lam_init);
        const int row = lat ? b * 2048 + qi : NL + b * 256 + qi;
        bf16_t* mrow = p.MIX + (size_t)row * DM + 512 + h * 128;
        const float* g = p.ev_da_g + (size_t)j * 512 + h * 128;
#pragma unroll
        for (int db = 0; db < 4; ++db)
#pragma unroll
            for (int r4 = 0; r4 < 4; ++r4) {
                const int d = db * 32 + 8 * r4 + 4 * hh;
                const f32x4 gg = *(const f32x4*)(g + d);
                *(uint2*)(mrow + d) = make_uint2(cvt_pk_bf16(o[db][r4 * 4 + 0] * sc * gg[0], o[db][r4 * 4 + 1] * sc * gg[1]), cvt_pk_bf16(o[db][r4 * 4 + 2] * sc * gg[2], o[db][r4 * 4 + 3] * sc * gg[3]));
            }
    }
    __syncthreads();
}

#define WA_BUFB 17920
__device__ void wa_block(const P& p, int item, int j, char* smem) {
    const int tid = otid(), lane = tid & 63, wid = tid >> 6, jq = lane & 31, hh = lane >> 5;
    const bool lat = item < 2048;
    int b, nb, hq;
    if (lat) { hq = item & 15; nb = (item >> 4) & 15; b = item >> 8; } else { const int it = item - 2048; hq = it & 15; nb = (it >> 4) & 1; b = it >> 5; }
    const int hkv = hq >> 2;
    const int qi = nb * 128 + wid * 32 + jq;
    const bf16_t* qp = lat ? p.AQL + ((size_t)(b * 16 + hq) * 2048 + qi) * 64 : p.AQC + ((size_t)(b * 16 + hq) * 256 + qi) * 64;
    bf16x8 qf[4];
#pragma unroll
    for (int ks = 0; ks < 4; ++ks) qf[ks] = *(const bf16x8*)(qp + (2 * ks + hh) * 8);
    const int lfirst = (nb == 0) ? 2 : 0, nloc = lat ? 6 - lfirst - ((nb == 15) ? 2 : 0) : 0;
    const int ntile = 4 + nloc;
    const bf16_t* kg = p.AK + (size_t)(b * 4 + hkv) * 2304 * 64 + (size_t)(tid >> 3) * 64 + (tid & 7) * 8;
    const bf16_t* vg = p.AV + (size_t)(b * 4 + hkv) * 64 * 2304 + (size_t)(tid >> 3) * 2304 + (tid & 7) * 8;
    uint4 k0, k1, v0, v1;
#define WA_KEY0(T) ((T) < 4 ? (T) * 64 : 256 + (nb - 1) * 128 + ((T) - 4 + lfirst) * 64)
#define WA_LOAD(KEY0) { k0 = *(const uint4*)(kg + (size_t)(KEY0) * 64); k1 = *(const uint4*)(kg + (size_t)((KEY0) + 32) * 64); v0 = *(const uint4*)(vg + (KEY0)); v1 = *(const uint4*)(vg + (size_t)32 * 2304 + (KEY0)); }
#define WA_STORE(BUF) { char* kb_ = (BUF) + (tid >> 3) * FA_KROW + (tid & 7) * 16; *(uint4*)kb_ = k0; *(uint4*)(kb_ + 32 * FA_KROW) = k1; \
                        char* vb_ = (BUF) + 9216 + (tid >> 3) * FA_VROW + (tid & 7) * 16; \
                        *(uint2*)vb_ = make_uint2(v0.x, v0.y); *(uint2*)(vb_ + 8) = make_uint2(v0.z, v0.w); \
                        *(uint2*)(vb_ + 32 * FA_VROW) = make_uint2(v1.x, v1.y); *(uint2*)(vb_ + 32 * FA_VROW + 8) = make_uint2(v1.z, v1.w); }
    f32x16 o[2];
#pragma unroll
    for (int db = 0; db < 2; ++db)
#pragma unroll
        for (int i = 0; i < 16; ++i) o[db][i] = 0.f;
    float m = p.od_sink[j * 16 + hq] * 1.4426950408889634f, l = hh == 0 ? 1.f : 0.f;
    { const int key0 = WA_KEY0(0); WA_LOAD(key0) }
    __syncthreads();
    WA_STORE(smem)
    __syncthreads();
    for (int t = 0; t < ntile; ++t) {
        char* cur = smem + (t & 1) * WA_BUFB;
        char* nxt = smem + ((t + 1) & 1) * WA_BUFB;
        if (t + 1 < ntile) { const int key0 = WA_KEY0(t + 1); WA_LOAD(key0) }
        if (t < 4) flash_tile<2, false>(qf, o, m, l, cur, cur + 9216, lane, 0, 0);
        else flash_tile<2, true>(qf, o, m, l, cur, cur + 9216, lane, qi, WA_KEY0(t) - 256);
        if (t + 1 < ntile) WA_STORE(nxt)
        __syncthreads();
    }
#undef WA_LOAD
#undef WA_STORE
#undef WA_KEY0
    const float inv = 1.f / (l + SHX(l, 32));
    const int row = lat ? b * 2048 + qi : NL + b * 256 + qi;
    bf16_t* mrow = p.MIX + (size_t)row * DM + hq * 64;
#pragma unroll
    for (int db = 0; db < 2; ++db)
#pragma unroll
        for (int r4 = 0; r4 < 4; ++r4) {
            const int d = db * 32 + 8 * r4 + 4 * hh;
            *(uint2*)(mrow + d) = make_uint2(cvt_pk_bf16(o[db][r4 * 4 + 0] * inv, o[db][r4 * 4 + 1] * inv), cvt_pk_bf16(o[db][r4 * 4 + 2] * inv, o[db][r4 * 4 + 3] * inv));
        }
}

__device__ __forceinline__ int ml_row(int b, int tc, int i) { return tc < 4 ? NL + b * 256 + tc * 64 + i : b * 2048 + (tc - 4) * 64 + i; }
__device__ __forceinline__ void ml_gates(const P& p, int j, int b, int h, int dir, int tc, int lane, float* sa, float* sb, float* sml, float& Bt, float& Mc) {
    const int row = ml_row(b, tc, lane);
    const float ig = p.GT[(size_t)row * 16 + (dir * 2) * 4 + h] + p.ev_gate_b[j * 16 + (dir * 2) * 4 + h];
    const float lf = log_sigmoid_f(p.GT[(size_t)row * 16 + (dir * 2 + 1) * 4 + h] + p.ev_gate_b[j * 16 + (dir * 2 + 1) * 4 + h]);
    float bc = lf;
    if (dir == 0) {
#pragma unroll
        for (int o = 1; o < 64; o <<= 1) { const float t2 = lshfl(bc, lane - o); if (lane >= o) bc += t2; }
    } else {
#pragma unroll
        for (int o = 1; o < 64; o <<= 1) { const float t2 = lshfl(bc, lane + o); if (lane + o < 64) bc += t2; }
    }
    const float a = ig - bc;
    float ml = a;
    if (dir == 0) {
#pragma unroll
        for (int o = 1; o < 64; o <<= 1) { const float t2 = lshfl(ml, lane - o); if (lane >= o) ml = fmaxf(ml, t2); }
    } else {
#pragma unroll
        for (int o = 1; o < 64; o <<= 1) { const float t2 = lshfl(ml, lane + o); if (lane + o < 64) ml = fmaxf(ml, t2); }
    }
    sa[lane] = a; sb[lane] = bc; sml[lane] = ml;
    const int last = dir == 0 ? 63 : 0;
    Bt = lshfl(bc, last); Mc = lshfl(ml, last);
}
__device__ __forceinline__ int ml_tc_of(int dir, int c) { return dir == 0 ? c : (c < 4 ? 3 - c : 39 - c); }
__device__ __forceinline__ int ml_c_of(int dir, int tc) { return dir == 0 ? tc : (tc < 4 ? 3 - tc : 39 - tc); }

__device__ void ml_pass1_item(const P& p, int item, int j, char* smem) {
    const int c = item % 36, dir = (item / 36) & 1, h = (item / 72) & 3, b = item / 288;
    const int tc = ml_tc_of(dir, c);
    const int tid = otid(), lane = tid & 63, wid = tid >> 6, jl = lane & 31, hh = lane >> 5;
    bf16_t* VT = (bf16_t*)smem;
    bf16_t* KWT = (bf16_t*)(smem + 18432);
    float* sa = (float*)(smem + 27648);
    float* sb = sa + 64; float* sml = sb + 64; float* sw = sml + 64; float* ssc = sw + 64;
    __syncthreads();
    if (wid == 0) {
        float Bt, Mc; ml_gates(p, j, b, h, dir, tc, lane, sa, sb, sml, Bt, Mc);
        sw[lane] = expf(sa[lane] - Mc);
        if (lane == 0) { p.CHB[item] = Bt; p.CHM[item] = Mc; }
    }
    __syncthreads();
#pragma unroll
    for (int i = 0; i < 4; ++i) {
        const int e = tid + 256 * i, st = e >> 4, ch = e & 15;
        const uint4 u = *(const uint4*)(p.PB + (size_t)ml_row(b, tc, st) * 1536 + 512 + h * 128 + ch * 8);
        bf16_t* d = VT + (ch * 8) * 72 + st;
        d[0] = (bf16_t)u.x; d[72] = (bf16_t)(u.x >> 16); d[144] = (bf16_t)u.y; d[216] = (bf16_t)(u.y >> 16);
        d[288] = (bf16_t)u.z; d[360] = (bf16_t)(u.z >> 16); d[432] = (bf16_t)u.w; d[504] = (bf16_t)(u.w >> 16);
    }
#pragma unroll
    for (int i = 0; i < 2; ++i) {
        const int e = tid + 256 * i, st = e >> 3, ch = e & 7;
        const uint4 u = *(const uint4*)(p.QKB + (size_t)ml_row(b, tc, st) * 512 + 256 + h * 64 + ch * 8);
        const float w = sw[st];
        bf16_t* d = KWT + (ch * 8) * 72 + st;
        const unsigned q0 = cvt_pk_bf16(bf_lo(u.x) * w, bf_hi(u.x) * w), q1 = cvt_pk_bf16(bf_lo(u.y) * w, bf_hi(u.y) * w), q2 = cvt_pk_bf16(bf_lo(u.z) * w, bf_hi(u.z) * w), q3 = cvt_pk_bf16(bf_lo(u.w) * w, bf_hi(u.w) * w);
        d[0] = (bf16_t)q0; d[72] = (bf16_t)(q0 >> 16); d[144] = (bf16_t)q1; d[216] = (bf16_t)(q1 >> 16);
        d[288] = (bf16_t)q2; d[360] = (bf16_t)(q2 >> 16); d[432] = (bf16_t)q3; d[504] = (bf16_t)(q3 >> 16);
    }
    __syncthreads();
    {
        const int db = wid & 1, vb0 = (wid >> 1) * 2;
        bf16x8 kf[4];
#pragma unroll
        for (int ks = 0; ks < 4; ++ks) kf[ks] = *(const bf16x8*)((const char*)KWT + (db * 32 + jl) * 144 + (2 * ks + hh) * 16);
        float* cl = p.CLOC + (size_t)item * 8192;
#pragma unroll
        for (int vv = 0; vv < 2; ++vv) {
            const int vb = vb0 + vv;
            f32x16 acc;
#pragma unroll
            for (int r = 0; r < 16; ++r) acc[r] = 0.f;
#pragma unroll
            for (int ks = 0; ks < 4; ++ks) {
                const bf16x8 vf = *(const bf16x8*)((const char*)VT + (vb * 32 + jl) * 144 + (2 * ks + hh) * 16);
                acc = __builtin_amdgcn_mfma_f32_32x32x16_bf16(vf, kf[ks], acc, 0, 0, 0);
            }
#pragma unroll
            for (int r = 0; r < 16; ++r) cl[(size_t)(vb * 32 + (r & 3) + 8 * (r >> 2) + 4 * hh) * 64 + db * 32 + jl] = acc[r];
        }
        if (tid < 64) {
            float sum = 0.f;
#pragma unroll
            for (int q = 0; q < 8; ++q) { const uint4 u = *(const uint4*)((const char*)KWT + tid * 144 + q * 16); sum += bf_lo(u.x) + bf_hi(u.x) + bf_lo(u.y) + bf_hi(u.y) + bf_lo(u.z) + bf_hi(u.z) + bf_lo(u.w) + bf_hi(u.w); }
            p.NLOC[(size_t)item * 64 + tid] = sum;
        }
    }
}

__device__ void ph_ml_pass2(const P& p) {
    const int gt = blockIdx.x * 256 + otid(), nthr = gridDim.x * 256;
    for (int w = gt; w < 64 * 2048; w += nthr) {
        const int chain = w >> 11, e = (w & 2047) * 4;
        float c0 = 0.f, c1 = 0.f, c2 = 0.f, c3 = 0.f, m = 0.f;
        for (int c = 0; c < 36; ++c) {
            const int it = chain * 36 + c;
            *(uint2*)(p.CST + (size_t)it * 8192 + e) = make_uint2(cvt_pk_bf16(c0, c1), cvt_pk_bf16(c2, c3));
            const float Bt = p.CHB[it], Mc = p.CHM[it];
            const float g = fmaxf(m, Mc), al = expf(m - g), be = expf(Mc - g);
            const float4 cl = *(const float4*)(p.CLOC + (size_t)it * 8192 + e);
            c0 = al * c0 + be * cl.x; c1 = al * c1 + be * cl.y; c2 = al * c2 + be * cl.z; c3 = al * c3 + be * cl.w;
            m = Bt + g;
        }
    }
    for (int w = gt; w < 64 * 64; w += nthr) {
        const int chain = w >> 6, d = w & 63;
        float n = 0.f, m = 0.f;
        for (int c = 0; c < 36; ++c) {
            const int it = chain * 36 + c;
            p.NST[(size_t)it * 64 + d] = n;
            if (d == 0) p.MST[it] = m;
            const float Bt = p.CHB[it], Mc = p.CHM[it];
            const float g = fmaxf(m, Mc);
            n = expf(m - g) * n + expf(Mc - g) * p.NLOC[(size_t)it * 64 + d];
            m = Bt + g;
        }
    }
}

__device__ void ml_pass3_item(const P& p, int item, int j, char* smem) {
    const int tc = item % 36, h = (item / 36) & 3, b = item / 144;
    const int tid = otid(), lane = tid & 63, wid = tid >> 6, jl = lane & 31, hh = lane >> 5, tb = wid & 1, dir = wid >> 1;
    char* Ql = smem;
    char* Kl = smem + 9216;
    bf16_t* VT = (bf16_t*)(smem + 18432);
    float* gs = (float*)(smem + 35840);
    float* ssc = gs + 512;
    __syncthreads();
    if (wid < 2) {
        const int d2 = wid; float Bt, Mc;
        float* sa = gs + d2 * 256; float* sb = sa + 64; float* sg = sb + 64; float* sn = sg + 64;
        ml_gates(p, j, b, h, d2, tc, lane, sa, sb, sg, Bt, Mc);
        const int sidx = ((b * 4 + h) * 2 + d2) * 36 + ml_c_of(d2, tc);
        const float mst = p.MST[sidx];
        sg[lane] = fmaxf(mst, sg[lane]);
        sn[lane] = p.NST[(size_t)sidx * 64 + lane];
        if (lane == 0) ssc[d2] = mst;
    }
#pragma unroll
    for (int i = 0; i < 2; ++i) {
        const int e = tid + 256 * i, st = e >> 3, ch = e & 7; const int row = ml_row(b, tc, st);
        *(uint4*)(Ql + st * 144 + ch * 16) = *(const uint4*)(p.QKB + (size_t)row * 512 + h * 64 + ch * 8);
        *(uint4*)(Kl + st * 144 + ch * 16) = *(const uint4*)(p.QKB + (size_t)row * 512 + 256 + h * 64 + ch * 8);
    }
#pragma unroll
    for (int i = 0; i < 4; ++i) {
        const int e = tid + 256 * i, st = e >> 4, ch = e & 15;
        const uint4 u = *(const uint4*)(p.PB + (size_t)ml_row(b, tc, st) * 1536 + 512 + h * 128 + ch * 8);
        bf16_t* d = VT + (ch * 8) * 68 + st;
        d[0] = (bf16_t)u.x; d[68] = (bf16_t)(u.x >> 16); d[136] = (bf16_t)u.y; d[204] = (bf16_t)(u.y >> 16);
        d[272] = (bf16_t)u.z; d[340] = (bf16_t)(u.z >> 16); d[408] = (bf16_t)u.w; d[476] = (bf16_t)(u.w >> 16);
    }
    __syncthreads();
    const float* sa = gs + dir * 256; const float* sb = sa + 64; const float* sg = sb + 64; const float* sn = sg + 64;
    const int t = tb * 32 + jl;
    const float gtv = sg[t], btv = sb[t], mst = ssc[dir];
    const float e2 = expf(mst - gtv);
    const int sidx = ((b * 4 + h) * 2 + dir) * 36 + ml_c_of(dir, tc);
    bf16x8 qf[4];
#pragma unroll
    for (int ks = 0; ks < 4; ++ks) qf[ks] = *(const bf16x8*)(Ql + t * 144 + (2 * ks + hh) * 16);
    f32x16 acc[4];
    {
        const bf16_t* cst = p.CST + (size_t)sidx * 8192 + (size_t)jl * 64 + hh * 8;
#pragma unroll
        for (int vb = 0; vb < 4; ++vb) {
#pragma unroll
            for (int r = 0; r < 16; ++r) acc[vb][r] = 0.f;
#pragma unroll
            for (int ks = 0; ks < 4; ++ks) {
                const bf16x8 cf = *(const bf16x8*)(cst + (size_t)vb * 32 * 64 + ks * 16);
                acc[vb] = __builtin_amdgcn_mfma_f32_32x32x16_bf16(cf, qf[ks], acc[vb], 0, 0, 0);
            }
            acc[vb] = acc[vb] * e2;
        }
    }
    float den = 0.f;
    {
        float nq = 0.f;
#pragma unroll
        for (int ks = 0; ks < 4; ++ks) {
            const u32x4 u = __builtin_bit_cast(u32x4, qf[ks]);
            const float* np = sn + 16 * ks + 8 * hh;
            nq += bf_lo(u[0]) * np[0] + bf_hi(u[0]) * np[1] + bf_lo(u[1]) * np[2] + bf_hi(u[1]) * np[3] + bf_lo(u[2]) * np[4] + bf_hi(u[2]) * np[5] + bf_lo(u[3]) * np[6] + bf_hi(u[3]) * np[7];
        }
        den = e2 * nq;
    }
#pragma unroll
    for (int sbk = 0; sbk < 2; ++sbk) {
        const bool use = dir == 0 ? (sbk <= tb) : (sbk >= tb);
        if (use) {
            f32x16 sc;
#pragma unroll
            for (int r = 0; r < 16; ++r) sc[r] = 0.f;
#pragma unroll
            for (int ks = 0; ks < 4; ++ks) {
                const bf16x8 kf = *(const bf16x8*)(Kl + (sbk * 32 + jl) * 144 + (2 * ks + hh) * 16);
                sc = __builtin_amdgcn_mfma_f32_32x32x16_bf16(kf, qf[ks], sc, 0, 0, 0);
            }
#pragma unroll
            for (int r4 = 0; r4 < 4; ++r4) {
                const int s0 = sbk * 32 + 8 * r4 + 4 * hh;
                const f32x4 av = *(const f32x4*)(sa + s0);
#pragma unroll
                for (int q = 0; q < 4; ++q) {
                    const int s2 = s0 + q;
                    const bool ok = dir == 0 ? (s2 <= t) : (s2 >= t);
                    const float pv = ok ? sc[r4 * 4 + q] * expf(av[q] - gtv) : 0.f;
                    sc[r4 * 4 + q] = pv; den += pv;
                }
            }
            bf16x8 pb[2];
            pb[0] = pack8(sc[0], sc[1], sc[2], sc[3], sc[4], sc[5], sc[6], sc[7]);
            pb[1] = pack8(sc[8], sc[9], sc[10], sc[11], sc[12], sc[13], sc[14], sc[15]);
#pragma unroll
            for (int vb = 0; vb < 4; ++vb)
#pragma unroll
                for (int k2 = 0; k2 < 2; ++k2) {
                    const char* vp = (const char*)VT + (vb * 32 + jl) * 136 + (sbk * 32 + k2 * 16 + 4 * hh) * 2;
                    const uint2 lo = *(const uint2*)vp, hi = *(const uint2*)(vp + 16);
                    const u32x4 u = (u32x4){lo.x, lo.y, hi.x, hi.y};
                    acc[vb] = __builtin_amdgcn_mfma_f32_32x32x16_bf16(__builtin_bit_cast(bf16x8, u), pb[k2], acc[vb], 0, 0, 0);
                }
        }
    }
    den += SHX(den, 32);
    const float scl = 1.f / fmaxf(fabsf(den), expf(-(btv + gtv)));
#pragma unroll
    for (int vb = 0; vb < 4; ++vb) acc[vb] = acc[vb] * scl;
    __syncthreads();
    float* X = (float*)smem + tb * 4096;
    if (dir == 1) {
#pragma unroll
        for (int vb = 0; vb < 4; ++vb)
#pragma unroll
            for (int r = 0; r < 16; ++r) X[(vb * 32 + (r & 3) + 8 * (r >> 2) + 4 * hh) * 32 + jl] = acc[vb][r];
    }
    __syncthreads();
    if (dir == 0) {
        float ss = 0.f;
#pragma unroll
        for (int vb = 0; vb < 4; ++vb)
#pragma unroll
            for (int r = 0; r < 16; ++r) { const float v = acc[vb][r] + X[(vb * 32 + (r & 3) + 8 * (r >> 2) + 4 * hh) * 32 + jl]; acc[vb][r] = v; ss += v * v; }
        ss += SHX(ss, 32);
        const float rstd = rsqrtf(ss * (1.f / 128.f) + 1e-6f);
        const int row = ml_row(b, tc, t);
        const float* g = p.ev_ml_g + (size_t)j * 512 + h * 128;
        const bf16_t* og = p.PB + (size_t)row * 1536 + 1024 + h * 128;
        bf16_t* mrow = p.MIX + (size_t)row * DM + h * 128;
#pragma unroll
        for (int vb = 0; vb < 4; ++vb)
#pragma unroll
            for (int r4 = 0; r4 < 4; ++r4) {
                const int v = vb * 32 + 8 * r4 + 4 * hh;
                const f32x4 gg = *(const f32x4*)(g + v);
                const uint2 ou = *(const uint2*)(og + v);
                *(uint2*)(mrow + v) = make_uint2(cvt_pk_bf16(acc[vb][r4 * 4 + 0] * rstd * gg[0] * sigmoid_f(bf_lo(ou.x)), acc[vb][r4 * 4 + 1] * rstd * gg[1] * sigmoid_f(bf_hi(ou.x))),
                                                 cvt_pk_bf16(acc[vb][r4 * 4 + 2] * rstd * gg[2] * sigmoid_f(bf_lo(ou.y)), acc[vb][r4 * 4 + 3] * rstd * gg[3] * sigmoid_f(bf_hi(ou.y))));
            }
    }
}

__device__ void ph_attn_even(const P& p, int ci, int L, int j, float* smem) {
    int* s_item = (int*)((char*)smem + 73728);
    for (;;) {
        __syncthreads();
        if (otid() == 0) *s_item = atomicAdd(&p.ctr[ci], 1);
        __syncthreads();
        const int item = *s_item;
        if (item >= 1152 + 2304) break;
        if (item < 1152) da_block(p, item, L, j, (char*)smem); else ml_pass1_item(p, item - 1152, j, (char*)smem);
    }
}
__device__ void ph_ml_pass3(const P& p, int j, float* smem) {
    for (int item = blockIdx.x; item < 1152; item += gridDim.x) ml_pass3_item(p, item, j, (char*)smem);
}
__device__ void ph_attn_odd(const P& p, int j, bool need_ctx, float* smem) {
    const int nitem = need_ctx ? 2304 : 2048;
    for (int item = blockIdx.x; item < nitem; item += gridDim.x) { wa_block(p, item, j, (char*)smem); __syncthreads(); }
}

#define SEL_LD 132
template <int NV>
__device__ __forceinline__ unsigned topk16_threshold(const unsigned (&k)[NV], unsigned start) {
    auto cnt = [&](unsigned c) { int n = 0;
#pragma unroll
        for (int i = 0; i < NV; ++i) n += __builtin_popcountll(__ballot(k[i] >= c));
        return n; };
    unsigned E = start; int n = cnt(E);
    if (n >= 16) { for (;;) { const unsigned E2 = E + 0x800000u; if (E2 < E) break; const int n2 = cnt(E2); if (n2 < 16) break; E = E2; n = n2; } }
    else { do { E -= 0x800000u; n = cnt(E); } while (n < 16); }
    unsigned T = E;
    for (int bit = 22; bit >= 0 && n != 16; --bit) { const unsigned c = T | (1u << bit); n = cnt(c); if (n >= 16) T = c; else n = 17; }
    return T;
}
__device__ __forceinline__ unsigned fkey(float f) { const unsigned u = __float_as_uint(f); return (u & 0x80000000u) ? ~u : (u | 0x80000000u); }
__device__ __forceinline__ unsigned mbcnt64(unsigned long long m) { return __builtin_amdgcn_mbcnt_hi((unsigned)(m >> 32), __builtin_amdgcn_mbcnt_lo((unsigned)m, 0u)); }
__device__ void ph_peer_select(const P& p, int L, int nrows, char* smem) {
    float* S = (float*)smem;
    const int tid = otid(), lane = tid & 63, wid = tid >> 6, fr = lane & 15, fq = lane >> 4;
    const bf16_t* KBL = p.KB + (size_t)L * 8 * 2 * 128 * 128;
    const int ntile = nrows / 32;
    bf16x8 kfr[8][4];
    int hcur = -1;
    for (int item = blockIdx.x; item < ntile * 8; item += gridDim.x) {
        const int h = item & 7, t0 = (item >> 3) * 32;
        __syncthreads();
        {
            const int pp = wid >> 1, th = wid & 1;
            const bf16_t* qp = p.QB + (size_t)(t0 + th * 16 + fr) * 2048 + h * 256 + pp * 128 + fq * 8;
            bf16x8 qf[4];
#pragma unroll
            for (int ks = 0; ks < 4; ++ks) qf[ks] = *(const bf16x8*)(qp + ks * 32);
            if (h != hcur) {
                const bf16_t* kp = KBL + ((size_t)(h * 2 + pp) * 128 + fr) * 128 + fq * 8;
#pragma unroll
                for (int ni = 0; ni < 8; ++ni)
#pragma unroll
                    for (int ks = 0; ks < 4; ++ks) kfr[ni][ks] = *(const bf16x8*)(kp + (size_t)ni * 16 * 128 + ks * 32);
                hcur = h;
            }
#pragma unroll
            for (int ni = 0; ni < 8; ++ni) {
                f32x4 acc = (f32x4){0.f, 0.f, 0.f, 0.f};
#pragma unroll
                for (int ks = 0; ks < 4; ++ks) acc = __builtin_amdgcn_mfma_f32_16x16x32_bf16(qf[ks], kfr[ni][ks], acc, 0, 0, 0);
#pragma unroll
                for (int j = 0; j < 4; ++j) S[(pp * 32 + th * 16 + fq * 4 + j) * SEL_LD + ni * 16 + fr] = acc[j];
            }
        }
        __syncthreads();
        for (int tt = 0; tt < 8; ++tt) {
            const int t = wid * 8 + tt, r = t0 + t;
            const float v00 = S[t * SEL_LD + lane], v01 = S[t * SEL_LD + 64 + lane], v10 = S[(32 + t) * SEL_LD + lane], v11 = S[(32 + t) * SEL_LD + 64 + lane];
            const unsigned ka0 = fkey(v00), ka1 = fkey(v01), kb0 = fkey(v10), kb1 = fkey(v11);
            const unsigned kA[2] = {ka0, ka1}, kB[2] = {kb0, kb1};
            const unsigned T0 = topk16_threshold<2>(kA, 0xBF800000u), T1 = topk16_threshold<2>(kB, 0xBF800000u);
            float* wsA = (float*)(smem + 34816 + wid * 512);
            {
                const unsigned long long g0 = __ballot(ka0 > T0), g1 = __ballot(ka1 > T0), e0 = __ballot(ka0 == T0), e1 = __ballot(ka1 == T0);
                const int need = 16 - __builtin_popcountll(g0) - __builtin_popcountll(g1);
                const int pe0 = __builtin_popcountll(e0), need1 = need - (pe0 < need ? pe0 : need);
                const bool s0 = (ka0 > T0) || (ka0 == T0 && (int)mbcnt64(e0) < need);
                const bool s1 = (ka1 > T0) || (ka1 == T0 && (int)mbcnt64(e1) < need1);
                const unsigned long long m0 = __ballot(s0), m1 = __ballot(s1);
                if (s0) { const int pos = mbcnt64(m0); wsA[pos] = v00; ((int*)wsA)[16 + pos] = lane; }
                if (s1) { const int pos = __builtin_popcountll(m0) + mbcnt64(m1); wsA[pos] = v01; ((int*)wsA)[16 + pos] = 64 + lane; }
            }
            {
                const unsigned long long g0 = __ballot(kb0 > T1), g1 = __ballot(kb1 > T1), e0 = __ballot(kb0 == T1), e1 = __ballot(kb1 == T1);
                const int need = 16 - __builtin_popcountll(g0) - __builtin_popcountll(g1);
                const int pe0 = __builtin_popcountll(e0), need1 = need - (pe0 < need ? pe0 : need);
                const bool s0 = (kb0 > T1) || (kb0 == T1 && (int)mbcnt64(e0) < need);
                const bool s1 = (kb1 > T1) || (kb1 == T1 && (int)mbcnt64(e1) < need1);
                const unsigned long long m0 = __ballot(s0), m1 = __ballot(s1);
                if (s0) { const int pos = mbcnt64(m0); wsA[32 + pos] = v10; ((int*)wsA)[48 + pos] = lane; }
                if (s1) { const int pos = __builtin_popcountll(m0) + mbcnt64(m1); wsA[32 + pos] = v11; ((int*)wsA)[48 + pos] = 64 + lane; }
            }
            __builtin_amdgcn_wave_barrier();
            float cand[4]; int cidx[4]; unsigned kc[4];
            {
                const float av = wsA[lane >> 2]; const int ai = ((int*)wsA)[16 + (lane >> 2)];
                const float4 bv = *(const float4*)(wsA + 32 + (lane & 3) * 4); const int4 bi = *(const int4*)((int*)wsA + 48 + (lane & 3) * 4);
                cand[0] = av + bv.x; cand[1] = av + bv.y; cand[2] = av + bv.z; cand[3] = av + bv.w;
                cidx[0] = ai * 128 + bi.x; cidx[1] = ai * 128 + bi.y; cidx[2] = ai * 128 + bi.z; cidx[3] = ai * 128 + bi.w;
#pragma unroll
                for (int c = 0; c < 4; ++c) kc[c] = fkey(cand[c]);
            }
            const unsigned T = topk16_threshold<4>(kc, 0xC0800000u);
            {
                int need = 16, base = 0;
#pragma unroll
                for (int c = 0; c < 4; ++c) need -= __builtin_popcountll(__ballot(kc[c] > T));
#pragma unroll
                for (int c = 0; c < 4; ++c) {
                    const unsigned long long e = __ballot(kc[c] == T);
                    const bool sel = (kc[c] > T) || (kc[c] == T && (int)mbcnt64(e) < need);
                    const int pe = __builtin_popcountll(e); need -= (pe < need ? pe : need);
                    const unsigned long long m = __ballot(sel);
                    if (sel) { const int pos = base + mbcnt64(m); wsA[64 + pos] = cand[c]; ((int*)wsA)[80 + pos] = cidx[c]; }
                    base += __builtin_popcountll(m);
                }
            }
            __builtin_amdgcn_wave_barrier();
            {
                const float cv = lane < 16 ? wsA[64 + lane] : -INFINITY;
                const float mx = wave_max(cv);
                const float ex = lane < 16 ? __builtin_amdgcn_exp2f((cv - mx) * 1.4426950408889634f) : 0.f;
                const float sum = wave_sum(ex);
                if (lane < 16) { p.GATE[(size_t)r * 128 + h * 16 + lane] = ex / sum; p.EIDX[(size_t)r * 128 + h * 16 + lane] = ((int*)wsA)[80 + lane]; }
            }
            __builtin_amdgcn_wave_barrier();
        }
    }
}


__device__ __forceinline__ void unpack8(const uint4 u, float* f) {
    f[0] = bf_lo(u.x); f[1] = bf_hi(u.x); f[2] = bf_lo(u.y); f[3] = bf_hi(u.y); f[4] = bf_lo(u.z); f[5] = bf_hi(u.z); f[6] = bf_lo(u.w); f[7] = bf_hi(u.w);
}
__device__ __forceinline__ void unpack16_u8(const uint4 u, float* f) {
    f[0] = (float)(u.x & 0xffu); f[1] = (float)((u.x >> 8) & 0xffu); f[2] = (float)((u.x >> 16) & 0xffu); f[3] = (float)((u.x >> 24) & 0xffu);
    f[4] = (float)(u.y & 0xffu); f[5] = (float)((u.y >> 8) & 0xffu); f[6] = (float)((u.y >> 16) & 0xffu); f[7] = (float)((u.y >> 24) & 0xffu);
    f[8] = (float)(u.z & 0xffu); f[9] = (float)((u.z >> 8) & 0xffu); f[10] = (float)((u.z >> 16) & 0xffu); f[11] = (float)((u.z >> 24) & 0xffu);
    f[12] = (float)(u.w & 0xffu); f[13] = (float)((u.w >> 8) & 0xffu); f[14] = (float)((u.w >> 16) & 0xffu); f[15] = (float)((u.w >> 24) & 0xffu);
}
__device__ void ph_peer_gather(const P& p, int L, int nrows, float oscale) {
    const int lane = otid() & 63, wid = otid() >> 6;
    const unsigned char* U = p.U8 + (size_t)L * 16384 * 1024; const unsigned char* V = p.V8 + (size_t)L * 16384 * 1024;
    const float* USC = p.USC + (size_t)L * 16384; const float* VSC = p.VSC + (size_t)L * 16384;
    const float* gate2 = p.modv + (size_t)L * 9 * 6144 + 5120;
    for (int r = blockIdx.x * 4 + wid; r < nrows; r += gridDim.x * 4) {
        const int e0 = p.EIDX[(size_t)r * 128 + lane], e1 = p.EIDX[(size_t)r * 128 + 64 + lane];
        const float g0 = p.GATE[(size_t)r * 128 + lane], g1 = p.GATE[(size_t)r * 128 + 64 + lane];
        const float us0 = USC[e0], us1 = USC[e1], vs0 = VSC[e0], vs1 = VSC[e1];
        float x[16];
        { const uint4 xa = *(const uint4*)(p.XN + (size_t)r * DM + lane * 16), xb = *(const uint4*)(p.XN + (size_t)r * DM + lane * 16 + 8); unpack8(xa, x); unpack8(xb, x + 8); }
        float sx = 0.f;
#pragma unroll
        for (int c = 0; c < 16; ++c) sx += x[c];
        sx = wave_sum(sx);
        float a0 = 0.f, a1 = 0.f;
#pragma unroll
        for (int half = 0; half < 2; ++half) {
            const int ev = half ? e1 : e0;
            float av = 0.f;
            for (int kb = 0; kb < 4; ++kb) {
                uint4 ua[16];
#pragma unroll
                for (int j = 0; j < 16; ++j) {
                    const int idx = __builtin_amdgcn_readlane(ev, kb * 16 + j);
                    ua[j] = *(const uint4*)(U + (size_t)idx * 1024 + lane * 16);
                }
#pragma unroll
                for (int j = 0; j < 16; ++j) {
                    float f[16]; unpack16_u8(ua[j], f);
                    float s = 0.f;
#pragma unroll
                    for (int c = 0; c < 16; ++c) s += x[c] * f[c];
                    s = wave_sum(s);
                    if (lane == kb * 16 + j) av = s;
                }
            }
            if (half) a1 = av; else a0 = av;
        }
        a0 = us0 * (a0 - 128.f * sx); a1 = us1 * (a1 - 128.f * sx);
        const float w0 = vs0 * g0 * 0.5f * a0 * (1.f + erff(a0 * 0.70710678118654752f));
        const float w1 = vs1 * g1 * 0.5f * a1 * (1.f + erff(a1 * 0.70710678118654752f));
        const float wsum = wave_sum(w0 + w1);
        float acc[16];
#pragma unroll
        for (int c = 0; c < 16; ++c) acc[c] = 0.f;
#pragma unroll
        for (int half = 0; half < 2; ++half) {
            const int ev = half ? e1 : e0; const int wv = __float_as_int(half ? w1 : w0);
            for (int kb = 0; kb < 4; ++kb) {
                uint4 ua[16];
#pragma unroll
                for (int j = 0; j < 16; ++j) {
                    const int idx = __builtin_amdgcn_readlane(ev, kb * 16 + j);
                    ua[j] = *(const uint4*)(V + (size_t)idx * 1024 + lane * 16);
                }
#pragma unroll
                for (int j = 0; j < 16; ++j) {
                    const float wj = __int_as_float(__builtin_amdgcn_readlane(wv, kb * 16 + j));
                    float f[16]; unpack16_u8(ua[j], f);
#pragma unroll
                    for (int c = 0; c < 16; ++c) acc[c] += wj * f[c];
                }
            }
        }
        const float* gp = gate2 + (size_t)modrow(r) * 6144 + lane * 16;
        float* hp = p.H + (size_t)r * DM + lane * 16;
        float hn[16]; float ss = 0.f;
#pragma unroll
        for (int q = 0; q < 4; ++q) {
            const float4 g = *(const float4*)(gp + q * 4);
            float4 hv = *(float4*)(hp + q * 4);
            hv.x += oscale * g.x * (acc[q * 4 + 0] - 128.f * wsum); hv.y += oscale * g.y * (acc[q * 4 + 1] - 128.f * wsum);
            hv.z += oscale * g.z * (acc[q * 4 + 2] - 128.f * wsum); hv.w += oscale * g.w * (acc[q * 4 + 3] - 128.f * wsum);
            if (L < 3) *(float4*)(hp + q * 4) = hv;
            hn[q * 4 + 0] = hv.x; hn[q * 4 + 1] = hv.y; hn[q * 4 + 2] = hv.z; hn[q * 4 + 3] = hv.w;
            ss += hv.x * hv.x + hv.y * hv.y + hv.z * hv.z + hv.w * hv.w;
        }
        ss = wave_sum(ss);
        const float rstd = rsqrtf(ss * (1.0f / DM) + 1e-6f);
        if (L < 3) {
            const float* g1 = p.norm1_g + (size_t)(L + 1) * DM + lane * 16;
            const float* mvn = p.modv + ((size_t)(L + 1) * 9 + modrow(r)) * 6144 + lane * 16;
            unsigned w[8];
#pragma unroll
            for (int q = 0; q < 4; ++q) {
                const float4 gg = *(const float4*)(g1 + q * 4), sh = *(const float4*)(mvn + q * 4), scl = *(const float4*)(mvn + 1024 + q * 4);
                w[q * 2] = cvt_pk_bf16(hn[q * 4 + 0] * rstd * gg.x * (1.f + scl.x) + sh.x, hn[q * 4 + 1] * rstd * gg.y * (1.f + scl.y) + sh.y);
                w[q * 2 + 1] = cvt_pk_bf16(hn[q * 4 + 2] * rstd * gg.z * (1.f + scl.z) + sh.z, hn[q * 4 + 3] * rstd * gg.w * (1.f + scl.w) + sh.w);
            }
            uint4* xp = (uint4*)(p.XN + (size_t)r * DM + lane * 16);
            xp[0] = make_uint4(w[0], w[1], w[2], w[3]); xp[1] = make_uint4(w[4], w[5], w[6], w[7]);
        } else {
            const float* fg = p.final_g + lane * 16;
            float* op = p.out + (size_t)r * DM + lane * 16;
#pragma unroll
            for (int q = 0; q < 4; ++q) {
                const float4 gg = *(const float4*)(fg + q * 4);
                *(float4*)(op + q * 4) = make_float4(hn[q * 4 + 0] * rstd * gg.x, hn[q * 4 + 1] * rstd * gg.y, hn[q * 4 + 2] * rstd * gg.z, hn[q * 4 + 3] * rstd * gg.w);
            }
        }
    }
}

#define NSUB 11
__device__ __forceinline__ bool phase_empty(int ph) {
    if (ph == 0) return false;
    const int L = (ph - 1) / NSUB, s = (ph - 1) % NSUB;
    return ((L & 1) && (s == 2 || s == 4 || s == 5)) || (L > 0 && s == 0);
}
__device__ void run_phase(const P& p, int ph, float* smem, int rep) {
    if (ph == 0) { ph_prologue(p, smem); return; }
    const int L = (ph - 1) / NSUB, s = (ph - 1) % NSUB, j = L >> 1;
    const bool even = (L & 1) == 0, need_ctx = L < 3;
    const int nrows = need_ctx ? NT : NL;
    const float* mv = p.modv + (size_t)L * 9 * 6144;
    switch (s) {
    case 0: ph_normmod(p.H, p.norm1_g + L * DM, mv, 0, 1024, p.XN, NT); break;
    case 1:
        if (even) ph_gemm(p.XN, p.WT + WT_EVIN(j), NT, 3200, EpiEven{p.PB, p.AQL, p.AQC, p.AK, p.AV, p.GT, p.rope}, (char*)smem);
        else ph_gemm(p.XN, p.WT + WT_ODIN(j), NT, ODW, EpiOdd{p.AQL, p.AQC, p.AK, p.AV, p.rope}, (char*)smem);
        break;
    case 2: if (even) ph_prep_even(p, j); break;
    case 3: if (even) ph_attn_even(p, L + 4 * rep, L, j, smem); else ph_attn_odd(p, j, need_ctx, smem); break;
    case 4: if (even) ph_ml_pass2(p); break;
    case 5: if (even) ph_ml_pass3(p, j, smem); break;
    case 6: ph_gemm(p.MIX, p.WT + (even ? WT_EVOUT(j) : WT_ODOUT(j)), nrows, DM, EpiResid{p.H, mv + 2048, rep ? 0.f : 1.f}, (char*)smem); break;
    case 7: ph_normmod(p.H, p.norm2_g + L * DM, mv, 3072, 4096, p.XN, nrows); break;
    case 8: ph_gemm(p.XN, p.WT + WT_PQ(L), nrows, 2048, EpiStoreBF16{p.QB, 2048}, (char*)smem); break;
    case 9: ph_peer_select(p, L, nrows, (char*)smem); break;
    case 10: ph_peer_gather(p, L, nrows, rep ? 0.f : 1.f); break;
    }
}

#define XB_TMO      128
#define XB_XCNT(j)  (256  + 64 * (j))
#define XB_XSUB(j)  (1280 + 64 * (j))
#define XB_XGEN(j)  (2304 + 64 * (j))
#define XB_TOP      3328
#define XB_TOPGEN   3392
#define XCD_BAR_WORDS 3456
#define XB_SPIN_CAP (1u << 20)
#define LAS __attribute__((address_space(3)))
__device__ __forceinline__ unsigned xb_ld(unsigned* p)              { return __hip_atomic_load(p, __ATOMIC_RELAXED, __HIP_MEMORY_SCOPE_AGENT); }
__device__ __forceinline__ unsigned xb_add(unsigned* p, unsigned v) { return __hip_atomic_fetch_add(p, v, __ATOMIC_RELAXED, __HIP_MEMORY_SCOPE_AGENT); }
__device__ __forceinline__ unsigned xb_xcc_id() { return (unsigned)__builtin_amdgcn_s_getreg((3 << 11) | 20) & 0xFu; }
#define XB_SPIN(cond, bar) do { unsigned _sp = 0; while (cond) { __builtin_amdgcn_s_sleep(1); \
    if ((++_sp & 255u) == 0u) { if (xb_ld(&(bar)[XB_TMO])) break; if (_sp > XB_SPIN_CAP) { atomicAdd(&(bar)[XB_TMO], 1u); break; } } } } while (0)
struct XcdBarrier { unsigned* bar; unsigned x; volatile LAS unsigned* st; };
__device__ __forceinline__ XcdBarrier xcd_barrier_post(unsigned* bar, volatile LAS unsigned* st) {
    XcdBarrier b; b.bar = bar; b.x = xb_xcc_id(); b.st = st;
    if (threadIdx.x == 0) (void)xb_add(&bar[XB_XCNT(b.x)], 1u);
    return b;
}
__device__ __forceinline__ void xcd_barrier_complete(unsigned* bar, unsigned x, unsigned& nloc, unsigned& nx) {
    const unsigned G = gridDim.x * gridDim.y * gridDim.z;
    unsigned sum, cnt, mine, sp = 0u;
    for (;;) {
        sum = 0u; cnt = 0u; mine = 0u;
#pragma unroll
        for (unsigned j = 0; j < 16; ++j) { const unsigned c = xb_ld(&bar[XB_XCNT(j)]); sum += c; cnt += (c > 0u) ? 1u : 0u; mine = (j == x) ? c : mine; }
        if (sum == G) break;
        __builtin_amdgcn_s_sleep(1);
        if ((++sp & 255u) == 0u) { if (xb_ld(&bar[XB_TMO])) break; if (sp > XB_SPIN_CAP) { atomicAdd(&bar[XB_TMO], 1u); break; } }
    }
    nloc = mine > 0u ? mine : 1u; nx = cnt > 0u ? cnt : 1u;
}
__device__ __forceinline__ void xcd_barrier(const XcdBarrier& b) {
    asm volatile("s_waitcnt vmcnt(0)" ::: "memory");
    __syncthreads();
    if (threadIdx.x == 0) {
        unsigned* bar = b.bar;
        __builtin_amdgcn_s_waitcnt(0);
        unsigned nloc = b.st[0], nx = b.st[1];
        if (nloc == 0u) { xcd_barrier_complete(bar, b.x, nloc, nx); b.st[0] = nloc; b.st[1] = nx; }
        const unsigned old = xb_add(&bar[XB_XSUB(b.x)], 1u);
        const unsigned gen = old / nloc;
        if (old + 1u == (gen + 1u) * nloc) {
            __builtin_amdgcn_fence(__ATOMIC_RELEASE, "agent");
            asm volatile("s_waitcnt vmcnt(0)" ::: "memory");
            const unsigned og = xb_add(&bar[XB_TOP], 1u);
            const unsigned tg = og / nx;
            if (og + 1u == (tg + 1u) * nx) xb_add(&bar[XB_TOPGEN], 1u);
            else XB_SPIN(xb_ld(&bar[XB_TOPGEN]) == tg, bar);
            __builtin_amdgcn_fence(__ATOMIC_ACQUIRE, "agent");
            xb_add(&bar[XB_XGEN(b.x)], 1u);
            asm volatile("s_waitcnt vmcnt(0)" ::: "memory");
        } else {
            XB_SPIN(xb_ld(&bar[XB_XGEN(b.x)]) == gen, bar);
            __builtin_amdgcn_fence(__ATOMIC_ACQUIRE, "agent");
            asm volatile("s_waitcnt vmcnt(0)" ::: "memory");
        }
    }
    __syncthreads();
}

__global__ void __launch_bounds__(256, 2) mega(P p) {
    extern __shared__ __attribute__((aligned(16))) float smem[];
    cg::grid_group grid = cg::this_grid();
    volatile LAS unsigned* st = (volatile LAS unsigned*)((char*)smem + 73744);
    if (threadIdx.x < 4) st[threadIdx.x] = 0u;
    __syncthreads();
    XcdBarrier xb = xcd_barrier_post(p.bar, st);
    for (int ph = p.ph_lo; ph < p.ph_hi; ++ph) {
        if (phase_empty(ph)) continue;
        run_phase(p, ph, smem, 0);
        if (PROBE_N > 1 && ph > 0 && (ph - 1) % NSUB == PROBE_S)
            for (int rep = 1; rep < PROBE_N; ++rep) { xcd_barrier(xb); run_phase(p, ph, smem, rep); }
        if (ph + 1 < p.ph_hi) { if (ph == 0) grid.sync(); else xcd_barrier(xb); }
    }
}

extern "C" void kernel_launch(void* const* d_in, const int* in_sizes, int n_in, void* d_out, int out_size, void* d_ws, size_t ws_size, hipStream_t stream) {
    static int grid_blocks = 0;
    if (!grid_blocks) {
        int dev = 0, cus = 0, per_cu = 0;
        hipGetDevice(&dev);
        hipDeviceGetAttribute(&cus, hipDeviceAttributeMultiprocessorCount, dev);
        hipFuncSetAttribute((const void*)mega, hipFuncAttributeMaxDynamicSharedMemorySize, LDS_BYTES);
        hipOccupancyMaxActiveBlocksPerMultiprocessor(&per_cu, mega, 256, LDS_BYTES);
        if (per_cu < 1) per_cu = 1;
        if (per_cu > 2) per_cu = 2;
        grid_blocks = cus * per_cu;
    }
    P p{};
    const float** ins = (const float**)&p;
    for (int i = 0; i < 24; ++i) ins[i] = (const float*)d_in[i];
    p.out = (float*)d_out;
    size_t off = 0; char* ws = (char*)d_ws;
    auto carve = [&](size_t bytes) { void* r = ws + off; off += (bytes + 255) & ~(size_t)255; return r; };
    p.modv = (float*)carve((size_t)4 * 9 * 6144 * 4);
    p.rope = (float*)carve((size_t)2048 * 64 * 4);
    p.H = (float*)carve((size_t)NT * DM * 4);
    p.XN = (bf16_t*)carve((size_t)NT * DM * 2);
    p.WT = (bf16_t*)carve(WT_TOTAL * 2);
    p.MIX = (bf16_t*)carve((size_t)NT * DM * 2);
    p.PB = (bf16_t*)carve((size_t)NT * 1536 * 2);
    p.GT = (float*)carve((size_t)NT * 16 * 4);
    p.AQL = (bf16_t*)carve((size_t)8 * 16 * 2048 * 64 * 2);
    p.AQC = (bf16_t*)carve((size_t)8 * 16 * 256 * 64 * 2);
    p.AK = (bf16_t*)carve((size_t)8 * 4 * 2 * 2304 * 64 * 2);
    p.AV = (bf16_t*)carve((size_t)8 * 4 * 128 * 2304 * 2);
    p.QKB = (bf16_t*)carve((size_t)NT * 512 * 2);
    p.CLOC = (float*)carve((size_t)2304 * 8192 * 4);
    p.CST = (bf16_t*)carve((size_t)2304 * 8192 * 2);
    p.NLOC = (float*)carve((size_t)2304 * 64 * 4);
    p.NST = (float*)carve((size_t)2304 * 64 * 4);
    p.CHB = (float*)carve((size_t)2304 * 4);
    p.CHM = (float*)carve((size_t)2304 * 4);
    p.MST = (float*)carve((size_t)2304 * 4);
    p.QB = (bf16_t*)carve((size_t)NT * 2048 * 2);
    p.GATE = (float*)carve((size_t)NT * 128 * 4);
    p.EIDX = (int*)carve((size_t)NT * 128 * 4);
    p.ctr = (int*)carve(256);
    p.bar = (unsigned*)carve((size_t)XCD_BAR_WORDS * 4);
    p.U8 = (unsigned char*)carve((size_t)4 * 16384 * 1024);
    p.V8 = (unsigned char*)carve((size_t)4 * 16384 * 1024);
    p.USC = (float*)carve((size_t)4 * 16384 * 4);
    p.VSC = (float*)carve((size_t)4 * 16384 * 4);
    p.KB = (bf16_t*)carve((size_t)4 * 8 * 2 * 128 * 128 * 2);
    if (off > ws_size) { fprintf(stderr, "kernel_launch: workspace too small: need %zu have %zu\n", off, ws_size); return; }
    hipMemsetAsync(p.bar, 0, (size_t)XCD_BAR_WORDS * 4, stream);
#if ONE_LAUNCH
    p.ph_lo = 0; p.ph_hi = NPH;
    void* args[] = {&p};
    hipError_t e = hipLaunchCooperativeKernel((void*)mega, dim3(grid_blocks), dim3(256), args, LDS_BYTES, stream);
    if (e != hipSuccess) fprintf(stderr, "cooperative launch failed: %s (grid %d)\n", hipGetErrorString(e), grid_blocks);
#else
    for (int ph = 0; ph < NPH; ++ph) {
        if (ph > 0 && ph < NPH - 1) { const int L = (ph - 1) / NSUB, s = (ph - 1) % NSUB; if ((s == 2 || s == 4 || s == 5) && (L & 1)) continue; }
        p.ph_lo = ph; p.ph_hi = ph + 1;
        hipLaunchKernelGGL(mega, dim3(grid_blocks), dim3(256), LDS_BYTES, stream, p);
    }
#endif
}
```

```cpp
#include <hip/hip_runtime.h>
#include <hip/hip_cooperative_groups.h>
#include <cstdio>
#include <cstdint>
namespace cg = cooperative_groups;

#ifndef ONE_LAUNCH
#define ONE_LAUNCH 1
#endif

#define NT 18432
#define NL 16384
#define DM 1024
#define EVW 3088
#define ODW 1536
#define C_QK 0
#define C_V 512
#define C_O 1024
#define C_G 1536
#define C_DQ 1552
#define C_DK 2064
#define C_DV 2576
#define NPH 45
#ifndef PROBE_S
#define PROBE_S -1
#endif
#ifndef PROBE_N
#define PROBE_N 1
#endif

typedef unsigned short bf16_t;
typedef short bf16x8 __attribute__((ext_vector_type(8)));
typedef float f32x4 __attribute__((ext_vector_type(4)));
#define LDS_BYTES 73792

typedef float f32x16 __attribute__((ext_vector_type(16)));
typedef unsigned u32x4 __attribute__((ext_vector_type(4)));
struct P {
    const float *x, *c, *ctx, *c_ctx, *mod_w, *mod_b, *norm1_g, *norm2_g, *ev_w_in, *ev_conv_w, *ev_conv_b, *ev_gate_b,
        *ev_ml_g, *ev_da_lam, *ev_da_g, *ev_w_out, *od_w_in, *od_sink, *od_w_out, *pr_w_q, *pr_keys, *pr_u, *pr_v, *final_g;
    float* out;
    float *modv, *H, *GATE, *rope, *GT, *CLOC, *NLOC, *NST, *CHB, *CHM, *MST;
    int *EIDX, *ctr;
    unsigned* bar;
    bf16_t *XN, *MIX, *WT, *KB, *QB, *PB, *AQL, *AQC, *AK, *AV, *QKB, *CST;
    unsigned char *U8, *V8;
    float *USC, *VSC, *XS;
    unsigned char* XQ;
    int ph_lo, ph_hi;
};
#define QSCALE 0.18033688011112042f

__device__ __forceinline__ int otid() { int t = threadIdx.x; asm volatile("" : "+v"(t)); return t; }
__device__ __forceinline__ unsigned pack_i8x4(float a, float b, float c, float d) {
    return ((unsigned)(int)rintf(a) & 0xffu) | (((unsigned)(int)rintf(b) & 0xffu) << 8) | (((unsigned)(int)rintf(c) & 0xffu) << 16) | ((unsigned)(int)rintf(d) << 24);
}
__device__ __forceinline__ int modrow(int r) { return r < NL ? (r >> 11) : 8; }
__device__ __forceinline__ float silu_f(float x) { return x / (1.f + expf(-x)); }
__device__ __forceinline__ float sigmoid_f(float x) { return 1.f / (1.f + expf(-x)); }
__device__ __forceinline__ float log_sigmoid_f(float x) { return fminf(x, 0.f) - log1pf(expf(-fabsf(x))); }
typedef __bf16 bf16v2_t __attribute__((ext_vector_type(2)));
typedef float f32x2_t __attribute__((ext_vector_type(2)));
__device__ __forceinline__ unsigned cvt_pk_bf16(float lo, float hi) { const bf16v2_t v = __builtin_convertvector((f32x2_t){lo, hi}, bf16v2_t); return __builtin_bit_cast(unsigned, v); }
__device__ __forceinline__ float bf_lo(unsigned u) { return __uint_as_float(u << 16); }
__device__ __forceinline__ float bf_hi(unsigned u) { return __uint_as_float(u & 0xffff0000u); }
#define WT_EVIN(j) ((size_t)(j) * 3200 * 1024)
#define WT_EVOUT(j) ((size_t)2 * 3200 * 1024 + (size_t)(j) * 1024 * 1024)
#define WT_ODIN(j) ((size_t)2 * 3200 * 1024 + (size_t)2 * 1024 * 1024 + (size_t)(j) * 1536 * 1024)
#define WT_ODOUT(j) ((size_t)2 * 3200 * 1024 + (size_t)2 * 1024 * 1024 + (size_t)2 * 1536 * 1024 + (size_t)(j) * 1024 * 1024)
#define WT_PQ(L) ((size_t)2 * 3200 * 1024 + (size_t)4 * 1024 * 1024 + (size_t)2 * 1536 * 1024 + (size_t)(L) * 2048 * 1024)
#define WT_TOTAL ((size_t)2 * 3200 * 1024 + (size_t)4 * 1024 * 1024 + (size_t)2 * 1536 * 1024 + (size_t)4 * 2048 * 1024)
__device__ __forceinline__ float lshfl(float v, int src) { return __int_as_float(__builtin_amdgcn_ds_bpermute(src << 2, __float_as_int(v))); }
#define SHX(v, m) lshfl((v), lane ^ (m))
#define wave_sum(v) wave_sum_l((v), lane)
#define wave_max(v) wave_max_l((v), lane)
__device__ __forceinline__ float wave_sum_l(float v, int lane) {
#pragma unroll
    for (int o = 32; o > 0; o >>= 1) v += lshfl(v, lane ^ o);
    return v;
}
__device__ __forceinline__ float wave_max_l(float v, int lane) {
#pragma unroll
    for (int o = 32; o > 0; o >>= 1) v = fmaxf(v, lshfl(v, lane ^ o));
    return v;
}

__device__ void cvt_copy_bf16(const float* src, bf16_t* dst, size_t n);
__device__ void quant_rows_i8(const float* src, unsigned char* dst, float* scl, int nrows);
__device__ void ph_prologue(const P& p, float* smem) {
    const int tid = otid(), nb = gridDim.x, bid = blockIdx.x;
    if (bid == 0 && tid < 64) p.ctr[tid] = 0;
    {
        const float4* xs = (const float4*)p.x; const float4* cs = (const float4*)p.ctx; float4* hd = (float4*)p.H;
        const size_t nx = (size_t)NL * DM / 4, nc = (size_t)(NT - NL) * DM / 4;
        for (size_t i = (size_t)bid * 256 + tid; i < nx + nc; i += (size_t)nb * 256) hd[i] = i < nx ? xs[i] : cs[i - nx];
    }
    for (int i = bid * 256 + tid; i < 2048 * 32; i += nb * 256) {
        const int s = i >> 5, d = i & 31;
        const float pos = (d < 16) ? (float)(s >> 6) : (float)(s & 63);
        const float inv = powf(10000.0f, -(float)(d & 15) / 16.0f);
        const float ang = pos * inv;
        p.rope[2 * i] = cosf(ang); p.rope[2 * i + 1] = sinf(ang);
    }
    float* sc = smem;
    float* red = smem + 9 * 1024;
    for (int i = tid; i < 9 * 1024; i += 256) { const int r = i >> 10, k = i & 1023; const float v = r < 8 ? p.c[r * 1024 + k] : p.c_ctx[k]; sc[i] = silu_f(v); }
    __syncthreads();
    for (int item = bid; item < 4 * 96; item += nb) {
        const int L = item / 96, n0 = (item % 96) * 64, tx = tid & 63, kq = tid >> 6;
        float acc[9];
#pragma unroll
        for (int r = 0; r < 9; ++r) acc[r] = 0.f;
        const float* w = p.mod_w + (size_t)L * 1024 * 6144 + n0 + tx;
        for (int k = kq * 256; k < kq * 256 + 256; ++k) {
            const float wv = w[(size_t)k * 6144];
#pragma unroll
            for (int r = 0; r < 9; ++r) acc[r] += sc[r * 1024 + k] * wv;
        }
#pragma unroll
        for (int r = 0; r < 9; ++r) red[(kq * 9 + r) * 64 + tx] = acc[r];
        __syncthreads();
        if (kq == 0) {
#pragma unroll
            for (int r = 0; r < 9; ++r) {
                const float s = red[(0 * 9 + r) * 64 + tx] + red[(1 * 9 + r) * 64 + tx] + red[(2 * 9 + r) * 64 + tx] + red[(3 * 9 + r) * 64 + tx];
                p.modv[((size_t)L * 9 + r) * 6144 + n0 + tx] = s + p.mod_b[L * 6144 + n0 + tx];
            }
        }
        __syncthreads();
    }
    {
        float (*tile)[65] = (float (*)[65])smem;
        for (int item = bid; item < 5440; item += nb) {
            int it = item, mat = 0, N = 0, Npad = 0; const float* src = nullptr; bf16_t* dst = nullptr;
            for (mat = 0; mat < 12; ++mat) {
                if (mat < 2) { N = EVW; Npad = 3200; src = p.ev_w_in + (size_t)mat * DM * EVW; dst = p.WT + WT_EVIN(mat); }
                else if (mat < 4) { N = 1024; Npad = 1024; src = p.ev_w_out + (size_t)(mat - 2) * DM * DM; dst = p.WT + WT_EVOUT(mat - 2); }
                else if (mat < 6) { N = ODW; Npad = ODW; src = p.od_w_in + (size_t)(mat - 4) * DM * ODW; dst = p.WT + WT_ODIN(mat - 4); }
                else if (mat < 8) { N = 1024; Npad = 1024; src = p.od_w_out + (size_t)(mat - 6) * DM * DM; dst = p.WT + WT_ODOUT(mat - 6); }
                else { N = 2048; Npad = 2048; src = p.pr_w_q + (size_t)(mat - 8) * DM * 2048; dst = p.WT + WT_PQ(mat - 8); }
                const int nt = 16 * (Npad / 64);
                if (it < nt) break;
                it -= nt;
            }
            const int k0 = (it & 15) * 64, n0 = (it >> 4) * 64;
            __syncthreads();
#pragma unroll
            for (int rep = 0; rep < 4; ++rep) {
                const int i = (tid >> 4) + 16 * rep, c4 = (tid & 15) * 4;
                float4 v = make_float4(0.f, 0.f, 0.f, 0.f);
                int sc = n0 + c4;
                if (mat < 2) sc = sc < 1536 ? sc : (sc < 3072 ? sc + 16 : (sc < 3088 ? sc - 3072 + 1536 : N));
                if (sc < N) v = *(const float4*)(src + (size_t)(k0 + i) * N + sc);
                tile[i][c4] = v.x; tile[i][c4 + 1] = v.y; tile[i][c4 + 2] = v.z; tile[i][c4 + 3] = v.w;
            }
            __syncthreads();
            {
                const int n = tid >> 2, kq = (tid & 3) * 16;
                unsigned w[8];
#pragma unroll
                for (int e = 0; e < 8; ++e) w[e] = cvt_pk_bf16(tile[kq + 2 * e][n], tile[kq + 2 * e + 1][n]);
                uint4* dp = (uint4*)(dst + (size_t)(n0 + n) * DM + k0 + kq);
                dp[0] = make_uint4(w[0], w[1], w[2], w[3]); dp[1] = make_uint4(w[4], w[5], w[6], w[7]);
            }
        }
    }
    quant_rows_i8(p.pr_u, p.U8, p.USC, 4 * 16384);
    quant_rows_i8(p.pr_v, p.V8, p.VSC, 4 * 16384);
    cvt_copy_bf16(p.pr_keys, p.KB, (size_t)4 * 8 * 2 * 128 * 128);
}

__device__ void ph_normmod_q(const P& p, const float* g, const float* modv_layer, int nrows) {
    const int lane = otid() & 63, wid = otid() >> 6;
    for (int r = blockIdx.x * 4 + wid; r < nrows; r += gridDim.x * 4) {
        const float4* s4 = (const float4*)(p.H + (size_t)r * DM + lane * 16);
        float4 v[4]; float ss = 0.f;
#pragma unroll
        for (int i = 0; i < 4; ++i) { v[i] = s4[i]; ss += v[i].x * v[i].x + v[i].y * v[i].y + v[i].z * v[i].z + v[i].w * v[i].w; }
        ss = wave_sum(ss);
        const float rstd = rsqrtf(ss * (1.0f / DM) + 1e-6f);
        const float* mv = modv_layer + (size_t)modrow(r) * 6144 + lane * 16;
        float o[16]; float mx = 0.f;
#pragma unroll
        for (int i = 0; i < 4; ++i) {
            const float4 gg = *(const float4*)(g + lane * 16 + i * 4), sh = *(const float4*)(mv + 3072 + i * 4), scl = *(const float4*)(mv + 4096 + i * 4);
            o[i * 4 + 0] = v[i].x * rstd * gg.x * (1.f + scl.x) + sh.x; o[i * 4 + 1] = v[i].y * rstd * gg.y * (1.f + scl.y) + sh.y;
            o[i * 4 + 2] = v[i].z * rstd * gg.z * (1.f + scl.z) + sh.z; o[i * 4 + 3] = v[i].w * rstd * gg.w * (1.f + scl.w) + sh.w;
            mx = fmaxf(mx, fmaxf(fmaxf(fabsf(o[i * 4]), fabsf(o[i * 4 + 1])), fmaxf(fabsf(o[i * 4 + 2]), fabsf(o[i * 4 + 3]))));
        }
        mx = wave_max(mx);
        const float inv = mx > 0.f ? 127.f / mx : 0.f;
        uint4* xp = (uint4*)(p.XN + (size_t)r * DM + lane * 16);
        xp[0] = make_uint4(cvt_pk_bf16(o[0], o[1]), cvt_pk_bf16(o[2], o[3]), cvt_pk_bf16(o[4], o[5]), cvt_pk_bf16(o[6], o[7]));
        xp[1] = make_uint4(cvt_pk_bf16(o[8], o[9]), cvt_pk_bf16(o[10], o[11]), cvt_pk_bf16(o[12], o[13]), cvt_pk_bf16(o[14], o[15]));
        *(uint4*)(p.XQ + (size_t)r * DM + lane * 16) = make_uint4(pack_i8x4(o[0] * inv, o[1] * inv, o[2] * inv, o[3] * inv), pack_i8x4(o[4] * inv, o[5] * inv, o[6] * inv, o[7] * inv),
                                                                  pack_i8x4(o[8] * inv, o[9] * inv, o[10] * inv, o[11] * inv), pack_i8x4(o[12] * inv, o[13] * inv, o[14] * inv, o[15] * inv));
        if (lane == 0) p.XS[r] = mx * (1.f / 127.f);
    }
}

__device__ void cvt_copy_bf16(const float* src, bf16_t* dst, size_t n) {
    const size_t n8 = n / 8;
    for (size_t i = (size_t)blockIdx.x * 256 + otid(); i < n8; i += (size_t)gridDim.x * 256) {
        const float4 a = ((const float4*)src)[2 * i], b = ((const float4*)src)[2 * i + 1];
        ((uint4*)dst)[i] = make_uint4(cvt_pk_bf16(a.x, a.y), cvt_pk_bf16(a.z, a.w), cvt_pk_bf16(b.x, b.y), cvt_pk_bf16(b.z, b.w));
    }
}

__device__ void quant_rows_i8(const float* src, unsigned char* dst, float* scl, int nrows) {
    const int lane = otid() & 63, wid = otid() >> 6;
    for (int r = blockIdx.x * 4 + wid; r < nrows; r += gridDim.x * 4) {
        const float4* sp = (const float4*)(src + (size_t)r * 1024 + lane * 16);
        float4 v[4]; float mx = 0.f;
#pragma unroll
        for (int i = 0; i < 4; ++i) { v[i] = sp[i]; mx = fmaxf(mx, fmaxf(fmaxf(fabsf(v[i].x), fabsf(v[i].y)), fmaxf(fabsf(v[i].z), fabsf(v[i].w)))); }
#pragma unroll
        for (int o = 32; o > 0; o >>= 1) mx = fmaxf(mx, SHX(mx, o));
        const float inv = mx > 0.f ? 127.f / mx : 0.f;
        unsigned w[4];
#pragma unroll
        for (int i = 0; i < 4; ++i) {
            w[i] = pack_i8x4(v[i].x * inv, v[i].y * inv, v[i].z * inv, v[i].w * inv);
        }
        *(uint4*)(dst + (size_t)r * 1024 + lane * 16) = make_uint4(w[0], w[1], w[2], w[3]);
        if (lane == 0) scl[r] = mx * (1.f / 127.f);
    }
}

__device__ void ph_normmod(const float* src, const float* g, const float* modv_layer, int shift_off, int scale_off, bf16_t* dst, int nrows) {
    const int lane = otid() & 63, wid = otid() >> 6;
    for (int r = blockIdx.x * 4 + wid; r < nrows; r += gridDim.x * 4) {
        const float4* s4 = (const float4*)(src + (size_t)r * DM);
        float4 v[4]; float ss = 0.f;
#pragma unroll
        for (int i = 0; i < 4; ++i) { v[i] = s4[i * 64 + lane]; ss += v[i].x * v[i].x + v[i].y * v[i].y + v[i].z * v[i].z + v[i].w * v[i].w; }
        ss = wave_sum(ss);
        const float rstd = rsqrtf(ss * (1.0f / DM) + 1e-6f);
        const float* mv = modv_layer + (size_t)modrow(r) * 6144;
        uint2* d2 = (uint2*)(dst + (size_t)r * DM);
#pragma unroll
        for (int i = 0; i < 4; ++i) {
            const int c = (i * 64 + lane) * 4;
            const float4 gg = *(const float4*)(g + c), sh = *(const float4*)(mv + shift_off + c), scl = *(const float4*)(mv + scale_off + c);
            float4 o;
            o.x = v[i].x * rstd * gg.x * (1.f + scl.x) + sh.x; o.y = v[i].y * rstd * gg.y * (1.f + scl.y) + sh.y;
            o.z = v[i].z * rstd * gg.z * (1.f + scl.z) + sh.z; o.w = v[i].w * rstd * gg.w * (1.f + scl.w) + sh.w;
            d2[i * 64 + lane] = make_uint2(cvt_pk_bf16(o.x, o.y), cvt_pk_bf16(o.z, o.w));
        }
    }
}

__device__ void ph_final(const P& p) {
    const int lane = otid() & 63, wid = otid() >> 6;
    for (int r = blockIdx.x * 4 + wid; r < NL; r += gridDim.x * 4) {
        const float4* s4 = (const float4*)(p.H + (size_t)r * DM);
        float4 v[4]; float ss = 0.f;
#pragma unroll
        for (int i = 0; i < 4; ++i) { v[i] = s4[i * 64 + lane]; ss += v[i].x * v[i].x + v[i].y * v[i].y + v[i].z * v[i].z + v[i].w * v[i].w; }
        ss = wave_sum(ss);
        const float rstd = rsqrtf(ss * (1.0f / DM) + 1e-6f);
        float4* d4 = (float4*)(p.out + (size_t)r * DM);
#pragma unroll
        for (int i = 0; i < 4; ++i) {
            const int c = (i * 64 + lane) * 4; const float4 gg = *(const float4*)(p.final_g + c);
            float4 o; o.x = v[i].x * rstd * gg.x; o.y = v[i].y * rstd * gg.y; o.z = v[i].z * rstd * gg.z; o.w = v[i].w * rstd * gg.w;
            d4[i * 64 + lane] = o;
        }
    }
}

#define GL_ROWB 144
#define GL_TILEB (128 * GL_ROWB)
struct TokPos { int b, pos, kpos; bool lat; };
__device__ __forceinline__ TokPos tokpos(int row) {
    TokPos t; t.lat = row < NL;
    if (t.lat) { t.b = row >> 11; t.pos = row & 2047; t.kpos = 256 + t.pos; } else { const int r = row - NL; t.b = r >> 8; t.pos = r & 255; t.kpos = t.pos; }
    return t;
}
struct EpiStoreBF16 {
    bf16_t* C; int ldc;
    __device__ __forceinline__ bool swapped(int) const { return false; }
    __device__ __forceinline__ void operator()(const f32x4 (&acc)[4][4], int m0, int n0, int wm, int wn, int fr, int fq) const {
#pragma unroll
        for (int mi = 0; mi < 4; ++mi)
#pragma unroll
            for (int ni = 0; ni < 4; ++ni) {
                const f32x4 v = acc[ni][mi];
                *(uint2*)(C + (size_t)(m0 + wm * 64 + mi * 16 + fr) * ldc + n0 + wn * 64 + ni * 16 + fq * 4) = make_uint2(cvt_pk_bf16(v[0], v[1]), cvt_pk_bf16(v[2], v[3]));
            }
    }
};
struct EpiResid {
    float* H; const float* gate; float scale;
    __device__ __forceinline__ bool swapped(int) const { return false; }
    __device__ __forceinline__ void operator()(const f32x4 (&acc)[4][4], int m0, int n0, int wm, int wn, int fr, int fq) const {
#pragma unroll
        for (int mi = 0; mi < 4; ++mi) {
            const int row = m0 + wm * 64 + mi * 16 + fr;
            const float* gp = gate + (size_t)modrow(row) * 6144;
#pragma unroll
            for (int ni = 0; ni < 4; ++ni) {
                const int col = n0 + wn * 64 + ni * 16 + fq * 4;
                const f32x4 g = *(const f32x4*)(gp + col);
                f32x4* hp = (f32x4*)(H + (size_t)row * DM + col);
                *hp = *hp + g * acc[ni][mi] * scale;
            }
        }
    }
};
__device__ __forceinline__ void rope_store64(const f32x4 (&acc)[4][4], int mi, bool do_rope, const float* ropep  , float scale, bf16_t* dst  , int fq) {
#pragma unroll
    for (int ni = 0; ni < 2; ++ni) {
        f32x4 x1 = acc[ni][mi], x2 = acc[ni + 2][mi];
        if (do_rope) {
            const f32x4 r0 = *(const f32x4*)(ropep + (ni * 16 + fq * 4) * 2), r1 = *(const f32x4*)(ropep + (ni * 16 + fq * 4) * 2 + 4);
            const f32x4 cs = (f32x4){r0[0], r0[2], r1[0], r1[2]}, sn = (f32x4){r0[1], r0[3], r1[1], r1[3]};
            const f32x4 y1 = x1 * cs - x2 * sn, y2 = x1 * sn + x2 * cs;
            x1 = y1; x2 = y2;
        }
        x1 = x1 * scale; x2 = x2 * scale;
        *(uint2*)(dst + ni * 16 + fq * 4) = make_uint2(cvt_pk_bf16(x1[0], x1[1]), cvt_pk_bf16(x1[2], x1[3]));
        *(uint2*)(dst + 32 + ni * 16 + fq * 4) = make_uint2(cvt_pk_bf16(x2[0], x2[1]), cvt_pk_bf16(x2[2], x2[3]));
    }
}
struct EpiEven {
    bf16_t *PB, *AQL, *AQC, *AK, *AV; float* GT; const float* rope;
    __device__ __forceinline__ bool swapped(int n0) const { return n0 >= 2560 && n0 < 3072; }
    __device__ __forceinline__ void operator()(const f32x4 (&acc)[4][4], int m0, int n0, int wm, int wn, int fr, int fq) const {
        const int t = n0 >> 7;
        if (t < 12) {
#pragma unroll
            for (int mi = 0; mi < 4; ++mi)
#pragma unroll
                for (int ni = 0; ni < 4; ++ni) {
                    const f32x4 v = acc[ni][mi];
                    *(uint2*)(PB + (size_t)(m0 + wm * 64 + mi * 16 + fr) * 1536 + n0 + wn * 64 + ni * 16 + fq * 4) = make_uint2(cvt_pk_bf16(v[0], v[1]), cvt_pk_bf16(v[2], v[3]));
                }
        } else if (t < 20) {
            const bool isq = t < 16; const int h = t & 3;
#pragma unroll
            for (int mi = 0; mi < 4; ++mi) {
                const TokPos tp = tokpos(m0 + wm * 64 + mi * 16 + fr);
                const int hm = (tp.b * 4 + h) * 2 + wn;
                bf16_t* dst;
                if (isq) dst = tp.lat ? AQL + ((size_t)hm * 2048 + tp.pos) * 64 : AQC + ((size_t)hm * 256 + tp.pos) * 64;
                else dst = AK + ((size_t)hm * 2304 + tp.kpos) * 64;
                rope_store64(acc, mi, tp.lat, rope + (size_t)tp.pos * 64, isq ? QSCALE : 1.0f, dst, fq);
            }
        } else if (t < 24) {
            const int h = t - 20;
#pragma unroll
            for (int mi = 0; mi < 4; ++mi) {
                const TokPos tp = tokpos(m0 + wm * 64 + mi * 16 + fq * 4);
#pragma unroll
                for (int ni = 0; ni < 4; ++ni) {
                    const f32x4 v = acc[ni][mi];
                    const int d = wn * 64 + ni * 16 + fr;
                    *(uint2*)(AV + ((size_t)(tp.b * 4 + h) * 128 + d) * 2304 + tp.kpos) = make_uint2(cvt_pk_bf16(v[0], v[1]), cvt_pk_bf16(v[2], v[3]));
                }
            }
        } else {
            if (wn == 0) {
#pragma unroll
                for (int mi = 0; mi < 4; ++mi) *(f32x4*)(GT + (size_t)(m0 + wm * 64 + mi * 16 + fr) * 16 + fq * 4) = acc[0][mi];
            }
        }
    }
};
struct EpiOdd {
    bf16_t *AQL, *AQC, *AK, *AV; const float* rope;
    __device__ __forceinline__ bool swapped(int n0) const { return n0 >= 1280; }
    __device__ __forceinline__ void operator()(const f32x4 (&acc)[4][4], int m0, int n0, int wm, int wn, int fr, int fq) const {
        const int t = n0 >> 7;
        if (t < 10) {
            const bool isq = t < 8; const int hd = isq ? t * 2 + wn : (t - 8) * 2 + wn;
#pragma unroll
            for (int mi = 0; mi < 4; ++mi) {
                const TokPos tp = tokpos(m0 + wm * 64 + mi * 16 + fr);
                bf16_t* dst;
                if (isq) dst = tp.lat ? AQL + ((size_t)(tp.b * 16 + hd) * 2048 + tp.pos) * 64 : AQC + ((size_t)(tp.b * 16 + hd) * 256 + tp.pos) * 64;
                else dst = AK + ((size_t)(tp.b * 4 + hd) * 2304 + tp.kpos) * 64;
                rope_store64(acc, mi, tp.lat, rope + (size_t)tp.pos * 64, isq ? QSCALE : 1.0f, dst, fq);
            }
        } else {
            const int hkv = (t - 10) * 2 + wn;
#pragma unroll
            for (int mi = 0; mi < 4; ++mi) {
                const TokPos tp = tokpos(m0 + wm * 64 + mi * 16 + fq * 4);
#pragma unroll
                for (int ni = 0; ni < 4; ++ni) {
                    const f32x4 v = acc[ni][mi];
                    const int d = ni * 16 + fr;
                    *(uint2*)(AV + ((size_t)(tp.b * 4 + hkv) * 64 + d) * 2304 + tp.kpos) = make_uint2(cvt_pk_bf16(v[0], v[1]), cvt_pk_bf16(v[2], v[3]));
                }
            }
        }
    }
};
template <bool SWAP>
__device__ __forceinline__ void gemm_tile_kloop(f32x4 (&acc)[4][4], const bf16_t* aub, const bf16_t* bub, char* smem, int lrow, int lch, int wm, int wn, int fr, int fq) {
    const unsigned voff = (unsigned)(lrow * DM + lch * 8) * 2u;
    uint4 ra0, ra1, ra2, ra3, rb0, rb1, rb2, rb3;
#define GL_LD(BASE, ROWS, KO) (*(const uint4*)((const char*)(BASE) + ((size_t)(ROWS) * DM + (KO)) * 2 + voff))
#define GL_LOAD(KO) { ra0 = GL_LD(aub, 0, KO); ra1 = GL_LD(aub, 32, KO); ra2 = GL_LD(aub, 64, KO); ra3 = GL_LD(aub, 96, KO); rb0 = GL_LD(bub, 0, KO); rb1 = GL_LD(bub, 32, KO); rb2 = GL_LD(bub, 64, KO); rb3 = GL_LD(bub, 96, KO); }
#define GL_STORE(BUF) { char* sa_ = (BUF) + lrow * GL_ROWB + lch * 16; char* sb_ = sa_ + GL_TILEB; \
                        *(uint4*)(sa_) = ra0; *(uint4*)(sa_ + 32 * GL_ROWB) = ra1; *(uint4*)(sa_ + 64 * GL_ROWB) = ra2; *(uint4*)(sa_ + 96 * GL_ROWB) = ra3; \
                        *(uint4*)(sb_) = rb0; *(uint4*)(sb_ + 32 * GL_ROWB) = rb1; *(uint4*)(sb_ + 64 * GL_ROWB) = rb2; *(uint4*)(sb_ + 96 * GL_ROWB) = rb3; }
    GL_LOAD(0)
    __syncthreads();
    GL_STORE(smem)
    __syncthreads();
    for (int kt = 0; kt < 16; ++kt) {
        char* cur = smem + (kt & 1) * 2 * GL_TILEB;
        char* nxt = smem + ((kt + 1) & 1) * 2 * GL_TILEB;
        if (kt + 1 < 16) GL_LOAD((kt + 1) * 64)
#pragma unroll
        for (int ks = 0; ks < 2; ++ks) {
            bf16x8 af[4], wf[4];
#pragma unroll
            for (int i = 0; i < 4; ++i) {
                af[i] = *(const bf16x8*)(cur + (wm * 64 + i * 16 + fr) * GL_ROWB + (ks * 4 + fq) * 16);
                wf[i] = *(const bf16x8*)(cur + GL_TILEB + (wn * 64 + i * 16 + fr) * GL_ROWB + (ks * 4 + fq) * 16);
            }
#pragma unroll
            for (int ni = 0; ni < 4; ++ni)
#pragma unroll
                for (int mi = 0; mi < 4; ++mi)
                    acc[ni][mi] = SWAP ? __builtin_amdgcn_mfma_f32_16x16x32_bf16(af[mi], wf[ni], acc[ni][mi], 0, 0, 0)
                                       : __builtin_amdgcn_mfma_f32_16x16x32_bf16(wf[ni], af[mi], acc[ni][mi], 0, 0, 0);
        }
        if (kt + 1 < 16) GL_STORE(nxt)
        __syncthreads();
    }
#undef GL_LD
#undef GL_LOAD
#undef GL_STORE
}
template <class Epi>
__device__ void ph_gemm(const bf16_t* A, const bf16_t* Bt, int M, int Npad, const Epi& epi, char* smem) {
    const int tid = otid(), lane = tid & 63, wid = tid >> 6, wm = wid >> 1, wn = wid & 1;
    const int fr = lane & 15, fq = lane >> 4;
    const int tm = M / 128, tn = Npad / 128, ntiles = tm * tn;
    const int lrow = tid >> 3, lch = tid & 7;
    for (int tile = blockIdx.x; tile < ntiles; tile += gridDim.x) {
        const int m0 = (tile % tm) * 128, n0 = (tile / tm) * 128;
        f32x4 acc[4][4];
#pragma unroll
        for (int a = 0; a < 4; ++a)
#pragma unroll
            for (int b = 0; b < 4; ++b) acc[a][b] = (f32x4){0.f, 0.f, 0.f, 0.f};
        const bf16_t* ap = A + (size_t)m0 * DM;
        const bf16_t* bp = Bt + (size_t)n0 * DM;
        if (epi.swapped(n0)) gemm_tile_kloop<true>(acc, ap, bp, smem, lrow, lch, wm, wn, fr, fq);
        else gemm_tile_kloop<false>(acc, ap, bp, smem, lrow, lch, wm, wn, fr, fq);
        int fr2 = fr, fq2 = fq, wm2 = wm, wn2 = wn;
        asm volatile("" : "+v"(fr2), "+v"(fq2), "+v"(wm2), "+v"(wn2));
        epi(acc, m0, n0, wm2, wn2, fr2, fq2);
    }
}

__device__ void ph_prep_even(const P& p, int j) {
    const float* cw = p.ev_conv_w + (size_t)j * 3 * 512; const float* cb = p.ev_conv_b + (size_t)j * 512;
    const size_t tot = (size_t)NT * 256;
    for (size_t i = (size_t)blockIdx.x * 256 + otid(); i < tot; i += (size_t)gridDim.x * 256) {
        const int r = (int)(i >> 8), c = (int)(i & 255) * 2;
        int t, T; if (r < NL) { t = r & 2047; T = 2048; } else { t = (r - NL) & 255; T = 256; }
        const unsigned x1 = *(const unsigned*)(p.PB + (size_t)r * 1536 + c);
        float v0 = cb[c] + bf_lo(x1) * cw[512 + c], v1 = cb[c + 1] + bf_hi(x1) * cw[512 + c + 1];
        if (t > 0) { const unsigned x0 = *(const unsigned*)(p.PB + (size_t)(r - 1) * 1536 + c); v0 += bf_lo(x0) * cw[c]; v1 += bf_hi(x0) * cw[c + 1]; }
        if (t < T - 1) { const unsigned x2 = *(const unsigned*)(p.PB + (size_t)(r + 1) * 1536 + c); v0 += bf_lo(x2) * cw[1024 + c]; v1 += bf_hi(x2) * cw[1024 + c + 1]; }
        v0 = silu_f(v0); v1 = silu_f(v1);
        if (c >= 256) { v0 *= 0.125f; v1 *= 0.125f; }
        *(unsigned*)(p.QKB + (size_t)r * 512 + c) = cvt_pk_bf16(v0, v1);
    }
}

#define FA_KROW 144
#define FA_VROW 136
__device__ __forceinline__ bf16x8 pack8(float a0, float a1, float a2, float a3, float a4, float a5, float a6, float a7) {
    const u32x4 u = (u32x4){cvt_pk_bf16(a0, a1), cvt_pk_bf16(a2, a3), cvt_pk_bf16(a4, a5), cvt_pk_bf16(a6, a7)};
    return __builtin_bit_cast(bf16x8, u);
}
template <int NDB, bool MASK>
__device__ __forceinline__ void flash_tile(const bf16x8 (&qf)[4], f32x16 (&o)[NDB], float& m, float& l, const char* Kl, const char* Vl, int lane, int qpos, int kp0) {
    const int j = lane & 31, h = lane >> 5;
    f32x16 s0, s1;
#pragma unroll
    for (int i = 0; i < 16; ++i) { s0[i] = 0.f; s1[i] = 0.f; }
#pragma unroll
    for (int ks = 0; ks < 4; ++ks) {
        const bf16x8 a0 = *(const bf16x8*)(Kl + j * FA_KROW + (2 * ks + h) * 16);
        const bf16x8 a1 = *(const bf16x8*)(Kl + (32 + j) * FA_KROW + (2 * ks + h) * 16);
        s0 = __builtin_amdgcn_mfma_f32_32x32x16_bf16(a0, qf[ks], s0, 0, 0, 0);
        s1 = __builtin_amdgcn_mfma_f32_32x32x16_bf16(a1, qf[ks], s1, 0, 0, 0);
    }
    if (MASK) {
#pragma unroll
        for (int r = 0; r < 16; ++r) {
            const int key = (r & 3) + 8 * (r >> 2) + 4 * h;
            const int d0 = qpos - (kp0 + key), d1 = d0 - 32;
            if (d0 > 128 || d0 < -128) s0[r] = -1e30f;
            if (d1 > 128 || d1 < -128) s1[r] = -1e30f;
        }
    }
    float mx = fmaxf(s0[0], s1[0]);
#pragma unroll
    for (int r = 1; r < 16; ++r) mx = fmaxf(mx, fmaxf(s0[r], s1[r]));
    mx = fmaxf(mx, SHX(mx, 32));
    const float mn = fmaxf(m, mx);
    const float alpha = __builtin_amdgcn_exp2f(m - mn);
    m = mn;
    float ls = 0.f;
#pragma unroll
    for (int r = 0; r < 16; ++r) { s0[r] = __builtin_amdgcn_exp2f(s0[r] - mn); s1[r] = __builtin_amdgcn_exp2f(s1[r] - mn); ls += s0[r] + s1[r]; }
    l = l * alpha + ls;
#pragma unroll
    for (int db = 0; db < NDB; ++db) o[db] = o[db] * alpha;
    bf16x8 pb[4];
    pb[0] = pack8(s0[0], s0[1], s0[2], s0[3], s0[4], s0[5], s0[6], s0[7]);
    pb[1] = pack8(s0[8], s0[9], s0[10], s0[11], s0[12], s0[13], s0[14], s0[15]);
    pb[2] = pack8(s1[0], s1[1], s1[2], s1[3], s1[4], s1[5], s1[6], s1[7]);
    pb[3] = pack8(s1[8], s1[9], s1[10], s1[11], s1[12], s1[13], s1[14], s1[15]);
#pragma unroll
    for (int db = 0; db < NDB; ++db)
#pragma unroll
        for (int kk = 0; kk < 4; ++kk) {
            const char* vp = Vl + (db * 32 + j) * FA_VROW + (kk * 16 + 4 * h) * 2;
            const uint2 lo = *(const uint2*)vp, hi = *(const uint2*)(vp + 16);
            const u32x4 u = (u32x4){lo.x, lo.y, hi.x, hi.y};
            o[db] = __builtin_amdgcn_mfma_f32_32x32x16_bf16(__builtin_bit_cast(bf16x8, u), pb[kk], o[db], 0, 0, 0);
        }
}

#define DA_BUFB 35840
__device__ void da_block(const P& p, int item, int L, int j, char* smem) {
    const int tid = otid(), lane = tid & 63, wid = tid >> 6, mp = wid & 1, qg = wid >> 1, jq = lane & 31, hh = lane >> 5;
    const bool lat = item < 1024;
    int b, h, qt;
    if (lat) { b = item >> 7; h = (item >> 5) & 3; qt = item & 31; } else { const int it = item - 1024; b = it >> 4; h = (it >> 2) & 3; qt = it & 3; }
    const int qi = qt * 64 + qg * 32 + jq;
    const bf16_t* qp = lat ? p.AQL + ((size_t)((b * 4 + h) * 2 + mp) * 2048 + qi) * 64 : p.AQC + ((size_t)((b * 4 + h) * 2 + mp) * 256 + qi) * 64;
    bf16x8 qf[4];
#pragma unroll
    for (int ks = 0; ks < 4; ++ks) qf[ks] = *(const bf16x8*)(qp + (2 * ks + hh) * 8);
    const int ntile = lat ? 36 : 4;
    const bf16_t* kg = p.AK + (size_t)((b * 4 + h) * 2) * 2304 * 64 + (size_t)(tid >> 3) * 64 + (tid & 7) * 8;
    const bf16_t* vg = p.AV + (size_t)(b * 4 + h) * 128 * 2304 + (size_t)(tid >> 3) * 2304 + (tid & 7) * 8;
    uint4 k0, k1, k2, k3, v0, v1, v2, v3;
#define DA_LOAD(KEY0) { k0 = *(const uint4*)(kg + (size_t)(KEY0) * 64); k1 = *(const uint4*)(kg + (size_t)((KEY0) + 32) * 64); \
                        k2 = *(const uint4*)(kg + (size_t)2304 * 64 + (size_t)(KEY0) * 64); k3 = *(const uint4*)(kg + (size_t)2304 * 64 + (size_t)((KEY0) + 32) * 64); \
                        v0 = *(const uint4*)(vg + (KEY0)); v1 = *(const uint4*)(vg + (size_t)32 * 2304 + (KEY0)); v2 = *(const uint4*)(vg + (size_t)64 * 2304 + (KEY0)); v3 = *(const uint4*)(vg + (size_t)96 * 2304 + (KEY0)); }
#define DA_STORE(BUF) { char* kb_ = (BUF) + (tid >> 3) * FA_KROW + (tid & 7) * 16; \
                        *(uint4*)kb_ = k0; *(uint4*)(kb_ + 32 * FA_KROW) = k1; *(uint4*)(kb_ + 64 * FA_KROW) = k2; *(uint4*)(kb_ + 96 * FA_KROW) = k3; \
                        char* vb_ = (BUF) + 18432 + (tid >> 3) * FA_VROW + (tid & 7) * 16; \
                        *(uint2*)vb_ = make_uint2(v0.x, v0.y); *(uint2*)(vb_ + 8) = make_uint2(v0.z, v0.w); \
                        *(uint2*)(vb_ + 32 * FA_VROW) = make_uint2(v1.x, v1.y); *(uint2*)(vb_ + 32 * FA_VROW + 8) = make_uint2(v1.z, v1.w); \
                        *(uint2*)(vb_ + 64 * FA_VROW) = make_uint2(v2.x, v2.y); *(uint2*)(vb_ + 64 * FA_VROW + 8) = make_uint2(v2.z, v2.w); \
                        *(uint2*)(vb_ + 96 * FA_VROW) = make_uint2(v3.x, v3.y); *(uint2*)(vb_ + 96 * FA_VROW + 8) = make_uint2(v3.z, v3.w); }
    f32x16 o[4];
#pragma unroll
    for (int db = 0; db < 4; ++db)
#pragma unroll
        for (int i = 0; i < 16; ++i) o[db][i] = 0.f;
    float m = -1e30f, l = 0.f;
    DA_LOAD(0)
    __syncthreads();
    DA_STORE(smem)
    __syncthreads();
    for (int t = 0; t < ntile; ++t) {
        char* cur = smem + (t & 1) * DA_BUFB;
        char* nxt = smem + ((t + 1) & 1) * DA_BUFB;
        if (t + 1 < ntile) DA_LOAD((t + 1) * 64)
        flash_tile<4, false>(qf, o, m, l, cur + mp * 9216, cur + 18432, lane, 0, 0);
        if (t + 1 < ntile) DA_STORE(nxt)
        __syncthreads();
    }
#undef DA_LOAD
#undef DA_STORE
    const float inv = 1.f / (l + SHX(l, 32));
#pragma unroll
    for (int db = 0; db < 4; ++db) o[db] = o[db] * inv;
    float* X = (float*)smem + qg * 4096;
    if (mp == 1) {
#pragma unroll
        for (int db = 0; db < 4; ++db)
#pragma unroll
            for (int r = 0; r < 16; ++r) X[(db * 32 + (r & 3) + 8 * (r >> 2) + 4 * hh) * 32 + jq] = o[db][r];
    }
    __syncthreads();
    if (mp == 0) {
        const float lam_init = 0.8f - 0.6f * expf(-0.3f * (float)L);
        const float* lp = p.ev_da_lam + (size_t)j * 256;
        float a0 = lp[lane] * lp[64 + lane], a1 = lp[128 + lane] * lp[192 + lane];
        a0 = wave_sum(a0); a1 = wave_sum(a1);
        const float lam = expf(a0) - expf(a1) + lam_init;
        float ss = 0.f;
#pragma unroll
        for (int db = 0; db < 4; ++db)
#pragma unroll
            for (int r = 0; r < 16; ++r) { const float v = o[db][r] - lam * X[(db * 32 + (r & 3) + 8 * (r >> 2) + 4 * hh) * 32 + jq]; o[db][r] = v; ss += v * v; }
        ss += SHX(ss, 32);
        const float sc = rsqrtf(ss * (1.f / 128.f) + 1e-6f) * (1.f - lam_init);
        const int row = lat ? b * 2048 + qi : NL + b * 256 + qi;
        bf16_t* mrow = p.MIX + (size_t)row * DM + 512 + h * 128;
        const float* g = p.ev_da_g + (size_t)j * 512 + h * 128;
#pragma unroll
        for (int db = 0; db < 4; ++db)
#pragma unroll
            for (int r4 = 0; r4 < 4; ++r4) {
                const int d = db * 32 + 8 * r4 + 4 * hh;
                const f32x4 gg = *(const f32x4*)(g + d);
                *(uint2*)(mrow + d) = make_uint2(cvt_pk_bf16(o[db][r4 * 4 + 0] * sc * gg[0], o[db][r4 * 4 + 1] * sc * gg[1]), cvt_pk_bf16(o[db][r4 * 4 + 2] * sc * gg[2], o[db][r4 * 4 + 3] * sc * gg[3]));
            }
    }
    __syncthreads();
}

#define WA_BUFB 17920
__device__ void wa_block(const P& p, int item, int j, char* smem) {
    const int tid = otid(), lane = tid & 63, wid = tid >> 6, jq = lane & 31, hh = lane >> 5;
    const bool lat = item < 2048;
    int b, nb, hq;
    if (lat) { hq = item & 15; nb = (item >> 4) & 15; b = item >> 8; } else { const int it = item - 2048; hq = it & 15; nb = (it >> 4) & 1; b = it >> 5; }
    const int hkv = hq >> 2;
    const int qi = nb * 128 + wid * 32 + jq;
    const bf16_t* qp = lat ? p.AQL + ((size_t)(b * 16 + hq) * 2048 + qi) * 64 : p.AQC + ((size_t)(b * 16 + hq) * 256 + qi) * 64;
    bf16x8 qf[4];
#pragma unroll
    for (int ks = 0; ks < 4; ++ks) qf[ks] = *(const bf16x8*)(qp + (2 * ks + hh) * 8);
    const int lfirst = (nb == 0) ? 2 : 0, nloc = lat ? 6 - lfirst - ((nb == 15) ? 2 : 0) : 0;
    const int ntile = 4 + nloc;
    const bf16_t* kg = p.AK + (size_t)(b * 4 + hkv) * 2304 * 64 + (size_t)(tid >> 3) * 64 + (tid & 7) * 8;
    const bf16_t* vg = p.AV + (size_t)(b * 4 + hkv) * 64 * 2304 + (size_t)(tid >> 3) * 2304 + (tid & 7) * 8;
    uint4 k0, k1, v0, v1;
#define WA_KEY0(T) ((T) < 4 ? (T) * 64 : 256 + (nb - 1) * 128 + ((T) - 4 + lfirst) * 64)
#define WA_LOAD(KEY0) { k0 = *(const uint4*)(kg + (size_t)(KEY0) * 64); k1 = *(const uint4*)(kg + (size_t)((KEY0) + 32) * 64); v0 = *(const uint4*)(vg + (KEY0)); v1 = *(const uint4*)(vg + (size_t)32 * 2304 + (KEY0)); }
#define WA_STORE(BUF) { char* kb_ = (BUF) + (tid >> 3) * FA_KROW + (tid & 7) * 16; *(uint4*)kb_ = k0; *(uint4*)(kb_ + 32 * FA_KROW) = k1; \
                        char* vb_ = (BUF) + 9216 + (tid >> 3) * FA_VROW + (tid & 7) * 16; \
                        *(uint2*)vb_ = make_uint2(v0.x, v0.y); *(uint2*)(vb_ + 8) = make_uint2(v0.z, v0.w); \
                        *(uint2*)(vb_ + 32 * FA_VROW) = make_uint2(v1.x, v1.y); *(uint2*)(vb_ + 32 * FA_VROW + 8) = make_uint2(v1.z, v1.w); }
    f32x16 o[2];
#pragma unroll
    for (int db = 0; db < 2; ++db)
#pragma unroll
        for (int i = 0; i < 16; ++i) o[db][i] = 0.f;
    float m = p.od_sink[j * 16 + hq] * 1.4426950408889634f, l = hh == 0 ? 1.f : 0.f;
    { const int key0 = WA_KEY0(0); WA_LOAD(key0) }
    __syncthreads();
    WA_STORE(smem)
    __syncthreads();
    for (int t = 0; t < ntile; ++t) {
        char* cur = smem + (t & 1) * WA_BUFB;
        char* nxt = smem + ((t + 1) & 1) * WA_BUFB;
        if (t + 1 < ntile) { const int key0 = WA_KEY0(t + 1); WA_LOAD(key0) }
        if (t < 4) flash_tile<2, false>(qf, o, m, l, cur, cur + 9216, lane, 0, 0);
        else flash_tile<2, true>(qf, o, m, l, cur, cur + 9216, lane, qi, WA_KEY0(t) - 256);
        if (t + 1 < ntile) WA_STORE(nxt)
        __syncthreads();
    }
#undef WA_LOAD
#undef WA_STORE
#undef WA_KEY0
    const float inv = 1.f / (l + SHX(l, 32));
    const int row = lat ? b * 2048 + qi : NL + b * 256 + qi;
    bf16_t* mrow = p.MIX + (size_t)row * DM + hq * 64;
#pragma unroll
    for (int db = 0; db < 2; ++db)
#pragma unroll
        for (int r4 = 0; r4 < 4; ++r4) {
            const int d = db * 32 + 8 * r4 + 4 * hh;
            *(uint2*)(mrow + d) = make_uint2(cvt_pk_bf16(o[db][r4 * 4 + 0] * inv, o[db][r4 * 4 + 1] * inv), cvt_pk_bf16(o[db][r4 * 4 + 2] * inv, o[db][r4 * 4 + 3] * inv));
        }
}

__device__ __forceinline__ int ml_row(int b, int tc, int i) { return tc < 4 ? NL + b * 256 + tc * 64 + i : b * 2048 + (tc - 4) * 64 + i; }
__device__ __forceinline__ void ml_gates(const P& p, int j, int b, int h, int dir, int tc, int lane, float* sa, float* sb, float* sml, float& Bt, float& Mc) {
    const int row = ml_row(b, tc, lane);
    const float ig = p.GT[(size_t)row * 16 + (dir * 2) * 4 + h] + p.ev_gate_b[j * 16 + (dir * 2) * 4 + h];
    const float lf = log_sigmoid_f(p.GT[(size_t)row * 16 + (dir * 2 + 1) * 4 + h] + p.ev_gate_b[j * 16 + (dir * 2 + 1) * 4 + h]);
    float bc = lf;
    if (dir == 0) {
#pragma unroll
        for (int o = 1; o < 64; o <<= 1) { const float t2 = lshfl(bc, lane - o); if (lane >= o) bc += t2; }
    } else {
#pragma unroll
        for (int o = 1; o < 64; o <<= 1) { const float t2 = lshfl(bc, lane + o); if (lane + o < 64) bc += t2; }
    }
    const float a = ig - bc;
    float ml = a;
    if (dir == 0) {
#pragma unroll
        for (int o = 1; o < 64; o <<= 1) { const float t2 = lshfl(ml, lane - o); if (lane >= o) ml = fmaxf(ml, t2); }
    } else {
#pragma unroll
        for (int o = 1; o < 64; o <<= 1) { const float t2 = lshfl(ml, lane + o); if (lane + o < 64) ml = fmaxf(ml, t2); }
    }
    sa[lane] = a; sb[lane] = bc; sml[lane] = ml;
    const int last = dir == 0 ? 63 : 0;
    Bt = lshfl(bc, last); Mc = lshfl(ml, last);
}
__device__ __forceinline__ int ml_tc_of(int dir, int c) { return dir == 0 ? c : (c < 4 ? 3 - c : 39 - c); }
__device__ __forceinline__ int ml_c_of(int dir, int tc) { return dir == 0 ? tc : (tc < 4 ? 3 - tc : 39 - tc); }

__device__ void ml_pass1_item(const P& p, int item, int j, char* smem) {
    const int c = item % 36, dir = (item / 36) & 1, h = (item / 72) & 3, b = item / 288;
    const int tc = ml_tc_of(dir, c);
    const int tid = otid(), lane = tid & 63, wid = tid >> 6, jl = lane & 31, hh = lane >> 5;
    bf16_t* VT = (bf16_t*)smem;
    bf16_t* KWT = (bf16_t*)(smem + 18432);
    float* sa = (float*)(smem + 27648);
    float* sb = sa + 64; float* sml = sb + 64; float* sw = sml + 64; float* ssc = sw + 64;
    __syncthreads();
    if (wid == 0) {
        float Bt, Mc; ml_gates(p, j, b, h, dir, tc, lane, sa, sb, sml, Bt, Mc);
        sw[lane] = expf(sa[lane] - Mc);
        if (lane == 0) { p.CHB[item] = Bt; p.CHM[item] = Mc; }
    }
    __syncthreads();
#pragma unroll
    for (int i = 0; i < 4; ++i) {
        const int e = tid + 256 * i, st = e >> 4, ch = e & 15;
        const uint4 u = *(const uint4*)(p.PB + (size_t)ml_row(b, tc, st) * 1536 + 512 + h * 128 + ch * 8);
        bf16_t* d = VT + (ch * 8) * 72 + st;
        d[0] = (bf16_t)u.x; d[72] = (bf16_t)(u.x >> 16); d[144] = (bf16_t)u.y; d[216] = (bf16_t)(u.y >> 16);
        d[288] = (bf16_t)u.z; d[360] = (bf16_t)(u.z >> 16); d[432] = (bf16_t)u.w; d[504] = (bf16_t)(u.w >> 16);
    }
#pragma unroll
    for (int i = 0; i < 2; ++i) {
        const int e = tid + 256 * i, st = e >> 3, ch = e & 7;
        const uint4 u = *(const uint4*)(p.QKB + (size_t)ml_row(b, tc, st) * 512 + 256 + h * 64 + ch * 8);
        const float w = sw[st];
        bf16_t* d = KWT + (ch * 8) * 72 + st;
        const unsigned q0 = cvt_pk_bf16(bf_lo(u.x) * w, bf_hi(u.x) * w), q1 = cvt_pk_bf16(bf_lo(u.y) * w, bf_hi(u.y) * w), q2 = cvt_pk_bf16(bf_lo(u.z) * w, bf_hi(u.z) * w), q3 = cvt_pk_bf16(bf_lo(u.w) * w, bf_hi(u.w) * w);
        d[0] = (bf16_t)q0; d[72] = (bf16_t)(q0 >> 16); d[144] = (bf16_t)q1; d[216] = (bf16_t)(q1 >> 16);
        d[288] = (bf16_t)q2; d[360] = (bf16_t)(q2 >> 16); d[432] = (bf16_t)q3; d[504] = (bf16_t)(q3 >> 16);
    }
    __syncthreads();
    {
        const int db = wid & 1, vb0 = (wid >> 1) * 2;
        bf16x8 kf[4];
#pragma unroll
        for (int ks = 0; ks < 4; ++ks) kf[ks] = *(const bf16x8*)((const char*)KWT + (db * 32 + jl) * 144 + (2 * ks + hh) * 16);
        float* cl = p.CLOC + (size_t)item * 8192;
#pragma unroll
        for (int vv = 0; vv < 2; ++vv) {
            const int vb = vb0 + vv;
            f32x16 acc;
#pragma unroll
            for (int r = 0; r < 16; ++r) acc[r] = 0.f;
#pragma unroll
            for (int ks = 0; ks < 4; ++ks) {
                const bf16x8 vf = *(const bf16x8*)((const char*)VT + (vb * 32 + jl) * 144 + (2 * ks + hh) * 16);
                acc = __builtin_amdgcn_mfma_f32_32x32x16_bf16(vf, kf[ks], acc, 0, 0, 0);
            }
#pragma unroll
            for (int r = 0; r < 16; ++r) cl[(size_t)(vb * 32 + (r & 3) + 8 * (r >> 2) + 4 * hh) * 64 + db * 32 + jl] = acc[r];
        }
        if (tid < 64) {
            float sum = 0.f;
#pragma unroll
            for (int q = 0; q < 8; ++q) { const uint4 u = *(const uint4*)((const char*)KWT + tid * 144 + q * 16); sum += bf_lo(u.x) + bf_hi(u.x) + bf_lo(u.y) + bf_hi(u.y) + bf_lo(u.z) + bf_hi(u.z) + bf_lo(u.w) + bf_hi(u.w); }
            p.NLOC[(size_t)item * 64 + tid] = sum;
        }
    }
}

__device__ void ph_ml_pass2(const P& p) {
    const int gt = blockIdx.x * 256 + otid(), nthr = gridDim.x * 256;
    for (int w = gt; w < 64 * 2048; w += nthr) {
        const int chain = w >> 11, e = (w & 2047) * 4;
        float c0 = 0.f, c1 = 0.f, c2 = 0.f, c3 = 0.f, m = 0.f;
        for (int c = 0; c < 36; ++c) {
            const int it = chain * 36 + c;
            *(uint2*)(p.CST + (size_t)it * 8192 + e) = make_uint2(cvt_pk_bf16(c0, c1), cvt_pk_bf16(c2, c3));
            const float Bt = p.CHB[it], Mc = p.CHM[it];
            const float g = fmaxf(m, Mc), al = expf(m - g), be = expf(Mc - g);
            const float4 cl = *(const float4*)(p.CLOC + (size_t)it * 8192 + e);
            c0 = al * c0 + be * cl.x; c1 = al * c1 + be * cl.y; c2 = al * c2 + be * cl.z; c3 = al * c3 + be * cl.w;
            m = Bt + g;
        }
    }
    for (int w = gt; w < 64 * 64; w += nthr) {
        const int chain = w >> 6, d = w & 63;
        float n = 0.f, m = 0.f;
        for (int c = 0; c < 36; ++c) {
            const int it = chain * 36 + c;
            p.NST[(size_t)it * 64 + d] = n;
            if (d == 0) p.MST[it] = m;
            const float Bt = p.CHB[it], Mc = p.CHM[it];
            const float g = fmaxf(m, Mc);
            n = expf(m - g) * n + expf(Mc - g) * p.NLOC[(size_t)it * 64 + d];
            m = Bt + g;
        }
    }
}

__device__ void ml_pass3_item(const P& p, int item, int j, char* smem) {
    const int tc = item % 36, h = (item / 36) & 3, b = item / 144;
    const int tid = otid(), lane = tid & 63, wid = tid >> 6, jl = lane & 31, hh = lane >> 5, tb = wid & 1, dir = wid >> 1;
    char* Ql = smem;
    char* Kl = smem + 9216;
    bf16_t* VT = (bf16_t*)(smem + 18432);
    float* gs = (float*)(smem + 35840);
    float* ssc = gs + 512;
    __syncthreads();
    if (wid < 2) {
        const int d2 = wid; float Bt, Mc;
        float* sa = gs + d2 * 256; float* sb = sa + 64; float* sg = sb + 64; float* sn = sg + 64;
        ml_gates(p, j, b, h, d2, tc, lane, sa, sb, sg, Bt, Mc);
        const int sidx = ((b * 4 + h) * 2 + d2) * 36 + ml_c_of(d2, tc);
        const float mst = p.MST[sidx];
        sg[lane] = fmaxf(mst, sg[lane]);
        sn[lane] = p.NST[(size_t)sidx * 64 + lane];
        if (lane == 0) ssc[d2] = mst;
    }
#pragma unroll
    for (int i = 0; i < 2; ++i) {
        const int e = tid + 256 * i, st = e >> 3, ch = e & 7; const int row = ml_row(b, tc, st);
        *(uint4*)(Ql + st * 144 + ch * 16) = *(const uint4*)(p.QKB + (size_t)row * 512 + h * 64 + ch * 8);
        *(uint4*)(Kl + st * 144 + ch * 16) = *(const uint4*)(p.QKB + (size_t)row * 512 + 256 + h * 64 + ch * 8);
    }
#pragma unroll
    for (int i = 0; i < 4; ++i) {
        const int e = tid + 256 * i, st = e >> 4, ch = e & 15;
        const uint4 u = *(const uint4*)(p.PB + (size_t)ml_row(b, tc, st) * 1536 + 512 + h * 128 + ch * 8);
        bf16_t* d = VT + (ch * 8) * 68 + st;
        d[0] = (bf16_t)u.x; d[68] = (bf16_t)(u.x >> 16); d[136] = (bf16_t)u.y; d[204] = (bf16_t)(u.y >> 16);
        d[272] = (bf16_t)u.z; d[340] = (bf16_t)(u.z >> 16); d[408] = (bf16_t)u.w; d[476] = (bf16_t)(u.w >> 16);
    }
    __syncthreads();
    const float* sa = gs + dir * 256; const float* sb = sa + 64; const float* sg = sb + 64; const float* sn = sg + 64;
    const int t = tb * 32 + jl;
    const float gtv = sg[t], btv = sb[t], mst = ssc[dir];
    const float e2 = expf(mst - gtv);
    const int sidx = ((b * 4 + h) * 2 + dir) * 36 + ml_c_of(dir, tc);
    bf16x8 qf[4];
#pragma unroll
    for (int ks = 0; ks < 4; ++ks) qf[ks] = *(const bf16x8*)(Ql + t * 144 + (2 * ks + hh) * 16);
    f32x16 acc[4];
    {
        const bf16_t* cst = p.CST + (size_t)sidx * 8192 + (size_t)jl * 64 + hh * 8;
#pragma unroll
        for (int vb = 0; vb < 4; ++vb) {
#pragma unroll
            for (int r = 0; r < 16; ++r) acc[vb][r] = 0.f;
#pragma unroll
            for (int ks = 0; ks < 4; ++ks) {
                const bf16x8 cf = *(const bf16x8*)(cst + (size_t)vb * 32 * 64 + ks * 16);
                acc[vb] = __builtin_amdgcn_mfma_f32_32x32x16_bf16(cf, qf[ks], acc[vb], 0, 0, 0);
            }
            acc[vb] = acc[vb] * e2;
        }
    }
    float den = 0.f;
    {
        float nq = 0.f;
#pragma unroll
        for (int ks = 0; ks < 4; ++ks) {
            const u32x4 u = __builtin_bit_cast(u32x4, qf[ks]);
            const float* np = sn + 16 * ks + 8 * hh;
            nq += bf_lo(u[0]) * np[0] + bf_hi(u[0]) * np[1] + bf_lo(u[1]) * np[2] + bf_hi(u[1]) * np[3] + bf_lo(u[2]) * np[4] + bf_hi(u[2]) * np[5] + bf_lo(u[3]) * np[6] + bf_hi(u[3]) * np[7];
        }
        den = e2 * nq;
    }
#pragma unroll
    for (int sbk = 0; sbk < 2; ++sbk) {
        const bool use = dir == 0 ? (sbk <= tb) : (sbk >= tb);
        if (use) {
            f32x16 sc;
#pragma unroll
            for (int r = 0; r < 16; ++r) sc[r] = 0.f;
#pragma unroll
            for (int ks = 0; ks < 4; ++ks) {
                const bf16x8 kf = *(const bf16x8*)(Kl + (sbk * 32 + jl) * 144 + (2 * ks + hh) * 16);
                sc = __builtin_amdgcn_mfma_f32_32x32x16_bf16(kf, qf[ks], sc, 0, 0, 0);
            }
#pragma unroll
            for (int r4 = 0; r4 < 4; ++r4) {
                const int s0 = sbk * 32 + 8 * r4 + 4 * hh;
                const f32x4 av = *(const f32x4*)(sa + s0);
#pragma unroll
                for (int q = 0; q < 4; ++q) {
                    const int s2 = s0 + q;
                    const bool ok = dir == 0 ? (s2 <= t) : (s2 >= t);
                    const float pv = ok ? sc[r4 * 4 + q] * expf(av[q] - gtv) : 0.f;
                    sc[r4 * 4 + q] = pv; den += pv;
                }
            }
            bf16x8 pb[2];
            pb[0] = pack8(sc[0], sc[1], sc[2], sc[3], sc[4], sc[5], sc[6], sc[7]);
            pb[1] = pack8(sc[8], sc[9], sc[10], sc[11], sc[12], sc[13], sc[14], sc[15]);
#pragma unroll
            for (int vb = 0; vb < 4; ++vb)
#pragma unroll
                for (int k2 = 0; k2 < 2; ++k2) {
                    const char* vp = (const char*)VT + (vb * 32 + jl) * 136 + (sbk * 32 + k2 * 16 + 4 * hh) * 2;
                    const uint2 lo = *(const uint2*)vp, hi = *(const uint2*)(vp + 16);
                    const u32x4 u = (u32x4){lo.x, lo.y, hi.x, hi.y};
                    acc[vb] = __builtin_amdgcn_mfma_f32_32x32x16_bf16(__builtin_bit_cast(bf16x8, u), pb[k2], acc[vb], 0, 0, 0);
                }
        }
    }
    den += SHX(den, 32);
    const float scl = 1.f / fmaxf(fabsf(den), expf(-(btv + gtv)));
#pragma unroll
    for (int vb = 0; vb < 4; ++vb) acc[vb] = acc[vb] * scl;
    __syncthreads();
    float* X = (float*)smem + tb * 4096;
    if (dir == 1) {
#pragma unroll
        for (int vb = 0; vb < 4; ++vb)
#pragma unroll
            for (int r = 0; r < 16; ++r) X[(vb * 32 + (r & 3) + 8 * (r >> 2) + 4 * hh) * 32 + jl] = acc[vb][r];
    }
    __syncthreads();
    if (dir == 0) {
        float ss = 0.f;
#pragma unroll
        for (int vb = 0; vb < 4; ++vb)
#pragma unroll
            for (int r = 0; r < 16; ++r) { const float v = acc[vb][r] + X[(vb * 32 + (r & 3) + 8 * (r >> 2) + 4 * hh) * 32 + jl]; acc[vb][r] = v; ss += v * v; }
        ss += SHX(ss, 32);
        const float rstd = rsqrtf(ss * (1.f / 128.f) + 1e-6f);
        const int row = ml_row(b, tc, t);
        const float* g = p.ev_ml_g + (size_t)j * 512 + h * 128;
        const bf16_t* og = p.PB + (size_t)row * 1536 + 1024 + h * 128;
        bf16_t* mrow = p.MIX + (size_t)row * DM + h * 128;
#pragma unroll
        for (int vb = 0; vb < 4; ++vb)
#pragma unroll
            for (int r4 = 0; r4 < 4; ++r4) {
                const int v = vb * 32 + 8 * r4 + 4 * hh;
                const f32x4 gg = *(const f32x4*)(g + v);
                const uint2 ou = *(const uint2*)(og + v);
                *(uint2*)(mrow + v) = make_uint2(cvt_pk_bf16(acc[vb][r4 * 4 + 0] * rstd * gg[0] * sigmoid_f(bf_lo(ou.x)), acc[vb][r4 * 4 + 1] * rstd * gg[1] * sigmoid_f(bf_hi(ou.x))),
                                                 cvt_pk_bf16(acc[vb][r4 * 4 + 2] * rstd * gg[2] * sigmoid_f(bf_lo(ou.y)), acc[vb][r4 * 4 + 3] * rstd * gg[3] * sigmoid_f(bf_hi(ou.y))));
            }
    }
}

__device__ void ph_attn_even(const P& p, int ci, int L, int j, float* smem) {
    int* s_item = (int*)((char*)smem + 73728);
    for (;;) {
        __syncthreads();
        if (otid() == 0) *s_item = atomicAdd(&p.ctr[ci], 1);
        __syncthreads();
        const int item = *s_item;
        if (item >= 1152 + 2304) break;
        if (item < 1152) da_block(p, item, L, j, (char*)smem); else ml_pass1_item(p, item - 1152, j, (char*)smem);
    }
}
__device__ void ph_ml_pass3(const P& p, int j, float* smem) {
    for (int item = blockIdx.x; item < 1152; item += gridDim.x) ml_pass3_item(p, item, j, (char*)smem);
}
__device__ void ph_attn_odd(const P& p, int j, bool need_ctx, float* smem) {
    const int nitem = need_ctx ? 2304 : 2048;
    for (int item = blockIdx.x; item < nitem; item += gridDim.x) { wa_block(p, item, j, (char*)smem); __syncthreads(); }
}

#define SEL_LD 132
template <int NV>
__device__ __forceinline__ unsigned topk16_threshold(const unsigned (&k)[NV], unsigned start) {
    auto cnt = [&](unsigned c) { int n = 0;
#pragma unroll
        for (int i = 0; i < NV; ++i) n += __builtin_popcountll(__ballot(k[i] >= c));
        return n; };
    unsigned E = start; int n = cnt(E);
    if (n >= 16) { for (;;) { const unsigned E2 = E + 0x800000u; if (E2 < E) break; const int n2 = cnt(E2); if (n2 < 16) break; E = E2; n = n2; } }
    else { do { E -= 0x800000u; n = cnt(E); } while (n < 16); }
    unsigned T = E;
    for (int bit = 22; bit >= 0 && n != 16; --bit) { const unsigned c = T | (1u << bit); n = cnt(c); if (n >= 16) T = c; else n = 17; }
    return T;
}
__device__ __forceinline__ unsigned fkey(float f) { const unsigned u = __float_as_uint(f); return (u & 0x80000000u) ? ~u : (u | 0x80000000u); }
__device__ __forceinline__ unsigned mbcnt64(unsigned long long m) { return __builtin_amdgcn_mbcnt_hi((unsigned)(m >> 32), __builtin_amdgcn_mbcnt_lo((unsigned)m, 0u)); }
__device__ void ph_peer_select(const P& p, int L, int nrows, char* smem) {
    float* S = (float*)smem;
    const int tid = otid(), lane = tid & 63, wid = tid >> 6, fr = lane & 15, fq = lane >> 4;
    const bf16_t* KBL = p.KB + (size_t)L * 8 * 2 * 128 * 128;
    const int ntile = nrows / 32;
    bf16x8 kfr[8][4];
    int hcur = -1;
    for (int item = blockIdx.x; item < ntile * 8; item += gridDim.x) {
        const int h = item & 7, t0 = (item >> 3) * 32;
        __syncthreads();
        {
            const int pp = wid >> 1, th = wid & 1;
            const bf16_t* qp = p.QB + (size_t)(t0 + th * 16 + fr) * 2048 + h * 256 + pp * 128 + fq * 8;
            bf16x8 qf[4];
#pragma unroll
            for (int ks = 0; ks < 4; ++ks) qf[ks] = *(const bf16x8*)(qp + ks * 32);
#ifndef SEL_NOCACHE
            if (h != hcur)
#endif
            {
                const bf16_t* kp = KBL + ((size_t)(h * 2 + pp) * 128 + fr) * 128 + fq * 8;
#pragma unroll
                for (int ni = 0; ni < 8; ++ni)
#pragma unroll
                    for (int ks = 0; ks < 4; ++ks) kfr[ni][ks] = *(const bf16x8*)(kp + (size_t)ni * 16 * 128 + ks * 32);
                hcur = h;
            }
#pragma unroll
            for (int ni = 0; ni < 8; ++ni) {
                f32x4 acc = (f32x4){0.f, 0.f, 0.f, 0.f};
#pragma unroll
                for (int ks = 0; ks < 4; ++ks) acc = __builtin_amdgcn_mfma_f32_16x16x32_bf16(qf[ks], kfr[ni][ks], acc, 0, 0, 0);
#pragma unroll
                for (int j = 0; j < 4; ++j) S[(pp * 32 + th * 16 + fq * 4 + j) * SEL_LD + ni * 16 + fr] = acc[j];
            }
        }
        __syncthreads();
        for (int tt = 0; tt < 8; ++tt) {
            const int t = wid * 8 + tt, r = t0 + t;
            const float v00 = S[t * SEL_LD + lane], v01 = S[t * SEL_LD + 64 + lane], v10 = S[(32 + t) * SEL_LD + lane], v11 = S[(32 + t) * SEL_LD + 64 + lane];
            const unsigned ka0 = fkey(v00), ka1 = fkey(v01), kb0 = fkey(v10), kb1 = fkey(v11);
            const unsigned kA[2] = {ka0, ka1}, kB[2] = {kb0, kb1};
            const unsigned T0 = topk16_threshold<2>(kA, 0xBF800000u), T1 = topk16_threshold<2>(kB, 0xBF800000u);
            float* wsA = (float*)(smem + 34816 + wid * 512);
            {
                const unsigned long long g0 = __ballot(ka0 > T0), g1 = __ballot(ka1 > T0), e0 = __ballot(ka0 == T0), e1 = __ballot(ka1 == T0);
                const int need = 16 - __builtin_popcountll(g0) - __builtin_popcountll(g1);
                const int pe0 = __builtin_popcountll(e0), need1 = need - (pe0 < need ? pe0 : need);
                const bool s0 = (ka0 > T0) || (ka0 == T0 && (int)mbcnt64(e0) < need);
                const bool s1 = (ka1 > T0) || (ka1 == T0 && (int)mbcnt64(e1) < need1);
                const unsigned long long m0 = __ballot(s0), m1 = __ballot(s1);
                if (s0) { const int pos = mbcnt64(m0); wsA[pos] = v00; ((int*)wsA)[16 + pos] = lane; }
                if (s1) { const int pos = __builtin_popcountll(m0) + mbcnt64(m1); wsA[pos] = v01; ((int*)wsA)[16 + pos] = 64 + lane; }
            }
            {
                const unsigned long long g0 = __ballot(kb0 > T1), g1 = __ballot(kb1 > T1), e0 = __ballot(kb0 == T1), e1 = __ballot(kb1 == T1);
                const int need = 16 - __builtin_popcountll(g0) - __builtin_popcountll(g1);
                const int pe0 = __builtin_popcountll(e0), need1 = need - (pe0 < need ? pe0 : need);
                const bool s0 = (kb0 > T1) || (kb0 == T1 && (int)mbcnt64(e0) < need);
                const bool s1 = (kb1 > T1) || (kb1 == T1 && (int)mbcnt64(e1) < need1);
                const unsigned long long m0 = __ballot(s0), m1 = __ballot(s1);
                if (s0) { const int pos = mbcnt64(m0); wsA[32 + pos] = v10; ((int*)wsA)[48 + pos] = lane; }
                if (s1) { const int pos = __builtin_popcountll(m0) + mbcnt64(m1); wsA[32 + pos] = v11; ((int*)wsA)[48 + pos] = 64 + lane; }
            }
            __builtin_amdgcn_wave_barrier();
            float cand[4]; int cidx[4]; unsigned kc[4];
            {
                const float av = wsA[lane >> 2]; const int ai = ((int*)wsA)[16 + (lane >> 2)];
                const float4 bv = *(const float4*)(wsA + 32 + (lane & 3) * 4); const int4 bi = *(const int4*)((int*)wsA + 48 + (lane & 3) * 4);
                cand[0] = av + bv.x; cand[1] = av + bv.y; cand[2] = av + bv.z; cand[3] = av + bv.w;
                cidx[0] = ai * 128 + bi.x; cidx[1] = ai * 128 + bi.y; cidx[2] = ai * 128 + bi.z; cidx[3] = ai * 128 + bi.w;
#pragma unroll
                for (int c = 0; c < 4; ++c) kc[c] = fkey(cand[c]);
            }
            const unsigned T = topk16_threshold<4>(kc, 0xC0800000u);
            {
                int need = 16, base = 0;
#pragma unroll
                for (int c = 0; c < 4; ++c) need -= __builtin_popcountll(__ballot(kc[c] > T));
#pragma unroll
                for (int c = 0; c < 4; ++c) {
                    const unsigned long long e = __ballot(kc[c] == T);
                    const bool sel = (kc[c] > T) || (kc[c] == T && (int)mbcnt64(e) < need);
                    const int pe = __builtin_popcountll(e); need -= (pe < need ? pe : need);
                    const unsigned long long m = __ballot(sel);
                    if (sel) { const int pos = base + mbcnt64(m); wsA[64 + pos] = cand[c]; ((int*)wsA)[80 + pos] = cidx[c]; }
                    base += __builtin_popcountll(m);
                }
            }
            __builtin_amdgcn_wave_barrier();
            {
                const float cv = lane < 16 ? wsA[64 + lane] : -INFINITY;
                const float mx = wave_max(cv);
                const float ex = lane < 16 ? __builtin_amdgcn_exp2f((cv - mx) * 1.4426950408889634f) : 0.f;
                const float sum = wave_sum(ex);
                if (lane < 16) { p.GATE[(size_t)r * 128 + h * 16 + lane] = ex / sum; p.EIDX[(size_t)r * 128 + h * 16 + lane] = ((int*)wsA)[80 + lane]; }
            }
            __builtin_amdgcn_wave_barrier();
        }
    }
}


__device__ __forceinline__ int wave_sum_i(int v, int lane) {
    v += __builtin_amdgcn_update_dpp(0, v, 0xB1, 0xF, 0xF, true);
    v += __builtin_amdgcn_update_dpp(0, v, 0x4E, 0xF, 0xF, true);
    v += __builtin_amdgcn_update_dpp(0, v, 0x141, 0xF, 0xF, true);
    v += __builtin_amdgcn_update_dpp(0, v, 0x140, 0xF, 0xF, true);
    v += __builtin_amdgcn_update_dpp(0, v, 0x142, 0xA, 0xF, false);
    v += __builtin_amdgcn_update_dpp(0, v, 0x143, 0xC, 0xF, false);
    return __builtin_amdgcn_readlane(v, 63);
}
__device__ void ph_peer_gather(const P& p, int L, int nrows, float oscale) {
    const int lane = otid() & 63, wid = __builtin_amdgcn_readfirstlane(otid() >> 6);
    const unsigned char* U = p.U8 + (size_t)L * 16384 * 1024; const unsigned char* V = p.V8 + (size_t)L * 16384 * 1024;
    const float* USC = p.USC + (size_t)L * 16384; const float* VSC = p.VSC + (size_t)L * 16384;
    const float* gate2 = p.modv + (size_t)L * 9 * 6144 + 5120;
    for (int r = blockIdx.x * 4 + wid; r < nrows; r += gridDim.x * 4) {
        const int e0 = p.EIDX[(size_t)r * 128 + lane], e1 = p.EIDX[(size_t)r * 128 + 64 + lane];
        const float g0 = p.GATE[(size_t)r * 128 + lane], g1 = p.GATE[(size_t)r * 128 + 64 + lane];
        const float us0 = USC[e0], us1 = USC[e1], vs0 = VSC[e0], vs1 = VSC[e1];
        const uint4 xq = *(const uint4*)(p.XQ + (size_t)r * DM + lane * 16);
        const float xs = p.XS[r];
        int d0 = 0, d1 = 0;
#pragma unroll
        for (int half = 0; half < 2; ++half) {
            const int ev = half ? e1 : e0;
            int dv = 0;
#pragma unroll 1
            for (int kb = 0; kb < 4; ++kb) {
                uint4 ua[16];
#pragma unroll
                for (int j = 0; j < 16; ++j) {
                    const int idx = __builtin_amdgcn_readlane(ev, kb * 16 + j);
                    ua[j] = *(const uint4*)(U + (size_t)idx * 1024 + lane * 16);
                }
#pragma unroll
                for (int j = 0; j < 16; ++j) {
                    int sdot = __builtin_amdgcn_sdot4((int)xq.x, (int)ua[j].x, 0, false);
                    sdot = __builtin_amdgcn_sdot4((int)xq.y, (int)ua[j].y, sdot, false);
                    sdot = __builtin_amdgcn_sdot4((int)xq.z, (int)ua[j].z, sdot, false);
                    sdot = __builtin_amdgcn_sdot4((int)xq.w, (int)ua[j].w, sdot, false);
                    sdot = wave_sum_i(sdot, lane);
                    if (lane == kb * 16 + j) dv = sdot;
                }
            }
            if (half) d1 = dv; else d0 = dv;
        }
        const float a0 = us0 * xs * (float)d0, a1 = us1 * xs * (float)d1;
        const float w0 = vs0 * g0 * 0.5f * a0 * (1.f + erff(a0 * 0.70710678118654752f));
        const float w1 = vs1 * g1 * 0.5f * a1 * (1.f + erff(a1 * 0.70710678118654752f));
        const float wmax = wave_max(fmaxf(fabsf(w0), fabsf(w1)));
        const float winv = wmax > 0.f ? 127.f / wmax : 0.f;
        const int wq0 = (int)rintf(w0 * winv) & 0xff, wq1 = (int)rintf(w1 * winv) & 0xff;
        int acc[16];
#pragma unroll
        for (int c = 0; c < 16; ++c) acc[c] = 0;
#pragma unroll
        for (int half = 0; half < 2; ++half) {
            const int ev = half ? e1 : e0; const int wqv = half ? wq1 : wq0;
#pragma unroll 1
            for (int kb = 0; kb < 4; ++kb) {
                uint4 ua[16];
#pragma unroll
                for (int j = 0; j < 16; ++j) {
                    const int idx = __builtin_amdgcn_readlane(ev, kb * 16 + j);
                    ua[j] = *(const uint4*)(V + (size_t)idx * 1024 + lane * 16);
                }
#pragma unroll
                for (int j4 = 0; j4 < 4; ++j4) {
                    const int k0 = kb * 16 + j4 * 4;
                    const int wpk = __builtin_amdgcn_readlane(wqv, k0) | (__builtin_amdgcn_readlane(wqv, k0 + 1) << 8) | (__builtin_amdgcn_readlane(wqv, k0 + 2) << 16) | (__builtin_amdgcn_readlane(wqv, k0 + 3) << 24);
#define TR_DOT(D, M) { const unsigned ablo = __builtin_amdgcn_perm(ua[j4 * 4 + 1].M, ua[j4 * 4].M, 0x05010400u), abhi = __builtin_amdgcn_perm(ua[j4 * 4 + 1].M, ua[j4 * 4].M, 0x07030602u); \
                        const unsigned celo = __builtin_amdgcn_perm(ua[j4 * 4 + 3].M, ua[j4 * 4 + 2].M, 0x05010400u), cehi = __builtin_amdgcn_perm(ua[j4 * 4 + 3].M, ua[j4 * 4 + 2].M, 0x07030602u); \
                        acc[(D) * 4 + 0] = __builtin_amdgcn_sdot4((int)__builtin_amdgcn_perm(celo, ablo, 0x05040100u), wpk, acc[(D) * 4 + 0], false); \
                        acc[(D) * 4 + 1] = __builtin_amdgcn_sdot4((int)__builtin_amdgcn_perm(celo, ablo, 0x07060302u), wpk, acc[(D) * 4 + 1], false); \
                        acc[(D) * 4 + 2] = __builtin_amdgcn_sdot4((int)__builtin_amdgcn_perm(cehi, abhi, 0x05040100u), wpk, acc[(D) * 4 + 2], false); \
                        acc[(D) * 4 + 3] = __builtin_amdgcn_sdot4((int)__builtin_amdgcn_perm(cehi, abhi, 0x07060302u), wpk, acc[(D) * 4 + 3], false); }
                    TR_DOT(0, x) TR_DOT(1, y) TR_DOT(2, z) TR_DOT(3, w)
#undef TR_DOT
                }
            }
        }
        const float osc = oscale * wmax * (1.f / 127.f);
        const float* gp = gate2 + (size_t)modrow(r) * 6144 + lane * 16;
        float* hp = p.H + (size_t)r * DM + lane * 16;
        float hn[16]; float ss = 0.f;
#pragma unroll
        for (int q = 0; q < 4; ++q) {
            const float4 g = *(const float4*)(gp + q * 4);
            float4 hv = *(float4*)(hp + q * 4);
            hv.x += osc * g.x * (float)acc[q * 4 + 0]; hv.y += osc * g.y * (float)acc[q * 4 + 1];
            hv.z += osc * g.z * (float)acc[q * 4 + 2]; hv.w += osc * g.w * (float)acc[q * 4 + 3];
            if (L < 3) *(float4*)(hp + q * 4) = hv;
            hn[q * 4 + 0] = hv.x; hn[q * 4 + 1] = hv.y; hn[q * 4 + 2] = hv.z; hn[q * 4 + 3] = hv.w;
            ss += hv.x * hv.x + hv.y * hv.y + hv.z * hv.z + hv.w * hv.w;
        }
        ss = wave_sum(ss);
        const float rstd = rsqrtf(ss * (1.0f / DM) + 1e-6f);
        if (L < 3) {
            const float* g1 = p.norm1_g + (size_t)(L + 1) * DM + lane * 16;
            const float* mvn = p.modv + ((size_t)(L + 1) * 9 + modrow(r)) * 6144 + lane * 16;
            unsigned w[8];
#pragma unroll
            for (int q = 0; q < 4; ++q) {
                const float4 gg = *(const float4*)(g1 + q * 4), sh = *(const float4*)(mvn + q * 4), scl = *(const float4*)(mvn + 1024 + q * 4);
                w[q * 2] = cvt_pk_bf16(hn[q * 4 + 0] * rstd * gg.x * (1.f + scl.x) + sh.x, hn[q * 4 + 1] * rstd * gg.y * (1.f + scl.y) + sh.y);
                w[q * 2 + 1] = cvt_pk_bf16(hn[q * 4 + 2] * rstd * gg.z * (1.f + scl.z) + sh.z, hn[q * 4 + 3] * rstd * gg.w * (1.f + scl.w) + sh.w);
            }
            uint4* xp = (uint4*)(p.XN + (size_t)r * DM + lane * 16);
            xp[0] = make_uint4(w[0], w[1], w[2], w[3]); xp[1] = make_uint4(w[4], w[5], w[6], w[7]);
        } else {
            const float* fg = p.final_g + lane * 16;
            float* op = p.out + (size_t)r * DM + lane * 16;
#pragma unroll
            for (int q = 0; q < 4; ++q) {
                const float4 gg = *(const float4*)(fg + q * 4);
                *(float4*)(op + q * 4) = make_float4(hn[q * 4 + 0] * rstd * gg.x, hn[q * 4 + 1] * rstd * gg.y, hn[q * 4 + 2] * rstd * gg.z, hn[q * 4 + 3] * rstd * gg.w);
            }
        }
    }
}

#define NSUB 11
__device__ __forceinline__ bool phase_empty(int ph) {
    if (ph == 0) return false;
    const int L = (ph - 1) / NSUB, s = (ph - 1) % NSUB;
    return ((L & 1) && (s == 2 || s == 4 || s == 5)) || (L > 0 && s == 0);
}
__device__ __forceinline__ void run_phase(const P& p, int ph, float* smem, int rep) {
    if (ph == 0) { ph_prologue(p, smem); return; }
    const int L = (ph - 1) / NSUB, s = (ph - 1) % NSUB, j = L >> 1;
    const bool even = (L & 1) == 0, need_ctx = L < 3;
    const int nrows = need_ctx ? NT : NL;
    const float* mv = p.modv + (size_t)L * 9 * 6144;
    switch (s) {
    case 0: ph_normmod(p.H, p.norm1_g + L * DM, mv, 0, 1024, p.XN, NT); break;
    case 1:
        if (even) ph_gemm(p.XN, p.WT + WT_EVIN(j), NT, 3200, EpiEven{p.PB, p.AQL, p.AQC, p.AK, p.AV, p.GT, p.rope}, (char*)smem);
        else ph_gemm(p.XN, p.WT + WT_ODIN(j), NT, ODW, EpiOdd{p.AQL, p.AQC, p.AK, p.AV, p.rope}, (char*)smem);
        break;
    case 2: if (even) ph_prep_even(p, j); break;
    case 3: if (even) ph_attn_even(p, L + 4 * rep, L, j, smem); else ph_attn_odd(p, j, need_ctx, smem); break;
    case 4: if (even) ph_ml_pass2(p); break;
    case 5: if (even) ph_ml_pass3(p, j, smem); break;
    case 6: ph_gemm(p.MIX, p.WT + (even ? WT_EVOUT(j) : WT_ODOUT(j)), nrows, DM, EpiResid{p.H, mv + 2048, rep ? 0.f : 1.f}, (char*)smem); break;
    case 7: ph_normmod_q(p, p.norm2_g + L * DM, mv, nrows); break;
    case 8: ph_gemm(p.XN, p.WT + WT_PQ(L), nrows, 2048, EpiStoreBF16{p.QB, 2048}, (char*)smem); break;
    case 9: ph_peer_select(p, L, nrows, (char*)smem); break;
    case 10: ph_peer_gather(p, L, nrows, rep ? 0.f : 1.f); break;
    }
}

#define XB_TMO      128
#define XB_XCNT(j)  (256  + 64 * (j))
#define XB_XSUB(j)  (1280 + 64 * (j))
#define XB_XGEN(j)  (2304 + 64 * (j))
#define XB_TOP      3328
#define XB_TOPGEN   3392
#define XCD_BAR_WORDS 3456
#define XB_SPIN_CAP (1u << 20)
#define LAS __attribute__((address_space(3)))
__device__ __forceinline__ unsigned xb_ld(unsigned* p)              { return __hip_atomic_load(p, __ATOMIC_RELAXED, __HIP_MEMORY_SCOPE_AGENT); }
__device__ __forceinline__ unsigned xb_add(unsigned* p, unsigned v) { return __hip_atomic_fetch_add(p, v, __ATOMIC_RELAXED, __HIP_MEMORY_SCOPE_AGENT); }
__device__ __forceinline__ unsigned xb_xcc_id() { return (unsigned)__builtin_amdgcn_s_getreg((3 << 11) | 20) & 0xFu; }
#define XB_SPIN(cond, bar) do { unsigned _sp = 0; while (cond) { __builtin_amdgcn_s_sleep(1); \
    if ((++_sp & 255u) == 0u) { if (xb_ld(&(bar)[XB_TMO])) break; if (_sp > XB_SPIN_CAP) { atomicAdd(&(bar)[XB_TMO], 1u); break; } } } } while (0)
struct XcdBarrier { unsigned* bar; unsigned x; volatile LAS unsigned* st; };
__device__ __forceinline__ XcdBarrier xcd_barrier_post(unsigned* bar, volatile LAS unsigned* st) {
    XcdBarrier b; b.bar = bar; b.x = xb_xcc_id(); b.st = st;
    if (threadIdx.x == 0) (void)xb_add(&bar[XB_XCNT(b.x)], 1u);
    return b;
}
__device__ __forceinline__ void xcd_barrier_complete(unsigned* bar, unsigned x, unsigned& nloc, unsigned& nx) {
    const unsigned G = gridDim.x * gridDim.y * gridDim.z;
    unsigned sum, cnt, mine, sp = 0u;
    for (;;) {
        sum = 0u; cnt = 0u; mine = 0u;
#pragma unroll
        for (unsigned j = 0; j < 16; ++j) { const unsigned c = xb_ld(&bar[XB_XCNT(j)]); sum += c; cnt += (c > 0u) ? 1u : 0u; mine = (j == x) ? c : mine; }
        if (sum == G) break;
        __builtin_amdgcn_s_sleep(1);
        if ((++sp & 255u) == 0u) { if (xb_ld(&bar[XB_TMO])) break; if (sp > XB_SPIN_CAP) { atomicAdd(&bar[XB_TMO], 1u); break; } }
    }
    nloc = mine > 0u ? mine : 1u; nx = cnt > 0u ? cnt : 1u;
}
__device__ __forceinline__ void xcd_barrier(const XcdBarrier& b) {
    asm volatile("s_waitcnt vmcnt(0)" ::: "memory");
    __syncthreads();
    if (threadIdx.x == 0) {
        unsigned* bar = b.bar;
        __builtin_amdgcn_s_waitcnt(0);
        unsigned nloc = b.st[0], nx = b.st[1];
        if (nloc == 0u) { xcd_barrier_complete(bar, b.x, nloc, nx); b.st[0] = nloc; b.st[1] = nx; }
        const unsigned old = xb_add(&bar[XB_XSUB(b.x)], 1u);
        const unsigned gen = old / nloc;
        if (old + 1u == (gen + 1u) * nloc) {
            __builtin_amdgcn_fence(__ATOMIC_RELEASE, "agent");
            asm volatile("s_waitcnt vmcnt(0)" ::: "memory");
            const unsigned og = xb_add(&bar[XB_TOP], 1u);
            const unsigned tg = og / nx;
            if (og + 1u == (tg + 1u) * nx) xb_add(&bar[XB_TOPGEN], 1u);
            else XB_SPIN(xb_ld(&bar[XB_TOPGEN]) == tg, bar);
            __builtin_amdgcn_fence(__ATOMIC_ACQUIRE, "agent");
            xb_add(&bar[XB_XGEN(b.x)], 1u);
            asm volatile("s_waitcnt vmcnt(0)" ::: "memory");
        } else {
            XB_SPIN(xb_ld(&bar[XB_XGEN(b.x)]) == gen, bar);
            __builtin_amdgcn_fence(__ATOMIC_ACQUIRE, "agent");
            asm volatile("s_waitcnt vmcnt(0)" ::: "memory");
        }
    }
    __syncthreads();
}

__global__ void __launch_bounds__(256, 2) mega(P p) {
    extern __shared__ __attribute__((aligned(16))) float smem[];
    cg::grid_group grid = cg::this_grid();
    volatile LAS unsigned* st = (volatile LAS unsigned*)((char*)smem + 73744);
    if (threadIdx.x < 4) st[threadIdx.x] = 0u;
    __syncthreads();
    XcdBarrier xb = xcd_barrier_post(p.bar, st);
    for (int ph = p.ph_lo; ph < p.ph_hi; ++ph) {
        if (phase_empty(ph)) continue;
        run_phase(p, ph, smem, 0);
        if (PROBE_N > 1 && ph > 0 && (ph - 1) % NSUB == PROBE_S)
            for (int rep = 1; rep < PROBE_N; ++rep) { xcd_barrier(xb); run_phase(p, ph, smem, rep); }
        if (ph + 1 < p.ph_hi) { if (ph == 0) grid.sync(); else xcd_barrier(xb); }
    }
}

extern "C" void kernel_launch(void* const* d_in, const int* in_sizes, int n_in, void* d_out, int out_size, void* d_ws, size_t ws_size, hipStream_t stream) {
    static int grid_blocks = 0;
    if (!grid_blocks) {
        int dev = 0, cus = 0, per_cu = 0;
        hipGetDevice(&dev);
        hipDeviceGetAttribute(&cus, hipDeviceAttributeMultiprocessorCount, dev);
        hipFuncSetAttribute((const void*)mega, hipFuncAttributeMaxDynamicSharedMemorySize, LDS_BYTES);
        hipOccupancyMaxActiveBlocksPerMultiprocessor(&per_cu, mega, 256, LDS_BYTES);
        if (per_cu < 1) per_cu = 1;
        if (per_cu > 2) per_cu = 2;
        grid_blocks = cus * per_cu;
    }
    P p{};
    const float** ins = (const float**)&p;
    for (int i = 0; i < 24; ++i) ins[i] = (const float*)d_in[i];
    p.out = (float*)d_out;
    size_t off = 0; char* ws = (char*)d_ws;
    auto carve = [&](size_t bytes) { void* r = ws + off; off += (bytes + 255) & ~(size_t)255; return r; };
    p.modv = (float*)carve((size_t)4 * 9 * 6144 * 4);
    p.rope = (float*)carve((size_t)2048 * 64 * 4);
    p.H = (float*)carve((size_t)NT * DM * 4);
    p.XN = (bf16_t*)carve((size_t)NT * DM * 2);
    p.WT = (bf16_t*)carve(WT_TOTAL * 2);
    p.MIX = (bf16_t*)carve((size_t)NT * DM * 2);
    p.PB = (bf16_t*)carve((size_t)NT * 1536 * 2);
    p.GT = (float*)carve((size_t)NT * 16 * 4);
    p.AQL = (bf16_t*)carve((size_t)8 * 16 * 2048 * 64 * 2);
    p.AQC = (bf16_t*)carve((size_t)8 * 16 * 256 * 64 * 2);
    p.AK = (bf16_t*)carve((size_t)8 * 4 * 2 * 2304 * 64 * 2);
    p.AV = (bf16_t*)carve((size_t)8 * 4 * 128 * 2304 * 2);
    p.QKB = (bf16_t*)carve((size_t)NT * 512 * 2);
    p.CLOC = (float*)carve((size_t)2304 * 8192 * 4);
    p.CST = (bf16_t*)carve((size_t)2304 * 8192 * 2);
    p.NLOC = (float*)carve((size_t)2304 * 64 * 4);
    p.NST = (float*)carve((size_t)2304 * 64 * 4);
    p.CHB = (float*)carve((size_t)2304 * 4);
    p.CHM = (float*)carve((size_t)2304 * 4);
    p.MST = (float*)carve((size_t)2304 * 4);
    p.QB = (bf16_t*)carve((size_t)NT * 2048 * 2);
    p.GATE = (float*)carve((size_t)NT * 128 * 4);
    p.EIDX = (int*)carve((size_t)NT * 128 * 4);
    p.ctr = (int*)carve(256);
    p.bar = (unsigned*)carve((size_t)XCD_BAR_WORDS * 4);
    p.U8 = (unsigned char*)carve((size_t)4 * 16384 * 1024);
    p.V8 = (unsigned char*)carve((size_t)4 * 16384 * 1024);
    p.XQ = (unsigned char*)carve((size_t)NT * DM);
    p.XS = (float*)carve((size_t)NT * 4);
    p.USC = (float*)carve((size_t)4 * 16384 * 4);
    p.VSC = (float*)carve((size_t)4 * 16384 * 4);
    p.KB = (bf16_t*)carve((size_t)4 * 8 * 2 * 128 * 128 * 2);
    if (off > ws_size) { fprintf(stderr, "kernel_launch: workspace too small: need %zu have %zu\n", off, ws_size); return; }
    hipMemsetAsync(p.bar, 0, (size_t)XCD_BAR_WORDS * 4, stream);
#if ONE_LAUNCH
    p.ph_lo = 0; p.ph_hi = NPH;
    void* args[] = {&p};
    hipError_t e = hipLaunchCooperativeKernel((void*)mega, dim3(grid_blocks), dim3(256), args, LDS_BYTES, stream);
    if (e != hipSuccess) fprintf(stderr, "cooperative launch failed: %s (grid %d)\n", hipGetErrorString(e), grid_blocks);
#else
    for (int ph = 0; ph < NPH; ++ph) {
        if (ph > 0 && ph < NPH - 1) { const int L = (ph - 1) / NSUB, s = (ph - 1) % NSUB; if ((s == 2 || s == 4 || s == 5) && (L & 1)) continue; }
        p.ph_lo = ph; p.ph_hi = ph + 1;
        hipLaunchKernelGGL(mega, dim3(grid_blocks), dim3(256), LDS_BYTES, stream, p);
    }
#endif
}
```

```cpp
#include <hip/hip_runtime.h>
#include <hip/hip_cooperative_groups.h>
#include <cstdio>
#include <cstdint>
namespace cg = cooperative_groups;

#ifndef ONE_LAUNCH
#define ONE_LAUNCH 1
#endif

#define NT 18432
#define NL 16384
#define DM 1024
#define EVW 3088
#define ODW 1536
#define C_QK 0
#define C_V 512
#define C_O 1024
#define C_G 1536
#define C_DQ 1552
#define C_DK 2064
#define C_DV 2576
#define NPH 45
#ifndef PROBE_S
#define PROBE_S -1
#endif
#ifndef PROBE_N
#define PROBE_N 1
#endif

typedef unsigned short bf16_t;
typedef short bf16x8 __attribute__((ext_vector_type(8)));
typedef float f32x4 __attribute__((ext_vector_type(4)));
#define LDS_BYTES 73792

typedef float f32x16 __attribute__((ext_vector_type(16)));
typedef unsigned u32x4 __attribute__((ext_vector_type(4)));
struct P {
    const float *x, *c, *ctx, *c_ctx, *mod_w, *mod_b, *norm1_g, *norm2_g, *ev_w_in, *ev_conv_w, *ev_conv_b, *ev_gate_b,
        *ev_ml_g, *ev_da_lam, *ev_da_g, *ev_w_out, *od_w_in, *od_sink, *od_w_out, *pr_w_q, *pr_keys, *pr_u, *pr_v, *final_g;
    float* out;
    float *modv, *H, *GATE, *rope, *GT, *CLOC, *NLOC, *NST, *CHB, *CHM, *MST;
    int *EIDX, *ctr;
    unsigned* bar;
    bf16_t *XN, *MIX, *WT, *KB, *QB, *PB, *AQL, *AQC, *AK, *AV, *QKB, *CST;
    unsigned char *U8, *V8;
    float *USC, *VSC, *XS;
    unsigned char* XQ;
    int ph_lo, ph_hi;
};
#define QSCALE 0.18033688011112042f

__device__ __forceinline__ int otid() { int t = threadIdx.x; asm volatile("" : "+v"(t)); return t; }
__device__ __forceinline__ unsigned pack_i8x4(float a, float b, float c, float d) {
    return ((unsigned)(int)rintf(a) & 0xffu) | (((unsigned)(int)rintf(b) & 0xffu) << 8) | (((unsigned)(int)rintf(c) & 0xffu) << 16) | ((unsigned)(int)rintf(d) << 24);
}
__device__ __forceinline__ int modrow(int r) { return r < NL ? (r >> 11) : 8; }
__device__ __forceinline__ float silu_f(float x) { return x / (1.f + expf(-x)); }
__device__ __forceinline__ float sigmoid_f(float x) { return 1.f / (1.f + expf(-x)); }
__device__ __forceinline__ float log_sigmoid_f(float x) { return fminf(x, 0.f) - log1pf(expf(-fabsf(x))); }
typedef __bf16 bf16v2_t __attribute__((ext_vector_type(2)));
typedef float f32x2_t __attribute__((ext_vector_type(2)));
__device__ __forceinline__ unsigned cvt_pk_bf16(float lo, float hi) { const bf16v2_t v = __builtin_convertvector((f32x2_t){lo, hi}, bf16v2_t); return __builtin_bit_cast(unsigned, v); }
__device__ __forceinline__ float bf_lo(unsigned u) { return __uint_as_float(u << 16); }
__device__ __forceinline__ float bf_hi(unsigned u) { return __uint_as_float(u & 0xffff0000u); }
__device__ __forceinline__ void unpack8(const uint4 u, float* f) {
    f[0] = bf_lo(u.x); f[1] = bf_hi(u.x); f[2] = bf_lo(u.y); f[3] = bf_hi(u.y); f[4] = bf_lo(u.z); f[5] = bf_hi(u.z); f[6] = bf_lo(u.w); f[7] = bf_hi(u.w);
}
#define WT_EVIN(j) ((size_t)(j) * 3200 * 1024)
#define WT_EVOUT(j) ((size_t)2 * 3200 * 1024 + (size_t)(j) * 1024 * 1024)
#define WT_ODIN(j) ((size_t)2 * 3200 * 1024 + (size_t)2 * 1024 * 1024 + (size_t)(j) * 1536 * 1024)
#define WT_ODOUT(j) ((size_t)2 * 3200 * 1024 + (size_t)2 * 1024 * 1024 + (size_t)2 * 1536 * 1024 + (size_t)(j) * 1024 * 1024)
#define WT_PQ(L) ((size_t)2 * 3200 * 1024 + (size_t)4 * 1024 * 1024 + (size_t)2 * 1536 * 1024 + (size_t)(L) * 2048 * 1024)
#define WT_TOTAL ((size_t)2 * 3200 * 1024 + (size_t)4 * 1024 * 1024 + (size_t)2 * 1536 * 1024 + (size_t)4 * 2048 * 1024)
__device__ __forceinline__ float lshfl(float v, int src) { return __int_as_float(__builtin_amdgcn_ds_bpermute(src << 2, __float_as_int(v))); }
#define SHX(v, m) lshfl((v), lane ^ (m))
#define wave_sum(v) wave_sum_l((v), lane)
#define wave_max(v) wave_max_l((v), lane)
__device__ __forceinline__ float wave_sum_l(float v, int lane) {
#pragma unroll
    for (int o = 32; o > 0; o >>= 1) v += lshfl(v, lane ^ o);
    return v;
}
__device__ __forceinline__ float wave_max_l(float v, int lane) {
#pragma unroll
    for (int o = 32; o > 0; o >>= 1) v = fmaxf(v, lshfl(v, lane ^ o));
    return v;
}

__device__ void cvt_copy_bf16(const float* src, bf16_t* dst, size_t n);
__device__ void quant_rows_i8(const float* src, unsigned char* dst, float* scl, int nrows);
__device__ void ph_prologue(const P& p, float* smem) {
    const int tid = otid(), nb = gridDim.x, bid = blockIdx.x;
    if (bid == 0 && tid < 64) p.ctr[tid] = 0;
    {
        const float4* xs = (const float4*)p.x; const float4* cs = (const float4*)p.ctx; float4* hd = (float4*)p.H;
        const size_t nx = (size_t)NL * DM / 4, nc = (size_t)(NT - NL) * DM / 4;
        for (size_t i = (size_t)bid * 256 + tid; i < nx + nc; i += (size_t)nb * 256) hd[i] = i < nx ? xs[i] : cs[i - nx];
    }
    for (int i = bid * 256 + tid; i < 2048 * 32; i += nb * 256) {
        const int s = i >> 5, d = i & 31;
        const float pos = (d < 16) ? (float)(s >> 6) : (float)(s & 63);
        const float inv = powf(10000.0f, -(float)(d & 15) / 16.0f);
        const float ang = pos * inv;
        p.rope[2 * i] = cosf(ang); p.rope[2 * i + 1] = sinf(ang);
    }
    float* sc = smem;
    float* red = smem + 9 * 1024;
    for (int i = tid; i < 9 * 1024; i += 256) { const int r = i >> 10, k = i & 1023; const float v = r < 8 ? p.c[r * 1024 + k] : p.c_ctx[k]; sc[i] = silu_f(v); }
    __syncthreads();
    for (int item = bid; item < 4 * 96; item += nb) {
        const int L = item / 96, n0 = (item % 96) * 64, tx = tid & 63, kq = tid >> 6;
        float acc[9];
#pragma unroll
        for (int r = 0; r < 9; ++r) acc[r] = 0.f;
        const float* w = p.mod_w + (size_t)L * 1024 * 6144 + n0 + tx;
        for (int k = kq * 256; k < kq * 256 + 256; ++k) {
            const float wv = w[(size_t)k * 6144];
#pragma unroll
            for (int r = 0; r < 9; ++r) acc[r] += sc[r * 1024 + k] * wv;
        }
#pragma unroll
        for (int r = 0; r < 9; ++r) red[(kq * 9 + r) * 64 + tx] = acc[r];
        __syncthreads();
        if (kq == 0) {
#pragma unroll
            for (int r = 0; r < 9; ++r) {
                const float s = red[(0 * 9 + r) * 64 + tx] + red[(1 * 9 + r) * 64 + tx] + red[(2 * 9 + r) * 64 + tx] + red[(3 * 9 + r) * 64 + tx];
                p.modv[((size_t)L * 9 + r) * 6144 + n0 + tx] = s + p.mod_b[L * 6144 + n0 + tx];
            }
        }
        __syncthreads();
    }
    {
        float (*tile)[65] = (float (*)[65])smem;
        for (int item = bid; item < 5440; item += nb) {
            int it = item, mat = 0, N = 0, Npad = 0; const float* src = nullptr; bf16_t* dst = nullptr;
            for (mat = 0; mat < 12; ++mat) {
                if (mat < 2) { N = EVW; Npad = 3200; src = p.ev_w_in + (size_t)mat * DM * EVW; dst = p.WT + WT_EVIN(mat); }
                else if (mat < 4) { N = 1024; Npad = 1024; src = p.ev_w_out + (size_t)(mat - 2) * DM * DM; dst = p.WT + WT_EVOUT(mat - 2); }
                else if (mat < 6) { N = ODW; Npad = ODW; src = p.od_w_in + (size_t)(mat - 4) * DM * ODW; dst = p.WT + WT_ODIN(mat - 4); }
                else if (mat < 8) { N = 1024; Npad = 1024; src = p.od_w_out + (size_t)(mat - 6) * DM * DM; dst = p.WT + WT_ODOUT(mat - 6); }
                else { N = 2048; Npad = 2048; src = p.pr_w_q + (size_t)(mat - 8) * DM * 2048; dst = p.WT + WT_PQ(mat - 8); }
                const int nt = 16 * (Npad / 64);
                if (it < nt) break;
                it -= nt;
            }
            const int k0 = (it & 15) * 64, n0 = (it >> 4) * 64;
            __syncthreads();
#pragma unroll
            for (int rep = 0; rep < 4; ++rep) {
                const int i = (tid >> 4) + 16 * rep, c4 = (tid & 15) * 4;
                float4 v = make_float4(0.f, 0.f, 0.f, 0.f);
                int sc = n0 + c4;
                if (mat < 2) sc = sc < 1536 ? sc : (sc < 3072 ? sc + 16 : (sc < 3088 ? sc - 3072 + 1536 : N));
                if (sc < N) v = *(const float4*)(src + (size_t)(k0 + i) * N + sc);
                tile[i][c4] = v.x; tile[i][c4 + 1] = v.y; tile[i][c4 + 2] = v.z; tile[i][c4 + 3] = v.w;
            }
            __syncthreads();
            {
                const int n = tid >> 2, kq = (tid & 3) * 16;
                unsigned w[8];
#pragma unroll
                for (int e = 0; e < 8; ++e) w[e] = cvt_pk_bf16(tile[kq + 2 * e][n], tile[kq + 2 * e + 1][n]);
                uint4* dp = (uint4*)(dst + (size_t)(n0 + n) * DM + k0 + kq);
                dp[0] = make_uint4(w[0], w[1], w[2], w[3]); dp[1] = make_uint4(w[4], w[5], w[6], w[7]);
            }
        }
    }
    quant_rows_i8(p.pr_u, p.U8, p.USC, 4 * 16384);
    quant_rows_i8(p.pr_v, p.V8, p.VSC, 4 * 16384);
    cvt_copy_bf16(p.pr_keys, p.KB, (size_t)4 * 8 * 2 * 128 * 128);
}

__device__ void ph_normmod_q(const P& p, const float* g, const float* modv_layer, int nrows) {
    const int lane = otid() & 63, wid = otid() >> 6;
    for (int r = blockIdx.x * 4 + wid; r < nrows; r += gridDim.x * 4) {
        const float4* s4 = (const float4*)(p.H + (size_t)r * DM + lane * 16);
        float4 v[4]; float ss = 0.f;
#pragma unroll
        for (int i = 0; i < 4; ++i) { v[i] = s4[i]; ss += v[i].x * v[i].x + v[i].y * v[i].y + v[i].z * v[i].z + v[i].w * v[i].w; }
        ss = wave_sum(ss);
        const float rstd = rsqrtf(ss * (1.0f / DM) + 1e-6f);
        const float* mv = modv_layer + (size_t)modrow(r) * 6144 + lane * 16;
        float o[16]; float mx = 0.f;
#pragma unroll
        for (int i = 0; i < 4; ++i) {
            const float4 gg = *(const float4*)(g + lane * 16 + i * 4), sh = *(const float4*)(mv + 3072 + i * 4), scl = *(const float4*)(mv + 4096 + i * 4);
            o[i * 4 + 0] = v[i].x * rstd * gg.x * (1.f + scl.x) + sh.x; o[i * 4 + 1] = v[i].y * rstd * gg.y * (1.f + scl.y) + sh.y;
            o[i * 4 + 2] = v[i].z * rstd * gg.z * (1.f + scl.z) + sh.z; o[i * 4 + 3] = v[i].w * rstd * gg.w * (1.f + scl.w) + sh.w;
            mx = fmaxf(mx, fmaxf(fmaxf(fabsf(o[i * 4]), fabsf(o[i * 4 + 1])), fmaxf(fabsf(o[i * 4 + 2]), fabsf(o[i * 4 + 3]))));
        }
        mx = wave_max(mx);
        const float inv = mx > 0.f ? 127.f / mx : 0.f;
        uint4* xp = (uint4*)(p.XN + (size_t)r * DM + lane * 16);
        xp[0] = make_uint4(cvt_pk_bf16(o[0], o[1]), cvt_pk_bf16(o[2], o[3]), cvt_pk_bf16(o[4], o[5]), cvt_pk_bf16(o[6], o[7]));
        xp[1] = make_uint4(cvt_pk_bf16(o[8], o[9]), cvt_pk_bf16(o[10], o[11]), cvt_pk_bf16(o[12], o[13]), cvt_pk_bf16(o[14], o[15]));
        *(uint4*)(p.XQ + (size_t)r * DM + lane * 16) = make_uint4(pack_i8x4(o[0] * inv, o[1] * inv, o[2] * inv, o[3] * inv), pack_i8x4(o[4] * inv, o[5] * inv, o[6] * inv, o[7] * inv),
                                                                  pack_i8x4(o[8] * inv, o[9] * inv, o[10] * inv, o[11] * inv), pack_i8x4(o[12] * inv, o[13] * inv, o[14] * inv, o[15] * inv));
        if (lane == 0) p.XS[r] = mx * (1.f / 127.f);
    }
}

__device__ void cvt_copy_bf16(const float* src, bf16_t* dst, size_t n) {
    const size_t n8 = n / 8;
    for (size_t i = (size_t)blockIdx.x * 256 + otid(); i < n8; i += (size_t)gridDim.x * 256) {
        const float4 a = ((const float4*)src)[2 * i], b = ((const float4*)src)[2 * i + 1];
        ((uint4*)dst)[i] = make_uint4(cvt_pk_bf16(a.x, a.y), cvt_pk_bf16(a.z, a.w), cvt_pk_bf16(b.x, b.y), cvt_pk_bf16(b.z, b.w));
    }
}

__device__ void quant_rows_i8(const float* src, unsigned char* dst, float* scl, int nrows) {
    const int lane = otid() & 63, wid = otid() >> 6;
    for (int r = blockIdx.x * 4 + wid; r < nrows; r += gridDim.x * 4) {
        const float4* sp = (const float4*)(src + (size_t)r * 1024 + lane * 16);
        float4 v[4]; float mx = 0.f;
#pragma unroll
        for (int i = 0; i < 4; ++i) { v[i] = sp[i]; mx = fmaxf(mx, fmaxf(fmaxf(fabsf(v[i].x), fabsf(v[i].y)), fmaxf(fabsf(v[i].z), fabsf(v[i].w)))); }
#pragma unroll
        for (int o = 32; o > 0; o >>= 1) mx = fmaxf(mx, SHX(mx, o));
        const float inv = mx > 0.f ? 127.f / mx : 0.f;
        unsigned w[4];
#pragma unroll
        for (int i = 0; i < 4; ++i) {
            w[i] = pack_i8x4(v[i].x * inv, v[i].y * inv, v[i].z * inv, v[i].w * inv);
        }
        *(uint4*)(dst + (size_t)r * 1024 + lane * 16) = make_uint4(w[0], w[1], w[2], w[3]);
        if (lane == 0) scl[r] = mx * (1.f / 127.f);
    }
}

__device__ void ph_normmod(const float* src, const float* g, const float* modv_layer, int shift_off, int scale_off, bf16_t* dst, int nrows) {
    const int lane = otid() & 63, wid = otid() >> 6;
    for (int r = blockIdx.x * 4 + wid; r < nrows; r += gridDim.x * 4) {
        const float4* s4 = (const float4*)(src + (size_t)r * DM);
        float4 v[4]; float ss = 0.f;
#pragma unroll
        for (int i = 0; i < 4; ++i) { v[i] = s4[i * 64 + lane]; ss += v[i].x * v[i].x + v[i].y * v[i].y + v[i].z * v[i].z + v[i].w * v[i].w; }
        ss = wave_sum(ss);
        const float rstd = rsqrtf(ss * (1.0f / DM) + 1e-6f);
        const float* mv = modv_layer + (size_t)modrow(r) * 6144;
        uint2* d2 = (uint2*)(dst + (size_t)r * DM);
#pragma unroll
        for (int i = 0; i < 4; ++i) {
            const int c = (i * 64 + lane) * 4;
            const float4 gg = *(const float4*)(g + c), sh = *(const float4*)(mv + shift_off + c), scl = *(const float4*)(mv + scale_off + c);
            float4 o;
            o.x = v[i].x * rstd * gg.x * (1.f + scl.x) + sh.x; o.y = v[i].y * rstd * gg.y * (1.f + scl.y) + sh.y;
            o.z = v[i].z * rstd * gg.z * (1.f + scl.z) + sh.z; o.w = v[i].w * rstd * gg.w * (1.f + scl.w) + sh.w;
            d2[i * 64 + lane] = make_uint2(cvt_pk_bf16(o.x, o.y), cvt_pk_bf16(o.z, o.w));
        }
    }
}

__device__ void ph_final(const P& p) {
    const int lane = otid() & 63, wid = otid() >> 6;
    for (int r = blockIdx.x * 4 + wid; r < NL; r += gridDim.x * 4) {
        const float4* s4 = (const float4*)(p.H + (size_t)r * DM);
        float4 v[4]; float ss = 0.f;
#pragma unroll
        for (int i = 0; i < 4; ++i) { v[i] = s4[i * 64 + lane]; ss += v[i].x * v[i].x + v[i].y * v[i].y + v[i].z * v[i].z + v[i].w * v[i].w; }
        ss = wave_sum(ss);
        const float rstd = rsqrtf(ss * (1.0f / DM) + 1e-6f);
        float4* d4 = (float4*)(p.out + (size_t)r * DM);
#pragma unroll
        for (int i = 0; i < 4; ++i) {
            const int c = (i * 64 + lane) * 4; const float4 gg = *(const float4*)(p.final_g + c);
            float4 o; o.x = v[i].x * rstd * gg.x; o.y = v[i].y * rstd * gg.y; o.z = v[i].z * rstd * gg.z; o.w = v[i].w * rstd * gg.w;
            d4[i * 64 + lane] = o;
        }
    }
}

#define GL_ROWB 144
#define GL_TILEB (128 * GL_ROWB)
struct TokPos { int b, pos, kpos; bool lat; };
__device__ __forceinline__ TokPos tokpos(int row) {
    TokPos t; t.lat = row < NL;
    if (t.lat) { t.b = row >> 11; t.pos = row & 2047; t.kpos = 256 + t.pos; } else { const int r = row - NL; t.b = r >> 8; t.pos = r & 255; t.kpos = t.pos; }
    return t;
}
struct EpiStoreBF16 {
    bf16_t* C; int ldc;
    __device__ __forceinline__ bool swapped(int) const { return false; }
    __device__ __forceinline__ void operator()(const f32x4 (&acc)[4][4], int m0, int n0, int wm, int wn, int fr, int fq) const {
#pragma unroll
        for (int mi = 0; mi < 4; ++mi)
#pragma unroll
            for (int ni = 0; ni < 4; ++ni) {
                const f32x4 v = acc[ni][mi];
                *(uint2*)(C + (size_t)(m0 + wm * 64 + mi * 16 + fr) * ldc + n0 + wn * 64 + ni * 16 + fq * 4) = make_uint2(cvt_pk_bf16(v[0], v[1]), cvt_pk_bf16(v[2], v[3]));
            }
    }
};
struct EpiResid {
    float* H; const float* gate; float scale;
    __device__ __forceinline__ bool swapped(int) const { return false; }
    __device__ __forceinline__ void operator()(const f32x4 (&acc)[4][4], int m0, int n0, int wm, int wn, int fr, int fq) const {
#pragma unroll
        for (int mi = 0; mi < 4; ++mi) {
            const int row = m0 + wm * 64 + mi * 16 + fr;
            const float* gp = gate + (size_t)modrow(row) * 6144;
#pragma unroll
            for (int ni = 0; ni < 4; ++ni) {
                const int col = n0 + wn * 64 + ni * 16 + fq * 4;
                const f32x4 g = *(const f32x4*)(gp + col);
                f32x4* hp = (f32x4*)(H + (size_t)row * DM + col);
                *hp = *hp + g * acc[ni][mi] * scale;
            }
        }
    }
};
__device__ __forceinline__ void rope_store64(const f32x4 (&acc)[4][4], int mi, bool do_rope, const float* ropep  , float scale, bf16_t* dst  , int fq) {
#pragma unroll
    for (int ni = 0; ni < 2; ++ni) {
        f32x4 x1 = acc[ni][mi], x2 = acc[ni + 2][mi];
        if (do_rope) {
            const f32x4 r0 = *(const f32x4*)(ropep + (ni * 16 + fq * 4) * 2), r1 = *(const f32x4*)(ropep + (ni * 16 + fq * 4) * 2 + 4);
            const f32x4 cs = (f32x4){r0[0], r0[2], r1[0], r1[2]}, sn = (f32x4){r0[1], r0[3], r1[1], r1[3]};
            const f32x4 y1 = x1 * cs - x2 * sn, y2 = x1 * sn + x2 * cs;
            x1 = y1; x2 = y2;
        }
        x1 = x1 * scale; x2 = x2 * scale;
        *(uint2*)(dst + ni * 16 + fq * 4) = make_uint2(cvt_pk_bf16(x1[0], x1[1]), cvt_pk_bf16(x1[2], x1[3]));
        *(uint2*)(dst + 32 + ni * 16 + fq * 4) = make_uint2(cvt_pk_bf16(x2[0], x2[1]), cvt_pk_bf16(x2[2], x2[3]));
    }
}
struct EpiEven {
    bf16_t *PB, *AQL, *AQC, *AK, *AV; float* GT; const float* rope;
    __device__ __forceinline__ bool swapped(int n0) const { return n0 >= 2560 && n0 < 3072; }
    __device__ __forceinline__ void operator()(const f32x4 (&acc)[4][4], int m0, int n0, int wm, int wn, int fr, int fq) const {
        const int t = n0 >> 7;
        if (t < 12) {
#pragma unroll
            for (int mi = 0; mi < 4; ++mi)
#pragma unroll
                for (int ni = 0; ni < 4; ++ni) {
                    const f32x4 v = acc[ni][mi];
                    *(uint2*)(PB + (size_t)(m0 + wm * 64 + mi * 16 + fr) * 1536 + n0 + wn * 64 + ni * 16 + fq * 4) = make_uint2(cvt_pk_bf16(v[0], v[1]), cvt_pk_bf16(v[2], v[3]));
                }
        } else if (t < 20) {
            const bool isq = t < 16; const int h = t & 3;
#pragma unroll
            for (int mi = 0; mi < 4; ++mi) {
                const TokPos tp = tokpos(m0 + wm * 64 + mi * 16 + fr);
                const int hm = (tp.b * 4 + h) * 2 + wn;
                bf16_t* dst;
                if (isq) dst = tp.lat ? AQL + ((size_t)hm * 2048 + tp.pos) * 64 : AQC + ((size_t)hm * 256 + tp.pos) * 64;
                else dst = AK + ((size_t)hm * 2304 + tp.kpos) * 64;
                rope_store64(acc, mi, tp.lat, rope + (size_t)tp.pos * 64, isq ? QSCALE : 1.0f, dst, fq);
            }
        } else if (t < 24) {
            const int h = t - 20;
#pragma unroll
            for (int mi = 0; mi < 4; ++mi) {
                const TokPos tp = tokpos(m0 + wm * 64 + mi * 16 + fq * 4);
#pragma unroll
                for (int ni = 0; ni < 4; ++ni) {
                    const f32x4 v = acc[ni][mi];
                    const int d = wn * 64 + ni * 16 + fr;
                    *(uint2*)(AV + ((size_t)(tp.b * 4 + h) * 128 + d) * 2304 + tp.kpos) = make_uint2(cvt_pk_bf16(v[0], v[1]), cvt_pk_bf16(v[2], v[3]));
                }
            }
        } else {
            if (wn == 0) {
#pragma unroll
                for (int mi = 0; mi < 4; ++mi) *(f32x4*)(GT + (size_t)(m0 + wm * 64 + mi * 16 + fr) * 16 + fq * 4) = acc[0][mi];
            }
        }
    }
};
struct EpiOdd {
    bf16_t *AQL, *AQC, *AK, *AV; const float* rope;
    __device__ __forceinline__ bool swapped(int n0) const { return n0 >= 1280; }
    __device__ __forceinline__ void operator()(const f32x4 (&acc)[4][4], int m0, int n0, int wm, int wn, int fr, int fq) const {
        const int t = n0 >> 7;
        if (t < 10) {
            const bool isq = t < 8; const int hd = isq ? t * 2 + wn : (t - 8) * 2 + wn;
#pragma unroll
            for (int mi = 0; mi < 4; ++mi) {
                const TokPos tp = tokpos(m0 + wm * 64 + mi * 16 + fr);
                bf16_t* dst;
                if (isq) dst = tp.lat ? AQL + ((size_t)(tp.b * 16 + hd) * 2048 + tp.pos) * 64 : AQC + ((size_t)(tp.b * 16 + hd) * 256 + tp.pos) * 64;
                else dst = AK + ((size_t)(tp.b * 4 + hd) * 2304 + tp.kpos) * 64;
                rope_store64(acc, mi, tp.lat, rope + (size_t)tp.pos * 64, isq ? QSCALE : 1.0f, dst, fq);
            }
        } else {
            const int hkv = (t - 10) * 2 + wn;
#pragma unroll
            for (int mi = 0; mi < 4; ++mi) {
                const TokPos tp = tokpos(m0 + wm * 64 + mi * 16 + fq * 4);
#pragma unroll
                for (int ni = 0; ni < 4; ++ni) {
                    const f32x4 v = acc[ni][mi];
                    const int d = ni * 16 + fr;
                    *(uint2*)(AV + ((size_t)(tp.b * 4 + hkv) * 64 + d) * 2304 + tp.kpos) = make_uint2(cvt_pk_bf16(v[0], v[1]), cvt_pk_bf16(v[2], v[3]));
                }
            }
        }
    }
};
#define LDS_AS __attribute__((address_space(3)))
template <bool SWAP>
__device__ __forceinline__ void gemm_tile_kloop(f32x4 (&acc)[4][4], const bf16_t* aub, const bf16_t* bub, char* smem, int lrow, int lch, int wm, int wn, int fr, int fq) {
    const int tid = lrow * 8 + lch, wid = tid >> 6, lane = tid & 63;
    const int srow = wid * 8 + (lane >> 3);
    const unsigned goff = (unsigned)(srow * DM + (((lane & 7) ^ (srow & 7)) << 3)) * 2u;
#define GL_DMA(BUF, KO) { _Pragma("unroll") for (int i = 0; i < 4; ++i) { \
        __builtin_amdgcn_global_load_lds((const unsigned*)((const char*)aub + ((size_t)(32 * i) * DM + (KO)) * 2 + goff), (LDS_AS unsigned*)((BUF) + (i * 32 + wid * 8) * 128), 16, 0, 0); \
        __builtin_amdgcn_global_load_lds((const unsigned*)((const char*)bub + ((size_t)(32 * i) * DM + (KO)) * 2 + goff), (LDS_AS unsigned*)((BUF) + 16384 + (i * 32 + wid * 8) * 128), 16, 0, 0); } }
    const int xr = fr & 7;
    GL_DMA(smem, 0)
    __syncthreads();
    for (int kt = 0; kt < 16; ++kt) {
        char* cur = smem + (kt & 1) * 32768;
        char* nxt = smem + ((kt + 1) & 1) * 32768;
        if (kt + 1 < 16) GL_DMA(nxt, (kt + 1) * 64)
#pragma unroll
        for (int ks = 0; ks < 2; ++ks) {
            bf16x8 af[4], wf[4];
#pragma unroll
            for (int i = 0; i < 4; ++i) {
                af[i] = *(const bf16x8*)(cur + (wm * 64 + i * 16 + fr) * 128 + (((ks * 4 + fq) ^ xr) << 4));
                wf[i] = *(const bf16x8*)(cur + 16384 + (wn * 64 + i * 16 + fr) * 128 + (((ks * 4 + fq) ^ xr) << 4));
            }
#pragma unroll
            for (int ni = 0; ni < 4; ++ni)
#pragma unroll
                for (int mi = 0; mi < 4; ++mi)
                    acc[ni][mi] = SWAP ? __builtin_amdgcn_mfma_f32_16x16x32_bf16(af[mi], wf[ni], acc[ni][mi], 0, 0, 0)
                                       : __builtin_amdgcn_mfma_f32_16x16x32_bf16(wf[ni], af[mi], acc[ni][mi], 0, 0, 0);
        }
        __syncthreads();
    }
#undef GL_DMA
}
template <class Epi>
__device__ void ph_gemm(const bf16_t* A, const bf16_t* Bt, int M, int Npad, const Epi& epi, char* smem) {
    const int tid = otid(), lane = tid & 63, wid = tid >> 6, wm = wid >> 1, wn = wid & 1;
    const int fr = lane & 15, fq = lane >> 4;
    const int tm = M / 128, tn = Npad / 128, ntiles = tm * tn;
    const int lrow = tid >> 3, lch = tid & 7;
    for (int tile = blockIdx.x; tile < ntiles; tile += gridDim.x) {
        const int m0 = (tile % tm) * 128, n0 = (tile / tm) * 128;
        f32x4 acc[4][4];
#pragma unroll
        for (int a = 0; a < 4; ++a)
#pragma unroll
            for (int b = 0; b < 4; ++b) acc[a][b] = (f32x4){0.f, 0.f, 0.f, 0.f};
        const bf16_t* ap = A + (size_t)m0 * DM;
        const bf16_t* bp = Bt + (size_t)n0 * DM;
        if (epi.swapped(n0)) gemm_tile_kloop<true>(acc, ap, bp, smem, lrow, lch, wm, wn, fr, fq);
        else gemm_tile_kloop<false>(acc, ap, bp, smem, lrow, lch, wm, wn, fr, fq);
        int fr2 = fr, fq2 = fq, wm2 = wm, wn2 = wn;
        asm volatile("" : "+v"(fr2), "+v"(fq2), "+v"(wm2), "+v"(wn2));
        epi(acc, m0, n0, wm2, wn2, fr2, fq2);
    }
}

__device__ void ph_prep_even(const P& p, int j) {
    const float* cw = p.ev_conv_w + (size_t)j * 3 * 512; const float* cb = p.ev_conv_b + (size_t)j * 512;
    const size_t tot = (size_t)NT * 256;
    for (size_t i = (size_t)blockIdx.x * 256 + otid(); i < tot; i += (size_t)gridDim.x * 256) {
        const int r = (int)(i >> 8), c = (int)(i & 255) * 2;
        int t, T; if (r < NL) { t = r & 2047; T = 2048; } else { t = (r - NL) & 255; T = 256; }
        const unsigned x1 = *(const unsigned*)(p.PB + (size_t)r * 1536 + c);
        float v0 = cb[c] + bf_lo(x1) * cw[512 + c], v1 = cb[c + 1] + bf_hi(x1) * cw[512 + c + 1];
        if (t > 0) { const unsigned x0 = *(const unsigned*)(p.PB + (size_t)(r - 1) * 1536 + c); v0 += bf_lo(x0) * cw[c]; v1 += bf_hi(x0) * cw[c + 1]; }
        if (t < T - 1) { const unsigned x2 = *(const unsigned*)(p.PB + (size_t)(r + 1) * 1536 + c); v0 += bf_lo(x2) * cw[1024 + c]; v1 += bf_hi(x2) * cw[1024 + c + 1]; }
        v0 = silu_f(v0); v1 = silu_f(v1);
        if (c >= 256) { v0 *= 0.125f; v1 *= 0.125f; }
        *(unsigned*)(p.QKB + (size_t)r * 512 + c) = cvt_pk_bf16(v0, v1);
    }
}

#define FA_KROW 144
#define FA_VROW 136
__device__ __forceinline__ bf16x8 pack8(float a0, float a1, float a2, float a3, float a4, float a5, float a6, float a7) {
    const u32x4 u = (u32x4){cvt_pk_bf16(a0, a1), cvt_pk_bf16(a2, a3), cvt_pk_bf16(a4, a5), cvt_pk_bf16(a6, a7)};
    return __builtin_bit_cast(bf16x8, u);
}
template <int NDB, bool MASK>
__device__ __forceinline__ void flash_tile(const bf16x8 (&qf)[4], f32x16 (&o)[NDB], float& m, float& l, const char* Kl, const char* Vl, int lane, int qpos, int kp0) {
    const int j = lane & 31, h = lane >> 5;
    f32x16 s0, s1;
#pragma unroll
    for (int i = 0; i < 16; ++i) { s0[i] = 0.f; s1[i] = 0.f; }
#pragma unroll
    for (int ks = 0; ks < 4; ++ks) {
        const bf16x8 a0 = *(const bf16x8*)(Kl + j * FA_KROW + (2 * ks + h) * 16);
        const bf16x8 a1 = *(const bf16x8*)(Kl + (32 + j) * FA_KROW + (2 * ks + h) * 16);
        s0 = __builtin_amdgcn_mfma_f32_32x32x16_bf16(a0, qf[ks], s0, 0, 0, 0);
        s1 = __builtin_amdgcn_mfma_f32_32x32x16_bf16(a1, qf[ks], s1, 0, 0, 0);
    }
    if (MASK) {
#pragma unroll
        for (int r = 0; r < 16; ++r) {
            const int key = (r & 3) + 8 * (r >> 2) + 4 * h;
            const int d0 = qpos - (kp0 + key), d1 = d0 - 32;
            if (d0 > 128 || d0 < -128) s0[r] = -1e30f;
            if (d1 > 128 || d1 < -128) s1[r] = -1e30f;
        }
    }
    float mx = fmaxf(s0[0], s1[0]);
#pragma unroll
    for (int r = 1; r < 16; ++r) mx = fmaxf(mx, fmaxf(s0[r], s1[r]));
    mx = fmaxf(mx, SHX(mx, 32));
    const float mn = fmaxf(m, mx);
    const float alpha = __builtin_amdgcn_exp2f(m - mn);
    m = mn;
    float ls = 0.f;
#pragma unroll
    for (int r = 0; r < 16; ++r) { s0[r] = __builtin_amdgcn_exp2f(s0[r] - mn); s1[r] = __builtin_amdgcn_exp2f(s1[r] - mn); ls += s0[r] + s1[r]; }
    l = l * alpha + ls;
#pragma unroll
    for (int db = 0; db < NDB; ++db) o[db] = o[db] * alpha;
    bf16x8 pb[4];
    pb[0] = pack8(s0[0], s0[1], s0[2], s0[3], s0[4], s0[5], s0[6], s0[7]);
    pb[1] = pack8(s0[8], s0[9], s0[10], s0[11], s0[12], s0[13], s0[14], s0[15]);
    pb[2] = pack8(s1[0], s1[1], s1[2], s1[3], s1[4], s1[5], s1[6], s1[7]);
    pb[3] = pack8(s1[8], s1[9], s1[10], s1[11], s1[12], s1[13], s1[14], s1[15]);
#pragma unroll
    for (int db = 0; db < NDB; ++db)
#pragma unroll
        for (int kk = 0; kk < 4; ++kk) {
            const char* vp = Vl + (db * 32 + j) * FA_VROW + (kk * 16 + 4 * h) * 2;
            const uint2 lo = *(const uint2*)vp, hi = *(const uint2*)(vp + 16);
            const u32x4 u = (u32x4){lo.x, lo.y, hi.x, hi.y};
            o[db] = __builtin_amdgcn_mfma_f32_32x32x16_bf16(__builtin_bit_cast(bf16x8, u), pb[kk], o[db], 0, 0, 0);
        }
}

#define DA_BUFB 35840
__device__ void da_block(const P& p, int item, int L, int j, char* smem) {
    const int tid = otid(), lane = tid & 63, wid = tid >> 6, mp = wid & 1, qg = wid >> 1, jq = lane & 31, hh = lane >> 5;
    const bool lat = item < 1024;
    int b, h, qt;
    if (lat) { b = item >> 7; h = (item >> 5) & 3; qt = item & 31; } else { const int it = item - 1024; b = it >> 4; h = (it >> 2) & 3; qt = it & 3; }
    const int qi = qt * 64 + qg * 32 + jq;
    const bf16_t* qp = lat ? p.AQL + ((size_t)((b * 4 + h) * 2 + mp) * 2048 + qi) * 64 : p.AQC + ((size_t)((b * 4 + h) * 2 + mp) * 256 + qi) * 64;
    bf16x8 qf[4];
#pragma unroll
    for (int ks = 0; ks < 4; ++ks) qf[ks] = *(const bf16x8*)(qp + (2 * ks + hh) * 8);
    const int ntile = lat ? 36 : 4;
    const bf16_t* kg = p.AK + (size_t)((b * 4 + h) * 2) * 2304 * 64 + (size_t)(tid >> 3) * 64 + (tid & 7) * 8;
    const bf16_t* vg = p.AV + (size_t)(b * 4 + h) * 128 * 2304 + (size_t)(tid >> 3) * 2304 + (tid & 7) * 8;
    uint4 k0, k1, k2, k3, v0, v1, v2, v3;
#define DA_LOAD(KEY0) { k0 = *(const uint4*)(kg + (size_t)(KEY0) * 64); k1 = *(const uint4*)(kg + (size_t)((KEY0) + 32) * 64); \
                        k2 = *(const uint4*)(kg + (size_t)2304 * 64 + (size_t)(KEY0) * 64); k3 = *(const uint4*)(kg + (size_t)2304 * 64 + (size_t)((KEY0) + 32) * 64); \
                        v0 = *(const uint4*)(vg + (KEY0)); v1 = *(const uint4*)(vg + (size_t)32 * 2304 + (KEY0)); v2 = *(const uint4*)(vg + (size_t)64 * 2304 + (KEY0)); v3 = *(const uint4*)(vg + (size_t)96 * 2304 + (KEY0)); }
#define DA_STORE(BUF) { char* kb_ = (BUF) + (tid >> 3) * FA_KROW + (tid & 7) * 16; \
                        *(uint4*)kb_ = k0; *(uint4*)(kb_ + 32 * FA_KROW) = k1; *(uint4*)(kb_ + 64 * FA_KROW) = k2; *(uint4*)(kb_ + 96 * FA_KROW) = k3; \
                        char* vb_ = (BUF) + 18432 + (tid >> 3) * FA_VROW + (tid & 7) * 16; \
                        *(uint2*)vb_ = make_uint2(v0.x, v0.y); *(uint2*)(vb_ + 8) = make_uint2(v0.z, v0.w); \
                        *(uint2*)(vb_ + 32 * FA_VROW) = make_uint2(v1.x, v1.y); *(uint2*)(vb_ + 32 * FA_VROW + 8) = make_uint2(v1.z, v1.w); \
                        *(uint2*)(vb_ + 64 * FA_VROW) = make_uint2(v2.x, v2.y); *(uint2*)(vb_ + 64 * FA_VROW + 8) = make_uint2(v2.z, v2.w); \
                        *(uint2*)(vb_ + 96 * FA_VROW) = make_uint2(v3.x, v3.y); *(uint2*)(vb_ + 96 * FA_VROW + 8) = make_uint2(v3.z, v3.w); }
    f32x16 o[4];
#pragma unroll
    for (int db = 0; db < 4; ++db)
#pragma unroll
        for (int i = 0; i < 16; ++i) o[db][i] = 0.f;
    float m = -1e30f, l = 0.f;
    DA_LOAD(0)
    __syncthreads();
    DA_STORE(smem)
    __syncthreads();
    for (int t = 0; t < ntile; ++t) {
        char* cur = smem + (t & 1) * DA_BUFB;
        char* nxt = smem + ((t + 1) & 1) * DA_BUFB;
        if (t + 1 < ntile) DA_LOAD((t + 1) * 64)
        flash_tile<4, false>(qf, o, m, l, cur + mp * 9216, cur + 18432, lane, 0, 0);
        if (t + 1 < ntile) DA_STORE(nxt)
        __syncthreads();
    }
#undef DA_LOAD
#undef DA_STORE
    const float inv = 1.f / (l + SHX(l, 32));
#pragma unroll
    for (int db = 0; db < 4; ++db) o[db] = o[db] * inv;
    float* X = (float*)smem + qg * 4096;
    if (mp == 1) {
#pragma unroll
        for (int db = 0; db < 4; ++db)
#pragma unroll
            for (int r = 0; r < 16; ++r) X[(db * 32 + (r & 3) + 8 * (r >> 2) + 4 * hh) * 32 + jq] = o[db][r];
    }
    __syncthreads();
    if (mp == 0) {
        const float lam_init = 0.8f - 0.6f * expf(-0.3f * (float)L);
        const float* lp = p.ev_da_lam + (size_t)j * 256;
        float a0 = lp[lane] * lp[64 + lane], a1 = lp[128 + lane] * lp[192 + lane];
        a0 = wave_sum(a0); a1 = wave_sum(a1);
        const float lam = expf(a0) - expf(a1) + lam_init;
        float ss = 0.f;
#pragma unroll
        for (int db = 0; db < 4; ++db)
#pragma unroll
            for (int r = 0; r < 16; ++r) { const float v = o[db][r] - lam * X[(db * 32 + (r & 3) + 8 * (r >> 2) + 4 * hh) * 32 + jq]; o[db][r] = v; ss += v * v; }
        ss += SHX(ss, 32);
        const float sc = rsqrtf(ss * (1.f / 128.f) + 1e-6f) * (1.f - lam_init);
        const int row = lat ? b * 2048 + qi : NL + b * 256 + qi;
        bf16_t* mrow = p.MIX + (size_t)row * DM + 512 + h * 128;
        const float* g = p.ev_da_g + (size_t)j * 512 + h * 128;
#pragma unroll
        for (int db = 0; db < 4; ++db)
#pragma unroll
            for (int r4 = 0; r4 < 4; ++r4) {
                const int d = db * 32 + 8 * r4 + 4 * hh;
                const f32x4 gg = *(const f32x4*)(g + d);
                *(uint2*)(mrow + d) = make_uint2(cvt_pk_bf16(o[db][r4 * 4 + 0] * sc * gg[0], o[db][r4 * 4 + 1] * sc * gg[1]), cvt_pk_bf16(o[db][r4 * 4 + 2] * sc * gg[2], o[db][r4 * 4 + 3] * sc * gg[3]));
            }
    }
    __syncthreads();
}

#define WA_BUFB 17920
__device__ void wa_block(const P& p, int item, int j, char* smem) {
    const int tid = otid(), lane = tid & 63, wid = tid >> 6, jq = lane & 31, hh = lane >> 5;
    const bool lat = item < 2048;
    int b, nb, hq;
    if (lat) { hq = item & 15; nb = (item >> 4) & 15; b = item >> 8; } else { const int it = item - 2048; hq = it & 15; nb = (it >> 4) & 1; b = it >> 5; }
    const int hkv = hq >> 2;
    const int qi = nb * 128 + wid * 32 + jq;
    const bf16_t* qp = lat ? p.AQL + ((size_t)(b * 16 + hq) * 2048 + qi) * 64 : p.AQC + ((size_t)(b * 16 + hq) * 256 + qi) * 64;
    bf16x8 qf[4];
#pragma unroll
    for (int ks = 0; ks < 4; ++ks) qf[ks] = *(const bf16x8*)(qp + (2 * ks + hh) * 8);
    const int lfirst = (nb == 0) ? 2 : 0, nloc = lat ? 6 - lfirst - ((nb == 15) ? 2 : 0) : 0;
    const int ntile = 4 + nloc;
    const bf16_t* kg = p.AK + (size_t)(b * 4 + hkv) * 2304 * 64 + (size_t)(tid >> 3) * 64 + (tid & 7) * 8;
    const bf16_t* vg = p.AV + (size_t)(b * 4 + hkv) * 64 * 2304 + (size_t)(tid >> 3) * 2304 + (tid & 7) * 8;
    uint4 k0, k1, v0, v1;
#define WA_KEY0(T) ((T) < 4 ? (T) * 64 : 256 + (nb - 1) * 128 + ((T) - 4 + lfirst) * 64)
#define WA_LOAD(KEY0) { k0 = *(const uint4*)(kg + (size_t)(KEY0) * 64); k1 = *(const uint4*)(kg + (size_t)((KEY0) + 32) * 64); v0 = *(const uint4*)(vg + (KEY0)); v1 = *(const uint4*)(vg + (size_t)32 * 2304 + (KEY0)); }
#define WA_STORE(BUF) { char* kb_ = (BUF) + (tid >> 3) * FA_KROW + (tid & 7) * 16; *(uint4*)kb_ = k0; *(uint4*)(kb_ + 32 * FA_KROW) = k1; \
                        char* vb_ = (BUF) + 9216 + (tid >> 3) * FA_VROW + (tid & 7) * 16; \
                        *(uint2*)vb_ = make_uint2(v0.x, v0.y); *(uint2*)(vb_ + 8) = make_uint2(v0.z, v0.w); \
                        *(uint2*)(vb_ + 32 * FA_VROW) = make_uint2(v1.x, v1.y); *(uint2*)(vb_ + 32 * FA_VROW + 8) = make_uint2(v1.z, v1.w); }
    f32x16 o[2];
#pragma unroll
    for (int db = 0; db < 2; ++db)
#pragma unroll
        for (int i = 0; i < 16; ++i) o[db][i] = 0.f;
    float m = p.od_sink[j * 16 + hq] * 1.4426950408889634f, l = hh == 0 ? 1.f : 0.f;
    { const int key0 = WA_KEY0(0); WA_LOAD(key0) }
    __syncthreads();
    WA_STORE(smem)
    __syncthreads();
    for (int t = 0; t < ntile; ++t) {
        char* cur = smem + (t & 1) * WA_BUFB;
        char* nxt = smem + ((t + 1) & 1) * WA_BUFB;
        if (t + 1 < ntile) { const int key0 = WA_KEY0(t + 1); WA_LOAD(key0) }
        if (t < 4) flash_tile<2, false>(qf, o, m, l, cur, cur + 9216, lane, 0, 0);
        else flash_tile<2, true>(qf, o, m, l, cur, cur + 9216, lane, qi, WA_KEY0(t) - 256);
        if (t + 1 < ntile) WA_STORE(nxt)
        __syncthreads();
    }
#undef WA_LOAD
#undef WA_STORE
#undef WA_KEY0
    const float inv = 1.f / (l + SHX(l, 32));
    const int row = lat ? b * 2048 + qi : NL + b * 256 + qi;
    bf16_t* mrow = p.MIX + (size_t)row * DM + hq * 64;
#pragma unroll
    for (int db = 0; db < 2; ++db)
#pragma unroll
        for (int r4 = 0; r4 < 4; ++r4) {
            const int d = db * 32 + 8 * r4 + 4 * hh;
            *(uint2*)(mrow + d) = make_uint2(cvt_pk_bf16(o[db][r4 * 4 + 0] * inv, o[db][r4 * 4 + 1] * inv), cvt_pk_bf16(o[db][r4 * 4 + 2] * inv, o[db][r4 * 4 + 3] * inv));
        }
}

__device__ __forceinline__ uint4 ml_conv8(const P& p, int j, int b, int tc, int st, int c0) {
    const int row = tc < 4 ? NL + b * 256 + tc * 64 + st : b * 2048 + (tc - 4) * 64 + st;
    const int t = tc < 4 ? tc * 64 + st : (tc - 4) * 64 + st, T = tc < 4 ? 256 : 2048;
    const float* cw = p.ev_conv_w + (size_t)j * 3 * 512 + c0; const float* cb = p.ev_conv_b + (size_t)j * 512 + c0;
    const uint4 x1 = *(const uint4*)(p.PB + (size_t)row * 1536 + c0);
    uint4 x0 = make_uint4(0u, 0u, 0u, 0u), x2 = x0;
    if (t > 0) x0 = *(const uint4*)(p.PB + (size_t)(row - 1) * 1536 + c0);
    if (t < T - 1) x2 = *(const uint4*)(p.PB + (size_t)(row + 1) * 1536 + c0);
    float a[8], bq[8], cq[8]; unpack8(x0, a); unpack8(x1, bq); unpack8(x2, cq);
    const float sc = c0 >= 256 ? 0.125f : 1.f;
    float o[8];
#pragma unroll
    for (int q = 0; q < 8; ++q) o[q] = silu_f(cb[q] + a[q] * cw[q] + bq[q] * cw[512 + q] + cq[q] * cw[1024 + q]) * sc;
    return make_uint4(cvt_pk_bf16(o[0], o[1]), cvt_pk_bf16(o[2], o[3]), cvt_pk_bf16(o[4], o[5]), cvt_pk_bf16(o[6], o[7]));
}
__device__ __forceinline__ int ml_row(int b, int tc, int i) { return tc < 4 ? NL + b * 256 + tc * 64 + i : b * 2048 + (tc - 4) * 64 + i; }
__device__ __forceinline__ void ml_gates(const P& p, int j, int b, int h, int dir, int tc, int lane, float* sa, float* sb, float* sml, float& Bt, float& Mc) {
    const int row = ml_row(b, tc, lane);
    const float ig = p.GT[(size_t)row * 16 + (dir * 2) * 4 + h] + p.ev_gate_b[j * 16 + (dir * 2) * 4 + h];
    const float lf = log_sigmoid_f(p.GT[(size_t)row * 16 + (dir * 2 + 1) * 4 + h] + p.ev_gate_b[j * 16 + (dir * 2 + 1) * 4 + h]);
    float bc = lf;
    if (dir == 0) {
#pragma unroll
        for (int o = 1; o < 64; o <<= 1) { const float t2 = lshfl(bc, lane - o); if (lane >= o) bc += t2; }
    } else {
#pragma unroll
        for (int o = 1; o < 64; o <<= 1) { const float t2 = lshfl(bc, lane + o); if (lane + o < 64) bc += t2; }
    }
    const float a = ig - bc;
    float ml = a;
    if (dir == 0) {
#pragma unroll
        for (int o = 1; o < 64; o <<= 1) { const float t2 = lshfl(ml, lane - o); if (lane >= o) ml = fmaxf(ml, t2); }
    } else {
#pragma unroll
        for (int o = 1; o < 64; o <<= 1) { const float t2 = lshfl(ml, lane + o); if (lane + o < 64) ml = fmaxf(ml, t2); }
    }
    sa[lane] = a; sb[lane] = bc; sml[lane] = ml;
    const int last = dir == 0 ? 63 : 0;
    Bt = lshfl(bc, last); Mc = lshfl(ml, last);
}
__device__ __forceinline__ int ml_tc_of(int dir, int c) { return dir == 0 ? c : (c < 4 ? 3 - c : 39 - c); }
__device__ __forceinline__ int ml_c_of(int dir, int tc) { return dir == 0 ? tc : (tc < 4 ? 3 - tc : 39 - tc); }

__device__ void ml_pass1_item(const P& p, int item, int j, char* smem) {
    const int c = item % 36, dir = (item / 36) & 1, h = (item / 72) & 3, b = item / 288;
    const int tc = ml_tc_of(dir, c);
    const int tid = otid(), lane = tid & 63, wid = tid >> 6, jl = lane & 31, hh = lane >> 5;
    bf16_t* VT = (bf16_t*)smem;
    bf16_t* KWT = (bf16_t*)(smem + 18432);
    float* sa = (float*)(smem + 27648);
    float* sb = sa + 64; float* sml = sb + 64; float* sw = sml + 64; float* ssc = sw + 64;
    __syncthreads();
    if (wid == 0) {
        float Bt, Mc; ml_gates(p, j, b, h, dir, tc, lane, sa, sb, sml, Bt, Mc);
        sw[lane] = expf(sa[lane] - Mc);
        if (lane == 0) { p.CHB[item] = Bt; p.CHM[item] = Mc; }
    }
    __syncthreads();
#pragma unroll
    for (int i = 0; i < 4; ++i) {
        const int e = tid + 256 * i, st = e >> 4, ch = e & 15;
        const uint4 u = *(const uint4*)(p.PB + (size_t)ml_row(b, tc, st) * 1536 + 512 + h * 128 + ch * 8);
        bf16_t* d = VT + (ch * 8) * 72 + st;
        d[0] = (bf16_t)u.x; d[72] = (bf16_t)(u.x >> 16); d[144] = (bf16_t)u.y; d[216] = (bf16_t)(u.y >> 16);
        d[288] = (bf16_t)u.z; d[360] = (bf16_t)(u.z >> 16); d[432] = (bf16_t)u.w; d[504] = (bf16_t)(u.w >> 16);
    }
#pragma unroll
    for (int i = 0; i < 2; ++i) {
        const int e = tid + 256 * i, st = e >> 3, ch = e & 7;
        const uint4 u = ml_conv8(p, j, b, tc, st, 256 + h * 64 + ch * 8);
        const float w = sw[st];
        bf16_t* d = KWT + (ch * 8) * 72 + st;
        const unsigned q0 = cvt_pk_bf16(bf_lo(u.x) * w, bf_hi(u.x) * w), q1 = cvt_pk_bf16(bf_lo(u.y) * w, bf_hi(u.y) * w), q2 = cvt_pk_bf16(bf_lo(u.z) * w, bf_hi(u.z) * w), q3 = cvt_pk_bf16(bf_lo(u.w) * w, bf_hi(u.w) * w);
        d[0] = (bf16_t)q0; d[72] = (bf16_t)(q0 >> 16); d[144] = (bf16_t)q1; d[216] = (bf16_t)(q1 >> 16);
        d[288] = (bf16_t)q2; d[360] = (bf16_t)(q2 >> 16); d[432] = (bf16_t)q3; d[504] = (bf16_t)(q3 >> 16);
    }
    __syncthreads();
    {
        const int db = wid & 1, vb0 = (wid >> 1) * 2;
        bf16x8 kf[4];
#pragma unroll
        for (int ks = 0; ks < 4; ++ks) kf[ks] = *(const bf16x8*)((const char*)KWT + (db * 32 + jl) * 144 + (2 * ks + hh) * 16);
        float* cl = p.CLOC + (size_t)item * 8192;
#pragma unroll
        for (int vv = 0; vv < 2; ++vv) {
            const int vb = vb0 + vv;
            f32x16 acc;
#pragma unroll
            for (int r = 0; r < 16; ++r) acc[r] = 0.f;
#pragma unroll
            for (int ks = 0; ks < 4; ++ks) {
                const bf16x8 vf = *(const bf16x8*)((const char*)VT + (vb * 32 + jl) * 144 + (2 * ks + hh) * 16);
                acc = __builtin_amdgcn_mfma_f32_32x32x16_bf16(vf, kf[ks], acc, 0, 0, 0);
            }
#pragma unroll
            for (int r = 0; r < 16; ++r) cl[(size_t)(vb * 32 + (r & 3) + 8 * (r >> 2) + 4 * hh) * 64 + db * 32 + jl] = acc[r];
        }
        if (tid < 64) {
            float sum = 0.f;
#pragma unroll
            for (int q = 0; q < 8; ++q) { const uint4 u = *(const uint4*)((const char*)KWT + tid * 144 + q * 16); sum += bf_lo(u.x) + bf_hi(u.x) + bf_lo(u.y) + bf_hi(u.y) + bf_lo(u.z) + bf_hi(u.z) + bf_lo(u.w) + bf_hi(u.w); }
            p.NLOC[(size_t)item * 64 + tid] = sum;
        }
    }
}

__device__ void ph_ml_pass2(const P& p) {
    const int gt = blockIdx.x * 256 + otid(), nthr = gridDim.x * 256;
    for (int w = gt; w < 64 * 2048; w += nthr) {
        const int chain = w >> 11, e = (w & 2047) * 4;
        float c0 = 0.f, c1 = 0.f, c2 = 0.f, c3 = 0.f, m = 0.f;
        for (int c = 0; c < 36; ++c) {
            const int it = chain * 36 + c;
            *(uint2*)(p.CST + (size_t)it * 8192 + e) = make_uint2(cvt_pk_bf16(c0, c1), cvt_pk_bf16(c2, c3));
            const float Bt = p.CHB[it], Mc = p.CHM[it];
            const float g = fmaxf(m, Mc), al = expf(m - g), be = expf(Mc - g);
            const float4 cl = *(const float4*)(p.CLOC + (size_t)it * 8192 + e);
            c0 = al * c0 + be * cl.x; c1 = al * c1 + be * cl.y; c2 = al * c2 + be * cl.z; c3 = al * c3 + be * cl.w;
            m = Bt + g;
        }
    }
    for (int w = gt; w < 64 * 64; w += nthr) {
        const int chain = w >> 6, d = w & 63;
        float n = 0.f, m = 0.f;
        for (int c = 0; c < 36; ++c) {
            const int it = chain * 36 + c;
            p.NST[(size_t)it * 64 + d] = n;
            if (d == 0) p.MST[it] = m;
            const float Bt = p.CHB[it], Mc = p.CHM[it];
            const float g = fmaxf(m, Mc);
            n = expf(m - g) * n + expf(Mc - g) * p.NLOC[(size_t)it * 64 + d];
            m = Bt + g;
        }
    }
}

__device__ void ml_pass3_item(const P& p, int item, int j, char* smem) {
    const int tc = item % 36, h = (item / 36) & 3, b = item / 144;
    const int tid = otid(), lane = tid & 63, wid = tid >> 6, jl = lane & 31, hh = lane >> 5, tb = wid & 1, dir = wid >> 1;
    char* Ql = smem;
    char* Kl = smem + 9216;
    bf16_t* VT = (bf16_t*)(smem + 18432);
    float* gs = (float*)(smem + 35840);
    float* ssc = gs + 512;
    __syncthreads();
    if (wid < 2) {
        const int d2 = wid; float Bt, Mc;
        float* sa = gs + d2 * 256; float* sb = sa + 64; float* sg = sb + 64; float* sn = sg + 64;
        ml_gates(p, j, b, h, d2, tc, lane, sa, sb, sg, Bt, Mc);
        const int sidx = ((b * 4 + h) * 2 + d2) * 36 + ml_c_of(d2, tc);
        const float mst = p.MST[sidx];
        sg[lane] = fmaxf(mst, sg[lane]);
        sn[lane] = p.NST[(size_t)sidx * 64 + lane];
        if (lane == 0) ssc[d2] = mst;
    }
#pragma unroll
    for (int i = 0; i < 2; ++i) {
        const int e = tid + 256 * i, st = e >> 3, ch = e & 7; const int row = ml_row(b, tc, st);
        *(uint4*)(Ql + st * 144 + ch * 16) = ml_conv8(p, j, b, tc, st, h * 64 + ch * 8);
        *(uint4*)(Kl + st * 144 + ch * 16) = ml_conv8(p, j, b, tc, st, 256 + h * 64 + ch * 8);
    }
#pragma unroll
    for (int i = 0; i < 4; ++i) {
        const int e = tid + 256 * i, st = e >> 4, ch = e & 15;
        const uint4 u = *(const uint4*)(p.PB + (size_t)ml_row(b, tc, st) * 1536 + 512 + h * 128 + ch * 8);
        bf16_t* d = VT + (ch * 8) * 68 + st;
        d[0] = (bf16_t)u.x; d[68] = (bf16_t)(u.x >> 16); d[136] = (bf16_t)u.y; d[204] = (bf16_t)(u.y >> 16);
        d[272] = (bf16_t)u.z; d[340] = (bf16_t)(u.z >> 16); d[408] = (bf16_t)u.w; d[476] = (bf16_t)(u.w >> 16);
    }
    __syncthreads();
    const float* sa = gs + dir * 256; const float* sb = sa + 64; const float* sg = sb + 64; const float* sn = sg + 64;
    const int t = tb * 32 + jl;
    const float gtv = sg[t], btv = sb[t], mst = ssc[dir];
    const float e2 = expf(mst - gtv);
    const int sidx = ((b * 4 + h) * 2 + dir) * 36 + ml_c_of(dir, tc);
    bf16x8 qf[4];
#pragma unroll
    for (int ks = 0; ks < 4; ++ks) qf[ks] = *(const bf16x8*)(Ql + t * 144 + (2 * ks + hh) * 16);
    f32x16 acc[4];
    {
        const bf16_t* cst = p.CST + (size_t)sidx * 8192 + (size_t)jl * 64 + hh * 8;
#pragma unroll
        for (int vb = 0; vb < 4; ++vb) {
#pragma unroll
            for (int r = 0; r < 16; ++r) acc[vb][r] = 0.f;
#pragma unroll
            for (int ks = 0; ks < 4; ++ks) {
                const bf16x8 cf = *(const bf16x8*)(cst + (size_t)vb * 32 * 64 + ks * 16);
                acc[vb] = __builtin_amdgcn_mfma_f32_32x32x16_bf16(cf, qf[ks], acc[vb], 0, 0, 0);
            }
            acc[vb] = acc[vb] * e2;
        }
    }
    float den = 0.f;
    {
        float nq = 0.f;
#pragma unroll
        for (int ks = 0; ks < 4; ++ks) {
            const u32x4 u = __builtin_bit_cast(u32x4, qf[ks]);
            const float* np = sn + 16 * ks + 8 * hh;
            nq += bf_lo(u[0]) * np[0] + bf_hi(u[0]) * np[1] + bf_lo(u[1]) * np[2] + bf_hi(u[1]) * np[3] + bf_lo(u[2]) * np[4] + bf_hi(u[2]) * np[5] + bf_lo(u[3]) * np[6] + bf_hi(u[3]) * np[7];
        }
        den = e2 * nq;
    }
#pragma unroll
    for (int sbk = 0; sbk < 2; ++sbk) {
        const bool use = dir == 0 ? (sbk <= tb) : (sbk >= tb);
        if (use) {
            f32x16 sc;
#pragma unroll
            for (int r = 0; r < 16; ++r) sc[r] = 0.f;
#pragma unroll
            for (int ks = 0; ks < 4; ++ks) {
                const bf16x8 kf = *(const bf16x8*)(Kl + (sbk * 32 + jl) * 144 + (2 * ks + hh) * 16);
                sc = __builtin_amdgcn_mfma_f32_32x32x16_bf16(kf, qf[ks], sc, 0, 0, 0);
            }
#pragma unroll
            for (int r4 = 0; r4 < 4; ++r4) {
                const int s0 = sbk * 32 + 8 * r4 + 4 * hh;
                const f32x4 av = *(const f32x4*)(sa + s0);
#pragma unroll
                for (int q = 0; q < 4; ++q) {
                    const int s2 = s0 + q;
                    const bool ok = dir == 0 ? (s2 <= t) : (s2 >= t);
                    const float pv = ok ? sc[r4 * 4 + q] * expf(av[q] - gtv) : 0.f;
                    sc[r4 * 4 + q] = pv; den += pv;
                }
            }
            bf16x8 pb[2];
            pb[0] = pack8(sc[0], sc[1], sc[2], sc[3], sc[4], sc[5], sc[6], sc[7]);
            pb[1] = pack8(sc[8], sc[9], sc[10], sc[11], sc[12], sc[13], sc[14], sc[15]);
#pragma unroll
            for (int vb = 0; vb < 4; ++vb)
#pragma unroll
                for (int k2 = 0; k2 < 2; ++k2) {
                    const char* vp = (const char*)VT + (vb * 32 + jl) * 136 + (sbk * 32 + k2 * 16 + 4 * hh) * 2;
                    const uint2 lo = *(const uint2*)vp, hi = *(const uint2*)(vp + 16);
                    const u32x4 u = (u32x4){lo.x, lo.y, hi.x, hi.y};
                    acc[vb] = __builtin_amdgcn_mfma_f32_32x32x16_bf16(__builtin_bit_cast(bf16x8, u), pb[k2], acc[vb], 0, 0, 0);
                }
        }
    }
    den += SHX(den, 32);
    const float scl = 1.f / fmaxf(fabsf(den), expf(-(btv + gtv)));
#pragma unroll
    for (int vb = 0; vb < 4; ++vb) acc[vb] = acc[vb] * scl;
    __syncthreads();
    float* X = (float*)smem + tb * 4096;
    if (dir == 1) {
#pragma unroll
        for (int vb = 0; vb < 4; ++vb)
#pragma unroll
            for (int r = 0; r < 16; ++r) X[(vb * 32 + (r & 3) + 8 * (r >> 2) + 4 * hh) * 32 + jl] = acc[vb][r];
    }
    __syncthreads();
    if (dir == 0) {
        float ss = 0.f;
#pragma unroll
        for (int vb = 0; vb < 4; ++vb)
#pragma unroll
            for (int r = 0; r < 16; ++r) { const float v = acc[vb][r] + X[(vb * 32 + (r & 3) + 8 * (r >> 2) + 4 * hh) * 32 + jl]; acc[vb][r] = v; ss += v * v; }
        ss += SHX(ss, 32);
        const float rstd = rsqrtf(ss * (1.f / 128.f) + 1e-6f);
        const int row = ml_row(b, tc, t);
        const float* g = p.ev_ml_g + (size_t)j * 512 + h * 128;
        const bf16_t* og = p.PB + (size_t)row * 1536 + 1024 + h * 128;
        bf16_t* mrow = p.MIX + (size_t)row * DM + h * 128;
#pragma unroll
        for (int vb = 0; vb < 4; ++vb)
#pragma unroll
            for (int r4 = 0; r4 < 4; ++r4) {
                const int v = vb * 32 + 8 * r4 + 4 * hh;
                const f32x4 gg = *(const f32x4*)(g + v);
                const uint2 ou = *(const uint2*)(og + v);
                *(uint2*)(mrow + v) = make_uint2(cvt_pk_bf16(acc[vb][r4 * 4 + 0] * rstd * gg[0] * sigmoid_f(bf_lo(ou.x)), acc[vb][r4 * 4 + 1] * rstd * gg[1] * sigmoid_f(bf_hi(ou.x))),
                                                 cvt_pk_bf16(acc[vb][r4 * 4 + 2] * rstd * gg[2] * sigmoid_f(bf_lo(ou.y)), acc[vb][r4 * 4 + 3] * rstd * gg[3] * sigmoid_f(bf_hi(ou.y))));
            }
    }
}

__device__ void ph_attn_even(const P& p, int ci, int L, int j, float* smem) {
    int* s_item = (int*)((char*)smem + 73728);
    for (;;) {
        __syncthreads();
        if (otid() == 0) *s_item = atomicAdd(&p.ctr[ci], 1);
        __syncthreads();
        const int item = *s_item;
        if (item >= 1152 + 2304) break;
        if (item < 1152) da_block(p, item, L, j, (char*)smem); else ml_pass1_item(p, item - 1152, j, (char*)smem);
    }
}
__device__ void ph_ml_pass3(const P& p, int j, float* smem) {
    for (int item = blockIdx.x; item < 1152; item += gridDim.x) ml_pass3_item(p, item, j, (char*)smem);
}
__device__ void ph_attn_odd(const P& p, int j, bool need_ctx, float* smem) {
    const int nitem = need_ctx ? 2304 : 2048;
    for (int item = blockIdx.x; item < nitem; item += gridDim.x) { wa_block(p, item, j, (char*)smem); __syncthreads(); }
}

#define SEL_LD 132
template <int NV>
__device__ __forceinline__ unsigned topk16_threshold(const unsigned (&k)[NV], unsigned start) {
    auto cnt = [&](unsigned c) { int n = 0;
#pragma unroll
        for (int i = 0; i < NV; ++i) n += __builtin_popcountll(__ballot(k[i] >= c));
        return n; };
    unsigned E = start; int n = cnt(E);
    if (n >= 16) { for (;;) { const unsigned E2 = E + 0x800000u; if (E2 < E) break; const int n2 = cnt(E2); if (n2 < 16) break; E = E2; n = n2; } }
    else { do { E -= 0x800000u; n = cnt(E); } while (n < 16); }
    unsigned T = E;
    for (int bit = 22; bit >= 0 && n != 16; --bit) { const unsigned c = T | (1u << bit); n = cnt(c); if (n >= 16) T = c; else n = 17; }
    return T;
}
__device__ __forceinline__ unsigned fkey(float f) { const unsigned u = __float_as_uint(f); return (u & 0x80000000u) ? ~u : (u | 0x80000000u); }
__device__ __forceinline__ unsigned mbcnt64(unsigned long long m) { return __builtin_amdgcn_mbcnt_hi((unsigned)(m >> 32), __builtin_amdgcn_mbcnt_lo((unsigned)m, 0u)); }
__device__ void ph_peer_select(const P& p, int L, int nrows, char* smem) {
    float* S = (float*)smem;
    const int tid = otid(), lane = tid & 63, wid = tid >> 6, fr = lane & 15, fq = lane >> 4;
    const bf16_t* KBL = p.KB + (size_t)L * 8 * 2 * 128 * 128;
    const int ntile = nrows / 32;
    bf16x8 kfr[8][4];
    int hcur = -1;
    for (int item = blockIdx.x; item < ntile * 8; item += gridDim.x) {
        const int h = item & 7, t0 = (item >> 3) * 32;
        __syncthreads();
        {
            const int pp = wid >> 1, th = wid & 1;
            const bf16_t* qp = p.QB + (size_t)(t0 + th * 16 + fr) * 2048 + h * 256 + pp * 128 + fq * 8;
            bf16x8 qf[4];
#pragma unroll
            for (int ks = 0; ks < 4; ++ks) qf[ks] = *(const bf16x8*)(qp + ks * 32);
#ifndef SEL_NOCACHE
            if (h != hcur)
#endif
            {
                const bf16_t* kp = KBL + ((size_t)(h * 2 + pp) * 128 + fr) * 128 + fq * 8;
#pragma unroll
                for (int ni = 0; ni < 8; ++ni)
#pragma unroll
                    for (int ks = 0; ks < 4; ++ks) kfr[ni][ks] = *(const bf16x8*)(kp + (size_t)ni * 16 * 128 + ks * 32);
                hcur = h;
            }
#pragma unroll
            for (int ni = 0; ni < 8; ++ni) {
                f32x4 acc = (f32x4){0.f, 0.f, 0.f, 0.f};
#pragma unroll
                for (int ks = 0; ks < 4; ++ks) acc = __builtin_amdgcn_mfma_f32_16x16x32_bf16(qf[ks], kfr[ni][ks], acc, 0, 0, 0);
#pragma unroll
                for (int j = 0; j < 4; ++j) S[(pp * 32 + th * 16 + fq * 4 + j) * SEL_LD + ni * 16 + fr] = acc[j];
            }
        }
        __syncthreads();
        for (int tt = 0; tt < 8; ++tt) {
            const int t = wid * 8 + tt, r = t0 + t;
            const float v00 = S[t * SEL_LD + lane], v01 = S[t * SEL_LD + 64 + lane], v10 = S[(32 + t) * SEL_LD + lane], v11 = S[(32 + t) * SEL_LD + 64 + lane];
            const unsigned ka0 = fkey(v00), ka1 = fkey(v01), kb0 = fkey(v10), kb1 = fkey(v11);
            const unsigned kA[2] = {ka0, ka1}, kB[2] = {kb0, kb1};
            const unsigned T0 = topk16_threshold<2>(kA, 0xBF800000u), T1 = topk16_threshold<2>(kB, 0xBF800000u);
            float* wsA = (float*)(smem + 34816 + wid * 512);
            {
                const unsigned long long g0 = __ballot(ka0 > T0), g1 = __ballot(ka1 > T0), e0 = __ballot(ka0 == T0), e1 = __ballot(ka1 == T0);
                const int need = 16 - __builtin_popcountll(g0) - __builtin_popcountll(g1);
                const int pe0 = __builtin_popcountll(e0), need1 = need - (pe0 < need ? pe0 : need);
                const bool s0 = (ka0 > T0) || (ka0 == T0 && (int)mbcnt64(e0) < need);
                const bool s1 = (ka1 > T0) || (ka1 == T0 && (int)mbcnt64(e1) < need1);
                const unsigned long long m0 = __ballot(s0), m1 = __ballot(s1);
                if (s0) { const int pos = mbcnt64(m0); wsA[pos] = v00; ((int*)wsA)[16 + pos] = lane; }
                if (s1) { const int pos = __builtin_popcountll(m0) + mbcnt64(m1); wsA[pos] = v01; ((int*)wsA)[16 + pos] = 64 + lane; }
            }
            {
                const unsigned long long g0 = __ballot(kb0 > T1), g1 = __ballot(kb1 > T1), e0 = __ballot(kb0 == T1), e1 = __ballot(kb1 == T1);
                const int need = 16 - __builtin_popcountll(g0) - __builtin_popcountll(g1);
                const int pe0 = __builtin_popcountll(e0), need1 = need - (pe0 < need ? pe0 : need);
                const bool s0 = (kb0 > T1) || (kb0 == T1 && (int)mbcnt64(e0) < need);
                const bool s1 = (kb1 > T1) || (kb1 == T1 && (int)mbcnt64(e1) < need1);
                const unsigned long long m0 = __ballot(s0), m1 = __ballot(s1);
                if (s0) { const int pos = mbcnt64(m0); wsA[32 + pos] = v10; ((int*)wsA)[48 + pos] = lane; }
                if (s1) { const int pos = __builtin_popcountll(m0) + mbcnt64(m1); wsA[32 + pos] = v11; ((int*)wsA)[48 + pos] = 64 + lane; }
            }
            __builtin_amdgcn_wave_barrier();
            float cand[4]; int cidx[4]; unsigned kc[4];
            {
                const float av = wsA[lane >> 2]; const int ai = ((int*)wsA)[16 + (lane >> 2)];
                const float4 bv = *(const float4*)(wsA + 32 + (lane & 3) * 4); const int4 bi = *(const int4*)((int*)wsA + 48 + (lane & 3) * 4);
                cand[0] = av + bv.x; cand[1] = av + bv.y; cand[2] = av + bv.z; cand[3] = av + bv.w;
                cidx[0] = ai * 128 + bi.x; cidx[1] = ai * 128 + bi.y; cidx[2] = ai * 128 + bi.z; cidx[3] = ai * 128 + bi.w;
#pragma unroll
                for (int c = 0; c < 4; ++c) kc[c] = fkey(cand[c]);
            }
            const unsigned T = topk16_threshold<4>(kc, 0xC0800000u);
            {
                int need = 16, base = 0;
#pragma unroll
                for (int c = 0; c < 4; ++c) need -= __builtin_popcountll(__ballot(kc[c] > T));
#pragma unroll
                for (int c = 0; c < 4; ++c) {
                    const unsigned long long e = __ballot(kc[c] == T);
                    const bool sel = (kc[c] > T) || (kc[c] == T && (int)mbcnt64(e) < need);
                    const int pe = __builtin_popcountll(e); need -= (pe < need ? pe : need);
                    const unsigned long long m = __ballot(sel);
                    if (sel) { const int pos = base + mbcnt64(m); wsA[64 + pos] = cand[c]; ((int*)wsA)[80 + pos] = cidx[c]; }
                    base += __builtin_popcountll(m);
                }
            }
            __builtin_amdgcn_wave_barrier();
            {
                const float cv = lane < 16 ? wsA[64 + lane] : -INFINITY;
                const float mx = wave_max(cv);
                const float ex = lane < 16 ? __builtin_amdgcn_exp2f((cv - mx) * 1.4426950408889634f) : 0.f;
                const float sum = wave_sum(ex);
                if (lane < 16) { p.GATE[(size_t)r * 128 + h * 16 + lane] = ex / sum; p.EIDX[(size_t)r * 128 + h * 16 + lane] = ((int*)wsA)[80 + lane]; }
            }
            __builtin_amdgcn_wave_barrier();
        }
    }
}


__device__ __forceinline__ int wave_sum_i(int v, int lane) {
    v += __builtin_amdgcn_update_dpp(0, v, 0xB1, 0xF, 0xF, true);
    v += __builtin_amdgcn_update_dpp(0, v, 0x4E, 0xF, 0xF, true);
    v += __builtin_amdgcn_update_dpp(0, v, 0x141, 0xF, 0xF, true);
    v += __builtin_amdgcn_update_dpp(0, v, 0x140, 0xF, 0xF, true);
    v += __builtin_amdgcn_update_dpp(0, v, 0x142, 0xA, 0xF, false);
    v += __builtin_amdgcn_update_dpp(0, v, 0x143, 0xC, 0xF, false);
    return __builtin_amdgcn_readlane(v, 63);
}
__device__ void ph_peer_gather(const P& p, int L, int nrows, float oscale) {
    const int lane = otid() & 63, wid = __builtin_amdgcn_readfirstlane(otid() >> 6);
    const unsigned char* U = p.U8 + (size_t)L * 16384 * 1024; const unsigned char* V = p.V8 + (size_t)L * 16384 * 1024;
    const float* USC = p.USC + (size_t)L * 16384; const float* VSC = p.VSC + (size_t)L * 16384;
    const float* gate2 = p.modv + (size_t)L * 9 * 6144 + 5120;
    for (int r = blockIdx.x * 4 + wid; r < nrows; r += gridDim.x * 4) {
        const int e0 = p.EIDX[(size_t)r * 128 + lane], e1 = p.EIDX[(size_t)r * 128 + 64 + lane];
        const float g0 = p.GATE[(size_t)r * 128 + lane], g1 = p.GATE[(size_t)r * 128 + 64 + lane];
        const float us0 = USC[e0], us1 = USC[e1], vs0 = VSC[e0], vs1 = VSC[e1];
        const uint4 xq = *(const uint4*)(p.XQ + (size_t)r * DM + lane * 16);
        const float xs = p.XS[r];
        int d0 = 0, d1 = 0;
#pragma unroll
        for (int half = 0; half < 2; ++half) {
            const int ev = half ? e1 : e0;
            int dv = 0;
#pragma unroll 1
            for (int kb = 0; kb < 4; ++kb) {
                uint4 ua[16];
#pragma unroll
                for (int j = 0; j < 16; ++j) {
                    const int idx = __builtin_amdgcn_readlane(ev, kb * 16 + j);
                    ua[j] = *(const uint4*)(U + (size_t)idx * 1024 + lane * 16);
                }
#pragma unroll
                for (int j = 0; j < 16; ++j) {
                    int sdot = __builtin_amdgcn_sdot4((int)xq.x, (int)ua[j].x, 0, false);
                    sdot = __builtin_amdgcn_sdot4((int)xq.y, (int)ua[j].y, sdot, false);
                    sdot = __builtin_amdgcn_sdot4((int)xq.z, (int)ua[j].z, sdot, false);
                    sdot = __builtin_amdgcn_sdot4((int)xq.w, (int)ua[j].w, sdot, false);
                    sdot = wave_sum_i(sdot, lane);
                    if (lane == kb * 16 + j) dv = sdot;
                }
            }
            if (half) d1 = dv; else d0 = dv;
        }
        const float a0 = us0 * xs * (float)d0, a1 = us1 * xs * (float)d1;
        const float w0 = vs0 * g0 * 0.5f * a0 * (1.f + erff(a0 * 0.70710678118654752f));
        const float w1 = vs1 * g1 * 0.5f * a1 * (1.f + erff(a1 * 0.70710678118654752f));
        const float wmax = wave_max(fmaxf(fabsf(w0), fabsf(w1)));
        const float winv = wmax > 0.f ? 127.f / wmax : 0.f;
        const int wq0 = (int)rintf(w0 * winv) & 0xff, wq1 = (int)rintf(w1 * winv) & 0xff;
        int acc[16];
#pragma unroll
        for (int c = 0; c < 16; ++c) acc[c] = 0;
#pragma unroll
        for (int half = 0; half < 2; ++half) {
            const int ev = half ? e1 : e0; const int wqv = half ? wq1 : wq0;
#pragma unroll 1
            for (int kb = 0; kb < 4; ++kb) {
                uint4 ua[16];
#pragma unroll
                for (int j = 0; j < 16; ++j) {
                    const int idx = __builtin_amdgcn_readlane(ev, kb * 16 + j);
                    ua[j] = *(const uint4*)(V + (size_t)idx * 1024 + lane * 16);
                }
#pragma unroll
                for (int j4 = 0; j4 < 4; ++j4) {
                    const int k0 = kb * 16 + j4 * 4;
                    const int wpk = __builtin_amdgcn_readlane(wqv, k0) | (__builtin_amdgcn_readlane(wqv, k0 + 1) << 8) | (__builtin_amdgcn_readlane(wqv, k0 + 2) << 16) | (__builtin_amdgcn_readlane(wqv, k0 + 3) << 24);
#define TR_DOT(D, M) { const unsigned ablo = __builtin_amdgcn_perm(ua[j4 * 4 + 1].M, ua[j4 * 4].M, 0x05010400u), abhi = __builtin_amdgcn_perm(ua[j4 * 4 + 1].M, ua[j4 * 4].M, 0x07030602u); \
                        const unsigned celo = __builtin_amdgcn_perm(ua[j4 * 4 + 3].M, ua[j4 * 4 + 2].M, 0x05010400u), cehi = __builtin_amdgcn_perm(ua[j4 * 4 + 3].M, ua[j4 * 4 + 2].M, 0x07030602u); \
                        acc[(D) * 4 + 0] = __builtin_amdgcn_sdot4((int)__builtin_amdgcn_perm(celo, ablo, 0x05040100u), wpk, acc[(D) * 4 + 0], false); \
                        acc[(D) * 4 + 1] = __builtin_amdgcn_sdot4((int)__builtin_amdgcn_perm(celo, ablo, 0x07060302u), wpk, acc[(D) * 4 + 1], false); \
                        acc[(D) * 4 + 2] = __builtin_amdgcn_sdot4((int)__builtin_amdgcn_perm(cehi, abhi, 0x05040100u), wpk, acc[(D) * 4 + 2], false); \
                        acc[(D) * 4 + 3] = __builtin_amdgcn_sdot4((int)__builtin_amdgcn_perm(cehi, abhi, 0x07060302u), wpk, acc[(D) * 4 + 3], false); }
                    TR_DOT(0, x) TR_DOT(1, y) TR_DOT(2, z) TR_DOT(3, w)
#undef TR_DOT
                }
            }
        }
        const float osc = oscale * wmax * (1.f / 127.f);
        const float* gp = gate2 + (size_t)modrow(r) * 6144 + lane * 16;
        float* hp = p.H + (size_t)r * DM + lane * 16;
        float hn[16]; float ss = 0.f;
#pragma unroll
        for (int q = 0; q < 4; ++q) {
            const float4 g = *(const float4*)(gp + q * 4);
            float4 hv = *(float4*)(hp + q * 4);
            hv.x += osc * g.x * (float)acc[q * 4 + 0]; hv.y += osc * g.y * (float)acc[q * 4 + 1];
            hv.z += osc * g.z * (float)acc[q * 4 + 2]; hv.w += osc * g.w * (float)acc[q * 4 + 3];
            if (L < 3) *(float4*)(hp + q * 4) = hv;
            hn[q * 4 + 0] = hv.x; hn[q * 4 + 1] = hv.y; hn[q * 4 + 2] = hv.z; hn[q * 4 + 3] = hv.w;
            ss += hv.x * hv.x + hv.y * hv.y + hv.z * hv.z + hv.w * hv.w;
        }
        ss = wave_sum(ss);
        const float rstd = rsqrtf(ss * (1.0f / DM) + 1e-6f);
        if (L < 3) {
            const float* g1 = p.norm1_g + (size_t)(L + 1) * DM + lane * 16;
            const float* mvn = p.modv + ((size_t)(L + 1) * 9 + modrow(r)) * 6144 + lane * 16;
            unsigned w[8];
#pragma unroll
            for (int q = 0; q < 4; ++q) {
                const float4 gg = *(const float4*)(g1 + q * 4), sh = *(const float4*)(mvn + q * 4), scl = *(const float4*)(mvn + 1024 + q * 4);
                w[q * 2] = cvt_pk_bf16(hn[q * 4 + 0] * rstd * gg.x * (1.f + scl.x) + sh.x, hn[q * 4 + 1] * rstd * gg.y * (1.f + scl.y) + sh.y);
                w[q * 2 + 1] = cvt_pk_bf16(hn[q * 4 + 2] * rstd * gg.z * (1.f + scl.z) + sh.z, hn[q * 4 + 3] * rstd * gg.w * (1.f + scl.w) + sh.w);
            }
            uint4* xp = (uint4*)(p.XN + (size_t)r * DM + lane * 16);
            xp[0] = make_uint4(w[0], w[1], w[2], w[3]); xp[1] = make_uint4(w[4], w[5], w[6], w[7]);
        } else {
            const float* fg = p.final_g + lane * 16;
            float* op = p.out + (size_t)r * DM + lane * 16;
#pragma unroll
            for (int q = 0; q < 4; ++q) {
                const float4 gg = *(const float4*)(fg + q * 4);
                *(float4*)(op + q * 4) = make_float4(hn[q * 4 + 0] * rstd * gg.x, hn[q * 4 + 1] * rstd * gg.y, hn[q * 4 + 2] * rstd * gg.z, hn[q * 4 + 3] * rstd * gg.w);
            }
        }
    }
}

#define NSUB 11
__device__ __forceinline__ bool phase_empty(int ph) {
    if (ph == 0) return false;
    const int L = (ph - 1) / NSUB, s = (ph - 1) % NSUB;
    return s == 2 || ((L & 1) && (s == 4 || s == 5)) || (L > 0 && s == 0);
}
__device__ __forceinline__ void run_phase(const P& p, int ph, float* smem, int rep) {
    if (ph == 0) { ph_prologue(p, smem); return; }
    const int L = (ph - 1) / NSUB, s = (ph - 1) % NSUB, j = L >> 1;
    const bool even = (L & 1) == 0, need_ctx = L < 3;
    const int nrows = need_ctx ? NT : NL;
    const float* mv = p.modv + (size_t)L * 9 * 6144;
    switch (s) {
    case 0: ph_normmod(p.H, p.norm1_g + L * DM, mv, 0, 1024, p.XN, NT); break;
    case 1:
        if (even) ph_gemm(p.XN, p.WT + WT_EVIN(j), NT, 3200, EpiEven{p.PB, p.AQL, p.AQC, p.AK, p.AV, p.GT, p.rope}, (char*)smem);
        else ph_gemm(p.XN, p.WT + WT_ODIN(j), NT, ODW, EpiOdd{p.AQL, p.AQC, p.AK, p.AV, p.rope}, (char*)smem);
        break;
    case 3: if (even) ph_attn_even(p, L + 4 * rep, L, j, smem); else ph_attn_odd(p, j, need_ctx, smem); break;
    case 4: if (even) ph_ml_pass2(p); break;
    case 5: if (even) ph_ml_pass3(p, j, smem); break;
    case 6: ph_gemm(p.MIX, p.WT + (even ? WT_EVOUT(j) : WT_ODOUT(j)), nrows, DM, EpiResid{p.H, mv + 2048, rep ? 0.f : 1.f}, (char*)smem); break;
    case 7: ph_normmod_q(p, p.norm2_g + L * DM, mv, nrows); break;
    case 8: ph_gemm(p.XN, p.WT + WT_PQ(L), nrows, 2048, EpiStoreBF16{p.QB, 2048}, (char*)smem); break;
    case 9: ph_peer_select(p, L, nrows, (char*)smem); break;
    case 10: ph_peer_gather(p, L, nrows, rep ? 0.f : 1.f); break;
    }
}

#define XB_TMO      128
#define XB_XCNT(j)  (256  + 64 * (j))
#define XB_XSUB(j)  (1280 + 64 * (j))
#define XB_XGEN(j)  (2304 + 64 * (j))
#define XB_TOP      3328
#define XB_TOPGEN   3392
#define XCD_BAR_WORDS 3456
#define XB_SPIN_CAP (1u << 20)
#define LAS __attribute__((address_space(3)))
__device__ __forceinline__ unsigned xb_ld(unsigned* p)              { return __hip_atomic_load(p, __ATOMIC_RELAXED, __HIP_MEMORY_SCOPE_AGENT); }
__device__ __forceinline__ unsigned xb_add(unsigned* p, unsigned v) { return __hip_atomic_fetch_add(p, v, __ATOMIC_RELAXED, __HIP_MEMORY_SCOPE_AGENT); }
__device__ __forceinline__ unsigned xb_xcc_id() { return (unsigned)__builtin_amdgcn_s_getreg((3 << 11) | 20) & 0xFu; }
#define XB_SPIN(cond, bar) do { unsigned _sp = 0; while (cond) { __builtin_amdgcn_s_sleep(1); \
    if ((++_sp & 255u) == 0u) { if (xb_ld(&(bar)[XB_TMO])) break; if (_sp > XB_SPIN_CAP) { atomicAdd(&(bar)[XB_TMO], 1u); break; } } } } while (0)
struct XcdBarrier { unsigned* bar; unsigned x; volatile LAS unsigned* st; };
__device__ __forceinline__ XcdBarrier xcd_barrier_post(unsigned* bar, volatile LAS unsigned* st) {
    XcdBarrier b; b.bar = bar; b.x = xb_xcc_id(); b.st = st;
    if (threadIdx.x == 0) (void)xb_add(&bar[XB_XCNT(b.x)], 1u);
    return b;
}
__device__ __forceinline__ void xcd_barrier_complete(unsigned* bar, unsigned x, unsigned& nloc, unsigned& nx) {
    const unsigned G = gridDim.x * gridDim.y * gridDim.z;
    unsigned sum, cnt, mine, sp = 0u;
    for (;;) {
        sum = 0u; cnt = 0u; mine = 0u;
#pragma unroll
        for (unsigned j = 0; j < 16; ++j) { const unsigned c = xb_ld(&bar[XB_XCNT(j)]); sum += c; cnt += (c > 0u) ? 1u : 0u; mine = (j == x) ? c : mine; }
        if (sum == G) break;
        __builtin_amdgcn_s_sleep(1);
        if ((++sp & 255u) == 0u) { if (xb_ld(&bar[XB_TMO])) break; if (sp > XB_SPIN_CAP) { atomicAdd(&bar[XB_TMO], 1u); break; } }
    }
    nloc = mine > 0u ? mine : 1u; nx = cnt > 0u ? cnt : 1u;
}
__device__ __forceinline__ void xcd_barrier(const XcdBarrier& b) {
    asm volatile("s_waitcnt vmcnt(0)" ::: "memory");
    __syncthreads();
    if (threadIdx.x == 0) {
        unsigned* bar = b.bar;
        __builtin_amdgcn_s_waitcnt(0);
        unsigned nloc = b.st[0], nx = b.st[1];
        if (nloc == 0u) { xcd_barrier_complete(bar, b.x, nloc, nx); b.st[0] = nloc; b.st[1] = nx; }
        const unsigned old = xb_add(&bar[XB_XSUB(b.x)], 1u);
        const unsigned gen = old / nloc;
        if (old + 1u == (gen + 1u) * nloc) {
            __builtin_amdgcn_fence(__ATOMIC_RELEASE, "agent");
            asm volatile("s_waitcnt vmcnt(0)" ::: "memory");
            const unsigned og = xb_add(&bar[XB_TOP], 1u);
            const unsigned tg = og / nx;
            if (og + 1u == (tg + 1u) * nx) xb_add(&bar[XB_TOPGEN], 1u);
            else XB_SPIN(xb_ld(&bar[XB_TOPGEN]) == tg, bar);
            __builtin_amdgcn_fence(__ATOMIC_ACQUIRE, "agent");
            xb_add(&bar[XB_XGEN(b.x)], 1u);
            asm volatile("s_waitcnt vmcnt(0)" ::: "memory");
        } else {
            XB_SPIN(xb_ld(&bar[XB_XGEN(b.x)]) == gen, bar);
            __builtin_amdgcn_fence(__ATOMIC_ACQUIRE, "agent");
            asm volatile("s_waitcnt vmcnt(0)" ::: "memory");
        }
    }
    __syncthreads();
}

__global__ void __launch_bounds__(256, 2) mega(P p) {
    extern __shared__ __attribute__((aligned(16))) float smem[];
    cg::grid_group grid = cg::this_grid();
    volatile LAS unsigned* st = (volatile LAS unsigned*)((char*)smem + 73744);
    if (threadIdx.x < 4) st[threadIdx.x] = 0u;
    __syncthreads();
    XcdBarrier xb = xcd_barrier_post(p.bar, st);
    for (int ph = p.ph_lo; ph < p.ph_hi; ++ph) {
        if (phase_empty(ph)) continue;
        run_phase(p, ph, smem, 0);
        if (PROBE_N > 1 && ph > 0 && (ph - 1) % NSUB == PROBE_S)
            for (int rep = 1; rep < PROBE_N; ++rep) { xcd_barrier(xb); run_phase(p, ph, smem, rep); }
        if (ph + 1 < p.ph_hi) { if (ph == 0) grid.sync(); else xcd_barrier(xb); }
    }
}

extern "C" void kernel_launch(void* const* d_in, const int* in_sizes, int n_in, void* d_out, int out_size, void* d_ws, size_t ws_size, hipStream_t stream) {
    static int grid_blocks = 0;
    if (!grid_blocks) {
        int dev = 0, cus = 0, per_cu = 0;
        hipGetDevice(&dev);
        hipDeviceGetAttribute(&cus, hipDeviceAttributeMultiprocessorCount, dev);
        hipFuncSetAttribute((const void*)mega, hipFuncAttributeMaxDynamicSharedMemorySize, LDS_BYTES);
        hipOccupancyMaxActiveBlocksPerMultiprocessor(&per_cu, mega, 256, LDS_BYTES);
        if (per_cu < 1) per_cu = 1;
        if (per_cu > 2) per_cu = 2;
        grid_blocks = cus * per_cu;
    }
    P p{};
    const float** ins = (const float**)&p;
    for (int i = 0; i < 24; ++i) ins[i] = (const float*)d_in[i];
    p.out = (float*)d_out;
    size_t off = 0; char* ws = (char*)d_ws;
    auto carve = [&](size_t bytes) { void* r = ws + off; off += (bytes + 255) & ~(size_t)255; return r; };
    p.modv = (float*)carve((size_t)4 * 9 * 6144 * 4);
    p.rope = (float*)carve((size_t)2048 * 64 * 4);
    p.H = (float*)carve((size_t)NT * DM * 4);
    p.XN = (bf16_t*)carve((size_t)NT * DM * 2);
    p.WT = (bf16_t*)carve(WT_TOTAL * 2);
    p.MIX = (bf16_t*)carve((size_t)NT * DM * 2);
    p.PB = (bf16_t*)carve((size_t)NT * 1536 * 2);
    p.GT = (float*)carve((size_t)NT * 16 * 4);
    p.AQL = (bf16_t*)carve((size_t)8 * 16 * 2048 * 64 * 2);
    p.AQC = (bf16_t*)carve((size_t)8 * 16 * 256 * 64 * 2);
    p.AK = (bf16_t*)carve((size_t)8 * 4 * 2 * 2304 * 64 * 2);
    p.AV = (bf16_t*)carve((size_t)8 * 4 * 128 * 2304 * 2);
    p.QKB = (bf16_t*)carve((size_t)NT * 512 * 2);
    p.CLOC = (float*)carve((size_t)2304 * 8192 * 4);
    p.CST = (bf16_t*)carve((size_t)2304 * 8192 * 2);
    p.NLOC = (float*)carve((size_t)2304 * 64 * 4);
    p.NST = (float*)carve((size_t)2304 * 64 * 4);
    p.CHB = (float*)carve((size_t)2304 * 4);
    p.CHM = (float*)carve((size_t)2304 * 4);
    p.MST = (float*)carve((size_t)2304 * 4);
    p.QB = (bf16_t*)carve((size_t)NT * 2048 * 2);
    p.GATE = (float*)carve((size_t)NT * 128 * 4);
    p.EIDX = (int*)carve((size_t)NT * 128 * 4);
    p.ctr = (int*)carve(256);
    p.bar = (unsigned*)carve((size_t)XCD_BAR_WORDS * 4);
    p.U8 = (unsigned char*)carve((size_t)4 * 16384 * 1024);
    p.V8 = (unsigned char*)carve((size_t)4 * 16384 * 1024);
    p.XQ = (unsigned char*)carve((size_t)NT * DM);
    p.XS = (float*)carve((size_t)NT * 4);
    p.USC = (float*)carve((size_t)4 * 16384 * 4);
    p.VSC = (float*)carve((size_t)4 * 16384 * 4);
    p.KB = (bf16_t*)carve((size_t)4 * 8 * 2 * 128 * 128 * 2);
    if (off > ws_size) { fprintf(stderr, "kernel_launch: workspace too small: need %zu have %zu\n", off, ws_size); return; }
    hipMemsetAsync(p.bar, 0, (size_t)XCD_BAR_WORDS * 4, stream);
#if ONE_LAUNCH
    p.ph_lo = 0; p.ph_hi = NPH;
    void* args[] = {&p};
    hipError_t e = hipLaunchCooperativeKernel((void*)mega, dim3(grid_blocks), dim3(256), args, LDS_BYTES, stream);
    if (e != hipSuccess) fprintf(stderr, "cooperative launch failed: %s (grid %d)\n", hipGetErrorString(e), grid_blocks);
#else
    for (int ph = 0; ph < NPH; ++ph) {
        if (ph > 0 && ph < NPH - 1) { const int L = (ph - 1) / NSUB, s = (ph - 1) % NSUB; if ((s == 2 || s == 4 || s == 5) && (L & 1)) continue; }
        p.ph_lo = ph; p.ph_hi = ph + 1;
        hipLaunchKernelGGL(mega, dim3(grid_blocks), dim3(256), LDS_BYTES, stream, p);
    }
#endif
}
```

```cpp
#include <hip/hip_runtime.h>
#include <hip/hip_cooperative_groups.h>
#include <cstdio>
#include <cstdint>
namespace cg = cooperative_groups;

#ifndef ONE_LAUNCH
#define ONE_LAUNCH 1
#endif

#define NT 18432
#define NL 16384
#define DM 1024
#define EVW 3088
#define ODW 1536
#define C_QK 0
#define C_V 512
#define C_O 1024
#define C_G 1536
#define C_DQ 1552
#define C_DK 2064
#define C_DV 2576
#define NPH 45
#ifndef PROBE_S
#define PROBE_S -1
#endif
#ifndef PROBE_N
#define PROBE_N 1
#endif

typedef unsigned short bf16_t;
typedef short bf16x8 __attribute__((ext_vector_type(8)));
typedef float f32x4 __attribute__((ext_vector_type(4)));
#define LDS_BYTES 73792

typedef float f32x16 __attribute__((ext_vector_type(16)));
typedef unsigned u32x4 __attribute__((ext_vector_type(4)));
struct P {
    const float *x, *c, *ctx, *c_ctx, *mod_w, *mod_b, *norm1_g, *norm2_g, *ev_w_in, *ev_conv_w, *ev_conv_b, *ev_gate_b,
        *ev_ml_g, *ev_da_lam, *ev_da_g, *ev_w_out, *od_w_in, *od_sink, *od_w_out, *pr_w_q, *pr_keys, *pr_u, *pr_v, *final_g;
    float* out;
    float *modv, *H, *GATE, *rope, *GT, *CLOC, *NLOC, *NST, *CHB, *CHM, *MST;
    int *EIDX, *ctr;
    unsigned* bar;
    bf16_t *XN, *MIX, *WT, *KB, *QB, *PB, *AQL, *AQC, *AK, *AV, *QKB, *CST;
    unsigned char *U8, *V8;
    float *USC, *VSC, *XS;
    unsigned char* XQ;
    int ph_lo, ph_hi;
};
#define QSCALE 0.18033688011112042f

__device__ __forceinline__ int otid() { int t = threadIdx.x; asm volatile("" : "+v"(t)); return t; }
__device__ __forceinline__ unsigned pack_i8x4(float a, float b, float c, float d) {
    return ((unsigned)(int)rintf(a) & 0xffu) | (((unsigned)(int)rintf(b) & 0xffu) << 8) | (((unsigned)(int)rintf(c) & 0xffu) << 16) | ((unsigned)(int)rintf(d) << 24);
}
__device__ __forceinline__ int modrow(int r) { return r < NL ? (r >> 11) : 8; }
__device__ __forceinline__ float silu_f(float x) { return x / (1.f + expf(-x)); }
__device__ __forceinline__ float sigmoid_f(float x) { return 1.f / (1.f + expf(-x)); }
__device__ __forceinline__ float log_sigmoid_f(float x) { return fminf(x, 0.f) - log1pf(expf(-fabsf(x))); }
typedef __bf16 bf16v2_t __attribute__((ext_vector_type(2)));
typedef float f32x2_t __attribute__((ext_vector_type(2)));
__device__ __forceinline__ unsigned cvt_pk_bf16(float lo, float hi) { const bf16v2_t v = __builtin_convertvector((f32x2_t){lo, hi}, bf16v2_t); return __builtin_bit_cast(unsigned, v); }
__device__ __forceinline__ float bf_lo(unsigned u) { return __uint_as_float(u << 16); }
__device__ __forceinline__ float bf_hi(unsigned u) { return __uint_as_float(u & 0xffff0000u); }
__device__ __forceinline__ void unpack8(const uint4 u, float* f) {
    f[0] = bf_lo(u.x); f[1] = bf_hi(u.x); f[2] = bf_lo(u.y); f[3] = bf_hi(u.y); f[4] = bf_lo(u.z); f[5] = bf_hi(u.z); f[6] = bf_lo(u.w); f[7] = bf_hi(u.w);
}
#define WT_EVIN(j) ((size_t)(j) * 3200 * 1024)
#define WT_EVOUT(j) ((size_t)2 * 3200 * 1024 + (size_t)(j) * 1024 * 1024)
#define WT_ODIN(j) ((size_t)2 * 3200 * 1024 + (size_t)2 * 1024 * 1024 + (size_t)(j) * 1536 * 1024)
#define WT_ODOUT(j) ((size_t)2 * 3200 * 1024 + (size_t)2 * 1024 * 1024 + (size_t)2 * 1536 * 1024 + (size_t)(j) * 1024 * 1024)
#define WT_PQ(L) ((size_t)2 * 3200 * 1024 + (size_t)4 * 1024 * 1024 + (size_t)2 * 1536 * 1024 + (size_t)(L) * 2048 * 1024)
#define WT_TOTAL ((size_t)2 * 3200 * 1024 + (size_t)4 * 1024 * 1024 + (size_t)2 * 1536 * 1024 + (size_t)4 * 2048 * 1024)
__device__ __forceinline__ float lshfl(float v, int src) { return __int_as_float(__builtin_amdgcn_ds_bpermute(src << 2, __float_as_int(v))); }
#define SHX(v, m) lshfl((v), lane ^ (m))
#define wave_sum(v) wave_sum_l((v), lane)
#define wave_max(v) wave_max_l((v), lane)
template <int CTRL, int RMASK> __device__ __forceinline__ float dppf(float v, float fill) { return __int_as_float(__builtin_amdgcn_update_dpp(__float_as_int(fill), __float_as_int(v), CTRL, RMASK, 0xF, false)); }
__device__ __forceinline__ float wave_sum_l(float v, int lane) {
    v += dppf<0xB1, 0xF>(v, 0.f); v += dppf<0x4E, 0xF>(v, 0.f); v += dppf<0x141, 0xF>(v, 0.f); v += dppf<0x140, 0xF>(v, 0.f);
    v += dppf<0x142, 0xA>(v, 0.f); v += dppf<0x143, 0xC>(v, 0.f);
    return __int_as_float(__builtin_amdgcn_readlane(__float_as_int(v), 63));
}
__device__ __forceinline__ float wave_max_l(float v, int lane) {
    v = fmaxf(v, dppf<0xB1, 0xF>(v, v)); v = fmaxf(v, dppf<0x4E, 0xF>(v, v)); v = fmaxf(v, dppf<0x141, 0xF>(v, v)); v = fmaxf(v, dppf<0x140, 0xF>(v, v));
    v = fmaxf(v, dppf<0x142, 0xA>(v, v)); v = fmaxf(v, dppf<0x143, 0xC>(v, v));
    return __int_as_float(__builtin_amdgcn_readlane(__float_as_int(v), 63));
}

__device__ void cvt_copy_bf16(const float* src, bf16_t* dst, size_t n);
__device__ void quant_rows_i8(const float* src, unsigned char* dst, float* scl, int nrows);
__device__ void ph_prologue(const P& p, float* smem) {
    const int tid = otid(), nb = gridDim.x, bid = blockIdx.x;
    if (bid == 0 && tid < 64) p.ctr[tid] = 0;
    {
        const float4* xs = (const float4*)p.x; const float4* cs = (const float4*)p.ctx; float4* hd = (float4*)p.H;
        const size_t nx = (size_t)NL * DM / 4, nc = (size_t)(NT - NL) * DM / 4;
        for (size_t i = (size_t)bid * 256 + tid; i < nx + nc; i += (size_t)nb * 256) hd[i] = i < nx ? xs[i] : cs[i - nx];
    }
    for (int i = bid * 256 + tid; i < 2048 * 32; i += nb * 256) {
        const int s = i >> 5, d = i & 31;
        const float pos = (d < 16) ? (float)(s >> 6) : (float)(s & 63);
        const float inv = powf(10000.0f, -(float)(d & 15) / 16.0f);
        const float ang = pos * inv;
        p.rope[2 * i] = cosf(ang); p.rope[2 * i + 1] = sinf(ang);
    }
    float* sc = smem;
    float* red = smem + 9 * 1024;
    for (int i = tid; i < 9 * 1024; i += 256) { const int r = i >> 10, k = i & 1023; const float v = r < 8 ? p.c[r * 1024 + k] : p.c_ctx[k]; sc[i] = silu_f(v); }
    __syncthreads();
    for (int item = bid; item < 4 * 96; item += nb) {
        const int L = item / 96, n0 = (item % 96) * 64, tx = tid & 63, kq = tid >> 6;
        float acc[9];
#pragma unroll
        for (int r = 0; r < 9; ++r) acc[r] = 0.f;
        const float* w = p.mod_w + (size_t)L * 1024 * 6144 + n0 + tx;
        for (int k = kq * 256; k < kq * 256 + 256; ++k) {
            const float wv = w[(size_t)k * 6144];
#pragma unroll
            for (int r = 0; r < 9; ++r) acc[r] += sc[r * 1024 + k] * wv;
        }
#pragma unroll
        for (int r = 0; r < 9; ++r) red[(kq * 9 + r) * 64 + tx] = acc[r];
        __syncthreads();
        if (kq == 0) {
#pragma unroll
            for (int r = 0; r < 9; ++r) {
                const float s = red[(0 * 9 + r) * 64 + tx] + red[(1 * 9 + r) * 64 + tx] + red[(2 * 9 + r) * 64 + tx] + red[(3 * 9 + r) * 64 + tx];
                p.modv[((size_t)L * 9 + r) * 6144 + n0 + tx] = s + p.mod_b[L * 6144 + n0 + tx];
            }
        }
        __syncthreads();
    }
    {
        float (*tile)[65] = (float (*)[65])smem;
        for (int item = bid; item < 5440; item += nb) {
            int it = item, mat = 0, N = 0, Npad = 0; const float* src = nullptr; bf16_t* dst = nullptr;
            for (mat = 0; mat < 12; ++mat) {
                if (mat < 2) { N = EVW; Npad = 3200; src = p.ev_w_in + (size_t)mat * DM * EVW; dst = p.WT + WT_EVIN(mat); }
                else if (mat < 4) { N = 1024; Npad = 1024; src = p.ev_w_out + (size_t)(mat - 2) * DM * DM; dst = p.WT + WT_EVOUT(mat - 2); }
                else if (mat < 6) { N = ODW; Npad = ODW; src = p.od_w_in + (size_t)(mat - 4) * DM * ODW; dst = p.WT + WT_ODIN(mat - 4); }
                else if (mat < 8) { N = 1024; Npad = 1024; src = p.od_w_out + (size_t)(mat - 6) * DM * DM; dst = p.WT + WT_ODOUT(mat - 6); }
                else { N = 2048; Npad = 2048; src = p.pr_w_q + (size_t)(mat - 8) * DM * 2048; dst = p.WT + WT_PQ(mat - 8); }
                const int nt = 16 * (Npad / 64);
                if (it < nt) break;
                it -= nt;
            }
            const int k0 = (it & 15) * 64, n0 = (it >> 4) * 64;
            __syncthreads();
#pragma unroll
            for (int rep = 0; rep < 4; ++rep) {
                const int i = (tid >> 4) + 16 * rep, c4 = (tid & 15) * 4;
                float4 v = make_float4(0.f, 0.f, 0.f, 0.f);
                int sc = n0 + c4;
                if (mat < 2) sc = sc < 1536 ? sc : (sc < 3072 ? sc + 16 : (sc < 3088 ? sc - 3072 + 1536 : N));
                if (sc < N) v = *(const float4*)(src + (size_t)(k0 + i) * N + sc);
                tile[i][c4] = v.x; tile[i][c4 + 1] = v.y; tile[i][c4 + 2] = v.z; tile[i][c4 + 3] = v.w;
            }
            __syncthreads();
            {
                const int n = tid >> 2, kq = (tid & 3) * 16;
                unsigned w[8];
#pragma unroll
                for (int e = 0; e < 8; ++e) w[e] = cvt_pk_bf16(tile[kq + 2 * e][n], tile[kq + 2 * e + 1][n]);
                uint4* dp = (uint4*)(dst + (size_t)(n0 + n) * DM + k0 + kq);
                dp[0] = make_uint4(w[0], w[1], w[2], w[3]); dp[1] = make_uint4(w[4], w[5], w[6], w[7]);
            }
        }
    }
    quant_rows_i8(p.pr_u, p.U8, p.USC, 4 * 16384);
    quant_rows_i8(p.pr_v, p.V8, p.VSC, 4 * 16384);
    cvt_copy_bf16(p.pr_keys, p.KB, (size_t)4 * 8 * 2 * 128 * 128);
}

__device__ void ph_normmod_q(const P& p, const float* g, const float* modv_layer, int nrows) {
    const int lane = otid() & 63, wid = otid() >> 6;
    for (int r = blockIdx.x * 4 + wid; r < nrows; r += gridDim.x * 4) {
        const float4* s4 = (const float4*)(p.H + (size_t)r * DM + lane * 16);
        float4 v[4]; float ss = 0.f;
#pragma unroll
        for (int i = 0; i < 4; ++i) { v[i] = s4[i]; ss += v[i].x * v[i].x + v[i].y * v[i].y + v[i].z * v[i].z + v[i].w * v[i].w; }
        ss = wave_sum(ss);
        const float rstd = rsqrtf(ss * (1.0f / DM) + 1e-6f);
        const float* mv = modv_layer + (size_t)modrow(r) * 6144 + lane * 16;
        float o[16]; float mx = 0.f;
#pragma unroll
        for (int i = 0; i < 4; ++i) {
            const float4 gg = *(const float4*)(g + lane * 16 + i * 4), sh = *(const float4*)(mv + 3072 + i * 4), scl = *(const float4*)(mv + 4096 + i * 4);
            o[i * 4 + 0] = v[i].x * rstd * gg.x * (1.f + scl.x) + sh.x; o[i * 4 + 1] = v[i].y * rstd * gg.y * (1.f + scl.y) + sh.y;
            o[i * 4 + 2] = v[i].z * rstd * gg.z * (1.f + scl.z) + sh.z; o[i * 4 + 3] = v[i].w * rstd * gg.w * (1.f + scl.w) + sh.w;
            mx = fmaxf(mx, fmaxf(fmaxf(fabsf(o[i * 4]), fabsf(o[i * 4 + 1])), fmaxf(fabsf(o[i * 4 + 2]), fabsf(o[i * 4 + 3]))));
        }
        mx = wave_max(mx);
        const float inv = mx > 0.f ? 127.f / mx : 0.f;
        uint4* xp = (uint4*)(p.XN + (size_t)r * DM + lane * 16);
        xp[0] = make_uint4(cvt_pk_bf16(o[0], o[1]), cvt_pk_bf16(o[2], o[3]), cvt_pk_bf16(o[4], o[5]), cvt_pk_bf16(o[6], o[7]));
        xp[1] = make_uint4(cvt_pk_bf16(o[8], o[9]), cvt_pk_bf16(o[10], o[11]), cvt_pk_bf16(o[12], o[13]), cvt_pk_bf16(o[14], o[15]));
        *(uint4*)(p.XQ + (size_t)r * DM + lane * 16) = make_uint4(pack_i8x4(o[0] * inv, o[1] * inv, o[2] * inv, o[3] * inv), pack_i8x4(o[4] * inv, o[5] * inv, o[6] * inv, o[7] * inv),
                                                                  pack_i8x4(o[8] * inv, o[9] * inv, o[10] * inv, o[11] * inv), pack_i8x4(o[12] * inv, o[13] * inv, o[14] * inv, o[15] * inv));
        if (lane == 0) p.XS[r] = mx * (1.f / 127.f);
    }
}

__device__ void cvt_copy_bf16(const float* src, bf16_t* dst, size_t n) {
    const size_t n8 = n / 8;
    for (size_t i = (size_t)blockIdx.x * 256 + otid(); i < n8; i += (size_t)gridDim.x * 256) {
        const float4 a = ((const float4*)src)[2 * i], b = ((const float4*)src)[2 * i + 1];
        ((uint4*)dst)[i] = make_uint4(cvt_pk_bf16(a.x, a.y), cvt_pk_bf16(a.z, a.w), cvt_pk_bf16(b.x, b.y), cvt_pk_bf16(b.z, b.w));
    }
}

__device__ void quant_rows_i8(const float* src, unsigned char* dst, float* scl, int nrows) {
    const int lane = otid() & 63, wid = otid() >> 6;
    for (int r = blockIdx.x * 4 + wid; r < nrows; r += gridDim.x * 4) {
        const float4* sp = (const float4*)(src + (size_t)r * 1024 + lane * 16);
        float4 v[4]; float mx = 0.f;
#pragma unroll
        for (int i = 0; i < 4; ++i) { v[i] = sp[i]; mx = fmaxf(mx, fmaxf(fmaxf(fabsf(v[i].x), fabsf(v[i].y)), fmaxf(fabsf(v[i].z), fabsf(v[i].w)))); }
#pragma unroll
        for (int o = 32; o > 0; o >>= 1) mx = fmaxf(mx, SHX(mx, o));
        const float inv = mx > 0.f ? 127.f / mx : 0.f;
        unsigned w[4];
#pragma unroll
        for (int i = 0; i < 4; ++i) {
            w[i] = pack_i8x4(v[i].x * inv, v[i].y * inv, v[i].z * inv, v[i].w * inv);
        }
        *(uint4*)(dst + (size_t)r * 1024 + lane * 16) = make_uint4(w[0], w[1], w[2], w[3]);
        if (lane == 0) scl[r] = mx * (1.f / 127.f);
    }
}

__device__ void ph_normmod(const float* src, const float* g, const float* modv_layer, int shift_off, int scale_off, bf16_t* dst, int nrows) {
    const int lane = otid() & 63, wid = otid() >> 6;
    for (int r = blockIdx.x * 4 + wid; r < nrows; r += gridDim.x * 4) {
        const float4* s4 = (const float4*)(src + (size_t)r * DM);
        float4 v[4]; float ss = 0.f;
#pragma unroll
        for (int i = 0; i < 4; ++i) { v[i] = s4[i * 64 + lane]; ss += v[i].x * v[i].x + v[i].y * v[i].y + v[i].z * v[i].z + v[i].w * v[i].w; }
        ss = wave_sum(ss);
        const float rstd = rsqrtf(ss * (1.0f / DM) + 1e-6f);
        const float* mv = modv_layer + (size_t)modrow(r) * 6144;
        uint2* d2 = (uint2*)(dst + (size_t)r * DM);
#pragma unroll
        for (int i = 0; i < 4; ++i) {
            const int c = (i * 64 + lane) * 4;
            const float4 gg = *(const float4*)(g + c), sh = *(const float4*)(mv + shift_off + c), scl = *(const float4*)(mv + scale_off + c);
            float4 o;
            o.x = v[i].x * rstd * gg.x * (1.f + scl.x) + sh.x; o.y = v[i].y * rstd * gg.y * (1.f + scl.y) + sh.y;
            o.z = v[i].z * rstd * gg.z * (1.f + scl.z) + sh.z; o.w = v[i].w * rstd * gg.w * (1.f + scl.w) + sh.w;
            d2[i * 64 + lane] = make_uint2(cvt_pk_bf16(o.x, o.y), cvt_pk_bf16(o.z, o.w));
        }
    }
}

__device__ void ph_final(const P& p) {
    const int lane = otid() & 63, wid = otid() >> 6;
    for (int r = blockIdx.x * 4 + wid; r < NL; r += gridDim.x * 4) {
        const float4* s4 = (const float4*)(p.H + (size_t)r * DM);
        float4 v[4]; float ss = 0.f;
#pragma unroll
        for (int i = 0; i < 4; ++i) { v[i] = s4[i * 64 + lane]; ss += v[i].x * v[i].x + v[i].y * v[i].y + v[i].z * v[i].z + v[i].w * v[i].w; }
        ss = wave_sum(ss);
        const float rstd = rsqrtf(ss * (1.0f / DM) + 1e-6f);
        float4* d4 = (float4*)(p.out + (size_t)r * DM);
#pragma unroll
        for (int i = 0; i < 4; ++i) {
            const int c = (i * 64 + lane) * 4; const float4 gg = *(const float4*)(p.final_g + c);
            float4 o; o.x = v[i].x * rstd * gg.x; o.y = v[i].y * rstd * gg.y; o.z = v[i].z * rstd * gg.z; o.w = v[i].w * rstd * gg.w;
            d4[i * 64 + lane] = o;
        }
    }
}

#define GL_ROWB 144
#define GL_TILEB (128 * GL_ROWB)
struct TokPos { int b, pos, kpos; bool lat; };
__device__ __forceinline__ TokPos tokpos(int row) {
    TokPos t; t.lat = row < NL;
    if (t.lat) { t.b = row >> 11; t.pos = row & 2047; t.kpos = 256 + t.pos; } else { const int r = row - NL; t.b = r >> 8; t.pos = r & 255; t.kpos = t.pos; }
    return t;
}
struct EpiStoreBF16 {
    bf16_t* C; int ldc;
    __device__ __forceinline__ bool swapped(int) const { return false; }
    __device__ __forceinline__ void operator()(const f32x4 (&acc)[4][4], int m0, int n0, int wm, int wn, int fr, int fq) const {
#pragma unroll
        for (int mi = 0; mi < 4; ++mi)
#pragma unroll
            for (int ni = 0; ni < 4; ++ni) {
                const f32x4 v = acc[ni][mi];
                *(uint2*)(C + (size_t)(m0 + wm * 64 + mi * 16 + fr) * ldc + n0 + wn * 64 + ni * 16 + fq * 4) = make_uint2(cvt_pk_bf16(v[0], v[1]), cvt_pk_bf16(v[2], v[3]));
            }
    }
};
struct EpiResid {
    float* H; const float* gate; float scale;
    __device__ __forceinline__ bool swapped(int) const { return false; }
    __device__ __forceinline__ void operator()(const f32x4 (&acc)[4][4], int m0, int n0, int wm, int wn, int fr, int fq) const {
#pragma unroll
        for (int mi = 0; mi < 4; ++mi) {
            const int row = m0 + wm * 64 + mi * 16 + fr;
            const float* gp = gate + (size_t)modrow(row) * 6144;
#pragma unroll
            for (int ni = 0; ni < 4; ++ni) {
                const int col = n0 + wn * 64 + ni * 16 + fq * 4;
                const f32x4 g = *(const f32x4*)(gp + col);
                f32x4* hp = (f32x4*)(H + (size_t)row * DM + col);
                *hp = *hp + g * acc[ni][mi] * scale;
            }
        }
    }
};
__device__ __forceinline__ void rope_store64(const f32x4 (&acc)[4][4], int mi, bool do_rope, const float* ropep  , float scale, bf16_t* dst  , int fq) {
#pragma unroll
    for (int ni = 0; ni < 2; ++ni) {
        f32x4 x1 = acc[ni][mi], x2 = acc[ni + 2][mi];
        if (do_rope) {
            const f32x4 r0 = *(const f32x4*)(ropep + (ni * 16 + fq * 4) * 2), r1 = *(const f32x4*)(ropep + (ni * 16 + fq * 4) * 2 + 4);
            const f32x4 cs = (f32x4){r0[0], r0[2], r1[0], r1[2]}, sn = (f32x4){r0[1], r0[3], r1[1], r1[3]};
            const f32x4 y1 = x1 * cs - x2 * sn, y2 = x1 * sn + x2 * cs;
            x1 = y1; x2 = y2;
        }
        x1 = x1 * scale; x2 = x2 * scale;
        *(uint2*)(dst + ni * 16 + fq * 4) = make_uint2(cvt_pk_bf16(x1[0], x1[1]), cvt_pk_bf16(x1[2], x1[3]));
        *(uint2*)(dst + 32 + ni * 16 + fq * 4) = make_uint2(cvt_pk_bf16(x2[0], x2[1]), cvt_pk_bf16(x2[2], x2[3]));
    }
}
struct EpiEven {
    bf16_t *PB, *AQL, *AQC, *AK, *AV; float* GT; const float* rope;
    __device__ __forceinline__ bool swapped(int n0) const { return n0 >= 2560 && n0 < 3072; }
    __device__ __forceinline__ void operator()(const f32x4 (&acc)[4][4], int m0, int n0, int wm, int wn, int fr, int fq) const {
        const int t = n0 >> 7;
        if (t < 12) {
#pragma unroll
            for (int mi = 0; mi < 4; ++mi)
#pragma unroll
                for (int ni = 0; ni < 4; ++ni) {
                    const f32x4 v = acc[ni][mi];
                    *(uint2*)(PB + (size_t)(m0 + wm * 64 + mi * 16 + fr) * 1536 + n0 + wn * 64 + ni * 16 + fq * 4) = make_uint2(cvt_pk_bf16(v[0], v[1]), cvt_pk_bf16(v[2], v[3]));
                }
        } else if (t < 20) {
            const bool isq = t < 16; const int h = t & 3;
#pragma unroll
            for (int mi = 0; mi < 4; ++mi) {
                const TokPos tp = tokpos(m0 + wm * 64 + mi * 16 + fr);
                const int hm = (tp.b * 4 + h) * 2 + wn;
                bf16_t* dst;
                if (isq) dst = tp.lat ? AQL + ((size_t)hm * 2048 + tp.pos) * 64 : AQC + ((size_t)hm * 256 + tp.pos) * 64;
                else dst = AK + ((size_t)hm * 2304 + tp.kpos) * 64;
                rope_store64(acc, mi, tp.lat, rope + (size_t)tp.pos * 64, isq ? QSCALE : 1.0f, dst, fq);
            }
        } else if (t < 24) {
            const int h = t - 20;
#pragma unroll
            for (int mi = 0; mi < 4; ++mi) {
                const TokPos tp = tokpos(m0 + wm * 64 + mi * 16 + fq * 4);
#pragma unroll
                for (int ni = 0; ni < 4; ++ni) {
                    const f32x4 v = acc[ni][mi];
                    const int d = wn * 64 + ni * 16 + fr;
                    *(uint2*)(AV + ((size_t)(tp.b * 4 + h) * 128 + d) * 2304 + tp.kpos) = make_uint2(cvt_pk_bf16(v[0], v[1]), cvt_pk_bf16(v[2], v[3]));
                }
            }
        } else {
            if (wn == 0) {
#pragma unroll
                for (int mi = 0; mi < 4; ++mi) *(f32x4*)(GT + (size_t)(m0 + wm * 64 + mi * 16 + fr) * 16 + fq * 4) = acc[0][mi];
            }
        }
    }
};
struct EpiOdd {
    bf16_t *AQL, *AQC, *AK, *AV; const float* rope;
    __device__ __forceinline__ bool swapped(int n0) const { return n0 >= 1280; }
    __device__ __forceinline__ void operator()(const f32x4 (&acc)[4][4], int m0, int n0, int wm, int wn, int fr, int fq) const {
        const int t = n0 >> 7;
        if (t < 10) {
            const bool isq = t < 8; const int hd = isq ? t * 2 + wn : (t - 8) * 2 + wn;
#pragma unroll
            for (int mi = 0; mi < 4; ++mi) {
                const TokPos tp = tokpos(m0 + wm * 64 + mi * 16 + fr);
                bf16_t* dst;
                if (isq) dst = tp.lat ? AQL + ((size_t)(tp.b * 16 + hd) * 2048 + tp.pos) * 64 : AQC + ((size_t)(tp.b * 16 + hd) * 256 + tp.pos) * 64;
                else dst = AK + ((size_t)(tp.b * 4 + hd) * 2304 + tp.kpos) * 64;
                rope_store64(acc, mi, tp.lat, rope + (size_t)tp.pos * 64, isq ? QSCALE : 1.0f, dst, fq);
            }
        } else {
            const int hkv = (t - 10) * 2 + wn;
#pragma unroll
            for (int mi = 0; mi < 4; ++mi) {
                const TokPos tp = tokpos(m0 + wm * 64 + mi * 16 + fq * 4);
#pragma unroll
                for (int ni = 0; ni < 4; ++ni) {
                    const f32x4 v = acc[ni][mi];
                    const int d = ni * 16 + fr;
                    *(uint2*)(AV + ((size_t)(tp.b * 4 + hkv) * 64 + d) * 2304 + tp.kpos) = make_uint2(cvt_pk_bf16(v[0], v[1]), cvt_pk_bf16(v[2], v[3]));
                }
            }
        }
    }
};
#define LDS_AS __attribute__((address_space(3)))
template <bool SWAP>
__device__ __forceinline__ void gemm_tile_kloop(f32x4 (&acc)[4][4], const bf16_t* aub, const bf16_t* bub, char* smem, int lrow, int lch, int wm, int wn, int fr, int fq) {
    const int tid = lrow * 8 + lch, wid = tid >> 6, lane = tid & 63;
    const int srow = wid * 8 + (lane >> 3);
    const unsigned goff = (unsigned)(srow * DM + (((lane & 7) ^ (srow & 7)) << 3)) * 2u;
#define GL_DMA(BUF, KO) { _Pragma("unroll") for (int i = 0; i < 4; ++i) { \
        __builtin_amdgcn_global_load_lds((const unsigned*)((const char*)aub + ((size_t)(32 * i) * DM + (KO)) * 2 + goff), (LDS_AS unsigned*)((BUF) + (i * 32 + wid * 8) * 128), 16, 0, 0); \
        __builtin_amdgcn_global_load_lds((const unsigned*)((const char*)bub + ((size_t)(32 * i) * DM + (KO)) * 2 + goff), (LDS_AS unsigned*)((BUF) + 16384 + (i * 32 + wid * 8) * 128), 16, 0, 0); } }
    const int xr = fr & 7;
    GL_DMA(smem, 0)
    __syncthreads();
    for (int kt = 0; kt < 16; ++kt) {
        char* cur = smem + (kt & 1) * 32768;
        char* nxt = smem + ((kt + 1) & 1) * 32768;
        if (kt + 1 < 16) GL_DMA(nxt, (kt + 1) * 64)
#pragma unroll
        for (int ks = 0; ks < 2; ++ks) {
            bf16x8 af[4], wf[4];
#pragma unroll
            for (int i = 0; i < 4; ++i) {
                af[i] = *(const bf16x8*)(cur + (wm * 64 + i * 16 + fr) * 128 + (((ks * 4 + fq) ^ xr) << 4));
                wf[i] = *(const bf16x8*)(cur + 16384 + (wn * 64 + i * 16 + fr) * 128 + (((ks * 4 + fq) ^ xr) << 4));
            }
#pragma unroll
            for (int ni = 0; ni < 4; ++ni)
#pragma unroll
                for (int mi = 0; mi < 4; ++mi)
                    acc[ni][mi] = SWAP ? __builtin_amdgcn_mfma_f32_16x16x32_bf16(af[mi], wf[ni], acc[ni][mi], 0, 0, 0)
                                       : __builtin_amdgcn_mfma_f32_16x16x32_bf16(wf[ni], af[mi], acc[ni][mi], 0, 0, 0);
        }
        __syncthreads();
    }
#undef GL_DMA
}
template <class Epi>
__device__ void ph_gemm(const bf16_t* A, const bf16_t* Bt, int M, int Npad, const Epi& epi, char* smem) {
    const int tid = otid(), lane = tid & 63, wid = tid >> 6, wm = wid >> 1, wn = wid & 1;
    const int fr = lane & 15, fq = lane >> 4;
    const int tm = M / 128, tn = Npad / 128, ntiles = tm * tn;
    const int lrow = tid >> 3, lch = tid & 7;
    for (int tile = blockIdx.x; tile < ntiles; tile += gridDim.x) {
        const int m0 = (tile % tm) * 128, n0 = (tile / tm) * 128;
        f32x4 acc[4][4];
#pragma unroll
        for (int a = 0; a < 4; ++a)
#pragma unroll
            for (int b = 0; b < 4; ++b) acc[a][b] = (f32x4){0.f, 0.f, 0.f, 0.f};
        const bf16_t* ap = A + (size_t)m0 * DM;
        const bf16_t* bp = Bt + (size_t)n0 * DM;
        if (epi.swapped(n0)) gemm_tile_kloop<true>(acc, ap, bp, smem, lrow, lch, wm, wn, fr, fq);
        else gemm_tile_kloop<false>(acc, ap, bp, smem, lrow, lch, wm, wn, fr, fq);
        int fr2 = fr, fq2 = fq, wm2 = wm, wn2 = wn;
        asm volatile("" : "+v"(fr2), "+v"(fq2), "+v"(wm2), "+v"(wn2));
        epi(acc, m0, n0, wm2, wn2, fr2, fq2);
    }
}

__device__ void ph_prep_even(const P& p, int j) {
    const float* cw = p.ev_conv_w + (size_t)j * 3 * 512; const float* cb = p.ev_conv_b + (size_t)j * 512;
    const size_t tot = (size_t)NT * 256;
    for (size_t i = (size_t)blockIdx.x * 256 + otid(); i < tot; i += (size_t)gridDim.x * 256) {
        const int r = (int)(i >> 8), c = (int)(i & 255) * 2;
        int t, T; if (r < NL) { t = r & 2047; T = 2048; } else { t = (r - NL) & 255; T = 256; }
        const unsigned x1 = *(const unsigned*)(p.PB + (size_t)r * 1536 + c);
        float v0 = cb[c] + bf_lo(x1) * cw[512 + c], v1 = cb[c + 1] + bf_hi(x1) * cw[512 + c + 1];
        if (t > 0) { const unsigned x0 = *(const unsigned*)(p.PB + (size_t)(r - 1) * 1536 + c); v0 += bf_lo(x0) * cw[c]; v1 += bf_hi(x0) * cw[c + 1]; }
        if (t < T - 1) { const unsigned x2 = *(const unsigned*)(p.PB + (size_t)(r + 1) * 1536 + c); v0 += bf_lo(x2) * cw[1024 + c]; v1 += bf_hi(x2) * cw[1024 + c + 1]; }
        v0 = silu_f(v0); v1 = silu_f(v1);
        if (c >= 256) { v0 *= 0.125f; v1 *= 0.125f; }
        *(unsigned*)(p.QKB + (size_t)r * 512 + c) = cvt_pk_bf16(v0, v1);
    }
}

#define FA_KROW 144
#define FA_VROW 136
__device__ __forceinline__ bf16x8 pack8(float a0, float a1, float a2, float a3, float a4, float a5, float a6, float a7) {
    const u32x4 u = (u32x4){cvt_pk_bf16(a0, a1), cvt_pk_bf16(a2, a3), cvt_pk_bf16(a4, a5), cvt_pk_bf16(a6, a7)};
    return __builtin_bit_cast(bf16x8, u);
}
template <int NDB, bool MASK>
__device__ __forceinline__ void flash_tile(const bf16x8 (&qf)[4], f32x16 (&o)[NDB], float& m, float& l, const char* Kl, const char* Vl, int lane, int qpos, int kp0) {
    const int j = lane & 31, h = lane >> 5;
    f32x16 s0, s1;
#pragma unroll
    for (int i = 0; i < 16; ++i) { s0[i] = 0.f; s1[i] = 0.f; }
#pragma unroll
    for (int ks = 0; ks < 4; ++ks) {
        const bf16x8 a0 = *(const bf16x8*)(Kl + j * FA_KROW + (2 * ks + h) * 16);
        const bf16x8 a1 = *(const bf16x8*)(Kl + (32 + j) * FA_KROW + (2 * ks + h) * 16);
        s0 = __builtin_amdgcn_mfma_f32_32x32x16_bf16(a0, qf[ks], s0, 0, 0, 0);
        s1 = __builtin_amdgcn_mfma_f32_32x32x16_bf16(a1, qf[ks], s1, 0, 0, 0);
    }
    if (MASK) {
#pragma unroll
        for (int r = 0; r < 16; ++r) {
            const int key = (r & 3) + 8 * (r >> 2) + 4 * h;
            const int d0 = qpos - (kp0 + key), d1 = d0 - 32;
            if (d0 > 128 || d0 < -128) s0[r] = -1e30f;
            if (d1 > 128 || d1 < -128) s1[r] = -1e30f;
        }
    }
    float mx = fmaxf(s0[0], s1[0]);
#pragma unroll
    for (int r = 1; r < 16; ++r) mx = fmaxf(mx, fmaxf(s0[r], s1[r]));
    mx = fmaxf(mx, SHX(mx, 32));
    const float mn = fmaxf(m, mx);
    const float alpha = __builtin_amdgcn_exp2f(m - mn);
    m = mn;
    float ls = 0.f;
#pragma unroll
    for (int r = 0; r < 16; ++r) { s0[r] = __builtin_amdgcn_exp2f(s0[r] - mn); s1[r] = __builtin_amdgcn_exp2f(s1[r] - mn); ls += s0[r] + s1[r]; }
    l = l * alpha + ls;
    if (__ballot(alpha != 1.0f)) {
#pragma unroll
        for (int db = 0; db < NDB; ++db) o[db] = o[db] * alpha;
    }
    bf16x8 pb[4];
    pb[0] = pack8(s0[0], s0[1], s0[2], s0[3], s0[4], s0[5], s0[6], s0[7]);
    pb[1] = pack8(s0[8], s0[9], s0[10], s0[11], s0[12], s0[13], s0[14], s0[15]);
    pb[2] = pack8(s1[0], s1[1], s1[2], s1[3], s1[4], s1[5], s1[6], s1[7]);
    pb[3] = pack8(s1[8], s1[9], s1[10], s1[11], s1[12], s1[13], s1[14], s1[15]);
#pragma unroll
    for (int db = 0; db < NDB; ++db)
#pragma unroll
        for (int kk = 0; kk < 4; ++kk) {
            const char* vp = Vl + (db * 32 + j) * FA_VROW + (kk * 16 + 4 * h) * 2;
            const uint2 lo = *(const uint2*)vp, hi = *(const uint2*)(vp + 16);
            const u32x4 u = (u32x4){lo.x, lo.y, hi.x, hi.y};
            o[db] = __builtin_amdgcn_mfma_f32_32x32x16_bf16(__builtin_bit_cast(bf16x8, u), pb[kk], o[db], 0, 0, 0);
        }
}

#define DA_BUFB 35840
__device__ void da_block(const P& p, int item, int L, int j, char* smem) {
    const int tid = otid(), lane = tid & 63, wid = tid >> 6, mp = wid & 1, qg = wid >> 1, jq = lane & 31, hh = lane >> 5;
    const bool lat = item < 1024;
    int b, h, qt;
    if (lat) { b = item >> 7; h = (item >> 5) & 3; qt = item & 31; } else { const int it = item - 1024; b = it >> 4; h = (it >> 2) & 3; qt = it & 3; }
    const int qi = qt * 64 + qg * 32 + jq;
    const bf16_t* qp = lat ? p.AQL + ((size_t)((b * 4 + h) * 2 + mp) * 2048 + qi) * 64 : p.AQC + ((size_t)((b * 4 + h) * 2 + mp) * 256 + qi) * 64;
    bf16x8 qf[4];
#pragma unroll
    for (int ks = 0; ks < 4; ++ks) qf[ks] = *(const bf16x8*)(qp + (2 * ks + hh) * 8);
    const int ntile = lat ? 36 : 4;
    const bf16_t* kg = p.AK + (size_t)((b * 4 + h) * 2) * 2304 * 64 + (size_t)(tid >> 3) * 64 + (tid & 7) * 8;
    const bf16_t* vg = p.AV + (size_t)(b * 4 + h) * 128 * 2304 + (size_t)(tid >> 3) * 2304 + (tid & 7) * 8;
    uint4 k0, k1, k2, k3, v0, v1, v2, v3;
#define DA_LOAD(KEY0) { k0 = *(const uint4*)(kg + (size_t)(KEY0) * 64); k1 = *(const uint4*)(kg + (size_t)((KEY0) + 32) * 64); \
                        k2 = *(const uint4*)(kg + (size_t)2304 * 64 + (size_t)(KEY0) * 64); k3 = *(const uint4*)(kg + (size_t)2304 * 64 + (size_t)((KEY0) + 32) * 64); \
                        v0 = *(const uint4*)(vg + (KEY0)); v1 = *(const uint4*)(vg + (size_t)32 * 2304 + (KEY0)); v2 = *(const uint4*)(vg + (size_t)64 * 2304 + (KEY0)); v3 = *(const uint4*)(vg + (size_t)96 * 2304 + (KEY0)); }
#define DA_STORE(BUF) { char* kb_ = (BUF) + (tid >> 3) * FA_KROW + (tid & 7) * 16; \
                        *(uint4*)kb_ = k0; *(uint4*)(kb_ + 32 * FA_KROW) = k1; *(uint4*)(kb_ + 64 * FA_KROW) = k2; *(uint4*)(kb_ + 96 * FA_KROW) = k3; \
                        char* vb_ = (BUF) + 18432 + (tid >> 3) * FA_VROW + (tid & 7) * 16; \
                        *(uint2*)vb_ = make_uint2(v0.x, v0.y); *(uint2*)(vb_ + 8) = make_uint2(v0.z, v0.w); \
                        *(uint2*)(vb_ + 32 * FA_VROW) = make_uint2(v1.x, v1.y); *(uint2*)(vb_ + 32 * FA_VROW + 8) = make_uint2(v1.z, v1.w); \
                        *(uint2*)(vb_ + 64 * FA_VROW) = make_uint2(v2.x, v2.y); *(uint2*)(vb_ + 64 * FA_VROW + 8) = make_uint2(v2.z, v2.w); \
                        *(uint2*)(vb_ + 96 * FA_VROW) = make_uint2(v3.x, v3.y); *(uint2*)(vb_ + 96 * FA_VROW + 8) = make_uint2(v3.z, v3.w); }
    f32x16 o[4];
#pragma unroll
    for (int db = 0; db < 4; ++db)
#pragma unroll
        for (int i = 0; i < 16; ++i) o[db][i] = 0.f;
    float m = -1e30f, l = 0.f;
    DA_LOAD(0)
    __syncthreads();
    DA_STORE(smem)
    __syncthreads();
    for (int t = 0; t < ntile; ++t) {
        char* cur = smem + (t & 1) * DA_BUFB;
        char* nxt = smem + ((t + 1) & 1) * DA_BUFB;
        if (t + 1 < ntile) DA_LOAD((t + 1) * 64)
        flash_tile<4, false>(qf, o, m, l, cur + mp * 9216, cur + 18432, lane, 0, 0);
        if (t + 1 < ntile) DA_STORE(nxt)
        __syncthreads();
    }
#undef DA_LOAD
#undef DA_STORE
    const float inv = 1.f / (l + SHX(l, 32));
#pragma unroll
    for (int db = 0; db < 4; ++db) o[db] = o[db] * inv;
    float* X = (float*)smem + qg * 4096;
    if (mp == 1) {
#pragma unroll
        for (int db = 0; db < 4; ++db)
#pragma unroll
            for (int r = 0; r < 16; ++r) X[(db * 32 + (r & 3) + 8 * (r >> 2) + 4 * hh) * 32 + jq] = o[db][r];
    }
    __syncthreads();
    if (mp == 0) {
        const float lam_init = 0.8f - 0.6f * expf(-0.3f * (float)L);
        const float* lp = p.ev_da_lam + (size_t)j * 256;
        float a0 = lp[lane] * lp[64 + lane], a1 = lp[128 + lane] * lp[192 + lane];
        a0 = wave_sum(a0); a1 = wave_sum(a1);
        const float lam = expf(a0) - expf(a1) + lam_init;
        float ss = 0.f;
#pragma unroll
        for (int db = 0; db < 4; ++db)
#pragma unroll
            for (int r = 0; r < 16; ++r) { const float v = o[db][r] - lam * X[(db * 32 + (r & 3) + 8 * (r >> 2) + 4 * hh) * 32 + jq]; o[db][r] = v; ss += v * v; }
        ss += SHX(ss, 32);
        const float sc = rsqrtf(ss * (1.f / 128.f) + 1e-6f) * (1.f - lam_init);
        const int row = lat ? b * 2048 + qi : NL + b * 256 + qi;
        bf16_t* mrow = p.MIX + (size_t)row * DM + 512 + h * 128;
        const float* g = p.ev_da_g + (size_t)j * 512 + h * 128;
#pragma unroll
        for (int db = 0; db < 4; ++db)
#pragma unroll
            for (int r4 = 0; r4 < 4; ++r4) {
                const int d = db * 32 + 8 * r4 + 4 * hh;
                const f32x4 gg = *(const f32x4*)(g + d);
                *(uint2*)(mrow + d) = make_uint2(cvt_pk_bf16(o[db][r4 * 4 + 0] * sc * gg[0], o[db][r4 * 4 + 1] * sc * gg[1]), cvt_pk_bf16(o[db][r4 * 4 + 2] * sc * gg[2], o[db][r4 * 4 + 3] * sc * gg[3]));
            }
    }
    __syncthreads();
}

#define WA_BUFB 17920
__device__ void wa_block(const P& p, int item, int j, char* smem) {
    const int tid = otid(), lane = tid & 63, wid = tid >> 6, jq = lane & 31, hh = lane >> 5;
    const bool lat = item < 2048;
    int b, nb, hq;
    if (lat) { hq = item & 15; nb = (item >> 4) & 15; b = item >> 8; } else { const int it = item - 2048; hq = it & 15; nb = (it >> 4) & 1; b = it >> 5; }
    const int hkv = hq >> 2;
    const int qi = nb * 128 + wid * 32 + jq;
    const bf16_t* qp = lat ? p.AQL + ((size_t)(b * 16 + hq) * 2048 + qi) * 64 : p.AQC + ((size_t)(b * 16 + hq) * 256 + qi) * 64;
    bf16x8 qf[4];
#pragma unroll
    for (int ks = 0; ks < 4; ++ks) qf[ks] = *(const bf16x8*)(qp + (2 * ks + hh) * 8);
    const int lfirst = (nb == 0) ? 2 : 0, nloc = lat ? 6 - lfirst - ((nb == 15) ? 2 : 0) : 0;
    const int ntile = 4 + nloc;
    const bf16_t* kg = p.AK + (size_t)(b * 4 + hkv) * 2304 * 64 + (size_t)(tid >> 3) * 64 + (tid & 7) * 8;
    const bf16_t* vg = p.AV + (size_t)(b * 4 + hkv) * 64 * 2304 + (size_t)(tid >> 3) * 2304 + (tid & 7) * 8;
    uint4 k0, k1, v0, v1;
#define WA_KEY0(T) ((T) < 4 ? (T) * 64 : 256 + (nb - 1) * 128 + ((T) - 4 + lfirst) * 64)
#define WA_LOAD(KEY0) { k0 = *(const uint4*)(kg + (size_t)(KEY0) * 64); k1 = *(const uint4*)(kg + (size_t)((KEY0) + 32) * 64); v0 = *(const uint4*)(vg + (KEY0)); v1 = *(const uint4*)(vg + (size_t)32 * 2304 + (KEY0)); }
#define WA_STORE(BUF) { char* kb_ = (BUF) + (tid >> 3) * FA_KROW + (tid & 7) * 16; *(uint4*)kb_ = k0; *(uint4*)(kb_ + 32 * FA_KROW) = k1; \
                        char* vb_ = (BUF) + 9216 + (tid >> 3) * FA_VROW + (tid & 7) * 16; \
                        *(uint2*)vb_ = make_uint2(v0.x, v0.y); *(uint2*)(vb_ + 8) = make_uint2(v0.z, v0.w); \
                        *(uint2*)(vb_ + 32 * FA_VROW) = make_uint2(v1.x, v1.y); *(uint2*)(vb_ + 32 * FA_VROW + 8) = make_uint2(v1.z, v1.w); }
    f32x16 o[2];
#pragma unroll
    for (int db = 0; db < 2; ++db)
#pragma unroll
        for (int i = 0; i < 16; ++i) o[db][i] = 0.f;
    float m = p.od_sink[j * 16 + hq] * 1.4426950408889634f, l = hh == 0 ? 1.f : 0.f;
    { const int key0 = WA_KEY0(0); WA_LOAD(key0) }
    __syncthreads();
    WA_STORE(smem)
    __syncthreads();
    for (int t = 0; t < ntile; ++t) {
        char* cur = smem + (t & 1) * WA_BUFB;
        char* nxt = smem + ((t + 1) & 1) * WA_BUFB;
        if (t + 1 < ntile) { const int key0 = WA_KEY0(t + 1); WA_LOAD(key0) }
        if (t < 4) flash_tile<2, false>(qf, o, m, l, cur, cur + 9216, lane, 0, 0);
        else flash_tile<2, true>(qf, o, m, l, cur, cur + 9216, lane, qi, WA_KEY0(t) - 256);
        if (t + 1 < ntile) WA_STORE(nxt)
        __syncthreads();
    }
#undef WA_LOAD
#undef WA_STORE
#undef WA_KEY0
    const float inv = 1.f / (l + SHX(l, 32));
    const int row = lat ? b * 2048 + qi : NL + b * 256 + qi;
    bf16_t* mrow = p.MIX + (size_t)row * DM + hq * 64;
#pragma unroll
    for (int db = 0; db < 2; ++db)
#pragma unroll
        for (int r4 = 0; r4 < 4; ++r4) {
            const int d = db * 32 + 8 * r4 + 4 * hh;
            *(uint2*)(mrow + d) = make_uint2(cvt_pk_bf16(o[db][r4 * 4 + 0] * inv, o[db][r4 * 4 + 1] * inv), cvt_pk_bf16(o[db][r4 * 4 + 2] * inv, o[db][r4 * 4 + 3] * inv));
        }
}

__device__ __forceinline__ uint4 ml_conv8(const P& p, int j, int b, int tc, int st, int c0) {
    const int row = tc < 4 ? NL + b * 256 + tc * 64 + st : b * 2048 + (tc - 4) * 64 + st;
    const int t = tc < 4 ? tc * 64 + st : (tc - 4) * 64 + st, T = tc < 4 ? 256 : 2048;
    const float* cw = p.ev_conv_w + (size_t)j * 3 * 512 + c0; const float* cb = p.ev_conv_b + (size_t)j * 512 + c0;
    const uint4 x1 = *(const uint4*)(p.PB + (size_t)row * 1536 + c0);
    uint4 x0 = make_uint4(0u, 0u, 0u, 0u), x2 = x0;
    if (t > 0) x0 = *(const uint4*)(p.PB + (size_t)(row - 1) * 1536 + c0);
    if (t < T - 1) x2 = *(const uint4*)(p.PB + (size_t)(row + 1) * 1536 + c0);
    float a[8], bq[8], cq[8]; unpack8(x0, a); unpack8(x1, bq); unpack8(x2, cq);
    const float sc = c0 >= 256 ? 0.125f : 1.f;
    float o[8];
#pragma unroll
    for (int q = 0; q < 8; ++q) o[q] = silu_f(cb[q] + a[q] * cw[q] + bq[q] * cw[512 + q] + cq[q] * cw[1024 + q]) * sc;
    return make_uint4(cvt_pk_bf16(o[0], o[1]), cvt_pk_bf16(o[2], o[3]), cvt_pk_bf16(o[4], o[5]), cvt_pk_bf16(o[6], o[7]));
}
__device__ __forceinline__ int ml_row(int b, int tc, int i) { return tc < 4 ? NL + b * 256 + tc * 64 + i : b * 2048 + (tc - 4) * 64 + i; }
__device__ __forceinline__ void ml_gates(const P& p, int j, int b, int h, int dir, int tc, int lane, float* sa, float* sb, float* sml, float& Bt, float& Mc) {
    const int row = ml_row(b, tc, lane);
    const float ig = p.GT[(size_t)row * 16 + (dir * 2) * 4 + h] + p.ev_gate_b[j * 16 + (dir * 2) * 4 + h];
    const float lf = log_sigmoid_f(p.GT[(size_t)row * 16 + (dir * 2 + 1) * 4 + h] + p.ev_gate_b[j * 16 + (dir * 2 + 1) * 4 + h]);
    float bc = lf;
    if (dir == 0) {
#pragma unroll
        for (int o = 1; o < 64; o <<= 1) { const float t2 = lshfl(bc, lane - o); if (lane >= o) bc += t2; }
    } else {
#pragma unroll
        for (int o = 1; o < 64; o <<= 1) { const float t2 = lshfl(bc, lane + o); if (lane + o < 64) bc += t2; }
    }
    const float a = ig - bc;
    float ml = a;
    if (dir == 0) {
#pragma unroll
        for (int o = 1; o < 64; o <<= 1) { const float t2 = lshfl(ml, lane - o); if (lane >= o) ml = fmaxf(ml, t2); }
    } else {
#pragma unroll
        for (int o = 1; o < 64; o <<= 1) { const float t2 = lshfl(ml, lane + o); if (lane + o < 64) ml = fmaxf(ml, t2); }
    }
    sa[lane] = a; sb[lane] = bc; sml[lane] = ml;
    const int last = dir == 0 ? 63 : 0;
    Bt = lshfl(bc, last); Mc = lshfl(ml, last);
}
__device__ __forceinline__ int ml_tc_of(int dir, int c) { return dir == 0 ? c : (c < 4 ? 3 - c : 39 - c); }
__device__ __forceinline__ int ml_c_of(int dir, int tc) { return dir == 0 ? tc : (tc < 4 ? 3 - tc : 39 - tc); }

__device__ void ml_pass1_item(const P& p, int item, int j, char* smem) {
    const int c = item % 36, dir = (item / 36) & 1, h = (item / 72) & 3, b = item / 288;
    const int tc = ml_tc_of(dir, c);
    const int tid = otid(), lane = tid & 63, wid = tid >> 6, jl = lane & 31, hh = lane >> 5;
    bf16_t* VT = (bf16_t*)smem;
    bf16_t* KWT = (bf16_t*)(smem + 18432);
    float* sa = (float*)(smem + 27648);
    float* sb = sa + 64; float* sml = sb + 64; float* sw = sml + 64; float* ssc = sw + 64;
    __syncthreads();
    if (wid == 0) {
        float Bt, Mc; ml_gates(p, j, b, h, dir, tc, lane, sa, sb, sml, Bt, Mc);
        sw[lane] = expf(sa[lane] - Mc);
        if (lane == 0) { p.CHB[item] = Bt; p.CHM[item] = Mc; }
    }
    __syncthreads();
#pragma unroll
    for (int i = 0; i < 4; ++i) {
        const int e = tid + 256 * i, st = e >> 4, ch = e & 15;
        const uint4 u = *(const uint4*)(p.PB + (size_t)ml_row(b, tc, st) * 1536 + 512 + h * 128 + ch * 8);
        bf16_t* d = VT + (ch * 8) * 72 + st;
        d[0] = (bf16_t)u.x; d[72] = (bf16_t)(u.x >> 16); d[144] = (bf16_t)u.y; d[216] = (bf16_t)(u.y >> 16);
        d[288] = (bf16_t)u.z; d[360] = (bf16_t)(u.z >> 16); d[432] = (bf16_t)u.w; d[504] = (bf16_t)(u.w >> 16);
    }
#pragma unroll
    for (int i = 0; i < 2; ++i) {
        const int e = tid + 256 * i, st = e >> 3, ch = e & 7;
        const uint4 u = ml_conv8(p, j, b, tc, st, 256 + h * 64 + ch * 8);
        const float w = sw[st];
        bf16_t* d = KWT + (ch * 8) * 72 + st;
        const unsigned q0 = cvt_pk_bf16(bf_lo(u.x) * w, bf_hi(u.x) * w), q1 = cvt_pk_bf16(bf_lo(u.y) * w, bf_hi(u.y) * w), q2 = cvt_pk_bf16(bf_lo(u.z) * w, bf_hi(u.z) * w), q3 = cvt_pk_bf16(bf_lo(u.w) * w, bf_hi(u.w) * w);
        d[0] = (bf16_t)q0; d[72] = (bf16_t)(q0 >> 16); d[144] = (bf16_t)q1; d[216] = (bf16_t)(q1 >> 16);
        d[288] = (bf16_t)q2; d[360] = (bf16_t)(q2 >> 16); d[432] = (bf16_t)q3; d[504] = (bf16_t)(q3 >> 16);
    }
    __syncthreads();
    {
        const int db = wid & 1, vb0 = (wid >> 1) * 2;
        bf16x8 kf[4];
#pragma unroll
        for (int ks = 0; ks < 4; ++ks) kf[ks] = *(const bf16x8*)((const char*)KWT + (db * 32 + jl) * 144 + (2 * ks + hh) * 16);
        float* cl = p.CLOC + (size_t)item * 8192;
#pragma unroll
        for (int vv = 0; vv < 2; ++vv) {
            const int vb = vb0 + vv;
            f32x16 acc;
#pragma unroll
            for (int r = 0; r < 16; ++r) acc[r] = 0.f;
#pragma unroll
            for (int ks = 0; ks < 4; ++ks) {
                const bf16x8 vf = *(const bf16x8*)((const char*)VT + (vb * 32 + jl) * 144 + (2 * ks + hh) * 16);
                acc = __builtin_amdgcn_mfma_f32_32x32x16_bf16(vf, kf[ks], acc, 0, 0, 0);
            }
#pragma unroll
            for (int r = 0; r < 16; ++r) cl[(size_t)(vb * 32 + (r & 3) + 8 * (r >> 2) + 4 * hh) * 64 + db * 32 + jl] = acc[r];
        }
        if (tid < 64) {
            float sum = 0.f;
#pragma unroll
            for (int q = 0; q < 8; ++q) { const uint4 u = *(const uint4*)((const char*)KWT + tid * 144 + q * 16); sum += bf_lo(u.x) + bf_hi(u.x) + bf_lo(u.y) + bf_hi(u.y) + bf_lo(u.z) + bf_hi(u.z) + bf_lo(u.w) + bf_hi(u.w); }
            p.NLOC[(size_t)item * 64 + tid] = sum;
        }
    }
}

__device__ void ph_ml_pass2(const P& p) {
    const int gt = blockIdx.x * 256 + otid(), nthr = gridDim.x * 256;
    for (int w = gt; w < 64 * 2048; w += nthr) {
        const int chain = w >> 11, e = (w & 2047) * 4;
        float c0 = 0.f, c1 = 0.f, c2 = 0.f, c3 = 0.f, m = 0.f;
        for (int c = 0; c < 36; ++c) {
            const int it = chain * 36 + c;
            *(uint2*)(p.CST + (size_t)it * 8192 + e) = make_uint2(cvt_pk_bf16(c0, c1), cvt_pk_bf16(c2, c3));
            const float Bt = p.CHB[it], Mc = p.CHM[it];
            const float g = fmaxf(m, Mc), al = expf(m - g), be = expf(Mc - g);
            const float4 cl = *(const float4*)(p.CLOC + (size_t)it * 8192 + e);
            c0 = al * c0 + be * cl.x; c1 = al * c1 + be * cl.y; c2 = al * c2 + be * cl.z; c3 = al * c3 + be * cl.w;
            m = Bt + g;
        }
    }
    for (int w = gt; w < 64 * 64; w += nthr) {
        const int chain = w >> 6, d = w & 63;
        float n = 0.f, m = 0.f;
        for (int c = 0; c < 36; ++c) {
            const int it = chain * 36 + c;
            p.NST[(size_t)it * 64 + d] = n;
            if (d == 0) p.MST[it] = m;
            const float Bt = p.CHB[it], Mc = p.CHM[it];
            const float g = fmaxf(m, Mc);
            n = expf(m - g) * n + expf(Mc - g) * p.NLOC[(size_t)it * 64 + d];
            m = Bt + g;
        }
    }
}

__device__ void ml_pass3_item(const P& p, int item, int j, char* smem) {
    const int tc = item % 36, h = (item / 36) & 3, b = item / 144;
    const int tid = otid(), lane = tid & 63, wid = tid >> 6, jl = lane & 31, hh = lane >> 5, tb = wid & 1, dir = wid >> 1;
    char* Ql = smem;
    char* Kl = smem + 9216;
    bf16_t* VT = (bf16_t*)(smem + 18432);
    float* gs = (float*)(smem + 35840);
    float* ssc = gs + 512;
    __syncthreads();
    if (wid < 2) {
        const int d2 = wid; float Bt, Mc;
        float* sa = gs + d2 * 256; float* sb = sa + 64; float* sg = sb + 64; float* sn = sg + 64;
        ml_gates(p, j, b, h, d2, tc, lane, sa, sb, sg, Bt, Mc);
        const int sidx = ((b * 4 + h) * 2 + d2) * 36 + ml_c_of(d2, tc);
        const float mst = p.MST[sidx];
        sg[lane] = fmaxf(mst, sg[lane]);
        sn[lane] = p.NST[(size_t)sidx * 64 + lane];
        if (lane == 0) ssc[d2] = mst;
    }
#pragma unroll
    for (int i = 0; i < 2; ++i) {
        const int e = tid + 256 * i, st = e >> 3, ch = e & 7; const int row = ml_row(b, tc, st);
        *(uint4*)(Ql + st * 144 + ch * 16) = ml_conv8(p, j, b, tc, st, h * 64 + ch * 8);
        *(uint4*)(Kl + st * 144 + ch * 16) = ml_conv8(p, j, b, tc, st, 256 + h * 64 + ch * 8);
    }
#pragma unroll
    for (int i = 0; i < 4; ++i) {
        const int e = tid + 256 * i, st = e >> 4, ch = e & 15;
        const uint4 u = *(const uint4*)(p.PB + (size_t)ml_row(b, tc, st) * 1536 + 512 + h * 128 + ch * 8);
        bf16_t* d = VT + (ch * 8) * 68 + st;
        d[0] = (bf16_t)u.x; d[68] = (bf16_t)(u.x >> 16); d[136] = (bf16_t)u.y; d[204] = (bf16_t)(u.y >> 16);
        d[272] = (bf16_t)u.z; d[340] = (bf16_t)(u.z >> 16); d[408] = (bf16_t)u.w; d[476] = (bf16_t)(u.w >> 16);
    }
    __syncthreads();
    const float* sa = gs + dir * 256; const float* sb = sa + 64; const float* sg = sb + 64; const float* sn = sg + 64;
    const int t = tb * 32 + jl;
    const float gtv = sg[t], btv = sb[t], mst = ssc[dir];
    const float e2 = expf(mst - gtv);
    const int sidx = ((b * 4 + h) * 2 + dir) * 36 + ml_c_of(dir, tc);
    bf16x8 qf[4];
#pragma unroll
    for (int ks = 0; ks < 4; ++ks) qf[ks] = *(const bf16x8*)(Ql + t * 144 + (2 * ks + hh) * 16);
    f32x16 acc[4];
    {
        const bf16_t* cst = p.CST + (size_t)sidx * 8192 + (size_t)jl * 64 + hh * 8;
#pragma unroll
        for (int vb = 0; vb < 4; ++vb) {
#pragma unroll
            for (int r = 0; r < 16; ++r) acc[vb][r] = 0.f;
#pragma unroll
            for (int ks = 0; ks < 4; ++ks) {
                const bf16x8 cf = *(const bf16x8*)(cst + (size_t)vb * 32 * 64 + ks * 16);
                acc[vb] = __builtin_amdgcn_mfma_f32_32x32x16_bf16(cf, qf[ks], acc[vb], 0, 0, 0);
            }
            acc[vb] = acc[vb] * e2;
        }
    }
    float den = 0.f;
    {
        float nq = 0.f;
#pragma unroll
        for (int ks = 0; ks < 4; ++ks) {
            const u32x4 u = __builtin_bit_cast(u32x4, qf[ks]);
            const float* np = sn + 16 * ks + 8 * hh;
            nq += bf_lo(u[0]) * np[0] + bf_hi(u[0]) * np[1] + bf_lo(u[1]) * np[2] + bf_hi(u[1]) * np[3] + bf_lo(u[2]) * np[4] + bf_hi(u[2]) * np[5] + bf_lo(u[3]) * np[6] + bf_hi(u[3]) * np[7];
        }
        den = e2 * nq;
    }
#pragma unroll
    for (int sbk = 0; sbk < 2; ++sbk) {
        const bool use = dir == 0 ? (sbk <= tb) : (sbk >= tb);
        if (use) {
            f32x16 sc;
#pragma unroll
            for (int r = 0; r < 16; ++r) sc[r] = 0.f;
#pragma unroll
            for (int ks = 0; ks < 4; ++ks) {
                const bf16x8 kf = *(const bf16x8*)(Kl + (sbk * 32 + jl) * 144 + (2 * ks + hh) * 16);
                sc = __builtin_amdgcn_mfma_f32_32x32x16_bf16(kf, qf[ks], sc, 0, 0, 0);
            }
#pragma unroll
            for (int r4 = 0; r4 < 4; ++r4) {
                const int s0 = sbk * 32 + 8 * r4 + 4 * hh;
                const f32x4 av = *(const f32x4*)(sa + s0);
#pragma unroll
                for (int q = 0; q < 4; ++q) {
                    const int s2 = s0 + q;
                    const bool ok = dir == 0 ? (s2 <= t) : (s2 >= t);
                    const float pv = ok ? sc[r4 * 4 + q] * expf(av[q] - gtv) : 0.f;
                    sc[r4 * 4 + q] = pv; den += pv;
                }
            }
            bf16x8 pb[2];
            pb[0] = pack8(sc[0], sc[1], sc[2], sc[3], sc[4], sc[5], sc[6], sc[7]);
            pb[1] = pack8(sc[8], sc[9], sc[10], sc[11], sc[12], sc[13], sc[14], sc[15]);
#pragma unroll
            for (int vb = 0; vb < 4; ++vb)
#pragma unroll
                for (int k2 = 0; k2 < 2; ++k2) {
                    const char* vp = (const char*)VT + (vb * 32 + jl) * 136 + (sbk * 32 + k2 * 16 + 4 * hh) * 2;
                    const uint2 lo = *(const uint2*)vp, hi = *(const uint2*)(vp + 16);
                    const u32x4 u = (u32x4){lo.x, lo.y, hi.x, hi.y};
                    acc[vb] = __builtin_amdgcn_mfma_f32_32x32x16_bf16(__builtin_bit_cast(bf16x8, u), pb[k2], acc[vb], 0, 0, 0);
                }
        }
    }
    den += SHX(den, 32);
    const float scl = 1.f / fmaxf(fabsf(den), expf(-(btv + gtv)));
#pragma unroll
    for (int vb = 0; vb < 4; ++vb) acc[vb] = acc[vb] * scl;
    __syncthreads();
    float* X = (float*)smem + tb * 4096;
    if (dir == 1) {
#pragma unroll
        for (int vb = 0; vb < 4; ++vb)
#pragma unroll
            for (int r = 0; r < 16; ++r) X[(vb * 32 + (r & 3) + 8 * (r >> 2) + 4 * hh) * 32 + jl] = acc[vb][r];
    }
    __syncthreads();
    if (dir == 0) {
        float ss = 0.f;
#pragma unroll
        for (int vb = 0; vb < 4; ++vb)
#pragma unroll
            for (int r = 0; r < 16; ++r) { const float v = acc[vb][r] + X[(vb * 32 + (r & 3) + 8 * (r >> 2) + 4 * hh) * 32 + jl]; acc[vb][r] = v; ss += v * v; }
        ss += SHX(ss, 32);
        const float rstd = rsqrtf(ss * (1.f / 128.f) + 1e-6f);
        const int row = ml_row(b, tc, t);
        const float* g = p.ev_ml_g + (size_t)j * 512 + h * 128;
        const bf16_t* og = p.PB + (size_t)row * 1536 + 1024 + h * 128;
        bf16_t* mrow = p.MIX + (size_t)row * DM + h * 128;
#pragma unroll
        for (int vb = 0; vb < 4; ++vb)
#pragma unroll
            for (int r4 = 0; r4 < 4; ++r4) {
                const int v = vb * 32 + 8 * r4 + 4 * hh;
                const f32x4 gg = *(const f32x4*)(g + v);
                const uint2 ou = *(const uint2*)(og + v);
                *(uint2*)(mrow + v) = make_uint2(cvt_pk_bf16(acc[vb][r4 * 4 + 0] * rstd * gg[0] * sigmoid_f(bf_lo(ou.x)), acc[vb][r4 * 4 + 1] * rstd * gg[1] * sigmoid_f(bf_hi(ou.x))),
                                                 cvt_pk_bf16(acc[vb][r4 * 4 + 2] * rstd * gg[2] * sigmoid_f(bf_lo(ou.y)), acc[vb][r4 * 4 + 3] * rstd * gg[3] * sigmoid_f(bf_hi(ou.y))));
            }
    }
}

__device__ void ph_attn_even(const P& p, int ci, int L, int j, float* smem) {
    int* s_item = (int*)((char*)smem + 73728);
    for (;;) {
        __syncthreads();
        if (otid() == 0) *s_item = atomicAdd(&p.ctr[ci], 1);
        __syncthreads();
        const int item = *s_item;
        if (item >= 1152 + 2304) break;
        if (item < 1152) da_block(p, item, L, j, (char*)smem); else ml_pass1_item(p, item - 1152, j, (char*)smem);
    }
}
__device__ void ph_ml_pass3(const P& p, int j, float* smem) {
    for (int item = blockIdx.x; item < 1152; item += gridDim.x) ml_pass3_item(p, item, j, (char*)smem);
}
__device__ void ph_attn_odd(const P& p, int j, bool need_ctx, float* smem) {
    const int nitem = need_ctx ? 2304 : 2048;
    for (int item = blockIdx.x; item < nitem; item += gridDim.x) { wa_block(p, item, j, (char*)smem); __syncthreads(); }
}

#define SEL_LD 132
template <int NV>
__device__ __forceinline__ unsigned topk16_threshold(const unsigned (&k)[NV], unsigned start) {
    auto cnt = [&](unsigned c) { int n = 0;
#pragma unroll
        for (int i = 0; i < NV; ++i) n += __builtin_popcountll(__ballot(k[i] >= c));
        return n; };
    unsigned E = start; int n = cnt(E);
    if (n >= 16) { for (;;) { const unsigned E2 = E + 0x800000u; if (E2 < E) break; const int n2 = cnt(E2); if (n2 < 16) break; E = E2; n = n2; } }
    else { do { E -= 0x800000u; n = cnt(E); } while (n < 16); }
    unsigned T = E;
    for (int bit = 22; bit >= 0 && n != 16; --bit) { const unsigned c = T | (1u << bit); n = cnt(c); if (n >= 16) T = c; else n = 17; }
    return T;
}
__device__ __forceinline__ unsigned fkey(float f) { const unsigned u = __float_as_uint(f); return (u & 0x80000000u) ? ~u : (u | 0x80000000u); }
__device__ __forceinline__ unsigned mbcnt64(unsigned long long m) { return __builtin_amdgcn_mbcnt_hi((unsigned)(m >> 32), __builtin_amdgcn_mbcnt_lo((unsigned)m, 0u)); }
__device__ void ph_peer_select(const P& p, int L, int nrows, char* smem) {
    float* S = (float*)smem;
    const int tid = otid(), lane = tid & 63, wid = tid >> 6, fr = lane & 15, fq = lane >> 4;
    const bf16_t* KBL = p.KB + (size_t)L * 8 * 2 * 128 * 128;
    const int ntile = nrows / 32;
    bf16x8 kfr[8][4];
    int hcur = -1;
    for (int item = blockIdx.x; item < ntile * 8; item += gridDim.x) {
        const int h = item & 7, t0 = (item >> 3) * 32;
        __syncthreads();
        {
            const int pp = wid >> 1, th = wid & 1;
            const bf16_t* qp = p.QB + (size_t)(t0 + th * 16 + fr) * 2048 + h * 256 + pp * 128 + fq * 8;
            bf16x8 qf[4];
#pragma unroll
            for (int ks = 0; ks < 4; ++ks) qf[ks] = *(const bf16x8*)(qp + ks * 32);
#ifndef SEL_NOCACHE
            if (h != hcur)
#endif
            {
                const bf16_t* kp = KBL + ((size_t)(h * 2 + pp) * 128 + fr) * 128 + fq * 8;
#pragma unroll
                for (int ni = 0; ni < 8; ++ni)
#pragma unroll
                    for (int ks = 0; ks < 4; ++ks) kfr[ni][ks] = *(const bf16x8*)(kp + (size_t)ni * 16 * 128 + ks * 32);
                hcur = h;
            }
#pragma unroll
            for (int ni = 0; ni < 8; ++ni) {
                f32x4 acc = (f32x4){0.f, 0.f, 0.f, 0.f};
#pragma unroll
                for (int ks = 0; ks < 4; ++ks) acc = __builtin_amdgcn_mfma_f32_16x16x32_bf16(qf[ks], kfr[ni][ks], acc, 0, 0, 0);
#pragma unroll
                for (int j = 0; j < 4; ++j) S[(pp * 32 + th * 16 + fq * 4 + j) * SEL_LD + ni * 16 + fr] = acc[j];
            }
        }
        __syncthreads();
        for (int tt = 0; tt < 8; ++tt) {
            const int t = wid * 8 + tt, r = t0 + t;
            const float v00 = S[t * SEL_LD + lane], v01 = S[t * SEL_LD + 64 + lane], v10 = S[(32 + t) * SEL_LD + lane], v11 = S[(32 + t) * SEL_LD + 64 + lane];
            const unsigned ka0 = fkey(v00), ka1 = fkey(v01), kb0 = fkey(v10), kb1 = fkey(v11);
            const unsigned kA[2] = {ka0, ka1}, kB[2] = {kb0, kb1};
            const unsigned T0 = topk16_threshold<2>(kA, 0xBF800000u), T1 = topk16_threshold<2>(kB, 0xBF800000u);
            float* wsA = (float*)(smem + 34816 + wid * 512);
            {
                const unsigned long long g0 = __ballot(ka0 > T0), g1 = __ballot(ka1 > T0), e0 = __ballot(ka0 == T0), e1 = __ballot(ka1 == T0);
                const int need = 16 - __builtin_popcountll(g0) - __builtin_popcountll(g1);
                const int pe0 = __builtin_popcountll(e0), need1 = need - (pe0 < need ? pe0 : need);
                const bool s0 = (ka0 > T0) || (ka0 == T0 && (int)mbcnt64(e0) < need);
                const bool s1 = (ka1 > T0) || (ka1 == T0 && (int)mbcnt64(e1) < need1);
                const unsigned long long m0 = __ballot(s0), m1 = __ballot(s1);
                if (s0) { const int pos = mbcnt64(m0); wsA[pos] = v00; ((int*)wsA)[16 + pos] = lane; }
                if (s1) { const int pos = __builtin_popcountll(m0) + mbcnt64(m1); wsA[pos] = v01; ((int*)wsA)[16 + pos] = 64 + lane; }
            }
            {
                const unsigned long long g0 = __ballot(kb0 > T1), g1 = __ballot(kb1 > T1), e0 = __ballot(kb0 == T1), e1 = __ballot(kb1 == T1);
                const int need = 16 - __builtin_popcountll(g0) - __builtin_popcountll(g1);
                const int pe0 = __builtin_popcountll(e0), need1 = need - (pe0 < need ? pe0 : need);
                const bool s0 = (kb0 > T1) || (kb0 == T1 && (int)mbcnt64(e0) < need);
                const bool s1 = (kb1 > T1) || (kb1 == T1 && (int)mbcnt64(e1) < need1);
                const unsigned long long m0 = __ballot(s0), m1 = __ballot(s1);
                if (s0) { const int pos = mbcnt64(m0); wsA[32 + pos] = v10; ((int*)wsA)[48 + pos] = lane; }
                if (s1) { const int pos = __builtin_popcountll(m0) + mbcnt64(m1); wsA[32 + pos] = v11; ((int*)wsA)[48 + pos] = 64 + lane; }
            }
            __builtin_amdgcn_wave_barrier();
            float cand[4]; int cidx[4]; unsigned kc[4];
            {
                const float av = wsA[lane >> 2]; const int ai = ((int*)wsA)[16 + (lane >> 2)];
                const float4 bv = *(const float4*)(wsA + 32 + (lane & 3) * 4); const int4 bi = *(const int4*)((int*)wsA + 48 + (lane & 3) * 4);
                cand[0] = av + bv.x; cand[1] = av + bv.y; cand[2] = av + bv.z; cand[3] = av + bv.w;
                cidx[0] = ai * 128 + bi.x; cidx[1] = ai * 128 + bi.y; cidx[2] = ai * 128 + bi.z; cidx[3] = ai * 128 + bi.w;
#pragma unroll
                for (int c = 0; c < 4; ++c) kc[c] = fkey(cand[c]);
            }
            const unsigned T = topk16_threshold<4>(kc, 0xC0800000u);
            {
                int need = 16, base = 0;
#pragma unroll
                for (int c = 0; c < 4; ++c) need -= __builtin_popcountll(__ballot(kc[c] > T));
#pragma unroll
                for (int c = 0; c < 4; ++c) {
                    const unsigned long long e = __ballot(kc[c] == T);
                    const bool sel = (kc[c] > T) || (kc[c] == T && (int)mbcnt64(e) < need);
                    const int pe = __builtin_popcountll(e); need -= (pe < need ? pe : need);
                    const unsigned long long m = __ballot(sel);
                    if (sel) { const int pos = base + mbcnt64(m); wsA[64 + pos] = cand[c]; ((int*)wsA)[80 + pos] = cidx[c]; }
                    base += __builtin_popcountll(m);
                }
            }
            __builtin_amdgcn_wave_barrier();
            {
                const float cv = lane < 16 ? wsA[64 + lane] : -INFINITY;
                const float mx = wave_max(cv);
                const float ex = lane < 16 ? __builtin_amdgcn_exp2f((cv - mx) * 1.4426950408889634f) : 0.f;
                const float sum = wave_sum(ex);
                if (lane < 16) { p.GATE[(size_t)r * 128 + h * 16 + lane] = ex / sum; p.EIDX[(size_t)r * 128 + h * 16 + lane] = ((int*)wsA)[80 + lane]; }
            }
            __builtin_amdgcn_wave_barrier();
        }
    }
}


__device__ __forceinline__ int wave_sum_i(int v, int lane) {
    v += __builtin_amdgcn_update_dpp(0, v, 0xB1, 0xF, 0xF, true);
    v += __builtin_amdgcn_update_dpp(0, v, 0x4E, 0xF, 0xF, true);
    v += __builtin_amdgcn_update_dpp(0, v, 0x141, 0xF, 0xF, true);
    v += __builtin_amdgcn_update_dpp(0, v, 0x140, 0xF, 0xF, true);
    v += __builtin_amdgcn_update_dpp(0, v, 0x142, 0xA, 0xF, false);
    v += __builtin_amdgcn_update_dpp(0, v, 0x143, 0xC, 0xF, false);
    return __builtin_amdgcn_readlane(v, 63);
}
__device__ void ph_peer_gather(const P& p, int L, int nrows, float oscale) {
    const int lane = otid() & 63, wid = __builtin_amdgcn_readfirstlane(otid() >> 6);
    const unsigned char* U = p.U8 + (size_t)L * 16384 * 1024; const unsigned char* V = p.V8 + (size_t)L * 16384 * 1024;
    const float* USC = p.USC + (size_t)L * 16384; const float* VSC = p.VSC + (size_t)L * 16384;
    const float* gate2 = p.modv + (size_t)L * 9 * 6144 + 5120;
    for (int r = blockIdx.x * 4 + wid; r < nrows; r += gridDim.x * 4) {
        const int e0 = p.EIDX[(size_t)r * 128 + lane], e1 = p.EIDX[(size_t)r * 128 + 64 + lane];
        const float g0 = p.GATE[(size_t)r * 128 + lane], g1 = p.GATE[(size_t)r * 128 + 64 + lane];
        const float us0 = USC[e0], us1 = USC[e1], vs0 = VSC[e0], vs1 = VSC[e1];
        const uint4 xq = *(const uint4*)(p.XQ + (size_t)r * DM + lane * 16);
        const float xs = p.XS[r];
        int d0 = 0, d1 = 0;
#pragma unroll
        for (int half = 0; half < 2; ++half) {
            const int ev = half ? e1 : e0;
            int dv = 0;
#pragma unroll 1
            for (int kb = 0; kb < 4; ++kb) {
                uint4 ua[16];
#pragma unroll
                for (int j = 0; j < 16; ++j) {
                    const int idx = __builtin_amdgcn_readlane(ev, kb * 16 + j);
                    ua[j] = *(const uint4*)(U + (size_t)idx * 1024 + lane * 16);
                }
#pragma unroll
                for (int j = 0; j < 16; ++j) {
                    int sdot = __builtin_amdgcn_sdot4((int)xq.x, (int)ua[j].x, 0, false);
                    sdot = __builtin_amdgcn_sdot4((int)xq.y, (int)ua[j].y, sdot, false);
                    sdot = __builtin_amdgcn_sdot4((int)xq.z, (int)ua[j].z, sdot, false);
                    sdot = __builtin_amdgcn_sdot4((int)xq.w, (int)ua[j].w, sdot, false);
                    sdot = wave_sum_i(sdot, lane);
                    if (lane == kb * 16 + j) dv = sdot;
                }
            }
            if (half) d1 = dv; else d0 = dv;
        }
        const float a0 = us0 * xs * (float)d0, a1 = us1 * xs * (float)d1;
        const float w0 = vs0 * g0 * 0.5f * a0 * (1.f + erff(a0 * 0.70710678118654752f));
        const float w1 = vs1 * g1 * 0.5f * a1 * (1.f + erff(a1 * 0.70710678118654752f));
        const float wmax = wave_max(fmaxf(fabsf(w0), fabsf(w1)));
        const float winv = wmax > 0.f ? 127.f / wmax : 0.f;
        const int wq0 = (int)rintf(w0 * winv) & 0xff, wq1 = (int)rintf(w1 * winv) & 0xff;
        int acc[16];
#pragma unroll
        for (int c = 0; c < 16; ++c) acc[c] = 0;
#pragma unroll
        for (int half = 0; half < 2; ++half) {
            const int ev = half ? e1 : e0; const int wqv = half ? wq1 : wq0;
#pragma unroll 1
            for (int kb = 0; kb < 4; ++kb) {
                uint4 ua[16];
#pragma unroll
                for (int j = 0; j < 16; ++j) {
                    const int idx = __builtin_amdgcn_readlane(ev, kb * 16 + j);
                    ua[j] = *(const uint4*)(V + (size_t)idx * 1024 + lane * 16);
                }
#pragma unroll
                for (int j4 = 0; j4 < 4; ++j4) {
                    const int k0 = kb * 16 + j4 * 4;
                    const int wpk = __builtin_amdgcn_readlane(wqv, k0) | (__builtin_amdgcn_readlane(wqv, k0 + 1) << 8) | (__builtin_amdgcn_readlane(wqv, k0 + 2) << 16) | (__builtin_amdgcn_readlane(wqv, k0 + 3) << 24);
#define TR_DOT(D, M) { const unsigned ablo = __builtin_amdgcn_perm(ua[j4 * 4 + 1].M, ua[j4 * 4].M, 0x05010400u), abhi = __builtin_amdgcn_perm(ua[j4 * 4 + 1].M, ua[j4 * 4].M, 0x07030602u); \
                        const unsigned celo = __builtin_amdgcn_perm(ua[j4 * 4 + 3].M, ua[j4 * 4 + 2].M, 0x05010400u), cehi = __builtin_amdgcn_perm(ua[j4 * 4 + 3].M, ua[j4 * 4 + 2].M, 0x07030602u); \
                        acc[(D) * 4 + 0] = __builtin_amdgcn_sdot4((int)__builtin_amdgcn_perm(celo, ablo, 0x05040100u), wpk, acc[(D) * 4 + 0], false); \
                        acc[(D) * 4 + 1] = __builtin_amdgcn_sdot4((int)__builtin_amdgcn_perm(celo, ablo, 0x07060302u), wpk, acc[(D) * 4 + 1], false); \
                        acc[(D) * 4 + 2] = __builtin_amdgcn_sdot4((int)__builtin_amdgcn_perm(cehi, abhi, 0x05040100u), wpk, acc[(D) * 4 + 2], false); \
                        acc[(D) * 4 + 3] = __builtin_amdgcn_sdot4((int)__builtin_amdgcn_perm(cehi, abhi, 0x07060302u), wpk, acc[(D) * 4 + 3], false); }
                    TR_DOT(0, x) TR_DOT(1, y) TR_DOT(2, z) TR_DOT(3, w)
#undef TR_DOT
                }
            }
        }
        const float osc = oscale * wmax * (1.f / 127.f);
        const float* gp = gate2 + (size_t)modrow(r) * 6144 + lane * 16;
        float* hp = p.H + (size_t)r * DM + lane * 16;
        float hn[16]; float ss = 0.f;
#pragma unroll
        for (int q = 0; q < 4; ++q) {
            const float4 g = *(const float4*)(gp + q * 4);
            float4 hv = *(float4*)(hp + q * 4);
            hv.x += osc * g.x * (float)acc[q * 4 + 0]; hv.y += osc * g.y * (float)acc[q * 4 + 1];
            hv.z += osc * g.z * (float)acc[q * 4 + 2]; hv.w += osc * g.w * (float)acc[q * 4 + 3];
            if (L < 3) *(float4*)(hp + q * 4) = hv;
            hn[q * 4 + 0] = hv.x; hn[q * 4 + 1] = hv.y; hn[q * 4 + 2] = hv.z; hn[q * 4 + 3] = hv.w;
            ss += hv.x * hv.x + hv.y * hv.y + hv.z * hv.z + hv.w * hv.w;
        }
        ss = wave_sum(ss);
        const float rstd = rsqrtf(ss * (1.0f / DM) + 1e-6f);
        if (L < 3) {
            const float* g1 = p.norm1_g + (size_t)(L + 1) * DM + lane * 16;
            const float* mvn = p.modv + ((size_t)(L + 1) * 9 + modrow(r)) * 6144 + lane * 16;
            unsigned w[8];
#pragma unroll
            for (int q = 0; q < 4; ++q) {
                const float4 gg = *(const float4*)(g1 + q * 4), sh = *(const float4*)(mvn + q * 4), scl = *(const float4*)(mvn + 1024 + q * 4);
                w[q * 2] = cvt_pk_bf16(hn[q * 4 + 0] * rstd * gg.x * (1.f + scl.x) + sh.x, hn[q * 4 + 1] * rstd * gg.y * (1.f + scl.y) + sh.y);
                w[q * 2 + 1] = cvt_pk_bf16(hn[q * 4 + 2] * rstd * gg.z * (1.f + scl.z) + sh.z, hn[q * 4 + 3] * rstd * gg.w * (1.f + scl.w) + sh.w);
            }
            uint4* xp = (uint4*)(p.XN + (size_t)r * DM + lane * 16);
            xp[0] = make_uint4(w[0], w[1], w[2], w[3]); xp[1] = make_uint4(w[4], w[5], w[6], w[7]);
        } else {
            const float* fg = p.final_g + lane * 16;
            float* op = p.out + (size_t)r * DM + lane * 16;
#pragma unroll
            for (int q = 0; q < 4; ++q) {
                const float4 gg = *(const float4*)(fg + q * 4);
                *(float4*)(op + q * 4) = make_float4(hn[q * 4 + 0] * rstd * gg.x, hn[q * 4 + 1] * rstd * gg.y, hn[q * 4 + 2] * rstd * gg.z, hn[q * 4 + 3] * rstd * gg.w);
            }
        }
    }
}

#define NSUB 11
__device__ __forceinline__ bool phase_empty(int ph) {
    if (ph == 0) return false;
    const int L = (ph - 1) / NSUB, s = (ph - 1) % NSUB;
    return s == 2 || ((L & 1) && (s == 4 || s == 5)) || (L > 0 && s == 0);
}
__device__ __forceinline__ void run_phase(const P& p, int ph, float* smem, int rep) {
    if (ph == 0) { ph_prologue(p, smem); return; }
    const int L = (ph - 1) / NSUB, s = (ph - 1) % NSUB, j = L >> 1;
    const bool even = (L & 1) == 0, need_ctx = L < 3;
    const int nrows = need_ctx ? NT : NL;
    const float* mv = p.modv + (size_t)L * 9 * 6144;
    switch (s) {
    case 0: ph_normmod(p.H, p.norm1_g + L * DM, mv, 0, 1024, p.XN, NT); break;
    case 1:
        if (even) ph_gemm(p.XN, p.WT + WT_EVIN(j), NT, 3200, EpiEven{p.PB, p.AQL, p.AQC, p.AK, p.AV, p.GT, p.rope}, (char*)smem);
        else ph_gemm(p.XN, p.WT + WT_ODIN(j), NT, ODW, EpiOdd{p.AQL, p.AQC, p.AK, p.AV, p.rope}, (char*)smem);
        break;
    case 3: if (even) ph_attn_even(p, L + 4 * rep, L, j, smem); else ph_attn_odd(p, j, need_ctx, smem); break;
    case 4: if (even) ph_ml_pass2(p); break;
    case 5: if (even) ph_ml_pass3(p, j, smem); break;
    case 6: ph_gemm(p.MIX, p.WT + (even ? WT_EVOUT(j) : WT_ODOUT(j)), nrows, DM, EpiResid{p.H, mv + 2048, rep ? 0.f : 1.f}, (char*)smem); break;
    case 7: ph_normmod_q(p, p.norm2_g + L * DM, mv, nrows); break;
    case 8: ph_gemm(p.XN, p.WT + WT_PQ(L), nrows, 2048, EpiStoreBF16{p.QB, 2048}, (char*)smem); break;
    case 9: ph_peer_select(p, L, nrows, (char*)smem); break;
    case 10: ph_peer_gather(p, L, nrows, rep ? 0.f : 1.f); break;
    }
}

#define XB_TMO      128
#define XB_XCNT(j)  (256  + 64 * (j))
#define XB_XSUB(j)  (1280 + 64 * (j))
#define XB_XGEN(j)  (2304 + 64 * (j))
#define XB_TOP      3328
#define XB_TOPGEN   3392
#define XCD_BAR_WORDS 3456
#define XB_SPIN_CAP (1u << 20)
#define LAS __attribute__((address_space(3)))
__device__ __forceinline__ unsigned xb_ld(unsigned* p)              { return __hip_atomic_load(p, __ATOMIC_RELAXED, __HIP_MEMORY_SCOPE_AGENT); }
__device__ __forceinline__ unsigned xb_add(unsigned* p, unsigned v) { return __hip_atomic_fetch_add(p, v, __ATOMIC_RELAXED, __HIP_MEMORY_SCOPE_AGENT); }
__device__ __forceinline__ unsigned xb_xcc_id() { return (unsigned)__builtin_amdgcn_s_getreg((3 << 11) | 20) & 0xFu; }
#define XB_SPIN(cond, bar) do { unsigned _sp = 0; while (cond) { __builtin_amdgcn_s_sleep(1); \
    if ((++_sp & 255u) == 0u) { if (xb_ld(&(bar)[XB_TMO])) break; if (_sp > XB_SPIN_CAP) { atomicAdd(&(bar)[XB_TMO], 1u); break; } } } } while (0)
struct XcdBarrier { unsigned* bar; unsigned x; volatile LAS unsigned* st; };
__device__ __forceinline__ XcdBarrier xcd_barrier_post(unsigned* bar, volatile LAS unsigned* st) {
    XcdBarrier b; b.bar = bar; b.x = xb_xcc_id(); b.st = st;
    if (threadIdx.x == 0) (void)xb_add(&bar[XB_XCNT(b.x)], 1u);
    return b;
}
__device__ __forceinline__ void xcd_barrier_complete(unsigned* bar, unsigned x, unsigned& nloc, unsigned& nx) {
    const unsigned G = gridDim.x * gridDim.y * gridDim.z;
    unsigned sum, cnt, mine, sp = 0u;
    for (;;) {
        sum = 0u; cnt = 0u; mine = 0u;
#pragma unroll
        for (unsigned j = 0; j < 16; ++j) { const unsigned c = xb_ld(&bar[XB_XCNT(j)]); sum += c; cnt += (c > 0u) ? 1u : 0u; mine = (j == x) ? c : mine; }
        if (sum == G) break;
        __builtin_amdgcn_s_sleep(1);
        if ((++sp & 255u) == 0u) { if (xb_ld(&bar[XB_TMO])) break; if (sp > XB_SPIN_CAP) { atomicAdd(&bar[XB_TMO], 1u); break; } }
    }
    nloc = mine > 0u ? mine : 1u; nx = cnt > 0u ? cnt : 1u;
}
__device__ __forceinline__ void xcd_barrier(const XcdBarrier& b) {
    asm volatile("s_waitcnt vmcnt(0)" ::: "memory");
    __syncthreads();
    if (threadIdx.x == 0) {
        unsigned* bar = b.bar;
        __builtin_amdgcn_s_waitcnt(0);
        unsigned nloc = b.st[0], nx = b.st[1];
        if (nloc == 0u) { xcd_barrier_complete(bar, b.x, nloc, nx); b.st[0] = nloc; b.st[1] = nx; }
        const unsigned old = xb_add(&bar[XB_XSUB(b.x)], 1u);
        const unsigned gen = old / nloc;
        if (old + 1u == (gen + 1u) * nloc) {
            __builtin_amdgcn_fence(__ATOMIC_RELEASE, "agent");
            asm volatile("s_waitcnt vmcnt(0)" ::: "memory");
            const unsigned og = xb_add(&bar[XB_TOP], 1u);
            const unsigned tg = og / nx;
            if (og + 1u == (tg + 1u) * nx) xb_add(&bar[XB_TOPGEN], 1u);
            else XB_SPIN(xb_ld(&bar[XB_TOPGEN]) == tg, bar);
            __builtin_amdgcn_fence(__ATOMIC_ACQUIRE, "agent");
            xb_add(&bar[XB_XGEN(b.x)], 1u);
            asm volatile("s_waitcnt vmcnt(0)" ::: "memory");
        } else {
            XB_SPIN(xb_ld(&bar[XB_XGEN(b.x)]) == gen, bar);
            __builtin_amdgcn_fence(__ATOMIC_ACQUIRE, "agent");
            asm volatile("s_waitcnt vmcnt(0)" ::: "memory");
        }
    }
    __syncthreads();
}

__global__ void __launch_bounds__(256, 2) mega(P p) {
    extern __shared__ __attribute__((aligned(16))) float smem[];
    cg::grid_group grid = cg::this_grid();
    volatile LAS unsigned* st = (volatile LAS unsigned*)((char*)smem + 73744);
    if (threadIdx.x < 4) st[threadIdx.x] = 0u;
    __syncthreads();
    XcdBarrier xb = xcd_barrier_post(p.bar, st);
    for (int ph = p.ph_lo; ph < p.ph_hi; ++ph) {
        if (phase_empty(ph)) continue;
        run_phase(p, ph, smem, 0);
        if (PROBE_N > 1 && ph > 0 && (ph - 1) % NSUB == PROBE_S)
            for (int rep = 1; rep < PROBE_N; ++rep) { xcd_barrier(xb); run_phase(p, ph, smem, rep); }
        if (ph + 1 < p.ph_hi) { if (ph == 0) grid.sync(); else xcd_barrier(xb); }
    }
}

extern "C" void kernel_launch(void* const* d_in, const int* in_sizes, int n_in, void* d_out, int out_size, void* d_ws, size_t ws_size, hipStream_t stream) {
    static int grid_blocks = 0;
    if (!grid_blocks) {
        int dev = 0, cus = 0, per_cu = 0;
        hipGetDevice(&dev);
        hipDeviceGetAttribute(&cus, hipDeviceAttributeMultiprocessorCount, dev);
        hipFuncSetAttribute((const void*)mega, hipFuncAttributeMaxDynamicSharedMemorySize, LDS_BYTES);
        hipOccupancyMaxActiveBlocksPerMultiprocessor(&per_cu, mega, 256, LDS_BYTES);
        if (per_cu < 1) per_cu = 1;
        if (per_cu > 2) per_cu = 2;
        grid_blocks = cus * per_cu;
    }
    P p{};
    const float** ins = (const float**)&p;
    for (int i = 0; i < 24; ++i) ins[i] = (const float*)d_in[i];
    p.out = (float*)d_out;
    size_t off = 0; char* ws = (char*)d_ws;
    auto carve = [&](size_t bytes) { void* r = ws + off; off += (bytes + 255) & ~(size_t)255; return r; };
    p.modv = (float*)carve((size_t)4 * 9 * 6144 * 4);
    p.rope = (float*)carve((size_t)2048 * 64 * 4);
    p.H = (float*)carve((size_t)NT * DM * 4);
    p.XN = (bf16_t*)carve((size_t)NT * DM * 2);
    p.WT = (bf16_t*)carve(WT_TOTAL * 2);
    p.MIX = (bf16_t*)carve((size_t)NT * DM * 2);
    p.PB = (bf16_t*)carve((size_t)NT * 1536 * 2);
    p.GT = (float*)carve((size_t)NT * 16 * 4);
    p.AQL = (bf16_t*)carve((size_t)8 * 16 * 2048 * 64 * 2);
    p.AQC = (bf16_t*)carve((size_t)8 * 16 * 256 * 64 * 2);
    p.AK = (bf16_t*)carve((size_t)8 * 4 * 2 * 2304 * 64 * 2);
    p.AV = (bf16_t*)carve((size_t)8 * 4 * 128 * 2304 * 2);
    p.QKB = (bf16_t*)carve((size_t)NT * 512 * 2);
    p.CLOC = (float*)carve((size_t)2304 * 8192 * 4);
    p.CST = (bf16_t*)carve((size_t)2304 * 8192 * 2);
    p.NLOC = (float*)carve((size_t)2304 * 64 * 4);
    p.NST = (float*)carve((size_t)2304 * 64 * 4);
    p.CHB = (float*)carve((size_t)2304 * 4);
    p.CHM = (float*)carve((size_t)2304 * 4);
    p.MST = (float*)carve((size_t)2304 * 4);
    p.QB = (bf16_t*)carve((size_t)NT * 2048 * 2);
    p.GATE = (float*)carve((size_t)NT * 128 * 4);
    p.EIDX = (int*)carve((size_t)NT * 128 * 4);
    p.ctr = (int*)carve(256);
    p.bar = (unsigned*)carve((size_t)XCD_BAR_WORDS * 4);
    p.U8 = (unsigned char*)carve((size_t)4 * 16384 * 1024);
    p.V8 = (unsigned char*)carve((size_t)4 * 16384 * 1024);
    p.XQ = (unsigned char*)carve((size_t)NT * DM);
    p.XS = (float*)carve((size_t)NT * 4);
    p.USC = (float*)carve((size_t)4 * 16384 * 4);
    p.VSC = (float*)carve((size_t)4 * 16384 * 4);
    p.KB = (bf16_t*)carve((size_t)4 * 8 * 2 * 128 * 128 * 2);
    if (off > ws_size) { fprintf(stderr, "kernel_launch: workspace too small: need %zu have %zu\n", off, ws_size); return; }
    hipMemsetAsync(p.bar, 0, (size_t)XCD_BAR_WORDS * 4, stream);
#if ONE_LAUNCH
    p.ph_lo = 0; p.ph_hi = NPH;
    void* args[] = {&p};
    hipError_t e = hipLaunchCooperativeKernel((void*)mega, dim3(grid_blocks), dim3(256), args, LDS_BYTES, stream);
    if (e != hipSuccess) fprintf(stderr, "cooperative launch failed: %s (grid %d)\n", hipGetErrorString(e), grid_blocks);
#else
    for (int ph = 0; ph < NPH; ++ph) {
        if (ph > 0 && ph < NPH - 1) { const int L = (ph - 1) / NSUB, s = (ph - 1) % NSUB; if ((s == 2 || s == 4 || s == 5) && (L & 1)) continue; }
        p.ph_lo = ph; p.ph_hi = ph + 1;
        hipLaunchKernelGGL(mega, dim3(grid_blocks), dim3(256), LDS_BYTES, stream, p);
    }
#endif
}
```

```cpp
#include <hip/hip_runtime.h>
#include <hip/hip_cooperative_groups.h>
#include <cstdio>
#include <cstdint>
namespace cg = cooperative_groups;

#ifndef ONE_LAUNCH
#define ONE_LAUNCH 1
#endif

#define NT 18432
#define NL 16384
#define DM 1024
#define EVW 3088
#define ODW 1536
#define C_QK 0
#define C_V 512
#define C_O 1024
#define C_G 1536
#define C_DQ 1552
#define C_DK 2064
#define C_DV 2576
#define NPH 45
#ifndef PROBE_S
#define PROBE_S -1
#endif
#ifndef PROBE_N
#define PROBE_N 1
#endif

typedef unsigned short bf16_t;
typedef short bf16x8 __attribute__((ext_vector_type(8)));
typedef float f32x4 __attribute__((ext_vector_type(4)));
#define LDS_BYTES 73792

typedef float f32x16 __attribute__((ext_vector_type(16)));
typedef unsigned u32x4 __attribute__((ext_vector_type(4)));
struct P {
    const float *x, *c, *ctx, *c_ctx, *mod_w, *mod_b, *norm1_g, *norm2_g, *ev_w_in, *ev_conv_w, *ev_conv_b, *ev_gate_b,
        *ev_ml_g, *ev_da_lam, *ev_da_g, *ev_w_out, *od_w_in, *od_sink, *od_w_out, *pr_w_q, *pr_keys, *pr_u, *pr_v, *final_g;
    float* out;
    float *modv, *H, *GATE, *rope, *GT, *CLOC, *NLOC, *NST, *CHB, *CHM, *MST;
    int *EIDX, *ctr;
    unsigned* bar;
    bf16_t *XN, *MIX, *WT, *KB, *QB, *PB, *AQL, *AQC, *AK, *AV, *QKB, *CST;
    unsigned char *U8, *V8;
    float *USC, *VSC, *XS;
    unsigned char* XQ;
    int ph_lo, ph_hi;
};
#define QSCALE 0.18033688011112042f

__device__ __forceinline__ int otid() { int t = threadIdx.x; asm volatile("" : "+v"(t)); return t; }
__device__ __forceinline__ unsigned pack_i8x4(float a, float b, float c, float d) {
    return ((unsigned)(int)rintf(a) & 0xffu) | (((unsigned)(int)rintf(b) & 0xffu) << 8) | (((unsigned)(int)rintf(c) & 0xffu) << 16) | ((unsigned)(int)rintf(d) << 24);
}
__device__ __forceinline__ int modrow(int r) { return r < NL ? (r >> 11) : 8; }
__device__ __forceinline__ float silu_f(float x) { return x / (1.f + expf(-x)); }
__device__ __forceinline__ float sigmoid_f(float x) { return 1.f / (1.f + expf(-x)); }
__device__ __forceinline__ float log_sigmoid_f(float x) { return fminf(x, 0.f) - log1pf(expf(-fabsf(x))); }
typedef __bf16 bf16v2_t __attribute__((ext_vector_type(2)));
typedef float f32x2_t __attribute__((ext_vector_type(2)));
__device__ __forceinline__ unsigned cvt_pk_bf16(float lo, float hi) { const bf16v2_t v = __builtin_convertvector((f32x2_t){lo, hi}, bf16v2_t); return __builtin_bit_cast(unsigned, v); }
__device__ __forceinline__ float bf_lo(unsigned u) { return __uint_as_float(u << 16); }
__device__ __forceinline__ float bf_hi(unsigned u) { return __uint_as_float(u & 0xffff0000u); }
__device__ __forceinline__ void unpack8(const uint4 u, float* f) {
    f[0] = bf_lo(u.x); f[1] = bf_hi(u.x); f[2] = bf_lo(u.y); f[3] = bf_hi(u.y); f[4] = bf_lo(u.z); f[5] = bf_hi(u.z); f[6] = bf_lo(u.w); f[7] = bf_hi(u.w);
}
#define WT_EVIN(j) ((size_t)(j) * 3200 * 1024)
#define WT_EVOUT(j) ((size_t)2 * 3200 * 1024 + (size_t)(j) * 1024 * 1024)
#define WT_ODIN(j) ((size_t)2 * 3200 * 1024 + (size_t)2 * 1024 * 1024 + (size_t)(j) * 1536 * 1024)
#define WT_ODOUT(j) ((size_t)2 * 3200 * 1024 + (size_t)2 * 1024 * 1024 + (size_t)2 * 1536 * 1024 + (size_t)(j) * 1024 * 1024)
#define WT_PQ(L) ((size_t)2 * 3200 * 1024 + (size_t)4 * 1024 * 1024 + (size_t)2 * 1536 * 1024 + (size_t)(L) * 2048 * 1024)
#define WT_TOTAL ((size_t)2 * 3200 * 1024 + (size_t)4 * 1024 * 1024 + (size_t)2 * 1536 * 1024 + (size_t)4 * 2048 * 1024)
__device__ __forceinline__ float lshfl(float v, int src) { return __int_as_float(__builtin_amdgcn_ds_bpermute(src << 2, __float_as_int(v))); }
#define SHX(v, m) lshfl((v), lane ^ (m))
#define wave_sum(v) wave_sum_l((v), lane)
#define wave_max(v) wave_max_l((v), lane)
template <int CTRL, int RMASK> __device__ __forceinline__ float dppf(float v, float fill) { return __int_as_float(__builtin_amdgcn_update_dpp(__float_as_int(fill), __float_as_int(v), CTRL, RMASK, 0xF, false)); }
__device__ __forceinline__ float wave_sum_l(float v, int lane) {
    v += dppf<0xB1, 0xF>(v, 0.f); v += dppf<0x4E, 0xF>(v, 0.f); v += dppf<0x141, 0xF>(v, 0.f); v += dppf<0x140, 0xF>(v, 0.f);
    v += dppf<0x142, 0xA>(v, 0.f); v += dppf<0x143, 0xC>(v, 0.f);
    return __int_as_float(__builtin_amdgcn_readlane(__float_as_int(v), 63));
}
__device__ __forceinline__ float wave_max_l(float v, int lane) {
    v = fmaxf(v, dppf<0xB1, 0xF>(v, v)); v = fmaxf(v, dppf<0x4E, 0xF>(v, v)); v = fmaxf(v, dppf<0x141, 0xF>(v, v)); v = fmaxf(v, dppf<0x140, 0xF>(v, v));
    v = fmaxf(v, dppf<0x142, 0xA>(v, v)); v = fmaxf(v, dppf<0x143, 0xC>(v, v));
    return __int_as_float(__builtin_amdgcn_readlane(__float_as_int(v), 63));
}

__device__ void cvt_copy_bf16(const float* src, bf16_t* dst, size_t n);
__device__ void quant_rows_i8(const float* src, unsigned char* dst, float* scl, int nrows);
__device__ void ph_prologue(const P& p, float* smem) {
    const int tid = otid(), nb = gridDim.x, bid = blockIdx.x;
    if (bid == 0) for (int i = tid; i < 2560; i += 256) p.ctr[i] = 0;
    {
        const float4* xs = (const float4*)p.x; const float4* cs = (const float4*)p.ctx; float4* hd = (float4*)p.H;
        const size_t nx = (size_t)NL * DM / 4, nc = (size_t)(NT - NL) * DM / 4;
        for (size_t i = (size_t)bid * 256 + tid; i < nx + nc; i += (size_t)nb * 256) hd[i] = i < nx ? xs[i] : cs[i - nx];
    }
    for (int i = bid * 256 + tid; i < 2048 * 32; i += nb * 256) {
        const int s = i >> 5, d = i & 31;
        const float pos = (d < 16) ? (float)(s >> 6) : (float)(s & 63);
        const float inv = powf(10000.0f, -(float)(d & 15) / 16.0f);
        const float ang = pos * inv;
        p.rope[2 * i] = cosf(ang); p.rope[2 * i + 1] = sinf(ang);
    }
    float* sc = smem;
    float* red = smem + 9 * 1024;
    for (int i = tid; i < 9 * 1024; i += 256) { const int r = i >> 10, k = i & 1023; const float v = r < 8 ? p.c[r * 1024 + k] : p.c_ctx[k]; sc[i] = silu_f(v); }
    __syncthreads();
    for (int item = bid; item < 4 * 96; item += nb) {
        const int L = item / 96, n0 = (item % 96) * 64, tx = tid & 63, kq = tid >> 6;
        float acc[9];
#pragma unroll
        for (int r = 0; r < 9; ++r) acc[r] = 0.f;
        const float* w = p.mod_w + (size_t)L * 1024 * 6144 + n0 + tx;
        for (int k = kq * 256; k < kq * 256 + 256; ++k) {
            const float wv = w[(size_t)k * 6144];
#pragma unroll
            for (int r = 0; r < 9; ++r) acc[r] += sc[r * 1024 + k] * wv;
        }
#pragma unroll
        for (int r = 0; r < 9; ++r) red[(kq * 9 + r) * 64 + tx] = acc[r];
        __syncthreads();
        if (kq == 0) {
#pragma unroll
            for (int r = 0; r < 9; ++r) {
                const float s = red[(0 * 9 + r) * 64 + tx] + red[(1 * 9 + r) * 64 + tx] + red[(2 * 9 + r) * 64 + tx] + red[(3 * 9 + r) * 64 + tx];
                p.modv[((size_t)L * 9 + r) * 6144 + n0 + tx] = s + p.mod_b[L * 6144 + n0 + tx];
            }
        }
        __syncthreads();
    }
    {
        float (*tile)[65] = (float (*)[65])smem;
        for (int item = bid; item < 5440; item += nb) {
            int it = item, mat = 0, N = 0, Npad = 0; const float* src = nullptr; bf16_t* dst = nullptr;
            for (mat = 0; mat < 12; ++mat) {
                if (mat < 2) { N = EVW; Npad = 3200; src = p.ev_w_in + (size_t)mat * DM * EVW; dst = p.WT + WT_EVIN(mat); }
                else if (mat < 4) { N = 1024; Npad = 1024; src = p.ev_w_out + (size_t)(mat - 2) * DM * DM; dst = p.WT + WT_EVOUT(mat - 2); }
                else if (mat < 6) { N = ODW; Npad = ODW; src = p.od_w_in + (size_t)(mat - 4) * DM * ODW; dst = p.WT + WT_ODIN(mat - 4); }
                else if (mat < 8) { N = 1024; Npad = 1024; src = p.od_w_out + (size_t)(mat - 6) * DM * DM; dst = p.WT + WT_ODOUT(mat - 6); }
                else { N = 2048; Npad = 2048; src = p.pr_w_q + (size_t)(mat - 8) * DM * 2048; dst = p.WT + WT_PQ(mat - 8); }
                const int nt = 16 * (Npad / 64);
                if (it < nt) break;
                it -= nt;
            }
            const int k0 = (it & 15) * 64, n0 = (it >> 4) * 64;
            __syncthreads();
#pragma unroll
            for (int rep = 0; rep < 4; ++rep) {
                const int i = (tid >> 4) + 16 * rep, c4 = (tid & 15) * 4;
                float4 v = make_float4(0.f, 0.f, 0.f, 0.f);
                int sc = n0 + c4;
                if (mat < 2) sc = sc < 1536 ? sc : (sc < 3072 ? sc + 16 : (sc < 3088 ? sc - 3072 + 1536 : N));
                if (sc < N) v = *(const float4*)(src + (size_t)(k0 + i) * N + sc);
                tile[i][c4] = v.x; tile[i][c4 + 1] = v.y; tile[i][c4 + 2] = v.z; tile[i][c4 + 3] = v.w;
            }
            __syncthreads();
            {
                const int n = tid >> 2, kq = (tid & 3) * 16;
                unsigned w[8];
#pragma unroll
                for (int e = 0; e < 8; ++e) w[e] = cvt_pk_bf16(tile[kq + 2 * e][n], tile[kq + 2 * e + 1][n]);
                uint4* dp = (uint4*)(dst + (size_t)(n0 + n) * DM + k0 + kq);
                dp[0] = make_uint4(w[0], w[1], w[2], w[3]); dp[1] = make_uint4(w[4], w[5], w[6], w[7]);
            }
        }
    }
    quant_rows_i8(p.pr_u, p.U8, p.USC, 4 * 16384);
    quant_rows_i8(p.pr_v, p.V8, p.VSC, 4 * 16384);
    cvt_copy_bf16(p.pr_keys, p.KB, (size_t)4 * 8 * 2 * 128 * 128);
}

__device__ void ph_normmod_q(const P& p, const float* g, const float* modv_layer, int nrows) {
    const int lane = otid() & 63, wid = otid() >> 6;
    for (int r = blockIdx.x * 4 + wid; r < nrows; r += gridDim.x * 4) {
        const float4* s4 = (const float4*)(p.H + (size_t)r * DM + lane * 16);
        float4 v[4]; float ss = 0.f;
#pragma unroll
        for (int i = 0; i < 4; ++i) { v[i] = s4[i]; ss += v[i].x * v[i].x + v[i].y * v[i].y + v[i].z * v[i].z + v[i].w * v[i].w; }
        ss = wave_sum(ss);
        const float rstd = rsqrtf(ss * (1.0f / DM) + 1e-6f);
        const float* mv = modv_layer + (size_t)modrow(r) * 6144 + lane * 16;
        float o[16]; float mx = 0.f;
#pragma unroll
        for (int i = 0; i < 4; ++i) {
            const float4 gg = *(const float4*)(g + lane * 16 + i * 4), sh = *(const float4*)(mv + 3072 + i * 4), scl = *(const float4*)(mv + 4096 + i * 4);
            o[i * 4 + 0] = v[i].x * rstd * gg.x * (1.f + scl.x) + sh.x; o[i * 4 + 1] = v[i].y * rstd * gg.y * (1.f + scl.y) + sh.y;
            o[i * 4 + 2] = v[i].z * rstd * gg.z * (1.f + scl.z) + sh.z; o[i * 4 + 3] = v[i].w * rstd * gg.w * (1.f + scl.w) + sh.w;
            mx = fmaxf(mx, fmaxf(fmaxf(fabsf(o[i * 4]), fabsf(o[i * 4 + 1])), fmaxf(fabsf(o[i * 4 + 2]), fabsf(o[i * 4 + 3]))));
        }
        mx = wave_max(mx);
        const float inv = mx > 0.f ? 127.f / mx : 0.f;
        uint4* xp = (uint4*)(p.XN + (size_t)r * DM + lane * 16);
        xp[0] = make_uint4(cvt_pk_bf16(o[0], o[1]), cvt_pk_bf16(o[2], o[3]), cvt_pk_bf16(o[4], o[5]), cvt_pk_bf16(o[6], o[7]));
        xp[1] = make_uint4(cvt_pk_bf16(o[8], o[9]), cvt_pk_bf16(o[10], o[11]), cvt_pk_bf16(o[12], o[13]), cvt_pk_bf16(o[14], o[15]));
        *(uint4*)(p.XQ + (size_t)r * DM + lane * 16) = make_uint4(pack_i8x4(o[0] * inv, o[1] * inv, o[2] * inv, o[3] * inv), pack_i8x4(o[4] * inv, o[5] * inv, o[6] * inv, o[7] * inv),
                                                                  pack_i8x4(o[8] * inv, o[9] * inv, o[10] * inv, o[11] * inv), pack_i8x4(o[12] * inv, o[13] * inv, o[14] * inv, o[15] * inv));
        if (lane == 0) p.XS[r] = mx * (1.f / 127.f);
    }
}

__device__ void cvt_copy_bf16(const float* src, bf16_t* dst, size_t n) {
    const size_t n8 = n / 8;
    for (size_t i = (size_t)blockIdx.x * 256 + otid(); i < n8; i += (size_t)gridDim.x * 256) {
        const float4 a = ((const float4*)src)[2 * i], b = ((const float4*)src)[2 * i + 1];
        ((uint4*)dst)[i] = make_uint4(cvt_pk_bf16(a.x, a.y), cvt_pk_bf16(a.z, a.w), cvt_pk_bf16(b.x, b.y), cvt_pk_bf16(b.z, b.w));
    }
}

__device__ void quant_rows_i8(const float* src, unsigned char* dst, float* scl, int nrows) {
    const int lane = otid() & 63, wid = otid() >> 6;
    for (int r = blockIdx.x * 4 + wid; r < nrows; r += gridDim.x * 4) {
        const float4* sp = (const float4*)(src + (size_t)r * 1024 + lane * 16);
        float4 v[4]; float mx = 0.f;
#pragma unroll
        for (int i = 0; i < 4; ++i) { v[i] = sp[i]; mx = fmaxf(mx, fmaxf(fmaxf(fabsf(v[i].x), fabsf(v[i].y)), fmaxf(fabsf(v[i].z), fabsf(v[i].w)))); }
#pragma unroll
        for (int o = 32; o > 0; o >>= 1) mx = fmaxf(mx, SHX(mx, o));
        const float inv = mx > 0.f ? 127.f / mx : 0.f;
        unsigned w[4];
#pragma unroll
        for (int i = 0; i < 4; ++i) {
            w[i] = pack_i8x4(v[i].x * inv, v[i].y * inv, v[i].z * inv, v[i].w * inv);
        }
        *(uint4*)(dst + (size_t)r * 1024 + lane * 16) = make_uint4(w[0], w[1], w[2], w[3]);
        if (lane == 0) scl[r] = mx * (1.f / 127.f);
    }
}

__device__ void ph_normmod(const float* src, const float* g, const float* modv_layer, int shift_off, int scale_off, bf16_t* dst, int nrows) {
    const int lane = otid() & 63, wid = otid() >> 6;
    for (int r = blockIdx.x * 4 + wid; r < nrows; r += gridDim.x * 4) {
        const float4* s4 = (const float4*)(src + (size_t)r * DM);
        float4 v[4]; float ss = 0.f;
#pragma unroll
        for (int i = 0; i < 4; ++i) { v[i] = s4[i * 64 + lane]; ss += v[i].x * v[i].x + v[i].y * v[i].y + v[i].z * v[i].z + v[i].w * v[i].w; }
        ss = wave_sum(ss);
        const float rstd = rsqrtf(ss * (1.0f / DM) + 1e-6f);
        const float* mv = modv_layer + (size_t)modrow(r) * 6144;
        uint2* d2 = (uint2*)(dst + (size_t)r * DM);
#pragma unroll
        for (int i = 0; i < 4; ++i) {
            const int c = (i * 64 + lane) * 4;
            const float4 gg = *(const float4*)(g + c), sh = *(const float4*)(mv + shift_off + c), scl = *(const float4*)(mv + scale_off + c);
            float4 o;
            o.x = v[i].x * rstd * gg.x * (1.f + scl.x) + sh.x; o.y = v[i].y * rstd * gg.y * (1.f + scl.y) + sh.y;
            o.z = v[i].z * rstd * gg.z * (1.f + scl.z) + sh.z; o.w = v[i].w * rstd * gg.w * (1.f + scl.w) + sh.w;
            d2[i * 64 + lane] = make_uint2(cvt_pk_bf16(o.x, o.y), cvt_pk_bf16(o.z, o.w));
        }
    }
}

__device__ void ph_final(const P& p) {
    const int lane = otid() & 63, wid = otid() >> 6;
    for (int r = blockIdx.x * 4 + wid; r < NL; r += gridDim.x * 4) {
        const float4* s4 = (const float4*)(p.H + (size_t)r * DM);
        float4 v[4]; float ss = 0.f;
#pragma unroll
        for (int i = 0; i < 4; ++i) { v[i] = s4[i * 64 + lane]; ss += v[i].x * v[i].x + v[i].y * v[i].y + v[i].z * v[i].z + v[i].w * v[i].w; }
        ss = wave_sum(ss);
        const float rstd = rsqrtf(ss * (1.0f / DM) + 1e-6f);
        float4* d4 = (float4*)(p.out + (size_t)r * DM);
#pragma unroll
        for (int i = 0; i < 4; ++i) {
            const int c = (i * 64 + lane) * 4; const float4 gg = *(const float4*)(p.final_g + c);
            float4 o; o.x = v[i].x * rstd * gg.x; o.y = v[i].y * rstd * gg.y; o.z = v[i].z * rstd * gg.z; o.w = v[i].w * rstd * gg.w;
            d4[i * 64 + lane] = o;
        }
    }
}

#define GL_ROWB 144
#define GL_TILEB (128 * GL_ROWB)
struct TokPos { int b, pos, kpos; bool lat; };
__device__ __forceinline__ TokPos tokpos(int row) {
    TokPos t; t.lat = row < NL;
    if (t.lat) { t.b = row >> 11; t.pos = row & 2047; t.kpos = 256 + t.pos; } else { const int r = row - NL; t.b = r >> 8; t.pos = r & 255; t.kpos = t.pos; }
    return t;
}
struct EpiStoreBF16 {
    bf16_t* C; int ldc;
    __device__ __forceinline__ bool swapped(int) const { return false; }
    __device__ __forceinline__ void operator()(const f32x4 (&acc)[4][4], int m0, int n0, int wm, int wn, int fr, int fq) const {
#pragma unroll
        for (int mi = 0; mi < 4; ++mi)
#pragma unroll
            for (int ni = 0; ni < 4; ++ni) {
                const f32x4 v = acc[ni][mi];
                *(uint2*)(C + (size_t)(m0 + wm * 64 + mi * 16 + fr) * ldc + n0 + wn * 64 + ni * 16 + fq * 4) = make_uint2(cvt_pk_bf16(v[0], v[1]), cvt_pk_bf16(v[2], v[3]));
            }
    }
};
struct EpiResid {
    float* H; const float* gate; float scale;
    __device__ __forceinline__ bool swapped(int) const { return false; }
    __device__ __forceinline__ void operator()(const f32x4 (&acc)[4][4], int m0, int n0, int wm, int wn, int fr, int fq) const {
#pragma unroll
        for (int mi = 0; mi < 4; ++mi) {
            const int row = m0 + wm * 64 + mi * 16 + fr;
            const float* gp = gate + (size_t)modrow(row) * 6144;
#pragma unroll
            for (int ni = 0; ni < 4; ++ni) {
                const int col = n0 + wn * 64 + ni * 16 + fq * 4;
                const f32x4 g = *(const f32x4*)(gp + col);
                f32x4* hp = (f32x4*)(H + (size_t)row * DM + col);
                *hp = *hp + g * acc[ni][mi] * scale;
            }
        }
    }
};
__device__ __forceinline__ void rope_store64(const f32x4 (&acc)[4][4], int mi, bool do_rope, const float* ropep  , float scale, bf16_t* dst  , int fq) {
#pragma unroll
    for (int ni = 0; ni < 2; ++ni) {
        f32x4 x1 = acc[ni][mi], x2 = acc[ni + 2][mi];
        if (do_rope) {
            const f32x4 r0 = *(const f32x4*)(ropep + (ni * 16 + fq * 4) * 2), r1 = *(const f32x4*)(ropep + (ni * 16 + fq * 4) * 2 + 4);
            const f32x4 cs = (f32x4){r0[0], r0[2], r1[0], r1[2]}, sn = (f32x4){r0[1], r0[3], r1[1], r1[3]};
            const f32x4 y1 = x1 * cs - x2 * sn, y2 = x1 * sn + x2 * cs;
            x1 = y1; x2 = y2;
        }
        x1 = x1 * scale; x2 = x2 * scale;
        *(uint2*)(dst + ni * 16 + fq * 4) = make_uint2(cvt_pk_bf16(x1[0], x1[1]), cvt_pk_bf16(x1[2], x1[3]));
        *(uint2*)(dst + 32 + ni * 16 + fq * 4) = make_uint2(cvt_pk_bf16(x2[0], x2[1]), cvt_pk_bf16(x2[2], x2[3]));
    }
}
struct EpiEven {
    bf16_t *PB, *AQL, *AQC, *AK, *AV; float* GT; const float* rope;
    __device__ __forceinline__ bool swapped(int n0) const { return n0 >= 2560 && n0 < 3072; }
    __device__ __forceinline__ void operator()(const f32x4 (&acc)[4][4], int m0, int n0, int wm, int wn, int fr, int fq) const {
        const int t = n0 >> 7;
        if (t < 12) {
#pragma unroll
            for (int mi = 0; mi < 4; ++mi)
#pragma unroll
                for (int ni = 0; ni < 4; ++ni) {
                    const f32x4 v = acc[ni][mi];
                    *(uint2*)(PB + (size_t)(m0 + wm * 64 + mi * 16 + fr) * 1536 + n0 + wn * 64 + ni * 16 + fq * 4) = make_uint2(cvt_pk_bf16(v[0], v[1]), cvt_pk_bf16(v[2], v[3]));
                }
        } else if (t < 20) {
            const bool isq = t < 16; const int h = t & 3;
#pragma unroll
            for (int mi = 0; mi < 4; ++mi) {
                const TokPos tp = tokpos(m0 + wm * 64 + mi * 16 + fr);
                const int hm = (tp.b * 4 + h) * 2 + wn;
                bf16_t* dst;
                if (isq) dst = tp.lat ? AQL + ((size_t)hm * 2048 + tp.pos) * 64 : AQC + ((size_t)hm * 256 + tp.pos) * 64;
                else dst = AK + ((size_t)hm * 2304 + tp.kpos) * 64;
                rope_store64(acc, mi, tp.lat, rope + (size_t)tp.pos * 64, isq ? QSCALE : 1.0f, dst, fq);
            }
        } else if (t < 24) {
            const int h = t - 20;
#pragma unroll
            for (int mi = 0; mi < 4; ++mi) {
                const TokPos tp = tokpos(m0 + wm * 64 + mi * 16 + fq * 4);
#pragma unroll
                for (int ni = 0; ni < 4; ++ni) {
                    const f32x4 v = acc[ni][mi];
                    const int d = wn * 64 + ni * 16 + fr;
                    *(uint2*)(AV + ((size_t)(tp.b * 4 + h) * 128 + d) * 2304 + tp.kpos) = make_uint2(cvt_pk_bf16(v[0], v[1]), cvt_pk_bf16(v[2], v[3]));
                }
            }
        } else {
            if (wn == 0) {
#pragma unroll
                for (int mi = 0; mi < 4; ++mi) *(f32x4*)(GT + (size_t)(m0 + wm * 64 + mi * 16 + fr) * 16 + fq * 4) = acc[0][mi];
            }
        }
    }
};
struct EpiOdd {
    bf16_t *AQL, *AQC, *AK, *AV; const float* rope;
    __device__ __forceinline__ bool swapped(int n0) const { return n0 >= 1280; }
    __device__ __forceinline__ void operator()(const f32x4 (&acc)[4][4], int m0, int n0, int wm, int wn, int fr, int fq) const {
        const int t = n0 >> 7;
        if (t < 10) {
            const bool isq = t < 8; const int hd = isq ? t * 2 + wn : (t - 8) * 2 + wn;
#pragma unroll
            for (int mi = 0; mi < 4; ++mi) {
                const TokPos tp = tokpos(m0 + wm * 64 + mi * 16 + fr);
                bf16_t* dst;
                if (isq) dst = tp.lat ? AQL + ((size_t)(tp.b * 16 + hd) * 2048 + tp.pos) * 64 : AQC + ((size_t)(tp.b * 16 + hd) * 256 + tp.pos) * 64;
                else dst = AK + ((size_t)(tp.b * 4 + hd) * 2304 + tp.kpos) * 64;
                rope_store64(acc, mi, tp.lat, rope + (size_t)tp.pos * 64, isq ? QSCALE : 1.0f, dst, fq);
            }
        } else {
            const int hkv = (t - 10) * 2 + wn;
#pragma unroll
            for (int mi = 0; mi < 4; ++mi) {
                const TokPos tp = tokpos(m0 + wm * 64 + mi * 16 + fq * 4);
#pragma unroll
                for (int ni = 0; ni < 4; ++ni) {
                    const f32x4 v = acc[ni][mi];
                    const int d = ni * 16 + fr;
                    *(uint2*)(AV + ((size_t)(tp.b * 4 + hkv) * 64 + d) * 2304 + tp.kpos) = make_uint2(cvt_pk_bf16(v[0], v[1]), cvt_pk_bf16(v[2], v[3]));
                }
            }
        }
    }
};
#define LDS_AS __attribute__((address_space(3)))
template <bool SWAP>
__device__ __forceinline__ void gemm_tile_kloop(f32x4 (&acc)[4][4], const bf16_t* aub, const bf16_t* bub, char* smem, int lrow, int lch, int wm, int wn, int fr, int fq) {
    const int tid = lrow * 8 + lch, wid = tid >> 6, lane = tid & 63;
    const int srow = wid * 8 + (lane >> 3);
    const unsigned goff = (unsigned)(srow * DM + (((lane & 7) ^ (srow & 7)) << 3)) * 2u;
#define GL_DMA(BUF, KO) { _Pragma("unroll") for (int i = 0; i < 4; ++i) { \
        __builtin_amdgcn_global_load_lds((const unsigned*)((const char*)aub + ((size_t)(32 * i) * DM + (KO)) * 2 + goff), (LDS_AS unsigned*)((BUF) + (i * 32 + wid * 8) * 128), 16, 0, 0); \
        __builtin_amdgcn_global_load_lds((const unsigned*)((const char*)bub + ((size_t)(32 * i) * DM + (KO)) * 2 + goff), (LDS_AS unsigned*)((BUF) + 16384 + (i * 32 + wid * 8) * 128), 16, 0, 0); } }
    const int xr = fr & 7;
    GL_DMA(smem, 0)
    __syncthreads();
    for (int kt = 0; kt < 16; ++kt) {
        char* cur = smem + (kt & 1) * 32768;
        char* nxt = smem + ((kt + 1) & 1) * 32768;
        if (kt + 1 < 16) GL_DMA(nxt, (kt + 1) * 64)
#pragma unroll
        for (int ks = 0; ks < 2; ++ks) {
            bf16x8 af[4], wf[4];
#pragma unroll
            for (int i = 0; i < 4; ++i) {
                af[i] = *(const bf16x8*)(cur + (wm * 64 + i * 16 + fr) * 128 + (((ks * 4 + fq) ^ xr) << 4));
                wf[i] = *(const bf16x8*)(cur + 16384 + (wn * 64 + i * 16 + fr) * 128 + (((ks * 4 + fq) ^ xr) << 4));
            }
#pragma unroll
            for (int ni = 0; ni < 4; ++ni)
#pragma unroll
                for (int mi = 0; mi < 4; ++mi)
                    acc[ni][mi] = SWAP ? __builtin_amdgcn_mfma_f32_16x16x32_bf16(af[mi], wf[ni], acc[ni][mi], 0, 0, 0)
                                       : __builtin_amdgcn_mfma_f32_16x16x32_bf16(wf[ni], af[mi], acc[ni][mi], 0, 0, 0);
        }
        __syncthreads();
    }
#undef GL_DMA
}
template <class Epi>
__device__ void ph_gemm(const bf16_t* A, const bf16_t* Bt, int M, int Npad, const Epi& epi, char* smem) {
    const int tid = otid(), lane = tid & 63, wid = tid >> 6, wm = wid >> 1, wn = wid & 1;
    const int fr = lane & 15, fq = lane >> 4;
    const int tm = M / 128, tn = Npad / 128, ntiles = tm * tn;
    const int lrow = tid >> 3, lch = tid & 7;
    for (int tile = blockIdx.x; tile < ntiles; tile += gridDim.x) {
        const int m0 = (tile % tm) * 128, n0 = (tile / tm) * 128;
        f32x4 acc[4][4];
#pragma unroll
        for (int a = 0; a < 4; ++a)
#pragma unroll
            for (int b = 0; b < 4; ++b) acc[a][b] = (f32x4){0.f, 0.f, 0.f, 0.f};
        const bf16_t* ap = A + (size_t)m0 * DM;
        const bf16_t* bp = Bt + (size_t)n0 * DM;
        if (epi.swapped(n0)) gemm_tile_kloop<true>(acc, ap, bp, smem, lrow, lch, wm, wn, fr, fq);
        else gemm_tile_kloop<false>(acc, ap, bp, smem, lrow, lch, wm, wn, fr, fq);
        int fr2 = fr, fq2 = fq, wm2 = wm, wn2 = wn;
        asm volatile("" : "+v"(fr2), "+v"(fq2), "+v"(wm2), "+v"(wn2));
        epi(acc, m0, n0, wm2, wn2, fr2, fq2);
    }
}

__device__ void ph_prep_even(const P& p, int j) {
    const float* cw = p.ev_conv_w + (size_t)j * 3 * 512; const float* cb = p.ev_conv_b + (size_t)j * 512;
    const size_t tot = (size_t)NT * 256;
    for (size_t i = (size_t)blockIdx.x * 256 + otid(); i < tot; i += (size_t)gridDim.x * 256) {
        const int r = (int)(i >> 8), c = (int)(i & 255) * 2;
        int t, T; if (r < NL) { t = r & 2047; T = 2048; } else { t = (r - NL) & 255; T = 256; }
        const unsigned x1 = *(const unsigned*)(p.PB + (size_t)r * 1536 + c);
        float v0 = cb[c] + bf_lo(x1) * cw[512 + c], v1 = cb[c + 1] + bf_hi(x1) * cw[512 + c + 1];
        if (t > 0) { const unsigned x0 = *(const unsigned*)(p.PB + (size_t)(r - 1) * 1536 + c); v0 += bf_lo(x0) * cw[c]; v1 += bf_hi(x0) * cw[c + 1]; }
        if (t < T - 1) { const unsigned x2 = *(const unsigned*)(p.PB + (size_t)(r + 1) * 1536 + c); v0 += bf_lo(x2) * cw[1024 + c]; v1 += bf_hi(x2) * cw[1024 + c + 1]; }
        v0 = silu_f(v0); v1 = silu_f(v1);
        if (c >= 256) { v0 *= 0.125f; v1 *= 0.125f; }
        *(unsigned*)(p.QKB + (size_t)r * 512 + c) = cvt_pk_bf16(v0, v1);
    }
}

#define FA_KROW 144
#define FA_VROW 136
__device__ __forceinline__ bf16x8 pack8(float a0, float a1, float a2, float a3, float a4, float a5, float a6, float a7) {
    const u32x4 u = (u32x4){cvt_pk_bf16(a0, a1), cvt_pk_bf16(a2, a3), cvt_pk_bf16(a4, a5), cvt_pk_bf16(a6, a7)};
    return __builtin_bit_cast(bf16x8, u);
}
template <int NDB, bool MASK>
__device__ __forceinline__ void flash_tile(const bf16x8 (&qf)[4], f32x16 (&o)[NDB], float& m, float& l, const char* Kl, const char* Vl, int lane, int qpos, int kp0) {
    const int j = lane & 31, h = lane >> 5;
    f32x16 s0, s1;
#pragma unroll
    for (int i = 0; i < 16; ++i) { s0[i] = 0.f; s1[i] = 0.f; }
#pragma unroll
    for (int ks = 0; ks < 4; ++ks) {
        const bf16x8 a0 = *(const bf16x8*)(Kl + j * FA_KROW + (2 * ks + h) * 16);
        const bf16x8 a1 = *(const bf16x8*)(Kl + (32 + j) * FA_KROW + (2 * ks + h) * 16);
        s0 = __builtin_amdgcn_mfma_f32_32x32x16_bf16(a0, qf[ks], s0, 0, 0, 0);
        s1 = __builtin_amdgcn_mfma_f32_32x32x16_bf16(a1, qf[ks], s1, 0, 0, 0);
    }
    if (MASK) {
#pragma unroll
        for (int r = 0; r < 16; ++r) {
            const int key = (r & 3) + 8 * (r >> 2) + 4 * h;
            const int d0 = qpos - (kp0 + key), d1 = d0 - 32;
            if (d0 > 128 || d0 < -128) s0[r] = -1e30f;
            if (d1 > 128 || d1 < -128) s1[r] = -1e30f;
        }
    }
    float mx = fmaxf(s0[0], s1[0]);
#pragma unroll
    for (int r = 1; r < 16; ++r) mx = fmaxf(mx, fmaxf(s0[r], s1[r]));
    mx = fmaxf(mx, SHX(mx, 32));
    const float mn = fmaxf(m, mx);
    const float alpha = __builtin_amdgcn_exp2f(m - mn);
    m = mn;
    float ls = 0.f;
#pragma unroll
    for (int r = 0; r < 16; ++r) { s0[r] = __builtin_amdgcn_exp2f(s0[r] - mn); s1[r] = __builtin_amdgcn_exp2f(s1[r] - mn); ls += s0[r] + s1[r]; }
    l = l * alpha + ls;
    if (__ballot(alpha != 1.0f)) {
#pragma unroll
        for (int db = 0; db < NDB; ++db) o[db] = o[db] * alpha;
    }
    bf16x8 pb[4];
    pb[0] = pack8(s0[0], s0[1], s0[2], s0[3], s0[4], s0[5], s0[6], s0[7]);
    pb[1] = pack8(s0[8], s0[9], s0[10], s0[11], s0[12], s0[13], s0[14], s0[15]);
    pb[2] = pack8(s1[0], s1[1], s1[2], s1[3], s1[4], s1[5], s1[6], s1[7]);
    pb[3] = pack8(s1[8], s1[9], s1[10], s1[11], s1[12], s1[13], s1[14], s1[15]);
#pragma unroll
    for (int db = 0; db < NDB; ++db)
#pragma unroll
        for (int kk = 0; kk < 4; ++kk) {
            const char* vp = Vl + (db * 32 + j) * FA_VROW + (kk * 16 + 4 * h) * 2;
            const uint2 lo = *(const uint2*)vp, hi = *(const uint2*)(vp + 16);
            const u32x4 u = (u32x4){lo.x, lo.y, hi.x, hi.y};
            o[db] = __builtin_amdgcn_mfma_f32_32x32x16_bf16(__builtin_bit_cast(bf16x8, u), pb[kk], o[db], 0, 0, 0);
        }
}

#define DA_BUFB 35840
__device__ void da_block(const P& p, int item, int L, int j, char* smem) {
    const int tid = otid(), lane = tid & 63, wid = tid >> 6, mp = wid & 1, qg = wid >> 1, jq = lane & 31, hh = lane >> 5;
    const bool lat = item < 1024;
    int b, h, qt;
    if (lat) { b = item >> 7; h = (item >> 5) & 3; qt = item & 31; } else { const int it = item - 1024; b = it >> 4; h = (it >> 2) & 3; qt = it & 3; }
    const int qi = qt * 64 + qg * 32 + jq;
    const bf16_t* qp = lat ? p.AQL + ((size_t)((b * 4 + h) * 2 + mp) * 2048 + qi) * 64 : p.AQC + ((size_t)((b * 4 + h) * 2 + mp) * 256 + qi) * 64;
    bf16x8 qf[4];
#pragma unroll
    for (int ks = 0; ks < 4; ++ks) qf[ks] = *(const bf16x8*)(qp + (2 * ks + hh) * 8);
    const int ntile = lat ? 36 : 4;
    const bf16_t* kg = p.AK + (size_t)((b * 4 + h) * 2) * 2304 * 64 + (size_t)(tid >> 3) * 64 + (tid & 7) * 8;
    const bf16_t* vg = p.AV + (size_t)(b * 4 + h) * 128 * 2304 + (size_t)(tid >> 3) * 2304 + (tid & 7) * 8;
    uint4 k0, k1, k2, k3, v0, v1, v2, v3;
#define DA_LOAD(KEY0) { k0 = *(const uint4*)(kg + (size_t)(KEY0) * 64); k1 = *(const uint4*)(kg + (size_t)((KEY0) + 32) * 64); \
                        k2 = *(const uint4*)(kg + (size_t)2304 * 64 + (size_t)(KEY0) * 64); k3 = *(const uint4*)(kg + (size_t)2304 * 64 + (size_t)((KEY0) + 32) * 64); \
                        v0 = *(const uint4*)(vg + (KEY0)); v1 = *(const uint4*)(vg + (size_t)32 * 2304 + (KEY0)); v2 = *(const uint4*)(vg + (size_t)64 * 2304 + (KEY0)); v3 = *(const uint4*)(vg + (size_t)96 * 2304 + (KEY0)); }
#define DA_STORE(BUF) { char* kb_ = (BUF) + (tid >> 3) * FA_KROW + (tid & 7) * 16; \
                        *(uint4*)kb_ = k0; *(uint4*)(kb_ + 32 * FA_KROW) = k1; *(uint4*)(kb_ + 64 * FA_KROW) = k2; *(uint4*)(kb_ + 96 * FA_KROW) = k3; \
                        char* vb_ = (BUF) + 18432 + (tid >> 3) * FA_VROW + (tid & 7) * 16; \
                        *(uint2*)vb_ = make_uint2(v0.x, v0.y); *(uint2*)(vb_ + 8) = make_uint2(v0.z, v0.w); \
                        *(uint2*)(vb_ + 32 * FA_VROW) = make_uint2(v1.x, v1.y); *(uint2*)(vb_ + 32 * FA_VROW + 8) = make_uint2(v1.z, v1.w); \
                        *(uint2*)(vb_ + 64 * FA_VROW) = make_uint2(v2.x, v2.y); *(uint2*)(vb_ + 64 * FA_VROW + 8) = make_uint2(v2.z, v2.w); \
                        *(uint2*)(vb_ + 96 * FA_VROW) = make_uint2(v3.x, v3.y); *(uint2*)(vb_ + 96 * FA_VROW + 8) = make_uint2(v3.z, v3.w); }
    f32x16 o[4];
#pragma unroll
    for (int db = 0; db < 4; ++db)
#pragma unroll
        for (int i = 0; i < 16; ++i) o[db][i] = 0.f;
    float m = -1e30f, l = 0.f;
    DA_LOAD(0)
    __syncthreads();
    DA_STORE(smem)
    __syncthreads();
    for (int t = 0; t < ntile; ++t) {
        char* cur = smem + (t & 1) * DA_BUFB;
        char* nxt = smem + ((t + 1) & 1) * DA_BUFB;
        if (t + 1 < ntile) DA_LOAD((t + 1) * 64)
        flash_tile<4, false>(qf, o, m, l, cur + mp * 9216, cur + 18432, lane, 0, 0);
        if (t + 1 < ntile) DA_STORE(nxt)
        __syncthreads();
    }
#undef DA_LOAD
#undef DA_STORE
    const float inv = 1.f / (l + SHX(l, 32));
#pragma unroll
    for (int db = 0; db < 4; ++db) o[db] = o[db] * inv;
    float* X = (float*)smem + qg * 4096;
    if (mp == 1) {
#pragma unroll
        for (int db = 0; db < 4; ++db)
#pragma unroll
            for (int r = 0; r < 16; ++r) X[(db * 32 + (r & 3) + 8 * (r >> 2) + 4 * hh) * 32 + jq] = o[db][r];
    }
    __syncthreads();
    if (mp == 0) {
        const float lam_init = 0.8f - 0.6f * expf(-0.3f * (float)L);
        const float* lp = p.ev_da_lam + (size_t)j * 256;
        float a0 = lp[lane] * lp[64 + lane], a1 = lp[128 + lane] * lp[192 + lane];
        a0 = wave_sum(a0); a1 = wave_sum(a1);
        const float lam = expf(a0) - expf(a1) + lam_init;
        float ss = 0.f;
#pragma unroll
        for (int db = 0; db < 4; ++db)
#pragma unroll
            for (int r = 0; r < 16; ++r) { const float v = o[db][r] - lam * X[(db * 32 + (r & 3) + 8 * (r >> 2) + 4 * hh) * 32 + jq]; o[db][r] = v; ss += v * v; }
        ss += SHX(ss, 32);
        const float sc = rsqrtf(ss * (1.f / 128.f) + 1e-6f) * (1.f - lam_init);
        const int row = lat ? b * 2048 + qi : NL + b * 256 + qi;
        bf16_t* mrow = p.MIX + (size_t)row * DM + 512 + h * 128;
        const float* g = p.ev_da_g + (size_t)j * 512 + h * 128;
#pragma unroll
        for (int db = 0; db < 4; ++db)
#pragma unroll
            for (int r4 = 0; r4 < 4; ++r4) {
                const int d = db * 32 + 8 * r4 + 4 * hh;
                const f32x4 gg = *(const f32x4*)(g + d);
                *(uint2*)(mrow + d) = make_uint2(cvt_pk_bf16(o[db][r4 * 4 + 0] * sc * gg[0], o[db][r4 * 4 + 1] * sc * gg[1]), cvt_pk_bf16(o[db][r4 * 4 + 2] * sc * gg[2], o[db][r4 * 4 + 3] * sc * gg[3]));
            }
    }
    __syncthreads();
}

#define WA_BUFB 17920
__device__ void wa_block(const P& p, int item, int j, char* smem) {
    const int tid = otid(), lane = tid & 63, wid = tid >> 6, jq = lane & 31, hh = lane >> 5;
    const bool lat = item < 2048;
    int b, nb, hq;
    if (lat) { hq = item & 15; nb = (item >> 4) & 15; b = item >> 8; } else { const int it = item - 2048; hq = it & 15; nb = (it >> 4) & 1; b = it >> 5; }
    const int hkv = hq >> 2;
    const int qi = nb * 128 + wid * 32 + jq;
    const bf16_t* qp = lat ? p.AQL + ((size_t)(b * 16 + hq) * 2048 + qi) * 64 : p.AQC + ((size_t)(b * 16 + hq) * 256 + qi) * 64;
    bf16x8 qf[4];
#pragma unroll
    for (int ks = 0; ks < 4; ++ks) qf[ks] = *(const bf16x8*)(qp + (2 * ks + hh) * 8);
    const int lfirst = (nb == 0) ? 2 : 0, nloc = lat ? 6 - lfirst - ((nb == 15) ? 2 : 0) : 0;
    const int ntile = 4 + nloc;
    const bf16_t* kg = p.AK + (size_t)(b * 4 + hkv) * 2304 * 64 + (size_t)(tid >> 3) * 64 + (tid & 7) * 8;
    const bf16_t* vg = p.AV + (size_t)(b * 4 + hkv) * 64 * 2304 + (size_t)(tid >> 3) * 2304 + (tid & 7) * 8;
    uint4 k0, k1, v0, v1;
#define WA_KEY0(T) ((T) < 4 ? (T) * 64 : 256 + (nb - 1) * 128 + ((T) - 4 + lfirst) * 64)
#define WA_LOAD(KEY0) { k0 = *(const uint4*)(kg + (size_t)(KEY0) * 64); k1 = *(const uint4*)(kg + (size_t)((KEY0) + 32) * 64); v0 = *(const uint4*)(vg + (KEY0)); v1 = *(const uint4*)(vg + (size_t)32 * 2304 + (KEY0)); }
#define WA_STORE(BUF) { char* kb_ = (BUF) + (tid >> 3) * FA_KROW + (tid & 7) * 16; *(uint4*)kb_ = k0; *(uint4*)(kb_ + 32 * FA_KROW) = k1; \
                        char* vb_ = (BUF) + 9216 + (tid >> 3) * FA_VROW + (tid & 7) * 16; \
                        *(uint2*)vb_ = make_uint2(v0.x, v0.y); *(uint2*)(vb_ + 8) = make_uint2(v0.z, v0.w); \
                        *(uint2*)(vb_ + 32 * FA_VROW) = make_uint2(v1.x, v1.y); *(uint2*)(vb_ + 32 * FA_VROW + 8) = make_uint2(v1.z, v1.w); }
    f32x16 o[2];
#pragma unroll
    for (int db = 0; db < 2; ++db)
#pragma unroll
        for (int i = 0; i < 16; ++i) o[db][i] = 0.f;
    float m = p.od_sink[j * 16 + hq] * 1.4426950408889634f, l = hh == 0 ? 1.f : 0.f;
    { const int key0 = WA_KEY0(0); WA_LOAD(key0) }
    __syncthreads();
    WA_STORE(smem)
    __syncthreads();
    for (int t = 0; t < ntile; ++t) {
        char* cur = smem + (t & 1) * WA_BUFB;
        char* nxt = smem + ((t + 1) & 1) * WA_BUFB;
        if (t + 1 < ntile) { const int key0 = WA_KEY0(t + 1); WA_LOAD(key0) }
        if (t < 4) flash_tile<2, false>(qf, o, m, l, cur, cur + 9216, lane, 0, 0);
        else flash_tile<2, true>(qf, o, m, l, cur, cur + 9216, lane, qi, WA_KEY0(t) - 256);
        if (t + 1 < ntile) WA_STORE(nxt)
        __syncthreads();
    }
#undef WA_LOAD
#undef WA_STORE
#undef WA_KEY0
    const float inv = 1.f / (l + SHX(l, 32));
    const int row = lat ? b * 2048 + qi : NL + b * 256 + qi;
    bf16_t* mrow = p.MIX + (size_t)row * DM + hq * 64;
#pragma unroll
    for (int db = 0; db < 2; ++db)
#pragma unroll
        for (int r4 = 0; r4 < 4; ++r4) {
            const int d = db * 32 + 8 * r4 + 4 * hh;
            *(uint2*)(mrow + d) = make_uint2(cvt_pk_bf16(o[db][r4 * 4 + 0] * inv, o[db][r4 * 4 + 1] * inv), cvt_pk_bf16(o[db][r4 * 4 + 2] * inv, o[db][r4 * 4 + 3] * inv));
        }
}

__device__ __forceinline__ uint4 ml_conv8(const P& p, int j, int b, int tc, int st, int c0) {
    const int row = tc < 4 ? NL + b * 256 + tc * 64 + st : b * 2048 + (tc - 4) * 64 + st;
    const int t = tc < 4 ? tc * 64 + st : (tc - 4) * 64 + st, T = tc < 4 ? 256 : 2048;
    const float* cw = p.ev_conv_w + (size_t)j * 3 * 512 + c0; const float* cb = p.ev_conv_b + (size_t)j * 512 + c0;
    const uint4 x1 = *(const uint4*)(p.PB + (size_t)row * 1536 + c0);
    uint4 x0 = make_uint4(0u, 0u, 0u, 0u), x2 = x0;
    if (t > 0) x0 = *(const uint4*)(p.PB + (size_t)(row - 1) * 1536 + c0);
    if (t < T - 1) x2 = *(const uint4*)(p.PB + (size_t)(row + 1) * 1536 + c0);
    float a[8], bq[8], cq[8]; unpack8(x0, a); unpack8(x1, bq); unpack8(x2, cq);
    const float sc = c0 >= 256 ? 0.125f : 1.f;
    float o[8];
#pragma unroll
    for (int q = 0; q < 8; ++q) o[q] = silu_f(cb[q] + a[q] * cw[q] + bq[q] * cw[512 + q] + cq[q] * cw[1024 + q]) * sc;
    return make_uint4(cvt_pk_bf16(o[0], o[1]), cvt_pk_bf16(o[2], o[3]), cvt_pk_bf16(o[4], o[5]), cvt_pk_bf16(o[6], o[7]));
}
__device__ __forceinline__ int ml_row(int b, int tc, int i) { return tc < 4 ? NL + b * 256 + tc * 64 + i : b * 2048 + (tc - 4) * 64 + i; }
__device__ __forceinline__ void ml_gates(const P& p, int j, int b, int h, int dir, int tc, int lane, float* sa, float* sb, float* sml, float& Bt, float& Mc) {
    const int row = ml_row(b, tc, lane);
    const float ig = p.GT[(size_t)row * 16 + (dir * 2) * 4 + h] + p.ev_gate_b[j * 16 + (dir * 2) * 4 + h];
    const float lf = log_sigmoid_f(p.GT[(size_t)row * 16 + (dir * 2 + 1) * 4 + h] + p.ev_gate_b[j * 16 + (dir * 2 + 1) * 4 + h]);
    float bc = lf;
    if (dir == 0) {
#pragma unroll
        for (int o = 1; o < 64; o <<= 1) { const float t2 = lshfl(bc, lane - o); if (lane >= o) bc += t2; }
    } else {
#pragma unroll
        for (int o = 1; o < 64; o <<= 1) { const float t2 = lshfl(bc, lane + o); if (lane + o < 64) bc += t2; }
    }
    const float a = ig - bc;
    float ml = a;
    if (dir == 0) {
#pragma unroll
        for (int o = 1; o < 64; o <<= 1) { const float t2 = lshfl(ml, lane - o); if (lane >= o) ml = fmaxf(ml, t2); }
    } else {
#pragma unroll
        for (int o = 1; o < 64; o <<= 1) { const float t2 = lshfl(ml, lane + o); if (lane + o < 64) ml = fmaxf(ml, t2); }
    }
    sa[lane] = a; sb[lane] = bc; sml[lane] = ml;
    const int last = dir == 0 ? 63 : 0;
    Bt = lshfl(bc, last); Mc = lshfl(ml, last);
}
__device__ __forceinline__ int ml_tc_of(int dir, int c) { return dir == 0 ? c : (c < 4 ? 3 - c : 39 - c); }
__device__ __forceinline__ int ml_c_of(int dir, int tc) { return dir == 0 ? tc : (tc < 4 ? 3 - tc : 39 - tc); }

__device__ void ml_pass1_item(const P& p, int item, int j, char* smem) {
    const int c = item % 36, dir = (item / 36) & 1, h = (item / 72) & 3, b = item / 288;
    const int tc = ml_tc_of(dir, c);
    const int tid = otid(), lane = tid & 63, wid = tid >> 6, jl = lane & 31, hh = lane >> 5;
    bf16_t* VT = (bf16_t*)smem;
    bf16_t* KWT = (bf16_t*)(smem + 18432);
    float* sa = (float*)(smem + 27648);
    float* sb = sa + 64; float* sml = sb + 64; float* sw = sml + 64; float* ssc = sw + 64;
    __syncthreads();
    if (wid == 0) {
        float Bt, Mc; ml_gates(p, j, b, h, dir, tc, lane, sa, sb, sml, Bt, Mc);
        sw[lane] = expf(sa[lane] - Mc);
        if (lane == 0) { p.CHB[item] = Bt; p.CHM[item] = Mc; }
    }
    __syncthreads();
#pragma unroll
    for (int i = 0; i < 4; ++i) {
        const int e = tid + 256 * i, st = e >> 4, ch = e & 15;
        const uint4 u = *(const uint4*)(p.PB + (size_t)ml_row(b, tc, st) * 1536 + 512 + h * 128 + ch * 8);
        bf16_t* d = VT + (ch * 8) * 72 + st;
        d[0] = (bf16_t)u.x; d[72] = (bf16_t)(u.x >> 16); d[144] = (bf16_t)u.y; d[216] = (bf16_t)(u.y >> 16);
        d[288] = (bf16_t)u.z; d[360] = (bf16_t)(u.z >> 16); d[432] = (bf16_t)u.w; d[504] = (bf16_t)(u.w >> 16);
    }
#pragma unroll
    for (int i = 0; i < 2; ++i) {
        const int e = tid + 256 * i, st = e >> 3, ch = e & 7;
        const uint4 u = ml_conv8(p, j, b, tc, st, 256 + h * 64 + ch * 8);
        const float w = sw[st];
        bf16_t* d = KWT + (ch * 8) * 72 + st;
        const unsigned q0 = cvt_pk_bf16(bf_lo(u.x) * w, bf_hi(u.x) * w), q1 = cvt_pk_bf16(bf_lo(u.y) * w, bf_hi(u.y) * w), q2 = cvt_pk_bf16(bf_lo(u.z) * w, bf_hi(u.z) * w), q3 = cvt_pk_bf16(bf_lo(u.w) * w, bf_hi(u.w) * w);
        d[0] = (bf16_t)q0; d[72] = (bf16_t)(q0 >> 16); d[144] = (bf16_t)q1; d[216] = (bf16_t)(q1 >> 16);
        d[288] = (bf16_t)q2; d[360] = (bf16_t)(q2 >> 16); d[432] = (bf16_t)q3; d[504] = (bf16_t)(q3 >> 16);
    }
    __syncthreads();
    {
        const int db = wid & 1, vb0 = (wid >> 1) * 2;
        bf16x8 kf[4];
#pragma unroll
        for (int ks = 0; ks < 4; ++ks) kf[ks] = *(const bf16x8*)((const char*)KWT + (db * 32 + jl) * 144 + (2 * ks + hh) * 16);
        float* cl = p.CLOC + (size_t)item * 8192;
#pragma unroll
        for (int vv = 0; vv < 2; ++vv) {
            const int vb = vb0 + vv;
            f32x16 acc;
#pragma unroll
            for (int r = 0; r < 16; ++r) acc[r] = 0.f;
#pragma unroll
            for (int ks = 0; ks < 4; ++ks) {
                const bf16x8 vf = *(const bf16x8*)((const char*)VT + (vb * 32 + jl) * 144 + (2 * ks + hh) * 16);
                acc = __builtin_amdgcn_mfma_f32_32x32x16_bf16(vf, kf[ks], acc, 0, 0, 0);
            }
#pragma unroll
            for (int r = 0; r < 16; ++r) cl[(size_t)(vb * 32 + (r & 3) + 8 * (r >> 2) + 4 * hh) * 64 + db * 32 + jl] = acc[r];
        }
        if (tid < 64) {
            float sum = 0.f;
#pragma unroll
            for (int q = 0; q < 8; ++q) { const uint4 u = *(const uint4*)((const char*)KWT + tid * 144 + q * 16); sum += bf_lo(u.x) + bf_hi(u.x) + bf_lo(u.y) + bf_hi(u.y) + bf_lo(u.z) + bf_hi(u.z) + bf_lo(u.w) + bf_hi(u.w); }
            p.NLOC[(size_t)item * 64 + tid] = sum;
        }
    }
}

__device__ void ph_ml_pass2(const P& p) {
    const int gt = blockIdx.x * 256 + otid(), nthr = gridDim.x * 256;
    for (int w = gt; w < 64 * 2048; w += nthr) {
        const int chain = w >> 11, e = (w & 2047) * 4;
        float c0 = 0.f, c1 = 0.f, c2 = 0.f, c3 = 0.f, m = 0.f;
        for (int c = 0; c < 36; ++c) {
            const int it = chain * 36 + c;
            *(uint2*)(p.CST + (size_t)it * 8192 + e) = make_uint2(cvt_pk_bf16(c0, c1), cvt_pk_bf16(c2, c3));
            const float Bt = p.CHB[it], Mc = p.CHM[it];
            const float g = fmaxf(m, Mc), al = expf(m - g), be = expf(Mc - g);
            const float4 cl = *(const float4*)(p.CLOC + (size_t)it * 8192 + e);
            c0 = al * c0 + be * cl.x; c1 = al * c1 + be * cl.y; c2 = al * c2 + be * cl.z; c3 = al * c3 + be * cl.w;
            m = Bt + g;
        }
    }
    for (int w = gt; w < 64 * 64; w += nthr) {
        const int chain = w >> 6, d = w & 63;
        float n = 0.f, m = 0.f;
        for (int c = 0; c < 36; ++c) {
            const int it = chain * 36 + c;
            p.NST[(size_t)it * 64 + d] = n;
            if (d == 0) p.MST[it] = m;
            const float Bt = p.CHB[it], Mc = p.CHM[it];
            const float g = fmaxf(m, Mc);
            n = expf(m - g) * n + expf(Mc - g) * p.NLOC[(size_t)it * 64 + d];
            m = Bt + g;
        }
    }
}

__device__ void ml_pass3_item(const P& p, int item, int j, char* smem) {
    const int tc = item % 36, h = (item / 36) & 3, b = item / 144;
    const int tid = otid(), lane = tid & 63, wid = tid >> 6, jl = lane & 31, hh = lane >> 5, tb = wid & 1, dir = wid >> 1;
    char* Ql = smem;
    char* Kl = smem + 9216;
    bf16_t* VT = (bf16_t*)(smem + 18432);
    float* gs = (float*)(smem + 35840);
    float* ssc = gs + 512;
    __syncthreads();
    if (wid < 2) {
        const int d2 = wid; float Bt, Mc;
        float* sa = gs + d2 * 256; float* sb = sa + 64; float* sg = sb + 64; float* sn = sg + 64;
        ml_gates(p, j, b, h, d2, tc, lane, sa, sb, sg, Bt, Mc);
        const int sidx = ((b * 4 + h) * 2 + d2) * 36 + ml_c_of(d2, tc);
        const float mst = p.MST[sidx];
        sg[lane] = fmaxf(mst, sg[lane]);
        sn[lane] = p.NST[(size_t)sidx * 64 + lane];
        if (lane == 0) ssc[d2] = mst;
    }
#pragma unroll
    for (int i = 0; i < 2; ++i) {
        const int e = tid + 256 * i, st = e >> 3, ch = e & 7; const int row = ml_row(b, tc, st);
        *(uint4*)(Ql + st * 144 + ch * 16) = ml_conv8(p, j, b, tc, st, h * 64 + ch * 8);
        *(uint4*)(Kl + st * 144 + ch * 16) = ml_conv8(p, j, b, tc, st, 256 + h * 64 + ch * 8);
    }
#pragma unroll
    for (int i = 0; i < 4; ++i) {
        const int e = tid + 256 * i, st = e >> 4, ch = e & 15;
        const uint4 u = *(const uint4*)(p.PB + (size_t)ml_row(b, tc, st) * 1536 + 512 + h * 128 + ch * 8);
        bf16_t* d = VT + (ch * 8) * 68 + st;
        d[0] = (bf16_t)u.x; d[68] = (bf16_t)(u.x >> 16); d[136] = (bf16_t)u.y; d[204] = (bf16_t)(u.y >> 16);
        d[272] = (bf16_t)u.z; d[340] = (bf16_t)(u.z >> 16); d[408] = (bf16_t)u.w; d[476] = (bf16_t)(u.w >> 16);
    }
    __syncthreads();
    const float* sa = gs + dir * 256; const float* sb = sa + 64; const float* sg = sb + 64; const float* sn = sg + 64;
    const int t = tb * 32 + jl;
    const float gtv = sg[t], btv = sb[t], mst = ssc[dir];
    const float e2 = expf(mst - gtv);
    const int sidx = ((b * 4 + h) * 2 + dir) * 36 + ml_c_of(dir, tc);
    bf16x8 qf[4];
#pragma unroll
    for (int ks = 0; ks < 4; ++ks) qf[ks] = *(const bf16x8*)(Ql + t * 144 + (2 * ks + hh) * 16);
    f32x16 acc[4];
    {
        const bf16_t* cst = p.CST + (size_t)sidx * 8192 + (size_t)jl * 64 + hh * 8;
#pragma unroll
        for (int vb = 0; vb < 4; ++vb) {
#pragma unroll
            for (int r = 0; r < 16; ++r) acc[vb][r] = 0.f;
#pragma unroll
            for (int ks = 0; ks < 4; ++ks) {
                const bf16x8 cf = *(const bf16x8*)(cst + (size_t)vb * 32 * 64 + ks * 16);
                acc[vb] = __builtin_amdgcn_mfma_f32_32x32x16_bf16(cf, qf[ks], acc[vb], 0, 0, 0);
            }
            acc[vb] = acc[vb] * e2;
        }
    }
    float den = 0.f;
    {
        float nq = 0.f;
#pragma unroll
        for (int ks = 0; ks < 4; ++ks) {
            const u32x4 u = __builtin_bit_cast(u32x4, qf[ks]);
            const float* np = sn + 16 * ks + 8 * hh;
            nq += bf_lo(u[0]) * np[0] + bf_hi(u[0]) * np[1] + bf_lo(u[1]) * np[2] + bf_hi(u[1]) * np[3] + bf_lo(u[2]) * np[4] + bf_hi(u[2]) * np[5] + bf_lo(u[3]) * np[6] + bf_hi(u[3]) * np[7];
        }
        den = e2 * nq;
    }
#pragma unroll
    for (int sbk = 0; sbk < 2; ++sbk) {
        const bool use = dir == 0 ? (sbk <= tb) : (sbk >= tb);
        if (use) {
            f32x16 sc;
#pragma unroll
            for (int r = 0; r < 16; ++r) sc[r] = 0.f;
#pragma unroll
            for (int ks = 0; ks < 4; ++ks) {
                const bf16x8 kf = *(const bf16x8*)(Kl + (sbk * 32 + jl) * 144 + (2 * ks + hh) * 16);
                sc = __builtin_amdgcn_mfma_f32_32x32x16_bf16(kf, qf[ks], sc, 0, 0, 0);
            }
#pragma unroll
            for (int r4 = 0; r4 < 4; ++r4) {
                const int s0 = sbk * 32 + 8 * r4 + 4 * hh;
                const f32x4 av = *(const f32x4*)(sa + s0);
#pragma unroll
                for (int q = 0; q < 4; ++q) {
                    const int s2 = s0 + q;
                    const bool ok = dir == 0 ? (s2 <= t) : (s2 >= t);
                    const float pv = ok ? sc[r4 * 4 + q] * expf(av[q] - gtv) : 0.f;
                    sc[r4 * 4 + q] = pv; den += pv;
                }
            }
            bf16x8 pb[2];
            pb[0] = pack8(sc[0], sc[1], sc[2], sc[3], sc[4], sc[5], sc[6], sc[7]);
            pb[1] = pack8(sc[8], sc[9], sc[10], sc[11], sc[12], sc[13], sc[14], sc[15]);
#pragma unroll
            for (int vb = 0; vb < 4; ++vb)
#pragma unroll
                for (int k2 = 0; k2 < 2; ++k2) {
                    const char* vp = (const char*)VT + (vb * 32 + jl) * 136 + (sbk * 32 + k2 * 16 + 4 * hh) * 2;
                    const uint2 lo = *(const uint2*)vp, hi = *(const uint2*)(vp + 16);
                    const u32x4 u = (u32x4){lo.x, lo.y, hi.x, hi.y};
                    acc[vb] = __builtin_amdgcn_mfma_f32_32x32x16_bf16(__builtin_bit_cast(bf16x8, u), pb[k2], acc[vb], 0, 0, 0);
                }
        }
    }
    den += SHX(den, 32);
    const float scl = 1.f / fmaxf(fabsf(den), expf(-(btv + gtv)));
#pragma unroll
    for (int vb = 0; vb < 4; ++vb) acc[vb] = acc[vb] * scl;
    __syncthreads();
    float* X = (float*)smem + tb * 4096;
    if (dir == 1) {
#pragma unroll
        for (int vb = 0; vb < 4; ++vb)
#pragma unroll
            for (int r = 0; r < 16; ++r) X[(vb * 32 + (r & 3) + 8 * (r >> 2) + 4 * hh) * 32 + jl] = acc[vb][r];
    }
    __syncthreads();
    if (dir == 0) {
        float ss = 0.f;
#pragma unroll
        for (int vb = 0; vb < 4; ++vb)
#pragma unroll
            for (int r = 0; r < 16; ++r) { const float v = acc[vb][r] + X[(vb * 32 + (r & 3) + 8 * (r >> 2) + 4 * hh) * 32 + jl]; acc[vb][r] = v; ss += v * v; }
        ss += SHX(ss, 32);
        const float rstd = rsqrtf(ss * (1.f / 128.f) + 1e-6f);
        const int row = ml_row(b, tc, t);
        const float* g = p.ev_ml_g + (size_t)j * 512 + h * 128;
        const bf16_t* og = p.PB + (size_t)row * 1536 + 1024 + h * 128;
        bf16_t* mrow = p.MIX + (size_t)row * DM + h * 128;
#pragma unroll
        for (int vb = 0; vb < 4; ++vb)
#pragma unroll
            for (int r4 = 0; r4 < 4; ++r4) {
                const int v = vb * 32 + 8 * r4 + 4 * hh;
                const f32x4 gg = *(const f32x4*)(g + v);
                const uint2 ou = *(const uint2*)(og + v);
                *(uint2*)(mrow + v) = make_uint2(cvt_pk_bf16(acc[vb][r4 * 4 + 0] * rstd * gg[0] * sigmoid_f(bf_lo(ou.x)), acc[vb][r4 * 4 + 1] * rstd * gg[1] * sigmoid_f(bf_hi(ou.x))),
                                                 cvt_pk_bf16(acc[vb][r4 * 4 + 2] * rstd * gg[2] * sigmoid_f(bf_lo(ou.y)), acc[vb][r4 * 4 + 3] * rstd * gg[3] * sigmoid_f(bf_hi(ou.y))));
            }
    }
}

__device__ void ph_attn_even(const P& p, int ci, int L, int j, float* smem) {
    int* s_item = (int*)((char*)smem + 73728);
    for (;;) {
        __syncthreads();
        if (otid() == 0) *s_item = atomicAdd(&p.ctr[ci], 1);
        __syncthreads();
        const int item = *s_item;
        if (item >= 1152 + 2304) break;
        if (item < 1152) da_block(p, item, L, j, (char*)smem); else ml_pass1_item(p, item - 1152, j, (char*)smem);
    }
}
__device__ void ph_ml_pass3(const P& p, int j, float* smem) {
    for (int item = blockIdx.x; item < 1152; item += gridDim.x) ml_pass3_item(p, item, j, (char*)smem);
}
__device__ void ph_attn_odd(const P& p, int j, bool need_ctx, float* smem) {
    const int nitem = need_ctx ? 2304 : 2048;
    for (int item = blockIdx.x; item < nitem; item += gridDim.x) { wa_block(p, item, j, (char*)smem); __syncthreads(); }
}

#define SEL_LD 132
template <int NV>
__device__ __forceinline__ unsigned topk16_threshold(const unsigned (&k)[NV], unsigned start) {
    auto cnt = [&](unsigned c) { int n = 0;
#pragma unroll
        for (int i = 0; i < NV; ++i) n += __builtin_popcountll(__ballot(k[i] >= c));
        return n; };
    unsigned E = start; int n = cnt(E);
    if (n >= 16) { for (;;) { const unsigned E2 = E + 0x800000u; if (E2 < E) break; const int n2 = cnt(E2); if (n2 < 16) break; E = E2; n = n2; } }
    else { do { E -= 0x800000u; n = cnt(E); } while (n < 16); }
    unsigned T = E;
    for (int bit = 22; bit >= 0 && n != 16; --bit) { const unsigned c = T | (1u << bit); n = cnt(c); if (n >= 16) T = c; else n = 17; }
    return T;
}
__device__ __forceinline__ unsigned fkey(float f) { const unsigned u = __float_as_uint(f); return (u & 0x80000000u) ? ~u : (u | 0x80000000u); }
__device__ __forceinline__ unsigned mbcnt64(unsigned long long m) { return __builtin_amdgcn_mbcnt_hi((unsigned)(m >> 32), __builtin_amdgcn_mbcnt_lo((unsigned)m, 0u)); }
template <class NextF, class DoneF>
__device__ __forceinline__ void peer_select_loop(const P& p, int L, char* smem, NextF&& next_item, DoneF&& done_item) {
    float* S = (float*)smem;
    const int tid = otid(), lane = tid & 63, wid = tid >> 6, fr = lane & 15, fq = lane >> 4;
    const bf16_t* KBL = p.KB + (size_t)L * 8 * 2 * 128 * 128;
    bf16x8 kfr[8][4];
    int hcur = -1;
    for (int ndone = 0;; ++ndone) {
        const int item = next_item(ndone);
        if (item < 0) break;
        const int h = item & 7, t0 = (item >> 3) * 32;
        __syncthreads();
        {
            const int pp = wid >> 1, th = wid & 1;
            const bf16_t* qp = p.QB + (size_t)(t0 + th * 16 + fr) * 2048 + h * 256 + pp * 128 + fq * 8;
            bf16x8 qf[4];
#pragma unroll
            for (int ks = 0; ks < 4; ++ks) qf[ks] = *(const bf16x8*)(qp + ks * 32);
#ifndef SEL_NOCACHE
            if (h != hcur)
#endif
            {
                const bf16_t* kp = KBL + ((size_t)(h * 2 + pp) * 128 + fr) * 128 + fq * 8;
#pragma unroll
                for (int ni = 0; ni < 8; ++ni)
#pragma unroll
                    for (int ks = 0; ks < 4; ++ks) kfr[ni][ks] = *(const bf16x8*)(kp + (size_t)ni * 16 * 128 + ks * 32);
                hcur = h;
            }
#pragma unroll
            for (int ni = 0; ni < 8; ++ni) {
                f32x4 acc = (f32x4){0.f, 0.f, 0.f, 0.f};
#pragma unroll
                for (int ks = 0; ks < 4; ++ks) acc = __builtin_amdgcn_mfma_f32_16x16x32_bf16(qf[ks], kfr[ni][ks], acc, 0, 0, 0);
#pragma unroll
                for (int j = 0; j < 4; ++j) S[(pp * 32 + th * 16 + fq * 4 + j) * SEL_LD + ni * 16 + fr] = acc[j];
            }
        }
        __syncthreads();
        for (int tt = 0; tt < 8; ++tt) {
            const int t = wid * 8 + tt, r = t0 + t;
            const float v00 = S[t * SEL_LD + lane], v01 = S[t * SEL_LD + 64 + lane], v10 = S[(32 + t) * SEL_LD + lane], v11 = S[(32 + t) * SEL_LD + 64 + lane];
            const unsigned ka0 = fkey(v00), ka1 = fkey(v01), kb0 = fkey(v10), kb1 = fkey(v11);
            const unsigned kA[2] = {ka0, ka1}, kB[2] = {kb0, kb1};
            const unsigned T0 = topk16_threshold<2>(kA, 0xBF800000u), T1 = topk16_threshold<2>(kB, 0xBF800000u);
            float* wsA = (float*)(smem + 34816 + wid * 512);
            {
                const unsigned long long g0 = __ballot(ka0 > T0), g1 = __ballot(ka1 > T0), e0 = __ballot(ka0 == T0), e1 = __ballot(ka1 == T0);
                const int need = 16 - __builtin_popcountll(g0) - __builtin_popcountll(g1);
                const int pe0 = __builtin_popcountll(e0), need1 = need - (pe0 < need ? pe0 : need);
                const bool s0 = (ka0 > T0) || (ka0 == T0 && (int)mbcnt64(e0) < need);
                const bool s1 = (ka1 > T0) || (ka1 == T0 && (int)mbcnt64(e1) < need1);
                const unsigned long long m0 = __ballot(s0), m1 = __ballot(s1);
                if (s0) { const int pos = mbcnt64(m0); wsA[pos] = v00; ((int*)wsA)[16 + pos] = lane; }
                if (s1) { const int pos = __builtin_popcountll(m0) + mbcnt64(m1); wsA[pos] = v01; ((int*)wsA)[16 + pos] = 64 + lane; }
            }
            {
                const unsigned long long g0 = __ballot(kb0 > T1), g1 = __ballot(kb1 > T1), e0 = __ballot(kb0 == T1), e1 = __ballot(kb1 == T1);
                const int need = 16 - __builtin_popcountll(g0) - __builtin_popcountll(g1);
                const int pe0 = __builtin_popcountll(e0), need1 = need - (pe0 < need ? pe0 : need);
                const bool s0 = (kb0 > T1) || (kb0 == T1 && (int)mbcnt64(e0) < need);
                const bool s1 = (kb1 > T1) || (kb1 == T1 && (int)mbcnt64(e1) < need1);
                const unsigned long long m0 = __ballot(s0), m1 = __ballot(s1);
                if (s0) { const int pos = mbcnt64(m0); wsA[32 + pos] = v10; ((int*)wsA)[48 + pos] = lane; }
                if (s1) { const int pos = __builtin_popcountll(m0) + mbcnt64(m1); wsA[32 + pos] = v11; ((int*)wsA)[48 + pos] = 64 + lane; }
            }
            __builtin_amdgcn_wave_barrier();
            float cand[4]; int cidx[4]; unsigned kc[4];
            {
                const float av = wsA[lane >> 2]; const int ai = ((int*)wsA)[16 + (lane >> 2)];
                const float4 bv = *(const float4*)(wsA + 32 + (lane & 3) * 4); const int4 bi = *(const int4*)((int*)wsA + 48 + (lane & 3) * 4);
                cand[0] = av + bv.x; cand[1] = av + bv.y; cand[2] = av + bv.z; cand[3] = av + bv.w;
                cidx[0] = ai * 128 + bi.x; cidx[1] = ai * 128 + bi.y; cidx[2] = ai * 128 + bi.z; cidx[3] = ai * 128 + bi.w;
#pragma unroll
                for (int c = 0; c < 4; ++c) kc[c] = fkey(cand[c]);
            }
            const unsigned T = topk16_threshold<4>(kc, 0xC0800000u);
            {
                int need = 16, base = 0;
#pragma unroll
                for (int c = 0; c < 4; ++c) need -= __builtin_popcountll(__ballot(kc[c] > T));
#pragma unroll
                for (int c = 0; c < 4; ++c) {
                    const unsigned long long e = __ballot(kc[c] == T);
                    const bool sel = (kc[c] > T) || (kc[c] == T && (int)mbcnt64(e) < need);
                    const int pe = __builtin_popcountll(e); need -= (pe < need ? pe : need);
                    const unsigned long long m = __ballot(sel);
                    if (sel) { const int pos = base + mbcnt64(m); wsA[64 + pos] = cand[c]; ((int*)wsA)[80 + pos] = cidx[c]; }
                    base += __builtin_popcountll(m);
                }
            }
            __builtin_amdgcn_wave_barrier();
            {
                const float cv = lane < 16 ? wsA[64 + lane] : -INFINITY;
                const float mx = wave_max(cv);
                const float ex = lane < 16 ? __builtin_amdgcn_exp2f((cv - mx) * 1.4426950408889634f) : 0.f;
                const float sum = wave_sum(ex);
                if (lane < 16) {
                    __hip_atomic_store(&p.GATE[(size_t)r * 128 + h * 16 + lane], ex / sum, __ATOMIC_RELAXED, __HIP_MEMORY_SCOPE_AGENT);
                    __hip_atomic_store(&p.EIDX[(size_t)r * 128 + h * 16 + lane], ((int*)wsA)[80 + lane], __ATOMIC_RELAXED, __HIP_MEMORY_SCOPE_AGENT);
                }
            }
            __builtin_amdgcn_wave_barrier();
        }
        done_item(item);
    }
}


__device__ __forceinline__ int wave_sum_i(int v, int lane) {
    v += __builtin_amdgcn_update_dpp(0, v, 0xB1, 0xF, 0xF, true);
    v += __builtin_amdgcn_update_dpp(0, v, 0x4E, 0xF, 0xF, true);
    v += __builtin_amdgcn_update_dpp(0, v, 0x141, 0xF, 0xF, true);
    v += __builtin_amdgcn_update_dpp(0, v, 0x140, 0xF, 0xF, true);
    v += __builtin_amdgcn_update_dpp(0, v, 0x142, 0xA, 0xF, false);
    v += __builtin_amdgcn_update_dpp(0, v, 0x143, 0xC, 0xF, false);
    return __builtin_amdgcn_readlane(v, 63);
}
__device__ __forceinline__ void peer_gather_token(const P& p, int L, int r, float oscale, int lane) {
    const unsigned char* U = p.U8 + (size_t)L * 16384 * 1024; const unsigned char* V = p.V8 + (size_t)L * 16384 * 1024;
    const float* USC = p.USC + (size_t)L * 16384; const float* VSC = p.VSC + (size_t)L * 16384;
    const float* gate2 = p.modv + (size_t)L * 9 * 6144 + 5120;
    {
        const int e0 = p.EIDX[(size_t)r * 128 + lane], e1 = p.EIDX[(size_t)r * 128 + 64 + lane];
        const float g0 = p.GATE[(size_t)r * 128 + lane], g1 = p.GATE[(size_t)r * 128 + 64 + lane];
        const float us0 = USC[e0], us1 = USC[e1], vs0 = VSC[e0], vs1 = VSC[e1];
        const uint4 xq = *(const uint4*)(p.XQ + (size_t)r * DM + lane * 16);
        const float xs = p.XS[r];
        int d0 = 0, d1 = 0;
#pragma unroll
        for (int half = 0; half < 2; ++half) {
            const int ev = half ? e1 : e0;
            int dv = 0;
#pragma unroll 1
            for (int kb = 0; kb < 4; ++kb) {
                uint4 ua[16];
#pragma unroll
                for (int j = 0; j < 16; ++j) {
                    const int idx = __builtin_amdgcn_readlane(ev, kb * 16 + j);
                    ua[j] = *(const uint4*)(U + (size_t)idx * 1024 + lane * 16);
                }
#pragma unroll
                for (int j = 0; j < 16; ++j) {
                    int sdot = __builtin_amdgcn_sdot4((int)xq.x, (int)ua[j].x, 0, false);
                    sdot = __builtin_amdgcn_sdot4((int)xq.y, (int)ua[j].y, sdot, false);
                    sdot = __builtin_amdgcn_sdot4((int)xq.z, (int)ua[j].z, sdot, false);
                    sdot = __builtin_amdgcn_sdot4((int)xq.w, (int)ua[j].w, sdot, false);
                    sdot = wave_sum_i(sdot, lane);
                    if (lane == kb * 16 + j) dv = sdot;
                }
            }
            if (half) d1 = dv; else d0 = dv;
        }
        const float a0 = us0 * xs * (float)d0, a1 = us1 * xs * (float)d1;
        const float w0 = vs0 * g0 * 0.5f * a0 * (1.f + erff(a0 * 0.70710678118654752f));
        const float w1 = vs1 * g1 * 0.5f * a1 * (1.f + erff(a1 * 0.70710678118654752f));
        const float wmax = wave_max(fmaxf(fabsf(w0), fabsf(w1)));
        const float winv = wmax > 0.f ? 127.f / wmax : 0.f;
        const int wq0 = (int)rintf(w0 * winv) & 0xff, wq1 = (int)rintf(w1 * winv) & 0xff;
        int acc[16];
#pragma unroll
        for (int c = 0; c < 16; ++c) acc[c] = 0;
#pragma unroll
        for (int half = 0; half < 2; ++half) {
            const int ev = half ? e1 : e0; const int wqv = half ? wq1 : wq0;
#pragma unroll 1
            for (int kb = 0; kb < 4; ++kb) {
                uint4 ua[16];
#pragma unroll
                for (int j = 0; j < 16; ++j) {
                    const int idx = __builtin_amdgcn_readlane(ev, kb * 16 + j);
                    ua[j] = *(const uint4*)(V + (size_t)idx * 1024 + lane * 16);
                }
#pragma unroll
                for (int j4 = 0; j4 < 4; ++j4) {
                    const int k0 = kb * 16 + j4 * 4;
                    const int wpk = __builtin_amdgcn_readlane(wqv, k0) | (__builtin_amdgcn_readlane(wqv, k0 + 1) << 8) | (__builtin_amdgcn_readlane(wqv, k0 + 2) << 16) | (__builtin_amdgcn_readlane(wqv, k0 + 3) << 24);
#define TR_DOT(D, M) { const unsigned ablo = __builtin_amdgcn_perm(ua[j4 * 4 + 1].M, ua[j4 * 4].M, 0x05010400u), abhi = __builtin_amdgcn_perm(ua[j4 * 4 + 1].M, ua[j4 * 4].M, 0x07030602u); \
                        const unsigned celo = __builtin_amdgcn_perm(ua[j4 * 4 + 3].M, ua[j4 * 4 + 2].M, 0x05010400u), cehi = __builtin_amdgcn_perm(ua[j4 * 4 + 3].M, ua[j4 * 4 + 2].M, 0x07030602u); \
                        acc[(D) * 4 + 0] = __builtin_amdgcn_sdot4((int)__builtin_amdgcn_perm(celo, ablo, 0x05040100u), wpk, acc[(D) * 4 + 0], false); \
                        acc[(D) * 4 + 1] = __builtin_amdgcn_sdot4((int)__builtin_amdgcn_perm(celo, ablo, 0x07060302u), wpk, acc[(D) * 4 + 1], false); \
                        acc[(D) * 4 + 2] = __builtin_amdgcn_sdot4((int)__builtin_amdgcn_perm(cehi, abhi, 0x05040100u), wpk, acc[(D) * 4 + 2], false); \
                        acc[(D) * 4 + 3] = __builtin_amdgcn_sdot4((int)__builtin_amdgcn_perm(cehi, abhi, 0x07060302u), wpk, acc[(D) * 4 + 3], false); }
                    TR_DOT(0, x) TR_DOT(1, y) TR_DOT(2, z) TR_DOT(3, w)
#undef TR_DOT
                }
            }
        }
        const float osc = oscale * wmax * (1.f / 127.f);
        const float* gp = gate2 + (size_t)modrow(r) * 6144 + lane * 16;
        float* hp = p.H + (size_t)r * DM + lane * 16;
        float hn[16]; float ss = 0.f;
#pragma unroll
        for (int q = 0; q < 4; ++q) {
            const float4 g = *(const float4*)(gp + q * 4);
            float4 hv = *(float4*)(hp + q * 4);
            hv.x += osc * g.x * (float)acc[q * 4 + 0]; hv.y += osc * g.y * (float)acc[q * 4 + 1];
            hv.z += osc * g.z * (float)acc[q * 4 + 2]; hv.w += osc * g.w * (float)acc[q * 4 + 3];
            if (L < 3) *(float4*)(hp + q * 4) = hv;
            hn[q * 4 + 0] = hv.x; hn[q * 4 + 1] = hv.y; hn[q * 4 + 2] = hv.z; hn[q * 4 + 3] = hv.w;
            ss += hv.x * hv.x + hv.y * hv.y + hv.z * hv.z + hv.w * hv.w;
        }
        ss = wave_sum(ss);
        const float rstd = rsqrtf(ss * (1.0f / DM) + 1e-6f);
        if (L < 3) {
            const float* g1 = p.norm1_g + (size_t)(L + 1) * DM + lane * 16;
            const float* mvn = p.modv + ((size_t)(L + 1) * 9 + modrow(r)) * 6144 + lane * 16;
            unsigned w[8];
#pragma unroll
            for (int q = 0; q < 4; ++q) {
                const float4 gg = *(const float4*)(g1 + q * 4), sh = *(const float4*)(mvn + q * 4), scl = *(const float4*)(mvn + 1024 + q * 4);
                w[q * 2] = cvt_pk_bf16(hn[q * 4 + 0] * rstd * gg.x * (1.f + scl.x) + sh.x, hn[q * 4 + 1] * rstd * gg.y * (1.f + scl.y) + sh.y);
                w[q * 2 + 1] = cvt_pk_bf16(hn[q * 4 + 2] * rstd * gg.z * (1.f + scl.z) + sh.z, hn[q * 4 + 3] * rstd * gg.w * (1.f + scl.w) + sh.w);
            }
            uint4* xp = (uint4*)(p.XN + (size_t)r * DM + lane * 16);
            xp[0] = make_uint4(w[0], w[1], w[2], w[3]); xp[1] = make_uint4(w[4], w[5], w[6], w[7]);
        } else {
            const float* fg = p.final_g + lane * 16;
            float* op = p.out + (size_t)r * DM + lane * 16;
#pragma unroll
            for (int q = 0; q < 4; ++q) {
                const float4 gg = *(const float4*)(fg + q * 4);
                *(float4*)(op + q * 4) = make_float4(hn[q * 4 + 0] * rstd * gg.x, hn[q * 4 + 1] * rstd * gg.y, hn[q * 4 + 2] * rstd * gg.z, hn[q * 4 + 3] * rstd * gg.w);
            }
        }
    }
}

__device__ void ph_peer_sg(const P& p, int L, int nrows, int* q2, unsigned* tflag, float oscale, char* smem) {
    int* s_item = (int*)(smem + 73728);
    const int tid = otid(), lane = tid & 63, wid = __builtin_amdgcn_readfirstlane(tid >> 6);
    const int nsel = (nrows / 32) * 8, ngat = nrows / 8;
    const bool roleS = ((blockIdx.x >> 8) & 1) == 0;
    peer_select_loop(p, L, smem,
        [&](int ndone) -> int {
            if (!roleS && ndone >= 1) return -1;
            __syncthreads();
            if (tid == 0) *s_item = atomicAdd(&q2[0], 1);
            __syncthreads();
            const int it = *s_item;
            return it < nsel ? it : -1;
        },
        [&](int item) {
            asm volatile("s_waitcnt vmcnt(0)" ::: "memory");
            __syncthreads();
            if (tid == 0) __hip_atomic_fetch_add(&tflag[item >> 3], 1u, __ATOMIC_RELAXED, __HIP_MEMORY_SCOPE_AGENT);
        });
    for (;;) {
        __syncthreads();
        if (tid == 0) {
            const int g = atomicAdd(&q2[1], 1);
            *s_item = g;
            if (g < ngat) {
                unsigned sp = 0;
                while (__hip_atomic_load(&tflag[g >> 2], __ATOMIC_RELAXED, __HIP_MEMORY_SCOPE_AGENT) < 8u) { __builtin_amdgcn_s_sleep(2); if (++sp > (1u << 24)) break; }
                __builtin_amdgcn_fence(__ATOMIC_ACQUIRE, "agent");
                asm volatile("s_waitcnt vmcnt(0)" ::: "memory");
            }
        }
        __syncthreads();
        const int g = *s_item;
        if (g >= ngat) break;
        peer_gather_token(p, L, g * 8 + wid * 2, oscale, lane);
        peer_gather_token(p, L, g * 8 + wid * 2 + 1, oscale, lane);
    }
}

#define NSUB 11
__device__ __forceinline__ bool phase_empty(int ph) {
    if (ph == 0) return false;
    const int L = (ph - 1) / NSUB, s = (ph - 1) % NSUB;
    return s == 2 || s == 10 || ((L & 1) && (s == 4 || s == 5)) || (L > 0 && s == 0);
}
__device__ __forceinline__ void run_phase(const P& p, int ph, float* smem, int rep) {
    if (ph == 0) { ph_prologue(p, smem); return; }
    const int L = (ph - 1) / NSUB, s = (ph - 1) % NSUB, j = L >> 1;
    const bool even = (L & 1) == 0, need_ctx = L < 3;
    const int nrows = need_ctx ? NT : NL;
    const float* mv = p.modv + (size_t)L * 9 * 6144;
    switch (s) {
    case 0: ph_normmod(p.H, p.norm1_g + L * DM, mv, 0, 1024, p.XN, NT); break;
    case 1:
        if (even) ph_gemm(p.XN, p.WT + WT_EVIN(j), NT, 3200, EpiEven{p.PB, p.AQL, p.AQC, p.AK, p.AV, p.GT, p.rope}, (char*)smem);
        else ph_gemm(p.XN, p.WT + WT_ODIN(j), NT, ODW, EpiOdd{p.AQL, p.AQC, p.AK, p.AV, p.rope}, (char*)smem);
        break;
    case 3: if (even) ph_attn_even(p, L + 4 * rep, L, j, smem); else ph_attn_odd(p, j, need_ctx, smem); break;
    case 4: if (even) ph_ml_pass2(p); break;
    case 5: if (even) ph_ml_pass3(p, j, smem); break;
    case 6: ph_gemm(p.MIX, p.WT + (even ? WT_EVOUT(j) : WT_ODOUT(j)), nrows, DM, EpiResid{p.H, mv + 2048, rep ? 0.f : 1.f}, (char*)smem); break;
    case 7: ph_normmod_q(p, p.norm2_g + L * DM, mv, nrows); break;
    case 8: ph_gemm(p.XN, p.WT + WT_PQ(L), nrows, 2048, EpiStoreBF16{p.QB, 2048}, (char*)smem); break;
    case 9: ph_peer_sg(p, L, nrows, p.ctr + 16 + L * 2, (unsigned*)p.ctr + 256 + L * 576, rep ? 0.f : 1.f, (char*)smem); break;
    }
}

#define XB_TMO      128
#define XB_XCNT(j)  (256  + 64 * (j))
#define XB_XSUB(j)  (1280 + 64 * (j))
#define XB_XGEN(j)  (2304 + 64 * (j))
#define XB_TOP      3328
#define XB_TOPGEN   3392
#define XCD_BAR_WORDS 3456
#define XB_SPIN_CAP (1u << 20)
#define LAS __attribute__((address_space(3)))
__device__ __forceinline__ unsigned xb_ld(unsigned* p)              { return __hip_atomic_load(p, __ATOMIC_RELAXED, __HIP_MEMORY_SCOPE_AGENT); }
__device__ __forceinline__ unsigned xb_add(unsigned* p, unsigned v) { return __hip_atomic_fetch_add(p, v, __ATOMIC_RELAXED, __HIP_MEMORY_SCOPE_AGENT); }
__device__ __forceinline__ unsigned xb_xcc_id() { return (unsigned)__builtin_amdgcn_s_getreg((3 << 11) | 20) & 0xFu; }
#define XB_SPIN(cond, bar) do { unsigned _sp = 0; while (cond) { __builtin_amdgcn_s_sleep(1); \
    if ((++_sp & 255u) == 0u) { if (xb_ld(&(bar)[XB_TMO])) break; if (_sp > XB_SPIN_CAP) { atomicAdd(&(bar)[XB_TMO], 1u); break; } } } } while (0)
struct XcdBarrier { unsigned* bar; unsigned x; volatile LAS unsigned* st; };
__device__ __forceinline__ XcdBarrier xcd_barrier_post(unsigned* bar, volatile LAS unsigned* st) {
    XcdBarrier b; b.bar = bar; b.x = xb_xcc_id(); b.st = st;
    if (threadIdx.x == 0) (void)xb_add(&bar[XB_XCNT(b.x)], 1u);
    return b;
}
__device__ __forceinline__ void xcd_barrier_complete(unsigned* bar, unsigned x, unsigned& nloc, unsigned& nx) {
    const unsigned G = gridDim.x * gridDim.y * gridDim.z;
    unsigned sum, cnt, mine, sp = 0u;
    for (;;) {
        sum = 0u; cnt = 0u; mine = 0u;
#pragma unroll
        for (unsigned j = 0; j < 16; ++j) { const unsigned c = xb_ld(&bar[XB_XCNT(j)]); sum += c; cnt += (c > 0u) ? 1u : 0u; mine = (j == x) ? c : mine; }
        if (sum == G) break;
        __builtin_amdgcn_s_sleep(1);
        if ((++sp & 255u) == 0u) { if (xb_ld(&bar[XB_TMO])) break; if (sp > XB_SPIN_CAP) { atomicAdd(&bar[XB_TMO], 1u); break; } }
    }
    nloc = mine > 0u ? mine : 1u; nx = cnt > 0u ? cnt : 1u;
}
__device__ __forceinline__ void xcd_barrier(const XcdBarrier& b) {
    asm volatile("s_waitcnt vmcnt(0)" ::: "memory");
    __syncthreads();
    if (threadIdx.x == 0) {
        unsigned* bar = b.bar;
        __builtin_amdgcn_s_waitcnt(0);
        unsigned nloc = b.st[0], nx = b.st[1];
        if (nloc == 0u) { xcd_barrier_complete(bar, b.x, nloc, nx); b.st[0] = nloc; b.st[1] = nx; }
        const unsigned old = xb_add(&bar[XB_XSUB(b.x)], 1u);
        const unsigned gen = old / nloc;
        if (old + 1u == (gen + 1u) * nloc) {
            __builtin_amdgcn_fence(__ATOMIC_RELEASE, "agent");
            asm volatile("s_waitcnt vmcnt(0)" ::: "memory");
            const unsigned og = xb_add(&bar[XB_TOP], 1u);
            const unsigned tg = og / nx;
            if (og + 1u == (tg + 1u) * nx) xb_add(&bar[XB_TOPGEN], 1u);
            else XB_SPIN(xb_ld(&bar[XB_TOPGEN]) == tg, bar);
            __builtin_amdgcn_fence(__ATOMIC_ACQUIRE, "agent");
            xb_add(&bar[XB_XGEN(b.x)], 1u);
            asm volatile("s_waitcnt vmcnt(0)" ::: "memory");
        } else {
            XB_SPIN(xb_ld(&bar[XB_XGEN(b.x)]) == gen, bar);
            __builtin_amdgcn_fence(__ATOMIC_ACQUIRE, "agent");
            asm volatile("s_waitcnt vmcnt(0)" ::: "memory");
        }
    }
    __syncthreads();
}

__global__ void __launch_bounds__(256, 2) mega(P p) {
    extern __shared__ __attribute__((aligned(16))) float smem[];
    cg::grid_group grid = cg::this_grid();
    volatile LAS unsigned* st = (volatile LAS unsigned*)((char*)smem + 73744);
    if (threadIdx.x < 4) st[threadIdx.x] = 0u;
    __syncthreads();
    XcdBarrier xb = xcd_barrier_post(p.bar, st);
    for (int ph = p.ph_lo; ph < p.ph_hi; ++ph) {
        if (phase_empty(ph)) continue;
        run_phase(p, ph, smem, 0);
        if (PROBE_N > 1 && ph > 0 && (ph - 1) % NSUB == PROBE_S)
            for (int rep = 1; rep < PROBE_N; ++rep) { xcd_barrier(xb); run_phase(p, ph, smem, rep); }
        if (ph + 1 < p.ph_hi) { if (ph == 0) grid.sync(); else xcd_barrier(xb); }
    }
}

extern "C" void kernel_launch(void* const* d_in, const int* in_sizes, int n_in, void* d_out, int out_size, void* d_ws, size_t ws_size, hipStream_t stream) {
    static int grid_blocks = 0;
    if (!grid_blocks) {
        int dev = 0, cus = 0, per_cu = 0;
        hipGetDevice(&dev);
        hipDeviceGetAttribute(&cus, hipDeviceAttributeMultiprocessorCount, dev);
        hipFuncSetAttribute((const void*)mega, hipFuncAttributeMaxDynamicSharedMemorySize, LDS_BYTES);
        hipOccupancyMaxActiveBlocksPerMultiprocessor(&per_cu, mega, 256, LDS_BYTES);
        if (per_cu < 1) per_cu = 1;
        if (per_cu > 2) per_cu = 2;
        grid_blocks = cus * per_cu;
    }
    P p{};
    const float** ins = (const float**)&p;
    for (int i = 0; i < 24; ++i) ins[i] = (const float*)d_in[i];
    p.out = (float*)d_out;
    size_t off = 0; char* ws = (char*)d_ws;
    auto carve = [&](size_t bytes) { void* r = ws + off; off += (bytes + 255) & ~(size_t)255; return r; };
    p.modv = (float*)carve((size_t)4 * 9 * 6144 * 4);
    p.rope = (float*)carve((size_t)2048 * 64 * 4);
    p.H = (float*)carve((size_t)NT * DM * 4);
    p.XN = (bf16_t*)carve((size_t)NT * DM * 2);
    p.WT = (bf16_t*)carve(WT_TOTAL * 2);
    p.MIX = (bf16_t*)carve((size_t)NT * DM * 2);
    p.PB = (bf16_t*)carve((size_t)NT * 1536 * 2);
    p.GT = (float*)carve((size_t)NT * 16 * 4);
    p.AQL = (bf16_t*)carve((size_t)8 * 16 * 2048 * 64 * 2);
    p.AQC = (bf16_t*)carve((size_t)8 * 16 * 256 * 64 * 2);
    p.AK = (bf16_t*)carve((size_t)8 * 4 * 2 * 2304 * 64 * 2);
    p.AV = (bf16_t*)carve((size_t)8 * 4 * 128 * 2304 * 2);
    p.QKB = (bf16_t*)carve((size_t)NT * 512 * 2);
    p.CLOC = (float*)carve((size_t)2304 * 8192 * 4);
    p.CST = (bf16_t*)carve((size_t)2304 * 8192 * 2);
    p.NLOC = (float*)carve((size_t)2304 * 64 * 4);
    p.NST = (float*)carve((size_t)2304 * 64 * 4);
    p.CHB = (float*)carve((size_t)2304 * 4);
    p.CHM = (float*)carve((size_t)2304 * 4);
    p.MST = (float*)carve((size_t)2304 * 4);
    p.QB = (bf16_t*)carve((size_t)NT * 2048 * 2);
    p.GATE = (float*)carve((size_t)NT * 128 * 4);
    p.EIDX = (int*)carve((size_t)NT * 128 * 4);
    p.ctr = (int*)carve(2560 * 4);
    p.bar = (unsigned*)carve((size_t)XCD_BAR_WORDS * 4);
    p.U8 = (unsigned char*)carve((size_t)4 * 16384 * 1024);
    p.V8 = (unsigned char*)carve((size_t)4 * 16384 * 1024);
    p.XQ = (unsigned char*)carve((size_t)NT * DM);
    p.XS = (float*)carve((size_t)NT * 4);
    p.USC = (float*)carve((size_t)4 * 16384 * 4);
    p.VSC = (float*)carve((size_t)4 * 16384 * 4);
    p.KB = (bf16_t*)carve((size_t)4 * 8 * 2 * 128 * 128 * 2);
    if (off > ws_size) { fprintf(stderr, "kernel_launch: workspace too small: need %zu have %zu\n", off, ws_size); return; }
    hipMemsetAsync(p.bar, 0, (size_t)XCD_BAR_WORDS * 4, stream);
#if ONE_LAUNCH
    p.ph_lo = 0; p.ph_hi = NPH;
    void* args[] = {&p};
    hipError_t e = hipLaunchCooperativeKernel((void*)mega, dim3(grid_blocks), dim3(256), args, LDS_BYTES, stream);
    if (e != hipSuccess) fprintf(stderr, "cooperative launch failed: %s (grid %d)\n", hipGetErrorString(e), grid_blocks);
#else
    for (int ph = 0; ph < NPH; ++ph) {
        if (ph > 0 && ph < NPH - 1) { const int L = (ph - 1) / NSUB, s = (ph - 1) % NSUB; if ((s == 2 || s == 4 || s == 5) && (L & 1)) continue; }
        p.ph_lo = ph; p.ph_hi = ph + 1;
        hipLaunchKernelGGL(mega, dim3(grid_blocks), dim3(256), LDS_BYTES, stream, p);
    }
#endif
}
```

```cpp
#include <hip/hip_runtime.h>
#include <hip/hip_cooperative_groups.h>
#include <cstdio>
#include <cstdint>
namespace cg = cooperative_groups;

#ifndef ONE_LAUNCH
#define ONE_LAUNCH 1
#endif

#define NT 18432
#define NL 16384
#define DM 1024
#define EVW 3088
#define ODW 1536
#define C_QK 0
#define C_V 512
#define C_O 1024
#define C_G 1536
#define C_DQ 1552
#define C_DK 2064
#define C_DV 2576
#define NPH 45
#ifndef PROBE_S
#define PROBE_S -1
#endif
#ifndef PROBE_N
#define PROBE_N 1
#endif

typedef unsigned short bf16_t;
typedef short bf16x8 __attribute__((ext_vector_type(8)));
typedef float f32x4 __attribute__((ext_vector_type(4)));
#define LDS_BYTES 73792

typedef float f32x16 __attribute__((ext_vector_type(16)));
typedef unsigned u32x4 __attribute__((ext_vector_type(4)));
struct P {
    const float *x, *c, *ctx, *c_ctx, *mod_w, *mod_b, *norm1_g, *norm2_g, *ev_w_in, *ev_conv_w, *ev_conv_b, *ev_gate_b,
        *ev_ml_g, *ev_da_lam, *ev_da_g, *ev_w_out, *od_w_in, *od_sink, *od_w_out, *pr_w_q, *pr_keys, *pr_u, *pr_v, *final_g;
    float* out;
    float *modv, *H, *GATE, *rope, *GT, *CLOC, *NLOC, *NST, *CHB, *CHM, *MST;
    int *EIDX, *ctr;
    unsigned* bar;
    bf16_t *XN, *MIX, *WT, *KB, *QB, *PB, *AQL, *AQC, *AK, *AV, *QKB, *CST;
    unsigned char *U8, *V8;
    float *USC, *VSC, *XS;
    unsigned char* XQ;
    int ph_lo, ph_hi;
};
#define QSCALE 0.18033688011112042f

__device__ __forceinline__ int otid() { int t = threadIdx.x; asm volatile("" : "+v"(t)); return t; }
__device__ __forceinline__ unsigned pack_i8x4(float a, float b, float c, float d) {
    return ((unsigned)(int)rintf(a) & 0xffu) | (((unsigned)(int)rintf(b) & 0xffu) << 8) | (((unsigned)(int)rintf(c) & 0xffu) << 16) | ((unsigned)(int)rintf(d) << 24);
}
__device__ __forceinline__ int xcc_id8() { return (int)((unsigned)__builtin_amdgcn_s_getreg((3 << 11) | 20) & 7u); }
__device__ __forceinline__ int modrow(int r) { return r < NL ? (r >> 11) : 8; }
__device__ __forceinline__ float silu_f(float x) { return x / (1.f + expf(-x)); }
__device__ __forceinline__ float sigmoid_f(float x) { return 1.f / (1.f + expf(-x)); }
__device__ __forceinline__ float log_sigmoid_f(float x) { return fminf(x, 0.f) - log1pf(expf(-fabsf(x))); }
typedef __bf16 bf16v2_t __attribute__((ext_vector_type(2)));
typedef float f32x2_t __attribute__((ext_vector_type(2)));
__device__ __forceinline__ unsigned cvt_pk_bf16(float lo, float hi) { const bf16v2_t v = __builtin_convertvector((f32x2_t){lo, hi}, bf16v2_t); return __builtin_bit_cast(unsigned, v); }
__device__ __forceinline__ float bf_lo(unsigned u) { return __uint_as_float(u << 16); }
__device__ __forceinline__ float bf_hi(unsigned u) { return __uint_as_float(u & 0xffff0000u); }
__device__ __forceinline__ void unpack8(const uint4 u, float* f) {
    f[0] = bf_lo(u.x); f[1] = bf_hi(u.x); f[2] = bf_lo(u.y); f[3] = bf_hi(u.y); f[4] = bf_lo(u.z); f[5] = bf_hi(u.z); f[6] = bf_lo(u.w); f[7] = bf_hi(u.w);
}
#define WT_EVIN(j) ((size_t)(j) * 3200 * 1024)
#define WT_EVOUT(j) ((size_t)2 * 3200 * 1024 + (size_t)(j) * 1024 * 1024)
#define WT_ODIN(j) ((size_t)2 * 3200 * 1024 + (size_t)2 * 1024 * 1024 + (size_t)(j) * 1536 * 1024)
#define WT_ODOUT(j) ((size_t)2 * 3200 * 1024 + (size_t)2 * 1024 * 1024 + (size_t)2 * 1536 * 1024 + (size_t)(j) * 1024 * 1024)
#define WT_PQ(L) ((size_t)2 * 3200 * 1024 + (size_t)4 * 1024 * 1024 + (size_t)2 * 1536 * 1024 + (size_t)(L) * 2048 * 1024)
#define WT_TOTAL ((size_t)2 * 3200 * 1024 + (size_t)4 * 1024 * 1024 + (size_t)2 * 1536 * 1024 + (size_t)4 * 2048 * 1024)
__device__ __forceinline__ float lshfl(float v, int src) { return __int_as_float(__builtin_amdgcn_ds_bpermute(src << 2, __float_as_int(v))); }
#define SHX(v, m) lshfl((v), lane ^ (m))
#define wave_sum(v) wave_sum_l((v), lane)
#define wave_max(v) wave_max_l((v), lane)
template <int CTRL> __device__ __forceinline__ int dppi(int v) { return __builtin_amdgcn_update_dpp(0, v, CTRL, 0xF, 0xF, true); }
template <int CTRL, int RMASK> __device__ __forceinline__ float dppf(float v, float fill) { return __int_as_float(__builtin_amdgcn_update_dpp(__float_as_int(fill), __float_as_int(v), CTRL, RMASK, 0xF, false)); }
__device__ __forceinline__ float wave_sum_l(float v, int lane) {
    v += dppf<0xB1, 0xF>(v, 0.f); v += dppf<0x4E, 0xF>(v, 0.f); v += dppf<0x141, 0xF>(v, 0.f); v += dppf<0x140, 0xF>(v, 0.f);
    v += dppf<0x142, 0xA>(v, 0.f); v += dppf<0x143, 0xC>(v, 0.f);
    return __int_as_float(__builtin_amdgcn_readlane(__float_as_int(v), 63));
}
__device__ __forceinline__ float wave_max_l(float v, int lane) {
    v = fmaxf(v, dppf<0xB1, 0xF>(v, v)); v = fmaxf(v, dppf<0x4E, 0xF>(v, v)); v = fmaxf(v, dppf<0x141, 0xF>(v, v)); v = fmaxf(v, dppf<0x140, 0xF>(v, v));
    v = fmaxf(v, dppf<0x142, 0xA>(v, v)); v = fmaxf(v, dppf<0x143, 0xC>(v, v));
    return __int_as_float(__builtin_amdgcn_readlane(__float_as_int(v), 63));
}

__device__ void cvt_copy_bf16(const float* src, bf16_t* dst, size_t n);
__device__ void quant_rows_i4(const float* src, unsigned char* dst, float* scl, int nrows);
__device__ void ph_prologue(const P& p, float* smem) {
    const int tid = otid(), nb = gridDim.x, bid = blockIdx.x;
    if (bid == 0) for (int i = tid; i < 2560; i += 256) p.ctr[i] = 0;
    {
        const float4* xs = (const float4*)p.x; const float4* cs = (const float4*)p.ctx; float4* hd = (float4*)p.H;
        const size_t nx = (size_t)NL * DM / 4, nc = (size_t)(NT - NL) * DM / 4;
        for (size_t i = (size_t)bid * 256 + tid; i < nx + nc; i += (size_t)nb * 256) hd[i] = i < nx ? xs[i] : cs[i - nx];
    }
    for (int i = bid * 256 + tid; i < 2048 * 32; i += nb * 256) {
        const int s = i >> 5, d = i & 31;
        const float pos = (d < 16) ? (float)(s >> 6) : (float)(s & 63);
        const float inv = powf(10000.0f, -(float)(d & 15) / 16.0f);
        const float ang = pos * inv;
        p.rope[2 * i] = cosf(ang); p.rope[2 * i + 1] = sinf(ang);
    }
    float* sc = smem;
    float* red = smem + 9 * 1024;
    for (int i = tid; i < 9 * 1024; i += 256) { const int r = i >> 10, k = i & 1023; const float v = r < 8 ? p.c[r * 1024 + k] : p.c_ctx[k]; sc[i] = silu_f(v); }
    __syncthreads();
    for (int item = bid; item < 4 * 96; item += nb) {
        const int L = item / 96, n0 = (item % 96) * 64, tx = tid & 63, kq = tid >> 6;
        float acc[9];
#pragma unroll
        for (int r = 0; r < 9; ++r) acc[r] = 0.f;
        const float* w = p.mod_w + (size_t)L * 1024 * 6144 + n0 + tx;
        for (int k = kq * 256; k < kq * 256 + 256; ++k) {
            const float wv = w[(size_t)k * 6144];
#pragma unroll
            for (int r = 0; r < 9; ++r) acc[r] += sc[r * 1024 + k] * wv;
        }
#pragma unroll
        for (int r = 0; r < 9; ++r) red[(kq * 9 + r) * 64 + tx] = acc[r];
        __syncthreads();
        if (kq == 0) {
#pragma unroll
            for (int r = 0; r < 9; ++r) {
                const float s = red[(0 * 9 + r) * 64 + tx] + red[(1 * 9 + r) * 64 + tx] + red[(2 * 9 + r) * 64 + tx] + red[(3 * 9 + r) * 64 + tx];
                p.modv[((size_t)L * 9 + r) * 6144 + n0 + tx] = s + p.mod_b[L * 6144 + n0 + tx];
            }
        }
        __syncthreads();
    }
    {
        float (*tile)[65] = (float (*)[65])smem;
        for (int item = bid; item < 5440; item += nb) {
            int it = item, mat = 0, N = 0, Npad = 0; const float* src = nullptr; bf16_t* dst = nullptr;
            for (mat = 0; mat < 12; ++mat) {
                if (mat < 2) { N = EVW; Npad = 3200; src = p.ev_w_in + (size_t)mat * DM * EVW; dst = p.WT + WT_EVIN(mat); }
                else if (mat < 4) { N = 1024; Npad = 1024; src = p.ev_w_out + (size_t)(mat - 2) * DM * DM; dst = p.WT + WT_EVOUT(mat - 2); }
                else if (mat < 6) { N = ODW; Npad = ODW; src = p.od_w_in + (size_t)(mat - 4) * DM * ODW; dst = p.WT + WT_ODIN(mat - 4); }
                else if (mat < 8) { N = 1024; Npad = 1024; src = p.od_w_out + (size_t)(mat - 6) * DM * DM; dst = p.WT + WT_ODOUT(mat - 6); }
                else { N = 2048; Npad = 2048; src = p.pr_w_q + (size_t)(mat - 8) * DM * 2048; dst = p.WT + WT_PQ(mat - 8); }
                const int nt = 16 * (Npad / 64);
                if (it < nt) break;
                it -= nt;
            }
            const int k0 = (it & 15) * 64, n0 = (it >> 4) * 64;
            __syncthreads();
#pragma unroll
            for (int rep = 0; rep < 4; ++rep) {
                const int i = (tid >> 4) + 16 * rep, c4 = (tid & 15) * 4;
                float4 v = make_float4(0.f, 0.f, 0.f, 0.f);
                int sc = n0 + c4;
                if (mat < 2) sc = sc < 1536 ? sc : (sc < 3072 ? sc + 16 : (sc < 3088 ? sc - 3072 + 1536 : N));
                if (sc < N) v = *(const float4*)(src + (size_t)(k0 + i) * N + sc);
                tile[i][c4] = v.x; tile[i][c4 + 1] = v.y; tile[i][c4 + 2] = v.z; tile[i][c4 + 3] = v.w;
            }
            __syncthreads();
            {
                const int n = tid >> 2, kq = (tid & 3) * 16;
                unsigned w[8];
#pragma unroll
                for (int e = 0; e < 8; ++e) w[e] = cvt_pk_bf16(tile[kq + 2 * e][n], tile[kq + 2 * e + 1][n]);
                uint4* dp = (uint4*)(dst + (size_t)(n0 + n) * DM + k0 + kq);
                dp[0] = make_uint4(w[0], w[1], w[2], w[3]); dp[1] = make_uint4(w[4], w[5], w[6], w[7]);
            }
        }
    }
    quant_rows_i4(p.pr_u, p.U8, p.USC, 4 * 16384);
    quant_rows_i4(p.pr_v, p.V8, p.VSC, 4 * 16384);
    cvt_copy_bf16(p.pr_keys, p.KB, (size_t)4 * 8 * 2 * 128 * 128);
}

__device__ void ph_normmod_q(const P& p, const float* g, const float* modv_layer, int nrows) {
    const int lane = otid() & 63, wid = __builtin_amdgcn_readfirstlane(otid() >> 6);
    for (int r = blockIdx.x * 4 + wid; r < nrows; r += gridDim.x * 4) {
        const float4* s4 = (const float4*)(p.H + (size_t)r * DM);
        float4 v[4]; float ss = 0.f;
#pragma unroll
        for (int i = 0; i < 4; ++i) { v[i] = s4[i * 64 + lane]; ss += v[i].x * v[i].x + v[i].y * v[i].y + v[i].z * v[i].z + v[i].w * v[i].w; }
        ss = wave_sum(ss);
        const float rstd = rsqrtf(ss * (1.0f / DM) + 1e-6f);
        const float* mv = modv_layer + (size_t)modrow(r) * 6144;
        float4 o[4]; float mx = 0.f;
#pragma unroll
        for (int i = 0; i < 4; ++i) {
            const int c = (i * 64 + lane) * 4;
            const float4 gg = *(const float4*)(g + c), sh = *(const float4*)(mv + 3072 + c), scl = *(const float4*)(mv + 4096 + c);
            o[i].x = v[i].x * rstd * gg.x * (1.f + scl.x) + sh.x; o[i].y = v[i].y * rstd * gg.y * (1.f + scl.y) + sh.y;
            o[i].z = v[i].z * rstd * gg.z * (1.f + scl.z) + sh.z; o[i].w = v[i].w * rstd * gg.w * (1.f + scl.w) + sh.w;
            mx = fmaxf(mx, fmaxf(fmaxf(fabsf(o[i].x), fabsf(o[i].y)), fmaxf(fabsf(o[i].z), fabsf(o[i].w))));
        }
        mx = wave_max(mx);
        const float inv = mx > 0.f ? 127.f / mx : 0.f;
        uint2* xn = (uint2*)(p.XN + (size_t)r * DM);
        unsigned* xq = (unsigned*)(p.XQ + (size_t)r * DM);
#pragma unroll
        for (int i = 0; i < 4; ++i) {
            xn[i * 64 + lane] = make_uint2(cvt_pk_bf16(o[i].x, o[i].y), cvt_pk_bf16(o[i].z, o[i].w));
            xq[i * 64 + lane] = pack_i8x4(o[i].x * inv, o[i].y * inv, o[i].z * inv, o[i].w * inv);
        }
        if (lane == 0) p.XS[r] = mx * (1.f / 127.f);
    }
}

__device__ void cvt_copy_bf16(const float* src, bf16_t* dst, size_t n) {
    const size_t n8 = n / 8;
    for (size_t i = (size_t)blockIdx.x * 256 + otid(); i < n8; i += (size_t)gridDim.x * 256) {
        const float4 a = ((const float4*)src)[2 * i], b = ((const float4*)src)[2 * i + 1];
        ((uint4*)dst)[i] = make_uint4(cvt_pk_bf16(a.x, a.y), cvt_pk_bf16(a.z, a.w), cvt_pk_bf16(b.x, b.y), cvt_pk_bf16(b.z, b.w));
    }
}

__device__ __forceinline__ unsigned lvl4(float x) { int i = (int)floorf(x) + 8; i = i < 0 ? 0 : (i > 15 ? 15 : i); return (unsigned)i; }
__device__ void quant_rows_i4(const float* src, unsigned char* dst, float* scl, int nrows) {
    const int lane = otid() & 63, wid = __builtin_amdgcn_readfirstlane(otid() >> 6);
    for (int r = blockIdx.x * 4 + wid; r < nrows; r += gridDim.x * 4) {
        const float4* sp = (const float4*)(src + (size_t)r * 1024);
        float4 v[4]; float mx = 0.f, ss = 0.f;
#pragma unroll
        for (int i = 0; i < 4; ++i) {
            v[i] = sp[i * 64 + lane]; mx = fmaxf(mx, fmaxf(fmaxf(fabsf(v[i].x), fabsf(v[i].y)), fmaxf(fabsf(v[i].z), fabsf(v[i].w))));
            ss += v[i].x * v[i].x + v[i].y * v[i].y + v[i].z * v[i].z + v[i].w * v[i].w;
        }
        mx = wave_max(mx); ss = wave_sum(ss);
        const float step = fmaxf(0.3352f * sqrtf(ss * (1.f / 1024.f)), mx * (1.f / 16.f));
        const float inv = step > 0.f ? 1.f / step : 0.f;
        unsigned* dp = (unsigned*)(dst + (size_t)r * 512);
#pragma unroll
        for (int i = 0; i < 4; ++i) {
            unsigned n = lvl4(v[i].x * inv) | (lvl4(v[i].y * inv) << 8) | (lvl4(v[i].z * inv) << 16) | (lvl4(v[i].w * inv) << 24);
            if (lane & 1) n = (n ^ 0x08080808u) << 4;
            n |= (unsigned)__builtin_amdgcn_update_dpp(0, (int)n, 0xB1, 0xF, 0xF, true);
            if (!(lane & 1)) dp[i * 32 + (lane >> 1)] = n;
        }
        if (lane == 0) scl[r] = step;
    }
}

__device__ void ph_normmod(const float* src, const float* g, const float* modv_layer, int shift_off, int scale_off, bf16_t* dst, int nrows) {
    const int lane = otid() & 63, wid = otid() >> 6;
    for (int r = blockIdx.x * 4 + wid; r < nrows; r += gridDim.x * 4) {
        const float4* s4 = (const float4*)(src + (size_t)r * DM);
        float4 v[4]; float ss = 0.f;
#pragma unroll
        for (int i = 0; i < 4; ++i) { v[i] = s4[i * 64 + lane]; ss += v[i].x * v[i].x + v[i].y * v[i].y + v[i].z * v[i].z + v[i].w * v[i].w; }
        ss = wave_sum(ss);
        const float rstd = rsqrtf(ss * (1.0f / DM) + 1e-6f);
        const float* mv = modv_layer + (size_t)modrow(r) * 6144;
        uint2* d2 = (uint2*)(dst + (size_t)r * DM);
#pragma unroll
        for (int i = 0; i < 4; ++i) {
            const int c = (i * 64 + lane) * 4;
            const float4 gg = *(const float4*)(g + c), sh = *(const float4*)(mv + shift_off + c), scl = *(const float4*)(mv + scale_off + c);
            float4 o;
            o.x = v[i].x * rstd * gg.x * (1.f + scl.x) + sh.x; o.y = v[i].y * rstd * gg.y * (1.f + scl.y) + sh.y;
            o.z = v[i].z * rstd * gg.z * (1.f + scl.z) + sh.z; o.w = v[i].w * rstd * gg.w * (1.f + scl.w) + sh.w;
            d2[i * 64 + lane] = make_uint2(cvt_pk_bf16(o.x, o.y), cvt_pk_bf16(o.z, o.w));
        }
    }
}

__device__ void ph_final(const P& p) {
    const int lane = otid() & 63, wid = otid() >> 6;
    for (int r = blockIdx.x * 4 + wid; r < NL; r += gridDim.x * 4) {
        const float4* s4 = (const float4*)(p.H + (size_t)r * DM);
        float4 v[4]; float ss = 0.f;
#pragma unroll
        for (int i = 0; i < 4; ++i) { v[i] = s4[i * 64 + lane]; ss += v[i].x * v[i].x + v[i].y * v[i].y + v[i].z * v[i].z + v[i].w * v[i].w; }
        ss = wave_sum(ss);
        const float rstd = rsqrtf(ss * (1.0f / DM) + 1e-6f);
        float4* d4 = (float4*)(p.out + (size_t)r * DM);
#pragma unroll
        for (int i = 0; i < 4; ++i) {
            const int c = (i * 64 + lane) * 4; const float4 gg = *(const float4*)(p.final_g + c);
            float4 o; o.x = v[i].x * rstd * gg.x; o.y = v[i].y * rstd * gg.y; o.z = v[i].z * rstd * gg.z; o.w = v[i].w * rstd * gg.w;
            d4[i * 64 + lane] = o;
        }
    }
}

#define GL_ROWB 144
#define GL_TILEB (128 * GL_ROWB)
struct TokPos { int b, pos, kpos; bool lat; };
__device__ __forceinline__ TokPos tokpos(int row) {
    TokPos t; t.lat = row < NL;
    if (t.lat) { t.b = row >> 11; t.pos = row & 2047; t.kpos = 256 + t.pos; } else { const int r = row - NL; t.b = r >> 8; t.pos = r & 255; t.kpos = t.pos; }
    return t;
}
struct EpiStoreBF16 {
    bf16_t* C; int ldc;
    __device__ __forceinline__ bool swapped(int) const { return false; }
    __device__ __forceinline__ void operator()(const f32x4 (&acc)[4][4], int m0, int n0, int wm, int wn, int fr, int fq) const {
#pragma unroll
        for (int mi = 0; mi < 4; ++mi)
#pragma unroll
            for (int ni = 0; ni < 4; ++ni) {
                const f32x4 v = acc[ni][mi];
                *(uint2*)(C + (size_t)(m0 + wm * 64 + mi * 16 + fr) * ldc + n0 + wn * 64 + ni * 16 + fq * 4) = make_uint2(cvt_pk_bf16(v[0], v[1]), cvt_pk_bf16(v[2], v[3]));
            }
    }
};
struct EpiResid {
    float* H; const float* gate; float scale;
    __device__ __forceinline__ bool swapped(int) const { return false; }
    __device__ __forceinline__ void operator()(const f32x4 (&acc)[4][4], int m0, int n0, int wm, int wn, int fr, int fq) const {
#pragma unroll
        for (int mi = 0; mi < 4; ++mi) {
            const int row = m0 + wm * 64 + mi * 16 + fr;
            const float* gp = gate + (size_t)modrow(row) * 6144;
#pragma unroll
            for (int ni = 0; ni < 4; ++ni) {
                const int col = n0 + wn * 64 + ni * 16 + fq * 4;
                const f32x4 g = *(const f32x4*)(gp + col);
                f32x4* hp = (f32x4*)(H + (size_t)row * DM + col);
                *hp = *hp + g * acc[ni][mi] * scale;
            }
        }
    }
};
__device__ __forceinline__ void rope_store64(const f32x4 (&acc)[4][4], int mi, bool do_rope, const float* ropep  , float scale, bf16_t* dst  , int fq) {
#pragma unroll
    for (int ni = 0; ni < 2; ++ni) {
        f32x4 x1 = acc[ni][mi], x2 = acc[ni + 2][mi];
        if (do_rope) {
            const f32x4 r0 = *(const f32x4*)(ropep + (ni * 16 + fq * 4) * 2), r1 = *(const f32x4*)(ropep + (ni * 16 + fq * 4) * 2 + 4);
            const f32x4 cs = (f32x4){r0[0], r0[2], r1[0], r1[2]}, sn = (f32x4){r0[1], r0[3], r1[1], r1[3]};
            const f32x4 y1 = x1 * cs - x2 * sn, y2 = x1 * sn + x2 * cs;
            x1 = y1; x2 = y2;
        }
        x1 = x1 * scale; x2 = x2 * scale;
        *(uint2*)(dst + ni * 16 + fq * 4) = make_uint2(cvt_pk_bf16(x1[0], x1[1]), cvt_pk_bf16(x1[2], x1[3]));
        *(uint2*)(dst + 32 + ni * 16 + fq * 4) = make_uint2(cvt_pk_bf16(x2[0], x2[1]), cvt_pk_bf16(x2[2], x2[3]));
    }
}
struct EpiEven {
    bf16_t *PB, *AQL, *AQC, *AK, *AV; float* GT; const float* rope;
    __device__ __forceinline__ bool swapped(int n0) const { return n0 >= 2560 && n0 < 3072; }
    __device__ __forceinline__ void operator()(const f32x4 (&acc)[4][4], int m0, int n0, int wm, int wn, int fr, int fq) const {
        const int t = n0 >> 7;
        if (t < 12) {
#pragma unroll
            for (int mi = 0; mi < 4; ++mi)
#pragma unroll
                for (int ni = 0; ni < 4; ++ni) {
                    const f32x4 v = acc[ni][mi];
                    *(uint2*)(PB + (size_t)(m0 + wm * 64 + mi * 16 + fr) * 1536 + n0 + wn * 64 + ni * 16 + fq * 4) = make_uint2(cvt_pk_bf16(v[0], v[1]), cvt_pk_bf16(v[2], v[3]));
                }
        } else if (t < 20) {
            const bool isq = t < 16; const int h = t & 3;
#pragma unroll
            for (int mi = 0; mi < 4; ++mi) {
                const TokPos tp = tokpos(m0 + wm * 64 + mi * 16 + fr);
                const int hm = (tp.b * 4 + h) * 2 + wn;
                bf16_t* dst;
                if (isq) dst = tp.lat ? AQL + ((size_t)hm * 2048 + tp.pos) * 64 : AQC + ((size_t)hm * 256 + tp.pos) * 64;
                else dst = AK + ((size_t)hm * 2304 + tp.kpos) * 64;
                rope_store64(acc, mi, tp.lat, rope + (size_t)tp.pos * 64, isq ? QSCALE : 1.0f, dst, fq);
            }
        } else if (t < 24) {
            const int h = t - 20;
#pragma unroll
            for (int mi = 0; mi < 4; ++mi) {
                const TokPos tp = tokpos(m0 + wm * 64 + mi * 16 + fq * 4);
#pragma unroll
                for (int ni = 0; ni < 4; ++ni) {
                    const f32x4 v = acc[ni][mi];
                    const int d = wn * 64 + ni * 16 + fr;
                    *(uint2*)(AV + ((size_t)(tp.b * 4 + h) * 128 + d) * 2304 + tp.kpos) = make_uint2(cvt_pk_bf16(v[0], v[1]), cvt_pk_bf16(v[2], v[3]));
                }
            }
        } else {
            if (wn == 0) {
#pragma unroll
                for (int mi = 0; mi < 4; ++mi) *(f32x4*)(GT + (size_t)(m0 + wm * 64 + mi * 16 + fr) * 16 + fq * 4) = acc[0][mi];
            }
        }
    }
};
struct EpiOdd {
    bf16_t *AQL, *AQC, *AK, *AV; const float* rope;
    __device__ __forceinline__ bool swapped(int n0) const { return n0 >= 1280; }
    __device__ __forceinline__ void operator()(const f32x4 (&acc)[4][4], int m0, int n0, int wm, int wn, int fr, int fq) const {
        const int t = n0 >> 7;
        if (t < 10) {
            const bool isq = t < 8; const int hd = isq ? t * 2 + wn : (t - 8) * 2 + wn;
#pragma unroll
            for (int mi = 0; mi < 4; ++mi) {
                const TokPos tp = tokpos(m0 + wm * 64 + mi * 16 + fr);
                bf16_t* dst;
                if (isq) dst = tp.lat ? AQL + ((size_t)(tp.b * 16 + hd) * 2048 + tp.pos) * 64 : AQC + ((size_t)(tp.b * 16 + hd) * 256 + tp.pos) * 64;
                else dst = AK + ((size_t)(tp.b * 4 + hd) * 2304 + tp.kpos) * 64;
                rope_store64(acc, mi, tp.lat, rope + (size_t)tp.pos * 64, isq ? QSCALE : 1.0f, dst, fq);
            }
        } else {
            const int hkv = (t - 10) * 2 + wn;
#pragma unroll
            for (int mi = 0; mi < 4; ++mi) {
                const TokPos tp = tokpos(m0 + wm * 64 + mi * 16 + fq * 4);
#pragma unroll
                for (int ni = 0; ni < 4; ++ni) {
                    const f32x4 v = acc[ni][mi];
                    const int d = ni * 16 + fr;
                    *(uint2*)(AV + ((size_t)(tp.b * 4 + hkv) * 64 + d) * 2304 + tp.kpos) = make_uint2(cvt_pk_bf16(v[0], v[1]), cvt_pk_bf16(v[2], v[3]));
                }
            }
        }
    }
};
#define LDS_AS __attribute__((address_space(3)))
template <bool SWAP>
__device__ __forceinline__ void gemm_tile_kloop(f32x4 (&acc)[4][4], const bf16_t* aub, const bf16_t* bub, char* smem, int lrow, int lch, int wm, int wn, int fr, int fq) {
    const int tid = lrow * 8 + lch, wid = tid >> 6, lane = tid & 63;
    const int srow = wid * 8 + (lane >> 3);
    const unsigned goff = (unsigned)(srow * DM + (((lane & 7) ^ (srow & 7)) << 3)) * 2u;
#define GL_DMA(BUF, KO) { _Pragma("unroll") for (int i = 0; i < 4; ++i) { \
        __builtin_amdgcn_global_load_lds((const unsigned*)((const char*)aub + ((size_t)(32 * i) * DM + (KO)) * 2 + goff), (LDS_AS unsigned*)((BUF) + (i * 32 + wid * 8) * 128), 16, 0, 0); \
        __builtin_amdgcn_global_load_lds((const unsigned*)((const char*)bub + ((size_t)(32 * i) * DM + (KO)) * 2 + goff), (LDS_AS unsigned*)((BUF) + 16384 + (i * 32 + wid * 8) * 128), 16, 0, 0); } }
    const int xr = fr & 7;
    GL_DMA(smem, 0)
    __syncthreads();
    for (int kt = 0; kt < 16; ++kt) {
        char* cur = smem + (kt & 1) * 32768;
        char* nxt = smem + ((kt + 1) & 1) * 32768;
        if (kt + 1 < 16) GL_DMA(nxt, (kt + 1) * 64)
#pragma unroll
        for (int ks = 0; ks < 2; ++ks) {
            bf16x8 af[4], wf[4];
#pragma unroll
            for (int i = 0; i < 4; ++i) {
                af[i] = *(const bf16x8*)(cur + (wm * 64 + i * 16 + fr) * 128 + (((ks * 4 + fq) ^ xr) << 4));
                wf[i] = *(const bf16x8*)(cur + 16384 + (wn * 64 + i * 16 + fr) * 128 + (((ks * 4 + fq) ^ xr) << 4));
            }
#pragma unroll
            for (int ni = 0; ni < 4; ++ni)
#pragma unroll
                for (int mi = 0; mi < 4; ++mi)
                    acc[ni][mi] = SWAP ? __builtin_amdgcn_mfma_f32_16x16x32_bf16(af[mi], wf[ni], acc[ni][mi], 0, 0, 0)
                                       : __builtin_amdgcn_mfma_f32_16x16x32_bf16(wf[ni], af[mi], acc[ni][mi], 0, 0, 0);
        }
        __syncthreads();
    }
#undef GL_DMA
}
template <class Epi>
__device__ void ph_gemm(const bf16_t* A, const bf16_t* Bt, int M, int Npad, const Epi& epi, char* smem) {
    const int tid = otid(), lane = tid & 63, wid = tid >> 6, wm = wid >> 1, wn = wid & 1;
    const int fr = lane & 15, fq = lane >> 4;
    const int tm = M / 128, tn = Npad / 128, ntiles = tm * tn;
    const int lrow = tid >> 3, lch = tid & 7;
    for (int tile = blockIdx.x; tile < ntiles; tile += gridDim.x) {
        int m0, n0;
        {
            const int q = ntiles >> 3, rr = ntiles & 7, xcd = tile & 7, off = tile >> 3;
            const int w = (xcd < rr ? xcd * (q + 1) : rr * (q + 1) + (xcd - rr) * q) + off;
            const int nig = 8 * tn, gid = w / nig, fm = gid * 8, gsz = (tm - fm) < 8 ? (tm - fm) : 8;
            m0 = (fm + (w % nig) % gsz) * 128; n0 = ((w % nig) / gsz) * 128;
        }
        f32x4 acc[4][4];
#pragma unroll
        for (int a = 0; a < 4; ++a)
#pragma unroll
            for (int b = 0; b < 4; ++b) acc[a][b] = (f32x4){0.f, 0.f, 0.f, 0.f};
        const bf16_t* ap = A + (size_t)m0 * DM;
        const bf16_t* bp = Bt + (size_t)n0 * DM;
        if (epi.swapped(n0)) gemm_tile_kloop<true>(acc, ap, bp, smem, lrow, lch, wm, wn, fr, fq);
        else gemm_tile_kloop<false>(acc, ap, bp, smem, lrow, lch, wm, wn, fr, fq);
        int fr2 = fr, fq2 = fq, wm2 = wm, wn2 = wn;
        asm volatile("" : "+v"(fr2), "+v"(fq2), "+v"(wm2), "+v"(wn2));
        epi(acc, m0, n0, wm2, wn2, fr2, fq2);
    }
}

__device__ void ph_prep_even(const P& p, int j) {
    const float* cw = p.ev_conv_w + (size_t)j * 3 * 512; const float* cb = p.ev_conv_b + (size_t)j * 512;
    const size_t tot = (size_t)NT * 256;
    for (size_t i = (size_t)blockIdx.x * 256 + otid(); i < tot; i += (size_t)gridDim.x * 256) {
        const int r = (int)(i >> 8), c = (int)(i & 255) * 2;
        int t, T; if (r < NL) { t = r & 2047; T = 2048; } else { t = (r - NL) & 255; T = 256; }
        const unsigned x1 = *(const unsigned*)(p.PB + (size_t)r * 1536 + c);
        float v0 = cb[c] + bf_lo(x1) * cw[512 + c], v1 = cb[c + 1] + bf_hi(x1) * cw[512 + c + 1];
        if (t > 0) { const unsigned x0 = *(const unsigned*)(p.PB + (size_t)(r - 1) * 1536 + c); v0 += bf_lo(x0) * cw[c]; v1 += bf_hi(x0) * cw[c + 1]; }
        if (t < T - 1) { const unsigned x2 = *(const unsigned*)(p.PB + (size_t)(r + 1) * 1536 + c); v0 += bf_lo(x2) * cw[1024 + c]; v1 += bf_hi(x2) * cw[1024 + c + 1]; }
        v0 = silu_f(v0); v1 = silu_f(v1);
        if (c >= 256) { v0 *= 0.125f; v1 *= 0.125f; }
        *(unsigned*)(p.QKB + (size_t)r * 512 + c) = cvt_pk_bf16(v0, v1);
    }
}

#define FA_KROW 144
#define FA_VROW 144
__device__ __forceinline__ bf16x8 pack8(float a0, float a1, float a2, float a3, float a4, float a5, float a6, float a7) {
    const u32x4 u = (u32x4){cvt_pk_bf16(a0, a1), cvt_pk_bf16(a2, a3), cvt_pk_bf16(a4, a5), cvt_pk_bf16(a6, a7)};
    return __builtin_bit_cast(bf16x8, u);
}
template <int NDB, bool MASK>
__device__ __forceinline__ void flash_tile(const bf16x8 (&qf)[4], f32x16 (&o)[NDB], float& m, float& l, const char* Kl, const char* Vl, int lane, int qpos, int kp0) {
    const int j = lane & 31, h = lane >> 5;
    f32x16 s0, s1;
#pragma unroll
    for (int i = 0; i < 16; ++i) { s0[i] = 0.f; s1[i] = 0.f; }
#pragma unroll
    for (int ks = 0; ks < 4; ++ks) {
        const bf16x8 a0 = *(const bf16x8*)(Kl + j * FA_KROW + (2 * ks + h) * 16);
        const bf16x8 a1 = *(const bf16x8*)(Kl + (32 + j) * FA_KROW + (2 * ks + h) * 16);
        s0 = __builtin_amdgcn_mfma_f32_32x32x16_bf16(a0, qf[ks], s0, 0, 0, 0);
        s1 = __builtin_amdgcn_mfma_f32_32x32x16_bf16(a1, qf[ks], s1, 0, 0, 0);
    }
    if (MASK) {
#pragma unroll
        for (int r = 0; r < 16; ++r) {
            const int key = (r & 3) + 8 * (r >> 2) + 4 * h;
            const int d0 = qpos - (kp0 + key), d1 = d0 - 32;
            if (d0 > 128 || d0 < -128) s0[r] = -1e30f;
            if (d1 > 128 || d1 < -128) s1[r] = -1e30f;
        }
    }
    float mx = fmaxf(s0[0], s1[0]);
#pragma unroll
    for (int r = 1; r < 16; ++r) mx = fmaxf(mx, fmaxf(s0[r], s1[r]));
    mx = fmaxf(mx, SHX(mx, 32));
    const float mn = fmaxf(m, mx);
    const float alpha = __builtin_amdgcn_exp2f(m - mn);
    m = mn;
    float ls = 0.f;
#pragma unroll
    for (int r = 0; r < 16; ++r) { s0[r] = __builtin_amdgcn_exp2f(s0[r] - mn); s1[r] = __builtin_amdgcn_exp2f(s1[r] - mn); ls += s0[r] + s1[r]; }
    l = l * alpha + ls;
    if (__ballot(alpha != 1.0f)) {
#pragma unroll
        for (int db = 0; db < NDB; ++db) o[db] = o[db] * alpha;
    }
    bf16x8 pb[4];
    pb[0] = pack8(s0[0], s0[1], s0[2], s0[3], s0[4], s0[5], s0[6], s0[7]);
    pb[1] = pack8(s0[8], s0[9], s0[10], s0[11], s0[12], s0[13], s0[14], s0[15]);
    pb[2] = pack8(s1[0], s1[1], s1[2], s1[3], s1[4], s1[5], s1[6], s1[7]);
    pb[3] = pack8(s1[8], s1[9], s1[10], s1[11], s1[12], s1[13], s1[14], s1[15]);
#pragma unroll
    for (int db = 0; db < NDB; ++db)
#pragma unroll
        for (int kk = 0; kk < 4; ++kk) {
            const bf16x8 vf = *(const bf16x8*)(Vl + (db * 32 + j) * FA_VROW + kk * 32 + h * 16);
            o[db] = __builtin_amdgcn_mfma_f32_32x32x16_bf16(vf, pb[kk], o[db], 0, 0, 0);
        }
}

#define DA_BUFB 36864
__device__ void da_block(const P& p, int item, int L, int j, char* smem) {
    const int tid = otid(), lane = tid & 63, wid = tid >> 6, mp = wid & 1, qg = wid >> 1, jq = lane & 31, hh = lane >> 5;
    const bool lat = item < 1024;
    int b, h, qt;
    if (lat) { b = item >> 7; h = (item >> 5) & 3; qt = item & 31; } else { const int it = item - 1024; b = it >> 4; h = (it >> 2) & 3; qt = it & 3; }
    const int qi = qt * 64 + qg * 32 + jq;
    const bf16_t* qp = lat ? p.AQL + ((size_t)((b * 4 + h) * 2 + mp) * 2048 + qi) * 64 : p.AQC + ((size_t)((b * 4 + h) * 2 + mp) * 256 + qi) * 64;
    bf16x8 qf[4];
#pragma unroll
    for (int ks = 0; ks < 4; ++ks) qf[ks] = *(const bf16x8*)(qp + (2 * ks + hh) * 8);
    const int ntile = lat ? 36 : 4;
    const bf16_t* kg = p.AK + (size_t)((b * 4 + h) * 2) * 2304 * 64 + (size_t)(tid >> 3) * 64 + (tid & 7) * 8;
    const bf16_t* vg = p.AV + (size_t)(b * 4 + h) * 128 * 2304 + (size_t)(tid >> 3) * 2304 + (tid & 7) * 8;
    uint4 k0, k1, k2, k3, v0, v1, v2, v3;
#define DA_LOAD(KEY0) { k0 = *(const uint4*)(kg + (size_t)(KEY0) * 64); k1 = *(const uint4*)(kg + (size_t)((KEY0) + 32) * 64); \
                        k2 = *(const uint4*)(kg + (size_t)2304 * 64 + (size_t)(KEY0) * 64); k3 = *(const uint4*)(kg + (size_t)2304 * 64 + (size_t)((KEY0) + 32) * 64); \
                        v0 = *(const uint4*)(vg + (KEY0)); v1 = *(const uint4*)(vg + (size_t)32 * 2304 + (KEY0)); v2 = *(const uint4*)(vg + (size_t)64 * 2304 + (KEY0)); v3 = *(const uint4*)(vg + (size_t)96 * 2304 + (KEY0)); }
#define DA_STORE(BUF) { char* kb_ = (BUF) + (tid >> 3) * FA_KROW + (tid & 7) * 16; \
                        *(uint4*)kb_ = k0; *(uint4*)(kb_ + 32 * FA_KROW) = k1; *(uint4*)(kb_ + 64 * FA_KROW) = k2; *(uint4*)(kb_ + 96 * FA_KROW) = k3; \
                        char* vb_ = (BUF) + 18432 + (tid >> 3) * FA_VROW + ((tid & 7) >> 1) * 32 + (tid & 1) * 8; \
                        *(uint2*)vb_ = make_uint2(v0.x, v0.y); *(uint2*)(vb_ + 16) = make_uint2(v0.z, v0.w); \
                        *(uint2*)(vb_ + 32 * FA_VROW) = make_uint2(v1.x, v1.y); *(uint2*)(vb_ + 32 * FA_VROW + 16) = make_uint2(v1.z, v1.w); \
                        *(uint2*)(vb_ + 64 * FA_VROW) = make_uint2(v2.x, v2.y); *(uint2*)(vb_ + 64 * FA_VROW + 16) = make_uint2(v2.z, v2.w); \
                        *(uint2*)(vb_ + 96 * FA_VROW) = make_uint2(v3.x, v3.y); *(uint2*)(vb_ + 96 * FA_VROW + 16) = make_uint2(v3.z, v3.w); }
    f32x16 o[4];
#pragma unroll
    for (int db = 0; db < 4; ++db)
#pragma unroll
        for (int i = 0; i < 16; ++i) o[db][i] = 0.f;
    float m = -1e30f, l = 0.f;
    DA_LOAD(0)
    __syncthreads();
    DA_STORE(smem)
    __syncthreads();
    for (int t = 0; t < ntile; ++t) {
        char* cur = smem + (t & 1) * DA_BUFB;
        char* nxt = smem + ((t + 1) & 1) * DA_BUFB;
        if (t + 1 < ntile) DA_LOAD((t + 1) * 64)
        flash_tile<4, false>(qf, o, m, l, cur + mp * 9216, cur + 18432, lane, 0, 0);
        if (t + 1 < ntile) DA_STORE(nxt)
        __syncthreads();
    }
#undef DA_LOAD
#undef DA_STORE
    const float inv = 1.f / (l + SHX(l, 32));
#pragma unroll
    for (int db = 0; db < 4; ++db) o[db] = o[db] * inv;
    float* X = (float*)smem + qg * 4096;
    if (mp == 1) {
#pragma unroll
        for (int db = 0; db < 4; ++db)
#pragma unroll
            for (int r = 0; r < 16; ++r) X[(db * 32 + (r & 3) + 8 * (r >> 2) + 4 * hh) * 32 + jq] = o[db][r];
    }
    __syncthreads();
    if (mp == 0) {
        const float lam_init = 0.8f - 0.6f * expf(-0.3f * (float)L);
        const float* lp = p.ev_da_lam + (size_t)j * 256;
        float a0 = lp[lane] * lp[64 + lane], a1 = lp[128 + lane] * lp[192 + lane];
        a0 = wave_sum(a0); a1 = wave_sum(a1);
        const float lam = expf(a0) - expf(a1) + lam_init;
        float ss = 0.f;
#pragma unroll
        for (int db = 0; db < 4; ++db)
#pragma unroll
            for (int r = 0; r < 16; ++r) { const float v = o[db][r] - lam * X[(db * 32 + (r & 3) + 8 * (r >> 2) + 4 * hh) * 32 + jq]; o[db][r] = v; ss += v * v; }
        ss += SHX(ss, 32);
        const float sc = rsqrtf(ss * (1.f / 128.f) + 1e-6f) * (1.f - lam_init);
        const int row = lat ? b * 2048 + qi : NL + b * 256 + qi;
        bf16_t* mrow = p.MIX + (size_t)row * DM + 512 + h * 128;
        const float* g = p.ev_da_g + (size_t)j * 512 + h * 128;
#pragma unroll
        for (int db = 0; db < 4; ++db)
#pragma unroll
            for (int r4 = 0; r4 < 4; ++r4) {
                const int d = db * 32 + 8 * r4 + 4 * hh;
                const f32x4 gg = *(const f32x4*)(g + d);
                *(uint2*)(mrow + d) = make_uint2(cvt_pk_bf16(o[db][r4 * 4 + 0] * sc * gg[0], o[db][r4 * 4 + 1] * sc * gg[1]), cvt_pk_bf16(o[db][r4 * 4 + 2] * sc * gg[2], o[db][r4 * 4 + 3] * sc * gg[3]));
            }
    }
    __syncthreads();
}

#define WA_BUFB 18432
__device__ void wa_block(const P& p, int item, int j, char* smem) {
    const int tid = otid(), lane = tid & 63, wid = tid >> 6, jq = lane & 31, hh = lane >> 5;
    const bool lat = item < 2048;
    int b, nb, hq;
    if (lat) { hq = item & 15; nb = (item >> 4) & 15; b = item >> 8; } else { const int it = item - 2048; hq = it & 15; nb = (it >> 4) & 1; b = it >> 5; }
    const int hkv = hq >> 2;
    const int qi = nb * 128 + wid * 32 + jq;
    const bf16_t* qp = lat ? p.AQL + ((size_t)(b * 16 + hq) * 2048 + qi) * 64 : p.AQC + ((size_t)(b * 16 + hq) * 256 + qi) * 64;
    bf16x8 qf[4];
#pragma unroll
    for (int ks = 0; ks < 4; ++ks) qf[ks] = *(const bf16x8*)(qp + (2 * ks + hh) * 8);
    const int lfirst = (nb == 0) ? 2 : 0, nloc = lat ? 6 - lfirst - ((nb == 15) ? 2 : 0) : 0;
    const int ntile = 4 + nloc;
    const bf16_t* kg = p.AK + (size_t)(b * 4 + hkv) * 2304 * 64 + (size_t)(tid >> 3) * 64 + (tid & 7) * 8;
    const bf16_t* vg = p.AV + (size_t)(b * 4 + hkv) * 64 * 2304 + (size_t)(tid >> 3) * 2304 + (tid & 7) * 8;
    uint4 k0, k1, v0, v1;
#define WA_KEY0(T) ((T) < 4 ? (T) * 64 : 256 + (nb - 1) * 128 + ((T) - 4 + lfirst) * 64)
#define WA_LOAD(KEY0) { k0 = *(const uint4*)(kg + (size_t)(KEY0) * 64); k1 = *(const uint4*)(kg + (size_t)((KEY0) + 32) * 64); v0 = *(const uint4*)(vg + (KEY0)); v1 = *(const uint4*)(vg + (size_t)32 * 2304 + (KEY0)); }
#define WA_STORE(BUF) { char* kb_ = (BUF) + (tid >> 3) * FA_KROW + (tid & 7) * 16; *(uint4*)kb_ = k0; *(uint4*)(kb_ + 32 * FA_KROW) = k1; \
                        char* vb_ = (BUF) + 9216 + (tid >> 3) * FA_VROW + ((tid & 7) >> 1) * 32 + (tid & 1) * 8; \
                        *(uint2*)vb_ = make_uint2(v0.x, v0.y); *(uint2*)(vb_ + 16) = make_uint2(v0.z, v0.w); \
                        *(uint2*)(vb_ + 32 * FA_VROW) = make_uint2(v1.x, v1.y); *(uint2*)(vb_ + 32 * FA_VROW + 16) = make_uint2(v1.z, v1.w); }
    f32x16 o[2];
#pragma unroll
    for (int db = 0; db < 2; ++db)
#pragma unroll
        for (int i = 0; i < 16; ++i) o[db][i] = 0.f;
    float m = p.od_sink[j * 16 + hq] * 1.4426950408889634f, l = hh == 0 ? 1.f : 0.f;
    { const int key0 = WA_KEY0(0); WA_LOAD(key0) }
    __syncthreads();
    WA_STORE(smem)
    __syncthreads();
    for (int t = 0; t < ntile; ++t) {
        char* cur = smem + (t & 1) * WA_BUFB;
        char* nxt = smem + ((t + 1) & 1) * WA_BUFB;
        if (t + 1 < ntile) { const int key0 = WA_KEY0(t + 1); WA_LOAD(key0) }
        if (t < 4) flash_tile<2, false>(qf, o, m, l, cur, cur + 9216, lane, 0, 0);
        else flash_tile<2, true>(qf, o, m, l, cur, cur + 9216, lane, qi, WA_KEY0(t) - 256);
        if (t + 1 < ntile) WA_STORE(nxt)
        __syncthreads();
    }
#undef WA_LOAD
#undef WA_STORE
#undef WA_KEY0
    const float inv = 1.f / (l + SHX(l, 32));
    const int row = lat ? b * 2048 + qi : NL + b * 256 + qi;
    bf16_t* mrow = p.MIX + (size_t)row * DM + hq * 64;
#pragma unroll
    for (int db = 0; db < 2; ++db)
#pragma unroll
        for (int r4 = 0; r4 < 4; ++r4) {
            const int d = db * 32 + 8 * r4 + 4 * hh;
            *(uint2*)(mrow + d) = make_uint2(cvt_pk_bf16(o[db][r4 * 4 + 0] * inv, o[db][r4 * 4 + 1] * inv), cvt_pk_bf16(o[db][r4 * 4 + 2] * inv, o[db][r4 * 4 + 3] * inv));
        }
}

__device__ __forceinline__ uint4 ml_conv8(const P& p, int j, int b, int tc, int st, int c0) {
    const int row = tc < 4 ? NL + b * 256 + tc * 64 + st : b * 2048 + (tc - 4) * 64 + st;
    const int t = tc < 4 ? tc * 64 + st : (tc - 4) * 64 + st, T = tc < 4 ? 256 : 2048;
    const float* cw = p.ev_conv_w + (size_t)j * 3 * 512 + c0; const float* cb = p.ev_conv_b + (size_t)j * 512 + c0;
    const uint4 x1 = *(const uint4*)(p.PB + (size_t)row * 1536 + c0);
    uint4 x0 = make_uint4(0u, 0u, 0u, 0u), x2 = x0;
    if (t > 0) x0 = *(const uint4*)(p.PB + (size_t)(row - 1) * 1536 + c0);
    if (t < T - 1) x2 = *(const uint4*)(p.PB + (size_t)(row + 1) * 1536 + c0);
    float a[8], bq[8], cq[8]; unpack8(x0, a); unpack8(x1, bq); unpack8(x2, cq);
    const float sc = c0 >= 256 ? 0.125f : 1.f;
    float o[8];
#pragma unroll
    for (int q = 0; q < 8; ++q) o[q] = silu_f(cb[q] + a[q] * cw[q] + bq[q] * cw[512 + q] + cq[q] * cw[1024 + q]) * sc;
    return make_uint4(cvt_pk_bf16(o[0], o[1]), cvt_pk_bf16(o[2], o[3]), cvt_pk_bf16(o[4], o[5]), cvt_pk_bf16(o[6], o[7]));
}
__device__ __forceinline__ int ml_row(int b, int tc, int i) { return tc < 4 ? NL + b * 256 + tc * 64 + i : b * 2048 + (tc - 4) * 64 + i; }
__device__ __forceinline__ void ml_gates(const P& p, int j, int b, int h, int dir, int tc, int lane, float* sa, float* sb, float* sml, float& Bt, float& Mc) {
    const int row = ml_row(b, tc, lane);
    const float ig = p.GT[(size_t)row * 16 + (dir * 2) * 4 + h] + p.ev_gate_b[j * 16 + (dir * 2) * 4 + h];
    const float lf = log_sigmoid_f(p.GT[(size_t)row * 16 + (dir * 2 + 1) * 4 + h] + p.ev_gate_b[j * 16 + (dir * 2 + 1) * 4 + h]);
    float bc = lf;
    if (dir == 0) {
#pragma unroll
        for (int o = 1; o < 64; o <<= 1) { const float t2 = lshfl(bc, lane - o); if (lane >= o) bc += t2; }
    } else {
#pragma unroll
        for (int o = 1; o < 64; o <<= 1) { const float t2 = lshfl(bc, lane + o); if (lane + o < 64) bc += t2; }
    }
    const float a = ig - bc;
    float ml = a;
    if (dir == 0) {
#pragma unroll
        for (int o = 1; o < 64; o <<= 1) { const float t2 = lshfl(ml, lane - o); if (lane >= o) ml = fmaxf(ml, t2); }
    } else {
#pragma unroll
        for (int o = 1; o < 64; o <<= 1) { const float t2 = lshfl(ml, lane + o); if (lane + o < 64) ml = fmaxf(ml, t2); }
    }
    sa[lane] = a; sb[lane] = bc; sml[lane] = ml;
    const int last = dir == 0 ? 63 : 0;
    Bt = lshfl(bc, last); Mc = lshfl(ml, last);
}
__device__ __forceinline__ int ml_tc_of(int dir, int c) { return dir == 0 ? c : (c < 4 ? 3 - c : 39 - c); }
__device__ __forceinline__ int ml_c_of(int dir, int tc) { return dir == 0 ? tc : (tc < 4 ? 3 - tc : 39 - tc); }

__device__ void ml_pass1_item(const P& p, int item, int j, char* smem) {
    const int c = item % 36, dir = (item / 36) & 1, h = (item / 72) & 3, b = item / 288;
    const int tc = ml_tc_of(dir, c);
    const int tid = otid(), lane = tid & 63, wid = tid >> 6, jl = lane & 31, hh = lane >> 5;
    bf16_t* VT = (bf16_t*)smem;
    bf16_t* KWT = (bf16_t*)(smem + 18432);
    float* sa = (float*)(smem + 27648);
    float* sb = sa + 64; float* sml = sb + 64; float* sw = sml + 64; float* ssc = sw + 64;
    __syncthreads();
    if (wid == 0) {
        float Bt, Mc; ml_gates(p, j, b, h, dir, tc, lane, sa, sb, sml, Bt, Mc);
        sw[lane] = expf(sa[lane] - Mc);
        if (lane == 0) { p.CHB[item] = Bt; p.CHM[item] = Mc; }
    }
    __syncthreads();
#pragma unroll
    for (int i = 0; i < 4; ++i) {
        const int e = tid + 256 * i, st = e >> 4, ch = e & 15;
        const uint4 u = *(const uint4*)(p.PB + (size_t)ml_row(b, tc, st) * 1536 + 512 + h * 128 + ch * 8);
        bf16_t* d = VT + (ch * 8) * 72 + st;
        d[0] = (bf16_t)u.x; d[72] = (bf16_t)(u.x >> 16); d[144] = (bf16_t)u.y; d[216] = (bf16_t)(u.y >> 16);
        d[288] = (bf16_t)u.z; d[360] = (bf16_t)(u.z >> 16); d[432] = (bf16_t)u.w; d[504] = (bf16_t)(u.w >> 16);
    }
#pragma unroll
    for (int i = 0; i < 2; ++i) {
        const int e = tid + 256 * i, st = e >> 3, ch = e & 7;
        const uint4 u = ml_conv8(p, j, b, tc, st, 256 + h * 64 + ch * 8);
        const float w = sw[st];
        bf16_t* d = KWT + (ch * 8) * 72 + st;
        const unsigned q0 = cvt_pk_bf16(bf_lo(u.x) * w, bf_hi(u.x) * w), q1 = cvt_pk_bf16(bf_lo(u.y) * w, bf_hi(u.y) * w), q2 = cvt_pk_bf16(bf_lo(u.z) * w, bf_hi(u.z) * w), q3 = cvt_pk_bf16(bf_lo(u.w) * w, bf_hi(u.w) * w);
        d[0] = (bf16_t)q0; d[72] = (bf16_t)(q0 >> 16); d[144] = (bf16_t)q1; d[216] = (bf16_t)(q1 >> 16);
        d[288] = (bf16_t)q2; d[360] = (bf16_t)(q2 >> 16); d[432] = (bf16_t)q3; d[504] = (bf16_t)(q3 >> 16);
    }
    __syncthreads();
    {
        const int db = wid & 1, vb0 = (wid >> 1) * 2;
        bf16x8 kf[4];
#pragma unroll
        for (int ks = 0; ks < 4; ++ks) kf[ks] = *(const bf16x8*)((const char*)KWT + (db * 32 + jl) * 144 + (2 * ks + hh) * 16);
        float* cl = p.CLOC + (size_t)item * 8192;
#pragma unroll
        for (int vv = 0; vv < 2; ++vv) {
            const int vb = vb0 + vv;
            f32x16 acc;
#pragma unroll
            for (int r = 0; r < 16; ++r) acc[r] = 0.f;
#pragma unroll
            for (int ks = 0; ks < 4; ++ks) {
                const bf16x8 vf = *(const bf16x8*)((const char*)VT + (vb * 32 + jl) * 144 + (2 * ks + hh) * 16);
                acc = __builtin_amdgcn_mfma_f32_32x32x16_bf16(vf, kf[ks], acc, 0, 0, 0);
            }
#pragma unroll
            for (int r = 0; r < 16; ++r) cl[(size_t)(vb * 32 + (r & 3) + 8 * (r >> 2) + 4 * hh) * 64 + db * 32 + jl] = acc[r];
        }
        if (tid < 64) {
            float sum = 0.f;
#pragma unroll
            for (int q = 0; q < 8; ++q) { const uint4 u = *(const uint4*)((const char*)KWT + tid * 144 + q * 16); sum += bf_lo(u.x) + bf_hi(u.x) + bf_lo(u.y) + bf_hi(u.y) + bf_lo(u.z) + bf_hi(u.z) + bf_lo(u.w) + bf_hi(u.w); }
            p.NLOC[(size_t)item * 64 + tid] = sum;
        }
    }
}

__device__ void ph_ml_pass2(const P& p) {
    const int gt = blockIdx.x * 256 + otid(), nthr = gridDim.x * 256;
    for (int w = gt; w < 64 * 2048; w += nthr) {
        const int chain = w >> 11, e = (w & 2047) * 4;
        float c0 = 0.f, c1 = 0.f, c2 = 0.f, c3 = 0.f, m = 0.f;
        for (int c = 0; c < 36; ++c) {
            const int it = chain * 36 + c;
            *(uint2*)(p.CST + (size_t)it * 8192 + e) = make_uint2(cvt_pk_bf16(c0, c1), cvt_pk_bf16(c2, c3));
            const float Bt = p.CHB[it], Mc = p.CHM[it];
            const float g = fmaxf(m, Mc), al = expf(m - g), be = expf(Mc - g);
            const float4 cl = *(const float4*)(p.CLOC + (size_t)it * 8192 + e);
            c0 = al * c0 + be * cl.x; c1 = al * c1 + be * cl.y; c2 = al * c2 + be * cl.z; c3 = al * c3 + be * cl.w;
            m = Bt + g;
        }
    }
    for (int w = gt; w < 64 * 64; w += nthr) {
        const int chain = w >> 6, d = w & 63;
        float n = 0.f, m = 0.f;
        for (int c = 0; c < 36; ++c) {
            const int it = chain * 36 + c;
            p.NST[(size_t)it * 64 + d] = n;
            if (d == 0) p.MST[it] = m;
            const float Bt = p.CHB[it], Mc = p.CHM[it];
            const float g = fmaxf(m, Mc);
            n = expf(m - g) * n + expf(Mc - g) * p.NLOC[(size_t)it * 64 + d];
            m = Bt + g;
        }
    }
}

__device__ void ml_pass3_item(const P& p, int item, int j, char* smem) {
    const int tc = item % 36, h = (item / 36) & 3, b = item / 144;
    const int tid = otid(), lane = tid & 63, wid = tid >> 6, jl = lane & 31, hh = lane >> 5, tb = wid & 1, dir = wid >> 1;
    char* Ql = smem;
    char* Kl = smem + 9216;
    bf16_t* VT = (bf16_t*)(smem + 18432);
    float* gs = (float*)(smem + 35840);
    float* ssc = gs + 512;
    __syncthreads();
    if (wid < 2) {
        const int d2 = wid; float Bt, Mc;
        float* sa = gs + d2 * 256; float* sb = sa + 64; float* sg = sb + 64; float* sn = sg + 64;
        ml_gates(p, j, b, h, d2, tc, lane, sa, sb, sg, Bt, Mc);
        const int sidx = ((b * 4 + h) * 2 + d2) * 36 + ml_c_of(d2, tc);
        const float mst = p.MST[sidx];
        sg[lane] = fmaxf(mst, sg[lane]);
        sn[lane] = p.NST[(size_t)sidx * 64 + lane];
        if (lane == 0) ssc[d2] = mst;
    }
#pragma unroll
    for (int i = 0; i < 2; ++i) {
        const int e = tid + 256 * i, st = e >> 3, ch = e & 7; const int row = ml_row(b, tc, st);
        *(uint4*)(Ql + st * 144 + ch * 16) = ml_conv8(p, j, b, tc, st, h * 64 + ch * 8);
        *(uint4*)(Kl + st * 144 + ch * 16) = ml_conv8(p, j, b, tc, st, 256 + h * 64 + ch * 8);
    }
#pragma unroll
    for (int i = 0; i < 4; ++i) {
        const int e = tid + 256 * i, st = e >> 4, ch = e & 15;
        const uint4 u = *(const uint4*)(p.PB + (size_t)ml_row(b, tc, st) * 1536 + 512 + h * 128 + ch * 8);
        bf16_t* d = VT + (ch * 8) * 68 + st;
        d[0] = (bf16_t)u.x; d[68] = (bf16_t)(u.x >> 16); d[136] = (bf16_t)u.y; d[204] = (bf16_t)(u.y >> 16);
        d[272] = (bf16_t)u.z; d[340] = (bf16_t)(u.z >> 16); d[408] = (bf16_t)u.w; d[476] = (bf16_t)(u.w >> 16);
    }
    __syncthreads();
    const float* sa = gs + dir * 256; const float* sb = sa + 64; const float* sg = sb + 64; const float* sn = sg + 64;
    const int t = tb * 32 + jl;
    const float gtv = sg[t], btv = sb[t], mst = ssc[dir];
    const float e2 = expf(mst - gtv);
    const int sidx = ((b * 4 + h) * 2 + dir) * 36 + ml_c_of(dir, tc);
    bf16x8 qf[4];
#pragma unroll
    for (int ks = 0; ks < 4; ++ks) qf[ks] = *(const bf16x8*)(Ql + t * 144 + (2 * ks + hh) * 16);
    f32x16 acc[4];
    {
        const bf16_t* cst = p.CST + (size_t)sidx * 8192 + (size_t)jl * 64 + hh * 8;
#pragma unroll
        for (int vb = 0; vb < 4; ++vb) {
#pragma unroll
            for (int r = 0; r < 16; ++r) acc[vb][r] = 0.f;
#pragma unroll
            for (int ks = 0; ks < 4; ++ks) {
                const bf16x8 cf = *(const bf16x8*)(cst + (size_t)vb * 32 * 64 + ks * 16);
                acc[vb] = __builtin_amdgcn_mfma_f32_32x32x16_bf16(cf, qf[ks], acc[vb], 0, 0, 0);
            }
            acc[vb] = acc[vb] * e2;
        }
    }
    float den = 0.f;
    {
        float nq = 0.f;
#pragma unroll
        for (int ks = 0; ks < 4; ++ks) {
            const u32x4 u = __builtin_bit_cast(u32x4, qf[ks]);
            const float* np = sn + 16 * ks + 8 * hh;
            nq += bf_lo(u[0]) * np[0] + bf_hi(u[0]) * np[1] + bf_lo(u[1]) * np[2] + bf_hi(u[1]) * np[3] + bf_lo(u[2]) * np[4] + bf_hi(u[2]) * np[5] + bf_lo(u[3]) * np[6] + bf_hi(u[3]) * np[7];
        }
        den = e2 * nq;
    }
#pragma unroll
    for (int sbk = 0; sbk < 2; ++sbk) {
        const bool use = dir == 0 ? (sbk <= tb) : (sbk >= tb);
        if (use) {
            f32x16 sc;
#pragma unroll
            for (int r = 0; r < 16; ++r) sc[r] = 0.f;
#pragma unroll
            for (int ks = 0; ks < 4; ++ks) {
                const bf16x8 kf = *(const bf16x8*)(Kl + (sbk * 32 + jl) * 144 + (2 * ks + hh) * 16);
                sc = __builtin_amdgcn_mfma_f32_32x32x16_bf16(kf, qf[ks], sc, 0, 0, 0);
            }
#pragma unroll
            for (int r4 = 0; r4 < 4; ++r4) {
                const int s0 = sbk * 32 + 8 * r4 + 4 * hh;
                const f32x4 av = *(const f32x4*)(sa + s0);
#pragma unroll
                for (int q = 0; q < 4; ++q) {
                    const int s2 = s0 + q;
                    const bool ok = dir == 0 ? (s2 <= t) : (s2 >= t);
                    const float pv = ok ? sc[r4 * 4 + q] * expf(av[q] - gtv) : 0.f;
                    sc[r4 * 4 + q] = pv; den += pv;
                }
            }
            bf16x8 pb[2];
            pb[0] = pack8(sc[0], sc[1], sc[2], sc[3], sc[4], sc[5], sc[6], sc[7]);
            pb[1] = pack8(sc[8], sc[9], sc[10], sc[11], sc[12], sc[13], sc[14], sc[15]);
#pragma unroll
            for (int vb = 0; vb < 4; ++vb)
#pragma unroll
                for (int k2 = 0; k2 < 2; ++k2) {
                    const char* vp = (const char*)VT + (vb * 32 + jl) * 136 + (sbk * 32 + k2 * 16 + 4 * hh) * 2;
                    const uint2 lo = *(const uint2*)vp, hi = *(const uint2*)(vp + 16);
                    const u32x4 u = (u32x4){lo.x, lo.y, hi.x, hi.y};
                    acc[vb] = __builtin_amdgcn_mfma_f32_32x32x16_bf16(__builtin_bit_cast(bf16x8, u), pb[k2], acc[vb], 0, 0, 0);
                }
        }
    }
    den += SHX(den, 32);
    const float scl = 1.f / fmaxf(fabsf(den), expf(-(btv + gtv)));
#pragma unroll
    for (int vb = 0; vb < 4; ++vb) acc[vb] = acc[vb] * scl;
    __syncthreads();
    float* X = (float*)smem + tb * 4096;
    if (dir == 1) {
#pragma unroll
        for (int vb = 0; vb < 4; ++vb)
#pragma unroll
            for (int r = 0; r < 16; ++r) X[(vb * 32 + (r & 3) + 8 * (r >> 2) + 4 * hh) * 32 + jl] = acc[vb][r];
    }
    __syncthreads();
    if (dir == 0) {
        float ss = 0.f;
#pragma unroll
        for (int vb = 0; vb < 4; ++vb)
#pragma unroll
            for (int r = 0; r < 16; ++r) { const float v = acc[vb][r] + X[(vb * 32 + (r & 3) + 8 * (r >> 2) + 4 * hh) * 32 + jl]; acc[vb][r] = v; ss += v * v; }
        ss += SHX(ss, 32);
        const float rstd = rsqrtf(ss * (1.f / 128.f) + 1e-6f);
        const int row = ml_row(b, tc, t);
        const float* g = p.ev_ml_g + (size_t)j * 512 + h * 128;
        const bf16_t* og = p.PB + (size_t)row * 1536 + 1024 + h * 128;
        bf16_t* mrow = p.MIX + (size_t)row * DM + h * 128;
#pragma unroll
        for (int vb = 0; vb < 4; ++vb)
#pragma unroll
            for (int r4 = 0; r4 < 4; ++r4) {
                const int v = vb * 32 + 8 * r4 + 4 * hh;
                const f32x4 gg = *(const f32x4*)(g + v);
                const uint2 ou = *(const uint2*)(og + v);
                *(uint2*)(mrow + v) = make_uint2(cvt_pk_bf16(acc[vb][r4 * 4 + 0] * rstd * gg[0] * sigmoid_f(bf_lo(ou.x)), acc[vb][r4 * 4 + 1] * rstd * gg[1] * sigmoid_f(bf_hi(ou.x))),
                                                 cvt_pk_bf16(acc[vb][r4 * 4 + 2] * rstd * gg[2] * sigmoid_f(bf_lo(ou.y)), acc[vb][r4 * 4 + 3] * rstd * gg[3] * sigmoid_f(bf_hi(ou.y))));
            }
    }
}

__device__ void ph_attn_even(const P& p, int ci, int L, int j, float* smem) {
    int* s_item = (int*)((char*)smem + 73728);
    int* dq = p.ctr + 64 + ci * 8;
    const int myx = xcc_id8();
    for (int sdx = 0; sdx < 8; ++sdx) {
        const int x = (myx + sdx) & 7;
        for (;;) {
            __syncthreads();
            if (otid() == 0) *s_item = atomicAdd(&dq[x], 1);
            __syncthreads();
            const int i = *s_item;
            if (i >= 144) break;
            const int pr = x + 8 * (i / 36), jq = i % 36, b = pr >> 2, h = pr & 3;
            da_block(p, jq < 32 ? b * 128 + h * 32 + jq : 1024 + b * 16 + h * 4 + (jq - 32), L, j, (char*)smem);
        }
    }
    for (;;) {
        __syncthreads();
        if (otid() == 0) *s_item = atomicAdd(&p.ctr[ci], 1);
        __syncthreads();
        const int item = *s_item;
        if (item >= 2304) break;
        ml_pass1_item(p, item, j, (char*)smem);
    }
}
__device__ void ph_ml_pass3(const P& p, int j, float* smem) {
    for (int item = blockIdx.x; item < 1152; item += gridDim.x) ml_pass3_item(p, item, j, (char*)smem);
}
__device__ void ph_attn_odd(const P& p, int j, bool need_ctx, float* smem) {
    const int nitem = need_ctx ? 2304 : 2048;
    for (int item = blockIdx.x; item < nitem; item += gridDim.x) { wa_block(p, item, j, (char*)smem); __syncthreads(); }
}

#define SEL_LD 132
#define SEL_NOCACHE 1
template <int NV>
__device__ __forceinline__ unsigned topk16_threshold(const unsigned (&k)[NV], unsigned start, bool& exact) {
    auto cnt = [&](unsigned c) { int n = 0;
#pragma unroll
        for (int i = 0; i < NV; ++i) n += __builtin_popcountll(__ballot(k[i] >= c));
        return n; };
    unsigned E = start; int n = cnt(E);
    if (n >= 16) { for (;;) { const unsigned E2 = E + 0x800000u; if (E2 < E) break; const int n2 = cnt(E2); if (n2 < 16) break; E = E2; n = n2; } }
    else { do { E -= 0x800000u; n = cnt(E); } while (n < 16); }
    unsigned T = E;
    for (int bit = 22; bit >= 0 && n != 16; --bit) { const unsigned c = T | (1u << bit); n = cnt(c); if (n >= 16) T = c; else n = 17; }
    exact = (n == 16);
    return T;
}
__device__ __forceinline__ unsigned fkey(float f) { const unsigned u = __float_as_uint(f); return (u & 0x80000000u) ? ~u : (u | 0x80000000u); }
__device__ __forceinline__ unsigned mbcnt64(unsigned long long m) { return __builtin_amdgcn_mbcnt_hi((unsigned)(m >> 32), __builtin_amdgcn_mbcnt_lo((unsigned)m, 0u)); }
__device__ __forceinline__ int rowsum16(int v) { v += dppi<0xB1>(v); v += dppi<0x4E>(v); v += dppi<0x141>(v); v += dppi<0x140>(v); return v; }
__device__ __forceinline__ int rowscan16(int v) { v += dppi<0x111>(v); v += dppi<0x112>(v); v += dppi<0x114>(v); v += dppi<0x118>(v); return v; }
__device__ __forceinline__ int qcount8p(unsigned k0, unsigned k1, unsigned k2, unsigned k3, unsigned k4, unsigned k5, unsigned k6, unsigned k7, unsigned x, int cin) {
    int c; unsigned long long m0, m1, m2, m3, m4, m5, m6, m7;
    asm volatile("v_cmp_ge_u32_e64 %1, %9, %17\n\tv_cmp_ge_u32_e64 %2, %10, %17\n\tv_cmp_ge_u32_e64 %3, %11, %17\n\tv_cmp_ge_u32_e64 %4, %12, %17\n\t"
                 "v_cmp_ge_u32_e64 %5, %13, %17\n\tv_cmp_ge_u32_e64 %6, %14, %17\n\tv_cmp_ge_u32_e64 %7, %15, %17\n\tv_cmp_ge_u32_e64 %8, %16, %17\n\t"
                 "v_addc_co_u32_e64 %0, vcc, %18, 0, %1\n\tv_addc_co_u32_e64 %0, vcc, %0, 0, %2\n\tv_addc_co_u32_e64 %0, vcc, %0, 0, %3\n\tv_addc_co_u32_e64 %0, vcc, %0, 0, %4\n\t"
                 "v_addc_co_u32_e64 %0, vcc, %0, 0, %5\n\tv_addc_co_u32_e64 %0, vcc, %0, 0, %6\n\tv_addc_co_u32_e64 %0, vcc, %0, 0, %7\n\tv_addc_co_u32_e64 %0, vcc, %0, 0, %8"
                 : "=&v"(c), "=&s"(m0), "=&s"(m1), "=&s"(m2), "=&s"(m3), "=&s"(m4), "=&s"(m5), "=&s"(m6), "=&s"(m7)
                 : "v"(k0), "v"(k1), "v"(k2), "v"(k3), "v"(k4), "v"(k5), "v"(k6), "v"(k7), "v"(x), "v"(cin) : "vcc");
    return c;
}
__device__ __forceinline__ int rowsum16a(int c) {
    asm volatile("s_nop 1\n\tv_add_u32_dpp %0, %0, %0 quad_perm:[1,0,3,2] row_mask:0xf bank_mask:0xf bound_ctrl:1\n\ts_nop 1\n\t"
                 "v_add_u32_dpp %0, %0, %0 quad_perm:[2,3,0,1] row_mask:0xf bank_mask:0xf bound_ctrl:1\n\ts_nop 1\n\t"
                 "v_add_u32_dpp %0, %0, %0 row_half_mirror row_mask:0xf bank_mask:0xf bound_ctrl:1\n\ts_nop 1\n\t"
                 "v_add_u32_dpp %0, %0, %0 row_mirror row_mask:0xf bank_mask:0xf bound_ctrl:1" : "+v"(c));
    return c;
}
__device__ __forceinline__ void rowsum16a2(int& a, int& b) {
    asm volatile("s_nop 1\n\t"
                 "v_add_u32_dpp %0, %0, %0 quad_perm:[1,0,3,2] row_mask:0xf bank_mask:0xf bound_ctrl:1\n\tv_add_u32_dpp %1, %1, %1 quad_perm:[1,0,3,2] row_mask:0xf bank_mask:0xf bound_ctrl:1\n\ts_nop 0\n\t"
                 "v_add_u32_dpp %0, %0, %0 quad_perm:[2,3,0,1] row_mask:0xf bank_mask:0xf bound_ctrl:1\n\tv_add_u32_dpp %1, %1, %1 quad_perm:[2,3,0,1] row_mask:0xf bank_mask:0xf bound_ctrl:1\n\ts_nop 0\n\t"
                 "v_add_u32_dpp %0, %0, %0 row_half_mirror row_mask:0xf bank_mask:0xf bound_ctrl:1\n\tv_add_u32_dpp %1, %1, %1 row_half_mirror row_mask:0xf bank_mask:0xf bound_ctrl:1\n\ts_nop 0\n\t"
                 "v_add_u32_dpp %0, %0, %0 row_mirror row_mask:0xf bank_mask:0xf bound_ctrl:1\n\tv_add_u32_dpp %1, %1, %1 row_mirror row_mask:0xf bank_mask:0xf bound_ctrl:1" : "+v"(a), "+v"(b));
}
template <int NV> __device__ __forceinline__ int qcountp(const unsigned (&k)[NV], unsigned x) {
    int c = 0;
#pragma unroll
    for (int e = 0; e < NV; e += 8) c = qcount8p(k[e], k[e + 1], k[e + 2], k[e + 3], k[e + 4], k[e + 5], k[e + 6], k[e + 7], x, c);
    return c;
}
template <int NV>
__device__ __forceinline__ void qsearch2(const unsigned (&ka)[NV], const unsigned (&kb)[NV], unsigned start, unsigned& TA, int& nA, unsigned& TB, int& nB) {
    int loA = qcountp<NV>(ka, start), hiA = qcountp<NV>(ka, start + 0x800000u); rowsum16a2(loA, hiA);
    int loB = qcountp<NV>(kb, start), hiB = qcountp<NV>(kb, start + 0x800000u); rowsum16a2(loB, hiB);
    const bool fast = __ballot(!(loA >= 16 && hiA < 16 && loB >= 16 && hiB < 16)) == 0ull;
    TA = TB = fast ? start : 0u; nA = fast ? loA : NV * 16; nB = fast ? loB : NV * 16;
    for (unsigned bit = fast ? (1u << 22) : (1u << 31); bit != 0u && __ballot((nA != 16) || (nB != 16)) != 0ull; bit >>= 1) {
        const unsigned xA = TA | bit, xB = TB | bit;
        int cA = qcountp<NV>(ka, xA), cB = qcountp<NV>(kb, xB); rowsum16a2(cA, cB);
        const bool gA = cA >= 16, gB = cB >= 16;
        TA = gA ? xA : TA; nA = gA ? cA : nA; TB = gB ? xB : TB; nB = gB ? cB : nB;
    }
}
template <int NV>
__device__ __forceinline__ void qsearch1(const unsigned (&k)[NV], unsigned start, unsigned& T, int& n) {
    int lo = qcountp<NV>(k, start), hi = qcountp<NV>(k, start + 0x800000u); rowsum16a2(lo, hi);
    const bool fast = __ballot(!(lo >= 16 && hi < 16)) == 0ull;
    T = fast ? start : 0u; n = fast ? lo : NV * 16;
    for (unsigned bit = fast ? (1u << 22) : (1u << 31); bit != 0u && __ballot(n != 16) != 0ull; bit >>= 1) {
        const unsigned x = T | bit;
        const int c = rowsum16a(qcountp<NV>(k, x));
        const bool g = c >= 16;
        T = g ? x : T; n = g ? c : n;
    }
}
template <int NV, class PayF>
__device__ __forceinline__ void qcompact(char* smem, const unsigned (&k)[NV], const float (&val)[NV], PayF pay, unsigned T, int n, int dst, int dump) {
    if (__ballot(n != 16) == 0ull) {
        int c = 0;
#pragma unroll
        for (int e = 0; e < NV; ++e) c += (k[e] >= T) ? 1 : 0;
        int pos = rowscan16(c) - c;
#pragma unroll
        for (int e = 0; e < NV; ++e) {
            const bool sel = k[e] >= T;
            *(float2*)(smem + (sel ? dst + pos * 8 : dump)) = make_float2(val[e], __int_as_float(pay(e)));
            pos += sel ? 1 : 0;
        }
    } else {
        int cg = 0, ce = 0;
#pragma unroll
        for (int e = 0; e < NV; ++e) { cg += (k[e] > T) ? 1 : 0; ce += (k[e] == T) ? 1 : 0; }
        const int need = 16 - rowsum16(cg), tr0 = rowscan16(ce) - ce;
        int c = 0, tr = tr0;
#pragma unroll
        for (int e = 0; e < NV; ++e) { const bool eq = k[e] == T; c += ((k[e] > T) || (eq && tr < need)) ? 1 : 0; tr += eq ? 1 : 0; }
        int pos = rowscan16(c) - c; tr = tr0;
#pragma unroll
        for (int e = 0; e < NV; ++e) {
            const bool eq = k[e] == T, sel = (k[e] > T) || (eq && tr < need);
            *(float2*)(smem + (sel ? dst + pos * 8 : dump)) = make_float2(val[e], __int_as_float(pay(e)));
            pos += sel ? 1 : 0; tr += eq ? 1 : 0;
        }
    }
}
template <class NextF, class DoneF>
__device__ __forceinline__ void peer_select_loop(const P& p, int L, char* smem, NextF&& next_item, DoneF&& done_item) {
    float* S = (float*)smem;
    const int tid = otid(), lane = tid & 63, wid = tid >> 6, fr = lane & 15, fq = lane >> 4;
    const bf16_t* KBL = p.KB + (size_t)L * 8 * 2 * 128 * 128;
    bf16x8 kfr[8][4];
    int hcur = -1;
    for (int ndone = 0;; ++ndone) {
        const int item = next_item(ndone);
        if (item < 0) break;
        const int h = item & 7, t0 = (item >> 3) * 32;
        __syncthreads();
        {
            const int pp = wid >> 1, th = wid & 1;
            const bf16_t* qp = p.QB + (size_t)(t0 + th * 16 + fr) * 2048 + h * 256 + pp * 128 + fq * 8;
            bf16x8 qf[4];
#pragma unroll
            for (int ks = 0; ks < 4; ++ks) qf[ks] = *(const bf16x8*)(qp + ks * 32);
#ifndef SEL_NOCACHE
            if (h != hcur)
#endif
            {
                const bf16_t* kp = KBL + ((size_t)(h * 2 + pp) * 128 + fr) * 128 + fq * 8;
#pragma unroll
                for (int ni = 0; ni < 8; ++ni)
#pragma unroll
                    for (int ks = 0; ks < 4; ++ks) kfr[ni][ks] = *(const bf16x8*)(kp + (size_t)ni * 16 * 128 + ks * 32);
                hcur = h;
            }
#pragma unroll
            for (int ni = 0; ni < 8; ++ni) {
                f32x4 acc = (f32x4){0.f, 0.f, 0.f, 0.f};
#pragma unroll
                for (int ks = 0; ks < 4; ++ks) acc = __builtin_amdgcn_mfma_f32_16x16x32_bf16(qf[ks], kfr[ni][ks], acc, 0, 0, 0);
#pragma unroll
                for (int j = 0; j < 4; ++j) S[(pp * 32 + th * 16 + fq * 4 + j) * SEL_LD + ni * 16 + fr] = acc[j];
            }
        }
        __syncthreads();
#pragma unroll 1
        for (int quad = 0; quad < 2; ++quad) {
            const int q = lane >> 4, i = lane & 15, t = wid * 8 + quad * 4 + q, r = t0 + t;
            const int wbase = 34816 + wid * 2560, rowb = wbase + q * 512, dump = wbase + 2048 + lane * 8;
            float vA[8], vB[8]; unsigned kA[8], kB[8];
#pragma unroll
            for (int m = 0; m < 2; ++m) {
                const float4 a4 = *(const float4*)(S + t * SEL_LD + 64 * m + 4 * i), b4 = *(const float4*)(S + (32 + t) * SEL_LD + 64 * m + 4 * i);
                vA[4 * m] = a4.x; vA[4 * m + 1] = a4.y; vA[4 * m + 2] = a4.z; vA[4 * m + 3] = a4.w;
                vB[4 * m] = b4.x; vB[4 * m + 1] = b4.y; vB[4 * m + 2] = b4.z; vB[4 * m + 3] = b4.w;
            }
#pragma unroll
            for (int e = 0; e < 8; ++e) { kA[e] = fkey(vA[e]); kB[e] = fkey(vB[e]); }
            {
                unsigned TA, TB; int nA, nB;
                qsearch2<8>(kA, kB, 0xBF800000u, TA, nA, TB, nB);
                const int ib = 4 * i;
                qcompact<8>(smem, kA, vA, [&](int e) { return ib + 64 * (e >> 2) + (e & 3); }, TA, nA, rowb, dump);
                qcompact<8>(smem, kB, vB, [&](int e) { return ib + 64 * (e >> 2) + (e & 3); }, TB, nB, rowb + 128, dump);
            }
            __builtin_amdgcn_wave_barrier();
            {
                const float2 av = *(const float2*)(smem + rowb + i * 8);
                float cand[16]; unsigned kc[16]; int bidx[16];
#pragma unroll
                for (int j2 = 0; j2 < 8; ++j2) {
                    const float4 bb = *(const float4*)(smem + rowb + 128 + j2 * 16);
                    cand[2 * j2] = av.x + bb.x; bidx[2 * j2] = __float_as_int(bb.y); cand[2 * j2 + 1] = av.x + bb.z; bidx[2 * j2 + 1] = __float_as_int(bb.w);
                }
#pragma unroll
                for (int j = 0; j < 16; ++j) kc[j] = fkey(cand[j]);
                unsigned TC; int nC;
                qsearch1<16>(kc, 0xC0800000u, TC, nC);
                const int ai128 = __float_as_int(av.y) * 128;
                __builtin_amdgcn_wave_barrier();
                qcompact<16>(smem, kc, cand, [&](int e) { return ai128 + bidx[e]; }, TC, nC, rowb + 256, dump);
            }
            __builtin_amdgcn_wave_barrier();
            {
                const float2 cv = *(const float2*)(smem + rowb + 256 + i * 8);
                float mx = cv.x;
                mx = fmaxf(mx, dppf<0xB1, 0xF>(mx, mx)); mx = fmaxf(mx, dppf<0x4E, 0xF>(mx, mx)); mx = fmaxf(mx, dppf<0x141, 0xF>(mx, mx)); mx = fmaxf(mx, dppf<0x140, 0xF>(mx, mx));
                const float ex = __builtin_amdgcn_exp2f((cv.x - mx) * 1.4426950408889634f);
                float sum = ex;
                sum += dppf<0xB1, 0xF>(sum, 0.f); sum += dppf<0x4E, 0xF>(sum, 0.f); sum += dppf<0x141, 0xF>(sum, 0.f); sum += dppf<0x140, 0xF>(sum, 0.f);
                __hip_atomic_store(&p.GATE[(size_t)r * 128 + h * 16 + i], ex * __builtin_amdgcn_rcpf(sum), __ATOMIC_RELAXED, __HIP_MEMORY_SCOPE_AGENT);
                __hip_atomic_store(&p.EIDX[(size_t)r * 128 + h * 16 + i], __float_as_int(cv.y), __ATOMIC_RELAXED, __HIP_MEMORY_SCOPE_AGENT);
            }
            __builtin_amdgcn_wave_barrier();
        }
        done_item(item);
    }
}


__device__ __forceinline__ int wave_sum_i(int v, int lane) {
    v += __builtin_amdgcn_update_dpp(0, v, 0xB1, 0xF, 0xF, true);
    v += __builtin_amdgcn_update_dpp(0, v, 0x4E, 0xF, 0xF, true);
    v += __builtin_amdgcn_update_dpp(0, v, 0x141, 0xF, 0xF, true);
    v += __builtin_amdgcn_update_dpp(0, v, 0x140, 0xF, 0xF, true);
    v += __builtin_amdgcn_update_dpp(0, v, 0x142, 0xA, 0xF, false);
    v += __builtin_amdgcn_update_dpp(0, v, 0x143, 0xC, 0xF, false);
    return __builtin_amdgcn_readlane(v, 63);
}
__device__ __forceinline__ int tred32(const int (&s)[32], int lane) {
    int t1[16], t2[8], t3[4], t4[2];
#pragma unroll
    for (int j = 0; j < 16; ++j) { const auto q = __builtin_amdgcn_permlane32_swap((unsigned)s[j], (unsigned)s[j + 16], false, false); t1[j] = (int)(q[0] + q[1]); }
#pragma unroll
    for (int j = 0; j < 8; ++j) { const auto q = __builtin_amdgcn_permlane16_swap((unsigned)t1[j], (unsigned)t1[j + 8], false, false); t2[j] = (int)(q[0] + q[1]); }
#pragma unroll
    for (int j = 0; j < 4; ++j) { const int ra = t2[j] + dppi<0x128>(t2[j]), rb = t2[j + 4] + dppi<0x128>(t2[j + 4]); t3[j] = (lane & 8) ? rb : ra; }
#pragma unroll
    for (int j = 0; j < 2; ++j) { const int ra = t3[j] + dppi<0x141>(t3[j]), rb = t3[j + 2] + dppi<0x141>(t3[j + 2]); t4[j] = (lane & 4) ? rb : ra; }
    const int ra = t4[0] + dppi<0x4E>(t4[0]), rb = t4[1] + dppi<0x4E>(t4[1]);
    return (lane & 2) ? rb : ra;
}
__device__ __forceinline__ void peer_gather_token(const P& p, int L, int r, float oscale, int lane) {
    const unsigned char* U = p.U8 + (size_t)L * 16384 * 512; const unsigned char* V = p.V8 + (size_t)L * 16384 * 512;
    const float* USC = p.USC + (size_t)L * 16384; const float* VSC = p.VSC + (size_t)L * 16384;
    const float* gate2 = p.modv + (size_t)L * 9 * 6144 + 5120;
    {
        const int sig = (lane & 1) * 32 + (lane >> 1);
        const int e0 = p.EIDX[(size_t)r * 128 + sig], e1 = p.EIDX[(size_t)r * 128 + 64 + sig];
        const float g0 = p.GATE[(size_t)r * 128 + sig], g1 = p.GATE[(size_t)r * 128 + 64 + sig];
        const float us0 = USC[e0], us1 = USC[e1], vs0 = VSC[e0], vs1 = VSC[e1];
        const uint4 xq = *(const uint4*)(p.XQ + (size_t)r * DM + lane * 16);
        const float xs = p.XS[r];
        const int sxlo = wave_sum_i(__builtin_amdgcn_sdot4((int)xq.x, 0x01010101, __builtin_amdgcn_sdot4((int)xq.z, 0x01010101, 0, false), false), lane);
        const int sxhi = wave_sum_i(__builtin_amdgcn_sdot4((int)xq.y, 0x01010101, __builtin_amdgcn_sdot4((int)xq.w, 0x01010101, 0, false), false), lane);
        const float cx = 0.5f * (float)sxhi - 7.5f * (float)sxlo;
        int d0 = 0, d1 = 0;
        const unsigned lane8 = (unsigned)lane * 8u;
#pragma unroll
        for (int half = 0; half < 2; ++half) {
            const int ev = half ? e1 : e0;
            int x0 = 0, x1 = 0;
#pragma unroll 1
            for (int kb = 0; kb < 2; ++kb) {
                uint2 ua[32];
#pragma unroll
                for (int j = 0; j < 32; ++j) {
                    const unsigned idx = (unsigned)__builtin_amdgcn_readlane(ev, 2 * j + kb);
                    ua[j] = *(const uint2*)(U + (size_t)(idx * 512u + lane8));
                }
                int sd[32];
#pragma unroll
                for (int j = 0; j < 32; ++j) {
                    int lo = __builtin_amdgcn_sdot4((int)xq.x, (int)(ua[j].x & 0x0F0F0F0Fu), 0, false);
                    lo = __builtin_amdgcn_sdot4((int)xq.z, (int)(ua[j].y & 0x0F0F0F0Fu), lo, false);
                    int hi = __builtin_amdgcn_sdot4((int)xq.y, (int)(ua[j].x & 0xF0F0F0F0u), 0, false);
                    hi = __builtin_amdgcn_sdot4((int)xq.w, (int)(ua[j].y & 0xF0F0F0F0u), hi, false);
                    sd[j] = (lo << 4) + hi;
                }
                const int t = tred32(sd, lane);
                if (kb) x1 = t; else x0 = t;
            }
            const int f0 = x0 + dppi<0xB1>(x0), f1 = x1 + dppi<0xB1>(x1);
            const int dv = (lane & 1) ? f1 : f0;
            if (half) d1 = dv; else d0 = dv;
        }
        const float a0 = us0 * xs * ((float)d0 * 0.0625f + cx), a1 = us1 * xs * ((float)d1 * 0.0625f + cx);
        const float w0 = vs0 * g0 * 0.5f * a0 * (1.f + erff(a0 * 0.70710678118654752f));
        const float w1 = vs1 * g1 * 0.5f * a1 * (1.f + erff(a1 * 0.70710678118654752f));
        const float wmax = wave_max(fmaxf(fabsf(w0), fabsf(w1)));
        const float winv = wmax > 0.f ? 127.f / wmax : 0.f;
        const int wi0 = (int)rintf(w0 * winv), wi1 = (int)rintf(w1 * winv);
        const int wq0 = wi0 & 0xff, wq1 = wi1 & 0xff;
        const float cw = (float)wave_sum_i(wi0 + wi1, lane);
        int accf[8], acch[8];
#pragma unroll
        for (int c = 0; c < 8; ++c) { accf[c] = 0; acch[c] = 0; }
#pragma unroll
        for (int half = 0; half < 2; ++half) {
            const int ev = half ? e1 : e0; const int wqv = half ? wq1 : wq0;
#pragma unroll 1
            for (int kb = 0; kb < 2; ++kb) {
                uint2 ua[32];
#pragma unroll
                for (int j = 0; j < 32; ++j) {
                    const unsigned idx = (unsigned)__builtin_amdgcn_readlane(ev, 2 * j + kb);
                    ua[j] = *(const uint2*)(V + (size_t)(idx * 512u + lane8));
                }
#pragma unroll
                for (int j4 = 0; j4 < 8; ++j4) {
                    const int k0 = j4 * 8 + kb;
                    const int wpk = __builtin_amdgcn_readlane(wqv, k0) | (__builtin_amdgcn_readlane(wqv, k0 + 2) << 8) | (__builtin_amdgcn_readlane(wqv, k0 + 4) << 16) | (__builtin_amdgcn_readlane(wqv, k0 + 6) << 24);
#define TR_ONE(I, T) { const unsigned tt = (T); accf[I] = __builtin_amdgcn_sdot4((int)tt, wpk, accf[I], false); acch[I] = __builtin_amdgcn_sdot4((int)(tt & 0xF0F0F0F0u), wpk, acch[I], false); }
#define TR_DOT(D, M) { const unsigned ablo = __builtin_amdgcn_perm(ua[j4 * 4 + 1].M, ua[j4 * 4].M, 0x05010400u), abhi = __builtin_amdgcn_perm(ua[j4 * 4 + 1].M, ua[j4 * 4].M, 0x07030602u); \
                        const unsigned celo = __builtin_amdgcn_perm(ua[j4 * 4 + 3].M, ua[j4 * 4 + 2].M, 0x05010400u), cehi = __builtin_amdgcn_perm(ua[j4 * 4 + 3].M, ua[j4 * 4 + 2].M, 0x07030602u); \
                        TR_ONE((D) * 4 + 0, __builtin_amdgcn_perm(celo, ablo, 0x05040100u)) TR_ONE((D) * 4 + 1, __builtin_amdgcn_perm(celo, ablo, 0x07060302u)) \
                        TR_ONE((D) * 4 + 2, __builtin_amdgcn_perm(cehi, abhi, 0x05040100u)) TR_ONE((D) * 4 + 3, __builtin_amdgcn_perm(cehi, abhi, 0x07060302u)) }
                    TR_DOT(0, x) TR_DOT(1, y)
#undef TR_DOT
#undef TR_ONE
                }
            }
        }
        float acc[16];
#pragma unroll
        for (int j = 0; j < 4; ++j) {
            acc[j] = (float)(accf[j] - acch[j]) - 7.5f * cw;          acc[4 + j] = (float)acch[j] * 0.0625f + 0.5f * cw;
            acc[8 + j] = (float)(accf[4 + j] - acch[4 + j]) - 7.5f * cw;  acc[12 + j] = (float)acch[4 + j] * 0.0625f + 0.5f * cw;
        }
        const float osc = oscale * wmax * (1.f / 127.f);
        const float* gp = gate2 + (size_t)modrow(r) * 6144 + lane * 16;
        float* hp = p.H + (size_t)r * DM + lane * 16;
        float hn[16]; float ss = 0.f;
#pragma unroll
        for (int q = 0; q < 4; ++q) {
            const float4 g = *(const float4*)(gp + q * 4);
            float4 hv = *(float4*)(hp + q * 4);
            hv.x += osc * g.x * (float)acc[q * 4 + 0]; hv.y += osc * g.y * (float)acc[q * 4 + 1];
            hv.z += osc * g.z * (float)acc[q * 4 + 2]; hv.w += osc * g.w * (float)acc[q * 4 + 3];
            if (L < 3) *(float4*)(hp + q * 4) = hv;
            hn[q * 4 + 0] = hv.x; hn[q * 4 + 1] = hv.y; hn[q * 4 + 2] = hv.z; hn[q * 4 + 3] = hv.w;
            ss += hv.x * hv.x + hv.y * hv.y + hv.z * hv.z + hv.w * hv.w;
        }
        ss = wave_sum(ss);
        const float rstd = rsqrtf(ss * (1.0f / DM) + 1e-6f);
        if (L < 3) {
            const float* g1 = p.norm1_g + (size_t)(L + 1) * DM + lane * 16;
            const float* mvn = p.modv + ((size_t)(L + 1) * 9 + modrow(r)) * 6144 + lane * 16;
            unsigned w[8];
#pragma unroll
            for (int q = 0; q < 4; ++q) {
                const float4 gg = *(const float4*)(g1 + q * 4), sh = *(const float4*)(mvn + q * 4), scl = *(const float4*)(mvn + 1024 + q * 4);
                w[q * 2] = cvt_pk_bf16(hn[q * 4 + 0] * rstd * gg.x * (1.f + scl.x) + sh.x, hn[q * 4 + 1] * rstd * gg.y * (1.f + scl.y) + sh.y);
                w[q * 2 + 1] = cvt_pk_bf16(hn[q * 4 + 2] * rstd * gg.z * (1.f + scl.z) + sh.z, hn[q * 4 + 3] * rstd * gg.w * (1.f + scl.w) + sh.w);
            }
            uint4* xp = (uint4*)(p.XN + (size_t)r * DM + lane * 16);
            xp[0] = make_uint4(w[0], w[1], w[2], w[3]); xp[1] = make_uint4(w[4], w[5], w[6], w[7]);
        } else {
            const float* fg = p.final_g + lane * 16;
            float* op = p.out + (size_t)r * DM + lane * 16;
#pragma unroll
            for (int q = 0; q < 4; ++q) {
                const float4 gg = *(const float4*)(fg + q * 4);
                *(float4*)(op + q * 4) = make_float4(hn[q * 4 + 0] * rstd * gg.x, hn[q * 4 + 1] * rstd * gg.y, hn[q * 4 + 2] * rstd * gg.z, hn[q * 4 + 3] * rstd * gg.w);
            }
        }
    }
}

__device__ void ph_peer_sg(const P& p, int L, int nrows, int* q2, unsigned* tflag, float oscale, char* smem) {
    int* s_item = (int*)(smem + 73728);
    const int tid = otid(), lane = tid & 63, wid = __builtin_amdgcn_readfirstlane(tid >> 6);
    const int nsel = (nrows / 32) * 8, ngat = nrows / 4;
    const bool roleS = ((blockIdx.x >> 3) & 1) == 0;
    peer_select_loop(p, L, smem,
        [&](int ndone) -> int {
            if (!roleS && ndone >= 3) return -1;
            __syncthreads();
            if (tid == 0) *s_item = atomicAdd(&q2[0], 1);
            __syncthreads();
            const int it = *s_item;
            return it < nsel ? it : -1;
        },
        [&](int item) {
            asm volatile("s_waitcnt vmcnt(0)" ::: "memory");
            __syncthreads();
            if (tid == 0) __hip_atomic_fetch_add(&tflag[item >> 3], 1u, __ATOMIC_RELAXED, __HIP_MEMORY_SCOPE_AGENT);
        });
    for (;;) {
        __syncthreads();
        if (tid == 0) {
            const int g = atomicAdd(&q2[1], 1);
            *s_item = g;
            if (g < ngat) {
                unsigned sp = 0;
                while (__hip_atomic_load(&tflag[g >> 3], __ATOMIC_RELAXED, __HIP_MEMORY_SCOPE_AGENT) < 8u) { __builtin_amdgcn_s_sleep(2); if (++sp > (1u << 24)) break; }
                __builtin_amdgcn_fence(__ATOMIC_ACQUIRE, "agent");
                asm volatile("s_waitcnt vmcnt(0)" ::: "memory");
            }
        }
        __syncthreads();
        const int g = *s_item;
        if (g >= ngat) break;
        peer_gather_token(p, L, g * 4 + wid, oscale, lane);
    }
}

#define NSUB 11
__device__ __forceinline__ bool phase_empty(int ph) {
    if (ph == 0) return false;
    const int L = (ph - 1) / NSUB, s = (ph - 1) % NSUB;
    return s == 2 || s == 10 || ((L & 1) && (s == 4 || s == 5)) || (L > 0 && s == 0);
}
__device__ __forceinline__ void run_phase(const P& p, int ph, float* smem, int rep) {
    if (ph == 0) { ph_prologue(p, smem); return; }
    const int L = (ph - 1) / NSUB, s = (ph - 1) % NSUB, j = L >> 1;
    const bool even = (L & 1) == 0, need_ctx = L < 3;
    const int nrows = need_ctx ? NT : NL;
    const float* mv = p.modv + (size_t)L * 9 * 6144;
    switch (s) {
    case 0: ph_normmod(p.H, p.norm1_g + L * DM, mv, 0, 1024, p.XN, NT); break;
    case 1:
        if (even) ph_gemm(p.XN, p.WT + WT_EVIN(j), NT, 3200, EpiEven{p.PB, p.AQL, p.AQC, p.AK, p.AV, p.GT, p.rope}, (char*)smem);
        else ph_gemm(p.XN, p.WT + WT_ODIN(j), NT, ODW, EpiOdd{p.AQL, p.AQC, p.AK, p.AV, p.rope}, (char*)smem);
        break;
    case 3: if (even) ph_attn_even(p, L + 4 * rep, L, j, smem); else ph_attn_odd(p, j, need_ctx, smem); break;
    case 4: if (even) ph_ml_pass2(p); break;
    case 5: if (even) ph_ml_pass3(p, j, smem); break;
    case 6: ph_gemm(p.MIX, p.WT + (even ? WT_EVOUT(j) : WT_ODOUT(j)), nrows, DM, EpiResid{p.H, mv + 2048, rep ? 0.f : 1.f}, (char*)smem); break;
    case 7: ph_normmod_q(p, p.norm2_g + L * DM, mv, nrows); break;
    case 8: ph_gemm(p.XN, p.WT + WT_PQ(L), nrows, 2048, EpiStoreBF16{p.QB, 2048}, (char*)smem); break;
    case 9: ph_peer_sg(p, L, nrows, p.ctr + 16 + L * 2, (unsigned*)p.ctr + 256 + L * 576, rep ? 0.f : 1.f, (char*)smem); break;
    }
}

#define XB_TMO      128
#define XB_XCNT(j)  (256  + 64 * (j))
#define XB_XSUB(j)  (1280 + 64 * (j))
#define XB_XGEN(j)  (2304 + 64 * (j))
#define XB_TOP      3328
#define XB_TOPGEN   3392
#define XCD_BAR_WORDS 3456
#define XB_SPIN_CAP (1u << 20)
#define LAS __attribute__((address_space(3)))
__device__ __forceinline__ unsigned xb_ld(unsigned* p)              { return __hip_atomic_load(p, __ATOMIC_RELAXED, __HIP_MEMORY_SCOPE_AGENT); }
__device__ __forceinline__ unsigned xb_add(unsigned* p, unsigned v) { return __hip_atomic_fetch_add(p, v, __ATOMIC_RELAXED, __HIP_MEMORY_SCOPE_AGENT); }
__device__ __forceinline__ unsigned xb_xcc_id() { return (unsigned)__builtin_amdgcn_s_getreg((3 << 11) | 20) & 0xFu; }
#define XB_SPIN(cond, bar) do { unsigned _sp = 0; while (cond) { __builtin_amdgcn_s_sleep(1); \
    if ((++_sp & 255u) == 0u) { if (xb_ld(&(bar)[XB_TMO])) break; if (_sp > XB_SPIN_CAP) { atomicAdd(&(bar)[XB_TMO], 1u); break; } } } } while (0)
struct XcdBarrier { unsigned* bar; unsigned x; volatile LAS unsigned* st; };
__device__ __forceinline__ XcdBarrier xcd_barrier_post(unsigned* bar, volatile LAS unsigned* st) {
    XcdBarrier b; b.bar = bar; b.x = xb_xcc_id(); b.st = st;
    if (threadIdx.x == 0) (void)xb_add(&bar[XB_XCNT(b.x)], 1u);
    return b;
}
__device__ __forceinline__ void xcd_barrier_complete(unsigned* bar, unsigned x, unsigned& nloc, unsigned& nx) {
    const unsigned G = gridDim.x * gridDim.y * gridDim.z;
    unsigned sum, cnt, mine, sp = 0u;
    for (;;) {
        sum = 0u; cnt = 0u; mine = 0u;
#pragma unroll
        for (unsigned j = 0; j < 16; ++j) { const unsigned c = xb_ld(&bar[XB_XCNT(j)]); sum += c; cnt += (c > 0u) ? 1u : 0u; mine = (j == x) ? c : mine; }
        if (sum == G) break;
        __builtin_amdgcn_s_sleep(1);
        if ((++sp & 255u) == 0u) { if (xb_ld(&bar[XB_TMO])) break; if (sp > XB_SPIN_CAP) { atomicAdd(&bar[XB_TMO], 1u); break; } }
    }
    nloc = mine > 0u ? mine : 1u; nx = cnt > 0u ? cnt : 1u;
}
__device__ __forceinline__ void xcd_barrier(const XcdBarrier& b) {
    asm volatile("s_waitcnt vmcnt(0)" ::: "memory");
    __syncthreads();
    if (threadIdx.x == 0) {
        unsigned* bar = b.bar;
        __builtin_amdgcn_s_waitcnt(0);
        unsigned nloc = b.st[0], nx = b.st[1];
        if (nloc == 0u) { xcd_barrier_complete(bar, b.x, nloc, nx); b.st[0] = nloc; b.st[1] = nx; }
        const unsigned old = xb_add(&bar[XB_XSUB(b.x)], 1u);
        const unsigned gen = old / nloc;
        if (old + 1u == (gen + 1u) * nloc) {
            __builtin_amdgcn_fence(__ATOMIC_RELEASE, "agent");
            asm volatile("s_waitcnt vmcnt(0)" ::: "memory");
            const unsigned og = xb_add(&bar[XB_TOP], 1u);
            const unsigned tg = og / nx;
            if (og + 1u == (tg + 1u) * nx) xb_add(&bar[XB_TOPGEN], 1u);
            else XB_SPIN(xb_ld(&bar[XB_TOPGEN]) == tg, bar);
            __builtin_amdgcn_fence(__ATOMIC_ACQUIRE, "agent");
            xb_add(&bar[XB_XGEN(b.x)], 1u);
            asm volatile("s_waitcnt vmcnt(0)" ::: "memory");
        } else {
            XB_SPIN(xb_ld(&bar[XB_XGEN(b.x)]) == gen, bar);
            __builtin_amdgcn_fence(__ATOMIC_ACQUIRE, "agent");
            asm volatile("s_waitcnt vmcnt(0)" ::: "memory");
        }
    }
    __syncthreads();
}

__global__ void __launch_bounds__(256, 2) mega(P p) {
    extern __shared__ __attribute__((aligned(16))) float smem[];
    cg::grid_group grid = cg::this_grid();
    volatile LAS unsigned* st = (volatile LAS unsigned*)((char*)smem + 73744);
    if (threadIdx.x < 4) st[threadIdx.x] = 0u;
    __syncthreads();
    XcdBarrier xb = xcd_barrier_post(p.bar, st);
    for (int ph = p.ph_lo; ph < p.ph_hi; ++ph) {
        if (phase_empty(ph)) continue;
        run_phase(p, ph, smem, 0);
        if (PROBE_N > 1 && ph > 0 && (ph - 1) % NSUB == PROBE_S)
            for (int rep = 1; rep < PROBE_N; ++rep) { xcd_barrier(xb); run_phase(p, ph, smem, rep); }
        if (ph + 1 < p.ph_hi) { if (ph == 0) grid.sync(); else xcd_barrier(xb); }
    }
}

extern "C" void kernel_launch(void* const* d_in, const int* in_sizes, int n_in, void* d_out, int out_size, void* d_ws, size_t ws_size, hipStream_t stream) {
    static int grid_blocks = 0;
    if (!grid_blocks) {
        int dev = 0, cus = 0, per_cu = 0;
        hipGetDevice(&dev);
        hipDeviceGetAttribute(&cus, hipDeviceAttributeMultiprocessorCount, dev);
        hipFuncSetAttribute((const void*)mega, hipFuncAttributeMaxDynamicSharedMemorySize, LDS_BYTES);
        hipOccupancyMaxActiveBlocksPerMultiprocessor(&per_cu, mega, 256, LDS_BYTES);
        if (per_cu < 1) per_cu = 1;
        if (per_cu > 2) per_cu = 2;
        grid_blocks = cus * per_cu;
    }
    P p{};
    const float** ins = (const float**)&p;
    for (int i = 0; i < 24; ++i) ins[i] = (const float*)d_in[i];
    p.out = (float*)d_out;
    size_t off = 0; char* ws = (char*)d_ws;
    auto carve = [&](size_t bytes) { void* r = ws + off; off += (bytes + 255) & ~(size_t)255; return r; };
    p.modv = (float*)carve((size_t)4 * 9 * 6144 * 4);
    p.rope = (float*)carve((size_t)2048 * 64 * 4);
    p.H = (float*)carve((size_t)NT * DM * 4);
    p.XN = (bf16_t*)carve((size_t)NT * DM * 2);
    p.WT = (bf16_t*)carve(WT_TOTAL * 2);
    p.MIX = (bf16_t*)carve((size_t)NT * DM * 2);
    p.PB = (bf16_t*)carve((size_t)NT * 1536 * 2);
    p.GT = (float*)carve((size_t)NT * 16 * 4);
    p.AQL = (bf16_t*)carve((size_t)8 * 16 * 2048 * 64 * 2);
    p.AQC = (bf16_t*)carve((size_t)8 * 16 * 256 * 64 * 2);
    p.AK = (bf16_t*)carve((size_t)8 * 4 * 2 * 2304 * 64 * 2);
    p.AV = (bf16_t*)carve((size_t)8 * 4 * 128 * 2304 * 2);
    p.QKB = (bf16_t*)carve((size_t)NT * 512 * 2);
    p.CLOC = (float*)carve((size_t)2304 * 8192 * 4);
    p.CST = (bf16_t*)carve((size_t)2304 * 8192 * 2);
    p.NLOC = (float*)carve((size_t)2304 * 64 * 4);
    p.NST = (float*)carve((size_t)2304 * 64 * 4);
    p.CHB = (float*)carve((size_t)2304 * 4);
    p.CHM = (float*)carve((size_t)2304 * 4);
    p.MST = (float*)carve((size_t)2304 * 4);
    p.QB = (bf16_t*)carve((size_t)NT * 2048 * 2);
    p.GATE = (float*)carve((size_t)NT * 128 * 4);
    p.EIDX = (int*)carve((size_t)NT * 128 * 4);
    p.ctr = (int*)carve(2560 * 4);
    p.bar = (unsigned*)carve((size_t)XCD_BAR_WORDS * 4);
    p.U8 = (unsigned char*)carve((size_t)4 * 16384 * 512);
    p.V8 = (unsigned char*)carve((size_t)4 * 16384 * 512);
    p.XQ = (unsigned char*)carve((size_t)NT * DM);
    p.XS = (float*)carve((size_t)NT * 4);
    p.USC = (float*)carve((size_t)4 * 16384 * 4);
    p.VSC = (float*)carve((size_t)4 * 16384 * 4);
    p.KB = (bf16_t*)carve((size_t)4 * 8 * 2 * 128 * 128 * 2);
    if (off > ws_size) { fprintf(stderr, "kernel_launch: workspace too small: need %zu have %zu\n", off, ws_size); return; }
    hipMemsetAsync(p.bar, 0, (size_t)XCD_BAR_WORDS * 4, stream);
#if ONE_LAUNCH
    p.ph_lo = 0; p.ph_hi = NPH;
    void* args[] = {&p};
    hipError_t e = hipLaunchCooperativeKernel((void*)mega, dim3(grid_blocks), dim3(256), args, LDS_BYTES, stream);
    if (e != hipSuccess) fprintf(stderr, "cooperative launch failed: %s (grid %d)\n", hipGetErrorString(e), grid_blocks);
#else
    for (int ph = 0; ph < NPH; ++ph) {
        if (ph > 0 && ph < NPH - 1) { const int L = (ph - 1) / NSUB, s = (ph - 1) % NSUB; if ((s == 2 || s == 4 || s == 5) && (L & 1)) continue; }
        p.ph_lo = ph; p.ph_hi = ph + 1;
        hipLaunchKernelGGL(mega, dim3(grid_blocks), dim3(256), LDS_BYTES, stream, p);
    }
#endif
}
```

```cpp
#include <hip/hip_runtime.h>
#include <hip/hip_cooperative_groups.h>
#include <cstdio>
#include <cstdint>
namespace cg = cooperative_groups;

#ifndef ONE_LAUNCH
#define ONE_LAUNCH 1
#endif

#define NT 18432
#define NL 16384
#define DM 1024
#define EVW 3088
#define ODW 1536
#define C_QK 0
#define C_V 512
#define C_O 1024
#define C_G 1536
#define C_DQ 1552
#define C_DK 2064
#define C_DV 2576
#define NPH 45
#ifndef PROBE_S
#define PROBE_S -1
#endif
#ifndef PROBE_N
#define PROBE_N 1
#endif

typedef unsigned short bf16_t;
typedef short bf16x8 __attribute__((ext_vector_type(8)));
typedef float f32x4 __attribute__((ext_vector_type(4)));
#define LDS_BYTES 73792

typedef float f32x16 __attribute__((ext_vector_type(16)));
typedef unsigned u32x4 __attribute__((ext_vector_type(4)));
struct P {
    const float *x, *c, *ctx, *c_ctx, *mod_w, *mod_b, *norm1_g, *norm2_g, *ev_w_in, *ev_conv_w, *ev_conv_b, *ev_gate_b,
        *ev_ml_g, *ev_da_lam, *ev_da_g, *ev_w_out, *od_w_in, *od_sink, *od_w_out, *pr_w_q, *pr_keys, *pr_u, *pr_v, *final_g;
    float* out;
    float *modv, *H, *GATE, *rope, *GT, *CLOC, *NLOC, *NST, *CHB, *CHM, *MST;
    int *EIDX, *ctr;
    unsigned* bar;
    bf16_t *XN, *MIX, *WT, *KB, *QB, *PB, *AQL, *AQC, *AK, *AV, *QKB, *CST;
    unsigned char *U8, *V8;
    float *USC, *VSC, *XS;
    unsigned char* XQ;
    int ph_lo, ph_hi;
};
#define QSCALE 0.18033688011112042f

__device__ __forceinline__ int otid() { int t = threadIdx.x; asm volatile("" : "+v"(t)); return t; }
__device__ __forceinline__ unsigned pack_i8x4(float a, float b, float c, float d) {
    return ((unsigned)(int)rintf(a) & 0xffu) | (((unsigned)(int)rintf(b) & 0xffu) << 8) | (((unsigned)(int)rintf(c) & 0xffu) << 16) | ((unsigned)(int)rintf(d) << 24);
}
__device__ __forceinline__ int xcc_id8() { return (int)((unsigned)__builtin_amdgcn_s_getreg((3 << 11) | 20) & 7u); }
__device__ __forceinline__ int modrow(int r) { return r < NL ? (r >> 11) : 8; }
__device__ __forceinline__ float silu_f(float x) { return x / (1.f + expf(-x)); }
__device__ __forceinline__ float sigmoid_f(float x) { return 1.f / (1.f + expf(-x)); }
__device__ __forceinline__ float log_sigmoid_f(float x) { return fminf(x, 0.f) - log1pf(expf(-fabsf(x))); }
typedef __bf16 bf16v2_t __attribute__((ext_vector_type(2)));
typedef float f32x2_t __attribute__((ext_vector_type(2)));
__device__ __forceinline__ unsigned cvt_pk_bf16(float lo, float hi) { const bf16v2_t v = __builtin_convertvector((f32x2_t){lo, hi}, bf16v2_t); return __builtin_bit_cast(unsigned, v); }
__device__ __forceinline__ float bf_lo(unsigned u) { return __uint_as_float(u << 16); }
__device__ __forceinline__ float bf_hi(unsigned u) { return __uint_as_float(u & 0xffff0000u); }
__device__ __forceinline__ void unpack8(const uint4 u, float* f) {
    f[0] = bf_lo(u.x); f[1] = bf_hi(u.x); f[2] = bf_lo(u.y); f[3] = bf_hi(u.y); f[4] = bf_lo(u.z); f[5] = bf_hi(u.z); f[6] = bf_lo(u.w); f[7] = bf_hi(u.w);
}
#define WT_EVIN(j) ((size_t)(j) * 3200 * 1024)
#define WT_EVOUT(j) ((size_t)2 * 3200 * 1024 + (size_t)(j) * 1024 * 1024)
#define WT_ODIN(j) ((size_t)2 * 3200 * 1024 + (size_t)2 * 1024 * 1024 + (size_t)(j) * 1536 * 1024)
#define WT_ODOUT(j) ((size_t)2 * 3200 * 1024 + (size_t)2 * 1024 * 1024 + (size_t)2 * 1536 * 1024 + (size_t)(j) * 1024 * 1024)
#define WT_PQ(L) ((size_t)2 * 3200 * 1024 + (size_t)4 * 1024 * 1024 + (size_t)2 * 1536 * 1024 + (size_t)(L) * 2048 * 1024)
#define WT_TOTAL ((size_t)2 * 3200 * 1024 + (size_t)4 * 1024 * 1024 + (size_t)2 * 1536 * 1024 + (size_t)4 * 2048 * 1024)
__device__ __forceinline__ float lshfl(float v, int src) { return __int_as_float(__builtin_amdgcn_ds_bpermute(src << 2, __float_as_int(v))); }
#define SHX(v, m) lshfl((v), lane ^ (m))
#define wave_sum(v) wave_sum_l((v), lane)
#define wave_max(v) wave_max_l((v), lane)
template <int CTRL> __device__ __forceinline__ int dppi(int v) { return __builtin_amdgcn_update_dpp(0, v, CTRL, 0xF, 0xF, true); }
template <int CTRL, int RMASK> __device__ __forceinline__ float dppf(float v, float fill) { return __int_as_float(__builtin_amdgcn_update_dpp(__float_as_int(fill), __float_as_int(v), CTRL, RMASK, 0xF, false)); }
__device__ __forceinline__ float wave_sum_l(float v, int lane) {
    v += dppf<0xB1, 0xF>(v, 0.f); v += dppf<0x4E, 0xF>(v, 0.f); v += dppf<0x141, 0xF>(v, 0.f); v += dppf<0x140, 0xF>(v, 0.f);
    v += dppf<0x142, 0xA>(v, 0.f); v += dppf<0x143, 0xC>(v, 0.f);
    return __int_as_float(__builtin_amdgcn_readlane(__float_as_int(v), 63));
}
__device__ __forceinline__ float wave_max_l(float v, int lane) {
    v = fmaxf(v, dppf<0xB1, 0xF>(v, v)); v = fmaxf(v, dppf<0x4E, 0xF>(v, v)); v = fmaxf(v, dppf<0x141, 0xF>(v, v)); v = fmaxf(v, dppf<0x140, 0xF>(v, v));
    v = fmaxf(v, dppf<0x142, 0xA>(v, v)); v = fmaxf(v, dppf<0x143, 0xC>(v, v));
    return __int_as_float(__builtin_amdgcn_readlane(__float_as_int(v), 63));
}

__device__ void cvt_copy_bf16(const float* src, bf16_t* dst, size_t n);
__device__ void quant_rows_i4(const float* src, unsigned char* dst, float* scl, int nrows);
__device__ void ph_prologue(const P& p, float* smem) {
    const int tid = otid(), nb = gridDim.x, bid = blockIdx.x;
    if (bid == 0) for (int i = tid; i < 2560; i += 256) p.ctr[i] = 0;
    {
        const float4* xs = (const float4*)p.x; const float4* cs = (const float4*)p.ctx; float4* hd = (float4*)p.H;
        const size_t nx = (size_t)NL * DM / 4, nc = (size_t)(NT - NL) * DM / 4;
        for (size_t i = (size_t)bid * 256 + tid; i < nx + nc; i += (size_t)nb * 256) hd[i] = i < nx ? xs[i] : cs[i - nx];
    }
    for (int i = bid * 256 + tid; i < 2048 * 32; i += nb * 256) {
        const int s = i >> 5, d = i & 31;
        const float pos = (d < 16) ? (float)(s >> 6) : (float)(s & 63);
        const float inv = powf(10000.0f, -(float)(d & 15) / 16.0f);
        const float ang = pos * inv;
        p.rope[2 * i] = cosf(ang); p.rope[2 * i + 1] = sinf(ang);
    }
    float* sc = smem;
    float* red = smem + 9 * 1024;
    for (int i = tid; i < 9 * 1024; i += 256) { const int r = i >> 10, k = i & 1023; const float v = r < 8 ? p.c[r * 1024 + k] : p.c_ctx[k]; sc[i] = silu_f(v); }
    __syncthreads();
    for (int item = bid; item < 4 * 96; item += nb) {
        const int L = item / 96, n0 = (item % 96) * 64, tx = tid & 63, kq = tid >> 6;
        float acc[9];
#pragma unroll
        for (int r = 0; r < 9; ++r) acc[r] = 0.f;
        const float* w = p.mod_w + (size_t)L * 1024 * 6144 + n0 + tx;
        for (int k = kq * 256; k < kq * 256 + 256; ++k) {
            const float wv = w[(size_t)k * 6144];
#pragma unroll
            for (int r = 0; r < 9; ++r) acc[r] += sc[r * 1024 + k] * wv;
        }
#pragma unroll
        for (int r = 0; r < 9; ++r) red[(kq * 9 + r) * 64 + tx] = acc[r];
        __syncthreads();
        if (kq == 0) {
#pragma unroll
            for (int r = 0; r < 9; ++r) {
                const float s = red[(0 * 9 + r) * 64 + tx] + red[(1 * 9 + r) * 64 + tx] + red[(2 * 9 + r) * 64 + tx] + red[(3 * 9 + r) * 64 + tx];
                p.modv[((size_t)L * 9 + r) * 6144 + n0 + tx] = s + p.mod_b[L * 6144 + n0 + tx];
            }
        }
        __syncthreads();
    }
    {
        float (*tile)[65] = (float (*)[65])smem;
        for (int item = bid; item < 5440; item += nb) {
            int it = item, mat = 0, N = 0, Npad = 0; const float* src = nullptr; bf16_t* dst = nullptr;
            for (mat = 0; mat < 12; ++mat) {
                if (mat < 2) { N = EVW; Npad = 3200; src = p.ev_w_in + (size_t)mat * DM * EVW; dst = p.WT + WT_EVIN(mat); }
                else if (mat < 4) { N = 1024; Npad = 1024; src = p.ev_w_out + (size_t)(mat - 2) * DM * DM; dst = p.WT + WT_EVOUT(mat - 2); }
                else if (mat < 6) { N = ODW; Npad = ODW; src = p.od_w_in + (size_t)(mat - 4) * DM * ODW; dst = p.WT + WT_ODIN(mat - 4); }
                else if (mat < 8) { N = 1024; Npad = 1024; src = p.od_w_out + (size_t)(mat - 6) * DM * DM; dst = p.WT + WT_ODOUT(mat - 6); }
                else { N = 2048; Npad = 2048; src = p.pr_w_q + (size_t)(mat - 8) * DM * 2048; dst = p.WT + WT_PQ(mat - 8); }
                const int nt = 16 * (Npad / 64);
                if (it < nt) break;
                it -= nt;
            }
            const int k0 = (it & 15) * 64, n0 = (it >> 4) * 64;
            __syncthreads();
#pragma unroll
            for (int rep = 0; rep < 4; ++rep) {
                const int i = (tid >> 4) + 16 * rep, c4 = (tid & 15) * 4;
                float4 v = make_float4(0.f, 0.f, 0.f, 0.f);
                int sc = n0 + c4;
                if (mat < 2) sc = sc < 1536 ? sc : (sc < 3072 ? sc + 16 : (sc < 3088 ? sc - 3072 + 1536 : N));
                if (sc < N) v = *(const float4*)(src + (size_t)(k0 + i) * N + sc);
                tile[i][c4] = v.x; tile[i][c4 + 1] = v.y; tile[i][c4 + 2] = v.z; tile[i][c4 + 3] = v.w;
            }
            __syncthreads();
            {
                const int n = tid >> 2, kq = (tid & 3) * 16;
                unsigned w[8];
#pragma unroll
                for (int e = 0; e < 8; ++e) w[e] = cvt_pk_bf16(tile[kq + 2 * e][n], tile[kq + 2 * e + 1][n]);
                uint4* dp = (uint4*)(dst + (size_t)(n0 + n) * DM + k0 + kq);
                dp[0] = make_uint4(w[0], w[1], w[2], w[3]); dp[1] = make_uint4(w[4], w[5], w[6], w[7]);
            }
        }
    }
    quant_rows_i4(p.pr_u, p.U8, p.USC, 4 * 16384);
    quant_rows_i4(p.pr_v, p.V8, p.VSC, 4 * 16384);
    cvt_copy_bf16(p.pr_keys, p.KB, (size_t)4 * 8 * 2 * 128 * 128);
}

__device__ void ph_normmod_q(const P& p, const float* g, const float* modv_layer, int nrows) {
    const int lane = otid() & 63, wid = __builtin_amdgcn_readfirstlane(otid() >> 6);
    for (int r = blockIdx.x * 4 + wid; r < nrows; r += gridDim.x * 4) {
        const float4* s4 = (const float4*)(p.H + (size_t)r * DM);
        float4 v[4]; float ss = 0.f;
#pragma unroll
        for (int i = 0; i < 4; ++i) { v[i] = s4[i * 64 + lane]; ss += v[i].x * v[i].x + v[i].y * v[i].y + v[i].z * v[i].z + v[i].w * v[i].w; }
        ss = wave_sum(ss);
        const float rstd = rsqrtf(ss * (1.0f / DM) + 1e-6f);
        const float* mv = modv_layer + (size_t)modrow(r) * 6144;
        float4 o[4]; float mx = 0.f;
#pragma unroll
        for (int i = 0; i < 4; ++i) {
            const int c = (i * 64 + lane) * 4;
            const float4 gg = *(const float4*)(g + c), sh = *(const float4*)(mv + 3072 + c), scl = *(const float4*)(mv + 4096 + c);
            o[i].x = v[i].x * rstd * gg.x * (1.f + scl.x) + sh.x; o[i].y = v[i].y * rstd * gg.y * (1.f + scl.y) + sh.y;
            o[i].z = v[i].z * rstd * gg.z * (1.f + scl.z) + sh.z; o[i].w = v[i].w * rstd * gg.w * (1.f + scl.w) + sh.w;
            mx = fmaxf(mx, fmaxf(fmaxf(fabsf(o[i].x), fabsf(o[i].y)), fmaxf(fabsf(o[i].z), fabsf(o[i].w))));
        }
        mx = wave_max(mx);
        const float inv = mx > 0.f ? 127.f / mx : 0.f;
        uint2* xn = (uint2*)(p.XN + (size_t)r * DM);
        unsigned* xq = (unsigned*)(p.XQ + (size_t)r * DM);
#pragma unroll
        for (int i = 0; i < 4; ++i) {
            xn[i * 64 + lane] = make_uint2(cvt_pk_bf16(o[i].x, o[i].y), cvt_pk_bf16(o[i].z, o[i].w));
            xq[i * 64 + lane] = pack_i8x4(o[i].x * inv, o[i].y * inv, o[i].z * inv, o[i].w * inv);
        }
        if (lane == 0) p.XS[r] = mx * (1.f / 127.f);
    }
}

__device__ void cvt_copy_bf16(const float* src, bf16_t* dst, size_t n) {
    const size_t n8 = n / 8;
    for (size_t i = (size_t)blockIdx.x * 256 + otid(); i < n8; i += (size_t)gridDim.x * 256) {
        const float4 a = ((const float4*)src)[2 * i], b = ((const float4*)src)[2 * i + 1];
        ((uint4*)dst)[i] = make_uint4(cvt_pk_bf16(a.x, a.y), cvt_pk_bf16(a.z, a.w), cvt_pk_bf16(b.x, b.y), cvt_pk_bf16(b.z, b.w));
    }
}

__device__ __forceinline__ unsigned lvl4(float x) { int i = (int)floorf(x) + 8; i = i < 0 ? 0 : (i > 15 ? 15 : i); return (unsigned)i; }
__device__ void quant_rows_i4(const float* src, unsigned char* dst, float* scl, int nrows) {
    const int lane = otid() & 63, wid = __builtin_amdgcn_readfirstlane(otid() >> 6);
    for (int r = blockIdx.x * 4 + wid; r < nrows; r += gridDim.x * 4) {
        const float4* sp = (const float4*)(src + (size_t)r * 1024);
        float4 v[4]; float mx = 0.f, ss = 0.f;
#pragma unroll
        for (int i = 0; i < 4; ++i) {
            v[i] = sp[i * 64 + lane]; mx = fmaxf(mx, fmaxf(fmaxf(fabsf(v[i].x), fabsf(v[i].y)), fmaxf(fabsf(v[i].z), fabsf(v[i].w))));
            ss += v[i].x * v[i].x + v[i].y * v[i].y + v[i].z * v[i].z + v[i].w * v[i].w;
        }
        mx = wave_max(mx); ss = wave_sum(ss);
        const float step = fmaxf(0.3352f * sqrtf(ss * (1.f / 1024.f)), mx * (1.f / 16.f));
        const float inv = step > 0.f ? 1.f / step : 0.f;
        unsigned* dp = (unsigned*)(dst + (size_t)r * 512);
#pragma unroll
        for (int i = 0; i < 4; ++i) {
            unsigned n = lvl4(v[i].x * inv) | (lvl4(v[i].y * inv) << 8) | (lvl4(v[i].z * inv) << 16) | (lvl4(v[i].w * inv) << 24);
            if (lane & 1) n = (n ^ 0x08080808u) << 4;
            n |= (unsigned)__builtin_amdgcn_update_dpp(0, (int)n, 0xB1, 0xF, 0xF, true);
            if (!(lane & 1)) dp[i * 32 + (lane >> 1)] = n;
        }
        if (lane == 0) scl[r] = step;
    }
}

__device__ void ph_normmod(const float* src, const float* g, const float* modv_layer, int shift_off, int scale_off, bf16_t* dst, int nrows) {
    const int lane = otid() & 63, wid = otid() >> 6;
    for (int r = blockIdx.x * 4 + wid; r < nrows; r += gridDim.x * 4) {
        const float4* s4 = (const float4*)(src + (size_t)r * DM);
        float4 v[4]; float ss = 0.f;
#pragma unroll
        for (int i = 0; i < 4; ++i) { v[i] = s4[i * 64 + lane]; ss += v[i].x * v[i].x + v[i].y * v[i].y + v[i].z * v[i].z + v[i].w * v[i].w; }
        ss = wave_sum(ss);
        const float rstd = rsqrtf(ss * (1.0f / DM) + 1e-6f);
        const float* mv = modv_layer + (size_t)modrow(r) * 6144;
        uint2* d2 = (uint2*)(dst + (size_t)r * DM);
#pragma unroll
        for (int i = 0; i < 4; ++i) {
            const int c = (i * 64 + lane) * 4;
            const float4 gg = *(const float4*)(g + c), sh = *(const float4*)(mv + shift_off + c), scl = *(const float4*)(mv + scale_off + c);
            float4 o;
            o.x = v[i].x * rstd * gg.x * (1.f + scl.x) + sh.x; o.y = v[i].y * rstd * gg.y * (1.f + scl.y) + sh.y;
            o.z = v[i].z * rstd * gg.z * (1.f + scl.z) + sh.z; o.w = v[i].w * rstd * gg.w * (1.f + scl.w) + sh.w;
            d2[i * 64 + lane] = make_uint2(cvt_pk_bf16(o.x, o.y), cvt_pk_bf16(o.z, o.w));
        }
    }
}

__device__ void ph_final(const P& p) {
    const int lane = otid() & 63, wid = otid() >> 6;
    for (int r = blockIdx.x * 4 + wid; r < NL; r += gridDim.x * 4) {
        const float4* s4 = (const float4*)(p.H + (size_t)r * DM);
        float4 v[4]; float ss = 0.f;
#pragma unroll
        for (int i = 0; i < 4; ++i) { v[i] = s4[i * 64 + lane]; ss += v[i].x * v[i].x + v[i].y * v[i].y + v[i].z * v[i].z + v[i].w * v[i].w; }
        ss = wave_sum(ss);
        const float rstd = rsqrtf(ss * (1.0f / DM) + 1e-6f);
        float4* d4 = (float4*)(p.out + (size_t)r * DM);
#pragma unroll
        for (int i = 0; i < 4; ++i) {
            const int c = (i * 64 + lane) * 4; const float4 gg = *(const float4*)(p.final_g + c);
            float4 o; o.x = v[i].x * rstd * gg.x; o.y = v[i].y * rstd * gg.y; o.z = v[i].z * rstd * gg.z; o.w = v[i].w * rstd * gg.w;
            d4[i * 64 + lane] = o;
        }
    }
}

#define GL_ROWB 144
#define GL_TILEB (128 * GL_ROWB)
struct TokPos { int b, pos, kpos; bool lat; };
__device__ __forceinline__ TokPos tokpos(int row) {
    TokPos t; t.lat = row < NL;
    if (t.lat) { t.b = row >> 11; t.pos = row & 2047; t.kpos = 256 + t.pos; } else { const int r = row - NL; t.b = r >> 8; t.pos = r & 255; t.kpos = t.pos; }
    return t;
}
struct EpiStoreBF16 {
    bf16_t* C; int ldc;
    __device__ __forceinline__ bool swapped(int) const { return false; }
    __device__ __forceinline__ void operator()(const f32x4 (&acc)[4][4], int m0, int n0, int wm, int wn, int fr, int fq) const {
#pragma unroll
        for (int mi = 0; mi < 4; ++mi)
#pragma unroll
            for (int ni = 0; ni < 4; ++ni) {
                const f32x4 v = acc[ni][mi];
                *(uint2*)(C + (size_t)(m0 + wm * 64 + mi * 16 + fr) * ldc + n0 + wn * 64 + ni * 16 + fq * 4) = make_uint2(cvt_pk_bf16(v[0], v[1]), cvt_pk_bf16(v[2], v[3]));
            }
    }
};
struct EpiResid {
    float* H; const float* gate; float scale;
    __device__ __forceinline__ bool swapped(int) const { return false; }
    __device__ __forceinline__ void operator()(const f32x4 (&acc)[4][4], int m0, int n0, int wm, int wn, int fr, int fq) const {
#pragma unroll
        for (int mi = 0; mi < 4; ++mi) {
            const int row = m0 + wm * 64 + mi * 16 + fr;
            const float* gp = gate + (size_t)modrow(row) * 6144;
#pragma unroll
            for (int ni = 0; ni < 4; ++ni) {
                const int col = n0 + wn * 64 + ni * 16 + fq * 4;
                const f32x4 g = *(const f32x4*)(gp + col);
                f32x4* hp = (f32x4*)(H + (size_t)row * DM + col);
                *hp = *hp + g * acc[ni][mi] * scale;
            }
        }
    }
};
__device__ __forceinline__ void rope_store64(const f32x4 (&acc)[4][4], int mi, bool do_rope, const float* ropep  , float scale, bf16_t* dst  , int fq) {
#pragma unroll
    for (int ni = 0; ni < 2; ++ni) {
        f32x4 x1 = acc[ni][mi], x2 = acc[ni + 2][mi];
        if (do_rope) {
            const f32x4 r0 = *(const f32x4*)(ropep + (ni * 16 + fq * 4) * 2), r1 = *(const f32x4*)(ropep + (ni * 16 + fq * 4) * 2 + 4);
            const f32x4 cs = (f32x4){r0[0], r0[2], r1[0], r1[2]}, sn = (f32x4){r0[1], r0[3], r1[1], r1[3]};
            const f32x4 y1 = x1 * cs - x2 * sn, y2 = x1 * sn + x2 * cs;
            x1 = y1; x2 = y2;
        }
        x1 = x1 * scale; x2 = x2 * scale;
        *(uint2*)(dst + ni * 16 + fq * 4) = make_uint2(cvt_pk_bf16(x1[0], x1[1]), cvt_pk_bf16(x1[2], x1[3]));
        *(uint2*)(dst + 32 + ni * 16 + fq * 4) = make_uint2(cvt_pk_bf16(x2[0], x2[1]), cvt_pk_bf16(x2[2], x2[3]));
    }
}
struct EpiEven {
    bf16_t *PB, *AQL, *AQC, *AK, *AV; float* GT; const float* rope;
    __device__ __forceinline__ bool swapped(int n0) const { return n0 >= 2560 && n0 < 3072; }
    __device__ __forceinline__ void operator()(const f32x4 (&acc)[4][4], int m0, int n0, int wm, int wn, int fr, int fq) const {
        const int t = n0 >> 7;
        if (t < 12) {
#pragma unroll
            for (int mi = 0; mi < 4; ++mi)
#pragma unroll
                for (int ni = 0; ni < 4; ++ni) {
                    const f32x4 v = acc[ni][mi];
                    *(uint2*)(PB + (size_t)(m0 + wm * 64 + mi * 16 + fr) * 1536 + n0 + wn * 64 + ni * 16 + fq * 4) = make_uint2(cvt_pk_bf16(v[0], v[1]), cvt_pk_bf16(v[2], v[3]));
                }
        } else if (t < 20) {
            const bool isq = t < 16; const int h = t & 3;
#pragma unroll
            for (int mi = 0; mi < 4; ++mi) {
                const TokPos tp = tokpos(m0 + wm * 64 + mi * 16 + fr);
                const int hm = (tp.b * 4 + h) * 2 + wn;
                bf16_t* dst;
                if (isq) dst = tp.lat ? AQL + ((size_t)hm * 2048 + tp.pos) * 64 : AQC + ((size_t)hm * 256 + tp.pos) * 64;
                else dst = AK + ((size_t)hm * 2304 + tp.kpos) * 64;
                rope_store64(acc, mi, tp.lat, rope + (size_t)tp.pos * 64, isq ? QSCALE : 1.0f, dst, fq);
            }
        } else if (t < 24) {
            const int h = t - 20;
#pragma unroll
            for (int mi = 0; mi < 4; ++mi) {
                const TokPos tp = tokpos(m0 + wm * 64 + mi * 16 + fq * 4);
#pragma unroll
                for (int ni = 0; ni < 4; ++ni) {
                    const f32x4 v = acc[ni][mi];
                    const int d = wn * 64 + ni * 16 + fr;
                    *(uint2*)(AV + ((size_t)(tp.b * 4 + h) * 128 + d) * 2304 + tp.kpos) = make_uint2(cvt_pk_bf16(v[0], v[1]), cvt_pk_bf16(v[2], v[3]));
                }
            }
        } else {
            if (wn == 0) {
#pragma unroll
                for (int mi = 0; mi < 4; ++mi) *(f32x4*)(GT + (size_t)(m0 + wm * 64 + mi * 16 + fr) * 16 + fq * 4) = acc[0][mi];
            }
        }
    }
};
struct EpiOdd {
    bf16_t *AQL, *AQC, *AK, *AV; const float* rope;
    __device__ __forceinline__ bool swapped(int n0) const { return n0 >= 1280; }
    __device__ __forceinline__ void operator()(const f32x4 (&acc)[4][4], int m0, int n0, int wm, int wn, int fr, int fq) const {
        const int t = n0 >> 7;
        if (t < 10) {
            const bool isq = t < 8; const int hd = isq ? t * 2 + wn : (t - 8) * 2 + wn;
#pragma unroll
            for (int mi = 0; mi < 4; ++mi) {
                const TokPos tp = tokpos(m0 + wm * 64 + mi * 16 + fr);
                bf16_t* dst;
                if (isq) dst = tp.lat ? AQL + ((size_t)(tp.b * 16 + hd) * 2048 + tp.pos) * 64 : AQC + ((size_t)(tp.b * 16 + hd) * 256 + tp.pos) * 64;
                else dst = AK + ((size_t)(tp.b * 4 + hd) * 2304 + tp.kpos) * 64;
                rope_store64(acc, mi, tp.lat, rope + (size_t)tp.pos * 64, isq ? QSCALE : 1.0f, dst, fq);
            }
        } else {
            const int hkv = (t - 10) * 2 + wn;
#pragma unroll
            for (int mi = 0; mi < 4; ++mi) {
                const TokPos tp = tokpos(m0 + wm * 64 + mi * 16 + fq * 4);
#pragma unroll
                for (int ni = 0; ni < 4; ++ni) {
                    const f32x4 v = acc[ni][mi];
                    const int d = ni * 16 + fr;
                    *(uint2*)(AV + ((size_t)(tp.b * 4 + hkv) * 64 + d) * 2304 + tp.kpos) = make_uint2(cvt_pk_bf16(v[0], v[1]), cvt_pk_bf16(v[2], v[3]));
                }
            }
        }
    }
};
#define LDS_AS __attribute__((address_space(3)))
template <bool SWAP>
__device__ __forceinline__ void gemm_tile_kloop(f32x4 (&acc)[4][4], const bf16_t* aub, const bf16_t* bub, char* smem, int lrow, int lch, int wm, int wn, int fr, int fq) {
    const int tid = lrow * 8 + lch, wid = tid >> 6, lane = tid & 63;
    const int srow = wid * 8 + (lane >> 3);
    const unsigned goff = (unsigned)(srow * DM + (((lane & 7) ^ (srow & 7)) << 3)) * 2u;
#define GL_DMA(BUF, KO) { _Pragma("unroll") for (int i = 0; i < 4; ++i) { \
        __builtin_amdgcn_global_load_lds((const unsigned*)((const char*)aub + ((size_t)(32 * i) * DM + (KO)) * 2 + goff), (LDS_AS unsigned*)((BUF) + (i * 32 + wid * 8) * 128), 16, 0, 0); \
        __builtin_amdgcn_global_load_lds((const unsigned*)((const char*)bub + ((size_t)(32 * i) * DM + (KO)) * 2 + goff), (LDS_AS unsigned*)((BUF) + 16384 + (i * 32 + wid * 8) * 128), 16, 0, 0); } }
    const int xr = fr & 7;
    GL_DMA(smem, 0)
    __syncthreads();
    for (int kt = 0; kt < 16; ++kt) {
        char* cur = smem + (kt & 1) * 32768;
        char* nxt = smem + ((kt + 1) & 1) * 32768;
        if (kt + 1 < 16) GL_DMA(nxt, (kt + 1) * 64)
#pragma unroll
        for (int ks = 0; ks < 2; ++ks) {
            bf16x8 af[4], wf[4];
#pragma unroll
            for (int i = 0; i < 4; ++i) {
                af[i] = *(const bf16x8*)(cur + (wm * 64 + i * 16 + fr) * 128 + (((ks * 4 + fq) ^ xr) << 4));
                wf[i] = *(const bf16x8*)(cur + 16384 + (wn * 64 + i * 16 + fr) * 128 + (((ks * 4 + fq) ^ xr) << 4));
            }
#pragma unroll
            for (int ni = 0; ni < 4; ++ni)
#pragma unroll
                for (int mi = 0; mi < 4; ++mi)
                    acc[ni][mi] = SWAP ? __builtin_amdgcn_mfma_f32_16x16x32_bf16(af[mi], wf[ni], acc[ni][mi], 0, 0, 0)
                                       : __builtin_amdgcn_mfma_f32_16x16x32_bf16(wf[ni], af[mi], acc[ni][mi], 0, 0, 0);
        }
        __syncthreads();
    }
#undef GL_DMA
}
template <class Epi>
__device__ void ph_gemm(const bf16_t* A, const bf16_t* Bt, int M, int Npad, const Epi& epi, char* smem) {
    const int tid = otid(), lane = tid & 63, wid = tid >> 6, wm = wid >> 1, wn = wid & 1;
    const int fr = lane & 15, fq = lane >> 4;
    const int tm = M / 128, tn = Npad / 128, ntiles = tm * tn;
    const int lrow = tid >> 3, lch = tid & 7;
    for (int tile = blockIdx.x; tile < ntiles; tile += gridDim.x) {
        int m0, n0;
        {
            const int q = ntiles >> 3, rr = ntiles & 7, xcd = tile & 7, off = tile >> 3;
            const int w = (xcd < rr ? xcd * (q + 1) : rr * (q + 1) + (xcd - rr) * q) + off;
            const int nig = 8 * tn, gid = w / nig, fm = gid * 8, gsz = (tm - fm) < 8 ? (tm - fm) : 8;
            m0 = (fm + (w % nig) % gsz) * 128; n0 = ((w % nig) / gsz) * 128;
        }
        f32x4 acc[4][4];
#pragma unroll
        for (int a = 0; a < 4; ++a)
#pragma unroll
            for (int b = 0; b < 4; ++b) acc[a][b] = (f32x4){0.f, 0.f, 0.f, 0.f};
        const bf16_t* ap = A + (size_t)m0 * DM;
        const bf16_t* bp = Bt + (size_t)n0 * DM;
        if (epi.swapped(n0)) gemm_tile_kloop<true>(acc, ap, bp, smem, lrow, lch, wm, wn, fr, fq);
        else gemm_tile_kloop<false>(acc, ap, bp, smem, lrow, lch, wm, wn, fr, fq);
        int fr2 = fr, fq2 = fq, wm2 = wm, wn2 = wn;
        asm volatile("" : "+v"(fr2), "+v"(fq2), "+v"(wm2), "+v"(wn2));
        epi(acc, m0, n0, wm2, wn2, fr2, fq2);
    }
}

__device__ void ph_prep_even(const P& p, int j) {
    const float* cw = p.ev_conv_w + (size_t)j * 3 * 512; const float* cb = p.ev_conv_b + (size_t)j * 512;
    const size_t tot = (size_t)NT * 256;
    for (size_t i = (size_t)blockIdx.x * 256 + otid(); i < tot; i += (size_t)gridDim.x * 256) {
        const int r = (int)(i >> 8), c = (int)(i & 255) * 2;
        int t, T; if (r < NL) { t = r & 2047; T = 2048; } else { t = (r - NL) & 255; T = 256; }
        const unsigned x1 = *(const unsigned*)(p.PB + (size_t)r * 1536 + c);
        float v0 = cb[c] + bf_lo(x1) * cw[512 + c], v1 = cb[c + 1] + bf_hi(x1) * cw[512 + c + 1];
        if (t > 0) { const unsigned x0 = *(const unsigned*)(p.PB + (size_t)(r - 1) * 1536 + c); v0 += bf_lo(x0) * cw[c]; v1 += bf_hi(x0) * cw[c + 1]; }
        if (t < T - 1) { const unsigned x2 = *(const unsigned*)(p.PB + (size_t)(r + 1) * 1536 + c); v0 += bf_lo(x2) * cw[1024 + c]; v1 += bf_hi(x2) * cw[1024 + c + 1]; }
        v0 = silu_f(v0); v1 = silu_f(v1);
        if (c >= 256) { v0 *= 0.125f; v1 *= 0.125f; }
        *(unsigned*)(p.QKB + (size_t)r * 512 + c) = cvt_pk_bf16(v0, v1);
    }
}

#define FA_KROW 144
#define FA_VROW 144
__device__ __forceinline__ bf16x8 pack8(float a0, float a1, float a2, float a3, float a4, float a5, float a6, float a7) {
    const u32x4 u = (u32x4){cvt_pk_bf16(a0, a1), cvt_pk_bf16(a2, a3), cvt_pk_bf16(a4, a5), cvt_pk_bf16(a6, a7)};
    return __builtin_bit_cast(bf16x8, u);
}
template <int NDB, bool MASK>
__device__ __forceinline__ void flash_tile(const bf16x8 (&qf)[4], f32x16 (&o)[NDB], float& m, float& l, const char* Kl, const char* Vl, int lane, int qpos, int kp0) {
    const int j = lane & 31, h = lane >> 5;
    f32x16 s0, s1;
#pragma unroll
    for (int i = 0; i < 16; ++i) { s0[i] = 0.f; s1[i] = 0.f; }
#pragma unroll
    for (int ks = 0; ks < 4; ++ks) {
        const bf16x8 a0 = *(const bf16x8*)(Kl + j * FA_KROW + (2 * ks + h) * 16);
        const bf16x8 a1 = *(const bf16x8*)(Kl + (32 + j) * FA_KROW + (2 * ks + h) * 16);
        s0 = __builtin_amdgcn_mfma_f32_32x32x16_bf16(a0, qf[ks], s0, 0, 0, 0);
        s1 = __builtin_amdgcn_mfma_f32_32x32x16_bf16(a1, qf[ks], s1, 0, 0, 0);
    }
    if (MASK) {
#pragma unroll
        for (int r = 0; r < 16; ++r) {
            const int key = (r & 3) + 8 * (r >> 2) + 4 * h;
            const int d0 = qpos - (kp0 + key), d1 = d0 - 32;
            if (d0 > 128 || d0 < -128) s0[r] = -1e30f;
            if (d1 > 128 || d1 < -128) s1[r] = -1e30f;
        }
    }
    float mx = fmaxf(s0[0], s1[0]);
#pragma unroll
    for (int r = 1; r < 16; ++r) mx = fmaxf(mx, fmaxf(s0[r], s1[r]));
    mx = fmaxf(mx, SHX(mx, 32));
    const float mn = fmaxf(m, mx);
    const float alpha = __builtin_amdgcn_exp2f(m - mn);
    m = mn;
    float ls = 0.f;
#pragma unroll
    for (int r = 0; r < 16; ++r) { s0[r] = __builtin_amdgcn_exp2f(s0[r] - mn); s1[r] = __builtin_amdgcn_exp2f(s1[r] - mn); ls += s0[r] + s1[r]; }
    l = l * alpha + ls;
    if (__ballot(alpha != 1.0f)) {
#pragma unroll
        for (int db = 0; db < NDB; ++db) o[db] = o[db] * alpha;
    }
    bf16x8 pb[4];
    pb[0] = pack8(s0[0], s0[1], s0[2], s0[3], s0[4], s0[5], s0[6], s0[7]);
    pb[1] = pack8(s0[8], s0[9], s0[10], s0[11], s0[12], s0[13], s0[14], s0[15]);
    pb[2] = pack8(s1[0], s1[1], s1[2], s1[3], s1[4], s1[5], s1[6], s1[7]);
    pb[3] = pack8(s1[8], s1[9], s1[10], s1[11], s1[12], s1[13], s1[14], s1[15]);
#pragma unroll
    for (int db = 0; db < NDB; ++db)
#pragma unroll
        for (int kk = 0; kk < 4; ++kk) {
            const bf16x8 vf = *(const bf16x8*)(Vl + (db * 32 + j) * FA_VROW + kk * 32 + h * 16);
            o[db] = __builtin_amdgcn_mfma_f32_32x32x16_bf16(vf, pb[kk], o[db], 0, 0, 0);
        }
}

#define DA_BUFB 36864
__device__ void da_block(const P& p, int item, int L, int j, char* smem) {
    const int tid = otid(), lane = tid & 63, wid = tid >> 6, mp = wid & 1, qg = wid >> 1, jq = lane & 31, hh = lane >> 5;
    const bool lat = item < 1024;
    int b, h, qt;
    if (lat) { b = item >> 7; h = (item >> 5) & 3; qt = item & 31; } else { const int it = item - 1024; b = it >> 4; h = (it >> 2) & 3; qt = it & 3; }
    const int qi = qt * 64 + qg * 32 + jq;
    const bf16_t* qp = lat ? p.AQL + ((size_t)((b * 4 + h) * 2 + mp) * 2048 + qi) * 64 : p.AQC + ((size_t)((b * 4 + h) * 2 + mp) * 256 + qi) * 64;
    bf16x8 qf[4];
#pragma unroll
    for (int ks = 0; ks < 4; ++ks) qf[ks] = *(const bf16x8*)(qp + (2 * ks + hh) * 8);
    const int ntile = lat ? 36 : 4;
    const bf16_t* kg = p.AK + (size_t)((b * 4 + h) * 2) * 2304 * 64 + (size_t)(tid >> 3) * 64 + (tid & 7) * 8;
    const bf16_t* vg = p.AV + (size_t)(b * 4 + h) * 128 * 2304 + (size_t)(tid >> 3) * 2304 + (tid & 7) * 8;
    uint4 k0, k1, k2, k3, v0, v1, v2, v3;
#define DA_LOAD(KEY0) { k0 = *(const uint4*)(kg + (size_t)(KEY0) * 64); k1 = *(const uint4*)(kg + (size_t)((KEY0) + 32) * 64); \
                        k2 = *(const uint4*)(kg + (size_t)2304 * 64 + (size_t)(KEY0) * 64); k3 = *(const uint4*)(kg + (size_t)2304 * 64 + (size_t)((KEY0) + 32) * 64); \
                        v0 = *(const uint4*)(vg + (KEY0)); v1 = *(const uint4*)(vg + (size_t)32 * 2304 + (KEY0)); v2 = *(const uint4*)(vg + (size_t)64 * 2304 + (KEY0)); v3 = *(const uint4*)(vg + (size_t)96 * 2304 + (KEY0)); }
#define DA_STORE(BUF) { char* kb_ = (BUF) + (tid >> 3) * FA_KROW + (tid & 7) * 16; \
                        *(uint4*)kb_ = k0; *(uint4*)(kb_ + 32 * FA_KROW) = k1; *(uint4*)(kb_ + 64 * FA_KROW) = k2; *(uint4*)(kb_ + 96 * FA_KROW) = k3; \
                        char* vb_ = (BUF) + 18432 + (tid >> 3) * FA_VROW + ((tid & 7) >> 1) * 32 + (tid & 1) * 8; \
                        *(uint2*)vb_ = make_uint2(v0.x, v0.y); *(uint2*)(vb_ + 16) = make_uint2(v0.z, v0.w); \
                        *(uint2*)(vb_ + 32 * FA_VROW) = make_uint2(v1.x, v1.y); *(uint2*)(vb_ + 32 * FA_VROW + 16) = make_uint2(v1.z, v1.w); \
                        *(uint2*)(vb_ + 64 * FA_VROW) = make_uint2(v2.x, v2.y); *(uint2*)(vb_ + 64 * FA_VROW + 16) = make_uint2(v2.z, v2.w); \
                        *(uint2*)(vb_ + 96 * FA_VROW) = make_uint2(v3.x, v3.y); *(uint2*)(vb_ + 96 * FA_VROW + 16) = make_uint2(v3.z, v3.w); }
    f32x16 o[4];
#pragma unroll
    for (int db = 0; db < 4; ++db)
#pragma unroll
        for (int i = 0; i < 16; ++i) o[db][i] = 0.f;
    float m = -1e30f, l = 0.f;
    DA_LOAD(0)
    __syncthreads();
    DA_STORE(smem)
    __syncthreads();
    for (int t = 0; t < ntile; ++t) {
        char* cur = smem + (t & 1) * DA_BUFB;
        char* nxt = smem + ((t + 1) & 1) * DA_BUFB;
        if (t + 1 < ntile) DA_LOAD((t + 1) * 64)
        flash_tile<4, false>(qf, o, m, l, cur + mp * 9216, cur + 18432, lane, 0, 0);
        if (t + 1 < ntile) DA_STORE(nxt)
        __syncthreads();
    }
#undef DA_LOAD
#undef DA_STORE
    const float inv = 1.f / (l + SHX(l, 32));
#pragma unroll
    for (int db = 0; db < 4; ++db) o[db] = o[db] * inv;
    float* X = (float*)smem + qg * 4096;
    if (mp == 1) {
#pragma unroll
        for (int db = 0; db < 4; ++db)
#pragma unroll
            for (int r = 0; r < 16; ++r) X[(db * 32 + (r & 3) + 8 * (r >> 2) + 4 * hh) * 32 + jq] = o[db][r];
    }
    __syncthreads();
    if (mp == 0) {
        const float lam_init = 0.8f - 0.6f * expf(-0.3f * (float)L);
        const float* lp = p.ev_da_lam + (size_t)j * 256;
        float a0 = lp[lane] * lp[64 + lane], a1 = lp[128 + lane] * lp[192 + lane];
        a0 = wave_sum(a0); a1 = wave_sum(a1);
        const float lam = expf(a0) - expf(a1) + lam_init;
        float ss = 0.f;
#pragma unroll
        for (int db = 0; db < 4; ++db)
#pragma unroll
            for (int r = 0; r < 16; ++r) { const float v = o[db][r] - lam * X[(db * 32 + (r & 3) + 8 * (r >> 2) + 4 * hh) * 32 + jq]; o[db][r] = v; ss += v * v; }
        ss += SHX(ss, 32);
        const float sc = rsqrtf(ss * (1.f / 128.f) + 1e-6f) * (1.f - lam_init);
        const int row = lat ? b * 2048 + qi : NL + b * 256 + qi;
        bf16_t* mrow = p.MIX + (size_t)row * DM + 512 + h * 128;
        const float* g = p.ev_da_g + (size_t)j * 512 + h * 128;
#pragma unroll
        for (int db = 0; db < 4; ++db)
#pragma unroll
            for (int r4 = 0; r4 < 4; ++r4) {
                const int d = db * 32 + 8 * r4 + 4 * hh;
                const f32x4 gg = *(const f32x4*)(g + d);
                *(uint2*)(mrow + d) = make_uint2(cvt_pk_bf16(o[db][r4 * 4 + 0] * sc * gg[0], o[db][r4 * 4 + 1] * sc * gg[1]), cvt_pk_bf16(o[db][r4 * 4 + 2] * sc * gg[2], o[db][r4 * 4 + 3] * sc * gg[3]));
            }
    }
    __syncthreads();
}

#define WA_BUFB 18432
__device__ void wa_block(const P& p, int item, int j, char* smem) {
    const int tid = otid(), lane = tid & 63, wid = tid >> 6, jq = lane & 31, hh = lane >> 5;
    const bool lat = item < 2048;
    int b, nb, hq;
    if (lat) { hq = item & 15; nb = (item >> 4) & 15; b = item >> 8; } else { const int it = item - 2048; hq = it & 15; nb = (it >> 4) & 1; b = it >> 5; }
    const int hkv = hq >> 2;
    const int qi = nb * 128 + wid * 32 + jq;
    const bf16_t* qp = lat ? p.AQL + ((size_t)(b * 16 + hq) * 2048 + qi) * 64 : p.AQC + ((size_t)(b * 16 + hq) * 256 + qi) * 64;
    bf16x8 qf[4];
#pragma unroll
    for (int ks = 0; ks < 4; ++ks) qf[ks] = *(const bf16x8*)(qp + (2 * ks + hh) * 8);
    const int lfirst = (nb == 0) ? 2 : 0, nloc = lat ? 6 - lfirst - ((nb == 15) ? 2 : 0) : 0;
    const int ntile = 4 + nloc;
    const bf16_t* kg = p.AK + (size_t)(b * 4 + hkv) * 2304 * 64 + (size_t)(tid >> 3) * 64 + (tid & 7) * 8;
    const bf16_t* vg = p.AV + (size_t)(b * 4 + hkv) * 64 * 2304 + (size_t)(tid >> 3) * 2304 + (tid & 7) * 8;
    uint4 k0, k1, v0, v1;
#define WA_KEY0(T) ((T) < 4 ? (T) * 64 : 256 + (nb - 1) * 128 + ((T) - 4 + lfirst) * 64)
#define WA_LOAD(KEY0) { k0 = *(const uint4*)(kg + (size_t)(KEY0) * 64); k1 = *(const uint4*)(kg + (size_t)((KEY0) + 32) * 64); v0 = *(const uint4*)(vg + (KEY0)); v1 = *(const uint4*)(vg + (size_t)32 * 2304 + (KEY0)); }
#define WA_STORE(BUF) { char* kb_ = (BUF) + (tid >> 3) * FA_KROW + (tid & 7) * 16; *(uint4*)kb_ = k0; *(uint4*)(kb_ + 32 * FA_KROW) = k1; \
                        char* vb_ = (BUF) + 9216 + (tid >> 3) * FA_VROW + ((tid & 7) >> 1) * 32 + (tid & 1) * 8; \
                        *(uint2*)vb_ = make_uint2(v0.x, v0.y); *(uint2*)(vb_ + 16) = make_uint2(v0.z, v0.w); \
                        *(uint2*)(vb_ + 32 * FA_VROW) = make_uint2(v1.x, v1.y); *(uint2*)(vb_ + 32 * FA_VROW + 16) = make_uint2(v1.z, v1.w); }
    f32x16 o[2];
#pragma unroll
    for (int db = 0; db < 2; ++db)
#pragma unroll
        for (int i = 0; i < 16; ++i) o[db][i] = 0.f;
    float m = p.od_sink[j * 16 + hq] * 1.4426950408889634f, l = hh == 0 ? 1.f : 0.f;
    { const int key0 = WA_KEY0(0); WA_LOAD(key0) }
    __syncthreads();
    WA_STORE(smem)
    __syncthreads();
    for (int t = 0; t < ntile; ++t) {
        char* cur = smem + (t & 1) * WA_BUFB;
        char* nxt = smem + ((t + 1) & 1) * WA_BUFB;
        if (t + 1 < ntile) { const int key0 = WA_KEY0(t + 1); WA_LOAD(key0) }
        if (t < 4) flash_tile<2, false>(qf, o, m, l, cur, cur + 9216, lane, 0, 0);
        else flash_tile<2, true>(qf, o, m, l, cur, cur + 9216, lane, qi, WA_KEY0(t) - 256);
        if (t + 1 < ntile) WA_STORE(nxt)
        __syncthreads();
    }
#undef WA_LOAD
#undef WA_STORE
#undef WA_KEY0
    const float inv = 1.f / (l + SHX(l, 32));
    const int row = lat ? b * 2048 + qi : NL + b * 256 + qi;
    bf16_t* mrow = p.MIX + (size_t)row * DM + hq * 64;
#pragma unroll
    for (int db = 0; db < 2; ++db)
#pragma unroll
        for (int r4 = 0; r4 < 4; ++r4) {
            const int d = db * 32 + 8 * r4 + 4 * hh;
            *(uint2*)(mrow + d) = make_uint2(cvt_pk_bf16(o[db][r4 * 4 + 0] * inv, o[db][r4 * 4 + 1] * inv), cvt_pk_bf16(o[db][r4 * 4 + 2] * inv, o[db][r4 * 4 + 3] * inv));
        }
}

__device__ __forceinline__ uint4 ml_conv8(const P& p, int j, int b, int tc, int st, int c0) {
    const int row = tc < 4 ? NL + b * 256 + tc * 64 + st : b * 2048 + (tc - 4) * 64 + st;
    const int t = tc < 4 ? tc * 64 + st : (tc - 4) * 64 + st, T = tc < 4 ? 256 : 2048;
    const float* cw = p.ev_conv_w + (size_t)j * 3 * 512 + c0; const float* cb = p.ev_conv_b + (size_t)j * 512 + c0;
    const uint4 x1 = *(const uint4*)(p.PB + (size_t)row * 1536 + c0);
    uint4 x0 = make_uint4(0u, 0u, 0u, 0u), x2 = x0;
    if (t > 0) x0 = *(const uint4*)(p.PB + (size_t)(row - 1) * 1536 + c0);
    if (t < T - 1) x2 = *(const uint4*)(p.PB + (size_t)(row + 1) * 1536 + c0);
    float a[8], bq[8], cq[8]; unpack8(x0, a); unpack8(x1, bq); unpack8(x2, cq);
    const float sc = c0 >= 256 ? 0.125f : 1.f;
    float o[8];
#pragma unroll
    for (int q = 0; q < 8; ++q) o[q] = silu_f(cb[q] + a[q] * cw[q] + bq[q] * cw[512 + q] + cq[q] * cw[1024 + q]) * sc;
    return make_uint4(cvt_pk_bf16(o[0], o[1]), cvt_pk_bf16(o[2], o[3]), cvt_pk_bf16(o[4], o[5]), cvt_pk_bf16(o[6], o[7]));
}
__device__ __forceinline__ int ml_row(int b, int tc, int i) { return tc < 4 ? NL + b * 256 + tc * 64 + i : b * 2048 + (tc - 4) * 64 + i; }
__device__ __forceinline__ void ml_gates(const P& p, int j, int b, int h, int dir, int tc, int lane, float* sa, float* sb, float* sml, float& Bt, float& Mc) {
    const int row = ml_row(b, tc, lane);
    const float ig = p.GT[(size_t)row * 16 + (dir * 2) * 4 + h] + p.ev_gate_b[j * 16 + (dir * 2) * 4 + h];
    const float lf = log_sigmoid_f(p.GT[(size_t)row * 16 + (dir * 2 + 1) * 4 + h] + p.ev_gate_b[j * 16 + (dir * 2 + 1) * 4 + h]);
    float bc = lf;
    if (dir == 0) {
#pragma unroll
        for (int o = 1; o < 64; o <<= 1) { const float t2 = lshfl(bc, lane - o); if (lane >= o) bc += t2; }
    } else {
#pragma unroll
        for (int o = 1; o < 64; o <<= 1) { const float t2 = lshfl(bc, lane + o); if (lane + o < 64) bc += t2; }
    }
    const float a = ig - bc;
    float ml = a;
    if (dir == 0) {
#pragma unroll
        for (int o = 1; o < 64; o <<= 1) { const float t2 = lshfl(ml, lane - o); if (lane >= o) ml = fmaxf(ml, t2); }
    } else {
#pragma unroll
        for (int o = 1; o < 64; o <<= 1) { const float t2 = lshfl(ml, lane + o); if (lane + o < 64) ml = fmaxf(ml, t2); }
    }
    sa[lane] = a; sb[lane] = bc; sml[lane] = ml;
    const int last = dir == 0 ? 63 : 0;
    Bt = lshfl(bc, last); Mc = lshfl(ml, last);
}
__device__ __forceinline__ int ml_tc_of(int dir, int c) { return dir == 0 ? c : (c < 4 ? 3 - c : 39 - c); }
__device__ __forceinline__ int ml_c_of(int dir, int tc) { return dir == 0 ? tc : (tc < 4 ? 3 - tc : 39 - tc); }

__device__ void ml_pass1_item(const P& p, int item, int j, char* smem) {
    const int c = item % 36, dir = (item / 36) & 1, h = (item / 72) & 3, b = item / 288;
    const int tc = ml_tc_of(dir, c);
    const int tid = otid(), lane = tid & 63, wid = tid >> 6, jl = lane & 31, hh = lane >> 5;
    bf16_t* VT = (bf16_t*)smem;
    bf16_t* KWT = (bf16_t*)(smem + 18432);
    float* sa = (float*)(smem + 27648);
    float* sb = sa + 64; float* sml = sb + 64; float* sw = sml + 64; float* ssc = sw + 64;
    __syncthreads();
    if (wid == 0) {
        float Bt, Mc; ml_gates(p, j, b, h, dir, tc, lane, sa, sb, sml, Bt, Mc);
        sw[lane] = expf(sa[lane] - Mc);
        if (lane == 0) { p.CHB[item] = Bt; p.CHM[item] = Mc; }
    }
    __syncthreads();
#pragma unroll
    for (int i = 0; i < 4; ++i) {
        const int e = tid + 256 * i, st = e >> 4, ch = e & 15;
        const uint4 u = *(const uint4*)(p.PB + (size_t)ml_row(b, tc, st) * 1536 + 512 + h * 128 + ch * 8);
        bf16_t* d = VT + (ch * 8) * 72 + st;
        d[0] = (bf16_t)u.x; d[72] = (bf16_t)(u.x >> 16); d[144] = (bf16_t)u.y; d[216] = (bf16_t)(u.y >> 16);
        d[288] = (bf16_t)u.z; d[360] = (bf16_t)(u.z >> 16); d[432] = (bf16_t)u.w; d[504] = (bf16_t)(u.w >> 16);
    }
#pragma unroll
    for (int i = 0; i < 2; ++i) {
        const int e = tid + 256 * i, st = e >> 3, ch = e & 7;
        const uint4 u = ml_conv8(p, j, b, tc, st, 256 + h * 64 + ch * 8);
        const float w = sw[st];
        bf16_t* d = KWT + (ch * 8) * 72 + st;
        const unsigned q0 = cvt_pk_bf16(bf_lo(u.x) * w, bf_hi(u.x) * w), q1 = cvt_pk_bf16(bf_lo(u.y) * w, bf_hi(u.y) * w), q2 = cvt_pk_bf16(bf_lo(u.z) * w, bf_hi(u.z) * w), q3 = cvt_pk_bf16(bf_lo(u.w) * w, bf_hi(u.w) * w);
        d[0] = (bf16_t)q0; d[72] = (bf16_t)(q0 >> 16); d[144] = (bf16_t)q1; d[216] = (bf16_t)(q1 >> 16);
        d[288] = (bf16_t)q2; d[360] = (bf16_t)(q2 >> 16); d[432] = (bf16_t)q3; d[504] = (bf16_t)(q3 >> 16);
    }
    __syncthreads();
    {
        const int db = wid & 1, vb0 = (wid >> 1) * 2;
        bf16x8 kf[4];
#pragma unroll
        for (int ks = 0; ks < 4; ++ks) kf[ks] = *(const bf16x8*)((const char*)KWT + (db * 32 + jl) * 144 + (2 * ks + hh) * 16);
        float* cl = p.CLOC + (size_t)item * 8192;
#pragma unroll
        for (int vv = 0; vv < 2; ++vv) {
            const int vb = vb0 + vv;
            f32x16 acc;
#pragma unroll
            for (int r = 0; r < 16; ++r) acc[r] = 0.f;
#pragma unroll
            for (int ks = 0; ks < 4; ++ks) {
                const bf16x8 vf = *(const bf16x8*)((const char*)VT + (vb * 32 + jl) * 144 + (2 * ks + hh) * 16);
                acc = __builtin_amdgcn_mfma_f32_32x32x16_bf16(vf, kf[ks], acc, 0, 0, 0);
            }
#pragma unroll
            for (int r = 0; r < 16; ++r) cl[(size_t)(vb * 32 + (r & 3) + 8 * (r >> 2) + 4 * hh) * 64 + db * 32 + jl] = acc[r];
        }
        if (tid < 64) {
            float sum = 0.f;
#pragma unroll
            for (int q = 0; q < 8; ++q) { const uint4 u = *(const uint4*)((const char*)KWT + tid * 144 + q * 16); sum += bf_lo(u.x) + bf_hi(u.x) + bf_lo(u.y) + bf_hi(u.y) + bf_lo(u.z) + bf_hi(u.z) + bf_lo(u.w) + bf_hi(u.w); }
            p.NLOC[(size_t)item * 64 + tid] = sum;
        }
    }
}

__device__ void ph_ml_pass2(const P& p) {
    const int gt = blockIdx.x * 256 + otid(), nthr = gridDim.x * 256;
    for (int w = gt; w < 64 * 2048; w += nthr) {
        const int chain = w >> 11, e = (w & 2047) * 4;
        float c0 = 0.f, c1 = 0.f, c2 = 0.f, c3 = 0.f, m = 0.f;
        for (int c = 0; c < 36; ++c) {
            const int it = chain * 36 + c;
            *(uint2*)(p.CST + (size_t)it * 8192 + e) = make_uint2(cvt_pk_bf16(c0, c1), cvt_pk_bf16(c2, c3));
            const float Bt = p.CHB[it], Mc = p.CHM[it];
            const float g = fmaxf(m, Mc), al = expf(m - g), be = expf(Mc - g);
            const float4 cl = *(const float4*)(p.CLOC + (size_t)it * 8192 + e);
            c0 = al * c0 + be * cl.x; c1 = al * c1 + be * cl.y; c2 = al * c2 + be * cl.z; c3 = al * c3 + be * cl.w;
            m = Bt + g;
        }
    }
    for (int w = gt; w < 64 * 64; w += nthr) {
        const int chain = w >> 6, d = w & 63;
        float n = 0.f, m = 0.f;
        for (int c = 0; c < 36; ++c) {
            const int it = chain * 36 + c;
            p.NST[(size_t)it * 64 + d] = n;
            if (d == 0) p.MST[it] = m;
            const float Bt = p.CHB[it], Mc = p.CHM[it];
            const float g = fmaxf(m, Mc);
            n = expf(m - g) * n + expf(Mc - g) * p.NLOC[(size_t)it * 64 + d];
            m = Bt + g;
        }
    }
}

__device__ void ml_pass3_item(const P& p, int item, int j, char* smem) {
    const int tc = item % 36, h = (item / 36) & 3, b = item / 144;
    const int tid = otid(), lane = tid & 63, wid = tid >> 6, jl = lane & 31, hh = lane >> 5, tb = wid & 1, dir = wid >> 1;
    char* Ql = smem;
    char* Kl = smem + 9216;
    bf16_t* VT = (bf16_t*)(smem + 18432);
    float* gs = (float*)(smem + 35840);
    float* ssc = gs + 512;
    __syncthreads();
    if (wid < 2) {
        const int d2 = wid; float Bt, Mc;
        float* sa = gs + d2 * 256; float* sb = sa + 64; float* sg = sb + 64; float* sn = sg + 64;
        ml_gates(p, j, b, h, d2, tc, lane, sa, sb, sg, Bt, Mc);
        const int sidx = ((b * 4 + h) * 2 + d2) * 36 + ml_c_of(d2, tc);
        const float mst = p.MST[sidx];
        sg[lane] = fmaxf(mst, sg[lane]);
        sn[lane] = p.NST[(size_t)sidx * 64 + lane];
        if (lane == 0) ssc[d2] = mst;
    }
#pragma unroll
    for (int i = 0; i < 2; ++i) {
        const int e = tid + 256 * i, st = e >> 3, ch = e & 7; const int row = ml_row(b, tc, st);
        *(uint4*)(Ql + st * 144 + ch * 16) = ml_conv8(p, j, b, tc, st, h * 64 + ch * 8);
        *(uint4*)(Kl + st * 144 + ch * 16) = ml_conv8(p, j, b, tc, st, 256 + h * 64 + ch * 8);
    }
#pragma unroll
    for (int i = 0; i < 4; ++i) {
        const int e = tid + 256 * i, st = e >> 4, ch = e & 15;
        const uint4 u = *(const uint4*)(p.PB + (size_t)ml_row(b, tc, st) * 1536 + 512 + h * 128 + ch * 8);
        bf16_t* d = VT + (ch * 8) * 68 + st;
        d[0] = (bf16_t)u.x; d[68] = (bf16_t)(u.x >> 16); d[136] = (bf16_t)u.y; d[204] = (bf16_t)(u.y >> 16);
        d[272] = (bf16_t)u.z; d[340] = (bf16_t)(u.z >> 16); d[408] = (bf16_t)u.w; d[476] = (bf16_t)(u.w >> 16);
    }
    __syncthreads();
    const float* sa = gs + dir * 256; const float* sb = sa + 64; const float* sg = sb + 64; const float* sn = sg + 64;
    const int t = tb * 32 + jl;
    const float gtv = sg[t], btv = sb[t], mst = ssc[dir];
    const float e2 = expf(mst - gtv);
    const int sidx = ((b * 4 + h) * 2 + dir) * 36 + ml_c_of(dir, tc);
    bf16x8 qf[4];
#pragma unroll
    for (int ks = 0; ks < 4; ++ks) qf[ks] = *(const bf16x8*)(Ql + t * 144 + (2 * ks + hh) * 16);
    f32x16 acc[4];
    {
        const bf16_t* cst = p.CST + (size_t)sidx * 8192 + (size_t)jl * 64 + hh * 8;
#pragma unroll
        for (int vb = 0; vb < 4; ++vb) {
#pragma unroll
            for (int r = 0; r < 16; ++r) acc[vb][r] = 0.f;
#pragma unroll
            for (int ks = 0; ks < 4; ++ks) {
                const bf16x8 cf = *(const bf16x8*)(cst + (size_t)vb * 32 * 64 + ks * 16);
                acc[vb] = __builtin_amdgcn_mfma_f32_32x32x16_bf16(cf, qf[ks], acc[vb], 0, 0, 0);
            }
            acc[vb] = acc[vb] * e2;
        }
    }
    float den = 0.f;
    {
        float nq = 0.f;
#pragma unroll
        for (int ks = 0; ks < 4; ++ks) {
            const u32x4 u = __builtin_bit_cast(u32x4, qf[ks]);
            const float* np = sn + 16 * ks + 8 * hh;
            nq += bf_lo(u[0]) * np[0] + bf_hi(u[0]) * np[1] + bf_lo(u[1]) * np[2] + bf_hi(u[1]) * np[3] + bf_lo(u[2]) * np[4] + bf_hi(u[2]) * np[5] + bf_lo(u[3]) * np[6] + bf_hi(u[3]) * np[7];
        }
        den = e2 * nq;
    }
#pragma unroll
    for (int sbk = 0; sbk < 2; ++sbk) {
        const bool use = dir == 0 ? (sbk <= tb) : (sbk >= tb);
        if (use) {
            f32x16 sc;
#pragma unroll
            for (int r = 0; r < 16; ++r) sc[r] = 0.f;
#pragma unroll
            for (int ks = 0; ks < 4; ++ks) {
                const bf16x8 kf = *(const bf16x8*)(Kl + (sbk * 32 + jl) * 144 + (2 * ks + hh) * 16);
                sc = __builtin_amdgcn_mfma_f32_32x32x16_bf16(kf, qf[ks], sc, 0, 0, 0);
            }
#pragma unroll
            for (int r4 = 0; r4 < 4; ++r4) {
                const int s0 = sbk * 32 + 8 * r4 + 4 * hh;
                const f32x4 av = *(const f32x4*)(sa + s0);
#pragma unroll
                for (int q = 0; q < 4; ++q) {
                    const int s2 = s0 + q;
                    const bool ok = dir == 0 ? (s2 <= t) : (s2 >= t);
                    const float pv = ok ? sc[r4 * 4 + q] * expf(av[q] - gtv) : 0.f;
                    sc[r4 * 4 + q] = pv; den += pv;
                }
            }
            bf16x8 pb[2];
            pb[0] = pack8(sc[0], sc[1], sc[2], sc[3], sc[4], sc[5], sc[6], sc[7]);
            pb[1] = pack8(sc[8], sc[9], sc[10], sc[11], sc[12], sc[13], sc[14], sc[15]);
#pragma unroll
            for (int vb = 0; vb < 4; ++vb)
#pragma unroll
                for (int k2 = 0; k2 < 2; ++k2) {
                    const char* vp = (const char*)VT + (vb * 32 + jl) * 136 + (sbk * 32 + k2 * 16 + 4 * hh) * 2;
                    const uint2 lo = *(const uint2*)vp, hi = *(const uint2*)(vp + 16);
                    const u32x4 u = (u32x4){lo.x, lo.y, hi.x, hi.y};
                    acc[vb] = __builtin_amdgcn_mfma_f32_32x32x16_bf16(__builtin_bit_cast(bf16x8, u), pb[k2], acc[vb], 0, 0, 0);
                }
        }
    }
    den += SHX(den, 32);
    const float scl = 1.f / fmaxf(fabsf(den), expf(-(btv + gtv)));
#pragma unroll
    for (int vb = 0; vb < 4; ++vb) acc[vb] = acc[vb] * scl;
    __syncthreads();
    float* X = (float*)smem + tb * 4096;
    if (dir == 1) {
#pragma unroll
        for (int vb = 0; vb < 4; ++vb)
#pragma unroll
            for (int r = 0; r < 16; ++r) X[(vb * 32 + (r & 3) + 8 * (r >> 2) + 4 * hh) * 32 + jl] = acc[vb][r];
    }
    __syncthreads();
    if (dir == 0) {
        float ss = 0.f;
#pragma unroll
        for (int vb = 0; vb < 4; ++vb)
#pragma unroll
            for (int r = 0; r < 16; ++r) { const float v = acc[vb][r] + X[(vb * 32 + (r & 3) + 8 * (r >> 2) + 4 * hh) * 32 + jl]; acc[vb][r] = v; ss += v * v; }
        ss += SHX(ss, 32);
        const float rstd = rsqrtf(ss * (1.f / 128.f) + 1e-6f);
        const int row = ml_row(b, tc, t);
        const float* g = p.ev_ml_g + (size_t)j * 512 + h * 128;
        const bf16_t* og = p.PB + (size_t)row * 1536 + 1024 + h * 128;
        bf16_t* mrow = p.MIX + (size_t)row * DM + h * 128;
#pragma unroll
        for (int vb = 0; vb < 4; ++vb)
#pragma unroll
            for (int r4 = 0; r4 < 4; ++r4) {
                const int v = vb * 32 + 8 * r4 + 4 * hh;
                const f32x4 gg = *(const f32x4*)(g + v);
                const uint2 ou = *(const uint2*)(og + v);
                *(uint2*)(mrow + v) = make_uint2(cvt_pk_bf16(acc[vb][r4 * 4 + 0] * rstd * gg[0] * sigmoid_f(bf_lo(ou.x)), acc[vb][r4 * 4 + 1] * rstd * gg[1] * sigmoid_f(bf_hi(ou.x))),
                                                 cvt_pk_bf16(acc[vb][r4 * 4 + 2] * rstd * gg[2] * sigmoid_f(bf_lo(ou.y)), acc[vb][r4 * 4 + 3] * rstd * gg[3] * sigmoid_f(bf_hi(ou.y))));
            }
    }
}

__device__ void ph_attn_even(const P& p, int ci, int L, int j, float* smem) {
    int* s_item = (int*)((char*)smem + 73728);
    int* dq = p.ctr + 64 + ci * 8;
    const int myx = xcc_id8();
    for (int sdx = 0; sdx < 8; ++sdx) {
        const int x = (myx + sdx) & 7;
        for (;;) {
            __syncthreads();
            if (otid() == 0) *s_item = atomicAdd(&dq[x], 1);
            __syncthreads();
            const int i = *s_item;
            if (i >= 144) break;
            const int pr = x + 8 * (i / 36), jq = i % 36, b = pr >> 2, h = pr & 3;
            da_block(p, jq < 32 ? b * 128 + h * 32 + jq : 1024 + b * 16 + h * 4 + (jq - 32), L, j, (char*)smem);
        }
    }
    for (;;) {
        __syncthreads();
        if (otid() == 0) *s_item = atomicAdd(&p.ctr[ci], 1);
        __syncthreads();
        const int item = *s_item;
        if (item >= 2304) break;
        ml_pass1_item(p, item, j, (char*)smem);
    }
}
__device__ void ph_ml_pass3(const P& p, int j, float* smem) {
    for (int item = blockIdx.x; item < 1152; item += gridDim.x) ml_pass3_item(p, item, j, (char*)smem);
}
__device__ void ph_attn_odd(const P& p, int j, bool need_ctx, float* smem) {
    const int nitem = need_ctx ? 2304 : 2048;
    for (int item = blockIdx.x; item < nitem; item += gridDim.x) { wa_block(p, item, j, (char*)smem); __syncthreads(); }
}

#define SEL_LD 132
#define SEL_NOCACHE 1
template <int NV>
__device__ __forceinline__ unsigned topk16_threshold(const unsigned (&k)[NV], unsigned start, bool& exact) {
    auto cnt = [&](unsigned c) { int n = 0;
#pragma unroll
        for (int i = 0; i < NV; ++i) n += __builtin_popcountll(__ballot(k[i] >= c));
        return n; };
    unsigned E = start; int n = cnt(E);
    if (n >= 16) { for (;;) { const unsigned E2 = E + 0x800000u; if (E2 < E) break; const int n2 = cnt(E2); if (n2 < 16) break; E = E2; n = n2; } }
    else { do { E -= 0x800000u; n = cnt(E); } while (n < 16); }
    unsigned T = E;
    for (int bit = 22; bit >= 0 && n != 16; --bit) { const unsigned c = T | (1u << bit); n = cnt(c); if (n >= 16) T = c; else n = 17; }
    exact = (n == 16);
    return T;
}
__device__ __forceinline__ unsigned fkey(float f) { const unsigned u = __float_as_uint(f); return (u & 0x80000000u) ? ~u : (u | 0x80000000u); }
__device__ __forceinline__ unsigned mbcnt64(unsigned long long m) { return __builtin_amdgcn_mbcnt_hi((unsigned)(m >> 32), __builtin_amdgcn_mbcnt_lo((unsigned)m, 0u)); }
__device__ __forceinline__ int rowsum16(int v) { v += dppi<0xB1>(v); v += dppi<0x4E>(v); v += dppi<0x141>(v); v += dppi<0x140>(v); return v; }
__device__ __forceinline__ int rowscan16(int v) { v += dppi<0x111>(v); v += dppi<0x112>(v); v += dppi<0x114>(v); v += dppi<0x118>(v); return v; }
__device__ __forceinline__ int qcount8p(unsigned k0, unsigned k1, unsigned k2, unsigned k3, unsigned k4, unsigned k5, unsigned k6, unsigned k7, unsigned x, int cin) {
    int c; unsigned long long m0, m1, m2, m3, m4, m5, m6, m7;
    asm volatile("v_cmp_ge_u32_e64 %1, %9, %17\n\tv_cmp_ge_u32_e64 %2, %10, %17\n\tv_cmp_ge_u32_e64 %3, %11, %17\n\tv_cmp_ge_u32_e64 %4, %12, %17\n\t"
                 "v_cmp_ge_u32_e64 %5, %13, %17\n\tv_cmp_ge_u32_e64 %6, %14, %17\n\tv_cmp_ge_u32_e64 %7, %15, %17\n\tv_cmp_ge_u32_e64 %8, %16, %17\n\t"
                 "v_addc_co_u32_e64 %0, vcc, %18, 0, %1\n\tv_addc_co_u32_e64 %0, vcc, %0, 0, %2\n\tv_addc_co_u32_e64 %0, vcc, %0, 0, %3\n\tv_addc_co_u32_e64 %0, vcc, %0, 0, %4\n\t"
                 "v_addc_co_u32_e64 %0, vcc, %0, 0, %5\n\tv_addc_co_u32_e64 %0, vcc, %0, 0, %6\n\tv_addc_co_u32_e64 %0, vcc, %0, 0, %7\n\tv_addc_co_u32_e64 %0, vcc, %0, 0, %8"
                 : "=&v"(c), "=&s"(m0), "=&s"(m1), "=&s"(m2), "=&s"(m3), "=&s"(m4), "=&s"(m5), "=&s"(m6), "=&s"(m7)
                 : "v"(k0), "v"(k1), "v"(k2), "v"(k3), "v"(k4), "v"(k5), "v"(k6), "v"(k7), "v"(x), "v"(cin) : "vcc");
    return c;
}
__device__ __forceinline__ int rowsum16a(int c) {
    asm volatile("s_nop 1\n\tv_add_u32_dpp %0, %0, %0 quad_perm:[1,0,3,2] row_mask:0xf bank_mask:0xf bound_ctrl:1\n\ts_nop 1\n\t"
                 "v_add_u32_dpp %0, %0, %0 quad_perm:[2,3,0,1] row_mask:0xf bank_mask:0xf bound_ctrl:1\n\ts_nop 1\n\t"
                 "v_add_u32_dpp %0, %0, %0 row_half_mirror row_mask:0xf bank_mask:0xf bound_ctrl:1\n\ts_nop 1\n\t"
                 "v_add_u32_dpp %0, %0, %0 row_mirror row_mask:0xf bank_mask:0xf bound_ctrl:1" : "+v"(c));
    return c;
}
__device__ __forceinline__ void rowsum16a2(int& a, int& b) {
    asm volatile("s_nop 1\n\t"
                 "v_add_u32_dpp %0, %0, %0 quad_perm:[1,0,3,2] row_mask:0xf bank_mask:0xf bound_ctrl:1\n\tv_add_u32_dpp %1, %1, %1 quad_perm:[1,0,3,2] row_mask:0xf bank_mask:0xf bound_ctrl:1\n\ts_nop 0\n\t"
                 "v_add_u32_dpp %0, %0, %0 quad_perm:[2,3,0,1] row_mask:0xf bank_mask:0xf bound_ctrl:1\n\tv_add_u32_dpp %1, %1, %1 quad_perm:[2,3,0,1] row_mask:0xf bank_mask:0xf bound_ctrl:1\n\ts_nop 0\n\t"
                 "v_add_u32_dpp %0, %0, %0 row_half_mirror row_mask:0xf bank_mask:0xf bound_ctrl:1\n\tv_add_u32_dpp %1, %1, %1 row_half_mirror row_mask:0xf bank_mask:0xf bound_ctrl:1\n\ts_nop 0\n\t"
                 "v_add_u32_dpp %0, %0, %0 row_mirror row_mask:0xf bank_mask:0xf bound_ctrl:1\n\tv_add_u32_dpp %1, %1, %1 row_mirror row_mask:0xf bank_mask:0xf bound_ctrl:1" : "+v"(a), "+v"(b));
}
template <int NV> __device__ __forceinline__ int qcountp(const unsigned (&k)[NV], unsigned x) {
    int c = 0;
#pragma unroll
    for (int e = 0; e < NV; e += 8) c = qcount8p(k[e], k[e + 1], k[e + 2], k[e + 3], k[e + 4], k[e + 5], k[e + 6], k[e + 7], x, c);
    return c;
}
template <int NV>
__device__ __forceinline__ void qsearch2(const unsigned (&ka)[NV], const unsigned (&kb)[NV], unsigned start, unsigned& TA, int& nA, unsigned& TB, int& nB) {
    unsigned EA = start, EB = start;
    int loA = qcountp<NV>(ka, start), hiA = qcountp<NV>(ka, start + 0x800000u); rowsum16a2(loA, hiA);
    int loB = qcountp<NV>(kb, start), hiB = qcountp<NV>(kb, start + 0x800000u); rowsum16a2(loB, hiB);
    for (;;) {
        const bool upA = hiA >= 16 && EA < 0xFF000000u, dnA = loA < 16, upB = hiB >= 16 && EB < 0xFF000000u, dnB = loB < 16;
        if (__ballot(upA || dnA || upB || dnB) == 0ull) break;
        EA = upA ? EA + 0x800000u : (dnA ? EA - 0x800000u : EA); EB = upB ? EB + 0x800000u : (dnB ? EB - 0x800000u : EB);
        const unsigned xA = upA ? EA + 0x800000u : EA, xB = upB ? EB + 0x800000u : EB;
        int cA = qcountp<NV>(ka, xA), cB = qcountp<NV>(kb, xB); rowsum16a2(cA, cB);
        const int l2A = upA ? hiA : (dnA ? cA : loA), h2A = upA ? cA : (dnA ? loA : hiA); loA = l2A; hiA = h2A;
        const int l2B = upB ? hiB : (dnB ? cB : loB), h2B = upB ? cB : (dnB ? loB : hiB); loB = l2B; hiB = h2B;
    }
    TA = EA; nA = loA; TB = EB; nB = loB;
    for (unsigned bit = 1u << 22; bit != 0u && __ballot((nA != 16) || (nB != 16)) != 0ull; bit >>= 1) {
        const unsigned xA = TA | bit, xB = TB | bit;
        int cA = qcountp<NV>(ka, xA), cB = qcountp<NV>(kb, xB); rowsum16a2(cA, cB);
        const bool gA = cA >= 16, gB = cB >= 16;
        TA = gA ? xA : TA; nA = gA ? cA : nA; TB = gB ? xB : TB; nB = gB ? cB : nB;
    }
}
template <int NV>
__device__ __forceinline__ void qsearch1(const unsigned (&k)[NV], unsigned start, unsigned& T, int& n) {
    unsigned E = start;
    int lo = qcountp<NV>(k, start), hi = qcountp<NV>(k, start + 0x800000u); rowsum16a2(lo, hi);
    for (;;) {
        const bool up = hi >= 16 && E < 0xFF000000u, dn = lo < 16;
        if (__ballot(up || dn) == 0ull) break;
        E = up ? E + 0x800000u : (dn ? E - 0x800000u : E);
        const unsigned x = up ? E + 0x800000u : E;
        const int c = rowsum16a(qcountp<NV>(k, x));
        const int l2 = up ? hi : (dn ? c : lo), h2 = up ? c : (dn ? lo : hi); lo = l2; hi = h2;
    }
    T = E; n = lo;
    for (unsigned bit = 1u << 22; bit != 0u && __ballot(n != 16) != 0ull; bit >>= 1) {
        const unsigned x = T | bit;
        const int c = rowsum16a(qcountp<NV>(k, x));
        const bool g = c >= 16;
        T = g ? x : T; n = g ? c : n;
    }
}
template <int NV, class PayF>
__device__ __forceinline__ void qcompact(char* smem, const unsigned (&k)[NV], const float (&val)[NV], PayF pay, unsigned T, int n, int dst, int dump) {
    if (__ballot(n != 16) == 0ull) {
        int c = 0;
#pragma unroll
        for (int e = 0; e < NV; ++e) c += (k[e] >= T) ? 1 : 0;
        int pos = rowscan16(c) - c;
#pragma unroll
        for (int e = 0; e < NV; ++e) {
            const bool sel = k[e] >= T;
            *(float2*)(smem + (sel ? dst + pos * 8 : dump)) = make_float2(val[e], __int_as_float(pay(e)));
            pos += sel ? 1 : 0;
        }
    } else {
        int cg = 0, ce = 0;
#pragma unroll
        for (int e = 0; e < NV; ++e) { cg += (k[e] > T) ? 1 : 0; ce += (k[e] == T) ? 1 : 0; }
        const int need = 16 - rowsum16(cg), tr0 = rowscan16(ce) - ce;
        int c = 0, tr = tr0;
#pragma unroll
        for (int e = 0; e < NV; ++e) { const bool eq = k[e] == T; c += ((k[e] > T) || (eq && tr < need)) ? 1 : 0; tr += eq ? 1 : 0; }
        int pos = rowscan16(c) - c; tr = tr0;
#pragma unroll
        for (int e = 0; e < NV; ++e) {
            const bool eq = k[e] == T, sel = (k[e] > T) || (eq && tr < need);
            *(float2*)(smem + (sel ? dst + pos * 8 : dump)) = make_float2(val[e], __int_as_float(pay(e)));
            pos += sel ? 1 : 0; tr += eq ? 1 : 0;
        }
    }
}
template <class NextF, class DoneF>
__device__ __forceinline__ void peer_select_loop(const P& p, int L, char* smem, NextF&& next_item, DoneF&& done_item) {
    float* S = (float*)smem;
    const int tid = otid(), lane = tid & 63, wid = tid >> 6, fr = lane & 15, fq = lane >> 4;
    const bf16_t* KBL = p.KB + (size_t)L * 8 * 2 * 128 * 128;
    bf16x8 kfr[8][4];
    int hcur = -1;
    for (int ndone = 0;; ++ndone) {
        const int item = next_item(ndone);
        if (item < 0) break;
        const int h = item & 7, t0 = (item >> 3) * 32;
        __syncthreads();
        {
            const int pp = wid >> 1, th = wid & 1;
            const bf16_t* qp = p.QB + (size_t)(t0 + th * 16 + fr) * 2048 + h * 256 + pp * 128 + fq * 8;
            bf16x8 qf[4];
#pragma unroll
            for (int ks = 0; ks < 4; ++ks) qf[ks] = *(const bf16x8*)(qp + ks * 32);
#ifndef SEL_NOCACHE
            if (h != hcur)
#endif
            {
                const bf16_t* kp = KBL + ((size_t)(h * 2 + pp) * 128 + fr) * 128 + fq * 8;
#pragma unroll
                for (int ni = 0; ni < 8; ++ni)
#pragma unroll
                    for (int ks = 0; ks < 4; ++ks) kfr[ni][ks] = *(const bf16x8*)(kp + (size_t)ni * 16 * 128 + ks * 32);
                hcur = h;
            }
#pragma unroll
            for (int ni = 0; ni < 8; ++ni) {
                f32x4 acc = (f32x4){0.f, 0.f, 0.f, 0.f};
#pragma unroll
                for (int ks = 0; ks < 4; ++ks) acc = __builtin_amdgcn_mfma_f32_16x16x32_bf16(qf[ks], kfr[ni][ks], acc, 0, 0, 0);
#pragma unroll
                for (int j = 0; j < 4; ++j) S[(pp * 32 + th * 16 + fq * 4 + j) * SEL_LD + ni * 16 + fr] = acc[j];
            }
        }
        __syncthreads();
#pragma unroll 1
        for (int quad = 0; quad < 2; ++quad) {
            const int q = lane >> 4, i = lane & 15, t = wid * 8 + quad * 4 + q, r = t0 + t;
            const int wbase = 34816 + wid * 2560, rowb = wbase + q * 512, dump = wbase + 2048 + lane * 8;
            float vA[8], vB[8]; unsigned kA[8], kB[8];
#pragma unroll
            for (int m = 0; m < 2; ++m) {
                const float4 a4 = *(const float4*)(S + t * SEL_LD + 64 * m + 4 * i), b4 = *(const float4*)(S + (32 + t) * SEL_LD + 64 * m + 4 * i);
                vA[4 * m] = a4.x; vA[4 * m + 1] = a4.y; vA[4 * m + 2] = a4.z; vA[4 * m + 3] = a4.w;
                vB[4 * m] = b4.x; vB[4 * m + 1] = b4.y; vB[4 * m + 2] = b4.z; vB[4 * m + 3] = b4.w;
            }
#pragma unroll
            for (int e = 0; e < 8; ++e) { kA[e] = fkey(vA[e]); kB[e] = fkey(vB[e]); }
            {
                unsigned TA, TB; int nA, nB;
                qsearch2<8>(kA, kB, 0xBF800000u, TA, nA, TB, nB);
                const int ib = 4 * i;
                qcompact<8>(smem, kA, vA, [&](int e) { return ib + 64 * (e >> 2) + (e & 3); }, TA, nA, rowb, dump);
                qcompact<8>(smem, kB, vB, [&](int e) { return ib + 64 * (e >> 2) + (e & 3); }, TB, nB, rowb + 128, dump);
            }
            __builtin_amdgcn_wave_barrier();
            {
                const float2 av = *(const float2*)(smem + rowb + i * 8);
                float cand[16]; unsigned kc[16]; int bidx[16];
#pragma unroll
                for (int j2 = 0; j2 < 8; ++j2) {
                    const float4 bb = *(const float4*)(smem + rowb + 128 + j2 * 16);
                    cand[2 * j2] = av.x + bb.x; bidx[2 * j2] = __float_as_int(bb.y); cand[2 * j2 + 1] = av.x + bb.z; bidx[2 * j2 + 1] = __float_as_int(bb.w);
                }
#pragma unroll
                for (int j = 0; j < 16; ++j) kc[j] = fkey(cand[j]);
                unsigned TC; int nC;
                qsearch1<16>(kc, 0xC0800000u, TC, nC);
                const int ai128 = __float_as_int(av.y) * 128;
                __builtin_amdgcn_wave_barrier();
                qcompact<16>(smem, kc, cand, [&](int e) { return ai128 + bidx[e]; }, TC, nC, rowb + 256, dump);
            }
            __builtin_amdgcn_wave_barrier();
            {
                const float2 cv = *(const float2*)(smem + rowb + 256 + i * 8);
                float mx = cv.x;
                mx = fmaxf(mx, dppf<0xB1, 0xF>(mx, mx)); mx = fmaxf(mx, dppf<0x4E, 0xF>(mx, mx)); mx = fmaxf(mx, dppf<0x141, 0xF>(mx, mx)); mx = fmaxf(mx, dppf<0x140, 0xF>(mx, mx));
                const float ex = __builtin_amdgcn_exp2f((cv.x - mx) * 1.4426950408889634f);
                float sum = ex;
                sum += dppf<0xB1, 0xF>(sum, 0.f); sum += dppf<0x4E, 0xF>(sum, 0.f); sum += dppf<0x141, 0xF>(sum, 0.f); sum += dppf<0x140, 0xF>(sum, 0.f);
                __hip_atomic_store(&p.GATE[(size_t)r * 128 + h * 16 + i], ex * __builtin_amdgcn_rcpf(sum), __ATOMIC_RELAXED, __HIP_MEMORY_SCOPE_AGENT);
                __hip_atomic_store(&p.EIDX[(size_t)r * 128 + h * 16 + i], __float_as_int(cv.y), __ATOMIC_RELAXED, __HIP_MEMORY_SCOPE_AGENT);
            }
            __builtin_amdgcn_wave_barrier();
        }
        done_item(item);
    }
}


__device__ __forceinline__ int wave_sum_i(int v, int lane) {
    v += __builtin_amdgcn_update_dpp(0, v, 0xB1, 0xF, 0xF, true);
    v += __builtin_amdgcn_update_dpp(0, v, 0x4E, 0xF, 0xF, true);
    v += __builtin_amdgcn_update_dpp(0, v, 0x141, 0xF, 0xF, true);
    v += __builtin_amdgcn_update_dpp(0, v, 0x140, 0xF, 0xF, true);
    v += __builtin_amdgcn_update_dpp(0, v, 0x142, 0xA, 0xF, false);
    v += __builtin_amdgcn_update_dpp(0, v, 0x143, 0xC, 0xF, false);
    return __builtin_amdgcn_readlane(v, 63);
}
__device__ __forceinline__ int tred32(const int (&s)[32], int lane) {
    int t1[16], t2[8], t3[4], t4[2];
#pragma unroll
    for (int j = 0; j < 16; ++j) { const auto q = __builtin_amdgcn_permlane32_swap((unsigned)s[j], (unsigned)s[j + 16], false, false); t1[j] = (int)(q[0] + q[1]); }
#pragma unroll
    for (int j = 0; j < 8; ++j) { const auto q = __builtin_amdgcn_permlane16_swap((unsigned)t1[j], (unsigned)t1[j + 8], false, false); t2[j] = (int)(q[0] + q[1]); }
#pragma unroll
    for (int j = 0; j < 4; ++j) { const int ra = t2[j] + dppi<0x128>(t2[j]), rb = t2[j + 4] + dppi<0x128>(t2[j + 4]); t3[j] = (lane & 8) ? rb : ra; }
#pragma unroll
    for (int j = 0; j < 2; ++j) { const int ra = t3[j] + dppi<0x141>(t3[j]), rb = t3[j + 2] + dppi<0x141>(t3[j + 2]); t4[j] = (lane & 4) ? rb : ra; }
    const int ra = t4[0] + dppi<0x4E>(t4[0]), rb = t4[1] + dppi<0x4E>(t4[1]);
    return (lane & 2) ? rb : ra;
}
__device__ __forceinline__ void peer_gather_token(const P& p, int L, int r, float oscale, int lane) {
    const unsigned char* U = p.U8 + (size_t)L * 16384 * 512; const unsigned char* V = p.V8 + (size_t)L * 16384 * 512;
    const float* USC = p.USC + (size_t)L * 16384; const float* VSC = p.VSC + (size_t)L * 16384;
    const float* gate2 = p.modv + (size_t)L * 9 * 6144 + 5120;
    {
        const int sig = (lane & 1) * 32 + (lane >> 1);
        const int e0 = p.EIDX[(size_t)r * 128 + sig], e1 = p.EIDX[(size_t)r * 128 + 64 + sig];
        const float g0 = p.GATE[(size_t)r * 128 + sig], g1 = p.GATE[(size_t)r * 128 + 64 + sig];
        const float us0 = USC[e0], us1 = USC[e1], vs0 = VSC[e0], vs1 = VSC[e1];
        const uint4 xq = *(const uint4*)(p.XQ + (size_t)r * DM + lane * 16);
        const float xs = p.XS[r];
        const int sxlo = wave_sum_i(__builtin_amdgcn_sdot4((int)xq.x, 0x01010101, __builtin_amdgcn_sdot4((int)xq.z, 0x01010101, 0, false), false), lane);
        const int sxhi = wave_sum_i(__builtin_amdgcn_sdot4((int)xq.y, 0x01010101, __builtin_amdgcn_sdot4((int)xq.w, 0x01010101, 0, false), false), lane);
        const float cx = 0.5f * (float)sxhi - 7.5f * (float)sxlo;
        int d0 = 0, d1 = 0;
        const unsigned lane8 = (unsigned)lane * 8u;
#pragma unroll
        for (int half = 0; half < 2; ++half) {
            const int ev = half ? e1 : e0;
            int x0 = 0, x1 = 0;
#pragma unroll 1
            for (int kb = 0; kb < 2; ++kb) {
                uint2 ua[32];
#pragma unroll
                for (int j = 0; j < 32; ++j) {
                    const unsigned idx = (unsigned)__builtin_amdgcn_readlane(ev, 2 * j + kb);
                    ua[j] = *(const uint2*)(U + (size_t)(idx * 512u + lane8));
                }
                int sd[32];
#pragma unroll
                for (int j = 0; j < 32; ++j) {
                    int lo = __builtin_amdgcn_sdot4((int)xq.x, (int)(ua[j].x & 0x0F0F0F0Fu), 0, false);
                    lo = __builtin_amdgcn_sdot4((int)xq.z, (int)(ua[j].y & 0x0F0F0F0Fu), lo, false);
                    int hi = __builtin_amdgcn_sdot4((int)xq.y, (int)(ua[j].x & 0xF0F0F0F0u), 0, false);
                    hi = __builtin_amdgcn_sdot4((int)xq.w, (int)(ua[j].y & 0xF0F0F0F0u), hi, false);
                    sd[j] = (lo << 4) + hi;
                }
                const int t = tred32(sd, lane);
                if (kb) x1 = t; else x0 = t;
            }
            const int f0 = x0 + dppi<0xB1>(x0), f1 = x1 + dppi<0xB1>(x1);
            const int dv = (lane & 1) ? f1 : f0;
            if (half) d1 = dv; else d0 = dv;
        }
        const float a0 = us0 * xs * ((float)d0 * 0.0625f + cx), a1 = us1 * xs * ((float)d1 * 0.0625f + cx);
        const float w0 = vs0 * g0 * 0.5f * a0 * (1.f + erff(a0 * 0.70710678118654752f));
        const float w1 = vs1 * g1 * 0.5f * a1 * (1.f + erff(a1 * 0.70710678118654752f));
        const float wmax = wave_max(fmaxf(fabsf(w0), fabsf(w1)));
        const float winv = wmax > 0.f ? 127.f / wmax : 0.f;
        const int wi0 = (int)rintf(w0 * winv), wi1 = (int)rintf(w1 * winv);
        const int wq0 = wi0 & 0xff, wq1 = wi1 & 0xff;
        const float cw = (float)wave_sum_i(wi0 + wi1, lane);
        int accf[8], acch[8];
#pragma unroll
        for (int c = 0; c < 8; ++c) { accf[c] = 0; acch[c] = 0; }
#pragma unroll
        for (int half = 0; half < 2; ++half) {
            const int ev = half ? e1 : e0; const int wqv = half ? wq1 : wq0;
#pragma unroll 1
            for (int kb = 0; kb < 2; ++kb) {
                uint2 ua[32];
#pragma unroll
                for (int j = 0; j < 32; ++j) {
                    const unsigned idx = (unsigned)__builtin_amdgcn_readlane(ev, 2 * j + kb);
                    ua[j] = *(const uint2*)(V + (size_t)(idx * 512u + lane8));
                }
#pragma unroll
                for (int j4 = 0; j4 < 8; ++j4) {
                    const int k0 = j4 * 8 + kb;
                    const int wpk = __builtin_amdgcn_readlane(wqv, k0) | (__builtin_amdgcn_readlane(wqv, k0 + 2) << 8) | (__builtin_amdgcn_readlane(wqv, k0 + 4) << 16) | (__builtin_amdgcn_readlane(wqv, k0 + 6) << 24);
#define TR_ONE(I, T) { const unsigned tt = (T); accf[I] = __builtin_amdgcn_sdot4((int)tt, wpk, accf[I], false); acch[I] = __builtin_amdgcn_sdot4((int)(tt & 0xF0F0F0F0u), wpk, acch[I], false); }
#define TR_DOT(D, M) { const unsigned ablo = __builtin_amdgcn_perm(ua[j4 * 4 + 1].M, ua[j4 * 4].M, 0x05010400u), abhi = __builtin_amdgcn_perm(ua[j4 * 4 + 1].M, ua[j4 * 4].M, 0x07030602u); \
                        const unsigned celo = __builtin_amdgcn_perm(ua[j4 * 4 + 3].M, ua[j4 * 4 + 2].M, 0x05010400u), cehi = __builtin_amdgcn_perm(ua[j4 * 4 + 3].M, ua[j4 * 4 + 2].M, 0x07030602u); \
                        TR_ONE((D) * 4 + 0, __builtin_amdgcn_perm(celo, ablo, 0x05040100u)) TR_ONE((D) * 4 + 1, __builtin_amdgcn_perm(celo, ablo, 0x07060302u)) \
                        TR_ONE((D) * 4 + 2, __builtin_amdgcn_perm(cehi, abhi, 0x05040100u)) TR_ONE((D) * 4 + 3, __builtin_amdgcn_perm(cehi, abhi, 0x07060302u)) }
                    TR_DOT(0, x) TR_DOT(1, y)
#undef TR_DOT
#undef TR_ONE
                }
            }
        }
        float acc[16];
#pragma unroll
        for (int j = 0; j < 4; ++j) {
            acc[j] = (float)(accf[j] - acch[j]) - 7.5f * cw;          acc[4 + j] = (float)acch[j] * 0.0625f + 0.5f * cw;
            acc[8 + j] = (float)(accf[4 + j] - acch[4 + j]) - 7.5f * cw;  acc[12 + j] = (float)acch[4 + j] * 0.0625f + 0.5f * cw;
        }
        const float osc = oscale * wmax * (1.f / 127.f);
        const float* gp = gate2 + (size_t)modrow(r) * 6144 + lane * 16;
        float* hp = p.H + (size_t)r * DM + lane * 16;
        float hn[16]; float ss = 0.f;
#pragma unroll
        for (int q = 0; q < 4; ++q) {
            const float4 g = *(const float4*)(gp + q * 4);
            float4 hv = *(float4*)(hp + q * 4);
            hv.x += osc * g.x * (float)acc[q * 4 + 0]; hv.y += osc * g.y * (float)acc[q * 4 + 1];
            hv.z += osc * g.z * (float)acc[q * 4 + 2]; hv.w += osc * g.w * (float)acc[q * 4 + 3];
            if (L < 3) *(float4*)(hp + q * 4) = hv;
            hn[q * 4 + 0] = hv.x; hn[q * 4 + 1] = hv.y; hn[q * 4 + 2] = hv.z; hn[q * 4 + 3] = hv.w;
            ss += hv.x * hv.x + hv.y * hv.y + hv.z * hv.z + hv.w * hv.w;
        }
        ss = wave_sum(ss);
        const float rstd = rsqrtf(ss * (1.0f / DM) + 1e-6f);
        if (L < 3) {
            const float* g1 = p.norm1_g + (size_t)(L + 1) * DM + lane * 16;
            const float* mvn = p.modv + ((size_t)(L + 1) * 9 + modrow(r)) * 6144 + lane * 16;
            unsigned w[8];
#pragma unroll
            for (int q = 0; q < 4; ++q) {
                const float4 gg = *(const float4*)(g1 + q * 4), sh = *(const float4*)(mvn + q * 4), scl = *(const float4*)(mvn + 1024 + q * 4);
                w[q * 2] = cvt_pk_bf16(hn[q * 4 + 0] * rstd * gg.x * (1.f + scl.x) + sh.x, hn[q * 4 + 1] * rstd * gg.y * (1.f + scl.y) + sh.y);
                w[q * 2 + 1] = cvt_pk_bf16(hn[q * 4 + 2] * rstd * gg.z * (1.f + scl.z) + sh.z, hn[q * 4 + 3] * rstd * gg.w * (1.f + scl.w) + sh.w);
            }
            uint4* xp = (uint4*)(p.XN + (size_t)r * DM + lane * 16);
            xp[0] = make_uint4(w[0], w[1], w[2], w[3]); xp[1] = make_uint4(w[4], w[5], w[6], w[7]);
        } else {
            const float* fg = p.final_g + lane * 16;
            float* op = p.out + (size_t)r * DM + lane * 16;
#pragma unroll
            for (int q = 0; q < 4; ++q) {
                const float4 gg = *(const float4*)(fg + q * 4);
                *(float4*)(op + q * 4) = make_float4(hn[q * 4 + 0] * rstd * gg.x, hn[q * 4 + 1] * rstd * gg.y, hn[q * 4 + 2] * rstd * gg.z, hn[q * 4 + 3] * rstd * gg.w);
            }
        }
    }
}

__device__ void ph_peer_sg(const P& p, int L, int nrows, int* q2, unsigned* tflag, float oscale, char* smem) {
    int* s_item = (int*)(smem + 73728);
    const int tid = otid(), lane = tid & 63, wid = __builtin_amdgcn_readfirstlane(tid >> 6);
    const int nsel = (nrows / 32) * 8, ngat = nrows / 4;
    const bool roleS = ((blockIdx.x >> 3) & 1) == 0;
    peer_select_loop(p, L, smem,
        [&](int ndone) -> int {
            if (!roleS && ndone >= 3) return -1;
            __syncthreads();
            if (tid == 0) *s_item = atomicAdd(&q2[0], 1);
            __syncthreads();
            const int it = *s_item;
            return it < nsel ? it : -1;
        },
        [&](int item) {
            asm volatile("s_waitcnt vmcnt(0)" ::: "memory");
            __syncthreads();
            if (tid == 0) __hip_atomic_fetch_add(&tflag[item >> 3], 1u, __ATOMIC_RELAXED, __HIP_MEMORY_SCOPE_AGENT);
        });
    for (;;) {
        __syncthreads();
        if (tid == 0) {
            const int g = atomicAdd(&q2[1], 1);
            *s_item = g;
            if (g < ngat) {
                unsigned sp = 0;
                while (__hip_atomic_load(&tflag[g >> 3], __ATOMIC_RELAXED, __HIP_MEMORY_SCOPE_AGENT) < 8u) { __builtin_amdgcn_s_sleep(2); if (++sp > (1u << 24)) break; }
                __builtin_amdgcn_fence(__ATOMIC_ACQUIRE, "agent");
                asm volatile("s_waitcnt vmcnt(0)" ::: "memory");
            }
        }
        __syncthreads();
        const int g = *s_item;
        if (g >= ngat) break;
        peer_gather_token(p, L, g * 4 + wid, oscale, lane);
    }
}

#define NSUB 11
__device__ __forceinline__ bool phase_empty(int ph) {
    if (ph == 0) return false;
    const int L = (ph - 1) / NSUB, s = (ph - 1) % NSUB;
    return s == 2 || s == 10 || ((L & 1) && (s == 4 || s == 5)) || (L > 0 && s == 0);
}
__device__ __forceinline__ void run_phase(const P& p, int ph, float* smem, int rep) {
    if (ph == 0) { ph_prologue(p, smem); return; }
    const int L = (ph - 1) / NSUB, s = (ph - 1) % NSUB, j = L >> 1;
    const bool even = (L & 1) == 0, need_ctx = L < 3;
    const int nrows = need_ctx ? NT : NL;
    const float* mv = p.modv + (size_t)L * 9 * 6144;
    switch (s) {
    case 0: ph_normmod(p.H, p.norm1_g + L * DM, mv, 0, 1024, p.XN, NT); break;
    case 1:
        if (even) ph_gemm(p.XN, p.WT + WT_EVIN(j), NT, 3200, EpiEven{p.PB, p.AQL, p.AQC, p.AK, p.AV, p.GT, p.rope}, (char*)smem);
        else ph_gemm(p.XN, p.WT + WT_ODIN(j), NT, ODW, EpiOdd{p.AQL, p.AQC, p.AK, p.AV, p.rope}, (char*)smem);
        break;
    case 3: if (even) ph_attn_even(p, L + 4 * rep, L, j, smem); else ph_attn_odd(p, j, need_ctx, smem); break;
    case 4: if (even) ph_ml_pass2(p); break;
    case 5: if (even) ph_ml_pass3(p, j, smem); break;
    case 6: ph_gemm(p.MIX, p.WT + (even ? WT_EVOUT(j) : WT_ODOUT(j)), nrows, DM, EpiResid{p.H, mv + 2048, rep ? 0.f : 1.f}, (char*)smem); break;
    case 7: ph_normmod_q(p, p.norm2_g + L * DM, mv, nrows); break;
    case 8: ph_gemm(p.XN, p.WT + WT_PQ(L), nrows, 2048, EpiStoreBF16{p.QB, 2048}, (char*)smem); break;
    case 9: ph_peer_sg(p, L, nrows, p.ctr + 16 + L * 2, (unsigned*)p.ctr + 256 + L * 576, rep ? 0.f : 1.f, (char*)smem); break;
    }
}

#define XB_TMO      128
#define XB_XCNT(j)  (256  + 64 * (j))
#define XB_XSUB(j)  (1280 + 64 * (j))
#define XB_XGEN(j)  (2304 + 64 * (j))
#define XB_TOP      3328
#define XB_TOPGEN   3392
#define XCD_BAR_WORDS 3456
#define XB_SPIN_CAP (1u << 20)
#define LAS __attribute__((address_space(3)))
__device__ __forceinline__ unsigned xb_ld(unsigned* p)              { return __hip_atomic_load(p, __ATOMIC_RELAXED, __HIP_MEMORY_SCOPE_AGENT); }
__device__ __forceinline__ unsigned xb_add(unsigned* p, unsigned v) { return __hip_atomic_fetch_add(p, v, __ATOMIC_RELAXED, __HIP_MEMORY_SCOPE_AGENT); }
__device__ __forceinline__ unsigned xb_xcc_id() { return (unsigned)__builtin_amdgcn_s_getreg((3 << 11) | 20) & 0xFu; }
#define XB_SPIN(cond, bar) do { unsigned _sp = 0; while (cond) { __builtin_amdgcn_s_sleep(1); \
    if ((++_sp & 255u) == 0u) { if (xb_ld(&(bar)[XB_TMO])) break; if (_sp > XB_SPIN_CAP) { atomicAdd(&(bar)[XB_TMO], 1u); break; } } } } while (0)
struct XcdBarrier { unsigned* bar; unsigned x; volatile LAS unsigned* st; };
__device__ __forceinline__ XcdBarrier xcd_barrier_post(unsigned* bar, volatile LAS unsigned* st) {
    XcdBarrier b; b.bar = bar; b.x = xb_xcc_id(); b.st = st;
    if (threadIdx.x == 0) (void)xb_add(&bar[XB_XCNT(b.x)], 1u);
    return b;
}
__device__ __forceinline__ void xcd_barrier_complete(unsigned* bar, unsigned x, unsigned& nloc, unsigned& nx) {
    const unsigned G = gridDim.x * gridDim.y * gridDim.z;
    unsigned sum, cnt, mine, sp = 0u;
    for (;;) {
        sum = 0u; cnt = 0u; mine = 0u;
#pragma unroll
        for (unsigned j = 0; j < 16; ++j) { const unsigned c = xb_ld(&bar[XB_XCNT(j)]); sum += c; cnt += (c > 0u) ? 1u : 0u; mine = (j == x) ? c : mine; }
        if (sum == G) break;
        __builtin_amdgcn_s_sleep(1);
        if ((++sp & 255u) == 0u) { if (xb_ld(&bar[XB_TMO])) break; if (sp > XB_SPIN_CAP) { atomicAdd(&bar[XB_TMO], 1u); break; } }
    }
    nloc = mine > 0u ? mine : 1u; nx = cnt > 0u ? cnt : 1u;
}
__device__ __forceinline__ void xcd_barrier(const XcdBarrier& b) {
    asm volatile("s_waitcnt vmcnt(0)" ::: "memory");
    __syncthreads();
    if (threadIdx.x == 0) {
        unsigned* bar = b.bar;
        __builtin_amdgcn_s_waitcnt(0);
        unsigned nloc = b.st[0], nx = b.st[1];
        if (nloc == 0u) { xcd_barrier_complete(bar, b.x, nloc, nx); b.st[0] = nloc; b.st[1] = nx; }
        const unsigned old = xb_add(&bar[XB_XSUB(b.x)], 1u);
        const unsigned gen = old / nloc;
        if (old + 1u == (gen + 1u) * nloc) {
            __builtin_amdgcn_fence(__ATOMIC_RELEASE, "agent");
            asm volatile("s_waitcnt vmcnt(0)" ::: "memory");
            const unsigned og = xb_add(&bar[XB_TOP], 1u);
            const unsigned tg = og / nx;
            if (og + 1u == (tg + 1u) * nx) xb_add(&bar[XB_TOPGEN], 1u);
            else XB_SPIN(xb_ld(&bar[XB_TOPGEN]) == tg, bar);
            __builtin_amdgcn_fence(__ATOMIC_ACQUIRE, "agent");
            xb_add(&bar[XB_XGEN(b.x)], 1u);
            asm volatile("s_waitcnt vmcnt(0)" ::: "memory");
        } else {
            XB_SPIN(xb_ld(&bar[XB_XGEN(b.x)]) == gen, bar);
            __builtin_amdgcn_fence(__ATOMIC_ACQUIRE, "agent");
            asm volatile("s_waitcnt vmcnt(0)" ::: "memory");
        }
    }
    __syncthreads();
}

__global__ void __launch_bounds__(256, 2) mega(P p) {
    extern __shared__ __attribute__((aligned(16))) float smem[];
    cg::grid_group grid = cg::this_grid();
    volatile LAS unsigned* st = (volatile LAS unsigned*)((char*)smem + 73744);
    if (threadIdx.x < 4) st[threadIdx.x] = 0u;
    __syncthreads();
    XcdBarrier xb = xcd_barrier_post(p.bar, st);
    for (int ph = p.ph_lo; ph < p.ph_hi; ++ph) {
        if (phase_empty(ph)) continue;
        run_phase(p, ph, smem, 0);
        if (PROBE_N > 1 && ph > 0 && (ph - 1) % NSUB == PROBE_S)
            for (int rep = 1; rep < PROBE_N; ++rep) { xcd_barrier(xb); run_phase(p, ph, smem, rep); }
        if (ph + 1 < p.ph_hi) { if (ph == 0) grid.sync(); else xcd_barrier(xb); }
    }
}

extern "C" void kernel_launch(void* const* d_in, const int* in_sizes, int n_in, void* d_out, int out_size, void* d_ws, size_t ws_size, hipStream_t stream) {
    static int grid_blocks = 0;
    if (!grid_blocks) {
        int dev = 0, cus = 0, per_cu = 0;
        hipGetDevice(&dev);
        hipDeviceGetAttribute(&cus, hipDeviceAttributeMultiprocessorCount, dev);
        hipFuncSetAttribute((const void*)mega, hipFuncAttributeMaxDynamicSharedMemorySize, LDS_BYTES);
        hipOccupancyMaxActiveBlocksPerMultiprocessor(&per_cu, mega, 256, LDS_BYTES);
        if (per_cu < 1) per_cu = 1;
        if (per_cu > 2) per_cu = 2;
        grid_blocks = cus * per_cu;
    }
    P p{};
    const float** ins = (const float**)&p;
    for (int i = 0; i < 24; ++i) ins[i] = (const float*)d_in[i];
    p.out = (float*)d_out;
    size_t off = 0; char* ws = (char*)d_ws;
    auto carve = [&](size_t bytes) { void* r = ws + off; off += (bytes + 255) & ~(size_t)255; return r; };
    p.modv = (float*)carve((size_t)4 * 9 * 6144 * 4);
    p.rope = (float*)carve((size_t)2048 * 64 * 4);
    p.H = (float*)carve((size_t)NT * DM * 4);
    p.XN = (bf16_t*)carve((size_t)NT * DM * 2);
    p.WT = (bf16_t*)carve(WT_TOTAL * 2);
    p.MIX = (bf16_t*)carve((size_t)NT * DM * 2);
    p.PB = (bf16_t*)carve((size_t)NT * 1536 * 2);
    p.GT = (float*)carve((size_t)NT * 16 * 4);
    p.AQL = (bf16_t*)carve((size_t)8 * 16 * 2048 * 64 * 2);
    p.AQC = (bf16_t*)carve((size_t)8 * 16 * 256 * 64 * 2);
    p.AK = (bf16_t*)carve((size_t)8 * 4 * 2 * 2304 * 64 * 2);
    p.AV = (bf16_t*)carve((size_t)8 * 4 * 128 * 2304 * 2);
    p.QKB = (bf16_t*)carve((size_t)NT * 512 * 2);
    p.CLOC = (float*)carve((size_t)2304 * 8192 * 4);
    p.CST = (bf16_t*)carve((size_t)2304 * 8192 * 2);
    p.NLOC = (float*)carve((size_t)2304 * 64 * 4);
    p.NST = (float*)carve((size_t)2304 * 64 * 4);
    p.CHB = (float*)carve((size_t)2304 * 4);
    p.CHM = (float*)carve((size_t)2304 * 4);
    p.MST = (float*)carve((size_t)2304 * 4);
    p.QB = (bf16_t*)carve((size_t)NT * 2048 * 2);
    p.GATE = (float*)carve((size_t)NT * 128 * 4);
    p.EIDX = (int*)carve((size_t)NT * 128 * 4);
    p.ctr = (int*)carve(2560 * 4);
    p.bar = (unsigned*)carve((size_t)XCD_BAR_WORDS * 4);
    p.U8 = (unsigned char*)carve((size_t)4 * 16384 * 512);
    p.V8 = (unsigned char*)carve((size_t)4 * 16384 * 512);
    p.XQ = (unsigned char*)carve((size_t)NT * DM);
    p.XS = (float*)carve((size_t)NT * 4);
    p.USC = (float*)carve((size_t)4 * 16384 * 4);
    p.VSC = (float*)carve((size_t)4 * 16384 * 4);
    p.KB = (bf16_t*)carve((size_t)4 * 8 * 2 * 128 * 128 * 2);
    if (off > ws_size) { fprintf(stderr, "kernel_launch: workspace too small: need %zu have %zu\n", off, ws_size); return; }
    hipMemsetAsync(p.bar, 0, (size_t)XCD_BAR_WORDS * 4, stream);
#if ONE_LAUNCH
    p.ph_lo = 0; p.ph_hi = NPH;
    void* args[] = {&p};
    hipError_t e = hipLaunchCooperativeKernel((void*)mega, dim3(grid_blocks), dim3(256), args, LDS_BYTES, stream);
    if (e != hipSuccess) fprintf(stderr, "cooperative launch failed: %s (grid %d)\n", hipGetErrorString(e), grid_blocks);
#else
    for (int ph = 0; ph < NPH; ++ph) {
        if (ph > 0 && ph < NPH - 1) { const int L = (ph - 1) / NSUB, s = (ph - 1) % NSUB; if ((s == 2 || s == 4 || s == 5) && (L & 1)) continue; }
        p.ph_lo = ph; p.ph_hi = ph + 1;
        hipLaunchKernelGGL(mega, dim3(grid_blocks), dim3(256), LDS_BYTES, stream, p);
    }
#endif
}
```

```cpp
#include <hip/hip_runtime.h>
#include <hip/hip_cooperative_groups.h>
#include <cstdio>
#include <cstdint>
namespace cg = cooperative_groups;

#ifndef ONE_LAUNCH
#define ONE_LAUNCH 1
#endif

#define NT 18432
#define NL 16384
#define DM 1024
#define EVW 3088
#define ODW 1536
#define C_QK 0
#define C_V 512
#define C_O 1024
#define C_G 1536
#define C_DQ 1552
#define C_DK 2064
#define C_DV 2576
#define NPH 45
#ifndef PROBE_S
#define PROBE_S -1
#endif
#ifndef PROBE_N
#define PROBE_N 1
#endif

typedef unsigned short bf16_t;
typedef short bf16x8 __attribute__((ext_vector_type(8)));
typedef float f32x4 __attribute__((ext_vector_type(4)));
#define LDS_BYTES 73792

typedef float f32x16 __attribute__((ext_vector_type(16)));
typedef unsigned u32x4 __attribute__((ext_vector_type(4)));
struct P {
    const float *x, *c, *ctx, *c_ctx, *mod_w, *mod_b, *norm1_g, *norm2_g, *ev_w_in, *ev_conv_w, *ev_conv_b, *ev_gate_b,
        *ev_ml_g, *ev_da_lam, *ev_da_g, *ev_w_out, *od_w_in, *od_sink, *od_w_out, *pr_w_q, *pr_keys, *pr_u, *pr_v, *final_g;
    float* out;
    float *modv, *H, *GATE, *rope, *GT, *CLOC, *NLOC, *NST, *CHB, *CHM, *MST;
    int *EIDX, *ctr;
    unsigned* bar;
    bf16_t *XN, *MIX, *WT, *KB, *QB, *PB, *AQL, *AQC, *AK, *AV, *QKB, *CST;
    unsigned char *U8, *V8;
    float *USC, *VSC, *XS;
    unsigned char* XQ;
    int ph_lo, ph_hi;
};
#define QSCALE 0.18033688011112042f

__device__ __forceinline__ int otid() { int t = threadIdx.x; asm volatile("" : "+v"(t)); return t; }
__device__ __forceinline__ unsigned pack_i8x4(float a, float b, float c, float d) {
    return ((unsigned)(int)rintf(a) & 0xffu) | (((unsigned)(int)rintf(b) & 0xffu) << 8) | (((unsigned)(int)rintf(c) & 0xffu) << 16) | ((unsigned)(int)rintf(d) << 24);
}
__device__ __forceinline__ int xcc_id8() { return (int)((unsigned)__builtin_amdgcn_s_getreg((3 << 11) | 20) & 7u); }
__device__ __forceinline__ int modrow(int r) { return r < NL ? (r >> 11) : 8; }
__device__ __forceinline__ float silu_f(float x) { return x / (1.f + expf(-x)); }
__device__ __forceinline__ float sigmoid_f(float x) { return 1.f / (1.f + expf(-x)); }
__device__ __forceinline__ float log_sigmoid_f(float x) { return fminf(x, 0.f) - log1pf(expf(-fabsf(x))); }
typedef __bf16 bf16v2_t __attribute__((ext_vector_type(2)));
typedef float f32x2_t __attribute__((ext_vector_type(2)));
__device__ __forceinline__ unsigned cvt_pk_bf16(float lo, float hi) { const bf16v2_t v = __builtin_convertvector((f32x2_t){lo, hi}, bf16v2_t); return __builtin_bit_cast(unsigned, v); }
__device__ __forceinline__ float bf_lo(unsigned u) { return __uint_as_float(u << 16); }
__device__ __forceinline__ float bf_hi(unsigned u) { return __uint_as_float(u & 0xffff0000u); }
__device__ __forceinline__ void unpack8(const uint4 u, float* f) {
    f[0] = bf_lo(u.x); f[1] = bf_hi(u.x); f[2] = bf_lo(u.y); f[3] = bf_hi(u.y); f[4] = bf_lo(u.z); f[5] = bf_hi(u.z); f[6] = bf_lo(u.w); f[7] = bf_hi(u.w);
}
#define WT_EVIN(j) ((size_t)(j) * 3200 * 1024)
#define WT_EVOUT(j) ((size_t)2 * 3200 * 1024 + (size_t)(j) * 1024 * 1024)
#define WT_ODIN(j) ((size_t)2 * 3200 * 1024 + (size_t)2 * 1024 * 1024 + (size_t)(j) * 1536 * 1024)
#define WT_ODOUT(j) ((size_t)2 * 3200 * 1024 + (size_t)2 * 1024 * 1024 + (size_t)2 * 1536 * 1024 + (size_t)(j) * 1024 * 1024)
#define WT_PQ(L) ((size_t)2 * 3200 * 1024 + (size_t)4 * 1024 * 1024 + (size_t)2 * 1536 * 1024 + (size_t)(L) * 2048 * 1024)
#define WT_TOTAL ((size_t)2 * 3200 * 1024 + (size_t)4 * 1024 * 1024 + (size_t)2 * 1536 * 1024 + (size_t)4 * 2048 * 1024)
__device__ __forceinline__ float lshfl(float v, int src) { return __int_as_float(__builtin_amdgcn_ds_bpermute(src << 2, __float_as_int(v))); }
#define SHX(v, m) lshfl((v), lane ^ (m))
#define wave_sum(v) wave_sum_l((v), lane)
#define wave_max(v) wave_max_l((v), lane)
template <int CTRL> __device__ __forceinline__ int dppi(int v) { return __builtin_amdgcn_update_dpp(0, v, CTRL, 0xF, 0xF, true); }
template <int CTRL, int RMASK> __device__ __forceinline__ float dppf(float v, float fill) { return __int_as_float(__builtin_amdgcn_update_dpp(__float_as_int(fill), __float_as_int(v), CTRL, RMASK, 0xF, false)); }
__device__ __forceinline__ float wave_sum_l(float v, int lane) {
    v += dppf<0xB1, 0xF>(v, 0.f); v += dppf<0x4E, 0xF>(v, 0.f); v += dppf<0x141, 0xF>(v, 0.f); v += dppf<0x140, 0xF>(v, 0.f);
    v += dppf<0x142, 0xA>(v, 0.f); v += dppf<0x143, 0xC>(v, 0.f);
    return __int_as_float(__builtin_amdgcn_readlane(__float_as_int(v), 63));
}
__device__ __forceinline__ float wave_max_l(float v, int lane) {
    v = fmaxf(v, dppf<0xB1, 0xF>(v, v)); v = fmaxf(v, dppf<0x4E, 0xF>(v, v)); v = fmaxf(v, dppf<0x141, 0xF>(v, v)); v = fmaxf(v, dppf<0x140, 0xF>(v, v));
    v = fmaxf(v, dppf<0x142, 0xA>(v, v)); v = fmaxf(v, dppf<0x143, 0xC>(v, v));
    return __int_as_float(__builtin_amdgcn_readlane(__float_as_int(v), 63));
}

__device__ void cvt_copy_bf16(const float* src, bf16_t* dst, size_t n);
__device__ void quant_rows_i4(const float* src, unsigned char* dst, float* scl, int rfirst, int nrows, int stride);
__device__ void ph_prologue(const P& p, float* smem) {
    const int tid = otid(), nb = gridDim.x, bid = blockIdx.x;
    if (bid == 0) for (int i = tid; i < 2560; i += 256) p.ctr[i] = 0;
    {
        const float4* xs = (const float4*)p.x; const float4* cs = (const float4*)p.ctx; float4* hd = (float4*)p.H;
        const size_t nx = (size_t)NL * DM / 4, nc = (size_t)(NT - NL) * DM / 4;
        const size_t st = (size_t)nb * 256, tot = nx + nc;
        for (size_t i = (size_t)bid * 256 + tid; i < tot; i += 4 * st) {
            const size_t i1 = i + st < tot ? i + st : i, i2 = i + 2 * st < tot ? i + 2 * st : i, i3 = i + 3 * st < tot ? i + 3 * st : i;
            const float4 t0 = i < nx ? xs[i] : cs[i - nx], t1 = i1 < nx ? xs[i1] : cs[i1 - nx], t2 = i2 < nx ? xs[i2] : cs[i2 - nx], t3 = i3 < nx ? xs[i3] : cs[i3 - nx];
            hd[i] = t0; hd[i1] = t1; hd[i2] = t2; hd[i3] = t3;
        }
    }
    for (int i = bid * 256 + tid; i < 2048 * 32; i += nb * 256) {
        const int s = i >> 5, d = i & 31;
        const float pos = (d < 16) ? (float)(s >> 6) : (float)(s & 63);
        const float inv = powf(10000.0f, -(float)(d & 15) / 16.0f);
        const float ang = pos * inv;
        p.rope[2 * i] = cosf(ang); p.rope[2 * i + 1] = sinf(ang);
    }
    float* sc = smem;
    float* red = smem + 9 * 1024;
    for (int i = tid; i < 9 * 1024; i += 256) { const int r = i >> 10, k = i & 1023; const float v = r < 8 ? p.c[r * 1024 + k] : p.c_ctx[k]; sc[i] = silu_f(v); }
    __syncthreads();
    for (int item = bid; item < 4 * 96; item += nb) {
        const int L = item / 96, n0 = (item % 96) * 64, tx = tid & 63, kq = tid >> 6;
        float acc[9];
#pragma unroll
        for (int r = 0; r < 9; ++r) acc[r] = 0.f;
        const float* w = p.mod_w + (size_t)L * 1024 * 6144 + n0 + tx;
#pragma unroll 1
        for (int k = kq * 256; k < kq * 256 + 256; k += 16) {
            float wv[16];
#pragma unroll
            for (int u = 0; u < 16; ++u) wv[u] = w[(size_t)(k + u) * 6144];
#pragma unroll
            for (int r = 0; r < 9; ++r) {
                const float4 s0 = *(const float4*)(sc + r * 1024 + k), s1 = *(const float4*)(sc + r * 1024 + k + 4), s2 = *(const float4*)(sc + r * 1024 + k + 8), s3 = *(const float4*)(sc + r * 1024 + k + 12);
                acc[r] += s0.x * wv[0] + s0.y * wv[1] + s0.z * wv[2] + s0.w * wv[3] + s1.x * wv[4] + s1.y * wv[5] + s1.z * wv[6] + s1.w * wv[7]
                        + s2.x * wv[8] + s2.y * wv[9] + s2.z * wv[10] + s2.w * wv[11] + s3.x * wv[12] + s3.y * wv[13] + s3.z * wv[14] + s3.w * wv[15];
            }
        }
#pragma unroll
        for (int r = 0; r < 9; ++r) red[(kq * 9 + r) * 64 + tx] = acc[r];
        __syncthreads();
        if (kq == 0) {
#pragma unroll
            for (int r = 0; r < 9; ++r) {
                const float s = red[(0 * 9 + r) * 64 + tx] + red[(1 * 9 + r) * 64 + tx] + red[(2 * 9 + r) * 64 + tx] + red[(3 * 9 + r) * 64 + tx];
                p.modv[((size_t)L * 9 + r) * 6144 + n0 + tx] = s + p.mod_b[L * 6144 + n0 + tx];
            }
        }
        __syncthreads();
    }
    {
        float (*tile)[65] = (float (*)[65])smem;
        auto decode = [&](int item, int& k0, int& n0, int& mat, int& N, const float*& src, bf16_t*& dst) {
            int it = item, Npad = 0;
            for (mat = 0; mat < 12; ++mat) {
                if (mat < 2) { N = EVW; Npad = 3200; src = p.ev_w_in + (size_t)mat * DM * EVW; dst = p.WT + WT_EVIN(mat); }
                else if (mat < 4) { N = 1024; Npad = 1024; src = p.ev_w_out + (size_t)(mat - 2) * DM * DM; dst = p.WT + WT_EVOUT(mat - 2); }
                else if (mat < 6) { N = ODW; Npad = ODW; src = p.od_w_in + (size_t)(mat - 4) * DM * ODW; dst = p.WT + WT_ODIN(mat - 4); }
                else if (mat < 8) { N = 1024; Npad = 1024; src = p.od_w_out + (size_t)(mat - 6) * DM * DM; dst = p.WT + WT_ODOUT(mat - 6); }
                else { N = 2048; Npad = 2048; src = p.pr_w_q + (size_t)(mat - 8) * DM * 2048; dst = p.WT + WT_PQ(mat - 8); }
                const int nt = 16 * (Npad / 64);
                if (it < nt) break;
                it -= nt;
            }
            k0 = (it & 15) * 64; n0 = (it >> 4) * 64;
        };
        auto fetch = [&](int k0, int n0, int mat, int N, const float* src, float4 (&v)[4]) {
#pragma unroll
            for (int rep = 0; rep < 4; ++rep) {
                const int i = (tid >> 4) + 16 * rep, c4 = (tid & 15) * 4;
                v[rep] = make_float4(0.f, 0.f, 0.f, 0.f);
                int sc = n0 + c4;
                if (mat < 2) sc = sc < 1536 ? sc : (sc < 3072 ? sc + 16 : (sc < 3088 ? sc - 3072 + 1536 : N));
                if (sc < N) v[rep] = *(const float4*)(src + (size_t)(k0 + i) * N + sc);
            }
        };
        float4 nx[4];
        int k0n = 0, n0n = 0, matn = 0, Nn = 0; const float* srcn = nullptr; bf16_t* dstn = nullptr;
        if (bid < 5440) { decode(bid, k0n, n0n, matn, Nn, srcn, dstn); fetch(k0n, n0n, matn, Nn, srcn, nx); }
        for (int item = bid; item < 5440; item += nb) {
            const int k0 = k0n, n0 = n0n; bf16_t* dst = dstn;
            float4 v[4];
#pragma unroll
            for (int rep = 0; rep < 4; ++rep) v[rep] = nx[rep];
            if (item + nb < 5440) { decode(item + nb, k0n, n0n, matn, Nn, srcn, dstn); fetch(k0n, n0n, matn, Nn, srcn, nx); }
            __syncthreads();
#pragma unroll
            for (int rep = 0; rep < 4; ++rep) {
                const int i = (tid >> 4) + 16 * rep, c4 = (tid & 15) * 4;
                tile[i][c4] = v[rep].x; tile[i][c4 + 1] = v[rep].y; tile[i][c4 + 2] = v[rep].z; tile[i][c4 + 3] = v[rep].w;
            }
            __syncthreads();
            {
                const int n = tid >> 2, kq = (tid & 3) * 16;
                unsigned w[8];
#pragma unroll
                for (int e = 0; e < 8; ++e) w[e] = cvt_pk_bf16(tile[kq + 2 * e][n], tile[kq + 2 * e + 1][n]);
                uint4* dp = (uint4*)(dst + (size_t)(n0 + n) * DM + k0 + kq);
                dp[0] = make_uint4(w[0], w[1], w[2], w[3]); dp[1] = make_uint4(w[4], w[5], w[6], w[7]);
            }
        }
    }
    {
        const int wid_ = __builtin_amdgcn_readfirstlane(otid() >> 6);
        quant_rows_i4(p.pr_u, p.U8, p.USC, blockIdx.x * 4 + wid_, 16384, gridDim.x * 4);
        quant_rows_i4(p.pr_v, p.V8, p.VSC, blockIdx.x * 4 + wid_, 16384, gridDim.x * 4);
    }
    cvt_copy_bf16(p.pr_keys, p.KB, (size_t)4 * 8 * 2 * 128 * 128);
}

__device__ void ph_normmod_q(const P& p, const float* g, const float* modv_layer, int nrows) {
    const int lane = otid() & 63, wid = __builtin_amdgcn_readfirstlane(otid() >> 6);
    for (int r = blockIdx.x * 4 + wid; r < nrows; r += gridDim.x * 4) {
        const float4* s4 = (const float4*)(p.H + (size_t)r * DM);
        float4 v[4]; float ss = 0.f;
#pragma unroll
        for (int i = 0; i < 4; ++i) { v[i] = s4[i * 64 + lane]; ss += v[i].x * v[i].x + v[i].y * v[i].y + v[i].z * v[i].z + v[i].w * v[i].w; }
        ss = wave_sum(ss);
        const float rstd = rsqrtf(ss * (1.0f / DM) + 1e-6f);
        const float* mv = modv_layer + (size_t)modrow(r) * 6144;
        float4 o[4]; float mx = 0.f;
#pragma unroll
        for (int i = 0; i < 4; ++i) {
            const int c = (i * 64 + lane) * 4;
            const float4 gg = *(const float4*)(g + c), sh = *(const float4*)(mv + 3072 + c), scl = *(const float4*)(mv + 4096 + c);
            o[i].x = v[i].x * rstd * gg.x * (1.f + scl.x) + sh.x; o[i].y = v[i].y * rstd * gg.y * (1.f + scl.y) + sh.y;
            o[i].z = v[i].z * rstd * gg.z * (1.f + scl.z) + sh.z; o[i].w = v[i].w * rstd * gg.w * (1.f + scl.w) + sh.w;
            mx = fmaxf(mx, fmaxf(fmaxf(fabsf(o[i].x), fabsf(o[i].y)), fmaxf(fabsf(o[i].z), fabsf(o[i].w))));
        }
        mx = wave_max(mx);
        const float inv = mx > 0.f ? 127.f / mx : 0.f;
        uint2* xn = (uint2*)(p.XN + (size_t)r * DM);
        unsigned* xq = (unsigned*)(p.XQ + (size_t)r * DM);
#pragma unroll
        for (int i = 0; i < 4; ++i) {
            xn[i * 64 + lane] = make_uint2(cvt_pk_bf16(o[i].x, o[i].y), cvt_pk_bf16(o[i].z, o[i].w));
            xq[i * 64 + lane] = pack_i8x4(o[i].x * inv, o[i].y * inv, o[i].z * inv, o[i].w * inv);
        }
        if (lane == 0) p.XS[r] = mx * (1.f / 127.f);
    }
}

__device__ void cvt_copy_bf16(const float* src, bf16_t* dst, size_t n) {
    const size_t n8 = n / 8;
    for (size_t i = (size_t)blockIdx.x * 256 + otid(); i < n8; i += (size_t)gridDim.x * 256) {
        const float4 a = ((const float4*)src)[2 * i], b = ((const float4*)src)[2 * i + 1];
        ((uint4*)dst)[i] = make_uint4(cvt_pk_bf16(a.x, a.y), cvt_pk_bf16(a.z, a.w), cvt_pk_bf16(b.x, b.y), cvt_pk_bf16(b.z, b.w));
    }
}

__device__ __forceinline__ unsigned lvl4(float x, float inv) { return (unsigned)(int)__builtin_amdgcn_fmed3f(fmaf(x, inv, 8.f), 0.f, 15.5f); }
__device__ void quant_rows_i4(const float* src, unsigned char* dst, float* scl, int rfirst, int nrows, int stride) {
    const int lane = otid() & 63;
    for (int r = rfirst; r < nrows; r += 4 * stride) {
        float4 v[4][4]; float mx[4], ss[4];
#pragma unroll
        for (int h = 0; h < 4; ++h) {
            const int rr = r + h * stride < nrows ? r + h * stride : r;
            const float4* sp = (const float4*)(src + (size_t)rr * 1024);
#pragma unroll
            for (int i = 0; i < 4; ++i) v[h][i] = sp[i * 64 + lane];
        }
#pragma unroll
        for (int h = 0; h < 4; ++h) {
            float m_ = 0.f, s_ = 0.f;
#pragma unroll
            for (int i = 0; i < 4; ++i) {
                m_ = fmaxf(m_, fmaxf(fmaxf(fabsf(v[h][i].x), fabsf(v[h][i].y)), fmaxf(fabsf(v[h][i].z), fabsf(v[h][i].w))));
                s_ += v[h][i].x * v[h][i].x + v[h][i].y * v[h][i].y + v[h][i].z * v[h][i].z + v[h][i].w * v[h][i].w;
            }
            mx[h] = wave_max(m_); ss[h] = wave_sum(s_);
        }
#pragma unroll
        for (int h = 0; h < 4; ++h) {
            const int rr = r + h * stride;
            if (rr < nrows) {
                const float step = fmaxf(0.3352f * sqrtf(ss[h] * (1.f / 1024.f)), mx[h] * (1.f / 16.f));
                const float inv = step > 0.f ? 1.f / step : 0.f;
                unsigned* dp = (unsigned*)(dst + (size_t)rr * 512);
#pragma unroll
                for (int i = 0; i < 4; ++i) {
                    const float4 x = v[h][i];
                    unsigned n = lvl4(x.x, inv) | (lvl4(x.y, inv) << 8) | (lvl4(x.z, inv) << 16) | (lvl4(x.w, inv) << 24);
                    if (lane & 1) n = (n ^ 0x08080808u) << 4;
                    n |= (unsigned)__builtin_amdgcn_update_dpp(0, (int)n, 0xB1, 0xF, 0xF, true);
                    if (!(lane & 1)) dp[i * 32 + (lane >> 1)] = n;
                }
                if (lane == 0) scl[rr] = step;
            }
        }
    }
}

__device__ void ph_normmod(const float* src, const float* g, const float* modv_layer, int shift_off, int scale_off, bf16_t* dst, int nrows) {
    const int lane = otid() & 63, wid = otid() >> 6;
    for (int r = blockIdx.x * 4 + wid; r < nrows; r += gridDim.x * 4) {
        const float4* s4 = (const float4*)(src + (size_t)r * DM);
        float4 v[4]; float ss = 0.f;
#pragma unroll
        for (int i = 0; i < 4; ++i) { v[i] = s4[i * 64 + lane]; ss += v[i].x * v[i].x + v[i].y * v[i].y + v[i].z * v[i].z + v[i].w * v[i].w; }
        ss = wave_sum(ss);
        const float rstd = rsqrtf(ss * (1.0f / DM) + 1e-6f);
        const float* mv = modv_layer + (size_t)modrow(r) * 6144;
        uint2* d2 = (uint2*)(dst + (size_t)r * DM);
#pragma unroll
        for (int i = 0; i < 4; ++i) {
            const int c = (i * 64 + lane) * 4;
            const float4 gg = *(const float4*)(g + c), sh = *(const float4*)(mv + shift_off + c), scl = *(const float4*)(mv + scale_off + c);
            float4 o;
            o.x = v[i].x * rstd * gg.x * (1.f + scl.x) + sh.x; o.y = v[i].y * rstd * gg.y * (1.f + scl.y) + sh.y;
            o.z = v[i].z * rstd * gg.z * (1.f + scl.z) + sh.z; o.w = v[i].w * rstd * gg.w * (1.f + scl.w) + sh.w;
            d2[i * 64 + lane] = make_uint2(cvt_pk_bf16(o.x, o.y), cvt_pk_bf16(o.z, o.w));
        }
    }
}

__device__ void ph_final(const P& p) {
    const int lane = otid() & 63, wid = otid() >> 6;
    for (int r = blockIdx.x * 4 + wid; r < NL; r += gridDim.x * 4) {
        const float4* s4 = (const float4*)(p.H + (size_t)r * DM);
        float4 v[4]; float ss = 0.f;
#pragma unroll
        for (int i = 0; i < 4; ++i) { v[i] = s4[i * 64 + lane]; ss += v[i].x * v[i].x + v[i].y * v[i].y + v[i].z * v[i].z + v[i].w * v[i].w; }
        ss = wave_sum(ss);
        const float rstd = rsqrtf(ss * (1.0f / DM) + 1e-6f);
        float4* d4 = (float4*)(p.out + (size_t)r * DM);
#pragma unroll
        for (int i = 0; i < 4; ++i) {
            const int c = (i * 64 + lane) * 4; const float4 gg = *(const float4*)(p.final_g + c);
            float4 o; o.x = v[i].x * rstd * gg.x; o.y = v[i].y * rstd * gg.y; o.z = v[i].z * rstd * gg.z; o.w = v[i].w * rstd * gg.w;
            d4[i * 64 + lane] = o;
        }
    }
}

#define GL_ROWB 144
#define GL_TILEB (128 * GL_ROWB)
struct TokPos { int b, pos, kpos; bool lat; };
__device__ __forceinline__ TokPos tokpos(int row) {
    TokPos t; t.lat = row < NL;
    if (t.lat) { t.b = row >> 11; t.pos = row & 2047; t.kpos = 256 + t.pos; } else { const int r = row - NL; t.b = r >> 8; t.pos = r & 255; t.kpos = t.pos; }
    return t;
}
struct EpiStoreBF16 {
    bf16_t* C; int ldc;
    __device__ __forceinline__ bool swapped(int) const { return false; }
    __device__ __forceinline__ void operator()(const f32x4 (&acc)[4][4], int m0, int n0, int wm, int wn, int fr, int fq) const {
#pragma unroll
        for (int mi = 0; mi < 4; ++mi)
#pragma unroll
            for (int ni = 0; ni < 4; ++ni) {
                const f32x4 v = acc[ni][mi];
                *(uint2*)(C + (size_t)(m0 + wm * 64 + mi * 16 + fr) * ldc + n0 + wn * 64 + ni * 16 + fq * 4) = make_uint2(cvt_pk_bf16(v[0], v[1]), cvt_pk_bf16(v[2], v[3]));
            }
    }
};
struct EpiResid {
    float* H; const float* gate; float scale;
    __device__ __forceinline__ bool swapped(int) const { return false; }
    __device__ __forceinline__ void operator()(const f32x4 (&acc)[4][4], int m0, int n0, int wm, int wn, int fr, int fq) const {
#pragma unroll
        for (int mi = 0; mi < 4; ++mi) {
            const int row = m0 + wm * 64 + mi * 16 + fr;
            const float* gp = gate + (size_t)modrow(row) * 6144;
            f32x4 g[4], h[4];
#pragma unroll
            for (int ni = 0; ni < 4; ++ni) {
                const int col = n0 + wn * 64 + ni * 16 + fq * 4;
                g[ni] = *(const f32x4*)(gp + col); h[ni] = *(const f32x4*)(H + (size_t)row * DM + col);
            }
            __builtin_amdgcn_sched_barrier(0);
#pragma unroll
            for (int ni = 0; ni < 4; ++ni) {
                const int col = n0 + wn * 64 + ni * 16 + fq * 4;
                *(f32x4*)(H + (size_t)row * DM + col) = h[ni] + g[ni] * acc[ni][mi] * scale;
            }
            __builtin_amdgcn_sched_barrier(0);
        }
    }
};
__device__ __forceinline__ void rope_store64(const f32x4 (&acc)[4][4], int mi, bool do_rope, const float* ropep  , float scale, bf16_t* dst  , int fq) {
#pragma unroll
    for (int ni = 0; ni < 2; ++ni) {
        f32x4 x1 = acc[ni][mi], x2 = acc[ni + 2][mi];
        if (do_rope) {
            const f32x4 r0 = *(const f32x4*)(ropep + (ni * 16 + fq * 4) * 2), r1 = *(const f32x4*)(ropep + (ni * 16 + fq * 4) * 2 + 4);
            const f32x4 cs = (f32x4){r0[0], r0[2], r1[0], r1[2]}, sn = (f32x4){r0[1], r0[3], r1[1], r1[3]};
            const f32x4 y1 = x1 * cs - x2 * sn, y2 = x1 * sn + x2 * cs;
            x1 = y1; x2 = y2;
        }
        x1 = x1 * scale; x2 = x2 * scale;
        *(uint2*)(dst + ni * 16 + fq * 4) = make_uint2(cvt_pk_bf16(x1[0], x1[1]), cvt_pk_bf16(x1[2], x1[3]));
        *(uint2*)(dst + 32 + ni * 16 + fq * 4) = make_uint2(cvt_pk_bf16(x2[0], x2[1]), cvt_pk_bf16(x2[2], x2[3]));
    }
}
struct EpiEven {
    bf16_t *PB, *AQL, *AQC, *AK, *AV; float* GT; const float* rope;
    __device__ __forceinline__ bool swapped(int n0) const { return n0 >= 2560 && n0 < 3072; }
    __device__ __forceinline__ void operator()(const f32x4 (&acc)[4][4], int m0, int n0, int wm, int wn, int fr, int fq) const {
        const int t = n0 >> 7;
        if (t < 12) {
#pragma unroll
            for (int mi = 0; mi < 4; ++mi)
#pragma unroll
                for (int ni = 0; ni < 4; ++ni) {
                    const f32x4 v = acc[ni][mi];
                    *(uint2*)(PB + (size_t)(m0 + wm * 64 + mi * 16 + fr) * 1536 + n0 + wn * 64 + ni * 16 + fq * 4) = make_uint2(cvt_pk_bf16(v[0], v[1]), cvt_pk_bf16(v[2], v[3]));
                }
        } else if (t < 20) {
            const bool isq = t < 16; const int h = t & 3;
#pragma unroll
            for (int mi = 0; mi < 4; ++mi) {
                const TokPos tp = tokpos(m0 + wm * 64 + mi * 16 + fr);
                const int hm = (tp.b * 4 + h) * 2 + wn;
                bf16_t* dst;
                if (isq) dst = tp.lat ? AQL + ((size_t)hm * 2048 + tp.pos) * 64 : AQC + ((size_t)hm * 256 + tp.pos) * 64;
                else dst = AK + ((size_t)hm * 2304 + tp.kpos) * 64;
                rope_store64(acc, mi, tp.lat, rope + (size_t)tp.pos * 64, isq ? QSCALE : 1.0f, dst, fq);
            }
        } else if (t < 24) {
            const int h = t - 20;
#pragma unroll
            for (int mi = 0; mi < 4; ++mi) {
                const TokPos tp = tokpos(m0 + wm * 64 + mi * 16 + fq * 4);
#pragma unroll
                for (int ni = 0; ni < 4; ++ni) {
                    const f32x4 v = acc[ni][mi];
                    const int d = wn * 64 + ni * 16 + fr;
                    *(uint2*)(AV + ((size_t)(tp.b * 4 + h) * 128 + d) * 2304 + tp.kpos) = make_uint2(cvt_pk_bf16(v[0], v[1]), cvt_pk_bf16(v[2], v[3]));
                }
            }
        } else {
            if (wn == 0) {
#pragma unroll
                for (int mi = 0; mi < 4; ++mi) *(f32x4*)(GT + (size_t)(m0 + wm * 64 + mi * 16 + fr) * 16 + fq * 4) = acc[0][mi];
            }
        }
    }
};
struct EpiOdd {
    bf16_t *AQL, *AQC, *AK, *AV; const float* rope;
    __device__ __forceinline__ bool swapped(int n0) const { return n0 >= 1280; }
    __device__ __forceinline__ void operator()(const f32x4 (&acc)[4][4], int m0, int n0, int wm, int wn, int fr, int fq) const {
        const int t = n0 >> 7;
        if (t < 10) {
            const bool isq = t < 8; const int hd = isq ? t * 2 + wn : (t - 8) * 2 + wn;
#pragma unroll
            for (int mi = 0; mi < 4; ++mi) {
                const TokPos tp = tokpos(m0 + wm * 64 + mi * 16 + fr);
                bf16_t* dst;
                if (isq) dst = tp.lat ? AQL + ((size_t)(tp.b * 16 + hd) * 2048 + tp.pos) * 64 : AQC + ((size_t)(tp.b * 16 + hd) * 256 + tp.pos) * 64;
                else dst = AK + ((size_t)(tp.b * 4 + hd) * 2304 + tp.kpos) * 64;
                rope_store64(acc, mi, tp.lat, rope + (size_t)tp.pos * 64, isq ? QSCALE : 1.0f, dst, fq);
            }
        } else {
            const int hkv = (t - 10) * 2 + wn;
#pragma unroll
            for (int mi = 0; mi < 4; ++mi) {
                const TokPos tp = tokpos(m0 + wm * 64 + mi * 16 + fq * 4);
#pragma unroll
                for (int ni = 0; ni < 4; ++ni) {
                    const f32x4 v = acc[ni][mi];
                    const int d = ni * 16 + fr;
                    *(uint2*)(AV + ((size_t)(tp.b * 4 + hkv) * 64 + d) * 2304 + tp.kpos) = make_uint2(cvt_pk_bf16(v[0], v[1]), cvt_pk_bf16(v[2], v[3]));
                }
            }
        }
    }
};
#define LDS_AS __attribute__((address_space(3)))
template <bool SWAP>
__device__ __forceinline__ void gemm_tile_kloop(f32x4 (&acc)[4][4], const bf16_t* aub, const bf16_t* bub, char* smem, int lrow, int lch, int wm, int wn, int fr, int fq) {
    const int tid = lrow * 8 + lch, wid = tid >> 6, lane = tid & 63;
    const int srow = wid * 8 + (lane >> 3);
    const unsigned goff = (unsigned)(srow * DM + (((lane & 7) ^ (srow & 7)) << 3)) * 2u;
#define GL_DMA(BUF, KO) { _Pragma("unroll") for (int i = 0; i < 4; ++i) { \
        __builtin_amdgcn_global_load_lds((const unsigned*)((const char*)aub + ((size_t)(32 * i) * DM + (KO)) * 2 + goff), (LDS_AS unsigned*)((BUF) + (i * 32 + wid * 8) * 128), 16, 0, 0); \
        __builtin_amdgcn_global_load_lds((const unsigned*)((const char*)bub + ((size_t)(32 * i) * DM + (KO)) * 2 + goff), (LDS_AS unsigned*)((BUF) + 16384 + (i * 32 + wid * 8) * 128), 16, 0, 0); } }
    const int xr = fr & 7;
    GL_DMA(smem, 0)
    __syncthreads();
    for (int kt = 0; kt < 16; ++kt) {
        char* cur = smem + (kt & 1) * 32768;
        char* nxt = smem + ((kt + 1) & 1) * 32768;
        if (kt + 1 < 16) GL_DMA(nxt, (kt + 1) * 64)
#pragma unroll
        for (int ks = 0; ks < 2; ++ks) {
            bf16x8 af[4], wf[4];
#pragma unroll
            for (int i = 0; i < 4; ++i) {
                af[i] = *(const bf16x8*)(cur + (wm * 64 + i * 16 + fr) * 128 + (((ks * 4 + fq) ^ xr) << 4));
                wf[i] = *(const bf16x8*)(cur + 16384 + (wn * 64 + i * 16 + fr) * 128 + (((ks * 4 + fq) ^ xr) << 4));
            }
#pragma unroll
            for (int ni = 0; ni < 4; ++ni)
#pragma unroll
                for (int mi = 0; mi < 4; ++mi)
                    acc[ni][mi] = SWAP ? __builtin_amdgcn_mfma_f32_16x16x32_bf16(af[mi], wf[ni], acc[ni][mi], 0, 0, 0)
                                       : __builtin_amdgcn_mfma_f32_16x16x32_bf16(wf[ni], af[mi], acc[ni][mi], 0, 0, 0);
        }
        __syncthreads();
    }
#undef GL_DMA
}
struct NoTail { __device__ __forceinline__ void operator()(char*) const {} };
struct PrepTail {
    const float *pu, *pv; unsigned char *U8, *V8; float *USC, *VSC; int Ln; int* q;
    __device__ __forceinline__ void operator()(char* smem) const {
        int* s_item = (int*)(smem + 73728);
        const int wid_ = __builtin_amdgcn_readfirstlane(otid() >> 6);
        for (;;) {
            __syncthreads();
            if (otid() == 0) *s_item = atomicAdd(q, 1);
            __syncthreads();
            const int item = *s_item;
            if (item >= 512) break;
            const int rb = Ln * 16384 + (item & 255) * 64;
            if (item < 256) quant_rows_i4(pu, U8, USC, rb + wid_, rb + 64, 4); else quant_rows_i4(pv, V8, VSC, rb + wid_, rb + 64, 4);
        }
    }
};
template <class Epi, class Tail = NoTail>
__device__ void ph_gemm(const bf16_t* A, const bf16_t* Bt, int M, int Npad, const Epi& epi, char* smem, const Tail& tail = Tail()) {
    const int tid = otid(), lane = tid & 63, wid = tid >> 6, wm = wid >> 1, wn = wid & 1;
    const int fr = lane & 15, fq = lane >> 4;
    const int tm = M / 128, tn = Npad / 128, ntiles = tm * tn;
    const int lrow = tid >> 3, lch = tid & 7;
    for (int tile = blockIdx.x; tile < ntiles; tile += gridDim.x) {
        int m0, n0;
        {
            const int q = ntiles >> 3, rr = ntiles & 7, xcd = tile & 7, off = tile >> 3;
            const int w = (xcd < rr ? xcd * (q + 1) : rr * (q + 1) + (xcd - rr) * q) + off;
            const int nig = 8 * tn, gid = w / nig, fm = gid * 8, gsz = (tm - fm) < 8 ? (tm - fm) : 8;
            m0 = (fm + (w % nig) % gsz) * 128; n0 = ((w % nig) / gsz) * 128;
        }
        f32x4 acc[4][4];
#pragma unroll
        for (int a = 0; a < 4; ++a)
#pragma unroll
            for (int b = 0; b < 4; ++b) acc[a][b] = (f32x4){0.f, 0.f, 0.f, 0.f};
        const bf16_t* ap = A + (size_t)m0 * DM;
        const bf16_t* bp = Bt + (size_t)n0 * DM;
        if (epi.swapped(n0)) gemm_tile_kloop<true>(acc, ap, bp, smem, lrow, lch, wm, wn, fr, fq);
        else gemm_tile_kloop<false>(acc, ap, bp, smem, lrow, lch, wm, wn, fr, fq);
        int fr2 = fr, fq2 = fq, wm2 = wm, wn2 = wn;
        asm volatile("" : "+v"(fr2), "+v"(fq2), "+v"(wm2), "+v"(wn2));
        epi(acc, m0, n0, wm2, wn2, fr2, fq2);
    }
    tail(smem);
}

__device__ void ph_prep_even(const P& p, int j) {
    const float* cw = p.ev_conv_w + (size_t)j * 3 * 512; const float* cb = p.ev_conv_b + (size_t)j * 512;
    const size_t tot = (size_t)NT * 256;
    for (size_t i = (size_t)blockIdx.x * 256 + otid(); i < tot; i += (size_t)gridDim.x * 256) {
        const int r = (int)(i >> 8), c = (int)(i & 255) * 2;
        int t, T; if (r < NL) { t = r & 2047; T = 2048; } else { t = (r - NL) & 255; T = 256; }
        const unsigned x1 = *(const unsigned*)(p.PB + (size_t)r * 1536 + c);
        float v0 = cb[c] + bf_lo(x1) * cw[512 + c], v1 = cb[c + 1] + bf_hi(x1) * cw[512 + c + 1];
        if (t > 0) { const unsigned x0 = *(const unsigned*)(p.PB + (size_t)(r - 1) * 1536 + c); v0 += bf_lo(x0) * cw[c]; v1 += bf_hi(x0) * cw[c + 1]; }
        if (t < T - 1) { const unsigned x2 = *(const unsigned*)(p.PB + (size_t)(r + 1) * 1536 + c); v0 += bf_lo(x2) * cw[1024 + c]; v1 += bf_hi(x2) * cw[1024 + c + 1]; }
        v0 = silu_f(v0); v1 = silu_f(v1);
        if (c >= 256) { v0 *= 0.125f; v1 *= 0.125f; }
        *(unsigned*)(p.QKB + (size_t)r * 512 + c) = cvt_pk_bf16(v0, v1);
    }
}

#define FA_KROW 144
#define FA_VROW 144
__device__ __forceinline__ bf16x8 pack8(float a0, float a1, float a2, float a3, float a4, float a5, float a6, float a7) {
    const u32x4 u = (u32x4){cvt_pk_bf16(a0, a1), cvt_pk_bf16(a2, a3), cvt_pk_bf16(a4, a5), cvt_pk_bf16(a6, a7)};
    return __builtin_bit_cast(bf16x8, u);
}
template <int NDB, bool MASK>
__device__ __forceinline__ void flash_tile(const bf16x8 (&qf)[4], f32x16 (&o)[NDB], float& m, float& l, const char* Kl, const char* Vl, int lane, int qpos, int kp0) {
    const int j = lane & 31, h = lane >> 5;
    f32x16 s0, s1;
#pragma unroll
    for (int i = 0; i < 16; ++i) { s0[i] = 0.f; s1[i] = 0.f; }
#pragma unroll
    for (int ks = 0; ks < 4; ++ks) {
        const bf16x8 a0 = *(const bf16x8*)(Kl + j * FA_KROW + (2 * ks + h) * 16);
        const bf16x8 a1 = *(const bf16x8*)(Kl + (32 + j) * FA_KROW + (2 * ks + h) * 16);
        s0 = __builtin_amdgcn_mfma_f32_32x32x16_bf16(a0, qf[ks], s0, 0, 0, 0);
        s1 = __builtin_amdgcn_mfma_f32_32x32x16_bf16(a1, qf[ks], s1, 0, 0, 0);
    }
    if (MASK) {
#pragma unroll
        for (int r = 0; r < 16; ++r) {
            const int key = (r & 3) + 8 * (r >> 2) + 4 * h;
            const int d0 = qpos - (kp0 + key), d1 = d0 - 32;
            if (d0 > 128 || d0 < -128) s0[r] = -1e30f;
            if (d1 > 128 || d1 < -128) s1[r] = -1e30f;
        }
    }
    float mx = fmaxf(s0[0], s1[0]);
#pragma unroll
    for (int r = 1; r < 16; ++r) mx = fmaxf(mx, fmaxf(s0[r], s1[r]));
    mx = fmaxf(mx, SHX(mx, 32));
    float alpha = 1.0f;
    if (__ballot(mx - m > 8.0f)) {
        const float mn = fmaxf(m, mx);
        alpha = __builtin_amdgcn_exp2f(m - mn);
        m = mn;
#pragma unroll
        for (int db = 0; db < NDB; ++db) o[db] = o[db] * alpha;
    }
    float ls = 0.f;
#pragma unroll
    for (int r = 0; r < 16; ++r) { s0[r] = __builtin_amdgcn_exp2f(s0[r] - m); s1[r] = __builtin_amdgcn_exp2f(s1[r] - m); ls += s0[r] + s1[r]; }
    l = l * alpha + ls;
    bf16x8 pb[4];
    pb[0] = pack8(s0[0], s0[1], s0[2], s0[3], s0[4], s0[5], s0[6], s0[7]);
    pb[1] = pack8(s0[8], s0[9], s0[10], s0[11], s0[12], s0[13], s0[14], s0[15]);
    pb[2] = pack8(s1[0], s1[1], s1[2], s1[3], s1[4], s1[5], s1[6], s1[7]);
    pb[3] = pack8(s1[8], s1[9], s1[10], s1[11], s1[12], s1[13], s1[14], s1[15]);
#pragma unroll
    for (int db = 0; db < NDB; ++db)
#pragma unroll
        for (int kk = 0; kk < 4; ++kk) {
            const bf16x8 vf = *(const bf16x8*)(Vl + (db * 32 + j) * FA_VROW + kk * 32 + h * 16);
            o[db] = __builtin_amdgcn_mfma_f32_32x32x16_bf16(vf, pb[kk], o[db], 0, 0, 0);
        }
}

#define DA_BUFB 36864
__device__ void da_block(const P& p, int item, int L, int j, char* smem) {
    const int tid = otid(), lane = tid & 63, wid = tid >> 6, mp = wid & 1, qg = wid >> 1, jq = lane & 31, hh = lane >> 5;
    const bool lat = item < 1024;
    int b, h, qt;
    if (lat) { b = item >> 7; h = (item >> 5) & 3; qt = item & 31; } else { const int it = item - 1024; b = it >> 4; h = (it >> 2) & 3; qt = it & 3; }
    const int qi = qt * 64 + qg * 32 + jq;
    const bf16_t* qp = lat ? p.AQL + ((size_t)((b * 4 + h) * 2 + mp) * 2048 + qi) * 64 : p.AQC + ((size_t)((b * 4 + h) * 2 + mp) * 256 + qi) * 64;
    bf16x8 qf[4];
#pragma unroll
    for (int ks = 0; ks < 4; ++ks) qf[ks] = *(const bf16x8*)(qp + (2 * ks + hh) * 8);
    const int ntile = lat ? 36 : 4;
    const bf16_t* kg = p.AK + (size_t)((b * 4 + h) * 2) * 2304 * 64 + (size_t)(tid >> 3) * 64 + (tid & 7) * 8;
    const bf16_t* vg = p.AV + (size_t)(b * 4 + h) * 128 * 2304 + (size_t)(tid >> 3) * 2304 + (tid & 7) * 8;
    uint4 k0, k1, k2, k3, v0, v1, v2, v3;
#define DA_LOAD(KEY0) { k0 = *(const uint4*)(kg + (size_t)(KEY0) * 64); k1 = *(const uint4*)(kg + (size_t)((KEY0) + 32) * 64); \
                        k2 = *(const uint4*)(kg + (size_t)2304 * 64 + (size_t)(KEY0) * 64); k3 = *(const uint4*)(kg + (size_t)2304 * 64 + (size_t)((KEY0) + 32) * 64); \
                        v0 = *(const uint4*)(vg + (KEY0)); v1 = *(const uint4*)(vg + (size_t)32 * 2304 + (KEY0)); v2 = *(const uint4*)(vg + (size_t)64 * 2304 + (KEY0)); v3 = *(const uint4*)(vg + (size_t)96 * 2304 + (KEY0)); }
#define DA_STORE(BUF) { char* kb_ = (BUF) + (tid >> 3) * FA_KROW + (tid & 7) * 16; \
                        *(uint4*)kb_ = k0; *(uint4*)(kb_ + 32 * FA_KROW) = k1; *(uint4*)(kb_ + 64 * FA_KROW) = k2; *(uint4*)(kb_ + 96 * FA_KROW) = k3; \
                        char* vb_ = (BUF) + 18432 + (tid >> 3) * FA_VROW + ((tid & 7) >> 1) * 32 + (tid & 1) * 8; \
                        *(uint2*)vb_ = make_uint2(v0.x, v0.y); *(uint2*)(vb_ + 16) = make_uint2(v0.z, v0.w); \
                        *(uint2*)(vb_ + 32 * FA_VROW) = make_uint2(v1.x, v1.y); *(uint2*)(vb_ + 32 * FA_VROW + 16) = make_uint2(v1.z, v1.w); \
                        *(uint2*)(vb_ + 64 * FA_VROW) = make_uint2(v2.x, v2.y); *(uint2*)(vb_ + 64 * FA_VROW + 16) = make_uint2(v2.z, v2.w); \
                        *(uint2*)(vb_ + 96 * FA_VROW) = make_uint2(v3.x, v3.y); *(uint2*)(vb_ + 96 * FA_VROW + 16) = make_uint2(v3.z, v3.w); }
    f32x16 o[4];
#pragma unroll
    for (int db = 0; db < 4; ++db)
#pragma unroll
        for (int i = 0; i < 16; ++i) o[db][i] = 0.f;
    float m = -1e30f, l = 0.f;
    DA_LOAD(0)
    __syncthreads();
    DA_STORE(smem)
    __syncthreads();
    for (int t = 0; t < ntile; ++t) {
        char* cur = smem + (t & 1) * DA_BUFB;
        char* nxt = smem + ((t + 1) & 1) * DA_BUFB;
        if (t + 1 < ntile) DA_LOAD((t + 1) * 64)
        flash_tile<4, false>(qf, o, m, l, cur + mp * 9216, cur + 18432, lane, 0, 0);
        if (t + 1 < ntile) DA_STORE(nxt)
        __syncthreads();
    }
#undef DA_LOAD
#undef DA_STORE
    const float inv = 1.f / (l + SHX(l, 32));
#pragma unroll
    for (int db = 0; db < 4; ++db) o[db] = o[db] * inv;
    float* X = (float*)smem + qg * 4096;
    if (mp == 1) {
#pragma unroll
        for (int db = 0; db < 4; ++db)
#pragma unroll
            for (int r = 0; r < 16; ++r) X[(db * 32 + (r & 3) + 8 * (r >> 2) + 4 * hh) * 32 + jq] = o[db][r];
    }
    __syncthreads();
    if (mp == 0) {
        const float lam_init = 0.8f - 0.6f * expf(-0.3f * (float)L);
        const float* lp = p.ev_da_lam + (size_t)j * 256;
        float a0 = lp[lane] * lp[64 + lane], a1 = lp[128 + lane] * lp[192 + lane];
        a0 = wave_sum(a0); a1 = wave_sum(a1);
        const float lam = expf(a0) - expf(a1) + lam_init;
        float ss = 0.f;
#pragma unroll
        for (int db = 0; db < 4; ++db)
#pragma unroll
            for (int r = 0; r < 16; ++r) { const float v = o[db][r] - lam * X[(db * 32 + (r & 3) + 8 * (r >> 2) + 4 * hh) * 32 + jq]; o[db][r] = v; ss += v * v; }
        ss += SHX(ss, 32);
        const float sc = rsqrtf(ss * (1.f / 128.f) + 1e-6f) * (1.f - lam_init);
        const int row = lat ? b * 2048 + qi : NL + b * 256 + qi;
        bf16_t* mrow = p.MIX + (size_t)row * DM + 512 + h * 128;
        const float* g = p.ev_da_g + (size_t)j * 512 + h * 128;
#pragma unroll
        for (int db = 0; db < 4; ++db)
#pragma unroll
            for (int r4 = 0; r4 < 4; ++r4) {
                const int d = db * 32 + 8 * r4 + 4 * hh;
                const f32x4 gg = *(const f32x4*)(g + d);
                *(uint2*)(mrow + d) = make_uint2(cvt_pk_bf16(o[db][r4 * 4 + 0] * sc * gg[0], o[db][r4 * 4 + 1] * sc * gg[1]), cvt_pk_bf16(o[db][r4 * 4 + 2] * sc * gg[2], o[db][r4 * 4 + 3] * sc * gg[3]));
            }
    }
    __syncthreads();
}

#define WA_BUFB 18432
__device__ void wa_block(const P& p, int item, int j, char* smem) {
    const int tid = otid(), lane = tid & 63, wid = tid >> 6, jq = lane & 31, hh = lane >> 5;
    const bool lat = item < 2048;
    int b, nb, hq;
    if (lat) { hq = item & 15; nb = (item >> 4) & 15; b = item >> 8; } else { const int it = item - 2048; hq = it & 15; nb = (it >> 4) & 1; b = it >> 5; }
    const int hkv = hq >> 2;
    const int qi = nb * 128 + wid * 32 + jq;
    const bf16_t* qp = lat ? p.AQL + ((size_t)(b * 16 + hq) * 2048 + qi) * 64 : p.AQC + ((size_t)(b * 16 + hq) * 256 + qi) * 64;
    bf16x8 qf[4];
#pragma unroll
    for (int ks = 0; ks < 4; ++ks) qf[ks] = *(const bf16x8*)(qp + (2 * ks + hh) * 8);
    const int lfirst = (nb == 0) ? 2 : 0, nloc = lat ? 6 - lfirst - ((nb == 15) ? 2 : 0) : 0;
    const int ntile = 4 + nloc;
    const bf16_t* kg = p.AK + (size_t)(b * 4 + hkv) * 2304 * 64 + (size_t)(tid >> 3) * 64 + (tid & 7) * 8;
    const bf16_t* vg = p.AV + (size_t)(b * 4 + hkv) * 64 * 2304 + (size_t)(tid >> 3) * 2304 + (tid & 7) * 8;
    uint4 k0, k1, v0, v1;
#define WA_KEY0(T) ((T) < 4 ? (T) * 64 : 256 + (nb - 1) * 128 + ((T) - 4 + lfirst) * 64)
#define WA_LOAD(KEY0) { k0 = *(const uint4*)(kg + (size_t)(KEY0) * 64); k1 = *(const uint4*)(kg + (size_t)((KEY0) + 32) * 64); v0 = *(const uint4*)(vg + (KEY0)); v1 = *(const uint4*)(vg + (size_t)32 * 2304 + (KEY0)); }
#define WA_STORE(BUF) { char* kb_ = (BUF) + (tid >> 3) * FA_KROW + (tid & 7) * 16; *(uint4*)kb_ = k0; *(uint4*)(kb_ + 32 * FA_KROW) = k1; \
                        char* vb_ = (BUF) + 9216 + (tid >> 3) * FA_VROW + ((tid & 7) >> 1) * 32 + (tid & 1) * 8; \
                        *(uint2*)vb_ = make_uint2(v0.x, v0.y); *(uint2*)(vb_ + 16) = make_uint2(v0.z, v0.w); \
                        *(uint2*)(vb_ + 32 * FA_VROW) = make_uint2(v1.x, v1.y); *(uint2*)(vb_ + 32 * FA_VROW + 16) = make_uint2(v1.z, v1.w); }
    f32x16 o[2];
#pragma unroll
    for (int db = 0; db < 2; ++db)
#pragma unroll
        for (int i = 0; i < 16; ++i) o[db][i] = 0.f;
    float m = p.od_sink[j * 16 + hq] * 1.4426950408889634f, l = hh == 0 ? 1.f : 0.f;
    { const int key0 = WA_KEY0(0); WA_LOAD(key0) }
    __syncthreads();
    WA_STORE(smem)
    __syncthreads();
    for (int t = 0; t < ntile; ++t) {
        char* cur = smem + (t & 1) * WA_BUFB;
        char* nxt = smem + ((t + 1) & 1) * WA_BUFB;
        if (t + 1 < ntile) { const int key0 = WA_KEY0(t + 1); WA_LOAD(key0) }
        if (t < 4) flash_tile<2, false>(qf, o, m, l, cur, cur + 9216, lane, 0, 0);
        else flash_tile<2, true>(qf, o, m, l, cur, cur + 9216, lane, qi, WA_KEY0(t) - 256);
        if (t + 1 < ntile) WA_STORE(nxt)
        __syncthreads();
    }
#undef WA_LOAD
#undef WA_STORE
#undef WA_KEY0
    const float inv = 1.f / (l + SHX(l, 32));
    const int row = lat ? b * 2048 + qi : NL + b * 256 + qi;
    bf16_t* mrow = p.MIX + (size_t)row * DM + hq * 64;
#pragma unroll
    for (int db = 0; db < 2; ++db)
#pragma unroll
        for (int r4 = 0; r4 < 4; ++r4) {
            const int d = db * 32 + 8 * r4 + 4 * hh;
            *(uint2*)(mrow + d) = make_uint2(cvt_pk_bf16(o[db][r4 * 4 + 0] * inv, o[db][r4 * 4 + 1] * inv), cvt_pk_bf16(o[db][r4 * 4 + 2] * inv, o[db][r4 * 4 + 3] * inv));
        }
}

__device__ __forceinline__ uint4 ml_conv8(const P& p, int j, int b, int tc, int st, int c0) {
    const int row = tc < 4 ? NL + b * 256 + tc * 64 + st : b * 2048 + (tc - 4) * 64 + st;
    const int t = tc < 4 ? tc * 64 + st : (tc - 4) * 64 + st, T = tc < 4 ? 256 : 2048;
    const float* cw = p.ev_conv_w + (size_t)j * 3 * 512 + c0; const float* cb = p.ev_conv_b + (size_t)j * 512 + c0;
    const uint4 x1 = *(const uint4*)(p.PB + (size_t)row * 1536 + c0);
    uint4 x0 = make_uint4(0u, 0u, 0u, 0u), x2 = x0;
    if (t > 0) x0 = *(const uint4*)(p.PB + (size_t)(row - 1) * 1536 + c0);
    if (t < T - 1) x2 = *(const uint4*)(p.PB + (size_t)(row + 1) * 1536 + c0);
    float a[8], bq[8], cq[8]; unpack8(x0, a); unpack8(x1, bq); unpack8(x2, cq);
    const float sc = c0 >= 256 ? 0.125f : 1.f;
    float o[8];
#pragma unroll
    for (int q = 0; q < 8; ++q) o[q] = silu_f(cb[q] + a[q] * cw[q] + bq[q] * cw[512 + q] + cq[q] * cw[1024 + q]) * sc;
    return make_uint4(cvt_pk_bf16(o[0], o[1]), cvt_pk_bf16(o[2], o[3]), cvt_pk_bf16(o[4], o[5]), cvt_pk_bf16(o[6], o[7]));
}
__device__ __forceinline__ int ml_row(int b, int tc, int i) { return tc < 4 ? NL + b * 256 + tc * 64 + i : b * 2048 + (tc - 4) * 64 + i; }
__device__ __forceinline__ void ml_gates(const P& p, int j, int b, int h, int dir, int tc, int lane, float* sa, float* sb, float* sml, float& Bt, float& Mc) {
    const int row = ml_row(b, tc, lane);
    const float ig = p.GT[(size_t)row * 16 + (dir * 2) * 4 + h] + p.ev_gate_b[j * 16 + (dir * 2) * 4 + h];
    const float lf = log_sigmoid_f(p.GT[(size_t)row * 16 + (dir * 2 + 1) * 4 + h] + p.ev_gate_b[j * 16 + (dir * 2 + 1) * 4 + h]);
    float bc = lf;
    if (dir == 0) {
#pragma unroll
        for (int o = 1; o < 64; o <<= 1) { const float t2 = lshfl(bc, lane - o); if (lane >= o) bc += t2; }
    } else {
#pragma unroll
        for (int o = 1; o < 64; o <<= 1) { const float t2 = lshfl(bc, lane + o); if (lane + o < 64) bc += t2; }
    }
    const float a = ig - bc;
    float ml = a;
    if (dir == 0) {
#pragma unroll
        for (int o = 1; o < 64; o <<= 1) { const float t2 = lshfl(ml, lane - o); if (lane >= o) ml = fmaxf(ml, t2); }
    } else {
#pragma unroll
        for (int o = 1; o < 64; o <<= 1) { const float t2 = lshfl(ml, lane + o); if (lane + o < 64) ml = fmaxf(ml, t2); }
    }
    sa[lane] = a; sb[lane] = bc; sml[lane] = ml;
    const int last = dir == 0 ? 63 : 0;
    Bt = lshfl(bc, last); Mc = lshfl(ml, last);
}
__device__ __forceinline__ int ml_tc_of(int dir, int c) { return dir == 0 ? c : (c < 4 ? 3 - c : 39 - c); }
__device__ __forceinline__ int ml_c_of(int dir, int tc) { return dir == 0 ? tc : (tc < 4 ? 3 - tc : 39 - tc); }

__device__ void ml_pass1_item(const P& p, int item, int j, char* smem) {
    const int c = item % 36, dir = (item / 36) & 1, h = (item / 72) & 3, b = item / 288;
    const int tc = ml_tc_of(dir, c);
    const int tid = otid(), lane = tid & 63, wid = tid >> 6, jl = lane & 31, hh = lane >> 5;
    bf16_t* VT = (bf16_t*)smem;
    bf16_t* KWT = (bf16_t*)(smem + 18432);
    float* sa = (float*)(smem + 27648);
    float* sb = sa + 64; float* sml = sb + 64; float* sw = sml + 64; float* ssc = sw + 64;
    __syncthreads();
    if (wid == 0) {
        float Bt, Mc; ml_gates(p, j, b, h, dir, tc, lane, sa, sb, sml, Bt, Mc);
        sw[lane] = expf(sa[lane] - Mc);
        if (lane == 0) { p.CHB[item] = Bt; p.CHM[item] = Mc; }
    }
    __syncthreads();
#pragma unroll
    for (int i = 0; i < 4; ++i) {
        const int e = tid + 256 * i, st = e >> 4, ch = e & 15;
        const uint4 u = *(const uint4*)(p.PB + (size_t)ml_row(b, tc, st) * 1536 + 512 + h * 128 + ch * 8);
        bf16_t* d = VT + (ch * 8) * 72 + st;
        d[0] = (bf16_t)u.x; d[72] = (bf16_t)(u.x >> 16); d[144] = (bf16_t)u.y; d[216] = (bf16_t)(u.y >> 16);
        d[288] = (bf16_t)u.z; d[360] = (bf16_t)(u.z >> 16); d[432] = (bf16_t)u.w; d[504] = (bf16_t)(u.w >> 16);
    }
#pragma unroll
    for (int i = 0; i < 2; ++i) {
        const int e = tid + 256 * i, st = e >> 3, ch = e & 7;
        const uint4 u = ml_conv8(p, j, b, tc, st, 256 + h * 64 + ch * 8);
        const float w = sw[st];
        bf16_t* d = KWT + (ch * 8) * 72 + st;
        const unsigned q0 = cvt_pk_bf16(bf_lo(u.x) * w, bf_hi(u.x) * w), q1 = cvt_pk_bf16(bf_lo(u.y) * w, bf_hi(u.y) * w), q2 = cvt_pk_bf16(bf_lo(u.z) * w, bf_hi(u.z) * w), q3 = cvt_pk_bf16(bf_lo(u.w) * w, bf_hi(u.w) * w);
        d[0] = (bf16_t)q0; d[72] = (bf16_t)(q0 >> 16); d[144] = (bf16_t)q1; d[216] = (bf16_t)(q1 >> 16);
        d[288] = (bf16_t)q2; d[360] = (bf16_t)(q2 >> 16); d[432] = (bf16_t)q3; d[504] = (bf16_t)(q3 >> 16);
    }
    __syncthreads();
    {
        const int db = wid & 1, vb0 = (wid >> 1) * 2;
        bf16x8 kf[4];
#pragma unroll
        for (int ks = 0; ks < 4; ++ks) kf[ks] = *(const bf16x8*)((const char*)KWT + (db * 32 + jl) * 144 + (2 * ks + hh) * 16);
        float* cl = p.CLOC + (size_t)item * 8192;
#pragma unroll
        for (int vv = 0; vv < 2; ++vv) {
            const int vb = vb0 + vv;
            f32x16 acc;
#pragma unroll
            for (int r = 0; r < 16; ++r) acc[r] = 0.f;
#pragma unroll
            for (int ks = 0; ks < 4; ++ks) {
                const bf16x8 vf = *(const bf16x8*)((const char*)VT + (vb * 32 + jl) * 144 + (2 * ks + hh) * 16);
                acc = __builtin_amdgcn_mfma_f32_32x32x16_bf16(vf, kf[ks], acc, 0, 0, 0);
            }
#pragma unroll
            for (int r = 0; r < 16; ++r) cl[(size_t)(vb * 32 + (r & 3) + 8 * (r >> 2) + 4 * hh) * 64 + db * 32 + jl] = acc[r];
        }
        if (tid < 64) {
            float sum = 0.f;
#pragma unroll
            for (int q = 0; q < 8; ++q) { const uint4 u = *(const uint4*)((const char*)KWT + tid * 144 + q * 16); sum += bf_lo(u.x) + bf_hi(u.x) + bf_lo(u.y) + bf_hi(u.y) + bf_lo(u.z) + bf_hi(u.z) + bf_lo(u.w) + bf_hi(u.w); }
            p.NLOC[(size_t)item * 64 + tid] = sum;
        }
    }
}

__device__ void ph_ml_pass2(const P& p) {
    const int gt = blockIdx.x * 256 + otid(), nthr = gridDim.x * 256;
    for (int w = gt; w < 64 * 2048; w += nthr) {
        const int chain = w >> 11, e = (w & 2047) * 4;
        float c0 = 0.f, c1 = 0.f, c2 = 0.f, c3 = 0.f, m = 0.f;
        const float4* clp = (const float4*)(p.CLOC + (size_t)chain * 36 * 8192 + e);
        float4 nx[6]; float nb[6], nm[6];
#pragma unroll
        for (int k = 0; k < 6; ++k) { nx[k] = clp[k * 2048]; nb[k] = p.CHB[chain * 36 + k]; nm[k] = p.CHM[chain * 36 + k]; }
#pragma unroll 1
        for (int cg = 0; cg < 36; cg += 6) {
            float4 cl[6]; float bt[6], mc[6];
#pragma unroll
            for (int k = 0; k < 6; ++k) { cl[k] = nx[k]; bt[k] = nb[k]; mc[k] = nm[k]; }
            if (cg + 6 < 36) {
#pragma unroll
                for (int k = 0; k < 6; ++k) { nx[k] = clp[(cg + 6 + k) * 2048]; nb[k] = p.CHB[chain * 36 + cg + 6 + k]; nm[k] = p.CHM[chain * 36 + cg + 6 + k]; }
            }
#pragma unroll
            for (int k = 0; k < 6; ++k) {
                const int it = chain * 36 + cg + k;
                *(uint2*)(p.CST + (size_t)it * 8192 + e) = make_uint2(cvt_pk_bf16(c0, c1), cvt_pk_bf16(c2, c3));
                const float g = fmaxf(m, mc[k]), al = expf(m - g), be = expf(mc[k] - g);
                c0 = al * c0 + be * cl[k].x; c1 = al * c1 + be * cl[k].y; c2 = al * c2 + be * cl[k].z; c3 = al * c3 + be * cl[k].w;
                m = bt[k] + g;
            }
        }
    }
    for (int w = gt; w < 64 * 64; w += nthr) {
        const int chain = w >> 6, d = w & 63;
        float n = 0.f, m = 0.f;
#pragma unroll 1
        for (int cg = 0; cg < 36; cg += 12) {
            float bt[12], mc[12], nl[12];
#pragma unroll
            for (int k = 0; k < 12; ++k) { const int it = chain * 36 + cg + k; bt[k] = p.CHB[it]; mc[k] = p.CHM[it]; nl[k] = p.NLOC[(size_t)it * 64 + d]; }
#pragma unroll
            for (int k = 0; k < 12; ++k) {
                const int it = chain * 36 + cg + k;
                p.NST[(size_t)it * 64 + d] = n;
                if (d == 0) p.MST[it] = m;
                const float g = fmaxf(m, mc[k]);
                n = expf(m - g) * n + expf(mc[k] - g) * nl[k];
                m = bt[k] + g;
            }
        }
    }
}

__device__ void ml_pass3_item(const P& p, int item, int j, char* smem) {
    const int tc = item % 36, h = (item / 36) & 3, b = item / 144;
    const int tid = otid(), lane = tid & 63, wid = tid >> 6, jl = lane & 31, hh = lane >> 5, tb = wid & 1, dir = wid >> 1;
    char* Ql = smem;
    char* Kl = smem + 9216;
    bf16_t* VT = (bf16_t*)(smem + 18432);
    float* gs = (float*)(smem + 35840);
    float* ssc = gs + 512;
    __syncthreads();
    if (wid < 2) {
        const int d2 = wid; float Bt, Mc;
        float* sa = gs + d2 * 256; float* sb = sa + 64; float* sg = sb + 64; float* sn = sg + 64;
        ml_gates(p, j, b, h, d2, tc, lane, sa, sb, sg, Bt, Mc);
        const int sidx = ((b * 4 + h) * 2 + d2) * 36 + ml_c_of(d2, tc);
        const float mst = p.MST[sidx];
        sg[lane] = fmaxf(mst, sg[lane]);
        sn[lane] = p.NST[(size_t)sidx * 64 + lane];
        if (lane == 0) ssc[d2] = mst;
    }
#pragma unroll
    for (int i = 0; i < 2; ++i) {
        const int e = tid + 256 * i, st = e >> 3, ch = e & 7; const int row = ml_row(b, tc, st);
        *(uint4*)(Ql + st * 144 + ch * 16) = ml_conv8(p, j, b, tc, st, h * 64 + ch * 8);
        *(uint4*)(Kl + st * 144 + ch * 16) = ml_conv8(p, j, b, tc, st, 256 + h * 64 + ch * 8);
    }
#pragma unroll
    for (int i = 0; i < 4; ++i) {
        const int e = tid + 256 * i, st = e >> 4, ch = e & 15;
        const uint4 u = *(const uint4*)(p.PB + (size_t)ml_row(b, tc, st) * 1536 + 512 + h * 128 + ch * 8);
        bf16_t* d = VT + (ch * 8) * 68 + st;
        d[0] = (bf16_t)u.x; d[68] = (bf16_t)(u.x >> 16); d[136] = (bf16_t)u.y; d[204] = (bf16_t)(u.y >> 16);
        d[272] = (bf16_t)u.z; d[340] = (bf16_t)(u.z >> 16); d[408] = (bf16_t)u.w; d[476] = (bf16_t)(u.w >> 16);
    }
    __syncthreads();
    const float* sa = gs + dir * 256; const float* sb = sa + 64; const float* sg = sb + 64; const float* sn = sg + 64;
    const int t = tb * 32 + jl;
    const float gtv = sg[t], btv = sb[t], mst = ssc[dir];
    const float e2 = expf(mst - gtv);
    const int sidx = ((b * 4 + h) * 2 + dir) * 36 + ml_c_of(dir, tc);
    bf16x8 qf[4];
#pragma unroll
    for (int ks = 0; ks < 4; ++ks) qf[ks] = *(const bf16x8*)(Ql + t * 144 + (2 * ks + hh) * 16);
    f32x16 acc[4];
    {
        const bf16_t* cst = p.CST + (size_t)sidx * 8192 + (size_t)jl * 64 + hh * 8;
#pragma unroll
        for (int vb = 0; vb < 4; ++vb) {
#pragma unroll
            for (int r = 0; r < 16; ++r) acc[vb][r] = 0.f;
#pragma unroll
            for (int ks = 0; ks < 4; ++ks) {
                const bf16x8 cf = *(const bf16x8*)(cst + (size_t)vb * 32 * 64 + ks * 16);
                acc[vb] = __builtin_amdgcn_mfma_f32_32x32x16_bf16(cf, qf[ks], acc[vb], 0, 0, 0);
            }
            acc[vb] = acc[vb] * e2;
        }
    }
    float den = 0.f;
    {
        float nq = 0.f;
#pragma unroll
        for (int ks = 0; ks < 4; ++ks) {
            const u32x4 u = __builtin_bit_cast(u32x4, qf[ks]);
            const float* np = sn + 16 * ks + 8 * hh;
            nq += bf_lo(u[0]) * np[0] + bf_hi(u[0]) * np[1] + bf_lo(u[1]) * np[2] + bf_hi(u[1]) * np[3] + bf_lo(u[2]) * np[4] + bf_hi(u[2]) * np[5] + bf_lo(u[3]) * np[6] + bf_hi(u[3]) * np[7];
        }
        den = e2 * nq;
    }
#pragma unroll
    for (int sbk = 0; sbk < 2; ++sbk) {
        const bool use = dir == 0 ? (sbk <= tb) : (sbk >= tb);
        if (use) {
            f32x16 sc;
#pragma unroll
            for (int r = 0; r < 16; ++r) sc[r] = 0.f;
#pragma unroll
            for (int ks = 0; ks < 4; ++ks) {
                const bf16x8 kf = *(const bf16x8*)(Kl + (sbk * 32 + jl) * 144 + (2 * ks + hh) * 16);
                sc = __builtin_amdgcn_mfma_f32_32x32x16_bf16(kf, qf[ks], sc, 0, 0, 0);
            }
#pragma unroll
            for (int r4 = 0; r4 < 4; ++r4) {
                const int s0 = sbk * 32 + 8 * r4 + 4 * hh;
                const f32x4 av = *(const f32x4*)(sa + s0);
#pragma unroll
                for (int q = 0; q < 4; ++q) {
                    const int s2 = s0 + q;
                    const bool ok = dir == 0 ? (s2 <= t) : (s2 >= t);
                    const float pv = ok ? sc[r4 * 4 + q] * expf(av[q] - gtv) : 0.f;
                    sc[r4 * 4 + q] = pv; den += pv;
                }
            }
            bf16x8 pb[2];
            pb[0] = pack8(sc[0], sc[1], sc[2], sc[3], sc[4], sc[5], sc[6], sc[7]);
            pb[1] = pack8(sc[8], sc[9], sc[10], sc[11], sc[12], sc[13], sc[14], sc[15]);
#pragma unroll
            for (int vb = 0; vb < 4; ++vb)
#pragma unroll
                for (int k2 = 0; k2 < 2; ++k2) {
                    const char* vp = (const char*)VT + (vb * 32 + jl) * 136 + (sbk * 32 + k2 * 16 + 4 * hh) * 2;
                    const uint2 lo = *(const uint2*)vp, hi = *(const uint2*)(vp + 16);
                    const u32x4 u = (u32x4){lo.x, lo.y, hi.x, hi.y};
                    acc[vb] = __builtin_amdgcn_mfma_f32_32x32x16_bf16(__builtin_bit_cast(bf16x8, u), pb[k2], acc[vb], 0, 0, 0);
                }
        }
    }
    den += SHX(den, 32);
    const float scl = 1.f / fmaxf(fabsf(den), expf(-(btv + gtv)));
#pragma unroll
    for (int vb = 0; vb < 4; ++vb) acc[vb] = acc[vb] * scl;
    __syncthreads();
    float* X = (float*)smem + tb * 4096;
    if (dir == 1) {
#pragma unroll
        for (int vb = 0; vb < 4; ++vb)
#pragma unroll
            for (int r = 0; r < 16; ++r) X[(vb * 32 + (r & 3) + 8 * (r >> 2) + 4 * hh) * 32 + jl] = acc[vb][r];
    }
    __syncthreads();
    if (dir == 0) {
        float ss = 0.f;
#pragma unroll
        for (int vb = 0; vb < 4; ++vb)
#pragma unroll
            for (int r = 0; r < 16; ++r) { const float v = acc[vb][r] + X[(vb * 32 + (r & 3) + 8 * (r >> 2) + 4 * hh) * 32 + jl]; acc[vb][r] = v; ss += v * v; }
        ss += SHX(ss, 32);
        const float rstd = rsqrtf(ss * (1.f / 128.f) + 1e-6f);
        const int row = ml_row(b, tc, t);
        const float* g = p.ev_ml_g + (size_t)j * 512 + h * 128;
        const bf16_t* og = p.PB + (size_t)row * 1536 + 1024 + h * 128;
        bf16_t* mrow = p.MIX + (size_t)row * DM + h * 128;
#pragma unroll
        for (int vb = 0; vb < 4; ++vb)
#pragma unroll
            for (int r4 = 0; r4 < 4; ++r4) {
                const int v = vb * 32 + 8 * r4 + 4 * hh;
                const f32x4 gg = *(const f32x4*)(g + v);
                const uint2 ou = *(const uint2*)(og + v);
                *(uint2*)(mrow + v) = make_uint2(cvt_pk_bf16(acc[vb][r4 * 4 + 0] * rstd * gg[0] * sigmoid_f(bf_lo(ou.x)), acc[vb][r4 * 4 + 1] * rstd * gg[1] * sigmoid_f(bf_hi(ou.x))),
                                                 cvt_pk_bf16(acc[vb][r4 * 4 + 2] * rstd * gg[2] * sigmoid_f(bf_lo(ou.y)), acc[vb][r4 * 4 + 3] * rstd * gg[3] * sigmoid_f(bf_hi(ou.y))));
            }
    }
}

__device__ void ph_attn_even(const P& p, int ci, int L, int j, float* smem) {
    int* s_item = (int*)((char*)smem + 73728);
    int* dq = p.ctr + 64 + ci * 8;
    const int myx = xcc_id8();
    for (int sdx = 0; sdx < 8; ++sdx) {
        const int x = (myx + sdx) & 7;
        for (;;) {
            __syncthreads();
            if (otid() == 0) *s_item = atomicAdd(&dq[x], 1);
            __syncthreads();
            const int i = *s_item;
            if (i >= 144) break;
            const int pr = x + 8 * (i / 36), jq = i % 36, b = pr >> 2, h = pr & 3;
            da_block(p, jq < 32 ? b * 128 + h * 32 + jq : 1024 + b * 16 + h * 4 + (jq - 32), L, j, (char*)smem);
        }
    }
    for (;;) {
        __syncthreads();
        if (otid() == 0) *s_item = atomicAdd(&p.ctr[ci], 1);
        __syncthreads();
        const int item = *s_item;
        if (item >= 2304) break;
        ml_pass1_item(p, item, j, (char*)smem);
    }
}
__device__ void ph_ml_pass3(const P& p, int j, float* smem) {
    for (int item = blockIdx.x; item < 1152; item += gridDim.x) ml_pass3_item(p, item, j, (char*)smem);
}
__device__ void ph_attn_odd(const P& p, int j, bool need_ctx, float* smem) {
    const int nitem = need_ctx ? 2304 : 2048;
    for (int item = blockIdx.x; item < nitem; item += gridDim.x) { wa_block(p, item, j, (char*)smem); __syncthreads(); }
}

#define SEL_LD 132
#define SEL_NOCACHE 1
template <int NV>
__device__ __forceinline__ unsigned topk16_threshold(const unsigned (&k)[NV], unsigned start, bool& exact) {
    auto cnt = [&](unsigned c) { int n = 0;
#pragma unroll
        for (int i = 0; i < NV; ++i) n += __builtin_popcountll(__ballot(k[i] >= c));
        return n; };
    unsigned E = start; int n = cnt(E);
    if (n >= 16) { for (;;) { const unsigned E2 = E + 0x800000u; if (E2 < E) break; const int n2 = cnt(E2); if (n2 < 16) break; E = E2; n = n2; } }
    else { do { E -= 0x800000u; n = cnt(E); } while (n < 16); }
    unsigned T = E;
    for (int bit = 22; bit >= 0 && n != 16; --bit) { const unsigned c = T | (1u << bit); n = cnt(c); if (n >= 16) T = c; else n = 17; }
    exact = (n == 16);
    return T;
}
__device__ __forceinline__ unsigned fkey(float f) { const unsigned u = __float_as_uint(f); return (u & 0x80000000u) ? ~u : (u | 0x80000000u); }
__device__ __forceinline__ unsigned mbcnt64(unsigned long long m) { return __builtin_amdgcn_mbcnt_hi((unsigned)(m >> 32), __builtin_amdgcn_mbcnt_lo((unsigned)m, 0u)); }
__device__ __forceinline__ int rowsum16(int v) { v += dppi<0xB1>(v); v += dppi<0x4E>(v); v += dppi<0x141>(v); v += dppi<0x140>(v); return v; }
__device__ __forceinline__ int rowscan16(int v) { v += dppi<0x111>(v); v += dppi<0x112>(v); v += dppi<0x114>(v); v += dppi<0x118>(v); return v; }
__device__ __forceinline__ int qcount8p(unsigned k0, unsigned k1, unsigned k2, unsigned k3, unsigned k4, unsigned k5, unsigned k6, unsigned k7, unsigned x, int cin) {
    int c; unsigned long long m0, m1, m2, m3, m4, m5, m6, m7;
    asm volatile("v_cmp_ge_u32_e64 %1, %9, %17\n\tv_cmp_ge_u32_e64 %2, %10, %17\n\tv_cmp_ge_u32_e64 %3, %11, %17\n\tv_cmp_ge_u32_e64 %4, %12, %17\n\t"
                 "v_cmp_ge_u32_e64 %5, %13, %17\n\tv_cmp_ge_u32_e64 %6, %14, %17\n\tv_cmp_ge_u32_e64 %7, %15, %17\n\tv_cmp_ge_u32_e64 %8, %16, %17\n\t"
                 "v_addc_co_u32_e64 %0, vcc, %18, 0, %1\n\tv_addc_co_u32_e64 %0, vcc, %0, 0, %2\n\tv_addc_co_u32_e64 %0, vcc, %0, 0, %3\n\tv_addc_co_u32_e64 %0, vcc, %0, 0, %4\n\t"
                 "v_addc_co_u32_e64 %0, vcc, %0, 0, %5\n\tv_addc_co_u32_e64 %0, vcc, %0, 0, %6\n\tv_addc_co_u32_e64 %0, vcc, %0, 0, %7\n\tv_addc_co_u32_e64 %0, vcc, %0, 0, %8"
                 : "=&v"(c), "=&s"(m0), "=&s"(m1), "=&s"(m2), "=&s"(m3), "=&s"(m4), "=&s"(m5), "=&s"(m6), "=&s"(m7)
                 : "v"(k0), "v"(k1), "v"(k2), "v"(k3), "v"(k4), "v"(k5), "v"(k6), "v"(k7), "v"(x), "v"(cin) : "vcc");
    return c;
}
__device__ __forceinline__ int rowsum16a(int c) {
    asm volatile("s_nop 1\n\tv_add_u32_dpp %0, %0, %0 quad_perm:[1,0,3,2] row_mask:0xf bank_mask:0xf bound_ctrl:1\n\ts_nop 1\n\t"
                 "v_add_u32_dpp %0, %0, %0 quad_perm:[2,3,0,1] row_mask:0xf bank_mask:0xf bound_ctrl:1\n\ts_nop 1\n\t"
                 "v_add_u32_dpp %0, %0, %0 row_half_mirror row_mask:0xf bank_mask:0xf bound_ctrl:1\n\ts_nop 1\n\t"
                 "v_add_u32_dpp %0, %0, %0 row_mirror row_mask:0xf bank_mask:0xf bound_ctrl:1" : "+v"(c));
    return c;
}
__device__ __forceinline__ void rowsum16a2(int& a, int& b) {
    asm volatile("s_nop 1\n\t"
                 "v_add_u32_dpp %0, %0, %0 quad_perm:[1,0,3,2] row_mask:0xf bank_mask:0xf bound_ctrl:1\n\tv_add_u32_dpp %1, %1, %1 quad_perm:[1,0,3,2] row_mask:0xf bank_mask:0xf bound_ctrl:1\n\ts_nop 0\n\t"
                 "v_add_u32_dpp %0, %0, %0 quad_perm:[2,3,0,1] row_mask:0xf bank_mask:0xf bound_ctrl:1\n\tv_add_u32_dpp %1, %1, %1 quad_perm:[2,3,0,1] row_mask:0xf bank_mask:0xf bound_ctrl:1\n\ts_nop 0\n\t"
                 "v_add_u32_dpp %0, %0, %0 row_half_mirror row_mask:0xf bank_mask:0xf bound_ctrl:1\n\tv_add_u32_dpp %1, %1, %1 row_half_mirror row_mask:0xf bank_mask:0xf bound_ctrl:1\n\ts_nop 0\n\t"
                 "v_add_u32_dpp %0, %0, %0 row_mirror row_mask:0xf bank_mask:0xf bound_ctrl:1\n\tv_add_u32_dpp %1, %1, %1 row_mirror row_mask:0xf bank_mask:0xf bound_ctrl:1" : "+v"(a), "+v"(b));
}
template <int NV> __device__ __forceinline__ int qcountp(const unsigned (&k)[NV], unsigned x) {
    int c = 0;
#pragma unroll
    for (int e = 0; e < NV; e += 8) c = qcount8p(k[e], k[e + 1], k[e + 2], k[e + 3], k[e + 4], k[e + 5], k[e + 6], k[e + 7], x, c);
    return c;
}
template <int NV>
__device__ __forceinline__ void qsearch2(const unsigned (&ka)[NV], const unsigned (&kb)[NV], unsigned start, unsigned& TA, int& nA, unsigned& TB, int& nB) {
    unsigned EA = start, EB = start;
    int loA = qcountp<NV>(ka, start), hiA = qcountp<NV>(ka, start + 0x800000u); rowsum16a2(loA, hiA);
    int loB = qcountp<NV>(kb, start), hiB = qcountp<NV>(kb, start + 0x800000u); rowsum16a2(loB, hiB);
    for (;;) {
        const bool upA = hiA >= 16 && EA < 0xFF000000u, dnA = loA < 16, upB = hiB >= 16 && EB < 0xFF000000u, dnB = loB < 16;
        if (__ballot(upA || dnA || upB || dnB) == 0ull) break;
        EA = upA ? EA + 0x800000u : (dnA ? EA - 0x800000u : EA); EB = upB ? EB + 0x800000u : (dnB ? EB - 0x800000u : EB);
        const unsigned xA = upA ? EA + 0x800000u : EA, xB = upB ? EB + 0x800000u : EB;
        int cA = qcountp<NV>(ka, xA), cB = qcountp<NV>(kb, xB); rowsum16a2(cA, cB);
        const int l2A = upA ? hiA : (dnA ? cA : loA), h2A = upA ? cA : (dnA ? loA : hiA); loA = l2A; hiA = h2A;
        const int l2B = upB ? hiB : (dnB ? cB : loB), h2B = upB ? cB : (dnB ? loB : hiB); loB = l2B; hiB = h2B;
    }
    TA = EA; nA = loA; TB = EB; nB = loB;
    for (unsigned bit = 1u << 22; bit != 0u && __ballot((nA != 16) || (nB != 16)) != 0ull; bit >>= 1) {
        const unsigned xA = TA | bit, xB = TB | bit;
        int cA = qcountp<NV>(ka, xA), cB = qcountp<NV>(kb, xB); rowsum16a2(cA, cB);
        const bool gA = cA >= 16, gB = cB >= 16;
        TA = gA ? xA : TA; nA = gA ? cA : nA; TB = gB ? xB : TB; nB = gB ? cB : nB;
    }
}
template <int NV>
__device__ __forceinline__ void qsearch1(const unsigned (&k)[NV], unsigned start, unsigned& T, int& n) {
    unsigned E = start;
    int lo = qcountp<NV>(k, start), hi = qcountp<NV>(k, start + 0x800000u); rowsum16a2(lo, hi);
    for (;;) {
        const bool up = hi >= 16 && E < 0xFF000000u, dn = lo < 16;
        if (__ballot(up || dn) == 0ull) break;
        E = up ? E + 0x800000u : (dn ? E - 0x800000u : E);
        const unsigned x = up ? E + 0x800000u : E;
        const int c = rowsum16a(qcountp<NV>(k, x));
        const int l2 = up ? hi : (dn ? c : lo), h2 = up ? c : (dn ? lo : hi); lo = l2; hi = h2;
    }
    T = E; n = lo;
    for (unsigned bit = 1u << 22; bit != 0u && __ballot(n != 16) != 0ull; bit >>= 1) {
        const unsigned x = T | bit;
        const int c = rowsum16a(qcountp<NV>(k, x));
        const bool g = c >= 16;
        T = g ? x : T; n = g ? c : n;
    }
}
template <int NV, class PayF>
__device__ __forceinline__ void qcompact(char* smem, const unsigned (&k)[NV], const float (&val)[NV], PayF pay, unsigned T, int n, int dst, int dump) {
    if (__ballot(n != 16) == 0ull) {
        int c = 0;
#pragma unroll
        for (int e = 0; e < NV; ++e) c += (k[e] >= T) ? 1 : 0;
        int pos = rowscan16(c) - c;
#pragma unroll
        for (int e = 0; e < NV; ++e) {
            const bool sel = k[e] >= T;
            *(float2*)(smem + (sel ? dst + pos * 8 : dump)) = make_float2(val[e], __int_as_float(pay(e)));
            pos += sel ? 1 : 0;
        }
    } else {
        int cg = 0, ce = 0;
#pragma unroll
        for (int e = 0; e < NV; ++e) { cg += (k[e] > T) ? 1 : 0; ce += (k[e] == T) ? 1 : 0; }
        const int need = 16 - rowsum16(cg), tr0 = rowscan16(ce) - ce;
        int c = 0, tr = tr0;
#pragma unroll
        for (int e = 0; e < NV; ++e) { const bool eq = k[e] == T; c += ((k[e] > T) || (eq && tr < need)) ? 1 : 0; tr += eq ? 1 : 0; }
        int pos = rowscan16(c) - c; tr = tr0;
#pragma unroll
        for (int e = 0; e < NV; ++e) {
            const bool eq = k[e] == T, sel = (k[e] > T) || (eq && tr < need);
            *(float2*)(smem + (sel ? dst + pos * 8 : dump)) = make_float2(val[e], __int_as_float(pay(e)));
            pos += sel ? 1 : 0; tr += eq ? 1 : 0;
        }
    }
}
template <class NextF, class DoneF>
__device__ __forceinline__ void peer_select_loop(const P& p, int L, char* smem, NextF&& next_item, DoneF&& done_item) {
    float* S = (float*)smem;
    const int tid = otid(), lane = tid & 63, wid = tid >> 6, fr = lane & 15, fq = lane >> 4;
    const bf16_t* KBL = p.KB + (size_t)L * 8 * 2 * 128 * 128;
    bf16x8 kfr[8][4];
    int hcur = -1;
    for (int ndone = 0;; ++ndone) {
        const int item = next_item(ndone);
        if (item < 0) break;
        const int h = item & 7, t0 = (item >> 3) * 32;
        __syncthreads();
        {
            const int pp = wid >> 1, th = wid & 1;
            const bf16_t* qp = p.QB + (size_t)(t0 + th * 16 + fr) * 2048 + h * 256 + pp * 128 + fq * 8;
            bf16x8 qf[4];
#pragma unroll
            for (int ks = 0; ks < 4; ++ks) qf[ks] = *(const bf16x8*)(qp + ks * 32);
#ifndef SEL_NOCACHE
            if (h != hcur)
#endif
            {
                const bf16_t* kp = KBL + ((size_t)(h * 2 + pp) * 128 + fr) * 128 + fq * 8;
#pragma unroll
                for (int ni = 0; ni < 8; ++ni)
#pragma unroll
                    for (int ks = 0; ks < 4; ++ks) kfr[ni][ks] = *(const bf16x8*)(kp + (size_t)ni * 16 * 128 + ks * 32);
                hcur = h;
            }
#pragma unroll
            for (int ni = 0; ni < 8; ++ni) {
                f32x4 acc = (f32x4){0.f, 0.f, 0.f, 0.f};
#pragma unroll
                for (int ks = 0; ks < 4; ++ks) acc = __builtin_amdgcn_mfma_f32_16x16x32_bf16(qf[ks], kfr[ni][ks], acc, 0, 0, 0);
#pragma unroll
                for (int j = 0; j < 4; ++j) S[(pp * 32 + th * 16 + fq * 4 + j) * SEL_LD + ni * 16 + fr] = acc[j];
            }
        }
        __syncthreads();
#pragma unroll 1
        for (int quad = 0; quad < 2; ++quad) {
            const int q = lane >> 4, i = lane & 15, t = wid * 8 + quad * 4 + q, r = t0 + t;
            const int wbase = 34816 + wid * 2560, rowb = wbase + q * 512, dump = wbase + 2048 + lane * 8;
            float vA[8], vB[8]; unsigned kA[8], kB[8];
#pragma unroll
            for (int m = 0; m < 2; ++m) {
                const float4 a4 = *(const float4*)(S + t * SEL_LD + 64 * m + 4 * i), b4 = *(const float4*)(S + (32 + t) * SEL_LD + 64 * m + 4 * i);
                vA[4 * m] = a4.x; vA[4 * m + 1] = a4.y; vA[4 * m + 2] = a4.z; vA[4 * m + 3] = a4.w;
                vB[4 * m] = b4.x; vB[4 * m + 1] = b4.y; vB[4 * m + 2] = b4.z; vB[4 * m + 3] = b4.w;
            }
#pragma unroll
            for (int e = 0; e < 8; ++e) { kA[e] = fkey(vA[e]); kB[e] = fkey(vB[e]); }
            {
                unsigned TA, TB; int nA, nB;
                qsearch2<8>(kA, kB, 0xBF800000u, TA, nA, TB, nB);
                const int ib = 4 * i;
                qcompact<8>(smem, kA, vA, [&](int e) { return ib + 64 * (e >> 2) + (e & 3); }, TA, nA, rowb, dump);
                qcompact<8>(smem, kB, vB, [&](int e) { return ib + 64 * (e >> 2) + (e & 3); }, TB, nB, rowb + 128, dump);
            }
            __builtin_amdgcn_wave_barrier();
            {
                const float2 av = *(const float2*)(smem + rowb + i * 8);
                float cand[16]; unsigned kc[16]; int bidx[16];
#pragma unroll
                for (int j2 = 0; j2 < 8; ++j2) {
                    const float4 bb = *(const float4*)(smem + rowb + 128 + j2 * 16);
                    cand[2 * j2] = av.x + bb.x; bidx[2 * j2] = __float_as_int(bb.y); cand[2 * j2 + 1] = av.x + bb.z; bidx[2 * j2 + 1] = __float_as_int(bb.w);
                }
#pragma unroll
                for (int j = 0; j < 16; ++j) kc[j] = fkey(cand[j]);
                unsigned TC; int nC;
                qsearch1<16>(kc, 0xC0800000u, TC, nC);
                const int ai128 = __float_as_int(av.y) * 128;
                __builtin_amdgcn_wave_barrier();
                qcompact<16>(smem, kc, cand, [&](int e) { return ai128 + bidx[e]; }, TC, nC, rowb + 256, dump);
            }
            __builtin_amdgcn_wave_barrier();
            {
                const float2 cv = *(const float2*)(smem + rowb + 256 + i * 8);
                float mx = cv.x;
                mx = fmaxf(mx, dppf<0xB1, 0xF>(mx, mx)); mx = fmaxf(mx, dppf<0x4E, 0xF>(mx, mx)); mx = fmaxf(mx, dppf<0x141, 0xF>(mx, mx)); mx = fmaxf(mx, dppf<0x140, 0xF>(mx, mx));
                const float ex = __builtin_amdgcn_exp2f((cv.x - mx) * 1.4426950408889634f);
                float sum = ex;
                sum += dppf<0xB1, 0xF>(sum, 0.f); sum += dppf<0x4E, 0xF>(sum, 0.f); sum += dppf<0x141, 0xF>(sum, 0.f); sum += dppf<0x140, 0xF>(sum, 0.f);
                __hip_atomic_store(&p.GATE[(size_t)r * 128 + h * 16 + i], ex * __builtin_amdgcn_rcpf(sum), __ATOMIC_RELAXED, __HIP_MEMORY_SCOPE_AGENT);
                __hip_atomic_store(&p.EIDX[(size_t)r * 128 + h * 16 + i], __float_as_int(cv.y), __ATOMIC_RELAXED, __HIP_MEMORY_SCOPE_AGENT);
            }
            __builtin_amdgcn_wave_barrier();
        }
        done_item(item);
    }
}


__device__ __forceinline__ int wave_sum_i(int v, int lane) {
    v += __builtin_amdgcn_update_dpp(0, v, 0xB1, 0xF, 0xF, true);
    v += __builtin_amdgcn_update_dpp(0, v, 0x4E, 0xF, 0xF, true);
    v += __builtin_amdgcn_update_dpp(0, v, 0x141, 0xF, 0xF, true);
    v += __builtin_amdgcn_update_dpp(0, v, 0x140, 0xF, 0xF, true);
    v += __builtin_amdgcn_update_dpp(0, v, 0x142, 0xA, 0xF, false);
    v += __builtin_amdgcn_update_dpp(0, v, 0x143, 0xC, 0xF, false);
    return __builtin_amdgcn_readlane(v, 63);
}
__device__ __forceinline__ int tred32(const int (&s)[32], int lane) {
    int t1[16], t2[8], t3[4], t4[2];
#pragma unroll
    for (int j = 0; j < 16; ++j) { const auto q = __builtin_amdgcn_permlane32_swap((unsigned)s[j], (unsigned)s[j + 16], false, false); t1[j] = (int)(q[0] + q[1]); }
#pragma unroll
    for (int j = 0; j < 8; ++j) { const auto q = __builtin_amdgcn_permlane16_swap((unsigned)t1[j], (unsigned)t1[j + 8], false, false); t2[j] = (int)(q[0] + q[1]); }
#pragma unroll
    for (int j = 0; j < 4; ++j) { const int ra = t2[j] + dppi<0x128>(t2[j]), rb = t2[j + 4] + dppi<0x128>(t2[j + 4]); t3[j] = (lane & 8) ? rb : ra; }
#pragma unroll
    for (int j = 0; j < 2; ++j) { const int ra = t3[j] + dppi<0x141>(t3[j]), rb = t3[j + 2] + dppi<0x141>(t3[j + 2]); t4[j] = (lane & 4) ? rb : ra; }
    const int ra = t4[0] + dppi<0x4E>(t4[0]), rb = t4[1] + dppi<0x4E>(t4[1]);
    return (lane & 2) ? rb : ra;
}
__device__ __forceinline__ void peer_gather_token(const P& p, int L, int r, float oscale, int lane, char* lrow) {
    const unsigned char* U = p.U8 + (size_t)L * 16384 * 512; const unsigned char* V = p.V8 + (size_t)L * 16384 * 512;
    const float* USC = p.USC + (size_t)L * 16384; const float* VSC = p.VSC + (size_t)L * 16384;
    const float* gate2 = p.modv + (size_t)L * 9 * 6144 + 5120;
    {
        const int sig = (lane & 1) * 32 + (lane >> 1);
        const int e0 = p.EIDX[(size_t)r * 128 + sig], e1 = p.EIDX[(size_t)r * 128 + 64 + sig];
        const float g0 = p.GATE[(size_t)r * 128 + sig], g1 = p.GATE[(size_t)r * 128 + 64 + sig];
        const float us0 = USC[e0], us1 = USC[e1], vs0 = VSC[e0], vs1 = VSC[e1];
        const uint4 xq = *(const uint4*)(p.XQ + (size_t)r * DM + lane * 16);
        const float xs = p.XS[r];
        const int slo = __builtin_amdgcn_sdot4((int)xq.x, 0x01010101, __builtin_amdgcn_sdot4((int)xq.z, 0x01010101, 0, false), false);
        const int shi = __builtin_amdgcn_sdot4((int)xq.y, 0x01010101, __builtin_amdgcn_sdot4((int)xq.w, 0x01010101, 0, false), false);
        const float cx = 0.5f * (float)wave_sum_i(shi - 15 * slo, lane);
        int d0 = 0, d1 = 0;
        const unsigned lane8 = (unsigned)lane * 8u, l16 = (unsigned)(lane & 31) * 16u;
        const bool hw = lane >= 32;
#define G_ISSUE(TAB, EV, KB) { _Pragma("unroll") for (int pr = 0; pr < 16; ++pr) { \
            const unsigned ia = (unsigned)__builtin_amdgcn_readlane((EV), 4 * pr + (KB)), ib = (unsigned)__builtin_amdgcn_readlane((EV), 4 * pr + 2 + (KB));   \
            __builtin_amdgcn_global_load_lds((const unsigned*)((TAB) + (size_t)((hw ? ib : ia) * 512u + l16)), (LDS_AS unsigned*)(lrow + pr * 1024), 16, 0, 0); } }
#define G_FETCH(UA) { _Pragma("unroll") for (int j = 0; j < 32; ++j) UA[j] = *(const uint2*)(lrow + j * 512 + lane8); asm volatile("s_waitcnt lgkmcnt(0)" ::: "memory"); }
        G_ISSUE(U, e0, 0)
#pragma unroll
        for (int half = 0; half < 2; ++half) {
            const int ev = half ? e1 : e0;
            int x0 = 0, x1 = 0;
#pragma unroll 1
            for (int kb = 0; kb < 2; ++kb) {
                uint2 ua[32];
                G_FETCH(ua)
                {
                    const int evn = kb == 0 ? ev : (half == 0 ? e1 : e0); const int kbn = kb ^ 1;
                    const unsigned char* tabn = (kb == 1 && half == 1) ? V : U;
                    G_ISSUE(tabn, evn, kbn)
                }
                int sd[32];
#pragma unroll
                for (int j = 0; j < 32; ++j) {
                    int t = __builtin_amdgcn_sdot4((int)xq.x, (int)(ua[j].x & 0x0F0F0F0Fu), 0, false);
                    t = __builtin_amdgcn_sdot4((int)xq.z, (int)(ua[j].y & 0x0F0F0F0Fu), t, false) << 4;
                    t = __builtin_amdgcn_sdot4((int)xq.y, (int)(ua[j].x & 0xF0F0F0F0u), t, false);
                    sd[j] = __builtin_amdgcn_sdot4((int)xq.w, (int)(ua[j].y & 0xF0F0F0F0u), t, false);
                }
                const int t = tred32(sd, lane);
                if (kb) x1 = t; else x0 = t;
            }
            const int f0 = x0 + dppi<0xB1>(x0), f1 = x1 + dppi<0xB1>(x1);
            const int dv = (lane & 1) ? f1 : f0;
            if (half) d1 = dv; else d0 = dv;
        }
        const float a0 = us0 * xs * ((float)d0 * 0.0625f + cx), a1 = us1 * xs * ((float)d1 * 0.0625f + cx);
        const float w0 = vs0 * g0 * 0.5f * a0 * (1.f + erff(a0 * 0.70710678118654752f));
        const float w1 = vs1 * g1 * 0.5f * a1 * (1.f + erff(a1 * 0.70710678118654752f));
        const float wmax = wave_max(fmaxf(fabsf(w0), fabsf(w1)));
        const float winv = wmax > 0.f ? 127.f / wmax : 0.f;
        const int wi0 = (int)rintf(w0 * winv), wi1 = (int)rintf(w1 * winv);
        const int wq0 = wi0 & 0xff, wq1 = wi1 & 0xff;
        const float cw = (float)wave_sum_i(wi0 + wi1, lane);
        int accf[8], acch[8];
        float4 hq[4], gq2[4];
#pragma unroll
        for (int c = 0; c < 8; ++c) { accf[c] = 0; acch[c] = 0; }
#pragma unroll
        for (int half = 0; half < 2; ++half) {
            const int ev = half ? e1 : e0; const int wqs = half ? wq1 : wq0;
            const int wqv = wqs | (__builtin_amdgcn_update_dpp(0, wqs, 0x102, 0xF, 0xF, true) << 8) | (__builtin_amdgcn_update_dpp(0, wqs, 0x104, 0xF, 0xF, true) << 16) | (__builtin_amdgcn_update_dpp(0, wqs, 0x106, 0xF, 0xF, true) << 24);
#pragma unroll 1
            for (int kb = 0; kb < 2; ++kb) {
                uint2 ua[32];
                G_FETCH(ua)
                if (!(kb == 1 && half == 1)) { const int evn = kb == 0 ? ev : e1; const int kbn = kb ^ 1; G_ISSUE(V, evn, kbn) }
                else {
                    const float* gp_ = gate2 + (size_t)modrow(r) * 6144 + lane * 16; const float* hp_ = p.H + (size_t)r * DM + lane * 16;
#pragma unroll
                    for (int q = 0; q < 4; ++q) { gq2[q] = *(const float4*)(gp_ + q * 4); hq[q] = *(const float4*)(hp_ + q * 4); }
                }
#pragma unroll
                for (int j4 = 0; j4 < 8; ++j4) {
                    const int k0 = j4 * 8 + kb;
                    const int wpk = __builtin_amdgcn_readlane(wqv, k0);
#define TR_ONE(I, T) { const unsigned tt = (T); accf[I] = __builtin_amdgcn_sdot4((int)tt, wpk, accf[I], false); acch[I] = __builtin_amdgcn_sdot4((int)(tt & 0xF0F0F0F0u), wpk, acch[I], false); }
#define TR_DOT(D, M) { const unsigned ablo = __builtin_amdgcn_perm(ua[j4 * 4 + 1].M, ua[j4 * 4].M, 0x05010400u), abhi = __builtin_amdgcn_perm(ua[j4 * 4 + 1].M, ua[j4 * 4].M, 0x07030602u); \
                        const unsigned celo = __builtin_amdgcn_perm(ua[j4 * 4 + 3].M, ua[j4 * 4 + 2].M, 0x05010400u), cehi = __builtin_amdgcn_perm(ua[j4 * 4 + 3].M, ua[j4 * 4 + 2].M, 0x07030602u); \
                        TR_ONE((D) * 4 + 0, __builtin_amdgcn_perm(celo, ablo, 0x05040100u)) TR_ONE((D) * 4 + 1, __builtin_amdgcn_perm(celo, ablo, 0x07060302u)) \
                        TR_ONE((D) * 4 + 2, __builtin_amdgcn_perm(cehi, abhi, 0x05040100u)) TR_ONE((D) * 4 + 3, __builtin_amdgcn_perm(cehi, abhi, 0x07060302u)) }
                    TR_DOT(0, x) TR_DOT(1, y)
#undef TR_DOT
#undef TR_ONE
                }
            }
        }
#undef G_FETCH
#undef G_ISSUE
        float acc[16];
#pragma unroll
        for (int j = 0; j < 4; ++j) {
            acc[j] = (float)(accf[j] - acch[j]) - 7.5f * cw;          acc[4 + j] = (float)acch[j] * 0.0625f + 0.5f * cw;
            acc[8 + j] = (float)(accf[4 + j] - acch[4 + j]) - 7.5f * cw;  acc[12 + j] = (float)acch[4 + j] * 0.0625f + 0.5f * cw;
        }
        const float osc = oscale * wmax * (1.f / 127.f);
        const float* gp = gate2 + (size_t)modrow(r) * 6144 + lane * 16;
        float* hp = p.H + (size_t)r * DM + lane * 16;
        float hn[16]; float ss = 0.f;
#pragma unroll
        for (int q = 0; q < 4; ++q) {
            const float4 g = gq2[q];
            float4 hv = hq[q];
            hv.x += osc * g.x * (float)acc[q * 4 + 0]; hv.y += osc * g.y * (float)acc[q * 4 + 1];
            hv.z += osc * g.z * (float)acc[q * 4 + 2]; hv.w += osc * g.w * (float)acc[q * 4 + 3];
            if (L < 3) *(float4*)(hp + q * 4) = hv;
            hn[q * 4 + 0] = hv.x; hn[q * 4 + 1] = hv.y; hn[q * 4 + 2] = hv.z; hn[q * 4 + 3] = hv.w;
            ss += hv.x * hv.x + hv.y * hv.y + hv.z * hv.z + hv.w * hv.w;
        }
        ss = wave_sum(ss);
        const float rstd = rsqrtf(ss * (1.0f / DM) + 1e-6f);
        if (L < 3) {
            const float* g1 = p.norm1_g + (size_t)(L + 1) * DM + lane * 16;
            const float* mvn = p.modv + ((size_t)(L + 1) * 9 + modrow(r)) * 6144 + lane * 16;
            unsigned w[8];
#pragma unroll
            for (int q = 0; q < 4; ++q) {
                const float4 gg = *(const float4*)(g1 + q * 4), sh = *(const float4*)(mvn + q * 4), scl = *(const float4*)(mvn + 1024 + q * 4);
                w[q * 2] = cvt_pk_bf16(hn[q * 4 + 0] * rstd * gg.x * (1.f + scl.x) + sh.x, hn[q * 4 + 1] * rstd * gg.y * (1.f + scl.y) + sh.y);
                w[q * 2 + 1] = cvt_pk_bf16(hn[q * 4 + 2] * rstd * gg.z * (1.f + scl.z) + sh.z, hn[q * 4 + 3] * rstd * gg.w * (1.f + scl.w) + sh.w);
            }
            uint4* xp = (uint4*)(p.XN + (size_t)r * DM + lane * 16);
            xp[0] = make_uint4(w[0], w[1], w[2], w[3]); xp[1] = make_uint4(w[4], w[5], w[6], w[7]);
        } else {
            const float* fg = p.final_g + lane * 16;
            float* op = p.out + (size_t)r * DM + lane * 16;
            float4 gq[4];
#pragma unroll
            for (int q = 0; q < 4; ++q) gq[q] = *(const float4*)(fg + q * 4);
#pragma unroll
            for (int q = 0; q < 4; ++q) {
                const float4 gg = gq[q];
                *(float4*)(op + q * 4) = make_float4(hn[q * 4 + 0] * rstd * gg.x, hn[q * 4 + 1] * rstd * gg.y, hn[q * 4 + 2] * rstd * gg.z, hn[q * 4 + 3] * rstd * gg.w);
            }
        }
    }
}

__device__ void ph_peer_sg(const P& p, int L, int nrows, int* q2, unsigned* tflag, float oscale, char* smem) {
    int* s_item = (int*)(smem + 73728);
    const int tid = otid(), lane = tid & 63, wid = __builtin_amdgcn_readfirstlane(tid >> 6);
    const int nsel = (nrows / 32) * 8, ngat = nrows / 4;
    const bool roleS = ((blockIdx.x >> 3) & 7) < 3;
    peer_select_loop(p, L, smem,
        [&](int ndone) -> int {
            if (!roleS && ndone >= 4) return -1;
            __syncthreads();
            if (tid == 0) *s_item = atomicAdd(&q2[0], 1);
            __syncthreads();
            const int it = *s_item;
            return it < nsel ? it : -1;
        },
        [&](int item) {
            asm volatile("s_waitcnt vmcnt(0)" ::: "memory");
            __syncthreads();
            if (tid == 0) __hip_atomic_fetch_add(&tflag[item >> 3], 1u, __ATOMIC_RELAXED, __HIP_MEMORY_SCOPE_AGENT);
        });
    for (;;) {
        __syncthreads();
        if (tid == 0) {
            const int g = atomicAdd(&q2[1], 1);
            *s_item = g;
            if (g < ngat) {
                unsigned sp = 0;
                while (__hip_atomic_load(&tflag[g >> 3], __ATOMIC_RELAXED, __HIP_MEMORY_SCOPE_AGENT) < 8u) { __builtin_amdgcn_s_sleep(2); if (++sp > (1u << 24)) break; }
                __builtin_amdgcn_fence(__ATOMIC_ACQUIRE, "agent");
                asm volatile("s_waitcnt vmcnt(0)" ::: "memory");
            }
        }
        __syncthreads();
        const int g = *s_item;
        if (g >= ngat) break;
        peer_gather_token(p, L, g * 4 + wid, oscale, lane, smem + wid * 16384);
    }
}

#define NSUB 11
__device__ __forceinline__ bool phase_empty(int ph) {
    if (ph == 0) return false;
    const int L = (ph - 1) / NSUB, s = (ph - 1) % NSUB;
    return s == 2 || s == 10 || ((L & 1) && (s == 4 || s == 5)) || (L > 0 && s == 0);
}
__device__ __forceinline__ void run_phase(const P& p, int ph, float* smem, int rep) {
    if (ph == 0) { ph_prologue(p, smem); return; }
    const int L = (ph - 1) / NSUB, s = (ph - 1) % NSUB, j = L >> 1;
    const bool even = (L & 1) == 0, need_ctx = L < 3;
    const int nrows = need_ctx ? NT : NL;
    const float* mv = p.modv + (size_t)L * 9 * 6144;
    switch (s) {
    case 0: ph_normmod(p.H, p.norm1_g + L * DM, mv, 0, 1024, p.XN, NT); break;
    case 1:
        if (even) ph_gemm(p.XN, p.WT + WT_EVIN(j), NT, 3200, EpiEven{p.PB, p.AQL, p.AQC, p.AK, p.AV, p.GT, p.rope}, (char*)smem);
        else ph_gemm(p.XN, p.WT + WT_ODIN(j), NT, ODW, EpiOdd{p.AQL, p.AQC, p.AK, p.AV, p.rope}, (char*)smem);
        break;
    case 3: if (even) ph_attn_even(p, L + 4 * rep, L, j, smem); else ph_attn_odd(p, j, need_ctx, smem); break;
    case 4: if (even) ph_ml_pass2(p); break;
    case 5: if (even) ph_ml_pass3(p, j, smem); break;
    case 6:
        if (L < 3) ph_gemm(p.MIX, p.WT + (even ? WT_EVOUT(j) : WT_ODOUT(j)), nrows, DM, EpiResid{p.H, mv + 2048, rep ? 0.f : 1.f}, (char*)smem, PrepTail{p.pr_u, p.pr_v, p.U8, p.V8, p.USC, p.VSC, L + 1, p.ctr + 32 + L});
        else ph_gemm(p.MIX, p.WT + (even ? WT_EVOUT(j) : WT_ODOUT(j)), nrows, DM, EpiResid{p.H, mv + 2048, rep ? 0.f : 1.f}, (char*)smem);
        break;
    case 7: ph_normmod_q(p, p.norm2_g + L * DM, mv, nrows); break;
    case 8: ph_gemm(p.XN, p.WT + WT_PQ(L), nrows, 2048, EpiStoreBF16{p.QB, 2048}, (char*)smem); break;
    case 9: ph_peer_sg(p, L, nrows, p.ctr + 16 + L * 2, (unsigned*)p.ctr + 256 + L * 576, rep ? 0.f : 1.f, (char*)smem); break;
    }
}

#define XB_TMO      128
#define XB_XCNT(j)  (256  + 64 * (j))
#define XB_XSUB(j)  (1280 + 64 * (j))
#define XB_XGEN(j)  (2304 + 64 * (j))
#define XB_TOP      3328
#define XB_TOPGEN   3392
#define XCD_BAR_WORDS 3456
#define XB_SPIN_CAP (1u << 20)
#define LAS __attribute__((address_space(3)))
__device__ __forceinline__ unsigned xb_ld(unsigned* p)              { return __hip_atomic_load(p, __ATOMIC_RELAXED, __HIP_MEMORY_SCOPE_AGENT); }
__device__ __forceinline__ unsigned xb_add(unsigned* p, unsigned v) { return __hip_atomic_fetch_add(p, v, __ATOMIC_RELAXED, __HIP_MEMORY_SCOPE_AGENT); }
__device__ __forceinline__ unsigned xb_xcc_id() { return (unsigned)__builtin_amdgcn_s_getreg((3 << 11) | 20) & 0xFu; }
#define XB_SPIN(cond, bar) do { unsigned _sp = 0; while (cond) { __builtin_amdgcn_s_sleep(1); \
    if ((++_sp & 255u) == 0u) { if (xb_ld(&(bar)[XB_TMO])) break; if (_sp > XB_SPIN_CAP) { atomicAdd(&(bar)[XB_TMO], 1u); break; } } } } while (0)
struct XcdBarrier { unsigned* bar; unsigned x; volatile LAS unsigned* st; };
__device__ __forceinline__ XcdBarrier xcd_barrier_post(unsigned* bar, volatile LAS unsigned* st) {
    XcdBarrier b; b.bar = bar; b.x = xb_xcc_id(); b.st = st;
    if (threadIdx.x == 0) (void)xb_add(&bar[XB_XCNT(b.x)], 1u);
    return b;
}
__device__ __forceinline__ void xcd_barrier_complete(unsigned* bar, unsigned x, unsigned& nloc, unsigned& nx) {
    const unsigned G = gridDim.x * gridDim.y * gridDim.z;
    unsigned sum, cnt, mine, sp = 0u;
    for (;;) {
        sum = 0u; cnt = 0u; mine = 0u;
#pragma unroll
        for (unsigned j = 0; j < 16; ++j) { const unsigned c = xb_ld(&bar[XB_XCNT(j)]); sum += c; cnt += (c > 0u) ? 1u : 0u; mine = (j == x) ? c : mine; }
        if (sum == G) break;
        __builtin_amdgcn_s_sleep(1);
        if ((++sp & 255u) == 0u) { if (xb_ld(&bar[XB_TMO])) break; if (sp > XB_SPIN_CAP) { atomicAdd(&bar[XB_TMO], 1u); break; } }
    }
    nloc = mine > 0u ? mine : 1u; nx = cnt > 0u ? cnt : 1u;
}
__device__ __forceinline__ void xcd_barrier(const XcdBarrier& b) {
    asm volatile("s_waitcnt vmcnt(0)" ::: "memory");
    __syncthreads();
    if (threadIdx.x == 0) {
        unsigned* bar = b.bar;
        __builtin_amdgcn_s_waitcnt(0);
        unsigned nloc = b.st[0], nx = b.st[1];
        if (nloc == 0u) { xcd_barrier_complete(bar, b.x, nloc, nx); b.st[0] = nloc; b.st[1] = nx; }
        const unsigned old = xb_add(&bar[XB_XSUB(b.x)], 1u);
        const unsigned gen = old / nloc;
        if (old + 1u == (gen + 1u) * nloc) {
            __builtin_amdgcn_fence(__ATOMIC_RELEASE, "agent");
            asm volatile("s_waitcnt vmcnt(0)" ::: "memory");
            const unsigned og = xb_add(&bar[XB_TOP], 1u);
            const unsigned tg = og / nx;
            if (og + 1u == (tg + 1u) * nx) xb_add(&bar[XB_TOPGEN], 1u);
            else XB_SPIN(xb_ld(&bar[XB_TOPGEN]) == tg, bar);
            __builtin_amdgcn_fence(__ATOMIC_ACQUIRE, "agent");
            xb_add(&bar[XB_XGEN(b.x)], 1u);
            asm volatile("s_waitcnt vmcnt(0)" ::: "memory");
        } else {
            XB_SPIN(xb_ld(&bar[XB_XGEN(b.x)]) == gen, bar);
            __builtin_amdgcn_fence(__ATOMIC_ACQUIRE, "agent");
            asm volatile("s_waitcnt vmcnt(0)" ::: "memory");
        }
    }
    __syncthreads();
}

__global__ void __launch_bounds__(256, 2) mega(P p) {
    extern __shared__ __attribute__((aligned(16))) float smem[];
    cg::grid_group grid = cg::this_grid();
    volatile LAS unsigned* st = (volatile LAS unsigned*)((char*)smem + 73744);
    if (threadIdx.x < 4) st[threadIdx.x] = 0u;
    __syncthreads();
    XcdBarrier xb = xcd_barrier_post(p.bar, st);
    for (int ph = p.ph_lo; ph < p.ph_hi; ++ph) {
        if (phase_empty(ph)) continue;
        run_phase(p, ph, smem, 0);
        if (PROBE_N > 1 && ph > 0 && (ph - 1) % NSUB == PROBE_S)
            for (int rep = 1; rep < PROBE_N; ++rep) { xcd_barrier(xb); run_phase(p, ph, smem, rep); }
        if (ph + 1 < p.ph_hi) { if (ph == 0) grid.sync(); else xcd_barrier(xb); }
    }
}

extern "C" void kernel_launch(void* const* d_in, const int* in_sizes, int n_in, void* d_out, int out_size, void* d_ws, size_t ws_size, hipStream_t stream) {
    static int grid_blocks = 0;
    if (!grid_blocks) {
        int dev = 0, cus = 0, per_cu = 0;
        hipGetDevice(&dev);
        hipDeviceGetAttribute(&cus, hipDeviceAttributeMultiprocessorCount, dev);
        hipFuncSetAttribute((const void*)mega, hipFuncAttributeMaxDynamicSharedMemorySize, LDS_BYTES);
        hipOccupancyMaxActiveBlocksPerMultiprocessor(&per_cu, mega, 256, LDS_BYTES);
        if (per_cu < 1) per_cu = 1;
        if (per_cu > 2) per_cu = 2;
        grid_blocks = cus * per_cu;
    }
    P p{};
    const float** ins = (const float**)&p;
    for (int i = 0; i < 24; ++i) ins[i] = (const float*)d_in[i];
    p.out = (float*)d_out;
    size_t off = 0; char* ws = (char*)d_ws;
    auto carve = [&](size_t bytes) { void* r = ws + off; off += (bytes + 255) & ~(size_t)255; return r; };
    p.modv = (float*)carve((size_t)4 * 9 * 6144 * 4);
    p.rope = (float*)carve((size_t)2048 * 64 * 4);
    p.H = (float*)carve((size_t)NT * DM * 4);
    p.XN = (bf16_t*)carve((size_t)NT * DM * 2);
    p.WT = (bf16_t*)carve(WT_TOTAL * 2);
    p.MIX = (bf16_t*)carve((size_t)NT * DM * 2);
    p.PB = (bf16_t*)carve((size_t)NT * 1536 * 2);
    p.GT = (float*)carve((size_t)NT * 16 * 4);
    p.AQL = (bf16_t*)carve((size_t)8 * 16 * 2048 * 64 * 2);
    p.AQC = (bf16_t*)carve((size_t)8 * 16 * 256 * 64 * 2);
    p.AK = (bf16_t*)carve((size_t)8 * 4 * 2 * 2304 * 64 * 2);
    p.AV = (bf16_t*)carve((size_t)8 * 4 * 128 * 2304 * 2);
    p.QKB = (bf16_t*)carve((size_t)NT * 512 * 2);
    p.CLOC = (float*)carve((size_t)2304 * 8192 * 4);
    p.CST = (bf16_t*)carve((size_t)2304 * 8192 * 2);
    p.NLOC = (float*)carve((size_t)2304 * 64 * 4);
    p.NST = (float*)carve((size_t)2304 * 64 * 4);
    p.CHB = (float*)carve((size_t)2304 * 4);
    p.CHM = (float*)carve((size_t)2304 * 4);
    p.MST = (float*)carve((size_t)2304 * 4);
    p.QB = (bf16_t*)carve((size_t)NT * 2048 * 2);
    p.GATE = (float*)carve((size_t)NT * 128 * 4);
    p.EIDX = (int*)carve((size_t)NT * 128 * 4);
    p.ctr = (int*)carve(2560 * 4);
    p.bar = (unsigned*)carve((size_t)XCD_BAR_WORDS * 4);
    p.U8 = (unsigned char*)carve((size_t)4 * 16384 * 512);
    p.V8 = (unsigned char*)carve((size_t)4 * 16384 * 512);
    p.XQ = (unsigned char*)carve((size_t)NT * DM);
    p.XS = (float*)carve((size_t)NT * 4);
    p.USC = (float*)carve((size_t)4 * 16384 * 4);
    p.VSC = (float*)carve((size_t)4 * 16384 * 4);
    p.KB = (bf16_t*)carve((size_t)4 * 8 * 2 * 128 * 128 * 2);
    if (off > ws_size) { fprintf(stderr, "kernel_launch: workspace too small: need %zu have %zu\n", off, ws_size); return; }
    hipMemsetAsync(p.bar, 0, (size_t)XCD_BAR_WORDS * 4, stream);
#if ONE_LAUNCH
    p.ph_lo = 0; p.ph_hi = NPH;
    void* args[] = {&p};
    hipError_t e = hipLaunchCooperativeKernel((void*)mega, dim3(grid_blocks), dim3(256), args, LDS_BYTES, stream);
    if (e != hipSuccess) fprintf(stderr, "cooperative launch failed: %s (grid %d)\n", hipGetErrorString(e), grid_blocks);
#else
    for (int ph = 0; ph < NPH; ++ph) {
        if (ph > 0 && ph < NPH - 1) { const int L = (ph - 1) / NSUB, s = (ph - 1) % NSUB; if ((s == 2 || s == 4 || s == 5) && (L & 1)) continue; }
        p.ph_lo = ph; p.ph_hi = ph + 1;
        hipLaunchKernelGGL(mega, dim3(grid_blocks), dim3(256), LDS_BYTES, stream, p);
    }
#endif
}
```
